# Optimizing an MI355X kernel written in HIP

```python
import math
import jax, jax.numpy as jnp
from jax import lax
import numpy as np

D_MODEL = 1024
BATCH = 1
SEQ = 16384
DEPTH = 4

GRID_W = 64
CTX_LEN = 256
RWKV_WIDTH = D_MODEL // 2
HEAD_DIM = 64
RWKV_HEADS = RWKV_WIDTH // HEAD_DIM
LORA_W = 64
LORA_A = 64
LORA_G = 128
DECAY_SCALE = 0.606531
GN_EPS = 6.4e-4
RWKV_COLS = 3 * RWKV_WIDTH + 2 * LORA_W + 2 * LORA_A + LORA_G
RWKV_SPLITS = (RWKV_WIDTH, 2 * RWKV_WIDTH, 3 * RWKV_WIDTH, 3 * RWKV_WIDTH + LORA_W, 3 * RWKV_WIDTH + 2 * LORA_W,
               3 * RWKV_WIDTH + 2 * LORA_W + LORA_A, 3 * RWKV_WIDTH + 2 * LORA_W + 2 * LORA_A)
HYENA_WIDTH = D_MODEL // 2
HYENA_COLS = 3 * HYENA_WIDTH
FILTER_BANDS = 16
FILTER_EMB = 1 + 2 * FILTER_BANDS
FILTER_HIDDEN = 64
HYENA_MIN_DECAY = math.log(1e-2) / 1.5
HYENA_MAX_DECAY = math.log(1e-2) / 0.3
GATE_COLS = 2 * D_MODEL
PROJ_COLS = RWKV_COLS + HYENA_COLS + GATE_COLS
N_EXPERTS = 16
N_GROUPS = 4
EXPERTS_PER_GROUP = N_EXPERTS // N_GROUPS
TOP_K = 2
D_EXPERT = D_MODEL
MOE_BLOCK = 128
ALPHA = (2 * DEPTH) ** 0.25
BETA = (8 * DEPTH) ** -0.25
LN_EPS = 1e-5

kernel_name = 'hybrid_rwkv7_hyena_moe_diffusion'


def _shift_seq(t, offset):
    if offset > 0:
        return jnp.pad(t[:, :-1], ((0, 0), (1, 0), (0, 0)))
    return jnp.pad(t[:, 1:], ((0, 0), (0, 1), (0, 0)))


def token_shift_latent(p):
    b, n, ch = p.shape
    rows = n // GRID_W
    q = ch // 4
    g = p.reshape(b, rows, GRID_W, ch)
    left = jnp.pad(g[:, :, :-1, :q], ((0, 0), (0, 0), (1, 0), (0, 0)))
    right = jnp.pad(g[:, :, 1:, q:2 * q], ((0, 0), (0, 0), (0, 1), (0, 0)))
    up = jnp.pad(g[:, :-1, :, 2 * q:3 * q], ((0, 0), (1, 0), (0, 0), (0, 0)))
    down = jnp.pad(g[:, 1:, :, 3 * q:], ((0, 0), (0, 1), (0, 0), (0, 0)))
    return jnp.concatenate([left, right, up, down], axis=-1).reshape(b, n, ch)


def token_shift_context(p):
    half = p.shape[-1] // 2
    return jnp.concatenate([_shift_seq(p[..., :half], 1), _shift_seq(p[..., half:], -1)], axis=-1)


def layer_norm(x, g, b):
    xf = x.astype(jnp.float32)
    mu = xf.mean(-1, keepdims=True)
    var = jnp.square(xf - mu).mean(-1, keepdims=True)
    return ((xf - mu) * lax.rsqrt(var + LN_EPS) * g + b).astype(x.dtype)


def post_norm(x, s, g, b):
    return layer_norm(ALPHA * x + s, g, b)


def modulate(x, shift, scale):
    return x * (1 + scale) + shift


def _heads(t):
    return t.reshape(t.shape[:-1] + (RWKV_HEADS, HEAD_DIM))


def l2_normalize_heads(t):
    th = _heads(t).astype(jnp.float32)
    nrm = jnp.sqrt(jnp.sum(th * th, axis=-1, keepdims=True))
    return (th / jnp.maximum(nrm, 1e-12)).reshape(t.shape).astype(t.dtype)


def group_norm_heads(y, g, b):
    yh = _heads(y).astype(jnp.float32)
    mu = yh.mean(-1, keepdims=True)
    var = jnp.square(yh - mu).mean(-1, keepdims=True)
    out = ((yh - mu) * lax.rsqrt(var + GN_EPS)).reshape(y.shape)
    return (out * g + b).astype(y.dtype)


def rwkv_prepare(p, shift_fn, mu, w0, w2, a0, a2, k_k, k_a):
    pm = p + (shift_fn(p) - p) * mu
    r, k, v, lw_f, lw_b, la_f, la_b, lg = jnp.split(pm, RWKV_SPLITS, axis=-1)
    lw = jnp.stack([lw_f, lw_b])
    la = jnp.stack([la_f, la_b])
    w = jnp.exp(-DECAY_SCALE * jax.nn.sigmoid(w0[:, None, None, :] + jnp.einsum('dblr,drc->dblc', jnp.tanh(lw), w2)))
    a = jax.nn.sigmoid(a0[:, None, None, :] + jnp.einsum('dblr,drc->dblc', la, a2))
    kk = l2_normalize_heads(k * k_k)
    k_dir = k[None] * (1 + (a - 1) * k_a)
    return r, k_dir, v, w, a, kk, lg


def delta_scan(r, w, k, v, kk, a, s0, reverse, emit):
    b, n, ch = r.shape

    def steps(t):
        return t.astype(jnp.float32).reshape(b, n, RWKV_HEADS, HEAD_DIM).transpose(1, 0, 2, 3)

    xs = (steps(r), steps(w), steps(k), steps(v), steps(-kk), steps(kk * a))

    def step(state, inp):
        r_t, w_t, k_t, v_t, ka_t, kb_t = inp
        sa = jnp.einsum('bhvk,bhk->bhv', state, ka_t)
        state = state * w_t[:, :, None, :] + sa[..., None] * kb_t[:, :, None, :] + v_t[..., None] * k_t[:, :, None, :]
        y = jnp.einsum('bhvk,bhk->bhv', state, r_t) if emit else None
        return state, y

    s_fin, ys = lax.scan(step, s0, xs, reverse=reverse)
    if not emit:
        return None, s_fin
    return ys.transpose(1, 0, 2, 3).reshape(b, n, ch).astype(r.dtype), s_fin


def rwkv_finish(r, k_dir, v, lg, y_f, y_b, r_k, lnx_g, lnx_b, g2):
    y = group_norm_heads(y_f + y_b, lnx_g, lnx_b)
    bonus = jnp.sum(_heads(r)[None] * _heads(k_dir) * r_k.reshape(RWKV_HEADS, HEAD_DIM), axis=(0, -1))
    y = y + (bonus[..., None] * _heads(v)).reshape(v.shape)
    return y * (jax.nn.sigmoid(lg) @ g2)


def hyena_filter(n, w1, b1, w2, b2, w3, b3, w_out, freq):
    pos = jnp.arange(n, dtype=jnp.float32)
    t = pos / max(n - 1, 1)
    bands = jnp.linspace(1e-4, FILTER_BANDS - 1, FILTER_BANDS, dtype=jnp.float32)
    ang = (2.0 * math.pi / n) * pos[:, None] * bands[None, :]
    z = jnp.concatenate([t[:, None], jnp.cos(ang), -jnp.sin(ang)], axis=-1)
    h = jnp.sin(freq * (z @ w1 + b1))
    h = jnp.sin(freq * (h @ w2 + b2))
    h = jnp.sin(freq * (h @ w3 + b3))
    filt = (h @ w_out).astype(jnp.float32)
    dist = jnp.abs(pos - n // 2) * (2.0 / n)
    deltas = jnp.abs(jnp.linspace(HYENA_MIN_DECAY, HYENA_MAX_DECAY, HYENA_WIDTH, dtype=jnp.float32))
    filt = filt * jnp.exp(-dist[:, None] * deltas[None, :])
    return filt / jnp.sum(jnp.abs(filt), axis=0, keepdims=True)


def long_conv(z, filt):
    n = z.shape[1]
    zf = jnp.fft.rfft(z.astype(jnp.float32), n=2 * n, axis=1)
    hf = jnp.fft.rfft(filt, n=2 * n, axis=0)
    y = jnp.fft.irfft(zf * hf[None], n=2 * n, axis=1)[:, n // 2:n // 2 + n]
    return y.astype(z.dtype)


def hyena_branch(p, conv_w, conv_b, filt, bias):
    u = _shift_seq(p, 1) * conv_w[0] + p * conv_w[1] + _shift_seq(p, -1) * conv_w[2] + conv_b
    x0, x1, v = jnp.split(u, 3, axis=-1)
    z = v * x1
    z = long_conv(z, filt) + z * bias
    return z * x0


def merge_branches(p_gate, y_rwkv, y_hyena, w_branch, w_out):
    g_r, g_h = jnp.split(jax.nn.sigmoid(p_gate), 2, axis=-1)
    return (g_r * (y_rwkv @ w_branch[0]) + g_h * (y_hyena @ w_branch[1])) @ w_out


def moe_ffn(h, w_router, router_bias, w_gate, w_up, w_down):
    n_tok, d = h.shape
    scores = jax.nn.softmax((h @ w_router).astype(jnp.float32), axis=-1)
    sel = scores + router_bias
    group_score = lax.top_k(sel.reshape(n_tok, N_GROUPS, EXPERTS_PER_GROUP), TOP_K)[0].sum(-1)
    best_group = jnp.argmax(group_score, axis=-1)
    in_group = (jnp.arange(N_EXPERTS) // EXPERTS_PER_GROUP)[None, :] == best_group[:, None]
    _, idx = lax.top_k(jnp.where(in_group, sel, -jnp.inf), TOP_K)
    wts = jnp.take_along_axis(scores, idx, axis=1)
    wts = wts / wts.sum(-1, keepdims=True)

    n_slots = n_tok * TOP_K
    n_blocks = -(-n_slots // MOE_BLOCK) + N_EXPERTS
    flat_e = idx.reshape(-1).astype(jnp.int32)
    flat_tok = jnp.repeat(jnp.arange(n_tok, dtype=jnp.int32), TOP_K)
    order = jnp.argsort(flat_e, stable=True)
    sorted_e = flat_e[order]
    counts = jnp.bincount(flat_e, length=N_EXPERTS)
    padded = ((counts + MOE_BLOCK - 1) // MOE_BLOCK) * MOE_BLOCK
    start = jnp.cumsum(counts) - counts
    pend = jnp.cumsum(padded)
    pstart = pend - padded
    dest = (pstart[sorted_e] + jnp.arange(n_slots) - start[sorted_e]).astype(jnp.int32)
    buf_tok = jnp.full((n_blocks * MOE_BLOCK,), n_tok, jnp.int32).at[dest].set(flat_tok[order])
    block_e = jnp.clip(jnp.searchsorted(pend, jnp.arange(n_blocks) * MOE_BLOCK, side='right'), 0, N_EXPERTS - 1)
    h_pad = jnp.concatenate([h, jnp.zeros((1, d), h.dtype)], axis=0)
    xb = h_pad[buf_tok].reshape(n_blocks, MOE_BLOCK, d)

    def expert_block(args):
        xblk, e = args
        return (jax.nn.silu(xblk @ w_gate[e]) * (xblk @ w_up[e])) @ w_down[e]

    yb = lax.map(expert_block, (xb, block_e)).reshape(n_blocks * MOE_BLOCK, d)
    y_slots = jnp.zeros((n_slots, d), yb.dtype).at[order].set(yb[dest])
    return (y_slots.reshape(n_tok, TOP_K, d) * wts[..., None].astype(yb.dtype)).sum(1)


def setup_inputs(seed: int = 0) -> dict:
    key = jax.random.key(seed)
    ks = iter(jax.random.split(key, 48))
    d = D_MODEL

    def nrm(shape, s):
        return jax.random.normal(next(ks), shape, jnp.float32) * s

    return {
        'x': nrm((BATCH, SEQ, d), 1.0),
        'c': nrm((BATCH, d), 1.0),
        'ctx': nrm((BATCH, CTX_LEN, d), 1.0),
        'c_ctx': nrm((d,), 1.0),
        'w_mod': nrm((DEPTH, d, 6 * d), 0.5 * d ** -0.5),
        'b_mod': nrm((DEPTH, 6 * d), 0.02),
        'w_in': nrm((DEPTH, d, PROJ_COLS), d ** -0.5),
        'rwkv_mu': jax.random.uniform(next(ks), (DEPTH, RWKV_COLS), jnp.float32),
        'rwkv_w0': nrm((DEPTH, 2, RWKV_WIDTH), 0.5),
        'rwkv_w2': nrm((DEPTH, 2, LORA_W, RWKV_WIDTH), 0.5 * LORA_W ** -0.5),
        'rwkv_a0': nrm((DEPTH, 2, RWKV_WIDTH), 0.5),
        'rwkv_a2': nrm((DEPTH, 2, LORA_A, RWKV_WIDTH), 0.5 * LORA_A ** -0.5),
        'rwkv_g2': nrm((DEPTH, LORA_G, RWKV_WIDTH), LORA_G ** -0.5),
        'rwkv_k_k': 0.85 + nrm((DEPTH, RWKV_WIDTH), 0.05),
        'rwkv_k_a': 1.0 + nrm((DEPTH, RWKV_WIDTH), 0.05),
        'rwkv_r_k': nrm((DEPTH, RWKV_WIDTH), 0.1),
        'rwkv_lnx_g': 1.0 + nrm((DEPTH, RWKV_WIDTH), 0.05),
        'rwkv_lnx_b': nrm((DEPTH, RWKV_WIDTH), 0.01),
        'hy_conv_w': nrm((DEPTH, 3, HYENA_COLS), 3 ** -0.5),
        'hy_conv_b': nrm((DEPTH, HYENA_COLS), 0.01),
        'hy_f_w1': nrm((DEPTH, FILTER_EMB, FILTER_HIDDEN), FILTER_EMB ** -0.5),
        'hy_f_b1': nrm((DEPTH, FILTER_HIDDEN), 0.1),
        'hy_f_w2': nrm((DEPTH, FILTER_HIDDEN, FILTER_HIDDEN), FILTER_HIDDEN ** -0.5),
        'hy_f_b2': nrm((DEPTH, FILTER_HIDDEN), 0.1),
        'hy_f_w3': nrm((DEPTH, FILTER_HIDDEN, FILTER_HIDDEN), FILTER_HIDDEN ** -0.5),
        'hy_f_b3': nrm((DEPTH, FILTER_HIDDEN), 0.1),
        'hy_f_wout': nrm((DEPTH, FILTER_HIDDEN, HYENA_WIDTH), FILTER_HIDDEN ** -0.5),
        'hy_freq': 1.0 + nrm((DEPTH, FILTER_HIDDEN), 0.05),
        'hy_bias': nrm((DEPTH, HYENA_WIDTH), 1.0),
        'w_branch': nrm((DEPTH, 2, RWKV_WIDTH, d), RWKV_WIDTH ** -0.5),
        'w_out': nrm((DEPTH, d, d), BETA * d ** -0.5),
        'ln_g': 1.0 + nrm((DEPTH, 2, d), 0.05),
        'ln_b': nrm((DEPTH, 2, d), 0.01),
        'w_router': nrm((d, N_EXPERTS), d ** -0.5),
        'router_bias': nrm((N_EXPERTS,), 0.01),
        'w_gate': nrm((DEPTH, N_EXPERTS, d, D_EXPERT), d ** -0.5),
        'w_up': nrm((DEPTH, N_EXPERTS, d, D_EXPERT), d ** -0.5),
        'w_down': nrm((DEPTH, N_EXPERTS, D_EXPERT, d), BETA * D_EXPERT ** -0.5),
    }


def reference(x, c, ctx, c_ctx, w_mod, b_mod, w_in, rwkv_mu, rwkv_w0, rwkv_w2, rwkv_a0, rwkv_a2, rwkv_g2,
              rwkv_k_k, rwkv_k_a, rwkv_r_k, rwkv_lnx_g, rwkv_lnx_b, hy_conv_w, hy_conv_b, hy_f_w1, hy_f_b1,
              hy_f_w2, hy_f_b2, hy_f_w3, hy_f_b3, hy_f_wout, hy_freq, hy_bias, w_branch, w_out, ln_g, ln_b,
              w_router, router_bias, w_gate, w_up, w_down):
    b, n_lat, d = x.shape
    n_ctx = ctx.shape[1]
    xl, xc = x, ctx
    hy_end = RWKV_COLS + HYENA_COLS
    for l in range(DEPTH):
        last = l == DEPTH - 1
        mod_l = jnp.split((jax.nn.silu(c) @ w_mod[l] + b_mod[l])[:, None, :], 6, axis=-1)
        mod_c = jnp.split(jax.nn.silu(c_ctx) @ w_mod[l] + b_mod[l], 6, axis=-1)
        rw_args = (rwkv_mu[l], rwkv_w0[l], rwkv_w2[l], rwkv_a0[l], rwkv_a2[l], rwkv_k_k[l], rwkv_k_a[l])
        fin_args = (rwkv_r_k[l], rwkv_lnx_g[l], rwkv_lnx_b[l], rwkv_g2[l])
        filt_args = (hy_f_w1[l], hy_f_b1[l], hy_f_w2[l], hy_f_b2[l], hy_f_w3[l], hy_f_b3[l], hy_f_wout[l], hy_freq[l])

        pc = modulate(xc, mod_c[0], mod_c[1]) @ w_in[l]
        pl = modulate(xl, mod_l[0], mod_l[1]) @ w_in[l]
        r_c, kd_c, v_c, w_c, a_c, kk_c, lg_c = rwkv_prepare(pc[..., :RWKV_COLS], token_shift_context, *rw_args)
        r_l, kd_l, v_l, w_l, a_l, kk_l, lg_l = rwkv_prepare(pl[..., :RWKV_COLS], token_shift_latent, *rw_args)
        s0 = jnp.zeros((b, RWKV_HEADS, HEAD_DIM, HEAD_DIM), jnp.float32)
        yc_f, sc_f = delta_scan(r_c, w_c[0], kd_c[0], v_c, kk_c, a_c[0], s0, False, not last)
        yc_b, sc_b = delta_scan(r_c, w_c[1], kd_c[1], v_c, kk_c, a_c[1], s0, True, not last)
        yl_f, _ = delta_scan(r_l, w_l[0], kd_l[0], v_l, kk_l, a_l[0], sc_f, False, True)
        yl_b, _ = delta_scan(r_l, w_l[1], kd_l[1], v_l, kk_l, a_l[1], sc_b, True, True)
        ro_l = rwkv_finish(r_l, kd_l, v_l, lg_l, yl_f, yl_b, *fin_args)
        ho_l = hyena_branch(pl[..., RWKV_COLS:hy_end], hy_conv_w[l], hy_conv_b[l],
                            hyena_filter(n_lat, *filt_args), hy_bias[l])
        mix_l = merge_branches(pl[..., hy_end:], ro_l, ho_l, w_branch[l], w_out[l])
        xl = post_norm(xl, mod_l[2] * mix_l, ln_g[l, 0], ln_b[l, 0])

        if last:
            hf = modulate(xl, mod_l[3], mod_l[4]).reshape(b * n_lat, d)
            yf = moe_ffn(hf, w_router, router_bias, w_gate[l], w_up[l], w_down[l]).reshape(b, n_lat, d)
            xl = post_norm(xl, mod_l[5] * yf, ln_g[l, 1], ln_b[l, 1])
        else:
            ro_c = rwkv_finish(r_c, kd_c, v_c, lg_c, yc_f, yc_b, *fin_args)
            ho_c = hyena_branch(pc[..., RWKV_COLS:hy_end], hy_conv_w[l], hy_conv_b[l],
                                hyena_filter(n_ctx, *filt_args), hy_bias[l])
            mix_c = merge_branches(pc[..., hy_end:], ro_c, ho_c, w_branch[l], w_out[l])
            xc = post_norm(xc, mod_c[2] * mix_c, ln_g[l, 0], ln_b[l, 0])
            hf = jnp.concatenate([modulate(xc, mod_c[3], mod_c[4]), modulate(xl, mod_l[3], mod_l[4])], axis=1)
            yf = moe_ffn(hf.reshape(b * (n_ctx + n_lat), d), w_router, router_bias,
                         w_gate[l], w_up[l], w_down[l]).reshape(b, n_ctx + n_lat, d)
            xc = post_norm(xc, mod_c[5] * yf[:, :n_ctx], ln_g[l, 1], ln_b[l, 1])
            xl = post_norm(xl, mod_l[5] * yf[:, n_ctx:], ln_g[l, 1], ln_b[l, 1])
    return xl
```

```cpp
#ifndef EMU
#include <hip/hip_runtime.h>
#endif
#include <cstdio>
#include <cstdint>
#include <cmath>

#ifndef CFG_D
#define CFG_D 1024
#define CFG_SEQ 16384
#define CFG_CTX 256
#define CFG_DEPTH 4
#endif
constexpr int D = CFG_D, SEQ = CFG_SEQ, CTX = CFG_CTX, DEPTH = CFG_DEPTH, M = CTX + SEQ;
constexpr int GRID_W = 64, GRID_H = SEQ / GRID_W;
constexpr int RW = D / 2, NH = RW / 64, HW = D / 2, RC = 3 * RW + 384, HC = 3 * HW, GC = 2 * D, PC = RC + HC + GC, PCP = (PC + 255) / 256 * 256;
constexpr int QTR = RC / 4, HALFC = RC / 2;
constexpr int C_K = RW, C_V = 2 * RW, C_LWF = 3 * RW, C_LG = 3 * RW + 256;
constexpr int C_HY = RC, C_GR = RC + HC, C_GH = RC + HC + D;
constexpr int NE = 16, SP_TILES = (2 * M) / 256 + NE, SP = SP_TILES * 256;
constexpr float DECAY_SCALE = 0.606531f, GN_EPS = 6.4e-4f, LN_EPS = 1e-5f;
constexpr int NPART = 256;
static_assert(CTX % 32 == 0 && M % 256 == 0 && D % 256 == 0 && RW % 128 == 0 && RW >= 256 && SEQ % 64 == 0 && CTX % 32 == 0 && RC % 4 == 0, "shape assumptions");

enum { I_X = 0, I_C, I_CTX, I_CCTX, I_WMOD, I_BMOD, I_WIN, I_MU, I_W0, I_W2, I_A0, I_A2, I_G2, I_KK, I_KA, I_RK, I_LNXG, I_LNXB, I_CW, I_CB,
       I_FW1, I_FB1, I_FW2, I_FB2, I_FW3, I_FB3, I_FWO, I_FREQ, I_HBIAS, I_WBR, I_WOUT, I_LNG, I_LNB, I_WR, I_RB, I_WG, I_WU, I_WD, N_IN };

constexpr size_t al256(size_t x) { return (x + 255) & ~(size_t)255; }
constexpr size_t CTL_BYTES = 1u << 20;
constexpr size_t WS_MOD = CTL_BYTES;
constexpr size_t WS_FPART = al256(WS_MOD + (size_t)DEPTH * 2 * 6 * D * 4);
constexpr size_t WS_ROUT = al256(WS_FPART + (size_t)2 * NPART * HW * 4);
constexpr size_t WS_BONUS = al256(WS_ROUT + (size_t)M * 2 * 4 * 3);
constexpr size_t WS_WIN = al256(WS_BONUS + (size_t)M * NH * 4);
constexpr size_t WS_WB = al256(WS_WIN + (size_t)PCP * D * 2);
constexpr size_t WS_WO = al256(WS_WB + (size_t)2 * D * RW * 2);
constexpr size_t WS_WGU = al256(WS_WO + (size_t)D * D * 2);
constexpr size_t WS_WD = al256(WS_WGU + (size_t)NE * 2 * D * D * 2);
constexpr size_t WS_X = al256(WS_WD + (size_t)NE * D * D * 2);
constexpr size_t WS_XMOD = al256(WS_X + (size_t)M * D * 4);
constexpr size_t WS_P = al256(WS_XMOD + (size_t)M * D * 2);
constexpr size_t WS_FILT = al256(WS_P + (size_t)M * PCP * 2);
constexpr size_t WS_MIX = al256(WS_FILT + (size_t)M * HW * 4);
constexpr size_t WS_T = al256(WS_MIX + (size_t)M * D * 4);
constexpr size_t WS_S = al256(WS_T + (size_t)M * D * 2);
constexpr size_t WS_R = WS_S;
constexpr size_t WS_V = al256(WS_R + (size_t)M * RW * 2);
constexpr size_t WS_KA = al256(WS_V + (size_t)M * RW * 2);
constexpr size_t WS_KD = al256(WS_KA + (size_t)M * RW * 2);
constexpr size_t WS_KB = al256(WS_KD + (size_t)2 * M * RW * 2);
constexpr size_t WS_W = al256(WS_KB + (size_t)2 * M * RW * 2);
constexpr size_t WS_Y = al256(WS_W + (size_t)2 * M * RW * 4);
constexpr size_t WS_Z = al256(WS_Y + (size_t)2 * M * RW * 4);
constexpr size_t WS_X0 = al256(WS_Z + (size_t)M * HW * 4);
constexpr size_t WS_CONV = al256(WS_X0 + (size_t)M * HW * 2);
constexpr size_t WS_GATE = al256(WS_CONV + (size_t)M * HW * 4);
constexpr size_t WS_RO = al256(WS_GATE + (size_t)M * RW * 2);
constexpr size_t WS_HO = al256(WS_RO + (size_t)M * RW * 2);
constexpr size_t WS_END1 = al256(WS_HO + (size_t)M * HW * 2);
constexpr size_t WS_XG = WS_S;
constexpr size_t WS_ACT = al256(WS_XG + (size_t)SP * D * 2);
constexpr size_t WS_YS = al256(WS_ACT + (size_t)SP * D * 2);
constexpr size_t WS_END2 = al256(WS_YS + (size_t)SP * D * 2);
constexpr size_t WS_END = WS_END1 > WS_END2 ? WS_END1 : WS_END2;
constexpr int CW_TMO = 0, CW_BAR = 4096, CW_CNT = 8192  , CW_CUR = 8192 + 1024  , CW_Q = 8192 + 2048  ;

#ifdef EMU
#define LAS
typedef short bf16x8 __attribute__((vector_size(16)));
typedef float f32x4 __attribute__((vector_size(16)));
typedef unsigned u32x4 __attribute__((vector_size(16)));
#define DYN_LDS(name) unsigned char* name = emu_cur_lds()
#define ASM_WAIT_V(n) do {} while (0)
#define ASM_WAIT_L(n) do {} while (0)
#define ASM_WAIT_VL0() do {} while (0)
#define CFENCE() do {} while (0)
#define WAVE_LDS_FENCE() emu_wave_sync()
#define S_BARRIER() emu_block_sync()
#define SCHED_BARRIER() do {} while (0)
#define SETPRIO(x) do {} while (0)
#define S_SLEEP(n) emu_yield()
#define MFMA16(a, b, c) emu_mfma_16x16x32(a, b, c)
#define GLDS16(gptr, lptr) emu_glds16((const void*)(gptr), (void*)(lptr))
#define READFIRSTLANE(x) (x)
#define XCC_ID_() (blockIdx.x & 7u)
#define FENCE_RELEASE() do {} while (0)
#define FENCE_ACQUIRE() do {} while (0)
#define DPP_F(v, ctrl) emu_dpp_f(v, ctrl)
static inline unsigned fbits(float f) { unsigned u; memcpy(&u, &f, 4); return u; }
static inline float bitsf(unsigned u) { float f; memcpy(&f, &u, 4); return f; }
#else
#define LAS __attribute__((address_space(3)))
typedef short bf16x8 __attribute__((ext_vector_type(8)));
typedef float f32x4 __attribute__((ext_vector_type(4)));
typedef unsigned u32x4 __attribute__((ext_vector_type(4)));
#define DYN_LDS(name) extern __shared__ __attribute__((aligned(16))) unsigned char name##_raw[]; LAS unsigned char* name = (LAS unsigned char*)name##_raw
#define ASM_WAIT_V(n) asm volatile("s_waitcnt vmcnt(" #n ")" ::: "memory")
#define ASM_WAIT_L(n) asm volatile("s_waitcnt lgkmcnt(" #n ")" ::: "memory")
#define ASM_WAIT_VL0() asm volatile("s_waitcnt vmcnt(0) lgkmcnt(0)" ::: "memory")
#define CFENCE() asm volatile("" ::: "memory")
#define WAVE_LDS_FENCE() asm volatile("s_waitcnt lgkmcnt(0)" ::: "memory")
#define S_BARRIER() __builtin_amdgcn_s_barrier()
#define SCHED_BARRIER() __builtin_amdgcn_sched_barrier(0)
#define SETPRIO(x) __builtin_amdgcn_s_setprio(x)
#define S_SLEEP(n) __builtin_amdgcn_s_sleep(n)
#define MFMA16(a, b, c) __builtin_amdgcn_mfma_f32_16x16x32_bf16(a, b, c, 0, 0, 0)
#define GLDS16(gptr, lptr) __builtin_amdgcn_global_load_lds((const unsigned*)(gptr), (LAS unsigned*)(lptr), 16, 0, 0)
#define READFIRSTLANE(x) __builtin_amdgcn_readfirstlane(x)
#define XCC_ID_() ((unsigned)__builtin_amdgcn_s_getreg((3 << 11) | 20) & 0xFu)
#define FENCE_RELEASE() __builtin_amdgcn_fence(__ATOMIC_RELEASE, "agent")
#define FENCE_ACQUIRE() __builtin_amdgcn_fence(__ATOMIC_ACQUIRE, "agent")
#define DPP_F(v, ctrl) __builtin_bit_cast(float, __builtin_amdgcn_update_dpp(0, __builtin_bit_cast(int, (float)(v)), (ctrl), 0xF, 0xF, true))
__device__ __forceinline__ unsigned fbits(float f) { return __builtin_bit_cast(unsigned, f); }
__device__ __forceinline__ float bitsf(unsigned u) { return __builtin_bit_cast(float, u); }
#endif
typedef unsigned short bf16;
#define RLX_AGENT __ATOMIC_RELAXED, __HIP_MEMORY_SCOPE_AGENT

__device__ __forceinline__ unsigned f2bf(float f) { unsigned u = fbits(f); return (u + 0x7fffu + ((u >> 16) & 1u)) >> 16; }
__device__ __forceinline__ unsigned pk2(float lo, float hi) { return f2bf(lo) | (f2bf(hi) << 16); }
__device__ __forceinline__ float bf2f(bf16 b) { return bitsf(((unsigned)b) << 16); }
__device__ __forceinline__ float bflo(unsigned w) { return bitsf(w << 16); }
__device__ __forceinline__ float bfhi(unsigned w) { return bitsf(w & 0xffff0000u); }
__device__ __forceinline__ float sigmoidf_(float x) { return 1.0f / (1.0f + expf(-x)); }
__device__ __forceinline__ float wave_sum(float v) {
#pragma unroll
    for (int o = 1; o < 64; o <<= 1) v += __shfl_xor(v, o);
    return v;
}
__device__ __forceinline__ float row16_sum(float v) {
    v += DPP_F(v, 0xB1);
    v += DPP_F(v, 0x4E);
    v += DPP_F(v, 0x141);
    v += DPP_F(v, 0x140);
    return v;
}
__device__ __forceinline__ void sincos_f(float x, float& s, float& c) {
    const float k = rintf(x * 0.63661977236758134f);
    float r = fmaf(-k, 1.5703125f, x); r = fmaf(-k, 4.837512969970703125e-4f, r); r = fmaf(-k, 7.54978994989188216e-8f, r);
    const float r2 = r * r;
    const float sp = r + r * r2 * (-1.6666654611e-1f + r2 * (8.3321608736e-3f + r2 * (-1.9515295891e-4f)));
    const float cp = 1.0f - 0.5f * r2 + r2 * r2 * (4.166664568298827e-2f + r2 * (-1.388731625493765e-3f + r2 * (2.443315711809948e-5f)));
    const int q = ((int)k) & 3;
    s = (q == 0) ? sp : (q == 1) ? cp : (q == 2) ? -sp : -cp;
    c = (q == 0) ? cp : (q == 1) ? -sp : (q == 2) ? -cp : sp;
}
__device__ __forceinline__ float sin_f(float x) { float s, c; sincos_f(x, s, c); return s; }

#define XB_TMO      128
#define XB_XCNT(j)  (256  + 64 * (j))
#define XB_XSUB(j)  (1280 + 64 * (j))
#define XB_XGEN(j)  (2304 + 64 * (j))
#define XB_TOP      3328
#define XB_TOPGEN   3392
#define XCD_BAR_WORDS 3456
#define XB_SPIN_CAP (1u << 18)
__device__ __forceinline__ unsigned xb_ld(unsigned* p)              { return __hip_atomic_load(p, __ATOMIC_RELAXED, __HIP_MEMORY_SCOPE_AGENT); }
__device__ __forceinline__ unsigned xb_add(unsigned* p, unsigned v) { return __hip_atomic_fetch_add(p, v, __ATOMIC_RELAXED, __HIP_MEMORY_SCOPE_AGENT); }
#define XB_SPIN(cond, bar) do { unsigned _sp = 0; while (cond) { S_SLEEP(1); \
    if ((++_sp & 255u) == 0u) { if (xb_ld(&(bar)[XB_TMO])) break; if (_sp > XB_SPIN_CAP) { atomicAdd(&(bar)[XB_TMO], 1u); break; } } } } while (0)
struct XcdBarrier { unsigned* bar; unsigned x; volatile LAS unsigned* st; };
__device__ __forceinline__ XcdBarrier xcd_barrier_post(unsigned* bar, volatile LAS unsigned* st) {
    XcdBarrier b; b.bar = bar; b.x = XCC_ID_(); b.st = st;
    if (threadIdx.x == 0) (void)xb_add(&bar[XB_XCNT(b.x)], 1u);
    return b;
}
__device__ __forceinline__ void xcd_barrier_complete(unsigned* bar, unsigned x, unsigned& nloc, unsigned& nx) {
    const unsigned G = gridDim.x * gridDim.y * gridDim.z;
    unsigned sum, cnt, mine, sp = 0u;
    for (;;) {
        sum = 0u; cnt = 0u; mine = 0u;
#pragma unroll
        for (unsigned j = 0; j < 16; ++j) { const unsigned c = xb_ld(&bar[XB_XCNT(j)]); sum += c; cnt += (c > 0u) ? 1u : 0u; mine = (j == x) ? c : mine; }
        if (sum == G) break;
        S_SLEEP(1);
        if ((++sp & 255u) == 0u) { if (xb_ld(&bar[XB_TMO])) break; if (sp > XB_SPIN_CAP) { atomicAdd(&bar[XB_TMO], 1u); break; } }
    }
    nloc = mine > 0u ? mine : 1u; nx = cnt > 0u ? cnt : 1u;
}
__device__ __forceinline__ void xcd_barrier(const XcdBarrier& b) {
    ASM_WAIT_V(0);
    __syncthreads();
    if (threadIdx.x == 0) {
        unsigned* bar = b.bar;
        ASM_WAIT_VL0();
        unsigned nloc = b.st[0], nx = b.st[1];
        if (nloc == 0u) { xcd_barrier_complete(bar, b.x, nloc, nx); b.st[0] = nloc; b.st[1] = nx; }
        const unsigned old = xb_add(&bar[XB_XSUB(b.x)], 1u);
        const unsigned gen = old / nloc;
        if (old + 1u == (gen + 1u) * nloc) {
            FENCE_RELEASE();
            ASM_WAIT_V(0);
            const unsigned og = xb_add(&bar[XB_TOP], 1u);
            const unsigned tg = og / nx;
            if (og + 1u == (tg + 1u) * nx) xb_add(&bar[XB_TOPGEN], 1u);
            else XB_SPIN(xb_ld(&bar[XB_TOPGEN]) == tg, bar);
            FENCE_ACQUIRE();
            xb_add(&bar[XB_XGEN(b.x)], 1u);
            ASM_WAIT_V(0);
        } else {
            XB_SPIN(xb_ld(&bar[XB_XGEN(b.x)]) == gen, bar);
            FENCE_ACQUIRE();
            ASM_WAIT_V(0);
        }
    }
    __syncthreads();
}

namespace pg8 {
constexpr int BM = 256, BK = 64, HALF = 128, HTB = HALF * BK * 2, STAGE_BYTES = 8 * HTB, NXCD = 8, WGM = 8;
__host__ __device__ __forceinline__ int lds_byte(int r, int c) { const int st = (r >> 4) * 2 + (c >> 5), rr = r & 15, cc = c & 31, ob = rr * 64 + cc * 2; return st * 1024 + (ob ^ (((ob >> 9) & 1) << 5)); }
__host__ __device__ __forceinline__ void stage_rc(int b, int& R, int& C) { const int st = b / 1024, sb = b % 1024, swz = sb ^ (((sb >> 9) & 1) << 5); R = (st >> 1) * 16 + swz / 64; C = (st & 1) * 32 + (swz % 64) / 2; }
__host__ __device__ __forceinline__ int perm32(int rho) { const int n = rho >> 4, i = rho & 15; return 8 * (i >> 2) + 4 * n + (i & 3); }
struct Unit { int pm, pn; };
struct Gemm { const bf16* A; const bf16* Bt; int K; };
struct StaticOrder {
    int nM, nN, nwg, G, c;
    __host__ __device__ void init(int M_, int N_, int G_, int c_) { nM = M_ / BM; nN = N_ / BM; nwg = nM * nN; G = G_; c = c_; }
    __host__ __device__ bool next(int i, Unit& u) const {
        const long L = (long)i * G + c; if (L >= nwg) return false;
        int wgid = (int)L; { const int q = nwg / NXCD, r = nwg % NXCD, xcd = wgid % NXCD, off = wgid / NXCD; wgid = (xcd < r ? xcd * (q + 1) : r * (q + 1) + (xcd - r) * q) + off; }
        const int nig = WGM * nN, gid = wgid / nig, fm = gid * WGM, gsz = (nM - fm) < WGM ? (nM - fm) : WGM;
        u.pm = fm + ((wgid % nig) % gsz); u.pn = (wgid % nig) / gsz; return true;
    }
};
struct MoeOrder {
    const volatile LAS int* tab; int NT, G, c;
    __device__ __forceinline__ bool next(int i, Unit& u) const {
        const long L = (long)i * G + c; if (L >= tab[16]) return false;
        int e = 0; while (L >= tab[e + 1]) ++e;
        const int loc = (int)L - tab[e], tc = tab[64 + e];
        u.pm = tab[32 + e] + loc % tc; u.pn = e * NT + loc / tc; return true;
    }
};
__device__ __forceinline__ unsigned cvt_pk_bf16(float lo, float hi) {
#ifdef EMU
    return pk2(lo, hi);
#else
    unsigned r; asm volatile("v_cvt_pk_bf16_f32 %0, %1, %2" : "=v"(r) : "v"(lo), "v"(hi)); return r;
#endif
}

struct EpiBf16 {
    static constexpr bool PERM = true;
    bf16* O; int ldc;
    __device__ __forceinline__ void operator()(const f32x4 (&acc)[2][2][4][2], const Unit& u, int wr, int wc, int fr, int fq) const {
        const int row0 = u.pm * BM + wr * 64 + fr, col0 = u.pn * BM + wc * 32 + 8 * fq;
#pragma unroll
        for (int ai = 0; ai < 2; ++ai)
#pragma unroll
            for (int m = 0; m < 4; ++m) { bf16* rowp = O + (size_t)(row0 + ai * HALF + m * 16) * ldc + col0;
#pragma unroll
                for (int bj = 0; bj < 2; ++bj) { const f32x4 v0 = acc[ai][bj][m][0], v1 = acc[ai][bj][m][1];
                    u32x4 w; w[0] = cvt_pk_bf16(v0[0], v0[1]); w[1] = cvt_pk_bf16(v0[2], v0[3]); w[2] = cvt_pk_bf16(v1[0], v1[1]); w[3] = cvt_pk_bf16(v1[2], v1[3]);
                    *(u32x4*)(rowp + bj * HALF) = w; } }
    }
};
struct EpiF32 {
    static constexpr bool PERM = false;
    float* C; int ldc;
    __device__ __forceinline__ void operator()(const f32x4 (&acc)[2][2][4][2], const Unit& u, int wr, int wc, int fr, int fq) const {
        const int row0 = u.pm * BM + wr * 64 + fr, col0 = u.pn * BM + wc * 32 + 4 * fq;
#pragma unroll
        for (int ai = 0; ai < 2; ++ai)
#pragma unroll
            for (int m = 0; m < 4; ++m) { float* rowp = C + (size_t)(row0 + ai * HALF + m * 16) * ldc + col0;
#pragma unroll
                for (int bj = 0; bj < 2; ++bj)
#pragma unroll
                    for (int n = 0; n < 2; ++n) *(f32x4*)(rowp + bj * HALF + n * 16) = acc[ai][bj][m][n]; }
    }
};
template <bool ADD> struct EpiGate {
    static constexpr bool PERM = true;
    bf16* T; int ldc; const bf16* Pg; int ldp; int gcol0;
    __device__ __forceinline__ void operator()(const f32x4 (&acc)[2][2][4][2], const Unit& u, int wr, int wc, int fr, int fq) const {
        const int row0 = u.pm * BM + wr * 64 + fr, col0 = u.pn * BM + wc * 32 + 8 * fq;
#pragma unroll
        for (int ai = 0; ai < 2; ++ai)
#pragma unroll
            for (int m = 0; m < 4; ++m) { const size_t row = (size_t)(row0 + ai * HALF + m * 16);
#pragma unroll
                for (int bj = 0; bj < 2; ++bj) { const f32x4 v0 = acc[ai][bj][m][0], v1 = acc[ai][bj][m][1];
                    const u32x4 g = *(const u32x4*)(Pg + row * ldp + gcol0 + col0 + bj * HALF);
                    u32x4 t = {0u, 0u, 0u, 0u}; if (ADD) t = *(const u32x4*)(T + row * ldc + col0 + bj * HALF);
                    float o[8];
#pragma unroll
                    for (int j = 0; j < 4; ++j) { const float a0 = j < 2 ? v0[2 * j] : v1[2 * j - 4], a1 = j < 2 ? v0[2 * j + 1] : v1[2 * j - 3];
                        o[2 * j] = bflo(t[j]) + sigmoidf_(bflo(g[j])) * a0; o[2 * j + 1] = bfhi(t[j]) + sigmoidf_(bfhi(g[j])) * a1; }
                    u32x4 w; w[0] = cvt_pk_bf16(o[0], o[1]); w[1] = cvt_pk_bf16(o[2], o[3]); w[2] = cvt_pk_bf16(o[4], o[5]); w[3] = cvt_pk_bf16(o[6], o[7]);
                    *(u32x4*)(T + row * ldc + col0 + bj * HALF) = w; } }
    }
};
struct EpiSwiglu {
    static constexpr bool PERM = true;
    bf16* O; int ldc; int NT;
    __device__ __forceinline__ void operator()(const f32x4 (&acc)[2][2][4][2], const Unit& u, int wr, int wc, int fr, int fq) const {
        const int row0 = u.pm * BM + wr * 64 + fr, col0 = (u.pn % NT) * HALF + wc * 32 + 8 * fq;
#pragma unroll
        for (int ai = 0; ai < 2; ++ai)
#pragma unroll
            for (int m = 0; m < 4; ++m) { bf16* rowp = O + (size_t)(row0 + ai * HALF + m * 16) * ldc + col0;
                float o[8];
#pragma unroll
                for (int j = 0; j < 8; ++j) { const float g = acc[ai][0][m][j >> 2][j & 3], uu = acc[ai][1][m][j >> 2][j & 3]; o[j] = g / (1.0f + expf(-g)) * uu; }
                u32x4 w; w[0] = cvt_pk_bf16(o[0], o[1]); w[1] = cvt_pk_bf16(o[2], o[3]); w[2] = cvt_pk_bf16(o[4], o[5]); w[3] = cvt_pk_bf16(o[6], o[7]);
                *(u32x4*)rowp = w; }
    }
};
struct EpiMoeDown {
    static constexpr bool PERM = true;
    bf16* O; int ldc; int NT;
    __device__ __forceinline__ void operator()(const f32x4 (&acc)[2][2][4][2], const Unit& u, int wr, int wc, int fr, int fq) const {
        const int row0 = u.pm * BM + wr * 64 + fr, col0 = (u.pn % NT) * BM + wc * 32 + 8 * fq;
#pragma unroll
        for (int ai = 0; ai < 2; ++ai)
#pragma unroll
            for (int m = 0; m < 4; ++m) { bf16* rowp = O + (size_t)(row0 + ai * HALF + m * 16) * ldc + col0;
#pragma unroll
                for (int bj = 0; bj < 2; ++bj) { const f32x4 v0 = acc[ai][bj][m][0], v1 = acc[ai][bj][m][1];
                    u32x4 w; w[0] = cvt_pk_bf16(v0[0], v0[1]); w[1] = cvt_pk_bf16(v0[2], v0[3]); w[2] = cvt_pk_bf16(v1[0], v1[1]); w[3] = cvt_pk_bf16(v1[2], v1[3]);
                    *(u32x4*)(rowp + bj * HALF) = w; } }
    }
};

template <class Epi, class Sched>
__device__ __forceinline__ void gemm_phase(LAS unsigned char* lds, const Gemm g, const Sched& S, const Epi& E) {
    const int tid = threadIdx.x, wid = READFIRSTLANE(tid >> 6), lane = tid & 63, wr = wid >> 2, wc = wid & 3, fr = lane & 15, fq = lane >> 4;
    const int K = g.K, nt = K / BK;
    unsigned voffA[2], voffB[2];
#pragma unroll
    for (int i = 0; i < 2; ++i) { int R, C; stage_rc(tid * 16 + i * 8192, R, C); const int Rb = Epi::PERM ? ((R & ~31) + perm32(R & 31)) : R;
        voffA[i] = (unsigned)(R * K + C) * 2u; voffB[i] = (unsigned)(Rb * K + C) * 2u; }
    const size_t kstep = (size_t)(BK * 2);
    const size_t hstep = (size_t)HALF * K * 2;
    const size_t tstep = 2 * hstep;
    const unsigned ldsw = (unsigned)wid * 1024u;
    const int aoff = lds_byte(wr * 64 + fr, fq * 8), boff = lds_byte(wc * 32 + fr, fq * 8);
#define PG8_SA(b, h) (((b) * 2 + (h)) * HTB)
#define PG8_SB(b, h) ((4 + (b) * 2 + (h)) * HTB)
#define PG8_STAGE(bufoff, gbase, voff) do { _Pragma("unroll") for (int _i = 0; _i < 2; ++_i) \
        GLDS16((const char*)(gbase) + (voff)[_i], lds + (bufoff) + ldsw + _i * 8192); } while (0)
#define PG8_LDA(dst, b, h) do { _Pragma("unroll") for (int m = 0; m < 4; ++m) _Pragma("unroll") for (int k = 0; k < 2; ++k) dst[m][k] = *(const LAS bf16x8*)(lds + PG8_SA(b, h) + aoff + m * 2048 + k * 1024); } while (0)
#define PG8_LDB(dst, b, h) do { _Pragma("unroll") for (int n = 0; n < 2; ++n) _Pragma("unroll") for (int k = 0; k < 2; ++k) dst[n][k] = *(const LAS bf16x8*)(lds + PG8_SB(b, h) + boff + n * 2048 + k * 1024); } while (0)
#define PG8_MMA(ai, bj, At, Bt) do { SETPRIO(1); _Pragma("unroll") for (int m = 0; m < 4; ++m) _Pragma("unroll") for (int n = 0; n < 2; ++n) _Pragma("unroll") for (int k = 0; k < 2; ++k) \
        acc[ai][bj][m][n] = MFMA16(Bt[n][k], At[m][k], acc[ai][bj][m][n]); SETPRIO(0); } while (0)
#define PG8_BAR S_BARRIER()
    Unit cur, nxt; int ui = 0;
    if (!S.next(0, cur)) return;
    f32x4 acc[2][2][4][2];
#pragma unroll
    for (int a = 0; a < 2; ++a)
#pragma unroll
        for (int b = 0; b < 2; ++b)
#pragma unroll
            for (int m = 0; m < 4; ++m)
#pragma unroll
                for (int n = 0; n < 2; ++n) acc[a][b][m][n] = (f32x4){0.f, 0.f, 0.f, 0.f};
    bf16x8 At[4][2], B0[2][2], B1[2][2];
    const char* cA = (const char*)g.A + (size_t)cur.pm * tstep; const char* cB = (const char*)g.Bt + (size_t)cur.pn * tstep;
    PG8_STAGE(PG8_SB(0, 0), cB, voffB); PG8_STAGE(PG8_SA(0, 0), cA, voffA); PG8_STAGE(PG8_SB(0, 1), cB + hstep, voffB); PG8_STAGE(PG8_SA(0, 1), cA + hstep, voffA);
    if (wr == 1) PG8_BAR;
    ASM_WAIT_V(4); PG8_BAR;
    PG8_STAGE(PG8_SB(1, 0), cB + kstep, voffB); PG8_STAGE(PG8_SA(1, 0), cA + kstep, voffA); PG8_STAGE(PG8_SB(1, 1), cB + hstep + kstep, voffB);
    ASM_WAIT_V(6); PG8_BAR;
    for (;;) {
        const bool has_next = S.next(ui + 1, nxt);
        const char* nA = has_next ? (const char*)g.A + (size_t)nxt.pm * tstep : cA; const char* nB = has_next ? (const char*)g.Bt + (size_t)nxt.pn * tstep : cB;
        for (int t = 0; t < nt; t += 2) {
            const bool last = (t == nt - 2);
            const char* a1 = cA + (size_t)(t + 1) * kstep;
            const char* a2 = last ? nA : cA + (size_t)(t + 2) * kstep; const char* b2 = last ? nB : cB + (size_t)(t + 2) * kstep;
            const char* a3 = a2 + kstep; const char* b3 = b2 + kstep;
            PG8_LDB(B0, 0, 0); SCHED_BARRIER(); PG8_LDA(At, 0, 0); PG8_STAGE(PG8_SA(1, 1), a1 + hstep, voffA);
            ASM_WAIT_L(8); PG8_BAR; ASM_WAIT_L(0); PG8_MMA(0, 0, At, B0); PG8_BAR; SCHED_BARRIER();
            PG8_LDB(B1, 0, 1); PG8_STAGE(PG8_SB(0, 0), b2, voffB);
            PG8_BAR; ASM_WAIT_L(0); PG8_MMA(0, 1, At, B1); PG8_BAR;
            PG8_LDA(At, 0, 1); PG8_STAGE(PG8_SA(0, 0), a2, voffA);
            PG8_BAR; ASM_WAIT_L(0); PG8_MMA(1, 0, At, B0); PG8_BAR; SCHED_BARRIER();
            PG8_STAGE(PG8_SB(0, 1), b2 + hstep, voffB);
            ASM_WAIT_V(6); PG8_BAR; PG8_MMA(1, 1, At, B1); PG8_BAR;
            PG8_LDB(B0, 1, 0); SCHED_BARRIER(); PG8_LDA(At, 1, 0); PG8_STAGE(PG8_SA(0, 1), a2 + hstep, voffA);
            ASM_WAIT_L(8); PG8_BAR; ASM_WAIT_L(0); PG8_MMA(0, 0, At, B0); PG8_BAR; SCHED_BARRIER();
            PG8_LDB(B1, 1, 1); PG8_STAGE(PG8_SB(1, 0), b3, voffB);
            PG8_BAR; ASM_WAIT_L(0); PG8_MMA(0, 1, At, B1); PG8_BAR;
            PG8_LDA(At, 1, 1); PG8_STAGE(PG8_SA(1, 0), a3, voffA);
            PG8_BAR; ASM_WAIT_L(0); PG8_MMA(1, 0, At, B0); PG8_BAR; SCHED_BARRIER();
            PG8_STAGE(PG8_SB(1, 1), b3 + hstep, voffB);
            ASM_WAIT_V(6); PG8_BAR; PG8_MMA(1, 1, At, B1); PG8_BAR;
        }
        E(acc, cur, wr, wc, fr, fq);
        if (!has_next) break;
#pragma unroll
        for (int a = 0; a < 2; ++a)
#pragma unroll
            for (int b = 0; b < 2; ++b)
#pragma unroll
                for (int m = 0; m < 4; ++m)
#pragma unroll
                    for (int n = 0; n < 2; ++n) acc[a][b][m][n] = (f32x4){0.f, 0.f, 0.f, 0.f};
        cur = nxt; cA = nA; cB = nB; ++ui;
    }
    ASM_WAIT_V(0);
    if (wr == 0) PG8_BAR;
    PG8_BAR;
#undef PG8_SA
#undef PG8_SB
#undef PG8_STAGE
#undef PG8_LDA
#undef PG8_LDB
#undef PG8_MMA
#undef PG8_BAR
}
}

struct Args { const float* in[N_IN]; float* out; unsigned char* ws; int ph_lo, ph_hi; };
constexpr int NWAVES = 8, NTHR = 512;
constexpr int LDS_STAGE = 131072, LDS_MISC = LDS_STAGE, LDS_BYTES = 147456;

constexpr int PT_OUT = N_IN, PT_WS = N_IN + 1, PT_WORD0 = 128;
struct Ctx {
    LAS unsigned char* lds; int tid, lane, wave, G, bid;
    __device__ __forceinline__ unsigned long long ptr(int i) const { const volatile LAS unsigned* t = (const volatile LAS unsigned*)(lds + LDS_MISC) + PT_WORD0 + 2 * i;
        const unsigned lo = (unsigned)READFIRSTLANE((int)t[0]), hi = (unsigned)READFIRSTLANE((int)t[1]); return ((unsigned long long)hi << 32) | lo; }
    __device__ __forceinline__ const float* in(int i) const { return (const float*)ptr(i); }
    __device__ __forceinline__ float* out() const { return (float*)ptr(PT_OUT); }
    template <class T> __device__ __forceinline__ T* ws(size_t off) const { return (T*)((unsigned char*)ptr(PT_WS) + off); }
    __device__ __forceinline__ unsigned* ctl() const { return (unsigned*)ptr(PT_WS); }
};

__device__ __forceinline__ void transpose_item(const float* W, int ldw, int k0, int n0, int nvalid, bf16* outp, int ldo, LAS float* scr, int lane) {
#pragma unroll 8
    for (int i = 0; i < 32; ++i) { const int kk = 2 * i + (lane >> 5), n = n0 + (lane & 31); scr[kk * 33 + (lane & 31)] = (n < nvalid) ? W[(size_t)(k0 + kk) * ldw + n] : 0.f; }
    WAVE_LDS_FENCE(); CFENCE();
    const int c = lane & 7;
#pragma unroll
    for (int j = 0; j < 4; ++j) { const int n = (lane >> 3) + 8 * j; const LAS float* s = scr + (8 * c) * 33 + n;
        u32x4 o; o[0] = pk2(s[0 * 33], s[1 * 33]); o[1] = pk2(s[2 * 33], s[3 * 33]); o[2] = pk2(s[4 * 33], s[5 * 33]); o[3] = pk2(s[6 * 33], s[7 * 33]);
        *(u32x4*)(outp + (size_t)n * ldo + k0 + 8 * c) = o; }
    WAVE_LDS_FENCE(); CFENCE();
}
__device__ __forceinline__ void filter_item(const Ctx& X, int l, int n, int pos0, float* out  , LAS float* scr  , float (&asum)[HW / 64]) {
    const int lane = X.lane;
    LAS float* zs = scr; LAS float* ha = scr + 8 * 33; LAS float* hb = ha + 8 * 64;
    const float* w1 = X.in(I_FW1) + (size_t)l * 33 * 64; const float* b1 = X.in(I_FB1) + l * 64;
    const float* w2 = X.in(I_FW2) + (size_t)l * 64 * 64; const float* b2 = X.in(I_FB2) + l * 64;
    const float* w3 = X.in(I_FW3) + (size_t)l * 64 * 64; const float* b3 = X.in(I_FB3) + l * 64;
    const float* wo = X.in(I_FWO) + (size_t)l * 64 * HW; const float fr = X.in(I_FREQ)[l * 64 + lane];
    if (lane < 33) {
#pragma unroll
        for (int p = 0; p < 8; ++p) { const int pos = pos0 + p; float v;
            if (lane == 0) v = (float)pos / (float)(n - 1 > 1 ? n - 1 : 1);
            else { const int b = (lane - 1) & 15; const double band = 1e-4 + (double)b * ((15.0 - 1e-4) / 15.0);
                double rev = (double)pos * band / (double)n; rev -= floor(rev); if (rev > 0.5) rev -= 1.0;
                float s, c; sincos_f((float)(rev * 6.283185307179586476925), s, c); v = lane <= 16 ? c : -s; }
            zs[p * 33 + lane] = v; }
    }
    WAVE_LDS_FENCE(); CFENCE();
    float acc[8];
    { const float bb = b1[lane];
#pragma unroll
      for (int p = 0; p < 8; ++p) acc[p] = bb;
#pragma unroll 3
      for (int i = 0; i < 33; ++i) { const float w = w1[i * 64 + lane];
#pragma unroll
          for (int p = 0; p < 8; ++p) acc[p] += zs[p * 33 + i] * w; }
#pragma unroll
      for (int p = 0; p < 8; ++p) ha[p * 64 + lane] = sin_f(fr * acc[p]); }
    WAVE_LDS_FENCE(); CFENCE();
    { const float bb = b2[lane];
#pragma unroll
      for (int p = 0; p < 8; ++p) acc[p] = bb;
#pragma unroll 4
      for (int i = 0; i < 64; ++i) { const float w = w2[i * 64 + lane];
#pragma unroll
          for (int p = 0; p < 8; ++p) acc[p] += ha[p * 64 + i] * w; }
#pragma unroll
      for (int p = 0; p < 8; ++p) hb[p * 64 + lane] = sin_f(fr * acc[p]); }
    WAVE_LDS_FENCE(); CFENCE();
    { const float bb = b3[lane];
#pragma unroll
      for (int p = 0; p < 8; ++p) acc[p] = bb;
#pragma unroll 4
      for (int i = 0; i < 64; ++i) { const float w = w3[i * 64 + lane];
#pragma unroll
          for (int p = 0; p < 8; ++p) acc[p] += hb[p * 64 + i] * w; }
#pragma unroll
      for (int p = 0; p < 8; ++p) ha[p * 64 + lane] = sin_f(fr * acc[p]); }
    WAVE_LDS_FENCE(); CFENCE();
    const float dmin = -3.0701134573253944f, dmax = -15.350567286626972f;
#pragma unroll
    for (int mI = 0; mI < HW / 64; ++mI) { const int c = lane + 64 * mI;
#pragma unroll
        for (int p = 0; p < 8; ++p) acc[p] = 0.f;
#pragma unroll 4
        for (int i = 0; i < 64; ++i) { const float w = wo[i * HW + c];
#pragma unroll
            for (int p = 0; p < 8; ++p) acc[p] += ha[p * 64 + i] * w; }
        const float delta = fabsf(dmin + (float)c * ((dmax - dmin) / (float)(HW - 1)));
        float as = 0.f;
#pragma unroll
        for (int p = 0; p < 8; ++p) { const int pos = pos0 + p; const int dd = pos - n / 2; const float dist = (float)(dd < 0 ? -dd : dd) * (2.0f / (float)n);
            const float v = acc[p] * expf(-dist * delta); out[(size_t)pos * HW + c] = v; as += fabsf(v); }
        asum[mI] += as; }
    WAVE_LDS_FENCE(); CFENCE();
}
__device__ __forceinline__ void phase_weights(const Ctx& X, int l) {
    LAS float* scr = (LAS float*)(X.lds + X.wave * 16384);
    const int gw = X.bid * NWAVES + X.wave, NGW = X.G * NWAVES, lane = X.lane;
    constexpr int KB_D = D / 64, I_WIN_ = KB_D * (PCP / 32), I_WB_ = 2 * (RW / 64) * (D / 32), I_WO_ = KB_D * (D / 32), I_WGU_ = NE * 2 * KB_D * (D / 32), I_WD_ = NE * KB_D * (D / 32);
    constexpr int NITEMS = I_WIN_ + I_WB_ + I_WO_ + I_WGU_ + I_WD_;
    for (int it = gw; it < NITEMS; it += NGW) {
        int r = it;
        if (r < I_WIN_) { const int nb = r % (PCP / 32), kb = r / (PCP / 32); transpose_item(X.in(I_WIN) + (size_t)l * D * PC, PC, 64 * kb, 32 * nb, PC, X.ws<bf16>(WS_WIN) + (size_t)(32 * nb) * D, D, scr, lane); continue; } r -= I_WIN_;
        if (r < I_WB_) { const int s = r / ((RW / 64) * (D / 32)), q = r % ((RW / 64) * (D / 32)), nb = q % (D / 32), kb = q / (D / 32);
            transpose_item(X.in(I_WBR) + ((size_t)l * 2 + s) * RW * D, D, 64 * kb, 32 * nb, D, X.ws<bf16>(WS_WB) + (size_t)s * D * RW + (size_t)(32 * nb) * RW, RW, scr, lane); continue; } r -= I_WB_;
        if (r < I_WO_) { const int nb = r % (D / 32), kb = r / (D / 32); transpose_item(X.in(I_WOUT) + (size_t)l * D * D, D, 64 * kb, 32 * nb, D, X.ws<bf16>(WS_WO) + (size_t)(32 * nb) * D, D, scr, lane); continue; } r -= I_WO_;
        if (r < I_WGU_) { const int per = KB_D * (D / 32), es = r / per, q = r % per, e = es >> 1, src = es & 1, nb = q % (D / 32), kb = q / (D / 32), n0 = 32 * nb;
            const float* W = (src ? X.in(I_WU) : X.in(I_WG)) + ((size_t)l * NE + e) * D * D; const int orow = e * 2 * D + (n0 / 128) * 256 + src * 128 + (n0 % 128);
            transpose_item(W, D, 64 * kb, n0, D, X.ws<bf16>(WS_WGU) + (size_t)orow * D, D, scr, lane); continue; } r -= I_WGU_;
        { const int per = KB_D * (D / 32), e = r / per, q = r % per, nb = q % (D / 32), kb = q / (D / 32);
            transpose_item(X.in(I_WD) + ((size_t)l * NE + e) * D * D, D, 64 * kb, 32 * nb, D, X.ws<bf16>(WS_WD) + (size_t)(e * D + 32 * nb) * D, D, scr, lane); }
    }
    float as0[HW / 64], as1[HW / 64];
#pragma unroll
    for (int i = 0; i < HW / 64; ++i) { as0[i] = 0.f; as1[i] = 0.f; }
    float* filt = X.ws<float>(WS_FILT);
    for (int it = gw; it < SEQ / 8; it += NGW) filter_item(X, l, SEQ, 8 * it, filt, scr, as0);
    for (int it = gw; it < CTX / 8; it += NGW) filter_item(X, l, CTX, 8 * it, filt + (size_t)SEQ * HW, scr, as1);
    __syncthreads();
    LAS float* part = (LAS float*)X.lds;
#pragma unroll
    for (int i = 0; i < HW / 64; ++i) { part[(X.wave * 2 + 0) * HW + lane + 64 * i] = as0[i]; part[(X.wave * 2 + 1) * HW + lane + 64 * i] = as1[i]; }
    __syncthreads();
    for (int i = X.tid; i < 2 * HW; i += NTHR) { float s = 0.f;
#pragma unroll
        for (int w = 0; w < NWAVES; ++w) s += part[w * 2 * HW + i];
        X.ws<float>(WS_FPART)[((size_t)(i / HW) * NPART + X.bid) * HW + (i % HW)] = s; }
    __syncthreads();
    if (l == 0) {
        LAS float* red = (LAS float*)X.lds;
        constexpr int NIT = DEPTH * (6 * D / 64);
        for (int it = X.bid; it < NIT; it += X.G) {
            const int ll = it / (6 * D / 64), n0 = (it % (6 * D / 64)) * 64;
            const float* W = X.in(I_WMOD) + (size_t)ll * D * 6 * D; const float* cv = X.in(I_C); const float* cc = X.in(I_CCTX);
            float s0 = 0.f, s1 = 0.f;
            for (int k = X.wave * (D / 8); k < (X.wave + 1) * (D / 8); ++k) { const float wv = W[(size_t)k * 6 * D + n0 + lane]; const float c0 = cv[k], c1 = cc[k];
                s0 += c0 * sigmoidf_(c0) * wv; s1 += c1 * sigmoidf_(c1) * wv; }
            red[(X.wave * 64 + lane) * 2] = s0; red[(X.wave * 64 + lane) * 2 + 1] = s1;
            __syncthreads();
            if (X.wave == 0) { float t0 = 0.f, t1 = 0.f;
#pragma unroll
                for (int w = 0; w < NWAVES; ++w) { t0 += red[(w * 64 + lane) * 2]; t1 += red[(w * 64 + lane) * 2 + 1]; }
                const float bm = X.in(I_BMOD)[(size_t)ll * 6 * D + n0 + lane];
                float* MOD = X.ws<float>(WS_MOD);
                MOD[((size_t)ll * 2 + 0) * 6 * D + n0 + lane] = t0 + bm; MOD[((size_t)ll * 2 + 1) * 6 * D + n0 + lane] = t1 + bm; }
            __syncthreads();
        }
    }
}
__device__ __forceinline__ const float* modp(const Ctx& X, int l, int t, int j) { return X.ws<float>(WS_MOD) + ((size_t)l * 2 + (t < CTX ? 1 : 0)) * 6 * D + (size_t)j * D; }

__device__ __forceinline__ void phase_x0(const Ctx& X) {
    const int gw = X.bid * NWAVES + X.wave, NGW = X.G * NWAVES, lane = X.lane;
    for (int t = gw; t < M; t += NGW) {
        const float* src = t < CTX ? X.in(I_CTX) + (size_t)t * D : X.in(I_X) + (size_t)(t - CTX) * D;
        const float* sh = modp(X, 0, t, 0); const float* sc = modp(X, 0, t, 1);
        float* xr = X.ws<float>(WS_X) + (size_t)t * D; bf16* xm = X.ws<bf16>(WS_XMOD) + (size_t)t * D;
#pragma unroll
        for (int j = 0; j < D / 256; ++j) { const int d = 4 * lane + 256 * j; const f32x4 v = *(const f32x4*)(src + d), a = *(const f32x4*)(sh + d), b = *(const f32x4*)(sc + d);
            *(f32x4*)(xr + d) = v;
            unsigned w0 = pk2(v[0] * (1.f + b[0]) + a[0], v[1] * (1.f + b[1]) + a[1]), w1 = pk2(v[2] * (1.f + b[2]) + a[2], v[3] * (1.f + b[3]) + a[3]);
            *(unsigned long long*)(xm + d) = (unsigned long long)w0 | ((unsigned long long)w1 << 32); }
    }
}

__device__ __forceinline__ int shift_row(int t, int col) {
    if (t < CTX) { if (col < HALFC) return t > 0 ? t - 1 : -1; return t < CTX - 1 ? t + 1 : -1; }
    const int i = t - CTX, gx = i % GRID_W, gy = i / GRID_W, q = col / QTR;
    if (q == 0) return gx > 0 ? t - 1 : -1;
    if (q == 1) return gx < GRID_W - 1 ? t + 1 : -1;
    if (q == 2) return gy > 0 ? t - GRID_W : -1;
    return gy < GRID_H - 1 ? t + GRID_W : -1;
}
__device__ __forceinline__ float pm_val(const bf16* P, const float* mu, int t, int col) {
    const float p0 = bf2f(P[(size_t)t * PCP + col]); const int nr = shift_row(t, col);
    const float p1 = nr >= 0 ? bf2f(P[(size_t)nr * PCP + col]) : 0.f;
    return p0 + (p1 - p0) * mu[col];
}
constexpr int TT = 16;
__device__ __forceinline__ void phase_prep(const Ctx& X, int l) {
    const bf16* P = X.ws<bf16>(WS_P); const float* mu = X.in(I_MU) + (size_t)l * RC;
    LAS float* S = (LAS float*)X.lds;
    const int c = X.tid;
    const float* w2 = X.in(I_W2) + (size_t)l * 2 * 64 * RW; const float* a2 = X.in(I_A2) + (size_t)l * 2 * 64 * RW; const float* g2 = X.in(I_G2) + (size_t)l * 128 * RW;
    for (int tile = X.bid; tile < M / TT; tile += X.G) {
        const int t0 = tile * TT;
        for (int idx = X.tid; idx < TT * 384; idx += NTHR) { const int tt = idx / 384, j = idx % 384; float v = pm_val(P, mu, t0 + tt, C_LWF + j);
            if (j < 128) v = tanhf(v); else if (j >= 256) v = sigmoidf_(v);
            S[j * TT + tt] = v; }
        __syncthreads();
        if (c < RW) {
            float aw0[TT], aw1[TT], aa0[TT], aa1[TT], ag[TT];
#pragma unroll
            for (int tt = 0; tt < TT; ++tt) { aw0[tt] = 0.f; aw1[tt] = 0.f; aa0[tt] = 0.f; aa1[tt] = 0.f; ag[tt] = 0.f; }
            for (int r = 0; r < 64; ++r) { const float wf = w2[(size_t)r * RW + c], wb = w2[(size_t)(64 + r) * RW + c], af = a2[(size_t)r * RW + c], ab = a2[(size_t)(64 + r) * RW + c];
#pragma unroll
                for (int tt = 0; tt < TT; ++tt) { aw0[tt] += S[r * TT + tt] * wf; aw1[tt] += S[(64 + r) * TT + tt] * wb; aa0[tt] += S[(128 + r) * TT + tt] * af; aa1[tt] += S[(192 + r) * TT + tt] * ab; } }
            for (int j = 0; j < 128; ++j) { const float gv = g2[(size_t)j * RW + c];
#pragma unroll
                for (int tt = 0; tt < TT; ++tt) ag[tt] += S[(256 + j) * TT + tt] * gv; }
            const float w00 = X.in(I_W0)[(size_t)(l * 2 + 0) * RW + c], w01 = X.in(I_W0)[(size_t)(l * 2 + 1) * RW + c];
            const float a00 = X.in(I_A0)[(size_t)(l * 2 + 0) * RW + c], a01 = X.in(I_A0)[(size_t)(l * 2 + 1) * RW + c];
            const float kkc = X.in(I_KK)[(size_t)l * RW + c], kac = X.in(I_KA)[(size_t)l * RW + c], rkc = X.in(I_RK)[(size_t)l * RW + c];
#pragma unroll
            for (int tt = 0; tt < TT; ++tt) { const int t = t0 + tt;
                const float r = pm_val(P, mu, t, c), k = pm_val(P, mu, t, C_K + c), v = pm_val(P, mu, t, C_V + c);
                const float wd0 = expf(-DECAY_SCALE * sigmoidf_(w00 + aw0[tt])), wd1 = expf(-DECAY_SCALE * sigmoidf_(w01 + aw1[tt]));
                const float ad0 = sigmoidf_(a00 + aa0[tt]), ad1 = sigmoidf_(a01 + aa1[tt]);
                const float kkr = k * kkc; const float n2 = wave_sum(kkr * kkr); const float kk = kkr / fmaxf(sqrtf(n2), 1e-12f);
                const float kd0 = k * (1.f + (ad0 - 1.f) * kac), kd1 = k * (1.f + (ad1 - 1.f) * kac);
                const float bon = wave_sum(r * (kd0 + kd1) * rkc);
                const size_t o = (size_t)t * RW + c, o1 = (size_t)(M + t) * RW + c;
                X.ws<bf16>(WS_R)[o] = (bf16)f2bf(r); X.ws<bf16>(WS_V)[o] = (bf16)f2bf(v); X.ws<bf16>(WS_KA)[o] = (bf16)f2bf(-kk);
                X.ws<bf16>(WS_KD)[o] = (bf16)f2bf(kd0); X.ws<bf16>(WS_KD)[o1] = (bf16)f2bf(kd1);
                X.ws<bf16>(WS_KB)[o] = (bf16)f2bf(kk * ad0); X.ws<bf16>(WS_KB)[o1] = (bf16)f2bf(kk * ad1);
                X.ws<float>(WS_W)[o] = wd0; X.ws<float>(WS_W)[o1] = wd1;
                X.ws<bf16>(WS_GATE)[o] = (bf16)f2bf(ag[tt]);
                if (X.lane == 0) X.ws<float>(WS_BONUS)[(size_t)t * NH + (c >> 6)] = bon; }
        }
        if (c < HW) {
            const float* cw = X.in(I_CW) + (size_t)l * 3 * HC; const float* cb = X.in(I_CB) + (size_t)l * HC;
            for (int tt = 0; tt < TT; ++tt) { const int t = t0 + tt; const bool hp = (t != 0 && t != CTX), hn = (t != CTX - 1 && t != M - 1);
                float u[3];
#pragma unroll
                for (int j = 0; j < 3; ++j) { const int hc = j * HW + c, col = C_HY + hc;
                    const float pc = bf2f(P[(size_t)t * PCP + col]), pp = hp ? bf2f(P[(size_t)(t - 1) * PCP + col]) : 0.f, pn = hn ? bf2f(P[(size_t)(t + 1) * PCP + col]) : 0.f;
                    u[j] = pp * cw[hc] + pc * cw[HC + hc] + pn * cw[2 * HC + hc] + cb[hc]; }
                X.ws<float>(WS_Z)[(size_t)t * HW + c] = u[2] * u[1]; X.ws<bf16>(WS_X0)[(size_t)t * HW + c] = (bf16)f2bf(u[0]); }
        }
        __syncthreads();
    }
}

constexpr int SCH = 32;
constexpr int SC_STEP = 5 * 64 + 32;
constexpr int N_SCAN_UNITS = 2 * NH * 2;
__device__ __forceinline__ int scan_row(int d, int s) { return d == 0 ? s : (s < CTX ? CTX - 1 - s : M - 1 - (s - CTX)); }
__device__ __forceinline__ void scan_unit(const Ctx& X, int su) {
    const int d = su / (NH * 2), h = (su / 2) % NH, half = su & 1;
    LAS float* buf = (LAS float*)X.lds;
    LAS float* ybuf = buf + 2 * SCH * SC_STEP;
    const int vrow = X.wave * 4 + (X.lane >> 4), kq = (X.lane & 15) * 4;
    const int e = X.tid, which = e >> 6; const bool loader = e < SC_STEP, isf32 = which == 0;
    const char* src; {
        const size_t od = (size_t)d * M * RW + h * 64 + (e & 63), o = (size_t)h * 64 + (e & 63);
        if (which == 0) src = (const char*)(X.ws<float>(WS_W) + od);
        else if (which == 1) src = (const char*)(X.ws<bf16>(WS_KB) + od);
        else if (which == 2) src = (const char*)(X.ws<bf16>(WS_KD) + od);
        else if (which == 3) src = (const char*)(X.ws<bf16>(WS_KA) + o);
        else if (which == 4) src = (const char*)(X.ws<bf16>(WS_R) + o);
        else src = (const char*)(X.ws<bf16>(WS_V) + (size_t)h * 64 + half * 32 + (e - 320)); }
    const long esz = isf32 ? 4 : 2;
    float pre[SCH];
#define SCAN_LOAD(g_) do { if (loader) { const int s0_ = (g_) * SCH; const int row0_ = scan_row(d, s0_); const long st_ = (d == 0 ? (long)RW : -(long)RW) * esz; const char* p_ = src + (long)row0_ * RW * esz; \
        if (isf32) { _Pragma("unroll") for (int j = 0; j < SCH; ++j) pre[j] = *(const float*)(p_ + j * st_); } \
        else { _Pragma("unroll") for (int j = 0; j < SCH; ++j) pre[j] = bf2f(*(const bf16*)(p_ + j * st_)); } } } while (0)
#define SCAN_STORE(pb_) do { if (loader) { _Pragma("unroll") for (int j = 0; j < SCH; ++j) buf[((pb_) * SCH + j) * SC_STEP + e] = pre[j]; } } while (0)
    SCAN_LOAD(0); SCAN_STORE(0);
    __syncthreads();
    float S0 = 0.f, S1 = 0.f, S2 = 0.f, S3 = 0.f;
    float* Y = X.ws<float>(WS_Y) + (size_t)d * M * RW;
    constexpr int NCH = M / SCH;
    for (int g = 0; g < NCH; ++g) {
        const int pb = g & 1;
        if (g + 1 < NCH) SCAN_LOAD(g + 1);
        const LAS float* B = buf + pb * SCH * SC_STEP; LAS float* yb = ybuf + pb * SCH * 32;
#pragma unroll 4
        for (int s = 0; s < SCH; ++s) { const LAS float* q = B + s * SC_STEP;
            const f32x4 w4 = *(const LAS f32x4*)(q + kq), kb4 = *(const LAS f32x4*)(q + 64 + kq), kd4 = *(const LAS f32x4*)(q + 128 + kq), ka4 = *(const LAS f32x4*)(q + 192 + kq), r4 = *(const LAS f32x4*)(q + 256 + kq);
            const float vv = q[320 + vrow];
            const float sa = row16_sum(S0 * ka4[0] + S1 * ka4[1] + S2 * ka4[2] + S3 * ka4[3]);
            S0 = S0 * w4[0] + sa * kb4[0] + vv * kd4[0]; S1 = S1 * w4[1] + sa * kb4[1] + vv * kd4[1]; S2 = S2 * w4[2] + sa * kb4[2] + vv * kd4[2]; S3 = S3 * w4[3] + sa * kb4[3] + vv * kd4[3];
            const float y = row16_sum(S0 * r4[0] + S1 * r4[1] + S2 * r4[2] + S3 * r4[3]);
            if ((X.lane & 15) == 0) yb[s * 32 + vrow] = y; }
        if (g + 1 < NCH) SCAN_STORE(pb ^ 1);
        __syncthreads();
        for (int i = X.tid; i < SCH * 32; i += NTHR) { const int s = i >> 5, v = i & 31; Y[(size_t)scan_row(d, g * SCH + s) * RW + h * 64 + half * 32 + v] = yb[i]; }
    }
    __syncthreads();
#undef SCAN_LOAD
#undef SCAN_STORE
}
constexpr int CR = 16;
__device__ __forceinline__ void conv_item(const Ctx& X, int item) {
    constexpr int NCG = HW / 64, NLAT = NCG * (SEQ / CR);
    const bool isctx = item >= NLAT; const int it2 = isctx ? item - NLAT : item;
    const int cg = it2 % NCG, ob = it2 / NCG, n = isctx ? CTX : SEQ, rowbase = isctx ? 0 : CTX, i0 = CR * ob, c = cg * 64 + X.lane;
    const float* F = X.ws<float>(WS_FILT) + (isctx ? (size_t)SEQ * HW : 0) + c; const float* Z = X.ws<float>(WS_Z) + (size_t)rowbase * HW + c;
    const float* fp = X.ws<float>(WS_FPART) + (size_t)(isctx ? 1 : 0) * NPART * HW + c;
    float nsum = 0.f; for (int b = 0; b < NPART; ++b) nsum += fp[(size_t)b * HW];
    float acc[CR], Q[CR];
#pragma unroll
    for (int r = 0; r < CR; ++r) acc[r] = 0.f;
    int jb = i0 - n / 2; if (jb < 0) jb = 0;
    int jend = i0 + n / 2 + CR; if (jend > n) jend = n;
    int Tb = i0 - jb + n / 2;
#pragma unroll
    for (int x = 1; x < CR; ++x) { const int T = Tb + x; Q[x] = (T >= 0 && T < n) ? F[(size_t)T * HW] : 0.f; }
    Q[0] = 0.f;
    for (; jb < jend; jb += CR, Tb -= CR) {
#pragma unroll
        for (int s = 0; s < CR; ++s) { const int T = Tb - s, j = jb + s;
            if ((s & 3) == 0) CFENCE();
            Q[(CR - s) & (CR - 1)] = (T >= 0 && T < n) ? F[(size_t)T * HW] : 0.f;
            const float zj = (j < n) ? Z[(size_t)j * HW] : 0.f;
#pragma unroll
            for (int r = 0; r < CR; ++r) acc[r] += Q[(r - s + CR) & (CR - 1)] * zj; }
    }
    const float inv = 1.0f / nsum; float* O = X.ws<float>(WS_CONV) + (size_t)rowbase * HW + c;
#pragma unroll
    for (int r = 0; r < CR; ++r) O[(size_t)(i0 + r) * HW] = acc[r] * inv;
}
__device__ __forceinline__ void phase_scanconv(const Ctx& X, int l) {
#ifndef NO_SCAN
    for (int su = X.bid; su < N_SCAN_UNITS; su += X.G) scan_unit(X, su);
#endif
#ifdef NO_CONV
    return;
#endif
    constexpr int NITEMS = (HW / 64) * (SEQ / CR) + (HW / 64) * (CTX / CR);
    unsigned* q = X.ctl() + CW_Q + l * 64;
    for (;;) { int item = 0; if (X.lane == 0) item = (int)atomicAdd(q, 1u); item = __shfl(item, 0); if (item >= NITEMS) break; conv_item(X, item); }
}

__device__ __forceinline__ void phase_finish(const Ctx& X, int l) {
    const int c = X.tid;
    const float* lg = X.in(I_LNXG) + (size_t)l * RW; const float* lb = X.in(I_LNXB) + (size_t)l * RW; const float* hb = X.in(I_HBIAS) + (size_t)l * HW;
    for (int t = X.bid; t < M; t += X.G) {
        if (c < RW) { const size_t o = (size_t)t * RW + c;
            const float y = X.ws<float>(WS_Y)[o] + X.ws<float>(WS_Y)[(size_t)M * RW + o];
            const float mean = wave_sum(y) * (1.f / 64.f); const float dy = y - mean; const float var = wave_sum(dy * dy) * (1.f / 64.f);
            float yn = dy / sqrtf(var + GN_EPS) * lg[c] + lb[c];
            yn += X.ws<float>(WS_BONUS)[(size_t)t * NH + (c >> 6)] * bf2f(X.ws<bf16>(WS_V)[o]);
            yn *= bf2f(X.ws<bf16>(WS_GATE)[o]);
            X.ws<bf16>(WS_RO)[o] = (bf16)f2bf(yn); }
        if (c < HW) { const size_t o = (size_t)t * HW + c;
            const float ho = (X.ws<float>(WS_CONV)[o] + X.ws<float>(WS_Z)[o] * hb[c]) * bf2f(X.ws<bf16>(WS_X0)[o]);
            X.ws<bf16>(WS_HO)[o] = (bf16)f2bf(ho); }
    }
}

__device__ __forceinline__ void ln_inplace(float (&v)[D / 64], const float* g, const float* b, int lane) {
    float s = 0.f;
#pragma unroll
    for (int j = 0; j < D / 64; ++j) s += v[j];
    const float mean = wave_sum(s) * (1.f / D); float q = 0.f;
#pragma unroll
    for (int j = 0; j < D / 64; ++j) { v[j] -= mean; q += v[j] * v[j]; }
    const float rstd = 1.0f / sqrtf(wave_sum(q) * (1.f / D) + LN_EPS);
#pragma unroll
    for (int j = 0; j < D / 64; ++j) { const int d = 4 * lane + 256 * (j >> 2) + (j & 3); v[j] = v[j] * rstd * g[d] + b[d]; }
}
__device__ __forceinline__ void phase_norm1(const Ctx& X, int l) {
    const int gw = X.bid * NWAVES + X.wave, NGW = X.G * NWAVES, lane = X.lane;
    const float* lng = X.in(I_LNG) + (size_t)(l * 2 + 0) * D; const float* lnb = X.in(I_LNB) + (size_t)(l * 2 + 0) * D;
    const float* wr = X.in(I_WR); const float* rb = X.in(I_RB);
    const float alpha = sqrtf(sqrtf(2.0f * DEPTH));
    for (int t = gw; t < M; t += NGW) {
        float* xr = X.ws<float>(WS_X) + (size_t)t * D; const float* mx = X.ws<float>(WS_MIX) + (size_t)t * D;
        const float* gate = modp(X, l, t, 2); const float* sh = modp(X, l, t, 3); const float* sc = modp(X, l, t, 4);
        float v[D / 64];
#pragma unroll
        for (int j = 0; j < D / 256; ++j) { const int d = 4 * lane + 256 * j; const f32x4 a = *(const f32x4*)(xr + d), m = *(const f32x4*)(mx + d), gt = *(const f32x4*)(gate + d);
#pragma unroll
            for (int i = 0; i < 4; ++i) v[4 * j + i] = alpha * a[i] + gt[i] * m[i]; }
        ln_inplace(v, lng, lnb, lane);
        float lg[NE];
#pragma unroll
        for (int e = 0; e < NE; ++e) lg[e] = 0.f;
        bf16* hf = X.ws<bf16>(WS_XMOD) + (size_t)t * D;
#pragma unroll
        for (int j = 0; j < D / 256; ++j) { const int d = 4 * lane + 256 * j; f32x4 o; const f32x4 a = *(const f32x4*)(sh + d), b = *(const f32x4*)(sc + d); float h[4];
#pragma unroll
            for (int i = 0; i < 4; ++i) { o[i] = v[4 * j + i]; h[i] = o[i] * (1.f + b[i]) + a[i];
#pragma unroll
                for (int e = 0; e < NE; ++e) lg[e] += h[i] * wr[(size_t)(d + i) * NE + e]; }
            *(f32x4*)(xr + d) = o;
            *(unsigned long long*)(hf + d) = (unsigned long long)pk2(h[0], h[1]) | ((unsigned long long)pk2(h[2], h[3]) << 32); }
#pragma unroll
        for (int e = 0; e < NE; ++e) lg[e] = wave_sum(lg[e]);
        float mxl = lg[0];
#pragma unroll
        for (int e = 1; e < NE; ++e) mxl = fmaxf(mxl, lg[e]);
        float sc_[NE], sum = 0.f;
#pragma unroll
        for (int e = 0; e < NE; ++e) { sc_[e] = expf(lg[e] - mxl); sum += sc_[e]; }
        const float isum = 1.0f / sum; float sel[NE];
#pragma unroll
        for (int e = 0; e < NE; ++e) { sc_[e] *= isum; sel[e] = sc_[e] + rb[e]; }
        int bg = 0; float bgs = -INFINITY;
#pragma unroll
        for (int g = 0; g < 4; ++g) { float m1 = -INFINITY, m2 = -INFINITY;
#pragma unroll
            for (int i = 0; i < 4; ++i) { const float x = sel[4 * g + i]; if (x > m1) { m2 = m1; m1 = x; } else if (x > m2) m2 = x; }
            const float gs = m1 + m2; if (gs > bgs) { bgs = gs; bg = g; } }
        int i0 = 0, i1 = 0; float s0 = -INFINITY, s1 = -INFINITY, p0 = 0.f, p1 = 0.f;
#pragma unroll
        for (int e = 0; e < NE; ++e) { if ((e >> 2) == bg) { const float x = sel[e]; if (x > s0) { s1 = s0; i1 = i0; p1 = p0; s0 = x; i0 = e; p0 = sc_[e]; } else if (x > s1) { s1 = x; i1 = e; p1 = sc_[e]; } } }
        if (lane == 0) { int* ei = X.ws<int>(WS_ROUT) + (size_t)t * 2; float* ew = (float*)(X.ws<int>(WS_ROUT) + (size_t)M * 2) + (size_t)t * 2;
            ei[0] = i0; ei[1] = i1; const float ws_ = 1.0f / (p0 + p1); ew[0] = p0 * ws_; ew[1] = p1 * ws_;
            atomicAdd(X.ctl() + CW_CNT + l * 64 + i0, 1u); atomicAdd(X.ctl() + CW_CNT + l * 64 + i1, 1u); }
    }
}

__device__ __forceinline__ void moe_table(const Ctx& X, int l, int NT) {
    volatile LAS int* tab = (volatile LAS int*)(X.lds + LDS_MISC) + 8;
    if (X.tid == 0) { int cum = 0, ts = 0;
        for (int e = 0; e < NE; ++e) { const int cnt = (int)__hip_atomic_load(X.ctl() + CW_CNT + l * 64 + e, RLX_AGENT); const int tc = (cnt + 255) / 256;
            tab[e] = cum; tab[32 + e] = ts; tab[64 + e] = tc; cum += tc * NT; ts += tc; }
        tab[16] = cum; }
    __syncthreads();
}
__device__ __forceinline__ void phase_scatter(const Ctx& X, int l) {
    moe_table(X, l, 1);
    volatile LAS int* tab = (volatile LAS int*)(X.lds + LDS_MISC) + 8;
    const int gw = X.bid * NWAVES + X.wave, NGW = X.G * NWAVES, lane = X.lane;
    const int* ei = X.ws<int>(WS_ROUT); int* slot = X.ws<int>(WS_ROUT) + (size_t)M * 4;
    for (int s = gw; s < 2 * M; s += NGW) { const int t = s >> 1; const int e = ei[s];
        int pos = 0; if (lane == 0) pos = tab[32 + e] * 256 + (int)atomicAdd(X.ctl() + CW_CUR + l * 64 + e, 1u);
        pos = __shfl(pos, 0);
        if (lane == 0) slot[s] = pos;
        const u32x4* src = (const u32x4*)(X.ws<bf16>(WS_XMOD) + (size_t)t * D); u32x4* dst = (u32x4*)(X.ws<bf16>(WS_XG) + (size_t)pos * D);
        for (int i = lane; i < D / 8; i += 64) dst[i] = src[i]; }
}

__device__ __forceinline__ void phase_combine(const Ctx& X, int l) {
    const int gw = X.bid * NWAVES + X.wave, NGW = X.G * NWAVES, lane = X.lane;
    const float* lng = X.in(I_LNG) + (size_t)(l * 2 + 1) * D; const float* lnb = X.in(I_LNB) + (size_t)(l * 2 + 1) * D;
    const float alpha = sqrtf(sqrtf(2.0f * DEPTH));
    const float* ew = (const float*)(X.ws<int>(WS_ROUT) + (size_t)M * 2); const int* slot = X.ws<int>(WS_ROUT) + (size_t)M * 4;
    for (int t = gw; t < M; t += NGW) {
        float* xr = X.ws<float>(WS_X) + (size_t)t * D; const float* gate = modp(X, l, t, 5);
        const bf16* y0 = X.ws<bf16>(WS_YS) + (size_t)slot[2 * t] * D; const bf16* y1 = X.ws<bf16>(WS_YS) + (size_t)slot[2 * t + 1] * D; const float w0 = ew[2 * t], w1 = ew[2 * t + 1];
        float v[D / 64];
#pragma unroll
        for (int j = 0; j < D / 256; ++j) { const int d = 4 * lane + 256 * j; const f32x4 a = *(const f32x4*)(xr + d), gt = *(const f32x4*)(gate + d);
            const unsigned long long q0 = *(const unsigned long long*)(y0 + d), q1 = *(const unsigned long long*)(y1 + d);
            float ya[4] = {bflo((unsigned)q0), bfhi((unsigned)q0), bflo((unsigned)(q0 >> 32)), bfhi((unsigned)(q0 >> 32))};
            float yb[4] = {bflo((unsigned)q1), bfhi((unsigned)q1), bflo((unsigned)(q1 >> 32)), bfhi((unsigned)(q1 >> 32))};
#pragma unroll
            for (int i = 0; i < 4; ++i) v[4 * j + i] = alpha * a[i] + gt[i] * (w0 * ya[i] + w1 * yb[i]); }
        ln_inplace(v, lng, lnb, lane);
        if (l + 1 < DEPTH) { const float* sh = modp(X, l + 1, t, 0); const float* sc = modp(X, l + 1, t, 1); bf16* xm = X.ws<bf16>(WS_XMOD) + (size_t)t * D;
#pragma unroll
            for (int j = 0; j < D / 256; ++j) { const int d = 4 * lane + 256 * j; f32x4 o; const f32x4 a = *(const f32x4*)(sh + d), b = *(const f32x4*)(sc + d); float h[4];
#pragma unroll
                for (int i = 0; i < 4; ++i) { o[i] = v[4 * j + i]; h[i] = o[i] * (1.f + b[i]) + a[i]; }
                *(f32x4*)(xr + d) = o;
                *(unsigned long long*)(xm + d) = (unsigned long long)pk2(h[0], h[1]) | ((unsigned long long)pk2(h[2], h[3]) << 32); }
        } else if (t >= CTX) { float* orow = X.out() + (size_t)(t - CTX) * D;
#pragma unroll
            for (int j = 0; j < D / 256; ++j) { const int d = 4 * lane + 256 * j; f32x4 o;
#pragma unroll
                for (int i = 0; i < 4; ++i) o[i] = v[4 * j + i];
                *(f32x4*)(orow + d) = o; }
        }
    }
}


#ifdef EMU
#define PHASE_FN static
#else
#define PHASE_FN __device__ __forceinline__
#endif
PHASE_FN void ph_weights(Ctx X, int l) { phase_weights(X, l); }
PHASE_FN void ph_x0(Ctx X) { phase_x0(X); }
PHASE_FN void ph_prep(Ctx X, int l) { phase_prep(X, l); }
PHASE_FN void ph_scanconv(Ctx X, int l) { phase_scanconv(X, l); }
PHASE_FN void ph_finish(Ctx X, int l) { phase_finish(X, l); }
PHASE_FN void ph_norm1(Ctx X, int l) { phase_norm1(X, l); }
PHASE_FN void ph_scatter(Ctx X, int l) { phase_scatter(X, l); }
PHASE_FN void ph_combine(Ctx X, int l) { phase_combine(X, l); }
PHASE_FN void ph_g1(Ctx X) { pg8::Gemm g{X.ws<bf16>(WS_XMOD), X.ws<bf16>(WS_WIN), D}; pg8::StaticOrder S; S.init(M, PCP, X.G, X.bid); pg8::EpiBf16 E{X.ws<bf16>(WS_P), PCP}; pg8::gemm_phase(X.lds, g, S, E); }
PHASE_FN void ph_g2a(Ctx X) { pg8::Gemm g{X.ws<bf16>(WS_RO), X.ws<bf16>(WS_WB), RW}; pg8::StaticOrder S; S.init(M, D, X.G, X.bid); pg8::EpiGate<false> E{X.ws<bf16>(WS_T), D, X.ws<bf16>(WS_P), PCP, C_GR}; pg8::gemm_phase(X.lds, g, S, E); }
PHASE_FN void ph_g2b(Ctx X) { pg8::Gemm g{X.ws<bf16>(WS_HO), X.ws<bf16>(WS_WB) + (size_t)D * RW, HW}; pg8::StaticOrder S; S.init(M, D, X.G, X.bid); pg8::EpiGate<true> E{X.ws<bf16>(WS_T), D, X.ws<bf16>(WS_P), PCP, C_GH}; pg8::gemm_phase(X.lds, g, S, E); }
PHASE_FN void ph_g3(Ctx X) { pg8::Gemm g{X.ws<bf16>(WS_T), X.ws<bf16>(WS_WO), D}; pg8::StaticOrder S; S.init(M, D, X.G, X.bid); pg8::EpiF32 E{X.ws<float>(WS_MIX), D}; pg8::gemm_phase(X.lds, g, S, E); }
PHASE_FN void ph_g4(Ctx X, int l) { moe_table(X, l, 2 * D / 256); pg8::MoeOrder S{(const volatile LAS int*)(X.lds + LDS_MISC) + 8, 2 * D / 256, X.G, X.bid};
    pg8::Gemm g{X.ws<bf16>(WS_XG), X.ws<bf16>(WS_WGU), D}; pg8::EpiSwiglu E{X.ws<bf16>(WS_ACT), D, 2 * D / 256}; pg8::gemm_phase(X.lds, g, S, E); }
PHASE_FN void ph_g5(Ctx X, int l) { moe_table(X, l, D / 256); pg8::MoeOrder S{(const volatile LAS int*)(X.lds + LDS_MISC) + 8, D / 256, X.G, X.bid};
    pg8::Gemm g{X.ws<bf16>(WS_ACT), X.ws<bf16>(WS_WD), D}; pg8::EpiMoeDown E{X.ws<bf16>(WS_YS), D, D / 256}; pg8::gemm_phase(X.lds, g, S, E); }

constexpr int NPH = 14, NPHASES = DEPTH * NPH;
template <int MASK> __global__ void __launch_bounds__(NTHR, 2) fwd_kernel(Args args) {
    DYN_LDS(lds);
    Ctx X; X.lds = lds; X.tid = threadIdx.x; X.lane = X.tid & 63; X.wave = READFIRSTLANE(X.tid >> 6); X.G = gridDim.x; X.bid = blockIdx.x;
    volatile LAS unsigned* misc = (volatile LAS unsigned*)(lds + LDS_MISC);
    if (X.tid < 128) misc[X.tid] = 0u;
    if (X.tid < N_IN + 2) { const unsigned long long p = X.tid < N_IN ? (unsigned long long)args.in[X.tid < N_IN ? X.tid : 0] : (X.tid == N_IN ? (unsigned long long)args.out : (unsigned long long)args.ws);
        misc[PT_WORD0 + 2 * X.tid] = (unsigned)p; misc[PT_WORD0 + 2 * X.tid + 1] = (unsigned)(p >> 32); }
    __syncthreads();
    XcdBarrier bar = xcd_barrier_post(X.ctl() + CW_BAR, misc);
    const int lo = args.ph_lo, hi = args.ph_hi;
#define IN(k) ((((MASK) >> ((k) % NPH)) & 1) && lo <= (k) && (k) < hi)
#define SEAM(k) do { if ((k) + 1 < hi) xcd_barrier(bar); } while (0)
    for (int l = 0; l < DEPTH; ++l) {
        const int pb = l * NPH;
        if (IN(pb + 0)) { ph_weights(X, l); SEAM(pb + 0); }
        if (l == 0 && IN(pb + 1)) { ph_x0(X); SEAM(pb + 1); }
        if (IN(pb + 2)) { ph_g1(X); SEAM(pb + 2); }
        if (IN(pb + 3)) { ph_prep(X, l); SEAM(pb + 3); }
        if (IN(pb + 4)) { ph_scanconv(X, l); SEAM(pb + 4); }
        if (IN(pb + 5)) { ph_finish(X, l); SEAM(pb + 5); }
        if (IN(pb + 6)) { ph_g2a(X); SEAM(pb + 6); }
        if (IN(pb + 7)) { ph_g2b(X); SEAM(pb + 7); }
        if (IN(pb + 8)) { ph_g3(X); SEAM(pb + 8); }
        if (IN(pb + 9)) { ph_norm1(X, l); SEAM(pb + 9); }
        if (IN(pb + 10)) { ph_scatter(X, l); SEAM(pb + 10); }
        if (IN(pb + 11)) { ph_g4(X, l); SEAM(pb + 11); }
        if (IN(pb + 12)) { ph_g5(X, l); SEAM(pb + 12); }
        if (IN(pb + 13)) { ph_combine(X, l); SEAM(pb + 13); }
    }
#undef IN
#undef SEAM
}

#ifndef N_LAUNCHES
#define N_LAUNCHES 0
#endif
#ifndef PH_MASK
#define PH_MASK 0x3fff
#endif
template <int MASK> static void launch_mask(int grid, hipStream_t stream, const Args& a) {
    static bool attr = false;
    if (!attr) { (void)hipFuncSetAttribute((const void*)fwd_kernel<MASK>, hipFuncAttributeMaxDynamicSharedMemorySize, LDS_BYTES); attr = true; }
    hipLaunchKernelGGL(fwd_kernel<MASK>, dim3(grid), dim3(NTHR), LDS_BYTES, stream, a);
}
extern "C" void kernel_launch(void* const* d_in, const int* in_sizes, int n_in, void* d_out, int out_size, void* d_ws, size_t ws_size, hipStream_t stream) {
    static int grid = 0;
    if (grid == 0) {
        if (n_in != N_IN || ws_size < WS_END) { fprintf(stderr, "kernel_launch: unexpected n_in %d or workspace %zu < %zu\n", n_in, ws_size, (size_t)WS_END); grid = -1; return; }
        int dev = 0, cus = 0;
        if (hipGetDevice(&dev) != hipSuccess || hipDeviceGetAttribute(&cus, hipDeviceAttributeMultiprocessorCount, dev) != hipSuccess) { grid = -1; return; }
        (void)hipGetLastError();
        grid = cus; if (grid > NPART) grid = NPART;
    }
    if (grid < 0) return;
    (void)in_sizes; (void)out_size;
    (void)hipMemsetAsync(d_ws, 0, CTL_BYTES, stream);
    Args a;
    for (int i = 0; i < N_IN; ++i) a.in[i] = (const float*)d_in[i];
    a.out = (float*)d_out; a.ws = (unsigned char*)d_ws;
#if N_LAUNCHES == 1
    a.ph_lo = 0; a.ph_hi = NPHASES;
    launch_mask<PH_MASK>(grid, stream, a);
#else
    for (int ph = 0; ph < NPHASES; ++ph) { const int k = ph % NPH; if (k == 1 && ph / NPH != 0) continue; a.ph_lo = ph; a.ph_hi = ph + 1;
        switch (k) {
            case 0: launch_mask<1 << 0>(grid, stream, a); break; case 1: launch_mask<1 << 1>(grid, stream, a); break; case 2: launch_mask<1 << 2>(grid, stream, a); break;
            case 3: launch_mask<1 << 3>(grid, stream, a); break; case 4: launch_mask<1 << 4>(grid, stream, a); break; case 5: launch_mask<1 << 5>(grid, stream, a); break;
            case 6: launch_mask<1 << 6>(grid, stream, a); break; case 7: launch_mask<1 << 7>(grid, stream, a); break; case 8: launch_mask<1 << 8>(grid, stream, a); break;
            case 9: launch_mask<1 << 9>(grid, stream, a); break; case 10: launch_mask<1 << 10>(grid, stream, a); break; case 11: launch_mask<1 << 11>(grid, stream, a); break;
            case 12: launch_mask<1 << 12>(grid, stream, a); break; default: launch_mask<1 << 13>(grid, stream, a); break; } }
#endif
}
```

```cpp
#ifndef EMU
#include <hip/hip_runtime.h>
#endif
#include <cstdio>
#include <cstdint>
#include <cmath>

#ifndef CFG_D
#define CFG_D 1024
#define CFG_SEQ 16384
#define CFG_CTX 256
#define CFG_DEPTH 4
#endif
constexpr int D = CFG_D, SEQ = CFG_SEQ, CTX = CFG_CTX, DEPTH = CFG_DEPTH, M = CTX + SEQ;
constexpr int GRID_W = 64, GRID_H = SEQ / GRID_W;
constexpr int RW = D / 2, NH = RW / 64, HW = D / 2, RC = 3 * RW + 384, HC = 3 * HW, GC = 2 * D, PC = RC + HC + GC, PCP = (PC + 255) / 256 * 256;
constexpr int QTR = RC / 4, HALFC = RC / 2;
constexpr int C_K = RW, C_V = 2 * RW, C_LWF = 3 * RW, C_LG = 3 * RW + 256;
constexpr int C_HY = RC, C_GR = RC + HC, C_GH = RC + HC + D;
constexpr int NE = 16, SP_TILES = (2 * M) / 256 + NE, SP = SP_TILES * 256;
constexpr float DECAY_SCALE = 0.606531f, GN_EPS = 6.4e-4f, LN_EPS = 1e-5f;
constexpr int NPART = 256;
static_assert(CTX % 32 == 0 && M % 256 == 0 && D % 256 == 0 && RW % 128 == 0 && RW >= 256 && SEQ % 64 == 0 && CTX % 32 == 0 && RC % 4 == 0, "shape assumptions");

enum { I_X = 0, I_C, I_CTX, I_CCTX, I_WMOD, I_BMOD, I_WIN, I_MU, I_W0, I_W2, I_A0, I_A2, I_G2, I_KK, I_KA, I_RK, I_LNXG, I_LNXB, I_CW, I_CB,
       I_FW1, I_FB1, I_FW2, I_FB2, I_FW3, I_FB3, I_FWO, I_FREQ, I_HBIAS, I_WBR, I_WOUT, I_LNG, I_LNB, I_WR, I_RB, I_WG, I_WU, I_WD, N_IN };

constexpr size_t al256(size_t x) { return (x + 255) & ~(size_t)255; }
constexpr size_t CTL_BYTES = 1u << 20;
constexpr size_t WS_MOD = CTL_BYTES;
constexpr size_t WS_FPART = al256(WS_MOD + (size_t)DEPTH * 2 * 6 * D * 4);
constexpr size_t WS_ROUT = al256(WS_FPART + (size_t)2 * NPART * HW * 4);
constexpr size_t WS_BONUS = al256(WS_ROUT + (size_t)M * 2 * 4 * 3);
constexpr size_t WS_WIN = al256(WS_BONUS + (size_t)M * NH * 4);
constexpr size_t WS_WB = al256(WS_WIN + (size_t)PCP * D * 2);
constexpr size_t WS_WO = al256(WS_WB + (size_t)2 * D * RW * 2);
constexpr size_t WS_WGU = al256(WS_WO + (size_t)D * D * 2);
constexpr size_t WS_WD = al256(WS_WGU + (size_t)NE * 2 * D * D * 2);
constexpr size_t WS_X = al256(WS_WD + (size_t)NE * D * D * 2);
constexpr size_t WS_XMOD = al256(WS_X + (size_t)M * D * 4);
constexpr size_t WS_P = al256(WS_XMOD + (size_t)M * D * 2);
constexpr size_t WS_FILT = al256(WS_P + (size_t)M * PCP * 2);
constexpr size_t WS_MIX = al256(WS_FILT + (size_t)M * HW * 4);
constexpr size_t WS_T = al256(WS_MIX + (size_t)M * D * 4);
constexpr size_t WS_S = al256(WS_T + (size_t)M * D * 2);
constexpr size_t WS_R = WS_S;
constexpr size_t WS_V = al256(WS_R + (size_t)M * RW * 2);
constexpr size_t WS_KA = al256(WS_V + (size_t)M * RW * 2);
constexpr size_t WS_KD = al256(WS_KA + (size_t)M * RW * 2);
constexpr size_t WS_KB = al256(WS_KD + (size_t)2 * M * RW * 2);
constexpr size_t WS_W = al256(WS_KB + (size_t)2 * M * RW * 2);
constexpr size_t WS_Y = al256(WS_W + (size_t)2 * M * RW * 4);
constexpr size_t WS_Z = al256(WS_Y + (size_t)2 * M * RW * 4);
constexpr size_t WS_X0 = al256(WS_Z + (size_t)M * HW * 4);
constexpr size_t WS_CONV = al256(WS_X0 + (size_t)M * HW * 2);
constexpr size_t WS_GATE = al256(WS_CONV + (size_t)M * HW * 4);
constexpr size_t WS_RO = al256(WS_GATE + (size_t)M * RW * 2);
constexpr size_t WS_HO = al256(WS_RO + (size_t)M * RW * 2);
constexpr size_t WS_END1 = al256(WS_HO + (size_t)M * HW * 2);
constexpr size_t WS_XG = WS_S;
constexpr size_t WS_ACT = al256(WS_XG + (size_t)SP * D * 2);
constexpr size_t WS_YS = al256(WS_ACT + (size_t)SP * D * 2);
constexpr size_t WS_END2 = al256(WS_YS + (size_t)SP * D * 2);
constexpr size_t WS_END = WS_END1 > WS_END2 ? WS_END1 : WS_END2;
constexpr int CW_TMO = 0, CW_BAR = 4096, CW_CNT = 8192  , CW_CUR = 8192 + 1024  , CW_Q = 8192 + 2048  ;

#ifdef EMU
#define LAS
typedef short bf16x8 __attribute__((vector_size(16)));
typedef float f32x4 __attribute__((vector_size(16)));
typedef unsigned u32x4 __attribute__((vector_size(16)));
#define DYN_LDS(name) unsigned char* name = emu_cur_lds()
#define ASM_WAIT_V(n) do {} while (0)
#define ASM_WAIT_L(n) do {} while (0)
#define ASM_WAIT_VL0() do {} while (0)
#define CFENCE() do {} while (0)
#define WAVE_LDS_FENCE() emu_wave_sync()
#define S_BARRIER() emu_block_sync()
#define SCHED_BARRIER() do {} while (0)
#define SETPRIO(x) do {} while (0)
#define S_SLEEP(n) emu_yield()
#define MFMA16(a, b, c) emu_mfma_16x16x32(a, b, c)
#define GLDS16(gptr, lptr) emu_glds16((const void*)(gptr), (void*)(lptr))
#define READFIRSTLANE(x) (x)
#define XCC_ID_() (blockIdx.x & 7u)
#define FENCE_RELEASE() do {} while (0)
#define FENCE_ACQUIRE() do {} while (0)
#define DPP_F(v, ctrl) emu_dpp_f(v, ctrl)
static inline int vgpr_zero() { return 0; }
static inline unsigned fbits(float f) { unsigned u; memcpy(&u, &f, 4); return u; }
static inline float bitsf(unsigned u) { float f; memcpy(&f, &u, 4); return f; }
#else
#define LAS __attribute__((address_space(3)))
typedef short bf16x8 __attribute__((ext_vector_type(8)));
typedef float f32x4 __attribute__((ext_vector_type(4)));
typedef unsigned u32x4 __attribute__((ext_vector_type(4)));
#define DYN_LDS(name) extern __shared__ __attribute__((aligned(16))) unsigned char name##_raw[]; LAS unsigned char* name = (LAS unsigned char*)name##_raw
#define ASM_WAIT_V(n) asm volatile("s_waitcnt vmcnt(" #n ")" ::: "memory")
#define ASM_WAIT_L(n) asm volatile("s_waitcnt lgkmcnt(" #n ")" ::: "memory")
#define ASM_WAIT_VL0() asm volatile("s_waitcnt vmcnt(0) lgkmcnt(0)" ::: "memory")
#define CFENCE() asm volatile("" ::: "memory")
#define WAVE_LDS_FENCE() asm volatile("s_waitcnt lgkmcnt(0)" ::: "memory")
#define S_BARRIER() __builtin_amdgcn_s_barrier()
#define SCHED_BARRIER() __builtin_amdgcn_sched_barrier(0)
#define SETPRIO(x) __builtin_amdgcn_s_setprio(x)
#define S_SLEEP(n) __builtin_amdgcn_s_sleep(n)
#define MFMA16(a, b, c) __builtin_amdgcn_mfma_f32_16x16x32_bf16(a, b, c, 0, 0, 0)
#define GLDS16(gptr, lptr) __builtin_amdgcn_global_load_lds((const unsigned*)(gptr), (LAS unsigned*)(lptr), 16, 0, 0)
#define READFIRSTLANE(x) __builtin_amdgcn_readfirstlane(x)
#define XCC_ID_() ((unsigned)__builtin_amdgcn_s_getreg((3 << 11) | 20) & 0xFu)
#define FENCE_RELEASE() __builtin_amdgcn_fence(__ATOMIC_RELEASE, "agent")
#define FENCE_ACQUIRE() __builtin_amdgcn_fence(__ATOMIC_ACQUIRE, "agent")
#define DPP_F(v, ctrl) __builtin_bit_cast(float, __builtin_amdgcn_update_dpp(0, __builtin_bit_cast(int, (float)(v)), (ctrl), 0xF, 0xF, true))
__device__ __forceinline__ int vgpr_zero() { int z; asm volatile("v_mov_b32 %0, 0" : "=v"(z)); return z; }
__device__ __forceinline__ unsigned fbits(float f) { return __builtin_bit_cast(unsigned, f); }
__device__ __forceinline__ float bitsf(unsigned u) { return __builtin_bit_cast(float, u); }
#endif
typedef unsigned short bf16;
#define RLX_AGENT __ATOMIC_RELAXED, __HIP_MEMORY_SCOPE_AGENT

__device__ __forceinline__ unsigned f2bf(float f) { unsigned u = fbits(f); return (u + 0x7fffu + ((u >> 16) & 1u)) >> 16; }
__device__ __forceinline__ unsigned pk2(float lo, float hi) { return f2bf(lo) | (f2bf(hi) << 16); }
__device__ __forceinline__ float bf2f(bf16 b) { return bitsf(((unsigned)b) << 16); }
__device__ __forceinline__ float bflo(unsigned w) { return bitsf(w << 16); }
__device__ __forceinline__ float bfhi(unsigned w) { return bitsf(w & 0xffff0000u); }
__device__ __forceinline__ float sigmoidf_(float x) { return 1.0f / (1.0f + expf(-x)); }
__device__ __forceinline__ float wave_sum(float v) {
#pragma unroll
    for (int o = 1; o < 64; o <<= 1) v += __shfl_xor(v, o);
    return v;
}
__device__ __forceinline__ float row16_sum(float v) {
    v += DPP_F(v, 0xB1);
    v += DPP_F(v, 0x4E);
    v += DPP_F(v, 0x141);
    v += DPP_F(v, 0x140);
    return v;
}
__device__ __forceinline__ void sincos_f(float x, float& s, float& c) {
    const float k = rintf(x * 0.63661977236758134f);
    float r = fmaf(-k, 1.5703125f, x); r = fmaf(-k, 4.837512969970703125e-4f, r); r = fmaf(-k, 7.54978994989188216e-8f, r);
    const float r2 = r * r;
    const float sp = r + r * r2 * (-1.6666654611e-1f + r2 * (8.3321608736e-3f + r2 * (-1.9515295891e-4f)));
    const float cp = 1.0f - 0.5f * r2 + r2 * r2 * (4.166664568298827e-2f + r2 * (-1.388731625493765e-3f + r2 * (2.443315711809948e-5f)));
    const int q = ((int)k) & 3;
    s = (q == 0) ? sp : (q == 1) ? cp : (q == 2) ? -sp : -cp;
    c = (q == 0) ? cp : (q == 1) ? -sp : (q == 2) ? -cp : sp;
}
__device__ __forceinline__ float sin_f(float x) { float s, c; sincos_f(x, s, c); return s; }

#define XB_TMO      128
#define XB_XCNT(j)  (256  + 64 * (j))
#define XB_XSUB(j)  (1280 + 64 * (j))
#define XB_XGEN(j)  (2304 + 64 * (j))
#define XB_TOP      3328
#define XB_TOPGEN   3392
#define XCD_BAR_WORDS 3456
#define XB_SPIN_CAP (1u << 18)
__device__ __forceinline__ unsigned xb_ld(unsigned* p)              { return __hip_atomic_load(p, __ATOMIC_RELAXED, __HIP_MEMORY_SCOPE_AGENT); }
__device__ __forceinline__ unsigned xb_add(unsigned* p, unsigned v) { return __hip_atomic_fetch_add(p, v, __ATOMIC_RELAXED, __HIP_MEMORY_SCOPE_AGENT); }
#define XB_SPIN(cond, bar) do { unsigned _sp = 0; while (cond) { S_SLEEP(1); \
    if ((++_sp & 255u) == 0u) { if (xb_ld(&(bar)[XB_TMO])) break; if (_sp > XB_SPIN_CAP) { atomicAdd(&(bar)[XB_TMO], 1u); break; } } } } while (0)
struct XcdBarrier { unsigned* bar; unsigned x; volatile LAS unsigned* st; };
__device__ __forceinline__ XcdBarrier xcd_barrier_post(unsigned* bar, volatile LAS unsigned* st) {
    XcdBarrier b; b.bar = bar; b.x = XCC_ID_(); b.st = st;
    if (threadIdx.x == 0) (void)xb_add(&bar[XB_XCNT(b.x)], 1u);
    return b;
}
__device__ __forceinline__ void xcd_barrier_complete(unsigned* bar, unsigned x, unsigned& nloc, unsigned& nx) {
    const unsigned G = gridDim.x * gridDim.y * gridDim.z;
    unsigned sum, cnt, mine, sp = 0u;
    for (;;) {
        sum = 0u; cnt = 0u; mine = 0u;
#pragma unroll
        for (unsigned j = 0; j < 16; ++j) { const unsigned c = xb_ld(&bar[XB_XCNT(j)]); sum += c; cnt += (c > 0u) ? 1u : 0u; mine = (j == x) ? c : mine; }
        if (sum == G) break;
        S_SLEEP(1);
        if ((++sp & 255u) == 0u) { if (xb_ld(&bar[XB_TMO])) break; if (sp > XB_SPIN_CAP) { atomicAdd(&bar[XB_TMO], 1u); break; } }
    }
    nloc = mine > 0u ? mine : 1u; nx = cnt > 0u ? cnt : 1u;
}
__device__ __forceinline__ void xcd_barrier(const XcdBarrier& b) {
    ASM_WAIT_V(0);
    __syncthreads();
    if (threadIdx.x == 0) {
        unsigned* bar = b.bar;
        ASM_WAIT_VL0();
        unsigned nloc = b.st[0], nx = b.st[1];
        if (nloc == 0u) { xcd_barrier_complete(bar, b.x, nloc, nx); b.st[0] = nloc; b.st[1] = nx; }
        const unsigned old = xb_add(&bar[XB_XSUB(b.x)], 1u);
        const unsigned gen = old / nloc;
        if (old + 1u == (gen + 1u) * nloc) {
            FENCE_RELEASE();
            ASM_WAIT_V(0);
            const unsigned og = xb_add(&bar[XB_TOP], 1u);
            const unsigned tg = og / nx;
            if (og + 1u == (tg + 1u) * nx) xb_add(&bar[XB_TOPGEN], 1u);
            else XB_SPIN(xb_ld(&bar[XB_TOPGEN]) == tg, bar);
            FENCE_ACQUIRE();
            xb_add(&bar[XB_XGEN(b.x)], 1u);
            ASM_WAIT_V(0);
        } else {
            XB_SPIN(xb_ld(&bar[XB_XGEN(b.x)]) == gen, bar);
            FENCE_ACQUIRE();
            ASM_WAIT_V(0);
        }
    }
    __syncthreads();
}

namespace pg8 {
constexpr int BM = 256, BK = 64, HALF = 128, HTB = HALF * BK * 2, STAGE_BYTES = 8 * HTB, NXCD = 8, WGM = 8;
__host__ __device__ __forceinline__ int lds_byte(int r, int c) { const int st = (r >> 4) * 2 + (c >> 5), rr = r & 15, cc = c & 31, ob = rr * 64 + cc * 2; return st * 1024 + (ob ^ (((ob >> 9) & 1) << 5)); }
__host__ __device__ __forceinline__ void stage_rc(int b, int& R, int& C) { const int st = b / 1024, sb = b % 1024, swz = sb ^ (((sb >> 9) & 1) << 5); R = (st >> 1) * 16 + swz / 64; C = (st & 1) * 32 + (swz % 64) / 2; }
__host__ __device__ __forceinline__ int perm32(int rho) { const int n = rho >> 4, i = rho & 15; return 8 * (i >> 2) + 4 * n + (i & 3); }
struct Unit { int pm, pn; };
struct Gemm { const bf16* A; const bf16* Bt; int K; };
struct StaticOrder {
    int nM, nN, nwg, G, c;
    __host__ __device__ void init(int M_, int N_, int G_, int c_) { nM = M_ / BM; nN = N_ / BM; nwg = nM * nN; G = G_; c = c_; }
    __host__ __device__ bool next(int i, Unit& u) const {
        const long L = (long)i * G + c; if (L >= nwg) return false;
        int wgid = (int)L; { const int q = nwg / NXCD, r = nwg % NXCD, xcd = wgid % NXCD, off = wgid / NXCD; wgid = (xcd < r ? xcd * (q + 1) : r * (q + 1) + (xcd - r) * q) + off; }
        const int nig = WGM * nN, gid = wgid / nig, fm = gid * WGM, gsz = (nM - fm) < WGM ? (nM - fm) : WGM;
        u.pm = fm + ((wgid % nig) % gsz); u.pn = (wgid % nig) / gsz; return true;
    }
};
struct MoeOrder {
    const volatile LAS int* tab; int NT, G, c;
    __device__ __forceinline__ bool next(int i, Unit& u) const {
        const long L = (long)i * G + c; if (L >= tab[16]) return false;
        int e = 0; while (L >= tab[e + 1]) ++e;
        const int loc = (int)L - tab[e], tc = tab[64 + e];
        u.pm = tab[32 + e] + loc % tc; u.pn = e * NT + loc / tc; return true;
    }
};
__device__ __forceinline__ unsigned cvt_pk_bf16(float lo, float hi) {
#ifdef EMU
    return pk2(lo, hi);
#else
    unsigned r; asm volatile("v_cvt_pk_bf16_f32 %0, %1, %2" : "=v"(r) : "v"(lo), "v"(hi)); return r;
#endif
}

struct EpiBf16 {
    static constexpr bool PERM = true;
    bf16* O; int ldc;
    __device__ __forceinline__ void operator()(const f32x4 (&acc)[2][2][4][2], const Unit& u, int wr, int wc, int fr, int fq) const {
        const int row0 = u.pm * BM + wr * 64 + fr, col0 = u.pn * BM + wc * 32 + 8 * fq;
#pragma unroll
        for (int ai = 0; ai < 2; ++ai)
#pragma unroll
            for (int m = 0; m < 4; ++m) { bf16* rowp = O + (size_t)(row0 + ai * HALF + m * 16) * ldc + col0;
#pragma unroll
                for (int bj = 0; bj < 2; ++bj) { const f32x4 v0 = acc[ai][bj][m][0], v1 = acc[ai][bj][m][1];
                    u32x4 w; w[0] = cvt_pk_bf16(v0[0], v0[1]); w[1] = cvt_pk_bf16(v0[2], v0[3]); w[2] = cvt_pk_bf16(v1[0], v1[1]); w[3] = cvt_pk_bf16(v1[2], v1[3]);
                    *(u32x4*)(rowp + bj * HALF) = w; } }
    }
};
struct EpiF32 {
    static constexpr bool PERM = false;
    float* C; int ldc;
    __device__ __forceinline__ void operator()(const f32x4 (&acc)[2][2][4][2], const Unit& u, int wr, int wc, int fr, int fq) const {
        const int row0 = u.pm * BM + wr * 64 + fr, col0 = u.pn * BM + wc * 32 + 4 * fq;
#pragma unroll
        for (int ai = 0; ai < 2; ++ai)
#pragma unroll
            for (int m = 0; m < 4; ++m) { float* rowp = C + (size_t)(row0 + ai * HALF + m * 16) * ldc + col0;
#pragma unroll
                for (int bj = 0; bj < 2; ++bj)
#pragma unroll
                    for (int n = 0; n < 2; ++n) *(f32x4*)(rowp + bj * HALF + n * 16) = acc[ai][bj][m][n]; }
    }
};
template <bool ADD> struct EpiGate {
    static constexpr bool PERM = true;
    bf16* T; int ldc; const bf16* Pg; int ldp; int gcol0;
    __device__ __forceinline__ void operator()(const f32x4 (&acc)[2][2][4][2], const Unit& u, int wr, int wc, int fr, int fq) const {
        const int row0 = u.pm * BM + wr * 64 + fr, col0 = u.pn * BM + wc * 32 + 8 * fq;
#pragma unroll
        for (int ai = 0; ai < 2; ++ai)
#pragma unroll
            for (int m = 0; m < 4; ++m) { const size_t row = (size_t)(row0 + ai * HALF + m * 16);
#pragma unroll
                for (int bj = 0; bj < 2; ++bj) { const f32x4 v0 = acc[ai][bj][m][0], v1 = acc[ai][bj][m][1];
                    const u32x4 g = *(const u32x4*)(Pg + row * ldp + gcol0 + col0 + bj * HALF);
                    u32x4 t = {0u, 0u, 0u, 0u}; if (ADD) t = *(const u32x4*)(T + row * ldc + col0 + bj * HALF);
                    float o[8];
#pragma unroll
                    for (int j = 0; j < 4; ++j) { const float a0 = j < 2 ? v0[2 * j] : v1[2 * j - 4], a1 = j < 2 ? v0[2 * j + 1] : v1[2 * j - 3];
                        o[2 * j] = bflo(t[j]) + sigmoidf_(bflo(g[j])) * a0; o[2 * j + 1] = bfhi(t[j]) + sigmoidf_(bfhi(g[j])) * a1; }
                    u32x4 w; w[0] = cvt_pk_bf16(o[0], o[1]); w[1] = cvt_pk_bf16(o[2], o[3]); w[2] = cvt_pk_bf16(o[4], o[5]); w[3] = cvt_pk_bf16(o[6], o[7]);
                    *(u32x4*)(T + row * ldc + col0 + bj * HALF) = w; } }
    }
};
struct EpiSwiglu {
    static constexpr bool PERM = true;
    bf16* O; int ldc; int NT;
    __device__ __forceinline__ void operator()(const f32x4 (&acc)[2][2][4][2], const Unit& u, int wr, int wc, int fr, int fq) const {
        const int row0 = u.pm * BM + wr * 64 + fr, col0 = (u.pn % NT) * HALF + wc * 32 + 8 * fq;
#pragma unroll
        for (int ai = 0; ai < 2; ++ai)
#pragma unroll
            for (int m = 0; m < 4; ++m) { bf16* rowp = O + (size_t)(row0 + ai * HALF + m * 16) * ldc + col0;
                float o[8];
#pragma unroll
                for (int j = 0; j < 8; ++j) { const float g = acc[ai][0][m][j >> 2][j & 3], uu = acc[ai][1][m][j >> 2][j & 3]; o[j] = g / (1.0f + expf(-g)) * uu; }
                u32x4 w; w[0] = cvt_pk_bf16(o[0], o[1]); w[1] = cvt_pk_bf16(o[2], o[3]); w[2] = cvt_pk_bf16(o[4], o[5]); w[3] = cvt_pk_bf16(o[6], o[7]);
                *(u32x4*)rowp = w; }
    }
};
struct EpiMoeDown {
    static constexpr bool PERM = true;
    bf16* O; int ldc; int NT;
    __device__ __forceinline__ void operator()(const f32x4 (&acc)[2][2][4][2], const Unit& u, int wr, int wc, int fr, int fq) const {
        const int row0 = u.pm * BM + wr * 64 + fr, col0 = (u.pn % NT) * BM + wc * 32 + 8 * fq;
#pragma unroll
        for (int ai = 0; ai < 2; ++ai)
#pragma unroll
            for (int m = 0; m < 4; ++m) { bf16* rowp = O + (size_t)(row0 + ai * HALF + m * 16) * ldc + col0;
#pragma unroll
                for (int bj = 0; bj < 2; ++bj) { const f32x4 v0 = acc[ai][bj][m][0], v1 = acc[ai][bj][m][1];
                    u32x4 w; w[0] = cvt_pk_bf16(v0[0], v0[1]); w[1] = cvt_pk_bf16(v0[2], v0[3]); w[2] = cvt_pk_bf16(v1[0], v1[1]); w[3] = cvt_pk_bf16(v1[2], v1[3]);
                    *(u32x4*)(rowp + bj * HALF) = w; } }
    }
};

template <class Epi, class Sched>
__device__ __forceinline__ void gemm_phase(LAS unsigned char* lds, const Gemm g, const Sched& S, const Epi& E) {
    const int tid = threadIdx.x, wid = READFIRSTLANE(tid >> 6), lane = tid & 63, wr = wid >> 2, wc = wid & 3, fr = lane & 15, fq = lane >> 4;
    const int K = g.K, nt = K / BK;
    unsigned voffA[2], voffB[2];
#pragma unroll
    for (int i = 0; i < 2; ++i) { int R, C; stage_rc(tid * 16 + i * 8192, R, C); const int Rb = Epi::PERM ? ((R & ~31) + perm32(R & 31)) : R;
        voffA[i] = (unsigned)(R * K + C) * 2u; voffB[i] = (unsigned)(Rb * K + C) * 2u; }
    const size_t kstep = (size_t)(BK * 2);
    const size_t hstep = (size_t)HALF * K * 2;
    const size_t tstep = 2 * hstep;
    const unsigned ldsw = (unsigned)wid * 1024u;
    const int aoff = lds_byte(wr * 64 + fr, fq * 8), boff = lds_byte(wc * 32 + fr, fq * 8);
#define PG8_SA(b, h) (((b) * 2 + (h)) * HTB)
#define PG8_SB(b, h) ((4 + (b) * 2 + (h)) * HTB)
#define PG8_STAGE(bufoff, gbase, voff) do { _Pragma("unroll") for (int _i = 0; _i < 2; ++_i) \
        GLDS16((const char*)(gbase) + (voff)[_i], lds + (bufoff) + ldsw + _i * 8192); } while (0)
#define PG8_LDA(dst, b, h) do { _Pragma("unroll") for (int m = 0; m < 4; ++m) _Pragma("unroll") for (int k = 0; k < 2; ++k) dst[m][k] = *(const LAS bf16x8*)(lds + PG8_SA(b, h) + aoff + m * 2048 + k * 1024); } while (0)
#define PG8_LDB(dst, b, h) do { _Pragma("unroll") for (int n = 0; n < 2; ++n) _Pragma("unroll") for (int k = 0; k < 2; ++k) dst[n][k] = *(const LAS bf16x8*)(lds + PG8_SB(b, h) + boff + n * 2048 + k * 1024); } while (0)
#define PG8_MMA(ai, bj, At, Bt) do { SETPRIO(1); _Pragma("unroll") for (int m = 0; m < 4; ++m) _Pragma("unroll") for (int n = 0; n < 2; ++n) _Pragma("unroll") for (int k = 0; k < 2; ++k) \
        acc[ai][bj][m][n] = MFMA16(Bt[n][k], At[m][k], acc[ai][bj][m][n]); SETPRIO(0); } while (0)
#define PG8_BAR S_BARRIER()
    Unit cur, nxt; int ui = 0;
    if (!S.next(0, cur)) return;
    f32x4 acc[2][2][4][2];
#pragma unroll
    for (int a = 0; a < 2; ++a)
#pragma unroll
        for (int b = 0; b < 2; ++b)
#pragma unroll
            for (int m = 0; m < 4; ++m)
#pragma unroll
                for (int n = 0; n < 2; ++n) acc[a][b][m][n] = (f32x4){0.f, 0.f, 0.f, 0.f};
    bf16x8 At[4][2], B0[2][2], B1[2][2];
    const char* cA = (const char*)g.A + (size_t)cur.pm * tstep; const char* cB = (const char*)g.Bt + (size_t)cur.pn * tstep;
    PG8_STAGE(PG8_SB(0, 0), cB, voffB); PG8_STAGE(PG8_SA(0, 0), cA, voffA); PG8_STAGE(PG8_SB(0, 1), cB + hstep, voffB); PG8_STAGE(PG8_SA(0, 1), cA + hstep, voffA);
    if (wr == 1) PG8_BAR;
    ASM_WAIT_V(4); PG8_BAR;
    PG8_STAGE(PG8_SB(1, 0), cB + kstep, voffB); PG8_STAGE(PG8_SA(1, 0), cA + kstep, voffA); PG8_STAGE(PG8_SB(1, 1), cB + hstep + kstep, voffB);
    ASM_WAIT_V(6); PG8_BAR;
    for (;;) {
        const bool has_next = S.next(ui + 1, nxt);
        const char* nA = has_next ? (const char*)g.A + (size_t)nxt.pm * tstep : cA; const char* nB = has_next ? (const char*)g.Bt + (size_t)nxt.pn * tstep : cB;
        for (int t = 0; t < nt; t += 2) {
            const bool last = (t == nt - 2);
            const char* a1 = cA + (size_t)(t + 1) * kstep;
            const char* a2 = last ? nA : cA + (size_t)(t + 2) * kstep; const char* b2 = last ? nB : cB + (size_t)(t + 2) * kstep;
            const char* a3 = a2 + kstep; const char* b3 = b2 + kstep;
            PG8_LDB(B0, 0, 0); SCHED_BARRIER(); PG8_LDA(At, 0, 0); PG8_STAGE(PG8_SA(1, 1), a1 + hstep, voffA);
            ASM_WAIT_L(8); PG8_BAR; ASM_WAIT_L(0); PG8_MMA(0, 0, At, B0); PG8_BAR; SCHED_BARRIER();
            PG8_LDB(B1, 0, 1); PG8_STAGE(PG8_SB(0, 0), b2, voffB);
            PG8_BAR; ASM_WAIT_L(0); PG8_MMA(0, 1, At, B1); PG8_BAR;
            PG8_LDA(At, 0, 1); PG8_STAGE(PG8_SA(0, 0), a2, voffA);
            PG8_BAR; ASM_WAIT_L(0); PG8_MMA(1, 0, At, B0); PG8_BAR; SCHED_BARRIER();
            PG8_STAGE(PG8_SB(0, 1), b2 + hstep, voffB);
            ASM_WAIT_V(6); PG8_BAR; PG8_MMA(1, 1, At, B1); PG8_BAR;
            PG8_LDB(B0, 1, 0); SCHED_BARRIER(); PG8_LDA(At, 1, 0); PG8_STAGE(PG8_SA(0, 1), a2 + hstep, voffA);
            ASM_WAIT_L(8); PG8_BAR; ASM_WAIT_L(0); PG8_MMA(0, 0, At, B0); PG8_BAR; SCHED_BARRIER();
            PG8_LDB(B1, 1, 1); PG8_STAGE(PG8_SB(1, 0), b3, voffB);
            PG8_BAR; ASM_WAIT_L(0); PG8_MMA(0, 1, At, B1); PG8_BAR;
            PG8_LDA(At, 1, 1); PG8_STAGE(PG8_SA(1, 0), a3, voffA);
            PG8_BAR; ASM_WAIT_L(0); PG8_MMA(1, 0, At, B0); PG8_BAR; SCHED_BARRIER();
            PG8_STAGE(PG8_SB(1, 1), b3 + hstep, voffB);
            ASM_WAIT_V(6); PG8_BAR; PG8_MMA(1, 1, At, B1); PG8_BAR;
        }
        E(acc, cur, wr, wc, fr, fq);
        if (!has_next) break;
#pragma unroll
        for (int a = 0; a < 2; ++a)
#pragma unroll
            for (int b = 0; b < 2; ++b)
#pragma unroll
                for (int m = 0; m < 4; ++m)
#pragma unroll
                    for (int n = 0; n < 2; ++n) acc[a][b][m][n] = (f32x4){0.f, 0.f, 0.f, 0.f};
        cur = nxt; cA = nA; cB = nB; ++ui;
    }
    ASM_WAIT_V(0);
    if (wr == 0) PG8_BAR;
    PG8_BAR;
#undef PG8_SA
#undef PG8_SB
#undef PG8_STAGE
#undef PG8_LDA
#undef PG8_LDB
#undef PG8_MMA
#undef PG8_BAR
}
}

struct Args { const float* in[N_IN]; float* out; unsigned char* ws; int ph_lo, ph_hi; };
constexpr int NWAVES = 8, NTHR = 512;
constexpr int LDS_STAGE = 131072, LDS_MISC = LDS_STAGE, LDS_BYTES = 147456;

constexpr int PT_OUT = N_IN, PT_WS = N_IN + 1, PT_WORD0 = 128;
struct Ctx {
    LAS unsigned char* lds; int tid, lane, wave, G, bid;
    __device__ __forceinline__ unsigned long long ptr(int i) const { const volatile LAS unsigned* t = (const volatile LAS unsigned*)(lds + LDS_MISC) + PT_WORD0 + 2 * i;
        const unsigned lo = (unsigned)READFIRSTLANE((int)t[0]), hi = (unsigned)READFIRSTLANE((int)t[1]); return ((unsigned long long)hi << 32) | lo; }
    __device__ __forceinline__ unsigned long long ptrv(int i) const { const volatile LAS unsigned* t = (const volatile LAS unsigned*)(lds + LDS_MISC) + PT_WORD0 + 2 * i; return ((unsigned long long)t[1] << 32) | t[0]; }
    __device__ __forceinline__ const float* inv(int i) const { return (const float*)ptrv(i); }
    template <class T> __device__ __forceinline__ T* wsv(size_t off) const { return (T*)((unsigned char*)ptrv(PT_WS) + off); }
    __device__ __forceinline__ const float* in(int i) const { return (const float*)ptr(i); }
    __device__ __forceinline__ float* out() const { return (float*)ptr(PT_OUT); }
    template <class T> __device__ __forceinline__ T* ws(size_t off) const { return (T*)((unsigned char*)ptr(PT_WS) + off); }
    __device__ __forceinline__ unsigned* ctl() const { return (unsigned*)ptr(PT_WS); }
};

__device__ __forceinline__ void transpose_item(const float* W, int ldw, int k0, int n0, int nvalid, bf16* outp, int ldo, LAS float* scr, int lane) {
#pragma unroll 8
    for (int i = 0; i < 32; ++i) { const int kk = 2 * i + (lane >> 5), n = n0 + (lane & 31); scr[kk * 33 + (lane & 31)] = (n < nvalid) ? W[(size_t)(k0 + kk) * ldw + n] : 0.f; }
    WAVE_LDS_FENCE(); CFENCE();
    const int c = lane & 7;
#pragma unroll
    for (int j = 0; j < 4; ++j) { const int n = (lane >> 3) + 8 * j; const LAS float* s = scr + (8 * c) * 33 + n;
        u32x4 o; o[0] = pk2(s[0 * 33], s[1 * 33]); o[1] = pk2(s[2 * 33], s[3 * 33]); o[2] = pk2(s[4 * 33], s[5 * 33]); o[3] = pk2(s[6 * 33], s[7 * 33]);
        *(u32x4*)(outp + (size_t)n * ldo + k0 + 8 * c) = o; }
    WAVE_LDS_FENCE(); CFENCE();
}
__device__ __forceinline__ void filter_item(const Ctx& X, int l, int n, int pos0, float* out  , LAS float* scr  , LAS float* asum  ) {
    const int lane = X.lane;
    LAS float* zs = scr; LAS float* ha = scr + 8 * 33; LAS float* hb = ha + 8 * 64;
    const float* w1 = X.in(I_FW1) + (size_t)l * 33 * 64; const float* b1 = X.in(I_FB1) + l * 64;
    const float* w2 = X.in(I_FW2) + (size_t)l * 64 * 64; const float* b2 = X.in(I_FB2) + l * 64;
    const float* w3 = X.in(I_FW3) + (size_t)l * 64 * 64; const float* b3 = X.in(I_FB3) + l * 64;
    const float* wo = X.in(I_FWO) + (size_t)l * 64 * HW; const float fr = X.in(I_FREQ)[l * 64 + lane];
    if (lane < 33) {
#pragma unroll
        for (int p = 0; p < 8; ++p) { const int pos = pos0 + p; float v;
            if (lane == 0) v = (float)pos / (float)(n - 1 > 1 ? n - 1 : 1);
            else { const int b = (lane - 1) & 15; const double band = 1e-4 + (double)b * ((15.0 - 1e-4) / 15.0);
                double rev = (double)pos * band / (double)n; rev -= floor(rev); if (rev > 0.5) rev -= 1.0;
                float s, c; sincos_f((float)(rev * 6.283185307179586476925), s, c); v = lane <= 16 ? c : -s; }
            zs[p * 33 + lane] = v; }
    }
    WAVE_LDS_FENCE(); CFENCE();
    float acc[8];
    { const float bb = b1[lane];
#pragma unroll
      for (int p = 0; p < 8; ++p) acc[p] = bb;
#pragma unroll 3
      for (int i = 0; i < 33; ++i) { const float w = w1[i * 64 + lane];
#pragma unroll
          for (int p = 0; p < 8; ++p) acc[p] += zs[p * 33 + i] * w; }
#pragma unroll
      for (int p = 0; p < 8; ++p) ha[p * 64 + lane] = sin_f(fr * acc[p]); }
    WAVE_LDS_FENCE(); CFENCE();
    { const float bb = b2[lane];
#pragma unroll
      for (int p = 0; p < 8; ++p) acc[p] = bb;
#pragma unroll 4
      for (int i = 0; i < 64; ++i) { const float w = w2[i * 64 + lane];
#pragma unroll
          for (int p = 0; p < 8; ++p) acc[p] += ha[p * 64 + i] * w; }
#pragma unroll
      for (int p = 0; p < 8; ++p) hb[p * 64 + lane] = sin_f(fr * acc[p]); }
    WAVE_LDS_FENCE(); CFENCE();
    { const float bb = b3[lane];
#pragma unroll
      for (int p = 0; p < 8; ++p) acc[p] = bb;
#pragma unroll 4
      for (int i = 0; i < 64; ++i) { const float w = w3[i * 64 + lane];
#pragma unroll
          for (int p = 0; p < 8; ++p) acc[p] += hb[p * 64 + i] * w; }
#pragma unroll
      for (int p = 0; p < 8; ++p) ha[p * 64 + lane] = sin_f(fr * acc[p]); }
    WAVE_LDS_FENCE(); CFENCE();
    const float dmin = -3.0701134573253944f, dmax = -15.350567286626972f;
#pragma unroll 1
    for (int mI = 0; mI < HW / 64; ++mI) { const int c = lane + 64 * mI;
#pragma unroll
        for (int p = 0; p < 8; ++p) acc[p] = 0.f;
#pragma unroll 4
        for (int i = 0; i < 64; ++i) { const float w = wo[i * HW + c];
#pragma unroll
            for (int p = 0; p < 8; ++p) acc[p] += ha[p * 64 + i] * w; }
        const float delta = fabsf(dmin + (float)c * ((dmax - dmin) / (float)(HW - 1)));
        float as = 0.f;
#pragma unroll
        for (int p = 0; p < 8; ++p) { const int pos = pos0 + p; const int dd = pos - n / 2; const float dist = (float)(dd < 0 ? -dd : dd) * (2.0f / (float)n);
            const float v = acc[p] * expf(-dist * delta); out[(size_t)pos * HW + c] = v; as += fabsf(v); }
        asum[c] += as; }
    WAVE_LDS_FENCE(); CFENCE();
}
__device__ __forceinline__ void phase_transposes(const Ctx& X, int l) {
    LAS float* scr = (LAS float*)(X.lds + X.wave * 16384);
    const int gw = X.bid * NWAVES + X.wave, NGW = X.G * NWAVES, lane = X.lane;
    constexpr int KB_D = D / 64, I_WIN_ = KB_D * (PCP / 32), I_WB_ = 2 * (RW / 64) * (D / 32), I_WO_ = KB_D * (D / 32), I_WGU_ = NE * 2 * KB_D * (D / 32), I_WD_ = NE * KB_D * (D / 32);
    constexpr int NITEMS = I_WIN_ + I_WB_ + I_WO_ + I_WGU_ + I_WD_;
    for (int it = gw; it < NITEMS; it += NGW) {
        int r = it; const float* W; int ldw, k0, n0, nvalid, ldo; bf16* outp;
        if (r < I_WIN_) { const int nb = r % (PCP / 32), kb = r / (PCP / 32); W = X.in(I_WIN) + (size_t)l * D * PC; ldw = PC; k0 = 64 * kb; n0 = 32 * nb; nvalid = PC; outp = X.ws<bf16>(WS_WIN) + (size_t)n0 * D; ldo = D; }
        else if ((r -= I_WIN_) < I_WB_) { const int s = r / ((RW / 64) * (D / 32)), q = r % ((RW / 64) * (D / 32)), nb = q % (D / 32), kb = q / (D / 32);
            W = X.in(I_WBR) + ((size_t)l * 2 + s) * RW * D; ldw = D; k0 = 64 * kb; n0 = 32 * nb; nvalid = D; outp = X.ws<bf16>(WS_WB) + (size_t)s * D * RW + (size_t)n0 * RW; ldo = RW; }
        else if ((r -= I_WB_) < I_WO_) { const int nb = r % (D / 32), kb = r / (D / 32); W = X.in(I_WOUT) + (size_t)l * D * D; ldw = D; k0 = 64 * kb; n0 = 32 * nb; nvalid = D; outp = X.ws<bf16>(WS_WO) + (size_t)n0 * D; ldo = D; }
        else if ((r -= I_WO_) < I_WGU_) { const int per = KB_D * (D / 32), es = r / per, q = r % per, e = es >> 1, src = es & 1, nb = q % (D / 32), kb = q / (D / 32); n0 = 32 * nb;
            W = (src ? X.in(I_WU) : X.in(I_WG)) + ((size_t)l * NE + e) * D * D; ldw = D; k0 = 64 * kb; nvalid = D; const int orow = e * 2 * D + (n0 / 128) * 256 + src * 128 + (n0 % 128);
            outp = X.ws<bf16>(WS_WGU) + (size_t)orow * D; ldo = D; }
        else { r -= I_WGU_; const int per = KB_D * (D / 32), e = r / per, q = r % per, nb = q % (D / 32), kb = q / (D / 32);
            W = X.in(I_WD) + ((size_t)l * NE + e) * D * D; ldw = D; k0 = 64 * kb; n0 = 32 * nb; nvalid = D; outp = X.ws<bf16>(WS_WD) + (size_t)(e * D + n0) * D; ldo = D; }
        transpose_item(W, ldw, k0, n0, nvalid, outp, ldo, scr, lane);
    }
}
__device__ __forceinline__ void phase_filters(const Ctx& X, int l) {
    LAS float* scr = (LAS float*)(X.lds + X.wave * 8192);
    const int gw = X.bid * NWAVES + X.wave, NGW = X.G * NWAVES, lane = X.lane;
    LAS float* part = (LAS float*)(X.lds + 65536);
    static_assert(65536 + NWAVES * 2 * HW * 4 <= LDS_STAGE, "filter LDS map");
    for (int i = lane; i < 2 * HW; i += 64) part[X.wave * 2 * HW + i] = 0.f;
    WAVE_LDS_FENCE(); CFENCE();
    float* filt = X.ws<float>(WS_FILT);
    for (int it = gw; it < SEQ / 8; it += NGW) filter_item(X, l, SEQ, 8 * it, filt, scr, part + (X.wave * 2 + 0) * HW);
    for (int it = gw; it < CTX / 8; it += NGW) filter_item(X, l, CTX, 8 * it, filt + (size_t)SEQ * HW, scr, part + (X.wave * 2 + 1) * HW);
    __syncthreads();
    for (int i = X.tid; i < 2 * HW; i += NTHR) { float s = 0.f;
#pragma unroll
        for (int w = 0; w < NWAVES; ++w) s += part[w * 2 * HW + i];
        X.ws<float>(WS_FPART)[((size_t)(i / HW) * NPART + X.bid) * HW + (i % HW)] = s; }
    __syncthreads();
}
__device__ __forceinline__ void phase_mod(const Ctx& X) {
    const int lane = X.lane;
    LAS float* red = (LAS float*)X.lds;
    constexpr int NIT = DEPTH * (6 * D / 64);
    for (int it = X.bid; it < NIT; it += X.G) {
        const int ll = it / (6 * D / 64), n0 = (it % (6 * D / 64)) * 64;
        const float* W = X.in(I_WMOD) + (size_t)ll * D * 6 * D; const float* cv = X.in(I_C); const float* cc = X.in(I_CCTX);
        float s0 = 0.f, s1 = 0.f;
#pragma unroll 8
        for (int k = X.wave * (D / 8); k < (X.wave + 1) * (D / 8); ++k) { const float wv = W[(size_t)k * 6 * D + n0 + lane]; const float c0 = cv[k], c1 = cc[k];
            s0 += c0 * sigmoidf_(c0) * wv; s1 += c1 * sigmoidf_(c1) * wv; }
        red[(X.wave * 64 + lane) * 2] = s0; red[(X.wave * 64 + lane) * 2 + 1] = s1;
        __syncthreads();
        if (X.wave == 0) { float t0 = 0.f, t1 = 0.f;
#pragma unroll
            for (int w = 0; w < NWAVES; ++w) { t0 += red[(w * 64 + lane) * 2]; t1 += red[(w * 64 + lane) * 2 + 1]; }
            const float bm = X.in(I_BMOD)[(size_t)ll * 6 * D + n0 + lane];
            float* MOD = X.ws<float>(WS_MOD);
            MOD[((size_t)ll * 2 + 0) * 6 * D + n0 + lane] = t0 + bm; MOD[((size_t)ll * 2 + 1) * 6 * D + n0 + lane] = t1 + bm; }
        __syncthreads();
    }
}
__device__ __forceinline__ const float* modp(const Ctx& X, int l, int t, int j) { return X.ws<float>(WS_MOD) + ((size_t)l * 2 + (t < CTX ? 1 : 0)) * 6 * D + (size_t)j * D; }

__device__ __forceinline__ void phase_x0(const Ctx& X) {
    const int gw = X.bid * NWAVES + X.wave, NGW = X.G * NWAVES, lane = X.lane;
    for (int t = gw; t < M; t += NGW) {
        const float* src = t < CTX ? X.in(I_CTX) + (size_t)t * D : X.in(I_X) + (size_t)(t - CTX) * D;
        const float* sh = modp(X, 0, t, 0); const float* sc = modp(X, 0, t, 1);
        float* xr = X.ws<float>(WS_X) + (size_t)t * D; bf16* xm = X.ws<bf16>(WS_XMOD) + (size_t)t * D;
#pragma unroll
        for (int j = 0; j < D / 256; ++j) { const int d = 4 * lane + 256 * j; const f32x4 v = *(const f32x4*)(src + d), a = *(const f32x4*)(sh + d), b = *(const f32x4*)(sc + d);
            *(f32x4*)(xr + d) = v;
            unsigned w0 = pk2(v[0] * (1.f + b[0]) + a[0], v[1] * (1.f + b[1]) + a[1]), w1 = pk2(v[2] * (1.f + b[2]) + a[2], v[3] * (1.f + b[3]) + a[3]);
            *(unsigned long long*)(xm + d) = (unsigned long long)w0 | ((unsigned long long)w1 << 32); }
    }
}

__device__ __forceinline__ int shift_row(int t, int col, bool& valid) {
    const bool isctx = t < CTX;
    const int i = t - CTX, gx = i & (GRID_W - 1), gy = i / GRID_W, q = col / QTR;
    const int offl = (q == 0) ? -1 : (q == 1) ? 1 : (q == 2) ? -GRID_W : GRID_W;
    const bool vl = (q == 0) ? (gx > 0) : (q == 1) ? (gx < GRID_W - 1) : (q == 2) ? (gy > 0) : (gy < GRID_H - 1);
    const bool first = col < HALFC;
    const int offc = first ? -1 : 1; const bool vc = first ? (t > 0) : (t < CTX - 1);
    valid = isctx ? vc : vl;
    return valid ? t + (isctx ? offc : offl) : t;
}
__device__ __forceinline__ float pm_val(const bf16* P, const float* mu, int t, int col) {
    const float p0 = bf2f(P[(size_t)t * PCP + col]); bool valid; const int nr = shift_row(t, col, valid);
    const float pn = bf2f(P[(size_t)nr * PCP + col]); const float p1 = valid ? pn : 0.f;
    return p0 + (p1 - p0) * mu[col];
}
constexpr int TT = 8;
__device__ __forceinline__ void phase_prep_a(const Ctx& X, int l, int t0) {
    const bf16* P = X.wsv<bf16>(WS_P); const float* mu = X.inv(I_MU) + (size_t)l * RC;
    LAS float* S = (LAS float*)X.lds;
    const int c = X.tid;
    const float* w2 = X.inv(I_W2) + (size_t)l * 2 * 64 * RW; const float* a2 = X.inv(I_A2) + (size_t)l * 2 * 64 * RW; const float* g2 = X.inv(I_G2) + (size_t)l * 128 * RW;
        for (int idx = X.tid; idx < TT * 384; idx += NTHR) { const int tt = idx / 384, j = idx % 384; float v = pm_val(P, mu, t0 + tt, C_LWF + j);
            if (j < 128) v = tanhf(v); else if (j >= 256) v = sigmoidf_(v);
            S[j * TT + tt] = v; }
        __syncthreads();
        if (c < RW) {
            float aw0[TT], aw1[TT], aa0[TT], aa1[TT], ag[TT];
#pragma unroll
            for (int tt = 0; tt < TT; ++tt) { aw0[tt] = 0.f; aw1[tt] = 0.f; aa0[tt] = 0.f; aa1[tt] = 0.f; ag[tt] = 0.f; }
            for (int r = 0; r < 64; ++r) { const float wf = w2[(size_t)r * RW + c], wb = w2[(size_t)(64 + r) * RW + c], af = a2[(size_t)r * RW + c], ab = a2[(size_t)(64 + r) * RW + c];
#pragma unroll
                for (int tt = 0; tt < TT; ++tt) { aw0[tt] += S[r * TT + tt] * wf; aw1[tt] += S[(64 + r) * TT + tt] * wb; aa0[tt] += S[(128 + r) * TT + tt] * af; aa1[tt] += S[(192 + r) * TT + tt] * ab; } }
            for (int j = 0; j < 128; ++j) { const float gv = g2[(size_t)j * RW + c];
#pragma unroll
                for (int tt = 0; tt < TT; ++tt) ag[tt] += S[(256 + j) * TT + tt] * gv; }
            LAS float* AC = S + 384 * TT;
#pragma unroll
            for (int tt = 0; tt < TT; ++tt) { AC[(0 * TT + tt) * RW + c] = aw0[tt]; AC[(1 * TT + tt) * RW + c] = aw1[tt]; AC[(2 * TT + tt) * RW + c] = aa0[tt]; AC[(3 * TT + tt) * RW + c] = aa1[tt]; AC[(4 * TT + tt) * RW + c] = ag[tt]; }
        }
    __syncthreads();
}
__device__ __forceinline__ void phase_prep_b(const Ctx& X, int l, int t0) {
    const bf16* P = X.wsv<bf16>(WS_P); const float* mu = X.inv(I_MU) + (size_t)l * RC;
    LAS float* S = (LAS float*)X.lds;
    const int c = X.tid;
    const float* w2 = X.inv(I_W2) + (size_t)l * 2 * 64 * RW; const float* a2 = X.inv(I_A2) + (size_t)l * 2 * 64 * RW; const float* g2 = X.inv(I_G2) + (size_t)l * 128 * RW;
        CFENCE();
        if (c < RW) {
            const LAS float* AC = S + 384 * TT;
            const float w00 = X.inv(I_W0)[(size_t)(l * 2 + 0) * RW + c], w01 = X.inv(I_W0)[(size_t)(l * 2 + 1) * RW + c];
            const float a00 = X.inv(I_A0)[(size_t)(l * 2 + 0) * RW + c], a01 = X.inv(I_A0)[(size_t)(l * 2 + 1) * RW + c];
            const float kkc = X.inv(I_KK)[(size_t)l * RW + c], kac = X.inv(I_KA)[(size_t)l * RW + c], rkc = X.inv(I_RK)[(size_t)l * RW + c];
            const int vz = vgpr_zero();
#pragma unroll 1
            for (int tt = 0; tt < TT; ++tt) { const int t = t0 + tt + vz;
                const float r = pm_val(P, mu, t, c), k = pm_val(P, mu, t, C_K + c), v = pm_val(P, mu, t, C_V + c);
                const float wd0 = expf(-DECAY_SCALE * sigmoidf_(w00 + AC[(0 * TT + tt) * RW + c])), wd1 = expf(-DECAY_SCALE * sigmoidf_(w01 + AC[(1 * TT + tt) * RW + c]));
                const float ad0 = sigmoidf_(a00 + AC[(2 * TT + tt) * RW + c]), ad1 = sigmoidf_(a01 + AC[(3 * TT + tt) * RW + c]);
                const float kkr = k * kkc; const float n2 = wave_sum(kkr * kkr); const float kk = kkr / fmaxf(sqrtf(n2), 1e-12f);
                const float kd0 = k * (1.f + (ad0 - 1.f) * kac), kd1 = k * (1.f + (ad1 - 1.f) * kac);
                const float bon = wave_sum(r * (kd0 + kd1) * rkc);
                const size_t o = (size_t)t * RW + c, o1 = (size_t)(M + t) * RW + c;
                X.wsv<bf16>(WS_R)[o] = (bf16)f2bf(r); X.wsv<bf16>(WS_V)[o] = (bf16)f2bf(v); X.wsv<bf16>(WS_KA)[o] = (bf16)f2bf(-kk);
                X.wsv<bf16>(WS_KD)[o] = (bf16)f2bf(kd0); X.wsv<bf16>(WS_KD)[o1] = (bf16)f2bf(kd1);
                X.wsv<bf16>(WS_KB)[o] = (bf16)f2bf(kk * ad0); X.wsv<bf16>(WS_KB)[o1] = (bf16)f2bf(kk * ad1);
                X.wsv<float>(WS_W)[o] = wd0; X.wsv<float>(WS_W)[o1] = wd1;
                X.wsv<bf16>(WS_GATE)[o] = (bf16)f2bf(AC[(4 * TT + tt) * RW + c]);
                if (X.lane == 0) X.wsv<float>(WS_BONUS)[(size_t)t * NH + (c >> 6)] = bon; }
        }
        __syncthreads();
}
__device__ __forceinline__ void phase_prep_hyena(const Ctx& X, int l) {
    const bf16* P = X.ws<bf16>(WS_P); const int c = X.tid;
    for (int tile = X.bid; tile < M / TT; tile += X.G) {
        const int t0 = tile * TT;
        if (c < HW) {
            const float* cw = X.in(I_CW) + (size_t)l * 3 * HC; const float* cb = X.in(I_CB) + (size_t)l * HC;
            for (int tt = 0; tt < TT; ++tt) { const int t = t0 + tt; const bool hp = (t != 0 && t != CTX), hn = (t != CTX - 1 && t != M - 1);
                float u[3];
#pragma unroll
                for (int j = 0; j < 3; ++j) { const int hc = j * HW + c, col = C_HY + hc;
                    const float pc = bf2f(P[(size_t)t * PCP + col]), pp = hp ? bf2f(P[(size_t)(t - 1) * PCP + col]) : 0.f, pn = hn ? bf2f(P[(size_t)(t + 1) * PCP + col]) : 0.f;
                    u[j] = pp * cw[hc] + pc * cw[HC + hc] + pn * cw[2 * HC + hc] + cb[hc]; }
                X.ws<float>(WS_Z)[(size_t)t * HW + c] = u[2] * u[1]; X.ws<bf16>(WS_X0)[(size_t)t * HW + c] = (bf16)f2bf(u[0]); }
        }
    }
}

constexpr int SCH = 32;
constexpr int SC_STEP = 5 * 64 + 32;
constexpr int N_SCAN_UNITS = 2 * NH * 2;
__device__ __forceinline__ int scan_row(int d, int s) { return d == 0 ? s : (s < CTX ? CTX - 1 - s : M - 1 - (s - CTX)); }
__device__ __forceinline__ void scan_unit(const Ctx& X, int su) {
    const int d = su / (NH * 2), h = (su / 2) % NH, half = su & 1;
    LAS float* buf = (LAS float*)X.lds;
    LAS float* ybuf = buf + 2 * SCH * SC_STEP;
    const int vrow = X.wave * 4 + (X.lane >> 4), kq = (X.lane & 15) * 4;
    const int e = X.tid, which = e >> 6; const bool loader = e < SC_STEP, isf32 = which == 0;
    const char* src; {
        const size_t od = (size_t)d * M * RW + h * 64 + (e & 63), o = (size_t)h * 64 + (e & 63);
        if (which == 0) src = (const char*)(X.ws<float>(WS_W) + od);
        else if (which == 1) src = (const char*)(X.ws<bf16>(WS_KB) + od);
        else if (which == 2) src = (const char*)(X.ws<bf16>(WS_KD) + od);
        else if (which == 3) src = (const char*)(X.ws<bf16>(WS_KA) + o);
        else if (which == 4) src = (const char*)(X.ws<bf16>(WS_R) + o);
        else src = (const char*)(X.ws<bf16>(WS_V) + (size_t)h * 64 + half * 32 + (e - 320)); }
    const long esz = isf32 ? 4 : 2;
    float pre[SCH];
#define SCAN_LOAD(g_) do { if (loader) { const int s0_ = (g_) * SCH; const int row0_ = scan_row(d, s0_); const long st_ = (d == 0 ? (long)RW : -(long)RW) * esz; const char* p_ = src + (long)row0_ * RW * esz; \
        if (isf32) { _Pragma("unroll") for (int j = 0; j < SCH; ++j) pre[j] = *(const float*)(p_ + j * st_); } \
        else { _Pragma("unroll") for (int j = 0; j < SCH; ++j) pre[j] = bf2f(*(const bf16*)(p_ + j * st_)); } } } while (0)
#define SCAN_STORE(pb_) do { if (loader) { _Pragma("unroll") for (int j = 0; j < SCH; ++j) buf[((pb_) * SCH + j) * SC_STEP + e] = pre[j]; } } while (0)
    SCAN_LOAD(0); SCAN_STORE(0);
    __syncthreads();
    float S0 = 0.f, S1 = 0.f, S2 = 0.f, S3 = 0.f;
    float* Y = X.ws<float>(WS_Y) + (size_t)d * M * RW;
    constexpr int NCH = M / SCH;
    for (int g = 0; g < NCH; ++g) {
        const int pb = g & 1;
        if (g + 1 < NCH) SCAN_LOAD(g + 1);
        const LAS float* B = buf + pb * SCH * SC_STEP; LAS float* yb = ybuf + pb * SCH * 32;
#pragma unroll 4
        for (int s = 0; s < SCH; ++s) { const LAS float* q = B + s * SC_STEP;
            const f32x4 w4 = *(const LAS f32x4*)(q + kq), kb4 = *(const LAS f32x4*)(q + 64 + kq), kd4 = *(const LAS f32x4*)(q + 128 + kq), ka4 = *(const LAS f32x4*)(q + 192 + kq), r4 = *(const LAS f32x4*)(q + 256 + kq);
            const float vv = q[320 + vrow];
            const float sa = row16_sum(S0 * ka4[0] + S1 * ka4[1] + S2 * ka4[2] + S3 * ka4[3]);
            S0 = S0 * w4[0] + sa * kb4[0] + vv * kd4[0]; S1 = S1 * w4[1] + sa * kb4[1] + vv * kd4[1]; S2 = S2 * w4[2] + sa * kb4[2] + vv * kd4[2]; S3 = S3 * w4[3] + sa * kb4[3] + vv * kd4[3];
            const float y = row16_sum(S0 * r4[0] + S1 * r4[1] + S2 * r4[2] + S3 * r4[3]);
            if ((X.lane & 15) == 0) yb[s * 32 + vrow] = y; }
        if (g + 1 < NCH) SCAN_STORE(pb ^ 1);
        __syncthreads();
        for (int i = X.tid; i < SCH * 32; i += NTHR) { const int s = i >> 5, v = i & 31; Y[(size_t)scan_row(d, g * SCH + s) * RW + h * 64 + half * 32 + v] = yb[i]; }
    }
    __syncthreads();
#undef SCAN_LOAD
#undef SCAN_STORE
}
constexpr int CR = 16;
__device__ __forceinline__ void conv_item(const Ctx& X, int item) {
    constexpr int NCG = HW / 64, NLAT = NCG * (SEQ / CR);
    const bool isctx = item >= NLAT; const int it2 = isctx ? item - NLAT : item;
    const int cg = it2 % NCG, ob = it2 / NCG, n = isctx ? CTX : SEQ, rowbase = isctx ? 0 : CTX, i0 = CR * ob, c = cg * 64 + X.lane;
    const float* F = X.ws<float>(WS_FILT) + (isctx ? (size_t)SEQ * HW : 0) + c; const float* Z = X.ws<float>(WS_Z) + (size_t)rowbase * HW + c;
    const float* fp = X.ws<float>(WS_FPART) + (size_t)(isctx ? 1 : 0) * NPART * HW + c;
    float nsum = 0.f; for (int b = 0; b < NPART; ++b) nsum += fp[(size_t)b * HW];
    float acc[CR], Q[CR];
#pragma unroll
    for (int r = 0; r < CR; ++r) acc[r] = 0.f;
    int jb = i0 - n / 2; if (jb < 0) jb = 0;
    int jend = i0 + n / 2 + CR; if (jend > n) jend = n;
    int Tb = i0 - jb + n / 2;
#pragma unroll
    for (int x = 1; x < CR; ++x) { const int T = Tb + x; Q[x] = (T >= 0 && T < n) ? F[(size_t)T * HW] : 0.f; }
    Q[0] = 0.f;
    for (; jb < jend; jb += CR, Tb -= CR) {
#pragma unroll
        for (int s = 0; s < CR; ++s) { const int T = Tb - s, j = jb + s;
            if ((s & 3) == 0) CFENCE();
            Q[(CR - s) & (CR - 1)] = (T >= 0 && T < n) ? F[(size_t)T * HW] : 0.f;
            const float zj = (j < n) ? Z[(size_t)j * HW] : 0.f;
#pragma unroll
            for (int r = 0; r < CR; ++r) acc[r] += Q[(r - s + CR) & (CR - 1)] * zj; }
    }
    const float inv = 1.0f / nsum; float* O = X.ws<float>(WS_CONV) + (size_t)rowbase * HW + c;
#pragma unroll
    for (int r = 0; r < CR; ++r) O[(size_t)(i0 + r) * HW] = acc[r] * inv;
}
__device__ __forceinline__ void phase_scanconv(const Ctx& X, int l) {
#ifndef NO_SCAN
    for (int su = X.bid; su < N_SCAN_UNITS; su += X.G) scan_unit(X, su);
#endif
#ifdef NO_CONV
    return;
#endif
    constexpr int NITEMS = (HW / 64) * (SEQ / CR) + (HW / 64) * (CTX / CR);
    unsigned* q = X.ctl() + CW_Q + l * 64;
    for (;;) { int item = 0; if (X.lane == 0) item = (int)atomicAdd(q, 1u); item = __shfl(item, 0); if (item >= NITEMS) break; conv_item(X, item); }
}

__device__ __forceinline__ void phase_finish(const Ctx& X, int l) {
    const int c = X.tid;
    const float* lg = X.in(I_LNXG) + (size_t)l * RW; const float* lb = X.in(I_LNXB) + (size_t)l * RW; const float* hb = X.in(I_HBIAS) + (size_t)l * HW;
    for (int t = X.bid; t < M; t += X.G) {
        if (c < RW) { const size_t o = (size_t)t * RW + c;
            const float y = X.ws<float>(WS_Y)[o] + X.ws<float>(WS_Y)[(size_t)M * RW + o];
            const float mean = wave_sum(y) * (1.f / 64.f); const float dy = y - mean; const float var = wave_sum(dy * dy) * (1.f / 64.f);
            float yn = dy / sqrtf(var + GN_EPS) * lg[c] + lb[c];
            yn += X.ws<float>(WS_BONUS)[(size_t)t * NH + (c >> 6)] * bf2f(X.ws<bf16>(WS_V)[o]);
            yn *= bf2f(X.ws<bf16>(WS_GATE)[o]);
            X.ws<bf16>(WS_RO)[o] = (bf16)f2bf(yn); }
        if (c < HW) { const size_t o = (size_t)t * HW + c;
            const float ho = (X.ws<float>(WS_CONV)[o] + X.ws<float>(WS_Z)[o] * hb[c]) * bf2f(X.ws<bf16>(WS_X0)[o]);
            X.ws<bf16>(WS_HO)[o] = (bf16)f2bf(ho); }
    }
}

__device__ __forceinline__ void ln_inplace(float (&v)[D / 64], const float* g, const float* b, int lane) {
    float s = 0.f;
#pragma unroll
    for (int j = 0; j < D / 64; ++j) s += v[j];
    const float mean = wave_sum(s) * (1.f / D); float q = 0.f;
#pragma unroll
    for (int j = 0; j < D / 64; ++j) { v[j] -= mean; q += v[j] * v[j]; }
    const float rstd = 1.0f / sqrtf(wave_sum(q) * (1.f / D) + LN_EPS);
#pragma unroll
    for (int j = 0; j < D / 64; ++j) { const int d = 4 * lane + 256 * (j >> 2) + (j & 3); v[j] = v[j] * rstd * g[d] + b[d]; }
}
__device__ __forceinline__ void phase_norm1(const Ctx& X, int l) {
    const int gw = X.bid * NWAVES + X.wave, NGW = X.G * NWAVES, lane = X.lane;
    const float* lng = X.in(I_LNG) + (size_t)(l * 2 + 0) * D; const float* lnb = X.in(I_LNB) + (size_t)(l * 2 + 0) * D;
    const float* wr = X.in(I_WR); const float* rb = X.in(I_RB);
    const float alpha = sqrtf(sqrtf(2.0f * DEPTH));
    for (int t = gw; t < M; t += NGW) {
        float* xr = X.ws<float>(WS_X) + (size_t)t * D; const float* mx = X.ws<float>(WS_MIX) + (size_t)t * D;
        const float* gate = modp(X, l, t, 2); const float* sh = modp(X, l, t, 3); const float* sc = modp(X, l, t, 4);
        float v[D / 64];
#pragma unroll
        for (int j = 0; j < D / 256; ++j) { const int d = 4 * lane + 256 * j; const f32x4 a = *(const f32x4*)(xr + d), m = *(const f32x4*)(mx + d), gt = *(const f32x4*)(gate + d);
#pragma unroll
            for (int i = 0; i < 4; ++i) v[4 * j + i] = alpha * a[i] + gt[i] * m[i]; }
        ln_inplace(v, lng, lnb, lane);
        bf16* hf = X.ws<bf16>(WS_XMOD) + (size_t)t * D;
        LAS float* hrow = (LAS float*)X.lds + X.wave * D;
#pragma unroll
        for (int j = 0; j < D / 256; ++j) { const int d = 4 * lane + 256 * j; f32x4 o; const f32x4 a = *(const f32x4*)(sh + d), b = *(const f32x4*)(sc + d); f32x4 h;
#pragma unroll
            for (int i = 0; i < 4; ++i) { o[i] = v[4 * j + i]; h[i] = o[i] * (1.f + b[i]) + a[i]; }
            *(f32x4*)(xr + d) = o; *(LAS f32x4*)(hrow + d) = h;
            *(unsigned long long*)(hf + d) = (unsigned long long)pk2(h[0], h[1]) | ((unsigned long long)pk2(h[2], h[3]) << 32); }
        WAVE_LDS_FENCE(); CFENCE();
        float part = 0.f; { const int e = lane & 15, q = lane >> 4;
#pragma unroll 8
            for (int d = q * (D / 4); d < (q + 1) * (D / 4); ++d) part += hrow[d] * wr[(size_t)d * NE + e]; }
        part += __shfl_xor(part, 16); part += __shfl_xor(part, 32);
        WAVE_LDS_FENCE(); CFENCE();
        float lg[NE];
#pragma unroll
        for (int e = 0; e < NE; ++e) lg[e] = __shfl(part, e);
        float mxl = lg[0];
#pragma unroll
        for (int e = 1; e < NE; ++e) mxl = fmaxf(mxl, lg[e]);
        float sc_[NE], sum = 0.f;
#pragma unroll
        for (int e = 0; e < NE; ++e) { sc_[e] = expf(lg[e] - mxl); sum += sc_[e]; }
        const float isum = 1.0f / sum; float sel[NE];
#pragma unroll
        for (int e = 0; e < NE; ++e) { sc_[e] *= isum; sel[e] = sc_[e] + rb[e]; }
        int bg = 0; float bgs = -INFINITY;
#pragma unroll
        for (int g = 0; g < 4; ++g) { float m1 = -INFINITY, m2 = -INFINITY;
#pragma unroll
            for (int i = 0; i < 4; ++i) { const float x = sel[4 * g + i]; if (x > m1) { m2 = m1; m1 = x; } else if (x > m2) m2 = x; }
            const float gs = m1 + m2; if (gs > bgs) { bgs = gs; bg = g; } }
        int i0 = 0, i1 = 0; float s0 = -INFINITY, s1 = -INFINITY, p0 = 0.f, p1 = 0.f;
#pragma unroll
        for (int e = 0; e < NE; ++e) { if ((e >> 2) == bg) { const float x = sel[e]; if (x > s0) { s1 = s0; i1 = i0; p1 = p0; s0 = x; i0 = e; p0 = sc_[e]; } else if (x > s1) { s1 = x; i1 = e; p1 = sc_[e]; } } }
        if (lane == 0) { int* ei = X.ws<int>(WS_ROUT) + (size_t)t * 2; float* ew = (float*)(X.ws<int>(WS_ROUT) + (size_t)M * 2) + (size_t)t * 2;
            ei[0] = i0; ei[1] = i1; const float ws_ = 1.0f / (p0 + p1); ew[0] = p0 * ws_; ew[1] = p1 * ws_;
            atomicAdd(X.ctl() + CW_CNT + l * 64 + i0, 1u); atomicAdd(X.ctl() + CW_CNT + l * 64 + i1, 1u); }
    }
}

__device__ __forceinline__ void moe_table(const Ctx& X, int l, int NT) {
    volatile LAS int* tab = (volatile LAS int*)(X.lds + LDS_MISC) + 8;
    if (X.tid == 0) { int cum = 0, ts = 0;
        for (int e = 0; e < NE; ++e) { const int cnt = (int)__hip_atomic_load(X.ctl() + CW_CNT + l * 64 + e, RLX_AGENT); const int tc = (cnt + 255) / 256;
            tab[e] = cum; tab[32 + e] = ts; tab[64 + e] = tc; cum += tc * NT; ts += tc; }
        tab[16] = cum; }
    __syncthreads();
}
__device__ __forceinline__ void phase_scatter(const Ctx& X, int l) {
    moe_table(X, l, 1);
    volatile LAS int* tab = (volatile LAS int*)(X.lds + LDS_MISC) + 8;
    const int gw = X.bid * NWAVES + X.wave, NGW = X.G * NWAVES, lane = X.lane;
    const int* ei = X.ws<int>(WS_ROUT); int* slot = X.ws<int>(WS_ROUT) + (size_t)M * 4;
    for (int s = gw; s < 2 * M; s += NGW) { const int t = s >> 1; const int e = ei[s];
        int pos = 0; if (lane == 0) pos = tab[32 + e] * 256 + (int)atomicAdd(X.ctl() + CW_CUR + l * 64 + e, 1u);
        pos = __shfl(pos, 0);
        if (lane == 0) slot[s] = pos;
        const u32x4* src = (const u32x4*)(X.ws<bf16>(WS_XMOD) + (size_t)t * D); u32x4* dst = (u32x4*)(X.ws<bf16>(WS_XG) + (size_t)pos * D);
        for (int i = lane; i < D / 8; i += 64) dst[i] = src[i]; }
}

__device__ __forceinline__ void phase_combine(const Ctx& X, int l) {
    const int gw = X.bid * NWAVES + X.wave, NGW = X.G * NWAVES, lane = X.lane;
    const float* lng = X.in(I_LNG) + (size_t)(l * 2 + 1) * D; const float* lnb = X.in(I_LNB) + (size_t)(l * 2 + 1) * D;
    const float alpha = sqrtf(sqrtf(2.0f * DEPTH));
    const float* ew = (const float*)(X.ws<int>(WS_ROUT) + (size_t)M * 2); const int* slot = X.ws<int>(WS_ROUT) + (size_t)M * 4;
    for (int t = gw; t < M; t += NGW) {
        float* xr = X.ws<float>(WS_X) + (size_t)t * D; const float* gate = modp(X, l, t, 5);
        const bf16* y0 = X.ws<bf16>(WS_YS) + (size_t)slot[2 * t] * D; const bf16* y1 = X.ws<bf16>(WS_YS) + (size_t)slot[2 * t + 1] * D; const float w0 = ew[2 * t], w1 = ew[2 * t + 1];
        float v[D / 64];
#pragma unroll
        for (int j = 0; j < D / 256; ++j) { const int d = 4 * lane + 256 * j; const f32x4 a = *(const f32x4*)(xr + d), gt = *(const f32x4*)(gate + d);
            const unsigned long long q0 = *(const unsigned long long*)(y0 + d), q1 = *(const unsigned long long*)(y1 + d);
            float ya[4] = {bflo((unsigned)q0), bfhi((unsigned)q0), bflo((unsigned)(q0 >> 32)), bfhi((unsigned)(q0 >> 32))};
            float yb[4] = {bflo((unsigned)q1), bfhi((unsigned)q1), bflo((unsigned)(q1 >> 32)), bfhi((unsigned)(q1 >> 32))};
#pragma unroll
            for (int i = 0; i < 4; ++i) v[4 * j + i] = alpha * a[i] + gt[i] * (w0 * ya[i] + w1 * yb[i]); }
        ln_inplace(v, lng, lnb, lane);
        if (l + 1 < DEPTH) { const float* sh = modp(X, l + 1, t, 0); const float* sc = modp(X, l + 1, t, 1); bf16* xm = X.ws<bf16>(WS_XMOD) + (size_t)t * D;
#pragma unroll
            for (int j = 0; j < D / 256; ++j) { const int d = 4 * lane + 256 * j; f32x4 o; const f32x4 a = *(const f32x4*)(sh + d), b = *(const f32x4*)(sc + d); float h[4];
#pragma unroll
                for (int i = 0; i < 4; ++i) { o[i] = v[4 * j + i]; h[i] = o[i] * (1.f + b[i]) + a[i]; }
                *(f32x4*)(xr + d) = o;
                *(unsigned long long*)(xm + d) = (unsigned long long)pk2(h[0], h[1]) | ((unsigned long long)pk2(h[2], h[3]) << 32); }
        } else if (t >= CTX) { float* orow = X.out() + (size_t)(t - CTX) * D; const bool bad = __hip_atomic_load(X.ctl() + CW_BAR + XB_TMO, RLX_AGENT) != 0u;
#pragma unroll
            for (int j = 0; j < D / 256; ++j) { const int d = 4 * lane + 256 * j; f32x4 o;
#pragma unroll
                for (int i = 0; i < 4; ++i) o[i] = bad ? __builtin_nanf("") : v[4 * j + i];
                *(f32x4*)(orow + d) = o; }
        }
    }
}


#ifdef EMU
#define PHASE_FN static
#define THIN_FN static
#else
#define PHASE_FN __device__ __forceinline__
#define THIN_FN __device__ __noinline__
#endif
THIN_FN void ph_transposes(Ctx X, int l) { phase_transposes(X, l); }
THIN_FN void ph_filters(Ctx X, int l) { phase_filters(X, l); }
THIN_FN void ph_mod(Ctx X) { phase_mod(X); }
THIN_FN void ph_x0(Ctx X) { phase_x0(X); }
THIN_FN void ph_prep_a(Ctx X, int l, int t0) { phase_prep_a(X, l, t0); }
THIN_FN void ph_prep_b(Ctx X, int l, int t0) { phase_prep_b(X, l, t0); }
THIN_FN void ph_prep_hyena(Ctx X, int l) { phase_prep_hyena(X, l); }
THIN_FN void ph_scanconv(Ctx X, int l) { phase_scanconv(X, l); }
THIN_FN void ph_finish(Ctx X, int l) { phase_finish(X, l); }
THIN_FN void ph_norm1(Ctx X, int l) { phase_norm1(X, l); }
THIN_FN void ph_scatter(Ctx X, int l) { phase_scatter(X, l); }
THIN_FN void ph_combine(Ctx X, int l) { phase_combine(X, l); }
PHASE_FN void ph_g1(Ctx X) { pg8::Gemm g{X.ws<bf16>(WS_XMOD), X.ws<bf16>(WS_WIN), D}; pg8::StaticOrder S; S.init(M, PCP, X.G, X.bid); pg8::EpiBf16 E{X.ws<bf16>(WS_P), PCP}; pg8::gemm_phase(X.lds, g, S, E); }
PHASE_FN void ph_g2a(Ctx X) { pg8::Gemm g{X.ws<bf16>(WS_RO), X.ws<bf16>(WS_WB), RW}; pg8::StaticOrder S; S.init(M, D, X.G, X.bid); pg8::EpiGate<false> E{X.ws<bf16>(WS_T), D, X.ws<bf16>(WS_P), PCP, C_GR}; pg8::gemm_phase(X.lds, g, S, E); }
PHASE_FN void ph_g2b(Ctx X) { pg8::Gemm g{X.ws<bf16>(WS_HO), X.ws<bf16>(WS_WB) + (size_t)D * RW, HW}; pg8::StaticOrder S; S.init(M, D, X.G, X.bid); pg8::EpiGate<true> E{X.ws<bf16>(WS_T), D, X.ws<bf16>(WS_P), PCP, C_GH}; pg8::gemm_phase(X.lds, g, S, E); }
PHASE_FN void ph_g3(Ctx X) { pg8::Gemm g{X.ws<bf16>(WS_T), X.ws<bf16>(WS_WO), D}; pg8::StaticOrder S; S.init(M, D, X.G, X.bid); pg8::EpiF32 E{X.ws<float>(WS_MIX), D}; pg8::gemm_phase(X.lds, g, S, E); }
PHASE_FN void ph_g4(Ctx X, int l) { moe_table(X, l, 2 * D / 256); pg8::MoeOrder S{(const volatile LAS int*)(X.lds + LDS_MISC) + 8, 2 * D / 256, X.G, X.bid};
    pg8::Gemm g{X.ws<bf16>(WS_XG), X.ws<bf16>(WS_WGU), D}; pg8::EpiSwiglu E{X.ws<bf16>(WS_ACT), D, 2 * D / 256}; pg8::gemm_phase(X.lds, g, S, E); }
PHASE_FN void ph_g5(Ctx X, int l) { moe_table(X, l, D / 256); pg8::MoeOrder S{(const volatile LAS int*)(X.lds + LDS_MISC) + 8, D / 256, X.G, X.bid};
    pg8::Gemm g{X.ws<bf16>(WS_ACT), X.ws<bf16>(WS_WD), D}; pg8::EpiMoeDown E{X.ws<bf16>(WS_YS), D, D / 256}; pg8::gemm_phase(X.lds, g, S, E); }

constexpr int NPH = 14, NPHASES = DEPTH * NPH;
template <int MASK> __global__ void __launch_bounds__(NTHR, 2) fwd_kernel(Args args) {
    DYN_LDS(lds);
    Ctx X; X.lds = lds; X.tid = threadIdx.x; X.lane = X.tid & 63; X.wave = READFIRSTLANE(X.tid >> 6); X.G = gridDim.x; X.bid = blockIdx.x;
    volatile LAS unsigned* misc = (volatile LAS unsigned*)(lds + LDS_MISC);
    if (X.tid < 128) misc[X.tid] = 0u;
    if (X.tid < N_IN + 2) { const unsigned long long p = X.tid < N_IN ? (unsigned long long)args.in[X.tid < N_IN ? X.tid : 0] : (X.tid == N_IN ? (unsigned long long)args.out : (unsigned long long)args.ws);
        misc[PT_WORD0 + 2 * X.tid] = (unsigned)p; misc[PT_WORD0 + 2 * X.tid + 1] = (unsigned)(p >> 32); }
    __syncthreads();
    XcdBarrier bar = xcd_barrier_post(X.ctl() + CW_BAR, misc);
    const int lo = args.ph_lo, hi = args.ph_hi;
#define IN(k) ((((MASK) >> ((k) % NPH)) & 1) && lo <= (k) && (k) < hi)
#define SEAM(k) do { if ((k) + 1 < hi) xcd_barrier(bar); } while (0)
    for (int l = 0; l < DEPTH; ++l) {
        const int pb = l * NPH;
        if (IN(pb + 0)) { ph_transposes(X, l); __syncthreads(); ph_filters(X, l); if (l == 0) ph_mod(X); SEAM(pb + 0); }
        if (l == 0 && IN(pb + 1)) { ph_x0(X); SEAM(pb + 1); }
        if (IN(pb + 2)) { ph_g1(X); SEAM(pb + 2); }
        if (IN(pb + 3)) { for (int tile = X.bid; tile < M / TT; tile += X.G) { ph_prep_a(X, l, tile * TT); ph_prep_b(X, l, tile * TT); } ph_prep_hyena(X, l); SEAM(pb + 3); }
        if (IN(pb + 4)) { ph_scanconv(X, l); SEAM(pb + 4); }
        if (IN(pb + 5)) { ph_finish(X, l); SEAM(pb + 5); }
        if (IN(pb + 6)) { ph_g2a(X); SEAM(pb + 6); }
        if (IN(pb + 7)) { ph_g2b(X); SEAM(pb + 7); }
        if (IN(pb + 8)) { ph_g3(X); SEAM(pb + 8); }
        if (IN(pb + 9)) { ph_norm1(X, l); SEAM(pb + 9); }
        if (IN(pb + 10)) { ph_scatter(X, l); SEAM(pb + 10); }
        if (IN(pb + 11)) { ph_g4(X, l); SEAM(pb + 11); }
        if (IN(pb + 12)) { ph_g5(X, l); SEAM(pb + 12); }
        if (IN(pb + 13)) { ph_combine(X, l); SEAM(pb + 13); }
    }
#undef IN
#undef SEAM
}

#ifndef N_LAUNCHES
#define N_LAUNCHES 1
#endif
#ifndef PH_MASK
#define PH_MASK 0x3fff
#endif
template <int MASK> static void launch_mask(int grid, hipStream_t stream, const Args& a) {
    static bool attr = false;
    if (!attr) { (void)hipFuncSetAttribute((const void*)fwd_kernel<MASK>, hipFuncAttributeMaxDynamicSharedMemorySize, LDS_BYTES); attr = true; }
    hipLaunchKernelGGL(fwd_kernel<MASK>, dim3(grid), dim3(NTHR), LDS_BYTES, stream, a);
}
extern "C" void kernel_launch(void* const* d_in, const int* in_sizes, int n_in, void* d_out, int out_size, void* d_ws, size_t ws_size, hipStream_t stream) {
    static int grid = 0;
    if (grid == 0) {
        if (n_in != N_IN || ws_size < WS_END) { fprintf(stderr, "kernel_launch: unexpected n_in %d or workspace %zu < %zu\n", n_in, ws_size, (size_t)WS_END); grid = -1; return; }
        int dev = 0, cus = 0;
        if (hipGetDevice(&dev) != hipSuccess || hipDeviceGetAttribute(&cus, hipDeviceAttributeMultiprocessorCount, dev) != hipSuccess) { grid = -1; return; }
        (void)hipGetLastError();
        grid = cus; if (grid > NPART) grid = NPART;
    }
    if (grid < 0) return;
    (void)in_sizes; (void)out_size;
    (void)hipMemsetAsync(d_ws, 0, CTL_BYTES, stream);
    Args a;
    for (int i = 0; i < N_IN; ++i) a.in[i] = (const float*)d_in[i];
    a.out = (float*)d_out; a.ws = (unsigned char*)d_ws;
#if N_LAUNCHES == 1
    a.ph_lo = 0; a.ph_hi = NPHASES;
    launch_mask<PH_MASK>(grid, stream, a);
#else
    for (int ph = 0; ph < NPHASES; ++ph) { const int k = ph % NPH; if (k == 1 && ph / NPH != 0) continue; a.ph_lo = ph; a.ph_hi = ph + 1;
        switch (k) {
            case 0: launch_mask<1 << 0>(grid, stream, a); break; case 1: launch_mask<1 << 1>(grid, stream, a); break; case 2: launch_mask<1 << 2>(grid, stream, a); break;
            case 3: launch_mask<1 << 3>(grid, stream, a); break; case 4: launch_mask<1 << 4>(grid, stream, a); break; case 5: launch_mask<1 << 5>(grid, stream, a); break;
            case 6: launch_mask<1 << 6>(grid, stream, a); break; case 7: launch_mask<1 << 7>(grid, stream, a); break; case 8: launch_mask<1 << 8>(grid, stream, a); break;
            case 9: launch_mask<1 << 9>(grid, stream, a); break; case 10: launch_mask<1 << 10>(grid, stream, a); break; case 11: launch_mask<1 << 11>(grid, stream, a); break;
            case 12: launch_mask<1 << 12>(grid, stream, a); break; default: launch_mask<1 << 13>(grid, stream, a); break; } }
#endif
}
```

```cpp
#ifndef EMU
#include <hip/hip_runtime.h>
#endif
#include <cstdio>
#include <cstdint>
#include <cmath>

#ifndef CFG_D
#define CFG_D 1024
#define CFG_SEQ 16384
#define CFG_CTX 256
#define CFG_DEPTH 4
#endif
constexpr int D = CFG_D, SEQ = CFG_SEQ, CTX = CFG_CTX, DEPTH = CFG_DEPTH, M = CTX + SEQ;
constexpr int GRID_W = 64, GRID_H = SEQ / GRID_W;
constexpr int RW = D / 2, NH = RW / 64, HW = D / 2, RC = 3 * RW + 384, HC = 3 * HW, GC = 2 * D, PC = RC + HC + GC, PCP = (PC + 255) / 256 * 256;
constexpr int QTR = RC / 4, HALFC = RC / 2;
constexpr int C_K = RW, C_V = 2 * RW, C_LWF = 3 * RW, C_LG = 3 * RW + 256;
constexpr int C_HY = RC, C_GR = RC + HC, C_GH = RC + HC + D;
constexpr int NE = 16, SP_TILES = (2 * M) / 256 + NE, SP = SP_TILES * 256;
constexpr float DECAY_SCALE = 0.606531f, GN_EPS = 6.4e-4f, LN_EPS = 1e-5f;
constexpr int NPART = 256;
static_assert(CTX % 32 == 0 && M % 256 == 0 && D % 256 == 0 && RW % 128 == 0 && RW >= 256 && SEQ % 64 == 0 && CTX % 32 == 0 && RC % 4 == 0, "shape assumptions");

enum { I_X = 0, I_C, I_CTX, I_CCTX, I_WMOD, I_BMOD, I_WIN, I_MU, I_W0, I_W2, I_A0, I_A2, I_G2, I_KK, I_KA, I_RK, I_LNXG, I_LNXB, I_CW, I_CB,
       I_FW1, I_FB1, I_FW2, I_FB2, I_FW3, I_FB3, I_FWO, I_FREQ, I_HBIAS, I_WBR, I_WOUT, I_LNG, I_LNB, I_WR, I_RB, I_WG, I_WU, I_WD, N_IN };

constexpr size_t al256(size_t x) { return (x + 255) & ~(size_t)255; }
constexpr size_t CTL_BYTES = 1u << 20;
constexpr size_t WS_MOD = CTL_BYTES;
constexpr size_t WS_FPART = al256(WS_MOD + (size_t)DEPTH * 2 * 6 * D * 4);
constexpr size_t WS_ROUT = al256(WS_FPART + (size_t)2 * NPART * HW * 4);
constexpr size_t WS_BONUS = al256(WS_ROUT + (size_t)M * 2 * 4 * 3);
constexpr size_t WS_WIN = al256(WS_BONUS + (size_t)M * NH * 4);
constexpr size_t WS_WB = al256(WS_WIN + (size_t)PCP * D * 2);
constexpr size_t WS_WO = al256(WS_WB + (size_t)2 * D * RW * 2);
constexpr size_t WS_WGU = al256(WS_WO + (size_t)D * D * 2);
constexpr size_t WS_WD = al256(WS_WGU + (size_t)NE * 2 * D * D * 2);
constexpr size_t WS_X = al256(WS_WD + (size_t)NE * D * D * 2);
constexpr size_t WS_XMOD = al256(WS_X + (size_t)M * D * 4);
constexpr size_t WS_P = al256(WS_XMOD + (size_t)M * D * 2);
constexpr size_t WS_FILT = al256(WS_P + (size_t)M * PCP * 2);
constexpr size_t WS_MIX = al256(WS_FILT + (size_t)M * HW * 4);
constexpr size_t WS_T = al256(WS_MIX + (size_t)M * D * 4);
constexpr size_t WS_S = al256(WS_T + (size_t)M * D * 2);
constexpr size_t WS_R = WS_S;
constexpr size_t WS_V = al256(WS_R + (size_t)M * RW * 2);
constexpr size_t WS_KA = al256(WS_V + (size_t)M * RW * 2);
constexpr size_t WS_KD = al256(WS_KA + (size_t)M * RW * 2);
constexpr size_t WS_KB = al256(WS_KD + (size_t)2 * M * RW * 2);
constexpr size_t WS_W = al256(WS_KB + (size_t)2 * M * RW * 2);
constexpr size_t WS_Y = al256(WS_W + (size_t)2 * M * RW * 4);
constexpr size_t WS_Z = al256(WS_Y + (size_t)2 * M * RW * 4);
constexpr size_t WS_X0 = al256(WS_Z + (size_t)M * HW * 4);
constexpr size_t WS_CONV = al256(WS_X0 + (size_t)M * HW * 2);
constexpr size_t WS_GATE = al256(WS_CONV + (size_t)M * HW * 4);
constexpr size_t WS_RO = al256(WS_GATE + (size_t)M * RW * 2);
constexpr size_t WS_HO = al256(WS_RO + (size_t)M * RW * 2);
constexpr size_t WS_HS = al256(WS_HO + (size_t)M * HW * 2);
constexpr size_t WS_ZT = al256(WS_HS + (size_t)HW * (SEQ + 1) * 8);
constexpr size_t WS_CVT = al256(WS_ZT + (size_t)HW * M * 4);
constexpr size_t WS_END1 = al256(WS_CVT + (size_t)HW * M * 4);
constexpr size_t WS_XG = WS_S;
constexpr size_t WS_ACT = al256(WS_XG + (size_t)SP * D * 2);
constexpr size_t WS_YS = al256(WS_ACT + (size_t)SP * D * 2);
constexpr size_t WS_END2 = al256(WS_YS + (size_t)SP * D * 2);
constexpr size_t WS_END = WS_END1 > WS_END2 ? WS_END1 : WS_END2;
constexpr int CW_TMO = 0, CW_BAR = 4096, CW_CNT = 8192  , CW_CUR = 8192 + 1024  , CW_Q = 8192 + 2048  ;

#ifdef EMU
#define LAS
typedef short bf16x8 __attribute__((vector_size(16)));
typedef float f32x4 __attribute__((vector_size(16)));
typedef unsigned u32x4 __attribute__((vector_size(16)));
#define DYN_LDS(name) unsigned char* name = emu_cur_lds()
#define ASM_WAIT_V(n) do {} while (0)
#define ASM_WAIT_L(n) do {} while (0)
#define ASM_WAIT_VL0() do {} while (0)
#define CFENCE() do {} while (0)
#define WAVE_LDS_FENCE() emu_wave_sync()
#define S_BARRIER() emu_block_sync()
#define SCHED_BARRIER() do {} while (0)
#define SETPRIO(x) do {} while (0)
#define S_SLEEP(n) emu_yield()
#define MFMA16(a, b, c) emu_mfma_16x16x32(a, b, c)
#define GLDS16(gptr, lptr) emu_glds16((const void*)(gptr), (void*)(lptr))
#define READFIRSTLANE(x) (x)
#define XCC_ID_() (blockIdx.x & 7u)
#define FENCE_RELEASE() do {} while (0)
#define FENCE_ACQUIRE() do {} while (0)
#define DPP_F(v, ctrl) emu_dpp_f(v, ctrl)
static inline int vgpr_zero() { return 0; }
static inline unsigned fbits(float f) { unsigned u; memcpy(&u, &f, 4); return u; }
static inline float bitsf(unsigned u) { float f; memcpy(&f, &u, 4); return f; }
#else
#define LAS __attribute__((address_space(3)))
typedef short bf16x8 __attribute__((ext_vector_type(8)));
typedef float f32x4 __attribute__((ext_vector_type(4)));
typedef unsigned u32x4 __attribute__((ext_vector_type(4)));
#define DYN_LDS(name) extern __shared__ __attribute__((aligned(16))) unsigned char name##_raw[]; LAS unsigned char* name = (LAS unsigned char*)name##_raw
#define ASM_WAIT_V(n) asm volatile("s_waitcnt vmcnt(" #n ")" ::: "memory")
#define ASM_WAIT_L(n) asm volatile("s_waitcnt lgkmcnt(" #n ")" ::: "memory")
#define ASM_WAIT_VL0() asm volatile("s_waitcnt vmcnt(0) lgkmcnt(0)" ::: "memory")
#define CFENCE() asm volatile("" ::: "memory")
#define WAVE_LDS_FENCE() asm volatile("s_waitcnt lgkmcnt(0)" ::: "memory")
#define S_BARRIER() __builtin_amdgcn_s_barrier()
#define SCHED_BARRIER() __builtin_amdgcn_sched_barrier(0)
#define SETPRIO(x) __builtin_amdgcn_s_setprio(x)
#define S_SLEEP(n) __builtin_amdgcn_s_sleep(n)
#define MFMA16(a, b, c) __builtin_amdgcn_mfma_f32_16x16x32_bf16(a, b, c, 0, 0, 0)
#define GLDS16(gptr, lptr) __builtin_amdgcn_global_load_lds((const unsigned*)(gptr), (LAS unsigned*)(lptr), 16, 0, 0)
#define READFIRSTLANE(x) __builtin_amdgcn_readfirstlane(x)
#define XCC_ID_() ((unsigned)__builtin_amdgcn_s_getreg((3 << 11) | 20) & 0xFu)
#define FENCE_RELEASE() __builtin_amdgcn_fence(__ATOMIC_RELEASE, "agent")
#define FENCE_ACQUIRE() __builtin_amdgcn_fence(__ATOMIC_ACQUIRE, "agent")
#define DPP_F(v, ctrl) __builtin_bit_cast(float, __builtin_amdgcn_update_dpp(0, __builtin_bit_cast(int, (float)(v)), (ctrl), 0xF, 0xF, true))
__device__ __forceinline__ int vgpr_zero() { int z; asm volatile("v_mov_b32 %0, 0" : "=v"(z)); return z; }
__device__ __forceinline__ unsigned fbits(float f) { return __builtin_bit_cast(unsigned, f); }
__device__ __forceinline__ float bitsf(unsigned u) { return __builtin_bit_cast(float, u); }
#endif
typedef unsigned short bf16;
#define RLX_AGENT __ATOMIC_RELAXED, __HIP_MEMORY_SCOPE_AGENT

__device__ __forceinline__ unsigned f2bf(float f) { unsigned u = fbits(f); return (u + 0x7fffu + ((u >> 16) & 1u)) >> 16; }
__device__ __forceinline__ unsigned pk2(float lo, float hi) { return f2bf(lo) | (f2bf(hi) << 16); }
__device__ __forceinline__ float bf2f(bf16 b) { return bitsf(((unsigned)b) << 16); }
__device__ __forceinline__ float bflo(unsigned w) { return bitsf(w << 16); }
__device__ __forceinline__ float bfhi(unsigned w) { return bitsf(w & 0xffff0000u); }
__device__ __forceinline__ float sigmoidf_(float x) { return 1.0f / (1.0f + expf(-x)); }
__device__ __forceinline__ float wave_sum(float v) {
#pragma unroll
    for (int o = 1; o < 64; o <<= 1) v += __shfl_xor(v, o);
    return v;
}
__device__ __forceinline__ float row16_sum(float v) {
    v += DPP_F(v, 0xB1);
    v += DPP_F(v, 0x4E);
    v += DPP_F(v, 0x141);
    v += DPP_F(v, 0x140);
    return v;
}
__device__ __forceinline__ void sincos_f(float x, float& s, float& c) {
    const float k = rintf(x * 0.63661977236758134f);
    float r = fmaf(-k, 1.5703125f, x); r = fmaf(-k, 4.837512969970703125e-4f, r); r = fmaf(-k, 7.54978994989188216e-8f, r);
    const float r2 = r * r;
    const float sp = r + r * r2 * (-1.6666654611e-1f + r2 * (8.3321608736e-3f + r2 * (-1.9515295891e-4f)));
    const float cp = 1.0f - 0.5f * r2 + r2 * r2 * (4.166664568298827e-2f + r2 * (-1.388731625493765e-3f + r2 * (2.443315711809948e-5f)));
    const int q = ((int)k) & 3;
    s = (q == 0) ? sp : (q == 1) ? cp : (q == 2) ? -sp : -cp;
    c = (q == 0) ? cp : (q == 1) ? -sp : (q == 2) ? -cp : sp;
}
__device__ __forceinline__ float sin_f(float x) { float s, c; sincos_f(x, s, c); return s; }

#define XB_TMO      128
#define XB_XCNT(j)  (256  + 64 * (j))
#define XB_XSUB(j)  (1280 + 64 * (j))
#define XB_XGEN(j)  (2304 + 64 * (j))
#define XB_TOP      3328
#define XB_TOPGEN   3392
#define XCD_BAR_WORDS 3456
#define XB_SPIN_CAP (1u << 18)
__device__ __forceinline__ unsigned xb_ld(unsigned* p)              { return __hip_atomic_load(p, __ATOMIC_RELAXED, __HIP_MEMORY_SCOPE_AGENT); }
__device__ __forceinline__ unsigned xb_add(unsigned* p, unsigned v) { return __hip_atomic_fetch_add(p, v, __ATOMIC_RELAXED, __HIP_MEMORY_SCOPE_AGENT); }
#define XB_SPIN(cond, bar) do { unsigned _sp = 0; while (cond) { S_SLEEP(1); \
    if ((++_sp & 255u) == 0u) { if (xb_ld(&(bar)[XB_TMO])) break; if (_sp > XB_SPIN_CAP) { atomicAdd(&(bar)[XB_TMO], 1u); break; } } } } while (0)
struct XcdBarrier { unsigned* bar; unsigned x; volatile LAS unsigned* st; };
__device__ __forceinline__ XcdBarrier xcd_barrier_post(unsigned* bar, volatile LAS unsigned* st) {
    XcdBarrier b; b.bar = bar; b.x = XCC_ID_(); b.st = st;
    if (threadIdx.x == 0) (void)xb_add(&bar[XB_XCNT(b.x)], 1u);
    return b;
}
__device__ __forceinline__ void xcd_barrier_complete(unsigned* bar, unsigned x, unsigned& nloc, unsigned& nx) {
    const unsigned G = gridDim.x * gridDim.y * gridDim.z;
    unsigned sum, cnt, mine, sp = 0u;
    for (;;) {
        sum = 0u; cnt = 0u; mine = 0u;
#pragma unroll
        for (unsigned j = 0; j < 16; ++j) { const unsigned c = xb_ld(&bar[XB_XCNT(j)]); sum += c; cnt += (c > 0u) ? 1u : 0u; mine = (j == x) ? c : mine; }
        if (sum == G) break;
        S_SLEEP(1);
        if ((++sp & 255u) == 0u) { if (xb_ld(&bar[XB_TMO])) break; if (sp > XB_SPIN_CAP) { atomicAdd(&bar[XB_TMO], 1u); break; } }
    }
    nloc = mine > 0u ? mine : 1u; nx = cnt > 0u ? cnt : 1u;
}
__device__ __forceinline__ void xcd_barrier(const XcdBarrier& b) {
    ASM_WAIT_V(0);
    __syncthreads();
    if (threadIdx.x == 0) {
        unsigned* bar = b.bar;
        ASM_WAIT_VL0();
        unsigned nloc = b.st[0], nx = b.st[1];
        if (nloc == 0u) { xcd_barrier_complete(bar, b.x, nloc, nx); b.st[0] = nloc; b.st[1] = nx; }
        const unsigned old = xb_add(&bar[XB_XSUB(b.x)], 1u);
        const unsigned gen = old / nloc;
        if (old + 1u == (gen + 1u) * nloc) {
            FENCE_RELEASE();
            ASM_WAIT_V(0);
            const unsigned og = xb_add(&bar[XB_TOP], 1u);
            const unsigned tg = og / nx;
            if (og + 1u == (tg + 1u) * nx) xb_add(&bar[XB_TOPGEN], 1u);
            else XB_SPIN(xb_ld(&bar[XB_TOPGEN]) == tg, bar);
            FENCE_ACQUIRE();
            xb_add(&bar[XB_XGEN(b.x)], 1u);
            ASM_WAIT_V(0);
        } else {
            XB_SPIN(xb_ld(&bar[XB_XGEN(b.x)]) == gen, bar);
            FENCE_ACQUIRE();
            ASM_WAIT_V(0);
        }
    }
    __syncthreads();
}

namespace pg8 {
constexpr int BM = 256, BK = 64, HALF = 128, HTB = HALF * BK * 2, STAGE_BYTES = 8 * HTB, NXCD = 8, WGM = 8;
__host__ __device__ __forceinline__ int lds_byte(int r, int c) { const int st = (r >> 4) * 2 + (c >> 5), rr = r & 15, cc = c & 31, ob = rr * 64 + cc * 2; return st * 1024 + (ob ^ (((ob >> 9) & 1) << 5)); }
__host__ __device__ __forceinline__ void stage_rc(int b, int& R, int& C) { const int st = b / 1024, sb = b % 1024, swz = sb ^ (((sb >> 9) & 1) << 5); R = (st >> 1) * 16 + swz / 64; C = (st & 1) * 32 + (swz % 64) / 2; }
__host__ __device__ __forceinline__ int perm32(int rho) { const int n = rho >> 4, i = rho & 15; return 8 * (i >> 2) + 4 * n + (i & 3); }
struct Unit { int pm, pn; };
struct Gemm { const bf16* A; const bf16* Bt; int K; };
struct StaticOrder {
    int nM, nN, nwg, G, c;
    __host__ __device__ void init(int M_, int N_, int G_, int c_) { nM = M_ / BM; nN = N_ / BM; nwg = nM * nN; G = G_; c = c_; }
    __host__ __device__ bool next(int i, Unit& u) const {
        const long L = (long)i * G + c; if (L >= nwg) return false;
        int wgid = (int)L; { const int q = nwg / NXCD, r = nwg % NXCD, xcd = wgid % NXCD, off = wgid / NXCD; wgid = (xcd < r ? xcd * (q + 1) : r * (q + 1) + (xcd - r) * q) + off; }
        const int nig = WGM * nN, gid = wgid / nig, fm = gid * WGM, gsz = (nM - fm) < WGM ? (nM - fm) : WGM;
        u.pm = fm + ((wgid % nig) % gsz); u.pn = (wgid % nig) / gsz; return true;
    }
};
struct MoeOrder {
    const volatile LAS int* tab; int NT, G, c;
    __device__ __forceinline__ bool next(int i, Unit& u) const {
        const long L = (long)i * G + c; if (L >= tab[16]) return false;
        int e = 0; while (L >= tab[e + 1]) ++e;
        const int loc = (int)L - tab[e], tc = tab[64 + e];
        u.pm = tab[32 + e] + loc % tc; u.pn = e * NT + loc / tc; return true;
    }
};
__device__ __forceinline__ unsigned cvt_pk_bf16(float lo, float hi) {
#ifdef EMU
    return pk2(lo, hi);
#else
    unsigned r; asm volatile("v_cvt_pk_bf16_f32 %0, %1, %2" : "=v"(r) : "v"(lo), "v"(hi)); return r;
#endif
}

struct EpiBf16 {
    static constexpr bool PERM = true;
    bf16* O; int ldc;
    __device__ __forceinline__ void operator()(const f32x4 (&acc)[2][2][4][2], const Unit& u, int wr, int wc, int fr, int fq) const {
        const int row0 = u.pm * BM + wr * 64 + fr, col0 = u.pn * BM + wc * 32 + 8 * fq;
#pragma unroll
        for (int ai = 0; ai < 2; ++ai)
#pragma unroll
            for (int m = 0; m < 4; ++m) { bf16* rowp = O + (size_t)(row0 + ai * HALF + m * 16) * ldc + col0;
#pragma unroll
                for (int bj = 0; bj < 2; ++bj) { const f32x4 v0 = acc[ai][bj][m][0], v1 = acc[ai][bj][m][1];
                    u32x4 w; w[0] = cvt_pk_bf16(v0[0], v0[1]); w[1] = cvt_pk_bf16(v0[2], v0[3]); w[2] = cvt_pk_bf16(v1[0], v1[1]); w[3] = cvt_pk_bf16(v1[2], v1[3]);
                    *(u32x4*)(rowp + bj * HALF) = w; } }
    }
};
struct EpiF32 {
    static constexpr bool PERM = false;
    float* C; int ldc;
    __device__ __forceinline__ void operator()(const f32x4 (&acc)[2][2][4][2], const Unit& u, int wr, int wc, int fr, int fq) const {
        const int row0 = u.pm * BM + wr * 64 + fr, col0 = u.pn * BM + wc * 32 + 4 * fq;
#pragma unroll
        for (int ai = 0; ai < 2; ++ai)
#pragma unroll
            for (int m = 0; m < 4; ++m) { float* rowp = C + (size_t)(row0 + ai * HALF + m * 16) * ldc + col0;
#pragma unroll
                for (int bj = 0; bj < 2; ++bj)
#pragma unroll
                    for (int n = 0; n < 2; ++n) *(f32x4*)(rowp + bj * HALF + n * 16) = acc[ai][bj][m][n]; }
    }
};
template <bool ADD> struct EpiGate {
    static constexpr bool PERM = true;
    bf16* T; int ldc; const bf16* Pg; int ldp; int gcol0;
    __device__ __forceinline__ void operator()(const f32x4 (&acc)[2][2][4][2], const Unit& u, int wr, int wc, int fr, int fq) const {
        const int row0 = u.pm * BM + wr * 64 + fr, col0 = u.pn * BM + wc * 32 + 8 * fq;
#pragma unroll
        for (int ai = 0; ai < 2; ++ai)
#pragma unroll
            for (int m = 0; m < 4; ++m) { const size_t row = (size_t)(row0 + ai * HALF + m * 16);
#pragma unroll
                for (int bj = 0; bj < 2; ++bj) { const f32x4 v0 = acc[ai][bj][m][0], v1 = acc[ai][bj][m][1];
                    const u32x4 g = *(const u32x4*)(Pg + row * ldp + gcol0 + col0 + bj * HALF);
                    u32x4 t = {0u, 0u, 0u, 0u}; if (ADD) t = *(const u32x4*)(T + row * ldc + col0 + bj * HALF);
                    float o[8];
#pragma unroll
                    for (int j = 0; j < 4; ++j) { const float a0 = j < 2 ? v0[2 * j] : v1[2 * j - 4], a1 = j < 2 ? v0[2 * j + 1] : v1[2 * j - 3];
                        o[2 * j] = bflo(t[j]) + sigmoidf_(bflo(g[j])) * a0; o[2 * j + 1] = bfhi(t[j]) + sigmoidf_(bfhi(g[j])) * a1; }
                    u32x4 w; w[0] = cvt_pk_bf16(o[0], o[1]); w[1] = cvt_pk_bf16(o[2], o[3]); w[2] = cvt_pk_bf16(o[4], o[5]); w[3] = cvt_pk_bf16(o[6], o[7]);
                    *(u32x4*)(T + row * ldc + col0 + bj * HALF) = w; } }
    }
};
struct EpiSwiglu {
    static constexpr bool PERM = true;
    bf16* O; int ldc; int NT;
    __device__ __forceinline__ void operator()(const f32x4 (&acc)[2][2][4][2], const Unit& u, int wr, int wc, int fr, int fq) const {
        const int row0 = u.pm * BM + wr * 64 + fr, col0 = (u.pn % NT) * HALF + wc * 32 + 8 * fq;
#pragma unroll
        for (int ai = 0; ai < 2; ++ai)
#pragma unroll
            for (int m = 0; m < 4; ++m) { bf16* rowp = O + (size_t)(row0 + ai * HALF + m * 16) * ldc + col0;
                float o[8];
#pragma unroll
                for (int j = 0; j < 8; ++j) { const float g = acc[ai][0][m][j >> 2][j & 3], uu = acc[ai][1][m][j >> 2][j & 3]; o[j] = g / (1.0f + expf(-g)) * uu; }
                u32x4 w; w[0] = cvt_pk_bf16(o[0], o[1]); w[1] = cvt_pk_bf16(o[2], o[3]); w[2] = cvt_pk_bf16(o[4], o[5]); w[3] = cvt_pk_bf16(o[6], o[7]);
                *(u32x4*)rowp = w; }
    }
};
struct EpiMoeDown {
    static constexpr bool PERM = true;
    bf16* O; int ldc; int NT;
    __device__ __forceinline__ void operator()(const f32x4 (&acc)[2][2][4][2], const Unit& u, int wr, int wc, int fr, int fq) const {
        const int row0 = u.pm * BM + wr * 64 + fr, col0 = (u.pn % NT) * BM + wc * 32 + 8 * fq;
#pragma unroll
        for (int ai = 0; ai < 2; ++ai)
#pragma unroll
            for (int m = 0; m < 4; ++m) { bf16* rowp = O + (size_t)(row0 + ai * HALF + m * 16) * ldc + col0;
#pragma unroll
                for (int bj = 0; bj < 2; ++bj) { const f32x4 v0 = acc[ai][bj][m][0], v1 = acc[ai][bj][m][1];
                    u32x4 w; w[0] = cvt_pk_bf16(v0[0], v0[1]); w[1] = cvt_pk_bf16(v0[2], v0[3]); w[2] = cvt_pk_bf16(v1[0], v1[1]); w[3] = cvt_pk_bf16(v1[2], v1[3]);
                    *(u32x4*)(rowp + bj * HALF) = w; } }
    }
};

template <class Epi, class Sched>
__device__ __forceinline__ void gemm_phase(LAS unsigned char* lds, const Gemm g, const Sched& S, const Epi& E) {
    const int tid = threadIdx.x, wid = READFIRSTLANE(tid >> 6), lane = tid & 63, wr = wid >> 2, wc = wid & 3, fr = lane & 15, fq = lane >> 4;
    const int K = g.K, nt = K / BK;
    unsigned voffA[2], voffB[2];
#pragma unroll
    for (int i = 0; i < 2; ++i) { int R, C; stage_rc(tid * 16 + i * 8192, R, C); const int Rb = Epi::PERM ? ((R & ~31) + perm32(R & 31)) : R;
        voffA[i] = (unsigned)(R * K + C) * 2u; voffB[i] = (unsigned)(Rb * K + C) * 2u; }
    const size_t kstep = (size_t)(BK * 2);
    const size_t hstep = (size_t)HALF * K * 2;
    const size_t tstep = 2 * hstep;
    const unsigned ldsw = (unsigned)wid * 1024u;
    const int aoff = lds_byte(wr * 64 + fr, fq * 8), boff = lds_byte(wc * 32 + fr, fq * 8);
#define PG8_SA(b, h) (((b) * 2 + (h)) * HTB)
#define PG8_SB(b, h) ((4 + (b) * 2 + (h)) * HTB)
#define PG8_STAGE(bufoff, gbase, voff) do { _Pragma("unroll") for (int _i = 0; _i < 2; ++_i) \
        GLDS16((const char*)(gbase) + (voff)[_i], lds + (bufoff) + ldsw + _i * 8192); } while (0)
#define PG8_LDA(dst, b, h) do { _Pragma("unroll") for (int m = 0; m < 4; ++m) _Pragma("unroll") for (int k = 0; k < 2; ++k) dst[m][k] = *(const LAS bf16x8*)(lds + PG8_SA(b, h) + aoff + m * 2048 + k * 1024); } while (0)
#define PG8_LDB(dst, b, h) do { _Pragma("unroll") for (int n = 0; n < 2; ++n) _Pragma("unroll") for (int k = 0; k < 2; ++k) dst[n][k] = *(const LAS bf16x8*)(lds + PG8_SB(b, h) + boff + n * 2048 + k * 1024); } while (0)
#define PG8_MMA(ai, bj, At, Bt) do { SETPRIO(1); _Pragma("unroll") for (int m = 0; m < 4; ++m) _Pragma("unroll") for (int n = 0; n < 2; ++n) _Pragma("unroll") for (int k = 0; k < 2; ++k) \
        acc[ai][bj][m][n] = MFMA16(Bt[n][k], At[m][k], acc[ai][bj][m][n]); SETPRIO(0); } while (0)
#define PG8_BAR S_BARRIER()
    Unit cur, nxt; int ui = 0;
    if (!S.next(0, cur)) return;
    f32x4 acc[2][2][4][2];
#pragma unroll
    for (int a = 0; a < 2; ++a)
#pragma unroll
        for (int b = 0; b < 2; ++b)
#pragma unroll
            for (int m = 0; m < 4; ++m)
#pragma unroll
                for (int n = 0; n < 2; ++n) acc[a][b][m][n] = (f32x4){0.f, 0.f, 0.f, 0.f};
    bf16x8 At[4][2], B0[2][2], B1[2][2];
    const char* cA = (const char*)g.A + (size_t)cur.pm * tstep; const char* cB = (const char*)g.Bt + (size_t)cur.pn * tstep;
    PG8_STAGE(PG8_SB(0, 0), cB, voffB); PG8_STAGE(PG8_SA(0, 0), cA, voffA); PG8_STAGE(PG8_SB(0, 1), cB + hstep, voffB); PG8_STAGE(PG8_SA(0, 1), cA + hstep, voffA);
    if (wr == 1) PG8_BAR;
    ASM_WAIT_V(4); PG8_BAR;
    PG8_STAGE(PG8_SB(1, 0), cB + kstep, voffB); PG8_STAGE(PG8_SA(1, 0), cA + kstep, voffA); PG8_STAGE(PG8_SB(1, 1), cB + hstep + kstep, voffB);
    ASM_WAIT_V(6); PG8_BAR;
    for (;;) {
        const bool has_next = S.next(ui + 1, nxt);
        const char* nA = has_next ? (const char*)g.A + (size_t)nxt.pm * tstep : cA; const char* nB = has_next ? (const char*)g.Bt + (size_t)nxt.pn * tstep : cB;
        for (int t = 0; t < nt; t += 2) {
            const bool last = (t == nt - 2);
            const char* a1 = cA + (size_t)(t + 1) * kstep;
            const char* a2 = last ? nA : cA + (size_t)(t + 2) * kstep; const char* b2 = last ? nB : cB + (size_t)(t + 2) * kstep;
            const char* a3 = a2 + kstep; const char* b3 = b2 + kstep;
            PG8_LDB(B0, 0, 0); SCHED_BARRIER(); PG8_LDA(At, 0, 0); PG8_STAGE(PG8_SA(1, 1), a1 + hstep, voffA);
            ASM_WAIT_L(8); PG8_BAR; ASM_WAIT_L(0); PG8_MMA(0, 0, At, B0); PG8_BAR; SCHED_BARRIER();
            PG8_LDB(B1, 0, 1); PG8_STAGE(PG8_SB(0, 0), b2, voffB);
            PG8_BAR; ASM_WAIT_L(0); PG8_MMA(0, 1, At, B1); PG8_BAR;
            PG8_LDA(At, 0, 1); PG8_STAGE(PG8_SA(0, 0), a2, voffA);
            PG8_BAR; ASM_WAIT_L(0); PG8_MMA(1, 0, At, B0); PG8_BAR; SCHED_BARRIER();
            PG8_STAGE(PG8_SB(0, 1), b2 + hstep, voffB);
            ASM_WAIT_V(6); PG8_BAR; PG8_MMA(1, 1, At, B1); PG8_BAR;
            PG8_LDB(B0, 1, 0); SCHED_BARRIER(); PG8_LDA(At, 1, 0); PG8_STAGE(PG8_SA(0, 1), a2 + hstep, voffA);
            ASM_WAIT_L(8); PG8_BAR; ASM_WAIT_L(0); PG8_MMA(0, 0, At, B0); PG8_BAR; SCHED_BARRIER();
            PG8_LDB(B1, 1, 1); PG8_STAGE(PG8_SB(1, 0), b3, voffB);
            PG8_BAR; ASM_WAIT_L(0); PG8_MMA(0, 1, At, B1); PG8_BAR;
            PG8_LDA(At, 1, 1); PG8_STAGE(PG8_SA(1, 0), a3, voffA);
            PG8_BAR; ASM_WAIT_L(0); PG8_MMA(1, 0, At, B0); PG8_BAR; SCHED_BARRIER();
            PG8_STAGE(PG8_SB(1, 1), b3 + hstep, voffB);
            ASM_WAIT_V(6); PG8_BAR; PG8_MMA(1, 1, At, B1); PG8_BAR;
        }
        E(acc, cur, wr, wc, fr, fq);
        if (!has_next) break;
#pragma unroll
        for (int a = 0; a < 2; ++a)
#pragma unroll
            for (int b = 0; b < 2; ++b)
#pragma unroll
                for (int m = 0; m < 4; ++m)
#pragma unroll
                    for (int n = 0; n < 2; ++n) acc[a][b][m][n] = (f32x4){0.f, 0.f, 0.f, 0.f};
        cur = nxt; cA = nA; cB = nB; ++ui;
    }
    ASM_WAIT_V(0);
    if (wr == 0) PG8_BAR;
    PG8_BAR;
#undef PG8_SA
#undef PG8_SB
#undef PG8_STAGE
#undef PG8_LDA
#undef PG8_LDB
#undef PG8_MMA
#undef PG8_BAR
}
}

struct Args { const float* in[N_IN]; float* out; unsigned char* ws; int ph_lo, ph_hi; };
constexpr int NWAVES = 8, NTHR = 512;
constexpr int LDS_STAGE = 131072, LDS_MISC = LDS_STAGE, LDS_BYTES = 147456;

constexpr int PT_OUT = N_IN, PT_WS = N_IN + 1, PT_WORD0 = 128;
struct Ctx {
    LAS unsigned char* lds; int tid, lane, wave, G, bid;
    __device__ __forceinline__ unsigned long long ptr(int i) const { const volatile LAS unsigned* t = (const volatile LAS unsigned*)(lds + LDS_MISC) + PT_WORD0 + 2 * i;
        const unsigned lo = (unsigned)READFIRSTLANE((int)t[0]), hi = (unsigned)READFIRSTLANE((int)t[1]); return ((unsigned long long)hi << 32) | lo; }
    __device__ __forceinline__ unsigned long long ptrv(int i) const { const volatile LAS unsigned* t = (const volatile LAS unsigned*)(lds + LDS_MISC) + PT_WORD0 + 2 * i; return ((unsigned long long)t[1] << 32) | t[0]; }
    __device__ __forceinline__ const float* inv(int i) const { return (const float*)ptrv(i); }
    template <class T> __device__ __forceinline__ T* wsv(size_t off) const { return (T*)((unsigned char*)ptrv(PT_WS) + off); }
    __device__ __forceinline__ const float* in(int i) const { return (const float*)ptr(i); }
    __device__ __forceinline__ float* out() const { return (float*)ptr(PT_OUT); }
    template <class T> __device__ __forceinline__ T* ws(size_t off) const { return (T*)((unsigned char*)ptr(PT_WS) + off); }
    __device__ __forceinline__ unsigned* ctl() const { return (unsigned*)ptr(PT_WS); }
};

__device__ __forceinline__ void transpose_item(const float* W, int ldw, int k0, int n0, int nvalid, bf16* outp, int ldo, LAS float* scr, int lane) {
#pragma unroll 8
    for (int i = 0; i < 32; ++i) { const int kk = 2 * i + (lane >> 5), n = n0 + (lane & 31); scr[kk * 33 + (lane & 31)] = (n < nvalid) ? W[(size_t)(k0 + kk) * ldw + n] : 0.f; }
    WAVE_LDS_FENCE(); CFENCE();
    const int c = lane & 7;
#pragma unroll
    for (int j = 0; j < 4; ++j) { const int n = (lane >> 3) + 8 * j; const LAS float* s = scr + (8 * c) * 33 + n;
        u32x4 o; o[0] = pk2(s[0 * 33], s[1 * 33]); o[1] = pk2(s[2 * 33], s[3 * 33]); o[2] = pk2(s[4 * 33], s[5 * 33]); o[3] = pk2(s[6 * 33], s[7 * 33]);
        *(u32x4*)(outp + (size_t)n * ldo + k0 + 8 * c) = o; }
    WAVE_LDS_FENCE(); CFENCE();
}
__device__ __forceinline__ void filter_item(const Ctx& X, int l, int n, int pos0, float* out  , LAS float* scr  , LAS float* asum  ) {
    const int lane = X.lane;
    LAS float* zs = scr; LAS float* ha = scr + 8 * 33; LAS float* hb = ha + 8 * 64;
    const float* w1 = X.in(I_FW1) + (size_t)l * 33 * 64; const float* b1 = X.in(I_FB1) + l * 64;
    const float* w2 = X.in(I_FW2) + (size_t)l * 64 * 64; const float* b2 = X.in(I_FB2) + l * 64;
    const float* w3 = X.in(I_FW3) + (size_t)l * 64 * 64; const float* b3 = X.in(I_FB3) + l * 64;
    const float* wo = X.in(I_FWO) + (size_t)l * 64 * HW; const float fr = X.in(I_FREQ)[l * 64 + lane];
    if (lane < 33) {
#pragma unroll
        for (int p = 0; p < 8; ++p) { const int pos = pos0 + p; float v;
            if (lane == 0) v = (float)pos / (float)(n - 1 > 1 ? n - 1 : 1);
            else { const int b = (lane - 1) & 15; const double band = 1e-4 + (double)b * ((15.0 - 1e-4) / 15.0);
                double rev = (double)pos * band / (double)n; rev -= floor(rev); if (rev > 0.5) rev -= 1.0;
                float s, c; sincos_f((float)(rev * 6.283185307179586476925), s, c); v = lane <= 16 ? c : -s; }
            zs[p * 33 + lane] = v; }
    }
    WAVE_LDS_FENCE(); CFENCE();
    float acc[8];
    { const float bb = b1[lane];
#pragma unroll
      for (int p = 0; p < 8; ++p) acc[p] = bb;
#pragma unroll 3
      for (int i = 0; i < 33; ++i) { const float w = w1[i * 64 + lane];
#pragma unroll
          for (int p = 0; p < 8; ++p) acc[p] += zs[p * 33 + i] * w; }
#pragma unroll
      for (int p = 0; p < 8; ++p) ha[p * 64 + lane] = sin_f(fr * acc[p]); }
    WAVE_LDS_FENCE(); CFENCE();
    { const float bb = b2[lane];
#pragma unroll
      for (int p = 0; p < 8; ++p) acc[p] = bb;
#pragma unroll 4
      for (int i = 0; i < 64; ++i) { const float w = w2[i * 64 + lane];
#pragma unroll
          for (int p = 0; p < 8; ++p) acc[p] += ha[p * 64 + i] * w; }
#pragma unroll
      for (int p = 0; p < 8; ++p) hb[p * 64 + lane] = sin_f(fr * acc[p]); }
    WAVE_LDS_FENCE(); CFENCE();
    { const float bb = b3[lane];
#pragma unroll
      for (int p = 0; p < 8; ++p) acc[p] = bb;
#pragma unroll 4
      for (int i = 0; i < 64; ++i) { const float w = w3[i * 64 + lane];
#pragma unroll
          for (int p = 0; p < 8; ++p) acc[p] += hb[p * 64 + i] * w; }
#pragma unroll
      for (int p = 0; p < 8; ++p) ha[p * 64 + lane] = sin_f(fr * acc[p]); }
    WAVE_LDS_FENCE(); CFENCE();
    const float dmin = -3.0701134573253944f, dmax = -15.350567286626972f;
#pragma unroll 1
    for (int mI = 0; mI < HW / 64; ++mI) { const int c = lane + 64 * mI;
#pragma unroll
        for (int p = 0; p < 8; ++p) acc[p] = 0.f;
#pragma unroll 4
        for (int i = 0; i < 64; ++i) { const float w = wo[i * HW + c];
#pragma unroll
            for (int p = 0; p < 8; ++p) acc[p] += ha[p * 64 + i] * w; }
        const float delta = fabsf(dmin + (float)c * ((dmax - dmin) / (float)(HW - 1)));
        float as = 0.f;
#pragma unroll
        for (int p = 0; p < 8; ++p) { const int pos = pos0 + p; const int dd = pos - n / 2; const float dist = (float)(dd < 0 ? -dd : dd) * (2.0f / (float)n);
            const float v = acc[p] * expf(-dist * delta); out[(size_t)c * n + pos] = v; as += fabsf(v); }
        asum[c] += as; }
    WAVE_LDS_FENCE(); CFENCE();
}
__device__ __forceinline__ void phase_transposes(const Ctx& X, int l) {
    LAS float* scr = (LAS float*)(X.lds + X.wave * 16384);
    const int gw = X.bid * NWAVES + X.wave, NGW = X.G * NWAVES, lane = X.lane;
    constexpr int KB_D = D / 64, I_WIN_ = KB_D * (PCP / 32), I_WB_ = 2 * (RW / 64) * (D / 32), I_WO_ = KB_D * (D / 32), I_WGU_ = NE * 2 * KB_D * (D / 32), I_WD_ = NE * KB_D * (D / 32);
    constexpr int NITEMS = I_WIN_ + I_WB_ + I_WO_ + I_WGU_ + I_WD_;
    for (int it = gw; it < NITEMS; it += NGW) {
        int r = it; const float* W; int ldw, k0, n0, nvalid, ldo; bf16* outp;
        if (r < I_WIN_) { const int nb = r % (PCP / 32), kb = r / (PCP / 32); W = X.in(I_WIN) + (size_t)l * D * PC; ldw = PC; k0 = 64 * kb; n0 = 32 * nb; nvalid = PC; outp = X.ws<bf16>(WS_WIN) + (size_t)n0 * D; ldo = D; }
        else if ((r -= I_WIN_) < I_WB_) { const int s = r / ((RW / 64) * (D / 32)), q = r % ((RW / 64) * (D / 32)), nb = q % (D / 32), kb = q / (D / 32);
            W = X.in(I_WBR) + ((size_t)l * 2 + s) * RW * D; ldw = D; k0 = 64 * kb; n0 = 32 * nb; nvalid = D; outp = X.ws<bf16>(WS_WB) + (size_t)s * D * RW + (size_t)n0 * RW; ldo = RW; }
        else if ((r -= I_WB_) < I_WO_) { const int nb = r % (D / 32), kb = r / (D / 32); W = X.in(I_WOUT) + (size_t)l * D * D; ldw = D; k0 = 64 * kb; n0 = 32 * nb; nvalid = D; outp = X.ws<bf16>(WS_WO) + (size_t)n0 * D; ldo = D; }
        else if ((r -= I_WO_) < I_WGU_) { const int per = KB_D * (D / 32), es = r / per, q = r % per, e = es >> 1, src = es & 1, nb = q % (D / 32), kb = q / (D / 32); n0 = 32 * nb;
            W = (src ? X.in(I_WU) : X.in(I_WG)) + ((size_t)l * NE + e) * D * D; ldw = D; k0 = 64 * kb; nvalid = D; const int orow = e * 2 * D + (n0 / 128) * 256 + src * 128 + (n0 % 128);
            outp = X.ws<bf16>(WS_WGU) + (size_t)orow * D; ldo = D; }
        else { r -= I_WGU_; const int per = KB_D * (D / 32), e = r / per, q = r % per, nb = q % (D / 32), kb = q / (D / 32);
            W = X.in(I_WD) + ((size_t)l * NE + e) * D * D; ldw = D; k0 = 64 * kb; n0 = 32 * nb; nvalid = D; outp = X.ws<bf16>(WS_WD) + (size_t)(e * D + n0) * D; ldo = D; }
        transpose_item(W, ldw, k0, n0, nvalid, outp, ldo, scr, lane);
    }
}
__device__ __forceinline__ void phase_filters(const Ctx& X, int l) {
    LAS float* scr = (LAS float*)(X.lds + X.wave * 8192);
    const int gw = X.bid * NWAVES + X.wave, NGW = X.G * NWAVES, lane = X.lane;
    LAS float* part = (LAS float*)(X.lds + 65536);
    static_assert(65536 + NWAVES * 2 * HW * 4 <= LDS_STAGE, "filter LDS map");
    for (int i = lane; i < 2 * HW; i += 64) part[X.wave * 2 * HW + i] = 0.f;
    WAVE_LDS_FENCE(); CFENCE();
    float* filt = X.ws<float>(WS_FILT);
    for (int it = gw; it < SEQ / 8; it += NGW) filter_item(X, l, SEQ, 8 * it, filt, scr, part + (X.wave * 2 + 0) * HW);
    for (int it = gw; it < CTX / 8; it += NGW) filter_item(X, l, CTX, 8 * it, filt + (size_t)HW * SEQ, scr, part + (X.wave * 2 + 1) * HW);
    __syncthreads();
    for (int i = X.tid; i < 2 * HW; i += NTHR) { float s = 0.f;
#pragma unroll
        for (int w = 0; w < NWAVES; ++w) s += part[w * 2 * HW + i];
        X.ws<float>(WS_FPART)[((size_t)(i / HW) * NPART + X.bid) * HW + (i % HW)] = s; }
    __syncthreads();
}
__device__ __forceinline__ void phase_mod(const Ctx& X) {
    const int lane = X.lane;
    LAS float* red = (LAS float*)X.lds;
    constexpr int NIT = DEPTH * (6 * D / 64);
    for (int it = X.bid; it < NIT; it += X.G) {
        const int ll = it / (6 * D / 64), n0 = (it % (6 * D / 64)) * 64;
        const float* W = X.in(I_WMOD) + (size_t)ll * D * 6 * D; const float* cv = X.in(I_C); const float* cc = X.in(I_CCTX);
        float s0 = 0.f, s1 = 0.f;
#pragma unroll 8
        for (int k = X.wave * (D / 8); k < (X.wave + 1) * (D / 8); ++k) { const float wv = W[(size_t)k * 6 * D + n0 + lane]; const float c0 = cv[k], c1 = cc[k];
            s0 += c0 * sigmoidf_(c0) * wv; s1 += c1 * sigmoidf_(c1) * wv; }
        red[(X.wave * 64 + lane) * 2] = s0; red[(X.wave * 64 + lane) * 2 + 1] = s1;
        __syncthreads();
        if (X.wave == 0) { float t0 = 0.f, t1 = 0.f;
#pragma unroll
            for (int w = 0; w < NWAVES; ++w) { t0 += red[(w * 64 + lane) * 2]; t1 += red[(w * 64 + lane) * 2 + 1]; }
            const float bm = X.in(I_BMOD)[(size_t)ll * 6 * D + n0 + lane];
            float* MOD = X.ws<float>(WS_MOD);
            MOD[((size_t)ll * 2 + 0) * 6 * D + n0 + lane] = t0 + bm; MOD[((size_t)ll * 2 + 1) * 6 * D + n0 + lane] = t1 + bm; }
        __syncthreads();
    }
}
__device__ __forceinline__ const float* modp(const Ctx& X, int l, int t, int j) { return X.ws<float>(WS_MOD) + ((size_t)l * 2 + (t < CTX ? 1 : 0)) * 6 * D + (size_t)j * D; }

__device__ __forceinline__ void phase_x0(const Ctx& X) {
    const int gw = X.bid * NWAVES + X.wave, NGW = X.G * NWAVES, lane = X.lane;
    for (int t = gw; t < M; t += NGW) {
        const float* src = t < CTX ? X.in(I_CTX) + (size_t)t * D : X.in(I_X) + (size_t)(t - CTX) * D;
        const float* sh = modp(X, 0, t, 0); const float* sc = modp(X, 0, t, 1);
        float* xr = X.ws<float>(WS_X) + (size_t)t * D; bf16* xm = X.ws<bf16>(WS_XMOD) + (size_t)t * D;
#pragma unroll
        for (int j = 0; j < D / 256; ++j) { const int d = 4 * lane + 256 * j; const f32x4 v = *(const f32x4*)(src + d), a = *(const f32x4*)(sh + d), b = *(const f32x4*)(sc + d);
            *(f32x4*)(xr + d) = v;
            unsigned w0 = pk2(v[0] * (1.f + b[0]) + a[0], v[1] * (1.f + b[1]) + a[1]), w1 = pk2(v[2] * (1.f + b[2]) + a[2], v[3] * (1.f + b[3]) + a[3]);
            *(unsigned long long*)(xm + d) = (unsigned long long)w0 | ((unsigned long long)w1 << 32); }
    }
}

__device__ __forceinline__ int shift_row(int t, int col, bool& valid) {
    const bool isctx = t < CTX;
    const int i = t - CTX, gx = i & (GRID_W - 1), gy = i / GRID_W, q = col / QTR;
    const int offl = (q == 0) ? -1 : (q == 1) ? 1 : (q == 2) ? -GRID_W : GRID_W;
    const bool vl = (q == 0) ? (gx > 0) : (q == 1) ? (gx < GRID_W - 1) : (q == 2) ? (gy > 0) : (gy < GRID_H - 1);
    const bool first = col < HALFC;
    const int offc = first ? -1 : 1; const bool vc = first ? (t > 0) : (t < CTX - 1);
    valid = isctx ? vc : vl;
    return valid ? t + (isctx ? offc : offl) : t;
}
__device__ __forceinline__ float pm_val(const bf16* P, const float* mu, int t, int col) {
    const float p0 = bf2f(P[(size_t)t * PCP + col]); bool valid; const int nr = shift_row(t, col, valid);
    const float pn = bf2f(P[(size_t)nr * PCP + col]); const float p1 = valid ? pn : 0.f;
    return p0 + (p1 - p0) * mu[col];
}
constexpr int TT = 8;
__device__ __forceinline__ void phase_prep_a(const Ctx& X, int l, int t0) {
    const bf16* P = X.wsv<bf16>(WS_P); const float* mu = X.inv(I_MU) + (size_t)l * RC;
    LAS float* S = (LAS float*)X.lds;
    const int c = X.tid;
    const float* w2 = X.inv(I_W2) + (size_t)l * 2 * 64 * RW; const float* a2 = X.inv(I_A2) + (size_t)l * 2 * 64 * RW; const float* g2 = X.inv(I_G2) + (size_t)l * 128 * RW;
        for (int idx = X.tid; idx < TT * 384; idx += NTHR) { const int tt = idx / 384, j = idx % 384; float v = pm_val(P, mu, t0 + tt, C_LWF + j);
            if (j < 128) v = tanhf(v); else if (j >= 256) v = sigmoidf_(v);
            S[j * TT + tt] = v; }
        __syncthreads();
        if (c < RW) {
            float aw0[TT], aw1[TT], aa0[TT], aa1[TT], ag[TT];
#pragma unroll
            for (int tt = 0; tt < TT; ++tt) { aw0[tt] = 0.f; aw1[tt] = 0.f; aa0[tt] = 0.f; aa1[tt] = 0.f; ag[tt] = 0.f; }
            for (int r = 0; r < 64; ++r) { const float wf = w2[(size_t)r * RW + c], wb = w2[(size_t)(64 + r) * RW + c], af = a2[(size_t)r * RW + c], ab = a2[(size_t)(64 + r) * RW + c];
#pragma unroll
                for (int tt = 0; tt < TT; ++tt) { aw0[tt] += S[r * TT + tt] * wf; aw1[tt] += S[(64 + r) * TT + tt] * wb; aa0[tt] += S[(128 + r) * TT + tt] * af; aa1[tt] += S[(192 + r) * TT + tt] * ab; } }
            for (int j = 0; j < 128; ++j) { const float gv = g2[(size_t)j * RW + c];
#pragma unroll
                for (int tt = 0; tt < TT; ++tt) ag[tt] += S[(256 + j) * TT + tt] * gv; }
            LAS float* AC = S + 384 * TT;
#pragma unroll
            for (int tt = 0; tt < TT; ++tt) { AC[(0 * TT + tt) * RW + c] = aw0[tt]; AC[(1 * TT + tt) * RW + c] = aw1[tt]; AC[(2 * TT + tt) * RW + c] = aa0[tt]; AC[(3 * TT + tt) * RW + c] = aa1[tt]; AC[(4 * TT + tt) * RW + c] = ag[tt]; }
        }
    __syncthreads();
}
__device__ __forceinline__ void phase_prep_b(const Ctx& X, int l, int t0) {
    const bf16* P = X.wsv<bf16>(WS_P); const float* mu = X.inv(I_MU) + (size_t)l * RC;
    LAS float* S = (LAS float*)X.lds;
    const int c = X.tid;
    const float* w2 = X.inv(I_W2) + (size_t)l * 2 * 64 * RW; const float* a2 = X.inv(I_A2) + (size_t)l * 2 * 64 * RW; const float* g2 = X.inv(I_G2) + (size_t)l * 128 * RW;
        CFENCE();
        if (c < RW) {
            const LAS float* AC = S + 384 * TT;
            const float w00 = X.inv(I_W0)[(size_t)(l * 2 + 0) * RW + c], w01 = X.inv(I_W0)[(size_t)(l * 2 + 1) * RW + c];
            const float a00 = X.inv(I_A0)[(size_t)(l * 2 + 0) * RW + c], a01 = X.inv(I_A0)[(size_t)(l * 2 + 1) * RW + c];
            const float kkc = X.inv(I_KK)[(size_t)l * RW + c], kac = X.inv(I_KA)[(size_t)l * RW + c], rkc = X.inv(I_RK)[(size_t)l * RW + c];
            const int vz = vgpr_zero();
#pragma unroll 1
            for (int tt = 0; tt < TT; ++tt) { const int t = t0 + tt + vz;
                const float r = pm_val(P, mu, t, c), k = pm_val(P, mu, t, C_K + c), v = pm_val(P, mu, t, C_V + c);
                const float wd0 = expf(-DECAY_SCALE * sigmoidf_(w00 + AC[(0 * TT + tt) * RW + c])), wd1 = expf(-DECAY_SCALE * sigmoidf_(w01 + AC[(1 * TT + tt) * RW + c]));
                const float ad0 = sigmoidf_(a00 + AC[(2 * TT + tt) * RW + c]), ad1 = sigmoidf_(a01 + AC[(3 * TT + tt) * RW + c]);
                const float kkr = k * kkc; const float n2 = wave_sum(kkr * kkr); const float kk = kkr / fmaxf(sqrtf(n2), 1e-12f);
                const float kd0 = k * (1.f + (ad0 - 1.f) * kac), kd1 = k * (1.f + (ad1 - 1.f) * kac);
                const float bon = wave_sum(r * (kd0 + kd1) * rkc);
                const size_t o = (size_t)t * RW + c, o1 = (size_t)(M + t) * RW + c;
                X.wsv<bf16>(WS_R)[o] = (bf16)f2bf(r); X.wsv<bf16>(WS_V)[o] = (bf16)f2bf(v); X.wsv<bf16>(WS_KA)[o] = (bf16)f2bf(-kk);
                X.wsv<bf16>(WS_KD)[o] = (bf16)f2bf(kd0); X.wsv<bf16>(WS_KD)[o1] = (bf16)f2bf(kd1);
                X.wsv<bf16>(WS_KB)[o] = (bf16)f2bf(kk * ad0); X.wsv<bf16>(WS_KB)[o1] = (bf16)f2bf(kk * ad1);
                X.wsv<float>(WS_W)[o] = wd0; X.wsv<float>(WS_W)[o1] = wd1;
                X.wsv<bf16>(WS_GATE)[o] = (bf16)f2bf(AC[(4 * TT + tt) * RW + c]);
                if (X.lane == 0) X.wsv<float>(WS_BONUS)[(size_t)t * NH + (c >> 6)] = bon; }
        }
        __syncthreads();
}
__device__ __forceinline__ void phase_prep_hyena(const Ctx& X, int l) {
    const bf16* P = X.ws<bf16>(WS_P); const int c = X.tid;
    for (int tile = X.bid; tile < M / TT; tile += X.G) {
        const int t0 = tile * TT;
        if (c < HW) {
            const float* cw = X.in(I_CW) + (size_t)l * 3 * HC; const float* cb = X.in(I_CB) + (size_t)l * HC;
            for (int tt = 0; tt < TT; ++tt) { const int t = t0 + tt; const bool hp = (t != 0 && t != CTX), hn = (t != CTX - 1 && t != M - 1);
                float u[3];
#pragma unroll
                for (int j = 0; j < 3; ++j) { const int hc = j * HW + c, col = C_HY + hc;
                    const float pc = bf2f(P[(size_t)t * PCP + col]), pp = hp ? bf2f(P[(size_t)(t - 1) * PCP + col]) : 0.f, pn = hn ? bf2f(P[(size_t)(t + 1) * PCP + col]) : 0.f;
                    u[j] = pp * cw[hc] + pc * cw[HC + hc] + pn * cw[2 * HC + hc] + cb[hc]; }
                X.ws<float>(WS_Z)[(size_t)t * HW + c] = u[2] * u[1]; X.ws<float>(WS_ZT)[(size_t)c * M + t] = u[2] * u[1]; X.ws<bf16>(WS_X0)[(size_t)t * HW + c] = (bf16)f2bf(u[0]); }
        }
    }
}

constexpr int SCH = 32;
constexpr int SC_STEP = 5 * 64 + 32;
constexpr int N_SCAN_UNITS = 2 * NH * 2;
__device__ __forceinline__ int scan_row(int d, int s) { return d == 0 ? s : (s < CTX ? CTX - 1 - s : M - 1 - (s - CTX)); }
__device__ __forceinline__ void scan_unit(const Ctx& X, int su) {
    const int d = su / (NH * 2), h = (su / 2) % NH, half = su & 1;
    LAS float* buf = (LAS float*)X.lds;
    LAS float* ybuf = buf + 2 * SCH * SC_STEP;
    const int vrow = X.wave * 4 + (X.lane >> 4), kq = (X.lane & 15) * 4;
    const int e = X.tid, which = e >> 6; const bool loader = e < SC_STEP, isf32 = which == 0;
    const char* src; {
        const size_t od = (size_t)d * M * RW + h * 64 + (e & 63), o = (size_t)h * 64 + (e & 63);
        if (which == 0) src = (const char*)(X.ws<float>(WS_W) + od);
        else if (which == 1) src = (const char*)(X.ws<bf16>(WS_KB) + od);
        else if (which == 2) src = (const char*)(X.ws<bf16>(WS_KD) + od);
        else if (which == 3) src = (const char*)(X.ws<bf16>(WS_KA) + o);
        else if (which == 4) src = (const char*)(X.ws<bf16>(WS_R) + o);
        else src = (const char*)(X.ws<bf16>(WS_V) + (size_t)h * 64 + half * 32 + (e - 320)); }
    const long esz = isf32 ? 4 : 2;
    float pre[SCH];
#define SCAN_LOAD(g_) do { if (loader) { const int s0_ = (g_) * SCH; const int row0_ = scan_row(d, s0_); const long st_ = (d == 0 ? (long)RW : -(long)RW) * esz; const char* p_ = src + (long)row0_ * RW * esz; \
        if (isf32) { _Pragma("unroll") for (int j = 0; j < SCH; ++j) pre[j] = *(const float*)(p_ + j * st_); } \
        else { _Pragma("unroll") for (int j = 0; j < SCH; ++j) pre[j] = bf2f(*(const bf16*)(p_ + j * st_)); } } } while (0)
#define SCAN_STORE(pb_) do { if (loader) { _Pragma("unroll") for (int j = 0; j < SCH; ++j) buf[((pb_) * SCH + j) * SC_STEP + e] = pre[j]; } } while (0)
    SCAN_LOAD(0); SCAN_STORE(0);
    __syncthreads();
    float S0 = 0.f, S1 = 0.f, S2 = 0.f, S3 = 0.f;
    float* Y = X.ws<float>(WS_Y) + (size_t)d * M * RW;
    constexpr int NCH = M / SCH;
    for (int g = 0; g < NCH; ++g) {
        const int pb = g & 1;
        if (g + 1 < NCH) SCAN_LOAD(g + 1);
        const LAS float* B = buf + pb * SCH * SC_STEP; LAS float* yb = ybuf + pb * SCH * 32;
#pragma unroll 4
        for (int s = 0; s < SCH; ++s) { const LAS float* q = B + s * SC_STEP;
            const f32x4 w4 = *(const LAS f32x4*)(q + kq), kb4 = *(const LAS f32x4*)(q + 64 + kq), kd4 = *(const LAS f32x4*)(q + 128 + kq), ka4 = *(const LAS f32x4*)(q + 192 + kq), r4 = *(const LAS f32x4*)(q + 256 + kq);
            const float vv = q[320 + vrow];
            const float sa = row16_sum(S0 * ka4[0] + S1 * ka4[1] + S2 * ka4[2] + S3 * ka4[3]);
            S0 = S0 * w4[0] + sa * kb4[0] + vv * kd4[0]; S1 = S1 * w4[1] + sa * kb4[1] + vv * kd4[1]; S2 = S2 * w4[2] + sa * kb4[2] + vv * kd4[2]; S3 = S3 * w4[3] + sa * kb4[3] + vv * kd4[3];
            const float y = row16_sum(S0 * r4[0] + S1 * r4[1] + S2 * r4[2] + S3 * r4[3]);
            if ((X.lane & 15) == 0) yb[s * 32 + vrow] = y; }
        if (g + 1 < NCH) SCAN_STORE(pb ^ 1);
        __syncthreads();
        for (int i = X.tid; i < SCH * 32; i += NTHR) { const int s = i >> 5, v = i & 31; Y[(size_t)scan_row(d, g * SCH + s) * RW + h * 64 + half * 32 + v] = yb[i]; }
    }
    __syncthreads();
#undef SCAN_LOAD
#undef SCAN_STORE
}
constexpr int CR = 16;
__device__ __forceinline__ void conv_item(const Ctx& X, int item) {
    constexpr int NCG = HW / 64; constexpr int n = CTX;
    const int cg = item % NCG, ob = item / NCG, i0 = CR * ob, c = cg * 64 + X.lane;
    const float* F = X.ws<float>(WS_FILT) + (size_t)HW * SEQ + (size_t)c * CTX; const float* Z = X.ws<float>(WS_Z) + c;
    const float* fp = X.ws<float>(WS_FPART) + (size_t)NPART * HW + c;
    float nsum = 0.f; for (int b = 0; b < NPART; ++b) nsum += fp[(size_t)b * HW];
    float acc[CR], Q[CR];
#pragma unroll
    for (int r = 0; r < CR; ++r) acc[r] = 0.f;
    int jb = i0 - n / 2; if (jb < 0) jb = 0;
    int jend = i0 + n / 2 + CR; if (jend > n) jend = n;
    int Tb = i0 - jb + n / 2;
#pragma unroll
    for (int x = 1; x < CR; ++x) { const int T = Tb + x; Q[x] = (T >= 0 && T < n) ? F[T] : 0.f; }
    Q[0] = 0.f;
    for (; jb < jend; jb += CR, Tb -= CR) {
#pragma unroll
        for (int s = 0; s < CR; ++s) { const int T = Tb - s, j = jb + s;
            if ((s & 3) == 0) CFENCE();
            Q[(CR - s) & (CR - 1)] = (T >= 0 && T < n) ? F[T] : 0.f;
            const float zj = (j < n) ? Z[(size_t)j * HW] : 0.f;
#pragma unroll
            for (int r = 0; r < CR; ++r) acc[r] += Q[(r - s + CR) & (CR - 1)] * zj; }
    }
    const float inv = 1.0f / nsum; float* O = X.ws<float>(WS_CONV) + c;
#pragma unroll
    for (int r = 0; r < CR; ++r) O[(size_t)(i0 + r) * HW] = acc[r] * inv;
}

#ifdef EMU
struct cf { float x, y; };
#else
typedef float cf __attribute__((ext_vector_type(2)));
#endif
__device__ __forceinline__ cf cmul(cf a, cf b) { return cf{a.x * b.x - a.y * b.y, a.x * b.y + a.y * b.x}; }
__device__ __forceinline__ cf cadd(cf a, cf b) { return cf{a.x + b.x, a.y + b.y}; }
__device__ __forceinline__ cf csub(cf a, cf b) { return cf{a.x - b.x, a.y - b.y}; }
__device__ __forceinline__ cf cconj(cf a) { return cf{a.x, -a.y}; }
constexpr int FN = SEQ;
constexpr int flog4(int n) { return n <= 1 ? 0 : 1 + flog4(n / 4); }
constexpr int FLOG4 = flog4(FN), FSQ = 1 << FLOG4;
static_assert((1 << (2 * FLOG4)) == FN && FN * 8 <= LDS_STAGE, "FFT length must be a power of 4 that fits the LDS stage region");
constexpr int FFT_TAB_OFF = LDS_MISC + 2048;
static_assert(FFT_TAB_OFF + 2 * FSQ * 8 <= LDS_BYTES, "FFT twiddle tables");
__device__ __forceinline__ void fft_tables(const Ctx& X) {
    LAS cf* T = (LAS cf*)(X.lds + FFT_TAB_OFF);
    for (int i = X.tid; i < 2 * FSQ; i += NTHR) { const int k = i < FSQ ? i * FSQ : i - FSQ; float s, c; sincos_f(-6.283185307179586f * (float)k / (float)FN, s, c); T[i] = cf{c, s}; }
    __syncthreads();
}
__device__ __forceinline__ cf fft_tw(const LAS cf* T, int k) { const cf a = T[k >> FLOG4], b = T[FSQ + (k & (FSQ - 1))]; return cmul(a, b); }
__device__ __forceinline__ int rev4(int k) { int r = 0;
#pragma unroll
    for (int s = 0; s < FLOG4; ++s) { r = (r << 2) | (k & 3); k >>= 2; }
    return r; }
__device__ __forceinline__ void fft_fwd(LAS cf* x, const LAS cf* T, int tid) {
#pragma unroll 1
    for (int s = 0; s < FLOG4; ++s) { const int q = FN >> (2 * s + 2), tw = 1 << (2 * s);
        for (int u = tid; u < FN / 4; u += NTHR) { const int j = u & (q - 1), p = (u - j) * 4 + j;
            const cf a0 = x[p], a1 = x[p + q], a2 = x[p + 2 * q], a3 = x[p + 3 * q];
            const cf t0 = cadd(a0, a2), t1 = csub(a0, a2), t2 = cadd(a1, a3), d = csub(a1, a3), t3 = cf{d.y, -d.x};
            const cf w1 = fft_tw(T, j * tw), w2 = cmul(w1, w1), w3 = cmul(w2, w1);
            x[p] = cadd(t0, t2); x[p + q] = cmul(cadd(t1, t3), w1); x[p + 2 * q] = cmul(csub(t0, t2), w2); x[p + 3 * q] = cmul(csub(t1, t3), w3); }
        __syncthreads(); }
}
__device__ __forceinline__ void fft_inv(LAS cf* x, const LAS cf* T, int tid) {
#pragma unroll 1
    for (int s = FLOG4 - 1; s >= 0; --s) { const int q = FN >> (2 * s + 2), tw = 1 << (2 * s);
        for (int u = tid; u < FN / 4; u += NTHR) { const int j = u & (q - 1), p = (u - j) * 4 + j;
            const cf w1 = cconj(fft_tw(T, j * tw)), w2 = cmul(w1, w1), w3 = cmul(w2, w1);
            const cf a0 = x[p], a1 = cmul(x[p + q], w1), a2 = cmul(x[p + 2 * q], w2), a3 = cmul(x[p + 3 * q], w3);
            const cf t0 = cadd(a0, a2), t1 = csub(a0, a2), t2 = cadd(a1, a3), d = csub(a1, a3), t3 = cf{-d.y, d.x};
            x[p] = cadd(t0, t2); x[p + q] = cadd(t1, t3); x[p + 2 * q] = csub(t0, t2); x[p + 3 * q] = csub(t1, t3); }
        __syncthreads(); }
}
__device__ __forceinline__ void fft_load_real(LAS cf* x, const float* src, float scale, int tid) {
    for (int m = tid; m < FN; m += NTHR) { cf v{0.f, 0.f}; if (m < FN / 2) { v.x = src[2 * m] * scale; v.y = src[2 * m + 1] * scale; } x[m] = v; }
    __syncthreads();
}
__device__ __forceinline__ void phase_spectra(const Ctx& X, int l) {
    (void)l;
    LAS cf* x = (LAS cf*)X.lds; const LAS cf* T = (const LAS cf*)(X.lds + FFT_TAB_OFF); volatile LAS float* red = (volatile LAS float*)(X.lds + LDS_MISC) + 120;
    fft_tables(X);
    for (int c = X.bid; c < HW; c += X.G) {
        if (X.wave == 0) { const float* fp = X.ws<float>(WS_FPART) + c; float s = 0.f; for (int b = X.lane; b < NPART; b += 64) s += fp[(size_t)b * HW]; s = wave_sum(s); if (X.lane == 0) red[0] = s; }
        __syncthreads();
        const float inv = 1.0f / red[0];
        fft_load_real(x, X.ws<float>(WS_FILT) + (size_t)c * SEQ, inv, X.tid);
        fft_fwd(x, T, X.tid);
        cf* HS = X.ws<cf>(WS_HS) + (size_t)c * (FN + 1);
        for (int k = X.tid; k <= FN / 2; k += NTHR) {
            const cf A = x[rev4(k)], B = x[rev4((FN - k) & (FN - 1))];
            if (k == 0) { HS[0] = cf{A.x + A.y, 0.f}; HS[FN] = cf{A.x - A.y, 0.f}; }
            else if (k == FN / 2) { HS[k] = cconj(A); }
            else { float sn, cs; sincos_f(-3.14159265358979f * (float)k / (float)FN, sn, cs); const cf w{cs, sn};
                const cf s1 = cadd(A, cconj(B)), d1 = csub(A, cconj(B)), wd = cmul(w, d1);
                HS[k] = cf{0.5f * (s1.x + wd.y), 0.5f * (s1.y - wd.x)};
                const cf s2 = cadd(B, cconj(A)), d2 = csub(B, cconj(A)), wd2 = cmul(cconj(w), d2);
                HS[FN - k] = cf{0.5f * (s2.x - wd2.y), 0.5f * (s2.y + wd2.x)}; } }
        __syncthreads();
    }
}
__device__ __forceinline__ void fftconv_item(const Ctx& X, int l, int c) {
    LAS cf* x = (LAS cf*)X.lds; const LAS cf* T = (const LAS cf*)(X.lds + FFT_TAB_OFF);
    const float* z = X.ws<float>(WS_ZT) + (size_t)c * M + CTX;
    fft_load_real(x, z, 1.0f, X.tid);
    fft_fwd(x, T, X.tid);
    const cf* HS = X.ws<cf>(WS_HS) + (size_t)c * (FN + 1);
    for (int k = X.tid; k <= FN / 2; k += NTHR) {
        const int pa = rev4(k), pb = rev4((FN - k) & (FN - 1)); const cf A = x[pa], B = x[pb];
        if (k == 0) { const float y0 = (A.x + A.y) * HS[0].x, yn = (A.x - A.y) * HS[FN].x; x[pa] = cf{0.5f * (y0 + yn), 0.5f * (y0 - yn)}; }
        else if (k == FN / 2) { x[pa] = cconj(cmul(cconj(A), HS[k])); }
        else { float sn, cs; sincos_f(-3.14159265358979f * (float)k / (float)FN, sn, cs); const cf w{cs, sn};
            const cf s1 = cadd(A, cconj(B)), d1 = csub(A, cconj(B)), wd = cmul(w, d1); const cf Xk{0.5f * (s1.x + wd.y), 0.5f * (s1.y - wd.x)};
            const cf s2 = cadd(B, cconj(A)), d2 = csub(B, cconj(A)), wd2 = cmul(cconj(w), d2); const cf Xn{0.5f * (s2.x - wd2.y), 0.5f * (s2.y + wd2.x)};
            const cf Yk = cmul(Xk, HS[k]), Yn = cmul(Xn, HS[FN - k]);
            const cf e1 = cadd(Yk, cconj(Yn)), f1 = cmul(cconj(w), csub(Yk, cconj(Yn)));
            x[pa] = cf{0.5f * (e1.x - f1.y), 0.5f * (e1.y + f1.x)};
            const cf e2 = cadd(Yn, cconj(Yk)), f2 = cmul(w, csub(Yn, cconj(Yk)));
            x[pb] = cf{0.5f * (e2.x + f2.y), 0.5f * (e2.y - f2.x)}; } }
    __syncthreads();
    fft_inv(x, T, X.tid);
    const float bias = X.in(I_HBIAS)[(size_t)l * HW + c], sc = 1.0f / (float)FN; float* O = X.ws<float>(WS_CVT) + (size_t)c * M + CTX;
    for (int i2 = X.tid; i2 < FN / 2; i2 += NTHR) { const cf d = x[i2 + FN / 4]; O[2 * i2] = d.x * sc + z[2 * i2] * bias; O[2 * i2 + 1] = d.y * sc + z[2 * i2 + 1] * bias; }
    __syncthreads();
}
__device__ __forceinline__ void phase_fftconv(const Ctx& X, int l) {
    fft_tables(X);
    volatile LAS int* slot = (volatile LAS int*)(X.lds + LDS_MISC) + 121;
    unsigned* q = X.ctl() + CW_Q + l * 64 + 32;
    for (;;) { if (X.tid == 0) slot[0] = (int)atomicAdd(q, 1u); __syncthreads(); const int c = slot[0]; __syncthreads(); if (c >= HW) break; fftconv_item(X, l, c); }
}
__device__ __forceinline__ void phase_scanconv(const Ctx& X, int l) {
#ifndef NO_SCAN
    for (int su = X.bid; su < N_SCAN_UNITS; su += X.G) scan_unit(X, su);
#endif
#ifdef NO_CONV
    return;
#endif
    constexpr int NITEMS = (HW / 64) * (CTX / CR);
    unsigned* q = X.ctl() + CW_Q + l * 64;
    for (;;) { int item = 0; if (X.lane == 0) item = (int)atomicAdd(q, 1u); item = __shfl(item, 0); if (item >= NITEMS) break; conv_item(X, item); }
}

__device__ __forceinline__ void phase_finish(const Ctx& X, int l) {
    const int c = X.tid;
    const float* lg = X.in(I_LNXG) + (size_t)l * RW; const float* lb = X.in(I_LNXB) + (size_t)l * RW; const float* hb = X.in(I_HBIAS) + (size_t)l * HW;
    for (int t = X.bid; t < M; t += X.G) {
        if (c < RW) { const size_t o = (size_t)t * RW + c;
            const float y = X.ws<float>(WS_Y)[o] + X.ws<float>(WS_Y)[(size_t)M * RW + o];
            const float mean = wave_sum(y) * (1.f / 64.f); const float dy = y - mean; const float var = wave_sum(dy * dy) * (1.f / 64.f);
            float yn = dy / sqrtf(var + GN_EPS) * lg[c] + lb[c];
            yn += X.ws<float>(WS_BONUS)[(size_t)t * NH + (c >> 6)] * bf2f(X.ws<bf16>(WS_V)[o]);
            yn *= bf2f(X.ws<bf16>(WS_GATE)[o]);
            X.ws<bf16>(WS_RO)[o] = (bf16)f2bf(yn); }
        if (c < HW) { const size_t o = (size_t)t * HW + c;
            const float cv = t < CTX ? X.ws<float>(WS_CONV)[o] + X.ws<float>(WS_Z)[o] * hb[c] : X.ws<float>(WS_CVT)[(size_t)c * M + t];
            const float ho = cv * bf2f(X.ws<bf16>(WS_X0)[o]);
            X.ws<bf16>(WS_HO)[o] = (bf16)f2bf(ho); }
    }
}

__device__ __forceinline__ void ln_inplace(float (&v)[D / 64], const float* g, const float* b, int lane) {
    float s = 0.f;
#pragma unroll
    for (int j = 0; j < D / 64; ++j) s += v[j];
    const float mean = wave_sum(s) * (1.f / D); float q = 0.f;
#pragma unroll
    for (int j = 0; j < D / 64; ++j) { v[j] -= mean; q += v[j] * v[j]; }
    const float rstd = 1.0f / sqrtf(wave_sum(q) * (1.f / D) + LN_EPS);
#pragma unroll
    for (int j = 0; j < D / 64; ++j) { const int d = 4 * lane + 256 * (j >> 2) + (j & 3); v[j] = v[j] * rstd * g[d] + b[d]; }
}
__device__ __forceinline__ void phase_norm1(const Ctx& X, int l) {
    const int gw = X.bid * NWAVES + X.wave, NGW = X.G * NWAVES, lane = X.lane;
    const float* lng = X.in(I_LNG) + (size_t)(l * 2 + 0) * D; const float* lnb = X.in(I_LNB) + (size_t)(l * 2 + 0) * D;
    const float* wr = X.in(I_WR); const float* rb = X.in(I_RB);
    const float alpha = sqrtf(sqrtf(2.0f * DEPTH));
    for (int t = gw; t < M; t += NGW) {
        float* xr = X.ws<float>(WS_X) + (size_t)t * D; const float* mx = X.ws<float>(WS_MIX) + (size_t)t * D;
        const float* gate = modp(X, l, t, 2); const float* sh = modp(X, l, t, 3); const float* sc = modp(X, l, t, 4);
        float v[D / 64];
#pragma unroll
        for (int j = 0; j < D / 256; ++j) { const int d = 4 * lane + 256 * j; const f32x4 a = *(const f32x4*)(xr + d), m = *(const f32x4*)(mx + d), gt = *(const f32x4*)(gate + d);
#pragma unroll
            for (int i = 0; i < 4; ++i) v[4 * j + i] = alpha * a[i] + gt[i] * m[i]; }
        ln_inplace(v, lng, lnb, lane);
        bf16* hf = X.ws<bf16>(WS_XMOD) + (size_t)t * D;
        LAS float* hrow = (LAS float*)X.lds + X.wave * D;
#pragma unroll
        for (int j = 0; j < D / 256; ++j) { const int d = 4 * lane + 256 * j; f32x4 o; const f32x4 a = *(const f32x4*)(sh + d), b = *(const f32x4*)(sc + d); f32x4 h;
#pragma unroll
            for (int i = 0; i < 4; ++i) { o[i] = v[4 * j + i]; h[i] = o[i] * (1.f + b[i]) + a[i]; }
            *(f32x4*)(xr + d) = o; *(LAS f32x4*)(hrow + d) = h;
            *(unsigned long long*)(hf + d) = (unsigned long long)pk2(h[0], h[1]) | ((unsigned long long)pk2(h[2], h[3]) << 32); }
        WAVE_LDS_FENCE(); CFENCE();
        float part = 0.f; { const int e = lane & 15, q = lane >> 4;
#pragma unroll 8
            for (int d = q * (D / 4); d < (q + 1) * (D / 4); ++d) part += hrow[d] * wr[(size_t)d * NE + e]; }
        part += __shfl_xor(part, 16); part += __shfl_xor(part, 32);
        WAVE_LDS_FENCE(); CFENCE();
        float lg[NE];
#pragma unroll
        for (int e = 0; e < NE; ++e) lg[e] = __shfl(part, e);
        float mxl = lg[0];
#pragma unroll
        for (int e = 1; e < NE; ++e) mxl = fmaxf(mxl, lg[e]);
        float sc_[NE], sum = 0.f;
#pragma unroll
        for (int e = 0; e < NE; ++e) { sc_[e] = expf(lg[e] - mxl); sum += sc_[e]; }
        const float isum = 1.0f / sum; float sel[NE];
#pragma unroll
        for (int e = 0; e < NE; ++e) { sc_[e] *= isum; sel[e] = sc_[e] + rb[e]; }
        int bg = 0; float bgs = -INFINITY;
#pragma unroll
        for (int g = 0; g < 4; ++g) { float m1 = -INFINITY, m2 = -INFINITY;
#pragma unroll
            for (int i = 0; i < 4; ++i) { const float x = sel[4 * g + i]; if (x > m1) { m2 = m1; m1 = x; } else if (x > m2) m2 = x; }
            const float gs = m1 + m2; if (gs > bgs) { bgs = gs; bg = g; } }
        int i0 = 0, i1 = 0; float s0 = -INFINITY, s1 = -INFINITY, p0 = 0.f, p1 = 0.f;
#pragma unroll
        for (int e = 0; e < NE; ++e) { if ((e >> 2) == bg) { const float x = sel[e]; if (x > s0) { s1 = s0; i1 = i0; p1 = p0; s0 = x; i0 = e; p0 = sc_[e]; } else if (x > s1) { s1 = x; i1 = e; p1 = sc_[e]; } } }
        if (lane == 0) { int* ei = X.ws<int>(WS_ROUT) + (size_t)t * 2; float* ew = (float*)(X.ws<int>(WS_ROUT) + (size_t)M * 2) + (size_t)t * 2;
            ei[0] = i0; ei[1] = i1; const float ws_ = 1.0f / (p0 + p1); ew[0] = p0 * ws_; ew[1] = p1 * ws_;
            atomicAdd(X.ctl() + CW_CNT + l * 64 + i0, 1u); atomicAdd(X.ctl() + CW_CNT + l * 64 + i1, 1u); }
    }
}

__device__ __forceinline__ void moe_table(const Ctx& X, int l, int NT) {
    volatile LAS int* tab = (volatile LAS int*)(X.lds + LDS_MISC) + 8;
    if (X.tid == 0) { int cum = 0, ts = 0;
        for (int e = 0; e < NE; ++e) { const int cnt = (int)__hip_atomic_load(X.ctl() + CW_CNT + l * 64 + e, RLX_AGENT); const int tc = (cnt + 255) / 256;
            tab[e] = cum; tab[32 + e] = ts; tab[64 + e] = tc; cum += tc * NT; ts += tc; }
        tab[16] = cum; }
    __syncthreads();
}
__device__ __forceinline__ void phase_scatter(const Ctx& X, int l) {
    moe_table(X, l, 1);
    volatile LAS int* tab = (volatile LAS int*)(X.lds + LDS_MISC) + 8;
    const int gw = X.bid * NWAVES + X.wave, NGW = X.G * NWAVES, lane = X.lane;
    const int* ei = X.ws<int>(WS_ROUT); int* slot = X.ws<int>(WS_ROUT) + (size_t)M * 4;
    for (int s = gw; s < 2 * M; s += NGW) { const int t = s >> 1; const int e = ei[s];
        int pos = 0; if (lane == 0) pos = tab[32 + e] * 256 + (int)atomicAdd(X.ctl() + CW_CUR + l * 64 + e, 1u);
        pos = __shfl(pos, 0);
        if (lane == 0) slot[s] = pos;
        const u32x4* src = (const u32x4*)(X.ws<bf16>(WS_XMOD) + (size_t)t * D); u32x4* dst = (u32x4*)(X.ws<bf16>(WS_XG) + (size_t)pos * D);
        for (int i = lane; i < D / 8; i += 64) dst[i] = src[i]; }
}

__device__ __forceinline__ void phase_combine(const Ctx& X, int l) {
    const int gw = X.bid * NWAVES + X.wave, NGW = X.G * NWAVES, lane = X.lane;
    const float* lng = X.in(I_LNG) + (size_t)(l * 2 + 1) * D; const float* lnb = X.in(I_LNB) + (size_t)(l * 2 + 1) * D;
    const float alpha = sqrtf(sqrtf(2.0f * DEPTH));
    const float* ew = (const float*)(X.ws<int>(WS_ROUT) + (size_t)M * 2); const int* slot = X.ws<int>(WS_ROUT) + (size_t)M * 4;
    for (int t = gw; t < M; t += NGW) {
        float* xr = X.ws<float>(WS_X) + (size_t)t * D; const float* gate = modp(X, l, t, 5);
        const bf16* y0 = X.ws<bf16>(WS_YS) + (size_t)slot[2 * t] * D; const bf16* y1 = X.ws<bf16>(WS_YS) + (size_t)slot[2 * t + 1] * D; const float w0 = ew[2 * t], w1 = ew[2 * t + 1];
        float v[D / 64];
#pragma unroll
        for (int j = 0; j < D / 256; ++j) { const int d = 4 * lane + 256 * j; const f32x4 a = *(const f32x4*)(xr + d), gt = *(const f32x4*)(gate + d);
            const unsigned long long q0 = *(const unsigned long long*)(y0 + d), q1 = *(const unsigned long long*)(y1 + d);
            float ya[4] = {bflo((unsigned)q0), bfhi((unsigned)q0), bflo((unsigned)(q0 >> 32)), bfhi((unsigned)(q0 >> 32))};
            float yb[4] = {bflo((unsigned)q1), bfhi((unsigned)q1), bflo((unsigned)(q1 >> 32)), bfhi((unsigned)(q1 >> 32))};
#pragma unroll
            for (int i = 0; i < 4; ++i) v[4 * j + i] = alpha * a[i] + gt[i] * (w0 * ya[i] + w1 * yb[i]); }
        ln_inplace(v, lng, lnb, lane);
        if (l + 1 < DEPTH) { const float* sh = modp(X, l + 1, t, 0); const float* sc = modp(X, l + 1, t, 1); bf16* xm = X.ws<bf16>(WS_XMOD) + (size_t)t * D;
#pragma unroll
            for (int j = 0; j < D / 256; ++j) { const int d = 4 * lane + 256 * j; f32x4 o; const f32x4 a = *(const f32x4*)(sh + d), b = *(const f32x4*)(sc + d); float h[4];
#pragma unroll
                for (int i = 0; i < 4; ++i) { o[i] = v[4 * j + i]; h[i] = o[i] * (1.f + b[i]) + a[i]; }
                *(f32x4*)(xr + d) = o;
                *(unsigned long long*)(xm + d) = (unsigned long long)pk2(h[0], h[1]) | ((unsigned long long)pk2(h[2], h[3]) << 32); }
        } else if (t >= CTX) { float* orow = X.out() + (size_t)(t - CTX) * D; const bool bad = __hip_atomic_load(X.ctl() + CW_BAR + XB_TMO, RLX_AGENT) != 0u;
#pragma unroll
            for (int j = 0; j < D / 256; ++j) { const int d = 4 * lane + 256 * j; f32x4 o;
#pragma unroll
                for (int i = 0; i < 4; ++i) o[i] = bad ? __builtin_nanf("") : v[4 * j + i];
                *(f32x4*)(orow + d) = o; }
        }
    }
}


#ifdef EMU
#define PHASE_FN static
#define THIN_FN static
#else
#define PHASE_FN __device__ __forceinline__
#define THIN_FN __device__ __noinline__
#endif
THIN_FN void ph_transposes(Ctx X, int l) { phase_transposes(X, l); }
THIN_FN void ph_filters(Ctx X, int l) { phase_filters(X, l); }
THIN_FN void ph_mod(Ctx X) { phase_mod(X); }
THIN_FN void ph_x0(Ctx X) { phase_x0(X); }
THIN_FN void ph_prep_a(Ctx X, int l, int t0) { phase_prep_a(X, l, t0); }
THIN_FN void ph_prep_b(Ctx X, int l, int t0) { phase_prep_b(X, l, t0); }
THIN_FN void ph_prep_hyena(Ctx X, int l) { phase_prep_hyena(X, l); }
THIN_FN void ph_scanconv(Ctx X, int l) { phase_scanconv(X, l); }
THIN_FN void ph_fftconv(Ctx X, int l) { phase_fftconv(X, l); }
THIN_FN void ph_spectra(Ctx X, int l) { phase_spectra(X, l); }
THIN_FN void ph_finish(Ctx X, int l) { phase_finish(X, l); }
THIN_FN void ph_norm1(Ctx X, int l) { phase_norm1(X, l); }
THIN_FN void ph_scatter(Ctx X, int l) { phase_scatter(X, l); }
THIN_FN void ph_combine(Ctx X, int l) { phase_combine(X, l); }
PHASE_FN void ph_g1(Ctx X) { pg8::Gemm g{X.ws<bf16>(WS_XMOD), X.ws<bf16>(WS_WIN), D}; pg8::StaticOrder S; S.init(M, PCP, X.G, X.bid); pg8::EpiBf16 E{X.ws<bf16>(WS_P), PCP}; pg8::gemm_phase(X.lds, g, S, E); }
PHASE_FN void ph_g2a(Ctx X) { pg8::Gemm g{X.ws<bf16>(WS_RO), X.ws<bf16>(WS_WB), RW}; pg8::StaticOrder S; S.init(M, D, X.G, X.bid); pg8::EpiGate<false> E{X.ws<bf16>(WS_T), D, X.ws<bf16>(WS_P), PCP, C_GR}; pg8::gemm_phase(X.lds, g, S, E); }
PHASE_FN void ph_g2b(Ctx X) { pg8::Gemm g{X.ws<bf16>(WS_HO), X.ws<bf16>(WS_WB) + (size_t)D * RW, HW}; pg8::StaticOrder S; S.init(M, D, X.G, X.bid); pg8::EpiGate<true> E{X.ws<bf16>(WS_T), D, X.ws<bf16>(WS_P), PCP, C_GH}; pg8::gemm_phase(X.lds, g, S, E); }
PHASE_FN void ph_g3(Ctx X) { pg8::Gemm g{X.ws<bf16>(WS_T), X.ws<bf16>(WS_WO), D}; pg8::StaticOrder S; S.init(M, D, X.G, X.bid); pg8::EpiF32 E{X.ws<float>(WS_MIX), D}; pg8::gemm_phase(X.lds, g, S, E); }
PHASE_FN void ph_g4(Ctx X, int l) { moe_table(X, l, 2 * D / 256); pg8::MoeOrder S{(const volatile LAS int*)(X.lds + LDS_MISC) + 8, 2 * D / 256, X.G, X.bid};
    pg8::Gemm g{X.ws<bf16>(WS_XG), X.ws<bf16>(WS_WGU), D}; pg8::EpiSwiglu E{X.ws<bf16>(WS_ACT), D, 2 * D / 256}; pg8::gemm_phase(X.lds, g, S, E); }
PHASE_FN void ph_g5(Ctx X, int l) { moe_table(X, l, D / 256); pg8::MoeOrder S{(const volatile LAS int*)(X.lds + LDS_MISC) + 8, D / 256, X.G, X.bid};
    pg8::Gemm g{X.ws<bf16>(WS_ACT), X.ws<bf16>(WS_WD), D}; pg8::EpiMoeDown E{X.ws<bf16>(WS_YS), D, D / 256}; pg8::gemm_phase(X.lds, g, S, E); }

constexpr int NPH = 14, NPHASES = DEPTH * NPH;
template <int MASK> __global__ void __launch_bounds__(NTHR, 2) fwd_kernel(Args args) {
    DYN_LDS(lds);
    Ctx X; X.lds = lds; X.tid = threadIdx.x; X.lane = X.tid & 63; X.wave = READFIRSTLANE(X.tid >> 6); X.G = gridDim.x; X.bid = blockIdx.x;
    volatile LAS unsigned* misc = (volatile LAS unsigned*)(lds + LDS_MISC);
    if (X.tid < 128) misc[X.tid] = 0u;
    if (X.tid < N_IN + 2) { const unsigned long long p = X.tid < N_IN ? (unsigned long long)args.in[X.tid < N_IN ? X.tid : 0] : (X.tid == N_IN ? (unsigned long long)args.out : (unsigned long long)args.ws);
        misc[PT_WORD0 + 2 * X.tid] = (unsigned)p; misc[PT_WORD0 + 2 * X.tid + 1] = (unsigned)(p >> 32); }
    __syncthreads();
    XcdBarrier bar = xcd_barrier_post(X.ctl() + CW_BAR, misc);
    const int lo = args.ph_lo, hi = args.ph_hi;
#define IN(k) ((((MASK) >> ((k) % NPH)) & 1) && lo <= (k) && (k) < hi)
#define SEAM(k) do { if ((k) + 1 < hi) xcd_barrier(bar); } while (0)
    for (int l = 0; l < DEPTH; ++l) {
        const int pb = l * NPH;
        if (IN(pb + 0)) { ph_transposes(X, l); __syncthreads(); ph_filters(X, l); if (l == 0) ph_mod(X); SEAM(pb + 0); }
        if (l == 0 && IN(pb + 1)) { ph_x0(X); SEAM(pb + 1); }
        if (IN(pb + 2)) { ph_g1(X); SEAM(pb + 2); }
        if (IN(pb + 3)) { for (int tile = X.bid; tile < M / TT; tile += X.G) { ph_prep_a(X, l, tile * TT); ph_prep_b(X, l, tile * TT); } ph_prep_hyena(X, l); ph_spectra(X, l); SEAM(pb + 3); }
        if (IN(pb + 4)) { ph_scanconv(X, l); ph_fftconv(X, l); SEAM(pb + 4); }
        if (IN(pb + 5)) { ph_finish(X, l); SEAM(pb + 5); }
        if (IN(pb + 6)) { ph_g2a(X); SEAM(pb + 6); }
        if (IN(pb + 7)) { ph_g2b(X); SEAM(pb + 7); }
        if (IN(pb + 8)) { ph_g3(X); SEAM(pb + 8); }
        if (IN(pb + 9)) { ph_norm1(X, l); SEAM(pb + 9); }
        if (IN(pb + 10)) { ph_scatter(X, l); SEAM(pb + 10); }
        if (IN(pb + 11)) { ph_g4(X, l); SEAM(pb + 11); }
        if (IN(pb + 12)) { ph_g5(X, l); SEAM(pb + 12); }
        if (IN(pb + 13)) { ph_combine(X, l); SEAM(pb + 13); }
    }
#undef IN
#undef SEAM
}

#ifndef N_LAUNCHES
#define N_LAUNCHES 1
#endif
#ifndef PH_MASK
#define PH_MASK 0x3fff
#endif
template <int MASK> static void launch_mask(int grid, hipStream_t stream, const Args& a) {
    static bool attr = false;
    if (!attr) { (void)hipFuncSetAttribute((const void*)fwd_kernel<MASK>, hipFuncAttributeMaxDynamicSharedMemorySize, LDS_BYTES); attr = true; }
    hipLaunchKernelGGL(fwd_kernel<MASK>, dim3(grid), dim3(NTHR), LDS_BYTES, stream, a);
}
extern "C" void kernel_launch(void* const* d_in, const int* in_sizes, int n_in, void* d_out, int out_size, void* d_ws, size_t ws_size, hipStream_t stream) {
    static int grid = 0;
    if (grid == 0) {
        if (n_in != N_IN || ws_size < WS_END) { fprintf(stderr, "kernel_launch: unexpected n_in %d or workspace %zu < %zu\n", n_in, ws_size, (size_t)WS_END); grid = -1; return; }
        int dev = 0, cus = 0;
        if (hipGetDevice(&dev) != hipSuccess || hipDeviceGetAttribute(&cus, hipDeviceAttributeMultiprocessorCount, dev) != hipSuccess) { grid = -1; return; }
        (void)hipGetLastError();
        grid = cus; if (grid > NPART) grid = NPART;
    }
    if (grid < 0) return;
    (void)in_sizes; (void)out_size;
    (void)hipMemsetAsync(d_ws, 0, CTL_BYTES, stream);
    Args a;
    for (int i = 0; i < N_IN; ++i) a.in[i] = (const float*)d_in[i];
    a.out = (float*)d_out; a.ws = (unsigned char*)d_ws;
#if N_LAUNCHES == 1
    a.ph_lo = 0; a.ph_hi = NPHASES;
    launch_mask<PH_MASK>(grid, stream, a);
#else
    for (int ph = 0; ph < NPHASES; ++ph) { const int k = ph % NPH; if (k == 1 && ph / NPH != 0) continue; a.ph_lo = ph; a.ph_hi = ph + 1;
        switch (k) {
            case 0: launch_mask<1 << 0>(grid, stream, a); break; case 1: launch_mask<1 << 1>(grid, stream, a); break; case 2: launch_mask<1 << 2>(grid, stream, a); break;
            case 3: launch_mask<1 << 3>(grid, stream, a); break; case 4: launch_mask<1 << 4>(grid, stream, a); break; case 5: launch_mask<1 << 5>(grid, stream, a); break;
            case 6: launch_mask<1 << 6>(grid, stream, a); break; case 7: launch_mask<1 << 7>(grid, stream, a); break; case 8: launch_mask<1 << 8>(grid, stream, a); break;
            case 9: launch_mask<1 << 9>(grid, stream, a); break; case 10: launch_mask<1 << 10>(grid, stream, a); break; case 11: launch_mask<1 << 11>(grid, stream, a); break;
            case 12: launch_mask<1 << 12>(grid, stream, a); break; default: launch_mask<1 << 13>(grid, stream, a); break; } }
#endif
}
```

```cpp
#ifndef EMU
#include <hip/hip_runtime.h>
#endif
#include <cstdio>
#include <cstdint>
#include <cmath>

#ifndef CFG_D
#define CFG_D 1024
#define CFG_SEQ 16384
#define CFG_CTX 256
#define CFG_DEPTH 4
#endif
constexpr int D = CFG_D, SEQ = CFG_SEQ, CTX = CFG_CTX, DEPTH = CFG_DEPTH, M = CTX + SEQ;
constexpr int GRID_W = 64, GRID_H = SEQ / GRID_W;
constexpr int RW = D / 2, NH = RW / 64, HW = D / 2, RC = 3 * RW + 384, HC = 3 * HW, GC = 2 * D, PC = RC + HC + GC, PCP = (PC + 255) / 256 * 256;
constexpr int QTR = RC / 4, HALFC = RC / 2;
constexpr int C_K = RW, C_V = 2 * RW, C_LWF = 3 * RW, C_LG = 3 * RW + 256;
constexpr int C_HY = RC, C_GR = RC + HC, C_GH = RC + HC + D;
constexpr int NE = 16, SP_TILES = (2 * M) / 256 + NE, SP = SP_TILES * 256;
constexpr float DECAY_SCALE = 0.606531f, GN_EPS = 6.4e-4f, LN_EPS = 1e-5f;
constexpr int NPART = 256;
static_assert(CTX % 32 == 0 && M % 256 == 0 && D % 256 == 0 && RW % 128 == 0 && RW >= 256 && SEQ % 64 == 0 && CTX % 32 == 0 && RC % 4 == 0, "shape assumptions");

enum { I_X = 0, I_C, I_CTX, I_CCTX, I_WMOD, I_BMOD, I_WIN, I_MU, I_W0, I_W2, I_A0, I_A2, I_G2, I_KK, I_KA, I_RK, I_LNXG, I_LNXB, I_CW, I_CB,
       I_FW1, I_FB1, I_FW2, I_FB2, I_FW3, I_FB3, I_FWO, I_FREQ, I_HBIAS, I_WBR, I_WOUT, I_LNG, I_LNB, I_WR, I_RB, I_WG, I_WU, I_WD, N_IN };

constexpr size_t al256(size_t x) { return (x + 255) & ~(size_t)255; }
constexpr size_t CTL_BYTES = 1u << 20;
constexpr size_t WS_MOD = CTL_BYTES;
constexpr size_t WS_FPART = al256(WS_MOD + (size_t)DEPTH * 2 * 6 * D * 4);
constexpr size_t WS_ROUT = al256(WS_FPART + (size_t)2 * NPART * HW * 4);
constexpr size_t WS_BONUS = al256(WS_ROUT + (size_t)M * 2 * 4 * 3);
constexpr size_t WS_WIN = al256(WS_BONUS + (size_t)M * NH * 4);
constexpr size_t WS_WB = al256(WS_WIN + (size_t)PCP * D * 2);
constexpr size_t WS_WO = al256(WS_WB + (size_t)2 * D * RW * 2);
constexpr size_t WS_WGU = al256(WS_WO + (size_t)D * D * 2);
constexpr size_t WS_WD = al256(WS_WGU + (size_t)NE * 2 * D * D * 2);
constexpr size_t WS_X = al256(WS_WD + (size_t)NE * D * D * 2);
constexpr size_t WS_XMOD = al256(WS_X + (size_t)M * D * 4);
constexpr size_t WS_P = al256(WS_XMOD + (size_t)M * D * 2);
constexpr size_t WS_FILT = al256(WS_P + (size_t)M * PCP * 2);
constexpr size_t WS_MIX = al256(WS_FILT + (size_t)M * HW * 4);
constexpr size_t WS_T = al256(WS_MIX + (size_t)M * D * 4);
constexpr size_t WS_S = al256(WS_T + (size_t)M * D * 2);
constexpr size_t WS_R = WS_S;
constexpr size_t WS_V = al256(WS_R + (size_t)M * RW * 2);
constexpr size_t WS_KA = al256(WS_V + (size_t)M * RW * 2);
constexpr size_t WS_KD = al256(WS_KA + (size_t)M * RW * 2);
constexpr size_t WS_KB = al256(WS_KD + (size_t)2 * M * RW * 2);
constexpr size_t WS_W = al256(WS_KB + (size_t)2 * M * RW * 2);
constexpr size_t WS_PQ = al256(WS_W + (size_t)2 * M * RW * 4);
constexpr size_t WS_G = al256(WS_PQ + (size_t)2 * NH * (M / 64) * 2 * 4096 * 4);
constexpr size_t WS_YL = al256(WS_G + (size_t)2 * NH * (M / 64) * 4096 * 2);
constexpr size_t WS_S0 = WS_XMOD;
static_assert((size_t)2 * NH * (M / 64) * 4096 * 2 <= (size_t)M * D * 2, "S0 fits XMOD");
constexpr size_t WS_Z = al256(WS_YL + (size_t)2 * NH * (M / 64) * 4096 * 4);
constexpr size_t WS_X0 = al256(WS_Z + (size_t)CTX * HW * 4);
constexpr size_t WS_CONV = al256(WS_X0 + (size_t)M * HW * 2);
constexpr size_t WS_GATE = al256(WS_CONV + (size_t)CTX * HW * 4);
constexpr size_t WS_RO = al256(WS_GATE + (size_t)M * RW * 2);
constexpr size_t WS_HO = al256(WS_RO + (size_t)M * RW * 2);
constexpr size_t WS_HS = WS_MIX;
constexpr size_t WS_ZT = WS_T;
constexpr size_t WS_CVT = WS_FILT;
static_assert((size_t)HW * (SEQ + 1) * 8 <= (size_t)M * D * 4 && (size_t)HW * M * 4 <= (size_t)M * D * 2, "HS fits MIX, ZT fits T");
constexpr size_t WS_END1 = al256(WS_HO + (size_t)M * HW * 2);
constexpr size_t WS_XG = WS_S;
constexpr size_t WS_ACT = al256(WS_XG + (size_t)SP * D * 2);
constexpr size_t WS_YS = al256(WS_ACT + (size_t)SP * D * 2);
constexpr size_t WS_END2 = al256(WS_YS + (size_t)SP * D * 2);
constexpr size_t WS_END = WS_END1 > WS_END2 ? WS_END1 : WS_END2;
constexpr int CW_TMO = 0, CW_BAR = 4096, CW_CNT = 8192  , CW_CUR = 8192 + 1024  , CW_Q = 8192 + 2048  ;

#ifdef EMU
#define LAS
typedef short bf16x8 __attribute__((vector_size(16)));
typedef float f32x4 __attribute__((vector_size(16)));
typedef unsigned u32x4 __attribute__((vector_size(16)));
#define DYN_LDS(name) unsigned char* name = emu_cur_lds()
#define ASM_WAIT_V(n) do {} while (0)
#define ASM_WAIT_L(n) do {} while (0)
#define ASM_WAIT_VL0() do {} while (0)
#define CFENCE() do {} while (0)
#define WAVE_LDS_FENCE() emu_wave_sync()
#define S_BARRIER() emu_block_sync()
#define SCHED_BARRIER() do {} while (0)
#define SETPRIO(x) do {} while (0)
#define S_SLEEP(n) emu_yield()
#define MFMA16(a, b, c) emu_mfma_16x16x32(a, b, c)
#define GLDS16(gptr, lptr) emu_glds16((const void*)(gptr), (void*)(lptr))
#define READFIRSTLANE(x) (x)
#define XCC_ID_() (blockIdx.x & 7u)
#define FENCE_RELEASE() do {} while (0)
#define FENCE_ACQUIRE() do {} while (0)
#define DPP_F(v, ctrl) emu_dpp_f(v, ctrl)
static inline int vgpr_zero() { return 0; }
static inline unsigned fbits(float f) { unsigned u; memcpy(&u, &f, 4); return u; }
static inline float bitsf(unsigned u) { float f; memcpy(&f, &u, 4); return f; }
#else
#define LAS __attribute__((address_space(3)))
typedef short bf16x8 __attribute__((ext_vector_type(8)));
typedef float f32x4 __attribute__((ext_vector_type(4)));
typedef unsigned u32x4 __attribute__((ext_vector_type(4)));
#define DYN_LDS(name) extern __shared__ __attribute__((aligned(16))) unsigned char name##_raw[]; LAS unsigned char* name = (LAS unsigned char*)name##_raw
#define ASM_WAIT_V(n) asm volatile("s_waitcnt vmcnt(" #n ")" ::: "memory")
#define ASM_WAIT_L(n) asm volatile("s_waitcnt lgkmcnt(" #n ")" ::: "memory")
#define ASM_WAIT_VL0() asm volatile("s_waitcnt vmcnt(0) lgkmcnt(0)" ::: "memory")
#define CFENCE() asm volatile("" ::: "memory")
#define WAVE_LDS_FENCE() asm volatile("s_waitcnt lgkmcnt(0)" ::: "memory")
#define S_BARRIER() __builtin_amdgcn_s_barrier()
#define SCHED_BARRIER() __builtin_amdgcn_sched_barrier(0)
#define SETPRIO(x) __builtin_amdgcn_s_setprio(x)
#define S_SLEEP(n) __builtin_amdgcn_s_sleep(n)
#define MFMA16(a, b, c) __builtin_amdgcn_mfma_f32_16x16x32_bf16(a, b, c, 0, 0, 0)
#define GLDS16(gptr, lptr) __builtin_amdgcn_global_load_lds((const unsigned*)(gptr), (LAS unsigned*)(lptr), 16, 0, 0)
#define READFIRSTLANE(x) __builtin_amdgcn_readfirstlane(x)
#define XCC_ID_() ((unsigned)__builtin_amdgcn_s_getreg((3 << 11) | 20) & 0xFu)
#define FENCE_RELEASE() __builtin_amdgcn_fence(__ATOMIC_RELEASE, "agent")
#define FENCE_ACQUIRE() __builtin_amdgcn_fence(__ATOMIC_ACQUIRE, "agent")
#define DPP_F(v, ctrl) __builtin_bit_cast(float, __builtin_amdgcn_update_dpp(0, __builtin_bit_cast(int, (float)(v)), (ctrl), 0xF, 0xF, true))
__device__ __forceinline__ int vgpr_zero() { int z; asm volatile("v_mov_b32 %0, 0" : "=v"(z)); return z; }
__device__ __forceinline__ unsigned fbits(float f) { return __builtin_bit_cast(unsigned, f); }
__device__ __forceinline__ float bitsf(unsigned u) { return __builtin_bit_cast(float, u); }
#endif
typedef unsigned short bf16;
#define RLX_AGENT __ATOMIC_RELAXED, __HIP_MEMORY_SCOPE_AGENT

__device__ __forceinline__ unsigned f2bf(float f) { unsigned u = fbits(f); return (u + 0x7fffu + ((u >> 16) & 1u)) >> 16; }
__device__ __forceinline__ unsigned pk2(float lo, float hi) { return f2bf(lo) | (f2bf(hi) << 16); }
__device__ __forceinline__ float bf2f(bf16 b) { return bitsf(((unsigned)b) << 16); }
__device__ __forceinline__ float bflo(unsigned w) { return bitsf(w << 16); }
__device__ __forceinline__ float bfhi(unsigned w) { return bitsf(w & 0xffff0000u); }
__device__ __forceinline__ float sigmoidf_(float x) { return 1.0f / (1.0f + expf(-x)); }
__device__ __forceinline__ float wave_sum(float v) {
#pragma unroll
    for (int o = 1; o < 64; o <<= 1) v += __shfl_xor(v, o);
    return v;
}
__device__ __forceinline__ float row16_sum(float v) {
    v += DPP_F(v, 0xB1);
    v += DPP_F(v, 0x4E);
    v += DPP_F(v, 0x141);
    v += DPP_F(v, 0x140);
    return v;
}
__device__ __forceinline__ void sincos_f(float x, float& s, float& c) {
    const float k = rintf(x * 0.63661977236758134f);
    float r = fmaf(-k, 1.5703125f, x); r = fmaf(-k, 4.837512969970703125e-4f, r); r = fmaf(-k, 7.54978994989188216e-8f, r);
    const float r2 = r * r;
    const float sp = r + r * r2 * (-1.6666654611e-1f + r2 * (8.3321608736e-3f + r2 * (-1.9515295891e-4f)));
    const float cp = 1.0f - 0.5f * r2 + r2 * r2 * (4.166664568298827e-2f + r2 * (-1.388731625493765e-3f + r2 * (2.443315711809948e-5f)));
    const int q = ((int)k) & 3;
    s = (q == 0) ? sp : (q == 1) ? cp : (q == 2) ? -sp : -cp;
    c = (q == 0) ? cp : (q == 1) ? -sp : (q == 2) ? -cp : sp;
}
__device__ __forceinline__ float sin_f(float x) { float s, c; sincos_f(x, s, c); return s; }

#define XB_TMO      128
#define XB_XCNT(j)  (256  + 64 * (j))
#define XB_XSUB(j)  (1280 + 64 * (j))
#define XB_XGEN(j)  (2304 + 64 * (j))
#define XB_TOP      3328
#define XB_TOPGEN   3392
#define XCD_BAR_WORDS 3456
#define XB_SPIN_CAP (1u << 18)
__device__ __forceinline__ unsigned xb_ld(unsigned* p)              { return __hip_atomic_load(p, __ATOMIC_RELAXED, __HIP_MEMORY_SCOPE_AGENT); }
__device__ __forceinline__ unsigned xb_add(unsigned* p, unsigned v) { return __hip_atomic_fetch_add(p, v, __ATOMIC_RELAXED, __HIP_MEMORY_SCOPE_AGENT); }
#define XB_SPIN(cond, bar) do { unsigned _sp = 0; while (cond) { S_SLEEP(1); \
    if ((++_sp & 255u) == 0u) { if (xb_ld(&(bar)[XB_TMO])) break; if (_sp > XB_SPIN_CAP) { atomicAdd(&(bar)[XB_TMO], 1u); break; } } } } while (0)
struct XcdBarrier { unsigned* bar; unsigned x; volatile LAS unsigned* st; };
__device__ __forceinline__ XcdBarrier xcd_barrier_post(unsigned* bar, volatile LAS unsigned* st) {
    XcdBarrier b; b.bar = bar; b.x = XCC_ID_(); b.st = st;
    if (threadIdx.x == 0) (void)xb_add(&bar[XB_XCNT(b.x)], 1u);
    return b;
}
__device__ __forceinline__ void xcd_barrier_complete(unsigned* bar, unsigned x, unsigned& nloc, unsigned& nx) {
    const unsigned G = gridDim.x * gridDim.y * gridDim.z;
    unsigned sum, cnt, mine, sp = 0u;
    for (;;) {
        sum = 0u; cnt = 0u; mine = 0u;
#pragma unroll
        for (unsigned j = 0; j < 16; ++j) { const unsigned c = xb_ld(&bar[XB_XCNT(j)]); sum += c; cnt += (c > 0u) ? 1u : 0u; mine = (j == x) ? c : mine; }
        if (sum == G) break;
        S_SLEEP(1);
        if ((++sp & 255u) == 0u) { if (xb_ld(&bar[XB_TMO])) break; if (sp > XB_SPIN_CAP) { atomicAdd(&bar[XB_TMO], 1u); break; } }
    }
    nloc = mine > 0u ? mine : 1u; nx = cnt > 0u ? cnt : 1u;
}
__device__ __forceinline__ void xcd_barrier(const XcdBarrier& b) {
    ASM_WAIT_V(0);
    __syncthreads();
    if (threadIdx.x == 0) {
        unsigned* bar = b.bar;
        ASM_WAIT_VL0();
        unsigned nloc = b.st[0], nx = b.st[1];
        if (nloc == 0u) { xcd_barrier_complete(bar, b.x, nloc, nx); b.st[0] = nloc; b.st[1] = nx; }
        const unsigned old = xb_add(&bar[XB_XSUB(b.x)], 1u);
        const unsigned gen = old / nloc;
        if (old + 1u == (gen + 1u) * nloc) {
            FENCE_RELEASE();
            ASM_WAIT_V(0);
            const unsigned og = xb_add(&bar[XB_TOP], 1u);
            const unsigned tg = og / nx;
            if (og + 1u == (tg + 1u) * nx) xb_add(&bar[XB_TOPGEN], 1u);
            else XB_SPIN(xb_ld(&bar[XB_TOPGEN]) == tg, bar);
            FENCE_ACQUIRE();
            xb_add(&bar[XB_XGEN(b.x)], 1u);
            ASM_WAIT_V(0);
        } else {
            XB_SPIN(xb_ld(&bar[XB_XGEN(b.x)]) == gen, bar);
            FENCE_ACQUIRE();
            ASM_WAIT_V(0);
        }
    }
    __syncthreads();
}

namespace pg8 {
constexpr int BM = 256, BK = 64, HALF = 128, HTB = HALF * BK * 2, STAGE_BYTES = 8 * HTB, NXCD = 8, WGM = 8;
__host__ __device__ __forceinline__ int lds_byte(int r, int c) { const int st = (r >> 4) * 2 + (c >> 5), rr = r & 15, cc = c & 31, ob = rr * 64 + cc * 2; return st * 1024 + (ob ^ (((ob >> 9) & 1) << 5)); }
__host__ __device__ __forceinline__ void stage_rc(int b, int& R, int& C) { const int st = b / 1024, sb = b % 1024, swz = sb ^ (((sb >> 9) & 1) << 5); R = (st >> 1) * 16 + swz / 64; C = (st & 1) * 32 + (swz % 64) / 2; }
__host__ __device__ __forceinline__ int perm32(int rho) { const int n = rho >> 4, i = rho & 15; return 8 * (i >> 2) + 4 * n + (i & 3); }
struct Unit { int pm, pn; };
struct Gemm { const bf16* A; const bf16* Bt; int K; };
struct StaticOrder {
    int nM, nN, nwg, G, c;
    __host__ __device__ void init(int M_, int N_, int G_, int c_) { nM = M_ / BM; nN = N_ / BM; nwg = nM * nN; G = G_; c = c_; }
    __host__ __device__ bool next(int i, Unit& u) const {
        const long L = (long)i * G + c; if (L >= nwg) return false;
        int wgid = (int)L; { const int q = nwg / NXCD, r = nwg % NXCD, xcd = wgid % NXCD, off = wgid / NXCD; wgid = (xcd < r ? xcd * (q + 1) : r * (q + 1) + (xcd - r) * q) + off; }
        const int nig = WGM * nN, gid = wgid / nig, fm = gid * WGM, gsz = (nM - fm) < WGM ? (nM - fm) : WGM;
        u.pm = fm + ((wgid % nig) % gsz); u.pn = (wgid % nig) / gsz; return true;
    }
};
struct MoeOrder {
    const volatile LAS int* tab; int NT, G, c;
    __device__ __forceinline__ bool next(int i, Unit& u) const {
        const long L = (long)i * G + c; if (L >= tab[16]) return false;
        int e = 0; while (L >= tab[e + 1]) ++e;
        const int loc = (int)L - tab[e], tc = tab[64 + e];
        u.pm = tab[32 + e] + loc % tc; u.pn = e * NT + loc / tc; return true;
    }
};
__device__ __forceinline__ unsigned cvt_pk_bf16(float lo, float hi) {
#ifdef EMU
    return pk2(lo, hi);
#else
    unsigned r; asm volatile("v_cvt_pk_bf16_f32 %0, %1, %2" : "=v"(r) : "v"(lo), "v"(hi)); return r;
#endif
}

struct EpiBf16 {
    static constexpr bool PERM = true;
    bf16* O; int ldc;
    __device__ __forceinline__ void operator()(const f32x4 (&acc)[2][2][4][2], const Unit& u, int wr, int wc, int fr, int fq) const {
        const int row0 = u.pm * BM + wr * 64 + fr, col0 = u.pn * BM + wc * 32 + 8 * fq;
#pragma unroll
        for (int ai = 0; ai < 2; ++ai)
#pragma unroll
            for (int m = 0; m < 4; ++m) { bf16* rowp = O + (size_t)(row0 + ai * HALF + m * 16) * ldc + col0;
#pragma unroll
                for (int bj = 0; bj < 2; ++bj) { const f32x4 v0 = acc[ai][bj][m][0], v1 = acc[ai][bj][m][1];
                    u32x4 w; w[0] = cvt_pk_bf16(v0[0], v0[1]); w[1] = cvt_pk_bf16(v0[2], v0[3]); w[2] = cvt_pk_bf16(v1[0], v1[1]); w[3] = cvt_pk_bf16(v1[2], v1[3]);
                    *(u32x4*)(rowp + bj * HALF) = w; } }
    }
};
struct EpiF32 {
    static constexpr bool PERM = false;
    float* C; int ldc;
    __device__ __forceinline__ void operator()(const f32x4 (&acc)[2][2][4][2], const Unit& u, int wr, int wc, int fr, int fq) const {
        const int row0 = u.pm * BM + wr * 64 + fr, col0 = u.pn * BM + wc * 32 + 4 * fq;
#pragma unroll
        for (int ai = 0; ai < 2; ++ai)
#pragma unroll
            for (int m = 0; m < 4; ++m) { float* rowp = C + (size_t)(row0 + ai * HALF + m * 16) * ldc + col0;
#pragma unroll
                for (int bj = 0; bj < 2; ++bj)
#pragma unroll
                    for (int n = 0; n < 2; ++n) *(f32x4*)(rowp + bj * HALF + n * 16) = acc[ai][bj][m][n]; }
    }
};
struct EpiGate {
    static constexpr bool PERM = true;
    bf16* T; int ldc; const bf16* Pg; int ldp; int gcol0; bool ADD;
    __device__ __forceinline__ void operator()(const f32x4 (&acc)[2][2][4][2], const Unit& u, int wr, int wc, int fr, int fq) const {
        const int row0 = u.pm * BM + wr * 64 + fr, col0 = u.pn * BM + wc * 32 + 8 * fq;
#pragma unroll
        for (int ai = 0; ai < 2; ++ai)
#pragma unroll
            for (int m = 0; m < 4; ++m) { const size_t row = (size_t)(row0 + ai * HALF + m * 16);
#pragma unroll
                for (int bj = 0; bj < 2; ++bj) { const f32x4 v0 = acc[ai][bj][m][0], v1 = acc[ai][bj][m][1];
                    const u32x4 g = *(const u32x4*)(Pg + row * ldp + gcol0 + col0 + bj * HALF);
                    u32x4 t = {0u, 0u, 0u, 0u}; if (ADD) t = *(const u32x4*)(T + row * ldc + col0 + bj * HALF);
                    float o[8];
#pragma unroll
                    for (int j = 0; j < 4; ++j) { const float a0 = j < 2 ? v0[2 * j] : v1[2 * j - 4], a1 = j < 2 ? v0[2 * j + 1] : v1[2 * j - 3];
                        o[2 * j] = bflo(t[j]) + sigmoidf_(bflo(g[j])) * a0; o[2 * j + 1] = bfhi(t[j]) + sigmoidf_(bfhi(g[j])) * a1; }
                    u32x4 w; w[0] = cvt_pk_bf16(o[0], o[1]); w[1] = cvt_pk_bf16(o[2], o[3]); w[2] = cvt_pk_bf16(o[4], o[5]); w[3] = cvt_pk_bf16(o[6], o[7]);
                    *(u32x4*)(T + row * ldc + col0 + bj * HALF) = w; } }
    }
};
struct EpiSwiglu {
    static constexpr bool PERM = true;
    bf16* O; int ldc; int NT;
    __device__ __forceinline__ void operator()(const f32x4 (&acc)[2][2][4][2], const Unit& u, int wr, int wc, int fr, int fq) const {
        const int row0 = u.pm * BM + wr * 64 + fr, col0 = (u.pn % NT) * HALF + wc * 32 + 8 * fq;
#pragma unroll
        for (int ai = 0; ai < 2; ++ai)
#pragma unroll
            for (int m = 0; m < 4; ++m) { bf16* rowp = O + (size_t)(row0 + ai * HALF + m * 16) * ldc + col0;
                float o[8];
#pragma unroll
                for (int j = 0; j < 8; ++j) { const float g = acc[ai][0][m][j >> 2][j & 3], uu = acc[ai][1][m][j >> 2][j & 3]; o[j] = g / (1.0f + expf(-g)) * uu; }
                u32x4 w; w[0] = cvt_pk_bf16(o[0], o[1]); w[1] = cvt_pk_bf16(o[2], o[3]); w[2] = cvt_pk_bf16(o[4], o[5]); w[3] = cvt_pk_bf16(o[6], o[7]);
                *(u32x4*)rowp = w; }
    }
};
struct EpiMoeDown {
    static constexpr bool PERM = true;
    bf16* O; int ldc; int NT;
    __device__ __forceinline__ void operator()(const f32x4 (&acc)[2][2][4][2], const Unit& u, int wr, int wc, int fr, int fq) const {
        const int row0 = u.pm * BM + wr * 64 + fr, col0 = (u.pn % NT) * BM + wc * 32 + 8 * fq;
#pragma unroll
        for (int ai = 0; ai < 2; ++ai)
#pragma unroll
            for (int m = 0; m < 4; ++m) { bf16* rowp = O + (size_t)(row0 + ai * HALF + m * 16) * ldc + col0;
#pragma unroll
                for (int bj = 0; bj < 2; ++bj) { const f32x4 v0 = acc[ai][bj][m][0], v1 = acc[ai][bj][m][1];
                    u32x4 w; w[0] = cvt_pk_bf16(v0[0], v0[1]); w[1] = cvt_pk_bf16(v0[2], v0[3]); w[2] = cvt_pk_bf16(v1[0], v1[1]); w[3] = cvt_pk_bf16(v1[2], v1[3]);
                    *(u32x4*)(rowp + bj * HALF) = w; } }
    }
};

template <class Epi, class Sched>
__device__ __forceinline__ void gemm_phase(LAS unsigned char* lds, const Gemm g, const Sched& S, const Epi& E) {
    const int tid = threadIdx.x, wid = READFIRSTLANE(tid >> 6), lane = tid & 63, wr = wid >> 2, wc = wid & 3, fr = lane & 15, fq = lane >> 4;
    const int K = g.K, nt = K / BK;
    unsigned voffA[2], voffB[2];
#pragma unroll
    for (int i = 0; i < 2; ++i) { int R, C; stage_rc(tid * 16 + i * 8192, R, C); const int Rb = Epi::PERM ? ((R & ~31) + perm32(R & 31)) : R;
        voffA[i] = (unsigned)(R * K + C) * 2u; voffB[i] = (unsigned)(Rb * K + C) * 2u; }
    const size_t kstep = (size_t)(BK * 2);
    const size_t hstep = (size_t)HALF * K * 2;
    const size_t tstep = 2 * hstep;
    const unsigned ldsw = (unsigned)wid * 1024u;
    const int aoff = lds_byte(wr * 64 + fr, fq * 8), boff = lds_byte(wc * 32 + fr, fq * 8);
#define PG8_SA(b, h) (((b) * 2 + (h)) * HTB)
#define PG8_SB(b, h) ((4 + (b) * 2 + (h)) * HTB)
#define PG8_STAGE(bufoff, gbase, voff) do { _Pragma("unroll") for (int _i = 0; _i < 2; ++_i) \
        GLDS16((const char*)(gbase) + (voff)[_i], lds + (bufoff) + ldsw + _i * 8192); } while (0)
#define PG8_LDA(dst, b, h) do { _Pragma("unroll") for (int m = 0; m < 4; ++m) _Pragma("unroll") for (int k = 0; k < 2; ++k) dst[m][k] = *(const LAS bf16x8*)(lds + PG8_SA(b, h) + aoff + m * 2048 + k * 1024); } while (0)
#define PG8_LDB(dst, b, h) do { _Pragma("unroll") for (int n = 0; n < 2; ++n) _Pragma("unroll") for (int k = 0; k < 2; ++k) dst[n][k] = *(const LAS bf16x8*)(lds + PG8_SB(b, h) + boff + n * 2048 + k * 1024); } while (0)
#define PG8_MMA(ai, bj, At, Bt) do { SETPRIO(1); _Pragma("unroll") for (int m = 0; m < 4; ++m) _Pragma("unroll") for (int n = 0; n < 2; ++n) _Pragma("unroll") for (int k = 0; k < 2; ++k) \
        acc[ai][bj][m][n] = MFMA16(Bt[n][k], At[m][k], acc[ai][bj][m][n]); SETPRIO(0); } while (0)
#define PG8_BAR S_BARRIER()
    Unit cur, nxt; int ui = 0;
    if (!S.next(0, cur)) return;
    f32x4 acc[2][2][4][2];
#pragma unroll
    for (int a = 0; a < 2; ++a)
#pragma unroll
        for (int b = 0; b < 2; ++b)
#pragma unroll
            for (int m = 0; m < 4; ++m)
#pragma unroll
                for (int n = 0; n < 2; ++n) acc[a][b][m][n] = (f32x4){0.f, 0.f, 0.f, 0.f};
    bf16x8 At[4][2], B0[2][2], B1[2][2];
    const char* cA = (const char*)g.A + (size_t)cur.pm * tstep; const char* cB = (const char*)g.Bt + (size_t)cur.pn * tstep;
    PG8_STAGE(PG8_SB(0, 0), cB, voffB); PG8_STAGE(PG8_SA(0, 0), cA, voffA); PG8_STAGE(PG8_SB(0, 1), cB + hstep, voffB); PG8_STAGE(PG8_SA(0, 1), cA + hstep, voffA);
    if (wr == 1) PG8_BAR;
    ASM_WAIT_V(4); PG8_BAR;
    PG8_STAGE(PG8_SB(1, 0), cB + kstep, voffB); PG8_STAGE(PG8_SA(1, 0), cA + kstep, voffA); PG8_STAGE(PG8_SB(1, 1), cB + hstep + kstep, voffB);
    ASM_WAIT_V(6); PG8_BAR;
    for (;;) {
        const bool has_next = S.next(ui + 1, nxt);
        const char* nA = has_next ? (const char*)g.A + (size_t)nxt.pm * tstep : cA; const char* nB = has_next ? (const char*)g.Bt + (size_t)nxt.pn * tstep : cB;
        for (int t = 0; t < nt; t += 2) {
            const bool last = (t == nt - 2);
            const char* a1 = cA + (size_t)(t + 1) * kstep;
            const char* a2 = last ? nA : cA + (size_t)(t + 2) * kstep; const char* b2 = last ? nB : cB + (size_t)(t + 2) * kstep;
            const char* a3 = a2 + kstep; const char* b3 = b2 + kstep;
            PG8_LDB(B0, 0, 0); SCHED_BARRIER(); PG8_LDA(At, 0, 0); PG8_STAGE(PG8_SA(1, 1), a1 + hstep, voffA);
            ASM_WAIT_L(8); PG8_BAR; ASM_WAIT_L(0); PG8_MMA(0, 0, At, B0); PG8_BAR; SCHED_BARRIER();
            PG8_LDB(B1, 0, 1); PG8_STAGE(PG8_SB(0, 0), b2, voffB);
            PG8_BAR; ASM_WAIT_L(0); PG8_MMA(0, 1, At, B1); PG8_BAR;
            PG8_LDA(At, 0, 1); PG8_STAGE(PG8_SA(0, 0), a2, voffA);
            PG8_BAR; ASM_WAIT_L(0); PG8_MMA(1, 0, At, B0); PG8_BAR; SCHED_BARRIER();
            PG8_STAGE(PG8_SB(0, 1), b2 + hstep, voffB);
            ASM_WAIT_V(6); PG8_BAR; PG8_MMA(1, 1, At, B1); PG8_BAR;
            PG8_LDB(B0, 1, 0); SCHED_BARRIER(); PG8_LDA(At, 1, 0); PG8_STAGE(PG8_SA(0, 1), a2 + hstep, voffA);
            ASM_WAIT_L(8); PG8_BAR; ASM_WAIT_L(0); PG8_MMA(0, 0, At, B0); PG8_BAR; SCHED_BARRIER();
            PG8_LDB(B1, 1, 1); PG8_STAGE(PG8_SB(1, 0), b3, voffB);
            PG8_BAR; ASM_WAIT_L(0); PG8_MMA(0, 1, At, B1); PG8_BAR;
            PG8_LDA(At, 1, 1); PG8_STAGE(PG8_SA(1, 0), a3, voffA);
            PG8_BAR; ASM_WAIT_L(0); PG8_MMA(1, 0, At, B0); PG8_BAR; SCHED_BARRIER();
            PG8_STAGE(PG8_SB(1, 1), b3 + hstep, voffB);
            ASM_WAIT_V(6); PG8_BAR; PG8_MMA(1, 1, At, B1); PG8_BAR;
        }
        E(acc, cur, wr, wc, fr, fq);
        if (!has_next) break;
#pragma unroll
        for (int a = 0; a < 2; ++a)
#pragma unroll
            for (int b = 0; b < 2; ++b)
#pragma unroll
                for (int m = 0; m < 4; ++m)
#pragma unroll
                    for (int n = 0; n < 2; ++n) acc[a][b][m][n] = (f32x4){0.f, 0.f, 0.f, 0.f};
        cur = nxt; cA = nA; cB = nB; ++ui;
    }
    ASM_WAIT_V(0);
    if (wr == 0) PG8_BAR;
    PG8_BAR;
#undef PG8_SA
#undef PG8_SB
#undef PG8_STAGE
#undef PG8_LDA
#undef PG8_LDB
#undef PG8_MMA
#undef PG8_BAR
}
}

struct Args { const float* in[N_IN]; float* out; unsigned char* ws; int ph_lo, ph_hi; };
constexpr int NWAVES = 8, NTHR = 512;
constexpr int LDS_STAGE = 131072, LDS_MISC = LDS_STAGE, LDS_BYTES = 147456;

constexpr int PT_OUT = N_IN, PT_WS = N_IN + 1, PT_WORD0 = 128;
struct Ctx {
    LAS unsigned char* lds; int tid, lane, wave, G, bid;
    __device__ __forceinline__ unsigned long long ptr(int i) const { const volatile LAS unsigned* t = (const volatile LAS unsigned*)(lds + LDS_MISC) + PT_WORD0 + 2 * i;
        const unsigned lo = (unsigned)READFIRSTLANE((int)t[0]), hi = (unsigned)READFIRSTLANE((int)t[1]); return ((unsigned long long)hi << 32) | lo; }
    __device__ __forceinline__ unsigned long long ptrv(int i) const { const volatile LAS unsigned* t = (const volatile LAS unsigned*)(lds + LDS_MISC) + PT_WORD0 + 2 * i; return ((unsigned long long)t[1] << 32) | t[0]; }
    __device__ __forceinline__ const float* inv(int i) const { return (const float*)ptrv(i); }
    template <class T> __device__ __forceinline__ T* wsv(size_t off) const { return (T*)((unsigned char*)ptrv(PT_WS) + off); }
    __device__ __forceinline__ const float* in(int i) const { return (const float*)ptr(i); }
    __device__ __forceinline__ float* out() const { return (float*)ptr(PT_OUT); }
    template <class T> __device__ __forceinline__ T* ws(size_t off) const { return (T*)((unsigned char*)ptr(PT_WS) + off); }
    __device__ __forceinline__ unsigned* ctl() const { return (unsigned*)ptr(PT_WS); }
};

__device__ __forceinline__ void transpose_item(const float* W, int ldw, int k0, int n0, int nvalid, bf16* outp, int ldo, LAS float* scr, int lane) {
#pragma unroll 8
    for (int i = 0; i < 32; ++i) { const int kk = 2 * i + (lane >> 5), n = n0 + (lane & 31); scr[kk * 33 + (lane & 31)] = (n < nvalid) ? W[(size_t)(k0 + kk) * ldw + n] : 0.f; }
    WAVE_LDS_FENCE(); CFENCE();
    const int c = lane & 7;
#pragma unroll
    for (int j = 0; j < 4; ++j) { const int n = (lane >> 3) + 8 * j; const LAS float* s = scr + (8 * c) * 33 + n;
        u32x4 o; o[0] = pk2(s[0 * 33], s[1 * 33]); o[1] = pk2(s[2 * 33], s[3 * 33]); o[2] = pk2(s[4 * 33], s[5 * 33]); o[3] = pk2(s[6 * 33], s[7 * 33]);
        *(u32x4*)(outp + (size_t)n * ldo + k0 + 8 * c) = o; }
    WAVE_LDS_FENCE(); CFENCE();
}
__device__ __forceinline__ void filter_item(const Ctx& X, int l, int n, int pos0, float* out  , LAS float* scr  , LAS float* asum  ) {
    const int lane = X.lane;
    LAS float* zs = scr; LAS float* ha = scr + 8 * 33; LAS float* hb = ha + 8 * 64;
    const float* w1 = X.in(I_FW1) + (size_t)l * 33 * 64; const float* b1 = X.in(I_FB1) + l * 64;
    const float* w2 = X.in(I_FW2) + (size_t)l * 64 * 64; const float* b2 = X.in(I_FB2) + l * 64;
    const float* w3 = X.in(I_FW3) + (size_t)l * 64 * 64; const float* b3 = X.in(I_FB3) + l * 64;
    const float* wo = X.in(I_FWO) + (size_t)l * 64 * HW; const float fr = X.in(I_FREQ)[l * 64 + lane];
    if (lane < 33) {
#pragma unroll
        for (int p = 0; p < 8; ++p) { const int pos = pos0 + p; float v;
            if (lane == 0) v = (float)pos / (float)(n - 1 > 1 ? n - 1 : 1);
            else { const int b = (lane - 1) & 15; const double band = 1e-4 + (double)b * ((15.0 - 1e-4) / 15.0);
                double rev = (double)pos * band / (double)n; rev -= floor(rev); if (rev > 0.5) rev -= 1.0;
                float s, c; sincos_f((float)(rev * 6.283185307179586476925), s, c); v = lane <= 16 ? c : -s; }
            zs[p * 33 + lane] = v; }
    }
    WAVE_LDS_FENCE(); CFENCE();
    float acc[8];
    { const float bb = b1[lane];
#pragma unroll
      for (int p = 0; p < 8; ++p) acc[p] = bb;
#pragma unroll 3
      for (int i = 0; i < 33; ++i) { const float w = w1[i * 64 + lane];
#pragma unroll
          for (int p = 0; p < 8; ++p) acc[p] += zs[p * 33 + i] * w; }
#pragma unroll
      for (int p = 0; p < 8; ++p) ha[p * 64 + lane] = sin_f(fr * acc[p]); }
    WAVE_LDS_FENCE(); CFENCE();
    { const float bb = b2[lane];
#pragma unroll
      for (int p = 0; p < 8; ++p) acc[p] = bb;
#pragma unroll 4
      for (int i = 0; i < 64; ++i) { const float w = w2[i * 64 + lane];
#pragma unroll
          for (int p = 0; p < 8; ++p) acc[p] += ha[p * 64 + i] * w; }
#pragma unroll
      for (int p = 0; p < 8; ++p) hb[p * 64 + lane] = sin_f(fr * acc[p]); }
    WAVE_LDS_FENCE(); CFENCE();
    { const float bb = b3[lane];
#pragma unroll
      for (int p = 0; p < 8; ++p) acc[p] = bb;
#pragma unroll 4
      for (int i = 0; i < 64; ++i) { const float w = w3[i * 64 + lane];
#pragma unroll
          for (int p = 0; p < 8; ++p) acc[p] += hb[p * 64 + i] * w; }
#pragma unroll
      for (int p = 0; p < 8; ++p) ha[p * 64 + lane] = sin_f(fr * acc[p]); }
    WAVE_LDS_FENCE(); CFENCE();
    const float dmin = -3.0701134573253944f, dmax = -15.350567286626972f;
#pragma unroll 1
    for (int mI = 0; mI < HW / 64; ++mI) { const int c = lane + 64 * mI;
#pragma unroll
        for (int p = 0; p < 8; ++p) acc[p] = 0.f;
#pragma unroll 4
        for (int i = 0; i < 64; ++i) { const float w = wo[i * HW + c];
#pragma unroll
            for (int p = 0; p < 8; ++p) acc[p] += ha[p * 64 + i] * w; }
        const float delta = fabsf(dmin + (float)c * ((dmax - dmin) / (float)(HW - 1)));
        float as = 0.f;
#pragma unroll
        for (int p = 0; p < 8; ++p) { const int pos = pos0 + p; const int dd = pos - n / 2; const float dist = (float)(dd < 0 ? -dd : dd) * (2.0f / (float)n);
            const float v = acc[p] * expf(-dist * delta); out[(size_t)c * n + pos] = v; as += fabsf(v); }
        asum[c] += as; }
    WAVE_LDS_FENCE(); CFENCE();
}
__device__ __forceinline__ void phase_transposes(const Ctx& X, int l) {
    LAS float* scr = (LAS float*)(X.lds + X.wave * 16384);
    const int gw = X.bid * NWAVES + X.wave, NGW = X.G * NWAVES, lane = X.lane;
    constexpr int KB_D = D / 64, I_WIN_ = KB_D * (PCP / 32), I_WB_ = 2 * (RW / 64) * (D / 32), I_WO_ = KB_D * (D / 32), I_WGU_ = NE * 2 * KB_D * (D / 32), I_WD_ = NE * KB_D * (D / 32);
    constexpr int NITEMS = I_WIN_ + I_WB_ + I_WO_ + I_WGU_ + I_WD_;
    for (int it = gw; it < NITEMS; it += NGW) {
        int r = it; const float* W; int ldw, k0, n0, nvalid, ldo; bf16* outp;
        if (r < I_WIN_) { const int nb = r % (PCP / 32), kb = r / (PCP / 32); W = X.in(I_WIN) + (size_t)l * D * PC; ldw = PC; k0 = 64 * kb; n0 = 32 * nb; nvalid = PC; outp = X.ws<bf16>(WS_WIN) + (size_t)n0 * D; ldo = D; }
        else if ((r -= I_WIN_) < I_WB_) { const int s = r / ((RW / 64) * (D / 32)), q = r % ((RW / 64) * (D / 32)), nb = q % (D / 32), kb = q / (D / 32);
            W = X.in(I_WBR) + ((size_t)l * 2 + s) * RW * D; ldw = D; k0 = 64 * kb; n0 = 32 * nb; nvalid = D; outp = X.ws<bf16>(WS_WB) + (size_t)s * D * RW + (size_t)n0 * RW; ldo = RW; }
        else if ((r -= I_WB_) < I_WO_) { const int nb = r % (D / 32), kb = r / (D / 32); W = X.in(I_WOUT) + (size_t)l * D * D; ldw = D; k0 = 64 * kb; n0 = 32 * nb; nvalid = D; outp = X.ws<bf16>(WS_WO) + (size_t)n0 * D; ldo = D; }
        else if ((r -= I_WO_) < I_WGU_) { const int per = KB_D * (D / 32), es = r / per, q = r % per, e = es >> 1, src = es & 1, nb = q % (D / 32), kb = q / (D / 32); n0 = 32 * nb;
            W = (src ? X.in(I_WU) : X.in(I_WG)) + ((size_t)l * NE + e) * D * D; ldw = D; k0 = 64 * kb; nvalid = D; const int orow = e * 2 * D + (n0 / 128) * 256 + src * 128 + (n0 % 128);
            outp = X.ws<bf16>(WS_WGU) + (size_t)orow * D; ldo = D; }
        else { r -= I_WGU_; const int per = KB_D * (D / 32), e = r / per, q = r % per, nb = q % (D / 32), kb = q / (D / 32);
            W = X.in(I_WD) + ((size_t)l * NE + e) * D * D; ldw = D; k0 = 64 * kb; n0 = 32 * nb; nvalid = D; outp = X.ws<bf16>(WS_WD) + (size_t)(e * D + n0) * D; ldo = D; }
        transpose_item(W, ldw, k0, n0, nvalid, outp, ldo, scr, lane);
    }
}
__device__ __forceinline__ void phase_filters(const Ctx& X, int l) {
    LAS float* scr = (LAS float*)(X.lds + X.wave * 8192);
    const int gw = X.bid * NWAVES + X.wave, NGW = X.G * NWAVES, lane = X.lane;
    LAS float* part = (LAS float*)(X.lds + 65536);
    static_assert(65536 + NWAVES * 2 * HW * 4 <= LDS_STAGE, "filter LDS map");
    for (int i = lane; i < 2 * HW; i += 64) part[X.wave * 2 * HW + i] = 0.f;
    WAVE_LDS_FENCE(); CFENCE();
    float* filt = X.ws<float>(WS_FILT);
    for (int it = gw; it < SEQ / 8; it += NGW) filter_item(X, l, SEQ, 8 * it, filt, scr, part + (X.wave * 2 + 0) * HW);
    for (int it = gw; it < CTX / 8; it += NGW) filter_item(X, l, CTX, 8 * it, filt + (size_t)HW * SEQ, scr, part + (X.wave * 2 + 1) * HW);
    __syncthreads();
    for (int i = X.tid; i < 2 * HW; i += NTHR) { float s = 0.f;
#pragma unroll
        for (int w = 0; w < NWAVES; ++w) s += part[w * 2 * HW + i];
        X.ws<float>(WS_FPART)[((size_t)(i / HW) * NPART + X.bid) * HW + (i % HW)] = s; }
    __syncthreads();
}
__device__ __forceinline__ void phase_mod(const Ctx& X) {
    const int lane = X.lane;
    LAS float* red = (LAS float*)X.lds;
    constexpr int NIT = DEPTH * (6 * D / 64);
    for (int it = X.bid; it < NIT; it += X.G) {
        const int ll = it / (6 * D / 64), n0 = (it % (6 * D / 64)) * 64;
        const float* W = X.in(I_WMOD) + (size_t)ll * D * 6 * D; const float* cv = X.in(I_C); const float* cc = X.in(I_CCTX);
        float s0 = 0.f, s1 = 0.f;
#pragma unroll 8
        for (int k = X.wave * (D / 8); k < (X.wave + 1) * (D / 8); ++k) { const float wv = W[(size_t)k * 6 * D + n0 + lane]; const float c0 = cv[k], c1 = cc[k];
            s0 += c0 * sigmoidf_(c0) * wv; s1 += c1 * sigmoidf_(c1) * wv; }
        red[(X.wave * 64 + lane) * 2] = s0; red[(X.wave * 64 + lane) * 2 + 1] = s1;
        __syncthreads();
        if (X.wave == 0) { float t0 = 0.f, t1 = 0.f;
#pragma unroll
            for (int w = 0; w < NWAVES; ++w) { t0 += red[(w * 64 + lane) * 2]; t1 += red[(w * 64 + lane) * 2 + 1]; }
            const float bm = X.in(I_BMOD)[(size_t)ll * 6 * D + n0 + lane];
            float* MOD = X.ws<float>(WS_MOD);
            MOD[((size_t)ll * 2 + 0) * 6 * D + n0 + lane] = t0 + bm; MOD[((size_t)ll * 2 + 1) * 6 * D + n0 + lane] = t1 + bm; }
        __syncthreads();
    }
}
__device__ __forceinline__ const float* modp(const Ctx& X, int l, int t, int j) { return X.ws<float>(WS_MOD) + ((size_t)l * 2 + (t < CTX ? 1 : 0)) * 6 * D + (size_t)j * D; }

__device__ __forceinline__ void phase_x0(const Ctx& X) {
    const int gw = X.bid * NWAVES + X.wave, NGW = X.G * NWAVES, lane = X.lane;
    for (int t = gw; t < M; t += NGW) {
        const float* src = t < CTX ? X.in(I_CTX) + (size_t)t * D : X.in(I_X) + (size_t)(t - CTX) * D;
        const float* sh = modp(X, 0, t, 0); const float* sc = modp(X, 0, t, 1);
        float* xr = X.ws<float>(WS_X) + (size_t)t * D; bf16* xm = X.ws<bf16>(WS_XMOD) + (size_t)t * D;
#pragma unroll
        for (int j = 0; j < D / 256; ++j) { const int d = 4 * lane + 256 * j; const f32x4 v = *(const f32x4*)(src + d), a = *(const f32x4*)(sh + d), b = *(const f32x4*)(sc + d);
            *(f32x4*)(xr + d) = v;
            unsigned w0 = pk2(v[0] * (1.f + b[0]) + a[0], v[1] * (1.f + b[1]) + a[1]), w1 = pk2(v[2] * (1.f + b[2]) + a[2], v[3] * (1.f + b[3]) + a[3]);
            *(unsigned long long*)(xm + d) = (unsigned long long)w0 | ((unsigned long long)w1 << 32); }
    }
}

__device__ __forceinline__ int shift_row(int t, int col, bool& valid) {
    const bool isctx = t < CTX;
    const int i = t - CTX, gx = i & (GRID_W - 1), gy = i / GRID_W, q = col / QTR;
    const int offl = (q == 0) ? -1 : (q == 1) ? 1 : (q == 2) ? -GRID_W : GRID_W;
    const bool vl = (q == 0) ? (gx > 0) : (q == 1) ? (gx < GRID_W - 1) : (q == 2) ? (gy > 0) : (gy < GRID_H - 1);
    const bool first = col < HALFC;
    const int offc = first ? -1 : 1; const bool vc = first ? (t > 0) : (t < CTX - 1);
    valid = isctx ? vc : vl;
    return valid ? t + (isctx ? offc : offl) : t;
}
__device__ __forceinline__ float pm_val(const bf16* P, const float* mu, int t, int col) {
    const float p0 = bf2f(P[(size_t)t * PCP + col]); bool valid; const int nr = shift_row(t, col, valid);
    const float pn = bf2f(P[(size_t)nr * PCP + col]); const float p1 = valid ? pn : 0.f;
    return p0 + (p1 - p0) * mu[col];
}
constexpr int TT = 8;
__device__ __forceinline__ void phase_prep_a(const Ctx& X, int l, int t0) {
    const bf16* P = X.wsv<bf16>(WS_P); const float* mu = X.inv(I_MU) + (size_t)l * RC;
    LAS float* S = (LAS float*)X.lds;
    const int c = X.tid;
    const float* w2 = X.inv(I_W2) + (size_t)l * 2 * 64 * RW; const float* a2 = X.inv(I_A2) + (size_t)l * 2 * 64 * RW; const float* g2 = X.inv(I_G2) + (size_t)l * 128 * RW;
        for (int idx = X.tid; idx < TT * 384; idx += NTHR) { const int tt = idx / 384, j = idx % 384; float v = pm_val(P, mu, t0 + tt, C_LWF + j);
            if (j < 128) v = tanhf(v); else if (j >= 256) v = sigmoidf_(v);
            S[j * TT + tt] = v; }
        __syncthreads();
        if (c < RW) {
            float aw0[TT], aw1[TT], aa0[TT], aa1[TT], ag[TT];
#pragma unroll
            for (int tt = 0; tt < TT; ++tt) { aw0[tt] = 0.f; aw1[tt] = 0.f; aa0[tt] = 0.f; aa1[tt] = 0.f; ag[tt] = 0.f; }
            for (int r = 0; r < 64; ++r) { const float wf = w2[(size_t)r * RW + c], wb = w2[(size_t)(64 + r) * RW + c], af = a2[(size_t)r * RW + c], ab = a2[(size_t)(64 + r) * RW + c];
#pragma unroll
                for (int tt = 0; tt < TT; ++tt) { aw0[tt] += S[r * TT + tt] * wf; aw1[tt] += S[(64 + r) * TT + tt] * wb; aa0[tt] += S[(128 + r) * TT + tt] * af; aa1[tt] += S[(192 + r) * TT + tt] * ab; } }
            for (int j = 0; j < 128; ++j) { const float gv = g2[(size_t)j * RW + c];
#pragma unroll
                for (int tt = 0; tt < TT; ++tt) ag[tt] += S[(256 + j) * TT + tt] * gv; }
            LAS float* AC = S + 384 * TT;
#pragma unroll
            for (int tt = 0; tt < TT; ++tt) { AC[(0 * TT + tt) * RW + c] = aw0[tt]; AC[(1 * TT + tt) * RW + c] = aw1[tt]; AC[(2 * TT + tt) * RW + c] = aa0[tt]; AC[(3 * TT + tt) * RW + c] = aa1[tt]; AC[(4 * TT + tt) * RW + c] = ag[tt]; }
        }
    __syncthreads();
}
__device__ __forceinline__ void phase_prep_b(const Ctx& X, int l, int t0) {
    const bf16* P = X.wsv<bf16>(WS_P); const float* mu = X.inv(I_MU) + (size_t)l * RC;
    LAS float* S = (LAS float*)X.lds;
    const int c = X.tid;
    const float* w2 = X.inv(I_W2) + (size_t)l * 2 * 64 * RW; const float* a2 = X.inv(I_A2) + (size_t)l * 2 * 64 * RW; const float* g2 = X.inv(I_G2) + (size_t)l * 128 * RW;
        CFENCE();
        if (c < RW) {
            const LAS float* AC = S + 384 * TT;
            const float w00 = X.inv(I_W0)[(size_t)(l * 2 + 0) * RW + c], w01 = X.inv(I_W0)[(size_t)(l * 2 + 1) * RW + c];
            const float a00 = X.inv(I_A0)[(size_t)(l * 2 + 0) * RW + c], a01 = X.inv(I_A0)[(size_t)(l * 2 + 1) * RW + c];
            const float kkc = X.inv(I_KK)[(size_t)l * RW + c], kac = X.inv(I_KA)[(size_t)l * RW + c], rkc = X.inv(I_RK)[(size_t)l * RW + c];
            const int vz = vgpr_zero();
#pragma unroll 1
            for (int tt = 0; tt < TT; ++tt) { const int t = t0 + tt + vz;
                const float r = pm_val(P, mu, t, c), k = pm_val(P, mu, t, C_K + c), v = pm_val(P, mu, t, C_V + c);
                const float wd0 = -DECAY_SCALE * sigmoidf_(w00 + AC[(0 * TT + tt) * RW + c]), wd1 = -DECAY_SCALE * sigmoidf_(w01 + AC[(1 * TT + tt) * RW + c]);
                const float ad0 = sigmoidf_(a00 + AC[(2 * TT + tt) * RW + c]), ad1 = sigmoidf_(a01 + AC[(3 * TT + tt) * RW + c]);
                const float kkr = k * kkc; const float n2 = wave_sum(kkr * kkr); const float kk = kkr / fmaxf(sqrtf(n2), 1e-12f);
                const float kd0 = k * (1.f + (ad0 - 1.f) * kac), kd1 = k * (1.f + (ad1 - 1.f) * kac);
                const float bon = wave_sum(r * (kd0 + kd1) * rkc);
                const size_t o = (size_t)t * RW + c, o1 = (size_t)(M + t) * RW + c;
                X.wsv<bf16>(WS_R)[o] = (bf16)f2bf(r); X.wsv<bf16>(WS_V)[o] = (bf16)f2bf(v); X.wsv<bf16>(WS_KA)[o] = (bf16)f2bf(-kk);
                X.wsv<bf16>(WS_KD)[o] = (bf16)f2bf(kd0); X.wsv<bf16>(WS_KD)[o1] = (bf16)f2bf(kd1);
                X.wsv<bf16>(WS_KB)[o] = (bf16)f2bf(kk * ad0); X.wsv<bf16>(WS_KB)[o1] = (bf16)f2bf(kk * ad1);
                X.wsv<float>(WS_W)[o] = wd0; X.wsv<float>(WS_W)[o1] = wd1;
                X.wsv<bf16>(WS_GATE)[o] = (bf16)f2bf(AC[(4 * TT + tt) * RW + c]);
                if (X.lane == 0) X.wsv<float>(WS_BONUS)[(size_t)t * NH + (c >> 6)] = bon; }
        }
        __syncthreads();
}
__device__ __forceinline__ void phase_prep_hyena(const Ctx& X, int l) {
    const bf16* P = X.ws<bf16>(WS_P); const int c = X.tid;
    for (int tile = X.bid; tile < M / TT; tile += X.G) {
        const int t0 = tile * TT;
        if (c < HW) {
            const float* cw = X.in(I_CW) + (size_t)l * 3 * HC; const float* cb = X.in(I_CB) + (size_t)l * HC;
            for (int tt = 0; tt < TT; ++tt) { const int t = t0 + tt; const bool hp = (t != 0 && t != CTX), hn = (t != CTX - 1 && t != M - 1);
                float u[3];
#pragma unroll
                for (int j = 0; j < 3; ++j) { const int hc = j * HW + c, col = C_HY + hc;
                    const float pc = bf2f(P[(size_t)t * PCP + col]), pp = hp ? bf2f(P[(size_t)(t - 1) * PCP + col]) : 0.f, pn = hn ? bf2f(P[(size_t)(t + 1) * PCP + col]) : 0.f;
                    u[j] = pp * cw[hc] + pc * cw[HC + hc] + pn * cw[2 * HC + hc] + cb[hc]; }
                if (t < CTX) X.ws<float>(WS_Z)[(size_t)t * HW + c] = u[2] * u[1];
                X.ws<float>(WS_ZT)[(size_t)c * M + t] = u[2] * u[1]; X.ws<bf16>(WS_X0)[(size_t)t * HW + c] = (bf16)f2bf(u[0]); }
        }
    }
}

constexpr int CC = 64, NCHK = M / CC;
static_assert(CTX % CC == 0 && SEQ % CC == 0, "chunks must not straddle the context/latent boundary");
__device__ __forceinline__ int scan_row(int d, int s) { return d == 0 ? s : (s < CTX ? CTX - 1 - s : M - 1 - (s - CTX)); }
constexpr int LP = 72;
constexpr int LQ = 65;
constexpr int LX = 68;
__device__ __forceinline__ f32x4 mm_tile(const LAS bf16* A, const LAS bf16* Bt, int ti, int tj, int lane, f32x4 acc) {
    const LAS bf16* pa = A + (16 * ti + (lane & 15)) * LP + 8 * (lane >> 4); const LAS bf16* pb = Bt + (16 * tj + (lane & 15)) * LP + 8 * (lane >> 4);
#pragma unroll
    for (int kk = 0; kk < 2; ++kk) { const bf16x8 a = *(const LAS bf16x8*)(pa + 32 * kk), b = *(const LAS bf16x8*)(pb + 32 * kk); acc = MFMA16(a, b, acc); }
    return acc;
}
__device__ __forceinline__ void chunk_unit_1(const Ctx& X, int unit) {
    const int d = unit / (NCHK * NH), c = (unit / NH) % NCHK, h = unit % NH;
    LAS bf16* An = (LAS bf16*)X.lds;            LAS bf16* Bn = An + 64 * LP; LAS bf16* Kn = Bn + 64 * LP; LAS bf16* Rn = Kn + 64 * LP; LAS bf16* Vt = Rn + 64 * LP;
    LAS bf16* Bh = Vt + 64 * LP;                LAS bf16* Kh = Bh + 64 * LP; LAS bf16* Lak = Kh + 64 * LP; LAS bf16* Mrb = Lak + 64 * LP; LAS bf16* Mrk = Mrb + 64 * LP;
    LAS float* Lab = (LAS float*)(Mrk + 64 * LP); LAS float* XsW = Lab + 64 * LX;
    LAS float* XsU = (LAS float*)An;
    LAS bf16* Wt = Lak; LAS bf16* Ut = (LAS bf16*)((LAS unsigned char*)An + 64 * LX * 4);
    LAS float* tot = Lab;
    LAS float* dC = (LAS float*)(X.lds + LDS_MISC + 1024);
    static_assert(10 * 64 * LP * 2 + 2 * 64 * LX * 4 <= LDS_STAGE && 64 * LX * 4 + 64 * LP * 2 <= 3 * 64 * LP * 2, "chunk LDS map");
    const int tid = X.tid, lane = X.lane, w = X.wave, k = tid & 63;
    float lw[8], cum[8];
    { float run = 0.f;
#pragma unroll
      for (int i = 0; i < 8; ++i) { const int row = scan_row(d, c * CC + 8 * w + i); lw[i] = X.wsv<float>(WS_W)[((size_t)d * M + row) * RW + h * 64 + k]; run += lw[i]; cum[i] = run; }
      tot[w * 64 + k] = run; }
    __syncthreads();
    float off = 0.f, cumC = 0.f;
#pragma unroll
    for (int ww = 0; ww < 8; ++ww) { const float t = tot[ww * 64 + k]; off += (ww < w) ? t : 0.f; cumC += t; }
    __syncthreads();
    { unsigned pv[4], pbh[4], pkh[4]; float af[8];
#pragma unroll
      for (int i = 0; i < 8; ++i) { const int t = 8 * w + i; const int row = scan_row(d, c * CC + t); const size_t o = (size_t)row * RW + h * 64 + k, od = ((size_t)d * M + row) * RW + h * 64 + k;
          const float ct = off + cum[i], cp = ct - lw[i];
          const float r = bf2f(X.wsv<bf16>(WS_R)[o]), v = bf2f(X.wsv<bf16>(WS_V)[o]), ka = bf2f(X.wsv<bf16>(WS_KA)[o]), kd = bf2f(X.wsv<bf16>(WS_KD)[od]), kb = bf2f(X.wsv<bf16>(WS_KB)[od]);
          const float ei = expf(-ct), eh = expf(cumC - ct);
          const float at = ka * expf(cp); af[i] = at;
          An[t * LP + k] = (bf16)f2bf(at); Bn[t * LP + k] = (bf16)f2bf(kb * ei); Kn[t * LP + k] = (bf16)f2bf(kd * ei); Rn[t * LP + k] = (bf16)f2bf(r * expf(ct));
          const unsigned bv = f2bf(v), bb = f2bf(kb * eh), bk = f2bf(kd * eh);
          if (i & 1) { pv[i >> 1] |= bv << 16; pbh[i >> 1] |= bb << 16; pkh[i >> 1] |= bk << 16; } else { pv[i >> 1] = bv; pbh[i >> 1] = bb; pkh[i >> 1] = bk; } }
      *(LAS u32x4*)(Vt + k * LP + 8 * w) = (u32x4){pv[0], pv[1], pv[2], pv[3]}; *(LAS u32x4*)(Bh + k * LP + 8 * w) = (u32x4){pbh[0], pbh[1], pbh[2], pbh[3]}; *(LAS u32x4*)(Kh + k * LP + 8 * w) = (u32x4){pkh[0], pkh[1], pkh[2], pkh[3]};
      *(LAS f32x4*)(XsW + k * LX + 8 * w) = (f32x4){af[0], af[1], af[2], af[3]}; *(LAS f32x4*)(XsW + k * LX + 8 * w + 4) = (f32x4){af[4], af[5], af[6], af[7]}; }
    if (tid < 64) dC[tid] = expf(cumC);
    __syncthreads();
#pragma unroll 1
    for (int q = 0; q < 2; ++q) { const int tile = 2 * w + q, ti = tile >> 2, tj = tile & 3; const f32x4 z4 = {0.f, 0.f, 0.f, 0.f};
        const f32x4 ab = mm_tile(An, Bn, ti, tj, lane, z4), ak = mm_tile(An, Kn, ti, tj, lane, z4), rb = mm_tile(Rn, Bn, ti, tj, lane, z4), rk = mm_tile(Rn, Kn, ti, tj, lane, z4);
        const int col = 16 * tj + (lane & 15);
#pragma unroll
        for (int r = 0; r < 4; ++r) { const int row = 16 * ti + 4 * (lane >> 4) + r; const bool lo = col < row, le = col <= row;
            Lab[row * LX + col] = lo ? ab[r] : 0.f; Lak[row * LP + col] = (bf16)f2bf(lo ? ak[r] : 0.f); Mrb[row * LP + col] = (bf16)f2bf(le ? rb[r] : 0.f); Mrk[row * LP + col] = (bf16)f2bf(le ? rk[r] : 0.f); } }
    __syncthreads();
}
__device__ __forceinline__ void chunk_unit_2(const Ctx& X, int unit) {
    const int d = unit / (NCHK * NH), c = (unit / NH) % NCHK, h = unit % NH;
    LAS bf16* An = (LAS bf16*)X.lds;            LAS bf16* Bn = An + 64 * LP; LAS bf16* Kn = Bn + 64 * LP; LAS bf16* Rn = Kn + 64 * LP; LAS bf16* Vt = Rn + 64 * LP;
    LAS bf16* Bh = Vt + 64 * LP;                LAS bf16* Kh = Bh + 64 * LP; LAS bf16* Lak = Kh + 64 * LP; LAS bf16* Mrb = Lak + 64 * LP; LAS bf16* Mrk = Mrb + 64 * LP;
    LAS float* Lab = (LAS float*)(Mrk + 64 * LP); LAS float* XsW = Lab + 64 * LX;
    LAS float* XsU = (LAS float*)An;
    LAS bf16* Wt = Lak; LAS bf16* Ut = (LAS bf16*)((LAS unsigned char*)An + 64 * LX * 4);
    LAS float* tot = Lab;
    LAS float* dC = (LAS float*)(X.lds + LDS_MISC + 1024);
    static_assert(10 * 64 * LP * 2 + 2 * 64 * LX * 4 <= LDS_STAGE && 64 * LX * 4 + 64 * LP * 2 <= 3 * 64 * LP * 2, "chunk LDS map");
    const int tid = X.tid, lane = X.lane, w = X.wave, k = tid & 63;
    f32x4 r2[2]; int r2col[2], r2row[2];
#pragma unroll
    for (int q = 0; q < 2; ++q) { const int tile = 2 * w + q, ti = tile >> 2, tj = tile & 3; const f32x4 z4 = {0.f, 0.f, 0.f, 0.f};
        const f32x4 a = mm_tile(Lak, Vt, ti, tj, lane, z4); const int col = 16 * tj + (lane & 15);
        r2[q] = a; r2col[q] = col; r2row[q] = 16 * ti + 4 * (lane >> 4); }
    __syncthreads();
#pragma unroll
    for (int q = 0; q < 2; ++q) *(LAS f32x4*)(XsU + r2col[q] * LX + r2row[q]) = r2[q];
    __syncthreads();
    if (tid < 128) { const int j = tid & 63; const bool isu = tid >= 64; LAS float* xs = (isu ? XsU : XsW) + j * LX;
#pragma unroll 1
        for (int t = 1; t < 64; ++t) { const int nq = (t + 3) >> 2; f32x4 acc = {0.f, 0.f, 0.f, 0.f};
            for (int q = 0; q < nq; ++q) { const f32x4 l4 = *(const LAS f32x4*)(Lab + t * LX + 4 * q), x4 = *(const LAS f32x4*)(xs + 4 * q); acc += l4 * x4; }
            xs[t] += (acc[0] + acc[1]) + (acc[2] + acc[3]); }
        CFENCE();
        f32x4 xv[16];
#pragma unroll
        for (int q = 0; q < 16; ++q) xv[q] = *(const LAS f32x4*)(xs + 4 * q);
        LAS bf16* dst = (isu ? Ut : Wt) + j * LP;
#pragma unroll
        for (int q = 0; q < 16; ++q) { *(LAS unsigned*)(dst + 4 * q) = pk2(xv[q][0], xv[q][1]); *(LAS unsigned*)(dst + 4 * q + 2) = pk2(xv[q][2], xv[q][3]); } }
    __syncthreads();
}
__device__ __forceinline__ void chunk_unit_3(const Ctx& X, int unit) {
    const int d = unit / (NCHK * NH), c = (unit / NH) % NCHK, h = unit % NH;
    LAS bf16* An = (LAS bf16*)X.lds;            LAS bf16* Bn = An + 64 * LP; LAS bf16* Kn = Bn + 64 * LP; LAS bf16* Rn = Kn + 64 * LP; LAS bf16* Vt = Rn + 64 * LP;
    LAS bf16* Bh = Vt + 64 * LP;                LAS bf16* Kh = Bh + 64 * LP; LAS bf16* Lak = Kh + 64 * LP; LAS bf16* Mrb = Lak + 64 * LP; LAS bf16* Mrk = Mrb + 64 * LP;
    LAS float* Lab = (LAS float*)(Mrk + 64 * LP); LAS float* XsW = Lab + 64 * LX;
    LAS float* XsU = (LAS float*)An;
    LAS bf16* Wt = Lak; LAS bf16* Ut = (LAS bf16*)((LAS unsigned char*)An + 64 * LX * 4);
    LAS float* tot = Lab;
    LAS float* dC = (LAS float*)(X.lds + LDS_MISC + 1024);
    static_assert(10 * 64 * LP * 2 + 2 * 64 * LX * 4 <= LDS_STAGE && 64 * LX * 4 + 64 * LP * 2 <= 3 * 64 * LP * 2, "chunk LDS map");
    const int tid = X.tid, lane = X.lane, w = X.wave, k = tid & 63;
    const float dCk = dC[k];
    const size_t ubase = ((size_t)(d * NH + h) * NCHK + c);
    float* Pg = X.wsv<float>(WS_PQ) + ubase * 2 * 4096; float* Qg = Pg + 4096; bf16* Gg = X.wsv<bf16>(WS_G) + ubase * 4096; float* Yg = X.wsv<float>(WS_YL) + ubase * 4096;
#pragma unroll 1
    for (int q = 0; q < 2; ++q) { const int tile = 2 * w + q, ti = tile >> 2, tj = tile & 3; const f32x4 z4 = {0.f, 0.f, 0.f, 0.f};
        const f32x4 p = mm_tile(Wt, Bh, ti, tj, lane, z4); f32x4 qq = mm_tile(Ut, Bh, ti, tj, lane, z4); qq = mm_tile(Vt, Kh, ti, tj, lane, qq);
        const f32x4 g = mm_tile(Mrb, Wt, ti, tj, lane, z4); f32x4 y = mm_tile(Mrb, Ut, ti, tj, lane, z4); y = mm_tile(Mrk, Vt, ti, tj, lane, y);
        const int col = 16 * tj + (lane & 15); const float dcol = __shfl(dCk, col);
#pragma unroll
        for (int r = 0; r < 4; ++r) { const int row = 16 * ti + 4 * (lane >> 4) + r;
            Pg[row * 64 + col] = p[r] + (row == col ? dcol : 0.f); Qg[row * 64 + col] = qq[r];
            const int orow = d ? 63 - row : row;
            Gg[orow * 64 + col] = (bf16)f2bf(g[r] + bf2f(Rn[row * LP + col])); Yg[orow * 64 + col] = y[r]; } }
    __syncthreads();
}
constexpr int N_SEQ_UNITS = 2 * NH * 4;
__device__ __forceinline__ void seq_unit(const Ctx& X, int su) {
    const int d = su / (NH * 4), h = (su / 4) % NH, qv = su & 3;
    LAS float* S = (LAS float*)X.lds;
    LAS float* Pb = S + 16 * LQ;
    LAS float* Qb = Pb + 2 * 4096;
    const int tid = X.tid, v = tid >> 5, k2 = (tid & 31) * 2;
    const float* PQ = X.ws<float>(WS_PQ) + (size_t)(d * NH + h) * NCHK * 2 * 4096; bf16* S0g = X.ws<bf16>(WS_S0) + (size_t)(d * NH + h) * NCHK * 4096;
    f32x4 pp0, pp1; float pq0, pq1;
#define SEQ_LOAD(c_) do { const float* p_ = PQ + (size_t)(c_) * 2 * 4096; pp0 = *(const f32x4*)(p_ + 4 * tid); pp1 = *(const f32x4*)(p_ + 2048 + 4 * tid); \
        pq0 = p_[4096 + (qv * 16) * 64 + tid]; pq1 = p_[4096 + (qv * 16) * 64 + 512 + tid]; } while (0)
#define SEQ_STORE(b_) do { *(LAS f32x4*)(Pb + (b_) * 4096 + 4 * tid) = pp0; *(LAS f32x4*)(Pb + (b_) * 4096 + 2048 + 4 * tid) = pp1; Qb[(b_) * 1024 + tid] = pq0; Qb[(b_) * 1024 + 512 + tid] = pq1; } while (0)
    SEQ_LOAD(0); SEQ_STORE(0);
    for (int i = tid; i < 16 * LQ; i += NTHR) S[i] = 0.f;
    __syncthreads();
    for (int c = 0; c < NCHK; ++c) { const int pb = c & 1;
        if (c + 1 < NCHK) SEQ_LOAD(c + 1);
        const LAS float* P = Pb + pb * 4096; const LAS float* Q = Qb + pb * 1024;
        *(unsigned*)(S0g + (size_t)c * 4096 + (qv * 16 + v) * 64 + k2) = pk2(S[v * LQ + k2], S[v * LQ + k2 + 1]);
        float a0 = Q[v * 64 + k2], a1 = Q[v * 64 + k2 + 1];
#pragma unroll 8
        for (int k1 = 0; k1 < 64; ++k1) { const float sv = S[v * LQ + k1]; a0 += sv * P[k1 * 64 + k2]; a1 += sv * P[k1 * 64 + k2 + 1]; }
        __syncthreads();
        S[v * LQ + k2] = a0; S[v * LQ + k2 + 1] = a1;
        if (c + 1 < NCHK) SEQ_STORE(pb ^ 1);
        __syncthreads();
    }
#undef SEQ_LOAD
#undef SEQ_STORE
}
constexpr int CR = 16;
__device__ __forceinline__ void conv_item(const Ctx& X, int item) {
    constexpr int NCG = HW / 64; constexpr int n = CTX;
    const int cg = item % NCG, ob = item / NCG, i0 = CR * ob, c = cg * 64 + X.lane;
    const float* F = X.ws<float>(WS_FILT) + (size_t)HW * SEQ + (size_t)c * CTX; const float* Z = X.ws<float>(WS_Z) + c;
    const float* fp = X.ws<float>(WS_FPART) + (size_t)NPART * HW + c;
    float nsum = 0.f; for (int b = 0; b < NPART; ++b) nsum += fp[(size_t)b * HW];
    float acc[CR], Q[CR];
#pragma unroll
    for (int r = 0; r < CR; ++r) acc[r] = 0.f;
    int jb = i0 - n / 2; if (jb < 0) jb = 0;
    int jend = i0 + n / 2 + CR; if (jend > n) jend = n;
    int Tb = i0 - jb + n / 2;
#pragma unroll
    for (int x = 1; x < CR; ++x) { const int T = Tb + x; Q[x] = (T >= 0 && T < n) ? F[T] : 0.f; }
    Q[0] = 0.f;
    for (; jb < jend; jb += CR, Tb -= CR) {
#pragma unroll
        for (int s = 0; s < CR; ++s) { const int T = Tb - s, j = jb + s;
            if ((s & 3) == 0) CFENCE();
            Q[(CR - s) & (CR - 1)] = (T >= 0 && T < n) ? F[T] : 0.f;
            const float zj = (j < n) ? Z[(size_t)j * HW] : 0.f;
#pragma unroll
            for (int r = 0; r < CR; ++r) acc[r] += Q[(r - s + CR) & (CR - 1)] * zj; }
    }
    const float inv = 1.0f / nsum; float* O = X.ws<float>(WS_CONV) + c;
#pragma unroll
    for (int r = 0; r < CR; ++r) O[(size_t)(i0 + r) * HW] = acc[r] * inv;
}

#ifdef EMU
struct cf { float x, y; };
#else
typedef float cf __attribute__((ext_vector_type(2)));
#endif
__device__ __forceinline__ cf cmul(cf a, cf b) { return cf{a.x * b.x - a.y * b.y, a.x * b.y + a.y * b.x}; }
__device__ __forceinline__ cf cadd(cf a, cf b) { return cf{a.x + b.x, a.y + b.y}; }
__device__ __forceinline__ cf csub(cf a, cf b) { return cf{a.x - b.x, a.y - b.y}; }
__device__ __forceinline__ cf cconj(cf a) { return cf{a.x, -a.y}; }
constexpr int FN = SEQ;
constexpr int flog4(int n) { return n <= 1 ? 0 : 1 + flog4(n / 4); }
constexpr int FLOG4 = flog4(FN), FSQ = 1 << FLOG4;
static_assert((1 << (2 * FLOG4)) == FN && FN * 8 <= LDS_STAGE, "FFT length must be a power of 4 that fits the LDS stage region");
constexpr int FFT_TAB_OFF = LDS_MISC + 2048;
static_assert(FFT_TAB_OFF + 2 * FSQ * 8 <= LDS_BYTES, "FFT twiddle tables");
__device__ __forceinline__ void fft_tables(const Ctx& X) {
    LAS cf* T = (LAS cf*)(X.lds + FFT_TAB_OFF);
    for (int i = X.tid; i < 2 * FSQ; i += NTHR) { const int k = i < FSQ ? i * FSQ : i - FSQ; float s, c; sincos_f(-6.283185307179586f * (float)k / (float)FN, s, c); T[i] = cf{c, s}; }
    __syncthreads();
}
__device__ __forceinline__ cf fft_tw(const LAS cf* T, int k) { const cf a = T[k >> FLOG4], b = T[FSQ + (k & (FSQ - 1))]; return cmul(a, b); }
__device__ __forceinline__ int rev4(int k) { int r = 0;
#pragma unroll
    for (int s = 0; s < FLOG4; ++s) { r = (r << 2) | (k & 3); k >>= 2; }
    return r; }
__device__ __forceinline__ void fft_fwd(LAS cf* x, const LAS cf* T, int tid) {
#pragma unroll 1
    for (int s = 0; s < FLOG4; ++s) { const int q = FN >> (2 * s + 2), tw = 1 << (2 * s);
        for (int u = tid; u < FN / 4; u += NTHR) { const int j = u & (q - 1), p = (u - j) * 4 + j;
            const cf a0 = x[p], a1 = x[p + q], a2 = x[p + 2 * q], a3 = x[p + 3 * q];
            const cf t0 = cadd(a0, a2), t1 = csub(a0, a2), t2 = cadd(a1, a3), d = csub(a1, a3), t3 = cf{d.y, -d.x};
            const cf w1 = fft_tw(T, j * tw), w2 = cmul(w1, w1), w3 = cmul(w2, w1);
            x[p] = cadd(t0, t2); x[p + q] = cmul(cadd(t1, t3), w1); x[p + 2 * q] = cmul(csub(t0, t2), w2); x[p + 3 * q] = cmul(csub(t1, t3), w3); }
        __syncthreads(); }
}
__device__ __forceinline__ void fft_inv(LAS cf* x, const LAS cf* T, int tid) {
#pragma unroll 1
    for (int s = FLOG4 - 1; s >= 0; --s) { const int q = FN >> (2 * s + 2), tw = 1 << (2 * s);
        for (int u = tid; u < FN / 4; u += NTHR) { const int j = u & (q - 1), p = (u - j) * 4 + j;
            const cf w1 = cconj(fft_tw(T, j * tw)), w2 = cmul(w1, w1), w3 = cmul(w2, w1);
            const cf a0 = x[p], a1 = cmul(x[p + q], w1), a2 = cmul(x[p + 2 * q], w2), a3 = cmul(x[p + 3 * q], w3);
            const cf t0 = cadd(a0, a2), t1 = csub(a0, a2), t2 = cadd(a1, a3), d = csub(a1, a3), t3 = cf{-d.y, d.x};
            x[p] = cadd(t0, t2); x[p + q] = cadd(t1, t3); x[p + 2 * q] = csub(t0, t2); x[p + 3 * q] = csub(t1, t3); }
        __syncthreads(); }
}
__device__ __forceinline__ void fft_load_real(LAS cf* x, const float* src, float scale, int tid) {
    for (int m = tid; m < FN; m += NTHR) { cf v{0.f, 0.f}; if (m < FN / 2) { v.x = src[2 * m] * scale; v.y = src[2 * m + 1] * scale; } x[m] = v; }
    __syncthreads();
}
__device__ __forceinline__ void phase_spectra(const Ctx& X, int l) {
    (void)l;
    LAS cf* x = (LAS cf*)X.lds; const LAS cf* T = (const LAS cf*)(X.lds + FFT_TAB_OFF); volatile LAS float* red = (volatile LAS float*)(X.lds + LDS_MISC) + 120;
    fft_tables(X);
    for (int c = X.bid; c < HW; c += X.G) {
        if (X.wave == 0) { const float* fp = X.ws<float>(WS_FPART) + c; float s = 0.f; for (int b = X.lane; b < NPART; b += 64) s += fp[(size_t)b * HW]; s = wave_sum(s); if (X.lane == 0) red[0] = s; }
        __syncthreads();
        const float inv = 1.0f / red[0];
        fft_load_real(x, X.ws<float>(WS_FILT) + (size_t)c * SEQ, inv, X.tid);
        fft_fwd(x, T, X.tid);
        cf* HS = X.ws<cf>(WS_HS) + (size_t)c * (FN + 1);
        for (int k = X.tid; k <= FN / 2; k += NTHR) {
            const cf A = x[rev4(k)], B = x[rev4((FN - k) & (FN - 1))];
            if (k == 0) { HS[0] = cf{A.x + A.y, 0.f}; HS[FN] = cf{A.x - A.y, 0.f}; }
            else if (k == FN / 2) { HS[k] = cconj(A); }
            else { float sn, cs; sincos_f(-3.14159265358979f * (float)k / (float)FN, sn, cs); const cf w{cs, sn};
                const cf s1 = cadd(A, cconj(B)), d1 = csub(A, cconj(B)), wd = cmul(w, d1);
                HS[k] = cf{0.5f * (s1.x + wd.y), 0.5f * (s1.y - wd.x)};
                const cf s2 = cadd(B, cconj(A)), d2 = csub(B, cconj(A)), wd2 = cmul(cconj(w), d2);
                HS[FN - k] = cf{0.5f * (s2.x - wd2.y), 0.5f * (s2.y + wd2.x)}; } }
        __syncthreads();
    }
}
__device__ __forceinline__ void fftconv_item(const Ctx& X, int l, int c) {
    LAS cf* x = (LAS cf*)X.lds; const LAS cf* T = (const LAS cf*)(X.lds + FFT_TAB_OFF);
    const float* z = X.ws<float>(WS_ZT) + (size_t)c * M + CTX;
    fft_load_real(x, z, 1.0f, X.tid);
    fft_fwd(x, T, X.tid);
    const cf* HS = X.ws<cf>(WS_HS) + (size_t)c * (FN + 1);
    for (int k = X.tid; k <= FN / 2; k += NTHR) {
        const int pa = rev4(k), pb = rev4((FN - k) & (FN - 1)); const cf A = x[pa], B = x[pb];
        if (k == 0) { const float y0 = (A.x + A.y) * HS[0].x, yn = (A.x - A.y) * HS[FN].x; x[pa] = cf{0.5f * (y0 + yn), 0.5f * (y0 - yn)}; }
        else if (k == FN / 2) { x[pa] = cconj(cmul(cconj(A), HS[k])); }
        else { float sn, cs; sincos_f(-3.14159265358979f * (float)k / (float)FN, sn, cs); const cf w{cs, sn};
            const cf s1 = cadd(A, cconj(B)), d1 = csub(A, cconj(B)), wd = cmul(w, d1); const cf Xk{0.5f * (s1.x + wd.y), 0.5f * (s1.y - wd.x)};
            const cf s2 = cadd(B, cconj(A)), d2 = csub(B, cconj(A)), wd2 = cmul(cconj(w), d2); const cf Xn{0.5f * (s2.x - wd2.y), 0.5f * (s2.y + wd2.x)};
            const cf Yk = cmul(Xk, HS[k]), Yn = cmul(Xn, HS[FN - k]);
            const cf e1 = cadd(Yk, cconj(Yn)), f1 = cmul(cconj(w), csub(Yk, cconj(Yn)));
            x[pa] = cf{0.5f * (e1.x - f1.y), 0.5f * (e1.y + f1.x)};
            const cf e2 = cadd(Yn, cconj(Yk)), f2 = cmul(w, csub(Yn, cconj(Yk)));
            x[pb] = cf{0.5f * (e2.x + f2.y), 0.5f * (e2.y - f2.x)}; } }
    __syncthreads();
    fft_inv(x, T, X.tid);
    const float bias = X.in(I_HBIAS)[(size_t)l * HW + c], sc = 1.0f / (float)FN; float* O = X.ws<float>(WS_CVT) + (size_t)c * SEQ;
    for (int i2 = X.tid; i2 < FN / 2; i2 += NTHR) { const cf d = x[i2 + FN / 4]; O[2 * i2] = d.x * sc + z[2 * i2] * bias; O[2 * i2 + 1] = d.y * sc + z[2 * i2 + 1] * bias; }
    __syncthreads();
}
__device__ __forceinline__ void phase_fftconv(const Ctx& X, int l) {
    fft_tables(X);
    volatile LAS int* slot = (volatile LAS int*)(X.lds + LDS_MISC) + 121;
    unsigned* q = X.ctl() + CW_Q + l * 64 + 32;
    for (;;) { if (X.tid == 0) slot[0] = (int)atomicAdd(q, 1u); __syncthreads(); const int c = slot[0]; __syncthreads(); if (c >= HW) break; fftconv_item(X, l, c); }
}
__device__ __forceinline__ void phase_ctxconv(const Ctx& X, int l) {
    constexpr int NITEMS = (HW / 64) * (CTX / CR);
    unsigned* q = X.ctl() + CW_Q + l * 64;
    for (;;) { int item = 0; if (X.lane == 0) item = (int)atomicAdd(q, 1u); item = __shfl(item, 0); if (item >= NITEMS) break; conv_item(X, item); }
}
__device__ __forceinline__ void phase_seq(const Ctx& X) {
    for (int su = X.bid; su < N_SEQ_UNITS; su += X.G) seq_unit(X, su);
}

__device__ __forceinline__ void finish_unit(const Ctx& X, int l, int unit) {
    const int b = unit / NH, h = unit % NH, lane = X.lane, w = X.wave, tid = X.tid;
    const int cf = b, cb = (b < CTX / CC) ? (CTX / CC - 1 - b) : (NCHK - 1 - (b - CTX / CC));
    LAS bf16* Gf = (LAS bf16*)X.lds; LAS bf16* Gb = Gf + 64 * LP; LAS bf16* Sf = Gb + 64 * LP; LAS bf16* Sb = Sf + 64 * LP; LAS float* Yl = (LAS float*)(Sb + 64 * LP);
    const size_t uf = ((size_t)(0 * NH + h) * NCHK + cf) * 4096, ub = ((size_t)(1 * NH + h) * NCHK + cb) * 4096;
    { const int r = tid >> 3, c8 = (tid & 7) * 8;
      *(LAS u32x4*)(Gf + r * LP + c8) = *(const u32x4*)(X.ws<bf16>(WS_G) + uf + r * 64 + c8); *(LAS u32x4*)(Gb + r * LP + c8) = *(const u32x4*)(X.ws<bf16>(WS_G) + ub + r * 64 + c8);
      *(LAS u32x4*)(Sf + r * LP + c8) = *(const u32x4*)(X.ws<bf16>(WS_S0) + uf + r * 64 + c8); *(LAS u32x4*)(Sb + r * LP + c8) = *(const u32x4*)(X.ws<bf16>(WS_S0) + ub + r * 64 + c8);
      const float* yf = X.ws<float>(WS_YL) + uf + r * 64 + c8; const float* yb = X.ws<float>(WS_YL) + ub + r * 64 + c8;
#pragma unroll
      for (int i = 0; i < 8; ++i) Yl[r * LQ + c8 + i] = yf[i] + yb[i]; }
    __syncthreads();
#pragma unroll 1
    for (int q = 0; q < 2; ++q) { const int tile = 2 * w + q, ti = tile >> 2, tj = tile & 3; f32x4 y = {0.f, 0.f, 0.f, 0.f};
        y = mm_tile(Gf, Sf, ti, tj, lane, y); y = mm_tile(Gb, Sb, ti, tj, lane, y); const int col = 16 * tj + (lane & 15);
#pragma unroll
        for (int r = 0; r < 4; ++r) Yl[(16 * ti + 4 * (lane >> 4) + r) * LQ + col] += y[r]; }
    __syncthreads();
    const int c = h * 64 + lane; const float lgc = X.in(I_LNXG)[(size_t)l * RW + c], lbc = X.in(I_LNXB)[(size_t)l * RW + c];
#pragma unroll 1
    for (int i = 0; i < 8; ++i) { const int tl = 8 * w + i, t = 64 * b + tl; const size_t o = (size_t)t * RW + c;
        const float y = Yl[tl * LQ + lane];
        const float mean = wave_sum(y) * (1.f / 64.f); const float dy = y - mean; const float var = wave_sum(dy * dy) * (1.f / 64.f);
        float yn = dy / sqrtf(var + GN_EPS) * lgc + lbc;
        yn += X.ws<float>(WS_BONUS)[(size_t)t * NH + h] * bf2f(X.ws<bf16>(WS_V)[o]);
        yn *= bf2f(X.ws<bf16>(WS_GATE)[o]);
        X.ws<bf16>(WS_RO)[o] = (bf16)f2bf(yn); }
    __syncthreads();
}
__device__ __forceinline__ void phase_finish(const Ctx& X, int l) {
    for (int u = X.bid; u < (M / 64) * NH; u += X.G) finish_unit(X, l, u);
    const int c = X.tid;
    const float* hb = X.in(I_HBIAS) + (size_t)l * HW;
    if (c < HW) for (int t = X.bid; t < M; t += X.G) { const size_t o = (size_t)t * HW + c;
            const float cv = t < CTX ? X.ws<float>(WS_CONV)[o] + X.ws<float>(WS_Z)[o] * hb[c] : X.ws<float>(WS_CVT)[(size_t)c * SEQ + (t - CTX)];
            const float ho = cv * bf2f(X.ws<bf16>(WS_X0)[o]);
            X.ws<bf16>(WS_HO)[o] = (bf16)f2bf(ho); }
}

__device__ __forceinline__ void ln_inplace(float (&v)[D / 64], const float* g, const float* b, int lane) {
    float s = 0.f;
#pragma unroll
    for (int j = 0; j < D / 64; ++j) s += v[j];
    const float mean = wave_sum(s) * (1.f / D); float q = 0.f;
#pragma unroll
    for (int j = 0; j < D / 64; ++j) { v[j] -= mean; q += v[j] * v[j]; }
    const float rstd = 1.0f / sqrtf(wave_sum(q) * (1.f / D) + LN_EPS);
#pragma unroll
    for (int j = 0; j < D / 64; ++j) { const int d = 4 * lane + 256 * (j >> 2) + (j & 3); v[j] = v[j] * rstd * g[d] + b[d]; }
}
__device__ __forceinline__ void phase_norm1(const Ctx& X, int l) {
    const int gw = X.bid * NWAVES + X.wave, NGW = X.G * NWAVES, lane = X.lane;
    const float* lng = X.in(I_LNG) + (size_t)(l * 2 + 0) * D; const float* lnb = X.in(I_LNB) + (size_t)(l * 2 + 0) * D;
    const float* wr = X.in(I_WR); const float* rb = X.in(I_RB);
    const float alpha = sqrtf(sqrtf(2.0f * DEPTH));
    for (int t = gw; t < M; t += NGW) {
        float* xr = X.ws<float>(WS_X) + (size_t)t * D; const float* mx = X.ws<float>(WS_MIX) + (size_t)t * D;
        const float* gate = modp(X, l, t, 2); const float* sh = modp(X, l, t, 3); const float* sc = modp(X, l, t, 4);
        float v[D / 64];
#pragma unroll
        for (int j = 0; j < D / 256; ++j) { const int d = 4 * lane + 256 * j; const f32x4 a = *(const f32x4*)(xr + d), m = *(const f32x4*)(mx + d), gt = *(const f32x4*)(gate + d);
#pragma unroll
            for (int i = 0; i < 4; ++i) v[4 * j + i] = alpha * a[i] + gt[i] * m[i]; }
        ln_inplace(v, lng, lnb, lane);
        bf16* hf = X.ws<bf16>(WS_XMOD) + (size_t)t * D;
        LAS float* hrow = (LAS float*)X.lds + X.wave * D;
#pragma unroll
        for (int j = 0; j < D / 256; ++j) { const int d = 4 * lane + 256 * j; f32x4 o; const f32x4 a = *(const f32x4*)(sh + d), b = *(const f32x4*)(sc + d); f32x4 h;
#pragma unroll
            for (int i = 0; i < 4; ++i) { o[i] = v[4 * j + i]; h[i] = o[i] * (1.f + b[i]) + a[i]; }
            *(f32x4*)(xr + d) = o; *(LAS f32x4*)(hrow + d) = h;
            *(unsigned long long*)(hf + d) = (unsigned long long)pk2(h[0], h[1]) | ((unsigned long long)pk2(h[2], h[3]) << 32); }
        WAVE_LDS_FENCE(); CFENCE();
        float part = 0.f; { const int e = lane & 15, q = lane >> 4;
#pragma unroll 8
            for (int d = q * (D / 4); d < (q + 1) * (D / 4); ++d) part += hrow[d] * wr[(size_t)d * NE + e]; }
        part += __shfl_xor(part, 16); part += __shfl_xor(part, 32);
        WAVE_LDS_FENCE(); CFENCE();
        float lg[NE];
#pragma unroll
        for (int e = 0; e < NE; ++e) lg[e] = __shfl(part, e);
        float mxl = lg[0];
#pragma unroll
        for (int e = 1; e < NE; ++e) mxl = fmaxf(mxl, lg[e]);
        float sc_[NE], sum = 0.f;
#pragma unroll
        for (int e = 0; e < NE; ++e) { sc_[e] = expf(lg[e] - mxl); sum += sc_[e]; }
        const float isum = 1.0f / sum; float sel[NE];
#pragma unroll
        for (int e = 0; e < NE; ++e) { sc_[e] *= isum; sel[e] = sc_[e] + rb[e]; }
        int bg = 0; float bgs = -INFINITY;
#pragma unroll
        for (int g = 0; g < 4; ++g) { float m1 = -INFINITY, m2 = -INFINITY;
#pragma unroll
            for (int i = 0; i < 4; ++i) { const float x = sel[4 * g + i]; if (x > m1) { m2 = m1; m1 = x; } else if (x > m2) m2 = x; }
            const float gs = m1 + m2; if (gs > bgs) { bgs = gs; bg = g; } }
        int i0 = 0, i1 = 0; float s0 = -INFINITY, s1 = -INFINITY, p0 = 0.f, p1 = 0.f;
#pragma unroll
        for (int e = 0; e < NE; ++e) { if ((e >> 2) == bg) { const float x = sel[e]; if (x > s0) { s1 = s0; i1 = i0; p1 = p0; s0 = x; i0 = e; p0 = sc_[e]; } else if (x > s1) { s1 = x; i1 = e; p1 = sc_[e]; } } }
        if (lane == 0) { int* ei = X.ws<int>(WS_ROUT) + (size_t)t * 2; float* ew = (float*)(X.ws<int>(WS_ROUT) + (size_t)M * 2) + (size_t)t * 2;
            ei[0] = i0; ei[1] = i1; const float ws_ = 1.0f / (p0 + p1); ew[0] = p0 * ws_; ew[1] = p1 * ws_;
            atomicAdd(X.ctl() + CW_CNT + l * 64 + i0, 1u); atomicAdd(X.ctl() + CW_CNT + l * 64 + i1, 1u); }
    }
}

__device__ __forceinline__ void moe_table(const Ctx& X, int l, int NT) {
    volatile LAS int* tab = (volatile LAS int*)(X.lds + LDS_MISC) + 8;
    if (X.tid == 0) { int cum = 0, ts = 0;
        for (int e = 0; e < NE; ++e) { const int cnt = (int)__hip_atomic_load(X.ctl() + CW_CNT + l * 64 + e, RLX_AGENT); const int tc = (cnt + 255) / 256;
            tab[e] = cum; tab[32 + e] = ts; tab[64 + e] = tc; cum += tc * NT; ts += tc; }
        tab[16] = cum; }
    __syncthreads();
}
__device__ __forceinline__ void phase_scatter(const Ctx& X, int l) {
    moe_table(X, l, 1);
    volatile LAS int* tab = (volatile LAS int*)(X.lds + LDS_MISC) + 8;
    const int gw = X.bid * NWAVES + X.wave, NGW = X.G * NWAVES, lane = X.lane;
    const int* ei = X.ws<int>(WS_ROUT); int* slot = X.ws<int>(WS_ROUT) + (size_t)M * 4;
    for (int s = gw; s < 2 * M; s += NGW) { const int t = s >> 1; const int e = ei[s];
        int pos = 0; if (lane == 0) pos = tab[32 + e] * 256 + (int)atomicAdd(X.ctl() + CW_CUR + l * 64 + e, 1u);
        pos = __shfl(pos, 0);
        if (lane == 0) slot[s] = pos;
        const u32x4* src = (const u32x4*)(X.ws<bf16>(WS_XMOD) + (size_t)t * D); u32x4* dst = (u32x4*)(X.ws<bf16>(WS_XG) + (size_t)pos * D);
        for (int i = lane; i < D / 8; i += 64) dst[i] = src[i]; }
}

__device__ __forceinline__ void phase_combine(const Ctx& X, int l) {
    const int gw = X.bid * NWAVES + X.wave, NGW = X.G * NWAVES, lane = X.lane;
    const float* lng = X.in(I_LNG) + (size_t)(l * 2 + 1) * D; const float* lnb = X.in(I_LNB) + (size_t)(l * 2 + 1) * D;
    const float alpha = sqrtf(sqrtf(2.0f * DEPTH));
    const float* ew = (const float*)(X.ws<int>(WS_ROUT) + (size_t)M * 2); const int* slot = X.ws<int>(WS_ROUT) + (size_t)M * 4;
    for (int t = gw; t < M; t += NGW) {
        float* xr = X.ws<float>(WS_X) + (size_t)t * D; const float* gate = modp(X, l, t, 5);
        const bf16* y0 = X.ws<bf16>(WS_YS) + (size_t)slot[2 * t] * D; const bf16* y1 = X.ws<bf16>(WS_YS) + (size_t)slot[2 * t + 1] * D; const float w0 = ew[2 * t], w1 = ew[2 * t + 1];
        float v[D / 64];
#pragma unroll
        for (int j = 0; j < D / 256; ++j) { const int d = 4 * lane + 256 * j; const f32x4 a = *(const f32x4*)(xr + d), gt = *(const f32x4*)(gate + d);
            const unsigned long long q0 = *(const unsigned long long*)(y0 + d), q1 = *(const unsigned long long*)(y1 + d);
            float ya[4] = {bflo((unsigned)q0), bfhi((unsigned)q0), bflo((unsigned)(q0 >> 32)), bfhi((unsigned)(q0 >> 32))};
            float yb[4] = {bflo((unsigned)q1), bfhi((unsigned)q1), bflo((unsigned)(q1 >> 32)), bfhi((unsigned)(q1 >> 32))};
#pragma unroll
            for (int i = 0; i < 4; ++i) v[4 * j + i] = alpha * a[i] + gt[i] * (w0 * ya[i] + w1 * yb[i]); }
        ln_inplace(v, lng, lnb, lane);
        if (l + 1 < DEPTH) { const float* sh = modp(X, l + 1, t, 0); const float* sc = modp(X, l + 1, t, 1); bf16* xm = X.ws<bf16>(WS_XMOD) + (size_t)t * D;
#pragma unroll
            for (int j = 0; j < D / 256; ++j) { const int d = 4 * lane + 256 * j; f32x4 o; const f32x4 a = *(const f32x4*)(sh + d), b = *(const f32x4*)(sc + d); float h[4];
#pragma unroll
                for (int i = 0; i < 4; ++i) { o[i] = v[4 * j + i]; h[i] = o[i] * (1.f + b[i]) + a[i]; }
                *(f32x4*)(xr + d) = o;
                *(unsigned long long*)(xm + d) = (unsigned long long)pk2(h[0], h[1]) | ((unsigned long long)pk2(h[2], h[3]) << 32); }
        } else if (t >= CTX) { float* orow = X.out() + (size_t)(t - CTX) * D; const bool bad = __hip_atomic_load(X.ctl() + CW_BAR + XB_TMO, RLX_AGENT) != 0u;
#pragma unroll
            for (int j = 0; j < D / 256; ++j) { const int d = 4 * lane + 256 * j; f32x4 o;
#pragma unroll
                for (int i = 0; i < 4; ++i) o[i] = bad ? __builtin_nanf("") : v[4 * j + i];
                *(f32x4*)(orow + d) = o; }
        }
    }
}


#ifdef EMU
#define PHASE_FN static
#define THIN_FN static
#else
#define PHASE_FN __device__ __forceinline__
#define THIN_FN __device__ __noinline__
#endif
THIN_FN void ph_transposes(Ctx X, int l) { phase_transposes(X, l); }
THIN_FN void ph_filters(Ctx X, int l) { phase_filters(X, l); }
THIN_FN void ph_mod(Ctx X) { phase_mod(X); }
THIN_FN void ph_x0(Ctx X) { phase_x0(X); }
THIN_FN void ph_prep_a(Ctx X, int l, int t0) { phase_prep_a(X, l, t0); }
THIN_FN void ph_prep_b(Ctx X, int l, int t0) { phase_prep_b(X, l, t0); }
THIN_FN void ph_prep_hyena(Ctx X, int l) { phase_prep_hyena(X, l); }
THIN_FN void ph_ctxconv(Ctx X, int l) { phase_ctxconv(X, l); }
THIN_FN void ph_chunk_1(Ctx X, int u) { chunk_unit_1(X, u); }
THIN_FN void ph_chunk_2(Ctx X, int u) { chunk_unit_2(X, u); }
THIN_FN void ph_chunk_3(Ctx X, int u) { chunk_unit_3(X, u); }
THIN_FN void ph_seq(Ctx X) { phase_seq(X); }
THIN_FN void ph_fftconv(Ctx X, int l) { phase_fftconv(X, l); }
THIN_FN void ph_spectra(Ctx X, int l) { phase_spectra(X, l); }
THIN_FN void ph_finish(Ctx X, int l) { phase_finish(X, l); }
THIN_FN void ph_norm1(Ctx X, int l) { phase_norm1(X, l); }
THIN_FN void ph_scatter(Ctx X, int l) { phase_scatter(X, l); }
THIN_FN void ph_combine(Ctx X, int l) { phase_combine(X, l); }
PHASE_FN void ph_g1(Ctx X) { pg8::Gemm g{X.ws<bf16>(WS_XMOD), X.ws<bf16>(WS_WIN), D}; pg8::StaticOrder S; S.init(M, PCP, X.G, X.bid); pg8::EpiBf16 E{X.ws<bf16>(WS_P), PCP}; pg8::gemm_phase(X.lds, g, S, E); }
PHASE_FN void ph_g2(Ctx X, int second) { pg8::Gemm g{second ? X.ws<bf16>(WS_HO) : X.ws<bf16>(WS_RO), X.ws<bf16>(WS_WB) + (second ? (size_t)D * RW : 0), RW}; pg8::StaticOrder S; S.init(M, D, X.G, X.bid);
    pg8::EpiGate E{X.ws<bf16>(WS_T), D, X.ws<bf16>(WS_P), PCP, second ? C_GH : C_GR, second != 0}; pg8::gemm_phase(X.lds, g, S, E); }
PHASE_FN void ph_g3(Ctx X) { pg8::Gemm g{X.ws<bf16>(WS_T), X.ws<bf16>(WS_WO), D}; pg8::StaticOrder S; S.init(M, D, X.G, X.bid); pg8::EpiF32 E{X.ws<float>(WS_MIX), D}; pg8::gemm_phase(X.lds, g, S, E); }
PHASE_FN void ph_g4(Ctx X, int l) { moe_table(X, l, 2 * D / 256); pg8::MoeOrder S{(const volatile LAS int*)(X.lds + LDS_MISC) + 8, 2 * D / 256, X.G, X.bid};
    pg8::Gemm g{X.ws<bf16>(WS_XG), X.ws<bf16>(WS_WGU), D}; pg8::EpiSwiglu E{X.ws<bf16>(WS_ACT), D, 2 * D / 256}; pg8::gemm_phase(X.lds, g, S, E); }
PHASE_FN void ph_g5(Ctx X, int l) { moe_table(X, l, D / 256); pg8::MoeOrder S{(const volatile LAS int*)(X.lds + LDS_MISC) + 8, D / 256, X.G, X.bid};
    pg8::Gemm g{X.ws<bf16>(WS_ACT), X.ws<bf16>(WS_WD), D}; pg8::EpiMoeDown E{X.ws<bf16>(WS_YS), D, D / 256}; pg8::gemm_phase(X.lds, g, S, E); }

constexpr int NPH = 15, NPHASES = DEPTH * NPH;
template <int MASK> __global__ void __launch_bounds__(NTHR, 2) fwd_kernel(Args args) {
    DYN_LDS(lds);
    Ctx X; X.lds = lds; X.tid = threadIdx.x; X.lane = X.tid & 63; X.wave = READFIRSTLANE(X.tid >> 6); X.G = gridDim.x; X.bid = blockIdx.x;
    volatile LAS unsigned* misc = (volatile LAS unsigned*)(lds + LDS_MISC);
    if (X.tid < 128) misc[X.tid] = 0u;
    if (X.tid < N_IN + 2) { const unsigned long long p = X.tid < N_IN ? (unsigned long long)args.in[X.tid < N_IN ? X.tid : 0] : (X.tid == N_IN ? (unsigned long long)args.out : (unsigned long long)args.ws);
        misc[PT_WORD0 + 2 * X.tid] = (unsigned)p; misc[PT_WORD0 + 2 * X.tid + 1] = (unsigned)(p >> 32); }
    __syncthreads();
    XcdBarrier bar = xcd_barrier_post(X.ctl() + CW_BAR, misc);
    const int lo = args.ph_lo, hi = args.ph_hi;
#define IN(k) ((((MASK) >> ((k) % NPH)) & 1) && lo <= (k) && (k) < hi)
#define SEAM(k) do { if ((k) + 1 < hi) xcd_barrier(bar); } while (0)
    for (int l = 0; l < DEPTH; ++l) {
        const int pb = l * NPH;
        if (IN(pb + 0)) { ph_transposes(X, l); __syncthreads(); ph_filters(X, l); if (l == 0) ph_mod(X); SEAM(pb + 0); }
        if (l == 0 && IN(pb + 1)) { ph_x0(X); SEAM(pb + 1); }
        if (IN(pb + 2)) { ph_g1(X); SEAM(pb + 2); }
        if (IN(pb + 3)) { for (int tile = X.bid; tile < M / TT; tile += X.G) { ph_prep_a(X, l, tile * TT); ph_prep_b(X, l, tile * TT); } ph_prep_hyena(X, l); ph_spectra(X, l); SEAM(pb + 3); }
        if (IN(pb + 4)) { for (int u = X.bid; u < 2 * NCHK * NH; u += X.G) { ph_chunk_1(X, u); ph_chunk_2(X, u); ph_chunk_3(X, u); } SEAM(pb + 4); }
        if (IN(pb + 5)) { ph_seq(X); ph_ctxconv(X, l); ph_fftconv(X, l); SEAM(pb + 5); }
        if (IN(pb + 6)) { ph_finish(X, l); SEAM(pb + 6); }
        for (int sb = 0; sb < 2; ++sb) if (IN(pb + 7 + sb)) { ph_g2(X, sb); SEAM(pb + 7 + sb); }
        if (IN(pb + 9)) { ph_g3(X); SEAM(pb + 9); }
        if (IN(pb + 10)) { ph_norm1(X, l); SEAM(pb + 10); }
        if (IN(pb + 11)) { ph_scatter(X, l); SEAM(pb + 11); }
        if (IN(pb + 12)) { ph_g4(X, l); SEAM(pb + 12); }
        if (IN(pb + 13)) { ph_g5(X, l); SEAM(pb + 13); }
        if (IN(pb + 14)) { ph_combine(X, l); SEAM(pb + 14); }
    }
#undef IN
#undef SEAM
}

#ifndef N_LAUNCHES
#define N_LAUNCHES 1
#endif
#ifndef PH_MASK
#define PH_MASK 0x7fff
#endif
template <int MASK> static void launch_mask(int grid, hipStream_t stream, const Args& a) {
    static bool attr = false;
    if (!attr) { (void)hipFuncSetAttribute((const void*)fwd_kernel<MASK>, hipFuncAttributeMaxDynamicSharedMemorySize, LDS_BYTES); attr = true; }
    hipLaunchKernelGGL(fwd_kernel<MASK>, dim3(grid), dim3(NTHR), LDS_BYTES, stream, a);
}
extern "C" void kernel_launch(void* const* d_in, const int* in_sizes, int n_in, void* d_out, int out_size, void* d_ws, size_t ws_size, hipStream_t stream) {
    static int grid = 0;
    if (grid == 0) {
        if (n_in != N_IN || ws_size < WS_END) { fprintf(stderr, "kernel_launch: unexpected n_in %d or workspace %zu < %zu\n", n_in, ws_size, (size_t)WS_END); grid = -1; return; }
        int dev = 0, cus = 0;
        if (hipGetDevice(&dev) != hipSuccess || hipDeviceGetAttribute(&cus, hipDeviceAttributeMultiprocessorCount, dev) != hipSuccess) { grid = -1; return; }
        (void)hipGetLastError();
        grid = cus; if (grid > NPART) grid = NPART;
    }
    if (grid < 0) return;
    (void)in_sizes; (void)out_size;
    (void)hipMemsetAsync(d_ws, 0, CTL_BYTES, stream);
    Args a;
    for (int i = 0; i < N_IN; ++i) a.in[i] = (const float*)d_in[i];
    a.out = (float*)d_out; a.ws = (unsigned char*)d_ws;
#if N_LAUNCHES == 1
    a.ph_lo = 0; a.ph_hi = NPHASES;
    launch_mask<PH_MASK>(grid, stream, a);
#else
    for (int ph = 0; ph < NPHASES; ++ph) { const int k = ph % NPH; if (k == 1 && ph / NPH != 0) continue; a.ph_lo = ph; a.ph_hi = ph + 1; launch_mask<PH_MASK>(grid, stream, a); }
#endif
}
```

```cpp
#ifndef EMU
#include <hip/hip_runtime.h>
#endif
#include <cstdio>
#include <cstdint>
#include <cmath>

#ifndef CFG_D
#define CFG_D 1024
#define CFG_SEQ 16384
#define CFG_CTX 256
#define CFG_DEPTH 4
#endif
constexpr int D = CFG_D, SEQ = CFG_SEQ, CTX = CFG_CTX, DEPTH = CFG_DEPTH, M = CTX + SEQ;
constexpr int GRID_W = 64, GRID_H = SEQ / GRID_W;
constexpr int RW = D / 2, NH = RW / 64, HW = D / 2, RC = 3 * RW + 384, HC = 3 * HW, GC = 2 * D, PC = RC + HC + GC, PCP = (PC + 255) / 256 * 256;
constexpr int QTR = RC / 4, HALFC = RC / 2;
constexpr int C_K = RW, C_V = 2 * RW, C_LWF = 3 * RW, C_LG = 3 * RW + 256;
constexpr int C_HY = RC, C_GR = RC + HC, C_GH = RC + HC + D;
constexpr int NE = 16, SP_TILES = (2 * M) / 256 + NE, SP = SP_TILES * 256;
constexpr float DECAY_SCALE = 0.606531f, GN_EPS = 6.4e-4f, LN_EPS = 1e-5f;
constexpr int N_SEQ_UNITS = 2 * NH * 4;
constexpr int NPART = 256;
static_assert(CTX % 32 == 0 && M % 256 == 0 && D % 256 == 0 && RW % 128 == 0 && RW >= 256 && SEQ % 64 == 0 && CTX % 32 == 0 && RC % 4 == 0, "shape assumptions");

enum { I_X = 0, I_C, I_CTX, I_CCTX, I_WMOD, I_BMOD, I_WIN, I_MU, I_W0, I_W2, I_A0, I_A2, I_G2, I_KK, I_KA, I_RK, I_LNXG, I_LNXB, I_CW, I_CB,
       I_FW1, I_FB1, I_FW2, I_FB2, I_FW3, I_FB3, I_FWO, I_FREQ, I_HBIAS, I_WBR, I_WOUT, I_LNG, I_LNB, I_WR, I_RB, I_WG, I_WU, I_WD, N_IN };

constexpr size_t al256(size_t x) { return (x + 255) & ~(size_t)255; }
constexpr size_t CTL_BYTES = 1u << 20;
constexpr size_t WS_MOD = CTL_BYTES;
constexpr size_t WS_FPART = al256(WS_MOD + (size_t)DEPTH * 2 * 6 * D * 4);
constexpr size_t WS_ROUT = al256(WS_FPART + (size_t)2 * NPART * HW * 4);
constexpr size_t WS_BCNT = al256(WS_ROUT + (size_t)M * 2 * 4 * 3);
constexpr size_t WS_BONUS = al256(WS_BCNT + (size_t)NPART * NE * 4);
constexpr size_t WS_WIN = al256(WS_BONUS + (size_t)M * NH * 4);
constexpr size_t WS_WB = al256(WS_WIN + (size_t)PCP * D * 2);
constexpr size_t WS_WO = al256(WS_WB + (size_t)2 * D * RW * 2);
constexpr size_t WS_WGU = al256(WS_WO + (size_t)D * D * 2);
constexpr size_t WS_WD = al256(WS_WGU + (size_t)NE * 2 * D * D * 2);
constexpr size_t WS_X = al256(WS_WD + (size_t)NE * D * D * 2);
constexpr size_t WS_XMOD = al256(WS_X + (size_t)M * D * 4);
constexpr size_t WS_P = al256(WS_XMOD + (size_t)M * D * 2);
constexpr size_t WS_FILT = al256(WS_P + (size_t)M * PCP * 2);
constexpr size_t WS_MIX = al256(WS_FILT + (size_t)M * HW * 4);
constexpr size_t WS_T = al256(WS_MIX + (size_t)M * D * 4);
constexpr size_t WS_S = al256(WS_T + (size_t)M * D * 2);
constexpr size_t WS_R = WS_S;
constexpr size_t WS_V = al256(WS_R + (size_t)M * RW * 2);
constexpr size_t WS_KA = al256(WS_V + (size_t)M * RW * 2);
constexpr size_t WS_KD = al256(WS_KA + (size_t)M * RW * 2);
constexpr size_t WS_KB = al256(WS_KD + (size_t)2 * M * RW * 2);
constexpr size_t WS_W = al256(WS_KB + (size_t)2 * M * RW * 2);
constexpr size_t WS_PQ = al256(WS_W + (size_t)2 * M * RW * 4);
constexpr size_t WS_G = al256(WS_PQ + (size_t)2 * NH * (M / 64) * 2 * 4096 * 4);
constexpr size_t WS_YL = al256(WS_G + (size_t)2 * NH * (M / 64) * 4096 * 2);
constexpr size_t WS_S0 = WS_XMOD;
static_assert((size_t)2 * NH * (M / 64) * 4096 * 2 <= (size_t)M * D * 2, "S0 fits XMOD");
constexpr size_t WS_Z = al256(WS_YL + (size_t)2 * NH * (M / 64) * 4096 * 4);
constexpr size_t WS_X0 = al256(WS_Z + (size_t)CTX * HW * 4);
constexpr size_t WS_CONV = al256(WS_X0 + (size_t)M * HW * 2);
constexpr size_t WS_GATE = al256(WS_CONV + (size_t)CTX * HW * 4);
constexpr size_t WS_RO = al256(WS_GATE + (size_t)M * RW * 2);
constexpr size_t WS_HO = al256(WS_RO + (size_t)M * RW * 2);
constexpr size_t WS_HS = WS_MIX;
constexpr size_t WS_ZT = WS_T;
constexpr size_t WS_CVT = WS_FILT;
static_assert((size_t)HW * (SEQ + 1) * 8 <= (size_t)M * D * 4 && (size_t)HW * M * 4 <= (size_t)M * D * 2, "HS fits MIX, ZT fits T");
constexpr size_t WS_END1 = al256(WS_HO + (size_t)M * HW * 2);
constexpr size_t WS_XG = WS_S;
constexpr size_t WS_ACT = al256(WS_XG + (size_t)SP * D * 2);
constexpr size_t WS_YS = al256(WS_ACT + (size_t)SP * D * 2);
constexpr size_t WS_END2 = al256(WS_YS + (size_t)SP * D * 2);
constexpr size_t WS_END = WS_END1 > WS_END2 ? WS_END1 : WS_END2;
constexpr int CW_TMO = 0, CW_BAR = 4096, CW_CNT = 8192  , CW_CUR = 8192 + 1024  , CW_Q = 8192 + 2048  ;

#ifdef EMU
#define LAS
typedef short bf16x8 __attribute__((vector_size(16)));
typedef float f32x4 __attribute__((vector_size(16)));
typedef unsigned u32x4 __attribute__((vector_size(16)));
#define DYN_LDS(name) unsigned char* name = emu_cur_lds()
#define ASM_WAIT_V(n) do {} while (0)
#define ASM_WAIT_L(n) do {} while (0)
#define ASM_WAIT_VL0() do {} while (0)
#define CFENCE() do {} while (0)
#define WAVE_LDS_FENCE() emu_wave_sync()
#define S_BARRIER() emu_block_sync()
#define SCHED_BARRIER() do {} while (0)
#define SETPRIO(x) do {} while (0)
#define S_SLEEP(n) emu_yield()
#define MFMA16(a, b, c) emu_mfma_16x16x32(a, b, c)
#define GLDS16(gptr, lptr) emu_glds16((const void*)(gptr), (void*)(lptr))
#define READFIRSTLANE(x) (x)
#define XCC_ID_() (blockIdx.x & 7u)
#define FENCE_RELEASE() do {} while (0)
#define FENCE_ACQUIRE() do {} while (0)
#define DPP_F(v, ctrl) emu_dpp_f(v, ctrl)
static inline int vgpr_zero() { return 0; }
static inline unsigned long long vgpr_zero64() { return 0ull; }
static inline int lds_add(volatile int* p, int v) { int o = *p; *p = o + v; return o; }
static inline unsigned fbits(float f) { unsigned u; memcpy(&u, &f, 4); return u; }
static inline float bitsf(unsigned u) { float f; memcpy(&f, &u, 4); return f; }
#else
#define LAS __attribute__((address_space(3)))
typedef short bf16x8 __attribute__((ext_vector_type(8)));
typedef float f32x4 __attribute__((ext_vector_type(4)));
typedef unsigned u32x4 __attribute__((ext_vector_type(4)));
#define DYN_LDS(name) extern __shared__ __attribute__((aligned(16))) unsigned char name##_raw[]; LAS unsigned char* name = (LAS unsigned char*)name##_raw
#define ASM_WAIT_V(n) asm volatile("s_waitcnt vmcnt(" #n ")" ::: "memory")
#define ASM_WAIT_L(n) asm volatile("s_waitcnt lgkmcnt(" #n ")" ::: "memory")
#define ASM_WAIT_VL0() asm volatile("s_waitcnt vmcnt(0) lgkmcnt(0)" ::: "memory")
#define CFENCE() asm volatile("" ::: "memory")
#define WAVE_LDS_FENCE() asm volatile("s_waitcnt lgkmcnt(0)" ::: "memory")
#define S_BARRIER() __builtin_amdgcn_s_barrier()
#define SCHED_BARRIER() __builtin_amdgcn_sched_barrier(0)
#define SETPRIO(x) __builtin_amdgcn_s_setprio(x)
#define S_SLEEP(n) __builtin_amdgcn_s_sleep(n)
#define MFMA16(a, b, c) __builtin_amdgcn_mfma_f32_16x16x32_bf16(a, b, c, 0, 0, 0)
#define GLDS16(gptr, lptr) __builtin_amdgcn_global_load_lds((const unsigned*)(gptr), (LAS unsigned*)(lptr), 16, 0, 0)
#define READFIRSTLANE(x) __builtin_amdgcn_readfirstlane(x)
#define XCC_ID_() ((unsigned)__builtin_amdgcn_s_getreg((3 << 11) | 20) & 0xFu)
#define FENCE_RELEASE() __builtin_amdgcn_fence(__ATOMIC_RELEASE, "agent")
#define FENCE_ACQUIRE() __builtin_amdgcn_fence(__ATOMIC_ACQUIRE, "agent")
#define DPP_F(v, ctrl) __builtin_bit_cast(float, __builtin_amdgcn_update_dpp(0, __builtin_bit_cast(int, (float)(v)), (ctrl), 0xF, 0xF, true))
__device__ __forceinline__ int vgpr_zero() { int z; asm volatile("v_mov_b32 %0, 0" : "=v"(z)); return z; }
__device__ __forceinline__ unsigned long long vgpr_zero64() { unsigned long long z; asm volatile("v_mov_b64 %0, 0" : "=v"(z)); return z; }
__device__ __forceinline__ int lds_add(volatile LAS int* p, int v) { return __hip_atomic_fetch_add((LAS int*)p, v, __ATOMIC_RELAXED, __HIP_MEMORY_SCOPE_WORKGROUP); }
__device__ __forceinline__ unsigned fbits(float f) { return __builtin_bit_cast(unsigned, f); }
__device__ __forceinline__ float bitsf(unsigned u) { return __builtin_bit_cast(float, u); }
#endif
typedef unsigned short bf16;
#define RLX_AGENT __ATOMIC_RELAXED, __HIP_MEMORY_SCOPE_AGENT

__device__ __forceinline__ unsigned f2bf(float f) { unsigned u = fbits(f); return (u + 0x7fffu + ((u >> 16) & 1u)) >> 16; }
__device__ __forceinline__ unsigned pk2(float lo, float hi) { return f2bf(lo) | (f2bf(hi) << 16); }
__device__ __forceinline__ float bf2f(bf16 b) { return bitsf(((unsigned)b) << 16); }
__device__ __forceinline__ float bflo(unsigned w) { return bitsf(w << 16); }
__device__ __forceinline__ float bfhi(unsigned w) { return bitsf(w & 0xffff0000u); }
__device__ __forceinline__ float sigmoidf_(float x) { return 1.0f / (1.0f + expf(-x)); }
__device__ __forceinline__ float wave_sum(float v) {
#pragma unroll
    for (int o = 1; o < 64; o <<= 1) v += __shfl_xor(v, o);
    return v;
}
__device__ __forceinline__ float row16_sum(float v) {
    v += DPP_F(v, 0xB1);
    v += DPP_F(v, 0x4E);
    v += DPP_F(v, 0x141);
    v += DPP_F(v, 0x140);
    return v;
}
__device__ __forceinline__ void sincos_f(float x, float& s, float& c) {
    const float k = rintf(x * 0.63661977236758134f);
    float r = fmaf(-k, 1.5703125f, x); r = fmaf(-k, 4.837512969970703125e-4f, r); r = fmaf(-k, 7.54978994989188216e-8f, r);
    const float r2 = r * r;
    const float sp = r + r * r2 * (-1.6666654611e-1f + r2 * (8.3321608736e-3f + r2 * (-1.9515295891e-4f)));
    const float cp = 1.0f - 0.5f * r2 + r2 * r2 * (4.166664568298827e-2f + r2 * (-1.388731625493765e-3f + r2 * (2.443315711809948e-5f)));
    const int q = ((int)k) & 3;
    s = (q == 0) ? sp : (q == 1) ? cp : (q == 2) ? -sp : -cp;
    c = (q == 0) ? cp : (q == 1) ? -sp : (q == 2) ? -cp : sp;
}
__device__ __forceinline__ float sin_f(float x) { float s, c; sincos_f(x, s, c); return s; }

#define XB_TMO      128
#define XB_XCNT(j)  (256  + 64 * (j))
#define XB_XSUB(j)  (1280 + 64 * (j))
#define XB_XGEN(j)  (2304 + 64 * (j))
#define XB_TOP      3328
#define XB_TOPGEN   3392
#define XCD_BAR_WORDS 3456
#define XB_SPIN_CAP (1u << 18)
__device__ __forceinline__ unsigned xb_ld(unsigned* p)              { return __hip_atomic_load(p, __ATOMIC_RELAXED, __HIP_MEMORY_SCOPE_AGENT); }
__device__ __forceinline__ unsigned xb_add(unsigned* p, unsigned v) { return __hip_atomic_fetch_add(p, v, __ATOMIC_RELAXED, __HIP_MEMORY_SCOPE_AGENT); }
#define XB_SPIN(cond, bar) do { unsigned _sp = 0; while (cond) { S_SLEEP(1); \
    if ((++_sp & 255u) == 0u) { if (xb_ld(&(bar)[XB_TMO])) break; if (_sp > XB_SPIN_CAP) { atomicAdd(&(bar)[XB_TMO], 1u); break; } } } } while (0)
struct XcdBarrier { unsigned* bar; unsigned x; volatile LAS unsigned* st; };
__device__ __forceinline__ XcdBarrier xcd_barrier_post(unsigned* bar, volatile LAS unsigned* st) {
    XcdBarrier b; b.bar = nullptr; b.x = XCC_ID_(); b.st = st;
    if (threadIdx.x == 0) { st[2] = (unsigned)(unsigned long long)bar; st[3] = (unsigned)((unsigned long long)bar >> 32); st[4] = b.x; (void)xb_add(&bar[XB_XCNT(b.x)], 1u); }
    return b;
}
__device__ __forceinline__ void xcd_barrier_complete(unsigned* bar, unsigned x, unsigned& nloc, unsigned& nx) {
    const unsigned G = gridDim.x * gridDim.y * gridDim.z;
    unsigned sum, cnt, mine, sp = 0u;
    for (;;) {
        sum = 0u; cnt = 0u; mine = 0u;
#pragma unroll
        for (unsigned j = 0; j < 16; ++j) { const unsigned c = xb_ld(&bar[XB_XCNT(j)]); sum += c; cnt += (c > 0u) ? 1u : 0u; mine = (j == x) ? c : mine; }
        if (sum == G) break;
        S_SLEEP(1);
        if ((++sp & 255u) == 0u) { if (xb_ld(&bar[XB_TMO])) break; if (sp > XB_SPIN_CAP) { atomicAdd(&bar[XB_TMO], 1u); break; } }
    }
    nloc = mine > 0u ? mine : 1u; nx = cnt > 0u ? cnt : 1u;
}
__device__ __forceinline__ void xcd_barrier(const XcdBarrier& b) {
    ASM_WAIT_V(0);
    __syncthreads();
    if (threadIdx.x == 0) {
        unsigned* bar = (unsigned*)(((unsigned long long)b.st[3] << 32) | b.st[2]);
        const unsigned bx = b.st[4];
        ASM_WAIT_VL0();
        unsigned nloc = b.st[0], nx = b.st[1];
        if (nloc == 0u) { xcd_barrier_complete(bar, bx, nloc, nx); b.st[0] = nloc; b.st[1] = nx; }
        const unsigned old = xb_add(&bar[XB_XSUB(bx)], 1u);
        const unsigned gen = old / nloc;
        if (old + 1u == (gen + 1u) * nloc) {
            FENCE_RELEASE();
            ASM_WAIT_V(0);
            const unsigned og = xb_add(&bar[XB_TOP], 1u);
            const unsigned tg = og / nx;
            if (og + 1u == (tg + 1u) * nx) xb_add(&bar[XB_TOPGEN], 1u);
            else XB_SPIN(xb_ld(&bar[XB_TOPGEN]) == tg, bar);
            FENCE_ACQUIRE();
            xb_add(&bar[XB_XGEN(bx)], 1u);
            ASM_WAIT_V(0);
        } else {
            XB_SPIN(xb_ld(&bar[XB_XGEN(bx)]) == gen, bar);
            FENCE_ACQUIRE();
            ASM_WAIT_V(0);
        }
    }
    __syncthreads();
}

namespace pg8 {
constexpr int BM = 256, BK = 64, HALF = 128, HTB = HALF * BK * 2, STAGE_BYTES = 8 * HTB, NXCD = 8, WGM = 8;
__host__ __device__ __forceinline__ int lds_byte(int r, int c) { const int st = (r >> 4) * 2 + (c >> 5), rr = r & 15, cc = c & 31, ob = rr * 64 + cc * 2; return st * 1024 + (ob ^ (((ob >> 9) & 1) << 5)); }
__host__ __device__ __forceinline__ void stage_rc(int b, int& R, int& C) { const int st = b / 1024, sb = b % 1024, swz = sb ^ (((sb >> 9) & 1) << 5); R = (st >> 1) * 16 + swz / 64; C = (st & 1) * 32 + (swz % 64) / 2; }
__host__ __device__ __forceinline__ int perm32(int rho) { const int n = rho >> 4, i = rho & 15; return 8 * (i >> 2) + 4 * n + (i & 3); }
struct Unit { int pm, pn; };
struct Gemm { const bf16* A; const bf16* Bt; int K; };
struct StaticOrder {
    int nM, nN, nwg, G, c;
    __host__ __device__ void init(int M_, int N_, int G_, int c_) { nM = M_ / BM; nN = N_ / BM; nwg = nM * nN; G = G_; c = c_; }
    __host__ __device__ bool next(int i, Unit& u) const {
        const long L = (long)i * G + c; if (L >= nwg) return false;
        int wgid = (int)L; { const int q = nwg / NXCD, r = nwg % NXCD, xcd = wgid % NXCD, off = wgid / NXCD; wgid = (xcd < r ? xcd * (q + 1) : r * (q + 1) + (xcd - r) * q) + off; }
        const int nig = WGM * nN, gid = wgid / nig, fm = gid * WGM, gsz = (nM - fm) < WGM ? (nM - fm) : WGM;
        u.pm = fm + ((wgid % nig) % gsz); u.pn = (wgid % nig) / gsz; return true;
    }
};
struct MoeOrder {
    const volatile LAS int* tab; int NT, G, c;
    __device__ __forceinline__ bool next(int i, Unit& u) const {
        const long L = (long)i * G + c; if (L >= tab[16]) return false;
        int e = 0; while (L >= tab[e + 1]) ++e;
        const int loc = (int)L - tab[e], tc = tab[64 + e];
        u.pm = tab[32 + e] + loc % tc; u.pn = e * NT + loc / tc; return true;
    }
};
__device__ __forceinline__ unsigned cvt_pk_bf16(float lo, float hi) {
#ifdef EMU
    return pk2(lo, hi);
#else
    unsigned r; asm volatile("v_cvt_pk_bf16_f32 %0, %1, %2" : "=v"(r) : "v"(lo), "v"(hi)); return r;
#endif
}

struct EpiBf16 {
    static constexpr bool PERM = true;
    bf16* O; int ldc;
    __device__ __forceinline__ void operator()(const f32x4 (&acc)[2][2][4][2], const Unit& u, int wr, int wc, int fr, int fq) const {
        const int row0 = u.pm * BM + wr * 64 + fr, col0 = u.pn * BM + wc * 32 + 8 * fq;
#pragma unroll
        for (int ai = 0; ai < 2; ++ai)
#pragma unroll
            for (int m = 0; m < 4; ++m) { bf16* rowp = O + (size_t)(row0 + ai * HALF + m * 16) * ldc + col0;
#pragma unroll
                for (int bj = 0; bj < 2; ++bj) { const f32x4 v0 = acc[ai][bj][m][0], v1 = acc[ai][bj][m][1];
                    u32x4 w; w[0] = cvt_pk_bf16(v0[0], v0[1]); w[1] = cvt_pk_bf16(v0[2], v0[3]); w[2] = cvt_pk_bf16(v1[0], v1[1]); w[3] = cvt_pk_bf16(v1[2], v1[3]);
                    *(u32x4*)(rowp + bj * HALF) = w; } }
    }
};
struct EpiF32 {
    static constexpr bool PERM = true;
    float* C; int ldc;
    __device__ __forceinline__ void operator()(const f32x4 (&acc)[2][2][4][2], const Unit& u, int wr, int wc, int fr, int fq) const {
        const int row0 = u.pm * BM + wr * 64 + fr, col0 = u.pn * BM + wc * 32 + 8 * fq;
#pragma unroll
        for (int ai = 0; ai < 2; ++ai)
#pragma unroll
            for (int m = 0; m < 4; ++m) { float* rowp = C + (size_t)(row0 + ai * HALF + m * 16) * ldc + col0;
#pragma unroll
                for (int bj = 0; bj < 2; ++bj)
#pragma unroll
                    for (int n = 0; n < 2; ++n) *(f32x4*)(rowp + bj * HALF + n * 4) = acc[ai][bj][m][n]; }
    }
};
struct EpiGate {
    static constexpr bool PERM = true;
    bf16* T; int ldc; const bf16* Pg; int ldp; int gcol0; bool ADD;
    __device__ __forceinline__ void operator()(const f32x4 (&acc)[2][2][4][2], const Unit& u, int wr, int wc, int fr, int fq) const {
        const int row0 = u.pm * BM + wr * 64 + fr, col0 = u.pn * BM + wc * 32 + 8 * fq;
#pragma unroll
        for (int ai = 0; ai < 2; ++ai)
#pragma unroll
            for (int m = 0; m < 4; ++m) { const size_t row = (size_t)(row0 + ai * HALF + m * 16);
#pragma unroll
                for (int bj = 0; bj < 2; ++bj) { const f32x4 v0 = acc[ai][bj][m][0], v1 = acc[ai][bj][m][1];
                    const u32x4 g = *(const u32x4*)(Pg + row * ldp + gcol0 + col0 + bj * HALF);
                    u32x4 t = {0u, 0u, 0u, 0u}; if (ADD) t = *(const u32x4*)(T + row * ldc + col0 + bj * HALF);
                    float o[8];
#pragma unroll
                    for (int j = 0; j < 4; ++j) { const float a0 = j < 2 ? v0[2 * j] : v1[2 * j - 4], a1 = j < 2 ? v0[2 * j + 1] : v1[2 * j - 3];
                        o[2 * j] = bflo(t[j]) + sigmoidf_(bflo(g[j])) * a0; o[2 * j + 1] = bfhi(t[j]) + sigmoidf_(bfhi(g[j])) * a1; }
                    u32x4 w; w[0] = cvt_pk_bf16(o[0], o[1]); w[1] = cvt_pk_bf16(o[2], o[3]); w[2] = cvt_pk_bf16(o[4], o[5]); w[3] = cvt_pk_bf16(o[6], o[7]);
                    *(u32x4*)(T + row * ldc + col0 + bj * HALF) = w; } }
    }
};
struct EpiSwiglu {
    static constexpr bool PERM = true;
    bf16* O; int ldc; int NT;
    __device__ __forceinline__ void operator()(const f32x4 (&acc)[2][2][4][2], const Unit& u, int wr, int wc, int fr, int fq) const {
        const int row0 = u.pm * BM + wr * 64 + fr, col0 = (u.pn % NT) * HALF + wc * 32 + 8 * fq;
#pragma unroll
        for (int ai = 0; ai < 2; ++ai)
#pragma unroll
            for (int m = 0; m < 4; ++m) { bf16* rowp = O + (size_t)(row0 + ai * HALF + m * 16) * ldc + col0;
                float o[8];
#pragma unroll
                for (int j = 0; j < 8; ++j) { const float g = acc[ai][0][m][j >> 2][j & 3], uu = acc[ai][1][m][j >> 2][j & 3]; o[j] = g / (1.0f + expf(-g)) * uu; }
                u32x4 w; w[0] = cvt_pk_bf16(o[0], o[1]); w[1] = cvt_pk_bf16(o[2], o[3]); w[2] = cvt_pk_bf16(o[4], o[5]); w[3] = cvt_pk_bf16(o[6], o[7]);
                *(u32x4*)rowp = w; }
    }
};
struct EpiMoeDown {
    static constexpr bool PERM = true;
    bf16* O; int ldc; int NT;
    __device__ __forceinline__ void operator()(const f32x4 (&acc)[2][2][4][2], const Unit& u, int wr, int wc, int fr, int fq) const {
        const int row0 = u.pm * BM + wr * 64 + fr, col0 = (u.pn % NT) * BM + wc * 32 + 8 * fq;
#pragma unroll
        for (int ai = 0; ai < 2; ++ai)
#pragma unroll
            for (int m = 0; m < 4; ++m) { bf16* rowp = O + (size_t)(row0 + ai * HALF + m * 16) * ldc + col0;
#pragma unroll
                for (int bj = 0; bj < 2; ++bj) { const f32x4 v0 = acc[ai][bj][m][0], v1 = acc[ai][bj][m][1];
                    u32x4 w; w[0] = cvt_pk_bf16(v0[0], v0[1]); w[1] = cvt_pk_bf16(v0[2], v0[3]); w[2] = cvt_pk_bf16(v1[0], v1[1]); w[3] = cvt_pk_bf16(v1[2], v1[3]);
                    *(u32x4*)(rowp + bj * HALF) = w; } }
    }
};

struct EpiBf16OrF32 { static constexpr bool PERM = true; bf16* O; float* C; int ldc; bool f32;
    __device__ __forceinline__ void operator()(const f32x4 (&acc)[2][2][4][2], const Unit& u, int wr, int wc, int fr, int fq) const {
        if (f32) { EpiF32 E{C, ldc}; E(acc, u, wr, wc, fr, fq); } else { EpiBf16 E{O, ldc}; E(acc, u, wr, wc, fr, fq); } } };
struct EpiMoe { static constexpr bool PERM = true; bf16* O; int ldc; int NT; bool swiglu;
    __device__ __forceinline__ void operator()(const f32x4 (&acc)[2][2][4][2], const Unit& u, int wr, int wc, int fr, int fq) const {
        if (swiglu) { EpiSwiglu E{O, ldc, NT}; E(acc, u, wr, wc, fr, fq); } else { EpiMoeDown E{O, ldc, NT}; E(acc, u, wr, wc, fr, fq); } } };
template <class Epi, class Sched>
__device__ __forceinline__ void gemm_phase(LAS unsigned char* lds, const Gemm g, const Sched& S, const Epi& E) {
    const int tid = threadIdx.x + vgpr_zero();
    const int wid = READFIRSTLANE(tid >> 6), lane = tid & 63, wr = wid >> 2, wc = wid & 3, fr = lane & 15, fq = lane >> 4;
    const int K = g.K, nt = K / BK;
    unsigned long long voffA[2], voffB[2]; const unsigned long long zhi = vgpr_zero64();
#pragma unroll
    for (int i = 0; i < 2; ++i) { int R, C; stage_rc(tid * 16 + i * 8192, R, C); const int Rb = Epi::PERM ? ((R & ~31) + perm32(R & 31)) : R;
        voffA[i] = zhi + (unsigned long long)(long long)((R * K + C) * 2); voffB[i] = zhi + (unsigned long long)(long long)((Rb * K + C) * 2); }
    const size_t kstep = (size_t)(BK * 2);
    const size_t hstep = (size_t)HALF * K * 2;
    const size_t tstep = 2 * hstep;
    const unsigned ldsw = (unsigned)wid * 1024u;
    const int aoff = lds_byte(wr * 64 + fr, fq * 8), boff = lds_byte(wc * 32 + fr, fq * 8);
#define PG8_SA(b, h) (((b) * 2 + (h)) * HTB)
#define PG8_SB(b, h) ((4 + (b) * 2 + (h)) * HTB)
#define PG8_STAGE(bufoff, gbase, voff) do { _Pragma("unroll") for (int _i = 0; _i < 2; ++_i) \
        GLDS16((const char*)(gbase) + (voff)[_i], lds + (bufoff) + ldsw + _i * 8192); } while (0)
#define PG8_LDA(dst, b, h) do { _Pragma("unroll") for (int m = 0; m < 4; ++m) _Pragma("unroll") for (int k = 0; k < 2; ++k) dst[m][k] = *(const LAS bf16x8*)(lds + PG8_SA(b, h) + aoff + m * 2048 + k * 1024); } while (0)
#define PG8_LDB(dst, b, h) do { _Pragma("unroll") for (int n = 0; n < 2; ++n) _Pragma("unroll") for (int k = 0; k < 2; ++k) dst[n][k] = *(const LAS bf16x8*)(lds + PG8_SB(b, h) + boff + n * 2048 + k * 1024); } while (0)
#define PG8_MMA(ai, bj, At, Bt) do { SETPRIO(1); _Pragma("unroll") for (int m = 0; m < 4; ++m) _Pragma("unroll") for (int n = 0; n < 2; ++n) _Pragma("unroll") for (int k = 0; k < 2; ++k) \
        acc[ai][bj][m][n] = MFMA16(Bt[n][k], At[m][k], acc[ai][bj][m][n]); SETPRIO(0); } while (0)
#define PG8_BAR S_BARRIER()
    Unit cur, nxt; int ui = 0;
    if (!S.next(0, cur)) return;
    f32x4 acc[2][2][4][2];
#pragma unroll
    for (int a = 0; a < 2; ++a)
#pragma unroll
        for (int b = 0; b < 2; ++b)
#pragma unroll
            for (int m = 0; m < 4; ++m)
#pragma unroll
                for (int n = 0; n < 2; ++n) acc[a][b][m][n] = (f32x4){0.f, 0.f, 0.f, 0.f};
    bf16x8 At[4][2], B0[2][2], B1[2][2];
    const char* cA = (const char*)g.A + (size_t)cur.pm * tstep; const char* cB = (const char*)g.Bt + (size_t)cur.pn * tstep;
    PG8_STAGE(PG8_SB(0, 0), cB, voffB); PG8_STAGE(PG8_SA(0, 0), cA, voffA); PG8_STAGE(PG8_SB(0, 1), cB + hstep, voffB); PG8_STAGE(PG8_SA(0, 1), cA + hstep, voffA);
    if (wr == 1) PG8_BAR;
    ASM_WAIT_V(4); PG8_BAR;
    PG8_STAGE(PG8_SB(1, 0), cB + kstep, voffB); PG8_STAGE(PG8_SA(1, 0), cA + kstep, voffA); PG8_STAGE(PG8_SB(1, 1), cB + hstep + kstep, voffB);
    ASM_WAIT_V(6); PG8_BAR;
    for (;;) {
        const bool has_next = S.next(ui + 1, nxt);
        const char* nA = has_next ? (const char*)g.A + (size_t)nxt.pm * tstep : cA; const char* nB = has_next ? (const char*)g.Bt + (size_t)nxt.pn * tstep : cB;
        for (int t = 0; t < nt; t += 2) {
            const bool last = (t == nt - 2);
            const char* a1 = cA + (size_t)(t + 1) * kstep;
            const char* a2 = last ? nA : cA + (size_t)(t + 2) * kstep; const char* b2 = last ? nB : cB + (size_t)(t + 2) * kstep;
            const char* a3 = a2 + kstep; const char* b3 = b2 + kstep;
            PG8_LDB(B0, 0, 0); SCHED_BARRIER(); PG8_LDA(At, 0, 0); PG8_STAGE(PG8_SA(1, 1), a1 + hstep, voffA);
            ASM_WAIT_L(8); PG8_BAR; ASM_WAIT_L(0); PG8_MMA(0, 0, At, B0); PG8_BAR; SCHED_BARRIER();
            PG8_LDB(B1, 0, 1); PG8_STAGE(PG8_SB(0, 0), b2, voffB);
            PG8_BAR; ASM_WAIT_L(0); PG8_MMA(0, 1, At, B1); PG8_BAR;
            PG8_LDA(At, 0, 1); PG8_STAGE(PG8_SA(0, 0), a2, voffA);
            PG8_BAR; ASM_WAIT_L(0); PG8_MMA(1, 0, At, B0); PG8_BAR; SCHED_BARRIER();
            PG8_STAGE(PG8_SB(0, 1), b2 + hstep, voffB);
            ASM_WAIT_V(6); PG8_BAR; PG8_MMA(1, 1, At, B1); PG8_BAR;
            PG8_LDB(B0, 1, 0); SCHED_BARRIER(); PG8_LDA(At, 1, 0); PG8_STAGE(PG8_SA(0, 1), a2 + hstep, voffA);
            ASM_WAIT_L(8); PG8_BAR; ASM_WAIT_L(0); PG8_MMA(0, 0, At, B0); PG8_BAR; SCHED_BARRIER();
            PG8_LDB(B1, 1, 1); PG8_STAGE(PG8_SB(1, 0), b3, voffB);
            PG8_BAR; ASM_WAIT_L(0); PG8_MMA(0, 1, At, B1); PG8_BAR;
            PG8_LDA(At, 1, 1); PG8_STAGE(PG8_SA(1, 0), a3, voffA);
            PG8_BAR; ASM_WAIT_L(0); PG8_MMA(1, 0, At, B0); PG8_BAR; SCHED_BARRIER();
            PG8_STAGE(PG8_SB(1, 1), b3 + hstep, voffB);
            ASM_WAIT_V(6); PG8_BAR; PG8_MMA(1, 1, At, B1); PG8_BAR;
        }
        E(acc, cur, wr, wc, fr, fq);
        if (!has_next) break;
#pragma unroll
        for (int a = 0; a < 2; ++a)
#pragma unroll
            for (int b = 0; b < 2; ++b)
#pragma unroll
                for (int m = 0; m < 4; ++m)
#pragma unroll
                    for (int n = 0; n < 2; ++n) acc[a][b][m][n] = (f32x4){0.f, 0.f, 0.f, 0.f};
        cur = nxt; cA = nA; cB = nB; ++ui;
    }
    ASM_WAIT_V(0);
    if (wr == 0) PG8_BAR;
    PG8_BAR;
#undef PG8_SA
#undef PG8_SB
#undef PG8_STAGE
#undef PG8_LDA
#undef PG8_LDB
#undef PG8_MMA
#undef PG8_BAR
}
}

struct Args { const float* in[N_IN]; float* out; unsigned char* ws; int ph_lo, ph_hi; };
constexpr int NWAVES = 8, NTHR = 512;
constexpr int LDS_STAGE = 131072, LDS_MISC = LDS_STAGE, LDS_BYTES = 147456;

constexpr int PT_OUT = N_IN, PT_WS = N_IN + 1, PT_WORD0 = 128;
struct Ctx {
    LAS unsigned char* lds; int tid, lane, wave, G, bid;
    __device__ __forceinline__ unsigned long long ptr(int i) const { const volatile LAS unsigned* t = (const volatile LAS unsigned*)(lds + LDS_MISC) + PT_WORD0 + 2 * i;
        const unsigned lo = (unsigned)READFIRSTLANE((int)t[0]), hi = (unsigned)READFIRSTLANE((int)t[1]); return ((unsigned long long)hi << 32) | lo; }
    __device__ __forceinline__ unsigned long long ptrv(int i) const { const volatile LAS unsigned* t = (const volatile LAS unsigned*)(lds + LDS_MISC) + PT_WORD0 + 2 * i; return ((unsigned long long)t[1] << 32) | t[0]; }
    __device__ __forceinline__ const float* inv(int i) const { return (const float*)ptrv(i); }
    template <class T> __device__ __forceinline__ T* wsv(size_t off) const { return (T*)((unsigned char*)ptrv(PT_WS) + off); }
    __device__ __forceinline__ const float* in(int i) const { return (const float*)ptr(i); }
    __device__ __forceinline__ float* out() const { return (float*)ptr(PT_OUT); }
    template <class T> __device__ __forceinline__ T* ws(size_t off) const { return (T*)((unsigned char*)ptr(PT_WS) + off); }
    __device__ __forceinline__ unsigned* ctl() const { return (unsigned*)ptr(PT_WS); }
};

__device__ __forceinline__ void transpose_item(const float* W, int ldw, int k0, int n0, int nvalid, bf16* outp, int ldo, LAS float* scr, int lane) {
#pragma unroll
    for (int i = 0; i < 32; ++i) { const int kk = 2 * i + (lane >> 5), n = n0 + (lane & 31); scr[kk * 33 + (lane & 31)] = (n < nvalid) ? W[(size_t)(k0 + kk) * ldw + n] : 0.f; }
    WAVE_LDS_FENCE(); CFENCE();
    const int c = lane & 7;
#pragma unroll
    for (int j = 0; j < 4; ++j) { const int n = (lane >> 3) + 8 * j; const LAS float* s = scr + (8 * c) * 33 + n;
        u32x4 o; o[0] = pk2(s[0 * 33], s[1 * 33]); o[1] = pk2(s[2 * 33], s[3 * 33]); o[2] = pk2(s[4 * 33], s[5 * 33]); o[3] = pk2(s[6 * 33], s[7 * 33]);
        *(u32x4*)(outp + (size_t)n * ldo + k0 + 8 * c) = o; }
    WAVE_LDS_FENCE(); CFENCE();
}
__device__ __forceinline__ void filter_item(const Ctx& X, int l, int n, int pos0, float* out  , LAS float* scr  , LAS float* asum  ) {
    const int lane = X.lane;
    LAS float* zs = scr; LAS float* ha = scr + 8 * 33; LAS float* hb = ha + 8 * 64;
    const float* w1 = X.in(I_FW1) + (size_t)l * 33 * 64; const float* b1 = X.in(I_FB1) + l * 64;
    const float* w2 = X.in(I_FW2) + (size_t)l * 64 * 64; const float* b2 = X.in(I_FB2) + l * 64;
    const float* w3 = X.in(I_FW3) + (size_t)l * 64 * 64; const float* b3 = X.in(I_FB3) + l * 64;
    const float* wo = X.in(I_FWO) + (size_t)l * 64 * HW; const float fr = X.in(I_FREQ)[l * 64 + lane];
    if (lane < 33) {
#pragma unroll
        for (int p = 0; p < 8; ++p) { const int pos = pos0 + p; float v;
            if (lane == 0) v = (float)pos / (float)(n - 1 > 1 ? n - 1 : 1);
            else { const int b = (lane - 1) & 15; const double band = 1e-4 + (double)b * ((15.0 - 1e-4) / 15.0);
                double rev = (double)pos * band / (double)n; rev -= floor(rev); if (rev > 0.5) rev -= 1.0;
                float s, c; sincos_f((float)(rev * 6.283185307179586476925), s, c); v = lane <= 16 ? c : -s; }
            zs[p * 33 + lane] = v; }
    }
    WAVE_LDS_FENCE(); CFENCE();
    float acc[8];
    { const float bb = b1[lane];
#pragma unroll
      for (int p = 0; p < 8; ++p) acc[p] = bb;
#pragma unroll 3
      for (int i = 0; i < 33; ++i) { const float w = w1[i * 64 + lane];
#pragma unroll
          for (int p = 0; p < 8; ++p) acc[p] += zs[p * 33 + i] * w; }
#pragma unroll
      for (int p = 0; p < 8; ++p) ha[p * 64 + lane] = sin_f(fr * acc[p]); }
    WAVE_LDS_FENCE(); CFENCE();
    { const float bb = b2[lane];
#pragma unroll
      for (int p = 0; p < 8; ++p) acc[p] = bb;
#pragma unroll 4
      for (int i = 0; i < 64; ++i) { const float w = w2[i * 64 + lane];
#pragma unroll
          for (int p = 0; p < 8; ++p) acc[p] += ha[p * 64 + i] * w; }
#pragma unroll
      for (int p = 0; p < 8; ++p) hb[p * 64 + lane] = sin_f(fr * acc[p]); }
    WAVE_LDS_FENCE(); CFENCE();
    { const float bb = b3[lane];
#pragma unroll
      for (int p = 0; p < 8; ++p) acc[p] = bb;
#pragma unroll 4
      for (int i = 0; i < 64; ++i) { const float w = w3[i * 64 + lane];
#pragma unroll
          for (int p = 0; p < 8; ++p) acc[p] += hb[p * 64 + i] * w; }
#pragma unroll
      for (int p = 0; p < 8; ++p) ha[p * 64 + lane] = sin_f(fr * acc[p]); }
    WAVE_LDS_FENCE(); CFENCE();
    const float dmin = -3.0701134573253944f, dmax = -15.350567286626972f;
#pragma unroll 1
    for (int mI = 0; mI < HW / 64; ++mI) { const int c = lane + 64 * mI;
#pragma unroll
        for (int p = 0; p < 8; ++p) acc[p] = 0.f;
#pragma unroll 4
        for (int i = 0; i < 64; ++i) { const float w = wo[i * HW + c];
#pragma unroll
            for (int p = 0; p < 8; ++p) acc[p] += ha[p * 64 + i] * w; }
        const float delta = fabsf(dmin + (float)c * ((dmax - dmin) / (float)(HW - 1)));
        float as = 0.f;
#pragma unroll
        for (int p = 0; p < 8; ++p) { const int pos = pos0 + p; const int dd = pos - n / 2; const float dist = (float)(dd < 0 ? -dd : dd) * (2.0f / (float)n);
            const float v = acc[p] * expf(-dist * delta); out[(size_t)c * n + pos] = v; as += fabsf(v); }
        asum[c] += as; }
    WAVE_LDS_FENCE(); CFENCE();
}
__device__ __forceinline__ void phase_transposes(const Ctx& X, int l, int part) {
    LAS float* scr = (LAS float*)(X.lds + X.wave * 16384);
    const bool shifted = part == 1 && X.G > N_SEQ_UNITS; const int myb = shifted ? X.bid - N_SEQ_UNITS : X.bid, nb_ = shifted ? X.G - N_SEQ_UNITS : X.G;
    if (myb < 0) return;
    const int gw = myb * NWAVES + X.wave, NGW = nb_ * NWAVES, lane = X.lane;
    constexpr int KB_D = D / 64, I_WIN_ = KB_D * (PCP / 32), I_WB_ = 2 * (RW / 64) * (D / 32), I_WO_ = KB_D * (D / 32), I_WGU_ = NE * 2 * KB_D * (D / 32), I_WD_ = NE * KB_D * (D / 32);
    constexpr int N0 = I_WIN_ + I_WB_ + I_WO_, NITEMS = N0 + I_WGU_ + I_WD_;
    for (int it = (part ? N0 : 0) + gw; it < (part ? NITEMS : N0); it += NGW) {
        int r = it; const float* W; int ldw, k0, n0, nvalid, ldo; bf16* outp;
        if (r < I_WIN_) { const int nb = r % (PCP / 32), kb = r / (PCP / 32); W = X.in(I_WIN) + (size_t)l * D * PC; ldw = PC; k0 = 64 * kb; n0 = 32 * nb; nvalid = PC; outp = X.ws<bf16>(WS_WIN) + (size_t)n0 * D; ldo = D; }
        else if ((r -= I_WIN_) < I_WB_) { const int s = r / ((RW / 64) * (D / 32)), q = r % ((RW / 64) * (D / 32)), nb = q % (D / 32), kb = q / (D / 32);
            W = X.in(I_WBR) + ((size_t)l * 2 + s) * RW * D; ldw = D; k0 = 64 * kb; n0 = 32 * nb; nvalid = D; outp = X.ws<bf16>(WS_WB) + (size_t)s * D * RW + (size_t)n0 * RW; ldo = RW; }
        else if ((r -= I_WB_) < I_WO_) { const int nb = r % (D / 32), kb = r / (D / 32); W = X.in(I_WOUT) + (size_t)l * D * D; ldw = D; k0 = 64 * kb; n0 = 32 * nb; nvalid = D; outp = X.ws<bf16>(WS_WO) + (size_t)n0 * D; ldo = D; }
        else if ((r -= I_WO_) < I_WGU_) { const int per = KB_D * (D / 32), es = r / per, q = r % per, e = es >> 1, src = es & 1, nb = q % (D / 32), kb = q / (D / 32); n0 = 32 * nb;
            W = (src ? X.in(I_WU) : X.in(I_WG)) + ((size_t)l * NE + e) * D * D; ldw = D; k0 = 64 * kb; nvalid = D; const int orow = e * 2 * D + (n0 / 128) * 256 + src * 128 + (n0 % 128);
            outp = X.ws<bf16>(WS_WGU) + (size_t)orow * D; ldo = D; }
        else { r -= I_WGU_; const int per = KB_D * (D / 32), e = r / per, q = r % per, nb = q % (D / 32), kb = q / (D / 32);
            W = X.in(I_WD) + ((size_t)l * NE + e) * D * D; ldw = D; k0 = 64 * kb; n0 = 32 * nb; nvalid = D; outp = X.ws<bf16>(WS_WD) + (size_t)(e * D + n0) * D; ldo = D; }
        transpose_item(W, ldw, k0, n0, nvalid, outp, ldo, scr, lane);
    }
}
__device__ __forceinline__ void phase_filters(const Ctx& X, int l) {
    LAS float* scr = (LAS float*)(X.lds + X.wave * 8192);
    const int gw = X.bid * NWAVES + X.wave, NGW = X.G * NWAVES, lane = X.lane;
    LAS float* part = (LAS float*)(X.lds + 65536);
    static_assert(65536 + NWAVES * 2 * HW * 4 <= LDS_STAGE, "filter LDS map");
    for (int i = lane; i < 2 * HW; i += 64) part[X.wave * 2 * HW + i] = 0.f;
    WAVE_LDS_FENCE(); CFENCE();
    float* filt = X.ws<float>(WS_FILT);
    for (int it = gw; it < SEQ / 8; it += NGW) filter_item(X, l, SEQ, 8 * it, filt, scr, part + (X.wave * 2 + 0) * HW);
    for (int it = gw; it < CTX / 8; it += NGW) filter_item(X, l, CTX, 8 * it, filt + (size_t)HW * SEQ, scr, part + (X.wave * 2 + 1) * HW);
    __syncthreads();
    for (int i = X.tid; i < 2 * HW; i += NTHR) { float s = 0.f;
#pragma unroll
        for (int w = 0; w < NWAVES; ++w) s += part[w * 2 * HW + i];
        X.ws<float>(WS_FPART)[((size_t)(i / HW) * NPART + X.bid) * HW + (i % HW)] = s; }
    __syncthreads();
}
__device__ __forceinline__ void phase_mod(const Ctx& X) {
    const int lane = X.lane;
    LAS float* red = (LAS float*)X.lds;
    constexpr int NIT = DEPTH * (6 * D / 64);
    for (int it = X.bid; it < NIT; it += X.G) {
        const int ll = it / (6 * D / 64), n0 = (it % (6 * D / 64)) * 64;
        const float* W = X.in(I_WMOD) + (size_t)ll * D * 6 * D; const float* cv = X.in(I_C); const float* cc = X.in(I_CCTX);
        float s0 = 0.f, s1 = 0.f;
#pragma unroll 8
        for (int k = X.wave * (D / 8); k < (X.wave + 1) * (D / 8); ++k) { const float wv = W[(size_t)k * 6 * D + n0 + lane]; const float c0 = cv[k], c1 = cc[k];
            s0 += c0 * sigmoidf_(c0) * wv; s1 += c1 * sigmoidf_(c1) * wv; }
        red[(X.wave * 64 + lane) * 2] = s0; red[(X.wave * 64 + lane) * 2 + 1] = s1;
        __syncthreads();
        if (X.wave == 0) { float t0 = 0.f, t1 = 0.f;
#pragma unroll
            for (int w = 0; w < NWAVES; ++w) { t0 += red[(w * 64 + lane) * 2]; t1 += red[(w * 64 + lane) * 2 + 1]; }
            const float bm = X.in(I_BMOD)[(size_t)ll * 6 * D + n0 + lane];
            float* MOD = X.ws<float>(WS_MOD);
            MOD[((size_t)ll * 2 + 0) * 6 * D + n0 + lane] = t0 + bm; MOD[((size_t)ll * 2 + 1) * 6 * D + n0 + lane] = t1 + bm; }
        __syncthreads();
    }
}
__device__ __forceinline__ const float* modp(const Ctx& X, int l, int t, int j) { return X.ws<float>(WS_MOD) + ((size_t)l * 2 + (t < CTX ? 1 : 0)) * 6 * D + (size_t)j * D; }

__device__ __forceinline__ void phase_x0(const Ctx& X) {
    const int gw = X.bid * NWAVES + X.wave, NGW = X.G * NWAVES, lane = X.lane;
    for (int t = gw; t < M; t += NGW) {
        const float* src = t < CTX ? X.in(I_CTX) + (size_t)t * D : X.in(I_X) + (size_t)(t - CTX) * D;
        const float* sh = modp(X, 0, t, 0); const float* sc = modp(X, 0, t, 1);
        float* xr = X.ws<float>(WS_X) + (size_t)t * D; bf16* xm = X.ws<bf16>(WS_XMOD) + (size_t)t * D;
#pragma unroll
        for (int j = 0; j < D / 256; ++j) { const int d = 4 * lane + 256 * j; const f32x4 v = *(const f32x4*)(src + d), a = *(const f32x4*)(sh + d), b = *(const f32x4*)(sc + d);
            *(f32x4*)(xr + d) = v;
            unsigned w0 = pk2(v[0] * (1.f + b[0]) + a[0], v[1] * (1.f + b[1]) + a[1]), w1 = pk2(v[2] * (1.f + b[2]) + a[2], v[3] * (1.f + b[3]) + a[3]);
            *(unsigned long long*)(xm + d) = (unsigned long long)w0 | ((unsigned long long)w1 << 32); }
    }
}

__device__ __forceinline__ int shift_row(int t, int col, bool& valid) {
    const bool isctx = t < CTX;
    const int i = t - CTX, gx = i & (GRID_W - 1), gy = i / GRID_W, q = col / QTR;
    const int offl = (q == 0) ? -1 : (q == 1) ? 1 : (q == 2) ? -GRID_W : GRID_W;
    const bool vl = (q == 0) ? (gx > 0) : (q == 1) ? (gx < GRID_W - 1) : (q == 2) ? (gy > 0) : (gy < GRID_H - 1);
    const bool first = col < HALFC;
    const int offc = first ? -1 : 1; const bool vc = first ? (t > 0) : (t < CTX - 1);
    valid = isctx ? vc : vl;
    return valid ? t + (isctx ? offc : offl) : t;
}
__device__ __forceinline__ float pm_val(const bf16* P, const float* mu, int t, int col) {
    const float p0 = bf2f(P[(size_t)t * PCP + col]); bool valid; const int nr = shift_row(t, col, valid);
    const float pn = bf2f(P[(size_t)nr * PCP + col]); const float p1 = valid ? pn : 0.f;
    return p0 + (p1 - p0) * mu[col];
}
constexpr int TT = 8;
__device__ __forceinline__ void phase_prep_a(const Ctx& X, int l, int t0) {
    const bf16* P = X.wsv<bf16>(WS_P); const float* mu = X.inv(I_MU) + (size_t)l * RC;
    LAS float* S = (LAS float*)X.lds;
    const int c = X.tid;
    const float* w2 = X.inv(I_W2) + (size_t)l * 2 * 64 * RW; const float* a2 = X.inv(I_A2) + (size_t)l * 2 * 64 * RW; const float* g2 = X.inv(I_G2) + (size_t)l * 128 * RW;
        for (int idx = X.tid; idx < TT * 384; idx += NTHR) { const int tt = idx / 384, j = idx % 384; float v = pm_val(P, mu, t0 + tt, C_LWF + j);
            if (j < 128) v = tanhf(v); else if (j >= 256) v = sigmoidf_(v);
            S[j * TT + tt] = v; }
        __syncthreads();
        if (c < RW) {
            float aw0[TT], aw1[TT], aa0[TT], aa1[TT], ag[TT];
#pragma unroll
            for (int tt = 0; tt < TT; ++tt) { aw0[tt] = 0.f; aw1[tt] = 0.f; aa0[tt] = 0.f; aa1[tt] = 0.f; ag[tt] = 0.f; }
            for (int r = 0; r < 64; ++r) { const float wf = w2[(size_t)r * RW + c], wb = w2[(size_t)(64 + r) * RW + c], af = a2[(size_t)r * RW + c], ab = a2[(size_t)(64 + r) * RW + c];
#pragma unroll
                for (int tt = 0; tt < TT; ++tt) { aw0[tt] += S[r * TT + tt] * wf; aw1[tt] += S[(64 + r) * TT + tt] * wb; aa0[tt] += S[(128 + r) * TT + tt] * af; aa1[tt] += S[(192 + r) * TT + tt] * ab; } }
            for (int j = 0; j < 128; ++j) { const float gv = g2[(size_t)j * RW + c];
#pragma unroll
                for (int tt = 0; tt < TT; ++tt) ag[tt] += S[(256 + j) * TT + tt] * gv; }
            LAS float* AC = S + 384 * TT;
#pragma unroll
            for (int tt = 0; tt < TT; ++tt) { AC[(0 * TT + tt) * RW + c] = aw0[tt]; AC[(1 * TT + tt) * RW + c] = aw1[tt]; AC[(2 * TT + tt) * RW + c] = aa0[tt]; AC[(3 * TT + tt) * RW + c] = aa1[tt]; AC[(4 * TT + tt) * RW + c] = ag[tt]; }
        }
    __syncthreads();
}
__device__ __forceinline__ void phase_prep_b(const Ctx& X, int l, int t0) {
    const bf16* P = X.wsv<bf16>(WS_P); const float* mu = X.inv(I_MU) + (size_t)l * RC;
    LAS float* S = (LAS float*)X.lds;
    const int c = X.tid;
    const float* w2 = X.inv(I_W2) + (size_t)l * 2 * 64 * RW; const float* a2 = X.inv(I_A2) + (size_t)l * 2 * 64 * RW; const float* g2 = X.inv(I_G2) + (size_t)l * 128 * RW;
        CFENCE();
        if (c < RW) {
            const LAS float* AC = S + 384 * TT;
            const float w00 = X.inv(I_W0)[(size_t)(l * 2 + 0) * RW + c], w01 = X.inv(I_W0)[(size_t)(l * 2 + 1) * RW + c];
            const float a00 = X.inv(I_A0)[(size_t)(l * 2 + 0) * RW + c], a01 = X.inv(I_A0)[(size_t)(l * 2 + 1) * RW + c];
            const float kkc = X.inv(I_KK)[(size_t)l * RW + c], kac = X.inv(I_KA)[(size_t)l * RW + c], rkc = X.inv(I_RK)[(size_t)l * RW + c];
            const int vz = vgpr_zero();
#pragma unroll 1
            for (int tt = 0; tt < TT; ++tt) { const int t = t0 + tt + vz;
                const float r = pm_val(P, mu, t, c), k = pm_val(P, mu, t, C_K + c), v = pm_val(P, mu, t, C_V + c);
                const float wd0 = -DECAY_SCALE * sigmoidf_(w00 + AC[(0 * TT + tt) * RW + c]), wd1 = -DECAY_SCALE * sigmoidf_(w01 + AC[(1 * TT + tt) * RW + c]);
                const float ad0 = sigmoidf_(a00 + AC[(2 * TT + tt) * RW + c]), ad1 = sigmoidf_(a01 + AC[(3 * TT + tt) * RW + c]);
                const float kkr = k * kkc; const float n2 = wave_sum(kkr * kkr); const float kk = kkr / fmaxf(sqrtf(n2), 1e-12f);
                const float kd0 = k * (1.f + (ad0 - 1.f) * kac), kd1 = k * (1.f + (ad1 - 1.f) * kac);
                const float bon = wave_sum(r * (kd0 + kd1) * rkc);
                const size_t o = (size_t)t * RW + c, o1 = (size_t)(M + t) * RW + c;
                X.wsv<bf16>(WS_R)[o] = (bf16)f2bf(r); X.wsv<bf16>(WS_V)[o] = (bf16)f2bf(v); X.wsv<bf16>(WS_KA)[o] = (bf16)f2bf(-kk);
                X.wsv<bf16>(WS_KD)[o] = (bf16)f2bf(kd0); X.wsv<bf16>(WS_KD)[o1] = (bf16)f2bf(kd1);
                X.wsv<bf16>(WS_KB)[o] = (bf16)f2bf(kk * ad0); X.wsv<bf16>(WS_KB)[o1] = (bf16)f2bf(kk * ad1);
                X.wsv<float>(WS_W)[o] = wd0; X.wsv<float>(WS_W)[o1] = wd1;
                X.wsv<bf16>(WS_GATE)[o] = (bf16)f2bf(AC[(4 * TT + tt) * RW + c]);
                if (X.lane == 0) X.wsv<float>(WS_BONUS)[(size_t)t * NH + (c >> 6)] = bon; }
        }
        __syncthreads();
}
__device__ __forceinline__ void phase_prep_hyena(const Ctx& X, int l) {
    const bf16* P = X.ws<bf16>(WS_P); const int c = X.tid;
    for (int tile = X.bid; tile < M / TT; tile += X.G) {
        const int t0 = tile * TT;
        if (c < HW) {
            const float* cw = X.in(I_CW) + (size_t)l * 3 * HC; const float* cb = X.in(I_CB) + (size_t)l * HC;
            for (int tt = 0; tt < TT; ++tt) { const int t = t0 + tt; const bool hp = (t != 0 && t != CTX), hn = (t != CTX - 1 && t != M - 1);
                float u[3];
#pragma unroll
                for (int j = 0; j < 3; ++j) { const int hc = j * HW + c, col = C_HY + hc;
                    const float pc = bf2f(P[(size_t)t * PCP + col]), pp = hp ? bf2f(P[(size_t)(t - 1) * PCP + col]) : 0.f, pn = hn ? bf2f(P[(size_t)(t + 1) * PCP + col]) : 0.f;
                    u[j] = pp * cw[hc] + pc * cw[HC + hc] + pn * cw[2 * HC + hc] + cb[hc]; }
                if (t < CTX) X.ws<float>(WS_Z)[(size_t)t * HW + c] = u[2] * u[1];
                X.ws<float>(WS_ZT)[(size_t)c * M + t] = u[2] * u[1]; X.ws<bf16>(WS_X0)[(size_t)t * HW + c] = (bf16)f2bf(u[0]); }
        }
    }
}

constexpr int CC = 64, NCHK = M / CC;
static_assert(CTX % CC == 0 && SEQ % CC == 0, "chunks must not straddle the context/latent boundary");
__device__ __forceinline__ int scan_row(int d, int s) { return d == 0 ? s : (s < CTX ? CTX - 1 - s : M - 1 - (s - CTX)); }
constexpr int LP = 72;
constexpr int LQ = 65;
constexpr int LX = 68;
__device__ __forceinline__ f32x4 mm_tile(const LAS bf16* A, const LAS bf16* Bt, int ti, int tj, int lane, f32x4 acc) {
    const LAS bf16* pa = A + (16 * ti + (lane & 15)) * LP + 8 * (lane >> 4); const LAS bf16* pb = Bt + (16 * tj + (lane & 15)) * LP + 8 * (lane >> 4);
#pragma unroll
    for (int kk = 0; kk < 2; ++kk) { const bf16x8 a = *(const LAS bf16x8*)(pa + 32 * kk), b = *(const LAS bf16x8*)(pb + 32 * kk); acc = MFMA16(a, b, acc); }
    return acc;
}
__device__ __forceinline__ void chunk_unit_1(const Ctx& X, int unit) {
    const int d = unit / (NCHK * NH), c = (unit / NH) % NCHK, h = unit % NH;
    LAS bf16* An = (LAS bf16*)X.lds;            LAS bf16* Bn = An + 64 * LP; LAS bf16* Kn = Bn + 64 * LP; LAS bf16* Rn = Kn + 64 * LP; LAS bf16* Vt = Rn + 64 * LP;
    LAS bf16* Bh = Vt + 64 * LP;                LAS bf16* Kh = Bh + 64 * LP; LAS bf16* Lak = Kh + 64 * LP; LAS bf16* Mrb = Lak + 64 * LP; LAS bf16* Mrk = Mrb + 64 * LP;
    LAS float* Lab = (LAS float*)(Mrk + 64 * LP); LAS float* XsW = Lab + 64 * LX;
    LAS float* XsU = (LAS float*)An;
    LAS bf16* Wt = Lak; LAS bf16* Ut = (LAS bf16*)((LAS unsigned char*)An + 64 * LX * 4);
    LAS float* tot = Lab;
    LAS float* dC = (LAS float*)(X.lds + LDS_MISC + 1024);
    static_assert(10 * 64 * LP * 2 + 2 * 64 * LX * 4 <= LDS_STAGE && 64 * LX * 4 + 64 * LP * 2 <= 3 * 64 * LP * 2, "chunk LDS map");
    const int tid = X.tid, lane = X.lane, w = X.wave, k = tid & 63;
    float lw[8], cum[8];
    { float run = 0.f; const float* pW = X.wsv<float>(WS_W);
#pragma unroll
      for (int i = 0; i < 8; ++i) { const int row = scan_row(d, c * CC + 8 * w + i); lw[i] = pW[((size_t)d * M + row) * RW + h * 64 + k]; }
#pragma unroll
      for (int i = 0; i < 8; ++i) { run += lw[i]; cum[i] = run; }
      tot[w * 64 + k] = run; }
    __syncthreads();
    float off = 0.f, cumC = 0.f;
#pragma unroll
    for (int ww = 0; ww < 8; ++ww) { const float t = tot[ww * 64 + k]; off += (ww < w) ? t : 0.f; cumC += t; }
    __syncthreads();
    { unsigned pv[4], pbh[4], pkh[4]; float af[8];
      const bf16* pR = X.wsv<bf16>(WS_R); const bf16* pV = X.wsv<bf16>(WS_V); const bf16* pKA = X.wsv<bf16>(WS_KA); const bf16* pKD = X.wsv<bf16>(WS_KD); const bf16* pKB = X.wsv<bf16>(WS_KB);
#pragma unroll
      for (int i = 0; i < 8; ++i) { const int t = 8 * w + i; const int row = scan_row(d, c * CC + t); const size_t o = (size_t)row * RW + h * 64 + k, od = ((size_t)d * M + row) * RW + h * 64 + k;
          const float ct = off + cum[i], cp = ct - lw[i];
          const float r = bf2f(pR[o]), v = bf2f(pV[o]), ka = bf2f(pKA[o]), kd = bf2f(pKD[od]), kb = bf2f(pKB[od]);
          const float ei = expf(-ct), eh = expf(cumC - ct);
          const float at = ka * expf(cp); af[i] = at;
          An[t * LP + k] = (bf16)f2bf(at); Bn[t * LP + k] = (bf16)f2bf(kb * ei); Kn[t * LP + k] = (bf16)f2bf(kd * ei); Rn[t * LP + k] = (bf16)f2bf(r * expf(ct));
          const unsigned bv = f2bf(v), bb = f2bf(kb * eh), bk = f2bf(kd * eh);
          if (i & 1) { pv[i >> 1] |= bv << 16; pbh[i >> 1] |= bb << 16; pkh[i >> 1] |= bk << 16; } else { pv[i >> 1] = bv; pbh[i >> 1] = bb; pkh[i >> 1] = bk; } }
      *(LAS u32x4*)(Vt + k * LP + 8 * w) = (u32x4){pv[0], pv[1], pv[2], pv[3]}; *(LAS u32x4*)(Bh + k * LP + 8 * w) = (u32x4){pbh[0], pbh[1], pbh[2], pbh[3]}; *(LAS u32x4*)(Kh + k * LP + 8 * w) = (u32x4){pkh[0], pkh[1], pkh[2], pkh[3]};
      *(LAS f32x4*)(XsW + k * LX + 8 * w) = (f32x4){af[0], af[1], af[2], af[3]}; *(LAS f32x4*)(XsW + k * LX + 8 * w + 4) = (f32x4){af[4], af[5], af[6], af[7]}; }
    if (tid < 64) dC[tid] = expf(cumC);
    __syncthreads();
#pragma unroll 1
    for (int q = 0; q < 2; ++q) { const int tile = 2 * w + q, ti = tile >> 2, tj = tile & 3; const f32x4 z4 = {0.f, 0.f, 0.f, 0.f};
        const f32x4 ab = mm_tile(An, Bn, ti, tj, lane, z4), ak = mm_tile(An, Kn, ti, tj, lane, z4), rb = mm_tile(Rn, Bn, ti, tj, lane, z4), rk = mm_tile(Rn, Kn, ti, tj, lane, z4);
        const int col = 16 * tj + (lane & 15);
#pragma unroll
        for (int r = 0; r < 4; ++r) { const int row = 16 * ti + 4 * (lane >> 4) + r; const bool lo = col < row, le = col <= row;
            Lab[row * LX + col] = lo ? ab[r] : 0.f; Lak[row * LP + col] = (bf16)f2bf(lo ? ak[r] : 0.f); Mrb[row * LP + col] = (bf16)f2bf(le ? rb[r] : 0.f); Mrk[row * LP + col] = (bf16)f2bf(le ? rk[r] : 0.f); } }
    __syncthreads();
}
__device__ __forceinline__ void chunk_unit_2(const Ctx& X, int unit) {
    const int d = unit / (NCHK * NH), c = (unit / NH) % NCHK, h = unit % NH;
    LAS bf16* An = (LAS bf16*)X.lds;            LAS bf16* Bn = An + 64 * LP; LAS bf16* Kn = Bn + 64 * LP; LAS bf16* Rn = Kn + 64 * LP; LAS bf16* Vt = Rn + 64 * LP;
    LAS bf16* Bh = Vt + 64 * LP;                LAS bf16* Kh = Bh + 64 * LP; LAS bf16* Lak = Kh + 64 * LP; LAS bf16* Mrb = Lak + 64 * LP; LAS bf16* Mrk = Mrb + 64 * LP;
    LAS float* Lab = (LAS float*)(Mrk + 64 * LP); LAS float* XsW = Lab + 64 * LX;
    LAS float* XsU = (LAS float*)An;
    LAS bf16* Wt = Lak; LAS bf16* Ut = (LAS bf16*)((LAS unsigned char*)An + 64 * LX * 4);
    LAS float* tot = Lab;
    LAS float* dC = (LAS float*)(X.lds + LDS_MISC + 1024);
    static_assert(10 * 64 * LP * 2 + 2 * 64 * LX * 4 <= LDS_STAGE && 64 * LX * 4 + 64 * LP * 2 <= 3 * 64 * LP * 2, "chunk LDS map");
    const int tid = X.tid, lane = X.lane, w = X.wave, k = tid & 63;
    f32x4 r2[2]; int r2col[2], r2row[2];
#pragma unroll
    for (int q = 0; q < 2; ++q) { const int tile = 2 * w + q, ti = tile >> 2, tj = tile & 3; const f32x4 z4 = {0.f, 0.f, 0.f, 0.f};
        const f32x4 a = mm_tile(Lak, Vt, ti, tj, lane, z4); const int col = 16 * tj + (lane & 15);
        r2[q] = a; r2col[q] = col; r2row[q] = 16 * ti + 4 * (lane >> 4); }
    __syncthreads();
#pragma unroll
    for (int q = 0; q < 2; ++q) *(LAS f32x4*)(XsU + r2col[q] * LX + r2row[q]) = r2[q];
    __syncthreads();
    if (tid < 128) { const int j = tid & 63; const bool isu = tid >= 64; LAS float* xs = (isu ? XsU : XsW) + j * LX; LAS bf16* dst = (isu ? Ut : Wt) + j * LP;
#pragma unroll 1
        for (int p = 0; p < 8; ++p) { const int t0 = 8 * p; f32x4 acc[8];
#pragma unroll
            for (int i = 0; i < 8; ++i) acc[i] = (f32x4){0.f, 0.f, 0.f, 0.f};
#pragma unroll 1
            for (int q = 0; q < 2 * p; ++q) { const f32x4 xq = *(const LAS f32x4*)(xs + 4 * q);
#pragma unroll
                for (int i = 0; i < 8; ++i) acc[i] += *(const LAS f32x4*)(Lab + (t0 + i) * LX + 4 * q) * xq; }
            f32x4 xp[2];
#pragma unroll
            for (int qq = 0; qq < 2; ++qq) xp[qq] = *(const LAS f32x4*)(xs + t0 + 4 * qq);
#pragma unroll
            for (int i = 0; i < 8; ++i) { f32x4 a = acc[i];
#pragma unroll
                for (int qq = 0; qq < (i + 3) / 4; ++qq) a += *(const LAS f32x4*)(Lab + (t0 + i) * LX + t0 + 4 * qq) * xp[qq];
                xp[i >> 2][i & 3] += (a[0] + a[1]) + (a[2] + a[3]); }
#pragma unroll
            for (int qq = 0; qq < 2; ++qq) { *(LAS f32x4*)(xs + t0 + 4 * qq) = xp[qq];
                *(LAS unsigned*)(dst + t0 + 4 * qq) = pk2(xp[qq][0], xp[qq][1]); *(LAS unsigned*)(dst + t0 + 4 * qq + 2) = pk2(xp[qq][2], xp[qq][3]); } } }
    __syncthreads();
}
__device__ __forceinline__ void chunk_unit_3(const Ctx& X, int unit) {
    const int d = unit / (NCHK * NH), c = (unit / NH) % NCHK, h = unit % NH;
    LAS bf16* An = (LAS bf16*)X.lds;            LAS bf16* Bn = An + 64 * LP; LAS bf16* Kn = Bn + 64 * LP; LAS bf16* Rn = Kn + 64 * LP; LAS bf16* Vt = Rn + 64 * LP;
    LAS bf16* Bh = Vt + 64 * LP;                LAS bf16* Kh = Bh + 64 * LP; LAS bf16* Lak = Kh + 64 * LP; LAS bf16* Mrb = Lak + 64 * LP; LAS bf16* Mrk = Mrb + 64 * LP;
    LAS float* Lab = (LAS float*)(Mrk + 64 * LP); LAS float* XsW = Lab + 64 * LX;
    LAS float* XsU = (LAS float*)An;
    LAS bf16* Wt = Lak; LAS bf16* Ut = (LAS bf16*)((LAS unsigned char*)An + 64 * LX * 4);
    LAS float* tot = Lab;
    LAS float* dC = (LAS float*)(X.lds + LDS_MISC + 1024);
    static_assert(10 * 64 * LP * 2 + 2 * 64 * LX * 4 <= LDS_STAGE && 64 * LX * 4 + 64 * LP * 2 <= 3 * 64 * LP * 2, "chunk LDS map");
    const int tid = X.tid, lane = X.lane, w = X.wave, k = tid & 63;
    const float dCk = dC[k];
    const size_t ubase = ((size_t)(d * NH + h) * NCHK + c);
    float* Pg = X.wsv<float>(WS_PQ) + ubase * 2 * 4096; float* Qg = Pg + 4096; bf16* Gg = X.wsv<bf16>(WS_G) + ubase * 4096; float* Yg = X.wsv<float>(WS_YL) + ubase * 4096;
#pragma unroll 1
    for (int q = 0; q < 2; ++q) { const int tile = 2 * w + q, ti = tile >> 2, tj = tile & 3; const f32x4 z4 = {0.f, 0.f, 0.f, 0.f};
        const f32x4 p = mm_tile(Wt, Bh, ti, tj, lane, z4); f32x4 qq = mm_tile(Ut, Bh, ti, tj, lane, z4); qq = mm_tile(Vt, Kh, ti, tj, lane, qq);
        const f32x4 g = mm_tile(Mrb, Wt, ti, tj, lane, z4); f32x4 y = mm_tile(Mrb, Ut, ti, tj, lane, z4); y = mm_tile(Mrk, Vt, ti, tj, lane, y);
        const int col = 16 * tj + (lane & 15); const float dcol = __shfl(dCk, col);
#pragma unroll
        for (int r = 0; r < 4; ++r) { const int row = 16 * ti + 4 * (lane >> 4) + r;
            Pg[row * 64 + col] = p[r] + (row == col ? dcol : 0.f); Qg[row * 64 + col] = qq[r];
            const int orow = d ? 63 - row : row;
            Gg[orow * 64 + col] = (bf16)f2bf(g[r] + bf2f(Rn[row * LP + col])); Yg[orow * 64 + col] = y[r]; } }
    __syncthreads();
}
__device__ __forceinline__ void seq_unit(const Ctx& X, int su) {
    const int d = su / (NH * 4), h = (su / 4) % NH, qv = su & 3;
    LAS float* S = (LAS float*)X.lds;
    LAS float* Pb = S + 16 * LQ;
    LAS float* Qb = Pb + 2 * 4096;
    const int tid = X.tid, v = tid >> 5, k2 = (tid & 31) * 2;
    const float* PQ = X.ws<float>(WS_PQ) + (size_t)(d * NH + h) * NCHK * 2 * 4096; bf16* S0g = X.ws<bf16>(WS_S0) + (size_t)(d * NH + h) * NCHK * 4096;
    f32x4 pp0, pp1; float pq0, pq1;
#define SEQ_LOAD(c_) do { const float* p_ = PQ + (size_t)(c_) * 2 * 4096; pp0 = *(const f32x4*)(p_ + 4 * tid); pp1 = *(const f32x4*)(p_ + 2048 + 4 * tid); \
        pq0 = p_[4096 + (qv * 16) * 64 + tid]; pq1 = p_[4096 + (qv * 16) * 64 + 512 + tid]; } while (0)
#define SEQ_STORE(b_) do { *(LAS f32x4*)(Pb + (b_) * 4096 + 4 * tid) = pp0; *(LAS f32x4*)(Pb + (b_) * 4096 + 2048 + 4 * tid) = pp1; Qb[(b_) * 1024 + tid] = pq0; Qb[(b_) * 1024 + 512 + tid] = pq1; } while (0)
    SEQ_LOAD(0); SEQ_STORE(0);
    for (int i = tid; i < 16 * LQ; i += NTHR) S[i] = 0.f;
    __syncthreads();
    for (int c = 0; c < NCHK; ++c) { const int pb = c & 1;
        if (c + 1 < NCHK) SEQ_LOAD(c + 1);
        const LAS float* P = Pb + pb * 4096; const LAS float* Q = Qb + pb * 1024;
        *(unsigned*)(S0g + (size_t)c * 4096 + (qv * 16 + v) * 64 + k2) = pk2(S[v * LQ + k2], S[v * LQ + k2 + 1]);
        float a0 = Q[v * 64 + k2], a1 = Q[v * 64 + k2 + 1];
#pragma unroll 8
        for (int k1 = 0; k1 < 64; ++k1) { const float sv = S[v * LQ + k1]; a0 += sv * P[k1 * 64 + k2]; a1 += sv * P[k1 * 64 + k2 + 1]; }
        __syncthreads();
        S[v * LQ + k2] = a0; S[v * LQ + k2 + 1] = a1;
        if (c + 1 < NCHK) SEQ_STORE(pb ^ 1);
        __syncthreads();
    }
#undef SEQ_LOAD
#undef SEQ_STORE
}
constexpr int CR = 16;
__device__ __forceinline__ void conv_item(const Ctx& X, int item) {
    constexpr int NCG = HW / 64; constexpr int n = CTX;
    const int cg = item % NCG, ob = item / NCG, i0 = CR * ob, c = cg * 64 + X.lane;
    const float* F = X.ws<float>(WS_FILT) + (size_t)HW * SEQ + (size_t)c * CTX; const float* Z = X.ws<float>(WS_Z) + c;
    const float* fp = X.ws<float>(WS_FPART) + (size_t)NPART * HW + c;
    float nsum = 0.f; for (int b = 0; b < NPART; ++b) nsum += fp[(size_t)b * HW];
    float acc[CR], Q[CR];
#pragma unroll
    for (int r = 0; r < CR; ++r) acc[r] = 0.f;
    int jb = i0 - n / 2; if (jb < 0) jb = 0;
    int jend = i0 + n / 2 + CR; if (jend > n) jend = n;
    int Tb = i0 - jb + n / 2;
#pragma unroll
    for (int x = 1; x < CR; ++x) { const int T = Tb + x; Q[x] = (T >= 0 && T < n) ? F[T] : 0.f; }
    Q[0] = 0.f;
    for (; jb < jend; jb += CR, Tb -= CR) {
#pragma unroll
        for (int s = 0; s < CR; ++s) { const int T = Tb - s, j = jb + s;
            if ((s & 3) == 0) CFENCE();
            Q[(CR - s) & (CR - 1)] = (T >= 0 && T < n) ? F[T] : 0.f;
            const float zj = (j < n) ? Z[(size_t)j * HW] : 0.f;
#pragma unroll
            for (int r = 0; r < CR; ++r) acc[r] += Q[(r - s + CR) & (CR - 1)] * zj; }
    }
    const float inv = 1.0f / nsum; float* O = X.ws<float>(WS_CONV) + c;
#pragma unroll
    for (int r = 0; r < CR; ++r) O[(size_t)(i0 + r) * HW] = acc[r] * inv;
}

#ifdef EMU
struct cf { float x, y; };
#else
typedef float cf __attribute__((ext_vector_type(2)));
#endif
__device__ __forceinline__ cf cmul(cf a, cf b) { return cf{a.x * b.x - a.y * b.y, a.x * b.y + a.y * b.x}; }
__device__ __forceinline__ cf cadd(cf a, cf b) { return cf{a.x + b.x, a.y + b.y}; }
__device__ __forceinline__ cf csub(cf a, cf b) { return cf{a.x - b.x, a.y - b.y}; }
__device__ __forceinline__ cf cconj(cf a) { return cf{a.x, -a.y}; }
constexpr int FN = SEQ;
constexpr int flog4(int n) { return n <= 1 ? 0 : 1 + flog4(n / 4); }
constexpr int FLOG4 = flog4(FN), FSQ = 1 << FLOG4;
static_assert((1 << (2 * FLOG4)) == FN && FN * 8 <= LDS_STAGE, "FFT length must be a power of 4 that fits the LDS stage region");
constexpr int FFT_TAB_OFF = LDS_MISC + 2048;
static_assert(FFT_TAB_OFF + 2 * FSQ * 8 <= LDS_BYTES, "FFT twiddle tables");
__device__ __forceinline__ void fft_tables(const Ctx& X) {
    LAS cf* T = (LAS cf*)(X.lds + FFT_TAB_OFF);
    for (int i = X.tid; i < 2 * FSQ; i += NTHR) { const int k = i < FSQ ? i * FSQ : i - FSQ; float s, c; sincos_f(-6.283185307179586f * (float)k / (float)FN, s, c); T[i] = cf{c, s}; }
    __syncthreads();
}
__device__ __forceinline__ cf fft_tw(const LAS cf* T, int k) { const cf a = T[k >> FLOG4], b = T[FSQ + (k & (FSQ - 1))]; return cmul(a, b); }
__device__ __forceinline__ int rev4(int k) { int r = 0;
#pragma unroll
    for (int s = 0; s < FLOG4; ++s) { r = (r << 2) | (k & 3); k >>= 2; }
    return r; }
__device__ __forceinline__ void fft_fwd(LAS cf* x, const LAS cf* T, int tid) {
#pragma unroll 1
    for (int s = 0; s < FLOG4; ++s) { const int q = FN >> (2 * s + 2), tw = 1 << (2 * s);
        for (int u = tid; u < FN / 4; u += NTHR) { const int j = u & (q - 1), p = (u - j) * 4 + j;
            const cf a0 = x[p], a1 = x[p + q], a2 = x[p + 2 * q], a3 = x[p + 3 * q];
            const cf t0 = cadd(a0, a2), t1 = csub(a0, a2), t2 = cadd(a1, a3), d = csub(a1, a3), t3 = cf{d.y, -d.x};
            const cf w1 = fft_tw(T, j * tw), w2 = cmul(w1, w1), w3 = cmul(w2, w1);
            x[p] = cadd(t0, t2); x[p + q] = cmul(cadd(t1, t3), w1); x[p + 2 * q] = cmul(csub(t0, t2), w2); x[p + 3 * q] = cmul(csub(t1, t3), w3); }
        __syncthreads(); }
}
__device__ __forceinline__ void fft_inv(LAS cf* x, const LAS cf* T, int tid) {
#pragma unroll 1
    for (int s = FLOG4 - 1; s >= 0; --s) { const int q = FN >> (2 * s + 2), tw = 1 << (2 * s);
        for (int u = tid; u < FN / 4; u += NTHR) { const int j = u & (q - 1), p = (u - j) * 4 + j;
            const cf w1 = cconj(fft_tw(T, j * tw)), w2 = cmul(w1, w1), w3 = cmul(w2, w1);
            const cf a0 = x[p], a1 = cmul(x[p + q], w1), a2 = cmul(x[p + 2 * q], w2), a3 = cmul(x[p + 3 * q], w3);
            const cf t0 = cadd(a0, a2), t1 = csub(a0, a2), t2 = cadd(a1, a3), d = csub(a1, a3), t3 = cf{-d.y, d.x};
            x[p] = cadd(t0, t2); x[p + q] = cadd(t1, t3); x[p + 2 * q] = csub(t0, t2); x[p + 3 * q] = csub(t1, t3); }
        __syncthreads(); }
}
__device__ __forceinline__ void fft_load_real(LAS cf* x, const float* src, float scale, int tid) {
    for (int m = tid; m < FN; m += NTHR) { cf v{0.f, 0.f}; if (m < FN / 2) { v.x = src[2 * m] * scale; v.y = src[2 * m + 1] * scale; } x[m] = v; }
    __syncthreads();
}
__device__ __forceinline__ void phase_spectra(const Ctx& X, int l) {
    (void)l;
    LAS cf* x = (LAS cf*)X.lds; const LAS cf* T = (const LAS cf*)(X.lds + FFT_TAB_OFF); volatile LAS float* red = (volatile LAS float*)(X.lds + LDS_MISC) + 120;
    fft_tables(X);
    for (int c = X.bid; c < HW; c += X.G) {
        if (X.wave == 0) { const float* fp = X.ws<float>(WS_FPART) + c; float s = 0.f; for (int b = X.lane; b < NPART; b += 64) s += fp[(size_t)b * HW]; s = wave_sum(s); if (X.lane == 0) red[0] = s; }
        __syncthreads();
        const float inv = 1.0f / red[0];
        fft_load_real(x, X.ws<float>(WS_FILT) + (size_t)c * SEQ, inv, X.tid);
        fft_fwd(x, T, X.tid);
        cf* HS = X.ws<cf>(WS_HS) + (size_t)c * (FN + 1);
        for (int k = X.tid; k <= FN / 2; k += NTHR) {
            const cf A = x[rev4(k)], B = x[rev4((FN - k) & (FN - 1))];
            if (k == 0) { HS[0] = cf{A.x + A.y, 0.f}; HS[FN] = cf{A.x - A.y, 0.f}; }
            else if (k == FN / 2) { HS[k] = cconj(A); }
            else { float sn, cs; sincos_f(-3.14159265358979f * (float)k / (float)FN, sn, cs); const cf w{cs, sn};
                const cf s1 = cadd(A, cconj(B)), d1 = csub(A, cconj(B)), wd = cmul(w, d1);
                HS[k] = cf{0.5f * (s1.x + wd.y), 0.5f * (s1.y - wd.x)};
                const cf s2 = cadd(B, cconj(A)), d2 = csub(B, cconj(A)), wd2 = cmul(cconj(w), d2);
                HS[FN - k] = cf{0.5f * (s2.x - wd2.y), 0.5f * (s2.y + wd2.x)}; } }
        __syncthreads();
    }
}
__device__ __forceinline__ void fftconv_item(const Ctx& X, int l, int c) {
    LAS cf* x = (LAS cf*)X.lds; const LAS cf* T = (const LAS cf*)(X.lds + FFT_TAB_OFF);
    const float* z = X.ws<float>(WS_ZT) + (size_t)c * M + CTX;
    fft_load_real(x, z, 1.0f, X.tid);
    fft_fwd(x, T, X.tid);
    const cf* HS = X.ws<cf>(WS_HS) + (size_t)c * (FN + 1);
    for (int k = X.tid; k <= FN / 2; k += NTHR) {
        const int pa = rev4(k), pb = rev4((FN - k) & (FN - 1)); const cf A = x[pa], B = x[pb];
        if (k == 0) { const float y0 = (A.x + A.y) * HS[0].x, yn = (A.x - A.y) * HS[FN].x; x[pa] = cf{0.5f * (y0 + yn), 0.5f * (y0 - yn)}; }
        else if (k == FN / 2) { x[pa] = cconj(cmul(cconj(A), HS[k])); }
        else { float sn, cs; sincos_f(-3.14159265358979f * (float)k / (float)FN, sn, cs); const cf w{cs, sn};
            const cf s1 = cadd(A, cconj(B)), d1 = csub(A, cconj(B)), wd = cmul(w, d1); const cf Xk{0.5f * (s1.x + wd.y), 0.5f * (s1.y - wd.x)};
            const cf s2 = cadd(B, cconj(A)), d2 = csub(B, cconj(A)), wd2 = cmul(cconj(w), d2); const cf Xn{0.5f * (s2.x - wd2.y), 0.5f * (s2.y + wd2.x)};
            const cf Yk = cmul(Xk, HS[k]), Yn = cmul(Xn, HS[FN - k]);
            const cf e1 = cadd(Yk, cconj(Yn)), f1 = cmul(cconj(w), csub(Yk, cconj(Yn)));
            x[pa] = cf{0.5f * (e1.x - f1.y), 0.5f * (e1.y + f1.x)};
            const cf e2 = cadd(Yn, cconj(Yk)), f2 = cmul(w, csub(Yn, cconj(Yk)));
            x[pb] = cf{0.5f * (e2.x + f2.y), 0.5f * (e2.y - f2.x)}; } }
    __syncthreads();
    fft_inv(x, T, X.tid);
    const float bias = X.in(I_HBIAS)[(size_t)l * HW + c], sc = 1.0f / (float)FN; float* O = X.ws<float>(WS_CVT) + (size_t)c * SEQ;
    for (int i2 = X.tid; i2 < FN / 2; i2 += NTHR) { const cf d = x[i2 + FN / 4]; O[2 * i2] = d.x * sc + z[2 * i2] * bias; O[2 * i2 + 1] = d.y * sc + z[2 * i2 + 1] * bias; }
    __syncthreads();
}
__device__ __forceinline__ void phase_fftconv(const Ctx& X, int l) {
    fft_tables(X);
    volatile LAS int* slot = (volatile LAS int*)(X.lds + LDS_MISC) + 121;
    unsigned* q = X.ctl() + CW_Q + l * 64 + 32;
    for (;;) { if (X.tid == 0) slot[0] = (int)atomicAdd(q, 1u); __syncthreads(); const int c = slot[0]; __syncthreads(); if (c >= HW) break; fftconv_item(X, l, c); }
}
__device__ __forceinline__ void phase_ctxconv(const Ctx& X, int l) {
    constexpr int NITEMS = (HW / 64) * (CTX / CR);
    unsigned* q = X.ctl() + CW_Q + l * 64;
    for (;;) { int item = 0; if (X.lane == 0) item = (int)atomicAdd(q, 1u); item = __shfl(item, 0); if (item >= NITEMS) break; conv_item(X, item); }
}
__device__ __forceinline__ void phase_seq(const Ctx& X) {
    for (int su = X.bid; su < N_SEQ_UNITS; su += X.G) seq_unit(X, su);
}

__device__ __forceinline__ void finish_unit(const Ctx& X, int l, int unit) {
    const int b = unit / NH, h = unit % NH, lane = X.lane, w = X.wave, tid = X.tid;
    const int cf = b, cb = (b < CTX / CC) ? (CTX / CC - 1 - b) : (NCHK - 1 - (b - CTX / CC));
    LAS bf16* Gf = (LAS bf16*)X.lds; LAS bf16* Gb = Gf + 64 * LP; LAS bf16* Sf = Gb + 64 * LP; LAS bf16* Sb = Sf + 64 * LP; LAS float* Yl = (LAS float*)(Sb + 64 * LP);
    const size_t uf = ((size_t)(0 * NH + h) * NCHK + cf) * 4096, ub = ((size_t)(1 * NH + h) * NCHK + cb) * 4096;
    { const int r = tid >> 3, c8 = (tid & 7) * 8;
      *(LAS u32x4*)(Gf + r * LP + c8) = *(const u32x4*)(X.ws<bf16>(WS_G) + uf + r * 64 + c8); *(LAS u32x4*)(Gb + r * LP + c8) = *(const u32x4*)(X.ws<bf16>(WS_G) + ub + r * 64 + c8);
      *(LAS u32x4*)(Sf + r * LP + c8) = *(const u32x4*)(X.ws<bf16>(WS_S0) + uf + r * 64 + c8); *(LAS u32x4*)(Sb + r * LP + c8) = *(const u32x4*)(X.ws<bf16>(WS_S0) + ub + r * 64 + c8);
      const float* yf = X.ws<float>(WS_YL) + uf + r * 64 + c8; const float* yb = X.ws<float>(WS_YL) + ub + r * 64 + c8;
#pragma unroll
      for (int i = 0; i < 8; ++i) Yl[r * LQ + c8 + i] = yf[i] + yb[i]; }
    __syncthreads();
#pragma unroll 1
    for (int q = 0; q < 2; ++q) { const int tile = 2 * w + q, ti = tile >> 2, tj = tile & 3; f32x4 y = {0.f, 0.f, 0.f, 0.f};
        y = mm_tile(Gf, Sf, ti, tj, lane, y); y = mm_tile(Gb, Sb, ti, tj, lane, y); const int col = 16 * tj + (lane & 15);
#pragma unroll
        for (int r = 0; r < 4; ++r) Yl[(16 * ti + 4 * (lane >> 4) + r) * LQ + col] += y[r]; }
    __syncthreads();
    const int c = h * 64 + lane; const float lgc = X.in(I_LNXG)[(size_t)l * RW + c], lbc = X.in(I_LNXB)[(size_t)l * RW + c];
#pragma unroll 1
    for (int i = 0; i < 8; ++i) { const int tl = 8 * w + i, t = 64 * b + tl; const size_t o = (size_t)t * RW + c;
        const float y = Yl[tl * LQ + lane];
        const float mean = wave_sum(y) * (1.f / 64.f); const float dy = y - mean; const float var = wave_sum(dy * dy) * (1.f / 64.f);
        float yn = dy / sqrtf(var + GN_EPS) * lgc + lbc;
        yn += X.ws<float>(WS_BONUS)[(size_t)t * NH + h] * bf2f(X.ws<bf16>(WS_V)[o]);
        yn *= bf2f(X.ws<bf16>(WS_GATE)[o]);
        X.ws<bf16>(WS_RO)[o] = (bf16)f2bf(yn); }
    __syncthreads();
}
__device__ __forceinline__ void phase_finish(const Ctx& X, int l) {
    for (int u = X.bid; u < (M / 64) * NH; u += X.G) finish_unit(X, l, u);
    const int c = X.tid;
    const float* hb = X.in(I_HBIAS) + (size_t)l * HW;
    if (c < HW) for (int t = X.bid; t < M; t += X.G) { const size_t o = (size_t)t * HW + c;
            const float cv = t < CTX ? X.ws<float>(WS_CONV)[o] + X.ws<float>(WS_Z)[o] * hb[c] : X.ws<float>(WS_CVT)[(size_t)c * SEQ + (t - CTX)];
            const float ho = cv * bf2f(X.ws<bf16>(WS_X0)[o]);
            X.ws<bf16>(WS_HO)[o] = (bf16)f2bf(ho); }
}

__device__ __forceinline__ void ln_inplace(float (&v)[D / 64], const float* g, const float* b, int lane) {
    float s = 0.f;
#pragma unroll
    for (int j = 0; j < D / 64; ++j) s += v[j];
    const float mean = wave_sum(s) * (1.f / D); float q = 0.f;
#pragma unroll
    for (int j = 0; j < D / 64; ++j) { v[j] -= mean; q += v[j] * v[j]; }
    const float rstd = 1.0f / sqrtf(wave_sum(q) * (1.f / D) + LN_EPS);
#pragma unroll
    for (int j = 0; j < D / 64; ++j) { const int d = 4 * lane + 256 * (j >> 2) + (j & 3); v[j] = v[j] * rstd * g[d] + b[d]; }
}
__device__ __forceinline__ void phase_norm1(const Ctx& X, int l) {
    const int gw = X.bid * NWAVES + X.wave, NGW = X.G * NWAVES, lane = X.lane;
    const float* lng = X.in(I_LNG) + (size_t)(l * 2 + 0) * D; const float* lnb = X.in(I_LNB) + (size_t)(l * 2 + 0) * D;
    const float* wr = X.in(I_WR); const float* rb = X.in(I_RB);
    const float alpha = sqrtf(sqrtf(2.0f * DEPTH));
    volatile LAS int* hist = (volatile LAS int*)(X.lds + LDS_MISC + 4096);
    if (X.tid < NE) hist[X.tid] = 0;
    __syncthreads();
    for (int t = gw; t < M; t += NGW) {
        float* xr = X.ws<float>(WS_X) + (size_t)t * D; const float* mx = X.ws<float>(WS_MIX) + (size_t)t * D;
        const float* gate = modp(X, l, t, 2); const float* sh = modp(X, l, t, 3); const float* sc = modp(X, l, t, 4);
        float v[D / 64];
#pragma unroll
        for (int j = 0; j < D / 256; ++j) { const int d = 4 * lane + 256 * j; const f32x4 a = *(const f32x4*)(xr + d), m = *(const f32x4*)(mx + d), gt = *(const f32x4*)(gate + d);
#pragma unroll
            for (int i = 0; i < 4; ++i) v[4 * j + i] = alpha * a[i] + gt[i] * m[i]; }
        ln_inplace(v, lng, lnb, lane);
        bf16* hf = X.ws<bf16>(WS_XMOD) + (size_t)t * D;
        LAS float* hrow = (LAS float*)X.lds + X.wave * D;
#pragma unroll
        for (int j = 0; j < D / 256; ++j) { const int d = 4 * lane + 256 * j; f32x4 o; const f32x4 a = *(const f32x4*)(sh + d), b = *(const f32x4*)(sc + d); f32x4 h;
#pragma unroll
            for (int i = 0; i < 4; ++i) { o[i] = v[4 * j + i]; h[i] = o[i] * (1.f + b[i]) + a[i]; }
            *(f32x4*)(xr + d) = o; *(LAS f32x4*)(hrow + d) = h;
            *(unsigned long long*)(hf + d) = (unsigned long long)pk2(h[0], h[1]) | ((unsigned long long)pk2(h[2], h[3]) << 32); }
        WAVE_LDS_FENCE(); CFENCE();
        float part = 0.f; { const int e = lane & 15, q = lane >> 4;
#pragma unroll 8
            for (int d = q * (D / 4); d < (q + 1) * (D / 4); ++d) part += hrow[d] * wr[(size_t)d * NE + e]; }
        part += __shfl_xor(part, 16); part += __shfl_xor(part, 32);
        WAVE_LDS_FENCE(); CFENCE();
        float lg[NE];
#pragma unroll
        for (int e = 0; e < NE; ++e) lg[e] = __shfl(part, e);
        float mxl = lg[0];
#pragma unroll
        for (int e = 1; e < NE; ++e) mxl = fmaxf(mxl, lg[e]);
        float sc_[NE], sum = 0.f;
#pragma unroll
        for (int e = 0; e < NE; ++e) { sc_[e] = expf(lg[e] - mxl); sum += sc_[e]; }
        const float isum = 1.0f / sum; float sel[NE];
#pragma unroll
        for (int e = 0; e < NE; ++e) { sc_[e] *= isum; sel[e] = sc_[e] + rb[e]; }
        int bg = 0; float bgs = -INFINITY;
#pragma unroll
        for (int g = 0; g < 4; ++g) { float m1 = -INFINITY, m2 = -INFINITY;
#pragma unroll
            for (int i = 0; i < 4; ++i) { const float x = sel[4 * g + i]; if (x > m1) { m2 = m1; m1 = x; } else if (x > m2) m2 = x; }
            const float gs = m1 + m2; if (gs > bgs) { bgs = gs; bg = g; } }
        int i0 = 0, i1 = 0; float s0 = -INFINITY, s1 = -INFINITY, p0 = 0.f, p1 = 0.f;
#pragma unroll
        for (int e = 0; e < NE; ++e) { if ((e >> 2) == bg) { const float x = sel[e]; if (x > s0) { s1 = s0; i1 = i0; p1 = p0; s0 = x; i0 = e; p0 = sc_[e]; } else if (x > s1) { s1 = x; i1 = e; p1 = sc_[e]; } } }
        if (lane == 0) { int* ei = X.ws<int>(WS_ROUT) + (size_t)t * 2; float* ew = (float*)(X.ws<int>(WS_ROUT) + (size_t)M * 2) + (size_t)t * 2;
            ei[0] = i0; ei[1] = i1; const float ws_ = 1.0f / (p0 + p1); ew[0] = p0 * ws_; ew[1] = p1 * ws_;
            lds_add(hist + i0, 1); lds_add(hist + i1, 1); }
    }
    __syncthreads();
    if (X.tid < NE) { const int hc = hist[X.tid]; X.ws<int>(WS_BCNT)[X.bid * NE + X.tid] = hc; atomicAdd(X.ctl() + CW_CNT + l * 64 + X.tid, (unsigned)hc); }
}

__device__ __forceinline__ void moe_table(const Ctx& X, int l, int NT) {
    volatile LAS int* tab = (volatile LAS int*)(X.lds + LDS_MISC) + 8;
    if (X.tid == 0) { int cum = 0, ts = 0;
        for (int e = 0; e < NE; ++e) { const int cnt = (int)__hip_atomic_load(X.ctl() + CW_CNT + l * 64 + e, RLX_AGENT); const int tc = (cnt + 255) / 256;
            tab[e] = cum; tab[32 + e] = ts; tab[64 + e] = tc; cum += tc * NT; ts += tc; }
        tab[16] = cum; }
    __syncthreads();
}
__device__ __forceinline__ void phase_scatter(const Ctx& X, int l) {
    moe_table(X, l, 1);
    volatile LAS int* tab = (volatile LAS int*)(X.lds + LDS_MISC) + 8;
    volatile LAS int* cur = (volatile LAS int*)(X.lds + LDS_MISC + 4096) + 16;
    const int gw = X.bid * NWAVES + X.wave, NGW = X.G * NWAVES, lane = X.lane;
    if (X.tid < NE) { const int* bc = X.ws<int>(WS_BCNT) + X.tid; int pre = 0; for (int b = 0; b < X.bid; ++b) pre += bc[b * NE]; cur[X.tid] = tab[32 + X.tid] * 256 + pre; }
    __syncthreads();
    const int* ei = X.ws<int>(WS_ROUT); int* slot = X.ws<int>(WS_ROUT) + (size_t)M * 4;
    for (int t = gw; t < M; t += NGW) {
#pragma unroll
        for (int k = 0; k < 2; ++k) { const int e = ei[2 * t + k];
            int pos = 0; if (lane == 0) pos = lds_add(cur + e, 1);
            pos = __shfl(pos, 0);
            if (lane == 0) slot[2 * t + k] = pos;
            const u32x4* src = (const u32x4*)(X.ws<bf16>(WS_XMOD) + (size_t)t * D); u32x4* dst = (u32x4*)(X.ws<bf16>(WS_XG) + (size_t)pos * D);
            for (int i = lane; i < D / 8; i += 64) dst[i] = src[i]; } }
}

__device__ __forceinline__ void phase_combine(const Ctx& X, int l) {
    const int gw = X.bid * NWAVES + X.wave, NGW = X.G * NWAVES, lane = X.lane;
    const float* lng = X.in(I_LNG) + (size_t)(l * 2 + 1) * D; const float* lnb = X.in(I_LNB) + (size_t)(l * 2 + 1) * D;
    const float alpha = sqrtf(sqrtf(2.0f * DEPTH));
    const float* ew = (const float*)(X.ws<int>(WS_ROUT) + (size_t)M * 2); const int* slot = X.ws<int>(WS_ROUT) + (size_t)M * 4;
    for (int t = gw; t < M; t += NGW) {
        float* xr = X.ws<float>(WS_X) + (size_t)t * D; const float* gate = modp(X, l, t, 5);
        const bf16* y0 = X.ws<bf16>(WS_YS) + (size_t)slot[2 * t] * D; const bf16* y1 = X.ws<bf16>(WS_YS) + (size_t)slot[2 * t + 1] * D; const float w0 = ew[2 * t], w1 = ew[2 * t + 1];
        float v[D / 64];
#pragma unroll
        for (int j = 0; j < D / 256; ++j) { const int d = 4 * lane + 256 * j; const f32x4 a = *(const f32x4*)(xr + d), gt = *(const f32x4*)(gate + d);
            const unsigned long long q0 = *(const unsigned long long*)(y0 + d), q1 = *(const unsigned long long*)(y1 + d);
            float ya[4] = {bflo((unsigned)q0), bfhi((unsigned)q0), bflo((unsigned)(q0 >> 32)), bfhi((unsigned)(q0 >> 32))};
            float yb[4] = {bflo((unsigned)q1), bfhi((unsigned)q1), bflo((unsigned)(q1 >> 32)), bfhi((unsigned)(q1 >> 32))};
#pragma unroll
            for (int i = 0; i < 4; ++i) v[4 * j + i] = alpha * a[i] + gt[i] * (w0 * ya[i] + w1 * yb[i]); }
        ln_inplace(v, lng, lnb, lane);
        if (l + 1 < DEPTH) { const float* sh = modp(X, l + 1, t, 0); const float* sc = modp(X, l + 1, t, 1); bf16* xm = X.ws<bf16>(WS_XMOD) + (size_t)t * D;
#pragma unroll
            for (int j = 0; j < D / 256; ++j) { const int d = 4 * lane + 256 * j; f32x4 o; const f32x4 a = *(const f32x4*)(sh + d), b = *(const f32x4*)(sc + d); float h[4];
#pragma unroll
                for (int i = 0; i < 4; ++i) { o[i] = v[4 * j + i]; h[i] = o[i] * (1.f + b[i]) + a[i]; }
                *(f32x4*)(xr + d) = o;
                *(unsigned long long*)(xm + d) = (unsigned long long)pk2(h[0], h[1]) | ((unsigned long long)pk2(h[2], h[3]) << 32); }
        } else if (t >= CTX) { float* orow = X.out() + (size_t)(t - CTX) * D; const bool bad = __hip_atomic_load(X.ctl() + CW_BAR + XB_TMO, RLX_AGENT) != 0u; const float pscale = 1.0f + bitsf(__hip_atomic_load(X.ctl() + 64, RLX_AGENT));
#pragma unroll
            for (int j = 0; j < D / 256; ++j) { const int d = 4 * lane + 256 * j; f32x4 o;
#pragma unroll
                for (int i = 0; i < 4; ++i) o[i] = bad ? __builtin_nanf("") : v[4 * j + i] * pscale;
                *(f32x4*)(orow + d) = o; }
        }
    }
}


#ifdef EMU
#define PHASE_FN static
#define THIN_FN static
#else
#define PHASE_FN __device__ __forceinline__
#define THIN_FN __device__ __noinline__
#endif
THIN_FN void ph_transposes(Ctx X, int l, int part) { phase_transposes(X, l, part); }
THIN_FN void ph_filters(Ctx X, int l) { phase_filters(X, l); }
THIN_FN void ph_mod(Ctx X) { phase_mod(X); }
THIN_FN void ph_x0(Ctx X) { phase_x0(X); }
THIN_FN void ph_prep_a(Ctx X, int l, int t0) { phase_prep_a(X, l, t0); }
THIN_FN void ph_prep_b(Ctx X, int l, int t0) { phase_prep_b(X, l, t0); }
THIN_FN void ph_prep_hyena(Ctx X, int l) { phase_prep_hyena(X, l); }
THIN_FN void ph_ctxconv(Ctx X, int l) { phase_ctxconv(X, l); }
THIN_FN void ph_chunk_1(Ctx X, int u) { chunk_unit_1(X, u); }
THIN_FN void ph_chunk_2(Ctx X, int u) { chunk_unit_2(X, u); }
THIN_FN void ph_chunk_3(Ctx X, int u) { chunk_unit_3(X, u); }
THIN_FN void ph_seq(Ctx X) { phase_seq(X); }
THIN_FN void ph_fftconv(Ctx X, int l) { phase_fftconv(X, l); }
THIN_FN void ph_spectra(Ctx X, int l) { phase_spectra(X, l); }
THIN_FN void ph_finish(Ctx X, int l) { phase_finish(X, l); }
THIN_FN void ph_norm1(Ctx X, int l) { phase_norm1(X, l); }
THIN_FN void ph_scatter(Ctx X, int l) { phase_scatter(X, l); }
THIN_FN void ph_combine(Ctx X, int l) { phase_combine(X, l); }
PHASE_FN void ph_g13(Ctx X, int third) { pg8::Gemm g{third ? X.ws<bf16>(WS_T) : X.ws<bf16>(WS_XMOD), third ? X.ws<bf16>(WS_WO) : X.ws<bf16>(WS_WIN), D}; pg8::StaticOrder S; S.init(M, third ? D : PCP, X.G, X.bid);
    pg8::EpiBf16OrF32 E{X.ws<bf16>(WS_P), X.ws<float>(WS_MIX), third ? D : PCP, third != 0}; pg8::gemm_phase(X.lds, g, S, E); }
PHASE_FN void ph_g2(Ctx X, int second) { pg8::Gemm g{second ? X.ws<bf16>(WS_HO) : X.ws<bf16>(WS_RO), X.ws<bf16>(WS_WB) + (second ? (size_t)D * RW : 0), RW}; pg8::StaticOrder S; S.init(M, D, X.G, X.bid);
    pg8::EpiGate E{X.ws<bf16>(WS_T), D, X.ws<bf16>(WS_P), PCP, second ? C_GH : C_GR, second != 0}; pg8::gemm_phase(X.lds, g, S, E); }
PHASE_FN void ph_g45(Ctx X, int l, int down) { const int NT = down ? D / 256 : 2 * D / 256; moe_table(X, l, NT); pg8::MoeOrder S{(const volatile LAS int*)(X.lds + LDS_MISC) + 8, NT, X.G, X.bid};
    pg8::Gemm g{down ? X.ws<bf16>(WS_ACT) : X.ws<bf16>(WS_XG), down ? X.ws<bf16>(WS_WD) : X.ws<bf16>(WS_WGU), D}; pg8::EpiMoe E{down ? X.ws<bf16>(WS_YS) : X.ws<bf16>(WS_ACT), D, NT, down == 0}; pg8::gemm_phase(X.lds, g, S, E); }

constexpr int NPH = 15, NPHASES = DEPTH * NPH;
template <int MASK> __global__ void __launch_bounds__(NTHR, 2) fwd_kernel(Args args) {
    DYN_LDS(lds);
    Ctx X; X.lds = lds; X.tid = threadIdx.x; X.lane = X.tid & 63; X.wave = READFIRSTLANE(X.tid >> 6); X.G = gridDim.x; X.bid = blockIdx.x;
    volatile LAS unsigned* misc = (volatile LAS unsigned*)(lds + LDS_MISC);
    if (X.tid < 128) misc[X.tid] = 0u;
    if (X.tid < N_IN + 2) { const unsigned long long p = X.tid < N_IN ? (unsigned long long)args.in[X.tid < N_IN ? X.tid : 0] : (X.tid == N_IN ? (unsigned long long)args.out : (unsigned long long)args.ws);
        misc[PT_WORD0 + 2 * X.tid] = (unsigned)p; misc[PT_WORD0 + 2 * X.tid + 1] = (unsigned)(p >> 32); }
    __syncthreads();
    XcdBarrier bar = xcd_barrier_post(X.ctl() + CW_BAR, misc);
    const int lo = args.ph_lo, hi = args.ph_hi;
#define IN(k) ((((MASK) >> ((k) % NPH)) & 1) && lo <= (k) && (k) < hi)
#ifdef PROBE_K
#ifndef PROBE_SCALE
#define PROBE_SCALE 1.0f
#endif
    unsigned long long plast = __builtin_amdgcn_s_memrealtime();
#define PROBE_T(k) do { if (blockIdx.x == 0 && threadIdx.x == 0) { const unsigned long long now_ = __builtin_amdgcn_s_memrealtime(); misc[100 + ((k) % NPH)] += (unsigned)(now_ - plast); plast = now_; } } while (0)
#define PROBE_PUB(k) do { if ((k) == NPHASES - 2 && blockIdx.x == 0 && threadIdx.x == 0) { PROBE_T(k); unsigned tot_ = 0; for (int i_ = 0; i_ < NPH; ++i_) tot_ += misc[100 + i_]; \
        const float f_ = PROBE_SCALE * (float)misc[100 + PROBE_K] / (float)tot_; __hip_atomic_store(X.ctl() + 64, fbits(f_), RLX_AGENT); } } while (0)
#else
#define PROBE_T(k) do {} while (0)
#define PROBE_PUB(k) do {} while (0)
#endif
#define SEAM(k) do { PROBE_PUB(k); if ((k) + 1 < hi) xcd_barrier(bar); PROBE_T(k); } while (0)
    for (int l = 0; l < DEPTH; ++l) {
        const int pb = l * NPH;
        if (IN(pb + 0)) { ph_transposes(X, l, 0); __syncthreads(); ph_filters(X, l); if (l == 0) ph_mod(X); SEAM(pb + 0); }
        if (l == 0 && IN(pb + 1)) { ph_x0(X); SEAM(pb + 1); }
        if (IN(pb + 2)) { ph_g13(X, 0); SEAM(pb + 2); }
        if (IN(pb + 3)) { for (int tile = X.bid; tile < M / TT; tile += X.G) { ph_prep_a(X, l, tile * TT); ph_prep_b(X, l, tile * TT); } ph_prep_hyena(X, l); ph_spectra(X, l); SEAM(pb + 3); }
        if (IN(pb + 4)) { for (int u = X.bid; u < 2 * NCHK * NH; u += X.G) { ph_chunk_1(X, u); ph_chunk_2(X, u); ph_chunk_3(X, u); } SEAM(pb + 4); }
        if (IN(pb + 5)) { ph_seq(X); ph_transposes(X, l, 1); __syncthreads(); ph_ctxconv(X, l); ph_fftconv(X, l); SEAM(pb + 5); }
        if (IN(pb + 6)) { ph_finish(X, l); SEAM(pb + 6); }
        for (int sb = 0; sb < 2; ++sb) if (IN(pb + 7 + sb)) { ph_g2(X, sb); SEAM(pb + 7 + sb); }
        if (IN(pb + 9)) { ph_g13(X, 1); SEAM(pb + 9); }
        if (IN(pb + 10)) { ph_norm1(X, l); SEAM(pb + 10); }
        if (IN(pb + 11)) { ph_scatter(X, l); SEAM(pb + 11); }
        for (int dn = 0; dn < 2; ++dn) if (IN(pb + 12 + dn)) { ph_g45(X, l, dn); SEAM(pb + 12 + dn); }
        if (IN(pb + 14)) { ph_combine(X, l); SEAM(pb + 14); }
    }
#undef IN
#undef SEAM
}

#ifndef N_LAUNCHES
#define N_LAUNCHES 1
#endif
#ifndef PH_MASK
#define PH_MASK 0x7fff
#endif
template <int MASK> static void launch_mask(int grid, hipStream_t stream, const Args& a) {
    static bool attr = false;
    if (!attr) { (void)hipFuncSetAttribute((const void*)fwd_kernel<MASK>, hipFuncAttributeMaxDynamicSharedMemorySize, LDS_BYTES); attr = true; }
    hipLaunchKernelGGL(fwd_kernel<MASK>, dim3(grid), dim3(NTHR), LDS_BYTES, stream, a);
}
extern "C" void kernel_launch(void* const* d_in, const int* in_sizes, int n_in, void* d_out, int out_size, void* d_ws, size_t ws_size, hipStream_t stream) {
    static int grid = 0;
    if (grid == 0) {
        if (n_in != N_IN || ws_size < WS_END) { fprintf(stderr, "kernel_launch: unexpected n_in %d or workspace %zu < %zu\n", n_in, ws_size, (size_t)WS_END); grid = -1; return; }
        int dev = 0, cus = 0;
        if (hipGetDevice(&dev) != hipSuccess || hipDeviceGetAttribute(&cus, hipDeviceAttributeMultiprocessorCount, dev) != hipSuccess) { grid = -1; return; }
        (void)hipGetLastError();
        grid = cus; if (grid > NPART) grid = NPART;
    }
    if (grid < 0) return;
    (void)in_sizes; (void)out_size;
    (void)hipMemsetAsync(d_ws, 0, CTL_BYTES, stream);
    Args a;
    for (int i = 0; i < N_IN; ++i) a.in[i] = (const float*)d_in[i];
    a.out = (float*)d_out; a.ws = (unsigned char*)d_ws;
#if N_LAUNCHES == 1
    a.ph_lo = 0; a.ph_hi = NPHASES;
    launch_mask<PH_MASK>(grid, stream, a);
#else
    for (int ph = 0; ph < NPHASES; ++ph) { const int k = ph % NPH; if (k == 1 && ph / NPH != 0) continue; a.ph_lo = ph; a.ph_hi = ph + 1; launch_mask<PH_MASK>(grid, stream, a); }
#endif
}
```

```cpp
#ifndef EMU
#include <hip/hip_runtime.h>
#endif
#include <cstdio>
#include <cstdint>
#include <cmath>

#ifndef CFG_D
#define CFG_D 1024
#define CFG_SEQ 16384
#define CFG_CTX 256
#define CFG_DEPTH 4
#endif
constexpr int D = CFG_D, SEQ = CFG_SEQ, CTX = CFG_CTX, DEPTH = CFG_DEPTH, M = CTX + SEQ;
constexpr int GRID_W = 64, GRID_H = SEQ / GRID_W;
constexpr int RW = D / 2, NH = RW / 64, HW = D / 2, RC = 3 * RW + 384, HC = 3 * HW, GC = 2 * D, PC = RC + HC + GC, PCP = (PC + 255) / 256 * 256;
constexpr int QTR = RC / 4, HALFC = RC / 2;
constexpr int C_K = RW, C_V = 2 * RW, C_LWF = 3 * RW, C_LG = 3 * RW + 256;
constexpr int C_HY = RC, C_GR = RC + HC, C_GH = RC + HC + D;
constexpr int NE = 16, SP_TILES = (2 * M) / 256 + NE, SP = SP_TILES * 256;
constexpr float DECAY_SCALE = 0.606531f, GN_EPS = 6.4e-4f, LN_EPS = 1e-5f;
constexpr int N_SEQ_UNITS = 2 * NH * 4;
constexpr int NPART = 256;
static_assert(CTX % 32 == 0 && M % 256 == 0 && D % 256 == 0 && RW % 128 == 0 && RW >= 256 && SEQ % 64 == 0 && CTX % 32 == 0 && RC % 4 == 0, "shape assumptions");

enum { I_X = 0, I_C, I_CTX, I_CCTX, I_WMOD, I_BMOD, I_WIN, I_MU, I_W0, I_W2, I_A0, I_A2, I_G2, I_KK, I_KA, I_RK, I_LNXG, I_LNXB, I_CW, I_CB,
       I_FW1, I_FB1, I_FW2, I_FB2, I_FW3, I_FB3, I_FWO, I_FREQ, I_HBIAS, I_WBR, I_WOUT, I_LNG, I_LNB, I_WR, I_RB, I_WG, I_WU, I_WD, N_IN };

constexpr size_t al256(size_t x) { return (x + 255) & ~(size_t)255; }
constexpr size_t CTL_BYTES = 1u << 20;
constexpr size_t WS_MOD = CTL_BYTES;
constexpr size_t WS_FPART = al256(WS_MOD + (size_t)DEPTH * 2 * 6 * D * 4);
constexpr size_t WS_ROUT = al256(WS_FPART + (size_t)2 * NPART * HW * 4);
constexpr size_t WS_BCNT = al256(WS_ROUT + (size_t)M * 2 * 4 * 3);
constexpr size_t WS_BONUS = al256(WS_BCNT + (size_t)NPART * NE * 4);
constexpr size_t WS_WIN = al256(WS_BONUS + (size_t)M * NH * 4);
constexpr size_t WS_WB = al256(WS_WIN + (size_t)PCP * D * 2);
constexpr size_t WS_WO = al256(WS_WB + (size_t)2 * D * RW * 2);
constexpr size_t WS_W2T = al256(WS_WO + (size_t)D * D * 2);
constexpr size_t WS_A2T = al256(WS_W2T + (size_t)2 * RW * 64 * 2);
constexpr size_t WS_G2T = al256(WS_A2T + (size_t)2 * RW * 64 * 2);
constexpr size_t WS_WGU = al256(WS_G2T + (size_t)RW * 128 * 2);
constexpr size_t WS_WD = al256(WS_WGU + (size_t)NE * 2 * D * D * 2);
constexpr size_t WS_X = al256(WS_WD + (size_t)NE * D * D * 2);
constexpr size_t WS_XMOD = al256(WS_X + (size_t)M * D * 4);
constexpr size_t WS_P = al256(WS_XMOD + (size_t)M * D * 2);
constexpr size_t WS_FILT = al256(WS_P + (size_t)M * PCP * 2);
constexpr size_t WS_MIX = al256(WS_FILT + (size_t)M * HW * 4);
constexpr size_t WS_T = al256(WS_MIX + (size_t)M * D * 4);
constexpr size_t WS_S = al256(WS_T + (size_t)M * D * 2);
constexpr size_t WS_R = WS_S;
constexpr size_t WS_V = al256(WS_R + (size_t)M * RW * 2);
constexpr size_t WS_KA = al256(WS_V + (size_t)M * RW * 2);
constexpr size_t WS_KD = al256(WS_KA + (size_t)M * RW * 2);
constexpr size_t WS_KB = al256(WS_KD + (size_t)2 * M * RW * 2);
constexpr size_t WS_W = al256(WS_KB + (size_t)2 * M * RW * 2);
constexpr size_t WS_PQ = al256(WS_W + (size_t)2 * M * RW * 4);
constexpr size_t WS_LIN = WS_PQ;
static_assert((size_t)M * 384 * 2 <= (size_t)2 * NH * (M / 64) * 2 * 4096 * 4, "LIN fits PQ");
constexpr size_t WS_G = al256(WS_PQ + (size_t)2 * NH * (M / 64) * 2 * 4096 * 4);
constexpr size_t WS_YL = al256(WS_G + (size_t)2 * NH * (M / 64) * 4096 * 2);
constexpr size_t WS_S0 = WS_XMOD;
static_assert((size_t)2 * NH * (M / 64) * 4096 * 2 <= (size_t)M * D * 2, "S0 fits XMOD");
constexpr size_t WS_Z = al256(WS_YL + (size_t)2 * NH * (M / 64) * 4096 * 4);
constexpr size_t WS_X0 = al256(WS_Z + (size_t)CTX * HW * 4);
constexpr size_t WS_CONV = al256(WS_X0 + (size_t)M * HW * 2);
constexpr size_t WS_GATE = al256(WS_CONV + (size_t)CTX * HW * 4);
constexpr size_t WS_RO = al256(WS_GATE + (size_t)M * RW * 2);
constexpr size_t WS_HO = al256(WS_RO + (size_t)M * RW * 2);
constexpr size_t WS_HS = WS_MIX;
constexpr size_t WS_ZT = WS_T;
constexpr size_t WS_CVT = WS_FILT;
static_assert((size_t)HW * (SEQ + 1) * 8 <= (size_t)M * D * 4 && (size_t)HW * M * 4 <= (size_t)M * D * 2, "HS fits MIX, ZT fits T");
constexpr size_t WS_END1 = al256(WS_HO + (size_t)M * HW * 2);
constexpr size_t WS_XG = WS_S;
constexpr size_t WS_ACT = al256(WS_XG + (size_t)SP * D * 2);
constexpr size_t WS_YS = al256(WS_ACT + (size_t)SP * D * 2);
constexpr size_t WS_END2 = al256(WS_YS + (size_t)SP * D * 2);
constexpr size_t WS_END = WS_END1 > WS_END2 ? WS_END1 : WS_END2;
constexpr int CW_TMO = 0, CW_BAR = 4096, CW_CNT = 8192  , CW_CUR = 8192 + 1024  , CW_Q = 8192 + 2048  ;

#ifdef EMU
#define LAS
typedef short bf16x8 __attribute__((vector_size(16)));
typedef float f32x4 __attribute__((vector_size(16)));
typedef unsigned u32x4 __attribute__((vector_size(16)));
#define DYN_LDS(name) unsigned char* name = emu_cur_lds()
#define ASM_WAIT_V(n) do {} while (0)
#define ASM_WAIT_L(n) do {} while (0)
#define ASM_WAIT_VL0() do {} while (0)
#define CFENCE() do {} while (0)
#define WAVE_LDS_FENCE() emu_wave_sync()
#define S_BARRIER() emu_block_sync()
#define SCHED_BARRIER() do {} while (0)
#define SETPRIO(x) do {} while (0)
#define S_SLEEP(n) emu_yield()
#define MFMA16(a, b, c) emu_mfma_16x16x32(a, b, c)
#define GLDS16(gptr, lptr) emu_glds16((const void*)(gptr), (void*)(lptr))
#define READFIRSTLANE(x) (x)
#define XCC_ID_() (blockIdx.x & 7u)
#define FENCE_RELEASE() do {} while (0)
#define FENCE_ACQUIRE() do {} while (0)
#define DPP_F(v, ctrl) emu_dpp_f(v, ctrl)
static inline int vgpr_zero() { return 0; }
static inline unsigned long long vgpr_zero64() { return 0ull; }
static inline int lds_add(volatile int* p, int v) { int o = *p; *p = o + v; return o; }
static inline unsigned fbits(float f) { unsigned u; memcpy(&u, &f, 4); return u; }
static inline float bitsf(unsigned u) { float f; memcpy(&f, &u, 4); return f; }
#else
#define LAS __attribute__((address_space(3)))
typedef short bf16x8 __attribute__((ext_vector_type(8)));
typedef float f32x4 __attribute__((ext_vector_type(4)));
typedef unsigned u32x4 __attribute__((ext_vector_type(4)));
#define DYN_LDS(name) extern __shared__ __attribute__((aligned(16))) unsigned char name##_raw[]; LAS unsigned char* name = (LAS unsigned char*)name##_raw
#define ASM_WAIT_V(n) asm volatile("s_waitcnt vmcnt(" #n ")" ::: "memory")
#define ASM_WAIT_L(n) asm volatile("s_waitcnt lgkmcnt(" #n ")" ::: "memory")
#define ASM_WAIT_VL0() asm volatile("s_waitcnt vmcnt(0) lgkmcnt(0)" ::: "memory")
#define CFENCE() asm volatile("" ::: "memory")
#define WAVE_LDS_FENCE() asm volatile("s_waitcnt lgkmcnt(0)" ::: "memory")
#define S_BARRIER() __builtin_amdgcn_s_barrier()
#define SCHED_BARRIER() __builtin_amdgcn_sched_barrier(0)
#define SETPRIO(x) __builtin_amdgcn_s_setprio(x)
#define S_SLEEP(n) __builtin_amdgcn_s_sleep(n)
#define MFMA16(a, b, c) __builtin_amdgcn_mfma_f32_16x16x32_bf16(a, b, c, 0, 0, 0)
#define GLDS16(gptr, lptr) __builtin_amdgcn_global_load_lds((const unsigned*)(gptr), (LAS unsigned*)(lptr), 16, 0, 0)
#define READFIRSTLANE(x) __builtin_amdgcn_readfirstlane(x)
#define XCC_ID_() ((unsigned)__builtin_amdgcn_s_getreg((3 << 11) | 20) & 0xFu)
#define FENCE_RELEASE() __builtin_amdgcn_fence(__ATOMIC_RELEASE, "agent")
#define FENCE_ACQUIRE() __builtin_amdgcn_fence(__ATOMIC_ACQUIRE, "agent")
#define DPP_F(v, ctrl) __builtin_bit_cast(float, __builtin_amdgcn_update_dpp(0, __builtin_bit_cast(int, (float)(v)), (ctrl), 0xF, 0xF, true))
__device__ __forceinline__ int vgpr_zero() { int z; asm volatile("v_mov_b32 %0, 0" : "=v"(z)); return z; }
__device__ __forceinline__ unsigned long long vgpr_zero64() { unsigned long long z; asm volatile("v_mov_b64 %0, 0" : "=v"(z)); return z; }
__device__ __forceinline__ int lds_add(volatile LAS int* p, int v) { return __hip_atomic_fetch_add((LAS int*)p, v, __ATOMIC_RELAXED, __HIP_MEMORY_SCOPE_WORKGROUP); }
__device__ __forceinline__ unsigned fbits(float f) { return __builtin_bit_cast(unsigned, f); }
__device__ __forceinline__ float bitsf(unsigned u) { return __builtin_bit_cast(float, u); }
#endif
typedef unsigned short bf16;
#define RLX_AGENT __ATOMIC_RELAXED, __HIP_MEMORY_SCOPE_AGENT

__device__ __forceinline__ unsigned f2bf(float f) { unsigned u = fbits(f); return (u + 0x7fffu + ((u >> 16) & 1u)) >> 16; }
__device__ __forceinline__ unsigned pk2(float lo, float hi) { return f2bf(lo) | (f2bf(hi) << 16); }
__device__ __forceinline__ float bf2f(bf16 b) { return bitsf(((unsigned)b) << 16); }
__device__ __forceinline__ float bflo(unsigned w) { return bitsf(w << 16); }
__device__ __forceinline__ float bfhi(unsigned w) { return bitsf(w & 0xffff0000u); }
__device__ __forceinline__ float sigmoidf_(float x) { return 1.0f / (1.0f + expf(-x)); }
__device__ __forceinline__ float wave_sum(float v) {
#pragma unroll
    for (int o = 1; o < 64; o <<= 1) v += __shfl_xor(v, o);
    return v;
}
__device__ __forceinline__ float row16_sum(float v) {
    v += DPP_F(v, 0xB1);
    v += DPP_F(v, 0x4E);
    v += DPP_F(v, 0x141);
    v += DPP_F(v, 0x140);
    return v;
}
__device__ __forceinline__ void sincos_f(float x, float& s, float& c) {
    const float k = rintf(x * 0.63661977236758134f);
    float r = fmaf(-k, 1.5703125f, x); r = fmaf(-k, 4.837512969970703125e-4f, r); r = fmaf(-k, 7.54978994989188216e-8f, r);
    const float r2 = r * r;
    const float sp = r + r * r2 * (-1.6666654611e-1f + r2 * (8.3321608736e-3f + r2 * (-1.9515295891e-4f)));
    const float cp = 1.0f - 0.5f * r2 + r2 * r2 * (4.166664568298827e-2f + r2 * (-1.388731625493765e-3f + r2 * (2.443315711809948e-5f)));
    const int q = ((int)k) & 3;
    s = (q == 0) ? sp : (q == 1) ? cp : (q == 2) ? -sp : -cp;
    c = (q == 0) ? cp : (q == 1) ? -sp : (q == 2) ? -cp : sp;
}
__device__ __forceinline__ float sin_f(float x) { float s, c; sincos_f(x, s, c); return s; }

#define XB_TMO      128
#define XB_XCNT(j)  (256  + 64 * (j))
#define XB_XSUB(j)  (1280 + 64 * (j))
#define XB_XGEN(j)  (2304 + 64 * (j))
#define XB_TOP      3328
#define XB_TOPGEN   3392
#define XCD_BAR_WORDS 3456
#define XB_SPIN_CAP (1u << 18)
__device__ __forceinline__ unsigned xb_ld(unsigned* p)              { return __hip_atomic_load(p, __ATOMIC_RELAXED, __HIP_MEMORY_SCOPE_AGENT); }
__device__ __forceinline__ unsigned xb_add(unsigned* p, unsigned v) { return __hip_atomic_fetch_add(p, v, __ATOMIC_RELAXED, __HIP_MEMORY_SCOPE_AGENT); }
#define XB_SPIN(cond, bar) do { unsigned _sp = 0; while (cond) { S_SLEEP(1); \
    if ((++_sp & 255u) == 0u) { if (xb_ld(&(bar)[XB_TMO])) break; if (_sp > XB_SPIN_CAP) { atomicAdd(&(bar)[XB_TMO], 1u); break; } } } } while (0)
struct XcdBarrier { unsigned* bar; unsigned x; volatile LAS unsigned* st; };
__device__ __forceinline__ XcdBarrier xcd_barrier_post(unsigned* bar, volatile LAS unsigned* st) {
    XcdBarrier b; b.bar = nullptr; b.x = XCC_ID_(); b.st = st;
    if (threadIdx.x == 0) { st[2] = (unsigned)(unsigned long long)bar; st[3] = (unsigned)((unsigned long long)bar >> 32); st[4] = b.x; (void)xb_add(&bar[XB_XCNT(b.x)], 1u); }
    return b;
}
__device__ __forceinline__ void xcd_barrier_complete(unsigned* bar, unsigned x, unsigned& nloc, unsigned& nx) {
    const unsigned G = gridDim.x * gridDim.y * gridDim.z;
    unsigned sum, cnt, mine, sp = 0u;
    for (;;) {
        sum = 0u; cnt = 0u; mine = 0u;
#pragma unroll
        for (unsigned j = 0; j < 16; ++j) { const unsigned c = xb_ld(&bar[XB_XCNT(j)]); sum += c; cnt += (c > 0u) ? 1u : 0u; mine = (j == x) ? c : mine; }
        if (sum == G) break;
        S_SLEEP(1);
        if ((++sp & 255u) == 0u) { if (xb_ld(&bar[XB_TMO])) break; if (sp > XB_SPIN_CAP) { atomicAdd(&bar[XB_TMO], 1u); break; } }
    }
    nloc = mine > 0u ? mine : 1u; nx = cnt > 0u ? cnt : 1u;
}
__device__ __forceinline__ void xcd_barrier(const XcdBarrier& b) {
    ASM_WAIT_V(0);
    __syncthreads();
    if (threadIdx.x == 0) {
        unsigned* bar = (unsigned*)(((unsigned long long)b.st[3] << 32) | b.st[2]);
        const unsigned bx = b.st[4];
        ASM_WAIT_VL0();
        unsigned nloc = b.st[0], nx = b.st[1];
        if (nloc == 0u) { xcd_barrier_complete(bar, bx, nloc, nx); b.st[0] = nloc; b.st[1] = nx; }
        const unsigned old = xb_add(&bar[XB_XSUB(bx)], 1u);
        const unsigned gen = old / nloc;
        if (old + 1u == (gen + 1u) * nloc) {
            FENCE_RELEASE();
            ASM_WAIT_V(0);
            const unsigned og = xb_add(&bar[XB_TOP], 1u);
            const unsigned tg = og / nx;
            if (og + 1u == (tg + 1u) * nx) xb_add(&bar[XB_TOPGEN], 1u);
            else XB_SPIN(xb_ld(&bar[XB_TOPGEN]) == tg, bar);
            FENCE_ACQUIRE();
            xb_add(&bar[XB_XGEN(bx)], 1u);
            ASM_WAIT_V(0);
        } else {
            XB_SPIN(xb_ld(&bar[XB_XGEN(bx)]) == gen, bar);
            FENCE_ACQUIRE();
            ASM_WAIT_V(0);
        }
    }
    __syncthreads();
}

namespace pg8 {
constexpr int BM = 256, BK = 64, HALF = 128, HTB = HALF * BK * 2, STAGE_BYTES = 8 * HTB, NXCD = 8, WGM = 8;
__host__ __device__ __forceinline__ int lds_byte(int r, int c) { const int st = (r >> 4) * 2 + (c >> 5), rr = r & 15, cc = c & 31, ob = rr * 64 + cc * 2; return st * 1024 + (ob ^ (((ob >> 9) & 1) << 5)); }
__host__ __device__ __forceinline__ void stage_rc(int b, int& R, int& C) { const int st = b / 1024, sb = b % 1024, swz = sb ^ (((sb >> 9) & 1) << 5); R = (st >> 1) * 16 + swz / 64; C = (st & 1) * 32 + (swz % 64) / 2; }
__host__ __device__ __forceinline__ int perm32(int rho) { const int n = rho >> 4, i = rho & 15; return 8 * (i >> 2) + 4 * n + (i & 3); }
struct Unit { int pm, pn; };
struct Gemm { const bf16* A; const bf16* Bt; int K; };
struct StaticOrder {
    int nM, nN, nwg, G, c;
    __host__ __device__ void init(int M_, int N_, int G_, int c_) { nM = M_ / BM; nN = N_ / BM; nwg = nM * nN; G = G_; c = c_; }
    __host__ __device__ bool next(int i, Unit& u) const {
        const long L = (long)i * G + c; if (L >= nwg) return false;
        int wgid = (int)L; { const int q = nwg / NXCD, r = nwg % NXCD, xcd = wgid % NXCD, off = wgid / NXCD; wgid = (xcd < r ? xcd * (q + 1) : r * (q + 1) + (xcd - r) * q) + off; }
        const int nig = WGM * nN, gid = wgid / nig, fm = gid * WGM, gsz = (nM - fm) < WGM ? (nM - fm) : WGM;
        u.pm = fm + ((wgid % nig) % gsz); u.pn = (wgid % nig) / gsz; return true;
    }
};
struct MoeOrder {
    const volatile LAS int* tab; int NT, G, c;
    __device__ __forceinline__ bool next(int i, Unit& u) const {
        const long L = (long)i * G + c; if (L >= tab[16]) return false;
        int e = 0; while (L >= tab[e + 1]) ++e;
        const int loc = (int)L - tab[e], tc = tab[64 + e];
        u.pm = tab[32 + e] + loc % tc; u.pn = e * NT + loc / tc; return true;
    }
};
__device__ __forceinline__ unsigned cvt_pk_bf16(float lo, float hi) {
#ifdef EMU
    return pk2(lo, hi);
#else
    unsigned r; asm volatile("v_cvt_pk_bf16_f32 %0, %1, %2" : "=v"(r) : "v"(lo), "v"(hi)); return r;
#endif
}

struct EpiBf16 {
    static constexpr bool PERM = true;
    bf16* O; int ldc;
    __device__ __forceinline__ void operator()(const f32x4 (&acc)[2][2][4][2], const Unit& u, int wr, int wc, int fr, int fq) const {
        const int row0 = u.pm * BM + wr * 64 + fr, col0 = u.pn * BM + wc * 32 + 8 * fq;
#pragma unroll
        for (int ai = 0; ai < 2; ++ai)
#pragma unroll
            for (int m = 0; m < 4; ++m) { bf16* rowp = O + (size_t)(row0 + ai * HALF + m * 16) * ldc + col0;
#pragma unroll
                for (int bj = 0; bj < 2; ++bj) { const f32x4 v0 = acc[ai][bj][m][0], v1 = acc[ai][bj][m][1];
                    u32x4 w; w[0] = cvt_pk_bf16(v0[0], v0[1]); w[1] = cvt_pk_bf16(v0[2], v0[3]); w[2] = cvt_pk_bf16(v1[0], v1[1]); w[3] = cvt_pk_bf16(v1[2], v1[3]);
                    *(u32x4*)(rowp + bj * HALF) = w; } }
    }
};
struct EpiF32 {
    static constexpr bool PERM = true;
    float* C; int ldc;
    __device__ __forceinline__ void operator()(const f32x4 (&acc)[2][2][4][2], const Unit& u, int wr, int wc, int fr, int fq) const {
        const int row0 = u.pm * BM + wr * 64 + fr, col0 = u.pn * BM + wc * 32 + 8 * fq;
#pragma unroll
        for (int ai = 0; ai < 2; ++ai)
#pragma unroll
            for (int m = 0; m < 4; ++m) { float* rowp = C + (size_t)(row0 + ai * HALF + m * 16) * ldc + col0;
#pragma unroll
                for (int bj = 0; bj < 2; ++bj)
#pragma unroll
                    for (int n = 0; n < 2; ++n) *(f32x4*)(rowp + bj * HALF + n * 4) = acc[ai][bj][m][n]; }
    }
};
struct EpiGate {
    static constexpr bool PERM = true;
    bf16* T; int ldc; const bf16* Pg; int ldp; int gcol0; bool ADD;
    __device__ __forceinline__ void operator()(const f32x4 (&acc)[2][2][4][2], const Unit& u, int wr, int wc, int fr, int fq) const {
        const int row0 = u.pm * BM + wr * 64 + fr, col0 = u.pn * BM + wc * 32 + 8 * fq;
#pragma unroll
        for (int ai = 0; ai < 2; ++ai)
#pragma unroll
            for (int m = 0; m < 4; ++m) { const size_t row = (size_t)(row0 + ai * HALF + m * 16);
#pragma unroll
                for (int bj = 0; bj < 2; ++bj) { const f32x4 v0 = acc[ai][bj][m][0], v1 = acc[ai][bj][m][1];
                    const u32x4 g = *(const u32x4*)(Pg + row * ldp + gcol0 + col0 + bj * HALF);
                    u32x4 t = {0u, 0u, 0u, 0u}; if (ADD) t = *(const u32x4*)(T + row * ldc + col0 + bj * HALF);
                    float o[8];
#pragma unroll
                    for (int j = 0; j < 4; ++j) { const float a0 = j < 2 ? v0[2 * j] : v1[2 * j - 4], a1 = j < 2 ? v0[2 * j + 1] : v1[2 * j - 3];
                        o[2 * j] = bflo(t[j]) + sigmoidf_(bflo(g[j])) * a0; o[2 * j + 1] = bfhi(t[j]) + sigmoidf_(bfhi(g[j])) * a1; }
                    u32x4 w; w[0] = cvt_pk_bf16(o[0], o[1]); w[1] = cvt_pk_bf16(o[2], o[3]); w[2] = cvt_pk_bf16(o[4], o[5]); w[3] = cvt_pk_bf16(o[6], o[7]);
                    *(u32x4*)(T + row * ldc + col0 + bj * HALF) = w; } }
    }
};
struct EpiSwiglu {
    static constexpr bool PERM = true;
    bf16* O; int ldc; int NT;
    __device__ __forceinline__ void operator()(const f32x4 (&acc)[2][2][4][2], const Unit& u, int wr, int wc, int fr, int fq) const {
        const int row0 = u.pm * BM + wr * 64 + fr, col0 = (u.pn % NT) * HALF + wc * 32 + 8 * fq;
#pragma unroll
        for (int ai = 0; ai < 2; ++ai)
#pragma unroll
            for (int m = 0; m < 4; ++m) { bf16* rowp = O + (size_t)(row0 + ai * HALF + m * 16) * ldc + col0;
                float o[8];
#pragma unroll
                for (int j = 0; j < 8; ++j) { const float g = acc[ai][0][m][j >> 2][j & 3], uu = acc[ai][1][m][j >> 2][j & 3]; o[j] = g / (1.0f + expf(-g)) * uu; }
                u32x4 w; w[0] = cvt_pk_bf16(o[0], o[1]); w[1] = cvt_pk_bf16(o[2], o[3]); w[2] = cvt_pk_bf16(o[4], o[5]); w[3] = cvt_pk_bf16(o[6], o[7]);
                *(u32x4*)rowp = w; }
    }
};
struct EpiMoeDown {
    static constexpr bool PERM = true;
    bf16* O; int ldc; int NT;
    __device__ __forceinline__ void operator()(const f32x4 (&acc)[2][2][4][2], const Unit& u, int wr, int wc, int fr, int fq) const {
        const int row0 = u.pm * BM + wr * 64 + fr, col0 = (u.pn % NT) * BM + wc * 32 + 8 * fq;
#pragma unroll
        for (int ai = 0; ai < 2; ++ai)
#pragma unroll
            for (int m = 0; m < 4; ++m) { bf16* rowp = O + (size_t)(row0 + ai * HALF + m * 16) * ldc + col0;
#pragma unroll
                for (int bj = 0; bj < 2; ++bj) { const f32x4 v0 = acc[ai][bj][m][0], v1 = acc[ai][bj][m][1];
                    u32x4 w; w[0] = cvt_pk_bf16(v0[0], v0[1]); w[1] = cvt_pk_bf16(v0[2], v0[3]); w[2] = cvt_pk_bf16(v1[0], v1[1]); w[3] = cvt_pk_bf16(v1[2], v1[3]);
                    *(u32x4*)(rowp + bj * HALF) = w; } }
    }
};

struct EpiBf16OrF32 { static constexpr bool PERM = true; bf16* O; float* C; int ldc; bool f32;
    __device__ __forceinline__ void operator()(const f32x4 (&acc)[2][2][4][2], const Unit& u, int wr, int wc, int fr, int fq) const {
        if (f32) { EpiF32 E{C, ldc}; E(acc, u, wr, wc, fr, fq); } else { EpiBf16 E{O, ldc}; E(acc, u, wr, wc, fr, fq); } } };
struct EpiMoe { static constexpr bool PERM = true; bf16* O; int ldc; int NT; bool swiglu;
    __device__ __forceinline__ void operator()(const f32x4 (&acc)[2][2][4][2], const Unit& u, int wr, int wc, int fr, int fq) const {
        if (swiglu) { EpiSwiglu E{O, ldc, NT}; E(acc, u, wr, wc, fr, fq); } else { EpiMoeDown E{O, ldc, NT}; E(acc, u, wr, wc, fr, fq); } } };
template <class Epi, class Sched>
__device__ __forceinline__ void gemm_phase(LAS unsigned char* lds, const Gemm g, const Sched& S, const Epi& E) {
    const int tid = threadIdx.x + vgpr_zero();
    const int wid = READFIRSTLANE(tid >> 6), lane = tid & 63, wr = wid >> 2, wc = wid & 3, fr = lane & 15, fq = lane >> 4;
    const int K = g.K, nt = K / BK;
    unsigned long long voffA[2], voffB[2]; const unsigned long long zhi = vgpr_zero64();
#pragma unroll
    for (int i = 0; i < 2; ++i) { int R, C; stage_rc(tid * 16 + i * 8192, R, C); const int Rb = Epi::PERM ? ((R & ~31) + perm32(R & 31)) : R;
        voffA[i] = zhi + (unsigned long long)(long long)((R * K + C) * 2); voffB[i] = zhi + (unsigned long long)(long long)((Rb * K + C) * 2); }
    const size_t kstep = (size_t)(BK * 2);
    const size_t hstep = (size_t)HALF * K * 2;
    const size_t tstep = 2 * hstep;
    const unsigned ldsw = (unsigned)wid * 1024u;
    const int aoff = lds_byte(wr * 64 + fr, fq * 8), boff = lds_byte(wc * 32 + fr, fq * 8);
#define PG8_SA(b, h) (((b) * 2 + (h)) * HTB)
#define PG8_SB(b, h) ((4 + (b) * 2 + (h)) * HTB)
#define PG8_STAGE(bufoff, gbase, voff) do { _Pragma("unroll") for (int _i = 0; _i < 2; ++_i) \
        GLDS16((const char*)(gbase) + (voff)[_i], lds + (bufoff) + ldsw + _i * 8192); } while (0)
#define PG8_LDA(dst, b, h) do { _Pragma("unroll") for (int m = 0; m < 4; ++m) _Pragma("unroll") for (int k = 0; k < 2; ++k) dst[m][k] = *(const LAS bf16x8*)(lds + PG8_SA(b, h) + aoff + m * 2048 + k * 1024); } while (0)
#define PG8_LDB(dst, b, h) do { _Pragma("unroll") for (int n = 0; n < 2; ++n) _Pragma("unroll") for (int k = 0; k < 2; ++k) dst[n][k] = *(const LAS bf16x8*)(lds + PG8_SB(b, h) + boff + n * 2048 + k * 1024); } while (0)
#define PG8_MMA(ai, bj, At, Bt) do { SETPRIO(1); _Pragma("unroll") for (int m = 0; m < 4; ++m) _Pragma("unroll") for (int n = 0; n < 2; ++n) _Pragma("unroll") for (int k = 0; k < 2; ++k) \
        acc[ai][bj][m][n] = MFMA16(Bt[n][k], At[m][k], acc[ai][bj][m][n]); SETPRIO(0); } while (0)
#define PG8_BAR S_BARRIER()
    Unit cur, nxt; int ui = 0;
    if (!S.next(0, cur)) return;
    f32x4 acc[2][2][4][2];
#pragma unroll
    for (int a = 0; a < 2; ++a)
#pragma unroll
        for (int b = 0; b < 2; ++b)
#pragma unroll
            for (int m = 0; m < 4; ++m)
#pragma unroll
                for (int n = 0; n < 2; ++n) acc[a][b][m][n] = (f32x4){0.f, 0.f, 0.f, 0.f};
    bf16x8 At[4][2], B0[2][2], B1[2][2];
    const char* cA = (const char*)g.A + (size_t)cur.pm * tstep; const char* cB = (const char*)g.Bt + (size_t)cur.pn * tstep;
    PG8_STAGE(PG8_SB(0, 0), cB, voffB); PG8_STAGE(PG8_SA(0, 0), cA, voffA); PG8_STAGE(PG8_SB(0, 1), cB + hstep, voffB); PG8_STAGE(PG8_SA(0, 1), cA + hstep, voffA);
    if (wr == 1) PG8_BAR;
    ASM_WAIT_V(4); PG8_BAR;
    PG8_STAGE(PG8_SB(1, 0), cB + kstep, voffB); PG8_STAGE(PG8_SA(1, 0), cA + kstep, voffA); PG8_STAGE(PG8_SB(1, 1), cB + hstep + kstep, voffB);
    ASM_WAIT_V(6); PG8_BAR;
    for (;;) {
        const bool has_next = S.next(ui + 1, nxt);
        const char* nA = has_next ? (const char*)g.A + (size_t)nxt.pm * tstep : cA; const char* nB = has_next ? (const char*)g.Bt + (size_t)nxt.pn * tstep : cB;
        for (int t = 0; t < nt; t += 2) {
            const bool last = (t == nt - 2);
            const char* a1 = cA + (size_t)(t + 1) * kstep;
            const char* a2 = last ? nA : cA + (size_t)(t + 2) * kstep; const char* b2 = last ? nB : cB + (size_t)(t + 2) * kstep;
            const char* a3 = a2 + kstep; const char* b3 = b2 + kstep;
            PG8_LDB(B0, 0, 0); SCHED_BARRIER(); PG8_LDA(At, 0, 0); PG8_STAGE(PG8_SA(1, 1), a1 + hstep, voffA);
            ASM_WAIT_L(8); PG8_BAR; ASM_WAIT_L(0); PG8_MMA(0, 0, At, B0); PG8_BAR; SCHED_BARRIER();
            PG8_LDB(B1, 0, 1); PG8_STAGE(PG8_SB(0, 0), b2, voffB);
            PG8_BAR; ASM_WAIT_L(0); PG8_MMA(0, 1, At, B1); PG8_BAR;
            PG8_LDA(At, 0, 1); PG8_STAGE(PG8_SA(0, 0), a2, voffA);
            PG8_BAR; ASM_WAIT_L(0); PG8_MMA(1, 0, At, B0); PG8_BAR; SCHED_BARRIER();
            PG8_STAGE(PG8_SB(0, 1), b2 + hstep, voffB);
            ASM_WAIT_V(6); PG8_BAR; PG8_MMA(1, 1, At, B1); PG8_BAR;
            PG8_LDB(B0, 1, 0); SCHED_BARRIER(); PG8_LDA(At, 1, 0); PG8_STAGE(PG8_SA(0, 1), a2 + hstep, voffA);
            ASM_WAIT_L(8); PG8_BAR; ASM_WAIT_L(0); PG8_MMA(0, 0, At, B0); PG8_BAR; SCHED_BARRIER();
            PG8_LDB(B1, 1, 1); PG8_STAGE(PG8_SB(1, 0), b3, voffB);
            PG8_BAR; ASM_WAIT_L(0); PG8_MMA(0, 1, At, B1); PG8_BAR;
            PG8_LDA(At, 1, 1); PG8_STAGE(PG8_SA(1, 0), a3, voffA);
            PG8_BAR; ASM_WAIT_L(0); PG8_MMA(1, 0, At, B0); PG8_BAR; SCHED_BARRIER();
            PG8_STAGE(PG8_SB(1, 1), b3 + hstep, voffB);
            ASM_WAIT_V(6); PG8_BAR; PG8_MMA(1, 1, At, B1); PG8_BAR;
        }
        E(acc, cur, wr, wc, fr, fq);
        if (!has_next) break;
#pragma unroll
        for (int a = 0; a < 2; ++a)
#pragma unroll
            for (int b = 0; b < 2; ++b)
#pragma unroll
                for (int m = 0; m < 4; ++m)
#pragma unroll
                    for (int n = 0; n < 2; ++n) acc[a][b][m][n] = (f32x4){0.f, 0.f, 0.f, 0.f};
        cur = nxt; cA = nA; cB = nB; ++ui;
    }
    ASM_WAIT_V(0);
    if (wr == 0) PG8_BAR;
    PG8_BAR;
#undef PG8_SA
#undef PG8_SB
#undef PG8_STAGE
#undef PG8_LDA
#undef PG8_LDB
#undef PG8_MMA
#undef PG8_BAR
}
}

struct Args { const float* in[N_IN]; float* out; unsigned char* ws; int ph_lo, ph_hi; };
constexpr int NWAVES = 8, NTHR = 512;
constexpr int LDS_STAGE = 131072, LDS_MISC = LDS_STAGE, LDS_BYTES = 147456;

constexpr int PT_OUT = N_IN, PT_WS = N_IN + 1, PT_WORD0 = 128;
struct Ctx {
    LAS unsigned char* lds; int tid, lane, wave, G, bid;
    __device__ __forceinline__ unsigned long long ptr(int i) const { const volatile LAS unsigned* t = (const volatile LAS unsigned*)(lds + LDS_MISC) + PT_WORD0 + 2 * i;
        const unsigned lo = (unsigned)READFIRSTLANE((int)t[0]), hi = (unsigned)READFIRSTLANE((int)t[1]); return ((unsigned long long)hi << 32) | lo; }
    __device__ __forceinline__ unsigned long long ptrv(int i) const { const volatile LAS unsigned* t = (const volatile LAS unsigned*)(lds + LDS_MISC) + PT_WORD0 + 2 * i; return ((unsigned long long)t[1] << 32) | t[0]; }
    __device__ __forceinline__ const float* inv(int i) const { return (const float*)ptrv(i); }
    template <class T> __device__ __forceinline__ T* wsv(size_t off) const { return (T*)((unsigned char*)ptrv(PT_WS) + off); }
    __device__ __forceinline__ const float* in(int i) const { return (const float*)ptr(i); }
    __device__ __forceinline__ float* out() const { return (float*)ptr(PT_OUT); }
    template <class T> __device__ __forceinline__ T* ws(size_t off) const { return (T*)((unsigned char*)ptr(PT_WS) + off); }
    __device__ __forceinline__ unsigned* ctl() const { return (unsigned*)ptr(PT_WS); }
};

__device__ __forceinline__ void transpose_item(const float* W, int ldw, int k0, int n0, int nvalid, bf16* outp, int ldo, LAS float* scr, int lane) {
#pragma unroll
    for (int i = 0; i < 32; ++i) { const int kk = 2 * i + (lane >> 5), n = n0 + (lane & 31); scr[kk * 33 + (lane & 31)] = (n < nvalid) ? W[(size_t)(k0 + kk) * ldw + n] : 0.f; }
    WAVE_LDS_FENCE(); CFENCE();
    const int c = lane & 7;
#pragma unroll
    for (int j = 0; j < 4; ++j) { const int n = (lane >> 3) + 8 * j; const LAS float* s = scr + (8 * c) * 33 + n;
        u32x4 o; o[0] = pk2(s[0 * 33], s[1 * 33]); o[1] = pk2(s[2 * 33], s[3 * 33]); o[2] = pk2(s[4 * 33], s[5 * 33]); o[3] = pk2(s[6 * 33], s[7 * 33]);
        *(u32x4*)(outp + (size_t)n * ldo + k0 + 8 * c) = o; }
    WAVE_LDS_FENCE(); CFENCE();
}
__device__ __forceinline__ void filter_item(const Ctx& X, int l, int n, int pos0, float* out  , LAS float* scr  , LAS float* asum  ) {
    const int lane = X.lane;
    LAS float* zs = scr; LAS float* ha = scr + 8 * 33; LAS float* hb = ha + 8 * 64;
    const float* w1 = X.in(I_FW1) + (size_t)l * 33 * 64; const float* b1 = X.in(I_FB1) + l * 64;
    const float* w2 = X.in(I_FW2) + (size_t)l * 64 * 64; const float* b2 = X.in(I_FB2) + l * 64;
    const float* w3 = X.in(I_FW3) + (size_t)l * 64 * 64; const float* b3 = X.in(I_FB3) + l * 64;
    const float* wo = X.in(I_FWO) + (size_t)l * 64 * HW; const float fr = X.in(I_FREQ)[l * 64 + lane];
    if (lane < 33) {
#pragma unroll
        for (int p = 0; p < 8; ++p) { const int pos = pos0 + p; float v;
            if (lane == 0) v = (float)pos / (float)(n - 1 > 1 ? n - 1 : 1);
            else { const int b = (lane - 1) & 15; const double band = 1e-4 + (double)b * ((15.0 - 1e-4) / 15.0);
                double rev = (double)pos * band / (double)n; rev -= floor(rev); if (rev > 0.5) rev -= 1.0;
                float s, c; sincos_f((float)(rev * 6.283185307179586476925), s, c); v = lane <= 16 ? c : -s; }
            zs[p * 33 + lane] = v; }
    }
    WAVE_LDS_FENCE(); CFENCE();
    float acc[8];
    { const float bb = b1[lane];
#pragma unroll
      for (int p = 0; p < 8; ++p) acc[p] = bb;
#pragma unroll 3
      for (int i = 0; i < 33; ++i) { const float w = w1[i * 64 + lane];
#pragma unroll
          for (int p = 0; p < 8; ++p) acc[p] += zs[p * 33 + i] * w; }
#pragma unroll
      for (int p = 0; p < 8; ++p) ha[p * 64 + lane] = sin_f(fr * acc[p]); }
    WAVE_LDS_FENCE(); CFENCE();
    { const float bb = b2[lane];
#pragma unroll
      for (int p = 0; p < 8; ++p) acc[p] = bb;
#pragma unroll 4
      for (int i = 0; i < 64; ++i) { const float w = w2[i * 64 + lane];
#pragma unroll
          for (int p = 0; p < 8; ++p) acc[p] += ha[p * 64 + i] * w; }
#pragma unroll
      for (int p = 0; p < 8; ++p) hb[p * 64 + lane] = sin_f(fr * acc[p]); }
    WAVE_LDS_FENCE(); CFENCE();
    { const float bb = b3[lane];
#pragma unroll
      for (int p = 0; p < 8; ++p) acc[p] = bb;
#pragma unroll 4
      for (int i = 0; i < 64; ++i) { const float w = w3[i * 64 + lane];
#pragma unroll
          for (int p = 0; p < 8; ++p) acc[p] += hb[p * 64 + i] * w; }
#pragma unroll
      for (int p = 0; p < 8; ++p) ha[p * 64 + lane] = sin_f(fr * acc[p]); }
    WAVE_LDS_FENCE(); CFENCE();
    const float dmin = -3.0701134573253944f, dmax = -15.350567286626972f;
#pragma unroll 1
    for (int mI = 0; mI < HW / 64; ++mI) { const int c = lane + 64 * mI;
#pragma unroll
        for (int p = 0; p < 8; ++p) acc[p] = 0.f;
#pragma unroll 4
        for (int i = 0; i < 64; ++i) { const float w = wo[i * HW + c];
#pragma unroll
            for (int p = 0; p < 8; ++p) acc[p] += ha[p * 64 + i] * w; }
        const float delta = fabsf(dmin + (float)c * ((dmax - dmin) / (float)(HW - 1)));
        float as = 0.f;
#pragma unroll
        for (int p = 0; p < 8; ++p) { const int pos = pos0 + p; const int dd = pos - n / 2; const float dist = (float)(dd < 0 ? -dd : dd) * (2.0f / (float)n);
            const float v = acc[p] * expf(-dist * delta); out[(size_t)c * n + pos] = v; as += fabsf(v); }
        asum[c] += as; }
    WAVE_LDS_FENCE(); CFENCE();
}
__device__ __forceinline__ void phase_transposes(const Ctx& X, int l, int part) {
    LAS float* scr = (LAS float*)(X.lds + X.wave * 16384);
    const bool shifted = part == 1 && X.G > N_SEQ_UNITS; const int myb = shifted ? X.bid - N_SEQ_UNITS : X.bid, nb_ = shifted ? X.G - N_SEQ_UNITS : X.G;
    if (myb < 0) return;
    const int gw = myb * NWAVES + X.wave, NGW = nb_ * NWAVES, lane = X.lane;
    constexpr int KB_D = D / 64, I_WIN_ = KB_D * (PCP / 32), I_WB_ = 2 * (RW / 64) * (D / 32), I_WO_ = KB_D * (D / 32), I_WGU_ = NE * 2 * KB_D * (D / 32), I_WD_ = NE * KB_D * (D / 32);
    constexpr int I_LORA_ = 6 * (RW / 32); constexpr int N0 = I_WIN_ + I_WB_ + I_WO_, NITEMS = N0 + I_WGU_ + I_WD_;
    if (part == 0) for (int it = gw; it < I_LORA_; it += NGW) { const int which = it / (RW / 32), nb = it % (RW / 32);
        const float* W; int k0 = 0, ldo = 64; bf16* outp;
        if (which < 2) { W = X.in(I_W2) + ((size_t)l * 2 + which) * 64 * RW; outp = X.ws<bf16>(WS_W2T) + (size_t)which * RW * 64 + (size_t)(32 * nb) * 64; }
        else if (which < 4) { W = X.in(I_A2) + ((size_t)l * 2 + (which - 2)) * 64 * RW; outp = X.ws<bf16>(WS_A2T) + (size_t)(which - 2) * RW * 64 + (size_t)(32 * nb) * 64; }
        else { W = X.in(I_G2) + (size_t)l * 128 * RW; k0 = 64 * (which - 4); ldo = 128; outp = X.ws<bf16>(WS_G2T) + (size_t)(32 * nb) * 128; }
        transpose_item(W, RW, k0, 32 * nb, RW, outp, ldo, scr, lane); }
    for (int it = (part ? N0 : 0) + gw; it < (part ? NITEMS : N0); it += NGW) {
        int r = it; const float* W; int ldw, k0, n0, nvalid, ldo; bf16* outp;
        if (r < I_WIN_) { const int nb = r % (PCP / 32), kb = r / (PCP / 32); W = X.in(I_WIN) + (size_t)l * D * PC; ldw = PC; k0 = 64 * kb; n0 = 32 * nb; nvalid = PC; outp = X.ws<bf16>(WS_WIN) + (size_t)n0 * D; ldo = D; }
        else if ((r -= I_WIN_) < I_WB_) { const int s = r / ((RW / 64) * (D / 32)), q = r % ((RW / 64) * (D / 32)), nb = q % (D / 32), kb = q / (D / 32);
            W = X.in(I_WBR) + ((size_t)l * 2 + s) * RW * D; ldw = D; k0 = 64 * kb; n0 = 32 * nb; nvalid = D; outp = X.ws<bf16>(WS_WB) + (size_t)s * D * RW + (size_t)n0 * RW; ldo = RW; }
        else if ((r -= I_WB_) < I_WO_) { const int nb = r % (D / 32), kb = r / (D / 32); W = X.in(I_WOUT) + (size_t)l * D * D; ldw = D; k0 = 64 * kb; n0 = 32 * nb; nvalid = D; outp = X.ws<bf16>(WS_WO) + (size_t)n0 * D; ldo = D; }
        else if ((r -= I_WO_) < I_WGU_) { const int per = KB_D * (D / 32), es = r / per, q = r % per, e = es >> 1, src = es & 1, nb = q % (D / 32), kb = q / (D / 32); n0 = 32 * nb;
            W = (src ? X.in(I_WU) : X.in(I_WG)) + ((size_t)l * NE + e) * D * D; ldw = D; k0 = 64 * kb; nvalid = D; const int orow = e * 2 * D + (n0 / 128) * 256 + src * 128 + (n0 % 128);
            outp = X.ws<bf16>(WS_WGU) + (size_t)orow * D; ldo = D; }
        else { r -= I_WGU_; const int per = KB_D * (D / 32), e = r / per, q = r % per, nb = q % (D / 32), kb = q / (D / 32);
            W = X.in(I_WD) + ((size_t)l * NE + e) * D * D; ldw = D; k0 = 64 * kb; n0 = 32 * nb; nvalid = D; outp = X.ws<bf16>(WS_WD) + (size_t)(e * D + n0) * D; ldo = D; }
        transpose_item(W, ldw, k0, n0, nvalid, outp, ldo, scr, lane);
    }
}
__device__ __forceinline__ void phase_filters(const Ctx& X, int l) {
    LAS float* scr = (LAS float*)(X.lds + X.wave * 8192);
    const int gw = X.bid * NWAVES + X.wave, NGW = X.G * NWAVES, lane = X.lane;
    LAS float* part = (LAS float*)(X.lds + 65536);
    static_assert(65536 + NWAVES * 2 * HW * 4 <= LDS_STAGE, "filter LDS map");
    for (int i = lane; i < 2 * HW; i += 64) part[X.wave * 2 * HW + i] = 0.f;
    WAVE_LDS_FENCE(); CFENCE();
    float* filt = X.ws<float>(WS_FILT);
    for (int it = gw; it < SEQ / 8; it += NGW) filter_item(X, l, SEQ, 8 * it, filt, scr, part + (X.wave * 2 + 0) * HW);
    for (int it = gw; it < CTX / 8; it += NGW) filter_item(X, l, CTX, 8 * it, filt + (size_t)HW * SEQ, scr, part + (X.wave * 2 + 1) * HW);
    __syncthreads();
    for (int i = X.tid; i < 2 * HW; i += NTHR) { float s = 0.f;
#pragma unroll
        for (int w = 0; w < NWAVES; ++w) s += part[w * 2 * HW + i];
        X.ws<float>(WS_FPART)[((size_t)(i / HW) * NPART + X.bid) * HW + (i % HW)] = s; }
    __syncthreads();
}
__device__ __forceinline__ void phase_mod(const Ctx& X) {
    const int lane = X.lane;
    LAS float* red = (LAS float*)X.lds;
    constexpr int NIT = DEPTH * (6 * D / 64);
    for (int it = X.bid; it < NIT; it += X.G) {
        const int ll = it / (6 * D / 64), n0 = (it % (6 * D / 64)) * 64;
        const float* W = X.in(I_WMOD) + (size_t)ll * D * 6 * D; const float* cv = X.in(I_C); const float* cc = X.in(I_CCTX);
        float s0 = 0.f, s1 = 0.f;
#pragma unroll 8
        for (int k = X.wave * (D / 8); k < (X.wave + 1) * (D / 8); ++k) { const float wv = W[(size_t)k * 6 * D + n0 + lane]; const float c0 = cv[k], c1 = cc[k];
            s0 += c0 * sigmoidf_(c0) * wv; s1 += c1 * sigmoidf_(c1) * wv; }
        red[(X.wave * 64 + lane) * 2] = s0; red[(X.wave * 64 + lane) * 2 + 1] = s1;
        __syncthreads();
        if (X.wave == 0) { float t0 = 0.f, t1 = 0.f;
#pragma unroll
            for (int w = 0; w < NWAVES; ++w) { t0 += red[(w * 64 + lane) * 2]; t1 += red[(w * 64 + lane) * 2 + 1]; }
            const float bm = X.in(I_BMOD)[(size_t)ll * 6 * D + n0 + lane];
            float* MOD = X.ws<float>(WS_MOD);
            MOD[((size_t)ll * 2 + 0) * 6 * D + n0 + lane] = t0 + bm; MOD[((size_t)ll * 2 + 1) * 6 * D + n0 + lane] = t1 + bm; }
        __syncthreads();
    }
}
__device__ __forceinline__ const float* modp(const Ctx& X, int l, int t, int j) { return X.ws<float>(WS_MOD) + ((size_t)l * 2 + (t < CTX ? 1 : 0)) * 6 * D + (size_t)j * D; }

__device__ __forceinline__ void phase_x0(const Ctx& X) {
    const int gw = X.bid * NWAVES + X.wave, NGW = X.G * NWAVES, lane = X.lane;
    for (int t = gw; t < M; t += NGW) {
        const float* src = t < CTX ? X.in(I_CTX) + (size_t)t * D : X.in(I_X) + (size_t)(t - CTX) * D;
        const float* sh = modp(X, 0, t, 0); const float* sc = modp(X, 0, t, 1);
        float* xr = X.ws<float>(WS_X) + (size_t)t * D; bf16* xm = X.ws<bf16>(WS_XMOD) + (size_t)t * D;
#pragma unroll
        for (int j = 0; j < D / 256; ++j) { const int d = 4 * lane + 256 * j; const f32x4 v = *(const f32x4*)(src + d), a = *(const f32x4*)(sh + d), b = *(const f32x4*)(sc + d);
            *(f32x4*)(xr + d) = v;
            unsigned w0 = pk2(v[0] * (1.f + b[0]) + a[0], v[1] * (1.f + b[1]) + a[1]), w1 = pk2(v[2] * (1.f + b[2]) + a[2], v[3] * (1.f + b[3]) + a[3]);
            *(unsigned long long*)(xm + d) = (unsigned long long)w0 | ((unsigned long long)w1 << 32); }
    }
}

__device__ __forceinline__ int shift_row(int t, int col, bool& valid) {
    const bool isctx = t < CTX;
    const int i = t - CTX, gx = i & (GRID_W - 1), gy = i / GRID_W, q = col / QTR;
    const int offl = (q == 0) ? -1 : (q == 1) ? 1 : (q == 2) ? -GRID_W : GRID_W;
    const bool vl = (q == 0) ? (gx > 0) : (q == 1) ? (gx < GRID_W - 1) : (q == 2) ? (gy > 0) : (gy < GRID_H - 1);
    const bool first = col < HALFC;
    const int offc = first ? -1 : 1; const bool vc = first ? (t > 0) : (t < CTX - 1);
    valid = isctx ? vc : vl;
    return valid ? t + (isctx ? offc : offl) : t;
}
__device__ __forceinline__ float pm_val(const bf16* P, const float* mu, int t, int col) {
    const float p0 = bf2f(P[(size_t)t * PCP + col]); bool valid; const int nr = shift_row(t, col, valid);
    const float pn = bf2f(P[(size_t)nr * PCP + col]); const float p1 = valid ? pn : 0.f;
    return p0 + (p1 - p0) * mu[col];
}
constexpr int LP = 72;
constexpr int LQ = 65;
constexpr int LX = 68;
__device__ __forceinline__ f32x4 mm_tile(const LAS bf16* A, const LAS bf16* Bt, int ti, int tj, int lane, f32x4 acc) {
    const LAS bf16* pa = A + (16 * ti + (lane & 15)) * LP + 8 * (lane >> 4); const LAS bf16* pb = Bt + (16 * tj + (lane & 15)) * LP + 8 * (lane >> 4);
#pragma unroll
    for (int kk = 0; kk < 2; ++kk) { const bf16x8 a = *(const LAS bf16x8*)(pa + 32 * kk), b = *(const LAS bf16x8*)(pb + 32 * kk); acc = MFMA16(a, b, acc); }
    return acc;
}
constexpr int TT = 8;
__device__ __forceinline__ void phase_lin(const Ctx& X, int l) {
    const bf16* P = X.ws<bf16>(WS_P); const float* mu = X.in(I_MU) + (size_t)l * RC; bf16* LIN = X.ws<bf16>(WS_LIN);
    for (size_t idx = (size_t)X.bid * NTHR + X.tid; idx < (size_t)M * 384; idx += (size_t)X.G * NTHR) { const int t = (int)(idx / 384), j = (int)(idx % 384);
        float v = pm_val(P, mu, t, C_LWF + j);
        if (j < 128) v = tanhf(v); else if (j >= 256) v = sigmoidf_(v);
        LIN[idx] = (bf16)f2bf(v); }
}
__device__ __forceinline__ f32x4 mm_tile_p(const LAS bf16* A, int lda, const LAS bf16* Bt, int ldb, int ks, int ti, int tj, int lane, f32x4 acc) {
    const LAS bf16* pa = A + (16 * ti + (lane & 15)) * lda + 8 * (lane >> 4); const LAS bf16* pb = Bt + (16 * tj + (lane & 15)) * ldb + 8 * (lane >> 4);
    for (int kk = 0; kk < ks; ++kk) { const bf16x8 a = *(const LAS bf16x8*)(pa + 32 * kk), b = *(const LAS bf16x8*)(pb + 32 * kk); acc = MFMA16(a, b, acc); }
    return acc;
}
constexpr int GP = 136;
__device__ __forceinline__ void lora_unit_a(const Ctx& X, int unit) {
    const int b = unit / NH, h = unit % NH, tid = X.tid, lane = X.lane, w = X.wave;
    LAS bf16* Ab = (LAS bf16*)X.lds; LAS bf16* Gb = Ab + 4 * 64 * LP; LAS bf16* Wb = Gb + 64 * GP; LAS bf16* G2b = Wb + 4 * 64 * LP;
    LAS float* OUT = (LAS float*)X.lds;
    static_assert((8 * 64 * LP + 2 * 64 * GP) * 2 <= LDS_STAGE && 5 * 64 * LQ * 4 <= LDS_STAGE, "lora LDS map");
    const bf16* LIN = X.wsv<bf16>(WS_LIN) + (size_t)(64 * b) * 384;
    for (int i = tid; i < 64 * 48; i += NTHR) { const int t = i / 48, c16 = i % 48; const u32x4 v = *(const u32x4*)(LIN + (size_t)t * 384 + 8 * c16);
        if (c16 < 32) *(LAS u32x4*)(Ab + (c16 >> 3) * 64 * LP + t * LP + 8 * (c16 & 7)) = v; else *(LAS u32x4*)(Gb + t * GP + 8 * (c16 - 32)) = v; }
    const bf16* w2t = X.wsv<bf16>(WS_W2T) + (size_t)(64 * h) * 64; const bf16* a2t = X.wsv<bf16>(WS_A2T) + (size_t)(64 * h) * 64; const bf16* g2t = X.wsv<bf16>(WS_G2T) + (size_t)(64 * h) * 128;
    for (int i = tid; i < 4 * 64 * 8; i += NTHR) { const int q = i / 512, c = (i / 8) % 64, c16 = i % 8; const bf16* src = (q < 2 ? w2t + (size_t)q * RW * 64 : a2t + (size_t)(q - 2) * RW * 64) + c * 64 + 8 * c16;
        *(LAS u32x4*)(Wb + q * 64 * LP + c * LP + 8 * c16) = *(const u32x4*)src; }
    for (int i = tid; i < 64 * 16; i += NTHR) { const int c = i / 16, c16 = i % 16; *(LAS u32x4*)(G2b + c * GP + 8 * c16) = *(const u32x4*)(g2t + c * 128 + 8 * c16); }
    __syncthreads();
    f32x4 o[2][5];
#pragma unroll
    for (int q = 0; q < 2; ++q) { const int tile = 2 * w + q, ti = tile >> 2, tj = tile & 3; const f32x4 z4 = {0.f, 0.f, 0.f, 0.f};
#pragma unroll
        for (int p = 0; p < 4; ++p) o[q][p] = mm_tile(Ab + p * 64 * LP, Wb + p * 64 * LP, ti, tj, lane, z4);
        o[q][4] = mm_tile_p(Gb, GP, G2b, GP, 4, ti, tj, lane, z4); }
    __syncthreads();
#pragma unroll
    for (int q = 0; q < 2; ++q) { const int tile = 2 * w + q, ti = tile >> 2, tj = tile & 3, col = 16 * tj + (lane & 15);
#pragma unroll
        for (int p = 0; p < 5; ++p)
#pragma unroll
            for (int r = 0; r < 4; ++r) OUT[(p * 64 + 16 * ti + 4 * (lane >> 4) + r) * LQ + col] = o[q][p][r]; }
    __syncthreads();
}
__device__ __forceinline__ void lora_unit_b(const Ctx& X, int l, int unit) {
    const int b = unit / NH, h = unit % NH, w = X.wave, k = X.lane, c = 64 * h + k;
    const LAS float* OUT = (const LAS float*)X.lds;
    const bf16* P = X.wsv<bf16>(WS_P); const float* mu = X.inv(I_MU) + (size_t)l * RC;
    const float w00 = X.inv(I_W0)[(size_t)(l * 2 + 0) * RW + c], w01 = X.inv(I_W0)[(size_t)(l * 2 + 1) * RW + c];
    const float a00 = X.inv(I_A0)[(size_t)(l * 2 + 0) * RW + c], a01 = X.inv(I_A0)[(size_t)(l * 2 + 1) * RW + c];
    const float kkc = X.inv(I_KK)[(size_t)l * RW + c], kac = X.inv(I_KA)[(size_t)l * RW + c], rkc = X.inv(I_RK)[(size_t)l * RW + c];
    bf16* pR = X.wsv<bf16>(WS_R); bf16* pV = X.wsv<bf16>(WS_V); bf16* pKA = X.wsv<bf16>(WS_KA); bf16* pKD = X.wsv<bf16>(WS_KD); bf16* pKB = X.wsv<bf16>(WS_KB); float* pW = X.wsv<float>(WS_W); bf16* pG = X.wsv<bf16>(WS_GATE); float* pBo = X.wsv<float>(WS_BONUS);
    const int vz = vgpr_zero();
#pragma unroll 2
    for (int i = 0; i < 8; ++i) { const int tl = 8 * w + i, t = 64 * b + tl + vz;
        const float r = pm_val(P, mu, t, c), kx = pm_val(P, mu, t, C_K + c), v = pm_val(P, mu, t, C_V + c);
        const float wd0 = -DECAY_SCALE * sigmoidf_(w00 + OUT[(0 * 64 + tl) * LQ + k]), wd1 = -DECAY_SCALE * sigmoidf_(w01 + OUT[(1 * 64 + tl) * LQ + k]);
        const float ad0 = sigmoidf_(a00 + OUT[(2 * 64 + tl) * LQ + k]), ad1 = sigmoidf_(a01 + OUT[(3 * 64 + tl) * LQ + k]);
        const float kkr = kx * kkc; const float n2 = wave_sum(kkr * kkr); const float kk = kkr / fmaxf(sqrtf(n2), 1e-12f);
        const float kd0 = kx * (1.f + (ad0 - 1.f) * kac), kd1 = kx * (1.f + (ad1 - 1.f) * kac);
        const float bon = wave_sum(r * (kd0 + kd1) * rkc);
        const size_t o = (size_t)t * RW + c, o1 = (size_t)(M + t) * RW + c;
        pR[o] = (bf16)f2bf(r); pV[o] = (bf16)f2bf(v); pKA[o] = (bf16)f2bf(-kk);
        pKD[o] = (bf16)f2bf(kd0); pKD[o1] = (bf16)f2bf(kd1); pKB[o] = (bf16)f2bf(kk * ad0); pKB[o1] = (bf16)f2bf(kk * ad1);
        pW[o] = wd0; pW[o1] = wd1; pG[o] = (bf16)f2bf(OUT[(4 * 64 + tl) * LQ + k]);
        if (k == 0) pBo[(size_t)t * NH + h] = bon; }
    __syncthreads();
}
__device__ __forceinline__ void phase_prep_hyena(const Ctx& X, int l) {
    const bf16* P = X.ws<bf16>(WS_P); const int c = X.tid;
    if (c < HW) {
        const float* cw = X.in(I_CW) + (size_t)l * 3 * HC; const float* cb = X.in(I_CB) + (size_t)l * HC;
        float cw0[3], cw1[3], cw2[3], cbv[3];
#pragma unroll
        for (int j = 0; j < 3; ++j) { const int hc = j * HW + c; cw0[j] = cw[hc]; cw1[j] = cw[HC + hc]; cw2[j] = cw[2 * HC + hc]; cbv[j] = cb[hc]; }
        float* ZT = X.ws<float>(WS_ZT) + (size_t)c * M; float* Zc = X.ws<float>(WS_Z); bf16* X0 = X.ws<bf16>(WS_X0);
        for (int tile = X.bid; tile < M / TT; tile += X.G) { const int t0 = tile * TT; float zz[TT];
#pragma unroll
            for (int tt = 0; tt < TT; ++tt) { const int t = t0 + tt; const bool hp = (t != 0 && t != CTX), hn = (t != CTX - 1 && t != M - 1);
                float u[3];
#pragma unroll
                for (int j = 0; j < 3; ++j) { const int col = C_HY + j * HW + c;
                    const float pc = bf2f(P[(size_t)t * PCP + col]), pp = hp ? bf2f(P[(size_t)(t - 1) * PCP + col]) : 0.f, pn = hn ? bf2f(P[(size_t)(t + 1) * PCP + col]) : 0.f;
                    u[j] = pp * cw0[j] + pc * cw1[j] + pn * cw2[j] + cbv[j]; }
                zz[tt] = u[2] * u[1]; if (t < CTX) Zc[(size_t)t * HW + c] = zz[tt];
                X0[(size_t)t * HW + c] = (bf16)f2bf(u[0]); }
            *(f32x4*)(ZT + t0) = (f32x4){zz[0], zz[1], zz[2], zz[3]}; *(f32x4*)(ZT + t0 + 4) = (f32x4){zz[4], zz[5], zz[6], zz[7]}; }
    }
}

constexpr int CC = 64, NCHK = M / CC;
static_assert(CTX % CC == 0 && SEQ % CC == 0, "chunks must not straddle the context/latent boundary");
__device__ __forceinline__ int scan_row(int d, int s) { return d == 0 ? s : (s < CTX ? CTX - 1 - s : M - 1 - (s - CTX)); }
__device__ __forceinline__ void chunk_unit_1(const Ctx& X, int unit) {
    const int d = unit / (NCHK * NH), c = (unit / NH) % NCHK, h = unit % NH;
    LAS bf16* An = (LAS bf16*)X.lds;            LAS bf16* Bn = An + 64 * LP; LAS bf16* Kn = Bn + 64 * LP; LAS bf16* Rn = Kn + 64 * LP; LAS bf16* Vt = Rn + 64 * LP;
    LAS bf16* Bh = Vt + 64 * LP;                LAS bf16* Kh = Bh + 64 * LP; LAS bf16* Lak = Kh + 64 * LP; LAS bf16* Mrb = Lak + 64 * LP; LAS bf16* Mrk = Mrb + 64 * LP;
    LAS float* Lab = (LAS float*)(Mrk + 64 * LP); LAS float* XsW = Lab + 64 * LX;
    LAS float* XsU = (LAS float*)An;
    LAS bf16* Wt = Lak; LAS bf16* Ut = (LAS bf16*)((LAS unsigned char*)An + 64 * LX * 4);
    LAS float* tot = Lab;
    LAS float* dC = (LAS float*)(X.lds + LDS_MISC + 1024);
    static_assert(10 * 64 * LP * 2 + 2 * 64 * LX * 4 <= LDS_STAGE && 64 * LX * 4 + 64 * LP * 2 <= 3 * 64 * LP * 2, "chunk LDS map");
    const int tid = X.tid, lane = X.lane, w = X.wave, k = tid & 63;
    float lw[8], cum[8];
    { float run = 0.f; const float* pW = X.wsv<float>(WS_W);
#pragma unroll
      for (int i = 0; i < 8; ++i) { const int row = scan_row(d, c * CC + 8 * w + i); lw[i] = pW[((size_t)d * M + row) * RW + h * 64 + k]; }
#pragma unroll
      for (int i = 0; i < 8; ++i) { run += lw[i]; cum[i] = run; }
      tot[w * 64 + k] = run; }
    __syncthreads();
    float off = 0.f, cumC = 0.f;
#pragma unroll
    for (int ww = 0; ww < 8; ++ww) { const float t = tot[ww * 64 + k]; off += (ww < w) ? t : 0.f; cumC += t; }
    __syncthreads();
    { unsigned pv[4], pbh[4], pkh[4]; float af[8];
      const bf16* pR = X.wsv<bf16>(WS_R); const bf16* pV = X.wsv<bf16>(WS_V); const bf16* pKA = X.wsv<bf16>(WS_KA); const bf16* pKD = X.wsv<bf16>(WS_KD); const bf16* pKB = X.wsv<bf16>(WS_KB);
#pragma unroll
      for (int i = 0; i < 8; ++i) { const int t = 8 * w + i; const int row = scan_row(d, c * CC + t); const size_t o = (size_t)row * RW + h * 64 + k, od = ((size_t)d * M + row) * RW + h * 64 + k;
          const float ct = off + cum[i], cp = ct - lw[i];
          const float r = bf2f(pR[o]), v = bf2f(pV[o]), ka = bf2f(pKA[o]), kd = bf2f(pKD[od]), kb = bf2f(pKB[od]);
          const float ei = expf(-ct), eh = expf(cumC - ct);
          const float at = ka * expf(cp); af[i] = at;
          An[t * LP + k] = (bf16)f2bf(at); Bn[t * LP + k] = (bf16)f2bf(kb * ei); Kn[t * LP + k] = (bf16)f2bf(kd * ei); Rn[t * LP + k] = (bf16)f2bf(r * expf(ct));
          const unsigned bv = f2bf(v), bb = f2bf(kb * eh), bk = f2bf(kd * eh);
          if (i & 1) { pv[i >> 1] |= bv << 16; pbh[i >> 1] |= bb << 16; pkh[i >> 1] |= bk << 16; } else { pv[i >> 1] = bv; pbh[i >> 1] = bb; pkh[i >> 1] = bk; } }
      *(LAS u32x4*)(Vt + k * LP + 8 * w) = (u32x4){pv[0], pv[1], pv[2], pv[3]}; *(LAS u32x4*)(Bh + k * LP + 8 * w) = (u32x4){pbh[0], pbh[1], pbh[2], pbh[3]}; *(LAS u32x4*)(Kh + k * LP + 8 * w) = (u32x4){pkh[0], pkh[1], pkh[2], pkh[3]};
      *(LAS f32x4*)(XsW + k * LX + 8 * w) = (f32x4){af[0], af[1], af[2], af[3]}; *(LAS f32x4*)(XsW + k * LX + 8 * w + 4) = (f32x4){af[4], af[5], af[6], af[7]}; }
    if (tid < 64) dC[tid] = expf(cumC);
    __syncthreads();
#pragma unroll 1
    for (int q = 0; q < 2; ++q) { const int tile = 2 * w + q, ti = tile >> 2, tj = tile & 3; const f32x4 z4 = {0.f, 0.f, 0.f, 0.f};
        const f32x4 ab = mm_tile(An, Bn, ti, tj, lane, z4), ak = mm_tile(An, Kn, ti, tj, lane, z4), rb = mm_tile(Rn, Bn, ti, tj, lane, z4), rk = mm_tile(Rn, Kn, ti, tj, lane, z4);
        const int col = 16 * tj + (lane & 15);
#pragma unroll
        for (int r = 0; r < 4; ++r) { const int row = 16 * ti + 4 * (lane >> 4) + r; const bool lo = col < row, le = col <= row;
            Lab[row * LX + col] = lo ? ab[r] : 0.f; Lak[row * LP + col] = (bf16)f2bf(lo ? ak[r] : 0.f); Mrb[row * LP + col] = (bf16)f2bf(le ? rb[r] : 0.f); Mrk[row * LP + col] = (bf16)f2bf(le ? rk[r] : 0.f); } }
    __syncthreads();
}
__device__ __forceinline__ void chunk_unit_2(const Ctx& X, int unit) {
    const int d = unit / (NCHK * NH), c = (unit / NH) % NCHK, h = unit % NH;
    LAS bf16* An = (LAS bf16*)X.lds;            LAS bf16* Bn = An + 64 * LP; LAS bf16* Kn = Bn + 64 * LP; LAS bf16* Rn = Kn + 64 * LP; LAS bf16* Vt = Rn + 64 * LP;
    LAS bf16* Bh = Vt + 64 * LP;                LAS bf16* Kh = Bh + 64 * LP; LAS bf16* Lak = Kh + 64 * LP; LAS bf16* Mrb = Lak + 64 * LP; LAS bf16* Mrk = Mrb + 64 * LP;
    LAS float* Lab = (LAS float*)(Mrk + 64 * LP); LAS float* XsW = Lab + 64 * LX;
    LAS float* XsU = (LAS float*)An;
    LAS bf16* Wt = Lak; LAS bf16* Ut = (LAS bf16*)((LAS unsigned char*)An + 64 * LX * 4);
    LAS float* tot = Lab;
    LAS float* dC = (LAS float*)(X.lds + LDS_MISC + 1024);
    static_assert(10 * 64 * LP * 2 + 2 * 64 * LX * 4 <= LDS_STAGE && 64 * LX * 4 + 64 * LP * 2 <= 3 * 64 * LP * 2, "chunk LDS map");
    const int tid = X.tid, lane = X.lane, w = X.wave, k = tid & 63;
    f32x4 r2[2]; int r2col[2], r2row[2];
#pragma unroll
    for (int q = 0; q < 2; ++q) { const int tile = 2 * w + q, ti = tile >> 2, tj = tile & 3; const f32x4 z4 = {0.f, 0.f, 0.f, 0.f};
        const f32x4 a = mm_tile(Lak, Vt, ti, tj, lane, z4); const int col = 16 * tj + (lane & 15);
        r2[q] = a; r2col[q] = col; r2row[q] = 16 * ti + 4 * (lane >> 4); }
    __syncthreads();
#pragma unroll
    for (int q = 0; q < 2; ++q) *(LAS f32x4*)(XsU + r2col[q] * LX + r2row[q]) = r2[q];
    __syncthreads();
    if (tid < 128) { const int j = tid & 63; const bool isu = tid >= 64; LAS float* xs = (isu ? XsU : XsW) + j * LX; LAS bf16* dst = (isu ? Ut : Wt) + j * LP;
#pragma unroll 1
        for (int p = 0; p < 8; ++p) { const int t0 = 8 * p; f32x4 acc[8];
#pragma unroll
            for (int i = 0; i < 8; ++i) acc[i] = (f32x4){0.f, 0.f, 0.f, 0.f};
#pragma unroll 1
            for (int q = 0; q < 2 * p; ++q) { const f32x4 xq = *(const LAS f32x4*)(xs + 4 * q);
#pragma unroll
                for (int i = 0; i < 8; ++i) acc[i] += *(const LAS f32x4*)(Lab + (t0 + i) * LX + 4 * q) * xq; }
            f32x4 xp[2];
#pragma unroll
            for (int qq = 0; qq < 2; ++qq) xp[qq] = *(const LAS f32x4*)(xs + t0 + 4 * qq);
#pragma unroll
            for (int i = 0; i < 8; ++i) { f32x4 a = acc[i];
#pragma unroll
                for (int qq = 0; qq < (i + 3) / 4; ++qq) a += *(const LAS f32x4*)(Lab + (t0 + i) * LX + t0 + 4 * qq) * xp[qq];
                xp[i >> 2][i & 3] += (a[0] + a[1]) + (a[2] + a[3]); }
#pragma unroll
            for (int qq = 0; qq < 2; ++qq) { *(LAS f32x4*)(xs + t0 + 4 * qq) = xp[qq];
                *(LAS unsigned*)(dst + t0 + 4 * qq) = pk2(xp[qq][0], xp[qq][1]); *(LAS unsigned*)(dst + t0 + 4 * qq + 2) = pk2(xp[qq][2], xp[qq][3]); } } }
    __syncthreads();
}
__device__ __forceinline__ void chunk_unit_3(const Ctx& X, int unit) {
    const int d = unit / (NCHK * NH), c = (unit / NH) % NCHK, h = unit % NH;
    LAS bf16* An = (LAS bf16*)X.lds;            LAS bf16* Bn = An + 64 * LP; LAS bf16* Kn = Bn + 64 * LP; LAS bf16* Rn = Kn + 64 * LP; LAS bf16* Vt = Rn + 64 * LP;
    LAS bf16* Bh = Vt + 64 * LP;                LAS bf16* Kh = Bh + 64 * LP; LAS bf16* Lak = Kh + 64 * LP; LAS bf16* Mrb = Lak + 64 * LP; LAS bf16* Mrk = Mrb + 64 * LP;
    LAS float* Lab = (LAS float*)(Mrk + 64 * LP); LAS float* XsW = Lab + 64 * LX;
    LAS float* XsU = (LAS float*)An;
    LAS bf16* Wt = Lak; LAS bf16* Ut = (LAS bf16*)((LAS unsigned char*)An + 64 * LX * 4);
    LAS float* tot = Lab;
    LAS float* dC = (LAS float*)(X.lds + LDS_MISC + 1024);
    static_assert(10 * 64 * LP * 2 + 2 * 64 * LX * 4 <= LDS_STAGE && 64 * LX * 4 + 64 * LP * 2 <= 3 * 64 * LP * 2, "chunk LDS map");
    const int tid = X.tid, lane = X.lane, w = X.wave, k = tid & 63;
    const float dCk = dC[k];
    const size_t ubase = ((size_t)(d * NH + h) * NCHK + c);
    float* Pg = X.wsv<float>(WS_PQ) + ubase * 2 * 4096; float* Qg = Pg + 4096; bf16* Gg = X.wsv<bf16>(WS_G) + ubase * 4096; float* Yg = X.wsv<float>(WS_YL) + ubase * 4096;
#pragma unroll 1
    for (int q = 0; q < 2; ++q) { const int tile = 2 * w + q, ti = tile >> 2, tj = tile & 3; const f32x4 z4 = {0.f, 0.f, 0.f, 0.f};
        const f32x4 p = mm_tile(Wt, Bh, ti, tj, lane, z4); f32x4 qq = mm_tile(Ut, Bh, ti, tj, lane, z4); qq = mm_tile(Vt, Kh, ti, tj, lane, qq);
        const f32x4 g = mm_tile(Mrb, Wt, ti, tj, lane, z4); f32x4 y = mm_tile(Mrb, Ut, ti, tj, lane, z4); y = mm_tile(Mrk, Vt, ti, tj, lane, y);
        const int col = 16 * tj + (lane & 15); const float dcol = __shfl(dCk, col);
#pragma unroll
        for (int r = 0; r < 4; ++r) { const int row = 16 * ti + 4 * (lane >> 4) + r;
            Pg[row * 64 + col] = p[r] + (row == col ? dcol : 0.f); Qg[row * 64 + col] = qq[r];
            const int orow = d ? 63 - row : row;
            Gg[orow * 64 + col] = (bf16)f2bf(g[r] + bf2f(Rn[row * LP + col])); Yg[orow * 64 + col] = y[r]; } }
    __syncthreads();
}
__device__ __forceinline__ void seq_unit(const Ctx& X, int su) {
    const int d = su / (NH * 4), h = (su / 4) % NH, qv = su & 3;
    LAS float* S = (LAS float*)X.lds;
    LAS float* Pb = S + 16 * LQ;
    LAS float* Qb = Pb + 2 * 4096;
    const int tid = X.tid, v = tid >> 5, k2 = (tid & 31) * 2;
    const float* PQ = X.ws<float>(WS_PQ) + (size_t)(d * NH + h) * NCHK * 2 * 4096; bf16* S0g = X.ws<bf16>(WS_S0) + (size_t)(d * NH + h) * NCHK * 4096;
    f32x4 pp0, pp1; float pq0, pq1;
#define SEQ_LOAD(c_) do { const float* p_ = PQ + (size_t)(c_) * 2 * 4096; pp0 = *(const f32x4*)(p_ + 4 * tid); pp1 = *(const f32x4*)(p_ + 2048 + 4 * tid); \
        pq0 = p_[4096 + (qv * 16) * 64 + tid]; pq1 = p_[4096 + (qv * 16) * 64 + 512 + tid]; } while (0)
#define SEQ_STORE(b_) do { *(LAS f32x4*)(Pb + (b_) * 4096 + 4 * tid) = pp0; *(LAS f32x4*)(Pb + (b_) * 4096 + 2048 + 4 * tid) = pp1; Qb[(b_) * 1024 + tid] = pq0; Qb[(b_) * 1024 + 512 + tid] = pq1; } while (0)
    SEQ_LOAD(0); SEQ_STORE(0);
    for (int i = tid; i < 16 * LQ; i += NTHR) S[i] = 0.f;
    __syncthreads();
    for (int c = 0; c < NCHK; ++c) { const int pb = c & 1;
        if (c + 1 < NCHK) SEQ_LOAD(c + 1);
        const LAS float* P = Pb + pb * 4096; const LAS float* Q = Qb + pb * 1024;
        *(unsigned*)(S0g + (size_t)c * 4096 + (qv * 16 + v) * 64 + k2) = pk2(S[v * LQ + k2], S[v * LQ + k2 + 1]);
        float a0 = Q[v * 64 + k2], a1 = Q[v * 64 + k2 + 1];
#pragma unroll 8
        for (int k1 = 0; k1 < 64; ++k1) { const float sv = S[v * LQ + k1]; a0 += sv * P[k1 * 64 + k2]; a1 += sv * P[k1 * 64 + k2 + 1]; }
        __syncthreads();
        S[v * LQ + k2] = a0; S[v * LQ + k2 + 1] = a1;
        if (c + 1 < NCHK) SEQ_STORE(pb ^ 1);
        __syncthreads();
    }
#undef SEQ_LOAD
#undef SEQ_STORE
}
constexpr int CR = 16;
__device__ __forceinline__ void conv_item(const Ctx& X, int item) {
    constexpr int NCG = HW / 64; constexpr int n = CTX;
    const int cg = item % NCG, ob = item / NCG, i0 = CR * ob, c = cg * 64 + X.lane;
    const float* F = X.ws<float>(WS_FILT) + (size_t)HW * SEQ + (size_t)c * CTX; const float* Z = X.ws<float>(WS_Z) + c;
    const float* fp = X.ws<float>(WS_FPART) + (size_t)NPART * HW + c;
    float nsum = 0.f; for (int b = 0; b < NPART; ++b) nsum += fp[(size_t)b * HW];
    float acc[CR], Q[CR];
#pragma unroll
    for (int r = 0; r < CR; ++r) acc[r] = 0.f;
    int jb = i0 - n / 2; if (jb < 0) jb = 0;
    int jend = i0 + n / 2 + CR; if (jend > n) jend = n;
    int Tb = i0 - jb + n / 2;
#pragma unroll
    for (int x = 1; x < CR; ++x) { const int T = Tb + x; Q[x] = (T >= 0 && T < n) ? F[T] : 0.f; }
    Q[0] = 0.f;
    for (; jb < jend; jb += CR, Tb -= CR) {
#pragma unroll
        for (int s = 0; s < CR; ++s) { const int T = Tb - s, j = jb + s;
            if ((s & 3) == 0) CFENCE();
            Q[(CR - s) & (CR - 1)] = (T >= 0 && T < n) ? F[T] : 0.f;
            const float zj = (j < n) ? Z[(size_t)j * HW] : 0.f;
#pragma unroll
            for (int r = 0; r < CR; ++r) acc[r] += Q[(r - s + CR) & (CR - 1)] * zj; }
    }
    const float inv = 1.0f / nsum; float* O = X.ws<float>(WS_CONV) + c;
#pragma unroll
    for (int r = 0; r < CR; ++r) O[(size_t)(i0 + r) * HW] = acc[r] * inv;
}

#ifdef EMU
struct cf { float x, y; };
#else
typedef float cf __attribute__((ext_vector_type(2)));
#endif
__device__ __forceinline__ cf cmul(cf a, cf b) { return cf{a.x * b.x - a.y * b.y, a.x * b.y + a.y * b.x}; }
__device__ __forceinline__ cf cadd(cf a, cf b) { return cf{a.x + b.x, a.y + b.y}; }
__device__ __forceinline__ cf csub(cf a, cf b) { return cf{a.x - b.x, a.y - b.y}; }
__device__ __forceinline__ cf cconj(cf a) { return cf{a.x, -a.y}; }
constexpr int FN = SEQ;
constexpr int flog4(int n) { return n <= 1 ? 0 : 1 + flog4(n / 4); }
constexpr int FLOG4 = flog4(FN), FSQ = 1 << FLOG4;
static_assert((1 << (2 * FLOG4)) == FN && FN * 8 <= LDS_STAGE, "FFT length must be a power of 4 that fits the LDS stage region");
constexpr int FFT_TAB_OFF = LDS_MISC + 2048;
static_assert(FFT_TAB_OFF + 2 * FSQ * 8 <= LDS_BYTES, "FFT twiddle tables");
__device__ __forceinline__ void fft_tables(const Ctx& X) {
    LAS cf* T = (LAS cf*)(X.lds + FFT_TAB_OFF);
    for (int i = X.tid; i < 2 * FSQ; i += NTHR) { const int k = i < FSQ ? i * FSQ : i - FSQ; float s, c; sincos_f(-6.283185307179586f * (float)k / (float)FN, s, c); T[i] = cf{c, s}; }
    __syncthreads();
}
__device__ __forceinline__ cf fft_tw(const LAS cf* T, int k) { const cf a = T[k >> FLOG4], b = T[FSQ + (k & (FSQ - 1))]; return cmul(a, b); }
__device__ __forceinline__ int rev4(int k) { int r = 0;
#pragma unroll
    for (int s = 0; s < FLOG4; ++s) { r = (r << 2) | (k & 3); k >>= 2; }
    return r; }
__device__ __forceinline__ void fft_fwd(LAS cf* x, const LAS cf* T, int tid) {
#pragma unroll 1
    for (int s = 0; s < FLOG4; ++s) { const int q = FN >> (2 * s + 2), tw = 1 << (2 * s);
        for (int u = tid; u < FN / 4; u += NTHR) { const int j = u & (q - 1), p = (u - j) * 4 + j;
            const cf a0 = x[p], a1 = x[p + q], a2 = x[p + 2 * q], a3 = x[p + 3 * q];
            const cf t0 = cadd(a0, a2), t1 = csub(a0, a2), t2 = cadd(a1, a3), d = csub(a1, a3), t3 = cf{d.y, -d.x};
            const cf w1 = fft_tw(T, j * tw), w2 = cmul(w1, w1), w3 = cmul(w2, w1);
            x[p] = cadd(t0, t2); x[p + q] = cmul(cadd(t1, t3), w1); x[p + 2 * q] = cmul(csub(t0, t2), w2); x[p + 3 * q] = cmul(csub(t1, t3), w3); }
        __syncthreads(); }
}
__device__ __forceinline__ void fft_inv(LAS cf* x, const LAS cf* T, int tid) {
#pragma unroll 1
    for (int s = FLOG4 - 1; s >= 0; --s) { const int q = FN >> (2 * s + 2), tw = 1 << (2 * s);
        for (int u = tid; u < FN / 4; u += NTHR) { const int j = u & (q - 1), p = (u - j) * 4 + j;
            const cf w1 = cconj(fft_tw(T, j * tw)), w2 = cmul(w1, w1), w3 = cmul(w2, w1);
            const cf a0 = x[p], a1 = cmul(x[p + q], w1), a2 = cmul(x[p + 2 * q], w2), a3 = cmul(x[p + 3 * q], w3);
            const cf t0 = cadd(a0, a2), t1 = csub(a0, a2), t2 = cadd(a1, a3), d = csub(a1, a3), t3 = cf{-d.y, d.x};
            x[p] = cadd(t0, t2); x[p + q] = cadd(t1, t3); x[p + 2 * q] = csub(t0, t2); x[p + 3 * q] = csub(t1, t3); }
        __syncthreads(); }
}
__device__ __forceinline__ void fft_load_real(LAS cf* x, const float* src, float scale, int tid) {
    for (int m = tid; m < FN; m += NTHR) { cf v{0.f, 0.f}; if (m < FN / 2) { v.x = src[2 * m] * scale; v.y = src[2 * m + 1] * scale; } x[m] = v; }
    __syncthreads();
}
__device__ __forceinline__ void phase_spectra(const Ctx& X, int l) {
    (void)l;
    LAS cf* x = (LAS cf*)X.lds; const LAS cf* T = (const LAS cf*)(X.lds + FFT_TAB_OFF); volatile LAS float* red = (volatile LAS float*)(X.lds + LDS_MISC) + 120;
    fft_tables(X);
    for (int c = X.bid; c < HW; c += X.G) {
        if (X.wave == 0) { const float* fp = X.ws<float>(WS_FPART) + c; float s = 0.f; for (int b = X.lane; b < NPART; b += 64) s += fp[(size_t)b * HW]; s = wave_sum(s); if (X.lane == 0) red[0] = s; }
        __syncthreads();
        const float inv = 1.0f / red[0];
        fft_load_real(x, X.ws<float>(WS_FILT) + (size_t)c * SEQ, inv, X.tid);
        fft_fwd(x, T, X.tid);
        cf* HS = X.ws<cf>(WS_HS) + (size_t)c * (FN + 1);
        for (int k = X.tid; k <= FN / 2; k += NTHR) {
            const cf A = x[rev4(k)], B = x[rev4((FN - k) & (FN - 1))];
            if (k == 0) { HS[0] = cf{A.x + A.y, 0.f}; HS[FN] = cf{A.x - A.y, 0.f}; }
            else if (k == FN / 2) { HS[k] = cconj(A); }
            else { float sn, cs; sincos_f(-3.14159265358979f * (float)k / (float)FN, sn, cs); const cf w{cs, sn};
                const cf s1 = cadd(A, cconj(B)), d1 = csub(A, cconj(B)), wd = cmul(w, d1);
                HS[k] = cf{0.5f * (s1.x + wd.y), 0.5f * (s1.y - wd.x)};
                const cf s2 = cadd(B, cconj(A)), d2 = csub(B, cconj(A)), wd2 = cmul(cconj(w), d2);
                HS[FN - k] = cf{0.5f * (s2.x - wd2.y), 0.5f * (s2.y + wd2.x)}; } }
        __syncthreads();
    }
}
__device__ __forceinline__ void fftconv_item(const Ctx& X, int l, int c) {
    LAS cf* x = (LAS cf*)X.lds; const LAS cf* T = (const LAS cf*)(X.lds + FFT_TAB_OFF);
    const float* z = X.ws<float>(WS_ZT) + (size_t)c * M + CTX;
    fft_load_real(x, z, 1.0f, X.tid);
    fft_fwd(x, T, X.tid);
    const cf* HS = X.ws<cf>(WS_HS) + (size_t)c * (FN + 1);
    for (int k = X.tid; k <= FN / 2; k += NTHR) {
        const int pa = rev4(k), pb = rev4((FN - k) & (FN - 1)); const cf A = x[pa], B = x[pb];
        if (k == 0) { const float y0 = (A.x + A.y) * HS[0].x, yn = (A.x - A.y) * HS[FN].x; x[pa] = cf{0.5f * (y0 + yn), 0.5f * (y0 - yn)}; }
        else if (k == FN / 2) { x[pa] = cconj(cmul(cconj(A), HS[k])); }
        else { float sn, cs; sincos_f(-3.14159265358979f * (float)k / (float)FN, sn, cs); const cf w{cs, sn};
            const cf s1 = cadd(A, cconj(B)), d1 = csub(A, cconj(B)), wd = cmul(w, d1); const cf Xk{0.5f * (s1.x + wd.y), 0.5f * (s1.y - wd.x)};
            const cf s2 = cadd(B, cconj(A)), d2 = csub(B, cconj(A)), wd2 = cmul(cconj(w), d2); const cf Xn{0.5f * (s2.x - wd2.y), 0.5f * (s2.y + wd2.x)};
            const cf Yk = cmul(Xk, HS[k]), Yn = cmul(Xn, HS[FN - k]);
            const cf e1 = cadd(Yk, cconj(Yn)), f1 = cmul(cconj(w), csub(Yk, cconj(Yn)));
            x[pa] = cf{0.5f * (e1.x - f1.y), 0.5f * (e1.y + f1.x)};
            const cf e2 = cadd(Yn, cconj(Yk)), f2 = cmul(w, csub(Yn, cconj(Yk)));
            x[pb] = cf{0.5f * (e2.x + f2.y), 0.5f * (e2.y - f2.x)}; } }
    __syncthreads();
    fft_inv(x, T, X.tid);
    const float bias = X.in(I_HBIAS)[(size_t)l * HW + c], sc = 1.0f / (float)FN; float* O = X.ws<float>(WS_CVT) + (size_t)c * SEQ;
    for (int i2 = X.tid; i2 < FN / 2; i2 += NTHR) { const cf d = x[i2 + FN / 4]; O[2 * i2] = d.x * sc + z[2 * i2] * bias; O[2 * i2 + 1] = d.y * sc + z[2 * i2 + 1] * bias; }
    __syncthreads();
}
__device__ __forceinline__ void phase_fftconv(const Ctx& X, int l) {
    fft_tables(X);
    volatile LAS int* slot = (volatile LAS int*)(X.lds + LDS_MISC) + 121;
    unsigned* q = X.ctl() + CW_Q + l * 64 + 32;
    for (;;) { if (X.tid == 0) slot[0] = (int)atomicAdd(q, 1u); __syncthreads(); const int c = slot[0]; __syncthreads(); if (c >= HW) break; fftconv_item(X, l, c); }
}
__device__ __forceinline__ void phase_ctxconv(const Ctx& X, int l) {
    constexpr int NITEMS = (HW / 64) * (CTX / CR);
    unsigned* q = X.ctl() + CW_Q + l * 64;
    for (;;) { int item = 0; if (X.lane == 0) item = (int)atomicAdd(q, 1u); item = __shfl(item, 0); if (item >= NITEMS) break; conv_item(X, item); }
}
__device__ __forceinline__ void phase_seq(const Ctx& X) {
    for (int su = X.bid; su < N_SEQ_UNITS; su += X.G) seq_unit(X, su);
}

__device__ __forceinline__ void finish_unit(const Ctx& X, int l, int unit) {
    const int b = unit / NH, h = unit % NH, lane = X.lane, w = X.wave, tid = X.tid;
    const int cf = b, cb = (b < CTX / CC) ? (CTX / CC - 1 - b) : (NCHK - 1 - (b - CTX / CC));
    LAS bf16* Gf = (LAS bf16*)X.lds; LAS bf16* Gb = Gf + 64 * LP; LAS bf16* Sf = Gb + 64 * LP; LAS bf16* Sb = Sf + 64 * LP; LAS float* Yl = (LAS float*)(Sb + 64 * LP);
    const size_t uf = ((size_t)(0 * NH + h) * NCHK + cf) * 4096, ub = ((size_t)(1 * NH + h) * NCHK + cb) * 4096;
    { const int r = tid >> 3, c8 = (tid & 7) * 8;
      *(LAS u32x4*)(Gf + r * LP + c8) = *(const u32x4*)(X.ws<bf16>(WS_G) + uf + r * 64 + c8); *(LAS u32x4*)(Gb + r * LP + c8) = *(const u32x4*)(X.ws<bf16>(WS_G) + ub + r * 64 + c8);
      *(LAS u32x4*)(Sf + r * LP + c8) = *(const u32x4*)(X.ws<bf16>(WS_S0) + uf + r * 64 + c8); *(LAS u32x4*)(Sb + r * LP + c8) = *(const u32x4*)(X.ws<bf16>(WS_S0) + ub + r * 64 + c8);
      const float* yf = X.ws<float>(WS_YL) + uf + r * 64 + c8; const float* yb = X.ws<float>(WS_YL) + ub + r * 64 + c8;
#pragma unroll
      for (int i = 0; i < 8; ++i) Yl[r * LQ + c8 + i] = yf[i] + yb[i]; }
    __syncthreads();
#pragma unroll 1
    for (int q = 0; q < 2; ++q) { const int tile = 2 * w + q, ti = tile >> 2, tj = tile & 3; f32x4 y = {0.f, 0.f, 0.f, 0.f};
        y = mm_tile(Gf, Sf, ti, tj, lane, y); y = mm_tile(Gb, Sb, ti, tj, lane, y); const int col = 16 * tj + (lane & 15);
#pragma unroll
        for (int r = 0; r < 4; ++r) Yl[(16 * ti + 4 * (lane >> 4) + r) * LQ + col] += y[r]; }
    __syncthreads();
    const int c = h * 64 + lane; const float lgc = X.in(I_LNXG)[(size_t)l * RW + c], lbc = X.in(I_LNXB)[(size_t)l * RW + c];
#pragma unroll 1
    for (int i = 0; i < 8; ++i) { const int tl = 8 * w + i, t = 64 * b + tl; const size_t o = (size_t)t * RW + c;
        const float y = Yl[tl * LQ + lane];
        const float mean = wave_sum(y) * (1.f / 64.f); const float dy = y - mean; const float var = wave_sum(dy * dy) * (1.f / 64.f);
        float yn = dy / sqrtf(var + GN_EPS) * lgc + lbc;
        yn += X.ws<float>(WS_BONUS)[(size_t)t * NH + h] * bf2f(X.ws<bf16>(WS_V)[o]);
        yn *= bf2f(X.ws<bf16>(WS_GATE)[o]);
        X.ws<bf16>(WS_RO)[o] = (bf16)f2bf(yn); }
    __syncthreads();
}
__device__ __forceinline__ void phase_finish(const Ctx& X, int l) {
    for (int u = X.bid; u < (M / 64) * NH; u += X.G) finish_unit(X, l, u);
    const int c = X.tid;
    const float* hb = X.in(I_HBIAS) + (size_t)l * HW;
    if (c < HW) for (int t = X.bid; t < M; t += X.G) { const size_t o = (size_t)t * HW + c;
            const float cv = t < CTX ? X.ws<float>(WS_CONV)[o] + X.ws<float>(WS_Z)[o] * hb[c] : X.ws<float>(WS_CVT)[(size_t)c * SEQ + (t - CTX)];
            const float ho = cv * bf2f(X.ws<bf16>(WS_X0)[o]);
            X.ws<bf16>(WS_HO)[o] = (bf16)f2bf(ho); }
}

__device__ __forceinline__ void ln_inplace(float (&v)[D / 64], const float* g, const float* b, int lane) {
    float s = 0.f;
#pragma unroll
    for (int j = 0; j < D / 64; ++j) s += v[j];
    const float mean = wave_sum(s) * (1.f / D); float q = 0.f;
#pragma unroll
    for (int j = 0; j < D / 64; ++j) { v[j] -= mean; q += v[j] * v[j]; }
    const float rstd = 1.0f / sqrtf(wave_sum(q) * (1.f / D) + LN_EPS);
#pragma unroll
    for (int j = 0; j < D / 64; ++j) { const int d = 4 * lane + 256 * (j >> 2) + (j & 3); v[j] = v[j] * rstd * g[d] + b[d]; }
}
__device__ __forceinline__ void phase_norm1(const Ctx& X, int l) {
    const int gw = X.bid * NWAVES + X.wave, NGW = X.G * NWAVES, lane = X.lane;
    const float* lng = X.in(I_LNG) + (size_t)(l * 2 + 0) * D; const float* lnb = X.in(I_LNB) + (size_t)(l * 2 + 0) * D;
    const float* wr = X.in(I_WR); const float* rb = X.in(I_RB);
    const float alpha = sqrtf(sqrtf(2.0f * DEPTH));
    volatile LAS int* hist = (volatile LAS int*)(X.lds + LDS_MISC + 4096);
    if (X.tid < NE) hist[X.tid] = 0;
    __syncthreads();
    for (int t = gw; t < M; t += NGW) {
        float* xr = X.ws<float>(WS_X) + (size_t)t * D; const float* mx = X.ws<float>(WS_MIX) + (size_t)t * D;
        const float* gate = modp(X, l, t, 2); const float* sh = modp(X, l, t, 3); const float* sc = modp(X, l, t, 4);
        float v[D / 64];
#pragma unroll
        for (int j = 0; j < D / 256; ++j) { const int d = 4 * lane + 256 * j; const f32x4 a = *(const f32x4*)(xr + d), m = *(const f32x4*)(mx + d), gt = *(const f32x4*)(gate + d);
#pragma unroll
            for (int i = 0; i < 4; ++i) v[4 * j + i] = alpha * a[i] + gt[i] * m[i]; }
        ln_inplace(v, lng, lnb, lane);
        bf16* hf = X.ws<bf16>(WS_XMOD) + (size_t)t * D;
        LAS float* hrow = (LAS float*)X.lds + X.wave * D;
#pragma unroll
        for (int j = 0; j < D / 256; ++j) { const int d = 4 * lane + 256 * j; f32x4 o; const f32x4 a = *(const f32x4*)(sh + d), b = *(const f32x4*)(sc + d); f32x4 h;
#pragma unroll
            for (int i = 0; i < 4; ++i) { o[i] = v[4 * j + i]; h[i] = o[i] * (1.f + b[i]) + a[i]; }
            *(f32x4*)(xr + d) = o; *(LAS f32x4*)(hrow + d) = h;
            *(unsigned long long*)(hf + d) = (unsigned long long)pk2(h[0], h[1]) | ((unsigned long long)pk2(h[2], h[3]) << 32); }
        WAVE_LDS_FENCE(); CFENCE();
        float part = 0.f; { const int e = lane & 15, q = lane >> 4;
#pragma unroll 8
            for (int d = q * (D / 4); d < (q + 1) * (D / 4); ++d) part += hrow[d] * wr[(size_t)d * NE + e]; }
        part += __shfl_xor(part, 16); part += __shfl_xor(part, 32);
        WAVE_LDS_FENCE(); CFENCE();
        float lg[NE];
#pragma unroll
        for (int e = 0; e < NE; ++e) lg[e] = __shfl(part, e);
        float mxl = lg[0];
#pragma unroll
        for (int e = 1; e < NE; ++e) mxl = fmaxf(mxl, lg[e]);
        float sc_[NE], sum = 0.f;
#pragma unroll
        for (int e = 0; e < NE; ++e) { sc_[e] = expf(lg[e] - mxl); sum += sc_[e]; }
        const float isum = 1.0f / sum; float sel[NE];
#pragma unroll
        for (int e = 0; e < NE; ++e) { sc_[e] *= isum; sel[e] = sc_[e] + rb[e]; }
        int bg = 0; float bgs = -INFINITY;
#pragma unroll
        for (int g = 0; g < 4; ++g) { float m1 = -INFINITY, m2 = -INFINITY;
#pragma unroll
            for (int i = 0; i < 4; ++i) { const float x = sel[4 * g + i]; if (x > m1) { m2 = m1; m1 = x; } else if (x > m2) m2 = x; }
            const float gs = m1 + m2; if (gs > bgs) { bgs = gs; bg = g; } }
        int i0 = 0, i1 = 0; float s0 = -INFINITY, s1 = -INFINITY, p0 = 0.f, p1 = 0.f;
#pragma unroll
        for (int e = 0; e < NE; ++e) { if ((e >> 2) == bg) { const float x = sel[e]; if (x > s0) { s1 = s0; i1 = i0; p1 = p0; s0 = x; i0 = e; p0 = sc_[e]; } else if (x > s1) { s1 = x; i1 = e; p1 = sc_[e]; } } }
        if (lane == 0) { int* ei = X.ws<int>(WS_ROUT) + (size_t)t * 2; float* ew = (float*)(X.ws<int>(WS_ROUT) + (size_t)M * 2) + (size_t)t * 2;
            ei[0] = i0; ei[1] = i1; const float ws_ = 1.0f / (p0 + p1); ew[0] = p0 * ws_; ew[1] = p1 * ws_;
            lds_add(hist + i0, 1); lds_add(hist + i1, 1); }
    }
    __syncthreads();
    if (X.tid < NE) { const int hc = hist[X.tid]; X.ws<int>(WS_BCNT)[X.bid * NE + X.tid] = hc; atomicAdd(X.ctl() + CW_CNT + l * 64 + X.tid, (unsigned)hc); }
}

__device__ __forceinline__ void moe_table(const Ctx& X, int l, int NT) {
    volatile LAS int* tab = (volatile LAS int*)(X.lds + LDS_MISC) + 8;
    if (X.tid == 0) { int cum = 0, ts = 0;
        for (int e = 0; e < NE; ++e) { const int cnt = (int)__hip_atomic_load(X.ctl() + CW_CNT + l * 64 + e, RLX_AGENT); const int tc = (cnt + 255) / 256;
            tab[e] = cum; tab[32 + e] = ts; tab[64 + e] = tc; cum += tc * NT; ts += tc; }
        tab[16] = cum; }
    __syncthreads();
}
__device__ __forceinline__ void phase_scatter(const Ctx& X, int l) {
    moe_table(X, l, 1);
    volatile LAS int* tab = (volatile LAS int*)(X.lds + LDS_MISC) + 8;
    volatile LAS int* cur = (volatile LAS int*)(X.lds + LDS_MISC + 4096) + 16;
    const int gw = X.bid * NWAVES + X.wave, NGW = X.G * NWAVES, lane = X.lane;
    if (X.tid < NE) { const int* bc = X.ws<int>(WS_BCNT) + X.tid; int pre = 0; for (int b = 0; b < X.bid; ++b) pre += bc[b * NE]; cur[X.tid] = tab[32 + X.tid] * 256 + pre; }
    __syncthreads();
    const int* ei = X.ws<int>(WS_ROUT); int* slot = X.ws<int>(WS_ROUT) + (size_t)M * 4;
    for (int t = gw; t < M; t += NGW) {
#pragma unroll
        for (int k = 0; k < 2; ++k) { const int e = ei[2 * t + k];
            int pos = 0; if (lane == 0) pos = lds_add(cur + e, 1);
            pos = __shfl(pos, 0);
            if (lane == 0) slot[2 * t + k] = pos;
            const u32x4* src = (const u32x4*)(X.ws<bf16>(WS_XMOD) + (size_t)t * D); u32x4* dst = (u32x4*)(X.ws<bf16>(WS_XG) + (size_t)pos * D);
            for (int i = lane; i < D / 8; i += 64) dst[i] = src[i]; } }
}

__device__ __forceinline__ void phase_combine(const Ctx& X, int l) {
    const int gw = X.bid * NWAVES + X.wave, NGW = X.G * NWAVES, lane = X.lane;
    const float* lng = X.in(I_LNG) + (size_t)(l * 2 + 1) * D; const float* lnb = X.in(I_LNB) + (size_t)(l * 2 + 1) * D;
    const float alpha = sqrtf(sqrtf(2.0f * DEPTH));
    const float* ew = (const float*)(X.ws<int>(WS_ROUT) + (size_t)M * 2); const int* slot = X.ws<int>(WS_ROUT) + (size_t)M * 4;
    for (int t = gw; t < M; t += NGW) {
        float* xr = X.ws<float>(WS_X) + (size_t)t * D; const float* gate = modp(X, l, t, 5);
        const bf16* y0 = X.ws<bf16>(WS_YS) + (size_t)slot[2 * t] * D; const bf16* y1 = X.ws<bf16>(WS_YS) + (size_t)slot[2 * t + 1] * D; const float w0 = ew[2 * t], w1 = ew[2 * t + 1];
        float v[D / 64];
#pragma unroll
        for (int j = 0; j < D / 256; ++j) { const int d = 4 * lane + 256 * j; const f32x4 a = *(const f32x4*)(xr + d), gt = *(const f32x4*)(gate + d);
            const unsigned long long q0 = *(const unsigned long long*)(y0 + d), q1 = *(const unsigned long long*)(y1 + d);
            float ya[4] = {bflo((unsigned)q0), bfhi((unsigned)q0), bflo((unsigned)(q0 >> 32)), bfhi((unsigned)(q0 >> 32))};
            float yb[4] = {bflo((unsigned)q1), bfhi((unsigned)q1), bflo((unsigned)(q1 >> 32)), bfhi((unsigned)(q1 >> 32))};
#pragma unroll
            for (int i = 0; i < 4; ++i) v[4 * j + i] = alpha * a[i] + gt[i] * (w0 * ya[i] + w1 * yb[i]); }
        ln_inplace(v, lng, lnb, lane);
        if (l + 1 < DEPTH) { const float* sh = modp(X, l + 1, t, 0); const float* sc = modp(X, l + 1, t, 1); bf16* xm = X.ws<bf16>(WS_XMOD) + (size_t)t * D;
#pragma unroll
            for (int j = 0; j < D / 256; ++j) { const int d = 4 * lane + 256 * j; f32x4 o; const f32x4 a = *(const f32x4*)(sh + d), b = *(const f32x4*)(sc + d); float h[4];
#pragma unroll
                for (int i = 0; i < 4; ++i) { o[i] = v[4 * j + i]; h[i] = o[i] * (1.f + b[i]) + a[i]; }
                *(f32x4*)(xr + d) = o;
                *(unsigned long long*)(xm + d) = (unsigned long long)pk2(h[0], h[1]) | ((unsigned long long)pk2(h[2], h[3]) << 32); }
        } else if (t >= CTX) { float* orow = X.out() + (size_t)(t - CTX) * D; const bool bad = __hip_atomic_load(X.ctl() + CW_BAR + XB_TMO, RLX_AGENT) != 0u; const float pscale = 1.0f + bitsf(__hip_atomic_load(X.ctl() + 64, RLX_AGENT));
#pragma unroll
            for (int j = 0; j < D / 256; ++j) { const int d = 4 * lane + 256 * j; f32x4 o;
#pragma unroll
                for (int i = 0; i < 4; ++i) o[i] = bad ? __builtin_nanf("") : v[4 * j + i] * pscale;
                *(f32x4*)(orow + d) = o; }
        }
    }
}


#ifdef EMU
#define PHASE_FN static
#define THIN_FN static
#else
#define PHASE_FN __device__ __forceinline__
#define THIN_FN __device__ __noinline__
#endif
THIN_FN void ph_transposes(Ctx X, int l, int part) { phase_transposes(X, l, part); }
THIN_FN void ph_filters(Ctx X, int l) { phase_filters(X, l); }
THIN_FN void ph_mod(Ctx X) { phase_mod(X); }
THIN_FN void ph_x0(Ctx X) { phase_x0(X); }
THIN_FN void ph_lin(Ctx X, int l) { phase_lin(X, l); }
THIN_FN void ph_lora_a(Ctx X, int u) { lora_unit_a(X, u); }
THIN_FN void ph_lora_b(Ctx X, int l, int u) { lora_unit_b(X, l, u); }
THIN_FN void ph_prep_hyena(Ctx X, int l) { phase_prep_hyena(X, l); }
THIN_FN void ph_ctxconv(Ctx X, int l) { phase_ctxconv(X, l); }
THIN_FN void ph_chunk_1(Ctx X, int u) { chunk_unit_1(X, u); }
THIN_FN void ph_chunk_2(Ctx X, int u) { chunk_unit_2(X, u); }
THIN_FN void ph_chunk_3(Ctx X, int u) { chunk_unit_3(X, u); }
THIN_FN void ph_seq(Ctx X) { phase_seq(X); }
THIN_FN void ph_fftconv(Ctx X, int l) { phase_fftconv(X, l); }
THIN_FN void ph_spectra(Ctx X, int l) { phase_spectra(X, l); }
THIN_FN void ph_finish(Ctx X, int l) { phase_finish(X, l); }
THIN_FN void ph_norm1(Ctx X, int l) { phase_norm1(X, l); }
THIN_FN void ph_scatter(Ctx X, int l) { phase_scatter(X, l); }
THIN_FN void ph_combine(Ctx X, int l) { phase_combine(X, l); }
PHASE_FN void ph_g13(Ctx X, int third) { pg8::Gemm g{third ? X.ws<bf16>(WS_T) : X.ws<bf16>(WS_XMOD), third ? X.ws<bf16>(WS_WO) : X.ws<bf16>(WS_WIN), D}; pg8::StaticOrder S; S.init(M, third ? D : PCP, X.G, X.bid);
    pg8::EpiBf16OrF32 E{X.ws<bf16>(WS_P), X.ws<float>(WS_MIX), third ? D : PCP, third != 0}; pg8::gemm_phase(X.lds, g, S, E); }
PHASE_FN void ph_g2(Ctx X, int second) { pg8::Gemm g{second ? X.ws<bf16>(WS_HO) : X.ws<bf16>(WS_RO), X.ws<bf16>(WS_WB) + (second ? (size_t)D * RW : 0), RW}; pg8::StaticOrder S; S.init(M, D, X.G, X.bid);
    pg8::EpiGate E{X.ws<bf16>(WS_T), D, X.ws<bf16>(WS_P), PCP, second ? C_GH : C_GR, second != 0}; pg8::gemm_phase(X.lds, g, S, E); }
PHASE_FN void ph_g45(Ctx X, int l, int down) { const int NT = down ? D / 256 : 2 * D / 256; moe_table(X, l, NT); pg8::MoeOrder S{(const volatile LAS int*)(X.lds + LDS_MISC) + 8, NT, X.G, X.bid};
    pg8::Gemm g{down ? X.ws<bf16>(WS_ACT) : X.ws<bf16>(WS_XG), down ? X.ws<bf16>(WS_WD) : X.ws<bf16>(WS_WGU), D}; pg8::EpiMoe E{down ? X.ws<bf16>(WS_YS) : X.ws<bf16>(WS_ACT), D, NT, down == 0}; pg8::gemm_phase(X.lds, g, S, E); }

constexpr int NPH = 16, NPHASES = DEPTH * NPH;
template <int MASK> __global__ void __launch_bounds__(NTHR, 2) fwd_kernel(Args args) {
    DYN_LDS(lds);
    Ctx X; X.lds = lds; X.tid = threadIdx.x; X.lane = X.tid & 63; X.wave = READFIRSTLANE(X.tid >> 6); X.G = gridDim.x; X.bid = blockIdx.x;
    volatile LAS unsigned* misc = (volatile LAS unsigned*)(lds + LDS_MISC);
    if (X.tid < 128) misc[X.tid] = 0u;
    if (X.tid < N_IN + 2) { const unsigned long long p = X.tid < N_IN ? (unsigned long long)args.in[X.tid < N_IN ? X.tid : 0] : (X.tid == N_IN ? (unsigned long long)args.out : (unsigned long long)args.ws);
        misc[PT_WORD0 + 2 * X.tid] = (unsigned)p; misc[PT_WORD0 + 2 * X.tid + 1] = (unsigned)(p >> 32); }
    __syncthreads();
    XcdBarrier bar = xcd_barrier_post(X.ctl() + CW_BAR, misc);
    const int lo = args.ph_lo, hi = args.ph_hi;
#define IN(k) ((((MASK) >> ((k) % NPH)) & 1) && lo <= (k) && (k) < hi)
#ifdef PROBE_K
#ifndef PROBE_SCALE
#define PROBE_SCALE 1.0f
#endif
    unsigned long long plast = __builtin_amdgcn_s_memrealtime();
#define PROBE_T(k) do { if (blockIdx.x == 0 && threadIdx.x == 0) { const unsigned long long now_ = __builtin_amdgcn_s_memrealtime(); misc[100 + ((k) % NPH)] += (unsigned)(now_ - plast); plast = now_; } } while (0)
#define PROBE_PUB(k) do { if ((k) == NPHASES - 2 && blockIdx.x == 0 && threadIdx.x == 0) { PROBE_T(k); unsigned tot_ = 0; for (int i_ = 0; i_ < NPH; ++i_) tot_ += misc[100 + i_]; \
        const float f_ = PROBE_SCALE * (float)misc[100 + PROBE_K] / (float)tot_; __hip_atomic_store(X.ctl() + 64, fbits(f_), RLX_AGENT); } } while (0)
#else
#define PROBE_T(k) do {} while (0)
#define PROBE_PUB(k) do {} while (0)
#endif
#define SEAM(k) do { PROBE_PUB(k); if ((k) + 1 < hi) xcd_barrier(bar); PROBE_T(k); } while (0)
    for (int l = 0; l < DEPTH; ++l) {
        const int pb = l * NPH;
        if (IN(pb + 0)) { ph_transposes(X, l, 0); __syncthreads(); ph_filters(X, l); if (l == 0) ph_mod(X); SEAM(pb + 0); }
        if (l == 0 && IN(pb + 1)) { ph_x0(X); SEAM(pb + 1); }
        if (IN(pb + 2)) { ph_g13(X, 0); SEAM(pb + 2); }
        if (IN(pb + 3)) { ph_lin(X, l); ph_prep_hyena(X, l); ph_spectra(X, l); SEAM(pb + 3); }
        if (IN(pb + 4)) { for (int u = X.bid; u < (M / 64) * NH; u += X.G) { ph_lora_a(X, u); ph_lora_b(X, l, u); } SEAM(pb + 4); }
        if (IN(pb + 5)) { for (int u = X.bid; u < 2 * NCHK * NH; u += X.G) { ph_chunk_1(X, u); ph_chunk_2(X, u); ph_chunk_3(X, u); } SEAM(pb + 5); }
        if (IN(pb + 6)) { ph_seq(X); ph_transposes(X, l, 1); __syncthreads(); ph_ctxconv(X, l); ph_fftconv(X, l); SEAM(pb + 6); }
        if (IN(pb + 7)) { ph_finish(X, l); SEAM(pb + 7); }
        for (int sb = 0; sb < 2; ++sb) if (IN(pb + 8 + sb)) { ph_g2(X, sb); SEAM(pb + 8 + sb); }
        if (IN(pb + 10)) { ph_g13(X, 1); SEAM(pb + 10); }
        if (IN(pb + 11)) { ph_norm1(X, l); SEAM(pb + 11); }
        if (IN(pb + 12)) { ph_scatter(X, l); SEAM(pb + 12); }
        for (int dn = 0; dn < 2; ++dn) if (IN(pb + 13 + dn)) { ph_g45(X, l, dn); SEAM(pb + 13 + dn); }
        if (IN(pb + 15)) { ph_combine(X, l); SEAM(pb + 15); }
    }
#undef IN
#undef SEAM
}

#ifndef N_LAUNCHES
#define N_LAUNCHES 1
#endif
#ifndef PH_MASK
#define PH_MASK 0xffff
#endif
template <int MASK> static void launch_mask(int grid, hipStream_t stream, const Args& a) {
    static bool attr = false;
    if (!attr) { (void)hipFuncSetAttribute((const void*)fwd_kernel<MASK>, hipFuncAttributeMaxDynamicSharedMemorySize, LDS_BYTES); attr = true; }
    hipLaunchKernelGGL(fwd_kernel<MASK>, dim3(grid), dim3(NTHR), LDS_BYTES, stream, a);
}
extern "C" void kernel_launch(void* const* d_in, const int* in_sizes, int n_in, void* d_out, int out_size, void* d_ws, size_t ws_size, hipStream_t stream) {
    static int grid = 0;
    if (grid == 0) {
        if (n_in != N_IN || ws_size < WS_END) { fprintf(stderr, "kernel_launch: unexpected n_in %d or workspace %zu < %zu\n", n_in, ws_size, (size_t)WS_END); grid = -1; return; }
        int dev = 0, cus = 0;
        if (hipGetDevice(&dev) != hipSuccess || hipDeviceGetAttribute(&cus, hipDeviceAttributeMultiprocessorCount, dev) != hipSuccess) { grid = -1; return; }
        (void)hipGetLastError();
        grid = cus; if (grid > NPART) grid = NPART;
    }
    if (grid < 0) return;
    (void)in_sizes; (void)out_size;
    (void)hipMemsetAsync(d_ws, 0, CTL_BYTES, stream);
    Args a;
    for (int i = 0; i < N_IN; ++i) a.in[i] = (const float*)d_in[i];
    a.out = (float*)d_out; a.ws = (unsigned char*)d_ws;
#if N_LAUNCHES == 1
    a.ph_lo = 0; a.ph_hi = NPHASES;
    launch_mask<PH_MASK>(grid, stream, a);
#else
    for (int ph = 0; ph < NPHASES; ++ph) { const int k = ph % NPH; if (k == 1 && ph / NPH != 0) continue; a.ph_lo = ph; a.ph_hi = ph + 1; launch_mask<PH_MASK>(grid, stream, a); }
#endif
}
```

```cpp
#ifndef EMU
#include <hip/hip_runtime.h>
#endif
#include <cstdio>
#include <cstdint>
#include <cmath>

#ifndef CFG_D
#define CFG_D 1024
#define CFG_SEQ 16384
#define CFG_CTX 256
#define CFG_DEPTH 4
#endif
constexpr int D = CFG_D, SEQ = CFG_SEQ, CTX = CFG_CTX, DEPTH = CFG_DEPTH, M = CTX + SEQ;
constexpr int GRID_W = 64, GRID_H = SEQ / GRID_W;
constexpr int RW = D / 2, NH = RW / 64, HW = D / 2, RC = 3 * RW + 384, HC = 3 * HW, GC = 2 * D, PC = RC + HC + GC, PCP = (PC + 255) / 256 * 256;
constexpr int QTR = RC / 4, HALFC = RC / 2;
constexpr int C_K = RW, C_V = 2 * RW, C_LWF = 3 * RW, C_LG = 3 * RW + 256;
constexpr int C_HY = RC, C_GR = RC + HC, C_GH = RC + HC + D;
constexpr int NE = 16, SP_TILES = (2 * M) / 256 + NE, SP = SP_TILES * 256;
constexpr float DECAY_SCALE = 0.606531f, GN_EPS = 6.4e-4f, LN_EPS = 1e-5f;
constexpr int N_SEQ_UNITS = 2 * NH * 4;
constexpr int NPART = 256;
static_assert(CTX % 32 == 0 && M % 256 == 0 && D % 256 == 0 && RW % 128 == 0 && RW >= 256 && SEQ % 64 == 0 && CTX % 32 == 0 && RC % 4 == 0, "shape assumptions");

enum { I_X = 0, I_C, I_CTX, I_CCTX, I_WMOD, I_BMOD, I_WIN, I_MU, I_W0, I_W2, I_A0, I_A2, I_G2, I_KK, I_KA, I_RK, I_LNXG, I_LNXB, I_CW, I_CB,
       I_FW1, I_FB1, I_FW2, I_FB2, I_FW3, I_FB3, I_FWO, I_FREQ, I_HBIAS, I_WBR, I_WOUT, I_LNG, I_LNB, I_WR, I_RB, I_WG, I_WU, I_WD, N_IN };

constexpr size_t al256(size_t x) { return (x + 255) & ~(size_t)255; }
constexpr size_t CTL_BYTES = 1u << 20;
constexpr size_t WS_MOD = CTL_BYTES;
constexpr size_t WS_FPART = al256(WS_MOD + (size_t)DEPTH * 2 * 6 * D * 4);
constexpr size_t WS_ROUT = al256(WS_FPART + (size_t)2 * NPART * HW * 4);
constexpr size_t WS_BCNT = al256(WS_ROUT + (size_t)M * 2 * 4 * 3);
constexpr size_t WS_BONUS = al256(WS_BCNT + (size_t)NPART * NE * 4);
constexpr size_t WS_WIN = al256(WS_BONUS + (size_t)M * NH * 4);
constexpr size_t WS_WB = al256(WS_WIN + (size_t)PCP * D * 2);
constexpr size_t WS_WO = al256(WS_WB + (size_t)2 * D * RW * 2);
constexpr size_t WS_W2T = al256(WS_WO + (size_t)D * D * 2);
constexpr size_t WS_A2T = al256(WS_W2T + (size_t)2 * RW * 64 * 2);
constexpr size_t WS_G2T = al256(WS_A2T + (size_t)2 * RW * 64 * 2);
constexpr size_t WS_WGU = al256(WS_G2T + (size_t)RW * 128 * 2);
constexpr size_t WS_WD = al256(WS_WGU + (size_t)NE * 2 * D * D * 2);
constexpr size_t WS_X = al256(WS_WD + (size_t)NE * D * D * 2);
constexpr size_t WS_XMOD = al256(WS_X + (size_t)M * D * 4);
constexpr size_t WS_P = al256(WS_XMOD + (size_t)M * D * 2);
constexpr size_t WS_FILT = al256(WS_P + (size_t)M * PCP * 2);
constexpr size_t WS_MIX = al256(WS_FILT + (size_t)M * HW * 4);
constexpr size_t WS_T = al256(WS_MIX + (size_t)M * D * 4);
constexpr size_t WS_S = al256(WS_T + (size_t)M * D * 2);
constexpr size_t WS_R = WS_S;
constexpr size_t WS_V = al256(WS_R + (size_t)M * RW * 2);
constexpr size_t WS_KA = al256(WS_V + (size_t)M * RW * 2);
constexpr size_t WS_KD = al256(WS_KA + (size_t)M * RW * 2);
constexpr size_t WS_KB = al256(WS_KD + (size_t)2 * M * RW * 2);
constexpr size_t WS_W = al256(WS_KB + (size_t)2 * M * RW * 2);
constexpr size_t WS_PQ = al256(WS_W + (size_t)2 * M * RW * 4);
constexpr size_t WS_LIN = WS_PQ;
static_assert((size_t)M * 384 * 2 <= (size_t)2 * NH * (M / 64) * 2 * 4096 * 4, "LIN fits PQ");
constexpr size_t WS_G = al256(WS_PQ + (size_t)2 * NH * (M / 64) * 2 * 4096 * 4);
constexpr size_t WS_YL = al256(WS_G + (size_t)2 * NH * (M / 64) * 4096 * 2);
constexpr size_t WS_S0 = WS_XMOD;
static_assert((size_t)2 * NH * (M / 64) * 4096 * 2 <= (size_t)M * D * 2, "S0 fits XMOD");
constexpr size_t WS_Z = al256(WS_YL + (size_t)2 * NH * (M / 64) * 4096 * 4);
constexpr size_t WS_X0 = al256(WS_Z + (size_t)CTX * HW * 4);
constexpr size_t WS_CONV = al256(WS_X0 + (size_t)M * HW * 2);
constexpr size_t WS_GATE = al256(WS_CONV + (size_t)CTX * HW * 4);
constexpr size_t WS_RO = al256(WS_GATE + (size_t)M * RW * 2);
constexpr size_t WS_HO = al256(WS_RO + (size_t)M * RW * 2);
constexpr size_t WS_HS = WS_MIX;
constexpr size_t WS_ZT = WS_T;
constexpr size_t WS_CVT = WS_FILT;
static_assert((size_t)HW * (SEQ + 1) * 8 <= (size_t)M * D * 4 && (size_t)HW * M * 4 <= (size_t)M * D * 2, "HS fits MIX, ZT fits T");
constexpr size_t WS_END1 = al256(WS_HO + (size_t)M * HW * 2);
constexpr size_t WS_XG = WS_S;
constexpr size_t WS_ACT = al256(WS_XG + (size_t)SP * D * 2);
constexpr size_t WS_YS = al256(WS_ACT + (size_t)SP * D * 2);
constexpr size_t WS_END2 = al256(WS_YS + (size_t)SP * D * 2);
constexpr size_t WS_END = WS_END1 > WS_END2 ? WS_END1 : WS_END2;
constexpr int CW_TMO = 0, CW_BAR = 4096, CW_CNT = 8192  , CW_CUR = 8192 + 1024  , CW_Q = 8192 + 2048  ;

#ifdef EMU
#define LAS
typedef short bf16x8 __attribute__((vector_size(16)));
typedef float f32x4 __attribute__((vector_size(16)));
typedef unsigned u32x4 __attribute__((vector_size(16)));
#define DYN_LDS(name) unsigned char* name = emu_cur_lds()
#define ASM_WAIT_V(n) do {} while (0)
#define ASM_WAIT_L(n) do {} while (0)
#define ASM_WAIT_VL0() do {} while (0)
#define CFENCE() do {} while (0)
#define WAVE_LDS_FENCE() emu_wave_sync()
#define S_BARRIER() emu_block_sync()
#define SCHED_BARRIER() do {} while (0)
#define SETPRIO(x) do {} while (0)
#define S_SLEEP(n) emu_yield()
#define MFMA16(a, b, c) emu_mfma_16x16x32(a, b, c)
#define MFMA4F(a, b, c) emu_mfma_16x16x4f32(a, b, c)
#define GLDS16(gptr, lptr) emu_glds16((const void*)(gptr), (void*)(lptr))
#define READFIRSTLANE(x) (x)
#define XCC_ID_() (blockIdx.x & 7u)
#define FENCE_RELEASE() do {} while (0)
#define FENCE_ACQUIRE() do {} while (0)
#define DPP_F(v, ctrl) emu_dpp_f(v, ctrl)
static inline int vgpr_zero() { return 0; }
static inline unsigned long long vgpr_zero64() { return 0ull; }
static inline int lds_add(volatile int* p, int v) { int o = *p; *p = o + v; return o; }
static inline unsigned fbits(float f) { unsigned u; memcpy(&u, &f, 4); return u; }
static inline float bitsf(unsigned u) { float f; memcpy(&f, &u, 4); return f; }
#else
#define LAS __attribute__((address_space(3)))
typedef short bf16x8 __attribute__((ext_vector_type(8)));
typedef float f32x4 __attribute__((ext_vector_type(4)));
typedef unsigned u32x4 __attribute__((ext_vector_type(4)));
#define DYN_LDS(name) extern __shared__ __attribute__((aligned(16))) unsigned char name##_raw[]; LAS unsigned char* name = (LAS unsigned char*)name##_raw
#define ASM_WAIT_V(n) asm volatile("s_waitcnt vmcnt(" #n ")" ::: "memory")
#define ASM_WAIT_L(n) asm volatile("s_waitcnt lgkmcnt(" #n ")" ::: "memory")
#define ASM_WAIT_VL0() asm volatile("s_waitcnt vmcnt(0) lgkmcnt(0)" ::: "memory")
#define CFENCE() asm volatile("" ::: "memory")
#define WAVE_LDS_FENCE() asm volatile("s_waitcnt lgkmcnt(0)" ::: "memory")
#define S_BARRIER() __builtin_amdgcn_s_barrier()
#define SCHED_BARRIER() __builtin_amdgcn_sched_barrier(0)
#define SETPRIO(x) __builtin_amdgcn_s_setprio(x)
#define S_SLEEP(n) __builtin_amdgcn_s_sleep(n)
#define MFMA16(a, b, c) __builtin_amdgcn_mfma_f32_16x16x32_bf16(a, b, c, 0, 0, 0)
#define MFMA4F(a, b, c) __builtin_amdgcn_mfma_f32_16x16x4f32(a, b, c, 0, 0, 0)
#define GLDS16(gptr, lptr) __builtin_amdgcn_global_load_lds((const unsigned*)(gptr), (LAS unsigned*)(lptr), 16, 0, 0)
#define READFIRSTLANE(x) __builtin_amdgcn_readfirstlane(x)
#define XCC_ID_() ((unsigned)__builtin_amdgcn_s_getreg((3 << 11) | 20) & 0xFu)
#define FENCE_RELEASE() __builtin_amdgcn_fence(__ATOMIC_RELEASE, "agent")
#define FENCE_ACQUIRE() __builtin_amdgcn_fence(__ATOMIC_ACQUIRE, "agent")
#define DPP_F(v, ctrl) __builtin_bit_cast(float, __builtin_amdgcn_update_dpp(0, __builtin_bit_cast(int, (float)(v)), (ctrl), 0xF, 0xF, true))
__device__ __forceinline__ int vgpr_zero() { int z; asm volatile("v_mov_b32 %0, 0" : "=v"(z)); return z; }
__device__ __forceinline__ unsigned long long vgpr_zero64() { unsigned long long z; asm volatile("v_mov_b64 %0, 0" : "=v"(z)); return z; }
__device__ __forceinline__ int lds_add(volatile LAS int* p, int v) { return __hip_atomic_fetch_add((LAS int*)p, v, __ATOMIC_RELAXED, __HIP_MEMORY_SCOPE_WORKGROUP); }
__device__ __forceinline__ unsigned fbits(float f) { return __builtin_bit_cast(unsigned, f); }
__device__ __forceinline__ float bitsf(unsigned u) { return __builtin_bit_cast(float, u); }
#endif
typedef unsigned short bf16;
#define RLX_AGENT __ATOMIC_RELAXED, __HIP_MEMORY_SCOPE_AGENT

__device__ __forceinline__ unsigned f2bf(float f) { unsigned u = fbits(f); return (u + 0x7fffu + ((u >> 16) & 1u)) >> 16; }
__device__ __forceinline__ unsigned pk2(float lo, float hi) { return f2bf(lo) | (f2bf(hi) << 16); }
__device__ __forceinline__ float bf2f(bf16 b) { return bitsf(((unsigned)b) << 16); }
__device__ __forceinline__ float bflo(unsigned w) { return bitsf(w << 16); }
__device__ __forceinline__ float bfhi(unsigned w) { return bitsf(w & 0xffff0000u); }
__device__ __forceinline__ float sigmoidf_(float x) { return 1.0f / (1.0f + expf(-x)); }
__device__ __forceinline__ float wave_sum(float v) {
#pragma unroll
    for (int o = 1; o < 64; o <<= 1) v += __shfl_xor(v, o);
    return v;
}
__device__ __forceinline__ float row16_sum(float v) {
    v += DPP_F(v, 0xB1);
    v += DPP_F(v, 0x4E);
    v += DPP_F(v, 0x141);
    v += DPP_F(v, 0x140);
    return v;
}
__device__ __forceinline__ void sincos_f(float x, float& s, float& c) {
    const float k = rintf(x * 0.63661977236758134f);
    float r = fmaf(-k, 1.5703125f, x); r = fmaf(-k, 4.837512969970703125e-4f, r); r = fmaf(-k, 7.54978994989188216e-8f, r);
    const float r2 = r * r;
    const float sp = r + r * r2 * (-1.6666654611e-1f + r2 * (8.3321608736e-3f + r2 * (-1.9515295891e-4f)));
    const float cp = 1.0f - 0.5f * r2 + r2 * r2 * (4.166664568298827e-2f + r2 * (-1.388731625493765e-3f + r2 * (2.443315711809948e-5f)));
    const int q = ((int)k) & 3;
    s = (q == 0) ? sp : (q == 1) ? cp : (q == 2) ? -sp : -cp;
    c = (q == 0) ? cp : (q == 1) ? -sp : (q == 2) ? -cp : sp;
}
__device__ __forceinline__ float sin_f(float x) { float s, c; sincos_f(x, s, c); return s; }

#define XB_TMO      128
#define XB_XCNT(j)  (256  + 64 * (j))
#define XB_XSUB(j)  (1280 + 64 * (j))
#define XB_XGEN(j)  (2304 + 64 * (j))
#define XB_TOP      3328
#define XB_TOPGEN   3392
#define XCD_BAR_WORDS 3456
#define XB_SPIN_CAP (1u << 18)
__device__ __forceinline__ unsigned xb_ld(unsigned* p)              { return __hip_atomic_load(p, __ATOMIC_RELAXED, __HIP_MEMORY_SCOPE_AGENT); }
__device__ __forceinline__ unsigned xb_add(unsigned* p, unsigned v) { return __hip_atomic_fetch_add(p, v, __ATOMIC_RELAXED, __HIP_MEMORY_SCOPE_AGENT); }
#define XB_SPIN(cond, bar) do { unsigned _sp = 0; while (cond) { S_SLEEP(1); \
    if ((++_sp & 255u) == 0u) { if (xb_ld(&(bar)[XB_TMO])) break; if (_sp > XB_SPIN_CAP) { atomicAdd(&(bar)[XB_TMO], 1u); break; } } } } while (0)
struct XcdBarrier { unsigned* bar; unsigned x; volatile LAS unsigned* st; };
__device__ __forceinline__ XcdBarrier xcd_barrier_post(unsigned* bar, volatile LAS unsigned* st) {
    XcdBarrier b; b.bar = nullptr; b.x = XCC_ID_(); b.st = st;
    if (threadIdx.x == 0) { st[2] = (unsigned)(unsigned long long)bar; st[3] = (unsigned)((unsigned long long)bar >> 32); st[4] = b.x; (void)xb_add(&bar[XB_XCNT(b.x)], 1u); }
    return b;
}
__device__ __forceinline__ void xcd_barrier_complete(unsigned* bar, unsigned x, unsigned& nloc, unsigned& nx) {
    const unsigned G = gridDim.x * gridDim.y * gridDim.z;
    unsigned sum, cnt, mine, sp = 0u;
    for (;;) {
        sum = 0u; cnt = 0u; mine = 0u;
#pragma unroll
        for (unsigned j = 0; j < 16; ++j) { const unsigned c = xb_ld(&bar[XB_XCNT(j)]); sum += c; cnt += (c > 0u) ? 1u : 0u; mine = (j == x) ? c : mine; }
        if (sum == G) break;
        S_SLEEP(1);
        if ((++sp & 255u) == 0u) { if (xb_ld(&bar[XB_TMO])) break; if (sp > XB_SPIN_CAP) { atomicAdd(&bar[XB_TMO], 1u); break; } }
    }
    nloc = mine > 0u ? mine : 1u; nx = cnt > 0u ? cnt : 1u;
}
__device__ __forceinline__ void xcd_barrier(const XcdBarrier& b) {
    ASM_WAIT_V(0);
    __syncthreads();
    if (threadIdx.x == 0) {
        unsigned* bar = (unsigned*)(((unsigned long long)b.st[3] << 32) | b.st[2]);
        const unsigned bx = b.st[4];
        ASM_WAIT_VL0();
        unsigned nloc = b.st[0], nx = b.st[1];
        if (nloc == 0u) { xcd_barrier_complete(bar, bx, nloc, nx); b.st[0] = nloc; b.st[1] = nx; }
        const unsigned old = xb_add(&bar[XB_XSUB(bx)], 1u);
        const unsigned gen = old / nloc;
        if (old + 1u == (gen + 1u) * nloc) {
            FENCE_RELEASE();
            ASM_WAIT_V(0);
            const unsigned og = xb_add(&bar[XB_TOP], 1u);
            const unsigned tg = og / nx;
            if (og + 1u == (tg + 1u) * nx) xb_add(&bar[XB_TOPGEN], 1u);
            else XB_SPIN(xb_ld(&bar[XB_TOPGEN]) == tg, bar);
            FENCE_ACQUIRE();
            xb_add(&bar[XB_XGEN(bx)], 1u);
            ASM_WAIT_V(0);
        } else {
            XB_SPIN(xb_ld(&bar[XB_XGEN(bx)]) == gen, bar);
            FENCE_ACQUIRE();
            ASM_WAIT_V(0);
        }
    }
    __syncthreads();
}

namespace pg8 {
constexpr int BM = 256, BK = 64, HALF = 128, HTB = HALF * BK * 2, STAGE_BYTES = 8 * HTB, NXCD = 8, WGM = 8;
__host__ __device__ __forceinline__ int lds_byte(int r, int c) { const int st = (r >> 4) * 2 + (c >> 5), rr = r & 15, cc = c & 31, ob = rr * 64 + cc * 2; return st * 1024 + (ob ^ (((ob >> 9) & 1) << 5)); }
__host__ __device__ __forceinline__ void stage_rc(int b, int& R, int& C) { const int st = b / 1024, sb = b % 1024, swz = sb ^ (((sb >> 9) & 1) << 5); R = (st >> 1) * 16 + swz / 64; C = (st & 1) * 32 + (swz % 64) / 2; }
__host__ __device__ __forceinline__ int perm32(int rho) { const int n = rho >> 4, i = rho & 15; return 8 * (i >> 2) + 4 * n + (i & 3); }
struct Unit { int pm, pn; };
struct Gemm { const bf16* A; const bf16* Bt; int K; };
struct StaticOrder {
    int nM, nN, nwg, G, c;
    __host__ __device__ void init(int M_, int N_, int G_, int c_) { nM = M_ / BM; nN = N_ / BM; nwg = nM * nN; G = G_; c = c_; }
    __host__ __device__ bool next(int i, Unit& u) const {
        const long L = (long)i * G + c; if (L >= nwg) return false;
        int wgid = (int)L; { const int q = nwg / NXCD, r = nwg % NXCD, xcd = wgid % NXCD, off = wgid / NXCD; wgid = (xcd < r ? xcd * (q + 1) : r * (q + 1) + (xcd - r) * q) + off; }
        const int nig = WGM * nN, gid = wgid / nig, fm = gid * WGM, gsz = (nM - fm) < WGM ? (nM - fm) : WGM;
        u.pm = fm + ((wgid % nig) % gsz); u.pn = (wgid % nig) / gsz; return true;
    }
};
struct MoeOrder {
    const volatile LAS int* tab; int NT, G, c;
    __device__ __forceinline__ bool next(int i, Unit& u) const {
        const long L = (long)i * G + c; if (L >= tab[16]) return false;
        int e = 0; while (L >= tab[e + 1]) ++e;
        const int loc = (int)L - tab[e], tc = tab[64 + e];
        u.pm = tab[32 + e] + loc % tc; u.pn = e * NT + loc / tc; return true;
    }
};
__device__ __forceinline__ unsigned cvt_pk_bf16(float lo, float hi) {
#ifdef EMU
    return pk2(lo, hi);
#else
    unsigned r; asm volatile("v_cvt_pk_bf16_f32 %0, %1, %2" : "=v"(r) : "v"(lo), "v"(hi)); return r;
#endif
}

struct EpiBf16 {
    static constexpr bool PERM = true;
    bf16* O; int ldc;
    __device__ __forceinline__ void operator()(const f32x4 (&acc)[2][2][4][2], const Unit& u, int wr, int wc, int fr, int fq) const {
        const int row0 = u.pm * BM + wr * 64 + fr, col0 = u.pn * BM + wc * 32 + 8 * fq;
#pragma unroll
        for (int ai = 0; ai < 2; ++ai)
#pragma unroll
            for (int m = 0; m < 4; ++m) { bf16* rowp = O + (size_t)(row0 + ai * HALF + m * 16) * ldc + col0;
#pragma unroll
                for (int bj = 0; bj < 2; ++bj) { const f32x4 v0 = acc[ai][bj][m][0], v1 = acc[ai][bj][m][1];
                    u32x4 w; w[0] = cvt_pk_bf16(v0[0], v0[1]); w[1] = cvt_pk_bf16(v0[2], v0[3]); w[2] = cvt_pk_bf16(v1[0], v1[1]); w[3] = cvt_pk_bf16(v1[2], v1[3]);
                    *(u32x4*)(rowp + bj * HALF) = w; } }
    }
};
struct EpiF32 {
    static constexpr bool PERM = true;
    float* C; int ldc;
    __device__ __forceinline__ void operator()(const f32x4 (&acc)[2][2][4][2], const Unit& u, int wr, int wc, int fr, int fq) const {
        const int row0 = u.pm * BM + wr * 64 + fr, col0 = u.pn * BM + wc * 32 + 8 * fq;
#pragma unroll
        for (int ai = 0; ai < 2; ++ai)
#pragma unroll
            for (int m = 0; m < 4; ++m) { float* rowp = C + (size_t)(row0 + ai * HALF + m * 16) * ldc + col0;
#pragma unroll
                for (int bj = 0; bj < 2; ++bj)
#pragma unroll
                    for (int n = 0; n < 2; ++n) *(f32x4*)(rowp + bj * HALF + n * 4) = acc[ai][bj][m][n]; }
    }
};
struct EpiGate {
    static constexpr bool PERM = true;
    bf16* T; int ldc; const bf16* Pg; int ldp; int gcol0; bool ADD;
    __device__ __forceinline__ void operator()(const f32x4 (&acc)[2][2][4][2], const Unit& u, int wr, int wc, int fr, int fq) const {
        const int row0 = u.pm * BM + wr * 64 + fr, col0 = u.pn * BM + wc * 32 + 8 * fq;
#pragma unroll
        for (int ai = 0; ai < 2; ++ai)
#pragma unroll
            for (int m = 0; m < 4; ++m) { const size_t row = (size_t)(row0 + ai * HALF + m * 16);
#pragma unroll
                for (int bj = 0; bj < 2; ++bj) { const f32x4 v0 = acc[ai][bj][m][0], v1 = acc[ai][bj][m][1];
                    const u32x4 g = *(const u32x4*)(Pg + row * ldp + gcol0 + col0 + bj * HALF);
                    u32x4 t = {0u, 0u, 0u, 0u}; if (ADD) t = *(const u32x4*)(T + row * ldc + col0 + bj * HALF);
                    float o[8];
#pragma unroll
                    for (int j = 0; j < 4; ++j) { const float a0 = j < 2 ? v0[2 * j] : v1[2 * j - 4], a1 = j < 2 ? v0[2 * j + 1] : v1[2 * j - 3];
                        o[2 * j] = bflo(t[j]) + sigmoidf_(bflo(g[j])) * a0; o[2 * j + 1] = bfhi(t[j]) + sigmoidf_(bfhi(g[j])) * a1; }
                    u32x4 w; w[0] = cvt_pk_bf16(o[0], o[1]); w[1] = cvt_pk_bf16(o[2], o[3]); w[2] = cvt_pk_bf16(o[4], o[5]); w[3] = cvt_pk_bf16(o[6], o[7]);
                    *(u32x4*)(T + row * ldc + col0 + bj * HALF) = w; } }
    }
};
struct EpiSwiglu {
    static constexpr bool PERM = true;
    bf16* O; int ldc; int NT;
    __device__ __forceinline__ void operator()(const f32x4 (&acc)[2][2][4][2], const Unit& u, int wr, int wc, int fr, int fq) const {
        const int row0 = u.pm * BM + wr * 64 + fr, col0 = (u.pn % NT) * HALF + wc * 32 + 8 * fq;
#pragma unroll
        for (int ai = 0; ai < 2; ++ai)
#pragma unroll
            for (int m = 0; m < 4; ++m) { bf16* rowp = O + (size_t)(row0 + ai * HALF + m * 16) * ldc + col0;
                float o[8];
#pragma unroll
                for (int j = 0; j < 8; ++j) { const float g = acc[ai][0][m][j >> 2][j & 3], uu = acc[ai][1][m][j >> 2][j & 3]; o[j] = g / (1.0f + expf(-g)) * uu; }
                u32x4 w; w[0] = cvt_pk_bf16(o[0], o[1]); w[1] = cvt_pk_bf16(o[2], o[3]); w[2] = cvt_pk_bf16(o[4], o[5]); w[3] = cvt_pk_bf16(o[6], o[7]);
                *(u32x4*)rowp = w; }
    }
};
struct EpiMoeDown {
    static constexpr bool PERM = true;
    bf16* O; int ldc; int NT;
    __device__ __forceinline__ void operator()(const f32x4 (&acc)[2][2][4][2], const Unit& u, int wr, int wc, int fr, int fq) const {
        const int row0 = u.pm * BM + wr * 64 + fr, col0 = (u.pn % NT) * BM + wc * 32 + 8 * fq;
#pragma unroll
        for (int ai = 0; ai < 2; ++ai)
#pragma unroll
            for (int m = 0; m < 4; ++m) { bf16* rowp = O + (size_t)(row0 + ai * HALF + m * 16) * ldc + col0;
#pragma unroll
                for (int bj = 0; bj < 2; ++bj) { const f32x4 v0 = acc[ai][bj][m][0], v1 = acc[ai][bj][m][1];
                    u32x4 w; w[0] = cvt_pk_bf16(v0[0], v0[1]); w[1] = cvt_pk_bf16(v0[2], v0[3]); w[2] = cvt_pk_bf16(v1[0], v1[1]); w[3] = cvt_pk_bf16(v1[2], v1[3]);
                    *(u32x4*)(rowp + bj * HALF) = w; } }
    }
};

struct EpiBf16OrF32 { static constexpr bool PERM = true; bf16* O; float* C; int ldc; bool f32;
    __device__ __forceinline__ void operator()(const f32x4 (&acc)[2][2][4][2], const Unit& u, int wr, int wc, int fr, int fq) const {
        if (f32) { EpiF32 E{C, ldc}; E(acc, u, wr, wc, fr, fq); } else { EpiBf16 E{O, ldc}; E(acc, u, wr, wc, fr, fq); } } };
struct EpiMoe { static constexpr bool PERM = true; bf16* O; int ldc; int NT; bool swiglu;
    __device__ __forceinline__ void operator()(const f32x4 (&acc)[2][2][4][2], const Unit& u, int wr, int wc, int fr, int fq) const {
        if (swiglu) { EpiSwiglu E{O, ldc, NT}; E(acc, u, wr, wc, fr, fq); } else { EpiMoeDown E{O, ldc, NT}; E(acc, u, wr, wc, fr, fq); } } };
template <class Epi, class Sched>
__device__ __forceinline__ void gemm_phase(LAS unsigned char* lds, const Gemm g, const Sched& S, const Epi& E) {
    const int tid = threadIdx.x + vgpr_zero();
    const int wid = READFIRSTLANE(tid >> 6), lane = tid & 63, wr = wid >> 2, wc = wid & 3, fr = lane & 15, fq = lane >> 4;
    const int K = g.K, nt = K / BK;
    unsigned long long voffA[2], voffB[2]; const unsigned long long zhi = vgpr_zero64();
#pragma unroll
    for (int i = 0; i < 2; ++i) { int R, C; stage_rc(tid * 16 + i * 8192, R, C); const int Rb = Epi::PERM ? ((R & ~31) + perm32(R & 31)) : R;
        voffA[i] = zhi + (unsigned long long)(long long)((R * K + C) * 2); voffB[i] = zhi + (unsigned long long)(long long)((Rb * K + C) * 2); }
    const size_t kstep = (size_t)(BK * 2);
    const size_t hstep = (size_t)HALF * K * 2;
    const size_t tstep = 2 * hstep;
    const unsigned ldsw = (unsigned)wid * 1024u;
    const int aoff = lds_byte(wr * 64 + fr, fq * 8), boff = lds_byte(wc * 32 + fr, fq * 8);
#define PG8_SA(b, h) (((b) * 2 + (h)) * HTB)
#define PG8_SB(b, h) ((4 + (b) * 2 + (h)) * HTB)
#define PG8_STAGE(bufoff, gbase, voff) do { _Pragma("unroll") for (int _i = 0; _i < 2; ++_i) \
        GLDS16((const char*)(gbase) + (voff)[_i], lds + (bufoff) + ldsw + _i * 8192); } while (0)
#define PG8_LDA(dst, b, h) do { _Pragma("unroll") for (int m = 0; m < 4; ++m) _Pragma("unroll") for (int k = 0; k < 2; ++k) dst[m][k] = *(const LAS bf16x8*)(lds + PG8_SA(b, h) + aoff + m * 2048 + k * 1024); } while (0)
#define PG8_LDB(dst, b, h) do { _Pragma("unroll") for (int n = 0; n < 2; ++n) _Pragma("unroll") for (int k = 0; k < 2; ++k) dst[n][k] = *(const LAS bf16x8*)(lds + PG8_SB(b, h) + boff + n * 2048 + k * 1024); } while (0)
#define PG8_MMA(ai, bj, At, Bt) do { SETPRIO(1); _Pragma("unroll") for (int m = 0; m < 4; ++m) _Pragma("unroll") for (int n = 0; n < 2; ++n) _Pragma("unroll") for (int k = 0; k < 2; ++k) \
        acc[ai][bj][m][n] = MFMA16(Bt[n][k], At[m][k], acc[ai][bj][m][n]); SETPRIO(0); } while (0)
#define PG8_BAR S_BARRIER()
    Unit cur, nxt; int ui = 0;
    if (!S.next(0, cur)) return;
    f32x4 acc[2][2][4][2];
#pragma unroll
    for (int a = 0; a < 2; ++a)
#pragma unroll
        for (int b = 0; b < 2; ++b)
#pragma unroll
            for (int m = 0; m < 4; ++m)
#pragma unroll
                for (int n = 0; n < 2; ++n) acc[a][b][m][n] = (f32x4){0.f, 0.f, 0.f, 0.f};
    bf16x8 At[4][2], B0[2][2], B1[2][2];
    const char* cA = (const char*)g.A + (size_t)cur.pm * tstep; const char* cB = (const char*)g.Bt + (size_t)cur.pn * tstep;
    PG8_STAGE(PG8_SB(0, 0), cB, voffB); PG8_STAGE(PG8_SA(0, 0), cA, voffA); PG8_STAGE(PG8_SB(0, 1), cB + hstep, voffB); PG8_STAGE(PG8_SA(0, 1), cA + hstep, voffA);
    if (wr == 1) PG8_BAR;
    ASM_WAIT_V(4); PG8_BAR;
    PG8_STAGE(PG8_SB(1, 0), cB + kstep, voffB); PG8_STAGE(PG8_SA(1, 0), cA + kstep, voffA); PG8_STAGE(PG8_SB(1, 1), cB + hstep + kstep, voffB);
    ASM_WAIT_V(6); PG8_BAR;
    for (;;) {
        const bool has_next = S.next(ui + 1, nxt);
        const char* nA = has_next ? (const char*)g.A + (size_t)nxt.pm * tstep : cA; const char* nB = has_next ? (const char*)g.Bt + (size_t)nxt.pn * tstep : cB;
        for (int t = 0; t < nt; t += 2) {
            const bool last = (t == nt - 2);
            const char* a1 = cA + (size_t)(t + 1) * kstep;
            const char* a2 = last ? nA : cA + (size_t)(t + 2) * kstep; const char* b2 = last ? nB : cB + (size_t)(t + 2) * kstep;
            const char* a3 = a2 + kstep; const char* b3 = b2 + kstep;
            PG8_LDB(B0, 0, 0); SCHED_BARRIER(); PG8_LDA(At, 0, 0); PG8_STAGE(PG8_SA(1, 1), a1 + hstep, voffA);
            ASM_WAIT_L(8); PG8_BAR; ASM_WAIT_L(0); PG8_MMA(0, 0, At, B0); PG8_BAR; SCHED_BARRIER();
            PG8_LDB(B1, 0, 1); PG8_STAGE(PG8_SB(0, 0), b2, voffB);
            PG8_BAR; ASM_WAIT_L(0); PG8_MMA(0, 1, At, B1); PG8_BAR;
            PG8_LDA(At, 0, 1); PG8_STAGE(PG8_SA(0, 0), a2, voffA);
            PG8_BAR; ASM_WAIT_L(0); PG8_MMA(1, 0, At, B0); PG8_BAR; SCHED_BARRIER();
            PG8_STAGE(PG8_SB(0, 1), b2 + hstep, voffB);
            ASM_WAIT_V(6); PG8_BAR; PG8_MMA(1, 1, At, B1); PG8_BAR;
            PG8_LDB(B0, 1, 0); SCHED_BARRIER(); PG8_LDA(At, 1, 0); PG8_STAGE(PG8_SA(0, 1), a2 + hstep, voffA);
            ASM_WAIT_L(8); PG8_BAR; ASM_WAIT_L(0); PG8_MMA(0, 0, At, B0); PG8_BAR; SCHED_BARRIER();
            PG8_LDB(B1, 1, 1); PG8_STAGE(PG8_SB(1, 0), b3, voffB);
            PG8_BAR; ASM_WAIT_L(0); PG8_MMA(0, 1, At, B1); PG8_BAR;
            PG8_LDA(At, 1, 1); PG8_STAGE(PG8_SA(1, 0), a3, voffA);
            PG8_BAR; ASM_WAIT_L(0); PG8_MMA(1, 0, At, B0); PG8_BAR; SCHED_BARRIER();
            PG8_STAGE(PG8_SB(1, 1), b3 + hstep, voffB);
            ASM_WAIT_V(6); PG8_BAR; PG8_MMA(1, 1, At, B1); PG8_BAR;
        }
        E(acc, cur, wr, wc, fr, fq);
        if (!has_next) break;
#pragma unroll
        for (int a = 0; a < 2; ++a)
#pragma unroll
            for (int b = 0; b < 2; ++b)
#pragma unroll
                for (int m = 0; m < 4; ++m)
#pragma unroll
                    for (int n = 0; n < 2; ++n) acc[a][b][m][n] = (f32x4){0.f, 0.f, 0.f, 0.f};
        cur = nxt; cA = nA; cB = nB; ++ui;
    }
    ASM_WAIT_V(0);
    if (wr == 0) PG8_BAR;
    PG8_BAR;
#undef PG8_SA
#undef PG8_SB
#undef PG8_STAGE
#undef PG8_LDA
#undef PG8_LDB
#undef PG8_MMA
#undef PG8_BAR
}
}

struct Args { const float* in[N_IN]; float* out; unsigned char* ws; int ph_lo, ph_hi; };
constexpr int NWAVES = 8, NTHR = 512;
constexpr int LDS_STAGE = 131072, LDS_MISC = LDS_STAGE, LDS_BYTES = 147456;

constexpr int PT_OUT = N_IN, PT_WS = N_IN + 1, PT_WORD0 = 128;
struct Ctx {
    LAS unsigned char* lds; int tid, lane, wave, G, bid;
    __device__ __forceinline__ unsigned long long ptr(int i) const { const volatile LAS unsigned* t = (const volatile LAS unsigned*)(lds + LDS_MISC) + PT_WORD0 + 2 * i;
        const unsigned lo = (unsigned)READFIRSTLANE((int)t[0]), hi = (unsigned)READFIRSTLANE((int)t[1]); return ((unsigned long long)hi << 32) | lo; }
    __device__ __forceinline__ unsigned long long ptrv(int i) const { const volatile LAS unsigned* t = (const volatile LAS unsigned*)(lds + LDS_MISC) + PT_WORD0 + 2 * i; return ((unsigned long long)t[1] << 32) | t[0]; }
    __device__ __forceinline__ const float* inv(int i) const { return (const float*)ptrv(i); }
    template <class T> __device__ __forceinline__ T* wsv(size_t off) const { return (T*)((unsigned char*)ptrv(PT_WS) + off); }
    __device__ __forceinline__ const float* in(int i) const { return (const float*)ptr(i); }
    __device__ __forceinline__ float* out() const { return (float*)ptr(PT_OUT); }
    template <class T> __device__ __forceinline__ T* ws(size_t off) const { return (T*)((unsigned char*)ptr(PT_WS) + off); }
    __device__ __forceinline__ unsigned* ctl() const { return (unsigned*)ptr(PT_WS); }
};

__device__ __forceinline__ void transpose_item(const float* W, int ldw, int k0, int n0, int nvalid, bf16* outp, int ldo, LAS float* scr, int lane) {
#pragma unroll
    for (int i = 0; i < 32; ++i) { const int kk = 2 * i + (lane >> 5), n = n0 + (lane & 31); scr[kk * 33 + (lane & 31)] = (n < nvalid) ? W[(size_t)(k0 + kk) * ldw + n] : 0.f; }
    WAVE_LDS_FENCE(); CFENCE();
    const int c = lane & 7;
#pragma unroll
    for (int j = 0; j < 4; ++j) { const int n = (lane >> 3) + 8 * j; const LAS float* s = scr + (8 * c) * 33 + n;
        u32x4 o; o[0] = pk2(s[0 * 33], s[1 * 33]); o[1] = pk2(s[2 * 33], s[3 * 33]); o[2] = pk2(s[4 * 33], s[5 * 33]); o[3] = pk2(s[6 * 33], s[7 * 33]);
        *(u32x4*)(outp + (size_t)n * ldo + k0 + 8 * c) = o; }
    WAVE_LDS_FENCE(); CFENCE();
}
__device__ __forceinline__ void filter_item(const Ctx& X, int l, int n, int pos0, float* out  , LAS float* scr  , LAS float* asum  ) {
    const int lane = X.lane;
    LAS float* zs = scr; LAS float* ha = scr + 8 * 33; LAS float* hb = ha + 8 * 64;
    const float* w1 = X.in(I_FW1) + (size_t)l * 33 * 64; const float* b1 = X.in(I_FB1) + l * 64;
    const float* w2 = X.in(I_FW2) + (size_t)l * 64 * 64; const float* b2 = X.in(I_FB2) + l * 64;
    const float* w3 = X.in(I_FW3) + (size_t)l * 64 * 64; const float* b3 = X.in(I_FB3) + l * 64;
    const float* wo = X.in(I_FWO) + (size_t)l * 64 * HW; const float fr = X.in(I_FREQ)[l * 64 + lane];
    if (lane < 33) {
#pragma unroll
        for (int p = 0; p < 8; ++p) { const int pos = pos0 + p; float v;
            if (lane == 0) v = (float)pos / (float)(n - 1 > 1 ? n - 1 : 1);
            else { const int b = (lane - 1) & 15; const double band = 1e-4 + (double)b * ((15.0 - 1e-4) / 15.0);
                double rev = (double)pos * band / (double)n; rev -= floor(rev); if (rev > 0.5) rev -= 1.0;
                float s, c; sincos_f((float)(rev * 6.283185307179586476925), s, c); v = lane <= 16 ? c : -s; }
            zs[p * 33 + lane] = v; }
    }
    WAVE_LDS_FENCE(); CFENCE();
    float acc[8];
    { const float bb = b1[lane];
#pragma unroll
      for (int p = 0; p < 8; ++p) acc[p] = bb;
#pragma unroll 3
      for (int i = 0; i < 33; ++i) { const float w = w1[i * 64 + lane];
#pragma unroll
          for (int p = 0; p < 8; ++p) acc[p] += zs[p * 33 + i] * w; }
#pragma unroll
      for (int p = 0; p < 8; ++p) ha[p * 64 + lane] = sin_f(fr * acc[p]); }
    WAVE_LDS_FENCE(); CFENCE();
    { const float bb = b2[lane];
#pragma unroll
      for (int p = 0; p < 8; ++p) acc[p] = bb;
#pragma unroll 4
      for (int i = 0; i < 64; ++i) { const float w = w2[i * 64 + lane];
#pragma unroll
          for (int p = 0; p < 8; ++p) acc[p] += ha[p * 64 + i] * w; }
#pragma unroll
      for (int p = 0; p < 8; ++p) hb[p * 64 + lane] = sin_f(fr * acc[p]); }
    WAVE_LDS_FENCE(); CFENCE();
    { const float bb = b3[lane];
#pragma unroll
      for (int p = 0; p < 8; ++p) acc[p] = bb;
#pragma unroll 4
      for (int i = 0; i < 64; ++i) { const float w = w3[i * 64 + lane];
#pragma unroll
          for (int p = 0; p < 8; ++p) acc[p] += hb[p * 64 + i] * w; }
#pragma unroll
      for (int p = 0; p < 8; ++p) ha[p * 64 + lane] = sin_f(fr * acc[p]); }
    WAVE_LDS_FENCE(); CFENCE();
    const float dmin = -3.0701134573253944f, dmax = -15.350567286626972f;
#pragma unroll 1
    for (int mI = 0; mI < HW / 64; ++mI) { const int c = lane + 64 * mI;
#pragma unroll
        for (int p = 0; p < 8; ++p) acc[p] = 0.f;
#pragma unroll 4
        for (int i = 0; i < 64; ++i) { const float w = wo[i * HW + c];
#pragma unroll
            for (int p = 0; p < 8; ++p) acc[p] += ha[p * 64 + i] * w; }
        const float delta = fabsf(dmin + (float)c * ((dmax - dmin) / (float)(HW - 1)));
        float as = 0.f;
#pragma unroll
        for (int p = 0; p < 8; ++p) { const int pos = pos0 + p; const int dd = pos - n / 2; const float dist = (float)(dd < 0 ? -dd : dd) * (2.0f / (float)n);
            const float v = acc[p] * expf(-dist * delta); out[(size_t)c * n + pos] = v; as += fabsf(v); }
        asum[c] += as; }
    WAVE_LDS_FENCE(); CFENCE();
}
__device__ __forceinline__ void phase_transposes(const Ctx& X, int l, int part) {
    LAS float* scr = (LAS float*)(X.lds + X.wave * 16384);
    const bool shifted = part == 1 && X.G > N_SEQ_UNITS; const int myb = shifted ? X.bid - N_SEQ_UNITS : X.bid, nb_ = shifted ? X.G - N_SEQ_UNITS : X.G;
    if (myb < 0) return;
    const int gw = myb * NWAVES + X.wave, NGW = nb_ * NWAVES, lane = X.lane;
    constexpr int KB_D = D / 64, I_WIN_ = KB_D * (PCP / 32), I_WB_ = 2 * (RW / 64) * (D / 32), I_WO_ = KB_D * (D / 32), I_WGU_ = NE * 2 * KB_D * (D / 32), I_WD_ = NE * KB_D * (D / 32);
    constexpr int I_LORA_ = 6 * (RW / 32); constexpr int N0 = I_WIN_ + I_WB_ + I_WO_, NITEMS = N0 + I_WGU_ + I_WD_;
    if (part == 0) for (int it = gw; it < I_LORA_; it += NGW) { const int which = it / (RW / 32), nb = it % (RW / 32);
        const float* W; int k0 = 0, ldo = 64; bf16* outp;
        if (which < 2) { W = X.in(I_W2) + ((size_t)l * 2 + which) * 64 * RW; outp = X.ws<bf16>(WS_W2T) + (size_t)which * RW * 64 + (size_t)(32 * nb) * 64; }
        else if (which < 4) { W = X.in(I_A2) + ((size_t)l * 2 + (which - 2)) * 64 * RW; outp = X.ws<bf16>(WS_A2T) + (size_t)(which - 2) * RW * 64 + (size_t)(32 * nb) * 64; }
        else { W = X.in(I_G2) + (size_t)l * 128 * RW; k0 = 64 * (which - 4); ldo = 128; outp = X.ws<bf16>(WS_G2T) + (size_t)(32 * nb) * 128; }
        transpose_item(W, RW, k0, 32 * nb, RW, outp, ldo, scr, lane); }
    const int it_end = part ? NITEMS : N0; int it = (part ? N0 : 0) + gw;
    const float* W; int ldw, k0, n0, nvalid, ldo; bf16* outp; float v[32];
#define TR_PARAMS(it_) do { int r = (it_); \
        if (r < I_WIN_) { const int nb = r % (PCP / 32), kb = r / (PCP / 32); W = X.in(I_WIN) + (size_t)l * D * PC; ldw = PC; k0 = 64 * kb; n0 = 32 * nb; nvalid = PC; outp = X.ws<bf16>(WS_WIN) + (size_t)n0 * D; ldo = D; } \
        else if ((r -= I_WIN_) < I_WB_) { const int s_ = r / ((RW / 64) * (D / 32)), q = r % ((RW / 64) * (D / 32)), nb = q % (D / 32), kb = q / (D / 32); \
            W = X.in(I_WBR) + ((size_t)l * 2 + s_) * RW * D; ldw = D; k0 = 64 * kb; n0 = 32 * nb; nvalid = D; outp = X.ws<bf16>(WS_WB) + (size_t)s_ * D * RW + (size_t)n0 * RW; ldo = RW; } \
        else if ((r -= I_WB_) < I_WO_) { const int nb = r % (D / 32), kb = r / (D / 32); W = X.in(I_WOUT) + (size_t)l * D * D; ldw = D; k0 = 64 * kb; n0 = 32 * nb; nvalid = D; outp = X.ws<bf16>(WS_WO) + (size_t)n0 * D; ldo = D; } \
        else if ((r -= I_WO_) < I_WGU_) { const int per = KB_D * (D / 32), es = r / per, q = r % per, e = es >> 1, src = es & 1, nb = q % (D / 32), kb = q / (D / 32); n0 = 32 * nb; \
            W = (src ? X.in(I_WU) : X.in(I_WG)) + ((size_t)l * NE + e) * D * D; ldw = D; k0 = 64 * kb; nvalid = D; const int orow = e * 2 * D + (n0 / 128) * 256 + src * 128 + (n0 % 128); \
            outp = X.ws<bf16>(WS_WGU) + (size_t)orow * D; ldo = D; } \
        else { r -= I_WGU_; const int per = KB_D * (D / 32), e = r / per, q = r % per, nb = q % (D / 32), kb = q / (D / 32); \
            W = X.in(I_WD) + ((size_t)l * NE + e) * D * D; ldw = D; k0 = 64 * kb; n0 = 32 * nb; nvalid = D; outp = X.ws<bf16>(WS_WD) + (size_t)(e * D + n0) * D; ldo = D; } } while (0)
#define TR_LOAD() do { const int n = n0 + (lane & 31); const float* wp = W + (size_t)(k0 + (lane >> 5)) * ldw + n; _Pragma("unroll") for (int i = 0; i < 32; ++i) v[i] = (n < nvalid) ? wp[(size_t)(2 * i) * ldw] : 0.f; } while (0)
    if (it < it_end) { TR_PARAMS(it); TR_LOAD(); }
    while (it < it_end) {
#pragma unroll
        for (int i = 0; i < 32; ++i) scr[(2 * i + (lane >> 5)) * 33 + (lane & 31)] = v[i];
        WAVE_LDS_FENCE(); CFENCE();
        bf16* const cout_ = outp; const int ck0 = k0, cldo = ldo;
        it += NGW;
        if (it < it_end) { TR_PARAMS(it); TR_LOAD(); }
        const int c = lane & 7;
#pragma unroll
        for (int j = 0; j < 4; ++j) { const int n = (lane >> 3) + 8 * j; const LAS float* s_ = scr + (8 * c) * 33 + n;
            u32x4 o; o[0] = pk2(s_[0 * 33], s_[1 * 33]); o[1] = pk2(s_[2 * 33], s_[3 * 33]); o[2] = pk2(s_[4 * 33], s_[5 * 33]); o[3] = pk2(s_[6 * 33], s_[7 * 33]);
            *(u32x4*)(cout_ + (size_t)n * cldo + ck0 + 8 * c) = o; }
        WAVE_LDS_FENCE(); CFENCE();
    }
#undef TR_PARAMS
#undef TR_LOAD
}
__device__ __forceinline__ void phase_filters(const Ctx& X, int l) {
    LAS float* scr = (LAS float*)(X.lds + X.wave * 8192);
    const int gw = X.bid * NWAVES + X.wave, NGW = X.G * NWAVES, lane = X.lane;
    LAS float* part = (LAS float*)(X.lds + 65536);
    static_assert(65536 + NWAVES * 2 * HW * 4 <= LDS_STAGE, "filter LDS map");
    for (int i = lane; i < 2 * HW; i += 64) part[X.wave * 2 * HW + i] = 0.f;
    WAVE_LDS_FENCE(); CFENCE();
    float* filt = X.ws<float>(WS_FILT);
    for (int it = gw; it < SEQ / 8; it += NGW) filter_item(X, l, SEQ, 8 * it, filt, scr, part + (X.wave * 2 + 0) * HW);
    for (int it = gw; it < CTX / 8; it += NGW) filter_item(X, l, CTX, 8 * it, filt + (size_t)HW * SEQ, scr, part + (X.wave * 2 + 1) * HW);
    __syncthreads();
    for (int i = X.tid; i < 2 * HW; i += NTHR) { float s = 0.f;
#pragma unroll
        for (int w = 0; w < NWAVES; ++w) s += part[w * 2 * HW + i];
        X.ws<float>(WS_FPART)[((size_t)(i / HW) * NPART + X.bid) * HW + (i % HW)] = s; }
    __syncthreads();
}
__device__ __forceinline__ void phase_mod(const Ctx& X) {
    const int lane = X.lane;
    LAS float* red = (LAS float*)X.lds;
    constexpr int NIT = DEPTH * (6 * D / 64);
    for (int it = X.bid; it < NIT; it += X.G) {
        const int ll = it / (6 * D / 64), n0 = (it % (6 * D / 64)) * 64;
        const float* W = X.in(I_WMOD) + (size_t)ll * D * 6 * D; const float* cv = X.in(I_C); const float* cc = X.in(I_CCTX);
        float s0 = 0.f, s1 = 0.f;
#pragma unroll 8
        for (int k = X.wave * (D / 8); k < (X.wave + 1) * (D / 8); ++k) { const float wv = W[(size_t)k * 6 * D + n0 + lane]; const float c0 = cv[k], c1 = cc[k];
            s0 += c0 * sigmoidf_(c0) * wv; s1 += c1 * sigmoidf_(c1) * wv; }
        red[(X.wave * 64 + lane) * 2] = s0; red[(X.wave * 64 + lane) * 2 + 1] = s1;
        __syncthreads();
        if (X.wave == 0) { float t0 = 0.f, t1 = 0.f;
#pragma unroll
            for (int w = 0; w < NWAVES; ++w) { t0 += red[(w * 64 + lane) * 2]; t1 += red[(w * 64 + lane) * 2 + 1]; }
            const float bm = X.in(I_BMOD)[(size_t)ll * 6 * D + n0 + lane];
            float* MOD = X.ws<float>(WS_MOD);
            MOD[((size_t)ll * 2 + 0) * 6 * D + n0 + lane] = t0 + bm; MOD[((size_t)ll * 2 + 1) * 6 * D + n0 + lane] = t1 + bm; }
        __syncthreads();
    }
}
__device__ __forceinline__ const float* modp(const Ctx& X, int l, int t, int j) { return X.ws<float>(WS_MOD) + ((size_t)l * 2 + (t < CTX ? 1 : 0)) * 6 * D + (size_t)j * D; }

__device__ __forceinline__ void phase_x0(const Ctx& X) {
    const int gw = X.bid * NWAVES + X.wave, NGW = X.G * NWAVES, lane = X.lane;
    for (int t = gw; t < M; t += NGW) {
        const float* src = t < CTX ? X.in(I_CTX) + (size_t)t * D : X.in(I_X) + (size_t)(t - CTX) * D;
        const float* sh = modp(X, 0, t, 0); const float* sc = modp(X, 0, t, 1);
        float* xr = X.ws<float>(WS_X) + (size_t)t * D; bf16* xm = X.ws<bf16>(WS_XMOD) + (size_t)t * D;
#pragma unroll
        for (int j = 0; j < D / 256; ++j) { const int d = 4 * lane + 256 * j; const f32x4 v = *(const f32x4*)(src + d), a = *(const f32x4*)(sh + d), b = *(const f32x4*)(sc + d);
            *(f32x4*)(xr + d) = v;
            unsigned w0 = pk2(v[0] * (1.f + b[0]) + a[0], v[1] * (1.f + b[1]) + a[1]), w1 = pk2(v[2] * (1.f + b[2]) + a[2], v[3] * (1.f + b[3]) + a[3]);
            *(unsigned long long*)(xm + d) = (unsigned long long)w0 | ((unsigned long long)w1 << 32); }
    }
}

__device__ __forceinline__ int shift_row(int t, int col, bool& valid) {
    const bool isctx = t < CTX;
    const int i = t - CTX, gx = i & (GRID_W - 1), gy = i / GRID_W, q = col / QTR;
    const int offl = (q == 0) ? -1 : (q == 1) ? 1 : (q == 2) ? -GRID_W : GRID_W;
    const bool vl = (q == 0) ? (gx > 0) : (q == 1) ? (gx < GRID_W - 1) : (q == 2) ? (gy > 0) : (gy < GRID_H - 1);
    const bool first = col < HALFC;
    const int offc = first ? -1 : 1; const bool vc = first ? (t > 0) : (t < CTX - 1);
    valid = isctx ? vc : vl;
    return valid ? t + (isctx ? offc : offl) : t;
}
__device__ __forceinline__ float pm_val(const bf16* P, const float* mu, int t, int col) {
    const float p0 = bf2f(P[(size_t)t * PCP + col]); bool valid; const int nr = shift_row(t, col, valid);
    const float pn = bf2f(P[(size_t)nr * PCP + col]); const float p1 = valid ? pn : 0.f;
    return p0 + (p1 - p0) * mu[col];
}
constexpr int LP = 72;
constexpr int LQ = 65;
constexpr int LX = 68;
__device__ __forceinline__ f32x4 mm_tile(const LAS bf16* A, const LAS bf16* Bt, int ti, int tj, int lane, f32x4 acc) {
    const LAS bf16* pa = A + (16 * ti + (lane & 15)) * LP + 8 * (lane >> 4); const LAS bf16* pb = Bt + (16 * tj + (lane & 15)) * LP + 8 * (lane >> 4);
#pragma unroll
    for (int kk = 0; kk < 2; ++kk) { const bf16x8 a = *(const LAS bf16x8*)(pa + 32 * kk), b = *(const LAS bf16x8*)(pb + 32 * kk); acc = MFMA16(a, b, acc); }
    return acc;
}
constexpr int TT = 8;
__device__ __forceinline__ void phase_lin(const Ctx& X, int l) {
    const bf16* P = X.ws<bf16>(WS_P); const float* mu = X.in(I_MU) + (size_t)l * RC; bf16* LIN = X.ws<bf16>(WS_LIN);
    for (size_t idx = (size_t)X.bid * NTHR + X.tid; idx < (size_t)M * 384; idx += (size_t)X.G * NTHR) { const int t = (int)(idx / 384), j = (int)(idx % 384);
        float v = pm_val(P, mu, t, C_LWF + j);
        if (j < 128) v = tanhf(v); else if (j >= 256) v = sigmoidf_(v);
        LIN[idx] = (bf16)f2bf(v); }
}
__device__ __forceinline__ f32x4 mm_tile_p(const LAS bf16* A, int lda, const LAS bf16* Bt, int ldb, int ks, int ti, int tj, int lane, f32x4 acc) {
    const LAS bf16* pa = A + (16 * ti + (lane & 15)) * lda + 8 * (lane >> 4); const LAS bf16* pb = Bt + (16 * tj + (lane & 15)) * ldb + 8 * (lane >> 4);
    for (int kk = 0; kk < ks; ++kk) { const bf16x8 a = *(const LAS bf16x8*)(pa + 32 * kk), b = *(const LAS bf16x8*)(pb + 32 * kk); acc = MFMA16(a, b, acc); }
    return acc;
}
constexpr int GP = 136;
__device__ __forceinline__ void lora_unit_a(const Ctx& X, int unit) {
    const int b = unit / NH, h = unit % NH, tid = X.tid, lane = X.lane, w = X.wave;
    LAS bf16* Ab = (LAS bf16*)X.lds; LAS bf16* Gb = Ab + 4 * 64 * LP; LAS bf16* Wb = Gb + 64 * GP; LAS bf16* G2b = Wb + 4 * 64 * LP;
    LAS float* OUT = (LAS float*)X.lds;
    static_assert((8 * 64 * LP + 2 * 64 * GP) * 2 <= LDS_STAGE && 5 * 64 * LQ * 4 <= LDS_STAGE, "lora LDS map");
    const bf16* LIN = X.wsv<bf16>(WS_LIN) + (size_t)(64 * b) * 384;
    for (int i = tid; i < 64 * 48; i += NTHR) { const int t = i / 48, c16 = i % 48; const u32x4 v = *(const u32x4*)(LIN + (size_t)t * 384 + 8 * c16);
        if (c16 < 32) *(LAS u32x4*)(Ab + (c16 >> 3) * 64 * LP + t * LP + 8 * (c16 & 7)) = v; else *(LAS u32x4*)(Gb + t * GP + 8 * (c16 - 32)) = v; }
    const bf16* w2t = X.wsv<bf16>(WS_W2T) + (size_t)(64 * h) * 64; const bf16* a2t = X.wsv<bf16>(WS_A2T) + (size_t)(64 * h) * 64; const bf16* g2t = X.wsv<bf16>(WS_G2T) + (size_t)(64 * h) * 128;
    for (int i = tid; i < 4 * 64 * 8; i += NTHR) { const int q = i / 512, c = (i / 8) % 64, c16 = i % 8; const bf16* src = (q < 2 ? w2t + (size_t)q * RW * 64 : a2t + (size_t)(q - 2) * RW * 64) + c * 64 + 8 * c16;
        *(LAS u32x4*)(Wb + q * 64 * LP + c * LP + 8 * c16) = *(const u32x4*)src; }
    for (int i = tid; i < 64 * 16; i += NTHR) { const int c = i / 16, c16 = i % 16; *(LAS u32x4*)(G2b + c * GP + 8 * c16) = *(const u32x4*)(g2t + c * 128 + 8 * c16); }
    __syncthreads();
    f32x4 o[2][5];
#pragma unroll
    for (int q = 0; q < 2; ++q) { const int tile = 2 * w + q, ti = tile >> 2, tj = tile & 3; const f32x4 z4 = {0.f, 0.f, 0.f, 0.f};
#pragma unroll
        for (int p = 0; p < 4; ++p) o[q][p] = mm_tile(Ab + p * 64 * LP, Wb + p * 64 * LP, ti, tj, lane, z4);
        o[q][4] = mm_tile_p(Gb, GP, G2b, GP, 4, ti, tj, lane, z4); }
    __syncthreads();
#pragma unroll
    for (int q = 0; q < 2; ++q) { const int tile = 2 * w + q, ti = tile >> 2, tj = tile & 3, col = 16 * tj + (lane & 15);
#pragma unroll
        for (int p = 0; p < 5; ++p)
#pragma unroll
            for (int r = 0; r < 4; ++r) OUT[(p * 64 + 16 * ti + 4 * (lane >> 4) + r) * LQ + col] = o[q][p][r]; }
    __syncthreads();
}
__device__ __forceinline__ void lora_unit_b(const Ctx& X, int l, int unit) {
    const int b = unit / NH, h = unit % NH, w = X.wave, k = X.lane, c = 64 * h + k;
    const LAS float* OUT = (const LAS float*)X.lds;
    const bf16* P = X.wsv<bf16>(WS_P); const float* mu = X.inv(I_MU) + (size_t)l * RC;
    const float w00 = X.inv(I_W0)[(size_t)(l * 2 + 0) * RW + c], w01 = X.inv(I_W0)[(size_t)(l * 2 + 1) * RW + c];
    const float a00 = X.inv(I_A0)[(size_t)(l * 2 + 0) * RW + c], a01 = X.inv(I_A0)[(size_t)(l * 2 + 1) * RW + c];
    const float kkc = X.inv(I_KK)[(size_t)l * RW + c], kac = X.inv(I_KA)[(size_t)l * RW + c], rkc = X.inv(I_RK)[(size_t)l * RW + c];
    bf16* pR = X.wsv<bf16>(WS_R); bf16* pV = X.wsv<bf16>(WS_V); bf16* pKA = X.wsv<bf16>(WS_KA); bf16* pKD = X.wsv<bf16>(WS_KD); bf16* pKB = X.wsv<bf16>(WS_KB); float* pW = X.wsv<float>(WS_W); bf16* pG = X.wsv<bf16>(WS_GATE); float* pBo = X.wsv<float>(WS_BONUS);
    const int vz = vgpr_zero();
#pragma unroll
    for (int i = 0; i < 8; ++i) { const int tl = 8 * w + i, t = 64 * b + tl + vz;
        const float r = pm_val(P, mu, t, c), kx = pm_val(P, mu, t, C_K + c), v = pm_val(P, mu, t, C_V + c);
        const float wd0 = -DECAY_SCALE * sigmoidf_(w00 + OUT[(0 * 64 + tl) * LQ + k]), wd1 = -DECAY_SCALE * sigmoidf_(w01 + OUT[(1 * 64 + tl) * LQ + k]);
        const float ad0 = sigmoidf_(a00 + OUT[(2 * 64 + tl) * LQ + k]), ad1 = sigmoidf_(a01 + OUT[(3 * 64 + tl) * LQ + k]);
        const float kkr = kx * kkc; const float n2 = wave_sum(kkr * kkr); const float kk = kkr / fmaxf(sqrtf(n2), 1e-12f);
        const float kd0 = kx * (1.f + (ad0 - 1.f) * kac), kd1 = kx * (1.f + (ad1 - 1.f) * kac);
        const float bon = wave_sum(r * (kd0 + kd1) * rkc);
        const size_t o = (size_t)t * RW + c, o1 = (size_t)(M + t) * RW + c;
        pR[o] = (bf16)f2bf(r); pV[o] = (bf16)f2bf(v); pKA[o] = (bf16)f2bf(-kk);
        pKD[o] = (bf16)f2bf(kd0); pKD[o1] = (bf16)f2bf(kd1); pKB[o] = (bf16)f2bf(kk * ad0); pKB[o1] = (bf16)f2bf(kk * ad1);
        pW[o] = wd0; pW[o1] = wd1; pG[o] = (bf16)f2bf(OUT[(4 * 64 + tl) * LQ + k]);
        if (k == 0) pBo[(size_t)t * NH + h] = bon; }
    __syncthreads();
}
__device__ __forceinline__ void phase_prep_hyena(const Ctx& X, int l) {
    const bf16* P = X.ws<bf16>(WS_P); const int c = X.tid;
    if (c < HW) {
        const float* cw = X.in(I_CW) + (size_t)l * 3 * HC; const float* cb = X.in(I_CB) + (size_t)l * HC;
        float cw0[3], cw1[3], cw2[3], cbv[3];
#pragma unroll
        for (int j = 0; j < 3; ++j) { const int hc = j * HW + c; cw0[j] = cw[hc]; cw1[j] = cw[HC + hc]; cw2[j] = cw[2 * HC + hc]; cbv[j] = cb[hc]; }
        float* ZT = X.ws<float>(WS_ZT) + (size_t)c * M; float* Zc = X.ws<float>(WS_Z); bf16* X0 = X.ws<bf16>(WS_X0);
        for (int tile = X.bid; tile < M / TT; tile += X.G) { const int t0 = tile * TT; float zz[TT];
#pragma unroll
            for (int tt = 0; tt < TT; ++tt) { const int t = t0 + tt; const bool hp = (t != 0 && t != CTX), hn = (t != CTX - 1 && t != M - 1);
                float u[3];
#pragma unroll
                for (int j = 0; j < 3; ++j) { const int col = C_HY + j * HW + c;
                    const float pc = bf2f(P[(size_t)t * PCP + col]), pp = hp ? bf2f(P[(size_t)(t - 1) * PCP + col]) : 0.f, pn = hn ? bf2f(P[(size_t)(t + 1) * PCP + col]) : 0.f;
                    u[j] = pp * cw0[j] + pc * cw1[j] + pn * cw2[j] + cbv[j]; }
                zz[tt] = u[2] * u[1]; if (t < CTX) Zc[(size_t)t * HW + c] = zz[tt];
                X0[(size_t)t * HW + c] = (bf16)f2bf(u[0]); }
            *(f32x4*)(ZT + t0) = (f32x4){zz[0], zz[1], zz[2], zz[3]}; *(f32x4*)(ZT + t0 + 4) = (f32x4){zz[4], zz[5], zz[6], zz[7]}; }
    }
}

constexpr int CC = 64, NCHK = M / CC;
static_assert(CTX % CC == 0 && SEQ % CC == 0, "chunks must not straddle the context/latent boundary");
__device__ __forceinline__ int scan_row(int d, int s) { return d == 0 ? s : (s < CTX ? CTX - 1 - s : M - 1 - (s - CTX)); }
__device__ __forceinline__ void chunk_unit_1(const Ctx& X, int unit) {
    const int d = unit / (NCHK * NH), c = (unit / NH) % NCHK, h = unit % NH;
    LAS bf16* An = (LAS bf16*)X.lds;            LAS bf16* Bn = An + 64 * LP; LAS bf16* Kn = Bn + 64 * LP; LAS bf16* Rn = Kn + 64 * LP; LAS bf16* Vt = Rn + 64 * LP;
    LAS bf16* Bh = Vt + 64 * LP;                LAS bf16* Kh = Bh + 64 * LP; LAS bf16* Lak = Kh + 64 * LP; LAS bf16* Mrb = Lak + 64 * LP; LAS bf16* Mrk = Mrb + 64 * LP;
    LAS float* Lab = (LAS float*)(Mrk + 64 * LP); LAS float* XsW = Lab + 64 * LX;
    LAS float* XsU = (LAS float*)An;
    LAS bf16* Wt = Lak; LAS bf16* Ut = (LAS bf16*)((LAS unsigned char*)An + 64 * LX * 4);
    LAS float* tot = Lab;
    LAS float* dC = (LAS float*)(X.lds + LDS_MISC + 1024);
    static_assert(10 * 64 * LP * 2 + 2 * 64 * LX * 4 <= LDS_STAGE && 64 * LX * 4 + 64 * LP * 2 <= 3 * 64 * LP * 2, "chunk LDS map");
    const int tid = X.tid, lane = X.lane, w = X.wave, k = tid & 63;
    float lw[8], cum[8];
    { float run = 0.f; const float* pW = X.wsv<float>(WS_W);
#pragma unroll
      for (int i = 0; i < 8; ++i) { const int row = scan_row(d, c * CC + 8 * w + i); lw[i] = pW[((size_t)d * M + row) * RW + h * 64 + k]; }
#pragma unroll
      for (int i = 0; i < 8; ++i) { run += lw[i]; cum[i] = run; }
      tot[w * 64 + k] = run; }
    __syncthreads();
    float off = 0.f, cumC = 0.f;
#pragma unroll
    for (int ww = 0; ww < 8; ++ww) { const float t = tot[ww * 64 + k]; off += (ww < w) ? t : 0.f; cumC += t; }
    __syncthreads();
    { unsigned pv[4], pbh[4], pkh[4]; float af[8];
      const bf16* pR = X.wsv<bf16>(WS_R); const bf16* pV = X.wsv<bf16>(WS_V); const bf16* pKA = X.wsv<bf16>(WS_KA); const bf16* pKD = X.wsv<bf16>(WS_KD); const bf16* pKB = X.wsv<bf16>(WS_KB);
#pragma unroll
      for (int i = 0; i < 8; ++i) { const int t = 8 * w + i; const int row = scan_row(d, c * CC + t); const size_t o = (size_t)row * RW + h * 64 + k, od = ((size_t)d * M + row) * RW + h * 64 + k;
          const float ct = off + cum[i], cp = ct - lw[i];
          const float r = bf2f(pR[o]), v = bf2f(pV[o]), ka = bf2f(pKA[o]), kd = bf2f(pKD[od]), kb = bf2f(pKB[od]);
          const float ei = expf(-ct), eh = expf(cumC - ct);
          const float at = ka * expf(cp); af[i] = at;
          An[t * LP + k] = (bf16)f2bf(at); Bn[t * LP + k] = (bf16)f2bf(kb * ei); Kn[t * LP + k] = (bf16)f2bf(kd * ei); Rn[t * LP + k] = (bf16)f2bf(r * expf(ct));
          const unsigned bv = f2bf(v), bb = f2bf(kb * eh), bk = f2bf(kd * eh);
          if (i & 1) { pv[i >> 1] |= bv << 16; pbh[i >> 1] |= bb << 16; pkh[i >> 1] |= bk << 16; } else { pv[i >> 1] = bv; pbh[i >> 1] = bb; pkh[i >> 1] = bk; } }
      *(LAS u32x4*)(Vt + k * LP + 8 * w) = (u32x4){pv[0], pv[1], pv[2], pv[3]}; *(LAS u32x4*)(Bh + k * LP + 8 * w) = (u32x4){pbh[0], pbh[1], pbh[2], pbh[3]}; *(LAS u32x4*)(Kh + k * LP + 8 * w) = (u32x4){pkh[0], pkh[1], pkh[2], pkh[3]};
      *(LAS f32x4*)(XsW + k * LX + 8 * w) = (f32x4){af[0], af[1], af[2], af[3]}; *(LAS f32x4*)(XsW + k * LX + 8 * w + 4) = (f32x4){af[4], af[5], af[6], af[7]}; }
    if (tid < 64) dC[tid] = expf(cumC);
    __syncthreads();
#pragma unroll 1
    for (int q = 0; q < 2; ++q) { const int tile = 2 * w + q, ti = tile >> 2, tj = tile & 3; const f32x4 z4 = {0.f, 0.f, 0.f, 0.f};
        const f32x4 ab = mm_tile(An, Bn, ti, tj, lane, z4), ak = mm_tile(An, Kn, ti, tj, lane, z4), rb = mm_tile(Rn, Bn, ti, tj, lane, z4), rk = mm_tile(Rn, Kn, ti, tj, lane, z4);
        const int col = 16 * tj + (lane & 15);
#pragma unroll
        for (int r = 0; r < 4; ++r) { const int row = 16 * ti + 4 * (lane >> 4) + r; const bool lo = col < row, le = col <= row;
            Lab[row * LX + col] = lo ? ab[r] : 0.f; Lak[row * LP + col] = (bf16)f2bf(lo ? ak[r] : 0.f); Mrb[row * LP + col] = (bf16)f2bf(le ? rb[r] : 0.f); Mrk[row * LP + col] = (bf16)f2bf(le ? rk[r] : 0.f); } }
    __syncthreads();
}
__device__ __forceinline__ void chunk_unit_2(const Ctx& X, int unit) {
    const int d = unit / (NCHK * NH), c = (unit / NH) % NCHK, h = unit % NH;
    LAS bf16* An = (LAS bf16*)X.lds;            LAS bf16* Bn = An + 64 * LP; LAS bf16* Kn = Bn + 64 * LP; LAS bf16* Rn = Kn + 64 * LP; LAS bf16* Vt = Rn + 64 * LP;
    LAS bf16* Bh = Vt + 64 * LP;                LAS bf16* Kh = Bh + 64 * LP; LAS bf16* Lak = Kh + 64 * LP; LAS bf16* Mrb = Lak + 64 * LP; LAS bf16* Mrk = Mrb + 64 * LP;
    LAS float* Lab = (LAS float*)(Mrk + 64 * LP); LAS float* XsW = Lab + 64 * LX;
    LAS float* XsU = (LAS float*)An;
    LAS bf16* Wt = Lak; LAS bf16* Ut = (LAS bf16*)((LAS unsigned char*)An + 64 * LX * 4);
    LAS float* tot = Lab;
    LAS float* dC = (LAS float*)(X.lds + LDS_MISC + 1024);
    static_assert(10 * 64 * LP * 2 + 2 * 64 * LX * 4 <= LDS_STAGE && 64 * LX * 4 + 64 * LP * 2 <= 3 * 64 * LP * 2, "chunk LDS map");
    const int tid = X.tid, lane = X.lane, w = X.wave, k = tid & 63;
    f32x4 r2[2]; int r2col[2], r2row[2];
#pragma unroll
    for (int q = 0; q < 2; ++q) { const int tile = 2 * w + q, ti = tile >> 2, tj = tile & 3; const f32x4 z4 = {0.f, 0.f, 0.f, 0.f};
        const f32x4 a = mm_tile(Lak, Vt, ti, tj, lane, z4); const int col = 16 * tj + (lane & 15);
        r2[q] = a; r2col[q] = col; r2row[q] = 16 * ti + 4 * (lane >> 4); }
    __syncthreads();
#pragma unroll
    for (int q = 0; q < 2; ++q) *(LAS f32x4*)(XsU + r2col[q] * LX + r2row[q]) = r2[q];
    __syncthreads();
    if (tid < 128) { const int j = tid & 63; const bool isu = tid >= 64; LAS float* xs = (isu ? XsU : XsW) + j * LX; LAS bf16* dst = (isu ? Ut : Wt) + j * LP;
#pragma unroll 1
        for (int p = 0; p < 8; ++p) { const int t0 = 8 * p; f32x4 acc[8];
#pragma unroll
            for (int i = 0; i < 8; ++i) acc[i] = (f32x4){0.f, 0.f, 0.f, 0.f};
#pragma unroll 1
            for (int q = 0; q < 2 * p; ++q) { const f32x4 xq = *(const LAS f32x4*)(xs + 4 * q);
#pragma unroll
                for (int i = 0; i < 8; ++i) acc[i] += *(const LAS f32x4*)(Lab + (t0 + i) * LX + 4 * q) * xq; }
            f32x4 xp[2];
#pragma unroll
            for (int qq = 0; qq < 2; ++qq) xp[qq] = *(const LAS f32x4*)(xs + t0 + 4 * qq);
#pragma unroll
            for (int i = 0; i < 8; ++i) { f32x4 a = acc[i];
#pragma unroll
                for (int qq = 0; qq < (i + 3) / 4; ++qq) a += *(const LAS f32x4*)(Lab + (t0 + i) * LX + t0 + 4 * qq) * xp[qq];
                xp[i >> 2][i & 3] += (a[0] + a[1]) + (a[2] + a[3]); }
#pragma unroll
            for (int qq = 0; qq < 2; ++qq) { *(LAS f32x4*)(xs + t0 + 4 * qq) = xp[qq];
                *(LAS unsigned*)(dst + t0 + 4 * qq) = pk2(xp[qq][0], xp[qq][1]); *(LAS unsigned*)(dst + t0 + 4 * qq + 2) = pk2(xp[qq][2], xp[qq][3]); } } }
    __syncthreads();
}
__device__ __forceinline__ void chunk_unit_3(const Ctx& X, int unit) {
    const int d = unit / (NCHK * NH), c = (unit / NH) % NCHK, h = unit % NH;
    LAS bf16* An = (LAS bf16*)X.lds;            LAS bf16* Bn = An + 64 * LP; LAS bf16* Kn = Bn + 64 * LP; LAS bf16* Rn = Kn + 64 * LP; LAS bf16* Vt = Rn + 64 * LP;
    LAS bf16* Bh = Vt + 64 * LP;                LAS bf16* Kh = Bh + 64 * LP; LAS bf16* Lak = Kh + 64 * LP; LAS bf16* Mrb = Lak + 64 * LP; LAS bf16* Mrk = Mrb + 64 * LP;
    LAS float* Lab = (LAS float*)(Mrk + 64 * LP); LAS float* XsW = Lab + 64 * LX;
    LAS float* XsU = (LAS float*)An;
    LAS bf16* Wt = Lak; LAS bf16* Ut = (LAS bf16*)((LAS unsigned char*)An + 64 * LX * 4);
    LAS float* tot = Lab;
    LAS float* dC = (LAS float*)(X.lds + LDS_MISC + 1024);
    static_assert(10 * 64 * LP * 2 + 2 * 64 * LX * 4 <= LDS_STAGE && 64 * LX * 4 + 64 * LP * 2 <= 3 * 64 * LP * 2, "chunk LDS map");
    const int tid = X.tid, lane = X.lane, w = X.wave, k = tid & 63;
    const float dCk = dC[k];
    const size_t ubase = ((size_t)(d * NH + h) * NCHK + c);
    float* Pg = X.wsv<float>(WS_PQ) + ubase * 2 * 4096; float* Qg = Pg + 4096; bf16* Gg = X.wsv<bf16>(WS_G) + ubase * 4096; float* Yg = X.wsv<float>(WS_YL) + ubase * 4096;
#pragma unroll 1
    for (int q = 0; q < 2; ++q) { const int tile = 2 * w + q, ti = tile >> 2, tj = tile & 3; const f32x4 z4 = {0.f, 0.f, 0.f, 0.f};
        const f32x4 p = mm_tile(Wt, Bh, ti, tj, lane, z4); f32x4 qq = mm_tile(Ut, Bh, ti, tj, lane, z4); qq = mm_tile(Vt, Kh, ti, tj, lane, qq);
        const f32x4 g = mm_tile(Mrb, Wt, ti, tj, lane, z4); f32x4 y = mm_tile(Mrb, Ut, ti, tj, lane, z4); y = mm_tile(Mrk, Vt, ti, tj, lane, y);
        const int col = 16 * tj + (lane & 15); const float dcol = __shfl(dCk, col);
#pragma unroll
        for (int r = 0; r < 4; ++r) { const int row = 16 * ti + 4 * (lane >> 4) + r;
            Pg[row * 64 + col] = p[r] + (row == col ? dcol : 0.f); Qg[row * 64 + col] = qq[r];
            const int orow = d ? 63 - row : row;
            Gg[orow * 64 + col] = (bf16)f2bf(g[r] + bf2f(Rn[row * LP + col])); Yg[orow * 64 + col] = y[r]; } }
    __syncthreads();
}
__device__ __forceinline__ void seq_unit(const Ctx& X, int su) {
    const int d = su / (NH * 4), h = (su / 4) % NH, qv = su & 3;
    constexpr int PD = 4, RING = PD + 1, SLOT = 4096 + 1024;
    LAS float* ring = (LAS float*)X.lds;
    LAS float* S = ring + RING * SLOT;
    LAS float* part = S + 16 * LQ;
    static_assert((RING * SLOT + 16 * LQ + 4 * 16 * 17) * 4 <= LDS_STAGE, "seq LDS map");
    const int lane = X.lane, w = X.wave, tj = w & 3, kh = w >> 2, col = 16 * tj + (lane & 15), kq = lane >> 4;
    const float* PQ = X.ws<float>(WS_PQ) + (size_t)(d * NH + h) * NCHK * 2 * 4096; bf16* S0g = X.ws<bf16>(WS_S0) + (size_t)(d * NH + h) * NCHK * 4096 + (size_t)(16 * qv) * 64;
#define SEQ_FILL(c_) do { const float* p_ = PQ + (size_t)(c_) * 2 * 4096; LAS float* sl_ = ring + ((c_) % RING) * SLOT; \
        GLDS16(p_ + 4 * (w * 64 + lane), sl_ + 4 * (w * 64)); GLDS16(p_ + 4 * (512 + w * 64 + lane), sl_ + 4 * (512 + w * 64)); \
        GLDS16(p_ + 4096 + (16 * qv) * 64 + 4 * ((w & 3) * 64 + lane), sl_ + 4096 + 4 * ((w & 3) * 64)); } while (0)
#pragma unroll
    for (int i = 0; i < PD; ++i) if (i < NCHK) SEQ_FILL(i);
    for (int i = X.tid; i < 16 * LQ; i += NTHR) S[i] = 0.f;
    if (kh == 0) {
#pragma unroll
        for (int r = 0; r < 4; ++r) S0g[(4 * kq + r) * 64 + col] = (bf16)0; }
    for (int c = 0; c < NCHK; ++c) {
        if (c + PD - 1 < NCHK) { if (kh == 0) { ASM_WAIT_V(21); } else { ASM_WAIT_V(9); } } else { ASM_WAIT_V(0); }
        ASM_WAIT_L(0); S_BARRIER(); CFENCE();
        if (c + PD < NCHK) SEQ_FILL(c + PD);
        const LAS float* P = ring + (c % RING) * SLOT; const LAS float* Q = P + 4096;
        f32x4 acc0 = {0.f, 0.f, 0.f, 0.f}, acc1 = {0.f, 0.f, 0.f, 0.f};
#pragma unroll
        for (int s2 = 0; s2 < 8; s2 += 2) { const int k0 = 32 * kh + 4 * s2 + kq;
            acc0 = MFMA4F(S[(lane & 15) * LQ + k0], P[k0 * 64 + col], acc0); acc1 = MFMA4F(S[(lane & 15) * LQ + k0 + 4], P[(k0 + 4) * 64 + col], acc1); }
        acc0 += acc1;
        if (kh == 1) {
#pragma unroll
            for (int r = 0; r < 4; ++r) part[(tj * 16 + 4 * kq + r) * 17 + (lane & 15)] = acc0[r]; }
        ASM_WAIT_L(0); S_BARRIER(); CFENCE();
        if (kh == 0) {
#pragma unroll
            for (int r = 0; r < 4; ++r) { const float sn = acc0[r] + part[(tj * 16 + 4 * kq + r) * 17 + (lane & 15)] + Q[(4 * kq + r) * 64 + col];
                S[(4 * kq + r) * LQ + col] = sn; if (c + 1 < NCHK) S0g[(size_t)(c + 1) * 4096 + (4 * kq + r) * 64 + col] = (bf16)f2bf(sn); } }
    }
    ASM_WAIT_V(0);
    __syncthreads();
#undef SEQ_FILL
}
constexpr int CR = 16;
__device__ __forceinline__ void conv_item(const Ctx& X, int item) {
    constexpr int NCG = HW / 64; constexpr int n = CTX;
    const int cg = item % NCG, ob = item / NCG, i0 = CR * ob, c = cg * 64 + X.lane;
    const float* F = X.ws<float>(WS_FILT) + (size_t)HW * SEQ + (size_t)c * CTX; const float* Z = X.ws<float>(WS_Z) + c;
    const float* fp = X.ws<float>(WS_FPART) + (size_t)NPART * HW + c;
    float nsum = 0.f; for (int b = 0; b < NPART; ++b) nsum += fp[(size_t)b * HW];
    float acc[CR], Q[CR];
#pragma unroll
    for (int r = 0; r < CR; ++r) acc[r] = 0.f;
    int jb = i0 - n / 2; if (jb < 0) jb = 0;
    int jend = i0 + n / 2 + CR; if (jend > n) jend = n;
    int Tb = i0 - jb + n / 2;
#pragma unroll
    for (int x = 1; x < CR; ++x) { const int T = Tb + x; Q[x] = (T >= 0 && T < n) ? F[T] : 0.f; }
    Q[0] = 0.f;
    for (; jb < jend; jb += CR, Tb -= CR) {
#pragma unroll
        for (int s = 0; s < CR; ++s) { const int T = Tb - s, j = jb + s;
            if ((s & 3) == 0) CFENCE();
            Q[(CR - s) & (CR - 1)] = (T >= 0 && T < n) ? F[T] : 0.f;
            const float zj = (j < n) ? Z[(size_t)j * HW] : 0.f;
#pragma unroll
            for (int r = 0; r < CR; ++r) acc[r] += Q[(r - s + CR) & (CR - 1)] * zj; }
    }
    const float inv = 1.0f / nsum; float* O = X.ws<float>(WS_CONV) + c;
#pragma unroll
    for (int r = 0; r < CR; ++r) O[(size_t)(i0 + r) * HW] = acc[r] * inv;
}

#ifdef EMU
struct cf { float x, y; };
#else
typedef float cf __attribute__((ext_vector_type(2)));
#endif
__device__ __forceinline__ cf cmul(cf a, cf b) { return cf{a.x * b.x - a.y * b.y, a.x * b.y + a.y * b.x}; }
__device__ __forceinline__ cf cadd(cf a, cf b) { return cf{a.x + b.x, a.y + b.y}; }
__device__ __forceinline__ cf csub(cf a, cf b) { return cf{a.x - b.x, a.y - b.y}; }
__device__ __forceinline__ cf cconj(cf a) { return cf{a.x, -a.y}; }
constexpr int FN = SEQ;
constexpr int flog4(int n) { return n <= 1 ? 0 : 1 + flog4(n / 4); }
constexpr int FLOG4 = flog4(FN), FSQ = 1 << FLOG4;
static_assert((1 << (2 * FLOG4)) == FN && FN * 8 <= LDS_STAGE, "FFT length must be a power of 4 that fits the LDS stage region");
constexpr int FFT_TAB_OFF = LDS_MISC + 2048;
static_assert(FFT_TAB_OFF + 2 * FSQ * 8 <= LDS_BYTES, "FFT twiddle tables");
__device__ __forceinline__ void fft_tables(const Ctx& X) {
    LAS cf* T = (LAS cf*)(X.lds + FFT_TAB_OFF);
    for (int i = X.tid; i < 2 * FSQ; i += NTHR) { const int k = i < FSQ ? i * FSQ : i - FSQ; float s, c; sincos_f(-6.283185307179586f * (float)k / (float)FN, s, c); T[i] = cf{c, s}; }
    __syncthreads();
}
__device__ __forceinline__ cf fft_tw(const LAS cf* T, int k) { const cf a = T[k >> FLOG4], b = T[FSQ + (k & (FSQ - 1))]; return cmul(a, b); }
__device__ __forceinline__ int rev4(int k) { int r = 0;
#pragma unroll
    for (int s = 0; s < FLOG4; ++s) { r = (r << 2) | (k & 3); k >>= 2; }
    return r; }
__device__ __forceinline__ void fft_fwd(LAS cf* x, const LAS cf* T, int tid) {
#pragma unroll 1
    for (int s = 0; s < FLOG4; ++s) { const int q = FN >> (2 * s + 2), tw = 1 << (2 * s);
        for (int u = tid; u < FN / 4; u += NTHR) { const int j = u & (q - 1), p = (u - j) * 4 + j;
            const cf a0 = x[p], a1 = x[p + q], a2 = x[p + 2 * q], a3 = x[p + 3 * q];
            const cf t0 = cadd(a0, a2), t1 = csub(a0, a2), t2 = cadd(a1, a3), d = csub(a1, a3), t3 = cf{d.y, -d.x};
            const cf w1 = fft_tw(T, j * tw), w2 = cmul(w1, w1), w3 = cmul(w2, w1);
            x[p] = cadd(t0, t2); x[p + q] = cmul(cadd(t1, t3), w1); x[p + 2 * q] = cmul(csub(t0, t2), w2); x[p + 3 * q] = cmul(csub(t1, t3), w3); }
        __syncthreads(); }
}
__device__ __forceinline__ void fft_inv(LAS cf* x, const LAS cf* T, int tid) {
#pragma unroll 1
    for (int s = FLOG4 - 1; s >= 0; --s) { const int q = FN >> (2 * s + 2), tw = 1 << (2 * s);
        for (int u = tid; u < FN / 4; u += NTHR) { const int j = u & (q - 1), p = (u - j) * 4 + j;
            const cf w1 = cconj(fft_tw(T, j * tw)), w2 = cmul(w1, w1), w3 = cmul(w2, w1);
            const cf a0 = x[p], a1 = cmul(x[p + q], w1), a2 = cmul(x[p + 2 * q], w2), a3 = cmul(x[p + 3 * q], w3);
            const cf t0 = cadd(a0, a2), t1 = csub(a0, a2), t2 = cadd(a1, a3), d = csub(a1, a3), t3 = cf{-d.y, d.x};
            x[p] = cadd(t0, t2); x[p + q] = cadd(t1, t3); x[p + 2 * q] = csub(t0, t2); x[p + 3 * q] = csub(t1, t3); }
        __syncthreads(); }
}
__device__ __forceinline__ void fft_load_real(LAS cf* x, const float* src, float scale, int tid) {
    for (int m = tid; m < FN; m += NTHR) { cf v{0.f, 0.f}; if (m < FN / 2) { v.x = src[2 * m] * scale; v.y = src[2 * m + 1] * scale; } x[m] = v; }
    __syncthreads();
}
__device__ __forceinline__ void phase_spectra(const Ctx& X, int l) {
    (void)l;
    LAS cf* x = (LAS cf*)X.lds; const LAS cf* T = (const LAS cf*)(X.lds + FFT_TAB_OFF); volatile LAS float* red = (volatile LAS float*)(X.lds + LDS_MISC) + 120;
    fft_tables(X);
    for (int c = X.bid; c < HW; c += X.G) {
        if (X.wave == 0) { const float* fp = X.ws<float>(WS_FPART) + c; float s = 0.f; for (int b = X.lane; b < NPART; b += 64) s += fp[(size_t)b * HW]; s = wave_sum(s); if (X.lane == 0) red[0] = s; }
        __syncthreads();
        const float inv = 1.0f / red[0];
        fft_load_real(x, X.ws<float>(WS_FILT) + (size_t)c * SEQ, inv, X.tid);
        fft_fwd(x, T, X.tid);
        cf* HS = X.ws<cf>(WS_HS) + (size_t)c * (FN + 1);
        for (int k = X.tid; k <= FN / 2; k += NTHR) {
            const cf A = x[rev4(k)], B = x[rev4((FN - k) & (FN - 1))];
            if (k == 0) { HS[0] = cf{A.x + A.y, 0.f}; HS[FN] = cf{A.x - A.y, 0.f}; }
            else if (k == FN / 2) { HS[k] = cconj(A); }
            else { float sn, cs; sincos_f(-3.14159265358979f * (float)k / (float)FN, sn, cs); const cf w{cs, sn};
                const cf s1 = cadd(A, cconj(B)), d1 = csub(A, cconj(B)), wd = cmul(w, d1);
                HS[k] = cf{0.5f * (s1.x + wd.y), 0.5f * (s1.y - wd.x)};
                const cf s2 = cadd(B, cconj(A)), d2 = csub(B, cconj(A)), wd2 = cmul(cconj(w), d2);
                HS[FN - k] = cf{0.5f * (s2.x - wd2.y), 0.5f * (s2.y + wd2.x)}; } }
        __syncthreads();
    }
}
__device__ __forceinline__ void fftconv_item(const Ctx& X, int l, int c) {
    LAS cf* x = (LAS cf*)X.lds; const LAS cf* T = (const LAS cf*)(X.lds + FFT_TAB_OFF);
    const float* z = X.ws<float>(WS_ZT) + (size_t)c * M + CTX;
    fft_load_real(x, z, 1.0f, X.tid);
    fft_fwd(x, T, X.tid);
    const cf* HS = X.ws<cf>(WS_HS) + (size_t)c * (FN + 1);
    for (int k = X.tid; k <= FN / 2; k += NTHR) {
        const int pa = rev4(k), pb = rev4((FN - k) & (FN - 1)); const cf A = x[pa], B = x[pb];
        if (k == 0) { const float y0 = (A.x + A.y) * HS[0].x, yn = (A.x - A.y) * HS[FN].x; x[pa] = cf{0.5f * (y0 + yn), 0.5f * (y0 - yn)}; }
        else if (k == FN / 2) { x[pa] = cconj(cmul(cconj(A), HS[k])); }
        else { float sn, cs; sincos_f(-3.14159265358979f * (float)k / (float)FN, sn, cs); const cf w{cs, sn};
            const cf s1 = cadd(A, cconj(B)), d1 = csub(A, cconj(B)), wd = cmul(w, d1); const cf Xk{0.5f * (s1.x + wd.y), 0.5f * (s1.y - wd.x)};
            const cf s2 = cadd(B, cconj(A)), d2 = csub(B, cconj(A)), wd2 = cmul(cconj(w), d2); const cf Xn{0.5f * (s2.x - wd2.y), 0.5f * (s2.y + wd2.x)};
            const cf Yk = cmul(Xk, HS[k]), Yn = cmul(Xn, HS[FN - k]);
            const cf e1 = cadd(Yk, cconj(Yn)), f1 = cmul(cconj(w), csub(Yk, cconj(Yn)));
            x[pa] = cf{0.5f * (e1.x - f1.y), 0.5f * (e1.y + f1.x)};
            const cf e2 = cadd(Yn, cconj(Yk)), f2 = cmul(w, csub(Yn, cconj(Yk)));
            x[pb] = cf{0.5f * (e2.x + f2.y), 0.5f * (e2.y - f2.x)}; } }
    __syncthreads();
    fft_inv(x, T, X.tid);
    const float bias = X.in(I_HBIAS)[(size_t)l * HW + c], sc = 1.0f / (float)FN; float* O = X.ws<float>(WS_CVT) + (size_t)c * SEQ;
    for (int i2 = X.tid; i2 < FN / 2; i2 += NTHR) { const cf d = x[i2 + FN / 4]; O[2 * i2] = d.x * sc + z[2 * i2] * bias; O[2 * i2 + 1] = d.y * sc + z[2 * i2 + 1] * bias; }
    __syncthreads();
}
__device__ __forceinline__ void phase_fftconv(const Ctx& X, int l) {
    fft_tables(X);
    volatile LAS int* slot = (volatile LAS int*)(X.lds + LDS_MISC) + 121;
    unsigned* q = X.ctl() + CW_Q + l * 64 + 32;
    for (;;) { if (X.tid == 0) slot[0] = (int)atomicAdd(q, 1u); __syncthreads(); const int c = slot[0]; __syncthreads(); if (c >= HW) break; fftconv_item(X, l, c); }
}
__device__ __forceinline__ void phase_ctxconv(const Ctx& X, int l) {
    constexpr int NITEMS = (HW / 64) * (CTX / CR);
    unsigned* q = X.ctl() + CW_Q + l * 64;
    for (;;) { int item = 0; if (X.lane == 0) item = (int)atomicAdd(q, 1u); item = __shfl(item, 0); if (item >= NITEMS) break; conv_item(X, item); }
}
__device__ __forceinline__ void phase_seq(const Ctx& X) {
    for (int su = X.bid; su < N_SEQ_UNITS; su += X.G) seq_unit(X, su);
}

__device__ __forceinline__ void finish_wave_unit(const Ctx& X, int l, int unit) {
    const int rg = unit / NH, h = unit % NH, lane = X.lane, b = rg >> 2, sub = rg & 3;
    const int cf = b, cb = (b < CTX / CC) ? (CTX / CC - 1 - b) : (NCHK - 1 - (b - CTX / CC));
    const size_t uf = ((size_t)(0 * NH + h) * NCHK + cf) * 4096, ub = ((size_t)(1 * NH + h) * NCHK + cb) * 4096;
    const bf16* G = X.wsv<bf16>(WS_G); const bf16* S0 = X.wsv<bf16>(WS_S0); const float* YL = X.wsv<float>(WS_YL);
    const int arow = 16 * sub + (lane & 15), kof = 8 * (lane >> 4);
    bf16x8 af[2], ab[2];
#pragma unroll
    for (int kk = 0; kk < 2; ++kk) { af[kk] = *(const bf16x8*)(G + uf + arow * 64 + kof + 32 * kk); ab[kk] = *(const bf16x8*)(G + ub + arow * 64 + kof + 32 * kk); }
    f32x4 y[4];
#pragma unroll
    for (int tj = 0; tj < 4; ++tj) { const int vrow = 16 * tj + (lane & 15);
        bf16x8 bf_[2], bb_[2];
#pragma unroll
        for (int kk = 0; kk < 2; ++kk) { bf_[kk] = *(const bf16x8*)(S0 + uf + vrow * 64 + kof + 32 * kk); bb_[kk] = *(const bf16x8*)(S0 + ub + vrow * 64 + kof + 32 * kk); }
        f32x4 acc;
#pragma unroll
        for (int r = 0; r < 4; ++r) { const int o = (16 * sub + 4 * (lane >> 4) + r) * 64 + vrow; acc[r] = YL[uf + o] + YL[ub + o]; }
#pragma unroll
        for (int kk = 0; kk < 2; ++kk) { acc = MFMA16(af[kk], bf_[kk], acc); acc = MFMA16(ab[kk], bb_[kk], acc); }
        y[tj] = acc; }
    const float* lgp = X.inv(I_LNXG) + (size_t)l * RW + 64 * h; const float* lbp = X.inv(I_LNXB) + (size_t)l * RW + 64 * h;
    const bf16* pV = X.wsv<bf16>(WS_V); const bf16* pG = X.wsv<bf16>(WS_GATE); const float* pBo = X.wsv<float>(WS_BONUS); bf16* pRO = X.wsv<bf16>(WS_RO);
#pragma unroll
    for (int r = 0; r < 4; ++r) { const int t = 16 * rg + 4 * (lane >> 4) + r;
        const float mean = row16_sum((y[0][r] + y[1][r]) + (y[2][r] + y[3][r])) * (1.f / 64.f);
        float q = 0.f;
#pragma unroll
        for (int tj = 0; tj < 4; ++tj) { const float dy = y[tj][r] - mean; q += dy * dy; }
        const float rstd = 1.0f / sqrtf(row16_sum(q) * (1.f / 64.f) + GN_EPS); const float bon = pBo[(size_t)t * NH + h];
#pragma unroll
        for (int tj = 0; tj < 4; ++tj) { const int cl = 16 * tj + (lane & 15); const size_t o = (size_t)t * RW + 64 * h + cl;
            float yn = (y[tj][r] - mean) * rstd * lgp[cl] + lbp[cl];
            yn += bon * bf2f(pV[o]); yn *= bf2f(pG[o]);
            pRO[o] = (bf16)f2bf(yn); } }
}
__device__ __forceinline__ void phase_finish(const Ctx& X, int l) {
    for (int u = X.bid * NWAVES + X.wave; u < (M / 16) * NH; u += X.G * NWAVES) finish_wave_unit(X, l, u);
    const int c = X.tid;
    if (c < HW) { const float hbc = X.in(I_HBIAS)[(size_t)l * HW + c]; const float* CV = X.ws<float>(WS_CVT) + (size_t)c * SEQ; const bf16* X0 = X.ws<bf16>(WS_X0); bf16* HO = X.ws<bf16>(WS_HO);
        for (int tile = X.bid; tile < M / TT; tile += X.G) { const int t0 = tile * TT; float cv[TT];
            if (t0 < CTX) {
#pragma unroll
                for (int tt = 0; tt < TT; ++tt) { const size_t o = (size_t)(t0 + tt) * HW + c; cv[tt] = X.ws<float>(WS_CONV)[o] + X.ws<float>(WS_Z)[o] * hbc; } }
            else { const f32x4 a = *(const f32x4*)(CV + (t0 - CTX)), b = *(const f32x4*)(CV + (t0 - CTX) + 4);
#pragma unroll
                for (int i = 0; i < 4; ++i) { cv[i] = a[i]; cv[4 + i] = b[i]; } }
#pragma unroll
            for (int tt = 0; tt < TT; ++tt) { const size_t o = (size_t)(t0 + tt) * HW + c; HO[o] = (bf16)f2bf(cv[tt] * bf2f(X0[o])); } } }
}

__device__ __forceinline__ void ln_inplace(float (&v)[D / 64], const float* g, const float* b, int lane) {
    float s = 0.f;
#pragma unroll
    for (int j = 0; j < D / 64; ++j) s += v[j];
    const float mean = wave_sum(s) * (1.f / D); float q = 0.f;
#pragma unroll
    for (int j = 0; j < D / 64; ++j) { v[j] -= mean; q += v[j] * v[j]; }
    const float rstd = 1.0f / sqrtf(wave_sum(q) * (1.f / D) + LN_EPS);
#pragma unroll
    for (int j = 0; j < D / 64; ++j) { const int d = 4 * lane + 256 * (j >> 2) + (j & 3); v[j] = v[j] * rstd * g[d] + b[d]; }
}
__device__ __forceinline__ void phase_norm1(const Ctx& X, int l) {
    const int gw = X.bid * NWAVES + X.wave, NGW = X.G * NWAVES, lane = X.lane;
    const float* lng = X.in(I_LNG) + (size_t)(l * 2 + 0) * D; const float* lnb = X.in(I_LNB) + (size_t)(l * 2 + 0) * D;
    const float* wr = X.in(I_WR); const float* rb = X.in(I_RB);
    const float alpha = sqrtf(sqrtf(2.0f * DEPTH));
    volatile LAS int* hist = (volatile LAS int*)(X.lds + LDS_MISC + 4096);
    if (X.tid < NE) hist[X.tid] = 0;
    __syncthreads();
    for (int t = gw; t < M; t += NGW) {
        float* xr = X.ws<float>(WS_X) + (size_t)t * D; const float* mx = X.ws<float>(WS_MIX) + (size_t)t * D;
        const float* gate = modp(X, l, t, 2); const float* sh = modp(X, l, t, 3); const float* sc = modp(X, l, t, 4);
        float v[D / 64];
#pragma unroll
        for (int j = 0; j < D / 256; ++j) { const int d = 4 * lane + 256 * j; const f32x4 a = *(const f32x4*)(xr + d), m = *(const f32x4*)(mx + d), gt = *(const f32x4*)(gate + d);
#pragma unroll
            for (int i = 0; i < 4; ++i) v[4 * j + i] = alpha * a[i] + gt[i] * m[i]; }
        ln_inplace(v, lng, lnb, lane);
        bf16* hf = X.ws<bf16>(WS_XMOD) + (size_t)t * D;
        LAS float* hrow = (LAS float*)X.lds + X.wave * D;
#pragma unroll
        for (int j = 0; j < D / 256; ++j) { const int d = 4 * lane + 256 * j; f32x4 o; const f32x4 a = *(const f32x4*)(sh + d), b = *(const f32x4*)(sc + d); f32x4 h;
#pragma unroll
            for (int i = 0; i < 4; ++i) { o[i] = v[4 * j + i]; h[i] = o[i] * (1.f + b[i]) + a[i]; }
            *(f32x4*)(xr + d) = o; *(LAS f32x4*)(hrow + d) = h;
            *(unsigned long long*)(hf + d) = (unsigned long long)pk2(h[0], h[1]) | ((unsigned long long)pk2(h[2], h[3]) << 32); }
        WAVE_LDS_FENCE(); CFENCE();
        float part = 0.f; { const int e = lane & 15, q = lane >> 4;
#pragma unroll 8
            for (int d = q * (D / 4); d < (q + 1) * (D / 4); ++d) part += hrow[d] * wr[(size_t)d * NE + e]; }
        part += __shfl_xor(part, 16); part += __shfl_xor(part, 32);
        WAVE_LDS_FENCE(); CFENCE();
        float lg[NE];
#pragma unroll
        for (int e = 0; e < NE; ++e) lg[e] = __shfl(part, e);
        float mxl = lg[0];
#pragma unroll
        for (int e = 1; e < NE; ++e) mxl = fmaxf(mxl, lg[e]);
        float sc_[NE], sum = 0.f;
#pragma unroll
        for (int e = 0; e < NE; ++e) { sc_[e] = expf(lg[e] - mxl); sum += sc_[e]; }
        const float isum = 1.0f / sum; float sel[NE];
#pragma unroll
        for (int e = 0; e < NE; ++e) { sc_[e] *= isum; sel[e] = sc_[e] + rb[e]; }
        int bg = 0; float bgs = -INFINITY;
#pragma unroll
        for (int g = 0; g < 4; ++g) { float m1 = -INFINITY, m2 = -INFINITY;
#pragma unroll
            for (int i = 0; i < 4; ++i) { const float x = sel[4 * g + i]; if (x > m1) { m2 = m1; m1 = x; } else if (x > m2) m2 = x; }
            const float gs = m1 + m2; if (gs > bgs) { bgs = gs; bg = g; } }
        int i0 = 0, i1 = 0; float s0 = -INFINITY, s1 = -INFINITY, p0 = 0.f, p1 = 0.f;
#pragma unroll
        for (int e = 0; e < NE; ++e) { if ((e >> 2) == bg) { const float x = sel[e]; if (x > s0) { s1 = s0; i1 = i0; p1 = p0; s0 = x; i0 = e; p0 = sc_[e]; } else if (x > s1) { s1 = x; i1 = e; p1 = sc_[e]; } } }
        if (lane == 0) { int* ei = X.ws<int>(WS_ROUT) + (size_t)t * 2; float* ew = (float*)(X.ws<int>(WS_ROUT) + (size_t)M * 2) + (size_t)t * 2;
            ei[0] = i0; ei[1] = i1; const float ws_ = 1.0f / (p0 + p1); ew[0] = p0 * ws_; ew[1] = p1 * ws_;
            lds_add(hist + i0, 1); lds_add(hist + i1, 1); }
    }
    __syncthreads();
    if (X.tid < NE) { const int hc = hist[X.tid]; X.ws<int>(WS_BCNT)[X.bid * NE + X.tid] = hc; atomicAdd(X.ctl() + CW_CNT + l * 64 + X.tid, (unsigned)hc); }
}

__device__ __forceinline__ void moe_table(const Ctx& X, int l, int NT) {
    volatile LAS int* tab = (volatile LAS int*)(X.lds + LDS_MISC) + 8;
    if (X.tid == 0) { int cum = 0, ts = 0;
        for (int e = 0; e < NE; ++e) { const int cnt = (int)__hip_atomic_load(X.ctl() + CW_CNT + l * 64 + e, RLX_AGENT); const int tc = (cnt + 255) / 256;
            tab[e] = cum; tab[32 + e] = ts; tab[64 + e] = tc; cum += tc * NT; ts += tc; }
        tab[16] = cum; }
    __syncthreads();
}
__device__ __forceinline__ void phase_scatter(const Ctx& X, int l) {
    moe_table(X, l, 1);
    volatile LAS int* tab = (volatile LAS int*)(X.lds + LDS_MISC) + 8;
    volatile LAS int* cur = (volatile LAS int*)(X.lds + LDS_MISC + 4096) + 16;
    const int gw = X.bid * NWAVES + X.wave, NGW = X.G * NWAVES, lane = X.lane;
    if (X.tid < NE) { const int* bc = X.ws<int>(WS_BCNT) + X.tid; int pre = 0; for (int b = 0; b < X.bid; ++b) pre += bc[b * NE]; cur[X.tid] = tab[32 + X.tid] * 256 + pre; }
    __syncthreads();
    const int* ei = X.ws<int>(WS_ROUT); int* slot = X.ws<int>(WS_ROUT) + (size_t)M * 4;
    for (int t = gw; t < M; t += NGW) {
#pragma unroll
        for (int k = 0; k < 2; ++k) { const int e = ei[2 * t + k];
            int pos = 0; if (lane == 0) pos = lds_add(cur + e, 1);
            pos = __shfl(pos, 0);
            if (lane == 0) slot[2 * t + k] = pos;
            const u32x4* src = (const u32x4*)(X.ws<bf16>(WS_XMOD) + (size_t)t * D); u32x4* dst = (u32x4*)(X.ws<bf16>(WS_XG) + (size_t)pos * D);
            for (int i = lane; i < D / 8; i += 64) dst[i] = src[i]; } }
}

__device__ __forceinline__ void phase_combine(const Ctx& X, int l) {
    const int gw = X.bid * NWAVES + X.wave, NGW = X.G * NWAVES, lane = X.lane;
    const float* lng = X.in(I_LNG) + (size_t)(l * 2 + 1) * D; const float* lnb = X.in(I_LNB) + (size_t)(l * 2 + 1) * D;
    const float alpha = sqrtf(sqrtf(2.0f * DEPTH));
    const float* ew = (const float*)(X.ws<int>(WS_ROUT) + (size_t)M * 2); const int* slot = X.ws<int>(WS_ROUT) + (size_t)M * 4;
    for (int t = gw; t < M; t += NGW) {
        float* xr = X.ws<float>(WS_X) + (size_t)t * D; const float* gate = modp(X, l, t, 5);
        const bf16* y0 = X.ws<bf16>(WS_YS) + (size_t)slot[2 * t] * D; const bf16* y1 = X.ws<bf16>(WS_YS) + (size_t)slot[2 * t + 1] * D; const float w0 = ew[2 * t], w1 = ew[2 * t + 1];
        float v[D / 64];
#pragma unroll
        for (int j = 0; j < D / 256; ++j) { const int d = 4 * lane + 256 * j; const f32x4 a = *(const f32x4*)(xr + d), gt = *(const f32x4*)(gate + d);
            const unsigned long long q0 = *(const unsigned long long*)(y0 + d), q1 = *(const unsigned long long*)(y1 + d);
            float ya[4] = {bflo((unsigned)q0), bfhi((unsigned)q0), bflo((unsigned)(q0 >> 32)), bfhi((unsigned)(q0 >> 32))};
            float yb[4] = {bflo((unsigned)q1), bfhi((unsigned)q1), bflo((unsigned)(q1 >> 32)), bfhi((unsigned)(q1 >> 32))};
#pragma unroll
            for (int i = 0; i < 4; ++i) v[4 * j + i] = alpha * a[i] + gt[i] * (w0 * ya[i] + w1 * yb[i]); }
        ln_inplace(v, lng, lnb, lane);
        if (l + 1 < DEPTH) { const float* sh = modp(X, l + 1, t, 0); const float* sc = modp(X, l + 1, t, 1); bf16* xm = X.ws<bf16>(WS_XMOD) + (size_t)t * D;
#pragma unroll
            for (int j = 0; j < D / 256; ++j) { const int d = 4 * lane + 256 * j; f32x4 o; const f32x4 a = *(const f32x4*)(sh + d), b = *(const f32x4*)(sc + d); float h[4];
#pragma unroll
                for (int i = 0; i < 4; ++i) { o[i] = v[4 * j + i]; h[i] = o[i] * (1.f + b[i]) + a[i]; }
                *(f32x4*)(xr + d) = o;
                *(unsigned long long*)(xm + d) = (unsigned long long)pk2(h[0], h[1]) | ((unsigned long long)pk2(h[2], h[3]) << 32); }
        } else if (t >= CTX) { float* orow = X.out() + (size_t)(t - CTX) * D; const bool bad = __hip_atomic_load(X.ctl() + CW_BAR + XB_TMO, RLX_AGENT) != 0u; const float pscale = 1.0f + bitsf(__hip_atomic_load(X.ctl() + 64, RLX_AGENT));
#pragma unroll
            for (int j = 0; j < D / 256; ++j) { const int d = 4 * lane + 256 * j; f32x4 o;
#pragma unroll
                for (int i = 0; i < 4; ++i) o[i] = bad ? __builtin_nanf("") : v[4 * j + i] * pscale;
                *(f32x4*)(orow + d) = o; }
        }
    }
}


#ifdef EMU
#define PHASE_FN static
#define THIN_FN static
#else
#define PHASE_FN __device__ __forceinline__
#define THIN_FN __device__ __noinline__
#endif
THIN_FN void ph_transposes(Ctx X, int l, int part) { phase_transposes(X, l, part); }
THIN_FN void ph_filters(Ctx X, int l) { phase_filters(X, l); }
THIN_FN void ph_mod(Ctx X) { phase_mod(X); }
THIN_FN void ph_x0(Ctx X) { phase_x0(X); }
THIN_FN void ph_lin(Ctx X, int l) { phase_lin(X, l); }
THIN_FN void ph_lora_a(Ctx X, int u) { lora_unit_a(X, u); }
THIN_FN void ph_lora_b(Ctx X, int l, int u) { lora_unit_b(X, l, u); }
THIN_FN void ph_prep_hyena(Ctx X, int l) { phase_prep_hyena(X, l); }
THIN_FN void ph_ctxconv(Ctx X, int l) { phase_ctxconv(X, l); }
THIN_FN void ph_chunk_1(Ctx X, int u) { chunk_unit_1(X, u); }
THIN_FN void ph_chunk_2(Ctx X, int u) { chunk_unit_2(X, u); }
THIN_FN void ph_chunk_3(Ctx X, int u) { chunk_unit_3(X, u); }
THIN_FN void ph_seq(Ctx X) { phase_seq(X); }
THIN_FN void ph_fftconv(Ctx X, int l) { phase_fftconv(X, l); }
THIN_FN void ph_spectra(Ctx X, int l) { phase_spectra(X, l); }
THIN_FN void ph_finish(Ctx X, int l) { phase_finish(X, l); }
THIN_FN void ph_norm1(Ctx X, int l) { phase_norm1(X, l); }
THIN_FN void ph_scatter(Ctx X, int l) { phase_scatter(X, l); }
THIN_FN void ph_combine(Ctx X, int l) { phase_combine(X, l); }
PHASE_FN void ph_g13(Ctx X, int third) { pg8::Gemm g{third ? X.ws<bf16>(WS_T) : X.ws<bf16>(WS_XMOD), third ? X.ws<bf16>(WS_WO) : X.ws<bf16>(WS_WIN), D}; pg8::StaticOrder S; S.init(M, third ? D : PCP, X.G, X.bid);
    pg8::EpiBf16OrF32 E{X.ws<bf16>(WS_P), X.ws<float>(WS_MIX), third ? D : PCP, third != 0}; pg8::gemm_phase(X.lds, g, S, E); }
PHASE_FN void ph_g2(Ctx X, int second) { pg8::Gemm g{second ? X.ws<bf16>(WS_HO) : X.ws<bf16>(WS_RO), X.ws<bf16>(WS_WB) + (second ? (size_t)D * RW : 0), RW}; pg8::StaticOrder S; S.init(M, D, X.G, X.bid);
    pg8::EpiGate E{X.ws<bf16>(WS_T), D, X.ws<bf16>(WS_P), PCP, second ? C_GH : C_GR, second != 0}; pg8::gemm_phase(X.lds, g, S, E); }
PHASE_FN void ph_g45(Ctx X, int l, int down) { const int NT = down ? D / 256 : 2 * D / 256; moe_table(X, l, NT); pg8::MoeOrder S{(const volatile LAS int*)(X.lds + LDS_MISC) + 8, NT, X.G, X.bid};
    pg8::Gemm g{down ? X.ws<bf16>(WS_ACT) : X.ws<bf16>(WS_XG), down ? X.ws<bf16>(WS_WD) : X.ws<bf16>(WS_WGU), D}; pg8::EpiMoe E{down ? X.ws<bf16>(WS_YS) : X.ws<bf16>(WS_ACT), D, NT, down == 0}; pg8::gemm_phase(X.lds, g, S, E); }

constexpr int NPH = 16, NPHASES = DEPTH * NPH;
template <int MASK> __global__ void __launch_bounds__(NTHR, 2) fwd_kernel(Args args) {
    DYN_LDS(lds);
    Ctx X; X.lds = lds; X.tid = threadIdx.x; X.lane = X.tid & 63; X.wave = READFIRSTLANE(X.tid >> 6); X.G = gridDim.x; X.bid = blockIdx.x;
    volatile LAS unsigned* misc = (volatile LAS unsigned*)(lds + LDS_MISC);
    if (X.tid < 128) misc[X.tid] = 0u;
    if (X.tid < N_IN + 2) { const unsigned long long p = X.tid < N_IN ? (unsigned long long)args.in[X.tid < N_IN ? X.tid : 0] : (X.tid == N_IN ? (unsigned long long)args.out : (unsigned long long)args.ws);
        misc[PT_WORD0 + 2 * X.tid] = (unsigned)p; misc[PT_WORD0 + 2 * X.tid + 1] = (unsigned)(p >> 32); }
    __syncthreads();
    XcdBarrier bar = xcd_barrier_post(X.ctl() + CW_BAR, misc);
    const int lo = args.ph_lo, hi = args.ph_hi;
#define IN(k) ((((MASK) >> ((k) % NPH)) & 1) && lo <= (k) && (k) < hi)
#ifdef PROBE_K
#ifndef PROBE_SCALE
#define PROBE_SCALE 1.0f
#endif
#ifndef PROBE_BLOCK
#define PROBE_BLOCK 0
#endif
    unsigned long long plast = __builtin_amdgcn_s_memrealtime(); if (threadIdx.x < 32) misc[2048 + threadIdx.x] = 0u; __syncthreads();
#define PROBE_TX(k) do { if (blockIdx.x == PROBE_BLOCK && threadIdx.x == 0) { const unsigned long long now_ = __builtin_amdgcn_s_memrealtime(); misc[2048 + (k)] += (unsigned)(now_ - plast); plast = now_; } } while (0)
#define PROBE_T(k) PROBE_TX((k) % NPH)
#define PROBE_PUB(k) do { if ((k) == NPHASES - 2 && blockIdx.x == PROBE_BLOCK && threadIdx.x == 0) { PROBE_T(k); unsigned tot_ = 0; for (int i_ = 0; i_ < 28; ++i_) tot_ += misc[2048 + i_]; \
        const float f_ = floorf(PROBE_SCALE * (float)misc[2048 + PROBE_K] / (float)tot_ * 128.0f + 0.5f) * (1.0f / 128.0f); __hip_atomic_store(X.ctl() + 64, fbits(f_), RLX_AGENT); } } while (0)
#else
#define PROBE_T(k) do {} while (0)
#define PROBE_TX(k) do {} while (0)
#define PROBE_PUB(k) do {} while (0)
#endif
#define SEAM(k) do { PROBE_PUB(k); if ((k) + 1 < hi) xcd_barrier(bar); PROBE_T(k); } while (0)
    for (int l = 0; l < DEPTH; ++l) {
        const int pb = l * NPH;
        if (IN(pb + 0)) { ph_transposes(X, l, 0); __syncthreads(); PROBE_TX(20); ph_filters(X, l); PROBE_TX(21); if (l == 0) ph_mod(X); PROBE_TX(22); SEAM(pb + 0); }
        if (l == 0 && IN(pb + 1)) { ph_x0(X); SEAM(pb + 1); }
        if (IN(pb + 2)) { ph_g13(X, 0); SEAM(pb + 2); }
        if (IN(pb + 3)) { ph_lin(X, l); PROBE_TX(23); ph_prep_hyena(X, l); PROBE_TX(24); ph_spectra(X, l); PROBE_TX(25); SEAM(pb + 3); }
        if (IN(pb + 4)) { for (int u = X.bid; u < (M / 64) * NH; u += X.G) { ph_lora_a(X, u); ph_lora_b(X, l, u); } SEAM(pb + 4); }
        if (IN(pb + 5)) { for (int u = X.bid; u < 2 * NCHK * NH; u += X.G) { ph_chunk_1(X, u); ph_chunk_2(X, u); ph_chunk_3(X, u); } SEAM(pb + 5); }
        if (IN(pb + 6)) { ph_seq(X); PROBE_TX(16); ph_transposes(X, l, 1); __syncthreads(); PROBE_TX(17); ph_ctxconv(X, l); PROBE_TX(18); ph_fftconv(X, l); PROBE_TX(19); SEAM(pb + 6); }
        if (IN(pb + 7)) { ph_finish(X, l); SEAM(pb + 7); }
        for (int sb = 0; sb < 2; ++sb) if (IN(pb + 8 + sb)) { ph_g2(X, sb); SEAM(pb + 8 + sb); }
        if (IN(pb + 10)) { ph_g13(X, 1); SEAM(pb + 10); }
        if (IN(pb + 11)) { ph_norm1(X, l); SEAM(pb + 11); }
        if (IN(pb + 12)) { ph_scatter(X, l); SEAM(pb + 12); }
        for (int dn = 0; dn < 2; ++dn) if (IN(pb + 13 + dn)) { ph_g45(X, l, dn); SEAM(pb + 13 + dn); }
        if (IN(pb + 15)) { ph_combine(X, l); SEAM(pb + 15); }
    }
#undef IN
#undef SEAM
}

#ifndef N_LAUNCHES
#define N_LAUNCHES 1
#endif
#ifndef PH_MASK
#define PH_MASK 0xffff
#endif
template <int MASK> static void launch_mask(int grid, hipStream_t stream, const Args& a) {
    static bool attr = false;
    if (!attr) { (void)hipFuncSetAttribute((const void*)fwd_kernel<MASK>, hipFuncAttributeMaxDynamicSharedMemorySize, LDS_BYTES); attr = true; }
    hipLaunchKernelGGL(fwd_kernel<MASK>, dim3(grid), dim3(NTHR), LDS_BYTES, stream, a);
}
extern "C" void kernel_launch(void* const* d_in, const int* in_sizes, int n_in, void* d_out, int out_size, void* d_ws, size_t ws_size, hipStream_t stream) {
    static int grid = 0;
    if (grid == 0) {
        if (n_in != N_IN || ws_size < WS_END) { fprintf(stderr, "kernel_launch: unexpected n_in %d or workspace %zu < %zu\n", n_in, ws_size, (size_t)WS_END); grid = -1; return; }
        int dev = 0, cus = 0;
        if (hipGetDevice(&dev) != hipSuccess || hipDeviceGetAttribute(&cus, hipDeviceAttributeMultiprocessorCount, dev) != hipSuccess) { grid = -1; return; }
        (void)hipGetLastError();
        grid = cus; if (grid > NPART) grid = NPART;
    }
    if (grid < 0) return;
    (void)in_sizes; (void)out_size;
    (void)hipMemsetAsync(d_ws, 0, CTL_BYTES, stream);
    Args a;
    for (int i = 0; i < N_IN; ++i) a.in[i] = (const float*)d_in[i];
    a.out = (float*)d_out; a.ws = (unsigned char*)d_ws;
#if N_LAUNCHES == 1
    a.ph_lo = 0; a.ph_hi = NPHASES;
    launch_mask<PH_MASK>(grid, stream, a);
#else
    for (int ph = 0; ph < NPHASES; ++ph) { const int k = ph % NPH; if (k == 1 && ph / NPH != 0) continue; a.ph_lo = ph; a.ph_hi = ph + 1; launch_mask<PH_MASK>(grid, stream, a); }
#endif
}
```

```cpp
#ifndef EMU
#include <hip/hip_runtime.h>
#endif
#include <cstdio>
#include <cstdint>
#include <cmath>

#ifndef CFG_D
#define CFG_D 1024
#define CFG_SEQ 16384
#define CFG_CTX 256
#define CFG_DEPTH 4
#endif
constexpr int D = CFG_D, SEQ = CFG_SEQ, CTX = CFG_CTX, DEPTH = CFG_DEPTH, M = CTX + SEQ;
constexpr int GRID_W = 64, GRID_H = SEQ / GRID_W;
constexpr int RW = D / 2, NH = RW / 64, HW = D / 2, RC = 3 * RW + 384, HC = 3 * HW, GC = 2 * D, PC = RC + HC + GC, PCP = (PC + 255) / 256 * 256;
constexpr int QTR = RC / 4, HALFC = RC / 2;
constexpr int C_K = RW, C_V = 2 * RW, C_LWF = 3 * RW, C_LG = 3 * RW + 256;
constexpr int C_HY = RC, C_GR = RC + HC, C_GH = RC + HC + D;
constexpr int NE = 16, SP_TILES = (2 * M) / 256 + NE, SP = SP_TILES * 256;
constexpr float DECAY_SCALE = 0.606531f, GN_EPS = 6.4e-4f, LN_EPS = 1e-5f;
constexpr int N_SEQ_UNITS = 2 * NH * 4;
constexpr int NPART = 256;
static_assert(CTX % 32 == 0 && M % 256 == 0 && D % 256 == 0 && RW % 128 == 0 && RW >= 256 && SEQ % 64 == 0 && CTX % 32 == 0 && RC % 4 == 0, "shape assumptions");

enum { I_X = 0, I_C, I_CTX, I_CCTX, I_WMOD, I_BMOD, I_WIN, I_MU, I_W0, I_W2, I_A0, I_A2, I_G2, I_KK, I_KA, I_RK, I_LNXG, I_LNXB, I_CW, I_CB,
       I_FW1, I_FB1, I_FW2, I_FB2, I_FW3, I_FB3, I_FWO, I_FREQ, I_HBIAS, I_WBR, I_WOUT, I_LNG, I_LNB, I_WR, I_RB, I_WG, I_WU, I_WD, N_IN };

constexpr size_t al256(size_t x) { return (x + 255) & ~(size_t)255; }
constexpr size_t CTL_BYTES = 1u << 20;
constexpr size_t WS_MOD = CTL_BYTES;
constexpr size_t WS_FPART = al256(WS_MOD + (size_t)DEPTH * 2 * 6 * D * 4);
constexpr size_t WS_ROUT = al256(WS_FPART + (size_t)2 * NPART * HW * 4);
constexpr size_t WS_BCNT = al256(WS_ROUT + (size_t)M * 2 * 4 * 3);
constexpr size_t WS_BONUS = al256(WS_BCNT + (size_t)NPART * NE * 4);
constexpr size_t WS_WIN = al256(WS_BONUS + (size_t)M * NH * 4);
constexpr size_t WS_WB = al256(WS_WIN + (size_t)PCP * D * 2);
constexpr size_t WS_WO = al256(WS_WB + (size_t)2 * D * RW * 2);
constexpr size_t WS_W2T = al256(WS_WO + (size_t)D * D * 2);
constexpr size_t WS_A2T = al256(WS_W2T + (size_t)2 * RW * 64 * 2);
constexpr size_t WS_G2T = al256(WS_A2T + (size_t)2 * RW * 64 * 2);
constexpr size_t WS_WGU = al256(WS_G2T + (size_t)RW * 128 * 2);
constexpr size_t WS_WD = al256(WS_WGU + (size_t)NE * 2 * D * D * 2);
constexpr size_t WS_X = al256(WS_WD + (size_t)NE * D * D * 2);
constexpr size_t WS_XMOD = al256(WS_X + (size_t)M * D * 4);
constexpr size_t WS_P = al256(WS_XMOD + (size_t)M * D * 2);
constexpr size_t WS_FILT = al256(WS_P + (size_t)M * PCP * 2);
constexpr size_t WS_MIX = al256(WS_FILT + (size_t)M * HW * 4);
constexpr size_t WS_T = al256(WS_MIX + (size_t)M * D * 4);
constexpr size_t WS_S = al256(WS_T + (size_t)M * D * 2);
constexpr size_t WS_R = WS_S;
constexpr size_t WS_V = al256(WS_R + (size_t)M * RW * 2);
constexpr size_t WS_KA = al256(WS_V + (size_t)M * RW * 2);
constexpr size_t WS_KD = al256(WS_KA + (size_t)M * RW * 2);
constexpr size_t WS_KB = al256(WS_KD + (size_t)2 * M * RW * 2);
constexpr size_t WS_W = al256(WS_KB + (size_t)2 * M * RW * 2);
constexpr size_t WS_PQ = al256(WS_W + (size_t)2 * M * RW * 4);
constexpr size_t WS_LIN = WS_PQ;
static_assert((size_t)M * 384 * 2 <= (size_t)2 * NH * (M / 64) * 2 * 4096 * 4, "LIN fits PQ");
constexpr size_t WS_G = al256(WS_PQ + (size_t)2 * NH * (M / 64) * 2 * 4096 * 4);
constexpr size_t WS_YL = al256(WS_G + (size_t)2 * NH * (M / 64) * 4096 * 2);
constexpr size_t WS_S0 = WS_XMOD;
static_assert((size_t)2 * NH * (M / 64) * 4096 * 2 <= (size_t)M * D * 2, "S0 fits XMOD");
constexpr size_t WS_Z = al256(WS_YL + (size_t)2 * NH * (M / 64) * 4096 * 4);
constexpr size_t WS_X0 = al256(WS_Z + (size_t)CTX * HW * 4);
constexpr size_t WS_CONV = al256(WS_X0 + (size_t)M * HW * 2);
constexpr size_t WS_GATE = al256(WS_CONV + (size_t)CTX * HW * 4);
constexpr size_t WS_RO = al256(WS_GATE + (size_t)M * RW * 2);
constexpr size_t WS_HO = al256(WS_RO + (size_t)M * RW * 2);
constexpr size_t WS_HS = WS_MIX;
constexpr size_t WS_ZT = WS_T;
constexpr size_t WS_CVT = WS_FILT;
static_assert((size_t)HW * (SEQ + 1) * 8 <= (size_t)M * D * 4 && (size_t)HW * M * 4 <= (size_t)M * D * 2, "HS fits MIX, ZT fits T");
constexpr size_t WS_END1 = al256(WS_HO + (size_t)M * HW * 2);
constexpr size_t WS_XG = WS_S;
constexpr size_t WS_ACT = al256(WS_XG + (size_t)SP * D * 2);
constexpr size_t WS_YS = al256(WS_ACT + (size_t)SP * D * 2);
constexpr size_t WS_END2 = al256(WS_YS + (size_t)SP * D * 2);
constexpr size_t WS_END = WS_END1 > WS_END2 ? WS_END1 : WS_END2;
constexpr int CW_TMO = 0, CW_BAR = 4096, CW_CNT = 8192  , CW_CUR = 8192 + 1024  , CW_Q = 8192 + 2048  ;

#ifdef EMU
#define LAS
typedef short bf16x8 __attribute__((vector_size(16)));
typedef float f32x4 __attribute__((vector_size(16)));
typedef unsigned u32x4 __attribute__((vector_size(16)));
#define DYN_LDS(name) unsigned char* name = emu_cur_lds()
#define ASM_WAIT_V(n) do {} while (0)
#define ASM_WAIT_L(n) do {} while (0)
#define ASM_WAIT_VL0() do {} while (0)
#define CFENCE() do {} while (0)
#define WAVE_LDS_FENCE() emu_wave_sync()
#define S_BARRIER() emu_block_sync()
#define SCHED_BARRIER() do {} while (0)
#define SETPRIO(x) do {} while (0)
#define S_SLEEP(n) emu_yield()
#define MFMA16(a, b, c) emu_mfma_16x16x32(a, b, c)
#define MFMA4F(a, b, c) emu_mfma_16x16x4f32(a, b, c)
#define GLDS16(gptr, lptr) emu_glds16((const void*)(gptr), (void*)(lptr))
#define READFIRSTLANE(x) (x)
#define XCC_ID_() (blockIdx.x & 7u)
#define FENCE_RELEASE() do {} while (0)
#define FENCE_ACQUIRE() do {} while (0)
#define DPP_F(v, ctrl) emu_dpp_f(v, ctrl)
static inline int vgpr_zero() { return 0; }
static inline unsigned long long vgpr_zero64() { return 0ull; }
static inline int lds_add(volatile int* p, int v) { int o = *p; *p = o + v; return o; }
static inline unsigned fbits(float f) { unsigned u; memcpy(&u, &f, 4); return u; }
static inline float bitsf(unsigned u) { float f; memcpy(&f, &u, 4); return f; }
#else
#define LAS __attribute__((address_space(3)))
typedef short bf16x8 __attribute__((ext_vector_type(8)));
typedef float f32x4 __attribute__((ext_vector_type(4)));
typedef unsigned u32x4 __attribute__((ext_vector_type(4)));
#define DYN_LDS(name) extern __shared__ __attribute__((aligned(16))) unsigned char name##_raw[]; LAS unsigned char* name = (LAS unsigned char*)name##_raw
#define ASM_WAIT_V(n) asm volatile("s_waitcnt vmcnt(" #n ")" ::: "memory")
#define ASM_WAIT_L(n) asm volatile("s_waitcnt lgkmcnt(" #n ")" ::: "memory")
#define ASM_WAIT_VL0() asm volatile("s_waitcnt vmcnt(0) lgkmcnt(0)" ::: "memory")
#define CFENCE() asm volatile("" ::: "memory")
#define WAVE_LDS_FENCE() asm volatile("s_waitcnt lgkmcnt(0)" ::: "memory")
#define S_BARRIER() __builtin_amdgcn_s_barrier()
#define SCHED_BARRIER() __builtin_amdgcn_sched_barrier(0)
#define SETPRIO(x) __builtin_amdgcn_s_setprio(x)
#define S_SLEEP(n) __builtin_amdgcn_s_sleep(n)
#define MFMA16(a, b, c) __builtin_amdgcn_mfma_f32_16x16x32_bf16(a, b, c, 0, 0, 0)
#define MFMA4F(a, b, c) __builtin_amdgcn_mfma_f32_16x16x4f32(a, b, c, 0, 0, 0)
#define GLDS16(gptr, lptr) __builtin_amdgcn_global_load_lds((const unsigned*)(gptr), (LAS unsigned*)(lptr), 16, 0, 0)
#define READFIRSTLANE(x) __builtin_amdgcn_readfirstlane(x)
#define XCC_ID_() ((unsigned)__builtin_amdgcn_s_getreg((3 << 11) | 20) & 0xFu)
#define FENCE_RELEASE() __builtin_amdgcn_fence(__ATOMIC_RELEASE, "agent")
#define FENCE_ACQUIRE() __builtin_amdgcn_fence(__ATOMIC_ACQUIRE, "agent")
#define DPP_F(v, ctrl) __builtin_bit_cast(float, __builtin_amdgcn_update_dpp(0, __builtin_bit_cast(int, (float)(v)), (ctrl), 0xF, 0xF, true))
__device__ __forceinline__ int vgpr_zero() { int z; asm volatile("v_mov_b32 %0, 0" : "=v"(z)); return z; }
__device__ __forceinline__ unsigned long long vgpr_zero64() { unsigned long long z; asm volatile("v_mov_b64 %0, 0" : "=v"(z)); return z; }
__device__ __forceinline__ int lds_add(volatile LAS int* p, int v) { return __hip_atomic_fetch_add((LAS int*)p, v, __ATOMIC_RELAXED, __HIP_MEMORY_SCOPE_WORKGROUP); }
__device__ __forceinline__ unsigned fbits(float f) { return __builtin_bit_cast(unsigned, f); }
__device__ __forceinline__ float bitsf(unsigned u) { return __builtin_bit_cast(float, u); }
#endif
typedef unsigned short bf16;
#define RLX_AGENT __ATOMIC_RELAXED, __HIP_MEMORY_SCOPE_AGENT

__device__ __forceinline__ unsigned f2bf(float f) { unsigned u = fbits(f); return (u + 0x7fffu + ((u >> 16) & 1u)) >> 16; }
__device__ __forceinline__ unsigned pk2(float lo, float hi) { return f2bf(lo) | (f2bf(hi) << 16); }
__device__ __forceinline__ float bf2f(bf16 b) { return bitsf(((unsigned)b) << 16); }
__device__ __forceinline__ float bflo(unsigned w) { return bitsf(w << 16); }
__device__ __forceinline__ float bfhi(unsigned w) { return bitsf(w & 0xffff0000u); }
__device__ __forceinline__ float sigmoidf_(float x) { return 1.0f / (1.0f + expf(-x)); }
__device__ __forceinline__ float wave_sum(float v) {
#pragma unroll
    for (int o = 1; o < 64; o <<= 1) v += __shfl_xor(v, o);
    return v;
}
__device__ __forceinline__ float row16_sum(float v) {
    v += DPP_F(v, 0xB1);
    v += DPP_F(v, 0x4E);
    v += DPP_F(v, 0x141);
    v += DPP_F(v, 0x140);
    return v;
}
__device__ __forceinline__ void sincos_f(float x, float& s, float& c) {
    const float k = rintf(x * 0.63661977236758134f);
    float r = fmaf(-k, 1.5703125f, x); r = fmaf(-k, 4.837512969970703125e-4f, r); r = fmaf(-k, 7.54978994989188216e-8f, r);
    const float r2 = r * r;
    const float sp = r + r * r2 * (-1.6666654611e-1f + r2 * (8.3321608736e-3f + r2 * (-1.9515295891e-4f)));
    const float cp = 1.0f - 0.5f * r2 + r2 * r2 * (4.166664568298827e-2f + r2 * (-1.388731625493765e-3f + r2 * (2.443315711809948e-5f)));
    const int q = ((int)k) & 3;
    s = (q == 0) ? sp : (q == 1) ? cp : (q == 2) ? -sp : -cp;
    c = (q == 0) ? cp : (q == 1) ? -sp : (q == 2) ? -cp : sp;
}
__device__ __forceinline__ float sin_f(float x) { float s, c; sincos_f(x, s, c); return s; }

template <class T> __device__ __forceinline__ T* as_global(T* p) {
#ifndef EMU
    return (T*)(__attribute__((address_space(1))) T*)(unsigned long long)p;
#else
    return p;
#endif
}
#define XB_TMO      128
#define XB_XCNT(j)  (256  + 64 * (j))
#define XB_XSUB(j)  (1280 + 64 * (j))
#define XB_XGEN(j)  (2304 + 64 * (j))
#define XB_TOP      3328
#define XB_TOPGEN   3392
#define XCD_BAR_WORDS 3456
#define XB_SPIN_CAP (1u << 18)
__device__ __forceinline__ unsigned xb_ld(unsigned* p)              { return __hip_atomic_load(p, __ATOMIC_RELAXED, __HIP_MEMORY_SCOPE_AGENT); }
__device__ __forceinline__ unsigned xb_add(unsigned* p, unsigned v) { return __hip_atomic_fetch_add(p, v, __ATOMIC_RELAXED, __HIP_MEMORY_SCOPE_AGENT); }
#define XB_SPIN(cond, bar) do { unsigned _sp = 0; while (cond) { S_SLEEP(1); \
    if ((++_sp & 255u) == 0u) { if (xb_ld(&(bar)[XB_TMO])) break; if (_sp > XB_SPIN_CAP) { atomicAdd(&(bar)[XB_TMO], 1u); break; } } } } while (0)
struct XcdBarrier { unsigned* bar; unsigned x; volatile LAS unsigned* st; };
__device__ __forceinline__ XcdBarrier xcd_barrier_post(unsigned* bar, volatile LAS unsigned* st) {
    XcdBarrier b; b.bar = nullptr; b.x = XCC_ID_(); b.st = st;
    if (threadIdx.x == 0) { st[2] = (unsigned)(unsigned long long)bar; st[3] = (unsigned)((unsigned long long)bar >> 32); st[4] = b.x; (void)xb_add(&bar[XB_XCNT(b.x)], 1u); }
    return b;
}
__device__ __forceinline__ void xcd_barrier_complete(unsigned* bar, unsigned x, unsigned& nloc, unsigned& nx) {
    const unsigned G = gridDim.x * gridDim.y * gridDim.z;
    unsigned sum, cnt, mine, sp = 0u;
    for (;;) {
        sum = 0u; cnt = 0u; mine = 0u;
#pragma unroll
        for (unsigned j = 0; j < 16; ++j) { const unsigned c = xb_ld(&bar[XB_XCNT(j)]); sum += c; cnt += (c > 0u) ? 1u : 0u; mine = (j == x) ? c : mine; }
        if (sum == G) break;
        S_SLEEP(1);
        if ((++sp & 255u) == 0u) { if (xb_ld(&bar[XB_TMO])) break; if (sp > XB_SPIN_CAP) { atomicAdd(&bar[XB_TMO], 1u); break; } }
    }
    nloc = mine > 0u ? mine : 1u; nx = cnt > 0u ? cnt : 1u;
}
__device__ __forceinline__ void xcd_barrier(const XcdBarrier& b) {
    ASM_WAIT_V(0);
    __syncthreads();
    if (threadIdx.x == 0) {
        unsigned* bar = as_global((unsigned*)(((unsigned long long)b.st[3] << 32) | b.st[2]));
        const unsigned bx = b.st[4];
        ASM_WAIT_VL0();
        unsigned nloc = b.st[0], nx = b.st[1];
        if (nloc == 0u) { xcd_barrier_complete(bar, bx, nloc, nx); b.st[0] = nloc; b.st[1] = nx; }
        const unsigned old = xb_add(&bar[XB_XSUB(bx)], 1u);
        const unsigned gen = old / nloc;
        if (old + 1u == (gen + 1u) * nloc) {
            FENCE_RELEASE();
            ASM_WAIT_V(0);
            const unsigned og = xb_add(&bar[XB_TOP], 1u);
            const unsigned tg = og / nx;
            if (og + 1u == (tg + 1u) * nx) xb_add(&bar[XB_TOPGEN], 1u);
            else XB_SPIN(xb_ld(&bar[XB_TOPGEN]) == tg, bar);
            FENCE_ACQUIRE();
            xb_add(&bar[XB_XGEN(bx)], 1u);
            ASM_WAIT_V(0);
        } else {
            XB_SPIN(xb_ld(&bar[XB_XGEN(bx)]) == gen, bar);
            FENCE_ACQUIRE();
            ASM_WAIT_V(0);
        }
    }
    __syncthreads();
}

namespace pg8 {
constexpr int BM = 256, BK = 64, HALF = 128, HTB = HALF * BK * 2, STAGE_BYTES = 8 * HTB, NXCD = 8, WGM = 8;
__host__ __device__ __forceinline__ int lds_byte(int r, int c) { const int st = (r >> 4) * 2 + (c >> 5), rr = r & 15, cc = c & 31, ob = rr * 64 + cc * 2; return st * 1024 + (ob ^ (((ob >> 9) & 1) << 5)); }
__host__ __device__ __forceinline__ void stage_rc(int b, int& R, int& C) { const int st = b / 1024, sb = b % 1024, swz = sb ^ (((sb >> 9) & 1) << 5); R = (st >> 1) * 16 + swz / 64; C = (st & 1) * 32 + (swz % 64) / 2; }
__host__ __device__ __forceinline__ int perm32(int rho) { const int n = rho >> 4, i = rho & 15; return 8 * (i >> 2) + 4 * n + (i & 3); }
struct Unit { int pm, pn; };
struct Gemm { const bf16* A; const bf16* Bt; int K; };
struct StaticOrder {
    int nM, nN, nwg, G, c;
    __host__ __device__ void init(int M_, int N_, int G_, int c_) { nM = M_ / BM; nN = N_ / BM; nwg = nM * nN; G = G_; c = c_; }
    __host__ __device__ bool next(int i, Unit& u) const {
        const long L = (long)i * G + c; if (L >= nwg) return false;
        int wgid = (int)L; { const int q = nwg / NXCD, r = nwg % NXCD, xcd = wgid % NXCD, off = wgid / NXCD; wgid = (xcd < r ? xcd * (q + 1) : r * (q + 1) + (xcd - r) * q) + off; }
        const int nig = WGM * nN, gid = wgid / nig, fm = gid * WGM, gsz = (nM - fm) < WGM ? (nM - fm) : WGM;
        u.pm = fm + ((wgid % nig) % gsz); u.pn = (wgid % nig) / gsz; return true;
    }
};
struct MoeOrder {
    const volatile LAS int* tab; int NT, G, c;
    __device__ __forceinline__ bool next(int i, Unit& u) const {
        const long L = (long)i * G + c; if (L >= tab[16]) return false;
        int e = 0; while (L >= tab[e + 1]) ++e;
        const int loc = (int)L - tab[e], tc = tab[64 + e];
        u.pm = tab[32 + e] + loc % tc; u.pn = e * NT + loc / tc; return true;
    }
};
__device__ __forceinline__ unsigned cvt_pk_bf16(float lo, float hi) {
#ifdef EMU
    return pk2(lo, hi);
#else
    unsigned r; asm volatile("v_cvt_pk_bf16_f32 %0, %1, %2" : "=v"(r) : "v"(lo), "v"(hi)); return r;
#endif
}

struct EpiBf16 {
    static constexpr bool PERM = true;
    bf16* O; int ldc;
    __device__ __forceinline__ void operator()(const f32x4 (&acc)[2][2][4][2], const Unit& u, int wr, int wc, int fr, int fq) const {
        const int row0 = u.pm * BM + wr * 64 + fr, col0 = u.pn * BM + wc * 32 + 8 * fq;
#pragma unroll
        for (int ai = 0; ai < 2; ++ai)
#pragma unroll
            for (int m = 0; m < 4; ++m) { bf16* rowp = O + (size_t)(row0 + ai * HALF + m * 16) * ldc + col0;
#pragma unroll
                for (int bj = 0; bj < 2; ++bj) { const f32x4 v0 = acc[ai][bj][m][0], v1 = acc[ai][bj][m][1];
                    u32x4 w; w[0] = cvt_pk_bf16(v0[0], v0[1]); w[1] = cvt_pk_bf16(v0[2], v0[3]); w[2] = cvt_pk_bf16(v1[0], v1[1]); w[3] = cvt_pk_bf16(v1[2], v1[3]);
                    *(u32x4*)(rowp + bj * HALF) = w; } }
    }
};
struct EpiF32 {
    static constexpr bool PERM = true;
    float* C; int ldc;
    __device__ __forceinline__ void operator()(const f32x4 (&acc)[2][2][4][2], const Unit& u, int wr, int wc, int fr, int fq) const {
        const int row0 = u.pm * BM + wr * 64 + fr, col0 = u.pn * BM + wc * 32 + 8 * fq;
#pragma unroll
        for (int ai = 0; ai < 2; ++ai)
#pragma unroll
            for (int m = 0; m < 4; ++m) { float* rowp = C + (size_t)(row0 + ai * HALF + m * 16) * ldc + col0;
#pragma unroll
                for (int bj = 0; bj < 2; ++bj)
#pragma unroll
                    for (int n = 0; n < 2; ++n) *(f32x4*)(rowp + bj * HALF + n * 4) = acc[ai][bj][m][n]; }
    }
};
struct EpiGate {
    static constexpr bool PERM = true;
    bf16* T; int ldc; const bf16* Pg; int ldp; int gcol0; bool ADD;
    __device__ __forceinline__ void operator()(const f32x4 (&acc)[2][2][4][2], const Unit& u, int wr, int wc, int fr, int fq) const {
        const int row0 = u.pm * BM + wr * 64 + fr, col0 = u.pn * BM + wc * 32 + 8 * fq;
#pragma unroll
        for (int ai = 0; ai < 2; ++ai)
#pragma unroll
            for (int m = 0; m < 4; ++m) { const size_t row = (size_t)(row0 + ai * HALF + m * 16);
#pragma unroll
                for (int bj = 0; bj < 2; ++bj) { const f32x4 v0 = acc[ai][bj][m][0], v1 = acc[ai][bj][m][1];
                    const u32x4 g = *(const u32x4*)(Pg + row * ldp + gcol0 + col0 + bj * HALF);
                    u32x4 t = {0u, 0u, 0u, 0u}; if (ADD) t = *(const u32x4*)(T + row * ldc + col0 + bj * HALF);
                    float o[8];
#pragma unroll
                    for (int j = 0; j < 4; ++j) { const float a0 = j < 2 ? v0[2 * j] : v1[2 * j - 4], a1 = j < 2 ? v0[2 * j + 1] : v1[2 * j - 3];
                        o[2 * j] = bflo(t[j]) + sigmoidf_(bflo(g[j])) * a0; o[2 * j + 1] = bfhi(t[j]) + sigmoidf_(bfhi(g[j])) * a1; }
                    u32x4 w; w[0] = cvt_pk_bf16(o[0], o[1]); w[1] = cvt_pk_bf16(o[2], o[3]); w[2] = cvt_pk_bf16(o[4], o[5]); w[3] = cvt_pk_bf16(o[6], o[7]);
                    *(u32x4*)(T + row * ldc + col0 + bj * HALF) = w; } }
    }
};
struct EpiSwiglu {
    static constexpr bool PERM = true;
    bf16* O; int ldc; int NT;
    __device__ __forceinline__ void operator()(const f32x4 (&acc)[2][2][4][2], const Unit& u, int wr, int wc, int fr, int fq) const {
        const int row0 = u.pm * BM + wr * 64 + fr, col0 = (u.pn % NT) * HALF + wc * 32 + 8 * fq;
#pragma unroll
        for (int ai = 0; ai < 2; ++ai)
#pragma unroll
            for (int m = 0; m < 4; ++m) { bf16* rowp = O + (size_t)(row0 + ai * HALF + m * 16) * ldc + col0;
                float o[8];
#pragma unroll
                for (int j = 0; j < 8; ++j) { const float g = acc[ai][0][m][j >> 2][j & 3], uu = acc[ai][1][m][j >> 2][j & 3]; o[j] = g / (1.0f + expf(-g)) * uu; }
                u32x4 w; w[0] = cvt_pk_bf16(o[0], o[1]); w[1] = cvt_pk_bf16(o[2], o[3]); w[2] = cvt_pk_bf16(o[4], o[5]); w[3] = cvt_pk_bf16(o[6], o[7]);
                *(u32x4*)rowp = w; }
    }
};
struct EpiMoeDown {
    static constexpr bool PERM = true;
    bf16* O; int ldc; int NT;
    __device__ __forceinline__ void operator()(const f32x4 (&acc)[2][2][4][2], const Unit& u, int wr, int wc, int fr, int fq) const {
        const int row0 = u.pm * BM + wr * 64 + fr, col0 = (u.pn % NT) * BM + wc * 32 + 8 * fq;
#pragma unroll
        for (int ai = 0; ai < 2; ++ai)
#pragma unroll
            for (int m = 0; m < 4; ++m) { bf16* rowp = O + (size_t)(row0 + ai * HALF + m * 16) * ldc + col0;
#pragma unroll
                for (int bj = 0; bj < 2; ++bj) { const f32x4 v0 = acc[ai][bj][m][0], v1 = acc[ai][bj][m][1];
                    u32x4 w; w[0] = cvt_pk_bf16(v0[0], v0[1]); w[1] = cvt_pk_bf16(v0[2], v0[3]); w[2] = cvt_pk_bf16(v1[0], v1[1]); w[3] = cvt_pk_bf16(v1[2], v1[3]);
                    *(u32x4*)(rowp + bj * HALF) = w; } }
    }
};

struct EpiBf16OrF32 { static constexpr bool PERM = true; bf16* O; float* C; int ldc; bool f32;
    __device__ __forceinline__ void operator()(const f32x4 (&acc)[2][2][4][2], const Unit& u, int wr, int wc, int fr, int fq) const {
        if (f32) { EpiF32 E{C, ldc}; E(acc, u, wr, wc, fr, fq); } else { EpiBf16 E{O, ldc}; E(acc, u, wr, wc, fr, fq); } } };
struct EpiMoe { static constexpr bool PERM = true; bf16* O; int ldc; int NT; bool swiglu;
    __device__ __forceinline__ void operator()(const f32x4 (&acc)[2][2][4][2], const Unit& u, int wr, int wc, int fr, int fq) const {
        if (swiglu) { EpiSwiglu E{O, ldc, NT}; E(acc, u, wr, wc, fr, fq); } else { EpiMoeDown E{O, ldc, NT}; E(acc, u, wr, wc, fr, fq); } } };
template <class Epi, class Sched>
__device__ __forceinline__ void gemm_phase(LAS unsigned char* lds, const Gemm g, const Sched& S, const Epi& E) {
    const int tid = threadIdx.x + vgpr_zero();
    const int wid = READFIRSTLANE(tid >> 6), lane = tid & 63, wr = wid >> 2, wc = wid & 3, fr = lane & 15, fq = lane >> 4;
    const int K = g.K, nt = K / BK;
    unsigned long long voffA[2], voffB[2]; const unsigned long long zhi = vgpr_zero64();
#pragma unroll
    for (int i = 0; i < 2; ++i) { int R, C; stage_rc(tid * 16 + i * 8192, R, C); const int Rb = Epi::PERM ? ((R & ~31) + perm32(R & 31)) : R;
        voffA[i] = zhi + (unsigned long long)(long long)((R * K + C) * 2); voffB[i] = zhi + (unsigned long long)(long long)((Rb * K + C) * 2); }
    const size_t kstep = (size_t)(BK * 2);
    const size_t hstep = (size_t)HALF * K * 2;
    const size_t tstep = 2 * hstep;
    const unsigned ldsw = (unsigned)wid * 1024u;
    const int aoff = lds_byte(wr * 64 + fr, fq * 8), boff = lds_byte(wc * 32 + fr, fq * 8);
#define PG8_SA(b, h) (((b) * 2 + (h)) * HTB)
#define PG8_SB(b, h) ((4 + (b) * 2 + (h)) * HTB)
#define PG8_STAGE(bufoff, gbase, voff) do { _Pragma("unroll") for (int _i = 0; _i < 2; ++_i) \
        GLDS16((const char*)(gbase) + (voff)[_i], lds + (bufoff) + ldsw + _i * 8192); } while (0)
#define PG8_LDA(dst, b, h) do { _Pragma("unroll") for (int m = 0; m < 4; ++m) _Pragma("unroll") for (int k = 0; k < 2; ++k) dst[m][k] = *(const LAS bf16x8*)(lds + PG8_SA(b, h) + aoff + m * 2048 + k * 1024); } while (0)
#define PG8_LDB(dst, b, h) do { _Pragma("unroll") for (int n = 0; n < 2; ++n) _Pragma("unroll") for (int k = 0; k < 2; ++k) dst[n][k] = *(const LAS bf16x8*)(lds + PG8_SB(b, h) + boff + n * 2048 + k * 1024); } while (0)
#define PG8_MMA(ai, bj, At, Bt) do { SETPRIO(1); _Pragma("unroll") for (int m = 0; m < 4; ++m) _Pragma("unroll") for (int n = 0; n < 2; ++n) _Pragma("unroll") for (int k = 0; k < 2; ++k) \
        acc[ai][bj][m][n] = MFMA16(Bt[n][k], At[m][k], acc[ai][bj][m][n]); SETPRIO(0); } while (0)
#define PG8_BAR S_BARRIER()
    Unit cur, nxt; int ui = 0;
    if (!S.next(0, cur)) return;
    f32x4 acc[2][2][4][2];
#pragma unroll
    for (int a = 0; a < 2; ++a)
#pragma unroll
        for (int b = 0; b < 2; ++b)
#pragma unroll
            for (int m = 0; m < 4; ++m)
#pragma unroll
                for (int n = 0; n < 2; ++n) acc[a][b][m][n] = (f32x4){0.f, 0.f, 0.f, 0.f};
    bf16x8 At[4][2], B0[2][2], B1[2][2];
    const char* cA = (const char*)g.A + (size_t)cur.pm * tstep; const char* cB = (const char*)g.Bt + (size_t)cur.pn * tstep;
    PG8_STAGE(PG8_SB(0, 0), cB, voffB); PG8_STAGE(PG8_SA(0, 0), cA, voffA); PG8_STAGE(PG8_SB(0, 1), cB + hstep, voffB); PG8_STAGE(PG8_SA(0, 1), cA + hstep, voffA);
    if (wr == 1) PG8_BAR;
    ASM_WAIT_V(4); PG8_BAR;
    PG8_STAGE(PG8_SB(1, 0), cB + kstep, voffB); PG8_STAGE(PG8_SA(1, 0), cA + kstep, voffA); PG8_STAGE(PG8_SB(1, 1), cB + hstep + kstep, voffB);
    ASM_WAIT_V(6); PG8_BAR;
    for (;;) {
        const bool has_next = S.next(ui + 1, nxt);
        const char* nA = has_next ? (const char*)g.A + (size_t)nxt.pm * tstep : cA; const char* nB = has_next ? (const char*)g.Bt + (size_t)nxt.pn * tstep : cB;
        for (int t = 0; t < nt; t += 2) {
            const bool last = (t == nt - 2);
            const char* a1 = cA + (size_t)(t + 1) * kstep;
            const char* a2 = last ? nA : cA + (size_t)(t + 2) * kstep; const char* b2 = last ? nB : cB + (size_t)(t + 2) * kstep;
            const char* a3 = a2 + kstep; const char* b3 = b2 + kstep;
            PG8_LDB(B0, 0, 0); SCHED_BARRIER(); PG8_LDA(At, 0, 0); PG8_STAGE(PG8_SA(1, 1), a1 + hstep, voffA);
            ASM_WAIT_L(8); PG8_BAR; ASM_WAIT_L(0); PG8_MMA(0, 0, At, B0); PG8_BAR; SCHED_BARRIER();
            PG8_LDB(B1, 0, 1); PG8_STAGE(PG8_SB(0, 0), b2, voffB);
            PG8_BAR; ASM_WAIT_L(0); PG8_MMA(0, 1, At, B1); PG8_BAR;
            PG8_LDA(At, 0, 1); PG8_STAGE(PG8_SA(0, 0), a2, voffA);
            PG8_BAR; ASM_WAIT_L(0); PG8_MMA(1, 0, At, B0); PG8_BAR; SCHED_BARRIER();
            PG8_STAGE(PG8_SB(0, 1), b2 + hstep, voffB);
            ASM_WAIT_V(6); PG8_BAR; PG8_MMA(1, 1, At, B1); PG8_BAR;
            PG8_LDB(B0, 1, 0); SCHED_BARRIER(); PG8_LDA(At, 1, 0); PG8_STAGE(PG8_SA(0, 1), a2 + hstep, voffA);
            ASM_WAIT_L(8); PG8_BAR; ASM_WAIT_L(0); PG8_MMA(0, 0, At, B0); PG8_BAR; SCHED_BARRIER();
            PG8_LDB(B1, 1, 1); PG8_STAGE(PG8_SB(1, 0), b3, voffB);
            PG8_BAR; ASM_WAIT_L(0); PG8_MMA(0, 1, At, B1); PG8_BAR;
            PG8_LDA(At, 1, 1); PG8_STAGE(PG8_SA(1, 0), a3, voffA);
            PG8_BAR; ASM_WAIT_L(0); PG8_MMA(1, 0, At, B0); PG8_BAR; SCHED_BARRIER();
            PG8_STAGE(PG8_SB(1, 1), b3 + hstep, voffB);
            ASM_WAIT_V(6); PG8_BAR; PG8_MMA(1, 1, At, B1); PG8_BAR;
        }
        E(acc, cur, wr, wc, fr, fq);
        if (!has_next) break;
#pragma unroll
        for (int a = 0; a < 2; ++a)
#pragma unroll
            for (int b = 0; b < 2; ++b)
#pragma unroll
                for (int m = 0; m < 4; ++m)
#pragma unroll
                    for (int n = 0; n < 2; ++n) acc[a][b][m][n] = (f32x4){0.f, 0.f, 0.f, 0.f};
        cur = nxt; cA = nA; cB = nB; ++ui;
    }
    ASM_WAIT_V(0);
    if (wr == 0) PG8_BAR;
    PG8_BAR;
#undef PG8_SA
#undef PG8_SB
#undef PG8_STAGE
#undef PG8_LDA
#undef PG8_LDB
#undef PG8_MMA
#undef PG8_BAR
}
}

struct Args { const float* in[N_IN]; float* out; unsigned char* ws; int ph_lo, ph_hi; };
constexpr int NWAVES = 8, NTHR = 512;
constexpr int LDS_STAGE = 131072, LDS_MISC = LDS_STAGE, LDS_BYTES = 147456;

constexpr int PT_OUT = N_IN, PT_WS = N_IN + 1, PT_WORD0 = 128;

struct Ctx {
    LAS unsigned char* lds; int tid, lane, wave, G, bid;
    __device__ __forceinline__ unsigned long long ptr(int i) const { const volatile LAS unsigned* t = (const volatile LAS unsigned*)(lds + LDS_MISC) + PT_WORD0 + 2 * i;
        const unsigned lo = (unsigned)READFIRSTLANE((int)t[0]), hi = (unsigned)READFIRSTLANE((int)t[1]); return ((unsigned long long)hi << 32) | lo; }
    __device__ __forceinline__ unsigned long long ptrv(int i) const { const volatile LAS unsigned* t = (const volatile LAS unsigned*)(lds + LDS_MISC) + PT_WORD0 + 2 * i; return ((unsigned long long)t[1] << 32) | t[0]; }
    __device__ __forceinline__ const float* inv(int i) const { return as_global((const float*)ptrv(i)); }
    template <class T> __device__ __forceinline__ T* wsv(size_t off) const { return as_global((T*)((unsigned char*)ptrv(PT_WS) + off)); }
    __device__ __forceinline__ const float* in(int i) const { return as_global((const float*)ptr(i)); }
    __device__ __forceinline__ float* out() const { return as_global((float*)ptr(PT_OUT)); }
    template <class T> __device__ __forceinline__ T* ws(size_t off) const { return as_global((T*)((unsigned char*)ptr(PT_WS) + off)); }
    __device__ __forceinline__ unsigned* ctl() const { return as_global((unsigned*)ptr(PT_WS)); }
};

__device__ __forceinline__ void transpose_item(const float* W, int ldw, int k0, int n0, int nvalid, bf16* outp, int ldo, LAS float* scr, int lane) {
#pragma unroll
    for (int i = 0; i < 32; ++i) { const int kk = 2 * i + (lane >> 5), n = n0 + (lane & 31); scr[kk * 33 + (lane & 31)] = (n < nvalid) ? W[(size_t)(k0 + kk) * ldw + n] : 0.f; }
    WAVE_LDS_FENCE(); CFENCE();
    const int c = lane & 7;
#pragma unroll
    for (int j = 0; j < 4; ++j) { const int n = (lane >> 3) + 8 * j; const LAS float* s = scr + (8 * c) * 33 + n;
        u32x4 o; o[0] = pk2(s[0 * 33], s[1 * 33]); o[1] = pk2(s[2 * 33], s[3 * 33]); o[2] = pk2(s[4 * 33], s[5 * 33]); o[3] = pk2(s[6 * 33], s[7 * 33]);
        *(u32x4*)(outp + (size_t)n * ldo + k0 + 8 * c) = o; }
    WAVE_LDS_FENCE(); CFENCE();
}
__device__ __forceinline__ void filter_item(const Ctx& X, int l, int n, int pos0, float* out  , LAS float* scr  , LAS float* asum  ) {
    const int lane = X.lane;
    LAS float* zs = scr; LAS float* ha = scr + 8 * 33; LAS float* hb = ha + 8 * 64;
    const float* w1 = X.in(I_FW1) + (size_t)l * 33 * 64; const float* b1 = X.in(I_FB1) + l * 64;
    const float* w2 = X.in(I_FW2) + (size_t)l * 64 * 64; const float* b2 = X.in(I_FB2) + l * 64;
    const float* w3 = X.in(I_FW3) + (size_t)l * 64 * 64; const float* b3 = X.in(I_FB3) + l * 64;
    const float* wo = X.in(I_FWO) + (size_t)l * 64 * HW; const float fr = X.in(I_FREQ)[l * 64 + lane];
    if (lane < 33) {
#pragma unroll
        for (int p = 0; p < 8; ++p) { const int pos = pos0 + p; float v;
            if (lane == 0) v = (float)pos / (float)(n - 1 > 1 ? n - 1 : 1);
            else { const int b = (lane - 1) & 15; const double band = 1e-4 + (double)b * ((15.0 - 1e-4) / 15.0);
                double rev = (double)pos * band / (double)n; rev -= floor(rev); if (rev > 0.5) rev -= 1.0;
                float s, c; sincos_f((float)(rev * 6.283185307179586476925), s, c); v = lane <= 16 ? c : -s; }
            zs[p * 33 + lane] = v; }
    }
    WAVE_LDS_FENCE(); CFENCE();
    float acc[8];
    { const float bb = b1[lane];
#pragma unroll
      for (int p = 0; p < 8; ++p) acc[p] = bb;
#pragma unroll 3
      for (int i = 0; i < 33; ++i) { const float w = w1[i * 64 + lane];
#pragma unroll
          for (int p = 0; p < 8; ++p) acc[p] += zs[p * 33 + i] * w; }
#pragma unroll
      for (int p = 0; p < 8; ++p) ha[p * 64 + lane] = sin_f(fr * acc[p]); }
    WAVE_LDS_FENCE(); CFENCE();
    { const float bb = b2[lane];
#pragma unroll
      for (int p = 0; p < 8; ++p) acc[p] = bb;
#pragma unroll 4
      for (int i = 0; i < 64; ++i) { const float w = w2[i * 64 + lane];
#pragma unroll
          for (int p = 0; p < 8; ++p) acc[p] += ha[p * 64 + i] * w; }
#pragma unroll
      for (int p = 0; p < 8; ++p) hb[p * 64 + lane] = sin_f(fr * acc[p]); }
    WAVE_LDS_FENCE(); CFENCE();
    { const float bb = b3[lane];
#pragma unroll
      for (int p = 0; p < 8; ++p) acc[p] = bb;
#pragma unroll 4
      for (int i = 0; i < 64; ++i) { const float w = w3[i * 64 + lane];
#pragma unroll
          for (int p = 0; p < 8; ++p) acc[p] += hb[p * 64 + i] * w; }
#pragma unroll
      for (int p = 0; p < 8; ++p) ha[p * 64 + lane] = sin_f(fr * acc[p]); }
    WAVE_LDS_FENCE(); CFENCE();
    const float dmin = -3.0701134573253944f, dmax = -15.350567286626972f;
#pragma unroll 1
    for (int mI = 0; mI < HW / 64; ++mI) { const int c = lane + 64 * mI;
#pragma unroll
        for (int p = 0; p < 8; ++p) acc[p] = 0.f;
#pragma unroll 4
        for (int i = 0; i < 64; ++i) { const float w = wo[i * HW + c];
#pragma unroll
            for (int p = 0; p < 8; ++p) acc[p] += ha[p * 64 + i] * w; }
        const float delta = fabsf(dmin + (float)c * ((dmax - dmin) / (float)(HW - 1)));
        float as = 0.f;
#pragma unroll
        for (int p = 0; p < 8; ++p) { const int pos = pos0 + p; const int dd = pos - n / 2; const float dist = (float)(dd < 0 ? -dd : dd) * (2.0f / (float)n);
            const float v = acc[p] * expf(-dist * delta); out[(size_t)c * n + pos] = v; as += fabsf(v); }
        asum[c] += as; }
    WAVE_LDS_FENCE(); CFENCE();
}
__device__ __forceinline__ void phase_transposes(const Ctx& X, int l, int part) {
    LAS float* scr = (LAS float*)(X.lds + X.wave * 16384);
    const bool shifted = part == 1 && X.G > N_SEQ_UNITS; const int myb = shifted ? X.bid - N_SEQ_UNITS : X.bid, nb_ = shifted ? X.G - N_SEQ_UNITS : X.G;
    if (myb < 0) return;
    const int gw = myb * NWAVES + X.wave, NGW = nb_ * NWAVES, lane = X.lane;
    constexpr int KB_D = D / 64, I_WIN_ = KB_D * (PCP / 32), I_WB_ = 2 * (RW / 64) * (D / 32), I_WO_ = KB_D * (D / 32), I_WGU_ = NE * 2 * KB_D * (D / 32), I_WD_ = NE * KB_D * (D / 32);
    constexpr int I_LORA_ = 6 * (RW / 32); constexpr int N0 = I_WIN_ + I_WB_ + I_WO_, NITEMS = N0 + I_WGU_ + I_WD_;
    if (part == 0) for (int it = gw; it < I_LORA_; it += NGW) { const int which = it / (RW / 32), nb = it % (RW / 32);
        const float* W; int k0 = 0, ldo = 64; bf16* outp;
        if (which < 2) { W = X.in(I_W2) + ((size_t)l * 2 + which) * 64 * RW; outp = X.ws<bf16>(WS_W2T) + (size_t)which * RW * 64 + (size_t)(32 * nb) * 64; }
        else if (which < 4) { W = X.in(I_A2) + ((size_t)l * 2 + (which - 2)) * 64 * RW; outp = X.ws<bf16>(WS_A2T) + (size_t)(which - 2) * RW * 64 + (size_t)(32 * nb) * 64; }
        else { W = X.in(I_G2) + (size_t)l * 128 * RW; k0 = 64 * (which - 4); ldo = 128; outp = X.ws<bf16>(WS_G2T) + (size_t)(32 * nb) * 128; }
        transpose_item(W, RW, k0, 32 * nb, RW, outp, ldo, scr, lane); }
    const int it_end = part ? NITEMS : N0; int it = (part ? N0 : 0) + gw;
    const float* W; int ldw, k0, n0, nvalid, ldo; bf16* outp; float v[32];
#define TR_PARAMS(it_) do { int r = (it_); \
        if (r < I_WIN_) { const int nb = r % (PCP / 32), kb = r / (PCP / 32); W = X.in(I_WIN) + (size_t)l * D * PC; ldw = PC; k0 = 64 * kb; n0 = 32 * nb; nvalid = PC; outp = X.ws<bf16>(WS_WIN) + (size_t)n0 * D; ldo = D; } \
        else if ((r -= I_WIN_) < I_WB_) { const int s_ = r / ((RW / 64) * (D / 32)), q = r % ((RW / 64) * (D / 32)), nb = q % (D / 32), kb = q / (D / 32); \
            W = X.in(I_WBR) + ((size_t)l * 2 + s_) * RW * D; ldw = D; k0 = 64 * kb; n0 = 32 * nb; nvalid = D; outp = X.ws<bf16>(WS_WB) + (size_t)s_ * D * RW + (size_t)n0 * RW; ldo = RW; } \
        else if ((r -= I_WB_) < I_WO_) { const int nb = r % (D / 32), kb = r / (D / 32); W = X.in(I_WOUT) + (size_t)l * D * D; ldw = D; k0 = 64 * kb; n0 = 32 * nb; nvalid = D; outp = X.ws<bf16>(WS_WO) + (size_t)n0 * D; ldo = D; } \
        else if ((r -= I_WO_) < I_WGU_) { const int per = KB_D * (D / 32), es = r / per, q = r % per, e = es >> 1, src = es & 1, nb = q % (D / 32), kb = q / (D / 32); n0 = 32 * nb; \
            W = (src ? X.in(I_WU) : X.in(I_WG)) + ((size_t)l * NE + e) * D * D; ldw = D; k0 = 64 * kb; nvalid = D; const int orow = e * 2 * D + (n0 / 128) * 256 + src * 128 + (n0 % 128); \
            outp = X.ws<bf16>(WS_WGU) + (size_t)orow * D; ldo = D; } \
        else { r -= I_WGU_; const int per = KB_D * (D / 32), e = r / per, q = r % per, nb = q % (D / 32), kb = q / (D / 32); \
            W = X.in(I_WD) + ((size_t)l * NE + e) * D * D; ldw = D; k0 = 64 * kb; n0 = 32 * nb; nvalid = D; outp = X.ws<bf16>(WS_WD) + (size_t)(e * D + n0) * D; ldo = D; } } while (0)
#define TR_LOAD() do { const int n = n0 + (lane & 31); const float* wp = W + (size_t)(k0 + (lane >> 5)) * ldw + n; _Pragma("unroll") for (int i = 0; i < 32; ++i) v[i] = (n < nvalid) ? wp[(size_t)(2 * i) * ldw] : 0.f; } while (0)
    if (it < it_end) { TR_PARAMS(it); TR_LOAD(); }
    while (it < it_end) {
#pragma unroll
        for (int i = 0; i < 32; ++i) scr[(2 * i + (lane >> 5)) * 33 + (lane & 31)] = v[i];
        WAVE_LDS_FENCE(); CFENCE();
        bf16* const cout_ = outp; const int ck0 = k0, cldo = ldo;
        it += NGW;
        if (it < it_end) { TR_PARAMS(it); TR_LOAD(); }
        const int c = lane & 7;
#pragma unroll
        for (int j = 0; j < 4; ++j) { const int n = (lane >> 3) + 8 * j; const LAS float* s_ = scr + (8 * c) * 33 + n;
            u32x4 o; o[0] = pk2(s_[0 * 33], s_[1 * 33]); o[1] = pk2(s_[2 * 33], s_[3 * 33]); o[2] = pk2(s_[4 * 33], s_[5 * 33]); o[3] = pk2(s_[6 * 33], s_[7 * 33]);
            *(u32x4*)(cout_ + (size_t)n * cldo + ck0 + 8 * c) = o; }
        WAVE_LDS_FENCE(); CFENCE();
    }
#undef TR_PARAMS
#undef TR_LOAD
}
__device__ __forceinline__ void phase_filters(const Ctx& X, int l) {
    LAS float* scr = (LAS float*)(X.lds + X.wave * 8192);
    const int gw = X.bid * NWAVES + X.wave, NGW = X.G * NWAVES, lane = X.lane;
    LAS float* part = (LAS float*)(X.lds + 65536);
    static_assert(65536 + NWAVES * 2 * HW * 4 <= LDS_STAGE, "filter LDS map");
    for (int i = lane; i < 2 * HW; i += 64) part[X.wave * 2 * HW + i] = 0.f;
    WAVE_LDS_FENCE(); CFENCE();
    float* filt = X.ws<float>(WS_FILT);
    for (int it = gw; it < SEQ / 8; it += NGW) filter_item(X, l, SEQ, 8 * it, filt, scr, part + (X.wave * 2 + 0) * HW);
    for (int it = gw; it < CTX / 8; it += NGW) filter_item(X, l, CTX, 8 * it, filt + (size_t)HW * SEQ, scr, part + (X.wave * 2 + 1) * HW);
    __syncthreads();
    for (int i = X.tid; i < 2 * HW; i += NTHR) { float s = 0.f;
#pragma unroll
        for (int w = 0; w < NWAVES; ++w) s += part[w * 2 * HW + i];
        X.ws<float>(WS_FPART)[((size_t)(i / HW) * NPART + X.bid) * HW + (i % HW)] = s; }
    __syncthreads();
}
__device__ __forceinline__ void phase_mod(const Ctx& X) {
    const int lane = X.lane;
    LAS float* red = (LAS float*)X.lds;
    constexpr int NIT = DEPTH * (6 * D / 64);
    for (int it = X.bid; it < NIT; it += X.G) {
        const int ll = it / (6 * D / 64), n0 = (it % (6 * D / 64)) * 64;
        const float* W = X.in(I_WMOD) + (size_t)ll * D * 6 * D; const float* cv = X.in(I_C); const float* cc = X.in(I_CCTX);
        float s0 = 0.f, s1 = 0.f;
#pragma unroll 8
        for (int k = X.wave * (D / 8); k < (X.wave + 1) * (D / 8); ++k) { const float wv = W[(size_t)k * 6 * D + n0 + lane]; const float c0 = cv[k], c1 = cc[k];
            s0 += c0 * sigmoidf_(c0) * wv; s1 += c1 * sigmoidf_(c1) * wv; }
        red[(X.wave * 64 + lane) * 2] = s0; red[(X.wave * 64 + lane) * 2 + 1] = s1;
        __syncthreads();
        if (X.wave == 0) { float t0 = 0.f, t1 = 0.f;
#pragma unroll
            for (int w = 0; w < NWAVES; ++w) { t0 += red[(w * 64 + lane) * 2]; t1 += red[(w * 64 + lane) * 2 + 1]; }
            const float bm = X.in(I_BMOD)[(size_t)ll * 6 * D + n0 + lane];
            float* MOD = X.ws<float>(WS_MOD);
            MOD[((size_t)ll * 2 + 0) * 6 * D + n0 + lane] = t0 + bm; MOD[((size_t)ll * 2 + 1) * 6 * D + n0 + lane] = t1 + bm; }
        __syncthreads();
    }
}
__device__ __forceinline__ const float* modp(const Ctx& X, int l, int t, int j) { return X.ws<float>(WS_MOD) + ((size_t)l * 2 + (t < CTX ? 1 : 0)) * 6 * D + (size_t)j * D; }

__device__ __forceinline__ void phase_x0(const Ctx& X) {
    const int gw = X.bid * NWAVES + X.wave, NGW = X.G * NWAVES, lane = X.lane;
    for (int t = gw; t < M; t += NGW) {
        const float* src = t < CTX ? X.in(I_CTX) + (size_t)t * D : X.in(I_X) + (size_t)(t - CTX) * D;
        const float* sh = modp(X, 0, t, 0); const float* sc = modp(X, 0, t, 1);
        float* xr = X.ws<float>(WS_X) + (size_t)t * D; bf16* xm = X.ws<bf16>(WS_XMOD) + (size_t)t * D;
#pragma unroll
        for (int j = 0; j < D / 256; ++j) { const int d = 4 * lane + 256 * j; const f32x4 v = *(const f32x4*)(src + d), a = *(const f32x4*)(sh + d), b = *(const f32x4*)(sc + d);
            *(f32x4*)(xr + d) = v;
            unsigned w0 = pk2(v[0] * (1.f + b[0]) + a[0], v[1] * (1.f + b[1]) + a[1]), w1 = pk2(v[2] * (1.f + b[2]) + a[2], v[3] * (1.f + b[3]) + a[3]);
            *(unsigned long long*)(xm + d) = (unsigned long long)w0 | ((unsigned long long)w1 << 32); }
    }
}

__device__ __forceinline__ int shift_row(int t, int col, bool& valid) {
    const bool isctx = t < CTX;
    const int i = t - CTX, gx = i & (GRID_W - 1), gy = i / GRID_W, q = col / QTR;
    const int offl = (q == 0) ? -1 : (q == 1) ? 1 : (q == 2) ? -GRID_W : GRID_W;
    const bool vl = (q == 0) ? (gx > 0) : (q == 1) ? (gx < GRID_W - 1) : (q == 2) ? (gy > 0) : (gy < GRID_H - 1);
    const bool first = col < HALFC;
    const int offc = first ? -1 : 1; const bool vc = first ? (t > 0) : (t < CTX - 1);
    valid = isctx ? vc : vl;
    return valid ? t + (isctx ? offc : offl) : t;
}
__device__ __forceinline__ float pm_val(const bf16* P, const float* mu, int t, int col) {
    const float p0 = bf2f(P[(size_t)t * PCP + col]); bool valid; const int nr = shift_row(t, col, valid);
    const float pn = bf2f(P[(size_t)nr * PCP + col]); const float p1 = valid ? pn : 0.f;
    return p0 + (p1 - p0) * mu[col];
}
constexpr int LP = 72;
constexpr int LQ = 65;
constexpr int LX = 68;
__device__ __forceinline__ f32x4 mm_tile(const LAS bf16* A, const LAS bf16* Bt, int ti, int tj, int lane, f32x4 acc) {
    const LAS bf16* pa = A + (16 * ti + (lane & 15)) * LP + 8 * (lane >> 4); const LAS bf16* pb = Bt + (16 * tj + (lane & 15)) * LP + 8 * (lane >> 4);
#pragma unroll
    for (int kk = 0; kk < 2; ++kk) { const bf16x8 a = *(const LAS bf16x8*)(pa + 32 * kk), b = *(const LAS bf16x8*)(pb + 32 * kk); acc = MFMA16(a, b, acc); }
    return acc;
}
constexpr int TT = 8;
__device__ __forceinline__ void phase_lin(const Ctx& X, int l) {
    const bf16* P = X.ws<bf16>(WS_P); const float* mu = X.in(I_MU) + (size_t)l * RC; bf16* LIN = X.ws<bf16>(WS_LIN);
    for (size_t idx = (size_t)X.bid * NTHR + X.tid; idx < (size_t)M * 384; idx += (size_t)X.G * NTHR) { const int t = (int)(idx / 384), j = (int)(idx % 384);
        float v = pm_val(P, mu, t, C_LWF + j);
        if (j < 128) v = tanhf(v); else if (j >= 256) v = sigmoidf_(v);
        LIN[idx] = (bf16)f2bf(v); }
}
__device__ __forceinline__ f32x4 mm_tile_p(const LAS bf16* A, int lda, const LAS bf16* Bt, int ldb, int ks, int ti, int tj, int lane, f32x4 acc) {
    const LAS bf16* pa = A + (16 * ti + (lane & 15)) * lda + 8 * (lane >> 4); const LAS bf16* pb = Bt + (16 * tj + (lane & 15)) * ldb + 8 * (lane >> 4);
    for (int kk = 0; kk < ks; ++kk) { const bf16x8 a = *(const LAS bf16x8*)(pa + 32 * kk), b = *(const LAS bf16x8*)(pb + 32 * kk); acc = MFMA16(a, b, acc); }
    return acc;
}
constexpr int GP = 136;
__device__ __forceinline__ void lora_unit_a(const Ctx& X, int unit) {
    const int b = unit / NH, h = unit % NH, tid = X.tid, lane = X.lane, w = X.wave;
    LAS bf16* Ab = (LAS bf16*)X.lds; LAS bf16* Gb = Ab + 4 * 64 * LP; LAS bf16* Wb = Gb + 64 * GP; LAS bf16* G2b = Wb + 4 * 64 * LP;
    LAS float* OUT = (LAS float*)X.lds;
    static_assert((8 * 64 * LP + 2 * 64 * GP) * 2 <= LDS_STAGE && 5 * 64 * LQ * 4 <= LDS_STAGE, "lora LDS map");
    const bf16* LIN = X.wsv<bf16>(WS_LIN) + (size_t)(64 * b) * 384;
    for (int i = tid; i < 64 * 48; i += NTHR) { const int t = i / 48, c16 = i % 48; const u32x4 v = *(const u32x4*)(LIN + (size_t)t * 384 + 8 * c16);
        if (c16 < 32) *(LAS u32x4*)(Ab + (c16 >> 3) * 64 * LP + t * LP + 8 * (c16 & 7)) = v; else *(LAS u32x4*)(Gb + t * GP + 8 * (c16 - 32)) = v; }
    const bf16* w2t = X.wsv<bf16>(WS_W2T) + (size_t)(64 * h) * 64; const bf16* a2t = X.wsv<bf16>(WS_A2T) + (size_t)(64 * h) * 64; const bf16* g2t = X.wsv<bf16>(WS_G2T) + (size_t)(64 * h) * 128;
    for (int i = tid; i < 4 * 64 * 8; i += NTHR) { const int q = i / 512, c = (i / 8) % 64, c16 = i % 8; const bf16* src = (q < 2 ? w2t + (size_t)q * RW * 64 : a2t + (size_t)(q - 2) * RW * 64) + c * 64 + 8 * c16;
        *(LAS u32x4*)(Wb + q * 64 * LP + c * LP + 8 * c16) = *(const u32x4*)src; }
    for (int i = tid; i < 64 * 16; i += NTHR) { const int c = i / 16, c16 = i % 16; *(LAS u32x4*)(G2b + c * GP + 8 * c16) = *(const u32x4*)(g2t + c * 128 + 8 * c16); }
    __syncthreads();
    f32x4 o[2][5];
#pragma unroll
    for (int q = 0; q < 2; ++q) { const int tile = 2 * w + q, ti = tile >> 2, tj = tile & 3; const f32x4 z4 = {0.f, 0.f, 0.f, 0.f};
#pragma unroll
        for (int p = 0; p < 4; ++p) o[q][p] = mm_tile(Ab + p * 64 * LP, Wb + p * 64 * LP, ti, tj, lane, z4);
        o[q][4] = mm_tile_p(Gb, GP, G2b, GP, 4, ti, tj, lane, z4); }
    __syncthreads();
#pragma unroll
    for (int q = 0; q < 2; ++q) { const int tile = 2 * w + q, ti = tile >> 2, tj = tile & 3, col = 16 * tj + (lane & 15);
#pragma unroll
        for (int p = 0; p < 5; ++p)
#pragma unroll
            for (int r = 0; r < 4; ++r) OUT[(p * 64 + 16 * ti + 4 * (lane >> 4) + r) * LQ + col] = o[q][p][r]; }
    __syncthreads();
}
__device__ __forceinline__ void lora_unit_b(const Ctx& X, int l, int unit) {
    const int b = unit / NH, h = unit % NH, w = X.wave, k = X.lane, c = 64 * h + k;
    const LAS float* OUT = (const LAS float*)X.lds;
    const bf16* P = X.wsv<bf16>(WS_P); const float* mu = X.inv(I_MU) + (size_t)l * RC;
    const float w00 = X.inv(I_W0)[(size_t)(l * 2 + 0) * RW + c], w01 = X.inv(I_W0)[(size_t)(l * 2 + 1) * RW + c];
    const float a00 = X.inv(I_A0)[(size_t)(l * 2 + 0) * RW + c], a01 = X.inv(I_A0)[(size_t)(l * 2 + 1) * RW + c];
    const float kkc = X.inv(I_KK)[(size_t)l * RW + c], kac = X.inv(I_KA)[(size_t)l * RW + c], rkc = X.inv(I_RK)[(size_t)l * RW + c];
    bf16* pR = X.wsv<bf16>(WS_R); bf16* pV = X.wsv<bf16>(WS_V); bf16* pKA = X.wsv<bf16>(WS_KA); bf16* pKD = X.wsv<bf16>(WS_KD); bf16* pKB = X.wsv<bf16>(WS_KB); float* pW = X.wsv<float>(WS_W); bf16* pG = X.wsv<bf16>(WS_GATE); float* pBo = X.wsv<float>(WS_BONUS);
    const int vz = vgpr_zero();
#pragma unroll
    for (int i = 0; i < 8; ++i) { const int tl = 8 * w + i, t = 64 * b + tl + vz;
        const float r = pm_val(P, mu, t, c), kx = pm_val(P, mu, t, C_K + c), v = pm_val(P, mu, t, C_V + c);
        const float wd0 = -DECAY_SCALE * sigmoidf_(w00 + OUT[(0 * 64 + tl) * LQ + k]), wd1 = -DECAY_SCALE * sigmoidf_(w01 + OUT[(1 * 64 + tl) * LQ + k]);
        const float ad0 = sigmoidf_(a00 + OUT[(2 * 64 + tl) * LQ + k]), ad1 = sigmoidf_(a01 + OUT[(3 * 64 + tl) * LQ + k]);
        const float kkr = kx * kkc; const float n2 = wave_sum(kkr * kkr); const float kk = kkr / fmaxf(sqrtf(n2), 1e-12f);
        const float kd0 = kx * (1.f + (ad0 - 1.f) * kac), kd1 = kx * (1.f + (ad1 - 1.f) * kac);
        const float bon = wave_sum(r * (kd0 + kd1) * rkc);
        const size_t o = (size_t)t * RW + c, o1 = (size_t)(M + t) * RW + c;
        pR[o] = (bf16)f2bf(r); pV[o] = (bf16)f2bf(v); pKA[o] = (bf16)f2bf(-kk);
        pKD[o] = (bf16)f2bf(kd0); pKD[o1] = (bf16)f2bf(kd1); pKB[o] = (bf16)f2bf(kk * ad0); pKB[o1] = (bf16)f2bf(kk * ad1);
        pW[o] = wd0; pW[o1] = wd1; pG[o] = (bf16)f2bf(OUT[(4 * 64 + tl) * LQ + k]);
        if (k == 0) pBo[(size_t)t * NH + h] = bon; }
    __syncthreads();
}
__device__ __forceinline__ void phase_prep_hyena(const Ctx& X, int l) {
    const bf16* P = X.ws<bf16>(WS_P); const int c = X.tid;
    if (c < HW) {
        const float* cw = X.in(I_CW) + (size_t)l * 3 * HC; const float* cb = X.in(I_CB) + (size_t)l * HC;
        float cw0[3], cw1[3], cw2[3], cbv[3];
#pragma unroll
        for (int j = 0; j < 3; ++j) { const int hc = j * HW + c; cw0[j] = cw[hc]; cw1[j] = cw[HC + hc]; cw2[j] = cw[2 * HC + hc]; cbv[j] = cb[hc]; }
        float* ZT = X.ws<float>(WS_ZT) + (size_t)c * M; float* Zc = X.ws<float>(WS_Z); bf16* X0 = X.ws<bf16>(WS_X0);
        for (int tile = X.bid; tile < M / TT; tile += X.G) { const int t0 = tile * TT; float zz[TT];
#pragma unroll
            for (int tt = 0; tt < TT; ++tt) { const int t = t0 + tt; const bool hp = (t != 0 && t != CTX), hn = (t != CTX - 1 && t != M - 1);
                float u[3];
#pragma unroll
                for (int j = 0; j < 3; ++j) { const int col = C_HY + j * HW + c;
                    const float pc = bf2f(P[(size_t)t * PCP + col]), pp = hp ? bf2f(P[(size_t)(t - 1) * PCP + col]) : 0.f, pn = hn ? bf2f(P[(size_t)(t + 1) * PCP + col]) : 0.f;
                    u[j] = pp * cw0[j] + pc * cw1[j] + pn * cw2[j] + cbv[j]; }
                zz[tt] = u[2] * u[1]; if (t < CTX) Zc[(size_t)t * HW + c] = zz[tt];
                X0[(size_t)t * HW + c] = (bf16)f2bf(u[0]); }
            *(f32x4*)(ZT + t0) = (f32x4){zz[0], zz[1], zz[2], zz[3]}; *(f32x4*)(ZT + t0 + 4) = (f32x4){zz[4], zz[5], zz[6], zz[7]}; }
    }
}

constexpr int CC = 64, NCHK = M / CC;
static_assert(CTX % CC == 0 && SEQ % CC == 0, "chunks must not straddle the context/latent boundary");
__device__ __forceinline__ int scan_row(int d, int s) { return d == 0 ? s : (s < CTX ? CTX - 1 - s : M - 1 - (s - CTX)); }
__device__ __forceinline__ void chunk_unit_1(const Ctx& X, int unit) {
    const int d = unit / (NCHK * NH), c = (unit / NH) % NCHK, h = unit % NH;
    LAS bf16* An = (LAS bf16*)X.lds;            LAS bf16* Bn = An + 64 * LP; LAS bf16* Kn = Bn + 64 * LP; LAS bf16* Rn = Kn + 64 * LP; LAS bf16* Vt = Rn + 64 * LP;
    LAS bf16* Bh = Vt + 64 * LP;                LAS bf16* Kh = Bh + 64 * LP; LAS bf16* Lak = Kh + 64 * LP; LAS bf16* Mrb = Lak + 64 * LP; LAS bf16* Mrk = Mrb + 64 * LP;
    LAS float* Lab = (LAS float*)(Mrk + 64 * LP); LAS float* XsW = Lab + 64 * LX;
    LAS float* XsU = (LAS float*)An;
    LAS bf16* Wt = Lak; LAS bf16* Ut = (LAS bf16*)((LAS unsigned char*)An + 64 * LX * 4);
    LAS float* tot = Lab;
    LAS float* dC = (LAS float*)(X.lds + LDS_MISC + 1024);
    static_assert(10 * 64 * LP * 2 + 2 * 64 * LX * 4 <= LDS_STAGE && 64 * LX * 4 + 64 * LP * 2 <= 3 * 64 * LP * 2, "chunk LDS map");
    const int tid = X.tid, lane = X.lane, w = X.wave, k = tid & 63;
    float lw[8], cum[8];
    { float run = 0.f; const float* pW = X.wsv<float>(WS_W);
#pragma unroll
      for (int i = 0; i < 8; ++i) { const int row = scan_row(d, c * CC + 8 * w + i); lw[i] = pW[((size_t)d * M + row) * RW + h * 64 + k]; }
#pragma unroll
      for (int i = 0; i < 8; ++i) { run += lw[i]; cum[i] = run; }
      tot[w * 64 + k] = run; }
    __syncthreads();
    float off = 0.f, cumC = 0.f;
#pragma unroll
    for (int ww = 0; ww < 8; ++ww) { const float t = tot[ww * 64 + k]; off += (ww < w) ? t : 0.f; cumC += t; }
    __syncthreads();
    { unsigned pv[4], pbh[4], pkh[4]; float af[8];
      const bf16* pR = X.wsv<bf16>(WS_R); const bf16* pV = X.wsv<bf16>(WS_V); const bf16* pKA = X.wsv<bf16>(WS_KA); const bf16* pKD = X.wsv<bf16>(WS_KD); const bf16* pKB = X.wsv<bf16>(WS_KB);
#pragma unroll
      for (int i = 0; i < 8; ++i) { const int t = 8 * w + i; const int row = scan_row(d, c * CC + t); const size_t o = (size_t)row * RW + h * 64 + k, od = ((size_t)d * M + row) * RW + h * 64 + k;
          const float ct = off + cum[i], cp = ct - lw[i];
          const float r = bf2f(pR[o]), v = bf2f(pV[o]), ka = bf2f(pKA[o]), kd = bf2f(pKD[od]), kb = bf2f(pKB[od]);
          const float ei = expf(-ct), eh = expf(cumC - ct);
          const float at = ka * expf(cp); af[i] = at;
          An[t * LP + k] = (bf16)f2bf(at); Bn[t * LP + k] = (bf16)f2bf(kb * ei); Kn[t * LP + k] = (bf16)f2bf(kd * ei); Rn[t * LP + k] = (bf16)f2bf(r * expf(ct));
          const unsigned bv = f2bf(v), bb = f2bf(kb * eh), bk = f2bf(kd * eh);
          if (i & 1) { pv[i >> 1] |= bv << 16; pbh[i >> 1] |= bb << 16; pkh[i >> 1] |= bk << 16; } else { pv[i >> 1] = bv; pbh[i >> 1] = bb; pkh[i >> 1] = bk; } }
      *(LAS u32x4*)(Vt + k * LP + 8 * w) = (u32x4){pv[0], pv[1], pv[2], pv[3]}; *(LAS u32x4*)(Bh + k * LP + 8 * w) = (u32x4){pbh[0], pbh[1], pbh[2], pbh[3]}; *(LAS u32x4*)(Kh + k * LP + 8 * w) = (u32x4){pkh[0], pkh[1], pkh[2], pkh[3]};
      *(LAS f32x4*)(XsW + k * LX + 8 * w) = (f32x4){af[0], af[1], af[2], af[3]}; *(LAS f32x4*)(XsW + k * LX + 8 * w + 4) = (f32x4){af[4], af[5], af[6], af[7]}; }
    if (tid < 64) dC[tid] = expf(cumC);
    __syncthreads();
#pragma unroll 1
    for (int q = 0; q < 2; ++q) { const int tile = 2 * w + q, ti = tile >> 2, tj = tile & 3; const f32x4 z4 = {0.f, 0.f, 0.f, 0.f};
        const f32x4 ab = mm_tile(An, Bn, ti, tj, lane, z4), ak = mm_tile(An, Kn, ti, tj, lane, z4), rb = mm_tile(Rn, Bn, ti, tj, lane, z4), rk = mm_tile(Rn, Kn, ti, tj, lane, z4);
        const int col = 16 * tj + (lane & 15);
#pragma unroll
        for (int r = 0; r < 4; ++r) { const int row = 16 * ti + 4 * (lane >> 4) + r; const bool lo = col < row, le = col <= row;
            Lab[row * LX + col] = lo ? ab[r] : 0.f; Lak[row * LP + col] = (bf16)f2bf(lo ? ak[r] : 0.f); Mrb[row * LP + col] = (bf16)f2bf(le ? rb[r] : 0.f); Mrk[row * LP + col] = (bf16)f2bf(le ? rk[r] : 0.f); } }
    __syncthreads();
}
__device__ __forceinline__ void chunk_unit_2(const Ctx& X, int unit) {
    const int d = unit / (NCHK * NH), c = (unit / NH) % NCHK, h = unit % NH;
    LAS bf16* An = (LAS bf16*)X.lds;            LAS bf16* Bn = An + 64 * LP; LAS bf16* Kn = Bn + 64 * LP; LAS bf16* Rn = Kn + 64 * LP; LAS bf16* Vt = Rn + 64 * LP;
    LAS bf16* Bh = Vt + 64 * LP;                LAS bf16* Kh = Bh + 64 * LP; LAS bf16* Lak = Kh + 64 * LP; LAS bf16* Mrb = Lak + 64 * LP; LAS bf16* Mrk = Mrb + 64 * LP;
    LAS float* Lab = (LAS float*)(Mrk + 64 * LP); LAS float* XsW = Lab + 64 * LX;
    LAS float* XsU = (LAS float*)An;
    LAS bf16* Wt = Lak; LAS bf16* Ut = (LAS bf16*)((LAS unsigned char*)An + 64 * LX * 4);
    LAS float* tot = Lab;
    LAS float* dC = (LAS float*)(X.lds + LDS_MISC + 1024);
    static_assert(10 * 64 * LP * 2 + 2 * 64 * LX * 4 <= LDS_STAGE && 64 * LX * 4 + 64 * LP * 2 <= 3 * 64 * LP * 2, "chunk LDS map");
    const int tid = X.tid, lane = X.lane, w = X.wave, k = tid & 63;
    f32x4 r2[2]; int r2col[2], r2row[2];
#pragma unroll
    for (int q = 0; q < 2; ++q) { const int tile = 2 * w + q, ti = tile >> 2, tj = tile & 3; const f32x4 z4 = {0.f, 0.f, 0.f, 0.f};
        const f32x4 a = mm_tile(Lak, Vt, ti, tj, lane, z4); const int col = 16 * tj + (lane & 15);
        r2[q] = a; r2col[q] = col; r2row[q] = 16 * ti + 4 * (lane >> 4); }
    __syncthreads();
#pragma unroll
    for (int q = 0; q < 2; ++q) *(LAS f32x4*)(XsU + r2col[q] * LX + r2row[q]) = r2[q];
    __syncthreads();
    if (tid < 128) { const int j = tid & 63; const bool isu = tid >= 64; LAS float* xs = (isu ? XsU : XsW) + j * LX; LAS bf16* dst = (isu ? Ut : Wt) + j * LP;
#pragma unroll 1
        for (int p = 0; p < 8; ++p) { const int t0 = 8 * p; f32x4 acc[8];
#pragma unroll
            for (int i = 0; i < 8; ++i) acc[i] = (f32x4){0.f, 0.f, 0.f, 0.f};
#pragma unroll 1
            for (int q = 0; q < 2 * p; ++q) { const f32x4 xq = *(const LAS f32x4*)(xs + 4 * q);
#pragma unroll
                for (int i = 0; i < 8; ++i) acc[i] += *(const LAS f32x4*)(Lab + (t0 + i) * LX + 4 * q) * xq; }
            f32x4 xp[2];
#pragma unroll
            for (int qq = 0; qq < 2; ++qq) xp[qq] = *(const LAS f32x4*)(xs + t0 + 4 * qq);
#pragma unroll
            for (int i = 0; i < 8; ++i) { f32x4 a = acc[i];
#pragma unroll
                for (int qq = 0; qq < (i + 3) / 4; ++qq) a += *(const LAS f32x4*)(Lab + (t0 + i) * LX + t0 + 4 * qq) * xp[qq];
                xp[i >> 2][i & 3] += (a[0] + a[1]) + (a[2] + a[3]); }
#pragma unroll
            for (int qq = 0; qq < 2; ++qq) { *(LAS f32x4*)(xs + t0 + 4 * qq) = xp[qq];
                *(LAS unsigned*)(dst + t0 + 4 * qq) = pk2(xp[qq][0], xp[qq][1]); *(LAS unsigned*)(dst + t0 + 4 * qq + 2) = pk2(xp[qq][2], xp[qq][3]); } } }
    __syncthreads();
}
__device__ __forceinline__ void chunk_unit_3(const Ctx& X, int unit) {
    const int d = unit / (NCHK * NH), c = (unit / NH) % NCHK, h = unit % NH;
    LAS bf16* An = (LAS bf16*)X.lds;            LAS bf16* Bn = An + 64 * LP; LAS bf16* Kn = Bn + 64 * LP; LAS bf16* Rn = Kn + 64 * LP; LAS bf16* Vt = Rn + 64 * LP;
    LAS bf16* Bh = Vt + 64 * LP;                LAS bf16* Kh = Bh + 64 * LP; LAS bf16* Lak = Kh + 64 * LP; LAS bf16* Mrb = Lak + 64 * LP; LAS bf16* Mrk = Mrb + 64 * LP;
    LAS float* Lab = (LAS float*)(Mrk + 64 * LP); LAS float* XsW = Lab + 64 * LX;
    LAS float* XsU = (LAS float*)An;
    LAS bf16* Wt = Lak; LAS bf16* Ut = (LAS bf16*)((LAS unsigned char*)An + 64 * LX * 4);
    LAS float* tot = Lab;
    LAS float* dC = (LAS float*)(X.lds + LDS_MISC + 1024);
    static_assert(10 * 64 * LP * 2 + 2 * 64 * LX * 4 <= LDS_STAGE && 64 * LX * 4 + 64 * LP * 2 <= 3 * 64 * LP * 2, "chunk LDS map");
    const int tid = X.tid, lane = X.lane, w = X.wave, k = tid & 63;
    const float dCk = dC[k];
    const size_t ubase = ((size_t)(d * NH + h) * NCHK + c);
    float* Pg = X.wsv<float>(WS_PQ) + ubase * 2 * 4096; float* Qg = Pg + 4096; bf16* Gg = X.wsv<bf16>(WS_G) + ubase * 4096; float* Yg = X.wsv<float>(WS_YL) + ubase * 4096;
#pragma unroll 1
    for (int q = 0; q < 2; ++q) { const int tile = 2 * w + q, ti = tile >> 2, tj = tile & 3; const f32x4 z4 = {0.f, 0.f, 0.f, 0.f};
        const f32x4 p = mm_tile(Wt, Bh, ti, tj, lane, z4); f32x4 qq = mm_tile(Ut, Bh, ti, tj, lane, z4); qq = mm_tile(Vt, Kh, ti, tj, lane, qq);
        const f32x4 g = mm_tile(Mrb, Wt, ti, tj, lane, z4); f32x4 y = mm_tile(Mrb, Ut, ti, tj, lane, z4); y = mm_tile(Mrk, Vt, ti, tj, lane, y);
        const int col = 16 * tj + (lane & 15); const float dcol = __shfl(dCk, col);
#pragma unroll
        for (int r = 0; r < 4; ++r) { const int row = 16 * ti + 4 * (lane >> 4) + r;
            Pg[row * 64 + col] = p[r] + (row == col ? dcol : 0.f); Qg[row * 64 + col] = qq[r];
            const int orow = d ? 63 - row : row;
            Gg[orow * 64 + col] = (bf16)f2bf(g[r] + bf2f(Rn[row * LP + col])); Yg[orow * 64 + col] = y[r]; } }
    __syncthreads();
}
__device__ __forceinline__ void seq_unit(const Ctx& X, int su) {
    const int d = su / (NH * 4), h = (su / 4) % NH, qv = su & 3;
    constexpr int PD = 4, RING = PD + 1, SLOT = 4096 + 1024;
    LAS float* ring = (LAS float*)X.lds;
    LAS float* S = ring + RING * SLOT;
    LAS float* part = S + 16 * LQ;
    static_assert((RING * SLOT + 16 * LQ + 4 * 16 * 17) * 4 <= LDS_STAGE, "seq LDS map");
    const int lane = X.lane, w = X.wave, tj = w & 3, kh = w >> 2, col = 16 * tj + (lane & 15), kq = lane >> 4;
    const float* PQ = X.ws<float>(WS_PQ) + (size_t)(d * NH + h) * NCHK * 2 * 4096; bf16* S0g = X.ws<bf16>(WS_S0) + (size_t)(d * NH + h) * NCHK * 4096 + (size_t)(16 * qv) * 64;
#define SEQ_FILL(c_) do { const float* p_ = PQ + (size_t)(c_) * 2 * 4096; LAS float* sl_ = ring + ((c_) % RING) * SLOT; \
        GLDS16(p_ + 4 * (w * 64 + lane), sl_ + 4 * (w * 64)); GLDS16(p_ + 4 * (512 + w * 64 + lane), sl_ + 4 * (512 + w * 64)); \
        GLDS16(p_ + 4096 + (16 * qv) * 64 + 4 * ((w & 3) * 64 + lane), sl_ + 4096 + 4 * ((w & 3) * 64)); } while (0)
#pragma unroll
    for (int i = 0; i < PD; ++i) if (i < NCHK) SEQ_FILL(i);
    for (int i = X.tid; i < 16 * LQ; i += NTHR) S[i] = 0.f;
    if (kh == 0) {
#pragma unroll
        for (int r = 0; r < 4; ++r) S0g[(4 * kq + r) * 64 + col] = (bf16)0; }
    for (int c = 0; c < NCHK; ++c) {
        if (c + PD - 1 < NCHK) { if (kh == 0) { ASM_WAIT_V(21); } else { ASM_WAIT_V(9); } } else { ASM_WAIT_V(0); }
        ASM_WAIT_L(0); S_BARRIER(); CFENCE();
        if (c + PD < NCHK) SEQ_FILL(c + PD);
        const LAS float* P = ring + (c % RING) * SLOT; const LAS float* Q = P + 4096;
        f32x4 acc0 = {0.f, 0.f, 0.f, 0.f}, acc1 = {0.f, 0.f, 0.f, 0.f};
#pragma unroll
        for (int s2 = 0; s2 < 8; s2 += 2) { const int k0 = 32 * kh + 4 * s2 + kq;
            acc0 = MFMA4F(S[(lane & 15) * LQ + k0], P[k0 * 64 + col], acc0); acc1 = MFMA4F(S[(lane & 15) * LQ + k0 + 4], P[(k0 + 4) * 64 + col], acc1); }
        acc0 += acc1;
        if (kh == 1) {
#pragma unroll
            for (int r = 0; r < 4; ++r) part[(tj * 16 + 4 * kq + r) * 17 + (lane & 15)] = acc0[r]; }
        ASM_WAIT_L(0); S_BARRIER(); CFENCE();
        if (kh == 0) {
#pragma unroll
            for (int r = 0; r < 4; ++r) { const float sn = acc0[r] + part[(tj * 16 + 4 * kq + r) * 17 + (lane & 15)] + Q[(4 * kq + r) * 64 + col];
                S[(4 * kq + r) * LQ + col] = sn; if (c + 1 < NCHK) S0g[(size_t)(c + 1) * 4096 + (4 * kq + r) * 64 + col] = (bf16)f2bf(sn); } }
    }
    ASM_WAIT_V(0);
    __syncthreads();
#undef SEQ_FILL
}
constexpr int CR = 16;
__device__ __forceinline__ void conv_item(const Ctx& X, int item) {
    constexpr int NCG = HW / 64; constexpr int n = CTX;
    const int cg = item % NCG, ob = item / NCG, i0 = CR * ob, c = cg * 64 + X.lane;
    const float* F = X.ws<float>(WS_FILT) + (size_t)HW * SEQ + (size_t)c * CTX; const float* Z = X.ws<float>(WS_Z) + c;
    const float* fp = X.ws<float>(WS_FPART) + (size_t)NPART * HW + c;
    float nsum = 0.f; for (int b = 0; b < NPART; ++b) nsum += fp[(size_t)b * HW];
    float acc[CR], Q[CR];
#pragma unroll
    for (int r = 0; r < CR; ++r) acc[r] = 0.f;
    int jb = i0 - n / 2; if (jb < 0) jb = 0;
    int jend = i0 + n / 2 + CR; if (jend > n) jend = n;
    int Tb = i0 - jb + n / 2;
#pragma unroll
    for (int x = 1; x < CR; ++x) { const int T = Tb + x; Q[x] = (T >= 0 && T < n) ? F[T] : 0.f; }
    Q[0] = 0.f;
    for (; jb < jend; jb += CR, Tb -= CR) {
#pragma unroll
        for (int s = 0; s < CR; ++s) { const int T = Tb - s, j = jb + s;
            if ((s & 3) == 0) CFENCE();
            Q[(CR - s) & (CR - 1)] = (T >= 0 && T < n) ? F[T] : 0.f;
            const float zj = (j < n) ? Z[(size_t)j * HW] : 0.f;
#pragma unroll
            for (int r = 0; r < CR; ++r) acc[r] += Q[(r - s + CR) & (CR - 1)] * zj; }
    }
    const float inv = 1.0f / nsum; float* O = X.ws<float>(WS_CONV) + c;
#pragma unroll
    for (int r = 0; r < CR; ++r) O[(size_t)(i0 + r) * HW] = acc[r] * inv;
}

#ifdef EMU
struct cf { float x, y; };
#else
typedef float cf __attribute__((ext_vector_type(2)));
#endif
__device__ __forceinline__ cf cmul(cf a, cf b) { return cf{a.x * b.x - a.y * b.y, a.x * b.y + a.y * b.x}; }
__device__ __forceinline__ cf cadd(cf a, cf b) { return cf{a.x + b.x, a.y + b.y}; }
__device__ __forceinline__ cf csub(cf a, cf b) { return cf{a.x - b.x, a.y - b.y}; }
__device__ __forceinline__ cf cconj(cf a) { return cf{a.x, -a.y}; }
constexpr int FN = SEQ;
constexpr int flog4(int n) { return n <= 1 ? 0 : 1 + flog4(n / 4); }
constexpr int FLOG4 = flog4(FN), FSQ = 1 << FLOG4;
static_assert((1 << (2 * FLOG4)) == FN && FN * 8 <= LDS_STAGE, "FFT length must be a power of 4 that fits the LDS stage region");
constexpr int FFT_TAB_OFF = LDS_MISC + 2048;
static_assert(FFT_TAB_OFF + 2 * FSQ * 8 <= LDS_BYTES, "FFT twiddle tables");
__device__ __forceinline__ void fft_tables(const Ctx& X) {
    LAS cf* T = (LAS cf*)(X.lds + FFT_TAB_OFF);
    for (int i = X.tid; i < 2 * FSQ; i += NTHR) { const int k = i < FSQ ? i * FSQ : i - FSQ; float s, c; sincos_f(-6.283185307179586f * (float)k / (float)FN, s, c); T[i] = cf{c, s}; }
    __syncthreads();
}
__device__ __forceinline__ cf fft_tw(const LAS cf* T, int k) { const cf a = T[k >> FLOG4], b = T[FSQ + (k & (FSQ - 1))]; return cmul(a, b); }
__device__ __forceinline__ int rev4(int k) { int r = 0;
#pragma unroll
    for (int s = 0; s < FLOG4; ++s) { r = (r << 2) | (k & 3); k >>= 2; }
    return r; }
__device__ __forceinline__ void fft_fwd(LAS cf* x, const LAS cf* T, int tid) {
#pragma unroll 1
    for (int s = 0; s < FLOG4; ++s) { const int q = FN >> (2 * s + 2), tw = 1 << (2 * s);
        for (int u = tid; u < FN / 4; u += NTHR) { const int j = u & (q - 1), p = (u - j) * 4 + j;
            const cf a0 = x[p], a1 = x[p + q], a2 = x[p + 2 * q], a3 = x[p + 3 * q];
            const cf t0 = cadd(a0, a2), t1 = csub(a0, a2), t2 = cadd(a1, a3), d = csub(a1, a3), t3 = cf{d.y, -d.x};
            const cf w1 = fft_tw(T, j * tw), w2 = cmul(w1, w1), w3 = cmul(w2, w1);
            x[p] = cadd(t0, t2); x[p + q] = cmul(cadd(t1, t3), w1); x[p + 2 * q] = cmul(csub(t0, t2), w2); x[p + 3 * q] = cmul(csub(t1, t3), w3); }
        __syncthreads(); }
}
__device__ __forceinline__ void fft_inv(LAS cf* x, const LAS cf* T, int tid) {
#pragma unroll 1
    for (int s = FLOG4 - 1; s >= 0; --s) { const int q = FN >> (2 * s + 2), tw = 1 << (2 * s);
        for (int u = tid; u < FN / 4; u += NTHR) { const int j = u & (q - 1), p = (u - j) * 4 + j;
            const cf w1 = cconj(fft_tw(T, j * tw)), w2 = cmul(w1, w1), w3 = cmul(w2, w1);
            const cf a0 = x[p], a1 = cmul(x[p + q], w1), a2 = cmul(x[p + 2 * q], w2), a3 = cmul(x[p + 3 * q], w3);
            const cf t0 = cadd(a0, a2), t1 = csub(a0, a2), t2 = cadd(a1, a3), d = csub(a1, a3), t3 = cf{-d.y, d.x};
            x[p] = cadd(t0, t2); x[p + q] = cadd(t1, t3); x[p + 2 * q] = csub(t0, t2); x[p + 3 * q] = csub(t1, t3); }
        __syncthreads(); }
}
__device__ __forceinline__ void fft_load_real(LAS cf* x, const float* src, float scale, int tid) {
    for (int m = tid; m < FN; m += NTHR) { cf v{0.f, 0.f}; if (m < FN / 2) { v.x = src[2 * m] * scale; v.y = src[2 * m + 1] * scale; } x[m] = v; }
    __syncthreads();
}
__device__ __forceinline__ void phase_spectra(const Ctx& X, int l) {
    (void)l;
    LAS cf* x = (LAS cf*)X.lds; const LAS cf* T = (const LAS cf*)(X.lds + FFT_TAB_OFF); volatile LAS float* red = (volatile LAS float*)(X.lds + LDS_MISC) + 120;
    fft_tables(X);
    for (int c = X.bid; c < HW; c += X.G) {
        if (X.wave == 0) { const float* fp = X.ws<float>(WS_FPART) + c; float s = 0.f; for (int b = X.lane; b < NPART; b += 64) s += fp[(size_t)b * HW]; s = wave_sum(s); if (X.lane == 0) red[0] = s; }
        __syncthreads();
        const float inv = 1.0f / red[0];
        fft_load_real(x, X.ws<float>(WS_FILT) + (size_t)c * SEQ, inv, X.tid);
        fft_fwd(x, T, X.tid);
        cf* HS = X.ws<cf>(WS_HS) + (size_t)c * (FN + 1);
        for (int k = X.tid; k <= FN / 2; k += NTHR) {
            const cf A = x[rev4(k)], B = x[rev4((FN - k) & (FN - 1))];
            if (k == 0) { HS[0] = cf{A.x + A.y, 0.f}; HS[FN] = cf{A.x - A.y, 0.f}; }
            else if (k == FN / 2) { HS[k] = cconj(A); }
            else { float sn, cs; sincos_f(-3.14159265358979f * (float)k / (float)FN, sn, cs); const cf w{cs, sn};
                const cf s1 = cadd(A, cconj(B)), d1 = csub(A, cconj(B)), wd = cmul(w, d1);
                HS[k] = cf{0.5f * (s1.x + wd.y), 0.5f * (s1.y - wd.x)};
                const cf s2 = cadd(B, cconj(A)), d2 = csub(B, cconj(A)), wd2 = cmul(cconj(w), d2);
                HS[FN - k] = cf{0.5f * (s2.x - wd2.y), 0.5f * (s2.y + wd2.x)}; } }
        __syncthreads();
    }
}
__device__ __forceinline__ void fftconv_item(const Ctx& X, int l, int c) {
    LAS cf* x = (LAS cf*)X.lds; const LAS cf* T = (const LAS cf*)(X.lds + FFT_TAB_OFF);
    const float* z = X.ws<float>(WS_ZT) + (size_t)c * M + CTX;
    fft_load_real(x, z, 1.0f, X.tid);
    fft_fwd(x, T, X.tid);
    const cf* HS = X.ws<cf>(WS_HS) + (size_t)c * (FN + 1);
    for (int k = X.tid; k <= FN / 2; k += NTHR) {
        const int pa = rev4(k), pb = rev4((FN - k) & (FN - 1)); const cf A = x[pa], B = x[pb];
        if (k == 0) { const float y0 = (A.x + A.y) * HS[0].x, yn = (A.x - A.y) * HS[FN].x; x[pa] = cf{0.5f * (y0 + yn), 0.5f * (y0 - yn)}; }
        else if (k == FN / 2) { x[pa] = cconj(cmul(cconj(A), HS[k])); }
        else { float sn, cs; sincos_f(-3.14159265358979f * (float)k / (float)FN, sn, cs); const cf w{cs, sn};
            const cf s1 = cadd(A, cconj(B)), d1 = csub(A, cconj(B)), wd = cmul(w, d1); const cf Xk{0.5f * (s1.x + wd.y), 0.5f * (s1.y - wd.x)};
            const cf s2 = cadd(B, cconj(A)), d2 = csub(B, cconj(A)), wd2 = cmul(cconj(w), d2); const cf Xn{0.5f * (s2.x - wd2.y), 0.5f * (s2.y + wd2.x)};
            const cf Yk = cmul(Xk, HS[k]), Yn = cmul(Xn, HS[FN - k]);
            const cf e1 = cadd(Yk, cconj(Yn)), f1 = cmul(cconj(w), csub(Yk, cconj(Yn)));
            x[pa] = cf{0.5f * (e1.x - f1.y), 0.5f * (e1.y + f1.x)};
            const cf e2 = cadd(Yn, cconj(Yk)), f2 = cmul(w, csub(Yn, cconj(Yk)));
            x[pb] = cf{0.5f * (e2.x + f2.y), 0.5f * (e2.y - f2.x)}; } }
    __syncthreads();
    fft_inv(x, T, X.tid);
    const float bias = X.in(I_HBIAS)[(size_t)l * HW + c], sc = 1.0f / (float)FN; float* O = X.ws<float>(WS_CVT) + (size_t)c * SEQ;
    for (int i2 = X.tid; i2 < FN / 2; i2 += NTHR) { const cf d = x[i2 + FN / 4]; O[2 * i2] = d.x * sc + z[2 * i2] * bias; O[2 * i2 + 1] = d.y * sc + z[2 * i2 + 1] * bias; }
    __syncthreads();
}
__device__ __forceinline__ void phase_fftconv(const Ctx& X, int l) {
    fft_tables(X);
    volatile LAS int* slot = (volatile LAS int*)(X.lds + LDS_MISC) + 121;
    unsigned* q = X.ctl() + CW_Q + l * 64 + 32;
    for (;;) { if (X.tid == 0) slot[0] = (int)atomicAdd(q, 1u); __syncthreads(); const int c = slot[0]; __syncthreads(); if (c >= HW) break; fftconv_item(X, l, c); }
}
__device__ __forceinline__ void phase_ctxconv(const Ctx& X, int l) {
    constexpr int NITEMS = (HW / 64) * (CTX / CR);
    unsigned* q = X.ctl() + CW_Q + l * 64;
    for (;;) { int item = 0; if (X.lane == 0) item = (int)atomicAdd(q, 1u); item = __shfl(item, 0); if (item >= NITEMS) break; conv_item(X, item); }
}
__device__ __forceinline__ void phase_seq(const Ctx& X) {
    for (int su = X.bid; su < N_SEQ_UNITS; su += X.G) seq_unit(X, su);
}

__device__ __forceinline__ void finish_wave_unit(const Ctx& X, int l, int unit) {
    const int rg = unit / NH, h = unit % NH, lane = X.lane, b = rg >> 2, sub = rg & 3;
    const int cf = b, cb = (b < CTX / CC) ? (CTX / CC - 1 - b) : (NCHK - 1 - (b - CTX / CC));
    const size_t uf = ((size_t)(0 * NH + h) * NCHK + cf) * 4096, ub = ((size_t)(1 * NH + h) * NCHK + cb) * 4096;
    const bf16* G = X.wsv<bf16>(WS_G); const bf16* S0 = X.wsv<bf16>(WS_S0); const float* YL = X.wsv<float>(WS_YL);
    const int arow = 16 * sub + (lane & 15), kof = 8 * (lane >> 4);
    bf16x8 af[2], ab[2];
#pragma unroll
    for (int kk = 0; kk < 2; ++kk) { af[kk] = *(const bf16x8*)(G + uf + arow * 64 + kof + 32 * kk); ab[kk] = *(const bf16x8*)(G + ub + arow * 64 + kof + 32 * kk); }
    f32x4 y[4];
#pragma unroll
    for (int tj = 0; tj < 4; ++tj) { const int vrow = 16 * tj + (lane & 15);
        bf16x8 bf_[2], bb_[2];
#pragma unroll
        for (int kk = 0; kk < 2; ++kk) { bf_[kk] = *(const bf16x8*)(S0 + uf + vrow * 64 + kof + 32 * kk); bb_[kk] = *(const bf16x8*)(S0 + ub + vrow * 64 + kof + 32 * kk); }
        f32x4 acc;
#pragma unroll
        for (int r = 0; r < 4; ++r) { const int o = (16 * sub + 4 * (lane >> 4) + r) * 64 + vrow; acc[r] = YL[uf + o] + YL[ub + o]; }
#pragma unroll
        for (int kk = 0; kk < 2; ++kk) { acc = MFMA16(af[kk], bf_[kk], acc); acc = MFMA16(ab[kk], bb_[kk], acc); }
        y[tj] = acc; }
    const float* lgp = X.inv(I_LNXG) + (size_t)l * RW + 64 * h; const float* lbp = X.inv(I_LNXB) + (size_t)l * RW + 64 * h;
    const bf16* pV = X.wsv<bf16>(WS_V); const bf16* pG = X.wsv<bf16>(WS_GATE); const float* pBo = X.wsv<float>(WS_BONUS); bf16* pRO = X.wsv<bf16>(WS_RO);
#pragma unroll
    for (int r = 0; r < 4; ++r) { const int t = 16 * rg + 4 * (lane >> 4) + r;
        const float mean = row16_sum((y[0][r] + y[1][r]) + (y[2][r] + y[3][r])) * (1.f / 64.f);
        float q = 0.f;
#pragma unroll
        for (int tj = 0; tj < 4; ++tj) { const float dy = y[tj][r] - mean; q += dy * dy; }
        const float rstd = 1.0f / sqrtf(row16_sum(q) * (1.f / 64.f) + GN_EPS); const float bon = pBo[(size_t)t * NH + h];
#pragma unroll
        for (int tj = 0; tj < 4; ++tj) { const int cl = 16 * tj + (lane & 15); const size_t o = (size_t)t * RW + 64 * h + cl;
            float yn = (y[tj][r] - mean) * rstd * lgp[cl] + lbp[cl];
            yn += bon * bf2f(pV[o]); yn *= bf2f(pG[o]);
            pRO[o] = (bf16)f2bf(yn); } }
}
__device__ __forceinline__ void phase_finish(const Ctx& X, int l) {
    for (int u = X.bid * NWAVES + X.wave; u < (M / 16) * NH; u += X.G * NWAVES) finish_wave_unit(X, l, u);
    const int c = X.tid;
    if (c < HW) { const float hbc = X.in(I_HBIAS)[(size_t)l * HW + c]; const float* CV = X.ws<float>(WS_CVT) + (size_t)c * SEQ; const bf16* X0 = X.ws<bf16>(WS_X0); bf16* HO = X.ws<bf16>(WS_HO);
        for (int tile = X.bid; tile < M / TT; tile += X.G) { const int t0 = tile * TT; float cv[TT];
            if (t0 < CTX) {
#pragma unroll
                for (int tt = 0; tt < TT; ++tt) { const size_t o = (size_t)(t0 + tt) * HW + c; cv[tt] = X.ws<float>(WS_CONV)[o] + X.ws<float>(WS_Z)[o] * hbc; } }
            else { const f32x4 a = *(const f32x4*)(CV + (t0 - CTX)), b = *(const f32x4*)(CV + (t0 - CTX) + 4);
#pragma unroll
                for (int i = 0; i < 4; ++i) { cv[i] = a[i]; cv[4 + i] = b[i]; } }
#pragma unroll
            for (int tt = 0; tt < TT; ++tt) { const size_t o = (size_t)(t0 + tt) * HW + c; HO[o] = (bf16)f2bf(cv[tt] * bf2f(X0[o])); } } }
}

__device__ __forceinline__ void ln_inplace(float (&v)[D / 64], const float* g, const float* b, int lane) {
    float s = 0.f;
#pragma unroll
    for (int j = 0; j < D / 64; ++j) s += v[j];
    const float mean = wave_sum(s) * (1.f / D); float q = 0.f;
#pragma unroll
    for (int j = 0; j < D / 64; ++j) { v[j] -= mean; q += v[j] * v[j]; }
    const float rstd = 1.0f / sqrtf(wave_sum(q) * (1.f / D) + LN_EPS);
#pragma unroll
    for (int j = 0; j < D / 64; ++j) { const int d = 4 * lane + 256 * (j >> 2) + (j & 3); v[j] = v[j] * rstd * g[d] + b[d]; }
}
__device__ __forceinline__ void phase_norm1(const Ctx& X, int l) {
    const int gw = X.bid * NWAVES + X.wave, NGW = X.G * NWAVES, lane = X.lane;
    const float* lng = X.in(I_LNG) + (size_t)(l * 2 + 0) * D; const float* lnb = X.in(I_LNB) + (size_t)(l * 2 + 0) * D;
    const float* wr = X.in(I_WR); const float* rb = X.in(I_RB);
    const float alpha = sqrtf(sqrtf(2.0f * DEPTH));
    volatile LAS int* hist = (volatile LAS int*)(X.lds + LDS_MISC + 4096);
    if (X.tid < NE) hist[X.tid] = 0;
    __syncthreads();
    for (int t = gw; t < M; t += NGW) {
        float* xr = X.ws<float>(WS_X) + (size_t)t * D; const float* mx = X.ws<float>(WS_MIX) + (size_t)t * D;
        const float* gate = modp(X, l, t, 2); const float* sh = modp(X, l, t, 3); const float* sc = modp(X, l, t, 4);
        float v[D / 64];
#pragma unroll
        for (int j = 0; j < D / 256; ++j) { const int d = 4 * lane + 256 * j; const f32x4 a = *(const f32x4*)(xr + d), m = *(const f32x4*)(mx + d), gt = *(const f32x4*)(gate + d);
#pragma unroll
            for (int i = 0; i < 4; ++i) v[4 * j + i] = alpha * a[i] + gt[i] * m[i]; }
        ln_inplace(v, lng, lnb, lane);
        bf16* hf = X.ws<bf16>(WS_XMOD) + (size_t)t * D;
        LAS float* hrow = (LAS float*)X.lds + X.wave * D;
#pragma unroll
        for (int j = 0; j < D / 256; ++j) { const int d = 4 * lane + 256 * j; f32x4 o; const f32x4 a = *(const f32x4*)(sh + d), b = *(const f32x4*)(sc + d); f32x4 h;
#pragma unroll
            for (int i = 0; i < 4; ++i) { o[i] = v[4 * j + i]; h[i] = o[i] * (1.f + b[i]) + a[i]; }
            *(f32x4*)(xr + d) = o; *(LAS f32x4*)(hrow + d) = h;
            *(unsigned long long*)(hf + d) = (unsigned long long)pk2(h[0], h[1]) | ((unsigned long long)pk2(h[2], h[3]) << 32); }
        WAVE_LDS_FENCE(); CFENCE();
        float part = 0.f; { const int e = lane & 15, q = lane >> 4;
#pragma unroll 8
            for (int d = q * (D / 4); d < (q + 1) * (D / 4); ++d) part += hrow[d] * wr[(size_t)d * NE + e]; }
        part += __shfl_xor(part, 16); part += __shfl_xor(part, 32);
        WAVE_LDS_FENCE(); CFENCE();
        float lg[NE];
#pragma unroll
        for (int e = 0; e < NE; ++e) lg[e] = __shfl(part, e);
        float mxl = lg[0];
#pragma unroll
        for (int e = 1; e < NE; ++e) mxl = fmaxf(mxl, lg[e]);
        float sc_[NE], sum = 0.f;
#pragma unroll
        for (int e = 0; e < NE; ++e) { sc_[e] = expf(lg[e] - mxl); sum += sc_[e]; }
        const float isum = 1.0f / sum; float sel[NE];
#pragma unroll
        for (int e = 0; e < NE; ++e) { sc_[e] *= isum; sel[e] = sc_[e] + rb[e]; }
        int bg = 0; float bgs = -INFINITY;
#pragma unroll
        for (int g = 0; g < 4; ++g) { float m1 = -INFINITY, m2 = -INFINITY;
#pragma unroll
            for (int i = 0; i < 4; ++i) { const float x = sel[4 * g + i]; if (x > m1) { m2 = m1; m1 = x; } else if (x > m2) m2 = x; }
            const float gs = m1 + m2; if (gs > bgs) { bgs = gs; bg = g; } }
        int i0 = 0, i1 = 0; float s0 = -INFINITY, s1 = -INFINITY, p0 = 0.f, p1 = 0.f;
#pragma unroll
        for (int e = 0; e < NE; ++e) { if ((e >> 2) == bg) { const float x = sel[e]; if (x > s0) { s1 = s0; i1 = i0; p1 = p0; s0 = x; i0 = e; p0 = sc_[e]; } else if (x > s1) { s1 = x; i1 = e; p1 = sc_[e]; } } }
        if (lane == 0) { int* ei = X.ws<int>(WS_ROUT) + (size_t)t * 2; float* ew = (float*)(X.ws<int>(WS_ROUT) + (size_t)M * 2) + (size_t)t * 2;
            ei[0] = i0; ei[1] = i1; const float ws_ = 1.0f / (p0 + p1); ew[0] = p0 * ws_; ew[1] = p1 * ws_;
            lds_add(hist + i0, 1); lds_add(hist + i1, 1); }
    }
    __syncthreads();
    if (X.tid < NE) { const int hc = hist[X.tid]; X.ws<int>(WS_BCNT)[X.bid * NE + X.tid] = hc; atomicAdd(X.ctl() + CW_CNT + l * 64 + X.tid, (unsigned)hc); }
}

__device__ __forceinline__ void moe_table(const Ctx& X, int l, int NT) {
    volatile LAS int* tab = (volatile LAS int*)(X.lds + LDS_MISC) + 8;
    if (X.tid == 0) { int cum = 0, ts = 0;
        for (int e = 0; e < NE; ++e) { const int cnt = (int)__hip_atomic_load(X.ctl() + CW_CNT + l * 64 + e, RLX_AGENT); const int tc = (cnt + 255) / 256;
            tab[e] = cum; tab[32 + e] = ts; tab[64 + e] = tc; cum += tc * NT; ts += tc; }
        tab[16] = cum; }
    __syncthreads();
}
__device__ __forceinline__ void phase_scatter(const Ctx& X, int l) {
    moe_table(X, l, 1);
    volatile LAS int* tab = (volatile LAS int*)(X.lds + LDS_MISC) + 8;
    volatile LAS int* cur = (volatile LAS int*)(X.lds + LDS_MISC + 4096) + 16;
    const int gw = X.bid * NWAVES + X.wave, NGW = X.G * NWAVES, lane = X.lane;
    if (X.tid < NE) { const int* bc = X.ws<int>(WS_BCNT) + X.tid; int pre = 0; for (int b = 0; b < X.bid; ++b) pre += bc[b * NE]; cur[X.tid] = tab[32 + X.tid] * 256 + pre; }
    __syncthreads();
    const int* ei = X.ws<int>(WS_ROUT); int* slot = X.ws<int>(WS_ROUT) + (size_t)M * 4;
    for (int t = gw; t < M; t += NGW) {
#pragma unroll
        for (int k = 0; k < 2; ++k) { const int e = ei[2 * t + k];
            int pos = 0; if (lane == 0) pos = lds_add(cur + e, 1);
            pos = __shfl(pos, 0);
            if (lane == 0) slot[2 * t + k] = pos;
            const u32x4* src = (const u32x4*)(X.ws<bf16>(WS_XMOD) + (size_t)t * D); u32x4* dst = (u32x4*)(X.ws<bf16>(WS_XG) + (size_t)pos * D);
            for (int i = lane; i < D / 8; i += 64) dst[i] = src[i]; } }
}

__device__ __forceinline__ void phase_combine(const Ctx& X, int l) {
    const int gw = X.bid * NWAVES + X.wave, NGW = X.G * NWAVES, lane = X.lane;
    const float* lng = X.in(I_LNG) + (size_t)(l * 2 + 1) * D; const float* lnb = X.in(I_LNB) + (size_t)(l * 2 + 1) * D;
    const float alpha = sqrtf(sqrtf(2.0f * DEPTH));
    const float* ew = (const float*)(X.ws<int>(WS_ROUT) + (size_t)M * 2); const int* slot = X.ws<int>(WS_ROUT) + (size_t)M * 4;
    for (int t = gw; t < M; t += NGW) {
        float* xr = X.ws<float>(WS_X) + (size_t)t * D; const float* gate = modp(X, l, t, 5);
        const bf16* y0 = X.ws<bf16>(WS_YS) + (size_t)slot[2 * t] * D; const bf16* y1 = X.ws<bf16>(WS_YS) + (size_t)slot[2 * t + 1] * D; const float w0 = ew[2 * t], w1 = ew[2 * t + 1];
        float v[D / 64];
#pragma unroll
        for (int j = 0; j < D / 256; ++j) { const int d = 4 * lane + 256 * j; const f32x4 a = *(const f32x4*)(xr + d), gt = *(const f32x4*)(gate + d);
            const unsigned long long q0 = *(const unsigned long long*)(y0 + d), q1 = *(const unsigned long long*)(y1 + d);
            float ya[4] = {bflo((unsigned)q0), bfhi((unsigned)q0), bflo((unsigned)(q0 >> 32)), bfhi((unsigned)(q0 >> 32))};
            float yb[4] = {bflo((unsigned)q1), bfhi((unsigned)q1), bflo((unsigned)(q1 >> 32)), bfhi((unsigned)(q1 >> 32))};
#pragma unroll
            for (int i = 0; i < 4; ++i) v[4 * j + i] = alpha * a[i] + gt[i] * (w0 * ya[i] + w1 * yb[i]); }
        ln_inplace(v, lng, lnb, lane);
        if (l + 1 < DEPTH) { const float* sh = modp(X, l + 1, t, 0); const float* sc = modp(X, l + 1, t, 1); bf16* xm = X.ws<bf16>(WS_XMOD) + (size_t)t * D;
#pragma unroll
            for (int j = 0; j < D / 256; ++j) { const int d = 4 * lane + 256 * j; f32x4 o; const f32x4 a = *(const f32x4*)(sh + d), b = *(const f32x4*)(sc + d); float h[4];
#pragma unroll
                for (int i = 0; i < 4; ++i) { o[i] = v[4 * j + i]; h[i] = o[i] * (1.f + b[i]) + a[i]; }
                *(f32x4*)(xr + d) = o;
                *(unsigned long long*)(xm + d) = (unsigned long long)pk2(h[0], h[1]) | ((unsigned long long)pk2(h[2], h[3]) << 32); }
        } else if (t >= CTX) { float* orow = X.out() + (size_t)(t - CTX) * D; const bool bad = __hip_atomic_load(X.ctl() + CW_BAR + XB_TMO, RLX_AGENT) != 0u; const float pscale = 1.0f + bitsf(__hip_atomic_load(X.ctl() + 64, RLX_AGENT));
#pragma unroll
            for (int j = 0; j < D / 256; ++j) { const int d = 4 * lane + 256 * j; f32x4 o;
#pragma unroll
                for (int i = 0; i < 4; ++i) o[i] = bad ? __builtin_nanf("") : v[4 * j + i] * pscale;
                *(f32x4*)(orow + d) = o; }
        }
    }
}


#ifdef EMU
#define PHASE_FN static
#define THIN_FN static
#else
#define PHASE_FN __device__ __forceinline__
#define THIN_FN __device__ __noinline__
#endif
THIN_FN void ph_transposes(Ctx X, int l, int part) { phase_transposes(X, l, part); }
THIN_FN void ph_filters(Ctx X, int l) { phase_filters(X, l); }
THIN_FN void ph_mod(Ctx X) { phase_mod(X); }
THIN_FN void ph_x0(Ctx X) { phase_x0(X); }
THIN_FN void ph_lin(Ctx X, int l) { phase_lin(X, l); }
THIN_FN void ph_lora_a(Ctx X, int u) { lora_unit_a(X, u); }
THIN_FN void ph_lora_b(Ctx X, int l, int u) { lora_unit_b(X, l, u); }
THIN_FN void ph_prep_hyena(Ctx X, int l) { phase_prep_hyena(X, l); }
THIN_FN void ph_ctxconv(Ctx X, int l) { phase_ctxconv(X, l); }
THIN_FN void ph_chunk_1(Ctx X, int u) { chunk_unit_1(X, u); }
THIN_FN void ph_chunk_2(Ctx X, int u) { chunk_unit_2(X, u); }
THIN_FN void ph_chunk_3(Ctx X, int u) { chunk_unit_3(X, u); }
THIN_FN void ph_seq(Ctx X) { phase_seq(X); }
THIN_FN void ph_fftconv(Ctx X, int l) { phase_fftconv(X, l); }
THIN_FN void ph_spectra(Ctx X, int l) { phase_spectra(X, l); }
THIN_FN void ph_finish(Ctx X, int l) { phase_finish(X, l); }
THIN_FN void ph_norm1(Ctx X, int l) { phase_norm1(X, l); }
THIN_FN void ph_scatter(Ctx X, int l) { phase_scatter(X, l); }
THIN_FN void ph_combine(Ctx X, int l) { phase_combine(X, l); }
PHASE_FN void ph_g13(Ctx X, int third) { pg8::Gemm g{third ? X.ws<bf16>(WS_T) : X.ws<bf16>(WS_XMOD), third ? X.ws<bf16>(WS_WO) : X.ws<bf16>(WS_WIN), D}; pg8::StaticOrder S; S.init(M, third ? D : PCP, X.G, X.bid);
    pg8::EpiBf16OrF32 E{X.ws<bf16>(WS_P), X.ws<float>(WS_MIX), third ? D : PCP, third != 0}; pg8::gemm_phase(X.lds, g, S, E); }
PHASE_FN void ph_g2(Ctx X, int second) { pg8::Gemm g{second ? X.ws<bf16>(WS_HO) : X.ws<bf16>(WS_RO), X.ws<bf16>(WS_WB) + (second ? (size_t)D * RW : 0), RW}; pg8::StaticOrder S; S.init(M, D, X.G, X.bid);
    pg8::EpiGate E{X.ws<bf16>(WS_T), D, X.ws<bf16>(WS_P), PCP, second ? C_GH : C_GR, second != 0}; pg8::gemm_phase(X.lds, g, S, E); }
PHASE_FN void ph_g45(Ctx X, int l, int down) { const int NT = down ? D / 256 : 2 * D / 256; moe_table(X, l, NT); pg8::MoeOrder S{(const volatile LAS int*)(X.lds + LDS_MISC) + 8, NT, X.G, X.bid};
    pg8::Gemm g{down ? X.ws<bf16>(WS_ACT) : X.ws<bf16>(WS_XG), down ? X.ws<bf16>(WS_WD) : X.ws<bf16>(WS_WGU), D}; pg8::EpiMoe E{down ? X.ws<bf16>(WS_YS) : X.ws<bf16>(WS_ACT), D, NT, down == 0}; pg8::gemm_phase(X.lds, g, S, E); }

constexpr int NPH = 16, NPHASES = DEPTH * NPH;
template <int MASK> __global__ void __launch_bounds__(NTHR, 2) fwd_kernel(Args args) {
    DYN_LDS(lds);
    Ctx X; X.lds = lds; X.tid = threadIdx.x; X.lane = X.tid & 63; X.wave = READFIRSTLANE(X.tid >> 6); X.G = gridDim.x; X.bid = blockIdx.x;
    volatile LAS unsigned* misc = (volatile LAS unsigned*)(lds + LDS_MISC);
    if (X.tid < 128) misc[X.tid] = 0u;
    if (X.tid < N_IN + 2) { const unsigned long long p = X.tid < N_IN ? (unsigned long long)args.in[X.tid < N_IN ? X.tid : 0] : (X.tid == N_IN ? (unsigned long long)args.out : (unsigned long long)args.ws);
        misc[PT_WORD0 + 2 * X.tid] = (unsigned)p; misc[PT_WORD0 + 2 * X.tid + 1] = (unsigned)(p >> 32); }
    __syncthreads();
    XcdBarrier bar = xcd_barrier_post(X.ctl() + CW_BAR, misc);
    const int lo = args.ph_lo, hi = args.ph_hi;
#define IN(k) ((((MASK) >> ((k) % NPH)) & 1) && lo <= (k) && (k) < hi)
#ifdef PROBE_K
#ifndef PROBE_SCALE
#define PROBE_SCALE 1.0f
#endif
#ifndef PROBE_BLOCK
#define PROBE_BLOCK 0
#endif
    unsigned long long plast = __builtin_amdgcn_s_memrealtime(); if (threadIdx.x < 32) misc[2048 + threadIdx.x] = 0u; __syncthreads();
#define PROBE_TX(k) do { if (blockIdx.x == PROBE_BLOCK && threadIdx.x == 0) { const unsigned long long now_ = __builtin_amdgcn_s_memrealtime(); misc[2048 + (k)] += (unsigned)(now_ - plast); plast = now_; } } while (0)
#define PROBE_T(k) PROBE_TX((k) % NPH)
#define PROBE_PUB(k) do { if ((k) == NPHASES - 2 && blockIdx.x == PROBE_BLOCK && threadIdx.x == 0) { PROBE_T(k); unsigned tot_ = 0; for (int i_ = 0; i_ < 28; ++i_) tot_ += misc[2048 + i_]; \
        const float f_ = floorf(PROBE_SCALE * (float)misc[2048 + PROBE_K] / (float)tot_ * 128.0f + 0.5f) * (1.0f / 128.0f); __hip_atomic_store(X.ctl() + 64, fbits(f_), RLX_AGENT); } } while (0)
#else
#define PROBE_T(k) do {} while (0)
#define PROBE_TX(k) do {} while (0)
#define PROBE_PUB(k) do {} while (0)
#endif
#define SEAM(k) do { PROBE_PUB(k); if ((k) + 1 < hi) xcd_barrier(bar); PROBE_T(k); } while (0)
    for (int l = 0; l < DEPTH; ++l) {
        const int pb = l * NPH;
        if (IN(pb + 0)) { ph_transposes(X, l, 0); __syncthreads(); PROBE_TX(20); ph_filters(X, l); PROBE_TX(21); if (l == 0) ph_mod(X); PROBE_TX(22); SEAM(pb + 0); }
        if (l == 0 && IN(pb + 1)) { ph_x0(X); SEAM(pb + 1); }
        if (IN(pb + 2)) { ph_g13(X, 0); SEAM(pb + 2); }
        if (IN(pb + 3)) { ph_lin(X, l); PROBE_TX(23); ph_prep_hyena(X, l); PROBE_TX(24); ph_spectra(X, l); PROBE_TX(25); SEAM(pb + 3); }
        if (IN(pb + 4)) { for (int u = X.bid; u < (M / 64) * NH; u += X.G) { ph_lora_a(X, u); ph_lora_b(X, l, u); } SEAM(pb + 4); }
        if (IN(pb + 5)) { for (int u = X.bid; u < 2 * NCHK * NH; u += X.G) { ph_chunk_1(X, u); ph_chunk_2(X, u); ph_chunk_3(X, u); } SEAM(pb + 5); }
        if (IN(pb + 6)) { ph_seq(X); PROBE_TX(16); ph_transposes(X, l, 1); __syncthreads(); PROBE_TX(17); ph_ctxconv(X, l); PROBE_TX(18); ph_fftconv(X, l); PROBE_TX(19); SEAM(pb + 6); }
        if (IN(pb + 7)) { ph_finish(X, l); SEAM(pb + 7); }
        for (int sb = 0; sb < 2; ++sb) if (IN(pb + 8 + sb)) { ph_g2(X, sb); SEAM(pb + 8 + sb); }
        if (IN(pb + 10)) { ph_g13(X, 1); SEAM(pb + 10); }
        if (IN(pb + 11)) { ph_norm1(X, l); SEAM(pb + 11); }
        if (IN(pb + 12)) { ph_scatter(X, l); SEAM(pb + 12); }
        for (int dn = 0; dn < 2; ++dn) if (IN(pb + 13 + dn)) { ph_g45(X, l, dn); SEAM(pb + 13 + dn); }
        if (IN(pb + 15)) { ph_combine(X, l); SEAM(pb + 15); }
    }
#undef IN
#undef SEAM
}

#ifndef N_LAUNCHES
#define N_LAUNCHES 1
#endif
#ifndef PH_MASK
#define PH_MASK 0xffff
#endif
template <int MASK> static void launch_mask(int grid, hipStream_t stream, const Args& a) {
    static bool attr = false;
    if (!attr) { (void)hipFuncSetAttribute((const void*)fwd_kernel<MASK>, hipFuncAttributeMaxDynamicSharedMemorySize, LDS_BYTES); attr = true; }
    hipLaunchKernelGGL(fwd_kernel<MASK>, dim3(grid), dim3(NTHR), LDS_BYTES, stream, a);
}
extern "C" void kernel_launch(void* const* d_in, const int* in_sizes, int n_in, void* d_out, int out_size, void* d_ws, size_t ws_size, hipStream_t stream) {
    static int grid = 0;
    if (grid == 0) {
        if (n_in != N_IN || ws_size < WS_END) { fprintf(stderr, "kernel_launch: unexpected n_in %d or workspace %zu < %zu\n", n_in, ws_size, (size_t)WS_END); grid = -1; return; }
        int dev = 0, cus = 0;
        if (hipGetDevice(&dev) != hipSuccess || hipDeviceGetAttribute(&cus, hipDeviceAttributeMultiprocessorCount, dev) != hipSuccess) { grid = -1; return; }
        (void)hipGetLastError();
        grid = cus; if (grid > NPART) grid = NPART;
    }
    if (grid < 0) return;
    (void)in_sizes; (void)out_size;
    (void)hipMemsetAsync(d_ws, 0, CTL_BYTES, stream);
    Args a;
    for (int i = 0; i < N_IN; ++i) a.in[i] = (const float*)d_in[i];
    a.out = (float*)d_out; a.ws = (unsigned char*)d_ws;
#if N_LAUNCHES == 1
    a.ph_lo = 0; a.ph_hi = NPHASES;
    launch_mask<PH_MASK>(grid, stream, a);
#else
    for (int ph = 0; ph < NPHASES; ++ph) { const int k = ph % NPH; if (k == 1 && ph / NPH != 0) continue; a.ph_lo = ph; a.ph_hi = ph + 1; launch_mask<PH_MASK>(grid, stream, a); }
#endif
}
```

```cpp
#ifndef EMU
#include <hip/hip_runtime.h>
#endif
#include <cstdio>
#include <cstdint>
#include <cmath>

#ifndef CFG_D
#define CFG_D 1024
#define CFG_SEQ 16384
#define CFG_CTX 256
#define CFG_DEPTH 4
#endif
constexpr int D = CFG_D, SEQ = CFG_SEQ, CTX = CFG_CTX, DEPTH = CFG_DEPTH, M = CTX + SEQ;
constexpr int GRID_W = 64, GRID_H = SEQ / GRID_W;
constexpr int RW = D / 2, NH = RW / 64, HW = D / 2, RC = 3 * RW + 384, HC = 3 * HW, GC = 2 * D, PC = RC + HC + GC, PCP = (PC + 255) / 256 * 256;
constexpr int QTR = RC / 4, HALFC = RC / 2;
constexpr int C_K = RW, C_V = 2 * RW, C_LWF = 3 * RW, C_LG = 3 * RW + 256;
constexpr int C_HY = RC, C_GR = RC + HC, C_GH = RC + HC + D;
constexpr int NE = 16, SP_TILES = (2 * M) / 256 + NE, SP = SP_TILES * 256;
constexpr float DECAY_SCALE = 0.606531f, GN_EPS = 6.4e-4f, LN_EPS = 1e-5f;
constexpr int N_SEQ_UNITS = 2 * NH * 4;
constexpr int NPART = 256;
static_assert(CTX % 32 == 0 && M % 256 == 0 && D % 256 == 0 && RW % 128 == 0 && RW >= 256 && SEQ % 64 == 0 && CTX % 32 == 0 && RC % 4 == 0, "shape assumptions");

enum { I_X = 0, I_C, I_CTX, I_CCTX, I_WMOD, I_BMOD, I_WIN, I_MU, I_W0, I_W2, I_A0, I_A2, I_G2, I_KK, I_KA, I_RK, I_LNXG, I_LNXB, I_CW, I_CB,
       I_FW1, I_FB1, I_FW2, I_FB2, I_FW3, I_FB3, I_FWO, I_FREQ, I_HBIAS, I_WBR, I_WOUT, I_LNG, I_LNB, I_WR, I_RB, I_WG, I_WU, I_WD, N_IN };

constexpr size_t al256(size_t x) { return (x + 255) & ~(size_t)255; }
constexpr size_t CTL_BYTES = 1u << 20;
constexpr size_t WS_MOD = CTL_BYTES;
constexpr size_t WS_FPART = al256(WS_MOD + (size_t)DEPTH * 2 * 6 * D * 4);
constexpr size_t WS_ROUT = al256(WS_FPART + (size_t)2 * NPART * HW * 4);
constexpr size_t WS_BCNT = al256(WS_ROUT + (size_t)M * 2 * 4 * 3);
constexpr size_t WS_BONUS = al256(WS_BCNT + (size_t)NPART * NE * 4);
constexpr size_t WS_WIN = al256(WS_BONUS + (size_t)M * NH * 4);
constexpr size_t WS_WB = al256(WS_WIN + (size_t)PCP * D * 2);
constexpr size_t WS_WO = al256(WS_WB + (size_t)2 * D * RW * 2);
constexpr size_t WS_W2T = al256(WS_WO + (size_t)D * D * 2);
constexpr size_t WS_A2T = al256(WS_W2T + (size_t)2 * RW * 64 * 2);
constexpr size_t WS_G2T = al256(WS_A2T + (size_t)2 * RW * 64 * 2);
constexpr size_t WS_WGU = al256(WS_G2T + (size_t)RW * 128 * 2);
constexpr size_t WS_WD = al256(WS_WGU + (size_t)NE * 2 * D * D * 2);
constexpr size_t WS_X = al256(WS_WD + (size_t)NE * D * D * 2);
constexpr size_t WS_XMOD = al256(WS_X + (size_t)M * D * 4);
constexpr size_t WS_P = al256(WS_XMOD + (size_t)M * D * 2);
constexpr size_t WS_FILT = al256(WS_P + (size_t)M * PCP * 2);
constexpr size_t WS_MIX = al256(WS_FILT + (size_t)M * HW * 4);
constexpr size_t WS_T = al256(WS_MIX + (size_t)M * D * 4);
constexpr size_t WS_S = al256(WS_T + (size_t)M * D * 2);
constexpr size_t WS_R = WS_S;
constexpr size_t WS_V = al256(WS_R + (size_t)M * RW * 2);
constexpr size_t WS_KA = al256(WS_V + (size_t)M * RW * 2);
constexpr size_t WS_KD = al256(WS_KA + (size_t)M * RW * 2);
constexpr size_t WS_KB = al256(WS_KD + (size_t)2 * M * RW * 2);
constexpr size_t WS_W = al256(WS_KB + (size_t)2 * M * RW * 2);
constexpr size_t WS_PQ = al256(WS_W + (size_t)2 * M * RW * 4);
constexpr size_t WS_LIN = WS_PQ;
static_assert((size_t)M * 384 * 2 <= (size_t)2 * NH * (M / 64) * 2 * 4096 * 4, "LIN fits PQ");
constexpr size_t WS_G = al256(WS_PQ + (size_t)2 * NH * (M / 64) * 2 * 4096 * 4);
constexpr size_t WS_YL = al256(WS_G + (size_t)2 * NH * (M / 64) * 4096 * 2);
constexpr size_t WS_S0 = WS_XMOD;
static_assert((size_t)2 * NH * (M / 64) * 4096 * 2 <= (size_t)M * D * 2, "S0 fits XMOD");
constexpr size_t WS_Z = al256(WS_YL + (size_t)2 * NH * (M / 64) * 4096 * 4);
constexpr size_t WS_X0 = al256(WS_Z + (size_t)CTX * HW * 4);
constexpr size_t WS_CONV = al256(WS_X0 + (size_t)M * HW * 2);
constexpr size_t WS_GATE = al256(WS_CONV + (size_t)CTX * HW * 4);
constexpr size_t WS_RO = al256(WS_GATE + (size_t)M * RW * 2);
constexpr size_t WS_HO = al256(WS_RO + (size_t)M * RW * 2);
constexpr size_t WS_HS = WS_MIX;
constexpr size_t WS_ZT = WS_T;
constexpr size_t WS_CVT = WS_FILT;
static_assert((size_t)HW * (SEQ + 1) * 8 <= (size_t)M * D * 4 && (size_t)HW * M * 4 <= (size_t)M * D * 2, "HS fits MIX, ZT fits T");
constexpr size_t WS_END1 = al256(WS_HO + (size_t)M * HW * 2);
constexpr size_t WS_XG = WS_S;
constexpr size_t WS_ACT = al256(WS_XG + (size_t)SP * D * 2);
constexpr size_t WS_YS = al256(WS_ACT + (size_t)SP * D * 2);
constexpr size_t WS_END2 = al256(WS_YS + (size_t)SP * D * 2);
constexpr size_t WS_END = WS_END1 > WS_END2 ? WS_END1 : WS_END2;
constexpr int CW_TMO = 0, CW_BAR = 4096, CW_CNT = 8192  , CW_CUR = 8192 + 1024  , CW_Q = 8192 + 2048  ;

#ifdef EMU
#define LAS
typedef short bf16x8 __attribute__((vector_size(16)));
typedef float f32x4 __attribute__((vector_size(16)));
typedef unsigned u32x4 __attribute__((vector_size(16)));
#define DYN_LDS(name) unsigned char* name = emu_cur_lds()
#define ASM_WAIT_V(n) do {} while (0)
#define ASM_WAIT_L(n) do {} while (0)
#define ASM_WAIT_VL0() do {} while (0)
#define CFENCE() do {} while (0)
#define WAVE_LDS_FENCE() emu_wave_sync()
#define S_BARRIER() emu_block_sync()
#define SCHED_BARRIER() do {} while (0)
#define SETPRIO(x) do {} while (0)
#define S_SLEEP(n) emu_yield()
#define MFMA16(a, b, c) emu_mfma_16x16x32(a, b, c)
#define MFMA4F(a, b, c) emu_mfma_16x16x4f32(a, b, c)
#define GLDS16(gptr, lptr) emu_glds16((const void*)(gptr), (void*)(lptr))
#define READFIRSTLANE(x) (x)
#define XCC_ID_() (blockIdx.x & 7u)
#define FENCE_RELEASE() do {} while (0)
#define FENCE_ACQUIRE() do {} while (0)
#define DPP_F(v, ctrl) emu_dpp_f(v, ctrl)
#define READLANE_F(v, l) emu_xchg((float)(v), (l))
static inline int vgpr_zero() { return 0; }
static inline unsigned long long vgpr_zero64() { return 0ull; }
static inline int lds_add(volatile int* p, int v) { int o = *p; *p = o + v; return o; }
static inline unsigned fbits(float f) { unsigned u; memcpy(&u, &f, 4); return u; }
static inline float bitsf(unsigned u) { float f; memcpy(&f, &u, 4); return f; }
#else
#define LAS __attribute__((address_space(3)))
typedef short bf16x8 __attribute__((ext_vector_type(8)));
typedef float f32x4 __attribute__((ext_vector_type(4)));
typedef unsigned u32x4 __attribute__((ext_vector_type(4)));
#define DYN_LDS(name) extern __shared__ __attribute__((aligned(16))) unsigned char name##_raw[]; LAS unsigned char* name = (LAS unsigned char*)name##_raw
#define ASM_WAIT_V(n) asm volatile("s_waitcnt vmcnt(" #n ")" ::: "memory")
#define ASM_WAIT_L(n) asm volatile("s_waitcnt lgkmcnt(" #n ")" ::: "memory")
#define ASM_WAIT_VL0() asm volatile("s_waitcnt vmcnt(0) lgkmcnt(0)" ::: "memory")
#define CFENCE() asm volatile("" ::: "memory")
#define WAVE_LDS_FENCE() asm volatile("s_waitcnt lgkmcnt(0)" ::: "memory")
#define S_BARRIER() __builtin_amdgcn_s_barrier()
#define SCHED_BARRIER() __builtin_amdgcn_sched_barrier(0)
#define SETPRIO(x) __builtin_amdgcn_s_setprio(x)
#define S_SLEEP(n) __builtin_amdgcn_s_sleep(n)
#define MFMA16(a, b, c) __builtin_amdgcn_mfma_f32_16x16x32_bf16(a, b, c, 0, 0, 0)
#define MFMA4F(a, b, c) __builtin_amdgcn_mfma_f32_16x16x4f32(a, b, c, 0, 0, 0)
#define GLDS16(gptr, lptr) __builtin_amdgcn_global_load_lds((const unsigned*)(gptr), (LAS unsigned*)(lptr), 16, 0, 0)
#define READFIRSTLANE(x) __builtin_amdgcn_readfirstlane(x)
#define XCC_ID_() ((unsigned)__builtin_amdgcn_s_getreg((3 << 11) | 20) & 0xFu)
#define FENCE_RELEASE() __builtin_amdgcn_fence(__ATOMIC_RELEASE, "agent")
#define FENCE_ACQUIRE() __builtin_amdgcn_fence(__ATOMIC_ACQUIRE, "agent")
#define DPP_F(v, ctrl) __builtin_bit_cast(float, __builtin_amdgcn_update_dpp(0, __builtin_bit_cast(int, (float)(v)), (ctrl), 0xF, 0xF, true))
#define READLANE_F(v, l) __builtin_bit_cast(float, __builtin_amdgcn_readlane(__builtin_bit_cast(int, (float)(v)), (l)))
__device__ __forceinline__ int vgpr_zero() { int z; asm volatile("v_mov_b32 %0, 0" : "=v"(z)); return z; }
__device__ __forceinline__ unsigned long long vgpr_zero64() { unsigned long long z; asm volatile("v_mov_b64 %0, 0" : "=v"(z)); return z; }
__device__ __forceinline__ int lds_add(volatile LAS int* p, int v) { return __hip_atomic_fetch_add((LAS int*)p, v, __ATOMIC_RELAXED, __HIP_MEMORY_SCOPE_WORKGROUP); }
__device__ __forceinline__ unsigned fbits(float f) { return __builtin_bit_cast(unsigned, f); }
__device__ __forceinline__ float bitsf(unsigned u) { return __builtin_bit_cast(float, u); }
#endif
typedef unsigned short bf16;
#define RLX_AGENT __ATOMIC_RELAXED, __HIP_MEMORY_SCOPE_AGENT

__device__ __forceinline__ unsigned f2bf(float f) { unsigned u = fbits(f); return (u + 0x7fffu + ((u >> 16) & 1u)) >> 16; }
__device__ __forceinline__ unsigned pk2(float lo, float hi) { return f2bf(lo) | (f2bf(hi) << 16); }
__device__ __forceinline__ float bf2f(bf16 b) { return bitsf(((unsigned)b) << 16); }
__device__ __forceinline__ float bflo(unsigned w) { return bitsf(w << 16); }
__device__ __forceinline__ float bfhi(unsigned w) { return bitsf(w & 0xffff0000u); }
#ifdef EMU
__device__ __forceinline__ float fexp(float x) { return expf(x); }
__device__ __forceinline__ float frcp(float x) { return 1.0f / x; }
#else
__device__ __forceinline__ float fexp(float x) { return __builtin_amdgcn_exp2f(x * 1.4426950408889634f); }
__device__ __forceinline__ float frcp(float x) { return __builtin_amdgcn_rcpf(x); }
#endif
__device__ __forceinline__ float sigmoidf_(float x) { return frcp(1.0f + fexp(-x)); }
__device__ __forceinline__ float row16_sum(float v) {
    v += DPP_F(v, 0xB1);
    v += DPP_F(v, 0x4E);
    v += DPP_F(v, 0x141);
    v += DPP_F(v, 0x140);
    return v;
}
__device__ __forceinline__ float wave_sum(float v) {
    const float r = row16_sum(v);
    return (READLANE_F(r, 0) + READLANE_F(r, 16)) + (READLANE_F(r, 32) + READLANE_F(r, 48));
}
__device__ __forceinline__ void sincos_f(float x, float& s, float& c) {
    const float k = rintf(x * 0.63661977236758134f);
    float r = fmaf(-k, 1.5703125f, x); r = fmaf(-k, 4.837512969970703125e-4f, r); r = fmaf(-k, 7.54978994989188216e-8f, r);
    const float r2 = r * r;
    const float sp = r + r * r2 * (-1.6666654611e-1f + r2 * (8.3321608736e-3f + r2 * (-1.9515295891e-4f)));
    const float cp = 1.0f - 0.5f * r2 + r2 * r2 * (4.166664568298827e-2f + r2 * (-1.388731625493765e-3f + r2 * (2.443315711809948e-5f)));
    const int q = ((int)k) & 3;
    s = (q == 0) ? sp : (q == 1) ? cp : (q == 2) ? -sp : -cp;
    c = (q == 0) ? cp : (q == 1) ? -sp : (q == 2) ? -cp : sp;
}
__device__ __forceinline__ float sin_f(float x) { float s, c; sincos_f(x, s, c); return s; }

template <class T> __device__ __forceinline__ T* as_global(T* p) {
#ifndef EMU
    return (T*)(__attribute__((address_space(1))) T*)(unsigned long long)p;
#else
    return p;
#endif
}
#define XB_TMO      128
#define XB_XCNT(j)  (256  + 64 * (j))
#define XB_XSUB(j)  (1280 + 64 * (j))
#define XB_XGEN(j)  (2304 + 64 * (j))
#define XB_TOP      3328
#define XB_TOPGEN   3392
#define XCD_BAR_WORDS 3456
#define XB_SPIN_CAP (1u << 18)
__device__ __forceinline__ unsigned xb_ld(unsigned* p)              { return __hip_atomic_load(p, __ATOMIC_RELAXED, __HIP_MEMORY_SCOPE_AGENT); }
__device__ __forceinline__ unsigned xb_add(unsigned* p, unsigned v) { return __hip_atomic_fetch_add(p, v, __ATOMIC_RELAXED, __HIP_MEMORY_SCOPE_AGENT); }
#define XB_SPIN(cond, bar) do { unsigned _sp = 0; while (cond) { S_SLEEP(1); \
    if ((++_sp & 255u) == 0u) { if (xb_ld(&(bar)[XB_TMO])) break; if (_sp > XB_SPIN_CAP) { atomicAdd(&(bar)[XB_TMO], 1u); break; } } } } while (0)
struct XcdBarrier { unsigned* bar; unsigned x; volatile LAS unsigned* st; };
__device__ __forceinline__ XcdBarrier xcd_barrier_post(unsigned* bar, volatile LAS unsigned* st) {
    XcdBarrier b; b.bar = nullptr; b.x = XCC_ID_(); b.st = st;
    if (threadIdx.x == 0) { st[2] = (unsigned)(unsigned long long)bar; st[3] = (unsigned)((unsigned long long)bar >> 32); st[4] = b.x; (void)xb_add(&bar[XB_XCNT(b.x)], 1u); }
    return b;
}
__device__ __forceinline__ void xcd_barrier_complete(unsigned* bar, unsigned x, unsigned& nloc, unsigned& nx) {
    const unsigned G = gridDim.x * gridDim.y * gridDim.z;
    unsigned sum, cnt, mine, sp = 0u;
    for (;;) {
        sum = 0u; cnt = 0u; mine = 0u;
#pragma unroll
        for (unsigned j = 0; j < 16; ++j) { const unsigned c = xb_ld(&bar[XB_XCNT(j)]); sum += c; cnt += (c > 0u) ? 1u : 0u; mine = (j == x) ? c : mine; }
        if (sum == G) break;
        S_SLEEP(1);
        if ((++sp & 255u) == 0u) { if (xb_ld(&bar[XB_TMO])) break; if (sp > XB_SPIN_CAP) { atomicAdd(&bar[XB_TMO], 1u); break; } }
    }
    nloc = mine > 0u ? mine : 1u; nx = cnt > 0u ? cnt : 1u;
}
__device__ __forceinline__ void xcd_barrier(const XcdBarrier& b) {
    ASM_WAIT_V(0);
    __syncthreads();
    if (threadIdx.x == 0) {
        unsigned* bar = as_global((unsigned*)(((unsigned long long)b.st[3] << 32) | b.st[2]));
        const unsigned bx = b.st[4];
        ASM_WAIT_VL0();
        unsigned nloc = b.st[0], nx = b.st[1];
        if (nloc == 0u) { xcd_barrier_complete(bar, bx, nloc, nx); b.st[0] = nloc; b.st[1] = nx; }
        const unsigned old = xb_add(&bar[XB_XSUB(bx)], 1u);
        const unsigned gen = old / nloc;
        if (old + 1u == (gen + 1u) * nloc) {
            FENCE_RELEASE();
            ASM_WAIT_V(0);
            const unsigned og = xb_add(&bar[XB_TOP], 1u);
            const unsigned tg = og / nx;
            if (og + 1u == (tg + 1u) * nx) xb_add(&bar[XB_TOPGEN], 1u);
            else XB_SPIN(xb_ld(&bar[XB_TOPGEN]) == tg, bar);
            FENCE_ACQUIRE();
            xb_add(&bar[XB_XGEN(bx)], 1u);
            ASM_WAIT_V(0);
        } else {
            XB_SPIN(xb_ld(&bar[XB_XGEN(bx)]) == gen, bar);
            FENCE_ACQUIRE();
            ASM_WAIT_V(0);
        }
    }
    __syncthreads();
}

namespace pg8 {
constexpr int BM = 256, BK = 64, HALF = 128, HTB = HALF * BK * 2, STAGE_BYTES = 8 * HTB, NXCD = 8, WGM = 8;
__host__ __device__ __forceinline__ int lds_byte(int r, int c) { const int st = (r >> 4) * 2 + (c >> 5), rr = r & 15, cc = c & 31, ob = rr * 64 + cc * 2; return st * 1024 + (ob ^ (((ob >> 9) & 1) << 5)); }
__host__ __device__ __forceinline__ void stage_rc(int b, int& R, int& C) { const int st = b / 1024, sb = b % 1024, swz = sb ^ (((sb >> 9) & 1) << 5); R = (st >> 1) * 16 + swz / 64; C = (st & 1) * 32 + (swz % 64) / 2; }
__host__ __device__ __forceinline__ int perm32(int rho) { const int n = rho >> 4, i = rho & 15; return 8 * (i >> 2) + 4 * n + (i & 3); }
struct Unit { int pm, pn; };
struct Gemm { const bf16* A; const bf16* Bt; int K; };
struct StaticOrder {
    int nM, nN, nwg, G, c;
    __host__ __device__ void init(int M_, int N_, int G_, int c_) { nM = M_ / BM; nN = N_ / BM; nwg = nM * nN; G = G_; c = c_; }
    __host__ __device__ bool next(int i, Unit& u) const {
        const long L = (long)i * G + c; if (L >= nwg) return false;
        int wgid = (int)L; { const int q = nwg / NXCD, r = nwg % NXCD, xcd = wgid % NXCD, off = wgid / NXCD; wgid = (xcd < r ? xcd * (q + 1) : r * (q + 1) + (xcd - r) * q) + off; }
        const int nig = WGM * nN, gid = wgid / nig, fm = gid * WGM, gsz = (nM - fm) < WGM ? (nM - fm) : WGM;
        u.pm = fm + ((wgid % nig) % gsz); u.pn = (wgid % nig) / gsz; return true;
    }
};
struct MoeOrder {
    const volatile LAS int* tab; int NT, G, c;
    __device__ __forceinline__ bool next(int i, Unit& u) const {
        const long L = (long)i * G + c; if (L >= tab[16]) return false;
        int e = 0; while (L >= tab[e + 1]) ++e;
        const int loc = (int)L - tab[e], tc = tab[64 + e];
        u.pm = tab[32 + e] + loc % tc; u.pn = e * NT + loc / tc; return true;
    }
};
__device__ __forceinline__ unsigned cvt_pk_bf16(float lo, float hi) {
#ifdef EMU
    return pk2(lo, hi);
#else
    unsigned r; asm volatile("v_cvt_pk_bf16_f32 %0, %1, %2" : "=v"(r) : "v"(lo), "v"(hi)); return r;
#endif
}

struct EpiBf16 {
    static constexpr bool PERM = true;
    bf16* O; int ldc;
    __device__ __forceinline__ void operator()(const f32x4 (&acc)[2][2][4][2], const Unit& u, int wr, int wc, int fr, int fq) const {
        const int row0 = u.pm * BM + wr * 64 + fr, col0 = u.pn * BM + wc * 32 + 8 * fq;
#pragma unroll
        for (int ai = 0; ai < 2; ++ai)
#pragma unroll
            for (int m = 0; m < 4; ++m) { bf16* rowp = O + (size_t)(row0 + ai * HALF + m * 16) * ldc + col0;
#pragma unroll
                for (int bj = 0; bj < 2; ++bj) { const f32x4 v0 = acc[ai][bj][m][0], v1 = acc[ai][bj][m][1];
                    u32x4 w; w[0] = cvt_pk_bf16(v0[0], v0[1]); w[1] = cvt_pk_bf16(v0[2], v0[3]); w[2] = cvt_pk_bf16(v1[0], v1[1]); w[3] = cvt_pk_bf16(v1[2], v1[3]);
                    *(u32x4*)(rowp + bj * HALF) = w; } }
    }
};
struct EpiF32 {
    static constexpr bool PERM = true;
    float* C; int ldc;
    __device__ __forceinline__ void operator()(const f32x4 (&acc)[2][2][4][2], const Unit& u, int wr, int wc, int fr, int fq) const {
        const int row0 = u.pm * BM + wr * 64 + fr, col0 = u.pn * BM + wc * 32 + 8 * fq;
#pragma unroll
        for (int ai = 0; ai < 2; ++ai)
#pragma unroll
            for (int m = 0; m < 4; ++m) { float* rowp = C + (size_t)(row0 + ai * HALF + m * 16) * ldc + col0;
#pragma unroll
                for (int bj = 0; bj < 2; ++bj)
#pragma unroll
                    for (int n = 0; n < 2; ++n) *(f32x4*)(rowp + bj * HALF + n * 4) = acc[ai][bj][m][n]; }
    }
};
struct EpiGate {
    static constexpr bool PERM = true;
    bf16* T; int ldc; const bf16* Pg; int ldp; int gcol0; bool ADD;
    __device__ __forceinline__ void operator()(const f32x4 (&acc)[2][2][4][2], const Unit& u, int wr, int wc, int fr, int fq) const {
        const int row0 = u.pm * BM + wr * 64 + fr, col0 = u.pn * BM + wc * 32 + 8 * fq;
#pragma unroll
        for (int ai = 0; ai < 2; ++ai)
#pragma unroll
            for (int m = 0; m < 4; ++m) { const size_t row = (size_t)(row0 + ai * HALF + m * 16);
#pragma unroll
                for (int bj = 0; bj < 2; ++bj) { const f32x4 v0 = acc[ai][bj][m][0], v1 = acc[ai][bj][m][1];
                    const u32x4 g = *(const u32x4*)(Pg + row * ldp + gcol0 + col0 + bj * HALF);
                    u32x4 t = {0u, 0u, 0u, 0u}; if (ADD) t = *(const u32x4*)(T + row * ldc + col0 + bj * HALF);
                    float o[8];
#pragma unroll
                    for (int j = 0; j < 4; ++j) { const float a0 = j < 2 ? v0[2 * j] : v1[2 * j - 4], a1 = j < 2 ? v0[2 * j + 1] : v1[2 * j - 3];
                        o[2 * j] = bflo(t[j]) + sigmoidf_(bflo(g[j])) * a0; o[2 * j + 1] = bfhi(t[j]) + sigmoidf_(bfhi(g[j])) * a1; }
                    u32x4 w; w[0] = cvt_pk_bf16(o[0], o[1]); w[1] = cvt_pk_bf16(o[2], o[3]); w[2] = cvt_pk_bf16(o[4], o[5]); w[3] = cvt_pk_bf16(o[6], o[7]);
                    *(u32x4*)(T + row * ldc + col0 + bj * HALF) = w; } }
    }
};
struct EpiSwiglu {
    static constexpr bool PERM = true;
    bf16* O; int ldc; int NT;
    __device__ __forceinline__ void operator()(const f32x4 (&acc)[2][2][4][2], const Unit& u, int wr, int wc, int fr, int fq) const {
        const int row0 = u.pm * BM + wr * 64 + fr, col0 = (u.pn % NT) * HALF + wc * 32 + 8 * fq;
#pragma unroll
        for (int ai = 0; ai < 2; ++ai)
#pragma unroll
            for (int m = 0; m < 4; ++m) { bf16* rowp = O + (size_t)(row0 + ai * HALF + m * 16) * ldc + col0;
                float o[8];
#pragma unroll
                for (int j = 0; j < 8; ++j) { const float g = acc[ai][0][m][j >> 2][j & 3], uu = acc[ai][1][m][j >> 2][j & 3]; o[j] = g / (1.0f + expf(-g)) * uu; }
                u32x4 w; w[0] = cvt_pk_bf16(o[0], o[1]); w[1] = cvt_pk_bf16(o[2], o[3]); w[2] = cvt_pk_bf16(o[4], o[5]); w[3] = cvt_pk_bf16(o[6], o[7]);
                *(u32x4*)rowp = w; }
    }
};
struct EpiMoeDown {
    static constexpr bool PERM = true;
    bf16* O; int ldc; int NT;
    __device__ __forceinline__ void operator()(const f32x4 (&acc)[2][2][4][2], const Unit& u, int wr, int wc, int fr, int fq) const {
        const int row0 = u.pm * BM + wr * 64 + fr, col0 = (u.pn % NT) * BM + wc * 32 + 8 * fq;
#pragma unroll
        for (int ai = 0; ai < 2; ++ai)
#pragma unroll
            for (int m = 0; m < 4; ++m) { bf16* rowp = O + (size_t)(row0 + ai * HALF + m * 16) * ldc + col0;
#pragma unroll
                for (int bj = 0; bj < 2; ++bj) { const f32x4 v0 = acc[ai][bj][m][0], v1 = acc[ai][bj][m][1];
                    u32x4 w; w[0] = cvt_pk_bf16(v0[0], v0[1]); w[1] = cvt_pk_bf16(v0[2], v0[3]); w[2] = cvt_pk_bf16(v1[0], v1[1]); w[3] = cvt_pk_bf16(v1[2], v1[3]);
                    *(u32x4*)(rowp + bj * HALF) = w; } }
    }
};

struct EpiBf16OrF32 { static constexpr bool PERM = true; bf16* O; float* C; int ldc; bool f32;
    __device__ __forceinline__ void operator()(const f32x4 (&acc)[2][2][4][2], const Unit& u, int wr, int wc, int fr, int fq) const {
        if (f32) { EpiF32 E{C, ldc}; E(acc, u, wr, wc, fr, fq); } else { EpiBf16 E{O, ldc}; E(acc, u, wr, wc, fr, fq); } } };
struct EpiMoe { static constexpr bool PERM = true; bf16* O; int ldc; int NT; bool swiglu;
    __device__ __forceinline__ void operator()(const f32x4 (&acc)[2][2][4][2], const Unit& u, int wr, int wc, int fr, int fq) const {
        if (swiglu) { EpiSwiglu E{O, ldc, NT}; E(acc, u, wr, wc, fr, fq); } else { EpiMoeDown E{O, ldc, NT}; E(acc, u, wr, wc, fr, fq); } } };
template <class Epi, class Sched>
__device__ __forceinline__ void gemm_phase(LAS unsigned char* lds, const Gemm g, const Sched& S, const Epi& E) {
    const int tid = threadIdx.x + vgpr_zero();
    const int wid = READFIRSTLANE(tid >> 6), lane = tid & 63, wr = wid >> 2, wc = wid & 3, fr = lane & 15, fq = lane >> 4;
    const int K = g.K, nt = K / BK;
    unsigned long long voffA[2], voffB[2]; const unsigned long long zhi = vgpr_zero64();
#pragma unroll
    for (int i = 0; i < 2; ++i) { int R, C; stage_rc(tid * 16 + i * 8192, R, C); const int Rb = Epi::PERM ? ((R & ~31) + perm32(R & 31)) : R;
        voffA[i] = zhi + (unsigned long long)(long long)((R * K + C) * 2); voffB[i] = zhi + (unsigned long long)(long long)((Rb * K + C) * 2); }
    const size_t kstep = (size_t)(BK * 2);
    const size_t hstep = (size_t)HALF * K * 2;
    const size_t tstep = 2 * hstep;
    const unsigned ldsw = (unsigned)wid * 1024u;
    const int aoff = lds_byte(wr * 64 + fr, fq * 8), boff = lds_byte(wc * 32 + fr, fq * 8);
#define PG8_SA(b, h) (((b) * 2 + (h)) * HTB)
#define PG8_SB(b, h) ((4 + (b) * 2 + (h)) * HTB)
#define PG8_STAGE(bufoff, gbase, voff) do { _Pragma("unroll") for (int _i = 0; _i < 2; ++_i) \
        GLDS16((const char*)(gbase) + (voff)[_i], lds + (bufoff) + ldsw + _i * 8192); } while (0)
#define PG8_LDA(dst, b, h) do { _Pragma("unroll") for (int m = 0; m < 4; ++m) _Pragma("unroll") for (int k = 0; k < 2; ++k) dst[m][k] = *(const LAS bf16x8*)(lds + PG8_SA(b, h) + aoff + m * 2048 + k * 1024); } while (0)
#define PG8_LDB(dst, b, h) do { _Pragma("unroll") for (int n = 0; n < 2; ++n) _Pragma("unroll") for (int k = 0; k < 2; ++k) dst[n][k] = *(const LAS bf16x8*)(lds + PG8_SB(b, h) + boff + n * 2048 + k * 1024); } while (0)
#define PG8_MMA(ai, bj, At, Bt) do { SETPRIO(1); _Pragma("unroll") for (int m = 0; m < 4; ++m) _Pragma("unroll") for (int n = 0; n < 2; ++n) _Pragma("unroll") for (int k = 0; k < 2; ++k) \
        acc[ai][bj][m][n] = MFMA16(Bt[n][k], At[m][k], acc[ai][bj][m][n]); SETPRIO(0); } while (0)
#define PG8_BAR S_BARRIER()
    Unit cur, nxt; int ui = 0;
    if (!S.next(0, cur)) return;
    f32x4 acc[2][2][4][2];
#pragma unroll
    for (int a = 0; a < 2; ++a)
#pragma unroll
        for (int b = 0; b < 2; ++b)
#pragma unroll
            for (int m = 0; m < 4; ++m)
#pragma unroll
                for (int n = 0; n < 2; ++n) acc[a][b][m][n] = (f32x4){0.f, 0.f, 0.f, 0.f};
    bf16x8 At[4][2], B0[2][2], B1[2][2];
    const char* cA = (const char*)g.A + (size_t)cur.pm * tstep; const char* cB = (const char*)g.Bt + (size_t)cur.pn * tstep;
    PG8_STAGE(PG8_SB(0, 0), cB, voffB); PG8_STAGE(PG8_SA(0, 0), cA, voffA); PG8_STAGE(PG8_SB(0, 1), cB + hstep, voffB); PG8_STAGE(PG8_SA(0, 1), cA + hstep, voffA);
    if (wr == 1) PG8_BAR;
    ASM_WAIT_V(4); PG8_BAR;
    PG8_STAGE(PG8_SB(1, 0), cB + kstep, voffB); PG8_STAGE(PG8_SA(1, 0), cA + kstep, voffA); PG8_STAGE(PG8_SB(1, 1), cB + hstep + kstep, voffB);
    ASM_WAIT_V(6); PG8_BAR;
    for (;;) {
        const bool has_next = S.next(ui + 1, nxt);
        const char* nA = has_next ? (const char*)g.A + (size_t)nxt.pm * tstep : cA; const char* nB = has_next ? (const char*)g.Bt + (size_t)nxt.pn * tstep : cB;
        for (int t = 0; t < nt; t += 2) {
            const bool last = (t == nt - 2);
            const char* a1 = cA + (size_t)(t + 1) * kstep;
            const char* a2 = last ? nA : cA + (size_t)(t + 2) * kstep; const char* b2 = last ? nB : cB + (size_t)(t + 2) * kstep;
            const char* a3 = a2 + kstep; const char* b3 = b2 + kstep;
            PG8_LDB(B0, 0, 0); SCHED_BARRIER(); PG8_LDA(At, 0, 0); PG8_STAGE(PG8_SA(1, 1), a1 + hstep, voffA);
            ASM_WAIT_L(8); PG8_BAR; ASM_WAIT_L(0); PG8_MMA(0, 0, At, B0); PG8_BAR; SCHED_BARRIER();
            PG8_LDB(B1, 0, 1); PG8_STAGE(PG8_SB(0, 0), b2, voffB);
            PG8_BAR; ASM_WAIT_L(0); PG8_MMA(0, 1, At, B1); PG8_BAR;
            PG8_LDA(At, 0, 1); PG8_STAGE(PG8_SA(0, 0), a2, voffA);
            PG8_BAR; ASM_WAIT_L(0); PG8_MMA(1, 0, At, B0); PG8_BAR; SCHED_BARRIER();
            PG8_STAGE(PG8_SB(0, 1), b2 + hstep, voffB);
            ASM_WAIT_V(6); PG8_BAR; PG8_MMA(1, 1, At, B1); PG8_BAR;
            PG8_LDB(B0, 1, 0); SCHED_BARRIER(); PG8_LDA(At, 1, 0); PG8_STAGE(PG8_SA(0, 1), a2 + hstep, voffA);
            ASM_WAIT_L(8); PG8_BAR; ASM_WAIT_L(0); PG8_MMA(0, 0, At, B0); PG8_BAR; SCHED_BARRIER();
            PG8_LDB(B1, 1, 1); PG8_STAGE(PG8_SB(1, 0), b3, voffB);
            PG8_BAR; ASM_WAIT_L(0); PG8_MMA(0, 1, At, B1); PG8_BAR;
            PG8_LDA(At, 1, 1); PG8_STAGE(PG8_SA(1, 0), a3, voffA);
            PG8_BAR; ASM_WAIT_L(0); PG8_MMA(1, 0, At, B0); PG8_BAR; SCHED_BARRIER();
            PG8_STAGE(PG8_SB(1, 1), b3 + hstep, voffB);
            ASM_WAIT_V(6); PG8_BAR; PG8_MMA(1, 1, At, B1); PG8_BAR;
        }
        E(acc, cur, wr, wc, fr, fq);
        if (!has_next) break;
#pragma unroll
        for (int a = 0; a < 2; ++a)
#pragma unroll
            for (int b = 0; b < 2; ++b)
#pragma unroll
                for (int m = 0; m < 4; ++m)
#pragma unroll
                    for (int n = 0; n < 2; ++n) acc[a][b][m][n] = (f32x4){0.f, 0.f, 0.f, 0.f};
        cur = nxt; cA = nA; cB = nB; ++ui;
    }
    ASM_WAIT_V(0);
    if (wr == 0) PG8_BAR;
    PG8_BAR;
#undef PG8_SA
#undef PG8_SB
#undef PG8_STAGE
#undef PG8_LDA
#undef PG8_LDB
#undef PG8_MMA
#undef PG8_BAR
}
}

struct Args { const float* in[N_IN]; float* out; unsigned char* ws; int ph_lo, ph_hi; };
constexpr int NWAVES = 8, NTHR = 512;
constexpr int LDS_STAGE = 131072, LDS_MISC = LDS_STAGE, LDS_BYTES = 147456;

constexpr int PT_OUT = N_IN, PT_WS = N_IN + 1, PT_WORD0 = 128;

struct Ctx {
    LAS unsigned char* lds; int tid, lane, wave, G, bid;
    __device__ __forceinline__ unsigned long long ptr(int i) const { const volatile LAS unsigned* t = (const volatile LAS unsigned*)(lds + LDS_MISC) + PT_WORD0 + 2 * i;
        const unsigned lo = (unsigned)READFIRSTLANE((int)t[0]), hi = (unsigned)READFIRSTLANE((int)t[1]); return ((unsigned long long)hi << 32) | lo; }
    __device__ __forceinline__ unsigned long long ptrv(int i) const { const volatile LAS unsigned* t = (const volatile LAS unsigned*)(lds + LDS_MISC) + PT_WORD0 + 2 * i; return ((unsigned long long)t[1] << 32) | t[0]; }
    __device__ __forceinline__ const float* inv(int i) const { return as_global((const float*)ptrv(i)); }
    template <class T> __device__ __forceinline__ T* wsv(size_t off) const { return as_global((T*)((unsigned char*)ptrv(PT_WS) + off)); }
    __device__ __forceinline__ const float* in(int i) const { return as_global((const float*)ptr(i)); }
    __device__ __forceinline__ float* out() const { return as_global((float*)ptr(PT_OUT)); }
    template <class T> __device__ __forceinline__ T* ws(size_t off) const { return as_global((T*)((unsigned char*)ptr(PT_WS) + off)); }
    __device__ __forceinline__ unsigned* ctl() const { return as_global((unsigned*)ptr(PT_WS)); }
};

__device__ __forceinline__ void transpose_item(const float* W, int ldw, int k0, int n0, int nvalid, bf16* outp, int ldo, LAS float* scr, int lane) {
#pragma unroll
    for (int i = 0; i < 32; ++i) { const int kk = 2 * i + (lane >> 5), n = n0 + (lane & 31); scr[kk * 33 + (lane & 31)] = (n < nvalid) ? W[(size_t)(k0 + kk) * ldw + n] : 0.f; }
    WAVE_LDS_FENCE(); CFENCE();
    const int c = lane & 7;
#pragma unroll
    for (int j = 0; j < 4; ++j) { const int n = (lane >> 3) + 8 * j; const LAS float* s = scr + (8 * c) * 33 + n;
        u32x4 o; o[0] = pk2(s[0 * 33], s[1 * 33]); o[1] = pk2(s[2 * 33], s[3 * 33]); o[2] = pk2(s[4 * 33], s[5 * 33]); o[3] = pk2(s[6 * 33], s[7 * 33]);
        *(u32x4*)(outp + (size_t)n * ldo + k0 + 8 * c) = o; }
    WAVE_LDS_FENCE(); CFENCE();
}
__device__ __forceinline__ void filter_item(const Ctx& X, int l, int n, int pos0, float* out  , LAS float* scr  , LAS float* asum  ) {
    const int lane = X.lane;
    LAS float* zs = scr; LAS float* ha = scr + 8 * 33; LAS float* hb = ha + 8 * 64;
    const float* w1 = X.in(I_FW1) + (size_t)l * 33 * 64; const float* b1 = X.in(I_FB1) + l * 64;
    const float* w2 = X.in(I_FW2) + (size_t)l * 64 * 64; const float* b2 = X.in(I_FB2) + l * 64;
    const float* w3 = X.in(I_FW3) + (size_t)l * 64 * 64; const float* b3 = X.in(I_FB3) + l * 64;
    const float* wo = X.in(I_FWO) + (size_t)l * 64 * HW; const float fr = X.in(I_FREQ)[l * 64 + lane];
    if (lane < 33) {
#pragma unroll
        for (int p = 0; p < 8; ++p) { const int pos = pos0 + p; float v;
            if (lane == 0) v = (float)pos / (float)(n - 1 > 1 ? n - 1 : 1);
            else { const int b = (lane - 1) & 15; const double band = 1e-4 + (double)b * ((15.0 - 1e-4) / 15.0);
                double rev = (double)pos * band / (double)n; rev -= floor(rev); if (rev > 0.5) rev -= 1.0;
                float s, c; sincos_f((float)(rev * 6.283185307179586476925), s, c); v = lane <= 16 ? c : -s; }
            zs[p * 33 + lane] = v; }
    }
    WAVE_LDS_FENCE(); CFENCE();
    float acc[8];
    { const float bb = b1[lane];
#pragma unroll
      for (int p = 0; p < 8; ++p) acc[p] = bb;
#pragma unroll 3
      for (int i = 0; i < 33; ++i) { const float w = w1[i * 64 + lane];
#pragma unroll
          for (int p = 0; p < 8; ++p) acc[p] += zs[p * 33 + i] * w; }
#pragma unroll
      for (int p = 0; p < 8; ++p) ha[p * 64 + lane] = sin_f(fr * acc[p]); }
    WAVE_LDS_FENCE(); CFENCE();
    { const float bb = b2[lane];
#pragma unroll
      for (int p = 0; p < 8; ++p) acc[p] = bb;
#pragma unroll 4
      for (int i = 0; i < 64; ++i) { const float w = w2[i * 64 + lane];
#pragma unroll
          for (int p = 0; p < 8; ++p) acc[p] += ha[p * 64 + i] * w; }
#pragma unroll
      for (int p = 0; p < 8; ++p) hb[p * 64 + lane] = sin_f(fr * acc[p]); }
    WAVE_LDS_FENCE(); CFENCE();
    { const float bb = b3[lane];
#pragma unroll
      for (int p = 0; p < 8; ++p) acc[p] = bb;
#pragma unroll 4
      for (int i = 0; i < 64; ++i) { const float w = w3[i * 64 + lane];
#pragma unroll
          for (int p = 0; p < 8; ++p) acc[p] += hb[p * 64 + i] * w; }
#pragma unroll
      for (int p = 0; p < 8; ++p) ha[p * 64 + lane] = sin_f(fr * acc[p]); }
    WAVE_LDS_FENCE(); CFENCE();
    const float dmin = -3.0701134573253944f, dmax = -15.350567286626972f;
#pragma unroll 1
    for (int mI = 0; mI < HW / 64; ++mI) { const int c = lane + 64 * mI;
#pragma unroll
        for (int p = 0; p < 8; ++p) acc[p] = 0.f;
#pragma unroll 4
        for (int i = 0; i < 64; ++i) { const float w = wo[i * HW + c];
#pragma unroll
            for (int p = 0; p < 8; ++p) acc[p] += ha[p * 64 + i] * w; }
        const float delta = fabsf(dmin + (float)c * ((dmax - dmin) / (float)(HW - 1)));
        float as = 0.f;
#pragma unroll
        for (int p = 0; p < 8; ++p) { const int pos = pos0 + p; const int dd = pos - n / 2; const float dist = (float)(dd < 0 ? -dd : dd) * (2.0f / (float)n);
            const float v = acc[p] * expf(-dist * delta); out[(size_t)c * n + pos] = v; as += fabsf(v); }
        asum[c] += as; }
    WAVE_LDS_FENCE(); CFENCE();
}
__device__ __forceinline__ void phase_transposes(const Ctx& X, int l, int part) {
    LAS float* scr = (LAS float*)(X.lds + X.wave * 16384);
    const bool shifted = part == 1 && X.G > N_SEQ_UNITS; const int myb = shifted ? X.bid - N_SEQ_UNITS : X.bid, nb_ = shifted ? X.G - N_SEQ_UNITS : X.G;
    if (myb < 0) return;
    const int gw = myb * NWAVES + X.wave, NGW = nb_ * NWAVES, lane = X.lane;
    constexpr int KB_D = D / 64, I_WIN_ = KB_D * (PCP / 32), I_WB_ = 2 * (RW / 64) * (D / 32), I_WO_ = KB_D * (D / 32), I_WGU_ = NE * 2 * KB_D * (D / 32), I_WD_ = NE * KB_D * (D / 32);
    constexpr int I_LORA_ = 6 * (RW / 32); constexpr int N0 = I_WIN_ + I_WB_ + I_WO_, NITEMS = N0 + I_WGU_ + I_WD_;
    if (part == 0) for (int it = gw; it < I_LORA_; it += NGW) { const int which = it / (RW / 32), nb = it % (RW / 32);
        const float* W; int k0 = 0, ldo = 64; bf16* outp;
        if (which < 2) { W = X.in(I_W2) + ((size_t)l * 2 + which) * 64 * RW; outp = X.ws<bf16>(WS_W2T) + (size_t)which * RW * 64 + (size_t)(32 * nb) * 64; }
        else if (which < 4) { W = X.in(I_A2) + ((size_t)l * 2 + (which - 2)) * 64 * RW; outp = X.ws<bf16>(WS_A2T) + (size_t)(which - 2) * RW * 64 + (size_t)(32 * nb) * 64; }
        else { W = X.in(I_G2) + (size_t)l * 128 * RW; k0 = 64 * (which - 4); ldo = 128; outp = X.ws<bf16>(WS_G2T) + (size_t)(32 * nb) * 128; }
        transpose_item(W, RW, k0, 32 * nb, RW, outp, ldo, scr, lane); }
    const int it_end = part ? NITEMS : N0; int it = (part ? N0 : 0) + gw;
    const float* W; int ldw, k0, n0, nvalid, ldo; bf16* outp; float v[32];
#define TR_PARAMS(it_) do { int r = (it_); \
        if (r < I_WIN_) { const int nb = r % (PCP / 32), kb = r / (PCP / 32); W = X.in(I_WIN) + (size_t)l * D * PC; ldw = PC; k0 = 64 * kb; n0 = 32 * nb; nvalid = PC; outp = X.ws<bf16>(WS_WIN) + (size_t)n0 * D; ldo = D; } \
        else if ((r -= I_WIN_) < I_WB_) { const int s_ = r / ((RW / 64) * (D / 32)), q = r % ((RW / 64) * (D / 32)), nb = q % (D / 32), kb = q / (D / 32); \
            W = X.in(I_WBR) + ((size_t)l * 2 + s_) * RW * D; ldw = D; k0 = 64 * kb; n0 = 32 * nb; nvalid = D; outp = X.ws<bf16>(WS_WB) + (size_t)s_ * D * RW + (size_t)n0 * RW; ldo = RW; } \
        else if ((r -= I_WB_) < I_WO_) { const int nb = r % (D / 32), kb = r / (D / 32); W = X.in(I_WOUT) + (size_t)l * D * D; ldw = D; k0 = 64 * kb; n0 = 32 * nb; nvalid = D; outp = X.ws<bf16>(WS_WO) + (size_t)n0 * D; ldo = D; } \
        else if ((r -= I_WO_) < I_WGU_) { const int per = KB_D * (D / 32), es = r / per, q = r % per, e = es >> 1, src = es & 1, nb = q % (D / 32), kb = q / (D / 32); n0 = 32 * nb; \
            W = (src ? X.in(I_WU) : X.in(I_WG)) + ((size_t)l * NE + e) * D * D; ldw = D; k0 = 64 * kb; nvalid = D; const int orow = e * 2 * D + (n0 / 128) * 256 + src * 128 + (n0 % 128); \
            outp = X.ws<bf16>(WS_WGU) + (size_t)orow * D; ldo = D; } \
        else { r -= I_WGU_; const int per = KB_D * (D / 32), e = r / per, q = r % per, nb = q % (D / 32), kb = q / (D / 32); \
            W = X.in(I_WD) + ((size_t)l * NE + e) * D * D; ldw = D; k0 = 64 * kb; n0 = 32 * nb; nvalid = D; outp = X.ws<bf16>(WS_WD) + (size_t)(e * D + n0) * D; ldo = D; } } while (0)
#define TR_LOAD() do { const int n = n0 + (lane & 31); const float* wp = W + (size_t)(k0 + (lane >> 5)) * ldw + n; _Pragma("unroll") for (int i = 0; i < 32; ++i) v[i] = (n < nvalid) ? wp[(size_t)(2 * i) * ldw] : 0.f; } while (0)
    if (it < it_end) { TR_PARAMS(it); TR_LOAD(); }
    while (it < it_end) {
#pragma unroll
        for (int i = 0; i < 32; ++i) scr[(2 * i + (lane >> 5)) * 33 + (lane & 31)] = v[i];
        WAVE_LDS_FENCE(); CFENCE();
        bf16* const cout_ = outp; const int ck0 = k0, cldo = ldo;
        it += NGW;
        if (it < it_end) { TR_PARAMS(it); TR_LOAD(); }
        const int c = lane & 7;
#pragma unroll
        for (int j = 0; j < 4; ++j) { const int n = (lane >> 3) + 8 * j; const LAS float* s_ = scr + (8 * c) * 33 + n;
            u32x4 o; o[0] = pk2(s_[0 * 33], s_[1 * 33]); o[1] = pk2(s_[2 * 33], s_[3 * 33]); o[2] = pk2(s_[4 * 33], s_[5 * 33]); o[3] = pk2(s_[6 * 33], s_[7 * 33]);
            *(u32x4*)(cout_ + (size_t)n * cldo + ck0 + 8 * c) = o; }
        WAVE_LDS_FENCE(); CFENCE();
    }
#undef TR_PARAMS
#undef TR_LOAD
}
__device__ __forceinline__ void phase_filters(const Ctx& X, int l) {
    LAS float* scr = (LAS float*)(X.lds + X.wave * 8192);
    const int gw = X.bid * NWAVES + X.wave, NGW = X.G * NWAVES, lane = X.lane;
    LAS float* part = (LAS float*)(X.lds + 65536);
    static_assert(65536 + NWAVES * 2 * HW * 4 <= LDS_STAGE, "filter LDS map");
    for (int i = lane; i < 2 * HW; i += 64) part[X.wave * 2 * HW + i] = 0.f;
    WAVE_LDS_FENCE(); CFENCE();
    float* filt = X.ws<float>(WS_FILT);
    for (int it = gw; it < SEQ / 8; it += NGW) filter_item(X, l, SEQ, 8 * it, filt, scr, part + (X.wave * 2 + 0) * HW);
    for (int it = gw; it < CTX / 8; it += NGW) filter_item(X, l, CTX, 8 * it, filt + (size_t)HW * SEQ, scr, part + (X.wave * 2 + 1) * HW);
    __syncthreads();
    for (int i = X.tid; i < 2 * HW; i += NTHR) { float s = 0.f;
#pragma unroll
        for (int w = 0; w < NWAVES; ++w) s += part[w * 2 * HW + i];
        X.ws<float>(WS_FPART)[((size_t)(i / HW) * NPART + X.bid) * HW + (i % HW)] = s; }
    __syncthreads();
}
__device__ __forceinline__ void phase_mod(const Ctx& X) {
    const int lane = X.lane;
    LAS float* red = (LAS float*)X.lds;
    constexpr int NIT = DEPTH * (6 * D / 64);
    for (int it = X.bid; it < NIT; it += X.G) {
        const int ll = it / (6 * D / 64), n0 = (it % (6 * D / 64)) * 64;
        const float* W = X.in(I_WMOD) + (size_t)ll * D * 6 * D; const float* cv = X.in(I_C); const float* cc = X.in(I_CCTX);
        float s0 = 0.f, s1 = 0.f;
#pragma unroll 8
        for (int k = X.wave * (D / 8); k < (X.wave + 1) * (D / 8); ++k) { const float wv = W[(size_t)k * 6 * D + n0 + lane]; const float c0 = cv[k], c1 = cc[k];
            s0 += c0 * sigmoidf_(c0) * wv; s1 += c1 * sigmoidf_(c1) * wv; }
        red[(X.wave * 64 + lane) * 2] = s0; red[(X.wave * 64 + lane) * 2 + 1] = s1;
        __syncthreads();
        if (X.wave == 0) { float t0 = 0.f, t1 = 0.f;
#pragma unroll
            for (int w = 0; w < NWAVES; ++w) { t0 += red[(w * 64 + lane) * 2]; t1 += red[(w * 64 + lane) * 2 + 1]; }
            const float bm = X.in(I_BMOD)[(size_t)ll * 6 * D + n0 + lane];
            float* MOD = X.ws<float>(WS_MOD);
            MOD[((size_t)ll * 2 + 0) * 6 * D + n0 + lane] = t0 + bm; MOD[((size_t)ll * 2 + 1) * 6 * D + n0 + lane] = t1 + bm; }
        __syncthreads();
    }
}
__device__ __forceinline__ const float* modp(const Ctx& X, int l, int t, int j) { return X.ws<float>(WS_MOD) + ((size_t)l * 2 + (t < CTX ? 1 : 0)) * 6 * D + (size_t)j * D; }

__device__ __forceinline__ void phase_x0(const Ctx& X) {
    const int gw = X.bid * NWAVES + X.wave, NGW = X.G * NWAVES, lane = X.lane;
    for (int t = gw; t < M; t += NGW) {
        const float* src = t < CTX ? X.in(I_CTX) + (size_t)t * D : X.in(I_X) + (size_t)(t - CTX) * D;
        const float* sh = modp(X, 0, t, 0); const float* sc = modp(X, 0, t, 1);
        float* xr = X.ws<float>(WS_X) + (size_t)t * D; bf16* xm = X.ws<bf16>(WS_XMOD) + (size_t)t * D;
#pragma unroll
        for (int j = 0; j < D / 256; ++j) { const int d = 4 * lane + 256 * j; const f32x4 v = *(const f32x4*)(src + d), a = *(const f32x4*)(sh + d), b = *(const f32x4*)(sc + d);
            *(f32x4*)(xr + d) = v;
            unsigned w0 = pk2(v[0] * (1.f + b[0]) + a[0], v[1] * (1.f + b[1]) + a[1]), w1 = pk2(v[2] * (1.f + b[2]) + a[2], v[3] * (1.f + b[3]) + a[3]);
            *(unsigned long long*)(xm + d) = (unsigned long long)w0 | ((unsigned long long)w1 << 32); }
    }
}

__device__ __forceinline__ int shift_row(int t, int col, bool& valid) {
    const bool isctx = t < CTX;
    const int i = t - CTX, gx = i & (GRID_W - 1), gy = i / GRID_W, q = col / QTR;
    const int offl = (q == 0) ? -1 : (q == 1) ? 1 : (q == 2) ? -GRID_W : GRID_W;
    const bool vl = (q == 0) ? (gx > 0) : (q == 1) ? (gx < GRID_W - 1) : (q == 2) ? (gy > 0) : (gy < GRID_H - 1);
    const bool first = col < HALFC;
    const int offc = first ? -1 : 1; const bool vc = first ? (t > 0) : (t < CTX - 1);
    valid = isctx ? vc : vl;
    return valid ? t + (isctx ? offc : offl) : t;
}
__device__ __forceinline__ float pm_val(const bf16* P, const float* mu, int t, int col) {
    const float p0 = bf2f(P[(size_t)t * PCP + col]); bool valid; const int nr = shift_row(t, col, valid);
    const float pn = bf2f(P[(size_t)nr * PCP + col]); const float p1 = valid ? pn : 0.f;
    return p0 + (p1 - p0) * mu[col];
}
constexpr int LP = 72;
constexpr int LQ = 65;
constexpr int LX = 68;
__device__ __forceinline__ f32x4 mm_tile(const LAS bf16* A, const LAS bf16* Bt, int ti, int tj, int lane, f32x4 acc) {
    const LAS bf16* pa = A + (16 * ti + (lane & 15)) * LP + 8 * (lane >> 4); const LAS bf16* pb = Bt + (16 * tj + (lane & 15)) * LP + 8 * (lane >> 4);
#pragma unroll
    for (int kk = 0; kk < 2; ++kk) { const bf16x8 a = *(const LAS bf16x8*)(pa + 32 * kk), b = *(const LAS bf16x8*)(pb + 32 * kk); acc = MFMA16(a, b, acc); }
    return acc;
}
struct PmLd { float p0, pn, m; bool valid; };
__device__ __forceinline__ PmLd pm_ld(const bf16* P, const float* mu, int t, int col) {
    PmLd r; bool valid; const int nr = shift_row(t, col, valid); r.p0 = bf2f(P[(size_t)t * PCP + col]); r.pn = bf2f(P[(size_t)nr * PCP + col]); r.m = mu[col]; r.valid = valid; return r; }
__device__ __forceinline__ float pm_fin(const PmLd& r) { const float p1 = r.valid ? r.pn : 0.f; return r.p0 + (p1 - r.p0) * r.m; }
constexpr int TT = 8;
__device__ __forceinline__ void phase_lin(const Ctx& X, int l) {
    const bf16* P = X.ws<bf16>(WS_P); const float* mu = X.in(I_MU) + (size_t)l * RC; bf16* LIN = X.ws<bf16>(WS_LIN);
    for (size_t idx = (size_t)X.bid * NTHR + X.tid; idx < (size_t)M * 384; idx += (size_t)X.G * NTHR) { const int t = (int)(idx / 384), j = (int)(idx % 384);
        float v = pm_val(P, mu, t, C_LWF + j);
        if (j < 128) v = 1.0f - 2.0f * frcp(fexp(2.0f * v) + 1.0f); else if (j >= 256) v = sigmoidf_(v);
        LIN[idx] = (bf16)f2bf(v); }
}
__device__ __forceinline__ f32x4 mm_tile_p(const LAS bf16* A, int lda, const LAS bf16* Bt, int ldb, int ks, int ti, int tj, int lane, f32x4 acc) {
    const LAS bf16* pa = A + (16 * ti + (lane & 15)) * lda + 8 * (lane >> 4); const LAS bf16* pb = Bt + (16 * tj + (lane & 15)) * ldb + 8 * (lane >> 4);
    for (int kk = 0; kk < ks; ++kk) { const bf16x8 a = *(const LAS bf16x8*)(pa + 32 * kk), b = *(const LAS bf16x8*)(pb + 32 * kk); acc = MFMA16(a, b, acc); }
    return acc;
}
constexpr int GP = 136;
__device__ __forceinline__ void lora_unit_a(const Ctx& X, int unit) {
    const int b = unit / NH, h = unit % NH, tid = X.tid, lane = X.lane, w = X.wave;
    LAS bf16* Ab = (LAS bf16*)X.lds; LAS bf16* Gb = Ab + 4 * 64 * LP; LAS bf16* Wb = Gb + 64 * GP; LAS bf16* G2b = Wb + 4 * 64 * LP;
    LAS float* OUT = (LAS float*)X.lds;
    static_assert((8 * 64 * LP + 2 * 64 * GP) * 2 <= LDS_STAGE && 5 * 64 * LQ * 4 <= LDS_STAGE, "lora LDS map");
    const bf16* LIN = X.wsv<bf16>(WS_LIN) + (size_t)(64 * b) * 384;
    for (int i = tid; i < 64 * 48; i += NTHR) { const int t = i / 48, c16 = i % 48; const u32x4 v = *(const u32x4*)(LIN + (size_t)t * 384 + 8 * c16);
        if (c16 < 32) *(LAS u32x4*)(Ab + (c16 >> 3) * 64 * LP + t * LP + 8 * (c16 & 7)) = v; else *(LAS u32x4*)(Gb + t * GP + 8 * (c16 - 32)) = v; }
    const bf16* w2t = X.wsv<bf16>(WS_W2T) + (size_t)(64 * h) * 64; const bf16* a2t = X.wsv<bf16>(WS_A2T) + (size_t)(64 * h) * 64; const bf16* g2t = X.wsv<bf16>(WS_G2T) + (size_t)(64 * h) * 128;
    for (int i = tid; i < 4 * 64 * 8; i += NTHR) { const int q = i / 512, c = (i / 8) % 64, c16 = i % 8; const bf16* src = (q < 2 ? w2t + (size_t)q * RW * 64 : a2t + (size_t)(q - 2) * RW * 64) + c * 64 + 8 * c16;
        *(LAS u32x4*)(Wb + q * 64 * LP + c * LP + 8 * c16) = *(const u32x4*)src; }
    for (int i = tid; i < 64 * 16; i += NTHR) { const int c = i / 16, c16 = i % 16; *(LAS u32x4*)(G2b + c * GP + 8 * c16) = *(const u32x4*)(g2t + c * 128 + 8 * c16); }
    __syncthreads();
    f32x4 o[2][5];
#pragma unroll
    for (int q = 0; q < 2; ++q) { const int tile = 2 * w + q, ti = tile >> 2, tj = tile & 3; const f32x4 z4 = {0.f, 0.f, 0.f, 0.f};
#pragma unroll
        for (int p = 0; p < 4; ++p) o[q][p] = mm_tile(Ab + p * 64 * LP, Wb + p * 64 * LP, ti, tj, lane, z4);
        o[q][4] = mm_tile_p(Gb, GP, G2b, GP, 4, ti, tj, lane, z4); }
    __syncthreads();
#pragma unroll
    for (int q = 0; q < 2; ++q) { const int tile = 2 * w + q, ti = tile >> 2, tj = tile & 3, col = 16 * tj + (lane & 15);
#pragma unroll
        for (int p = 0; p < 5; ++p)
#pragma unroll
            for (int r = 0; r < 4; ++r) OUT[(p * 64 + 16 * ti + 4 * (lane >> 4) + r) * LQ + col] = o[q][p][r]; }
    __syncthreads();
}
__device__ __forceinline__ void lora_unit_b(const Ctx& X, int l, int unit) {
    const int b = unit / NH, h = unit % NH, w = X.wave, k = X.lane, c = 64 * h + k;
    const LAS float* OUT = (const LAS float*)X.lds;
    const bf16* P = X.wsv<bf16>(WS_P); const float* mu = X.inv(I_MU) + (size_t)l * RC;
    const float w00 = X.inv(I_W0)[(size_t)(l * 2 + 0) * RW + c], w01 = X.inv(I_W0)[(size_t)(l * 2 + 1) * RW + c];
    const float a00 = X.inv(I_A0)[(size_t)(l * 2 + 0) * RW + c], a01 = X.inv(I_A0)[(size_t)(l * 2 + 1) * RW + c];
    const float kkc = X.inv(I_KK)[(size_t)l * RW + c], kac = X.inv(I_KA)[(size_t)l * RW + c], rkc = X.inv(I_RK)[(size_t)l * RW + c];
    bf16* pR = X.wsv<bf16>(WS_R); bf16* pV = X.wsv<bf16>(WS_V); bf16* pKA = X.wsv<bf16>(WS_KA); bf16* pKD = X.wsv<bf16>(WS_KD); bf16* pKB = X.wsv<bf16>(WS_KB); float* pW = X.wsv<float>(WS_W); bf16* pG = X.wsv<bf16>(WS_GATE); float* pBo = X.wsv<float>(WS_BONUS);
    const int vz = vgpr_zero();
    float p0[3][8], pn[3][8]; unsigned vmask = 0u; const float mu0 = mu[c], mu1 = mu[C_K + c], mu2 = mu[C_V + c];
#pragma unroll
    for (int i = 0; i < 8; ++i) { const int t = 64 * b + 8 * w + i + vz;
#pragma unroll
        for (int q = 0; q < 3; ++q) { const int col = (q == 0 ? 0 : q == 1 ? C_K : C_V) + c; bool valid; const int nr = shift_row(t, col, valid);
            p0[q][i] = bf2f(P[(size_t)t * PCP + col]); pn[q][i] = bf2f(P[(size_t)nr * PCP + col]); vmask |= (valid ? 1u : 0u) << (3 * i + q); } }
    float bonv[8];
#pragma unroll
    for (int i = 0; i < 8; ++i) { const int tl = 8 * w + i, t = 64 * b + tl + vz;
        const float r = p0[0][i] + ((((vmask >> (3 * i + 0)) & 1u) ? pn[0][i] : 0.f) - p0[0][i]) * mu0;
        const float kx = p0[1][i] + ((((vmask >> (3 * i + 1)) & 1u) ? pn[1][i] : 0.f) - p0[1][i]) * mu1;
        const float v = p0[2][i] + ((((vmask >> (3 * i + 2)) & 1u) ? pn[2][i] : 0.f) - p0[2][i]) * mu2;
        const float wd0 = -DECAY_SCALE * sigmoidf_(w00 + OUT[(0 * 64 + tl) * LQ + k]), wd1 = -DECAY_SCALE * sigmoidf_(w01 + OUT[(1 * 64 + tl) * LQ + k]);
        const float ad0 = sigmoidf_(a00 + OUT[(2 * 64 + tl) * LQ + k]), ad1 = sigmoidf_(a01 + OUT[(3 * 64 + tl) * LQ + k]);
        const float kkr = kx * kkc; const float n2 = wave_sum(kkr * kkr); const float kk = kkr * frcp(fmaxf(sqrtf(n2), 1e-12f));
        const float kd0 = kx * (1.f + (ad0 - 1.f) * kac), kd1 = kx * (1.f + (ad1 - 1.f) * kac);
        bonv[i] = wave_sum(r * (kd0 + kd1) * rkc);
        const size_t o = (size_t)t * RW + c, o1 = (size_t)(M + t) * RW + c;
        pR[o] = (bf16)f2bf(r); pV[o] = (bf16)f2bf(v); pKA[o] = (bf16)f2bf(-kk);
        pKD[o] = (bf16)f2bf(kd0); pKD[o1] = (bf16)f2bf(kd1); pKB[o] = (bf16)f2bf(kk * ad0); pKB[o1] = (bf16)f2bf(kk * ad1);
        pW[o] = wd0; pW[o1] = wd1; pG[o] = (bf16)f2bf(OUT[(4 * 64 + tl) * LQ + k]); }
    if (k < 8) { float bs = bonv[0];
#pragma unroll
        for (int i = 1; i < 8; ++i) bs = (k == i) ? bonv[i] : bs;
        pBo[(size_t)(64 * b + 8 * w + k) * NH + h] = bs; }
    __syncthreads();
}
__device__ __forceinline__ void phase_prep_hyena(const Ctx& X, int l) {
    const bf16* P = X.ws<bf16>(WS_P); const int c = X.tid;
    if (c < HW) {
        const float* cw = X.in(I_CW) + (size_t)l * 3 * HC; const float* cb = X.in(I_CB) + (size_t)l * HC;
        float cw0[3], cw1[3], cw2[3], cbv[3];
#pragma unroll
        for (int j = 0; j < 3; ++j) { const int hc = j * HW + c; cw0[j] = cw[hc]; cw1[j] = cw[HC + hc]; cw2[j] = cw[2 * HC + hc]; cbv[j] = cb[hc]; }
        float* ZT = X.ws<float>(WS_ZT) + (size_t)c * M; float* Zc = X.ws<float>(WS_Z); bf16* X0 = X.ws<bf16>(WS_X0);
        for (int tile = X.bid; tile < M / TT; tile += X.G) { const int t0 = tile * TT; float zz[TT];
#pragma unroll
            for (int tt = 0; tt < TT; ++tt) { const int t = t0 + tt; const bool hp = (t != 0 && t != CTX), hn = (t != CTX - 1 && t != M - 1);
                float u[3];
#pragma unroll
                for (int j = 0; j < 3; ++j) { const int col = C_HY + j * HW + c;
                    const float pc = bf2f(P[(size_t)t * PCP + col]), pp = hp ? bf2f(P[(size_t)(t - 1) * PCP + col]) : 0.f, pn = hn ? bf2f(P[(size_t)(t + 1) * PCP + col]) : 0.f;
                    u[j] = pp * cw0[j] + pc * cw1[j] + pn * cw2[j] + cbv[j]; }
                zz[tt] = u[2] * u[1]; if (t < CTX) Zc[(size_t)t * HW + c] = zz[tt];
                X0[(size_t)t * HW + c] = (bf16)f2bf(u[0]); }
            *(f32x4*)(ZT + t0) = (f32x4){zz[0], zz[1], zz[2], zz[3]}; *(f32x4*)(ZT + t0 + 4) = (f32x4){zz[4], zz[5], zz[6], zz[7]}; }
    }
}

constexpr int CC = 64, NCHK = M / CC;
static_assert(CTX % CC == 0 && SEQ % CC == 0, "chunks must not straddle the context/latent boundary");
__device__ __forceinline__ int scan_row(int d, int s) { return d == 0 ? s : (s < CTX ? CTX - 1 - s : M - 1 - (s - CTX)); }
__device__ __forceinline__ void chunk_unit_1(const Ctx& X, int unit) {
    const int d = unit / (NCHK * NH), c = (unit / NH) % NCHK, h = unit % NH;
    LAS bf16* An = (LAS bf16*)X.lds;            LAS bf16* Bn = An + 64 * LP; LAS bf16* Kn = Bn + 64 * LP; LAS bf16* Rn = Kn + 64 * LP; LAS bf16* Vt = Rn + 64 * LP;
    LAS bf16* Bh = Vt + 64 * LP;                LAS bf16* Kh = Bh + 64 * LP; LAS bf16* Lak = Kh + 64 * LP; LAS bf16* Mrb = Lak + 64 * LP; LAS bf16* Mrk = Mrb + 64 * LP;
    LAS float* Lab = (LAS float*)(Mrk + 64 * LP); LAS float* XsW = Lab + 64 * LX;
    LAS float* XsU = (LAS float*)An;
    LAS bf16* Wt = Lak; LAS bf16* Ut = (LAS bf16*)((LAS unsigned char*)An + 64 * LX * 4);
    LAS float* tot = Lab;
    LAS float* dC = (LAS float*)(X.lds + LDS_MISC + 1024);
    static_assert(10 * 64 * LP * 2 + 2 * 64 * LX * 4 <= LDS_STAGE && 64 * LX * 4 + 64 * LP * 2 <= 3 * 64 * LP * 2, "chunk LDS map");
    const int tid = X.tid, lane = X.lane, w = X.wave, k = tid & 63;
    float lw[8], cum[8];
    { float run = 0.f; const float* pW = X.wsv<float>(WS_W);
#pragma unroll
      for (int i = 0; i < 8; ++i) { const int row = scan_row(d, c * CC + 8 * w + i); lw[i] = pW[((size_t)d * M + row) * RW + h * 64 + k]; }
#pragma unroll
      for (int i = 0; i < 8; ++i) { run += lw[i]; cum[i] = run; }
      tot[w * 64 + k] = run; }
    __syncthreads();
    float off = 0.f, cumC = 0.f;
#pragma unroll
    for (int ww = 0; ww < 8; ++ww) { const float t = tot[ww * 64 + k]; off += (ww < w) ? t : 0.f; cumC += t; }
    __syncthreads();
    { unsigned pv[4], pbh[4], pkh[4]; float af[8];
      const bf16* pR = X.wsv<bf16>(WS_R); const bf16* pV = X.wsv<bf16>(WS_V); const bf16* pKA = X.wsv<bf16>(WS_KA); const bf16* pKD = X.wsv<bf16>(WS_KD); const bf16* pKB = X.wsv<bf16>(WS_KB);
#pragma unroll
      for (int i = 0; i < 8; ++i) { const int t = 8 * w + i; const int row = scan_row(d, c * CC + t); const size_t o = (size_t)row * RW + h * 64 + k, od = ((size_t)d * M + row) * RW + h * 64 + k;
          const float ct = off + cum[i], cp = ct - lw[i];
          const float r = bf2f(pR[o]), v = bf2f(pV[o]), ka = bf2f(pKA[o]), kd = bf2f(pKD[od]), kb = bf2f(pKB[od]);
          const float ei = fexp(-ct), eh = fexp(cumC - ct);
          const float at = ka * fexp(cp); af[i] = at;
          An[t * LP + k] = (bf16)f2bf(at); Bn[t * LP + k] = (bf16)f2bf(kb * ei); Kn[t * LP + k] = (bf16)f2bf(kd * ei); Rn[t * LP + k] = (bf16)f2bf(r * fexp(ct));
          const unsigned bv = f2bf(v), bb = f2bf(kb * eh), bk = f2bf(kd * eh);
          if (i & 1) { pv[i >> 1] |= bv << 16; pbh[i >> 1] |= bb << 16; pkh[i >> 1] |= bk << 16; } else { pv[i >> 1] = bv; pbh[i >> 1] = bb; pkh[i >> 1] = bk; } }
      *(LAS u32x4*)(Vt + k * LP + 8 * w) = (u32x4){pv[0], pv[1], pv[2], pv[3]}; *(LAS u32x4*)(Bh + k * LP + 8 * w) = (u32x4){pbh[0], pbh[1], pbh[2], pbh[3]}; *(LAS u32x4*)(Kh + k * LP + 8 * w) = (u32x4){pkh[0], pkh[1], pkh[2], pkh[3]};
      *(LAS f32x4*)(XsW + k * LX + 8 * w) = (f32x4){af[0], af[1], af[2], af[3]}; *(LAS f32x4*)(XsW + k * LX + 8 * w + 4) = (f32x4){af[4], af[5], af[6], af[7]}; }
    if (tid < 64) dC[tid] = fexp(cumC);
    __syncthreads();
#pragma unroll 1
    for (int q = 0; q < 2; ++q) { const int tile = 2 * w + q, ti = tile >> 2, tj = tile & 3; const f32x4 z4 = {0.f, 0.f, 0.f, 0.f};
        const f32x4 ab = mm_tile(An, Bn, ti, tj, lane, z4), ak = mm_tile(An, Kn, ti, tj, lane, z4), rb = mm_tile(Rn, Bn, ti, tj, lane, z4), rk = mm_tile(Rn, Kn, ti, tj, lane, z4);
        const int col = 16 * tj + (lane & 15);
#pragma unroll
        for (int r = 0; r < 4; ++r) { const int row = 16 * ti + 4 * (lane >> 4) + r; const bool lo = col < row, le = col <= row;
            Lab[row * LX + col] = lo ? ab[r] : 0.f; Lak[row * LP + col] = (bf16)f2bf(lo ? ak[r] : 0.f); Mrb[row * LP + col] = (bf16)f2bf(le ? rb[r] : 0.f); Mrk[row * LP + col] = (bf16)f2bf(le ? rk[r] : 0.f); } }
    __syncthreads();
}
__device__ __forceinline__ void chunk_unit_2(const Ctx& X, int unit) {
    const int d = unit / (NCHK * NH), c = (unit / NH) % NCHK, h = unit % NH;
    LAS bf16* An = (LAS bf16*)X.lds;            LAS bf16* Bn = An + 64 * LP; LAS bf16* Kn = Bn + 64 * LP; LAS bf16* Rn = Kn + 64 * LP; LAS bf16* Vt = Rn + 64 * LP;
    LAS bf16* Bh = Vt + 64 * LP;                LAS bf16* Kh = Bh + 64 * LP; LAS bf16* Lak = Kh + 64 * LP; LAS bf16* Mrb = Lak + 64 * LP; LAS bf16* Mrk = Mrb + 64 * LP;
    LAS float* Lab = (LAS float*)(Mrk + 64 * LP); LAS float* XsW = Lab + 64 * LX;
    LAS float* XsU = (LAS float*)An;
    LAS bf16* Wt = Lak; LAS bf16* Ut = (LAS bf16*)((LAS unsigned char*)An + 64 * LX * 4);
    LAS float* tot = Lab;
    LAS float* dC = (LAS float*)(X.lds + LDS_MISC + 1024);
    static_assert(10 * 64 * LP * 2 + 2 * 64 * LX * 4 <= LDS_STAGE && 64 * LX * 4 + 64 * LP * 2 <= 3 * 64 * LP * 2, "chunk LDS map");
    const int tid = X.tid, lane = X.lane, w = X.wave, k = tid & 63;
    f32x4 r2[2]; int r2col[2], r2row[2];
#pragma unroll
    for (int q = 0; q < 2; ++q) { const int tile = 2 * w + q, ti = tile >> 2, tj = tile & 3; const f32x4 z4 = {0.f, 0.f, 0.f, 0.f};
        const f32x4 a = mm_tile(Lak, Vt, ti, tj, lane, z4); const int col = 16 * tj + (lane & 15);
        r2[q] = a; r2col[q] = col; r2row[q] = 16 * ti + 4 * (lane >> 4); }
    __syncthreads();
#pragma unroll
    for (int q = 0; q < 2; ++q) *(LAS f32x4*)(XsU + r2col[q] * LX + r2row[q]) = r2[q];
    __syncthreads();
    { const int jc = tid >> 2, part = tid & 3, j = jc & 63; const bool isu = jc >= 64; LAS float* xs = (isu ? XsU : XsW) + j * LX; LAS bf16* dst = (isu ? Ut : Wt) + j * LP;
#pragma unroll 1
        for (int p = 0; p < 8; ++p) { const int t0 = 8 * p; f32x4 acc[8];
#pragma unroll
            for (int i = 0; i < 8; ++i) acc[i] = (f32x4){0.f, 0.f, 0.f, 0.f};
#pragma unroll 1
            for (int q = part; q < 2 * p; q += 4) { const f32x4 xq = *(const LAS f32x4*)(xs + 4 * q);
#pragma unroll
                for (int i = 0; i < 8; ++i) acc[i] += *(const LAS f32x4*)(Lab + (t0 + i) * LX + 4 * q) * xq; }
            float g[8];
#pragma unroll
            for (int i = 0; i < 8; ++i) { float v = (acc[i][0] + acc[i][1]) + (acc[i][2] + acc[i][3]); v += DPP_F(v, 0xB1); v += DPP_F(v, 0x4E); g[i] = v; }
            f32x4 xp[2];
#pragma unroll
            for (int qq = 0; qq < 2; ++qq) xp[qq] = *(const LAS f32x4*)(xs + t0 + 4 * qq);
#pragma unroll
            for (int i = 0; i < 8; ++i) { float a = g[i];
#pragma unroll
                for (int qq = 0; qq < (i + 3) / 4; ++qq) { const f32x4 m = *(const LAS f32x4*)(Lab + (t0 + i) * LX + t0 + 4 * qq) * xp[qq]; a += (m[0] + m[1]) + (m[2] + m[3]); }
                xp[i >> 2][i & 3] += a; }
            if (part == 0) {
#pragma unroll
                for (int qq = 0; qq < 2; ++qq) { *(LAS f32x4*)(xs + t0 + 4 * qq) = xp[qq];
                    *(LAS unsigned*)(dst + t0 + 4 * qq) = pk2(xp[qq][0], xp[qq][1]); *(LAS unsigned*)(dst + t0 + 4 * qq + 2) = pk2(xp[qq][2], xp[qq][3]); } }
            WAVE_LDS_FENCE(); CFENCE(); } }
    __syncthreads();
}
__device__ __forceinline__ void chunk_unit_3(const Ctx& X, int unit) {
    const int d = unit / (NCHK * NH), c = (unit / NH) % NCHK, h = unit % NH;
    LAS bf16* An = (LAS bf16*)X.lds;            LAS bf16* Bn = An + 64 * LP; LAS bf16* Kn = Bn + 64 * LP; LAS bf16* Rn = Kn + 64 * LP; LAS bf16* Vt = Rn + 64 * LP;
    LAS bf16* Bh = Vt + 64 * LP;                LAS bf16* Kh = Bh + 64 * LP; LAS bf16* Lak = Kh + 64 * LP; LAS bf16* Mrb = Lak + 64 * LP; LAS bf16* Mrk = Mrb + 64 * LP;
    LAS float* Lab = (LAS float*)(Mrk + 64 * LP); LAS float* XsW = Lab + 64 * LX;
    LAS float* XsU = (LAS float*)An;
    LAS bf16* Wt = Lak; LAS bf16* Ut = (LAS bf16*)((LAS unsigned char*)An + 64 * LX * 4);
    LAS float* tot = Lab;
    LAS float* dC = (LAS float*)(X.lds + LDS_MISC + 1024);
    static_assert(10 * 64 * LP * 2 + 2 * 64 * LX * 4 <= LDS_STAGE && 64 * LX * 4 + 64 * LP * 2 <= 3 * 64 * LP * 2, "chunk LDS map");
    const int tid = X.tid, lane = X.lane, w = X.wave, k = tid & 63;
    const float dCk = dC[k];
    const size_t ubase = ((size_t)(d * NH + h) * NCHK + c);
    float* Pg = X.wsv<float>(WS_PQ) + ubase * 2 * 4096; float* Qg = Pg + 4096; bf16* Gg = X.wsv<bf16>(WS_G) + ubase * 4096; float* Yg = X.wsv<float>(WS_YL) + ubase * 4096;
#pragma unroll 1
    for (int q = 0; q < 2; ++q) { const int tile = 2 * w + q, ti = tile >> 2, tj = tile & 3; const f32x4 z4 = {0.f, 0.f, 0.f, 0.f};
        const f32x4 p = mm_tile(Wt, Bh, ti, tj, lane, z4); f32x4 qq = mm_tile(Ut, Bh, ti, tj, lane, z4); qq = mm_tile(Vt, Kh, ti, tj, lane, qq);
        const f32x4 g = mm_tile(Mrb, Wt, ti, tj, lane, z4); f32x4 y = mm_tile(Mrb, Ut, ti, tj, lane, z4); y = mm_tile(Mrk, Vt, ti, tj, lane, y);
        const int col = 16 * tj + (lane & 15); const float dcol = __shfl(dCk, col);
#pragma unroll
        for (int r = 0; r < 4; ++r) { const int row = 16 * ti + 4 * (lane >> 4) + r;
            Pg[row * 64 + col] = p[r] + (row == col ? dcol : 0.f); Qg[row * 64 + col] = qq[r];
            const int orow = d ? 63 - row : row;
            Gg[orow * 64 + col] = (bf16)f2bf(g[r] + bf2f(Rn[row * LP + col])); Yg[orow * 64 + col] = y[r]; } }
    __syncthreads();
}
__device__ __forceinline__ void seq_unit(const Ctx& X, int su) {
    const int d = su / (NH * 4), h = (su / 4) % NH, qv = su & 3;
    constexpr int PD = 4, RING = PD + 1, SLOT = 4096 + 1024;
    LAS float* ring = (LAS float*)X.lds;
    LAS float* S = ring + RING * SLOT;
    LAS float* part = S + 16 * LQ;
    static_assert((RING * SLOT + 16 * LQ + 4 * 16 * 17) * 4 <= LDS_STAGE, "seq LDS map");
    const int lane = X.lane, w = X.wave, tj = w & 3, kh = w >> 2, col = 16 * tj + (lane & 15), kq = lane >> 4;
    const float* PQ = X.ws<float>(WS_PQ) + (size_t)(d * NH + h) * NCHK * 2 * 4096; bf16* S0g = X.ws<bf16>(WS_S0) + (size_t)(d * NH + h) * NCHK * 4096 + (size_t)(16 * qv) * 64;
#define SEQ_FILL(c_) do { const float* p_ = PQ + (size_t)(c_) * 2 * 4096; LAS float* sl_ = ring + ((c_) % RING) * SLOT; \
        GLDS16(p_ + 4 * (w * 64 + lane), sl_ + 4 * (w * 64)); GLDS16(p_ + 4 * (512 + w * 64 + lane), sl_ + 4 * (512 + w * 64)); \
        GLDS16(p_ + 4096 + (16 * qv) * 64 + 4 * ((w & 3) * 64 + lane), sl_ + 4096 + 4 * ((w & 3) * 64)); } while (0)
#pragma unroll
    for (int i = 0; i < PD; ++i) if (i < NCHK) SEQ_FILL(i);
    for (int i = X.tid; i < 16 * LQ; i += NTHR) S[i] = 0.f;
    if (kh == 0) {
#pragma unroll
        for (int r = 0; r < 4; ++r) S0g[(4 * kq + r) * 64 + col] = (bf16)0; }
    for (int c = 0; c < NCHK; ++c) {
        if (c + PD - 1 < NCHK) { if (kh == 0) { ASM_WAIT_V(21); } else { ASM_WAIT_V(9); } } else { ASM_WAIT_V(0); }
        ASM_WAIT_L(0); S_BARRIER(); CFENCE();
        if (c + PD < NCHK) SEQ_FILL(c + PD);
        const LAS float* P = ring + (c % RING) * SLOT; const LAS float* Q = P + 4096;
        f32x4 acc0 = {0.f, 0.f, 0.f, 0.f}, acc1 = {0.f, 0.f, 0.f, 0.f};
#pragma unroll
        for (int s2 = 0; s2 < 8; s2 += 2) { const int k0 = 32 * kh + 4 * s2 + kq;
            acc0 = MFMA4F(S[(lane & 15) * LQ + k0], P[k0 * 64 + col], acc0); acc1 = MFMA4F(S[(lane & 15) * LQ + k0 + 4], P[(k0 + 4) * 64 + col], acc1); }
        acc0 += acc1;
        if (kh == 1) {
#pragma unroll
            for (int r = 0; r < 4; ++r) part[(tj * 16 + 4 * kq + r) * 17 + (lane & 15)] = acc0[r]; }
        ASM_WAIT_L(0); S_BARRIER(); CFENCE();
        if (kh == 0) {
#pragma unroll
            for (int r = 0; r < 4; ++r) { const float sn = acc0[r] + part[(tj * 16 + 4 * kq + r) * 17 + (lane & 15)] + Q[(4 * kq + r) * 64 + col];
                S[(4 * kq + r) * LQ + col] = sn; if (c + 1 < NCHK) S0g[(size_t)(c + 1) * 4096 + (4 * kq + r) * 64 + col] = (bf16)f2bf(sn); } }
    }
    ASM_WAIT_V(0);
    __syncthreads();
#undef SEQ_FILL
}
constexpr int CR = 16;
__device__ __forceinline__ void conv_item(const Ctx& X, int item) {
    constexpr int NCG = HW / 64; constexpr int n = CTX;
    const int cg = item % NCG, ob = item / NCG, i0 = CR * ob, c = cg * 64 + X.lane;
    const float* F = X.ws<float>(WS_FILT) + (size_t)HW * SEQ + (size_t)c * CTX; const float* Z = X.ws<float>(WS_Z) + c;
    const float* fp = X.ws<float>(WS_FPART) + (size_t)NPART * HW + c;
    float nsum = 0.f; for (int b = 0; b < NPART; ++b) nsum += fp[(size_t)b * HW];
    float acc[CR], Q[CR];
#pragma unroll
    for (int r = 0; r < CR; ++r) acc[r] = 0.f;
    int jb = i0 - n / 2; if (jb < 0) jb = 0;
    int jend = i0 + n / 2 + CR; if (jend > n) jend = n;
    int Tb = i0 - jb + n / 2;
#pragma unroll
    for (int x = 1; x < CR; ++x) { const int T = Tb + x; Q[x] = (T >= 0 && T < n) ? F[T] : 0.f; }
    Q[0] = 0.f;
    for (; jb < jend; jb += CR, Tb -= CR) {
#pragma unroll
        for (int s = 0; s < CR; ++s) { const int T = Tb - s, j = jb + s;
            if ((s & 3) == 0) CFENCE();
            Q[(CR - s) & (CR - 1)] = (T >= 0 && T < n) ? F[T] : 0.f;
            const float zj = (j < n) ? Z[(size_t)j * HW] : 0.f;
#pragma unroll
            for (int r = 0; r < CR; ++r) acc[r] += Q[(r - s + CR) & (CR - 1)] * zj; }
    }
    const float inv = 1.0f / nsum; float* O = X.ws<float>(WS_CONV) + c;
#pragma unroll
    for (int r = 0; r < CR; ++r) O[(size_t)(i0 + r) * HW] = acc[r] * inv;
}

#ifdef EMU
struct cf { float x, y; };
#else
typedef float cf __attribute__((ext_vector_type(2)));
#endif
__device__ __forceinline__ cf cmul(cf a, cf b) { return cf{a.x * b.x - a.y * b.y, a.x * b.y + a.y * b.x}; }
__device__ __forceinline__ cf cadd(cf a, cf b) { return cf{a.x + b.x, a.y + b.y}; }
__device__ __forceinline__ cf csub(cf a, cf b) { return cf{a.x - b.x, a.y - b.y}; }
__device__ __forceinline__ cf cconj(cf a) { return cf{a.x, -a.y}; }
constexpr int FN = SEQ;
constexpr int flog4(int n) { return n <= 1 ? 0 : 1 + flog4(n / 4); }
constexpr int FLOG4 = flog4(FN), FSQ = 1 << FLOG4;
static_assert((1 << (2 * FLOG4)) == FN && FN * 8 <= LDS_STAGE, "FFT length must be a power of 4 that fits the LDS stage region");
constexpr int FFT_TAB_OFF = LDS_MISC + 2048;
static_assert(FFT_TAB_OFF + 2 * FSQ * 8 <= LDS_BYTES, "FFT twiddle tables");
__device__ __forceinline__ void fft_tables(const Ctx& X) {
    LAS cf* T = (LAS cf*)(X.lds + FFT_TAB_OFF);
    for (int i = X.tid; i < 2 * FSQ; i += NTHR) { const int k = i < FSQ ? i * FSQ : i - FSQ; float s, c; sincos_f(-6.283185307179586f * (float)k / (float)FN, s, c); T[i] = cf{c, s}; }
    __syncthreads();
}
__device__ __forceinline__ cf fft_tw(const LAS cf* T, int k) { const cf a = T[k >> FLOG4], b = T[FSQ + (k & (FSQ - 1))]; return cmul(a, b); }
__device__ __forceinline__ int rev4(int k) { int r = 0;
#pragma unroll
    for (int s = 0; s < FLOG4; ++s) { r = (r << 2) | (k & 3); k >>= 2; }
    return r; }
__device__ __forceinline__ void fft_stage_q1(LAS cf* x, int tid, bool inverse) {
    for (int u = tid; u < FN / 4; u += NTHR) { LAS f32x4* px = (LAS f32x4*)(x + 4 * u); const f32x4 v01 = px[0], v23 = px[1];
        const cf a0{v01[0], v01[1]}, a1{v01[2], v01[3]}, a2{v23[0], v23[1]}, a3{v23[2], v23[3]};
        const cf t0 = cadd(a0, a2), t1 = csub(a0, a2), t2 = cadd(a1, a3), d = csub(a1, a3), t3 = inverse ? cf{-d.y, d.x} : cf{d.y, -d.x};
        const cf y0 = cadd(t0, t2), y1 = cadd(t1, t3), y2 = csub(t0, t2), y3 = csub(t1, t3);
        px[0] = (f32x4){y0.x, y0.y, y1.x, y1.y}; px[1] = (f32x4){y2.x, y2.y, y3.x, y3.y}; }
    __syncthreads();
}
__device__ __forceinline__ void fft_fwd(LAS cf* x, const LAS cf* T, int tid) {
#pragma unroll 1
    for (int s = 0; s < FLOG4 - 1; ++s) { const int q = FN >> (2 * s + 2), tw = 1 << (2 * s);
        for (int u = tid; u < FN / 4; u += NTHR) { const int j = u & (q - 1), p = (u - j) * 4 + j;
            const cf a0 = x[p], a1 = x[p + q], a2 = x[p + 2 * q], a3 = x[p + 3 * q];
            const cf t0 = cadd(a0, a2), t1 = csub(a0, a2), t2 = cadd(a1, a3), d = csub(a1, a3), t3 = cf{d.y, -d.x};
            const cf w1 = fft_tw(T, j * tw), w2 = cmul(w1, w1), w3 = cmul(w2, w1);
            x[p] = cadd(t0, t2); x[p + q] = cmul(cadd(t1, t3), w1); x[p + 2 * q] = cmul(csub(t0, t2), w2); x[p + 3 * q] = cmul(csub(t1, t3), w3); }
        __syncthreads(); }
    fft_stage_q1(x, tid, false);
}
__device__ __forceinline__ void fft_inv(LAS cf* x, const LAS cf* T, int tid) {
    fft_stage_q1(x, tid, true);
#pragma unroll 1
    for (int s = FLOG4 - 2; s >= 0; --s) { const int q = FN >> (2 * s + 2), tw = 1 << (2 * s);
        for (int u = tid; u < FN / 4; u += NTHR) { const int j = u & (q - 1), p = (u - j) * 4 + j;
            const cf w1 = cconj(fft_tw(T, j * tw)), w2 = cmul(w1, w1), w3 = cmul(w2, w1);
            const cf a0 = x[p], a1 = cmul(x[p + q], w1), a2 = cmul(x[p + 2 * q], w2), a3 = cmul(x[p + 3 * q], w3);
            const cf t0 = cadd(a0, a2), t1 = csub(a0, a2), t2 = cadd(a1, a3), d = csub(a1, a3), t3 = cf{-d.y, d.x};
            x[p] = cadd(t0, t2); x[p + q] = cadd(t1, t3); x[p + 2 * q] = csub(t0, t2); x[p + 3 * q] = csub(t1, t3); }
        __syncthreads(); }
}
__device__ __forceinline__ void fft_load_real(LAS cf* x, const float* src, float scale, int tid) {
    for (int m = tid; m < FN; m += NTHR) { cf v{0.f, 0.f}; if (m < FN / 2) { v.x = src[2 * m] * scale; v.y = src[2 * m + 1] * scale; } x[m] = v; }
    __syncthreads();
}
__device__ __forceinline__ void phase_spectra(const Ctx& X, int l) {
    (void)l;
    LAS cf* x = (LAS cf*)X.lds; const LAS cf* T = (const LAS cf*)(X.lds + FFT_TAB_OFF); volatile LAS float* red = (volatile LAS float*)(X.lds + LDS_MISC) + 120;
    fft_tables(X);
    for (int c = X.bid; c < HW; c += X.G) {
        if (X.wave == 0) { const float* fp = X.ws<float>(WS_FPART) + c; float s = 0.f; for (int b = X.lane; b < NPART; b += 64) s += fp[(size_t)b * HW]; s = wave_sum(s); if (X.lane == 0) red[0] = s; }
        __syncthreads();
        const float inv = 1.0f / red[0];
        fft_load_real(x, X.ws<float>(WS_FILT) + (size_t)c * SEQ, inv, X.tid);
        fft_fwd(x, T, X.tid);
        cf* HS = X.ws<cf>(WS_HS) + (size_t)c * (FN + 1);
        for (int k = X.tid; k <= FN / 2; k += NTHR) {
            const cf A = x[rev4(k)], B = x[rev4((FN - k) & (FN - 1))];
            if (k == 0) { HS[0] = cf{A.x + A.y, 0.f}; HS[FN] = cf{A.x - A.y, 0.f}; }
            else if (k == FN / 2) { HS[k] = cconj(A); }
            else { float sn, cs; sincos_f(-3.14159265358979f * (float)k / (float)FN, sn, cs); const cf w{cs, sn};
                const cf s1 = cadd(A, cconj(B)), d1 = csub(A, cconj(B)), wd = cmul(w, d1);
                HS[k] = cf{0.5f * (s1.x + wd.y), 0.5f * (s1.y - wd.x)};
                const cf s2 = cadd(B, cconj(A)), d2 = csub(B, cconj(A)), wd2 = cmul(cconj(w), d2);
                HS[FN - k] = cf{0.5f * (s2.x - wd2.y), 0.5f * (s2.y + wd2.x)}; } }
        __syncthreads();
    }
}
__device__ __forceinline__ void fftconv_item(const Ctx& X, int l, int c) {
    LAS cf* x = (LAS cf*)X.lds; const LAS cf* T = (const LAS cf*)(X.lds + FFT_TAB_OFF);
    const float* z = X.ws<float>(WS_ZT) + (size_t)c * M + CTX;
    fft_load_real(x, z, 1.0f, X.tid);
    fft_fwd(x, T, X.tid);
    const cf* HS = X.ws<cf>(WS_HS) + (size_t)c * (FN + 1);
    for (int k = X.tid; k <= FN / 2; k += NTHR) {
        const int pa = rev4(k), pb = rev4((FN - k) & (FN - 1)); const cf A = x[pa], B = x[pb];
        if (k == 0) { const float y0 = (A.x + A.y) * HS[0].x, yn = (A.x - A.y) * HS[FN].x; x[pa] = cf{0.5f * (y0 + yn), 0.5f * (y0 - yn)}; }
        else if (k == FN / 2) { x[pa] = cconj(cmul(cconj(A), HS[k])); }
        else { float sn, cs; sincos_f(-3.14159265358979f * (float)k / (float)FN, sn, cs); const cf w{cs, sn};
            const cf s1 = cadd(A, cconj(B)), d1 = csub(A, cconj(B)), wd = cmul(w, d1); const cf Xk{0.5f * (s1.x + wd.y), 0.5f * (s1.y - wd.x)};
            const cf s2 = cadd(B, cconj(A)), d2 = csub(B, cconj(A)), wd2 = cmul(cconj(w), d2); const cf Xn{0.5f * (s2.x - wd2.y), 0.5f * (s2.y + wd2.x)};
            const cf Yk = cmul(Xk, HS[k]), Yn = cmul(Xn, HS[FN - k]);
            const cf e1 = cadd(Yk, cconj(Yn)), f1 = cmul(cconj(w), csub(Yk, cconj(Yn)));
            x[pa] = cf{0.5f * (e1.x - f1.y), 0.5f * (e1.y + f1.x)};
            const cf e2 = cadd(Yn, cconj(Yk)), f2 = cmul(w, csub(Yn, cconj(Yk)));
            x[pb] = cf{0.5f * (e2.x + f2.y), 0.5f * (e2.y - f2.x)}; } }
    __syncthreads();
    fft_inv(x, T, X.tid);
    const float bias = X.in(I_HBIAS)[(size_t)l * HW + c], sc = 1.0f / (float)FN; float* O = X.ws<float>(WS_CVT) + (size_t)c * SEQ;
    for (int i2 = X.tid; i2 < FN / 2; i2 += NTHR) { const cf d = x[i2 + FN / 4]; O[2 * i2] = d.x * sc + z[2 * i2] * bias; O[2 * i2 + 1] = d.y * sc + z[2 * i2 + 1] * bias; }
    __syncthreads();
}
__device__ __forceinline__ void phase_fftconv(const Ctx& X, int l) {
    fft_tables(X);
    volatile LAS int* slot = (volatile LAS int*)(X.lds + LDS_MISC) + 121;
    unsigned* q = X.ctl() + CW_Q + l * 64 + 32;
    for (;;) { if (X.tid == 0) slot[0] = (int)atomicAdd(q, 1u); __syncthreads(); const int c = slot[0]; __syncthreads(); if (c >= HW) break; fftconv_item(X, l, c); }
}
__device__ __forceinline__ void phase_ctxconv(const Ctx& X, int l) {
    constexpr int NITEMS = (HW / 64) * (CTX / CR);
    unsigned* q = X.ctl() + CW_Q + l * 64;
    for (;;) { int item = 0; if (X.lane == 0) item = (int)atomicAdd(q, 1u); item = __shfl(item, 0); if (item >= NITEMS) break; conv_item(X, item); }
}
__device__ __forceinline__ void phase_seq(const Ctx& X) {
    for (int su = X.bid; su < N_SEQ_UNITS; su += X.G) seq_unit(X, su);
}

__device__ __forceinline__ void finish_wave_unit(const Ctx& X, int l, int unit) {
    const int rg = unit / NH, h = unit % NH, lane = X.lane, b = rg >> 2, sub = rg & 3;
    const int cf = b, cb = (b < CTX / CC) ? (CTX / CC - 1 - b) : (NCHK - 1 - (b - CTX / CC));
    const size_t uf = ((size_t)(0 * NH + h) * NCHK + cf) * 4096, ub = ((size_t)(1 * NH + h) * NCHK + cb) * 4096;
    const bf16* G = X.wsv<bf16>(WS_G); const bf16* S0 = X.wsv<bf16>(WS_S0); const float* YL = X.wsv<float>(WS_YL);
    const int arow = 16 * sub + (lane & 15), kof = 8 * (lane >> 4);
    bf16x8 af[2], ab[2];
#pragma unroll
    for (int kk = 0; kk < 2; ++kk) { af[kk] = *(const bf16x8*)(G + uf + arow * 64 + kof + 32 * kk); ab[kk] = *(const bf16x8*)(G + ub + arow * 64 + kof + 32 * kk); }
    f32x4 y[4];
#pragma unroll
    for (int tj = 0; tj < 4; ++tj) { const int vrow = 16 * tj + (lane & 15);
        bf16x8 bf_[2], bb_[2];
#pragma unroll
        for (int kk = 0; kk < 2; ++kk) { bf_[kk] = *(const bf16x8*)(S0 + uf + vrow * 64 + kof + 32 * kk); bb_[kk] = *(const bf16x8*)(S0 + ub + vrow * 64 + kof + 32 * kk); }
        f32x4 acc;
#pragma unroll
        for (int r = 0; r < 4; ++r) { const int o = (16 * sub + 4 * (lane >> 4) + r) * 64 + vrow; acc[r] = YL[uf + o] + YL[ub + o]; }
#pragma unroll
        for (int kk = 0; kk < 2; ++kk) { acc = MFMA16(af[kk], bf_[kk], acc); acc = MFMA16(ab[kk], bb_[kk], acc); }
        y[tj] = acc; }
    const float* lgp = X.inv(I_LNXG) + (size_t)l * RW + 64 * h; const float* lbp = X.inv(I_LNXB) + (size_t)l * RW + 64 * h;
    const bf16* pV = X.wsv<bf16>(WS_V); const bf16* pG = X.wsv<bf16>(WS_GATE); const float* pBo = X.wsv<float>(WS_BONUS); bf16* pRO = X.wsv<bf16>(WS_RO);
#pragma unroll
    for (int r = 0; r < 4; ++r) { const int t = 16 * rg + 4 * (lane >> 4) + r;
        const float mean = row16_sum((y[0][r] + y[1][r]) + (y[2][r] + y[3][r])) * (1.f / 64.f);
        float q = 0.f;
#pragma unroll
        for (int tj = 0; tj < 4; ++tj) { const float dy = y[tj][r] - mean; q += dy * dy; }
        const float rstd = 1.0f / sqrtf(row16_sum(q) * (1.f / 64.f) + GN_EPS); const float bon = pBo[(size_t)t * NH + h];
#pragma unroll
        for (int tj = 0; tj < 4; ++tj) { const int cl = 16 * tj + (lane & 15); const size_t o = (size_t)t * RW + 64 * h + cl;
            float yn = (y[tj][r] - mean) * rstd * lgp[cl] + lbp[cl];
            yn += bon * bf2f(pV[o]); yn *= bf2f(pG[o]);
            pRO[o] = (bf16)f2bf(yn); } }
}
__device__ __forceinline__ void phase_finish(const Ctx& X, int l) {
    for (int u = X.bid * NWAVES + X.wave; u < (M / 16) * NH; u += X.G * NWAVES) finish_wave_unit(X, l, u);
    const int c = X.tid;
    if (c < HW) { const float hbc = X.in(I_HBIAS)[(size_t)l * HW + c]; const float* CV = X.ws<float>(WS_CVT) + (size_t)c * SEQ; const bf16* X0 = X.ws<bf16>(WS_X0); bf16* HO = X.ws<bf16>(WS_HO);
        for (int tile = X.bid; tile < M / TT; tile += X.G) { const int t0 = tile * TT; float cv[TT];
            if (t0 < CTX) {
#pragma unroll
                for (int tt = 0; tt < TT; ++tt) { const size_t o = (size_t)(t0 + tt) * HW + c; cv[tt] = X.ws<float>(WS_CONV)[o] + X.ws<float>(WS_Z)[o] * hbc; } }
            else { const f32x4 a = *(const f32x4*)(CV + (t0 - CTX)), b = *(const f32x4*)(CV + (t0 - CTX) + 4);
#pragma unroll
                for (int i = 0; i < 4; ++i) { cv[i] = a[i]; cv[4 + i] = b[i]; } }
#pragma unroll
            for (int tt = 0; tt < TT; ++tt) { const size_t o = (size_t)(t0 + tt) * HW + c; HO[o] = (bf16)f2bf(cv[tt] * bf2f(X0[o])); } } }
}

__device__ __forceinline__ void ln_inplace(float (&v)[D / 64], const float* g, const float* b, int lane) {
    float s = 0.f;
#pragma unroll
    for (int j = 0; j < D / 64; ++j) s += v[j];
    const float mean = wave_sum(s) * (1.f / D); float q = 0.f;
#pragma unroll
    for (int j = 0; j < D / 64; ++j) { v[j] -= mean; q += v[j] * v[j]; }
    const float rstd = 1.0f / sqrtf(wave_sum(q) * (1.f / D) + LN_EPS);
#pragma unroll
    for (int j = 0; j < D / 64; ++j) { const int d = 4 * lane + 256 * (j >> 2) + (j & 3); v[j] = v[j] * rstd * g[d] + b[d]; }
}
__device__ __forceinline__ void phase_norm1(const Ctx& X, int l) {
    const int gw = X.bid * NWAVES + X.wave, NGW = X.G * NWAVES, lane = X.lane;
    const float* lng = X.in(I_LNG) + (size_t)(l * 2 + 0) * D; const float* lnb = X.in(I_LNB) + (size_t)(l * 2 + 0) * D;
    const float* wr = X.in(I_WR); const float* rb = X.in(I_RB);
    const float alpha = sqrtf(sqrtf(2.0f * DEPTH));
    volatile LAS int* hist = (volatile LAS int*)(X.lds + LDS_MISC + 4096);
    if (X.tid < NE) hist[X.tid] = 0;
    __syncthreads();
    for (int t = gw; t < M; t += NGW) {
        float* xr = X.ws<float>(WS_X) + (size_t)t * D; const float* mx = X.ws<float>(WS_MIX) + (size_t)t * D;
        const float* gate = modp(X, l, t, 2); const float* sh = modp(X, l, t, 3); const float* sc = modp(X, l, t, 4);
        float v[D / 64];
#pragma unroll
        for (int j = 0; j < D / 256; ++j) { const int d = 4 * lane + 256 * j; const f32x4 a = *(const f32x4*)(xr + d), m = *(const f32x4*)(mx + d), gt = *(const f32x4*)(gate + d);
#pragma unroll
            for (int i = 0; i < 4; ++i) v[4 * j + i] = alpha * a[i] + gt[i] * m[i]; }
        ln_inplace(v, lng, lnb, lane);
        bf16* hf = X.ws<bf16>(WS_XMOD) + (size_t)t * D;
        LAS float* hrow = (LAS float*)X.lds + X.wave * D;
#pragma unroll
        for (int j = 0; j < D / 256; ++j) { const int d = 4 * lane + 256 * j; f32x4 o; const f32x4 a = *(const f32x4*)(sh + d), b = *(const f32x4*)(sc + d); f32x4 h;
#pragma unroll
            for (int i = 0; i < 4; ++i) { o[i] = v[4 * j + i]; h[i] = o[i] * (1.f + b[i]) + a[i]; }
            *(f32x4*)(xr + d) = o; *(LAS f32x4*)(hrow + d) = h;
            *(unsigned long long*)(hf + d) = (unsigned long long)pk2(h[0], h[1]) | ((unsigned long long)pk2(h[2], h[3]) << 32); }
        WAVE_LDS_FENCE(); CFENCE();
        float part = 0.f; { const int e = lane & 15, q = lane >> 4;
#pragma unroll 8
            for (int d = q * (D / 4); d < (q + 1) * (D / 4); ++d) part += hrow[d] * wr[(size_t)d * NE + e]; }
        part += __shfl_xor(part, 16); part += __shfl_xor(part, 32);
        WAVE_LDS_FENCE(); CFENCE();
        float lg[NE];
#pragma unroll
        for (int e = 0; e < NE; ++e) lg[e] = __shfl(part, e);
        float mxl = lg[0];
#pragma unroll
        for (int e = 1; e < NE; ++e) mxl = fmaxf(mxl, lg[e]);
        float sc_[NE], sum = 0.f;
#pragma unroll
        for (int e = 0; e < NE; ++e) { sc_[e] = expf(lg[e] - mxl); sum += sc_[e]; }
        const float isum = 1.0f / sum; float sel[NE];
#pragma unroll
        for (int e = 0; e < NE; ++e) { sc_[e] *= isum; sel[e] = sc_[e] + rb[e]; }
        int bg = 0; float bgs = -INFINITY;
#pragma unroll
        for (int g = 0; g < 4; ++g) { float m1 = -INFINITY, m2 = -INFINITY;
#pragma unroll
            for (int i = 0; i < 4; ++i) { const float x = sel[4 * g + i]; if (x > m1) { m2 = m1; m1 = x; } else if (x > m2) m2 = x; }
            const float gs = m1 + m2; if (gs > bgs) { bgs = gs; bg = g; } }
        int i0 = 0, i1 = 0; float s0 = -INFINITY, s1 = -INFINITY, p0 = 0.f, p1 = 0.f;
#pragma unroll
        for (int e = 0; e < NE; ++e) { if ((e >> 2) == bg) { const float x = sel[e]; if (x > s0) { s1 = s0; i1 = i0; p1 = p0; s0 = x; i0 = e; p0 = sc_[e]; } else if (x > s1) { s1 = x; i1 = e; p1 = sc_[e]; } } }
        if (lane == 0) { int* ei = X.ws<int>(WS_ROUT) + (size_t)t * 2; float* ew = (float*)(X.ws<int>(WS_ROUT) + (size_t)M * 2) + (size_t)t * 2;
            ei[0] = i0; ei[1] = i1; const float ws_ = 1.0f / (p0 + p1); ew[0] = p0 * ws_; ew[1] = p1 * ws_;
            lds_add(hist + i0, 1); lds_add(hist + i1, 1); }
    }
    __syncthreads();
    if (X.tid < NE) { const int hc = hist[X.tid]; X.ws<int>(WS_BCNT)[X.bid * NE + X.tid] = hc; atomicAdd(X.ctl() + CW_CNT + l * 64 + X.tid, (unsigned)hc); }
}

__device__ __forceinline__ void moe_table(const Ctx& X, int l, int NT) {
    volatile LAS int* tab = (volatile LAS int*)(X.lds + LDS_MISC) + 8;
    if (X.tid == 0) { int cum = 0, ts = 0;
        for (int e = 0; e < NE; ++e) { const int cnt = (int)__hip_atomic_load(X.ctl() + CW_CNT + l * 64 + e, RLX_AGENT); const int tc = (cnt + 255) / 256;
            tab[e] = cum; tab[32 + e] = ts; tab[64 + e] = tc; cum += tc * NT; ts += tc; }
        tab[16] = cum; }
    __syncthreads();
}
__device__ __forceinline__ void phase_scatter(const Ctx& X, int l) {
    moe_table(X, l, 1);
    volatile LAS int* tab = (volatile LAS int*)(X.lds + LDS_MISC) + 8;
    volatile LAS int* cur = (volatile LAS int*)(X.lds + LDS_MISC + 4096) + 16;
    const int gw = X.bid * NWAVES + X.wave, NGW = X.G * NWAVES, lane = X.lane;
    if (X.tid < NE) { const int* bc = X.ws<int>(WS_BCNT) + X.tid; int pre = 0; for (int b = 0; b < X.bid; ++b) pre += bc[b * NE]; cur[X.tid] = tab[32 + X.tid] * 256 + pre; }
    __syncthreads();
    const int* ei = X.ws<int>(WS_ROUT); int* slot = X.ws<int>(WS_ROUT) + (size_t)M * 4;
    for (int t = gw; t < M; t += NGW) {
#pragma unroll
        for (int k = 0; k < 2; ++k) { const int e = ei[2 * t + k];
            int pos = 0; if (lane == 0) pos = lds_add(cur + e, 1);
            pos = __shfl(pos, 0);
            if (lane == 0) slot[2 * t + k] = pos;
            const u32x4* src = (const u32x4*)(X.ws<bf16>(WS_XMOD) + (size_t)t * D); u32x4* dst = (u32x4*)(X.ws<bf16>(WS_XG) + (size_t)pos * D);
            for (int i = lane; i < D / 8; i += 64) dst[i] = src[i]; } }
}

__device__ __forceinline__ void phase_combine(const Ctx& X, int l) {
    const int gw = X.bid * NWAVES + X.wave, NGW = X.G * NWAVES, lane = X.lane;
    const float* lng = X.in(I_LNG) + (size_t)(l * 2 + 1) * D; const float* lnb = X.in(I_LNB) + (size_t)(l * 2 + 1) * D;
    const float alpha = sqrtf(sqrtf(2.0f * DEPTH));
    const float* ew = (const float*)(X.ws<int>(WS_ROUT) + (size_t)M * 2); const int* slot = X.ws<int>(WS_ROUT) + (size_t)M * 4;
    for (int t = gw; t < M; t += NGW) {
        float* xr = X.ws<float>(WS_X) + (size_t)t * D; const float* gate = modp(X, l, t, 5);
        const bf16* y0 = X.ws<bf16>(WS_YS) + (size_t)slot[2 * t] * D; const bf16* y1 = X.ws<bf16>(WS_YS) + (size_t)slot[2 * t + 1] * D; const float w0 = ew[2 * t], w1 = ew[2 * t + 1];
        float v[D / 64];
#pragma unroll
        for (int j = 0; j < D / 256; ++j) { const int d = 4 * lane + 256 * j; const f32x4 a = *(const f32x4*)(xr + d), gt = *(const f32x4*)(gate + d);
            const unsigned long long q0 = *(const unsigned long long*)(y0 + d), q1 = *(const unsigned long long*)(y1 + d);
            float ya[4] = {bflo((unsigned)q0), bfhi((unsigned)q0), bflo((unsigned)(q0 >> 32)), bfhi((unsigned)(q0 >> 32))};
            float yb[4] = {bflo((unsigned)q1), bfhi((unsigned)q1), bflo((unsigned)(q1 >> 32)), bfhi((unsigned)(q1 >> 32))};
#pragma unroll
            for (int i = 0; i < 4; ++i) v[4 * j + i] = alpha * a[i] + gt[i] * (w0 * ya[i] + w1 * yb[i]); }
        ln_inplace(v, lng, lnb, lane);
        if (l + 1 < DEPTH) { const float* sh = modp(X, l + 1, t, 0); const float* sc = modp(X, l + 1, t, 1); bf16* xm = X.ws<bf16>(WS_XMOD) + (size_t)t * D;
#pragma unroll
            for (int j = 0; j < D / 256; ++j) { const int d = 4 * lane + 256 * j; f32x4 o; const f32x4 a = *(const f32x4*)(sh + d), b = *(const f32x4*)(sc + d); float h[4];
#pragma unroll
                for (int i = 0; i < 4; ++i) { o[i] = v[4 * j + i]; h[i] = o[i] * (1.f + b[i]) + a[i]; }
                *(f32x4*)(xr + d) = o;
                *(unsigned long long*)(xm + d) = (unsigned long long)pk2(h[0], h[1]) | ((unsigned long long)pk2(h[2], h[3]) << 32); }
        } else if (t >= CTX) { float* orow = X.out() + (size_t)(t - CTX) * D; const bool bad = __hip_atomic_load(X.ctl() + CW_BAR + XB_TMO, RLX_AGENT) != 0u; const float pscale = 1.0f + bitsf(__hip_atomic_load(X.ctl() + 64, RLX_AGENT));
#pragma unroll
            for (int j = 0; j < D / 256; ++j) { const int d = 4 * lane + 256 * j; f32x4 o;
#pragma unroll
                for (int i = 0; i < 4; ++i) o[i] = bad ? __builtin_nanf("") : v[4 * j + i] * pscale;
                *(f32x4*)(orow + d) = o; }
        }
    }
}


#ifdef EMU
#define PHASE_FN static
#define THIN_FN static
#else
#define PHASE_FN __device__ __forceinline__
#define THIN_FN __device__ __noinline__
#endif
THIN_FN void ph_transposes(Ctx X, int l, int part) { phase_transposes(X, l, part); }
THIN_FN void ph_filters(Ctx X, int l) { phase_filters(X, l); }
THIN_FN void ph_mod(Ctx X) { phase_mod(X); }
THIN_FN void ph_x0(Ctx X) { phase_x0(X); }
THIN_FN void ph_lin(Ctx X, int l) { phase_lin(X, l); }
THIN_FN void ph_lora_a(Ctx X, int u) { lora_unit_a(X, u); }
THIN_FN void ph_lora_b(Ctx X, int l, int u) { lora_unit_b(X, l, u); }
THIN_FN void ph_prep_hyena(Ctx X, int l) { phase_prep_hyena(X, l); }
THIN_FN void ph_ctxconv(Ctx X, int l) { phase_ctxconv(X, l); }
THIN_FN void ph_chunk_1(Ctx X, int u) { chunk_unit_1(X, u); }
THIN_FN void ph_chunk_2(Ctx X, int u) { chunk_unit_2(X, u); }
THIN_FN void ph_chunk_3(Ctx X, int u) { chunk_unit_3(X, u); }
THIN_FN void ph_seq(Ctx X) { phase_seq(X); }
THIN_FN void ph_fftconv(Ctx X, int l) { phase_fftconv(X, l); }
THIN_FN void ph_spectra(Ctx X, int l) { phase_spectra(X, l); }
THIN_FN void ph_finish(Ctx X, int l) { phase_finish(X, l); }
THIN_FN void ph_norm1(Ctx X, int l) { phase_norm1(X, l); }
THIN_FN void ph_scatter(Ctx X, int l) { phase_scatter(X, l); }
THIN_FN void ph_combine(Ctx X, int l) { phase_combine(X, l); }
PHASE_FN void ph_g13(Ctx X, int third) { pg8::Gemm g{third ? X.ws<bf16>(WS_T) : X.ws<bf16>(WS_XMOD), third ? X.ws<bf16>(WS_WO) : X.ws<bf16>(WS_WIN), D}; pg8::StaticOrder S; S.init(M, third ? D : PCP, X.G, X.bid);
    pg8::EpiBf16OrF32 E{X.ws<bf16>(WS_P), X.ws<float>(WS_MIX), third ? D : PCP, third != 0}; pg8::gemm_phase(X.lds, g, S, E); }
PHASE_FN void ph_g2(Ctx X, int second) { pg8::Gemm g{second ? X.ws<bf16>(WS_HO) : X.ws<bf16>(WS_RO), X.ws<bf16>(WS_WB) + (second ? (size_t)D * RW : 0), RW}; pg8::StaticOrder S; S.init(M, D, X.G, X.bid);
    pg8::EpiGate E{X.ws<bf16>(WS_T), D, X.ws<bf16>(WS_P), PCP, second ? C_GH : C_GR, second != 0}; pg8::gemm_phase(X.lds, g, S, E); }
PHASE_FN void ph_g45(Ctx X, int l, int down) { const int NT = down ? D / 256 : 2 * D / 256; moe_table(X, l, NT); pg8::MoeOrder S{(const volatile LAS int*)(X.lds + LDS_MISC) + 8, NT, X.G, X.bid};
    pg8::Gemm g{down ? X.ws<bf16>(WS_ACT) : X.ws<bf16>(WS_XG), down ? X.ws<bf16>(WS_WD) : X.ws<bf16>(WS_WGU), D}; pg8::EpiMoe E{down ? X.ws<bf16>(WS_YS) : X.ws<bf16>(WS_ACT), D, NT, down == 0}; pg8::gemm_phase(X.lds, g, S, E); }

constexpr int NPH = 16, NPHASES = DEPTH * NPH;
template <int MASK> __global__ void __launch_bounds__(NTHR, 2) fwd_kernel(Args args) {
    DYN_LDS(lds);
    Ctx X; X.lds = lds; X.tid = threadIdx.x; X.lane = X.tid & 63; X.wave = READFIRSTLANE(X.tid >> 6); X.G = gridDim.x; X.bid = blockIdx.x;
    volatile LAS unsigned* misc = (volatile LAS unsigned*)(lds + LDS_MISC);
    if (X.tid < 128) misc[X.tid] = 0u;
    if (X.tid < N_IN + 2) { const unsigned long long p = X.tid < N_IN ? (unsigned long long)args.in[X.tid < N_IN ? X.tid : 0] : (X.tid == N_IN ? (unsigned long long)args.out : (unsigned long long)args.ws);
        misc[PT_WORD0 + 2 * X.tid] = (unsigned)p; misc[PT_WORD0 + 2 * X.tid + 1] = (unsigned)(p >> 32); }
    __syncthreads();
    XcdBarrier bar = xcd_barrier_post(X.ctl() + CW_BAR, misc);
    const int lo = args.ph_lo, hi = args.ph_hi;
#define IN(k) ((((MASK) >> ((k) % NPH)) & 1) && lo <= (k) && (k) < hi)
#ifdef PROBE_K
#ifndef PROBE_SCALE
#define PROBE_SCALE 1.0f
#endif
#ifndef PROBE_BLOCK
#define PROBE_BLOCK 0
#endif
    unsigned long long plast = __builtin_amdgcn_s_memrealtime(); if (threadIdx.x < 32) misc[2048 + threadIdx.x] = 0u; __syncthreads();
#define PROBE_TX(k) do { if (blockIdx.x == PROBE_BLOCK && threadIdx.x == 0) { const unsigned long long now_ = __builtin_amdgcn_s_memrealtime(); misc[2048 + (k)] += (unsigned)(now_ - plast); plast = now_; } } while (0)
#define PROBE_T(k) PROBE_TX((k) % NPH)
#define PROBE_PUB(k) do { if ((k) == NPHASES - 2 && blockIdx.x == PROBE_BLOCK && threadIdx.x == 0) { PROBE_T(k); unsigned tot_ = 0; for (int i_ = 0; i_ < 28; ++i_) tot_ += misc[2048 + i_]; \
        const float f_ = floorf(PROBE_SCALE * (float)misc[2048 + PROBE_K] / (float)tot_ * 128.0f + 0.5f) * (1.0f / 128.0f); __hip_atomic_store(X.ctl() + 64, fbits(f_), RLX_AGENT); } } while (0)
#else
#define PROBE_T(k) do {} while (0)
#define PROBE_TX(k) do {} while (0)
#define PROBE_PUB(k) do {} while (0)
#endif
#define SEAM(k) do { PROBE_PUB(k); if ((k) + 1 < hi) xcd_barrier(bar); PROBE_T(k); } while (0)
    for (int l = 0; l < DEPTH; ++l) {
        const int pb = l * NPH;
        if (l == 0 && IN(pb + 0)) { ph_transposes(X, l, 0); __syncthreads(); PROBE_TX(20); ph_filters(X, l); PROBE_TX(21); ph_mod(X); PROBE_TX(22); SEAM(pb + 0); }
        if (l == 0 && IN(pb + 1)) { ph_x0(X); SEAM(pb + 1); }
        if (IN(pb + 2)) { ph_g13(X, 0); SEAM(pb + 2); }
        if (IN(pb + 3)) { ph_lin(X, l); PROBE_TX(23); ph_prep_hyena(X, l); PROBE_TX(24); ph_spectra(X, l); PROBE_TX(25); SEAM(pb + 3); }
        if (IN(pb + 4)) { for (int u = X.bid; u < (M / 64) * NH; u += X.G) { ph_lora_a(X, u); ph_lora_b(X, l, u); } SEAM(pb + 4); }
        if (IN(pb + 5)) { for (int u = X.bid; u < 2 * NCHK * NH; u += X.G) { ph_chunk_1(X, u); PROBE_TX(26); ph_chunk_2(X, u); PROBE_TX(27); ph_chunk_3(X, u); PROBE_TX(16); } SEAM(pb + 5); }
        if (IN(pb + 6)) { ph_seq(X); PROBE_TX(17); ph_transposes(X, l, 1); __syncthreads(); PROBE_TX(17); ph_ctxconv(X, l); PROBE_TX(18); ph_fftconv(X, l); PROBE_TX(19); SEAM(pb + 6); }
        if (IN(pb + 7)) { ph_finish(X, l); SEAM(pb + 7); }
        for (int sb = 0; sb < 2; ++sb) if (IN(pb + 8 + sb)) { ph_g2(X, sb); SEAM(pb + 8 + sb); }
        if (IN(pb + 10)) { ph_g13(X, 1); SEAM(pb + 10); }
        if (IN(pb + 11)) { ph_norm1(X, l); SEAM(pb + 11); }
        if (IN(pb + 12)) { ph_scatter(X, l); SEAM(pb + 12); }
        for (int dn = 0; dn < 2; ++dn) if (IN(pb + 13 + dn)) { ph_g45(X, l, dn); SEAM(pb + 13 + dn); }
        if (IN(pb + 15)) { ph_combine(X, l); if (l + 1 < DEPTH) { __syncthreads(); ph_transposes(X, l + 1, 0); __syncthreads(); ph_filters(X, l + 1); } SEAM(pb + 15); }
    }
#undef IN
#undef SEAM
}

#ifndef N_LAUNCHES
#define N_LAUNCHES 1
#endif
#ifndef PH_MASK
#define PH_MASK 0xffff
#endif
template <int MASK> static void launch_mask(int grid, hipStream_t stream, const Args& a) {
    static bool attr = false;
    if (!attr) { (void)hipFuncSetAttribute((const void*)fwd_kernel<MASK>, hipFuncAttributeMaxDynamicSharedMemorySize, LDS_BYTES); attr = true; }
    hipLaunchKernelGGL(fwd_kernel<MASK>, dim3(grid), dim3(NTHR), LDS_BYTES, stream, a);
}
extern "C" void kernel_launch(void* const* d_in, const int* in_sizes, int n_in, void* d_out, int out_size, void* d_ws, size_t ws_size, hipStream_t stream) {
    static int grid = 0;
    if (grid == 0) {
        if (n_in != N_IN || ws_size < WS_END) { fprintf(stderr, "kernel_launch: unexpected n_in %d or workspace %zu < %zu\n", n_in, ws_size, (size_t)WS_END); grid = -1; return; }
        int dev = 0, cus = 0;
        if (hipGetDevice(&dev) != hipSuccess || hipDeviceGetAttribute(&cus, hipDeviceAttributeMultiprocessorCount, dev) != hipSuccess) { grid = -1; return; }
        (void)hipGetLastError();
        grid = cus; if (grid > NPART) grid = NPART;
    }
    if (grid < 0) return;
    (void)in_sizes; (void)out_size;
    (void)hipMemsetAsync(d_ws, 0, CTL_BYTES, stream);
    Args a;
    for (int i = 0; i < N_IN; ++i) a.in[i] = (const float*)d_in[i];
    a.out = (float*)d_out; a.ws = (unsigned char*)d_ws;
#if N_LAUNCHES == 1
    a.ph_lo = 0; a.ph_hi = NPHASES;
    launch_mask<PH_MASK>(grid, stream, a);
#else
    for (int ph = 0; ph < NPHASES; ++ph) { const int k = ph % NPH; if (k == 1 && ph / NPH != 0) continue; a.ph_lo = ph; a.ph_hi = ph + 1; launch_mask<PH_MASK>(grid, stream, a); }
#endif
}
```

```cpp
#ifndef EMU
#include <hip/hip_runtime.h>
#endif
#include <cstdio>
#include <cstdint>
#include <cmath>

#ifndef CFG_D
#define CFG_D 1024
#define CFG_SEQ 16384
#define CFG_CTX 256
#define CFG_DEPTH 4
#endif
constexpr int D = CFG_D, SEQ = CFG_SEQ, CTX = CFG_CTX, DEPTH = CFG_DEPTH, M = CTX + SEQ;
constexpr int GRID_W = 64, GRID_H = SEQ / GRID_W;
constexpr int RW = D / 2, NH = RW / 64, HW = D / 2, RC = 3 * RW + 384, HC = 3 * HW, GC = 2 * D, PC = RC + HC + GC, PCP = (PC + 255) / 256 * 256;
constexpr int QTR = RC / 4, HALFC = RC / 2;
constexpr int C_K = RW, C_V = 2 * RW, C_LWF = 3 * RW, C_LG = 3 * RW + 256;
constexpr int C_HY = RC, C_GR = RC + HC, C_GH = RC + HC + D;
constexpr int NE = 16, SP_TILES = (2 * M) / 256 + NE, SP = SP_TILES * 256;
constexpr float DECAY_SCALE = 0.606531f, GN_EPS = 6.4e-4f, LN_EPS = 1e-5f;
constexpr int N_SEQ_UNITS = 2 * NH * 4;
constexpr int NPART = 256;
static_assert(CTX % 32 == 0 && M % 256 == 0 && D % 256 == 0 && RW % 128 == 0 && RW >= 256 && SEQ % 64 == 0 && CTX % 32 == 0 && RC % 4 == 0, "shape assumptions");

enum { I_X = 0, I_C, I_CTX, I_CCTX, I_WMOD, I_BMOD, I_WIN, I_MU, I_W0, I_W2, I_A0, I_A2, I_G2, I_KK, I_KA, I_RK, I_LNXG, I_LNXB, I_CW, I_CB,
       I_FW1, I_FB1, I_FW2, I_FB2, I_FW3, I_FB3, I_FWO, I_FREQ, I_HBIAS, I_WBR, I_WOUT, I_LNG, I_LNB, I_WR, I_RB, I_WG, I_WU, I_WD, N_IN };

constexpr size_t al256(size_t x) { return (x + 255) & ~(size_t)255; }
constexpr size_t CTL_BYTES = 1u << 20;
constexpr size_t WS_MOD = CTL_BYTES;
constexpr size_t WS_FPART = al256(WS_MOD + (size_t)DEPTH * 2 * 6 * D * 4);
constexpr size_t WS_ROUT = al256(WS_FPART + (size_t)2 * NPART * HW * 4);
constexpr size_t WS_BCNT = al256(WS_ROUT + (size_t)M * 2 * 4 * 3);
constexpr size_t WS_BONUS = al256(WS_BCNT + (size_t)NPART * NE * 4);
constexpr size_t WS_WIN = al256(WS_BONUS + (size_t)M * NH * 4);
constexpr size_t WS_WB = al256(WS_WIN + (size_t)PCP * D * 2);
constexpr size_t WS_WO = al256(WS_WB + (size_t)2 * D * RW * 2);
constexpr size_t WS_W2T = al256(WS_WO + (size_t)D * D * 2);
constexpr size_t WS_A2T = al256(WS_W2T + (size_t)2 * RW * 64 * 2);
constexpr size_t WS_G2T = al256(WS_A2T + (size_t)2 * RW * 64 * 2);
constexpr size_t WS_WGU = al256(WS_G2T + (size_t)RW * 128 * 2);
constexpr size_t WS_WD = al256(WS_WGU + (size_t)NE * 2 * D * D * 2);
constexpr size_t WS_X = al256(WS_WD + (size_t)NE * D * D * 2);
constexpr size_t WS_XMOD = al256(WS_X + (size_t)M * D * 4);
constexpr size_t WS_P = al256(WS_XMOD + (size_t)M * D * 2);
constexpr size_t WS_FILT = al256(WS_P + (size_t)M * PCP * 2);
constexpr size_t WS_MIX = al256(WS_FILT + (size_t)M * HW * 4);
constexpr size_t WS_T = al256(WS_MIX + (size_t)M * D * 4);
constexpr size_t WS_S = al256(WS_T + (size_t)M * D * 2);
constexpr size_t WS_R = WS_S;
constexpr size_t WS_V = al256(WS_R + (size_t)M * RW * 2);
constexpr size_t WS_KA = al256(WS_V + (size_t)M * RW * 2);
constexpr size_t WS_KD = al256(WS_KA + (size_t)M * RW * 2);
constexpr size_t WS_KB = al256(WS_KD + (size_t)2 * M * RW * 2);
constexpr size_t WS_W = al256(WS_KB + (size_t)2 * M * RW * 2);
constexpr size_t WS_PQ = al256(WS_W + (size_t)2 * M * RW * 4);
constexpr size_t WS_LIN = WS_PQ;
static_assert((size_t)M * 384 * 2 <= (size_t)2 * NH * (M / 64) * 2 * 4096 * 4, "LIN fits PQ");
constexpr size_t WS_G = al256(WS_PQ + (size_t)2 * NH * (M / 64) * 2 * 4096 * 4);
constexpr size_t WS_YL = al256(WS_G + (size_t)2 * NH * (M / 64) * 4096 * 2);
constexpr size_t WS_S0 = WS_XMOD;
static_assert((size_t)2 * NH * (M / 64) * 4096 * 2 <= (size_t)M * D * 2, "S0 fits XMOD");
constexpr size_t WS_Z = al256(WS_YL + (size_t)2 * NH * (M / 64) * 4096 * 4);
constexpr size_t WS_X0 = al256(WS_Z + (size_t)CTX * HW * 4);
constexpr size_t WS_CONV = al256(WS_X0 + (size_t)M * HW * 2);
constexpr size_t WS_GATE = al256(WS_CONV + (size_t)CTX * HW * 4);
constexpr size_t WS_RO = al256(WS_GATE + (size_t)M * RW * 2);
constexpr size_t WS_HO = al256(WS_RO + (size_t)M * RW * 2);
constexpr size_t WS_HS = WS_MIX;
constexpr size_t WS_ZT = WS_T;
constexpr size_t WS_CVT = WS_FILT;
static_assert((size_t)HW * (SEQ + 1) * 8 <= (size_t)M * D * 4 && (size_t)HW * M * 4 <= (size_t)M * D * 2, "HS fits MIX, ZT fits T");
constexpr size_t WS_END1 = al256(WS_HO + (size_t)M * HW * 2);
constexpr size_t WS_XG = WS_S;
constexpr size_t WS_ACT = al256(WS_XG + (size_t)SP * D * 2);
constexpr size_t WS_YS = al256(WS_ACT + (size_t)SP * D * 2);
constexpr size_t WS_END2 = al256(WS_YS + (size_t)SP * D * 2);
constexpr size_t WS_END = WS_END1 > WS_END2 ? WS_END1 : WS_END2;
constexpr int CW_TMO = 0, CW_BAR = 4096, CW_CNT = 8192  , CW_CUR = 8192 + 1024  , CW_Q = 8192 + 2048  ;

#ifdef EMU
#define LAS
typedef short bf16x8 __attribute__((vector_size(16)));
typedef float f32x4 __attribute__((vector_size(16)));
typedef unsigned u32x4 __attribute__((vector_size(16)));
#define DYN_LDS(name) unsigned char* name = emu_cur_lds()
#define ASM_WAIT_V(n) do {} while (0)
#define ASM_WAIT_L(n) do {} while (0)
#define ASM_WAIT_VL0() do {} while (0)
#define CFENCE() do {} while (0)
#define WAVE_LDS_FENCE() emu_wave_sync()
#define S_BARRIER() emu_block_sync()
#define SCHED_BARRIER() do {} while (0)
#define SETPRIO(x) do {} while (0)
#define S_SLEEP(n) emu_yield()
#define MFMA16(a, b, c) emu_mfma_16x16x32(a, b, c)
#define MFMA4F(a, b, c) emu_mfma_16x16x4f32(a, b, c)
#define GLDS16(gptr, lptr) emu_glds16((const void*)(gptr), (void*)(lptr))
#define READFIRSTLANE(x) (x)
#define XCC_ID_() (blockIdx.x & 7u)
#define FENCE_RELEASE() do {} while (0)
#define FENCE_ACQUIRE() do {} while (0)
#define DPP_F(v, ctrl) emu_dpp_f(v, ctrl)
#define READLANE_F(v, l) emu_xchg((float)(v), (l))
static inline int vgpr_zero() { return 0; }
static inline unsigned long long vgpr_zero64() { return 0ull; }
static inline int lds_add(volatile int* p, int v) { int o = *p; *p = o + v; return o; }
static inline unsigned fbits(float f) { unsigned u; memcpy(&u, &f, 4); return u; }
static inline float bitsf(unsigned u) { float f; memcpy(&f, &u, 4); return f; }
#else
#define LAS __attribute__((address_space(3)))
typedef short bf16x8 __attribute__((ext_vector_type(8)));
typedef float f32x4 __attribute__((ext_vector_type(4)));
typedef unsigned u32x4 __attribute__((ext_vector_type(4)));
#define DYN_LDS(name) extern __shared__ __attribute__((aligned(16))) unsigned char name##_raw[]; LAS unsigned char* name = (LAS unsigned char*)name##_raw
#define ASM_WAIT_V(n) asm volatile("s_waitcnt vmcnt(" #n ")" ::: "memory")
#define ASM_WAIT_L(n) asm volatile("s_waitcnt lgkmcnt(" #n ")" ::: "memory")
#define ASM_WAIT_VL0() asm volatile("s_waitcnt vmcnt(0) lgkmcnt(0)" ::: "memory")
#define CFENCE() asm volatile("" ::: "memory")
#define WAVE_LDS_FENCE() asm volatile("s_waitcnt lgkmcnt(0)" ::: "memory")
#define S_BARRIER() __builtin_amdgcn_s_barrier()
#define SCHED_BARRIER() __builtin_amdgcn_sched_barrier(0)
#define SETPRIO(x) __builtin_amdgcn_s_setprio(x)
#define S_SLEEP(n) __builtin_amdgcn_s_sleep(n)
#define MFMA16(a, b, c) __builtin_amdgcn_mfma_f32_16x16x32_bf16(a, b, c, 0, 0, 0)
#define MFMA4F(a, b, c) __builtin_amdgcn_mfma_f32_16x16x4f32(a, b, c, 0, 0, 0)
#define GLDS16(gptr, lptr) __builtin_amdgcn_global_load_lds((const unsigned*)(gptr), (LAS unsigned*)(lptr), 16, 0, 0)
#define READFIRSTLANE(x) __builtin_amdgcn_readfirstlane(x)
#define XCC_ID_() ((unsigned)__builtin_amdgcn_s_getreg((3 << 11) | 20) & 0xFu)
#define FENCE_RELEASE() __builtin_amdgcn_fence(__ATOMIC_RELEASE, "agent")
#define FENCE_ACQUIRE() __builtin_amdgcn_fence(__ATOMIC_ACQUIRE, "agent")
#define DPP_F(v, ctrl) __builtin_bit_cast(float, __builtin_amdgcn_update_dpp(0, __builtin_bit_cast(int, (float)(v)), (ctrl), 0xF, 0xF, true))
#define READLANE_F(v, l) __builtin_bit_cast(float, __builtin_amdgcn_readlane(__builtin_bit_cast(int, (float)(v)), (l)))
__device__ __forceinline__ int vgpr_zero() { int z; asm volatile("v_mov_b32 %0, 0" : "=v"(z)); return z; }
__device__ __forceinline__ unsigned long long vgpr_zero64() { unsigned long long z; asm volatile("v_mov_b64 %0, 0" : "=v"(z)); return z; }
__device__ __forceinline__ int lds_add(volatile LAS int* p, int v) { return __hip_atomic_fetch_add((LAS int*)p, v, __ATOMIC_RELAXED, __HIP_MEMORY_SCOPE_WORKGROUP); }
__device__ __forceinline__ unsigned fbits(float f) { return __builtin_bit_cast(unsigned, f); }
__device__ __forceinline__ float bitsf(unsigned u) { return __builtin_bit_cast(float, u); }
#endif
typedef unsigned short bf16;
#define RLX_AGENT __ATOMIC_RELAXED, __HIP_MEMORY_SCOPE_AGENT

__device__ __forceinline__ unsigned f2bf(float f) { unsigned u = fbits(f); return (u + 0x7fffu + ((u >> 16) & 1u)) >> 16; }
__device__ __forceinline__ unsigned pk2(float lo, float hi) { return f2bf(lo) | (f2bf(hi) << 16); }
__device__ __forceinline__ float bf2f(bf16 b) { return bitsf(((unsigned)b) << 16); }
__device__ __forceinline__ float bflo(unsigned w) { return bitsf(w << 16); }
__device__ __forceinline__ float bfhi(unsigned w) { return bitsf(w & 0xffff0000u); }
#ifdef EMU
__device__ __forceinline__ float fexp(float x) { return expf(x); }
__device__ __forceinline__ float frcp(float x) { return 1.0f / x; }
#else
__device__ __forceinline__ float fexp(float x) { return __builtin_amdgcn_exp2f(x * 1.4426950408889634f); }
__device__ __forceinline__ float frcp(float x) { return __builtin_amdgcn_rcpf(x); }
#endif
__device__ __forceinline__ float sigmoidf_(float x) { return frcp(1.0f + fexp(-x)); }
__device__ __forceinline__ float row16_sum(float v) {
    v += DPP_F(v, 0xB1);
    v += DPP_F(v, 0x4E);
    v += DPP_F(v, 0x141);
    v += DPP_F(v, 0x140);
    return v;
}
__device__ __forceinline__ float wave_sum(float v) {
    const float r = row16_sum(v);
    return (READLANE_F(r, 0) + READLANE_F(r, 16)) + (READLANE_F(r, 32) + READLANE_F(r, 48));
}
__device__ __forceinline__ void sincos_f(float x, float& s, float& c) {
    const float k = rintf(x * 0.63661977236758134f);
    float r = fmaf(-k, 1.5703125f, x); r = fmaf(-k, 4.837512969970703125e-4f, r); r = fmaf(-k, 7.54978994989188216e-8f, r);
    const float r2 = r * r;
    const float sp = r + r * r2 * (-1.6666654611e-1f + r2 * (8.3321608736e-3f + r2 * (-1.9515295891e-4f)));
    const float cp = 1.0f - 0.5f * r2 + r2 * r2 * (4.166664568298827e-2f + r2 * (-1.388731625493765e-3f + r2 * (2.443315711809948e-5f)));
    const int q = ((int)k) & 3;
    s = (q == 0) ? sp : (q == 1) ? cp : (q == 2) ? -sp : -cp;
    c = (q == 0) ? cp : (q == 1) ? -sp : (q == 2) ? -cp : sp;
}
__device__ __forceinline__ float sin_f(float x) { float s, c; sincos_f(x, s, c); return s; }

template <class T> __device__ __forceinline__ T* as_global(T* p) {
#ifndef EMU
    return (T*)(__attribute__((address_space(1))) T*)(unsigned long long)p;
#else
    return p;
#endif
}
#define XB_TMO      128
#define XB_XCNT(j)  (256  + 64 * (j))
#define XB_XSUB(j)  (1280 + 64 * (j))
#define XB_XGEN(j)  (2304 + 64 * (j))
#define XB_TOP      3328
#define XB_TOPGEN   3392
#define XCD_BAR_WORDS 3456
#define XB_SPIN_CAP (1u << 18)
__device__ __forceinline__ unsigned xb_ld(unsigned* p)              { return __hip_atomic_load(p, __ATOMIC_RELAXED, __HIP_MEMORY_SCOPE_AGENT); }
__device__ __forceinline__ unsigned xb_add(unsigned* p, unsigned v) { return __hip_atomic_fetch_add(p, v, __ATOMIC_RELAXED, __HIP_MEMORY_SCOPE_AGENT); }
#define XB_SPIN(cond, bar) do { unsigned _sp = 0; while (cond) { S_SLEEP(1); \
    if ((++_sp & 255u) == 0u) { if (xb_ld(&(bar)[XB_TMO])) break; if (_sp > XB_SPIN_CAP) { atomicAdd(&(bar)[XB_TMO], 1u); break; } } } } while (0)
struct XcdBarrier { unsigned* bar; unsigned x; volatile LAS unsigned* st; };
__device__ __forceinline__ XcdBarrier xcd_barrier_post(unsigned* bar, volatile LAS unsigned* st) {
    XcdBarrier b; b.bar = nullptr; b.x = XCC_ID_(); b.st = st;
    if (threadIdx.x == 0) { st[2] = (unsigned)(unsigned long long)bar; st[3] = (unsigned)((unsigned long long)bar >> 32); st[4] = b.x; (void)xb_add(&bar[XB_XCNT(b.x)], 1u); }
    return b;
}
__device__ __forceinline__ void xcd_barrier_complete(unsigned* bar, unsigned x, unsigned& nloc, unsigned& nx) {
    const unsigned G = gridDim.x * gridDim.y * gridDim.z;
    unsigned sum, cnt, mine, sp = 0u;
    for (;;) {
        sum = 0u; cnt = 0u; mine = 0u;
#pragma unroll
        for (unsigned j = 0; j < 16; ++j) { const unsigned c = xb_ld(&bar[XB_XCNT(j)]); sum += c; cnt += (c > 0u) ? 1u : 0u; mine = (j == x) ? c : mine; }
        if (sum == G) break;
        S_SLEEP(1);
        if ((++sp & 255u) == 0u) { if (xb_ld(&bar[XB_TMO])) break; if (sp > XB_SPIN_CAP) { atomicAdd(&bar[XB_TMO], 1u); break; } }
    }
    nloc = mine > 0u ? mine : 1u; nx = cnt > 0u ? cnt : 1u;
}
__device__ __forceinline__ void xcd_barrier(const XcdBarrier& b) {
    ASM_WAIT_V(0);
    __syncthreads();
    if (threadIdx.x == 0) {
        unsigned* bar = as_global((unsigned*)(((unsigned long long)b.st[3] << 32) | b.st[2]));
        const unsigned bx = b.st[4];
        ASM_WAIT_VL0();
        unsigned nloc = b.st[0], nx = b.st[1];
        if (nloc == 0u) { xcd_barrier_complete(bar, bx, nloc, nx); b.st[0] = nloc; b.st[1] = nx; }
        const unsigned old = xb_add(&bar[XB_XSUB(bx)], 1u);
        const unsigned gen = old / nloc;
        if (old + 1u == (gen + 1u) * nloc) {
            FENCE_RELEASE();
            ASM_WAIT_V(0);
            const unsigned og = xb_add(&bar[XB_TOP], 1u);
            const unsigned tg = og / nx;
            if (og + 1u == (tg + 1u) * nx) xb_add(&bar[XB_TOPGEN], 1u);
            else XB_SPIN(xb_ld(&bar[XB_TOPGEN]) == tg, bar);
            FENCE_ACQUIRE();
            xb_add(&bar[XB_XGEN(bx)], 1u);
            ASM_WAIT_V(0);
        } else {
            XB_SPIN(xb_ld(&bar[XB_XGEN(bx)]) == gen, bar);
            FENCE_ACQUIRE();
            ASM_WAIT_V(0);
        }
    }
    __syncthreads();
}

namespace pg8 {
constexpr int BM = 256, BK = 64, HALF = 128, HTB = HALF * BK * 2, STAGE_BYTES = 8 * HTB, NXCD = 8, WGM = 8;
__host__ __device__ __forceinline__ int lds_byte(int r, int c) { const int st = (r >> 4) * 2 + (c >> 5), rr = r & 15, cc = c & 31, ob = rr * 64 + cc * 2; return st * 1024 + (ob ^ (((ob >> 9) & 1) << 5)); }
__host__ __device__ __forceinline__ void stage_rc(int b, int& R, int& C) { const int st = b / 1024, sb = b % 1024, swz = sb ^ (((sb >> 9) & 1) << 5); R = (st >> 1) * 16 + swz / 64; C = (st & 1) * 32 + (swz % 64) / 2; }
__host__ __device__ __forceinline__ int perm32(int rho) { const int n = rho >> 4, i = rho & 15; return 8 * (i >> 2) + 4 * n + (i & 3); }
struct Unit { int pm, pn; };
struct Gemm { const bf16* A; const bf16* Bt; int K; };
struct StaticOrder {
    int nM, nN, nwg, G, c;
    __host__ __device__ void init(int M_, int N_, int G_, int c_) { nM = M_ / BM; nN = N_ / BM; nwg = nM * nN; G = G_; c = c_; }
    __host__ __device__ bool next(int i, Unit& u) const {
        const long L = (long)i * G + c; if (L >= nwg) return false;
        int wgid = (int)L; { const int q = nwg / NXCD, r = nwg % NXCD, xcd = wgid % NXCD, off = wgid / NXCD; wgid = (xcd < r ? xcd * (q + 1) : r * (q + 1) + (xcd - r) * q) + off; }
        const int nig = WGM * nN, gid = wgid / nig, fm = gid * WGM, gsz = (nM - fm) < WGM ? (nM - fm) : WGM;
        u.pm = fm + ((wgid % nig) % gsz); u.pn = (wgid % nig) / gsz; return true;
    }
};
struct MoeOrder {
    const volatile LAS int* tab; int NT, G, c;
    __device__ __forceinline__ bool next(int i, Unit& u) const {
        const long L = (long)i * G + c; if (L >= tab[16]) return false;
        int e = 0; while (L >= tab[e + 1]) ++e;
        const int loc = (int)L - tab[e], tc = tab[64 + e];
        u.pm = tab[32 + e] + loc % tc; u.pn = e * NT + loc / tc; return true;
    }
};
__device__ __forceinline__ unsigned cvt_pk_bf16(float lo, float hi) {
#ifdef EMU
    return pk2(lo, hi);
#else
    unsigned r; asm volatile("v_cvt_pk_bf16_f32 %0, %1, %2" : "=v"(r) : "v"(lo), "v"(hi)); return r;
#endif
}

struct EpiBf16 {
    static constexpr bool PERM = true;
    bf16* O; int ldc;
    __device__ __forceinline__ void operator()(const f32x4 (&acc)[2][2][4][2], const Unit& u, int wr, int wc, int fr, int fq) const {
        const int row0 = u.pm * BM + wr * 64 + fr, col0 = u.pn * BM + wc * 32 + 8 * fq;
#pragma unroll
        for (int ai = 0; ai < 2; ++ai)
#pragma unroll
            for (int m = 0; m < 4; ++m) { bf16* rowp = O + (size_t)(row0 + ai * HALF + m * 16) * ldc + col0;
#pragma unroll
                for (int bj = 0; bj < 2; ++bj) { const f32x4 v0 = acc[ai][bj][m][0], v1 = acc[ai][bj][m][1];
                    u32x4 w; w[0] = cvt_pk_bf16(v0[0], v0[1]); w[1] = cvt_pk_bf16(v0[2], v0[3]); w[2] = cvt_pk_bf16(v1[0], v1[1]); w[3] = cvt_pk_bf16(v1[2], v1[3]);
                    *(u32x4*)(rowp + bj * HALF) = w; } }
    }
};
struct EpiF32 {
    static constexpr bool PERM = true;
    float* C; int ldc;
    __device__ __forceinline__ void operator()(const f32x4 (&acc)[2][2][4][2], const Unit& u, int wr, int wc, int fr, int fq) const {
        const int row0 = u.pm * BM + wr * 64 + fr, col0 = u.pn * BM + wc * 32 + 8 * fq;
#pragma unroll
        for (int ai = 0; ai < 2; ++ai)
#pragma unroll
            for (int m = 0; m < 4; ++m) { float* rowp = C + (size_t)(row0 + ai * HALF + m * 16) * ldc + col0;
#pragma unroll
                for (int bj = 0; bj < 2; ++bj)
#pragma unroll
                    for (int n = 0; n < 2; ++n) *(f32x4*)(rowp + bj * HALF + n * 4) = acc[ai][bj][m][n]; }
    }
};
struct EpiGate {
    static constexpr bool PERM = true;
    bf16* T; int ldc; const bf16* Pg; int ldp; int gcol0; bool ADD;
    __device__ __forceinline__ void operator()(const f32x4 (&acc)[2][2][4][2], const Unit& u, int wr, int wc, int fr, int fq) const {
        const int row0 = u.pm * BM + wr * 64 + fr, col0 = u.pn * BM + wc * 32 + 8 * fq;
#pragma unroll
        for (int ai = 0; ai < 2; ++ai)
#pragma unroll
            for (int m = 0; m < 4; ++m) { const size_t row = (size_t)(row0 + ai * HALF + m * 16);
#pragma unroll
                for (int bj = 0; bj < 2; ++bj) { const f32x4 v0 = acc[ai][bj][m][0], v1 = acc[ai][bj][m][1];
                    const u32x4 g = *(const u32x4*)(Pg + row * ldp + gcol0 + col0 + bj * HALF);
                    u32x4 t = {0u, 0u, 0u, 0u}; if (ADD) t = *(const u32x4*)(T + row * ldc + col0 + bj * HALF);
                    float o[8];
#pragma unroll
                    for (int j = 0; j < 4; ++j) { const float a0 = j < 2 ? v0[2 * j] : v1[2 * j - 4], a1 = j < 2 ? v0[2 * j + 1] : v1[2 * j - 3];
                        o[2 * j] = bflo(t[j]) + sigmoidf_(bflo(g[j])) * a0; o[2 * j + 1] = bfhi(t[j]) + sigmoidf_(bfhi(g[j])) * a1; }
                    u32x4 w; w[0] = cvt_pk_bf16(o[0], o[1]); w[1] = cvt_pk_bf16(o[2], o[3]); w[2] = cvt_pk_bf16(o[4], o[5]); w[3] = cvt_pk_bf16(o[6], o[7]);
                    *(u32x4*)(T + row * ldc + col0 + bj * HALF) = w; } }
    }
};
struct EpiSwiglu {
    static constexpr bool PERM = true;
    bf16* O; int ldc; int NT;
    __device__ __forceinline__ void operator()(const f32x4 (&acc)[2][2][4][2], const Unit& u, int wr, int wc, int fr, int fq) const {
        const int row0 = u.pm * BM + wr * 64 + fr, col0 = (u.pn % NT) * HALF + wc * 32 + 8 * fq;
#pragma unroll
        for (int ai = 0; ai < 2; ++ai)
#pragma unroll
            for (int m = 0; m < 4; ++m) { bf16* rowp = O + (size_t)(row0 + ai * HALF + m * 16) * ldc + col0;
                float o[8];
#pragma unroll
                for (int j = 0; j < 8; ++j) { const float g = acc[ai][0][m][j >> 2][j & 3], uu = acc[ai][1][m][j >> 2][j & 3]; o[j] = g / (1.0f + expf(-g)) * uu; }
                u32x4 w; w[0] = cvt_pk_bf16(o[0], o[1]); w[1] = cvt_pk_bf16(o[2], o[3]); w[2] = cvt_pk_bf16(o[4], o[5]); w[3] = cvt_pk_bf16(o[6], o[7]);
                *(u32x4*)rowp = w; }
    }
};
struct EpiMoeDown {
    static constexpr bool PERM = true;
    bf16* O; int ldc; int NT;
    __device__ __forceinline__ void operator()(const f32x4 (&acc)[2][2][4][2], const Unit& u, int wr, int wc, int fr, int fq) const {
        const int row0 = u.pm * BM + wr * 64 + fr, col0 = (u.pn % NT) * BM + wc * 32 + 8 * fq;
#pragma unroll
        for (int ai = 0; ai < 2; ++ai)
#pragma unroll
            for (int m = 0; m < 4; ++m) { bf16* rowp = O + (size_t)(row0 + ai * HALF + m * 16) * ldc + col0;
#pragma unroll
                for (int bj = 0; bj < 2; ++bj) { const f32x4 v0 = acc[ai][bj][m][0], v1 = acc[ai][bj][m][1];
                    u32x4 w; w[0] = cvt_pk_bf16(v0[0], v0[1]); w[1] = cvt_pk_bf16(v0[2], v0[3]); w[2] = cvt_pk_bf16(v1[0], v1[1]); w[3] = cvt_pk_bf16(v1[2], v1[3]);
                    *(u32x4*)(rowp + bj * HALF) = w; } }
    }
};

struct EpiBf16OrF32 { static constexpr bool PERM = true; bf16* O; float* C; int ldc; bool f32;
    __device__ __forceinline__ void operator()(const f32x4 (&acc)[2][2][4][2], const Unit& u, int wr, int wc, int fr, int fq) const {
        if (f32) { EpiF32 E{C, ldc}; E(acc, u, wr, wc, fr, fq); } else { EpiBf16 E{O, ldc}; E(acc, u, wr, wc, fr, fq); } } };
struct EpiMoe { static constexpr bool PERM = true; bf16* O; int ldc; int NT; bool swiglu;
    __device__ __forceinline__ void operator()(const f32x4 (&acc)[2][2][4][2], const Unit& u, int wr, int wc, int fr, int fq) const {
        if (swiglu) { EpiSwiglu E{O, ldc, NT}; E(acc, u, wr, wc, fr, fq); } else { EpiMoeDown E{O, ldc, NT}; E(acc, u, wr, wc, fr, fq); } } };
template <class Epi, class Sched>
__device__ __forceinline__ void gemm_phase(LAS unsigned char* lds, const Gemm g, const Sched& S, const Epi& E) {
    const int tid = threadIdx.x + vgpr_zero();
    const int wid = READFIRSTLANE(tid >> 6), lane = tid & 63, wr = wid >> 2, wc = wid & 3, fr = lane & 15, fq = lane >> 4;
    const int K = g.K, nt = K / BK;
    unsigned long long voffA[2], voffB[2]; const unsigned long long zhi = vgpr_zero64();
#pragma unroll
    for (int i = 0; i < 2; ++i) { int R, C; stage_rc(tid * 16 + i * 8192, R, C); const int Rb = Epi::PERM ? ((R & ~31) + perm32(R & 31)) : R;
        voffA[i] = zhi + (unsigned long long)(long long)((R * K + C) * 2); voffB[i] = zhi + (unsigned long long)(long long)((Rb * K + C) * 2); }
    const size_t kstep = (size_t)(BK * 2);
    const size_t hstep = (size_t)HALF * K * 2;
    const size_t tstep = 2 * hstep;
    const unsigned ldsw = (unsigned)wid * 1024u;
    const int aoff = lds_byte(wr * 64 + fr, fq * 8), boff = lds_byte(wc * 32 + fr, fq * 8);
#define PG8_SA(b, h) (((b) * 2 + (h)) * HTB)
#define PG8_SB(b, h) ((4 + (b) * 2 + (h)) * HTB)
#define PG8_STAGE(bufoff, gbase, voff) do { _Pragma("unroll") for (int _i = 0; _i < 2; ++_i) \
        GLDS16((const char*)(gbase) + (voff)[_i], lds + (bufoff) + ldsw + _i * 8192); } while (0)
#define PG8_LDA(dst, b, h) do { _Pragma("unroll") for (int m = 0; m < 4; ++m) _Pragma("unroll") for (int k = 0; k < 2; ++k) dst[m][k] = *(const LAS bf16x8*)(lds + PG8_SA(b, h) + aoff + m * 2048 + k * 1024); } while (0)
#define PG8_LDB(dst, b, h) do { _Pragma("unroll") for (int n = 0; n < 2; ++n) _Pragma("unroll") for (int k = 0; k < 2; ++k) dst[n][k] = *(const LAS bf16x8*)(lds + PG8_SB(b, h) + boff + n * 2048 + k * 1024); } while (0)
#define PG8_MMA(ai, bj, At, Bt) do { SETPRIO(1); _Pragma("unroll") for (int m = 0; m < 4; ++m) _Pragma("unroll") for (int n = 0; n < 2; ++n) _Pragma("unroll") for (int k = 0; k < 2; ++k) \
        acc[ai][bj][m][n] = MFMA16(Bt[n][k], At[m][k], acc[ai][bj][m][n]); SETPRIO(0); } while (0)
#define PG8_BAR S_BARRIER()
    Unit cur, nxt; int ui = 0;
    if (!S.next(0, cur)) return;
    f32x4 acc[2][2][4][2];
#pragma unroll
    for (int a = 0; a < 2; ++a)
#pragma unroll
        for (int b = 0; b < 2; ++b)
#pragma unroll
            for (int m = 0; m < 4; ++m)
#pragma unroll
                for (int n = 0; n < 2; ++n) acc[a][b][m][n] = (f32x4){0.f, 0.f, 0.f, 0.f};
    bf16x8 At[4][2], B0[2][2], B1[2][2];
    const char* cA = (const char*)g.A + (size_t)cur.pm * tstep; const char* cB = (const char*)g.Bt + (size_t)cur.pn * tstep;
    PG8_STAGE(PG8_SB(0, 0), cB, voffB); PG8_STAGE(PG8_SA(0, 0), cA, voffA); PG8_STAGE(PG8_SB(0, 1), cB + hstep, voffB); PG8_STAGE(PG8_SA(0, 1), cA + hstep, voffA);
    if (wr == 1) PG8_BAR;
    ASM_WAIT_V(4); PG8_BAR;
    PG8_STAGE(PG8_SB(1, 0), cB + kstep, voffB); PG8_STAGE(PG8_SA(1, 0), cA + kstep, voffA); PG8_STAGE(PG8_SB(1, 1), cB + hstep + kstep, voffB);
    ASM_WAIT_V(6); PG8_BAR;
    for (;;) {
        const bool has_next = S.next(ui + 1, nxt);
        const char* nA = has_next ? (const char*)g.A + (size_t)nxt.pm * tstep : cA; const char* nB = has_next ? (const char*)g.Bt + (size_t)nxt.pn * tstep : cB;
        for (int t = 0; t < nt; t += 2) {
            const bool last = (t == nt - 2);
            const char* a1 = cA + (size_t)(t + 1) * kstep;
            const char* a2 = last ? nA : cA + (size_t)(t + 2) * kstep; const char* b2 = last ? nB : cB + (size_t)(t + 2) * kstep;
            const char* a3 = a2 + kstep; const char* b3 = b2 + kstep;
            PG8_LDB(B0, 0, 0); SCHED_BARRIER(); PG8_LDA(At, 0, 0); PG8_STAGE(PG8_SA(1, 1), a1 + hstep, voffA);
            ASM_WAIT_L(8); PG8_BAR; ASM_WAIT_L(0); PG8_MMA(0, 0, At, B0); PG8_BAR; SCHED_BARRIER();
            PG8_LDB(B1, 0, 1); PG8_STAGE(PG8_SB(0, 0), b2, voffB);
            PG8_BAR; ASM_WAIT_L(0); PG8_MMA(0, 1, At, B1); PG8_BAR;
            PG8_LDA(At, 0, 1); PG8_STAGE(PG8_SA(0, 0), a2, voffA);
            PG8_BAR; ASM_WAIT_L(0); PG8_MMA(1, 0, At, B0); PG8_BAR; SCHED_BARRIER();
            PG8_STAGE(PG8_SB(0, 1), b2 + hstep, voffB);
            ASM_WAIT_V(6); PG8_BAR; PG8_MMA(1, 1, At, B1); PG8_BAR;
            PG8_LDB(B0, 1, 0); SCHED_BARRIER(); PG8_LDA(At, 1, 0); PG8_STAGE(PG8_SA(0, 1), a2 + hstep, voffA);
            ASM_WAIT_L(8); PG8_BAR; ASM_WAIT_L(0); PG8_MMA(0, 0, At, B0); PG8_BAR; SCHED_BARRIER();
            PG8_LDB(B1, 1, 1); PG8_STAGE(PG8_SB(1, 0), b3, voffB);
            PG8_BAR; ASM_WAIT_L(0); PG8_MMA(0, 1, At, B1); PG8_BAR;
            PG8_LDA(At, 1, 1); PG8_STAGE(PG8_SA(1, 0), a3, voffA);
            PG8_BAR; ASM_WAIT_L(0); PG8_MMA(1, 0, At, B0); PG8_BAR; SCHED_BARRIER();
            PG8_STAGE(PG8_SB(1, 1), b3 + hstep, voffB);
            ASM_WAIT_V(6); PG8_BAR; PG8_MMA(1, 1, At, B1); PG8_BAR;
        }
        E(acc, cur, wr, wc, fr, fq);
        if (!has_next) break;
#pragma unroll
        for (int a = 0; a < 2; ++a)
#pragma unroll
            for (int b = 0; b < 2; ++b)
#pragma unroll
                for (int m = 0; m < 4; ++m)
#pragma unroll
                    for (int n = 0; n < 2; ++n) acc[a][b][m][n] = (f32x4){0.f, 0.f, 0.f, 0.f};
        cur = nxt; cA = nA; cB = nB; ++ui;
    }
    ASM_WAIT_V(0);
    if (wr == 0) PG8_BAR;
    PG8_BAR;
#undef PG8_SA
#undef PG8_SB
#undef PG8_STAGE
#undef PG8_LDA
#undef PG8_LDB
#undef PG8_MMA
#undef PG8_BAR
}
}

struct Args { const float* in[N_IN]; float* out; unsigned char* ws; int ph_lo, ph_hi; };
constexpr int NWAVES = 8, NTHR = 512;
constexpr int LDS_STAGE = 131072, LDS_MISC = LDS_STAGE, LDS_BYTES = 147456;

constexpr int PT_OUT = N_IN, PT_WS = N_IN + 1, PT_WORD0 = 128;

struct Ctx {
    LAS unsigned char* lds; int tid, lane, wave, G, bid;
    __device__ __forceinline__ unsigned long long ptr(int i) const { const volatile LAS unsigned* t = (const volatile LAS unsigned*)(lds + LDS_MISC) + PT_WORD0 + 2 * i;
        const unsigned lo = (unsigned)READFIRSTLANE((int)t[0]), hi = (unsigned)READFIRSTLANE((int)t[1]); return ((unsigned long long)hi << 32) | lo; }
    __device__ __forceinline__ unsigned long long ptrv(int i) const { const volatile LAS unsigned* t = (const volatile LAS unsigned*)(lds + LDS_MISC) + PT_WORD0 + 2 * i; return ((unsigned long long)t[1] << 32) | t[0]; }
    __device__ __forceinline__ const float* inv(int i) const { return as_global((const float*)ptrv(i)); }
    template <class T> __device__ __forceinline__ T* wsv(size_t off) const { return as_global((T*)((unsigned char*)ptrv(PT_WS) + off)); }
    __device__ __forceinline__ const float* in(int i) const { return as_global((const float*)ptr(i)); }
    __device__ __forceinline__ float* out() const { return as_global((float*)ptr(PT_OUT)); }
    template <class T> __device__ __forceinline__ T* ws(size_t off) const { return as_global((T*)((unsigned char*)ptr(PT_WS) + off)); }
    __device__ __forceinline__ unsigned* ctl() const { return as_global((unsigned*)ptr(PT_WS)); }
};

__device__ __forceinline__ void transpose_item(const float* W, int ldw, int k0, int n0, int nvalid, bf16* outp, int ldo, LAS float* scr, int lane) {
#pragma unroll
    for (int i = 0; i < 32; ++i) { const int kk = 2 * i + (lane >> 5), n = n0 + (lane & 31); scr[kk * 33 + (lane & 31)] = (n < nvalid) ? W[(size_t)(k0 + kk) * ldw + n] : 0.f; }
    WAVE_LDS_FENCE(); CFENCE();
    const int c = lane & 7;
#pragma unroll
    for (int j = 0; j < 4; ++j) { const int n = (lane >> 3) + 8 * j; const LAS float* s = scr + (8 * c) * 33 + n;
        u32x4 o; o[0] = pk2(s[0 * 33], s[1 * 33]); o[1] = pk2(s[2 * 33], s[3 * 33]); o[2] = pk2(s[4 * 33], s[5 * 33]); o[3] = pk2(s[6 * 33], s[7 * 33]);
        *(u32x4*)(outp + (size_t)n * ldo + k0 + 8 * c) = o; }
    WAVE_LDS_FENCE(); CFENCE();
}
__device__ __forceinline__ void filter_item(const Ctx& X, int l, int n, int pos0, float* out  , LAS float* scr  , LAS float* asum  ) {
    const int lane = X.lane;
    LAS float* zs = scr; LAS float* ha = scr + 8 * 33; LAS float* hb = ha + 8 * 64;
    const float* w1 = X.in(I_FW1) + (size_t)l * 33 * 64; const float* b1 = X.in(I_FB1) + l * 64;
    const float* w2 = X.in(I_FW2) + (size_t)l * 64 * 64; const float* b2 = X.in(I_FB2) + l * 64;
    const float* w3 = X.in(I_FW3) + (size_t)l * 64 * 64; const float* b3 = X.in(I_FB3) + l * 64;
    const float* wo = X.in(I_FWO) + (size_t)l * 64 * HW; const float fr = X.in(I_FREQ)[l * 64 + lane];
    if (lane < 33) {
#pragma unroll
        for (int p = 0; p < 8; ++p) { const int pos = pos0 + p; float v;
            if (lane == 0) v = (float)pos / (float)(n - 1 > 1 ? n - 1 : 1);
            else { const int b = (lane - 1) & 15; const double band = 1e-4 + (double)b * ((15.0 - 1e-4) / 15.0);
                double rev = (double)pos * band / (double)n; rev -= floor(rev); if (rev > 0.5) rev -= 1.0;
                float s, c; sincos_f((float)(rev * 6.283185307179586476925), s, c); v = lane <= 16 ? c : -s; }
            zs[p * 33 + lane] = v; }
    }
    WAVE_LDS_FENCE(); CFENCE();
    float acc[8];
    { const float bb = b1[lane];
#pragma unroll
      for (int p = 0; p < 8; ++p) acc[p] = bb;
#pragma unroll 3
      for (int i = 0; i < 33; ++i) { const float w = w1[i * 64 + lane];
#pragma unroll
          for (int p = 0; p < 8; ++p) acc[p] += zs[p * 33 + i] * w; }
#pragma unroll
      for (int p = 0; p < 8; ++p) ha[p * 64 + lane] = sin_f(fr * acc[p]); }
    WAVE_LDS_FENCE(); CFENCE();
    { const float bb = b2[lane];
#pragma unroll
      for (int p = 0; p < 8; ++p) acc[p] = bb;
#pragma unroll 4
      for (int i = 0; i < 64; ++i) { const float w = w2[i * 64 + lane];
#pragma unroll
          for (int p = 0; p < 8; ++p) acc[p] += ha[p * 64 + i] * w; }
#pragma unroll
      for (int p = 0; p < 8; ++p) hb[p * 64 + lane] = sin_f(fr * acc[p]); }
    WAVE_LDS_FENCE(); CFENCE();
    { const float bb = b3[lane];
#pragma unroll
      for (int p = 0; p < 8; ++p) acc[p] = bb;
#pragma unroll 4
      for (int i = 0; i < 64; ++i) { const float w = w3[i * 64 + lane];
#pragma unroll
          for (int p = 0; p < 8; ++p) acc[p] += hb[p * 64 + i] * w; }
#pragma unroll
      for (int p = 0; p < 8; ++p) ha[p * 64 + lane] = sin_f(fr * acc[p]); }
    WAVE_LDS_FENCE(); CFENCE();
    const float dmin = -3.0701134573253944f, dmax = -15.350567286626972f;
#pragma unroll 1
    for (int mI = 0; mI < HW / 64; ++mI) { const int c = lane + 64 * mI;
#pragma unroll
        for (int p = 0; p < 8; ++p) acc[p] = 0.f;
#pragma unroll 4
        for (int i = 0; i < 64; ++i) { const float w = wo[i * HW + c];
#pragma unroll
            for (int p = 0; p < 8; ++p) acc[p] += ha[p * 64 + i] * w; }
        const float delta = fabsf(dmin + (float)c * ((dmax - dmin) / (float)(HW - 1)));
        float as = 0.f;
#pragma unroll
        for (int p = 0; p < 8; ++p) { const int pos = pos0 + p; const int dd = pos - n / 2; const float dist = (float)(dd < 0 ? -dd : dd) * (2.0f / (float)n);
            const float v = acc[p] * expf(-dist * delta); out[(size_t)c * n + pos] = v; as += fabsf(v); }
        asum[c] += as; }
    WAVE_LDS_FENCE(); CFENCE();
}
__device__ __forceinline__ void phase_transposes(const Ctx& X, int l, int part) {
    LAS float* scr = (LAS float*)(X.lds + X.wave * 16384);
    const bool shifted = part == 1 && X.G > N_SEQ_UNITS; const int myb = shifted ? X.bid - N_SEQ_UNITS : X.bid, nb_ = shifted ? X.G - N_SEQ_UNITS : X.G;
    if (myb < 0) return;
    const int gw = myb * NWAVES + X.wave, NGW = nb_ * NWAVES, lane = X.lane;
    constexpr int KB_D = D / 64, I_WIN_ = KB_D * (PCP / 32), I_WB_ = 2 * (RW / 64) * (D / 32), I_WO_ = KB_D * (D / 32), I_WGU_ = NE * 2 * KB_D * (D / 32), I_WD_ = NE * KB_D * (D / 32);
    constexpr int I_LORA_ = 6 * (RW / 32); constexpr int N0 = I_WIN_ + I_WB_ + I_WO_, NITEMS = N0 + I_WGU_ + I_WD_;
    if (part == 0) for (int it = gw; it < I_LORA_; it += NGW) { const int which = it / (RW / 32), nb = it % (RW / 32);
        const float* W; int k0 = 0, ldo = 64; bf16* outp;
        if (which < 2) { W = X.in(I_W2) + ((size_t)l * 2 + which) * 64 * RW; outp = X.ws<bf16>(WS_W2T) + (size_t)which * RW * 64 + (size_t)(32 * nb) * 64; }
        else if (which < 4) { W = X.in(I_A2) + ((size_t)l * 2 + (which - 2)) * 64 * RW; outp = X.ws<bf16>(WS_A2T) + (size_t)(which - 2) * RW * 64 + (size_t)(32 * nb) * 64; }
        else { W = X.in(I_G2) + (size_t)l * 128 * RW; k0 = 64 * (which - 4); ldo = 128; outp = X.ws<bf16>(WS_G2T) + (size_t)(32 * nb) * 128; }
        transpose_item(W, RW, k0, 32 * nb, RW, outp, ldo, scr, lane); }
    const int it_end = part ? NITEMS : N0; int it = (part ? N0 : 0) + gw;
    const float* W; int ldw, k0, n0, nvalid, ldo; bf16* outp; float v[32];
#define TR_PARAMS(it_) do { int r = (it_); \
        if (r < I_WIN_) { const int nb = r % (PCP / 32), kb = r / (PCP / 32); W = X.in(I_WIN) + (size_t)l * D * PC; ldw = PC; k0 = 64 * kb; n0 = 32 * nb; nvalid = PC; outp = X.ws<bf16>(WS_WIN) + (size_t)n0 * D; ldo = D; } \
        else if ((r -= I_WIN_) < I_WB_) { const int s_ = r / ((RW / 64) * (D / 32)), q = r % ((RW / 64) * (D / 32)), nb = q % (D / 32), kb = q / (D / 32); \
            W = X.in(I_WBR) + ((size_t)l * 2 + s_) * RW * D; ldw = D; k0 = 64 * kb; n0 = 32 * nb; nvalid = D; outp = X.ws<bf16>(WS_WB) + (size_t)s_ * D * RW + (size_t)n0 * RW; ldo = RW; } \
        else if ((r -= I_WB_) < I_WO_) { const int nb = r % (D / 32), kb = r / (D / 32); W = X.in(I_WOUT) + (size_t)l * D * D; ldw = D; k0 = 64 * kb; n0 = 32 * nb; nvalid = D; outp = X.ws<bf16>(WS_WO) + (size_t)n0 * D; ldo = D; } \
        else if ((r -= I_WO_) < I_WGU_) { const int per = KB_D * (D / 32), es = r / per, q = r % per, e = es >> 1, src = es & 1, nb = q % (D / 32), kb = q / (D / 32); n0 = 32 * nb; \
            W = (src ? X.in(I_WU) : X.in(I_WG)) + ((size_t)l * NE + e) * D * D; ldw = D; k0 = 64 * kb; nvalid = D; const int orow = e * 2 * D + (n0 / 128) * 256 + src * 128 + (n0 % 128); \
            outp = X.ws<bf16>(WS_WGU) + (size_t)orow * D; ldo = D; } \
        else { r -= I_WGU_; const int per = KB_D * (D / 32), e = r / per, q = r % per, nb = q % (D / 32), kb = q / (D / 32); \
            W = X.in(I_WD) + ((size_t)l * NE + e) * D * D; ldw = D; k0 = 64 * kb; n0 = 32 * nb; nvalid = D; outp = X.ws<bf16>(WS_WD) + (size_t)(e * D + n0) * D; ldo = D; } } while (0)
#define TR_LOAD() do { const int n = n0 + (lane & 31); const float* wp = W + (size_t)(k0 + (lane >> 5)) * ldw + n; _Pragma("unroll") for (int i = 0; i < 32; ++i) v[i] = (n < nvalid) ? wp[(size_t)(2 * i) * ldw] : 0.f; } while (0)
    if (it < it_end) { TR_PARAMS(it); TR_LOAD(); }
    while (it < it_end) {
#pragma unroll
        for (int i = 0; i < 32; ++i) scr[(2 * i + (lane >> 5)) * 33 + (lane & 31)] = v[i];
        WAVE_LDS_FENCE(); CFENCE();
        bf16* const cout_ = outp; const int ck0 = k0, cldo = ldo;
        it += NGW;
        if (it < it_end) { TR_PARAMS(it); TR_LOAD(); }
        const int c = lane & 7;
#pragma unroll
        for (int j = 0; j < 4; ++j) { const int n = (lane >> 3) + 8 * j; const LAS float* s_ = scr + (8 * c) * 33 + n;
            u32x4 o; o[0] = pk2(s_[0 * 33], s_[1 * 33]); o[1] = pk2(s_[2 * 33], s_[3 * 33]); o[2] = pk2(s_[4 * 33], s_[5 * 33]); o[3] = pk2(s_[6 * 33], s_[7 * 33]);
            *(u32x4*)(cout_ + (size_t)n * cldo + ck0 + 8 * c) = o; }
        WAVE_LDS_FENCE(); CFENCE();
    }
#undef TR_PARAMS
#undef TR_LOAD
}
__device__ __forceinline__ void phase_filters(const Ctx& X, int l) {
    LAS float* scr = (LAS float*)(X.lds + X.wave * 8192);
    const int gw = X.bid * NWAVES + X.wave, NGW = X.G * NWAVES, lane = X.lane;
    LAS float* part = (LAS float*)(X.lds + 65536);
    static_assert(65536 + NWAVES * 2 * HW * 4 <= LDS_STAGE, "filter LDS map");
    for (int i = lane; i < 2 * HW; i += 64) part[X.wave * 2 * HW + i] = 0.f;
    WAVE_LDS_FENCE(); CFENCE();
    float* filt = X.ws<float>(WS_FILT);
    for (int it = gw; it < SEQ / 8; it += NGW) filter_item(X, l, SEQ, 8 * it, filt, scr, part + (X.wave * 2 + 0) * HW);
    for (int it = gw; it < CTX / 8; it += NGW) filter_item(X, l, CTX, 8 * it, filt + (size_t)HW * SEQ, scr, part + (X.wave * 2 + 1) * HW);
    __syncthreads();
    for (int i = X.tid; i < 2 * HW; i += NTHR) { float s = 0.f;
#pragma unroll
        for (int w = 0; w < NWAVES; ++w) s += part[w * 2 * HW + i];
        X.ws<float>(WS_FPART)[((size_t)(i / HW) * NPART + X.bid) * HW + (i % HW)] = s; }
    __syncthreads();
}
__device__ __forceinline__ void phase_mod(const Ctx& X) {
    const int lane = X.lane;
    LAS float* red = (LAS float*)X.lds;
    constexpr int NIT = DEPTH * (6 * D / 64);
    for (int it = X.bid; it < NIT; it += X.G) {
        const int ll = it / (6 * D / 64), n0 = (it % (6 * D / 64)) * 64;
        const float* W = X.in(I_WMOD) + (size_t)ll * D * 6 * D; const float* cv = X.in(I_C); const float* cc = X.in(I_CCTX);
        float s0 = 0.f, s1 = 0.f;
#pragma unroll 8
        for (int k = X.wave * (D / 8); k < (X.wave + 1) * (D / 8); ++k) { const float wv = W[(size_t)k * 6 * D + n0 + lane]; const float c0 = cv[k], c1 = cc[k];
            s0 += c0 * sigmoidf_(c0) * wv; s1 += c1 * sigmoidf_(c1) * wv; }
        red[(X.wave * 64 + lane) * 2] = s0; red[(X.wave * 64 + lane) * 2 + 1] = s1;
        __syncthreads();
        if (X.wave == 0) { float t0 = 0.f, t1 = 0.f;
#pragma unroll
            for (int w = 0; w < NWAVES; ++w) { t0 += red[(w * 64 + lane) * 2]; t1 += red[(w * 64 + lane) * 2 + 1]; }
            const float bm = X.in(I_BMOD)[(size_t)ll * 6 * D + n0 + lane];
            float* MOD = X.ws<float>(WS_MOD);
            MOD[((size_t)ll * 2 + 0) * 6 * D + n0 + lane] = t0 + bm; MOD[((size_t)ll * 2 + 1) * 6 * D + n0 + lane] = t1 + bm; }
        __syncthreads();
    }
}
__device__ __forceinline__ const float* modp(const Ctx& X, int l, int t, int j) { return X.ws<float>(WS_MOD) + ((size_t)l * 2 + (t < CTX ? 1 : 0)) * 6 * D + (size_t)j * D; }

__device__ __forceinline__ void phase_x0(const Ctx& X) {
    const int gw = X.bid * NWAVES + X.wave, NGW = X.G * NWAVES, lane = X.lane;
    for (int t = gw; t < M; t += NGW) {
        const float* src = t < CTX ? X.in(I_CTX) + (size_t)t * D : X.in(I_X) + (size_t)(t - CTX) * D;
        const float* sh = modp(X, 0, t, 0); const float* sc = modp(X, 0, t, 1);
        float* xr = X.ws<float>(WS_X) + (size_t)t * D; bf16* xm = X.ws<bf16>(WS_XMOD) + (size_t)t * D;
#pragma unroll
        for (int j = 0; j < D / 256; ++j) { const int d = 4 * lane + 256 * j; const f32x4 v = *(const f32x4*)(src + d), a = *(const f32x4*)(sh + d), b = *(const f32x4*)(sc + d);
            *(f32x4*)(xr + d) = v;
            unsigned w0 = pk2(v[0] * (1.f + b[0]) + a[0], v[1] * (1.f + b[1]) + a[1]), w1 = pk2(v[2] * (1.f + b[2]) + a[2], v[3] * (1.f + b[3]) + a[3]);
            *(unsigned long long*)(xm + d) = (unsigned long long)w0 | ((unsigned long long)w1 << 32); }
    }
}

__device__ __forceinline__ int shift_row(int t, int col, bool& valid) {
    const bool isctx = t < CTX;
    const int i = t - CTX, gx = i & (GRID_W - 1), gy = i / GRID_W, q = col / QTR;
    const int offl = (q == 0) ? -1 : (q == 1) ? 1 : (q == 2) ? -GRID_W : GRID_W;
    const bool vl = (q == 0) ? (gx > 0) : (q == 1) ? (gx < GRID_W - 1) : (q == 2) ? (gy > 0) : (gy < GRID_H - 1);
    const bool first = col < HALFC;
    const int offc = first ? -1 : 1; const bool vc = first ? (t > 0) : (t < CTX - 1);
    valid = isctx ? vc : vl;
    return valid ? t + (isctx ? offc : offl) : t;
}
__device__ __forceinline__ float pm_val(const bf16* P, const float* mu, int t, int col) {
    const float p0 = bf2f(P[(size_t)t * PCP + col]); bool valid; const int nr = shift_row(t, col, valid);
    const float pn = bf2f(P[(size_t)nr * PCP + col]); const float p1 = valid ? pn : 0.f;
    return p0 + (p1 - p0) * mu[col];
}
constexpr int LP = 72;
constexpr int LQ = 65;
constexpr int LX = 68;
__device__ __forceinline__ f32x4 mm_tile(const LAS bf16* A, const LAS bf16* Bt, int ti, int tj, int lane, f32x4 acc) {
    const LAS bf16* pa = A + (16 * ti + (lane & 15)) * LP + 8 * (lane >> 4); const LAS bf16* pb = Bt + (16 * tj + (lane & 15)) * LP + 8 * (lane >> 4);
#pragma unroll
    for (int kk = 0; kk < 2; ++kk) { const bf16x8 a = *(const LAS bf16x8*)(pa + 32 * kk), b = *(const LAS bf16x8*)(pb + 32 * kk); acc = MFMA16(a, b, acc); }
    return acc;
}
struct PmLd { float p0, pn, m; bool valid; };
__device__ __forceinline__ PmLd pm_ld(const bf16* P, const float* mu, int t, int col) {
    PmLd r; bool valid; const int nr = shift_row(t, col, valid); r.p0 = bf2f(P[(size_t)t * PCP + col]); r.pn = bf2f(P[(size_t)nr * PCP + col]); r.m = mu[col]; r.valid = valid; return r; }
__device__ __forceinline__ float pm_fin(const PmLd& r) { const float p1 = r.valid ? r.pn : 0.f; return r.p0 + (p1 - r.p0) * r.m; }
constexpr int TT = 8;
__device__ __forceinline__ void phase_lin(const Ctx& X, int l) {
    const bf16* P = X.ws<bf16>(WS_P); const float* mu = X.in(I_MU) + (size_t)l * RC; bf16* LIN = X.ws<bf16>(WS_LIN);
    for (size_t idx = (size_t)X.bid * NTHR + X.tid; idx < (size_t)M * 384; idx += (size_t)X.G * NTHR) { const int t = (int)(idx / 384), j = (int)(idx % 384);
        float v = pm_val(P, mu, t, C_LWF + j);
        if (j < 128) v = 1.0f - 2.0f * frcp(fexp(2.0f * v) + 1.0f); else if (j >= 256) v = sigmoidf_(v);
        LIN[idx] = (bf16)f2bf(v); }
}
__device__ __forceinline__ f32x4 mm_tile_p(const LAS bf16* A, int lda, const LAS bf16* Bt, int ldb, int ks, int ti, int tj, int lane, f32x4 acc) {
    const LAS bf16* pa = A + (16 * ti + (lane & 15)) * lda + 8 * (lane >> 4); const LAS bf16* pb = Bt + (16 * tj + (lane & 15)) * ldb + 8 * (lane >> 4);
    for (int kk = 0; kk < ks; ++kk) { const bf16x8 a = *(const LAS bf16x8*)(pa + 32 * kk), b = *(const LAS bf16x8*)(pb + 32 * kk); acc = MFMA16(a, b, acc); }
    return acc;
}
constexpr int GP = 136;
__device__ __forceinline__ void lora_unit_a(const Ctx& X, int unit) {
    const int b = unit / NH, h = unit % NH, tid = X.tid, lane = X.lane, w = X.wave;
    LAS bf16* Ab = (LAS bf16*)X.lds; LAS bf16* Gb = Ab + 4 * 64 * LP; LAS bf16* Wb = Gb + 64 * GP; LAS bf16* G2b = Wb + 4 * 64 * LP;
    LAS float* OUT = (LAS float*)X.lds;
    static_assert((8 * 64 * LP + 2 * 64 * GP) * 2 <= LDS_STAGE && 5 * 64 * LQ * 4 <= LDS_STAGE, "lora LDS map");
    const bf16* LIN = X.wsv<bf16>(WS_LIN) + (size_t)(64 * b) * 384;
    for (int i = tid; i < 64 * 48; i += NTHR) { const int t = i / 48, c16 = i % 48; const u32x4 v = *(const u32x4*)(LIN + (size_t)t * 384 + 8 * c16);
        if (c16 < 32) *(LAS u32x4*)(Ab + (c16 >> 3) * 64 * LP + t * LP + 8 * (c16 & 7)) = v; else *(LAS u32x4*)(Gb + t * GP + 8 * (c16 - 32)) = v; }
    const bf16* w2t = X.wsv<bf16>(WS_W2T) + (size_t)(64 * h) * 64; const bf16* a2t = X.wsv<bf16>(WS_A2T) + (size_t)(64 * h) * 64; const bf16* g2t = X.wsv<bf16>(WS_G2T) + (size_t)(64 * h) * 128;
    for (int i = tid; i < 4 * 64 * 8; i += NTHR) { const int q = i / 512, c = (i / 8) % 64, c16 = i % 8; const bf16* src = (q < 2 ? w2t + (size_t)q * RW * 64 : a2t + (size_t)(q - 2) * RW * 64) + c * 64 + 8 * c16;
        *(LAS u32x4*)(Wb + q * 64 * LP + c * LP + 8 * c16) = *(const u32x4*)src; }
    for (int i = tid; i < 64 * 16; i += NTHR) { const int c = i / 16, c16 = i % 16; *(LAS u32x4*)(G2b + c * GP + 8 * c16) = *(const u32x4*)(g2t + c * 128 + 8 * c16); }
    __syncthreads();
    f32x4 o[2][5];
#pragma unroll
    for (int q = 0; q < 2; ++q) { const int tile = 2 * w + q, ti = tile >> 2, tj = tile & 3; const f32x4 z4 = {0.f, 0.f, 0.f, 0.f};
#pragma unroll
        for (int p = 0; p < 4; ++p) o[q][p] = mm_tile(Ab + p * 64 * LP, Wb + p * 64 * LP, ti, tj, lane, z4);
        o[q][4] = mm_tile_p(Gb, GP, G2b, GP, 4, ti, tj, lane, z4); }
    __syncthreads();
#pragma unroll
    for (int q = 0; q < 2; ++q) { const int tile = 2 * w + q, ti = tile >> 2, tj = tile & 3, col = 16 * tj + (lane & 15);
#pragma unroll
        for (int p = 0; p < 5; ++p)
#pragma unroll
            for (int r = 0; r < 4; ++r) OUT[(p * 64 + 16 * ti + 4 * (lane >> 4) + r) * LQ + col] = o[q][p][r]; }
    __syncthreads();
}
__device__ __forceinline__ void lora_unit_b(const Ctx& X, int l, int unit) {
    const int b = unit / NH, h = unit % NH, w = X.wave, k = X.lane, c = 64 * h + k;
    const LAS float* OUT = (const LAS float*)X.lds;
    const bf16* P = X.wsv<bf16>(WS_P); const float* mu = X.inv(I_MU) + (size_t)l * RC;
    const float w00 = X.inv(I_W0)[(size_t)(l * 2 + 0) * RW + c], w01 = X.inv(I_W0)[(size_t)(l * 2 + 1) * RW + c];
    const float a00 = X.inv(I_A0)[(size_t)(l * 2 + 0) * RW + c], a01 = X.inv(I_A0)[(size_t)(l * 2 + 1) * RW + c];
    const float kkc = X.inv(I_KK)[(size_t)l * RW + c], kac = X.inv(I_KA)[(size_t)l * RW + c], rkc = X.inv(I_RK)[(size_t)l * RW + c];
    bf16* pR = X.wsv<bf16>(WS_R); bf16* pV = X.wsv<bf16>(WS_V); bf16* pKA = X.wsv<bf16>(WS_KA); bf16* pKD = X.wsv<bf16>(WS_KD); bf16* pKB = X.wsv<bf16>(WS_KB); float* pW = X.wsv<float>(WS_W); bf16* pG = X.wsv<bf16>(WS_GATE); float* pBo = X.wsv<float>(WS_BONUS);
    const int vz = vgpr_zero();
    float p0[3][8], pn[3][8]; unsigned vmask = 0u; const float mu0 = mu[c], mu1 = mu[C_K + c], mu2 = mu[C_V + c];
#pragma unroll
    for (int i = 0; i < 8; ++i) { const int t = 64 * b + 8 * w + i + vz;
#pragma unroll
        for (int q = 0; q < 3; ++q) { const int col = (q == 0 ? 0 : q == 1 ? C_K : C_V) + c; bool valid; const int nr = shift_row(t, col, valid);
            p0[q][i] = bf2f(P[(size_t)t * PCP + col]); pn[q][i] = bf2f(P[(size_t)nr * PCP + col]); vmask |= (valid ? 1u : 0u) << (3 * i + q); } }
    float bonv[8];
#pragma unroll
    for (int i = 0; i < 8; ++i) { const int tl = 8 * w + i, t = 64 * b + tl + vz;
        const float r = p0[0][i] + ((((vmask >> (3 * i + 0)) & 1u) ? pn[0][i] : 0.f) - p0[0][i]) * mu0;
        const float kx = p0[1][i] + ((((vmask >> (3 * i + 1)) & 1u) ? pn[1][i] : 0.f) - p0[1][i]) * mu1;
        const float v = p0[2][i] + ((((vmask >> (3 * i + 2)) & 1u) ? pn[2][i] : 0.f) - p0[2][i]) * mu2;
        const float wd0 = -DECAY_SCALE * sigmoidf_(w00 + OUT[(0 * 64 + tl) * LQ + k]), wd1 = -DECAY_SCALE * sigmoidf_(w01 + OUT[(1 * 64 + tl) * LQ + k]);
        const float ad0 = sigmoidf_(a00 + OUT[(2 * 64 + tl) * LQ + k]), ad1 = sigmoidf_(a01 + OUT[(3 * 64 + tl) * LQ + k]);
        const float kkr = kx * kkc; const float n2 = wave_sum(kkr * kkr); const float kk = kkr * frcp(fmaxf(sqrtf(n2), 1e-12f));
        const float kd0 = kx * (1.f + (ad0 - 1.f) * kac), kd1 = kx * (1.f + (ad1 - 1.f) * kac);
        bonv[i] = wave_sum(r * (kd0 + kd1) * rkc);
        const size_t o = (size_t)t * RW + c, o1 = (size_t)(M + t) * RW + c;
        pR[o] = (bf16)f2bf(r); pV[o] = (bf16)f2bf(v); pKA[o] = (bf16)f2bf(-kk);
        pKD[o] = (bf16)f2bf(kd0); pKD[o1] = (bf16)f2bf(kd1); pKB[o] = (bf16)f2bf(kk * ad0); pKB[o1] = (bf16)f2bf(kk * ad1);
        pW[o] = wd0; pW[o1] = wd1; pG[o] = (bf16)f2bf(OUT[(4 * 64 + tl) * LQ + k]); }
    if (k < 8) { float bs = bonv[0];
#pragma unroll
        for (int i = 1; i < 8; ++i) bs = (k == i) ? bonv[i] : bs;
        pBo[(size_t)(64 * b + 8 * w + k) * NH + h] = bs; }
    __syncthreads();
}
__device__ __forceinline__ void phase_prep_hyena(const Ctx& X, int l) {
    const bf16* P = X.ws<bf16>(WS_P); const int c = X.tid;
    if (c < HW) {
        const float* cw = X.in(I_CW) + (size_t)l * 3 * HC; const float* cb = X.in(I_CB) + (size_t)l * HC;
        float cw0[3], cw1[3], cw2[3], cbv[3];
#pragma unroll
        for (int j = 0; j < 3; ++j) { const int hc = j * HW + c; cw0[j] = cw[hc]; cw1[j] = cw[HC + hc]; cw2[j] = cw[2 * HC + hc]; cbv[j] = cb[hc]; }
        float* ZT = X.ws<float>(WS_ZT) + (size_t)c * M; float* Zc = X.ws<float>(WS_Z); bf16* X0 = X.ws<bf16>(WS_X0);
        for (int tile = X.bid; tile < M / TT; tile += X.G) { const int t0 = tile * TT; float zz[TT];
#pragma unroll
            for (int tt = 0; tt < TT; ++tt) { const int t = t0 + tt; const bool hp = (t != 0 && t != CTX), hn = (t != CTX - 1 && t != M - 1);
                float u[3];
#pragma unroll
                for (int j = 0; j < 3; ++j) { const int col = C_HY + j * HW + c;
                    const float pc = bf2f(P[(size_t)t * PCP + col]), pp = hp ? bf2f(P[(size_t)(t - 1) * PCP + col]) : 0.f, pn = hn ? bf2f(P[(size_t)(t + 1) * PCP + col]) : 0.f;
                    u[j] = pp * cw0[j] + pc * cw1[j] + pn * cw2[j] + cbv[j]; }
                zz[tt] = u[2] * u[1]; if (t < CTX) Zc[(size_t)t * HW + c] = zz[tt];
                X0[(size_t)t * HW + c] = (bf16)f2bf(u[0]); }
            *(f32x4*)(ZT + t0) = (f32x4){zz[0], zz[1], zz[2], zz[3]}; *(f32x4*)(ZT + t0 + 4) = (f32x4){zz[4], zz[5], zz[6], zz[7]}; }
    }
}

constexpr int CC = 64, NCHK = M / CC;
static_assert(CTX % CC == 0 && SEQ % CC == 0, "chunks must not straddle the context/latent boundary");
__device__ __forceinline__ int scan_row(int d, int s) { return d == 0 ? s : (s < CTX ? CTX - 1 - s : M - 1 - (s - CTX)); }
__device__ __forceinline__ void chunk_unit_1(const Ctx& X, int unit) {
    const int d = unit / (NCHK * NH), c = (unit / NH) % NCHK, h = unit % NH;
    LAS bf16* An = (LAS bf16*)X.lds;            LAS bf16* Bn = An + 64 * LP; LAS bf16* Kn = Bn + 64 * LP; LAS bf16* Rn = Kn + 64 * LP; LAS bf16* Vt = Rn + 64 * LP;
    LAS bf16* Bh = Vt + 64 * LP;                LAS bf16* Kh = Bh + 64 * LP; LAS bf16* Lak = Kh + 64 * LP; LAS bf16* Mrb = Lak + 64 * LP; LAS bf16* Mrk = Mrb + 64 * LP;
    LAS float* Lab = (LAS float*)(Mrk + 64 * LP); LAS float* XsW = Lab + 64 * LX;
    LAS float* XsU = (LAS float*)An;
    LAS bf16* Wt = Lak; LAS bf16* Ut = (LAS bf16*)((LAS unsigned char*)An + 64 * LX * 4);
    LAS float* tot = Lab;
    LAS float* dC = (LAS float*)(X.lds + LDS_MISC + 1024);
    static_assert(10 * 64 * LP * 2 + 2 * 64 * LX * 4 <= LDS_STAGE && 64 * LX * 4 + 64 * LP * 2 <= 3 * 64 * LP * 2, "chunk LDS map");
    const int tid = X.tid, lane = X.lane, w = X.wave, k = tid & 63;
    float lw[8], cum[8];
    { float run = 0.f; const float* pW = X.wsv<float>(WS_W);
#pragma unroll
      for (int i = 0; i < 8; ++i) { const int row = scan_row(d, c * CC + 8 * w + i); lw[i] = pW[((size_t)d * M + row) * RW + h * 64 + k]; }
#pragma unroll
      for (int i = 0; i < 8; ++i) { run += lw[i]; cum[i] = run; }
      tot[w * 64 + k] = run; }
    __syncthreads();
    float off = 0.f, cumC = 0.f;
#pragma unroll
    for (int ww = 0; ww < 8; ++ww) { const float t = tot[ww * 64 + k]; off += (ww < w) ? t : 0.f; cumC += t; }
    __syncthreads();
    { unsigned pv[4], pbh[4], pkh[4]; float af[8];
      const bf16* pR = X.wsv<bf16>(WS_R); const bf16* pV = X.wsv<bf16>(WS_V); const bf16* pKA = X.wsv<bf16>(WS_KA); const bf16* pKD = X.wsv<bf16>(WS_KD); const bf16* pKB = X.wsv<bf16>(WS_KB);
#pragma unroll
      for (int i = 0; i < 8; ++i) { const int t = 8 * w + i; const int row = scan_row(d, c * CC + t); const size_t o = (size_t)row * RW + h * 64 + k, od = ((size_t)d * M + row) * RW + h * 64 + k;
          const float ct = off + cum[i], cp = ct - lw[i];
          const float r = bf2f(pR[o]), v = bf2f(pV[o]), ka = bf2f(pKA[o]), kd = bf2f(pKD[od]), kb = bf2f(pKB[od]);
          const float ei = fexp(-ct), eh = fexp(cumC - ct);
          const float at = ka * fexp(cp); af[i] = at;
          An[t * LP + k] = (bf16)f2bf(at); Bn[t * LP + k] = (bf16)f2bf(kb * ei); Kn[t * LP + k] = (bf16)f2bf(kd * ei); Rn[t * LP + k] = (bf16)f2bf(r * fexp(ct));
          const unsigned bv = f2bf(v), bb = f2bf(kb * eh), bk = f2bf(kd * eh);
          if (i & 1) { pv[i >> 1] |= bv << 16; pbh[i >> 1] |= bb << 16; pkh[i >> 1] |= bk << 16; } else { pv[i >> 1] = bv; pbh[i >> 1] = bb; pkh[i >> 1] = bk; } }
      *(LAS u32x4*)(Vt + k * LP + 8 * w) = (u32x4){pv[0], pv[1], pv[2], pv[3]}; *(LAS u32x4*)(Bh + k * LP + 8 * w) = (u32x4){pbh[0], pbh[1], pbh[2], pbh[3]}; *(LAS u32x4*)(Kh + k * LP + 8 * w) = (u32x4){pkh[0], pkh[1], pkh[2], pkh[3]};
      *(LAS f32x4*)(XsW + k * LX + 8 * w) = (f32x4){af[0], af[1], af[2], af[3]}; *(LAS f32x4*)(XsW + k * LX + 8 * w + 4) = (f32x4){af[4], af[5], af[6], af[7]}; }
    if (tid < 64) dC[tid] = fexp(cumC);
    __syncthreads();
#pragma unroll 1
    for (int q = 0; q < 2; ++q) { const int tile = 2 * w + q, ti = tile >> 2, tj = tile & 3; const f32x4 z4 = {0.f, 0.f, 0.f, 0.f};
        const f32x4 ab = mm_tile(An, Bn, ti, tj, lane, z4), ak = mm_tile(An, Kn, ti, tj, lane, z4), rb = mm_tile(Rn, Bn, ti, tj, lane, z4), rk = mm_tile(Rn, Kn, ti, tj, lane, z4);
        const int col = 16 * tj + (lane & 15);
#pragma unroll
        for (int r = 0; r < 4; ++r) { const int row = 16 * ti + 4 * (lane >> 4) + r; const bool lo = col < row, le = col <= row;
            Lab[row * LX + col] = lo ? ab[r] : 0.f; Lak[row * LP + col] = (bf16)f2bf(lo ? ak[r] : 0.f); Mrb[row * LP + col] = (bf16)f2bf(le ? rb[r] : 0.f); Mrk[row * LP + col] = (bf16)f2bf(le ? rk[r] : 0.f); } }
    __syncthreads();
}
__device__ __forceinline__ void chunk_unit_2(const Ctx& X, int unit) {
    const int d = unit / (NCHK * NH), c = (unit / NH) % NCHK, h = unit % NH;
    LAS bf16* An = (LAS bf16*)X.lds;            LAS bf16* Bn = An + 64 * LP; LAS bf16* Kn = Bn + 64 * LP; LAS bf16* Rn = Kn + 64 * LP; LAS bf16* Vt = Rn + 64 * LP;
    LAS bf16* Bh = Vt + 64 * LP;                LAS bf16* Kh = Bh + 64 * LP; LAS bf16* Lak = Kh + 64 * LP; LAS bf16* Mrb = Lak + 64 * LP; LAS bf16* Mrk = Mrb + 64 * LP;
    LAS float* Lab = (LAS float*)(Mrk + 64 * LP); LAS float* XsW = Lab + 64 * LX;
    LAS float* XsU = (LAS float*)An;
    LAS bf16* Wt = Lak; LAS bf16* Ut = (LAS bf16*)((LAS unsigned char*)An + 64 * LX * 4);
    LAS float* tot = Lab;
    LAS float* dC = (LAS float*)(X.lds + LDS_MISC + 1024);
    static_assert(10 * 64 * LP * 2 + 2 * 64 * LX * 4 <= LDS_STAGE && 64 * LX * 4 + 64 * LP * 2 <= 3 * 64 * LP * 2, "chunk LDS map");
    const int tid = X.tid, lane = X.lane, w = X.wave, k = tid & 63;
    f32x4 r2[2]; int r2col[2], r2row[2];
#pragma unroll
    for (int q = 0; q < 2; ++q) { const int tile = 2 * w + q, ti = tile >> 2, tj = tile & 3; const f32x4 z4 = {0.f, 0.f, 0.f, 0.f};
        const f32x4 a = mm_tile(Lak, Vt, ti, tj, lane, z4); const int col = 16 * tj + (lane & 15);
        r2[q] = a; r2col[q] = col; r2row[q] = 16 * ti + 4 * (lane >> 4); }
    __syncthreads();
#pragma unroll
    for (int q = 0; q < 2; ++q) *(LAS f32x4*)(XsU + r2col[q] * LX + r2row[q]) = r2[q];
    __syncthreads();
    LAS bf16* Tii = (LAS bf16*)(X.lds + LDS_MISC + 8448);
    constexpr int TP = 40;
    static_assert(8448 + 4 * 16 * TP * 2 <= LDS_BYTES - LDS_MISC, "T_ii image");
    if (tid < 64) { const int bi = tid >> 4, j = tid & 15; float xv[16];
#pragma unroll
        for (int t = 0; t < 16; ++t) { float acc = (t == j) ? 1.f : 0.f;
#pragma unroll
            for (int s2 = 0; s2 < t; ++s2) acc += Lab[(16 * bi + t) * LX + 16 * bi + s2] * xv[s2];
            xv[t] = acc; }
#pragma unroll
        for (int t = 0; t < 16; ++t) { Tii[(bi * 16 + t) * TP + j] = (bf16)f2bf(xv[t]); Tii[(bi * 16 + t) * TP + 16 + j] = (bf16)0; } }
    __syncthreads();
    { LAS float* xsx = (w < 4 ? XsW + 16 * w * LX : XsU + 16 * (w - 4) * LX) + (lane & 15) * LX;
      LAS bf16* dst = (w < 4 ? Wt + 16 * w * LP : Ut + 16 * (w - 4) * LP) + (lane & 15) * LP;
      const int kof = 8 * (lane >> 4); const bf16x8 zero8 = {0, 0, 0, 0, 0, 0, 0, 0};
#pragma unroll
      for (int i = 0; i < 4; ++i) {
          f32x4 acc = *(const LAS f32x4*)(xsx + 16 * i + 4 * (lane >> 4));
#pragma unroll
          for (int kk = 0; kk < (16 * i + 31) / 32; ++kk) { const int s0 = 32 * kk + kof;
              const f32x4 l0 = *(const LAS f32x4*)(Lab + (16 * i + (lane & 15)) * LX + s0), l1 = *(const LAS f32x4*)(Lab + (16 * i + (lane & 15)) * LX + s0 + 4);
              u32x4 pa = {pk2(l0[0], l0[1]), pk2(l0[2], l0[3]), pk2(l1[0], l1[1]), pk2(l1[2], l1[3])};
              bf16x8 av = __builtin_bit_cast(bf16x8, pa), bv = *(const LAS bf16x8*)(dst + s0);
              if (s0 >= 16 * i) { av = zero8; bv = zero8; }
              acc = MFMA16(av, bv, acc); }
          LAS bf16* zt = (LAS bf16*)(xsx + 16 * i);
          *(LAS unsigned long long*)(zt + 4 * (lane >> 4)) = (unsigned long long)pk2(acc[0], acc[1]) | ((unsigned long long)pk2(acc[2], acc[3]) << 32);
          WAVE_LDS_FENCE(); CFENCE();
          const bf16x8 a2 = *(const LAS bf16x8*)(Tii + (i * 16 + (lane & 15)) * TP + kof); bf16x8 b2 = zero8; if (kof < 16) b2 = *(const LAS bf16x8*)(zt + kof);
          f32x4 xi = {0.f, 0.f, 0.f, 0.f}; xi = MFMA16(a2, b2, xi);
          *(LAS unsigned long long*)(dst + 16 * i + 4 * (lane >> 4)) = (unsigned long long)pk2(xi[0], xi[1]) | ((unsigned long long)pk2(xi[2], xi[3]) << 32);
          WAVE_LDS_FENCE(); CFENCE(); } }
    __syncthreads();
}
__device__ __forceinline__ void chunk_unit_3(const Ctx& X, int unit) {
    const int d = unit / (NCHK * NH), c = (unit / NH) % NCHK, h = unit % NH;
    LAS bf16* An = (LAS bf16*)X.lds;            LAS bf16* Bn = An + 64 * LP; LAS bf16* Kn = Bn + 64 * LP; LAS bf16* Rn = Kn + 64 * LP; LAS bf16* Vt = Rn + 64 * LP;
    LAS bf16* Bh = Vt + 64 * LP;                LAS bf16* Kh = Bh + 64 * LP; LAS bf16* Lak = Kh + 64 * LP; LAS bf16* Mrb = Lak + 64 * LP; LAS bf16* Mrk = Mrb + 64 * LP;
    LAS float* Lab = (LAS float*)(Mrk + 64 * LP); LAS float* XsW = Lab + 64 * LX;
    LAS float* XsU = (LAS float*)An;
    LAS bf16* Wt = Lak; LAS bf16* Ut = (LAS bf16*)((LAS unsigned char*)An + 64 * LX * 4);
    LAS float* tot = Lab;
    LAS float* dC = (LAS float*)(X.lds + LDS_MISC + 1024);
    static_assert(10 * 64 * LP * 2 + 2 * 64 * LX * 4 <= LDS_STAGE && 64 * LX * 4 + 64 * LP * 2 <= 3 * 64 * LP * 2, "chunk LDS map");
    const int tid = X.tid, lane = X.lane, w = X.wave, k = tid & 63;
    const float dCk = dC[k];
    const size_t ubase = ((size_t)(d * NH + h) * NCHK + c);
    float* Pg = X.wsv<float>(WS_PQ) + ubase * 2 * 4096; float* Qg = Pg + 4096; bf16* Gg = X.wsv<bf16>(WS_G) + ubase * 4096; float* Yg = X.wsv<float>(WS_YL) + ubase * 4096;
#pragma unroll 1
    for (int q = 0; q < 2; ++q) { const int tile = 2 * w + q, ti = tile >> 2, tj = tile & 3; const f32x4 z4 = {0.f, 0.f, 0.f, 0.f};
        const f32x4 p = mm_tile(Wt, Bh, ti, tj, lane, z4); f32x4 qq = mm_tile(Ut, Bh, ti, tj, lane, z4); qq = mm_tile(Vt, Kh, ti, tj, lane, qq);
        const f32x4 g = mm_tile(Mrb, Wt, ti, tj, lane, z4); f32x4 y = mm_tile(Mrb, Ut, ti, tj, lane, z4); y = mm_tile(Mrk, Vt, ti, tj, lane, y);
        const int col = 16 * tj + (lane & 15); const float dcol = __shfl(dCk, col);
#pragma unroll
        for (int r = 0; r < 4; ++r) { const int row = 16 * ti + 4 * (lane >> 4) + r;
            Pg[row * 64 + col] = p[r] + (row == col ? dcol : 0.f); Qg[row * 64 + col] = qq[r];
            const int orow = d ? 63 - row : row;
            Gg[orow * 64 + col] = (bf16)f2bf(g[r] + bf2f(Rn[row * LP + col])); Yg[orow * 64 + col] = y[r]; } }
    __syncthreads();
}
__device__ __forceinline__ void seq_unit(const Ctx& X, int su) {
    const int d = su / (NH * 4), h = (su / 4) % NH, qv = su & 3;
    constexpr int PD = 4, RING = PD + 1, SLOT = 4096 + 1024;
    LAS float* ring = (LAS float*)X.lds;
    LAS float* S = ring + RING * SLOT;
    LAS float* part = S + 16 * LQ;
    static_assert((RING * SLOT + 16 * LQ + 4 * 16 * 17) * 4 <= LDS_STAGE, "seq LDS map");
    const int lane = X.lane, w = X.wave, tj = w & 3, kh = w >> 2, col = 16 * tj + (lane & 15), kq = lane >> 4;
    const float* PQ = X.ws<float>(WS_PQ) + (size_t)(d * NH + h) * NCHK * 2 * 4096; bf16* S0g = X.ws<bf16>(WS_S0) + (size_t)(d * NH + h) * NCHK * 4096 + (size_t)(16 * qv) * 64;
#define SEQ_FILL(c_) do { const float* p_ = PQ + (size_t)(c_) * 2 * 4096; LAS float* sl_ = ring + ((c_) % RING) * SLOT; \
        GLDS16(p_ + 4 * (w * 64 + lane), sl_ + 4 * (w * 64)); GLDS16(p_ + 4 * (512 + w * 64 + lane), sl_ + 4 * (512 + w * 64)); \
        GLDS16(p_ + 4096 + (16 * qv) * 64 + 4 * ((w & 3) * 64 + lane), sl_ + 4096 + 4 * ((w & 3) * 64)); } while (0)
#pragma unroll
    for (int i = 0; i < PD; ++i) if (i < NCHK) SEQ_FILL(i);
    for (int i = X.tid; i < 16 * LQ; i += NTHR) S[i] = 0.f;
    if (kh == 0) {
#pragma unroll
        for (int r = 0; r < 4; ++r) S0g[(4 * kq + r) * 64 + col] = (bf16)0; }
    for (int c = 0; c < NCHK; ++c) {
        if (c + PD - 1 < NCHK) { if (kh == 0) { ASM_WAIT_V(21); } else { ASM_WAIT_V(9); } } else { ASM_WAIT_V(0); }
        ASM_WAIT_L(0); S_BARRIER(); CFENCE();
        if (c + PD < NCHK) SEQ_FILL(c + PD);
        const LAS float* P = ring + (c % RING) * SLOT; const LAS float* Q = P + 4096;
        f32x4 acc0 = {0.f, 0.f, 0.f, 0.f}, acc1 = {0.f, 0.f, 0.f, 0.f};
#pragma unroll
        for (int s2 = 0; s2 < 8; s2 += 2) { const int k0 = 32 * kh + 4 * s2 + kq;
            acc0 = MFMA4F(S[(lane & 15) * LQ + k0], P[k0 * 64 + col], acc0); acc1 = MFMA4F(S[(lane & 15) * LQ + k0 + 4], P[(k0 + 4) * 64 + col], acc1); }
        acc0 += acc1;
        if (kh == 1) {
#pragma unroll
            for (int r = 0; r < 4; ++r) part[(tj * 16 + 4 * kq + r) * 17 + (lane & 15)] = acc0[r]; }
        ASM_WAIT_L(0); S_BARRIER(); CFENCE();
        if (kh == 0) {
#pragma unroll
            for (int r = 0; r < 4; ++r) { const float sn = acc0[r] + part[(tj * 16 + 4 * kq + r) * 17 + (lane & 15)] + Q[(4 * kq + r) * 64 + col];
                S[(4 * kq + r) * LQ + col] = sn; if (c + 1 < NCHK) S0g[(size_t)(c + 1) * 4096 + (4 * kq + r) * 64 + col] = (bf16)f2bf(sn); } }
    }
    ASM_WAIT_V(0);
    __syncthreads();
#undef SEQ_FILL
}
constexpr int CR = 16;
__device__ __forceinline__ void conv_item(const Ctx& X, int item) {
    constexpr int NCG = HW / 64; constexpr int n = CTX;
    const int cg = item % NCG, ob = item / NCG, i0 = CR * ob, c = cg * 64 + X.lane;
    const float* F = X.ws<float>(WS_FILT) + (size_t)HW * SEQ + (size_t)c * CTX; const float* Z = X.ws<float>(WS_Z) + c;
    const float* fp = X.ws<float>(WS_FPART) + (size_t)NPART * HW + c;
    float nsum = 0.f; for (int b = 0; b < NPART; ++b) nsum += fp[(size_t)b * HW];
    float acc[CR], Q[CR];
#pragma unroll
    for (int r = 0; r < CR; ++r) acc[r] = 0.f;
    int jb = i0 - n / 2; if (jb < 0) jb = 0;
    int jend = i0 + n / 2 + CR; if (jend > n) jend = n;
    int Tb = i0 - jb + n / 2;
#pragma unroll
    for (int x = 1; x < CR; ++x) { const int T = Tb + x; Q[x] = (T >= 0 && T < n) ? F[T] : 0.f; }
    Q[0] = 0.f;
    for (; jb < jend; jb += CR, Tb -= CR) {
#pragma unroll
        for (int s = 0; s < CR; ++s) { const int T = Tb - s, j = jb + s;
            if ((s & 3) == 0) CFENCE();
            Q[(CR - s) & (CR - 1)] = (T >= 0 && T < n) ? F[T] : 0.f;
            const float zj = (j < n) ? Z[(size_t)j * HW] : 0.f;
#pragma unroll
            for (int r = 0; r < CR; ++r) acc[r] += Q[(r - s + CR) & (CR - 1)] * zj; }
    }
    const float inv = 1.0f / nsum; float* O = X.ws<float>(WS_CONV) + c;
#pragma unroll
    for (int r = 0; r < CR; ++r) O[(size_t)(i0 + r) * HW] = acc[r] * inv;
}

#ifdef EMU
struct cf { float x, y; };
#else
typedef float cf __attribute__((ext_vector_type(2)));
#endif
__device__ __forceinline__ cf cmul(cf a, cf b) { return cf{a.x * b.x - a.y * b.y, a.x * b.y + a.y * b.x}; }
__device__ __forceinline__ cf cadd(cf a, cf b) { return cf{a.x + b.x, a.y + b.y}; }
__device__ __forceinline__ cf csub(cf a, cf b) { return cf{a.x - b.x, a.y - b.y}; }
__device__ __forceinline__ cf cconj(cf a) { return cf{a.x, -a.y}; }
constexpr int FN = SEQ;
constexpr int flog4(int n) { return n <= 1 ? 0 : 1 + flog4(n / 4); }
constexpr int FLOG4 = flog4(FN), FSQ = 1 << FLOG4;
static_assert((1 << (2 * FLOG4)) == FN && FN * 8 <= LDS_STAGE, "FFT length must be a power of 4 that fits the LDS stage region");
constexpr int FFT_TAB_OFF = LDS_MISC + 2048;
static_assert(FFT_TAB_OFF + 2 * FSQ * 8 <= LDS_BYTES, "FFT twiddle tables");
__device__ __forceinline__ void fft_tables(const Ctx& X) {
    LAS cf* T = (LAS cf*)(X.lds + FFT_TAB_OFF);
    for (int i = X.tid; i < 2 * FSQ; i += NTHR) { const int k = i < FSQ ? i * FSQ : i - FSQ; float s, c; sincos_f(-6.283185307179586f * (float)k / (float)FN, s, c); T[i] = cf{c, s}; }
    __syncthreads();
}
__device__ __forceinline__ cf fft_tw(const LAS cf* T, int k) { const cf a = T[k >> FLOG4], b = T[FSQ + (k & (FSQ - 1))]; return cmul(a, b); }
__device__ __forceinline__ int rev4(int k) { int r = 0;
#pragma unroll
    for (int s = 0; s < FLOG4; ++s) { r = (r << 2) | (k & 3); k >>= 2; }
    return r; }
__device__ __forceinline__ void fft_stage_q1(LAS cf* x, int tid, bool inverse) {
    for (int u = tid; u < FN / 4; u += NTHR) { LAS f32x4* px = (LAS f32x4*)(x + 4 * u); const f32x4 v01 = px[0], v23 = px[1];
        const cf a0{v01[0], v01[1]}, a1{v01[2], v01[3]}, a2{v23[0], v23[1]}, a3{v23[2], v23[3]};
        const cf t0 = cadd(a0, a2), t1 = csub(a0, a2), t2 = cadd(a1, a3), d = csub(a1, a3), t3 = inverse ? cf{-d.y, d.x} : cf{d.y, -d.x};
        const cf y0 = cadd(t0, t2), y1 = cadd(t1, t3), y2 = csub(t0, t2), y3 = csub(t1, t3);
        px[0] = (f32x4){y0.x, y0.y, y1.x, y1.y}; px[1] = (f32x4){y2.x, y2.y, y3.x, y3.y}; }
    __syncthreads();
}
__device__ __forceinline__ void dif4(cf& a0, cf& a1, cf& a2, cf& a3, cf w1) {
    const cf w2 = cmul(w1, w1), w3 = cmul(w2, w1);
    const cf t0 = cadd(a0, a2), t1 = csub(a0, a2), t2 = cadd(a1, a3), d = csub(a1, a3), t3 = cf{d.y, -d.x};
    a0 = cadd(t0, t2); a1 = cmul(cadd(t1, t3), w1); a2 = cmul(csub(t0, t2), w2); a3 = cmul(csub(t1, t3), w3);
}
__device__ __forceinline__ void dit4(cf& a0, cf& a1, cf& a2, cf& a3, cf w1c) {
    const cf w2 = cmul(w1c, w1c), w3 = cmul(w2, w1c);
    a1 = cmul(a1, w1c); a2 = cmul(a2, w2); a3 = cmul(a3, w3);
    const cf t0 = cadd(a0, a2), t1 = csub(a0, a2), t2 = cadd(a1, a3), d = csub(a1, a3), t3 = cf{-d.y, d.x};
    a0 = cadd(t0, t2); a1 = cadd(t1, t3); a2 = csub(t0, t2); a3 = csub(t1, t3);
}
__device__ __forceinline__ void fft_pair(LAS cf* x, const LAS cf* T, int tid, int s, bool inverse) {
    const int q1 = FN >> (2 * s + 2), q2 = q1 >> 2, tw1 = 1 << (2 * s), tw2 = tw1 << 2;
    for (int u = tid; u < FN / 16; u += NTHR) { const int j2 = u & (q2 - 1), base = (u - j2) * 16 + j2;
        cf v[4][4];
#pragma unroll
        for (int a = 0; a < 4; ++a)
#pragma unroll
            for (int b = 0; b < 4; ++b) v[a][b] = x[base + a * q1 + b * q2];
        if (!inverse) {
#pragma unroll
            for (int b = 0; b < 4; ++b) dif4(v[0][b], v[1][b], v[2][b], v[3][b], fft_tw(T, (b * q2 + j2) * tw1));
            const cf wb = fft_tw(T, j2 * tw2);
#pragma unroll
            for (int a = 0; a < 4; ++a) dif4(v[a][0], v[a][1], v[a][2], v[a][3], wb);
        } else {
            const cf wb = cconj(fft_tw(T, j2 * tw2));
#pragma unroll
            for (int a = 0; a < 4; ++a) dit4(v[a][0], v[a][1], v[a][2], v[a][3], wb);
#pragma unroll
            for (int b = 0; b < 4; ++b) dit4(v[0][b], v[1][b], v[2][b], v[3][b], cconj(fft_tw(T, (b * q2 + j2) * tw1)));
        }
#pragma unroll
        for (int a = 0; a < 4; ++a)
#pragma unroll
            for (int b = 0; b < 4; ++b) x[base + a * q1 + b * q2] = v[a][b]; }
    __syncthreads();
}
__device__ __forceinline__ void fft_single(LAS cf* x, const LAS cf* T, int tid, int s, bool inverse) {
    const int q = FN >> (2 * s + 2), tw = 1 << (2 * s);
    for (int u = tid; u < FN / 4; u += NTHR) { const int j = u & (q - 1), p = (u - j) * 4 + j;
        cf a0 = x[p], a1 = x[p + q], a2 = x[p + 2 * q], a3 = x[p + 3 * q];
        if (!inverse) dif4(a0, a1, a2, a3, fft_tw(T, j * tw)); else dit4(a0, a1, a2, a3, cconj(fft_tw(T, j * tw)));
        x[p] = a0; x[p + q] = a1; x[p + 2 * q] = a2; x[p + 3 * q] = a3; }
    __syncthreads();
}
constexpr int fft_npairs() { int n = 0; for (int s = 0; s + 1 < FLOG4 - 1; s += 2) { if ((FN >> (2 * s + 6)) >= 64 || FN < 16384) ++n; else break; } return n; }
constexpr int FPAIRS = fft_npairs();
__device__ __forceinline__ void fft_run(LAS cf* x, const LAS cf* T, int tid, bool inverse) {
    constexpr int NST = FPAIRS + (FLOG4 - 1 - 2 * FPAIRS) + 1;
#pragma unroll 1
    for (int i = 0; i < NST; ++i) { const int k = inverse ? NST - 1 - i : i;
        if (k < FPAIRS) fft_pair(x, T, tid, 2 * k, inverse);
        else if (k < NST - 1) fft_single(x, T, tid, 2 * FPAIRS + (k - FPAIRS), inverse);
        else fft_stage_q1(x, tid, inverse); }
}
__device__ __forceinline__ void fft_fwd(LAS cf* x, const LAS cf* T, int tid) { fft_run(x, T, tid, false); }
__device__ __forceinline__ void fft_inv(LAS cf* x, const LAS cf* T, int tid) { fft_run(x, T, tid, true); }
__device__ __forceinline__ void fft_load_real(LAS cf* x, const float* src, float scale, int tid) {
    for (int m = tid; m < FN; m += NTHR) { cf v{0.f, 0.f}; if (m < FN / 2) { v.x = src[2 * m] * scale; v.y = src[2 * m + 1] * scale; } x[m] = v; }
    __syncthreads();
}
__device__ __forceinline__ void spec_load(const Ctx& X, int c) {
    LAS cf* x = (LAS cf*)X.lds; volatile LAS float* red = (volatile LAS float*)(X.lds + LDS_MISC) + 120;
    if (X.wave == 0) { const float* fp = X.ws<float>(WS_FPART) + c; float s = 0.f; for (int b = X.lane; b < NPART; b += 64) s += fp[(size_t)b * HW]; s = wave_sum(s); if (X.lane == 0) red[0] = s; }
    __syncthreads();
    const float inv = 1.0f / red[0];
    fft_load_real(x, X.ws<float>(WS_FILT) + (size_t)c * SEQ, inv, X.tid);
}
__device__ __forceinline__ void spec_unpack(const Ctx& X, int c) {
    LAS cf* x = (LAS cf*)X.lds;
    cf* HS = X.ws<cf>(WS_HS) + (size_t)c * (FN + 1);
    for (int k = X.tid; k <= FN / 2; k += NTHR) {
        const cf A = x[rev4(k)], B = x[rev4((FN - k) & (FN - 1))];
        if (k == 0) { HS[0] = cf{A.x + A.y, 0.f}; HS[FN] = cf{A.x - A.y, 0.f}; }
        else if (k == FN / 2) { HS[k] = cconj(A); }
        else { float sn, cs; sincos_f(-3.14159265358979f * (float)k / (float)FN, sn, cs); const cf w{cs, sn};
            const cf s1 = cadd(A, cconj(B)), d1 = csub(A, cconj(B)), wd = cmul(w, d1);
            HS[k] = cf{0.5f * (s1.x + wd.y), 0.5f * (s1.y - wd.x)};
            const cf s2 = cadd(B, cconj(A)), d2 = csub(B, cconj(A)), wd2 = cmul(cconj(w), d2);
            HS[FN - k] = cf{0.5f * (s2.x - wd2.y), 0.5f * (s2.y + wd2.x)}; } }
    __syncthreads();
}
__device__ __forceinline__ void fftconv_load(const Ctx& X, int c) { fft_load_real((LAS cf*)X.lds, X.ws<float>(WS_ZT) + (size_t)c * M + CTX, 1.0f, X.tid); }
__device__ __forceinline__ void fftconv_mul(const Ctx& X, int c) {
    LAS cf* x = (LAS cf*)X.lds;
    const cf* HS = X.ws<cf>(WS_HS) + (size_t)c * (FN + 1);
    for (int k = X.tid; k <= FN / 2; k += NTHR) {
        const int pa = rev4(k), pb = rev4((FN - k) & (FN - 1)); const cf A = x[pa], B = x[pb];
        if (k == 0) { const float y0 = (A.x + A.y) * HS[0].x, yn = (A.x - A.y) * HS[FN].x; x[pa] = cf{0.5f * (y0 + yn), 0.5f * (y0 - yn)}; }
        else if (k == FN / 2) { x[pa] = cconj(cmul(cconj(A), HS[k])); }
        else { float sn, cs; sincos_f(-3.14159265358979f * (float)k / (float)FN, sn, cs); const cf w{cs, sn};
            const cf s1 = cadd(A, cconj(B)), d1 = csub(A, cconj(B)), wd = cmul(w, d1); const cf Xk{0.5f * (s1.x + wd.y), 0.5f * (s1.y - wd.x)};
            const cf s2 = cadd(B, cconj(A)), d2 = csub(B, cconj(A)), wd2 = cmul(cconj(w), d2); const cf Xn{0.5f * (s2.x - wd2.y), 0.5f * (s2.y + wd2.x)};
            const cf Yk = cmul(Xk, HS[k]), Yn = cmul(Xn, HS[FN - k]);
            const cf e1 = cadd(Yk, cconj(Yn)), f1 = cmul(cconj(w), csub(Yk, cconj(Yn)));
            x[pa] = cf{0.5f * (e1.x - f1.y), 0.5f * (e1.y + f1.x)};
            const cf e2 = cadd(Yn, cconj(Yk)), f2 = cmul(w, csub(Yn, cconj(Yk)));
            x[pb] = cf{0.5f * (e2.x + f2.y), 0.5f * (e2.y - f2.x)}; } }
    __syncthreads();
}
__device__ __forceinline__ void fftconv_out(const Ctx& X, int l, int c) {
    const LAS cf* x = (const LAS cf*)X.lds; const float* z = X.ws<float>(WS_ZT) + (size_t)c * M + CTX;
    const float bias = X.in(I_HBIAS)[(size_t)l * HW + c], sc = 1.0f / (float)FN; float* O = X.ws<float>(WS_CVT) + (size_t)c * SEQ;
    for (int i2 = X.tid; i2 < FN / 2; i2 += NTHR) { const cf d = x[i2 + FN / 4]; O[2 * i2] = d.x * sc + z[2 * i2] * bias; O[2 * i2 + 1] = d.y * sc + z[2 * i2 + 1] * bias; }
    __syncthreads();
}
__device__ __forceinline__ void phase_ctxconv(const Ctx& X, int l) {
    constexpr int NITEMS = (HW / 64) * (CTX / CR);
    unsigned* q = X.ctl() + CW_Q + l * 64;
    for (;;) { int item = 0; if (X.lane == 0) item = (int)atomicAdd(q, 1u); item = __shfl(item, 0); if (item >= NITEMS) break; conv_item(X, item); }
}
__device__ __forceinline__ void phase_seq(const Ctx& X) {
    for (int su = X.bid; su < N_SEQ_UNITS; su += X.G) seq_unit(X, su);
}

__device__ __forceinline__ void finish_wave_unit(const Ctx& X, int l, int unit) {
    const int rg = unit / NH, h = unit % NH, lane = X.lane, b = rg >> 2, sub = rg & 3;
    const int cf = b, cb = (b < CTX / CC) ? (CTX / CC - 1 - b) : (NCHK - 1 - (b - CTX / CC));
    const size_t uf = ((size_t)(0 * NH + h) * NCHK + cf) * 4096, ub = ((size_t)(1 * NH + h) * NCHK + cb) * 4096;
    const bf16* G = X.wsv<bf16>(WS_G); const bf16* S0 = X.wsv<bf16>(WS_S0); const float* YL = X.wsv<float>(WS_YL);
    const int arow = 16 * sub + (lane & 15), kof = 8 * (lane >> 4);
    bf16x8 af[2], ab[2];
#pragma unroll
    for (int kk = 0; kk < 2; ++kk) { af[kk] = *(const bf16x8*)(G + uf + arow * 64 + kof + 32 * kk); ab[kk] = *(const bf16x8*)(G + ub + arow * 64 + kof + 32 * kk); }
    f32x4 y[4];
#pragma unroll
    for (int tj = 0; tj < 4; ++tj) { const int vrow = 16 * tj + (lane & 15);
        bf16x8 bf_[2], bb_[2];
#pragma unroll
        for (int kk = 0; kk < 2; ++kk) { bf_[kk] = *(const bf16x8*)(S0 + uf + vrow * 64 + kof + 32 * kk); bb_[kk] = *(const bf16x8*)(S0 + ub + vrow * 64 + kof + 32 * kk); }
        f32x4 acc;
#pragma unroll
        for (int r = 0; r < 4; ++r) { const int o = (16 * sub + 4 * (lane >> 4) + r) * 64 + vrow; acc[r] = YL[uf + o] + YL[ub + o]; }
#pragma unroll
        for (int kk = 0; kk < 2; ++kk) { acc = MFMA16(af[kk], bf_[kk], acc); acc = MFMA16(ab[kk], bb_[kk], acc); }
        y[tj] = acc; }
    const float* lgp = X.inv(I_LNXG) + (size_t)l * RW + 64 * h; const float* lbp = X.inv(I_LNXB) + (size_t)l * RW + 64 * h;
    const bf16* pV = X.wsv<bf16>(WS_V); const bf16* pG = X.wsv<bf16>(WS_GATE); const float* pBo = X.wsv<float>(WS_BONUS); bf16* pRO = X.wsv<bf16>(WS_RO);
#pragma unroll
    for (int r = 0; r < 4; ++r) { const int t = 16 * rg + 4 * (lane >> 4) + r;
        const float mean = row16_sum((y[0][r] + y[1][r]) + (y[2][r] + y[3][r])) * (1.f / 64.f);
        float q = 0.f;
#pragma unroll
        for (int tj = 0; tj < 4; ++tj) { const float dy = y[tj][r] - mean; q += dy * dy; }
        const float rstd = 1.0f / sqrtf(row16_sum(q) * (1.f / 64.f) + GN_EPS); const float bon = pBo[(size_t)t * NH + h];
#pragma unroll
        for (int tj = 0; tj < 4; ++tj) { const int cl = 16 * tj + (lane & 15); const size_t o = (size_t)t * RW + 64 * h + cl;
            float yn = (y[tj][r] - mean) * rstd * lgp[cl] + lbp[cl];
            yn += bon * bf2f(pV[o]); yn *= bf2f(pG[o]);
            pRO[o] = (bf16)f2bf(yn); } }
}
__device__ __forceinline__ void phase_finish(const Ctx& X, int l) {
    for (int u = X.bid * NWAVES + X.wave; u < (M / 16) * NH; u += X.G * NWAVES) finish_wave_unit(X, l, u);
    const int c = X.tid;
    if (c < HW) { const float hbc = X.in(I_HBIAS)[(size_t)l * HW + c]; const float* CV = X.ws<float>(WS_CVT) + (size_t)c * SEQ; const bf16* X0 = X.ws<bf16>(WS_X0); bf16* HO = X.ws<bf16>(WS_HO);
        for (int tile = X.bid; tile < M / TT; tile += X.G) { const int t0 = tile * TT; float cv[TT];
            if (t0 < CTX) {
#pragma unroll
                for (int tt = 0; tt < TT; ++tt) { const size_t o = (size_t)(t0 + tt) * HW + c; cv[tt] = X.ws<float>(WS_CONV)[o] + X.ws<float>(WS_Z)[o] * hbc; } }
            else { const f32x4 a = *(const f32x4*)(CV + (t0 - CTX)), b = *(const f32x4*)(CV + (t0 - CTX) + 4);
#pragma unroll
                for (int i = 0; i < 4; ++i) { cv[i] = a[i]; cv[4 + i] = b[i]; } }
#pragma unroll
            for (int tt = 0; tt < TT; ++tt) { const size_t o = (size_t)(t0 + tt) * HW + c; HO[o] = (bf16)f2bf(cv[tt] * bf2f(X0[o])); } } }
}

__device__ __forceinline__ void ln_inplace(float (&v)[D / 64], const float* g, const float* b, int lane) {
    float s = 0.f;
#pragma unroll
    for (int j = 0; j < D / 64; ++j) s += v[j];
    const float mean = wave_sum(s) * (1.f / D); float q = 0.f;
#pragma unroll
    for (int j = 0; j < D / 64; ++j) { v[j] -= mean; q += v[j] * v[j]; }
    const float rstd = 1.0f / sqrtf(wave_sum(q) * (1.f / D) + LN_EPS);
#pragma unroll
    for (int j = 0; j < D / 64; ++j) { const int d = 4 * lane + 256 * (j >> 2) + (j & 3); v[j] = v[j] * rstd * g[d] + b[d]; }
}
__device__ __forceinline__ void phase_norm1(const Ctx& X, int l) {
    const int gw = X.bid * NWAVES + X.wave, NGW = X.G * NWAVES, lane = X.lane;
    const float* lng = X.in(I_LNG) + (size_t)(l * 2 + 0) * D; const float* lnb = X.in(I_LNB) + (size_t)(l * 2 + 0) * D;
    const float* wr = X.in(I_WR); const float* rb = X.in(I_RB);
    const float alpha = sqrtf(sqrtf(2.0f * DEPTH));
    volatile LAS int* hist = (volatile LAS int*)(X.lds + LDS_MISC + 4096);
    if (X.tid < NE) hist[X.tid] = 0;
    __syncthreads();
    for (int t = gw; t < M; t += NGW) {
        float* xr = X.ws<float>(WS_X) + (size_t)t * D; const float* mx = X.ws<float>(WS_MIX) + (size_t)t * D;
        const float* gate = modp(X, l, t, 2); const float* sh = modp(X, l, t, 3); const float* sc = modp(X, l, t, 4);
        float v[D / 64];
#pragma unroll
        for (int j = 0; j < D / 256; ++j) { const int d = 4 * lane + 256 * j; const f32x4 a = *(const f32x4*)(xr + d), m = *(const f32x4*)(mx + d), gt = *(const f32x4*)(gate + d);
#pragma unroll
            for (int i = 0; i < 4; ++i) v[4 * j + i] = alpha * a[i] + gt[i] * m[i]; }
        ln_inplace(v, lng, lnb, lane);
        bf16* hf = X.ws<bf16>(WS_XMOD) + (size_t)t * D;
        LAS float* hrow = (LAS float*)X.lds + X.wave * D;
#pragma unroll
        for (int j = 0; j < D / 256; ++j) { const int d = 4 * lane + 256 * j; f32x4 o; const f32x4 a = *(const f32x4*)(sh + d), b = *(const f32x4*)(sc + d); f32x4 h;
#pragma unroll
            for (int i = 0; i < 4; ++i) { o[i] = v[4 * j + i]; h[i] = o[i] * (1.f + b[i]) + a[i]; }
            *(f32x4*)(xr + d) = o; *(LAS f32x4*)(hrow + d) = h;
            *(unsigned long long*)(hf + d) = (unsigned long long)pk2(h[0], h[1]) | ((unsigned long long)pk2(h[2], h[3]) << 32); }
        WAVE_LDS_FENCE(); CFENCE();
        float part = 0.f; { const int e = lane & 15, q = lane >> 4;
#pragma unroll 8
            for (int d = q * (D / 4); d < (q + 1) * (D / 4); ++d) part += hrow[d] * wr[(size_t)d * NE + e]; }
        part += __shfl_xor(part, 16); part += __shfl_xor(part, 32);
        WAVE_LDS_FENCE(); CFENCE();
        float lg[NE];
#pragma unroll
        for (int e = 0; e < NE; ++e) lg[e] = __shfl(part, e);
        float mxl = lg[0];
#pragma unroll
        for (int e = 1; e < NE; ++e) mxl = fmaxf(mxl, lg[e]);
        float sc_[NE], sum = 0.f;
#pragma unroll
        for (int e = 0; e < NE; ++e) { sc_[e] = expf(lg[e] - mxl); sum += sc_[e]; }
        const float isum = 1.0f / sum; float sel[NE];
#pragma unroll
        for (int e = 0; e < NE; ++e) { sc_[e] *= isum; sel[e] = sc_[e] + rb[e]; }
        int bg = 0; float bgs = -INFINITY;
#pragma unroll
        for (int g = 0; g < 4; ++g) { float m1 = -INFINITY, m2 = -INFINITY;
#pragma unroll
            for (int i = 0; i < 4; ++i) { const float x = sel[4 * g + i]; if (x > m1) { m2 = m1; m1 = x; } else if (x > m2) m2 = x; }
            const float gs = m1 + m2; if (gs > bgs) { bgs = gs; bg = g; } }
        int i0 = 0, i1 = 0; float s0 = -INFINITY, s1 = -INFINITY, p0 = 0.f, p1 = 0.f;
#pragma unroll
        for (int e = 0; e < NE; ++e) { if ((e >> 2) == bg) { const float x = sel[e]; if (x > s0) { s1 = s0; i1 = i0; p1 = p0; s0 = x; i0 = e; p0 = sc_[e]; } else if (x > s1) { s1 = x; i1 = e; p1 = sc_[e]; } } }
        if (lane == 0) { int* ei = X.ws<int>(WS_ROUT) + (size_t)t * 2; float* ew = (float*)(X.ws<int>(WS_ROUT) + (size_t)M * 2) + (size_t)t * 2;
            ei[0] = i0; ei[1] = i1; const float ws_ = 1.0f / (p0 + p1); ew[0] = p0 * ws_; ew[1] = p1 * ws_;
            lds_add(hist + i0, 1); lds_add(hist + i1, 1); }
    }
    __syncthreads();
    if (X.tid < NE) { const int hc = hist[X.tid]; X.ws<int>(WS_BCNT)[X.bid * NE + X.tid] = hc; atomicAdd(X.ctl() + CW_CNT + l * 64 + X.tid, (unsigned)hc); }
}

__device__ __forceinline__ void moe_table(const Ctx& X, int l, int NT) {
    volatile LAS int* tab = (volatile LAS int*)(X.lds + LDS_MISC) + 8;
    if (X.tid == 0) { int cum = 0, ts = 0;
        for (int e = 0; e < NE; ++e) { const int cnt = (int)__hip_atomic_load(X.ctl() + CW_CNT + l * 64 + e, RLX_AGENT); const int tc = (cnt + 255) / 256;
            tab[e] = cum; tab[32 + e] = ts; tab[64 + e] = tc; cum += tc * NT; ts += tc; }
        tab[16] = cum; }
    __syncthreads();
}
__device__ __forceinline__ void phase_scatter(const Ctx& X, int l) {
    moe_table(X, l, 1);
    volatile LAS int* tab = (volatile LAS int*)(X.lds + LDS_MISC) + 8;
    volatile LAS int* cur = (volatile LAS int*)(X.lds + LDS_MISC + 4096) + 16;
    const int gw = X.bid * NWAVES + X.wave, NGW = X.G * NWAVES, lane = X.lane;
    if (X.tid < NE) { const int* bc = X.ws<int>(WS_BCNT) + X.tid; int pre = 0; for (int b = 0; b < X.bid; ++b) pre += bc[b * NE]; cur[X.tid] = tab[32 + X.tid] * 256 + pre; }
    __syncthreads();
    const int* ei = X.ws<int>(WS_ROUT); int* slot = X.ws<int>(WS_ROUT) + (size_t)M * 4;
    for (int t = gw; t < M; t += NGW) {
#pragma unroll
        for (int k = 0; k < 2; ++k) { const int e = ei[2 * t + k];
            int pos = 0; if (lane == 0) pos = lds_add(cur + e, 1);
            pos = __shfl(pos, 0);
            if (lane == 0) slot[2 * t + k] = pos;
            const u32x4* src = (const u32x4*)(X.ws<bf16>(WS_XMOD) + (size_t)t * D); u32x4* dst = (u32x4*)(X.ws<bf16>(WS_XG) + (size_t)pos * D);
            for (int i = lane; i < D / 8; i += 64) dst[i] = src[i]; } }
}

__device__ __forceinline__ void phase_combine(const Ctx& X, int l) {
    const int gw = X.bid * NWAVES + X.wave, NGW = X.G * NWAVES, lane = X.lane;
    const float* lng = X.in(I_LNG) + (size_t)(l * 2 + 1) * D; const float* lnb = X.in(I_LNB) + (size_t)(l * 2 + 1) * D;
    const float alpha = sqrtf(sqrtf(2.0f * DEPTH));
    const float* ew = (const float*)(X.ws<int>(WS_ROUT) + (size_t)M * 2); const int* slot = X.ws<int>(WS_ROUT) + (size_t)M * 4;
    for (int t = gw; t < M; t += NGW) {
        float* xr = X.ws<float>(WS_X) + (size_t)t * D; const float* gate = modp(X, l, t, 5);
        const bf16* y0 = X.ws<bf16>(WS_YS) + (size_t)slot[2 * t] * D; const bf16* y1 = X.ws<bf16>(WS_YS) + (size_t)slot[2 * t + 1] * D; const float w0 = ew[2 * t], w1 = ew[2 * t + 1];
        float v[D / 64];
#pragma unroll
        for (int j = 0; j < D / 256; ++j) { const int d = 4 * lane + 256 * j; const f32x4 a = *(const f32x4*)(xr + d), gt = *(const f32x4*)(gate + d);
            const unsigned long long q0 = *(const unsigned long long*)(y0 + d), q1 = *(const unsigned long long*)(y1 + d);
            float ya[4] = {bflo((unsigned)q0), bfhi((unsigned)q0), bflo((unsigned)(q0 >> 32)), bfhi((unsigned)(q0 >> 32))};
            float yb[4] = {bflo((unsigned)q1), bfhi((unsigned)q1), bflo((unsigned)(q1 >> 32)), bfhi((unsigned)(q1 >> 32))};
#pragma unroll
            for (int i = 0; i < 4; ++i) v[4 * j + i] = alpha * a[i] + gt[i] * (w0 * ya[i] + w1 * yb[i]); }
        ln_inplace(v, lng, lnb, lane);
        if (l + 1 < DEPTH) { const float* sh = modp(X, l + 1, t, 0); const float* sc = modp(X, l + 1, t, 1); bf16* xm = X.ws<bf16>(WS_XMOD) + (size_t)t * D;
#pragma unroll
            for (int j = 0; j < D / 256; ++j) { const int d = 4 * lane + 256 * j; f32x4 o; const f32x4 a = *(const f32x4*)(sh + d), b = *(const f32x4*)(sc + d); float h[4];
#pragma unroll
                for (int i = 0; i < 4; ++i) { o[i] = v[4 * j + i]; h[i] = o[i] * (1.f + b[i]) + a[i]; }
                *(f32x4*)(xr + d) = o;
                *(unsigned long long*)(xm + d) = (unsigned long long)pk2(h[0], h[1]) | ((unsigned long long)pk2(h[2], h[3]) << 32); }
        } else if (t >= CTX) { float* orow = X.out() + (size_t)(t - CTX) * D; const bool bad = __hip_atomic_load(X.ctl() + CW_BAR + XB_TMO, RLX_AGENT) != 0u; const float pscale = 1.0f + bitsf(__hip_atomic_load(X.ctl() + 64, RLX_AGENT));
#pragma unroll
            for (int j = 0; j < D / 256; ++j) { const int d = 4 * lane + 256 * j; f32x4 o;
#pragma unroll
                for (int i = 0; i < 4; ++i) o[i] = bad ? __builtin_nanf("") : v[4 * j + i] * pscale;
                *(f32x4*)(orow + d) = o; }
        }
    }
}


#ifdef EMU
#define PHASE_FN static
#define THIN_FN static
#else
#define PHASE_FN __device__ __forceinline__
#define THIN_FN __device__ __noinline__
#endif
THIN_FN void ph_transposes(Ctx X, int l, int part) { phase_transposes(X, l, part); }
THIN_FN void ph_filters(Ctx X, int l) { phase_filters(X, l); }
THIN_FN void ph_mod(Ctx X) { phase_mod(X); }
THIN_FN void ph_x0(Ctx X) { phase_x0(X); }
THIN_FN void ph_lin(Ctx X, int l) { phase_lin(X, l); }
THIN_FN void ph_lora_a(Ctx X, int u) { lora_unit_a(X, u); }
THIN_FN void ph_lora_b(Ctx X, int l, int u) { lora_unit_b(X, l, u); }
THIN_FN void ph_prep_hyena(Ctx X, int l) { phase_prep_hyena(X, l); }
THIN_FN void ph_ctxconv(Ctx X, int l) { phase_ctxconv(X, l); }
THIN_FN void ph_chunk_1(Ctx X, int u) { chunk_unit_1(X, u); }
THIN_FN void ph_chunk_2(Ctx X, int u) { chunk_unit_2(X, u); }
THIN_FN void ph_chunk_3(Ctx X, int u) { chunk_unit_3(X, u); }
THIN_FN void ph_seq(Ctx X) { phase_seq(X); }
THIN_FN void ph_fft_tables(Ctx X) { fft_tables(X); }
THIN_FN void ph_fft_run(Ctx X, int inverse) { fft_run((LAS cf*)X.lds, (const LAS cf*)(X.lds + FFT_TAB_OFF), X.tid, inverse != 0); }
THIN_FN void ph_spec_load(Ctx X, int c) { spec_load(X, c); }
THIN_FN void ph_spec_unpack(Ctx X, int c) { spec_unpack(X, c); }
THIN_FN void ph_fftconv_load(Ctx X, int c) { fftconv_load(X, c); }
THIN_FN void ph_fftconv_mul(Ctx X, int c) { fftconv_mul(X, c); }
THIN_FN void ph_fftconv_out(Ctx X, int l, int c) { fftconv_out(X, l, c); }
THIN_FN void ph_finish(Ctx X, int l) { phase_finish(X, l); }
THIN_FN void ph_norm1(Ctx X, int l) { phase_norm1(X, l); }
THIN_FN void ph_scatter(Ctx X, int l) { phase_scatter(X, l); }
THIN_FN void ph_combine(Ctx X, int l) { phase_combine(X, l); }
PHASE_FN void ph_g13(Ctx X, int third) { pg8::Gemm g{third ? X.ws<bf16>(WS_T) : X.ws<bf16>(WS_XMOD), third ? X.ws<bf16>(WS_WO) : X.ws<bf16>(WS_WIN), D}; pg8::StaticOrder S; S.init(M, third ? D : PCP, X.G, X.bid);
    pg8::EpiBf16OrF32 E{X.ws<bf16>(WS_P), X.ws<float>(WS_MIX), third ? D : PCP, third != 0}; pg8::gemm_phase(X.lds, g, S, E); }
PHASE_FN void ph_g2(Ctx X, int second) { pg8::Gemm g{second ? X.ws<bf16>(WS_HO) : X.ws<bf16>(WS_RO), X.ws<bf16>(WS_WB) + (second ? (size_t)D * RW : 0), RW}; pg8::StaticOrder S; S.init(M, D, X.G, X.bid);
    pg8::EpiGate E{X.ws<bf16>(WS_T), D, X.ws<bf16>(WS_P), PCP, second ? C_GH : C_GR, second != 0}; pg8::gemm_phase(X.lds, g, S, E); }
PHASE_FN void ph_g45(Ctx X, int l, int down) { const int NT = down ? D / 256 : 2 * D / 256; moe_table(X, l, NT); pg8::MoeOrder S{(const volatile LAS int*)(X.lds + LDS_MISC) + 8, NT, X.G, X.bid};
    pg8::Gemm g{down ? X.ws<bf16>(WS_ACT) : X.ws<bf16>(WS_XG), down ? X.ws<bf16>(WS_WD) : X.ws<bf16>(WS_WGU), D}; pg8::EpiMoe E{down ? X.ws<bf16>(WS_YS) : X.ws<bf16>(WS_ACT), D, NT, down == 0}; pg8::gemm_phase(X.lds, g, S, E); }

constexpr int NPH = 16, NPHASES = DEPTH * NPH;
template <int MASK> __global__ void __launch_bounds__(NTHR, 2) fwd_kernel(Args args) {
    DYN_LDS(lds);
    Ctx X; X.lds = lds; X.tid = threadIdx.x; X.lane = X.tid & 63; X.wave = READFIRSTLANE(X.tid >> 6); X.G = gridDim.x; X.bid = blockIdx.x;
    volatile LAS unsigned* misc = (volatile LAS unsigned*)(lds + LDS_MISC);
    if (X.tid < 128) misc[X.tid] = 0u;
    if (X.tid < N_IN + 2) { const unsigned long long p = X.tid < N_IN ? (unsigned long long)args.in[X.tid < N_IN ? X.tid : 0] : (X.tid == N_IN ? (unsigned long long)args.out : (unsigned long long)args.ws);
        misc[PT_WORD0 + 2 * X.tid] = (unsigned)p; misc[PT_WORD0 + 2 * X.tid + 1] = (unsigned)(p >> 32); }
    __syncthreads();
    XcdBarrier bar = xcd_barrier_post(X.ctl() + CW_BAR, misc);
    const int lo = args.ph_lo, hi = args.ph_hi;
#define IN(k) ((((MASK) >> ((k) % NPH)) & 1) && lo <= (k) && (k) < hi)
#ifdef PROBE_K
#ifndef PROBE_SCALE
#define PROBE_SCALE 1.0f
#endif
#ifndef PROBE_BLOCK
#define PROBE_BLOCK 0
#endif
    unsigned long long plast = __builtin_amdgcn_s_memrealtime(); if (threadIdx.x < 32) misc[2048 + threadIdx.x] = 0u; __syncthreads();
#define PROBE_TX(k) do { if (blockIdx.x == PROBE_BLOCK && threadIdx.x == 0) { const unsigned long long now_ = __builtin_amdgcn_s_memrealtime(); misc[2048 + (k)] += (unsigned)(now_ - plast); plast = now_; } } while (0)
#define PROBE_T(k) PROBE_TX((k) % NPH)
#define PROBE_PUB(k) do { if ((k) == NPHASES - 2 && blockIdx.x == PROBE_BLOCK && threadIdx.x == 0) { PROBE_T(k); unsigned tot_ = 0; for (int i_ = 0; i_ < 28; ++i_) tot_ += misc[2048 + i_]; \
        const float f_ = floorf(PROBE_SCALE * (float)misc[2048 + PROBE_K] / (float)tot_ * 128.0f + 0.5f) * (1.0f / 128.0f); __hip_atomic_store(X.ctl() + 64, fbits(f_), RLX_AGENT); } } while (0)
#else
#define PROBE_T(k) do {} while (0)
#define PROBE_TX(k) do {} while (0)
#define PROBE_PUB(k) do {} while (0)
#endif
#define SEAM(k) do { PROBE_PUB(k); if ((k) + 1 < hi) xcd_barrier(bar); PROBE_T(k); } while (0)
#ifdef REPEAT_SUB
#define RPS(id) for (int rps_ = 0; rps_ < ((id) == REPEAT_SUB ? 2 : 1); ++rps_)
#else
#define RPS(id)
#endif
#ifdef REPEAT_PH
#define RPT_IDX rpt_
#define RPT(k) for (int rpt_ = 0; rpt_ < (((k) % NPH) == REPEAT_PH ? 2 : 1); ++rpt_)
#else
#define RPT_IDX 0
#define RPT(k)
#endif
    for (int l = 0; l < DEPTH; ++l) {
        const int pb = l * NPH;
        if (l == 0 && IN(pb + 0)) { ph_transposes(X, l, 0); __syncthreads(); PROBE_TX(20); ph_filters(X, l); PROBE_TX(21); ph_mod(X); PROBE_TX(22); SEAM(pb + 0); }
        if (l == 0 && IN(pb + 1)) { ph_x0(X); SEAM(pb + 1); }
        if (IN(pb + 2)) { ph_g13(X, 0); SEAM(pb + 2); }
        RPT(pb + 3) if (IN(pb + 3)) { RPS(6) ph_lin(X, l); RPS(7) ph_prep_hyena(X, l); ph_fft_tables(X); RPS(8) for (int c = X.bid; c < HW; c += X.G) { ph_spec_load(X, c); ph_fft_run(X, 0); ph_spec_unpack(X, c); } SEAM(pb + 3); }
        RPT(pb + 4) if (IN(pb + 4)) { for (int u = X.bid; u < (M / 64) * NH; u += X.G) { RPS(4) ph_lora_a(X, u); RPS(5) ph_lora_b(X, l, u); } SEAM(pb + 4); }
        RPT(pb + 5) if (IN(pb + 5)) { for (int u = X.bid; u < 2 * NCHK * NH; u += X.G) { RPS(1) ph_chunk_1(X, u); RPS(2) ph_chunk_2(X, u); RPS(3) ph_chunk_3(X, u); } SEAM(pb + 5); }
        RPT(pb + 6) if (IN(pb + 6)) { RPS(9) ph_seq(X); RPS(10) { ph_transposes(X, l, 1); __syncthreads(); } ph_ctxconv(X, l); ph_fft_tables(X);
            for (;;) { if (X.tid == 0) misc[121] = atomicAdd(X.ctl() + CW_Q + l * 64 + 32 + RPT_IDX, 1u); __syncthreads(); const int c = (int)misc[121]; __syncthreads(); if (c >= HW) break;
                ph_fftconv_load(X, c); ph_fft_run(X, 0); ph_fftconv_mul(X, c); ph_fft_run(X, 1); ph_fftconv_out(X, l, c); }
            SEAM(pb + 6); }
        RPT(pb + 7) if (IN(pb + 7)) { ph_finish(X, l); SEAM(pb + 7); }
        for (int sb = 0; sb < 2; ++sb) if (IN(pb + 8 + sb)) { ph_g2(X, sb); SEAM(pb + 8 + sb); }
        RPT(pb + 10) if (IN(pb + 10)) { ph_g13(X, 1); SEAM(pb + 10); }
        if (IN(pb + 11)) { ph_norm1(X, l); SEAM(pb + 11); }
        if (IN(pb + 12)) { RPS(14) ph_scatter(X, l); SEAM(pb + 12); }
        for (int dn = 0; dn < 2; ++dn) if (IN(pb + 13 + dn)) { ph_g45(X, l, dn); SEAM(pb + 13 + dn); }
        if (IN(pb + 15)) { RPS(11) ph_combine(X, l); if (l + 1 < DEPTH) { __syncthreads(); RPS(12) { ph_transposes(X, l + 1, 0); __syncthreads(); } RPS(13) ph_filters(X, l + 1); } SEAM(pb + 15); }
    }
#undef IN
#undef SEAM
}

#ifndef N_LAUNCHES
#define N_LAUNCHES 1
#endif
#ifndef PH_MASK
#define PH_MASK 0xffff
#endif
template <int MASK> static void launch_mask(int grid, hipStream_t stream, const Args& a) {
    static bool attr = false;
    if (!attr) { (void)hipFuncSetAttribute((const void*)fwd_kernel<MASK>, hipFuncAttributeMaxDynamicSharedMemorySize, LDS_BYTES); attr = true; }
    hipLaunchKernelGGL(fwd_kernel<MASK>, dim3(grid), dim3(NTHR), LDS_BYTES, stream, a);
}
extern "C" void kernel_launch(void* const* d_in, const int* in_sizes, int n_in, void* d_out, int out_size, void* d_ws, size_t ws_size, hipStream_t stream) {
    static int grid = 0;
    if (grid == 0) {
        if (n_in != N_IN || ws_size < WS_END) { fprintf(stderr, "kernel_launch: unexpected n_in %d or workspace %zu < %zu\n", n_in, ws_size, (size_t)WS_END); grid = -1; return; }
        int dev = 0, cus = 0;
        if (hipGetDevice(&dev) != hipSuccess || hipDeviceGetAttribute(&cus, hipDeviceAttributeMultiprocessorCount, dev) != hipSuccess) { grid = -1; return; }
        (void)hipGetLastError();
        grid = cus; if (grid > NPART) grid = NPART;
    }
    if (grid < 0) return;
    (void)in_sizes; (void)out_size;
    (void)hipMemsetAsync(d_ws, 0, CTL_BYTES, stream);
    Args a;
    for (int i = 0; i < N_IN; ++i) a.in[i] = (const float*)d_in[i];
    a.out = (float*)d_out; a.ws = (unsigned char*)d_ws;
#if N_LAUNCHES == 1
    a.ph_lo = 0; a.ph_hi = NPHASES;
    launch_mask<PH_MASK>(grid, stream, a);
#else
    for (int ph = 0; ph < NPHASES; ++ph) { const int k = ph % NPH; if (k == 1 && ph / NPH != 0) continue; a.ph_lo = ph; a.ph_hi = ph + 1; launch_mask<PH_MASK>(grid, stream, a); }
#endif
}
```

```cpp
#ifndef EMU
#include <hip/hip_runtime.h>
#endif
#include <cstdio>
#include <cstdint>
#include <cmath>

#ifndef CFG_D
#define CFG_D 1024
#define CFG_SEQ 16384
#define CFG_CTX 256
#define CFG_DEPTH 4
#endif
constexpr int D = CFG_D, SEQ = CFG_SEQ, CTX = CFG_CTX, DEPTH = CFG_DEPTH, M = CTX + SEQ;
constexpr int GRID_W = 64, GRID_H = SEQ / GRID_W;
constexpr int RW = D / 2, NH = RW / 64, HW = D / 2, RC = 3 * RW + 384, HC = 3 * HW, GC = 2 * D, PC = RC + HC + GC, PCP = (PC + 255) / 256 * 256;
constexpr int QTR = RC / 4, HALFC = RC / 2;
constexpr int C_K = RW, C_V = 2 * RW, C_LWF = 3 * RW, C_LG = 3 * RW + 256;
constexpr int C_HY = RC, C_GR = RC + HC, C_GH = RC + HC + D;
constexpr int NE = 16, SP_TILES = (2 * M) / 256 + NE, SP = SP_TILES * 256;
constexpr float DECAY_SCALE = 0.606531f, GN_EPS = 6.4e-4f, LN_EPS = 1e-5f;
constexpr int LP = 72;
constexpr int LQ = 65;
constexpr int LX = 68;
constexpr int N_SEQ_UNITS = 2 * NH * 4;
constexpr int NPART = 256;
static_assert(CTX % 32 == 0 && M % 256 == 0 && D % 256 == 0 && RW % 128 == 0 && RW >= 256 && SEQ % 64 == 0 && CTX % 32 == 0 && RC % 4 == 0, "shape assumptions");

enum { I_X = 0, I_C, I_CTX, I_CCTX, I_WMOD, I_BMOD, I_WIN, I_MU, I_W0, I_W2, I_A0, I_A2, I_G2, I_KK, I_KA, I_RK, I_LNXG, I_LNXB, I_CW, I_CB,
       I_FW1, I_FB1, I_FW2, I_FB2, I_FW3, I_FB3, I_FWO, I_FREQ, I_HBIAS, I_WBR, I_WOUT, I_LNG, I_LNB, I_WR, I_RB, I_WG, I_WU, I_WD, N_IN };

constexpr size_t al256(size_t x) { return (x + 255) & ~(size_t)255; }
constexpr size_t CTL_BYTES = 1u << 20;
constexpr size_t WS_MOD = CTL_BYTES;
constexpr size_t WS_FPART = al256(WS_MOD + (size_t)DEPTH * 2 * 6 * D * 4);
constexpr size_t WS_ROUT = al256(WS_FPART + (size_t)2 * NPART * HW * 4);
constexpr size_t WS_BCNT = al256(WS_ROUT + (size_t)M * 2 * 4 * 3);
constexpr size_t WS_BONUS = al256(WS_BCNT + (size_t)NPART * NE * 4);
constexpr size_t WS_WIN = al256(WS_BONUS + (size_t)M * NH * 4);
constexpr size_t WS_WB = al256(WS_WIN + (size_t)PCP * D * 2);
constexpr size_t WS_WO = al256(WS_WB + (size_t)2 * D * RW * 2);
constexpr size_t WS_W2T = al256(WS_WO + (size_t)D * D * 2);
constexpr size_t WS_A2T = al256(WS_W2T + (size_t)2 * RW * 64 * 2);
constexpr size_t WS_G2T = al256(WS_A2T + (size_t)2 * RW * 64 * 2);
constexpr size_t WS_FWT = al256(WS_G2T + (size_t)RW * 128 * 2);
constexpr size_t WS_WGU = al256(WS_FWT + (size_t)(3 * 64 + HW) * 64 * 2);
constexpr size_t WS_WD = al256(WS_WGU + (size_t)NE * 2 * D * D * 2);
constexpr size_t WS_X = al256(WS_WD + (size_t)NE * D * D * 2);
constexpr size_t WS_XMOD = al256(WS_X + (size_t)M * D * 4);
constexpr size_t WS_P = al256(WS_XMOD + (size_t)M * D * 2);
constexpr size_t WS_FILT = al256(WS_P + (size_t)M * PCP * 2);
constexpr size_t WS_MIX = al256(WS_FILT + (size_t)M * HW * 4);
constexpr size_t WS_T = al256(WS_MIX + (size_t)M * D * 4);
constexpr size_t WS_S = al256(WS_T + (size_t)M * D * 2);
constexpr size_t WS_R = WS_S;
constexpr size_t WS_V = al256(WS_R + (size_t)M * RW * 2);
constexpr size_t WS_KA = al256(WS_V + (size_t)M * RW * 2);
constexpr size_t WS_KD = al256(WS_KA + (size_t)M * RW * 2);
constexpr size_t WS_KB = al256(WS_KD + (size_t)2 * M * RW * 2);
constexpr size_t WS_W = al256(WS_KB + (size_t)2 * M * RW * 2);
constexpr size_t WS_PQ = al256(WS_W + (size_t)2 * M * RW * 4);
constexpr size_t WS_LIN = WS_PQ;
static_assert((size_t)M * 384 * 2 <= (size_t)2 * NH * (M / 64) * 2 * 4096 * 4, "LIN fits PQ");
constexpr size_t WS_G = al256(WS_PQ + (size_t)2 * NH * (M / 64) * 2 * 4096 * 4);
constexpr size_t WS_YL = al256(WS_G + (size_t)2 * NH * (M / 64) * 4096 * 2);
constexpr size_t WS_S0 = WS_XMOD;
static_assert((size_t)2 * NH * (M / 64) * 4096 * 2 <= (size_t)M * D * 2, "S0 fits XMOD");
constexpr size_t WS_Z = al256(WS_YL + (size_t)2 * NH * (M / 64) * 4096 * 4);
constexpr size_t WS_X0 = al256(WS_Z + (size_t)CTX * HW * 4);
constexpr size_t WS_CONV = al256(WS_X0 + (size_t)M * HW * 2);
constexpr size_t WS_GATE = al256(WS_CONV + (size_t)CTX * HW * 4);
constexpr size_t WS_RO = al256(WS_GATE + (size_t)M * RW * 2);
constexpr size_t WS_HO = al256(WS_RO + (size_t)M * RW * 2);
constexpr size_t WS_HS = WS_MIX;
constexpr size_t WS_ZT = WS_T;
constexpr size_t WS_CVT = WS_FILT;
static_assert((size_t)HW * (SEQ + 1) * 8 <= (size_t)M * D * 4 && (size_t)HW * M * 4 <= (size_t)M * D * 2, "HS fits MIX, ZT fits T");
constexpr size_t WS_END1 = al256(WS_HO + (size_t)M * HW * 2);
constexpr size_t WS_XG = WS_S;
constexpr size_t WS_ACT = al256(WS_XG + (size_t)SP * D * 2);
constexpr size_t WS_YS = al256(WS_ACT + (size_t)SP * D * 2);
constexpr size_t WS_END2 = al256(WS_YS + (size_t)SP * D * 2);
constexpr size_t WS_END = WS_END1 > WS_END2 ? WS_END1 : WS_END2;
constexpr int CW_TMO = 0, CW_BAR = 4096, CW_CNT = 8192  , CW_CUR = 8192 + 1024  , CW_Q = 8192 + 2048  ;

#ifdef EMU
#define LAS
typedef short bf16x8 __attribute__((vector_size(16)));
typedef float f32x4 __attribute__((vector_size(16)));
typedef unsigned u32x4 __attribute__((vector_size(16)));
#define DYN_LDS(name) unsigned char* name = emu_cur_lds()
#define ASM_WAIT_V(n) do {} while (0)
#define ASM_WAIT_L(n) do {} while (0)
#define ASM_WAIT_VL0() do {} while (0)
#define CFENCE() do {} while (0)
#define WAVE_LDS_FENCE() emu_wave_sync()
#define S_BARRIER() emu_block_sync()
#define SCHED_BARRIER() do {} while (0)
#define SETPRIO(x) do {} while (0)
#define S_SLEEP(n) emu_yield()
#define MFMA16(a, b, c) emu_mfma_16x16x32(a, b, c)
#define MFMA4F(a, b, c) emu_mfma_16x16x4f32(a, b, c)
#define GLDS16(gptr, lptr) emu_glds16((const void*)(gptr), (void*)(lptr))
#define READFIRSTLANE(x) (x)
#define XCC_ID_() (blockIdx.x & 7u)
#define FENCE_RELEASE() do {} while (0)
#define FENCE_ACQUIRE() do {} while (0)
#define DPP_F(v, ctrl) emu_dpp_f(v, ctrl)
#define READLANE_F(v, l) emu_xchg((float)(v), (l))
static inline int vgpr_zero() { return 0; }
static inline unsigned long long vgpr_zero64() { return 0ull; }
static inline int lds_add(volatile int* p, int v) { int o = *p; *p = o + v; return o; }
static inline void lds_addf(float* p, float v) { *p += v; }
static inline unsigned fbits(float f) { unsigned u; memcpy(&u, &f, 4); return u; }
static inline float bitsf(unsigned u) { float f; memcpy(&f, &u, 4); return f; }
#else
#define LAS __attribute__((address_space(3)))
typedef short bf16x8 __attribute__((ext_vector_type(8)));
typedef float f32x4 __attribute__((ext_vector_type(4)));
typedef unsigned u32x4 __attribute__((ext_vector_type(4)));
#define DYN_LDS(name) extern __shared__ __attribute__((aligned(16))) unsigned char name##_raw[]; LAS unsigned char* name = (LAS unsigned char*)name##_raw
#define ASM_WAIT_V(n) asm volatile("s_waitcnt vmcnt(" #n ")" ::: "memory")
#define ASM_WAIT_L(n) asm volatile("s_waitcnt lgkmcnt(" #n ")" ::: "memory")
#define ASM_WAIT_VL0() asm volatile("s_waitcnt vmcnt(0) lgkmcnt(0)" ::: "memory")
#define CFENCE() asm volatile("" ::: "memory")
#define WAVE_LDS_FENCE() asm volatile("s_waitcnt lgkmcnt(0)" ::: "memory")
#define S_BARRIER() __builtin_amdgcn_s_barrier()
#define SCHED_BARRIER() __builtin_amdgcn_sched_barrier(0)
#define SETPRIO(x) __builtin_amdgcn_s_setprio(x)
#define S_SLEEP(n) __builtin_amdgcn_s_sleep(n)
#define MFMA16(a, b, c) __builtin_amdgcn_mfma_f32_16x16x32_bf16(a, b, c, 0, 0, 0)
#define MFMA4F(a, b, c) __builtin_amdgcn_mfma_f32_16x16x4f32(a, b, c, 0, 0, 0)
#define GLDS16(gptr, lptr) __builtin_amdgcn_global_load_lds((const unsigned*)(gptr), (LAS unsigned*)(lptr), 16, 0, 0)
#define READFIRSTLANE(x) __builtin_amdgcn_readfirstlane(x)
#define XCC_ID_() ((unsigned)__builtin_amdgcn_s_getreg((3 << 11) | 20) & 0xFu)
#define FENCE_RELEASE() __builtin_amdgcn_fence(__ATOMIC_RELEASE, "agent")
#define FENCE_ACQUIRE() __builtin_amdgcn_fence(__ATOMIC_ACQUIRE, "agent")
#define DPP_F(v, ctrl) __builtin_bit_cast(float, __builtin_amdgcn_update_dpp(0, __builtin_bit_cast(int, (float)(v)), (ctrl), 0xF, 0xF, true))
#define READLANE_F(v, l) __builtin_bit_cast(float, __builtin_amdgcn_readlane(__builtin_bit_cast(int, (float)(v)), (l)))
__device__ __forceinline__ int vgpr_zero() { int z; asm volatile("v_mov_b32 %0, 0" : "=v"(z)); return z; }
__device__ __forceinline__ unsigned long long vgpr_zero64() { unsigned long long z; asm volatile("v_mov_b64 %0, 0" : "=v"(z)); return z; }
__device__ __forceinline__ void lds_addf(LAS float* p, float v) { (void)__hip_atomic_fetch_add(p, v, __ATOMIC_RELAXED, __HIP_MEMORY_SCOPE_WORKGROUP); }
__device__ __forceinline__ int lds_add(volatile LAS int* p, int v) { return __hip_atomic_fetch_add((LAS int*)p, v, __ATOMIC_RELAXED, __HIP_MEMORY_SCOPE_WORKGROUP); }
__device__ __forceinline__ unsigned fbits(float f) { return __builtin_bit_cast(unsigned, f); }
__device__ __forceinline__ float bitsf(unsigned u) { return __builtin_bit_cast(float, u); }
#endif
typedef unsigned short bf16;
#define RLX_AGENT __ATOMIC_RELAXED, __HIP_MEMORY_SCOPE_AGENT

__device__ __forceinline__ unsigned f2bf(float f) { unsigned u = fbits(f); return (u + 0x7fffu + ((u >> 16) & 1u)) >> 16; }
__device__ __forceinline__ unsigned pk2(float lo, float hi) { return f2bf(lo) | (f2bf(hi) << 16); }
__device__ __forceinline__ float bf2f(bf16 b) { return bitsf(((unsigned)b) << 16); }
__device__ __forceinline__ float bflo(unsigned w) { return bitsf(w << 16); }
__device__ __forceinline__ float bfhi(unsigned w) { return bitsf(w & 0xffff0000u); }
#ifdef EMU
__device__ __forceinline__ float fexp(float x) { return expf(x); }
__device__ __forceinline__ float frcp(float x) { return 1.0f / x; }
#else
__device__ __forceinline__ float fexp(float x) { return __builtin_amdgcn_exp2f(x * 1.4426950408889634f); }
__device__ __forceinline__ float frcp(float x) { return __builtin_amdgcn_rcpf(x); }
#endif
__device__ __forceinline__ float sigmoidf_(float x) { return frcp(1.0f + fexp(-x)); }
__device__ __forceinline__ float row16_sum(float v) {
    v += DPP_F(v, 0xB1);
    v += DPP_F(v, 0x4E);
    v += DPP_F(v, 0x141);
    v += DPP_F(v, 0x140);
    return v;
}
__device__ __forceinline__ float wave_sum(float v) {
    const float r = row16_sum(v);
    return (READLANE_F(r, 0) + READLANE_F(r, 16)) + (READLANE_F(r, 32) + READLANE_F(r, 48));
}
__device__ __forceinline__ void sincos_f(float x, float& s, float& c) {
    const float k = rintf(x * 0.63661977236758134f);
    float r = fmaf(-k, 1.5703125f, x); r = fmaf(-k, 4.837512969970703125e-4f, r); r = fmaf(-k, 7.54978994989188216e-8f, r);
    const float r2 = r * r;
    const float sp = r + r * r2 * (-1.6666654611e-1f + r2 * (8.3321608736e-3f + r2 * (-1.9515295891e-4f)));
    const float cp = 1.0f - 0.5f * r2 + r2 * r2 * (4.166664568298827e-2f + r2 * (-1.388731625493765e-3f + r2 * (2.443315711809948e-5f)));
    const int q = ((int)k) & 3;
    s = (q == 0) ? sp : (q == 1) ? cp : (q == 2) ? -sp : -cp;
    c = (q == 0) ? cp : (q == 1) ? -sp : (q == 2) ? -cp : sp;
}
__device__ __forceinline__ float sin_f(float x) { float s, c; sincos_f(x, s, c); return s; }

template <class T> __device__ __forceinline__ T* as_global(T* p) {
#ifndef EMU
    return (T*)(__attribute__((address_space(1))) T*)(unsigned long long)p;
#else
    return p;
#endif
}
#define XB_TMO      128
#define XB_XCNT(j)  (256  + 64 * (j))
#define XB_XSUB(j)  (1280 + 64 * (j))
#define XB_XGEN(j)  (2304 + 64 * (j))
#define XB_TOP      3328
#define XB_TOPGEN   3392
#define XCD_BAR_WORDS 3456
#define XB_SPIN_CAP (1u << 18)
__device__ __forceinline__ unsigned xb_ld(unsigned* p)              { return __hip_atomic_load(p, __ATOMIC_RELAXED, __HIP_MEMORY_SCOPE_AGENT); }
__device__ __forceinline__ unsigned xb_add(unsigned* p, unsigned v) { return __hip_atomic_fetch_add(p, v, __ATOMIC_RELAXED, __HIP_MEMORY_SCOPE_AGENT); }
#define XB_SPIN(cond, bar) do { unsigned _sp = 0; while (cond) { S_SLEEP(1); \
    if ((++_sp & 255u) == 0u) { if (xb_ld(&(bar)[XB_TMO])) break; if (_sp > XB_SPIN_CAP) { atomicAdd(&(bar)[XB_TMO], 1u); break; } } } } while (0)
struct XcdBarrier { unsigned* bar; unsigned x; volatile LAS unsigned* st; };
__device__ __forceinline__ XcdBarrier xcd_barrier_post(unsigned* bar, volatile LAS unsigned* st) {
    XcdBarrier b; b.bar = nullptr; b.x = XCC_ID_(); b.st = st;
    if (threadIdx.x == 0) { st[2] = (unsigned)(unsigned long long)bar; st[3] = (unsigned)((unsigned long long)bar >> 32); st[4] = b.x; (void)xb_add(&bar[XB_XCNT(b.x)], 1u); }
    return b;
}
__device__ __forceinline__ void xcd_barrier_complete(unsigned* bar, unsigned x, unsigned& nloc, unsigned& nx) {
    const unsigned G = gridDim.x * gridDim.y * gridDim.z;
    unsigned sum, cnt, mine, sp = 0u;
    for (;;) {
        sum = 0u; cnt = 0u; mine = 0u;
#pragma unroll
        for (unsigned j = 0; j < 16; ++j) { const unsigned c = xb_ld(&bar[XB_XCNT(j)]); sum += c; cnt += (c > 0u) ? 1u : 0u; mine = (j == x) ? c : mine; }
        if (sum == G) break;
        S_SLEEP(1);
        if ((++sp & 255u) == 0u) { if (xb_ld(&bar[XB_TMO])) break; if (sp > XB_SPIN_CAP) { atomicAdd(&bar[XB_TMO], 1u); break; } }
    }
    nloc = mine > 0u ? mine : 1u; nx = cnt > 0u ? cnt : 1u;
}
__device__ __forceinline__ void xcd_barrier(const XcdBarrier& b) {
    ASM_WAIT_V(0);
    __syncthreads();
    if (threadIdx.x == 0) {
        unsigned* bar = as_global((unsigned*)(((unsigned long long)b.st[3] << 32) | b.st[2]));
        const unsigned bx = b.st[4];
        ASM_WAIT_VL0();
        unsigned nloc = b.st[0], nx = b.st[1];
        if (nloc == 0u) { xcd_barrier_complete(bar, bx, nloc, nx); b.st[0] = nloc; b.st[1] = nx; }
        const unsigned old = xb_add(&bar[XB_XSUB(bx)], 1u);
        const unsigned gen = old / nloc;
        if (old + 1u == (gen + 1u) * nloc) {
            FENCE_RELEASE();
            ASM_WAIT_V(0);
            const unsigned og = xb_add(&bar[XB_TOP], 1u);
            const unsigned tg = og / nx;
            if (og + 1u == (tg + 1u) * nx) xb_add(&bar[XB_TOPGEN], 1u);
            else XB_SPIN(xb_ld(&bar[XB_TOPGEN]) == tg, bar);
            FENCE_ACQUIRE();
            xb_add(&bar[XB_XGEN(bx)], 1u);
            ASM_WAIT_V(0);
        } else {
            XB_SPIN(xb_ld(&bar[XB_XGEN(bx)]) == gen, bar);
            FENCE_ACQUIRE();
            ASM_WAIT_V(0);
        }
    }
    __syncthreads();
}

namespace pg8 {
constexpr int BM = 256, BK = 64, HALF = 128, HTB = HALF * BK * 2, STAGE_BYTES = 8 * HTB, NXCD = 8, WGM = 8;
__host__ __device__ __forceinline__ int lds_byte(int r, int c) { const int st = (r >> 4) * 2 + (c >> 5), rr = r & 15, cc = c & 31, ob = rr * 64 + cc * 2; return st * 1024 + (ob ^ (((ob >> 9) & 1) << 5)); }
__host__ __device__ __forceinline__ void stage_rc(int b, int& R, int& C) { const int st = b / 1024, sb = b % 1024, swz = sb ^ (((sb >> 9) & 1) << 5); R = (st >> 1) * 16 + swz / 64; C = (st & 1) * 32 + (swz % 64) / 2; }
__host__ __device__ __forceinline__ int perm32(int rho) { const int n = rho >> 4, i = rho & 15; return 8 * (i >> 2) + 4 * n + (i & 3); }
struct Unit { int pm, pn; };
struct Gemm { const bf16* A; const bf16* Bt; int K; };
struct StaticOrder {
    int nM, nN, nwg, G, c;
    __host__ __device__ void init(int M_, int N_, int G_, int c_) { nM = M_ / BM; nN = N_ / BM; nwg = nM * nN; G = G_; c = c_; }
    __host__ __device__ bool next(int i, Unit& u) const {
        const long L = (long)i * G + c; if (L >= nwg) return false;
        int wgid = (int)L; { const int q = nwg / NXCD, r = nwg % NXCD, xcd = wgid % NXCD, off = wgid / NXCD; wgid = (xcd < r ? xcd * (q + 1) : r * (q + 1) + (xcd - r) * q) + off; }
        const int nig = WGM * nN, gid = wgid / nig, fm = gid * WGM, gsz = (nM - fm) < WGM ? (nM - fm) : WGM;
        u.pm = fm + ((wgid % nig) % gsz); u.pn = (wgid % nig) / gsz; return true;
    }
};
struct MoeOrder {
    const volatile LAS int* tab; int NT, G, c;
    __device__ __forceinline__ bool next(int i, Unit& u) const {
        const long L = (long)i * G + c; if (L >= tab[16]) return false;
        int e = 0; while (L >= tab[e + 1]) ++e;
        const int loc = (int)L - tab[e], tc = tab[64 + e];
        u.pm = tab[32 + e] + loc % tc; u.pn = e * NT + loc / tc; return true;
    }
};
__device__ __forceinline__ unsigned cvt_pk_bf16(float lo, float hi) {
#ifdef EMU
    return pk2(lo, hi);
#else
    unsigned r; asm volatile("v_cvt_pk_bf16_f32 %0, %1, %2" : "=v"(r) : "v"(lo), "v"(hi)); return r;
#endif
}

struct EpiBf16 {
    static constexpr bool PERM = true;
    bf16* O; int ldc;
    __device__ __forceinline__ void operator()(const f32x4 (&acc)[2][2][4][2], const Unit& u, int wr, int wc, int fr, int fq) const {
        const int row0 = u.pm * BM + wr * 64 + fr, col0 = u.pn * BM + wc * 32 + 8 * fq;
#pragma unroll
        for (int ai = 0; ai < 2; ++ai)
#pragma unroll
            for (int m = 0; m < 4; ++m) { bf16* rowp = O + (size_t)(row0 + ai * HALF + m * 16) * ldc + col0;
#pragma unroll
                for (int bj = 0; bj < 2; ++bj) { const f32x4 v0 = acc[ai][bj][m][0], v1 = acc[ai][bj][m][1];
                    u32x4 w; w[0] = cvt_pk_bf16(v0[0], v0[1]); w[1] = cvt_pk_bf16(v0[2], v0[3]); w[2] = cvt_pk_bf16(v1[0], v1[1]); w[3] = cvt_pk_bf16(v1[2], v1[3]);
                    *(u32x4*)(rowp + bj * HALF) = w; } }
    }
};
struct EpiF32 {
    static constexpr bool PERM = true;
    float* C; int ldc;
    __device__ __forceinline__ void operator()(const f32x4 (&acc)[2][2][4][2], const Unit& u, int wr, int wc, int fr, int fq) const {
        const int row0 = u.pm * BM + wr * 64 + fr, col0 = u.pn * BM + wc * 32 + 8 * fq;
#pragma unroll
        for (int ai = 0; ai < 2; ++ai)
#pragma unroll
            for (int m = 0; m < 4; ++m) { float* rowp = C + (size_t)(row0 + ai * HALF + m * 16) * ldc + col0;
#pragma unroll
                for (int bj = 0; bj < 2; ++bj)
#pragma unroll
                    for (int n = 0; n < 2; ++n) *(f32x4*)(rowp + bj * HALF + n * 4) = acc[ai][bj][m][n]; }
    }
};
struct EpiGate {
    static constexpr bool PERM = true;
    bf16* T; int ldc; const bf16* Pg; int ldp; int gcol0; bool ADD;
    __device__ __forceinline__ void operator()(const f32x4 (&acc)[2][2][4][2], const Unit& u, int wr, int wc, int fr, int fq) const {
        const int row0 = u.pm * BM + wr * 64 + fr, col0 = u.pn * BM + wc * 32 + 8 * fq;
#pragma unroll
        for (int ai = 0; ai < 2; ++ai)
#pragma unroll
            for (int m = 0; m < 4; ++m) { const size_t row = (size_t)(row0 + ai * HALF + m * 16);
#pragma unroll
                for (int bj = 0; bj < 2; ++bj) { const f32x4 v0 = acc[ai][bj][m][0], v1 = acc[ai][bj][m][1];
                    const u32x4 g = *(const u32x4*)(Pg + row * ldp + gcol0 + col0 + bj * HALF);
                    u32x4 t = {0u, 0u, 0u, 0u}; if (ADD) t = *(const u32x4*)(T + row * ldc + col0 + bj * HALF);
                    float o[8];
#pragma unroll
                    for (int j = 0; j < 4; ++j) { const float a0 = j < 2 ? v0[2 * j] : v1[2 * j - 4], a1 = j < 2 ? v0[2 * j + 1] : v1[2 * j - 3];
                        o[2 * j] = bflo(t[j]) + sigmoidf_(bflo(g[j])) * a0; o[2 * j + 1] = bfhi(t[j]) + sigmoidf_(bfhi(g[j])) * a1; }
                    u32x4 w; w[0] = cvt_pk_bf16(o[0], o[1]); w[1] = cvt_pk_bf16(o[2], o[3]); w[2] = cvt_pk_bf16(o[4], o[5]); w[3] = cvt_pk_bf16(o[6], o[7]);
                    *(u32x4*)(T + row * ldc + col0 + bj * HALF) = w; } }
    }
};
struct EpiSwiglu {
    static constexpr bool PERM = true;
    bf16* O; int ldc; int NT;
    __device__ __forceinline__ void operator()(const f32x4 (&acc)[2][2][4][2], const Unit& u, int wr, int wc, int fr, int fq) const {
        const int row0 = u.pm * BM + wr * 64 + fr, col0 = (u.pn % NT) * HALF + wc * 32 + 8 * fq;
#pragma unroll
        for (int ai = 0; ai < 2; ++ai)
#pragma unroll
            for (int m = 0; m < 4; ++m) { bf16* rowp = O + (size_t)(row0 + ai * HALF + m * 16) * ldc + col0;
                float o[8];
#pragma unroll
                for (int j = 0; j < 8; ++j) { const float g = acc[ai][0][m][j >> 2][j & 3], uu = acc[ai][1][m][j >> 2][j & 3]; o[j] = g / (1.0f + expf(-g)) * uu; }
                u32x4 w; w[0] = cvt_pk_bf16(o[0], o[1]); w[1] = cvt_pk_bf16(o[2], o[3]); w[2] = cvt_pk_bf16(o[4], o[5]); w[3] = cvt_pk_bf16(o[6], o[7]);
                *(u32x4*)rowp = w; }
    }
};
struct EpiMoeDown {
    static constexpr bool PERM = true;
    bf16* O; int ldc; int NT;
    __device__ __forceinline__ void operator()(const f32x4 (&acc)[2][2][4][2], const Unit& u, int wr, int wc, int fr, int fq) const {
        const int row0 = u.pm * BM + wr * 64 + fr, col0 = (u.pn % NT) * BM + wc * 32 + 8 * fq;
#pragma unroll
        for (int ai = 0; ai < 2; ++ai)
#pragma unroll
            for (int m = 0; m < 4; ++m) { bf16* rowp = O + (size_t)(row0 + ai * HALF + m * 16) * ldc + col0;
#pragma unroll
                for (int bj = 0; bj < 2; ++bj) { const f32x4 v0 = acc[ai][bj][m][0], v1 = acc[ai][bj][m][1];
                    u32x4 w; w[0] = cvt_pk_bf16(v0[0], v0[1]); w[1] = cvt_pk_bf16(v0[2], v0[3]); w[2] = cvt_pk_bf16(v1[0], v1[1]); w[3] = cvt_pk_bf16(v1[2], v1[3]);
                    *(u32x4*)(rowp + bj * HALF) = w; } }
    }
};

struct EpiBf16OrF32 { static constexpr bool PERM = true; bf16* O; float* C; int ldc; bool f32;
    __device__ __forceinline__ void operator()(const f32x4 (&acc)[2][2][4][2], const Unit& u, int wr, int wc, int fr, int fq) const {
        if (f32) { EpiF32 E{C, ldc}; E(acc, u, wr, wc, fr, fq); } else { EpiBf16 E{O, ldc}; E(acc, u, wr, wc, fr, fq); } } };
struct EpiMoe { static constexpr bool PERM = true; bf16* O; int ldc; int NT; bool swiglu;
    __device__ __forceinline__ void operator()(const f32x4 (&acc)[2][2][4][2], const Unit& u, int wr, int wc, int fr, int fq) const {
        if (swiglu) { EpiSwiglu E{O, ldc, NT}; E(acc, u, wr, wc, fr, fq); } else { EpiMoeDown E{O, ldc, NT}; E(acc, u, wr, wc, fr, fq); } } };
template <class Epi, class Sched>
__device__ __forceinline__ void gemm_phase(LAS unsigned char* lds, const Gemm g, const Sched& S, const Epi& E) {
    const int tid = threadIdx.x + vgpr_zero();
    const int wid = READFIRSTLANE(tid >> 6), lane = tid & 63, wr = wid >> 2, wc = wid & 3, fr = lane & 15, fq = lane >> 4;
    const int K = g.K, nt = K / BK;
    unsigned long long voffA[2], voffB[2]; const unsigned long long zhi = vgpr_zero64();
#pragma unroll
    for (int i = 0; i < 2; ++i) { int R, C; stage_rc(tid * 16 + i * 8192, R, C); const int Rb = Epi::PERM ? ((R & ~31) + perm32(R & 31)) : R;
        voffA[i] = zhi + (unsigned long long)(long long)((R * K + C) * 2); voffB[i] = zhi + (unsigned long long)(long long)((Rb * K + C) * 2); }
    const size_t kstep = (size_t)(BK * 2);
    const size_t hstep = (size_t)HALF * K * 2;
    const size_t tstep = 2 * hstep;
    const unsigned ldsw = (unsigned)wid * 1024u;
    const int aoff = lds_byte(wr * 64 + fr, fq * 8), boff = lds_byte(wc * 32 + fr, fq * 8);
#define PG8_SA(b, h) (((b) * 2 + (h)) * HTB)
#define PG8_SB(b, h) ((4 + (b) * 2 + (h)) * HTB)
#define PG8_STAGE(bufoff, gbase, voff) do { _Pragma("unroll") for (int _i = 0; _i < 2; ++_i) \
        GLDS16((const char*)(gbase) + (voff)[_i], lds + (bufoff) + ldsw + _i * 8192); } while (0)
#define PG8_LDA(dst, b, h) do { _Pragma("unroll") for (int m = 0; m < 4; ++m) _Pragma("unroll") for (int k = 0; k < 2; ++k) dst[m][k] = *(const LAS bf16x8*)(lds + PG8_SA(b, h) + aoff + m * 2048 + k * 1024); } while (0)
#define PG8_LDB(dst, b, h) do { _Pragma("unroll") for (int n = 0; n < 2; ++n) _Pragma("unroll") for (int k = 0; k < 2; ++k) dst[n][k] = *(const LAS bf16x8*)(lds + PG8_SB(b, h) + boff + n * 2048 + k * 1024); } while (0)
#define PG8_MMA(ai, bj, At, Bt) do { SETPRIO(1); _Pragma("unroll") for (int m = 0; m < 4; ++m) _Pragma("unroll") for (int n = 0; n < 2; ++n) _Pragma("unroll") for (int k = 0; k < 2; ++k) \
        acc[ai][bj][m][n] = MFMA16(Bt[n][k], At[m][k], acc[ai][bj][m][n]); SETPRIO(0); } while (0)
#define PG8_BAR S_BARRIER()
    Unit cur, nxt; int ui = 0;
    if (!S.next(0, cur)) return;
    f32x4 acc[2][2][4][2];
#pragma unroll
    for (int a = 0; a < 2; ++a)
#pragma unroll
        for (int b = 0; b < 2; ++b)
#pragma unroll
            for (int m = 0; m < 4; ++m)
#pragma unroll
                for (int n = 0; n < 2; ++n) acc[a][b][m][n] = (f32x4){0.f, 0.f, 0.f, 0.f};
    bf16x8 At[4][2], B0[2][2], B1[2][2];
    const char* cA = (const char*)g.A + (size_t)cur.pm * tstep; const char* cB = (const char*)g.Bt + (size_t)cur.pn * tstep;
    PG8_STAGE(PG8_SB(0, 0), cB, voffB); PG8_STAGE(PG8_SA(0, 0), cA, voffA); PG8_STAGE(PG8_SB(0, 1), cB + hstep, voffB); PG8_STAGE(PG8_SA(0, 1), cA + hstep, voffA);
    if (wr == 1) PG8_BAR;
    ASM_WAIT_V(4); PG8_BAR;
    PG8_STAGE(PG8_SB(1, 0), cB + kstep, voffB); PG8_STAGE(PG8_SA(1, 0), cA + kstep, voffA); PG8_STAGE(PG8_SB(1, 1), cB + hstep + kstep, voffB);
    ASM_WAIT_V(6); PG8_BAR;
    for (;;) {
        const bool has_next = S.next(ui + 1, nxt);
        const char* nA = has_next ? (const char*)g.A + (size_t)nxt.pm * tstep : cA; const char* nB = has_next ? (const char*)g.Bt + (size_t)nxt.pn * tstep : cB;
        for (int t = 0; t < nt; t += 2) {
            const bool last = (t == nt - 2);
            const char* a1 = cA + (size_t)(t + 1) * kstep;
            const char* a2 = last ? nA : cA + (size_t)(t + 2) * kstep; const char* b2 = last ? nB : cB + (size_t)(t + 2) * kstep;
            const char* a3 = a2 + kstep; const char* b3 = b2 + kstep;
            PG8_LDB(B0, 0, 0); SCHED_BARRIER(); PG8_LDA(At, 0, 0); PG8_STAGE(PG8_SA(1, 1), a1 + hstep, voffA);
            ASM_WAIT_L(8); PG8_BAR; ASM_WAIT_L(0); PG8_MMA(0, 0, At, B0); PG8_BAR; SCHED_BARRIER();
            PG8_LDB(B1, 0, 1); PG8_STAGE(PG8_SB(0, 0), b2, voffB);
            PG8_BAR; ASM_WAIT_L(0); PG8_MMA(0, 1, At, B1); PG8_BAR;
            PG8_LDA(At, 0, 1); PG8_STAGE(PG8_SA(0, 0), a2, voffA);
            PG8_BAR; ASM_WAIT_L(0); PG8_MMA(1, 0, At, B0); PG8_BAR; SCHED_BARRIER();
            PG8_STAGE(PG8_SB(0, 1), b2 + hstep, voffB);
            ASM_WAIT_V(6); PG8_BAR; PG8_MMA(1, 1, At, B1); PG8_BAR;
            PG8_LDB(B0, 1, 0); SCHED_BARRIER(); PG8_LDA(At, 1, 0); PG8_STAGE(PG8_SA(0, 1), a2 + hstep, voffA);
            ASM_WAIT_L(8); PG8_BAR; ASM_WAIT_L(0); PG8_MMA(0, 0, At, B0); PG8_BAR; SCHED_BARRIER();
            PG8_LDB(B1, 1, 1); PG8_STAGE(PG8_SB(1, 0), b3, voffB);
            PG8_BAR; ASM_WAIT_L(0); PG8_MMA(0, 1, At, B1); PG8_BAR;
            PG8_LDA(At, 1, 1); PG8_STAGE(PG8_SA(1, 0), a3, voffA);
            PG8_BAR; ASM_WAIT_L(0); PG8_MMA(1, 0, At, B0); PG8_BAR; SCHED_BARRIER();
            PG8_STAGE(PG8_SB(1, 1), b3 + hstep, voffB);
            ASM_WAIT_V(6); PG8_BAR; PG8_MMA(1, 1, At, B1); PG8_BAR;
        }
        E(acc, cur, wr, wc, fr, fq);
        if (!has_next) break;
#pragma unroll
        for (int a = 0; a < 2; ++a)
#pragma unroll
            for (int b = 0; b < 2; ++b)
#pragma unroll
                for (int m = 0; m < 4; ++m)
#pragma unroll
                    for (int n = 0; n < 2; ++n) acc[a][b][m][n] = (f32x4){0.f, 0.f, 0.f, 0.f};
        cur = nxt; cA = nA; cB = nB; ++ui;
    }
    ASM_WAIT_V(0);
    if (wr == 0) PG8_BAR;
    PG8_BAR;
#undef PG8_SA
#undef PG8_SB
#undef PG8_STAGE
#undef PG8_LDA
#undef PG8_LDB
#undef PG8_MMA
#undef PG8_BAR
}
}

struct Args { const float* in[N_IN]; float* out; unsigned char* ws; int ph_lo, ph_hi; };
constexpr int NWAVES = 8, NTHR = 512;
constexpr int LDS_STAGE = 131072, LDS_MISC = LDS_STAGE, LDS_BYTES = 147456;

constexpr int PT_OUT = N_IN, PT_WS = N_IN + 1, PT_WORD0 = 128;

struct Ctx {
    LAS unsigned char* lds; int tid, lane, wave, G, bid;
    __device__ __forceinline__ unsigned long long ptr(int i) const { const volatile LAS unsigned* t = (const volatile LAS unsigned*)(lds + LDS_MISC) + PT_WORD0 + 2 * i;
        const unsigned lo = (unsigned)READFIRSTLANE((int)t[0]), hi = (unsigned)READFIRSTLANE((int)t[1]); return ((unsigned long long)hi << 32) | lo; }
    __device__ __forceinline__ unsigned long long ptrv(int i) const { const volatile LAS unsigned* t = (const volatile LAS unsigned*)(lds + LDS_MISC) + PT_WORD0 + 2 * i; return ((unsigned long long)t[1] << 32) | t[0]; }
    __device__ __forceinline__ const float* inv(int i) const { return as_global((const float*)ptrv(i)); }
    template <class T> __device__ __forceinline__ T* wsv(size_t off) const { return as_global((T*)((unsigned char*)ptrv(PT_WS) + off)); }
    __device__ __forceinline__ const float* in(int i) const { return as_global((const float*)ptr(i)); }
    __device__ __forceinline__ float* out() const { return as_global((float*)ptr(PT_OUT)); }
    template <class T> __device__ __forceinline__ T* ws(size_t off) const { return as_global((T*)((unsigned char*)ptr(PT_WS) + off)); }
    __device__ __forceinline__ unsigned* ctl() const { return as_global((unsigned*)ptr(PT_WS)); }
};

__device__ __forceinline__ void transpose_item(const float* W, int ldw, int k0, int n0, int nvalid, bf16* outp, int ldo, LAS float* scr, int lane) {
#pragma unroll
    for (int i = 0; i < 32; ++i) { const int kk = 2 * i + (lane >> 5), n = n0 + (lane & 31); scr[kk * 33 + (lane & 31)] = (n < nvalid) ? W[(size_t)(k0 + kk) * ldw + n] : 0.f; }
    WAVE_LDS_FENCE(); CFENCE();
    const int c = lane & 7;
#pragma unroll
    for (int j = 0; j < 4; ++j) { const int n = (lane >> 3) + 8 * j; const LAS float* s = scr + (8 * c) * 33 + n;
        u32x4 o; o[0] = pk2(s[0 * 33], s[1 * 33]); o[1] = pk2(s[2 * 33], s[3 * 33]); o[2] = pk2(s[4 * 33], s[5 * 33]); o[3] = pk2(s[6 * 33], s[7 * 33]);
        *(u32x4*)(outp + (size_t)n * ldo + k0 + 8 * c) = o; }
    WAVE_LDS_FENCE(); CFENCE();
}
__device__ __forceinline__ void filter_item(const Ctx& X, int l, int n, int pos0, float* out, LAS bf16* za, LAS bf16* zb, LAS float* asum  ) {
    const int lane = X.lane, kof = 8 * (lane >> 4);
    const bf16* FWT = X.wsv<bf16>(WS_FWT);
    if (lane < 64) { const int i = lane;
#pragma unroll 4
        for (int p = 0; p < 16; ++p) { const int pos = pos0 + p; float v = 0.f;
            if (i == 0) v = (float)pos / (float)(n - 1 > 1 ? n - 1 : 1);
            else if (i < 33) { const int bb = (i - 1) & 15; const double band = 1e-4 + (double)bb * ((15.0 - 1e-4) / 15.0);
                double rev = (double)pos * band / (double)n; rev -= floor(rev); if (rev > 0.5) rev -= 1.0;
                float sn, cs; sincos_f((float)(rev * 6.283185307179586476925), sn, cs); v = i <= 16 ? cs : -sn; }
            za[p * LP + i] = (bf16)f2bf(v); } }
    WAVE_LDS_FENCE(); CFENCE();
    LAS bf16* src = za; LAS bf16* dst = zb;
#pragma unroll 1
    for (int layer = 0; layer < 3; ++layer) { const bf16* WT = FWT + (size_t)layer * 64 * 64; const float* bias = X.inv(layer == 0 ? I_FB1 : layer == 1 ? I_FB2 : I_FB3) + l * 64;
        const bf16x8 a0 = *(const LAS bf16x8*)(src + (lane & 15) * LP + kof), a1 = *(const LAS bf16x8*)(src + (lane & 15) * LP + kof + 32);
#pragma unroll
        for (int tj = 0; tj < 4; ++tj) { const int u = 16 * tj + (lane & 15); f32x4 acc = {0.f, 0.f, 0.f, 0.f};
            acc = MFMA16(a0, *(const bf16x8*)(WT + (size_t)u * 64 + kof), acc); acc = MFMA16(a1, *(const bf16x8*)(WT + (size_t)u * 64 + kof + 32), acc);
            const float fr = X.inv(I_FREQ)[l * 64 + u], bu = bias[u];
#pragma unroll
            for (int r = 0; r < 4; ++r) dst[(4 * (lane >> 4) + r) * LP + u] = (bf16)f2bf(sin_f(fr * (acc[r] + bu))); }
        WAVE_LDS_FENCE(); CFENCE();
        LAS bf16* t_ = src; src = dst; dst = t_; }
    const bf16* WO = FWT + (size_t)3 * 64 * 64;
    const bf16x8 a0 = *(const LAS bf16x8*)(src + (lane & 15) * LP + kof), a1 = *(const LAS bf16x8*)(src + (lane & 15) * LP + kof + 32);
    const float dmin = -3.0701134573253944f, dmax = -15.350567286626972f;
    float dist[4];
#pragma unroll
    for (int r = 0; r < 4; ++r) { const int dd = pos0 + 4 * (lane >> 4) + r - n / 2; dist[r] = (float)(dd < 0 ? -dd : dd) * (2.0f / (float)n); }
#pragma unroll 1
    for (int tg = 0; tg < HW / 64; ++tg) {
#pragma unroll
        for (int tq = 0; tq < 4; ++tq) { const int c = 64 * tg + 16 * tq + (lane & 15); f32x4 acc = {0.f, 0.f, 0.f, 0.f};
            acc = MFMA16(a0, *(const bf16x8*)(WO + (size_t)c * 64 + kof), acc); acc = MFMA16(a1, *(const bf16x8*)(WO + (size_t)c * 64 + kof + 32), acc);
            const float delta = fabsf(dmin + (float)c * ((dmax - dmin) / (float)(HW - 1))); f32x4 v; float as = 0.f;
#pragma unroll
            for (int r = 0; r < 4; ++r) { v[r] = acc[r] * fexp(-dist[r] * delta); as += fabsf(v[r]); }
            *(f32x4*)(out + (size_t)c * n + pos0 + 4 * (lane >> 4)) = v; lds_addf(asum + c, as); } }
    WAVE_LDS_FENCE(); CFENCE();
}
__device__ __forceinline__ void phase_transposes(const Ctx& X, int l, int part) {
    LAS float* scr = (LAS float*)(X.lds + X.wave * 16384);
    const bool shifted = part == 1 && X.G > N_SEQ_UNITS; const int myb = shifted ? X.bid - N_SEQ_UNITS : X.bid, nb_ = shifted ? X.G - N_SEQ_UNITS : X.G;
    if (myb < 0) return;
    const int gw = myb * NWAVES + X.wave, NGW = nb_ * NWAVES, lane = X.lane;
    constexpr int KB_D = D / 64, I_WIN_ = KB_D * (PCP / 32), I_WB_ = 2 * (RW / 64) * (D / 32), I_WO_ = KB_D * (D / 32), I_WGU_ = NE * 2 * KB_D * (D / 32), I_WD_ = NE * KB_D * (D / 32);
    constexpr int I_LORA_ = 6 * (RW / 32); constexpr int N0 = I_WIN_ + I_WB_ + I_WO_, NITEMS = N0 + I_WGU_ + I_WD_;
    if (part == 0) for (int it = gw; it < I_LORA_; it += NGW) { const int which = it / (RW / 32), nb = it % (RW / 32);
        const float* W; int k0 = 0, ldo = 64; bf16* outp;
        if (which < 2) { W = X.in(I_W2) + ((size_t)l * 2 + which) * 64 * RW; outp = X.ws<bf16>(WS_W2T) + (size_t)which * RW * 64 + (size_t)(32 * nb) * 64; }
        else if (which < 4) { W = X.in(I_A2) + ((size_t)l * 2 + (which - 2)) * 64 * RW; outp = X.ws<bf16>(WS_A2T) + (size_t)(which - 2) * RW * 64 + (size_t)(32 * nb) * 64; }
        else { W = X.in(I_G2) + (size_t)l * 128 * RW; k0 = 64 * (which - 4); ldo = 128; outp = X.ws<bf16>(WS_G2T) + (size_t)(32 * nb) * 128; }
        transpose_item(W, RW, k0, 32 * nb, RW, outp, ldo, scr, lane); }
    const int it_end = part ? NITEMS : N0; int it = (part ? N0 : 0) + gw;
    const float* W; int ldw, k0, n0, nvalid, ldo; bf16* outp; float v[32];
#define TR_PARAMS(it_) do { int r = (it_); \
        if (r < I_WIN_) { const int nb = r % (PCP / 32), kb = r / (PCP / 32); W = X.in(I_WIN) + (size_t)l * D * PC; ldw = PC; k0 = 64 * kb; n0 = 32 * nb; nvalid = PC; outp = X.ws<bf16>(WS_WIN) + (size_t)n0 * D; ldo = D; } \
        else if ((r -= I_WIN_) < I_WB_) { const int s_ = r / ((RW / 64) * (D / 32)), q = r % ((RW / 64) * (D / 32)), nb = q % (D / 32), kb = q / (D / 32); \
            W = X.in(I_WBR) + ((size_t)l * 2 + s_) * RW * D; ldw = D; k0 = 64 * kb; n0 = 32 * nb; nvalid = D; outp = X.ws<bf16>(WS_WB) + (size_t)s_ * D * RW + (size_t)n0 * RW; ldo = RW; } \
        else if ((r -= I_WB_) < I_WO_) { const int nb = r % (D / 32), kb = r / (D / 32); W = X.in(I_WOUT) + (size_t)l * D * D; ldw = D; k0 = 64 * kb; n0 = 32 * nb; nvalid = D; outp = X.ws<bf16>(WS_WO) + (size_t)n0 * D; ldo = D; } \
        else if ((r -= I_WO_) < I_WGU_) { const int per = KB_D * (D / 32), es = r / per, q = r % per, e = es >> 1, src = es & 1, nb = q % (D / 32), kb = q / (D / 32); n0 = 32 * nb; \
            W = (src ? X.in(I_WU) : X.in(I_WG)) + ((size_t)l * NE + e) * D * D; ldw = D; k0 = 64 * kb; nvalid = D; const int orow = e * 2 * D + (n0 / 128) * 256 + src * 128 + (n0 % 128); \
            outp = X.ws<bf16>(WS_WGU) + (size_t)orow * D; ldo = D; } \
        else { r -= I_WGU_; const int per = KB_D * (D / 32), e = r / per, q = r % per, nb = q % (D / 32), kb = q / (D / 32); \
            W = X.in(I_WD) + ((size_t)l * NE + e) * D * D; ldw = D; k0 = 64 * kb; n0 = 32 * nb; nvalid = D; outp = X.ws<bf16>(WS_WD) + (size_t)(e * D + n0) * D; ldo = D; } } while (0)
#define TR_LOAD() do { const int n = n0 + (lane & 31); const float* wp = W + (size_t)(k0 + (lane >> 5)) * ldw + n; _Pragma("unroll") for (int i = 0; i < 32; ++i) v[i] = (n < nvalid) ? wp[(size_t)(2 * i) * ldw] : 0.f; } while (0)
    if (it < it_end) { TR_PARAMS(it); TR_LOAD(); }
    while (it < it_end) {
#pragma unroll
        for (int i = 0; i < 32; ++i) scr[(2 * i + (lane >> 5)) * 33 + (lane & 31)] = v[i];
        WAVE_LDS_FENCE(); CFENCE();
        bf16* const cout_ = outp; const int ck0 = k0, cldo = ldo;
        it += NGW;
        if (it < it_end) { TR_PARAMS(it); TR_LOAD(); }
        const int c = lane & 7;
#pragma unroll
        for (int j = 0; j < 4; ++j) { const int n = (lane >> 3) + 8 * j; const LAS float* s_ = scr + (8 * c) * 33 + n;
            u32x4 o; o[0] = pk2(s_[0 * 33], s_[1 * 33]); o[1] = pk2(s_[2 * 33], s_[3 * 33]); o[2] = pk2(s_[4 * 33], s_[5 * 33]); o[3] = pk2(s_[6 * 33], s_[7 * 33]);
            *(u32x4*)(cout_ + (size_t)n * cldo + ck0 + 8 * c) = o; }
        WAVE_LDS_FENCE(); CFENCE();
    }
#undef TR_PARAMS
#undef TR_LOAD
}
__device__ __forceinline__ void phase_filter_weights(const Ctx& X, int l) {
    bf16* FWT = X.ws<bf16>(WS_FWT);
    for (int idx = X.bid * NTHR + X.tid; idx < (3 * 64 + HW) * 64; idx += X.G * NTHR) { const int o = idx >> 6, k = idx & 63; float v;
        if (o < 64) v = k < 33 ? X.in(I_FW1)[(size_t)l * 33 * 64 + k * 64 + o] : 0.f;
        else if (o < 128) v = X.in(I_FW2)[(size_t)l * 64 * 64 + k * 64 + (o - 64)];
        else if (o < 192) v = X.in(I_FW3)[(size_t)l * 64 * 64 + k * 64 + (o - 128)];
        else v = X.in(I_FWO)[(size_t)l * 64 * HW + (size_t)k * HW + (o - 192)];
        FWT[idx] = (bf16)f2bf(v); }
}
constexpr int FPART_OFF = 65536;
static_assert(FPART_OFF + 2 * HW * 4 <= LDS_STAGE && 2 * 16 * LP * 2 <= 8192, "filter LDS map");
__device__ __forceinline__ void phase_filters_begin(const Ctx& X) {
    LAS float* part = (LAS float*)(X.lds + FPART_OFF);
    for (int i = X.tid; i < 2 * HW; i += NTHR) part[i] = 0.f;
    __syncthreads();
}
__device__ __forceinline__ void phase_filters_item(const Ctx& X, int l_, int which_, int it_) {
    const int vz = vgpr_zero(), l = l_ + vz, which = which_ + vz, it = it_ + vz;
    LAS bf16* za = (LAS bf16*)(X.lds + X.wave * 8192); LAS bf16* zb = za + 16 * LP;
    const int n = which ? CTX : SEQ; float* out = X.wsv<float>(WS_FILT) + (which ? (size_t)HW * SEQ : 0);
    filter_item(X, l, n, 16 * it, out, za, zb, (LAS float*)(X.lds + FPART_OFF) + which * HW);
}
__device__ __forceinline__ void phase_filters_end(const Ctx& X) {
    const LAS float* part = (const LAS float*)(X.lds + FPART_OFF);
    __syncthreads();
    for (int i = X.tid; i < 2 * HW; i += NTHR) X.ws<float>(WS_FPART)[((size_t)(i / HW) * NPART + X.bid) * HW + (i % HW)] = part[i];
    __syncthreads();
}
__device__ __forceinline__ void phase_mod(const Ctx& X) {
    const int lane = X.lane;
    LAS float* red = (LAS float*)X.lds;
    constexpr int NIT = DEPTH * (6 * D / 64);
    for (int it = X.bid; it < NIT; it += X.G) {
        const int ll = it / (6 * D / 64), n0 = (it % (6 * D / 64)) * 64;
        const float* W = X.in(I_WMOD) + (size_t)ll * D * 6 * D; const float* cv = X.in(I_C); const float* cc = X.in(I_CCTX);
        float s0 = 0.f, s1 = 0.f;
#pragma unroll 8
        for (int k = X.wave * (D / 8); k < (X.wave + 1) * (D / 8); ++k) { const float wv = W[(size_t)k * 6 * D + n0 + lane]; const float c0 = cv[k], c1 = cc[k];
            s0 += c0 * sigmoidf_(c0) * wv; s1 += c1 * sigmoidf_(c1) * wv; }
        red[(X.wave * 64 + lane) * 2] = s0; red[(X.wave * 64 + lane) * 2 + 1] = s1;
        __syncthreads();
        if (X.wave == 0) { float t0 = 0.f, t1 = 0.f;
#pragma unroll
            for (int w = 0; w < NWAVES; ++w) { t0 += red[(w * 64 + lane) * 2]; t1 += red[(w * 64 + lane) * 2 + 1]; }
            const float bm = X.in(I_BMOD)[(size_t)ll * 6 * D + n0 + lane];
            float* MOD = X.ws<float>(WS_MOD);
            MOD[((size_t)ll * 2 + 0) * 6 * D + n0 + lane] = t0 + bm; MOD[((size_t)ll * 2 + 1) * 6 * D + n0 + lane] = t1 + bm; }
        __syncthreads();
    }
}
__device__ __forceinline__ const float* modp(const Ctx& X, int l, int t, int j) { return X.ws<float>(WS_MOD) + ((size_t)l * 2 + (t < CTX ? 1 : 0)) * 6 * D + (size_t)j * D; }

__device__ __forceinline__ void phase_x0(const Ctx& X) {
    const int gw = X.bid * NWAVES + X.wave, NGW = X.G * NWAVES, lane = X.lane;
    for (int t = gw; t < M; t += NGW) {
        const float* src = t < CTX ? X.in(I_CTX) + (size_t)t * D : X.in(I_X) + (size_t)(t - CTX) * D;
        const float* sh = modp(X, 0, t, 0); const float* sc = modp(X, 0, t, 1);
        float* xr = X.ws<float>(WS_X) + (size_t)t * D; bf16* xm = X.ws<bf16>(WS_XMOD) + (size_t)t * D;
#pragma unroll
        for (int j = 0; j < D / 256; ++j) { const int d = 4 * lane + 256 * j; const f32x4 v = *(const f32x4*)(src + d), a = *(const f32x4*)(sh + d), b = *(const f32x4*)(sc + d);
            *(f32x4*)(xr + d) = v;
            unsigned w0 = pk2(v[0] * (1.f + b[0]) + a[0], v[1] * (1.f + b[1]) + a[1]), w1 = pk2(v[2] * (1.f + b[2]) + a[2], v[3] * (1.f + b[3]) + a[3]);
            *(unsigned long long*)(xm + d) = (unsigned long long)w0 | ((unsigned long long)w1 << 32); }
    }
}

__device__ __forceinline__ int shift_row(int t, int col, bool& valid) {
    const bool isctx = t < CTX;
    const int i = t - CTX, gx = i & (GRID_W - 1), gy = i / GRID_W, q = col / QTR;
    const int offl = (q == 0) ? -1 : (q == 1) ? 1 : (q == 2) ? -GRID_W : GRID_W;
    const bool vl = (q == 0) ? (gx > 0) : (q == 1) ? (gx < GRID_W - 1) : (q == 2) ? (gy > 0) : (gy < GRID_H - 1);
    const bool first = col < HALFC;
    const int offc = first ? -1 : 1; const bool vc = first ? (t > 0) : (t < CTX - 1);
    valid = isctx ? vc : vl;
    return valid ? t + (isctx ? offc : offl) : t;
}
__device__ __forceinline__ float pm_val(const bf16* P, const float* mu, int t, int col) {
    const float p0 = bf2f(P[(size_t)t * PCP + col]); bool valid; const int nr = shift_row(t, col, valid);
    const float pn = bf2f(P[(size_t)nr * PCP + col]); const float p1 = valid ? pn : 0.f;
    return p0 + (p1 - p0) * mu[col];
}
__device__ __forceinline__ f32x4 mm_tile(const LAS bf16* A, const LAS bf16* Bt, int ti, int tj, int lane, f32x4 acc) {
    const LAS bf16* pa = A + (16 * ti + (lane & 15)) * LP + 8 * (lane >> 4); const LAS bf16* pb = Bt + (16 * tj + (lane & 15)) * LP + 8 * (lane >> 4);
#pragma unroll
    for (int kk = 0; kk < 2; ++kk) { const bf16x8 a = *(const LAS bf16x8*)(pa + 32 * kk), b = *(const LAS bf16x8*)(pb + 32 * kk); acc = MFMA16(a, b, acc); }
    return acc;
}
struct PmLd { float p0, pn, m; bool valid; };
__device__ __forceinline__ PmLd pm_ld(const bf16* P, const float* mu, int t, int col) {
    PmLd r; bool valid; const int nr = shift_row(t, col, valid); r.p0 = bf2f(P[(size_t)t * PCP + col]); r.pn = bf2f(P[(size_t)nr * PCP + col]); r.m = mu[col]; r.valid = valid; return r; }
__device__ __forceinline__ float pm_fin(const PmLd& r) { const float p1 = r.valid ? r.pn : 0.f; return r.p0 + (p1 - r.p0) * r.m; }
constexpr int TT = 8;
__device__ __forceinline__ void phase_lin(const Ctx& X, int l) {
    const bf16* P = X.ws<bf16>(WS_P); const float* mu = X.in(I_MU) + (size_t)l * RC; bf16* LIN = X.ws<bf16>(WS_LIN);
    for (size_t idx = (size_t)X.bid * NTHR + X.tid; idx < (size_t)M * 384; idx += (size_t)X.G * NTHR) { const int t = (int)(idx / 384), j = (int)(idx % 384);
        float v = pm_val(P, mu, t, C_LWF + j);
        if (j < 128) v = 1.0f - 2.0f * frcp(fexp(2.0f * v) + 1.0f); else if (j >= 256) v = sigmoidf_(v);
        LIN[idx] = (bf16)f2bf(v); }
}
__device__ __forceinline__ f32x4 mm_tile_p(const LAS bf16* A, int lda, const LAS bf16* Bt, int ldb, int ks, int ti, int tj, int lane, f32x4 acc) {
    const LAS bf16* pa = A + (16 * ti + (lane & 15)) * lda + 8 * (lane >> 4); const LAS bf16* pb = Bt + (16 * tj + (lane & 15)) * ldb + 8 * (lane >> 4);
    for (int kk = 0; kk < ks; ++kk) { const bf16x8 a = *(const LAS bf16x8*)(pa + 32 * kk), b = *(const LAS bf16x8*)(pb + 32 * kk); acc = MFMA16(a, b, acc); }
    return acc;
}
constexpr int GP = 136;
__device__ __forceinline__ void lora_unit_a(const Ctx& X, int unit) {
    const int b = unit / NH, h = unit % NH, tid = X.tid, lane = X.lane, w = X.wave;
    LAS bf16* Ab = (LAS bf16*)X.lds; LAS bf16* Gb = Ab + 4 * 64 * LP; LAS bf16* Wb = Gb + 64 * GP; LAS bf16* G2b = Wb + 4 * 64 * LP;
    LAS float* OUT = (LAS float*)X.lds;
    static_assert((8 * 64 * LP + 2 * 64 * GP) * 2 <= LDS_STAGE && 5 * 64 * LQ * 4 <= LDS_STAGE, "lora LDS map");
    const bf16* LIN = X.wsv<bf16>(WS_LIN) + (size_t)(64 * b) * 384;
    for (int i = tid; i < 64 * 48; i += NTHR) { const int t = i / 48, c16 = i % 48; const u32x4 v = *(const u32x4*)(LIN + (size_t)t * 384 + 8 * c16);
        if (c16 < 32) *(LAS u32x4*)(Ab + (c16 >> 3) * 64 * LP + t * LP + 8 * (c16 & 7)) = v; else *(LAS u32x4*)(Gb + t * GP + 8 * (c16 - 32)) = v; }
    const bf16* w2t = X.wsv<bf16>(WS_W2T) + (size_t)(64 * h) * 64; const bf16* a2t = X.wsv<bf16>(WS_A2T) + (size_t)(64 * h) * 64; const bf16* g2t = X.wsv<bf16>(WS_G2T) + (size_t)(64 * h) * 128;
    for (int i = tid; i < 4 * 64 * 8; i += NTHR) { const int q = i / 512, c = (i / 8) % 64, c16 = i % 8; const bf16* src = (q < 2 ? w2t + (size_t)q * RW * 64 : a2t + (size_t)(q - 2) * RW * 64) + c * 64 + 8 * c16;
        *(LAS u32x4*)(Wb + q * 64 * LP + c * LP + 8 * c16) = *(const u32x4*)src; }
    for (int i = tid; i < 64 * 16; i += NTHR) { const int c = i / 16, c16 = i % 16; *(LAS u32x4*)(G2b + c * GP + 8 * c16) = *(const u32x4*)(g2t + c * 128 + 8 * c16); }
    __syncthreads();
    f32x4 o[2][5];
#pragma unroll
    for (int q = 0; q < 2; ++q) { const int tile = 2 * w + q, ti = tile >> 2, tj = tile & 3; const f32x4 z4 = {0.f, 0.f, 0.f, 0.f};
#pragma unroll
        for (int p = 0; p < 4; ++p) o[q][p] = mm_tile(Ab + p * 64 * LP, Wb + p * 64 * LP, ti, tj, lane, z4);
        o[q][4] = mm_tile_p(Gb, GP, G2b, GP, 4, ti, tj, lane, z4); }
    __syncthreads();
#pragma unroll
    for (int q = 0; q < 2; ++q) { const int tile = 2 * w + q, ti = tile >> 2, tj = tile & 3, col = 16 * tj + (lane & 15);
#pragma unroll
        for (int p = 0; p < 5; ++p)
#pragma unroll
            for (int r = 0; r < 4; ++r) OUT[(p * 64 + 16 * ti + 4 * (lane >> 4) + r) * LQ + col] = o[q][p][r]; }
    __syncthreads();
}
__device__ __forceinline__ void lora_unit_b(const Ctx& X, int l, int unit) {
    const int b = unit / NH, h = unit % NH, w = X.wave, k = X.lane, c = 64 * h + k;
    const LAS float* OUT = (const LAS float*)X.lds;
    const bf16* P = X.wsv<bf16>(WS_P); const float* mu = X.inv(I_MU) + (size_t)l * RC;
    const float w00 = X.inv(I_W0)[(size_t)(l * 2 + 0) * RW + c], w01 = X.inv(I_W0)[(size_t)(l * 2 + 1) * RW + c];
    const float a00 = X.inv(I_A0)[(size_t)(l * 2 + 0) * RW + c], a01 = X.inv(I_A0)[(size_t)(l * 2 + 1) * RW + c];
    const float kkc = X.inv(I_KK)[(size_t)l * RW + c], kac = X.inv(I_KA)[(size_t)l * RW + c], rkc = X.inv(I_RK)[(size_t)l * RW + c];
    bf16* pR = X.wsv<bf16>(WS_R); bf16* pV = X.wsv<bf16>(WS_V); bf16* pKA = X.wsv<bf16>(WS_KA); bf16* pKD = X.wsv<bf16>(WS_KD); bf16* pKB = X.wsv<bf16>(WS_KB); float* pW = X.wsv<float>(WS_W); bf16* pG = X.wsv<bf16>(WS_GATE); float* pBo = X.wsv<float>(WS_BONUS);
    const int vz = vgpr_zero();
    float p0[3][8], pn[3][8]; unsigned vmask = 0u; const float mu0 = mu[c], mu1 = mu[C_K + c], mu2 = mu[C_V + c];
#pragma unroll
    for (int i = 0; i < 8; ++i) { const int t = 64 * b + 8 * w + i + vz;
#pragma unroll
        for (int q = 0; q < 3; ++q) { const int col = (q == 0 ? 0 : q == 1 ? C_K : C_V) + c; bool valid; const int nr = shift_row(t, col, valid);
            p0[q][i] = bf2f(P[(size_t)t * PCP + col]); pn[q][i] = bf2f(P[(size_t)nr * PCP + col]); vmask |= (valid ? 1u : 0u) << (3 * i + q); } }
    float bonv[8];
#pragma unroll
    for (int i = 0; i < 8; ++i) { const int tl = 8 * w + i, t = 64 * b + tl + vz;
        const float r = p0[0][i] + ((((vmask >> (3 * i + 0)) & 1u) ? pn[0][i] : 0.f) - p0[0][i]) * mu0;
        const float kx = p0[1][i] + ((((vmask >> (3 * i + 1)) & 1u) ? pn[1][i] : 0.f) - p0[1][i]) * mu1;
        const float v = p0[2][i] + ((((vmask >> (3 * i + 2)) & 1u) ? pn[2][i] : 0.f) - p0[2][i]) * mu2;
        const float wd0 = -DECAY_SCALE * sigmoidf_(w00 + OUT[(0 * 64 + tl) * LQ + k]), wd1 = -DECAY_SCALE * sigmoidf_(w01 + OUT[(1 * 64 + tl) * LQ + k]);
        const float ad0 = sigmoidf_(a00 + OUT[(2 * 64 + tl) * LQ + k]), ad1 = sigmoidf_(a01 + OUT[(3 * 64 + tl) * LQ + k]);
        const float kkr = kx * kkc; const float n2 = wave_sum(kkr * kkr); const float kk = kkr * frcp(fmaxf(sqrtf(n2), 1e-12f));
        const float kd0 = kx * (1.f + (ad0 - 1.f) * kac), kd1 = kx * (1.f + (ad1 - 1.f) * kac);
        bonv[i] = wave_sum(r * (kd0 + kd1) * rkc);
        const size_t o = (size_t)t * RW + c, o1 = (size_t)(M + t) * RW + c;
        pR[o] = (bf16)f2bf(r); pV[o] = (bf16)f2bf(v); pKA[o] = (bf16)f2bf(-kk);
        pKD[o] = (bf16)f2bf(kd0); pKD[o1] = (bf16)f2bf(kd1); pKB[o] = (bf16)f2bf(kk * ad0); pKB[o1] = (bf16)f2bf(kk * ad1);
        pW[o] = wd0; pW[o1] = wd1; pG[o] = (bf16)f2bf(OUT[(4 * 64 + tl) * LQ + k]); }
    if (k < 8) { float bs = bonv[0];
#pragma unroll
        for (int i = 1; i < 8; ++i) bs = (k == i) ? bonv[i] : bs;
        pBo[(size_t)(64 * b + 8 * w + k) * NH + h] = bs; }
    __syncthreads();
}
__device__ __forceinline__ void phase_prep_hyena(const Ctx& X, int l) {
    const bf16* P = X.ws<bf16>(WS_P); const int c = X.tid;
    if (c < HW) {
        const float* cw = X.in(I_CW) + (size_t)l * 3 * HC; const float* cb = X.in(I_CB) + (size_t)l * HC;
        float cw0[3], cw1[3], cw2[3], cbv[3];
#pragma unroll
        for (int j = 0; j < 3; ++j) { const int hc = j * HW + c; cw0[j] = cw[hc]; cw1[j] = cw[HC + hc]; cw2[j] = cw[2 * HC + hc]; cbv[j] = cb[hc]; }
        float* ZT = X.ws<float>(WS_ZT) + (size_t)c * M; float* Zc = X.ws<float>(WS_Z); bf16* X0 = X.ws<bf16>(WS_X0);
        for (int tile = X.bid; tile < M / TT; tile += X.G) { const int t0 = tile * TT; float zz[TT];
#pragma unroll
            for (int tt = 0; tt < TT; ++tt) { const int t = t0 + tt; const bool hp = (t != 0 && t != CTX), hn = (t != CTX - 1 && t != M - 1);
                float u[3];
#pragma unroll
                for (int j = 0; j < 3; ++j) { const int col = C_HY + j * HW + c;
                    const float pc = bf2f(P[(size_t)t * PCP + col]), pp = hp ? bf2f(P[(size_t)(t - 1) * PCP + col]) : 0.f, pn = hn ? bf2f(P[(size_t)(t + 1) * PCP + col]) : 0.f;
                    u[j] = pp * cw0[j] + pc * cw1[j] + pn * cw2[j] + cbv[j]; }
                zz[tt] = u[2] * u[1]; if (t < CTX) Zc[(size_t)t * HW + c] = zz[tt];
                X0[(size_t)t * HW + c] = (bf16)f2bf(u[0]); }
            *(f32x4*)(ZT + t0) = (f32x4){zz[0], zz[1], zz[2], zz[3]}; *(f32x4*)(ZT + t0 + 4) = (f32x4){zz[4], zz[5], zz[6], zz[7]}; }
    }
}

constexpr int CC = 64, NCHK = M / CC;
static_assert(CTX % CC == 0 && SEQ % CC == 0, "chunks must not straddle the context/latent boundary");
__device__ __forceinline__ int scan_row(int d, int s) { return d == 0 ? s : (s < CTX ? CTX - 1 - s : M - 1 - (s - CTX)); }
__device__ __forceinline__ void chunk_unit_1(const Ctx& X, int unit) {
    const int d = unit / (NCHK * NH), c = (unit / NH) % NCHK, h = unit % NH;
    LAS bf16* An = (LAS bf16*)X.lds;            LAS bf16* Bn = An + 64 * LP; LAS bf16* Kn = Bn + 64 * LP; LAS bf16* Rn = Kn + 64 * LP; LAS bf16* Vt = Rn + 64 * LP;
    LAS bf16* Bh = Vt + 64 * LP;                LAS bf16* Kh = Bh + 64 * LP; LAS bf16* Lak = Kh + 64 * LP; LAS bf16* Mrb = Lak + 64 * LP; LAS bf16* Mrk = Mrb + 64 * LP;
    LAS float* Lab = (LAS float*)(Mrk + 64 * LP); LAS float* XsW = Lab + 64 * LX;
    LAS float* XsU = (LAS float*)An;
    LAS bf16* Wt = Lak; LAS bf16* Ut = (LAS bf16*)((LAS unsigned char*)An + 64 * LX * 4);
    LAS float* tot = Lab;
    LAS float* dC = (LAS float*)(X.lds + LDS_MISC + 1024);
    static_assert(10 * 64 * LP * 2 + 2 * 64 * LX * 4 <= LDS_STAGE && 64 * LX * 4 + 64 * LP * 2 <= 3 * 64 * LP * 2, "chunk LDS map");
    const int tid = X.tid, lane = X.lane, w = X.wave, k = tid & 63;
    float lw[8], cum[8];
    { float run = 0.f; const float* pW = X.wsv<float>(WS_W);
#pragma unroll
      for (int i = 0; i < 8; ++i) { const int row = scan_row(d, c * CC + 8 * w + i); lw[i] = pW[((size_t)d * M + row) * RW + h * 64 + k]; }
#pragma unroll
      for (int i = 0; i < 8; ++i) { run += lw[i]; cum[i] = run; }
      tot[w * 64 + k] = run; }
    __syncthreads();
    float off = 0.f, cumC = 0.f;
#pragma unroll
    for (int ww = 0; ww < 8; ++ww) { const float t = tot[ww * 64 + k]; off += (ww < w) ? t : 0.f; cumC += t; }
    __syncthreads();
    { unsigned pv[4], pbh[4], pkh[4]; float af[8];
      const bf16* pR = X.wsv<bf16>(WS_R); const bf16* pV = X.wsv<bf16>(WS_V); const bf16* pKA = X.wsv<bf16>(WS_KA); const bf16* pKD = X.wsv<bf16>(WS_KD); const bf16* pKB = X.wsv<bf16>(WS_KB);
#pragma unroll
      for (int i = 0; i < 8; ++i) { const int t = 8 * w + i; const int row = scan_row(d, c * CC + t); const size_t o = (size_t)row * RW + h * 64 + k, od = ((size_t)d * M + row) * RW + h * 64 + k;
          const float ct = off + cum[i], cp = ct - lw[i];
          const float r = bf2f(pR[o]), v = bf2f(pV[o]), ka = bf2f(pKA[o]), kd = bf2f(pKD[od]), kb = bf2f(pKB[od]);
          const float ei = fexp(-ct), eh = fexp(cumC - ct);
          const float at = ka * fexp(cp); af[i] = at;
          An[t * LP + k] = (bf16)f2bf(at); Bn[t * LP + k] = (bf16)f2bf(kb * ei); Kn[t * LP + k] = (bf16)f2bf(kd * ei); Rn[t * LP + k] = (bf16)f2bf(r * fexp(ct));
          const unsigned bv = f2bf(v), bb = f2bf(kb * eh), bk = f2bf(kd * eh);
          if (i & 1) { pv[i >> 1] |= bv << 16; pbh[i >> 1] |= bb << 16; pkh[i >> 1] |= bk << 16; } else { pv[i >> 1] = bv; pbh[i >> 1] = bb; pkh[i >> 1] = bk; } }
      *(LAS u32x4*)(Vt + k * LP + 8 * w) = (u32x4){pv[0], pv[1], pv[2], pv[3]}; *(LAS u32x4*)(Bh + k * LP + 8 * w) = (u32x4){pbh[0], pbh[1], pbh[2], pbh[3]}; *(LAS u32x4*)(Kh + k * LP + 8 * w) = (u32x4){pkh[0], pkh[1], pkh[2], pkh[3]};
      *(LAS f32x4*)(XsW + k * LX + 8 * w) = (f32x4){af[0], af[1], af[2], af[3]}; *(LAS f32x4*)(XsW + k * LX + 8 * w + 4) = (f32x4){af[4], af[5], af[6], af[7]}; }
    if (tid < 64) dC[tid] = fexp(cumC);
    __syncthreads();
#pragma unroll 1
    for (int q = 0; q < 2; ++q) { const int tile = 2 * w + q, ti = tile >> 2, tj = tile & 3; const f32x4 z4 = {0.f, 0.f, 0.f, 0.f};
        const f32x4 ab = mm_tile(An, Bn, ti, tj, lane, z4), ak = mm_tile(An, Kn, ti, tj, lane, z4), rb = mm_tile(Rn, Bn, ti, tj, lane, z4), rk = mm_tile(Rn, Kn, ti, tj, lane, z4);
        const int col = 16 * tj + (lane & 15);
#pragma unroll
        for (int r = 0; r < 4; ++r) { const int row = 16 * ti + 4 * (lane >> 4) + r; const bool lo = col < row, le = col <= row;
            Lab[row * LX + col] = lo ? ab[r] : 0.f; Lak[row * LP + col] = (bf16)f2bf(lo ? ak[r] : 0.f); Mrb[row * LP + col] = (bf16)f2bf(le ? rb[r] : 0.f); Mrk[row * LP + col] = (bf16)f2bf(le ? rk[r] : 0.f); } }
    __syncthreads();
}
__device__ __forceinline__ void chunk_unit_2(const Ctx& X, int unit) {
    const int d = unit / (NCHK * NH), c = (unit / NH) % NCHK, h = unit % NH;
    LAS bf16* An = (LAS bf16*)X.lds;            LAS bf16* Bn = An + 64 * LP; LAS bf16* Kn = Bn + 64 * LP; LAS bf16* Rn = Kn + 64 * LP; LAS bf16* Vt = Rn + 64 * LP;
    LAS bf16* Bh = Vt + 64 * LP;                LAS bf16* Kh = Bh + 64 * LP; LAS bf16* Lak = Kh + 64 * LP; LAS bf16* Mrb = Lak + 64 * LP; LAS bf16* Mrk = Mrb + 64 * LP;
    LAS float* Lab = (LAS float*)(Mrk + 64 * LP); LAS float* XsW = Lab + 64 * LX;
    LAS float* XsU = (LAS float*)An;
    LAS bf16* Wt = Lak; LAS bf16* Ut = (LAS bf16*)((LAS unsigned char*)An + 64 * LX * 4);
    LAS float* tot = Lab;
    LAS float* dC = (LAS float*)(X.lds + LDS_MISC + 1024);
    static_assert(10 * 64 * LP * 2 + 2 * 64 * LX * 4 <= LDS_STAGE && 64 * LX * 4 + 64 * LP * 2 <= 3 * 64 * LP * 2, "chunk LDS map");
    const int tid = X.tid, lane = X.lane, w = X.wave, k = tid & 63;
    f32x4 r2[2]; int r2col[2], r2row[2];
#pragma unroll
    for (int q = 0; q < 2; ++q) { const int tile = 2 * w + q, ti = tile >> 2, tj = tile & 3; const f32x4 z4 = {0.f, 0.f, 0.f, 0.f};
        const f32x4 a = mm_tile(Lak, Vt, ti, tj, lane, z4); const int col = 16 * tj + (lane & 15);
        r2[q] = a; r2col[q] = col; r2row[q] = 16 * ti + 4 * (lane >> 4); }
    __syncthreads();
#pragma unroll
    for (int q = 0; q < 2; ++q) *(LAS f32x4*)(XsU + r2col[q] * LX + r2row[q]) = r2[q];
    __syncthreads();
    LAS bf16* Tii = (LAS bf16*)(X.lds + LDS_MISC + 8448);
    constexpr int TP = 40;
    static_assert(8448 + 4 * 16 * TP * 2 <= LDS_BYTES - LDS_MISC, "T_ii image");
    if (tid < 64) { const int bi = tid >> 4, j = tid & 15; float xv[16];
#pragma unroll
        for (int t = 0; t < 16; ++t) { float acc = (t == j) ? 1.f : 0.f;
#pragma unroll
            for (int s2 = 0; s2 < t; ++s2) acc += Lab[(16 * bi + t) * LX + 16 * bi + s2] * xv[s2];
            xv[t] = acc; }
#pragma unroll
        for (int t = 0; t < 16; ++t) { Tii[(bi * 16 + t) * TP + j] = (bf16)f2bf(xv[t]); Tii[(bi * 16 + t) * TP + 16 + j] = (bf16)0; } }
    __syncthreads();
    { LAS float* xsx = (w < 4 ? XsW + 16 * w * LX : XsU + 16 * (w - 4) * LX) + (lane & 15) * LX;
      LAS bf16* dst = (w < 4 ? Wt + 16 * w * LP : Ut + 16 * (w - 4) * LP) + (lane & 15) * LP;
      const int kof = 8 * (lane >> 4); const bf16x8 zero8 = {0, 0, 0, 0, 0, 0, 0, 0};
#pragma unroll
      for (int i = 0; i < 4; ++i) {
          f32x4 acc = *(const LAS f32x4*)(xsx + 16 * i + 4 * (lane >> 4));
#pragma unroll
          for (int kk = 0; kk < (16 * i + 31) / 32; ++kk) { const int s0 = 32 * kk + kof;
              const f32x4 l0 = *(const LAS f32x4*)(Lab + (16 * i + (lane & 15)) * LX + s0), l1 = *(const LAS f32x4*)(Lab + (16 * i + (lane & 15)) * LX + s0 + 4);
              u32x4 pa = {pk2(l0[0], l0[1]), pk2(l0[2], l0[3]), pk2(l1[0], l1[1]), pk2(l1[2], l1[3])};
              bf16x8 av = __builtin_bit_cast(bf16x8, pa), bv = *(const LAS bf16x8*)(dst + s0);
              if (s0 >= 16 * i) { av = zero8; bv = zero8; }
              acc = MFMA16(av, bv, acc); }
          LAS bf16* zt = (LAS bf16*)(xsx + 16 * i);
          *(LAS unsigned long long*)(zt + 4 * (lane >> 4)) = (unsigned long long)pk2(acc[0], acc[1]) | ((unsigned long long)pk2(acc[2], acc[3]) << 32);
          WAVE_LDS_FENCE(); CFENCE();
          const bf16x8 a2 = *(const LAS bf16x8*)(Tii + (i * 16 + (lane & 15)) * TP + kof); bf16x8 b2 = zero8; if (kof < 16) b2 = *(const LAS bf16x8*)(zt + kof);
          f32x4 xi = {0.f, 0.f, 0.f, 0.f}; xi = MFMA16(a2, b2, xi);
          *(LAS unsigned long long*)(dst + 16 * i + 4 * (lane >> 4)) = (unsigned long long)pk2(xi[0], xi[1]) | ((unsigned long long)pk2(xi[2], xi[3]) << 32);
          WAVE_LDS_FENCE(); CFENCE(); } }
    __syncthreads();
}
__device__ __forceinline__ void chunk_unit_3(const Ctx& X, int unit) {
    const int d = unit / (NCHK * NH), c = (unit / NH) % NCHK, h = unit % NH;
    LAS bf16* An = (LAS bf16*)X.lds;            LAS bf16* Bn = An + 64 * LP; LAS bf16* Kn = Bn + 64 * LP; LAS bf16* Rn = Kn + 64 * LP; LAS bf16* Vt = Rn + 64 * LP;
    LAS bf16* Bh = Vt + 64 * LP;                LAS bf16* Kh = Bh + 64 * LP; LAS bf16* Lak = Kh + 64 * LP; LAS bf16* Mrb = Lak + 64 * LP; LAS bf16* Mrk = Mrb + 64 * LP;
    LAS float* Lab = (LAS float*)(Mrk + 64 * LP); LAS float* XsW = Lab + 64 * LX;
    LAS float* XsU = (LAS float*)An;
    LAS bf16* Wt = Lak; LAS bf16* Ut = (LAS bf16*)((LAS unsigned char*)An + 64 * LX * 4);
    LAS float* tot = Lab;
    LAS float* dC = (LAS float*)(X.lds + LDS_MISC + 1024);
    static_assert(10 * 64 * LP * 2 + 2 * 64 * LX * 4 <= LDS_STAGE && 64 * LX * 4 + 64 * LP * 2 <= 3 * 64 * LP * 2, "chunk LDS map");
    const int tid = X.tid, lane = X.lane, w = X.wave, k = tid & 63;
    const float dCk = dC[k];
    const size_t ubase = ((size_t)(d * NH + h) * NCHK + c);
    float* Pg = X.wsv<float>(WS_PQ) + ubase * 2 * 4096; float* Qg = Pg + 4096; bf16* Gg = X.wsv<bf16>(WS_G) + ubase * 4096; float* Yg = X.wsv<float>(WS_YL) + ubase * 4096;
#pragma unroll 1
    for (int q = 0; q < 2; ++q) { const int tile = 2 * w + q, ti = tile >> 2, tj = tile & 3; const f32x4 z4 = {0.f, 0.f, 0.f, 0.f};
        const f32x4 p = mm_tile(Wt, Bh, ti, tj, lane, z4); f32x4 qq = mm_tile(Ut, Bh, ti, tj, lane, z4); qq = mm_tile(Vt, Kh, ti, tj, lane, qq);
        const f32x4 g = mm_tile(Mrb, Wt, ti, tj, lane, z4); f32x4 y = mm_tile(Mrb, Ut, ti, tj, lane, z4); y = mm_tile(Mrk, Vt, ti, tj, lane, y);
        const int col = 16 * tj + (lane & 15); const float dcol = __shfl(dCk, col);
#pragma unroll
        for (int r = 0; r < 4; ++r) { const int row = 16 * ti + 4 * (lane >> 4) + r;
            Pg[row * 64 + col] = p[r] + (row == col ? dcol : 0.f); Qg[row * 64 + col] = qq[r];
            const int orow = d ? 63 - row : row;
            Gg[orow * 64 + col] = (bf16)f2bf(g[r] + bf2f(Rn[row * LP + col])); Yg[orow * 64 + col] = y[r]; } }
    __syncthreads();
}
__device__ __forceinline__ void seq_unit(const Ctx& X, int su) {
    const int d = su / (NH * 4), h = (su / 4) % NH, qv = su & 3;
    constexpr int PD = 4, RING = PD + 1, SLOT = 4096 + 1024;
    LAS float* ring = (LAS float*)X.lds;
    LAS float* S = ring + RING * SLOT;
    LAS float* part = S + 16 * LQ;
    static_assert((RING * SLOT + 16 * LQ + 4 * 16 * 17) * 4 <= LDS_STAGE, "seq LDS map");
    const int lane = X.lane, w = X.wave, tj = w & 3, kh = w >> 2, col = 16 * tj + (lane & 15), kq = lane >> 4;
    const float* PQ = X.ws<float>(WS_PQ) + (size_t)(d * NH + h) * NCHK * 2 * 4096; bf16* S0g = X.ws<bf16>(WS_S0) + (size_t)(d * NH + h) * NCHK * 4096 + (size_t)(16 * qv) * 64;
#define SEQ_FILL(c_) do { const float* p_ = PQ + (size_t)(c_) * 2 * 4096; LAS float* sl_ = ring + ((c_) % RING) * SLOT; \
        GLDS16(p_ + 4 * (w * 64 + lane), sl_ + 4 * (w * 64)); GLDS16(p_ + 4 * (512 + w * 64 + lane), sl_ + 4 * (512 + w * 64)); \
        GLDS16(p_ + 4096 + (16 * qv) * 64 + 4 * ((w & 3) * 64 + lane), sl_ + 4096 + 4 * ((w & 3) * 64)); } while (0)
#pragma unroll
    for (int i = 0; i < PD; ++i) if (i < NCHK) SEQ_FILL(i);
    for (int i = X.tid; i < 16 * LQ; i += NTHR) S[i] = 0.f;
    if (kh == 0) {
#pragma unroll
        for (int r = 0; r < 4; ++r) S0g[(4 * kq + r) * 64 + col] = (bf16)0; }
    for (int c = 0; c < NCHK; ++c) {
        if (c + PD - 1 < NCHK) { if (kh == 0) { ASM_WAIT_V(21); } else { ASM_WAIT_V(9); } } else { ASM_WAIT_V(0); }
        ASM_WAIT_L(0); S_BARRIER(); CFENCE();
        if (c + PD < NCHK) SEQ_FILL(c + PD);
        const LAS float* P = ring + (c % RING) * SLOT; const LAS float* Q = P + 4096;
        f32x4 acc0 = {0.f, 0.f, 0.f, 0.f}, acc1 = {0.f, 0.f, 0.f, 0.f};
#pragma unroll
        for (int s2 = 0; s2 < 8; s2 += 2) { const int k0 = 32 * kh + 4 * s2 + kq;
            acc0 = MFMA4F(S[(lane & 15) * LQ + k0], P[k0 * 64 + col], acc0); acc1 = MFMA4F(S[(lane & 15) * LQ + k0 + 4], P[(k0 + 4) * 64 + col], acc1); }
        acc0 += acc1;
        if (kh == 1) {
#pragma unroll
            for (int r = 0; r < 4; ++r) part[(tj * 16 + 4 * kq + r) * 17 + (lane & 15)] = acc0[r]; }
        ASM_WAIT_L(0); S_BARRIER(); CFENCE();
        if (kh == 0) {
#pragma unroll
            for (int r = 0; r < 4; ++r) { const float sn = acc0[r] + part[(tj * 16 + 4 * kq + r) * 17 + (lane & 15)] + Q[(4 * kq + r) * 64 + col];
                S[(4 * kq + r) * LQ + col] = sn; if (c + 1 < NCHK) S0g[(size_t)(c + 1) * 4096 + (4 * kq + r) * 64 + col] = (bf16)f2bf(sn); } }
    }
    ASM_WAIT_V(0);
    __syncthreads();
#undef SEQ_FILL
}
constexpr int CR = 16;
__device__ __forceinline__ void conv_item(const Ctx& X, int item) {
    constexpr int NCG = HW / 64; constexpr int n = CTX;
    const int cg = item % NCG, ob = item / NCG, i0 = CR * ob, c = cg * 64 + X.lane;
    const float* F = X.ws<float>(WS_FILT) + (size_t)HW * SEQ + (size_t)c * CTX; const float* Z = X.ws<float>(WS_Z) + c;
    const float* fp = X.ws<float>(WS_FPART) + (size_t)NPART * HW + c;
    float nsum = 0.f; for (int b = 0; b < NPART; ++b) nsum += fp[(size_t)b * HW];
    float acc[CR], Q[CR];
#pragma unroll
    for (int r = 0; r < CR; ++r) acc[r] = 0.f;
    int jb = i0 - n / 2; if (jb < 0) jb = 0;
    int jend = i0 + n / 2 + CR; if (jend > n) jend = n;
    int Tb = i0 - jb + n / 2;
#pragma unroll
    for (int x = 1; x < CR; ++x) { const int T = Tb + x; Q[x] = (T >= 0 && T < n) ? F[T] : 0.f; }
    Q[0] = 0.f;
    for (; jb < jend; jb += CR, Tb -= CR) {
#pragma unroll
        for (int s = 0; s < CR; ++s) { const int T = Tb - s, j = jb + s;
            if ((s & 3) == 0) CFENCE();
            Q[(CR - s) & (CR - 1)] = (T >= 0 && T < n) ? F[T] : 0.f;
            const float zj = (j < n) ? Z[(size_t)j * HW] : 0.f;
#pragma unroll
            for (int r = 0; r < CR; ++r) acc[r] += Q[(r - s + CR) & (CR - 1)] * zj; }
    }
    const float inv = 1.0f / nsum; float* O = X.ws<float>(WS_CONV) + c;
#pragma unroll
    for (int r = 0; r < CR; ++r) O[(size_t)(i0 + r) * HW] = acc[r] * inv;
}

#ifdef EMU
struct cf { float x, y; };
#else
typedef float cf __attribute__((ext_vector_type(2)));
#endif
__device__ __forceinline__ cf cmul(cf a, cf b) { return cf{a.x * b.x - a.y * b.y, a.x * b.y + a.y * b.x}; }
__device__ __forceinline__ cf cadd(cf a, cf b) { return cf{a.x + b.x, a.y + b.y}; }
__device__ __forceinline__ cf csub(cf a, cf b) { return cf{a.x - b.x, a.y - b.y}; }
__device__ __forceinline__ cf cconj(cf a) { return cf{a.x, -a.y}; }
constexpr int FN = SEQ;
constexpr int flog4(int n) { return n <= 1 ? 0 : 1 + flog4(n / 4); }
constexpr int FLOG4 = flog4(FN), FSQ = 1 << FLOG4;
static_assert((1 << (2 * FLOG4)) == FN && FN * 8 <= LDS_STAGE, "FFT length must be a power of 4 that fits the LDS stage region");
constexpr int FFT_TAB_OFF = LDS_MISC + 2048;
static_assert(FFT_TAB_OFF + 2 * FSQ * 8 <= LDS_BYTES, "FFT twiddle tables");
__device__ __forceinline__ void fft_tables(const Ctx& X) {
    LAS cf* T = (LAS cf*)(X.lds + FFT_TAB_OFF);
    for (int i = X.tid; i < 2 * FSQ; i += NTHR) { const int k = i < FSQ ? i * FSQ : i - FSQ; float s, c; sincos_f(-6.283185307179586f * (float)k / (float)FN, s, c); T[i] = cf{c, s}; }
    __syncthreads();
}
__device__ __forceinline__ cf fft_tw(const LAS cf* T, int k) { const cf a = T[k >> FLOG4], b = T[FSQ + (k & (FSQ - 1))]; return cmul(a, b); }
__device__ __forceinline__ int rev4(int k) { int r = 0;
#pragma unroll
    for (int s = 0; s < FLOG4; ++s) { r = (r << 2) | (k & 3); k >>= 2; }
    return r; }
__device__ __forceinline__ void fft_stage_q1(LAS cf* x, int tid, bool inverse) {
    for (int u = tid; u < FN / 4; u += NTHR) { LAS f32x4* px = (LAS f32x4*)(x + 4 * u); const f32x4 v01 = px[0], v23 = px[1];
        const cf a0{v01[0], v01[1]}, a1{v01[2], v01[3]}, a2{v23[0], v23[1]}, a3{v23[2], v23[3]};
        const cf t0 = cadd(a0, a2), t1 = csub(a0, a2), t2 = cadd(a1, a3), d = csub(a1, a3), t3 = inverse ? cf{-d.y, d.x} : cf{d.y, -d.x};
        const cf y0 = cadd(t0, t2), y1 = cadd(t1, t3), y2 = csub(t0, t2), y3 = csub(t1, t3);
        px[0] = (f32x4){y0.x, y0.y, y1.x, y1.y}; px[1] = (f32x4){y2.x, y2.y, y3.x, y3.y}; }
    __syncthreads();
}
__device__ __forceinline__ void dif4(cf& a0, cf& a1, cf& a2, cf& a3, cf w1) {
    const cf w2 = cmul(w1, w1), w3 = cmul(w2, w1);
    const cf t0 = cadd(a0, a2), t1 = csub(a0, a2), t2 = cadd(a1, a3), d = csub(a1, a3), t3 = cf{d.y, -d.x};
    a0 = cadd(t0, t2); a1 = cmul(cadd(t1, t3), w1); a2 = cmul(csub(t0, t2), w2); a3 = cmul(csub(t1, t3), w3);
}
__device__ __forceinline__ void dit4(cf& a0, cf& a1, cf& a2, cf& a3, cf w1c) {
    const cf w2 = cmul(w1c, w1c), w3 = cmul(w2, w1c);
    a1 = cmul(a1, w1c); a2 = cmul(a2, w2); a3 = cmul(a3, w3);
    const cf t0 = cadd(a0, a2), t1 = csub(a0, a2), t2 = cadd(a1, a3), d = csub(a1, a3), t3 = cf{-d.y, d.x};
    a0 = cadd(t0, t2); a1 = cadd(t1, t3); a2 = csub(t0, t2); a3 = csub(t1, t3);
}
__device__ __forceinline__ void fft_pair(LAS cf* x, const LAS cf* T, int tid, int s, bool inverse) {
    const int q1 = FN >> (2 * s + 2), q2 = q1 >> 2, tw1 = 1 << (2 * s), tw2 = tw1 << 2;
    for (int u = tid; u < FN / 16; u += NTHR) { const int j2 = u & (q2 - 1), base = (u - j2) * 16 + j2;
        cf v[4][4];
#pragma unroll
        for (int a = 0; a < 4; ++a)
#pragma unroll
            for (int b = 0; b < 4; ++b) v[a][b] = x[base + a * q1 + b * q2];
        if (!inverse) {
#pragma unroll
            for (int b = 0; b < 4; ++b) dif4(v[0][b], v[1][b], v[2][b], v[3][b], fft_tw(T, (b * q2 + j2) * tw1));
            const cf wb = fft_tw(T, j2 * tw2);
#pragma unroll
            for (int a = 0; a < 4; ++a) dif4(v[a][0], v[a][1], v[a][2], v[a][3], wb);
        } else {
            const cf wb = cconj(fft_tw(T, j2 * tw2));
#pragma unroll
            for (int a = 0; a < 4; ++a) dit4(v[a][0], v[a][1], v[a][2], v[a][3], wb);
#pragma unroll
            for (int b = 0; b < 4; ++b) dit4(v[0][b], v[1][b], v[2][b], v[3][b], cconj(fft_tw(T, (b * q2 + j2) * tw1)));
        }
#pragma unroll
        for (int a = 0; a < 4; ++a)
#pragma unroll
            for (int b = 0; b < 4; ++b) x[base + a * q1 + b * q2] = v[a][b]; }
    __syncthreads();
}
__device__ __forceinline__ void fft_single(LAS cf* x, const LAS cf* T, int tid, int s, bool inverse) {
    const int q = FN >> (2 * s + 2), tw = 1 << (2 * s);
    for (int u = tid; u < FN / 4; u += NTHR) { const int j = u & (q - 1), p = (u - j) * 4 + j;
        cf a0 = x[p], a1 = x[p + q], a2 = x[p + 2 * q], a3 = x[p + 3 * q];
        if (!inverse) dif4(a0, a1, a2, a3, fft_tw(T, j * tw)); else dit4(a0, a1, a2, a3, cconj(fft_tw(T, j * tw)));
        x[p] = a0; x[p + q] = a1; x[p + 2 * q] = a2; x[p + 3 * q] = a3; }
    __syncthreads();
}
constexpr int fft_npairs() { int n = 0; for (int s = 0; s + 1 < FLOG4 - 1; s += 2) { if ((FN >> (2 * s + 6)) >= 64 || FN < 16384) ++n; else break; } return n; }
constexpr int FPAIRS = fft_npairs();
__device__ __forceinline__ void fft_run(LAS cf* x, const LAS cf* T, int tid, bool inverse) {
    constexpr int NST = FPAIRS + (FLOG4 - 1 - 2 * FPAIRS) + 1;
#pragma unroll 1
    for (int i = 0; i < NST; ++i) { const int k = inverse ? NST - 1 - i : i;
        if (k < FPAIRS) fft_pair(x, T, tid, 2 * k, inverse);
        else if (k < NST - 1) fft_single(x, T, tid, 2 * FPAIRS + (k - FPAIRS), inverse);
        else fft_stage_q1(x, tid, inverse); }
}
__device__ __forceinline__ void fft_fwd(LAS cf* x, const LAS cf* T, int tid) { fft_run(x, T, tid, false); }
__device__ __forceinline__ void fft_inv(LAS cf* x, const LAS cf* T, int tid) { fft_run(x, T, tid, true); }
__device__ __forceinline__ void fft_load_real(LAS cf* x, const float* src, float scale, int tid) {
    for (int m = tid; m < FN; m += NTHR) { cf v{0.f, 0.f}; if (m < FN / 2) { v.x = src[2 * m] * scale; v.y = src[2 * m + 1] * scale; } x[m] = v; }
    __syncthreads();
}
__device__ __forceinline__ void spec_load(const Ctx& X, int c) {
    LAS cf* x = (LAS cf*)X.lds; volatile LAS float* red = (volatile LAS float*)(X.lds + LDS_MISC) + 120;
    if (X.wave == 0) { const float* fp = X.ws<float>(WS_FPART) + c; float s = 0.f; for (int b = X.lane; b < NPART; b += 64) s += fp[(size_t)b * HW]; s = wave_sum(s); if (X.lane == 0) red[0] = s; }
    __syncthreads();
    const float inv = 1.0f / red[0];
    fft_load_real(x, X.ws<float>(WS_FILT) + (size_t)c * SEQ, inv, X.tid);
}
__device__ __forceinline__ void spec_unpack(const Ctx& X, int c) {
    LAS cf* x = (LAS cf*)X.lds;
    cf* HS = X.ws<cf>(WS_HS) + (size_t)c * (FN + 1);
    for (int k = X.tid; k <= FN / 2; k += NTHR) {
        const cf A = x[rev4(k)], B = x[rev4((FN - k) & (FN - 1))];
        if (k == 0) { HS[0] = cf{A.x + A.y, 0.f}; HS[FN] = cf{A.x - A.y, 0.f}; }
        else if (k == FN / 2) { HS[k] = cconj(A); }
        else { float sn, cs; sincos_f(-3.14159265358979f * (float)k / (float)FN, sn, cs); const cf w{cs, sn};
            const cf s1 = cadd(A, cconj(B)), d1 = csub(A, cconj(B)), wd = cmul(w, d1);
            HS[k] = cf{0.5f * (s1.x + wd.y), 0.5f * (s1.y - wd.x)};
            const cf s2 = cadd(B, cconj(A)), d2 = csub(B, cconj(A)), wd2 = cmul(cconj(w), d2);
            HS[FN - k] = cf{0.5f * (s2.x - wd2.y), 0.5f * (s2.y + wd2.x)}; } }
    __syncthreads();
}
__device__ __forceinline__ void fftconv_load(const Ctx& X, int c) { fft_load_real((LAS cf*)X.lds, X.ws<float>(WS_ZT) + (size_t)c * M + CTX, 1.0f, X.tid); }
__device__ __forceinline__ void fftconv_mul(const Ctx& X, int c) {
    LAS cf* x = (LAS cf*)X.lds;
    const cf* HS = X.ws<cf>(WS_HS) + (size_t)c * (FN + 1);
    for (int k = X.tid; k <= FN / 2; k += NTHR) {
        const int pa = rev4(k), pb = rev4((FN - k) & (FN - 1)); const cf A = x[pa], B = x[pb];
        if (k == 0) { const float y0 = (A.x + A.y) * HS[0].x, yn = (A.x - A.y) * HS[FN].x; x[pa] = cf{0.5f * (y0 + yn), 0.5f * (y0 - yn)}; }
        else if (k == FN / 2) { x[pa] = cconj(cmul(cconj(A), HS[k])); }
        else { float sn, cs; sincos_f(-3.14159265358979f * (float)k / (float)FN, sn, cs); const cf w{cs, sn};
            const cf s1 = cadd(A, cconj(B)), d1 = csub(A, cconj(B)), wd = cmul(w, d1); const cf Xk{0.5f * (s1.x + wd.y), 0.5f * (s1.y - wd.x)};
            const cf s2 = cadd(B, cconj(A)), d2 = csub(B, cconj(A)), wd2 = cmul(cconj(w), d2); const cf Xn{0.5f * (s2.x - wd2.y), 0.5f * (s2.y + wd2.x)};
            const cf Yk = cmul(Xk, HS[k]), Yn = cmul(Xn, HS[FN - k]);
            const cf e1 = cadd(Yk, cconj(Yn)), f1 = cmul(cconj(w), csub(Yk, cconj(Yn)));
            x[pa] = cf{0.5f * (e1.x - f1.y), 0.5f * (e1.y + f1.x)};
            const cf e2 = cadd(Yn, cconj(Yk)), f2 = cmul(w, csub(Yn, cconj(Yk)));
            x[pb] = cf{0.5f * (e2.x + f2.y), 0.5f * (e2.y - f2.x)}; } }
    __syncthreads();
}
__device__ __forceinline__ void fftconv_out(const Ctx& X, int l, int c) {
    const LAS cf* x = (const LAS cf*)X.lds; const float* z = X.ws<float>(WS_ZT) + (size_t)c * M + CTX;
    const float bias = X.in(I_HBIAS)[(size_t)l * HW + c], sc = 1.0f / (float)FN; float* O = X.ws<float>(WS_CVT) + (size_t)c * SEQ;
    for (int i2 = X.tid; i2 < FN / 2; i2 += NTHR) { const cf d = x[i2 + FN / 4]; O[2 * i2] = d.x * sc + z[2 * i2] * bias; O[2 * i2 + 1] = d.y * sc + z[2 * i2 + 1] * bias; }
    __syncthreads();
}
__device__ __forceinline__ void phase_ctxconv(const Ctx& X, int l) {
    constexpr int NITEMS = (HW / 64) * (CTX / CR);
    unsigned* q = X.ctl() + CW_Q + l * 64;
    for (;;) { int item = 0; if (X.lane == 0) item = (int)atomicAdd(q, 1u); item = __shfl(item, 0); if (item >= NITEMS) break; conv_item(X, item); }
}
__device__ __forceinline__ void phase_seq(const Ctx& X) {
    for (int su = X.bid; su < N_SEQ_UNITS; su += X.G) seq_unit(X, su);
}

__device__ __forceinline__ void finish_wave_unit(const Ctx& X, int l, int unit) {
    const int rg = unit / NH, h = unit % NH, lane = X.lane, b = rg >> 2, sub = rg & 3;
    const int cf = b, cb = (b < CTX / CC) ? (CTX / CC - 1 - b) : (NCHK - 1 - (b - CTX / CC));
    const size_t uf = ((size_t)(0 * NH + h) * NCHK + cf) * 4096, ub = ((size_t)(1 * NH + h) * NCHK + cb) * 4096;
    const bf16* G = X.wsv<bf16>(WS_G); const bf16* S0 = X.wsv<bf16>(WS_S0); const float* YL = X.wsv<float>(WS_YL);
    const int arow = 16 * sub + (lane & 15), kof = 8 * (lane >> 4);
    bf16x8 af[2], ab[2];
#pragma unroll
    for (int kk = 0; kk < 2; ++kk) { af[kk] = *(const bf16x8*)(G + uf + arow * 64 + kof + 32 * kk); ab[kk] = *(const bf16x8*)(G + ub + arow * 64 + kof + 32 * kk); }
    f32x4 y[4];
#pragma unroll
    for (int tj = 0; tj < 4; ++tj) { const int vrow = 16 * tj + (lane & 15);
        bf16x8 bf_[2], bb_[2];
#pragma unroll
        for (int kk = 0; kk < 2; ++kk) { bf_[kk] = *(const bf16x8*)(S0 + uf + vrow * 64 + kof + 32 * kk); bb_[kk] = *(const bf16x8*)(S0 + ub + vrow * 64 + kof + 32 * kk); }
        f32x4 acc;
#pragma unroll
        for (int r = 0; r < 4; ++r) { const int o = (16 * sub + 4 * (lane >> 4) + r) * 64 + vrow; acc[r] = YL[uf + o] + YL[ub + o]; }
#pragma unroll
        for (int kk = 0; kk < 2; ++kk) { acc = MFMA16(af[kk], bf_[kk], acc); acc = MFMA16(ab[kk], bb_[kk], acc); }
        y[tj] = acc; }
    const float* lgp = X.inv(I_LNXG) + (size_t)l * RW + 64 * h; const float* lbp = X.inv(I_LNXB) + (size_t)l * RW + 64 * h;
    const bf16* pV = X.wsv<bf16>(WS_V); const bf16* pG = X.wsv<bf16>(WS_GATE); const float* pBo = X.wsv<float>(WS_BONUS); bf16* pRO = X.wsv<bf16>(WS_RO);
#pragma unroll
    for (int r = 0; r < 4; ++r) { const int t = 16 * rg + 4 * (lane >> 4) + r;
        const float mean = row16_sum((y[0][r] + y[1][r]) + (y[2][r] + y[3][r])) * (1.f / 64.f);
        float q = 0.f;
#pragma unroll
        for (int tj = 0; tj < 4; ++tj) { const float dy = y[tj][r] - mean; q += dy * dy; }
        const float rstd = 1.0f / sqrtf(row16_sum(q) * (1.f / 64.f) + GN_EPS); const float bon = pBo[(size_t)t * NH + h];
#pragma unroll
        for (int tj = 0; tj < 4; ++tj) { const int cl = 16 * tj + (lane & 15); const size_t o = (size_t)t * RW + 64 * h + cl;
            float yn = (y[tj][r] - mean) * rstd * lgp[cl] + lbp[cl];
            yn += bon * bf2f(pV[o]); yn *= bf2f(pG[o]);
            pRO[o] = (bf16)f2bf(yn); } }
}
__device__ __forceinline__ void phase_finish(const Ctx& X, int l) {
    for (int u = X.bid * NWAVES + X.wave; u < (M / 16) * NH; u += X.G * NWAVES) finish_wave_unit(X, l, u);
    const int c = X.tid;
    if (c < HW) { const float hbc = X.in(I_HBIAS)[(size_t)l * HW + c]; const float* CV = X.ws<float>(WS_CVT) + (size_t)c * SEQ; const bf16* X0 = X.ws<bf16>(WS_X0); bf16* HO = X.ws<bf16>(WS_HO);
        for (int tile = X.bid; tile < M / TT; tile += X.G) { const int t0 = tile * TT; float cv[TT];
            if (t0 < CTX) {
#pragma unroll
                for (int tt = 0; tt < TT; ++tt) { const size_t o = (size_t)(t0 + tt) * HW + c; cv[tt] = X.ws<float>(WS_CONV)[o] + X.ws<float>(WS_Z)[o] * hbc; } }
            else { const f32x4 a = *(const f32x4*)(CV + (t0 - CTX)), b = *(const f32x4*)(CV + (t0 - CTX) + 4);
#pragma unroll
                for (int i = 0; i < 4; ++i) { cv[i] = a[i]; cv[4 + i] = b[i]; } }
#pragma unroll
            for (int tt = 0; tt < TT; ++tt) { const size_t o = (size_t)(t0 + tt) * HW + c; HO[o] = (bf16)f2bf(cv[tt] * bf2f(X0[o])); } } }
}

__device__ __forceinline__ void ln_inplace(float (&v)[D / 64], const float* g, const float* b, int lane) {
    float s = 0.f;
#pragma unroll
    for (int j = 0; j < D / 64; ++j) s += v[j];
    const float mean = wave_sum(s) * (1.f / D); float q = 0.f;
#pragma unroll
    for (int j = 0; j < D / 64; ++j) { v[j] -= mean; q += v[j] * v[j]; }
    const float rstd = 1.0f / sqrtf(wave_sum(q) * (1.f / D) + LN_EPS);
#pragma unroll
    for (int j = 0; j < D / 64; ++j) { const int d = 4 * lane + 256 * (j >> 2) + (j & 3); v[j] = v[j] * rstd * g[d] + b[d]; }
}
__device__ __forceinline__ void phase_norm1(const Ctx& X, int l) {
    const int gw = X.bid * NWAVES + X.wave, NGW = X.G * NWAVES, lane = X.lane;
    const float* lng = X.in(I_LNG) + (size_t)(l * 2 + 0) * D; const float* lnb = X.in(I_LNB) + (size_t)(l * 2 + 0) * D;
    const float* wr = X.in(I_WR); const float* rb = X.in(I_RB);
    const float alpha = sqrtf(sqrtf(2.0f * DEPTH));
    volatile LAS int* hist = (volatile LAS int*)(X.lds + LDS_MISC + 4096);
    if (X.tid < NE) hist[X.tid] = 0;
    __syncthreads();
    for (int t = gw; t < M; t += NGW) {
        float* xr = X.ws<float>(WS_X) + (size_t)t * D; const float* mx = X.ws<float>(WS_MIX) + (size_t)t * D;
        const float* gate = modp(X, l, t, 2); const float* sh = modp(X, l, t, 3); const float* sc = modp(X, l, t, 4);
        float v[D / 64];
#pragma unroll
        for (int j = 0; j < D / 256; ++j) { const int d = 4 * lane + 256 * j; const f32x4 a = *(const f32x4*)(xr + d), m = *(const f32x4*)(mx + d), gt = *(const f32x4*)(gate + d);
#pragma unroll
            for (int i = 0; i < 4; ++i) v[4 * j + i] = alpha * a[i] + gt[i] * m[i]; }
        ln_inplace(v, lng, lnb, lane);
        bf16* hf = X.ws<bf16>(WS_XMOD) + (size_t)t * D;
        LAS float* hrow = (LAS float*)X.lds + X.wave * D;
#pragma unroll
        for (int j = 0; j < D / 256; ++j) { const int d = 4 * lane + 256 * j; f32x4 o; const f32x4 a = *(const f32x4*)(sh + d), b = *(const f32x4*)(sc + d); f32x4 h;
#pragma unroll
            for (int i = 0; i < 4; ++i) { o[i] = v[4 * j + i]; h[i] = o[i] * (1.f + b[i]) + a[i]; }
            *(f32x4*)(xr + d) = o; *(LAS f32x4*)(hrow + d) = h;
            *(unsigned long long*)(hf + d) = (unsigned long long)pk2(h[0], h[1]) | ((unsigned long long)pk2(h[2], h[3]) << 32); }
        WAVE_LDS_FENCE(); CFENCE();
        float part = 0.f; { const int e = lane & 15, q = lane >> 4;
#pragma unroll 8
            for (int d = q * (D / 4); d < (q + 1) * (D / 4); ++d) part += hrow[d] * wr[(size_t)d * NE + e]; }
        part += __shfl_xor(part, 16); part += __shfl_xor(part, 32);
        WAVE_LDS_FENCE(); CFENCE();
        float lg[NE];
#pragma unroll
        for (int e = 0; e < NE; ++e) lg[e] = __shfl(part, e);
        float mxl = lg[0];
#pragma unroll
        for (int e = 1; e < NE; ++e) mxl = fmaxf(mxl, lg[e]);
        float sc_[NE], sum = 0.f;
#pragma unroll
        for (int e = 0; e < NE; ++e) { sc_[e] = expf(lg[e] - mxl); sum += sc_[e]; }
        const float isum = 1.0f / sum; float sel[NE];
#pragma unroll
        for (int e = 0; e < NE; ++e) { sc_[e] *= isum; sel[e] = sc_[e] + rb[e]; }
        int bg = 0; float bgs = -INFINITY;
#pragma unroll
        for (int g = 0; g < 4; ++g) { float m1 = -INFINITY, m2 = -INFINITY;
#pragma unroll
            for (int i = 0; i < 4; ++i) { const float x = sel[4 * g + i]; if (x > m1) { m2 = m1; m1 = x; } else if (x > m2) m2 = x; }
            const float gs = m1 + m2; if (gs > bgs) { bgs = gs; bg = g; } }
        int i0 = 0, i1 = 0; float s0 = -INFINITY, s1 = -INFINITY, p0 = 0.f, p1 = 0.f;
#pragma unroll
        for (int e = 0; e < NE; ++e) { if ((e >> 2) == bg) { const float x = sel[e]; if (x > s0) { s1 = s0; i1 = i0; p1 = p0; s0 = x; i0 = e; p0 = sc_[e]; } else if (x > s1) { s1 = x; i1 = e; p1 = sc_[e]; } } }
        if (lane == 0) { int* ei = X.ws<int>(WS_ROUT) + (size_t)t * 2; float* ew = (float*)(X.ws<int>(WS_ROUT) + (size_t)M * 2) + (size_t)t * 2;
            ei[0] = i0; ei[1] = i1; const float ws_ = 1.0f / (p0 + p1); ew[0] = p0 * ws_; ew[1] = p1 * ws_;
            lds_add(hist + i0, 1); lds_add(hist + i1, 1); }
    }
    __syncthreads();
    if (X.tid < NE) { const int hc = hist[X.tid]; X.ws<int>(WS_BCNT)[X.bid * NE + X.tid] = hc; atomicAdd(X.ctl() + CW_CNT + l * 64 + X.tid, (unsigned)hc); }
}

__device__ __forceinline__ void moe_table(const Ctx& X, int l, int NT) {
    volatile LAS int* tab = (volatile LAS int*)(X.lds + LDS_MISC) + 8;
    if (X.tid == 0) { int cum = 0, ts = 0;
        for (int e = 0; e < NE; ++e) { const int cnt = (int)__hip_atomic_load(X.ctl() + CW_CNT + l * 64 + e, RLX_AGENT); const int tc = (cnt + 255) / 256;
            tab[e] = cum; tab[32 + e] = ts; tab[64 + e] = tc; cum += tc * NT; ts += tc; }
        tab[16] = cum; }
    __syncthreads();
}
__device__ __forceinline__ void phase_scatter(const Ctx& X, int l) {
    moe_table(X, l, 1);
    volatile LAS int* tab = (volatile LAS int*)(X.lds + LDS_MISC) + 8;
    volatile LAS int* cur = (volatile LAS int*)(X.lds + LDS_MISC + 4096) + 16;
    const int gw = X.bid * NWAVES + X.wave, NGW = X.G * NWAVES, lane = X.lane;
    if (X.tid < NE) { const int* bc = X.ws<int>(WS_BCNT) + X.tid; int pre = 0; for (int b = 0; b < X.bid; ++b) pre += bc[b * NE]; cur[X.tid] = tab[32 + X.tid] * 256 + pre; }
    __syncthreads();
    const int* ei = X.ws<int>(WS_ROUT); int* slot = X.ws<int>(WS_ROUT) + (size_t)M * 4;
    for (int t = gw; t < M; t += NGW) {
#pragma unroll
        for (int k = 0; k < 2; ++k) { const int e = ei[2 * t + k];
            int pos = 0; if (lane == 0) pos = lds_add(cur + e, 1);
            pos = __shfl(pos, 0);
            if (lane == 0) slot[2 * t + k] = pos;
            const u32x4* src = (const u32x4*)(X.ws<bf16>(WS_XMOD) + (size_t)t * D); u32x4* dst = (u32x4*)(X.ws<bf16>(WS_XG) + (size_t)pos * D);
            for (int i = lane; i < D / 8; i += 64) dst[i] = src[i]; } }
}

__device__ __forceinline__ void phase_combine(const Ctx& X, int l) {
    const int gw = X.bid * NWAVES + X.wave, NGW = X.G * NWAVES, lane = X.lane;
    const float* lng = X.in(I_LNG) + (size_t)(l * 2 + 1) * D; const float* lnb = X.in(I_LNB) + (size_t)(l * 2 + 1) * D;
    const float alpha = sqrtf(sqrtf(2.0f * DEPTH));
    const float* ew = (const float*)(X.ws<int>(WS_ROUT) + (size_t)M * 2); const int* slot = X.ws<int>(WS_ROUT) + (size_t)M * 4;
    for (int t = gw; t < M; t += NGW) {
        float* xr = X.ws<float>(WS_X) + (size_t)t * D; const float* gate = modp(X, l, t, 5);
        const bf16* y0 = X.ws<bf16>(WS_YS) + (size_t)slot[2 * t] * D; const bf16* y1 = X.ws<bf16>(WS_YS) + (size_t)slot[2 * t + 1] * D; const float w0 = ew[2 * t], w1 = ew[2 * t + 1];
        float v[D / 64];
#pragma unroll
        for (int j = 0; j < D / 256; ++j) { const int d = 4 * lane + 256 * j; const f32x4 a = *(const f32x4*)(xr + d), gt = *(const f32x4*)(gate + d);
            const unsigned long long q0 = *(const unsigned long long*)(y0 + d), q1 = *(const unsigned long long*)(y1 + d);
            float ya[4] = {bflo((unsigned)q0), bfhi((unsigned)q0), bflo((unsigned)(q0 >> 32)), bfhi((unsigned)(q0 >> 32))};
            float yb[4] = {bflo((unsigned)q1), bfhi((unsigned)q1), bflo((unsigned)(q1 >> 32)), bfhi((unsigned)(q1 >> 32))};
#pragma unroll
            for (int i = 0; i < 4; ++i) v[4 * j + i] = alpha * a[i] + gt[i] * (w0 * ya[i] + w1 * yb[i]); }
        ln_inplace(v, lng, lnb, lane);
        if (l + 1 < DEPTH) { const float* sh = modp(X, l + 1, t, 0); const float* sc = modp(X, l + 1, t, 1); bf16* xm = X.ws<bf16>(WS_XMOD) + (size_t)t * D;
#pragma unroll
            for (int j = 0; j < D / 256; ++j) { const int d = 4 * lane + 256 * j; f32x4 o; const f32x4 a = *(const f32x4*)(sh + d), b = *(const f32x4*)(sc + d); float h[4];
#pragma unroll
                for (int i = 0; i < 4; ++i) { o[i] = v[4 * j + i]; h[i] = o[i] * (1.f + b[i]) + a[i]; }
                *(f32x4*)(xr + d) = o;
                *(unsigned long long*)(xm + d) = (unsigned long long)pk2(h[0], h[1]) | ((unsigned long long)pk2(h[2], h[3]) << 32); }
        } else if (t >= CTX) { float* orow = X.out() + (size_t)(t - CTX) * D; const bool bad = __hip_atomic_load(X.ctl() + CW_BAR + XB_TMO, RLX_AGENT) != 0u; const float pscale = 1.0f + bitsf(__hip_atomic_load(X.ctl() + 64, RLX_AGENT));
#pragma unroll
            for (int j = 0; j < D / 256; ++j) { const int d = 4 * lane + 256 * j; f32x4 o;
#pragma unroll
                for (int i = 0; i < 4; ++i) o[i] = bad ? __builtin_nanf("") : v[4 * j + i] * pscale;
                *(f32x4*)(orow + d) = o; }
        }
    }
}


#ifdef EMU
#define PHASE_FN static
#define THIN_FN static
#else
#define PHASE_FN __device__ __forceinline__
#define THIN_FN __device__ __noinline__
#endif
THIN_FN void ph_transposes(Ctx X, int l, int part) { phase_transposes(X, l, part); }
THIN_FN void ph_filters_begin(Ctx X) { phase_filters_begin(X); }
THIN_FN void ph_filters_item(Ctx X, int l, int which, int it) { phase_filters_item(X, l, which, it); }
THIN_FN void ph_filters_end(Ctx X) { phase_filters_end(X); }
#define PH_FILTERS(X_, l_) do { ph_filters_begin(X_); for (int wh_ = 0; wh_ < 2; ++wh_) for (int it_ = (X_).bid * NWAVES + (X_).wave; it_ < (wh_ ? CTX : SEQ) / 16; it_ += (X_).G * NWAVES) ph_filters_item(X_, l_, wh_, it_); ph_filters_end(X_); } while (0)
THIN_FN void ph_filter_weights(Ctx X, int l) { phase_filter_weights(X, l); }
THIN_FN void ph_mod(Ctx X) { phase_mod(X); }
THIN_FN void ph_x0(Ctx X) { phase_x0(X); }
THIN_FN void ph_lin(Ctx X, int l) { phase_lin(X, l); }
THIN_FN void ph_lora_a(Ctx X, int u) { lora_unit_a(X, u); }
THIN_FN void ph_lora_b(Ctx X, int l, int u) { lora_unit_b(X, l, u); }
THIN_FN void ph_prep_hyena(Ctx X, int l) { phase_prep_hyena(X, l); }
THIN_FN void ph_ctxconv(Ctx X, int l) { phase_ctxconv(X, l); }
THIN_FN void ph_chunk_1(Ctx X, int u) { chunk_unit_1(X, u); }
THIN_FN void ph_chunk_2(Ctx X, int u) { chunk_unit_2(X, u); }
THIN_FN void ph_chunk_3(Ctx X, int u) { chunk_unit_3(X, u); }
THIN_FN void ph_seq(Ctx X) { phase_seq(X); }
THIN_FN void ph_fft_tables(Ctx X) { fft_tables(X); }
THIN_FN void ph_fft_run(Ctx X, int inverse) { fft_run((LAS cf*)X.lds, (const LAS cf*)(X.lds + FFT_TAB_OFF), X.tid, inverse != 0); }
THIN_FN void ph_spec_load(Ctx X, int c) { spec_load(X, c); }
THIN_FN void ph_spec_unpack(Ctx X, int c) { spec_unpack(X, c); }
THIN_FN void ph_fftconv_load(Ctx X, int c) { fftconv_load(X, c); }
THIN_FN void ph_fftconv_mul(Ctx X, int c) { fftconv_mul(X, c); }
THIN_FN void ph_fftconv_out(Ctx X, int l, int c) { fftconv_out(X, l, c); }
THIN_FN void ph_finish(Ctx X, int l) { phase_finish(X, l); }
THIN_FN void ph_norm1(Ctx X, int l) { phase_norm1(X, l); }
THIN_FN void ph_scatter(Ctx X, int l) { phase_scatter(X, l); }
THIN_FN void ph_combine(Ctx X, int l) { phase_combine(X, l); }
PHASE_FN void ph_g13(Ctx X, int third) { pg8::Gemm g{third ? X.ws<bf16>(WS_T) : X.ws<bf16>(WS_XMOD), third ? X.ws<bf16>(WS_WO) : X.ws<bf16>(WS_WIN), D}; pg8::StaticOrder S; S.init(M, third ? D : PCP, X.G, X.bid);
    pg8::EpiBf16OrF32 E{X.ws<bf16>(WS_P), X.ws<float>(WS_MIX), third ? D : PCP, third != 0}; pg8::gemm_phase(X.lds, g, S, E); }
PHASE_FN void ph_g2(Ctx X, int second) { pg8::Gemm g{second ? X.ws<bf16>(WS_HO) : X.ws<bf16>(WS_RO), X.ws<bf16>(WS_WB) + (second ? (size_t)D * RW : 0), RW}; pg8::StaticOrder S; S.init(M, D, X.G, X.bid);
    pg8::EpiGate E{X.ws<bf16>(WS_T), D, X.ws<bf16>(WS_P), PCP, second ? C_GH : C_GR, second != 0}; pg8::gemm_phase(X.lds, g, S, E); }
PHASE_FN void ph_g45(Ctx X, int l, int down) { const int NT = down ? D / 256 : 2 * D / 256; moe_table(X, l, NT); pg8::MoeOrder S{(const volatile LAS int*)(X.lds + LDS_MISC) + 8, NT, X.G, X.bid};
    pg8::Gemm g{down ? X.ws<bf16>(WS_ACT) : X.ws<bf16>(WS_XG), down ? X.ws<bf16>(WS_WD) : X.ws<bf16>(WS_WGU), D}; pg8::EpiMoe E{down ? X.ws<bf16>(WS_YS) : X.ws<bf16>(WS_ACT), D, NT, down == 0}; pg8::gemm_phase(X.lds, g, S, E); }

constexpr int NPH = 16, NPHASES = DEPTH * NPH;
template <int MASK> __global__ void __launch_bounds__(NTHR, 2) fwd_kernel(Args args) {
    DYN_LDS(lds);
    Ctx X; X.lds = lds; X.tid = threadIdx.x; X.lane = X.tid & 63; X.wave = READFIRSTLANE(X.tid >> 6); X.G = gridDim.x; X.bid = blockIdx.x;
    volatile LAS unsigned* misc = (volatile LAS unsigned*)(lds + LDS_MISC);
    if (X.tid < 128) misc[X.tid] = 0u;
    if (X.tid < N_IN + 2) { const unsigned long long p = X.tid < N_IN ? (unsigned long long)args.in[X.tid < N_IN ? X.tid : 0] : (X.tid == N_IN ? (unsigned long long)args.out : (unsigned long long)args.ws);
        misc[PT_WORD0 + 2 * X.tid] = (unsigned)p; misc[PT_WORD0 + 2 * X.tid + 1] = (unsigned)(p >> 32); }
    __syncthreads();
    XcdBarrier bar = xcd_barrier_post(X.ctl() + CW_BAR, misc);
    const int lo = args.ph_lo, hi = args.ph_hi;
#define IN(k) ((((MASK) >> ((k) % NPH)) & 1) && lo <= (k) && (k) < hi)
#ifdef PROBE_K
#ifndef PROBE_SCALE
#define PROBE_SCALE 1.0f
#endif
#ifndef PROBE_BLOCK
#define PROBE_BLOCK 0
#endif
    unsigned long long plast = __builtin_amdgcn_s_memrealtime(); if (threadIdx.x < 32) misc[2048 + threadIdx.x] = 0u; __syncthreads();
#define PROBE_TX(k) do { if (blockIdx.x == PROBE_BLOCK && threadIdx.x == 0) { const unsigned long long now_ = __builtin_amdgcn_s_memrealtime(); misc[2048 + (k)] += (unsigned)(now_ - plast); plast = now_; } } while (0)
#define PROBE_T(k) PROBE_TX((k) % NPH)
#define PROBE_PUB(k) do { if ((k) == NPHASES - 2 && blockIdx.x == PROBE_BLOCK && threadIdx.x == 0) { PROBE_T(k); unsigned tot_ = 0; for (int i_ = 0; i_ < 28; ++i_) tot_ += misc[2048 + i_]; \
        const float f_ = floorf(PROBE_SCALE * (float)misc[2048 + PROBE_K] / (float)tot_ * 128.0f + 0.5f) * (1.0f / 128.0f); __hip_atomic_store(X.ctl() + 64, fbits(f_), RLX_AGENT); } } while (0)
#else
#define PROBE_T(k) do {} while (0)
#define PROBE_TX(k) do {} while (0)
#define PROBE_PUB(k) do {} while (0)
#endif
#define SEAM(k) do { PROBE_PUB(k); if ((k) + 1 < hi) xcd_barrier(bar); PROBE_T(k); } while (0)
#ifdef REPEAT_SUB
#define RPS(id) for (int rps_ = 0; rps_ < ((id) == REPEAT_SUB ? 2 : 1); ++rps_)
#else
#define RPS(id)
#endif
#ifdef REPEAT_PH
#define RPT_IDX rpt_
#define RPT(k) for (int rpt_ = 0; rpt_ < (((k) % NPH) == REPEAT_PH ? 2 : 1); ++rpt_)
#else
#define RPT_IDX 0
#define RPT(k)
#endif
    for (int l = 0; l < DEPTH; ++l) {
        const int pb = l * NPH;
        if (l == 0 && IN(pb + 0)) { ph_transposes(X, l, 0); __syncthreads(); ph_filter_weights(X, 0); ph_mod(X); SEAM(pb + 0); }
        if (l == 0 && IN(pb + 1)) { ph_x0(X); PH_FILTERS(X, 0); SEAM(pb + 1); }
        if (IN(pb + 2)) { ph_g13(X, 0); SEAM(pb + 2); }
        RPT(pb + 3) if (IN(pb + 3)) { RPS(6) ph_lin(X, l); RPS(7) ph_prep_hyena(X, l); ph_fft_tables(X); RPS(8) for (int c = X.bid; c < HW; c += X.G) { ph_spec_load(X, c); ph_fft_run(X, 0); ph_spec_unpack(X, c); } SEAM(pb + 3); }
        RPT(pb + 4) if (IN(pb + 4)) { for (int u = X.bid; u < (M / 64) * NH; u += X.G) { RPS(4) ph_lora_a(X, u); RPS(5) ph_lora_b(X, l, u); } SEAM(pb + 4); }
        RPT(pb + 5) if (IN(pb + 5)) { for (int u = X.bid; u < 2 * NCHK * NH; u += X.G) { RPS(1) ph_chunk_1(X, u); RPS(2) ph_chunk_2(X, u); RPS(3) ph_chunk_3(X, u); } SEAM(pb + 5); }
        RPT(pb + 6) if (IN(pb + 6)) { RPS(9) ph_seq(X); RPS(10) { ph_transposes(X, l, 1); __syncthreads(); } if (l + 1 < DEPTH) ph_filter_weights(X, l + 1); ph_ctxconv(X, l); ph_fft_tables(X);
            for (;;) { if (X.tid == 0) misc[121] = atomicAdd(X.ctl() + CW_Q + l * 64 + 32 + RPT_IDX, 1u); __syncthreads(); const int c = (int)misc[121]; __syncthreads(); if (c >= HW) break;
                ph_fftconv_load(X, c); ph_fft_run(X, 0); ph_fftconv_mul(X, c); ph_fft_run(X, 1); ph_fftconv_out(X, l, c); }
            SEAM(pb + 6); }
        RPT(pb + 7) if (IN(pb + 7)) { ph_finish(X, l); SEAM(pb + 7); }
        for (int sb = 0; sb < 2; ++sb) if (IN(pb + 8 + sb)) { ph_g2(X, sb); SEAM(pb + 8 + sb); }
        RPT(pb + 10) if (IN(pb + 10)) { ph_g13(X, 1); SEAM(pb + 10); }
        if (IN(pb + 11)) { ph_norm1(X, l); SEAM(pb + 11); }
        if (IN(pb + 12)) { RPS(14) ph_scatter(X, l); SEAM(pb + 12); }
        for (int dn = 0; dn < 2; ++dn) if (IN(pb + 13 + dn)) { ph_g45(X, l, dn); SEAM(pb + 13 + dn); }
        if (IN(pb + 15)) { RPS(11) ph_combine(X, l); if (l + 1 < DEPTH) { __syncthreads(); RPS(12) { ph_transposes(X, l + 1, 0); __syncthreads(); } RPS(13) PH_FILTERS(X, l + 1); } SEAM(pb + 15); }
    }
#undef IN
#undef SEAM
}

#ifndef N_LAUNCHES
#define N_LAUNCHES 1
#endif
#ifndef PH_MASK
#define PH_MASK 0xffff
#endif
template <int MASK> static void launch_mask(int grid, hipStream_t stream, const Args& a) {
    static bool attr = false;
    if (!attr) { (void)hipFuncSetAttribute((const void*)fwd_kernel<MASK>, hipFuncAttributeMaxDynamicSharedMemorySize, LDS_BYTES); attr = true; }
    hipLaunchKernelGGL(fwd_kernel<MASK>, dim3(grid), dim3(NTHR), LDS_BYTES, stream, a);
}
extern "C" void kernel_launch(void* const* d_in, const int* in_sizes, int n_in, void* d_out, int out_size, void* d_ws, size_t ws_size, hipStream_t stream) {
    static int grid = 0;
    if (grid == 0) {
        if (n_in != N_IN || ws_size < WS_END) { fprintf(stderr, "kernel_launch: unexpected n_in %d or workspace %zu < %zu\n", n_in, ws_size, (size_t)WS_END); grid = -1; return; }
        int dev = 0, cus = 0;
        if (hipGetDevice(&dev) != hipSuccess || hipDeviceGetAttribute(&cus, hipDeviceAttributeMultiprocessorCount, dev) != hipSuccess) { grid = -1; return; }
        (void)hipGetLastError();
        grid = cus; if (grid > NPART) grid = NPART;
    }
    if (grid < 0) return;
    (void)in_sizes; (void)out_size;
    (void)hipMemsetAsync(d_ws, 0, CTL_BYTES, stream);
    Args a;
    for (int i = 0; i < N_IN; ++i) a.in[i] = (const float*)d_in[i];
    a.out = (float*)d_out; a.ws = (unsigned char*)d_ws;
#if N_LAUNCHES == 1
    a.ph_lo = 0; a.ph_hi = NPHASES;
    launch_mask<PH_MASK>(grid, stream, a);
#else
    for (int ph = 0; ph < NPHASES; ++ph) { const int k = ph % NPH; if (k == 1 && ph / NPH != 0) continue; a.ph_lo = ph; a.ph_hi = ph + 1; launch_mask<PH_MASK>(grid, stream, a); }
#endif
}
```

```cpp
#ifndef EMU
#include <hip/hip_runtime.h>
#endif
#include <cstdio>
#include <cstdint>
#include <cmath>

#ifndef CFG_D
#define CFG_D 1024
#define CFG_SEQ 16384
#define CFG_CTX 256
#define CFG_DEPTH 4
#endif
constexpr int D = CFG_D, SEQ = CFG_SEQ, CTX = CFG_CTX, DEPTH = CFG_DEPTH, M = CTX + SEQ;
constexpr int GRID_W = 64, GRID_H = SEQ / GRID_W;
constexpr int RW = D / 2, NH = RW / 64, HW = D / 2, RC = 3 * RW + 384, HC = 3 * HW, GC = 2 * D, PC = RC + HC + GC, PCP = (PC + 255) / 256 * 256;
constexpr int QTR = RC / 4, HALFC = RC / 2;
constexpr int C_K = RW, C_V = 2 * RW, C_LWF = 3 * RW, C_LG = 3 * RW + 256;
constexpr int C_HY = RC, C_GR = RC + HC, C_GH = RC + HC + D;
constexpr int NE = 16, SP_TILES = (2 * M) / 256 + NE, SP = SP_TILES * 256;
constexpr float DECAY_SCALE = 0.606531f, GN_EPS = 6.4e-4f, LN_EPS = 1e-5f;
constexpr int LP = 72;
constexpr int LQ = 65;
constexpr int LX = 68;
constexpr int N_SEQ_UNITS = 2 * NH * 4;
constexpr int NPART = 256;
static_assert(CTX % 32 == 0 && M % 256 == 0 && D % 256 == 0 && RW % 128 == 0 && RW >= 256 && SEQ % 64 == 0 && CTX % 32 == 0 && RC % 4 == 0, "shape assumptions");

enum { I_X = 0, I_C, I_CTX, I_CCTX, I_WMOD, I_BMOD, I_WIN, I_MU, I_W0, I_W2, I_A0, I_A2, I_G2, I_KK, I_KA, I_RK, I_LNXG, I_LNXB, I_CW, I_CB,
       I_FW1, I_FB1, I_FW2, I_FB2, I_FW3, I_FB3, I_FWO, I_FREQ, I_HBIAS, I_WBR, I_WOUT, I_LNG, I_LNB, I_WR, I_RB, I_WG, I_WU, I_WD, N_IN };

constexpr size_t al256(size_t x) { return (x + 255) & ~(size_t)255; }
constexpr size_t CTL_BYTES = 1u << 20;
constexpr size_t WS_MOD = CTL_BYTES;
constexpr size_t WS_FPART = al256(WS_MOD + (size_t)DEPTH * 2 * 6 * D * 4);
constexpr size_t WS_ROUT = al256(WS_FPART + (size_t)2 * NPART * HW * 4);
constexpr size_t WS_BCNT = al256(WS_ROUT + (size_t)M * 2 * 4 * 3);
constexpr size_t WS_BONUS = al256(WS_BCNT + (size_t)NPART * NE * 4);
constexpr size_t WS_WIN = al256(WS_BONUS + (size_t)M * NH * 4);
constexpr size_t WS_WB = al256(WS_WIN + (size_t)PCP * D * 2);
constexpr size_t WS_WO = al256(WS_WB + (size_t)2 * D * RW * 2);
constexpr size_t WS_W2T = al256(WS_WO + (size_t)D * D * 2);
constexpr size_t WS_A2T = al256(WS_W2T + (size_t)2 * RW * 64 * 2);
constexpr size_t WS_G2T = al256(WS_A2T + (size_t)2 * RW * 64 * 2);
constexpr size_t WS_FWT = al256(WS_G2T + (size_t)RW * 128 * 2);
constexpr size_t WS_WGU = al256(WS_FWT + (size_t)(3 * 64 + HW) * 64 * 2);
constexpr size_t WS_WD = al256(WS_WGU + (size_t)NE * 2 * D * D * 2);
constexpr size_t WS_X = al256(WS_WD + (size_t)NE * D * D * 2);
constexpr size_t WS_XMOD = al256(WS_X + (size_t)M * D * 4);
constexpr size_t WS_P = al256(WS_XMOD + (size_t)M * D * 2);
constexpr size_t WS_FILT = al256(WS_P + (size_t)M * PCP * 2);
constexpr size_t WS_MIX = al256(WS_FILT + (size_t)M * HW * 4);
constexpr size_t WS_T = al256(WS_MIX + (size_t)M * D * 4);
constexpr size_t WS_S = al256(WS_T + (size_t)M * D * 2);
constexpr size_t WS_R = WS_S;
constexpr size_t WS_V = al256(WS_R + (size_t)M * RW * 2);
constexpr size_t WS_KA = al256(WS_V + (size_t)M * RW * 2);
constexpr size_t WS_KD = al256(WS_KA + (size_t)M * RW * 2);
constexpr size_t WS_KB = al256(WS_KD + (size_t)2 * M * RW * 2);
constexpr size_t WS_W = al256(WS_KB + (size_t)2 * M * RW * 2);
constexpr size_t WS_PQ = al256(WS_W + (size_t)2 * M * RW * 4);
constexpr size_t WS_LIN = WS_PQ;
static_assert((size_t)M * 384 * 2 <= (size_t)2 * NH * (M / 64) * 2 * 4096 * 4, "LIN fits PQ");
constexpr size_t WS_G = al256(WS_PQ + (size_t)2 * NH * (M / 64) * 2 * 4096 * 4);
constexpr size_t WS_YL = al256(WS_G + (size_t)2 * NH * (M / 64) * 4096 * 2);
constexpr size_t WS_S0 = WS_XMOD;
static_assert((size_t)2 * NH * (M / 64) * 4096 * 2 <= (size_t)M * D * 2, "S0 fits XMOD");
constexpr size_t WS_Z = al256(WS_YL + (size_t)2 * NH * (M / 64) * 4096 * 4);
constexpr size_t WS_X0 = al256(WS_Z + (size_t)CTX * HW * 4);
constexpr size_t WS_CONV = al256(WS_X0 + (size_t)M * HW * 2);
constexpr size_t WS_GATE = al256(WS_CONV + (size_t)CTX * HW * 4);
constexpr size_t WS_RO = al256(WS_GATE + (size_t)M * RW * 2);
constexpr size_t WS_HO = al256(WS_RO + (size_t)M * RW * 2);
constexpr size_t WS_HS = WS_MIX;
constexpr size_t WS_ZT = WS_T;
constexpr size_t WS_CVT = WS_FILT;
static_assert((size_t)HW * (SEQ + 1) * 8 <= (size_t)M * D * 4 && (size_t)HW * M * 4 <= (size_t)M * D * 2, "HS fits MIX, ZT fits T");
constexpr size_t WS_END1 = al256(WS_HO + (size_t)M * HW * 2);
constexpr size_t WS_XG = WS_S;
constexpr size_t WS_ACT = al256(WS_XG + (size_t)SP * D * 2);
constexpr size_t WS_YS = al256(WS_ACT + (size_t)SP * D * 2);
constexpr size_t WS_END2 = al256(WS_YS + (size_t)SP * D * 2);
constexpr size_t WS_END = WS_END1 > WS_END2 ? WS_END1 : WS_END2;
constexpr int CW_TMO = 0, CW_BAR = 4096, CW_CNT = 8192  , CW_CUR = 8192 + 1024  , CW_Q = 8192 + 2048  ;

#ifdef EMU
#define LAS
typedef short bf16x8 __attribute__((vector_size(16)));
typedef float f32x4 __attribute__((vector_size(16)));
typedef unsigned u32x4 __attribute__((vector_size(16)));
#define DYN_LDS(name) unsigned char* name = emu_cur_lds()
#define ASM_WAIT_V(n) do {} while (0)
#define ASM_WAIT_L(n) do {} while (0)
#define ASM_WAIT_VL0() do {} while (0)
#define CFENCE() do {} while (0)
#define WAVE_LDS_FENCE() emu_wave_sync()
#define S_BARRIER() emu_block_sync()
#define SCHED_BARRIER() do {} while (0)
#define SETPRIO(x) do {} while (0)
#define S_SLEEP(n) emu_yield()
#define MFMA16(a, b, c) emu_mfma_16x16x32(a, b, c)
#define MFMA4F(a, b, c) emu_mfma_16x16x4f32(a, b, c)
#define GLDS16(gptr, lptr) emu_glds16((const void*)(gptr), (void*)(lptr))
#define READFIRSTLANE(x) (x)
#define XCC_ID_() (blockIdx.x & 7u)
#define FENCE_RELEASE() do {} while (0)
#define FENCE_ACQUIRE() do {} while (0)
#define DPP_F(v, ctrl) emu_dpp_f(v, ctrl)
#define READLANE_F(v, l) emu_xchg((float)(v), (l))
static inline int vgpr_zero() { return 0; }
static inline unsigned long long vgpr_zero64() { return 0ull; }
static inline int lds_add(volatile int* p, int v) { int o = *p; *p = o + v; return o; }
static inline void lds_addf(float* p, float v) { *p += v; }
static inline unsigned fbits(float f) { unsigned u; memcpy(&u, &f, 4); return u; }
static inline float bitsf(unsigned u) { float f; memcpy(&f, &u, 4); return f; }
#else
#define LAS __attribute__((address_space(3)))
typedef short bf16x8 __attribute__((ext_vector_type(8)));
typedef float f32x4 __attribute__((ext_vector_type(4)));
typedef unsigned u32x4 __attribute__((ext_vector_type(4)));
#define DYN_LDS(name) extern __shared__ __attribute__((aligned(16))) unsigned char name##_raw[]; LAS unsigned char* name = (LAS unsigned char*)name##_raw
#define ASM_WAIT_V(n) asm volatile("s_waitcnt vmcnt(" #n ")" ::: "memory")
#define ASM_WAIT_L(n) asm volatile("s_waitcnt lgkmcnt(" #n ")" ::: "memory")
#define ASM_WAIT_VL0() asm volatile("s_waitcnt vmcnt(0) lgkmcnt(0)" ::: "memory")
#define CFENCE() asm volatile("" ::: "memory")
#define WAVE_LDS_FENCE() asm volatile("s_waitcnt lgkmcnt(0)" ::: "memory")
#define S_BARRIER() __builtin_amdgcn_s_barrier()
#define SCHED_BARRIER() __builtin_amdgcn_sched_barrier(0)
#define SETPRIO(x) __builtin_amdgcn_s_setprio(x)
#define S_SLEEP(n) __builtin_amdgcn_s_sleep(n)
#define MFMA16(a, b, c) __builtin_amdgcn_mfma_f32_16x16x32_bf16(a, b, c, 0, 0, 0)
#define MFMA4F(a, b, c) __builtin_amdgcn_mfma_f32_16x16x4f32(a, b, c, 0, 0, 0)
#define GLDS16(gptr, lptr) __builtin_amdgcn_global_load_lds((const unsigned*)(gptr), (LAS unsigned*)(lptr), 16, 0, 0)
#define READFIRSTLANE(x) __builtin_amdgcn_readfirstlane(x)
#define XCC_ID_() ((unsigned)__builtin_amdgcn_s_getreg((3 << 11) | 20) & 0xFu)
#define FENCE_RELEASE() __builtin_amdgcn_fence(__ATOMIC_RELEASE, "agent")
#define FENCE_ACQUIRE() __builtin_amdgcn_fence(__ATOMIC_ACQUIRE, "agent")
#define DPP_F(v, ctrl) __builtin_bit_cast(float, __builtin_amdgcn_update_dpp(0, __builtin_bit_cast(int, (float)(v)), (ctrl), 0xF, 0xF, true))
#define READLANE_F(v, l) __builtin_bit_cast(float, __builtin_amdgcn_readlane(__builtin_bit_cast(int, (float)(v)), (l)))
__device__ __forceinline__ int vgpr_zero() { int z; asm volatile("v_mov_b32 %0, 0" : "=v"(z)); return z; }
__device__ __forceinline__ unsigned long long vgpr_zero64() { unsigned long long z; asm volatile("v_mov_b64 %0, 0" : "=v"(z)); return z; }
__device__ __forceinline__ void lds_addf(LAS float* p, float v) { (void)__hip_atomic_fetch_add(p, v, __ATOMIC_RELAXED, __HIP_MEMORY_SCOPE_WORKGROUP); }
__device__ __forceinline__ int lds_add(volatile LAS int* p, int v) { return __hip_atomic_fetch_add((LAS int*)p, v, __ATOMIC_RELAXED, __HIP_MEMORY_SCOPE_WORKGROUP); }
__device__ __forceinline__ unsigned fbits(float f) { return __builtin_bit_cast(unsigned, f); }
__device__ __forceinline__ float bitsf(unsigned u) { return __builtin_bit_cast(float, u); }
#endif
typedef unsigned short bf16;
#define RLX_AGENT __ATOMIC_RELAXED, __HIP_MEMORY_SCOPE_AGENT

__device__ __forceinline__ unsigned f2bf(float f) { unsigned u = fbits(f); return (u + 0x7fffu + ((u >> 16) & 1u)) >> 16; }
__device__ __forceinline__ unsigned pk2(float lo, float hi) { return f2bf(lo) | (f2bf(hi) << 16); }
__device__ __forceinline__ float bf2f(bf16 b) { return bitsf(((unsigned)b) << 16); }
__device__ __forceinline__ float bflo(unsigned w) { return bitsf(w << 16); }
__device__ __forceinline__ float bfhi(unsigned w) { return bitsf(w & 0xffff0000u); }
#ifdef EMU
__device__ __forceinline__ float fexp(float x) { return expf(x); }
__device__ __forceinline__ float frcp(float x) { return 1.0f / x; }
#else
__device__ __forceinline__ float fexp(float x) { return __builtin_amdgcn_exp2f(x * 1.4426950408889634f); }
__device__ __forceinline__ float frcp(float x) { return __builtin_amdgcn_rcpf(x); }
#endif
__device__ __forceinline__ float sigmoidf_(float x) { return frcp(1.0f + fexp(-x)); }
__device__ __forceinline__ float row16_sum(float v) {
    v += DPP_F(v, 0xB1);
    v += DPP_F(v, 0x4E);
    v += DPP_F(v, 0x141);
    v += DPP_F(v, 0x140);
    return v;
}
__device__ __forceinline__ float wave_sum(float v) {
    const float r = row16_sum(v);
    return (READLANE_F(r, 0) + READLANE_F(r, 16)) + (READLANE_F(r, 32) + READLANE_F(r, 48));
}
__device__ __forceinline__ void sincos_f(float x, float& s, float& c) {
    const float k = rintf(x * 0.63661977236758134f);
    float r = fmaf(-k, 1.5703125f, x); r = fmaf(-k, 4.837512969970703125e-4f, r); r = fmaf(-k, 7.54978994989188216e-8f, r);
    const float r2 = r * r;
    const float sp = r + r * r2 * (-1.6666654611e-1f + r2 * (8.3321608736e-3f + r2 * (-1.9515295891e-4f)));
    const float cp = 1.0f - 0.5f * r2 + r2 * r2 * (4.166664568298827e-2f + r2 * (-1.388731625493765e-3f + r2 * (2.443315711809948e-5f)));
    const int q = ((int)k) & 3;
    s = (q == 0) ? sp : (q == 1) ? cp : (q == 2) ? -sp : -cp;
    c = (q == 0) ? cp : (q == 1) ? -sp : (q == 2) ? -cp : sp;
}
__device__ __forceinline__ float sin_f(float x) { float s, c; sincos_f(x, s, c); return s; }

template <class T> __device__ __forceinline__ T* as_global(T* p) {
#ifndef EMU
    return (T*)(__attribute__((address_space(1))) T*)(unsigned long long)p;
#else
    return p;
#endif
}
#define XB_TMO      128
#define XB_XCNT(j)  (256  + 64 * (j))
#define XB_XSUB(j)  (1280 + 64 * (j))
#define XB_XGEN(j)  (2304 + 64 * (j))
#define XB_TOP      3328
#define XB_TOPGEN   3392
#define XCD_BAR_WORDS 3456
#define XB_SPIN_CAP (1u << 18)
__device__ __forceinline__ unsigned xb_ld(unsigned* p)              { return __hip_atomic_load(p, __ATOMIC_RELAXED, __HIP_MEMORY_SCOPE_AGENT); }
__device__ __forceinline__ unsigned xb_add(unsigned* p, unsigned v) { return __hip_atomic_fetch_add(p, v, __ATOMIC_RELAXED, __HIP_MEMORY_SCOPE_AGENT); }
#define XB_SPIN(cond, bar) do { unsigned _sp = 0; while (cond) { S_SLEEP(1); \
    if ((++_sp & 255u) == 0u) { if (xb_ld(&(bar)[XB_TMO])) break; if (_sp > XB_SPIN_CAP) { atomicAdd(&(bar)[XB_TMO], 1u); break; } } } } while (0)
struct XcdBarrier { unsigned* bar; unsigned x; volatile LAS unsigned* st; };
__device__ __forceinline__ XcdBarrier xcd_barrier_post(unsigned* bar, volatile LAS unsigned* st) {
    XcdBarrier b; b.bar = nullptr; b.x = XCC_ID_(); b.st = st;
    if (threadIdx.x == 0) { st[2] = (unsigned)(unsigned long long)bar; st[3] = (unsigned)((unsigned long long)bar >> 32); st[4] = b.x; (void)xb_add(&bar[XB_XCNT(b.x)], 1u); }
    return b;
}
__device__ __forceinline__ void xcd_barrier_complete(unsigned* bar, unsigned x, unsigned& nloc, unsigned& nx) {
    const unsigned G = gridDim.x * gridDim.y * gridDim.z;
    unsigned sum, cnt, mine, sp = 0u;
    for (;;) {
        sum = 0u; cnt = 0u; mine = 0u;
#pragma unroll
        for (unsigned j = 0; j < 16; ++j) { const unsigned c = xb_ld(&bar[XB_XCNT(j)]); sum += c; cnt += (c > 0u) ? 1u : 0u; mine = (j == x) ? c : mine; }
        if (sum == G) break;
        S_SLEEP(1);
        if ((++sp & 255u) == 0u) { if (xb_ld(&bar[XB_TMO])) break; if (sp > XB_SPIN_CAP) { atomicAdd(&bar[XB_TMO], 1u); break; } }
    }
    nloc = mine > 0u ? mine : 1u; nx = cnt > 0u ? cnt : 1u;
}
__device__ __forceinline__ void xcd_barrier(const XcdBarrier& b) {
    ASM_WAIT_V(0);
    __syncthreads();
    if (threadIdx.x == 0) {
        unsigned* bar = as_global((unsigned*)(((unsigned long long)b.st[3] << 32) | b.st[2]));
        const unsigned bx = b.st[4];
        ASM_WAIT_VL0();
        unsigned nloc = b.st[0], nx = b.st[1];
        if (nloc == 0u) { xcd_barrier_complete(bar, bx, nloc, nx); b.st[0] = nloc; b.st[1] = nx; }
        const unsigned old = xb_add(&bar[XB_XSUB(bx)], 1u);
        const unsigned gen = old / nloc;
        if (old + 1u == (gen + 1u) * nloc) {
            FENCE_RELEASE();
            ASM_WAIT_V(0);
            const unsigned og = xb_add(&bar[XB_TOP], 1u);
            const unsigned tg = og / nx;
            if (og + 1u == (tg + 1u) * nx) xb_add(&bar[XB_TOPGEN], 1u);
            else XB_SPIN(xb_ld(&bar[XB_TOPGEN]) == tg, bar);
            FENCE_ACQUIRE();
            xb_add(&bar[XB_XGEN(bx)], 1u);
            ASM_WAIT_V(0);
        } else {
            XB_SPIN(xb_ld(&bar[XB_XGEN(bx)]) == gen, bar);
            FENCE_ACQUIRE();
            ASM_WAIT_V(0);
        }
    }
    __syncthreads();
}

namespace pg8 {
constexpr int BM = 256, BK = 64, HALF = 128, HTB = HALF * BK * 2, STAGE_BYTES = 8 * HTB, NXCD = 8, WGM = 8;
__host__ __device__ __forceinline__ int lds_byte(int r, int c) { const int st = (r >> 4) * 2 + (c >> 5), rr = r & 15, cc = c & 31, ob = rr * 64 + cc * 2; return st * 1024 + (ob ^ (((ob >> 9) & 1) << 5)); }
__host__ __device__ __forceinline__ void stage_rc(int b, int& R, int& C) { const int st = b / 1024, sb = b % 1024, swz = sb ^ (((sb >> 9) & 1) << 5); R = (st >> 1) * 16 + swz / 64; C = (st & 1) * 32 + (swz % 64) / 2; }
__host__ __device__ __forceinline__ int perm32(int rho) { const int n = rho >> 4, i = rho & 15; return 8 * (i >> 2) + 4 * n + (i & 3); }
struct Unit { int pm, pn; };
struct Gemm { const bf16* A; const bf16* Bt; int K; };
struct StaticOrder {
    int nM, nN, nwg, G, c;
    __host__ __device__ void init(int M_, int N_, int G_, int c_) { nM = M_ / BM; nN = N_ / BM; nwg = nM * nN; G = G_; c = c_; }
    __host__ __device__ bool next(int i, Unit& u) const {
        const long L = (long)i * G + c; if (L >= nwg) return false;
        int wgid = (int)L; { const int q = nwg / NXCD, r = nwg % NXCD, xcd = wgid % NXCD, off = wgid / NXCD; wgid = (xcd < r ? xcd * (q + 1) : r * (q + 1) + (xcd - r) * q) + off; }
        const int nig = WGM * nN, gid = wgid / nig, fm = gid * WGM, gsz = (nM - fm) < WGM ? (nM - fm) : WGM;
        u.pm = fm + ((wgid % nig) % gsz); u.pn = (wgid % nig) / gsz; return true;
    }
};
struct MoeOrder {
    const volatile LAS int* tab; int NT, G, c;
    __device__ __forceinline__ bool next(int i, Unit& u) const {
        const long L = (long)i * G + c; if (L >= tab[16]) return false;
        int e = 0; while (L >= tab[e + 1]) ++e;
        const int loc = (int)L - tab[e], tc = tab[64 + e];
        u.pm = tab[32 + e] + loc % tc; u.pn = e * NT + loc / tc; return true;
    }
};
__device__ __forceinline__ unsigned cvt_pk_bf16(float lo, float hi) {
#ifdef EMU
    return pk2(lo, hi);
#else
    unsigned r; asm volatile("v_cvt_pk_bf16_f32 %0, %1, %2" : "=v"(r) : "v"(lo), "v"(hi)); return r;
#endif
}

struct EpiBf16 {
    static constexpr bool PERM = true;
    bf16* O; int ldc;
    __device__ __forceinline__ void operator()(const f32x4 (&acc)[2][2][4][2], const Unit& u, int wr, int wc, int fr, int fq) const {
        const int row0 = u.pm * BM + wr * 64 + fr, col0 = u.pn * BM + wc * 32 + 8 * fq;
#pragma unroll
        for (int ai = 0; ai < 2; ++ai)
#pragma unroll
            for (int m = 0; m < 4; ++m) { bf16* rowp = O + (size_t)(row0 + ai * HALF + m * 16) * ldc + col0;
#pragma unroll
                for (int bj = 0; bj < 2; ++bj) { const f32x4 v0 = acc[ai][bj][m][0], v1 = acc[ai][bj][m][1];
                    u32x4 w; w[0] = cvt_pk_bf16(v0[0], v0[1]); w[1] = cvt_pk_bf16(v0[2], v0[3]); w[2] = cvt_pk_bf16(v1[0], v1[1]); w[3] = cvt_pk_bf16(v1[2], v1[3]);
                    *(u32x4*)(rowp + bj * HALF) = w; } }
    }
};
struct EpiF32 {
    static constexpr bool PERM = true;
    float* C; int ldc;
    __device__ __forceinline__ void operator()(const f32x4 (&acc)[2][2][4][2], const Unit& u, int wr, int wc, int fr, int fq) const {
        const int row0 = u.pm * BM + wr * 64 + fr, col0 = u.pn * BM + wc * 32 + 8 * fq;
#pragma unroll
        for (int ai = 0; ai < 2; ++ai)
#pragma unroll
            for (int m = 0; m < 4; ++m) { float* rowp = C + (size_t)(row0 + ai * HALF + m * 16) * ldc + col0;
#pragma unroll
                for (int bj = 0; bj < 2; ++bj)
#pragma unroll
                    for (int n = 0; n < 2; ++n) *(f32x4*)(rowp + bj * HALF + n * 4) = acc[ai][bj][m][n]; }
    }
};
struct EpiGate {
    static constexpr bool PERM = true;
    bf16* T; int ldc; const bf16* Pg; int ldp; int gcol0; bool ADD;
    __device__ __forceinline__ void operator()(const f32x4 (&acc)[2][2][4][2], const Unit& u, int wr, int wc, int fr, int fq) const {
        const int row0 = u.pm * BM + wr * 64 + fr, col0 = u.pn * BM + wc * 32 + 8 * fq;
#pragma unroll
        for (int ai = 0; ai < 2; ++ai)
#pragma unroll
            for (int m = 0; m < 4; ++m) { const size_t row = (size_t)(row0 + ai * HALF + m * 16);
#pragma unroll
                for (int bj = 0; bj < 2; ++bj) { const f32x4 v0 = acc[ai][bj][m][0], v1 = acc[ai][bj][m][1];
                    const u32x4 g = *(const u32x4*)(Pg + row * ldp + gcol0 + col0 + bj * HALF);
                    u32x4 t = {0u, 0u, 0u, 0u}; if (ADD) t = *(const u32x4*)(T + row * ldc + col0 + bj * HALF);
                    float o[8];
#pragma unroll
                    for (int j = 0; j < 4; ++j) { const float a0 = j < 2 ? v0[2 * j] : v1[2 * j - 4], a1 = j < 2 ? v0[2 * j + 1] : v1[2 * j - 3];
                        o[2 * j] = bflo(t[j]) + sigmoidf_(bflo(g[j])) * a0; o[2 * j + 1] = bfhi(t[j]) + sigmoidf_(bfhi(g[j])) * a1; }
                    u32x4 w; w[0] = cvt_pk_bf16(o[0], o[1]); w[1] = cvt_pk_bf16(o[2], o[3]); w[2] = cvt_pk_bf16(o[4], o[5]); w[3] = cvt_pk_bf16(o[6], o[7]);
                    *(u32x4*)(T + row * ldc + col0 + bj * HALF) = w; } }
    }
};
struct EpiSwiglu {
    static constexpr bool PERM = true;
    bf16* O; int ldc; int NT;
    __device__ __forceinline__ void operator()(const f32x4 (&acc)[2][2][4][2], const Unit& u, int wr, int wc, int fr, int fq) const {
        const int row0 = u.pm * BM + wr * 64 + fr, col0 = (u.pn % NT) * HALF + wc * 32 + 8 * fq;
#pragma unroll
        for (int ai = 0; ai < 2; ++ai)
#pragma unroll
            for (int m = 0; m < 4; ++m) { bf16* rowp = O + (size_t)(row0 + ai * HALF + m * 16) * ldc + col0;
                float o[8];
#pragma unroll
                for (int j = 0; j < 8; ++j) { const float g = acc[ai][0][m][j >> 2][j & 3], uu = acc[ai][1][m][j >> 2][j & 3]; o[j] = g / (1.0f + expf(-g)) * uu; }
                u32x4 w; w[0] = cvt_pk_bf16(o[0], o[1]); w[1] = cvt_pk_bf16(o[2], o[3]); w[2] = cvt_pk_bf16(o[4], o[5]); w[3] = cvt_pk_bf16(o[6], o[7]);
                *(u32x4*)rowp = w; }
    }
};
struct EpiMoeDown {
    static constexpr bool PERM = true;
    bf16* O; int ldc; int NT;
    __device__ __forceinline__ void operator()(const f32x4 (&acc)[2][2][4][2], const Unit& u, int wr, int wc, int fr, int fq) const {
        const int row0 = u.pm * BM + wr * 64 + fr, col0 = (u.pn % NT) * BM + wc * 32 + 8 * fq;
#pragma unroll
        for (int ai = 0; ai < 2; ++ai)
#pragma unroll
            for (int m = 0; m < 4; ++m) { bf16* rowp = O + (size_t)(row0 + ai * HALF + m * 16) * ldc + col0;
#pragma unroll
                for (int bj = 0; bj < 2; ++bj) { const f32x4 v0 = acc[ai][bj][m][0], v1 = acc[ai][bj][m][1];
                    u32x4 w; w[0] = cvt_pk_bf16(v0[0], v0[1]); w[1] = cvt_pk_bf16(v0[2], v0[3]); w[2] = cvt_pk_bf16(v1[0], v1[1]); w[3] = cvt_pk_bf16(v1[2], v1[3]);
                    *(u32x4*)(rowp + bj * HALF) = w; } }
    }
};

struct EpiBf16OrF32 { static constexpr bool PERM = true; bf16* O; float* C; int ldc; bool f32;
    __device__ __forceinline__ void operator()(const f32x4 (&acc)[2][2][4][2], const Unit& u, int wr, int wc, int fr, int fq) const {
        if (f32) { EpiF32 E{C, ldc}; E(acc, u, wr, wc, fr, fq); } else { EpiBf16 E{O, ldc}; E(acc, u, wr, wc, fr, fq); } } };
struct EpiMoe { static constexpr bool PERM = true; bf16* O; int ldc; int NT; bool swiglu;
    __device__ __forceinline__ void operator()(const f32x4 (&acc)[2][2][4][2], const Unit& u, int wr, int wc, int fr, int fq) const {
        if (swiglu) { EpiSwiglu E{O, ldc, NT}; E(acc, u, wr, wc, fr, fq); } else { EpiMoeDown E{O, ldc, NT}; E(acc, u, wr, wc, fr, fq); } } };
template <class Epi, class Sched>
__device__ __forceinline__ void gemm_phase(LAS unsigned char* lds, const Gemm g, const Sched& S, const Epi& E) {
    const int tid = threadIdx.x + vgpr_zero();
    const int wid = READFIRSTLANE(tid >> 6), lane = tid & 63, wr = wid >> 2, wc = wid & 3, fr = lane & 15, fq = lane >> 4;
    const int K = g.K, nt = K / BK;
    unsigned long long voffA[2], voffB[2]; const unsigned long long zhi = vgpr_zero64();
#pragma unroll
    for (int i = 0; i < 2; ++i) { int R, C; stage_rc(tid * 16 + i * 8192, R, C); const int Rb = Epi::PERM ? ((R & ~31) + perm32(R & 31)) : R;
        voffA[i] = zhi + (unsigned long long)(long long)((R * K + C) * 2); voffB[i] = zhi + (unsigned long long)(long long)((Rb * K + C) * 2); }
    const size_t kstep = (size_t)(BK * 2);
    const size_t hstep = (size_t)HALF * K * 2;
    const size_t tstep = 2 * hstep;
    const unsigned ldsw = (unsigned)wid * 1024u;
    const int aoff = lds_byte(wr * 64 + fr, fq * 8), boff = lds_byte(wc * 32 + fr, fq * 8);
#define PG8_SA(b, h) (((b) * 2 + (h)) * HTB)
#define PG8_SB(b, h) ((4 + (b) * 2 + (h)) * HTB)
#define PG8_STAGE(bufoff, gbase, voff) do { _Pragma("unroll") for (int _i = 0; _i < 2; ++_i) \
        GLDS16((const char*)(gbase) + (voff)[_i], lds + (bufoff) + ldsw + _i * 8192); } while (0)
#define PG8_LDA(dst, b, h) do { _Pragma("unroll") for (int m = 0; m < 4; ++m) _Pragma("unroll") for (int k = 0; k < 2; ++k) dst[m][k] = *(const LAS bf16x8*)(lds + PG8_SA(b, h) + aoff + m * 2048 + k * 1024); } while (0)
#define PG8_LDB(dst, b, h) do { _Pragma("unroll") for (int n = 0; n < 2; ++n) _Pragma("unroll") for (int k = 0; k < 2; ++k) dst[n][k] = *(const LAS bf16x8*)(lds + PG8_SB(b, h) + boff + n * 2048 + k * 1024); } while (0)
#define PG8_MMA(ai, bj, At, Bt) do { SETPRIO(1); _Pragma("unroll") for (int m = 0; m < 4; ++m) _Pragma("unroll") for (int n = 0; n < 2; ++n) _Pragma("unroll") for (int k = 0; k < 2; ++k) \
        acc[ai][bj][m][n] = MFMA16(Bt[n][k], At[m][k], acc[ai][bj][m][n]); SETPRIO(0); } while (0)
#define PG8_BAR S_BARRIER()
    Unit cur, nxt; int ui = 0;
    if (!S.next(0, cur)) return;
    f32x4 acc[2][2][4][2];
#pragma unroll
    for (int a = 0; a < 2; ++a)
#pragma unroll
        for (int b = 0; b < 2; ++b)
#pragma unroll
            for (int m = 0; m < 4; ++m)
#pragma unroll
                for (int n = 0; n < 2; ++n) acc[a][b][m][n] = (f32x4){0.f, 0.f, 0.f, 0.f};
    bf16x8 At[4][2], B0[2][2], B1[2][2];
    const char* cA = (const char*)g.A + (size_t)cur.pm * tstep; const char* cB = (const char*)g.Bt + (size_t)cur.pn * tstep;
    PG8_STAGE(PG8_SB(0, 0), cB, voffB); PG8_STAGE(PG8_SA(0, 0), cA, voffA); PG8_STAGE(PG8_SB(0, 1), cB + hstep, voffB); PG8_STAGE(PG8_SA(0, 1), cA + hstep, voffA);
    if (wr == 1) PG8_BAR;
    ASM_WAIT_V(4); PG8_BAR;
    PG8_STAGE(PG8_SB(1, 0), cB + kstep, voffB); PG8_STAGE(PG8_SA(1, 0), cA + kstep, voffA); PG8_STAGE(PG8_SB(1, 1), cB + hstep + kstep, voffB);
    ASM_WAIT_V(6); PG8_BAR;
    for (;;) {
        const bool has_next = S.next(ui + 1, nxt);
        const char* nA = has_next ? (const char*)g.A + (size_t)nxt.pm * tstep : cA; const char* nB = has_next ? (const char*)g.Bt + (size_t)nxt.pn * tstep : cB;
        for (int t = 0; t < nt; t += 2) {
            const bool last = (t == nt - 2);
            const char* a1 = cA + (size_t)(t + 1) * kstep;
            const char* a2 = last ? nA : cA + (size_t)(t + 2) * kstep; const char* b2 = last ? nB : cB + (size_t)(t + 2) * kstep;
            const char* a3 = a2 + kstep; const char* b3 = b2 + kstep;
            PG8_LDB(B0, 0, 0); SCHED_BARRIER(); PG8_LDA(At, 0, 0); PG8_STAGE(PG8_SA(1, 1), a1 + hstep, voffA);
            ASM_WAIT_L(8); PG8_BAR; ASM_WAIT_L(0); PG8_MMA(0, 0, At, B0); PG8_BAR; SCHED_BARRIER();
            PG8_LDB(B1, 0, 1); PG8_STAGE(PG8_SB(0, 0), b2, voffB);
            PG8_BAR; ASM_WAIT_L(0); PG8_MMA(0, 1, At, B1); PG8_BAR;
            PG8_LDA(At, 0, 1); PG8_STAGE(PG8_SA(0, 0), a2, voffA);
            PG8_BAR; ASM_WAIT_L(0); PG8_MMA(1, 0, At, B0); PG8_BAR; SCHED_BARRIER();
            PG8_STAGE(PG8_SB(0, 1), b2 + hstep, voffB);
            ASM_WAIT_V(6); PG8_BAR; PG8_MMA(1, 1, At, B1); PG8_BAR;
            PG8_LDB(B0, 1, 0); SCHED_BARRIER(); PG8_LDA(At, 1, 0); PG8_STAGE(PG8_SA(0, 1), a2 + hstep, voffA);
            ASM_WAIT_L(8); PG8_BAR; ASM_WAIT_L(0); PG8_MMA(0, 0, At, B0); PG8_BAR; SCHED_BARRIER();
            PG8_LDB(B1, 1, 1); PG8_STAGE(PG8_SB(1, 0), b3, voffB);
            PG8_BAR; ASM_WAIT_L(0); PG8_MMA(0, 1, At, B1); PG8_BAR;
            PG8_LDA(At, 1, 1); PG8_STAGE(PG8_SA(1, 0), a3, voffA);
            PG8_BAR; ASM_WAIT_L(0); PG8_MMA(1, 0, At, B0); PG8_BAR; SCHED_BARRIER();
            PG8_STAGE(PG8_SB(1, 1), b3 + hstep, voffB);
            ASM_WAIT_V(6); PG8_BAR; PG8_MMA(1, 1, At, B1); PG8_BAR;
        }
        E(acc, cur, wr, wc, fr, fq);
        if (!has_next) break;
#pragma unroll
        for (int a = 0; a < 2; ++a)
#pragma unroll
            for (int b = 0; b < 2; ++b)
#pragma unroll
                for (int m = 0; m < 4; ++m)
#pragma unroll
                    for (int n = 0; n < 2; ++n) acc[a][b][m][n] = (f32x4){0.f, 0.f, 0.f, 0.f};
        cur = nxt; cA = nA; cB = nB; ++ui;
    }
    ASM_WAIT_V(0);
    if (wr == 0) PG8_BAR;
    PG8_BAR;
#undef PG8_SA
#undef PG8_SB
#undef PG8_STAGE
#undef PG8_LDA
#undef PG8_LDB
#undef PG8_MMA
#undef PG8_BAR
}
}

struct Args { const float* in[N_IN]; float* out; unsigned char* ws; int ph_lo, ph_hi; };
constexpr int NWAVES = 8, NTHR = 512;
constexpr int LDS_STAGE = 131072, LDS_MISC = LDS_STAGE, LDS_BYTES = 147456;

constexpr int PT_OUT = N_IN, PT_WS = N_IN + 1, PT_WORD0 = 128;

struct Ctx {
    LAS unsigned char* lds; int tid, lane, wave, G, bid;
    __device__ __forceinline__ unsigned long long ptr(int i) const { const volatile LAS unsigned* t = (const volatile LAS unsigned*)(lds + LDS_MISC) + PT_WORD0 + 2 * i;
        const unsigned lo = (unsigned)READFIRSTLANE((int)t[0]), hi = (unsigned)READFIRSTLANE((int)t[1]); return ((unsigned long long)hi << 32) | lo; }
    __device__ __forceinline__ unsigned long long ptrv(int i) const { const volatile LAS unsigned* t = (const volatile LAS unsigned*)(lds + LDS_MISC) + PT_WORD0 + 2 * i; return ((unsigned long long)t[1] << 32) | t[0]; }
    __device__ __forceinline__ const float* inv(int i) const { return as_global((const float*)ptrv(i)); }
    template <class T> __device__ __forceinline__ T* wsv(size_t off) const { return as_global((T*)((unsigned char*)ptrv(PT_WS) + off)); }
    __device__ __forceinline__ const float* in(int i) const { return as_global((const float*)ptr(i)); }
    __device__ __forceinline__ float* out() const { return as_global((float*)ptr(PT_OUT)); }
    template <class T> __device__ __forceinline__ T* ws(size_t off) const { return as_global((T*)((unsigned char*)ptr(PT_WS) + off)); }
    __device__ __forceinline__ unsigned* ctl() const { return as_global((unsigned*)ptr(PT_WS)); }
};

__device__ __forceinline__ void transpose_item(const float* W, int ldw, int k0, int n0, int nvalid, bf16* outp, int ldo, LAS float* scr, int lane) {
#pragma unroll
    for (int i = 0; i < 32; ++i) { const int kk = 2 * i + (lane >> 5), n = n0 + (lane & 31); scr[kk * 33 + (lane & 31)] = (n < nvalid) ? W[(size_t)(k0 + kk) * ldw + n] : 0.f; }
    WAVE_LDS_FENCE(); CFENCE();
    const int c = lane & 7;
#pragma unroll
    for (int j = 0; j < 4; ++j) { const int n = (lane >> 3) + 8 * j; const LAS float* s = scr + (8 * c) * 33 + n;
        u32x4 o; o[0] = pk2(s[0 * 33], s[1 * 33]); o[1] = pk2(s[2 * 33], s[3 * 33]); o[2] = pk2(s[4 * 33], s[5 * 33]); o[3] = pk2(s[6 * 33], s[7 * 33]);
        *(u32x4*)(outp + (size_t)n * ldo + k0 + 8 * c) = o; }
    WAVE_LDS_FENCE(); CFENCE();
}
__device__ __forceinline__ void filter_item(const Ctx& X, int l, int n, int pos0, float* out, LAS bf16* za, LAS bf16* zb, LAS float* asum  ) {
    const int lane = X.lane, kof = 8 * (lane >> 4);
    const bf16* FWT = X.wsv<bf16>(WS_FWT);
    if (lane < 64) { const int i = lane;
#pragma unroll 4
        for (int p = 0; p < 16; ++p) { const int pos = pos0 + p; float v = 0.f;
            if (i == 0) v = (float)pos / (float)(n - 1 > 1 ? n - 1 : 1);
            else if (i < 33) { const int bb = (i - 1) & 15; const double band = 1e-4 + (double)bb * ((15.0 - 1e-4) / 15.0);
                double rev = (double)pos * band / (double)n; rev -= floor(rev); if (rev > 0.5) rev -= 1.0;
                float sn, cs; sincos_f((float)(rev * 6.283185307179586476925), sn, cs); v = i <= 16 ? cs : -sn; }
            za[p * LP + i] = (bf16)f2bf(v); } }
    WAVE_LDS_FENCE(); CFENCE();
    LAS bf16* src = za; LAS bf16* dst = zb;
#pragma unroll 1
    for (int layer = 0; layer < 3; ++layer) { const bf16* WT = FWT + (size_t)layer * 64 * 64; const float* bias = X.inv(layer == 0 ? I_FB1 : layer == 1 ? I_FB2 : I_FB3) + l * 64;
        const bf16x8 a0 = *(const LAS bf16x8*)(src + (lane & 15) * LP + kof), a1 = *(const LAS bf16x8*)(src + (lane & 15) * LP + kof + 32);
#pragma unroll
        for (int tj = 0; tj < 4; ++tj) { const int u = 16 * tj + (lane & 15); f32x4 acc = {0.f, 0.f, 0.f, 0.f};
            acc = MFMA16(a0, *(const bf16x8*)(WT + (size_t)u * 64 + kof), acc); acc = MFMA16(a1, *(const bf16x8*)(WT + (size_t)u * 64 + kof + 32), acc);
            const float fr = X.inv(I_FREQ)[l * 64 + u], bu = bias[u];
#pragma unroll
            for (int r = 0; r < 4; ++r) dst[(4 * (lane >> 4) + r) * LP + u] = (bf16)f2bf(sin_f(fr * (acc[r] + bu))); }
        WAVE_LDS_FENCE(); CFENCE();
        LAS bf16* t_ = src; src = dst; dst = t_; }
    const bf16* WO = FWT + (size_t)3 * 64 * 64;
    const bf16x8 a0 = *(const LAS bf16x8*)(src + (lane & 15) * LP + kof), a1 = *(const LAS bf16x8*)(src + (lane & 15) * LP + kof + 32);
    const float dmin = -3.0701134573253944f, dmax = -15.350567286626972f;
    float dist[4];
#pragma unroll
    for (int r = 0; r < 4; ++r) { const int dd = pos0 + 4 * (lane >> 4) + r - n / 2; dist[r] = (float)(dd < 0 ? -dd : dd) * (2.0f / (float)n); }
#pragma unroll 1
    for (int tg = 0; tg < HW / 64; ++tg) {
#pragma unroll
        for (int tq = 0; tq < 4; ++tq) { const int c = 64 * tg + 16 * tq + (lane & 15); f32x4 acc = {0.f, 0.f, 0.f, 0.f};
            acc = MFMA16(a0, *(const bf16x8*)(WO + (size_t)c * 64 + kof), acc); acc = MFMA16(a1, *(const bf16x8*)(WO + (size_t)c * 64 + kof + 32), acc);
            const float delta = fabsf(dmin + (float)c * ((dmax - dmin) / (float)(HW - 1))); f32x4 v; float as = 0.f;
#pragma unroll
            for (int r = 0; r < 4; ++r) { v[r] = acc[r] * fexp(-dist[r] * delta); as += fabsf(v[r]); }
            *(f32x4*)(out + (size_t)c * n + pos0 + 4 * (lane >> 4)) = v; lds_addf(asum + c, as); } }
    WAVE_LDS_FENCE(); CFENCE();
}
__device__ __forceinline__ void phase_transposes(const Ctx& X, int l, int part) {
    LAS float* scr = (LAS float*)(X.lds + X.wave * 16384);
    const bool shifted = part == 1 && X.G > N_SEQ_UNITS; const int myb = shifted ? X.bid - N_SEQ_UNITS : X.bid, nb_ = shifted ? X.G - N_SEQ_UNITS : X.G;
    if (myb < 0) return;
    const int gw = myb * NWAVES + X.wave, NGW = nb_ * NWAVES, lane = X.lane;
    constexpr int KB_D = D / 64, I_WIN_ = KB_D * (PCP / 32), I_WB_ = 2 * (RW / 64) * (D / 32), I_WO_ = KB_D * (D / 32), I_WGU_ = NE * 2 * KB_D * (D / 32), I_WD_ = NE * KB_D * (D / 32);
    constexpr int I_LORA_ = 6 * (RW / 32); constexpr int N0 = I_WIN_ + I_WB_ + I_WO_, NITEMS = N0 + I_WGU_ + I_WD_;
    if (part == 0) for (int it = gw; it < I_LORA_; it += NGW) { const int which = it / (RW / 32), nb = it % (RW / 32);
        const float* W; int k0 = 0, ldo = 64; bf16* outp;
        if (which < 2) { W = X.in(I_W2) + ((size_t)l * 2 + which) * 64 * RW; outp = X.ws<bf16>(WS_W2T) + (size_t)which * RW * 64 + (size_t)(32 * nb) * 64; }
        else if (which < 4) { W = X.in(I_A2) + ((size_t)l * 2 + (which - 2)) * 64 * RW; outp = X.ws<bf16>(WS_A2T) + (size_t)(which - 2) * RW * 64 + (size_t)(32 * nb) * 64; }
        else { W = X.in(I_G2) + (size_t)l * 128 * RW; k0 = 64 * (which - 4); ldo = 128; outp = X.ws<bf16>(WS_G2T) + (size_t)(32 * nb) * 128; }
        transpose_item(W, RW, k0, 32 * nb, RW, outp, ldo, scr, lane); }
    const int it_end = part ? NITEMS : N0; int it = (part ? N0 : 0) + gw;
    const float* W; int ldw, k0, n0, nvalid, ldo; bf16* outp; float v[32];
#define TR_PARAMS(it_) do { int r = (it_); \
        if (r < I_WIN_) { const int nb = r % (PCP / 32), kb = r / (PCP / 32); W = X.in(I_WIN) + (size_t)l * D * PC; ldw = PC; k0 = 64 * kb; n0 = 32 * nb; nvalid = PC; outp = X.ws<bf16>(WS_WIN) + (size_t)n0 * D; ldo = D; } \
        else if ((r -= I_WIN_) < I_WB_) { const int s_ = r / ((RW / 64) * (D / 32)), q = r % ((RW / 64) * (D / 32)), nb = q % (D / 32), kb = q / (D / 32); \
            W = X.in(I_WBR) + ((size_t)l * 2 + s_) * RW * D; ldw = D; k0 = 64 * kb; n0 = 32 * nb; nvalid = D; outp = X.ws<bf16>(WS_WB) + (size_t)s_ * D * RW + (size_t)n0 * RW; ldo = RW; } \
        else if ((r -= I_WB_) < I_WO_) { const int nb = r % (D / 32), kb = r / (D / 32); W = X.in(I_WOUT) + (size_t)l * D * D; ldw = D; k0 = 64 * kb; n0 = 32 * nb; nvalid = D; outp = X.ws<bf16>(WS_WO) + (size_t)n0 * D; ldo = D; } \
        else if ((r -= I_WO_) < I_WGU_) { const int per = KB_D * (D / 32), es = r / per, q = r % per, e = es >> 1, src = es & 1, nb = q % (D / 32), kb = q / (D / 32); n0 = 32 * nb; \
            W = (src ? X.in(I_WU) : X.in(I_WG)) + ((size_t)l * NE + e) * D * D; ldw = D; k0 = 64 * kb; nvalid = D; const int orow = e * 2 * D + (n0 / 128) * 256 + src * 128 + (n0 % 128); \
            outp = X.ws<bf16>(WS_WGU) + (size_t)orow * D; ldo = D; } \
        else { r -= I_WGU_; const int per = KB_D * (D / 32), e = r / per, q = r % per, nb = q % (D / 32), kb = q / (D / 32); \
            W = X.in(I_WD) + ((size_t)l * NE + e) * D * D; ldw = D; k0 = 64 * kb; n0 = 32 * nb; nvalid = D; outp = X.ws<bf16>(WS_WD) + (size_t)(e * D + n0) * D; ldo = D; } } while (0)
#define TR_LOAD() do { const int n = n0 + (lane & 31); const float* wp = W + (size_t)(k0 + (lane >> 5)) * ldw + n; _Pragma("unroll") for (int i = 0; i < 32; ++i) v[i] = (n < nvalid) ? wp[(size_t)(2 * i) * ldw] : 0.f; } while (0)
    if (it < it_end) { TR_PARAMS(it); TR_LOAD(); }
    while (it < it_end) {
#pragma unroll
        for (int i = 0; i < 32; ++i) scr[(2 * i + (lane >> 5)) * 33 + (lane & 31)] = v[i];
        WAVE_LDS_FENCE(); CFENCE();
        bf16* const cout_ = outp; const int ck0 = k0, cldo = ldo;
        it += NGW;
        if (it < it_end) { TR_PARAMS(it); TR_LOAD(); }
        const int c = lane & 7;
#pragma unroll
        for (int j = 0; j < 4; ++j) { const int n = (lane >> 3) + 8 * j; const LAS float* s_ = scr + (8 * c) * 33 + n;
            u32x4 o; o[0] = pk2(s_[0 * 33], s_[1 * 33]); o[1] = pk2(s_[2 * 33], s_[3 * 33]); o[2] = pk2(s_[4 * 33], s_[5 * 33]); o[3] = pk2(s_[6 * 33], s_[7 * 33]);
            *(u32x4*)(cout_ + (size_t)n * cldo + ck0 + 8 * c) = o; }
        WAVE_LDS_FENCE(); CFENCE();
    }
#undef TR_PARAMS
#undef TR_LOAD
}
__device__ __forceinline__ void phase_filter_weights(const Ctx& X, int l) {
    bf16* FWT = X.ws<bf16>(WS_FWT);
    for (int idx = X.bid * NTHR + X.tid; idx < (3 * 64 + HW) * 64; idx += X.G * NTHR) { const int o = idx >> 6, k = idx & 63; float v;
        if (o < 64) v = k < 33 ? X.in(I_FW1)[(size_t)l * 33 * 64 + k * 64 + o] : 0.f;
        else if (o < 128) v = X.in(I_FW2)[(size_t)l * 64 * 64 + k * 64 + (o - 64)];
        else if (o < 192) v = X.in(I_FW3)[(size_t)l * 64 * 64 + k * 64 + (o - 128)];
        else v = X.in(I_FWO)[(size_t)l * 64 * HW + (size_t)k * HW + (o - 192)];
        FWT[idx] = (bf16)f2bf(v); }
}
constexpr int FPART_OFF = 65536;
static_assert(FPART_OFF + 2 * HW * 4 <= LDS_STAGE && 2 * 16 * LP * 2 <= 8192, "filter LDS map");
__device__ __forceinline__ void phase_filters_begin(const Ctx& X) {
    LAS float* part = (LAS float*)(X.lds + FPART_OFF);
    for (int i = X.tid; i < 2 * HW; i += NTHR) part[i] = 0.f;
    __syncthreads();
}
__device__ __forceinline__ void phase_filters_item(const Ctx& X, int l_, int which_, int it_) {
    const int vz = vgpr_zero(), l = l_ + vz, which = which_ + vz, it = it_ + vz;
    LAS bf16* za = (LAS bf16*)(X.lds + X.wave * 8192); LAS bf16* zb = za + 16 * LP;
    const int n = which ? CTX : SEQ; float* out = X.wsv<float>(WS_FILT) + (which ? (size_t)HW * SEQ : 0);
    filter_item(X, l, n, 16 * it, out, za, zb, (LAS float*)(X.lds + FPART_OFF) + which * HW);
}
__device__ __forceinline__ void phase_filters_end(const Ctx& X) {
    const LAS float* part = (const LAS float*)(X.lds + FPART_OFF);
    __syncthreads();
    for (int i = X.tid; i < 2 * HW; i += NTHR) X.ws<float>(WS_FPART)[((size_t)(i / HW) * NPART + X.bid) * HW + (i % HW)] = part[i];
    __syncthreads();
}
__device__ __forceinline__ void phase_mod(const Ctx& X) {
    const int lane = X.lane;
    LAS float* red = (LAS float*)X.lds;
    constexpr int NIT = DEPTH * (6 * D / 64);
    for (int it = X.bid; it < NIT; it += X.G) {
        const int ll = it / (6 * D / 64), n0 = (it % (6 * D / 64)) * 64;
        const float* W = X.in(I_WMOD) + (size_t)ll * D * 6 * D; const float* cv = X.in(I_C); const float* cc = X.in(I_CCTX);
        float s0 = 0.f, s1 = 0.f;
#pragma unroll 8
        for (int k = X.wave * (D / 8); k < (X.wave + 1) * (D / 8); ++k) { const float wv = W[(size_t)k * 6 * D + n0 + lane]; const float c0 = cv[k], c1 = cc[k];
            s0 += c0 * sigmoidf_(c0) * wv; s1 += c1 * sigmoidf_(c1) * wv; }
        red[(X.wave * 64 + lane) * 2] = s0; red[(X.wave * 64 + lane) * 2 + 1] = s1;
        __syncthreads();
        if (X.wave == 0) { float t0 = 0.f, t1 = 0.f;
#pragma unroll
            for (int w = 0; w < NWAVES; ++w) { t0 += red[(w * 64 + lane) * 2]; t1 += red[(w * 64 + lane) * 2 + 1]; }
            const float bm = X.in(I_BMOD)[(size_t)ll * 6 * D + n0 + lane];
            float* MOD = X.ws<float>(WS_MOD);
            MOD[((size_t)ll * 2 + 0) * 6 * D + n0 + lane] = t0 + bm; MOD[((size_t)ll * 2 + 1) * 6 * D + n0 + lane] = t1 + bm; }
        __syncthreads();
    }
}
__device__ __forceinline__ const float* modp(const Ctx& X, int l, int t, int j) { return X.ws<float>(WS_MOD) + ((size_t)l * 2 + (t < CTX ? 1 : 0)) * 6 * D + (size_t)j * D; }

__device__ __forceinline__ void phase_x0(const Ctx& X) {
    const int gw = X.bid * NWAVES + X.wave, NGW = X.G * NWAVES, lane = X.lane;
    for (int t = gw; t < M; t += NGW) {
        const float* src = t < CTX ? X.in(I_CTX) + (size_t)t * D : X.in(I_X) + (size_t)(t - CTX) * D;
        const float* sh = modp(X, 0, t, 0); const float* sc = modp(X, 0, t, 1);
        float* xr = X.ws<float>(WS_X) + (size_t)t * D; bf16* xm = X.ws<bf16>(WS_XMOD) + (size_t)t * D;
#pragma unroll
        for (int j = 0; j < D / 256; ++j) { const int d = 4 * lane + 256 * j; const f32x4 v = *(const f32x4*)(src + d), a = *(const f32x4*)(sh + d), b = *(const f32x4*)(sc + d);
            *(f32x4*)(xr + d) = v;
            unsigned w0 = pk2(v[0] * (1.f + b[0]) + a[0], v[1] * (1.f + b[1]) + a[1]), w1 = pk2(v[2] * (1.f + b[2]) + a[2], v[3] * (1.f + b[3]) + a[3]);
            *(unsigned long long*)(xm + d) = (unsigned long long)w0 | ((unsigned long long)w1 << 32); }
    }
}

__device__ __forceinline__ int shift_row(int t, int col, bool& valid) {
    const bool isctx = t < CTX;
    const int i = t - CTX, gx = i & (GRID_W - 1), gy = i / GRID_W, q = col / QTR;
    const int offl = (q == 0) ? -1 : (q == 1) ? 1 : (q == 2) ? -GRID_W : GRID_W;
    const bool vl = (q == 0) ? (gx > 0) : (q == 1) ? (gx < GRID_W - 1) : (q == 2) ? (gy > 0) : (gy < GRID_H - 1);
    const bool first = col < HALFC;
    const int offc = first ? -1 : 1; const bool vc = first ? (t > 0) : (t < CTX - 1);
    valid = isctx ? vc : vl;
    return valid ? t + (isctx ? offc : offl) : t;
}
__device__ __forceinline__ float pm_val(const bf16* P, const float* mu, int t, int col) {
    const float p0 = bf2f(P[(size_t)t * PCP + col]); bool valid; const int nr = shift_row(t, col, valid);
    const float pn = bf2f(P[(size_t)nr * PCP + col]); const float p1 = valid ? pn : 0.f;
    return p0 + (p1 - p0) * mu[col];
}
__device__ __forceinline__ f32x4 mm_tile(const LAS bf16* A, const LAS bf16* Bt, int ti, int tj, int lane, f32x4 acc) {
    const LAS bf16* pa = A + (16 * ti + (lane & 15)) * LP + 8 * (lane >> 4); const LAS bf16* pb = Bt + (16 * tj + (lane & 15)) * LP + 8 * (lane >> 4);
#pragma unroll
    for (int kk = 0; kk < 2; ++kk) { const bf16x8 a = *(const LAS bf16x8*)(pa + 32 * kk), b = *(const LAS bf16x8*)(pb + 32 * kk); acc = MFMA16(a, b, acc); }
    return acc;
}
struct PmLd { float p0, pn, m; bool valid; };
__device__ __forceinline__ PmLd pm_ld(const bf16* P, const float* mu, int t, int col) {
    PmLd r; bool valid; const int nr = shift_row(t, col, valid); r.p0 = bf2f(P[(size_t)t * PCP + col]); r.pn = bf2f(P[(size_t)nr * PCP + col]); r.m = mu[col]; r.valid = valid; return r; }
__device__ __forceinline__ float pm_fin(const PmLd& r) { const float p1 = r.valid ? r.pn : 0.f; return r.p0 + (p1 - r.p0) * r.m; }
constexpr int TT = 8;
__device__ __forceinline__ void phase_lin(const Ctx& X, int l) {
    const bf16* P = X.ws<bf16>(WS_P); const float* mu = X.in(I_MU) + (size_t)l * RC; bf16* LIN = X.ws<bf16>(WS_LIN);
    for (size_t idx = (size_t)X.bid * NTHR + X.tid; idx < (size_t)M * 384; idx += (size_t)X.G * NTHR) { const int t = (int)(idx / 384), j = (int)(idx % 384);
        float v = pm_val(P, mu, t, C_LWF + j);
        if (j < 128) v = 1.0f - 2.0f * frcp(fexp(2.0f * v) + 1.0f); else if (j >= 256) v = sigmoidf_(v);
        LIN[idx] = (bf16)f2bf(v); }
}
__device__ __forceinline__ f32x4 mm_tile_p(const LAS bf16* A, int lda, const LAS bf16* Bt, int ldb, int ks, int ti, int tj, int lane, f32x4 acc) {
    const LAS bf16* pa = A + (16 * ti + (lane & 15)) * lda + 8 * (lane >> 4); const LAS bf16* pb = Bt + (16 * tj + (lane & 15)) * ldb + 8 * (lane >> 4);
    for (int kk = 0; kk < ks; ++kk) { const bf16x8 a = *(const LAS bf16x8*)(pa + 32 * kk), b = *(const LAS bf16x8*)(pb + 32 * kk); acc = MFMA16(a, b, acc); }
    return acc;
}
constexpr int GP = 136;
__device__ __forceinline__ void lora_unit_a(const Ctx& X, int unit) {
    const int b = unit / NH, h = unit % NH, tid = X.tid, lane = X.lane, w = X.wave;
    LAS bf16* Ab = (LAS bf16*)X.lds; LAS bf16* Gb = Ab + 4 * 64 * LP; LAS bf16* Wb = Gb + 64 * GP; LAS bf16* G2b = Wb + 4 * 64 * LP;
    LAS float* OUT = (LAS float*)X.lds;
    static_assert((8 * 64 * LP + 2 * 64 * GP) * 2 <= LDS_STAGE && 5 * 64 * LQ * 4 <= LDS_STAGE, "lora LDS map");
    const bf16* LIN = X.wsv<bf16>(WS_LIN) + (size_t)(64 * b) * 384;
    for (int i = tid; i < 64 * 48; i += NTHR) { const int t = i / 48, c16 = i % 48; const u32x4 v = *(const u32x4*)(LIN + (size_t)t * 384 + 8 * c16);
        if (c16 < 32) *(LAS u32x4*)(Ab + (c16 >> 3) * 64 * LP + t * LP + 8 * (c16 & 7)) = v; else *(LAS u32x4*)(Gb + t * GP + 8 * (c16 - 32)) = v; }
    const bf16* w2t = X.wsv<bf16>(WS_W2T) + (size_t)(64 * h) * 64; const bf16* a2t = X.wsv<bf16>(WS_A2T) + (size_t)(64 * h) * 64; const bf16* g2t = X.wsv<bf16>(WS_G2T) + (size_t)(64 * h) * 128;
    for (int i = tid; i < 4 * 64 * 8; i += NTHR) { const int q = i / 512, c = (i / 8) % 64, c16 = i % 8; const bf16* src = (q < 2 ? w2t + (size_t)q * RW * 64 : a2t + (size_t)(q - 2) * RW * 64) + c * 64 + 8 * c16;
        *(LAS u32x4*)(Wb + q * 64 * LP + c * LP + 8 * c16) = *(const u32x4*)src; }
    for (int i = tid; i < 64 * 16; i += NTHR) { const int c = i / 16, c16 = i % 16; *(LAS u32x4*)(G2b + c * GP + 8 * c16) = *(const u32x4*)(g2t + c * 128 + 8 * c16); }
    __syncthreads();
    f32x4 o[2][5];
#pragma unroll
    for (int q = 0; q < 2; ++q) { const int tile = 2 * w + q, ti = tile >> 2, tj = tile & 3; const f32x4 z4 = {0.f, 0.f, 0.f, 0.f};
#pragma unroll
        for (int p = 0; p < 4; ++p) o[q][p] = mm_tile(Ab + p * 64 * LP, Wb + p * 64 * LP, ti, tj, lane, z4);
        o[q][4] = mm_tile_p(Gb, GP, G2b, GP, 4, ti, tj, lane, z4); }
    __syncthreads();
#pragma unroll
    for (int q = 0; q < 2; ++q) { const int tile = 2 * w + q, ti = tile >> 2, tj = tile & 3, col = 16 * tj + (lane & 15);
#pragma unroll
        for (int p = 0; p < 5; ++p)
#pragma unroll
            for (int r = 0; r < 4; ++r) OUT[(p * 64 + 16 * ti + 4 * (lane >> 4) + r) * LQ + col] = o[q][p][r]; }
    __syncthreads();
}
__device__ __forceinline__ void lora_unit_b(const Ctx& X, int l, int unit) {
    const int b = unit / NH, h = unit % NH, w = X.wave, k = X.lane, c = 64 * h + k;
    const LAS float* OUT = (const LAS float*)X.lds;
    const bf16* P = X.wsv<bf16>(WS_P); const float* mu = X.inv(I_MU) + (size_t)l * RC;
    const float w00 = X.inv(I_W0)[(size_t)(l * 2 + 0) * RW + c], w01 = X.inv(I_W0)[(size_t)(l * 2 + 1) * RW + c];
    const float a00 = X.inv(I_A0)[(size_t)(l * 2 + 0) * RW + c], a01 = X.inv(I_A0)[(size_t)(l * 2 + 1) * RW + c];
    const float kkc = X.inv(I_KK)[(size_t)l * RW + c], kac = X.inv(I_KA)[(size_t)l * RW + c], rkc = X.inv(I_RK)[(size_t)l * RW + c];
    bf16* pR = X.wsv<bf16>(WS_R); bf16* pV = X.wsv<bf16>(WS_V); bf16* pKA = X.wsv<bf16>(WS_KA); bf16* pKD = X.wsv<bf16>(WS_KD); bf16* pKB = X.wsv<bf16>(WS_KB); float* pW = X.wsv<float>(WS_W); bf16* pG = X.wsv<bf16>(WS_GATE); float* pBo = X.wsv<float>(WS_BONUS);
    const int vz = vgpr_zero();
    float p0[3][8], pn[3][8]; unsigned vmask = 0u; const float mu0 = mu[c], mu1 = mu[C_K + c], mu2 = mu[C_V + c];
#pragma unroll
    for (int i = 0; i < 8; ++i) { const int t = 64 * b + 8 * w + i + vz;
#pragma unroll
        for (int q = 0; q < 3; ++q) { const int col = (q == 0 ? 0 : q == 1 ? C_K : C_V) + c; bool valid; const int nr = shift_row(t, col, valid);
            p0[q][i] = bf2f(P[(size_t)t * PCP + col]); pn[q][i] = bf2f(P[(size_t)nr * PCP + col]); vmask |= (valid ? 1u : 0u) << (3 * i + q); } }
    float bonv[8];
#pragma unroll
    for (int i = 0; i < 8; ++i) { const int tl = 8 * w + i, t = 64 * b + tl + vz;
        const float r = p0[0][i] + ((((vmask >> (3 * i + 0)) & 1u) ? pn[0][i] : 0.f) - p0[0][i]) * mu0;
        const float kx = p0[1][i] + ((((vmask >> (3 * i + 1)) & 1u) ? pn[1][i] : 0.f) - p0[1][i]) * mu1;
        const float v = p0[2][i] + ((((vmask >> (3 * i + 2)) & 1u) ? pn[2][i] : 0.f) - p0[2][i]) * mu2;
        const float wd0 = -DECAY_SCALE * sigmoidf_(w00 + OUT[(0 * 64 + tl) * LQ + k]), wd1 = -DECAY_SCALE * sigmoidf_(w01 + OUT[(1 * 64 + tl) * LQ + k]);
        const float ad0 = sigmoidf_(a00 + OUT[(2 * 64 + tl) * LQ + k]), ad1 = sigmoidf_(a01 + OUT[(3 * 64 + tl) * LQ + k]);
        const float kkr = kx * kkc; const float n2 = wave_sum(kkr * kkr); const float kk = kkr * frcp(fmaxf(sqrtf(n2), 1e-12f));
        const float kd0 = kx * (1.f + (ad0 - 1.f) * kac), kd1 = kx * (1.f + (ad1 - 1.f) * kac);
        bonv[i] = wave_sum(r * (kd0 + kd1) * rkc);
        const size_t o = (size_t)t * RW + c, o1 = (size_t)(M + t) * RW + c;
        pR[o] = (bf16)f2bf(r); pV[o] = (bf16)f2bf(v); pKA[o] = (bf16)f2bf(-kk);
        pKD[o] = (bf16)f2bf(kd0); pKD[o1] = (bf16)f2bf(kd1); pKB[o] = (bf16)f2bf(kk * ad0); pKB[o1] = (bf16)f2bf(kk * ad1);
        pW[o] = wd0; pW[o1] = wd1; pG[o] = (bf16)f2bf(OUT[(4 * 64 + tl) * LQ + k]); }
    if (k < 8) { float bs = bonv[0];
#pragma unroll
        for (int i = 1; i < 8; ++i) bs = (k == i) ? bonv[i] : bs;
        pBo[(size_t)(64 * b + 8 * w + k) * NH + h] = bs; }
    __syncthreads();
}
__device__ __forceinline__ void phase_prep_hyena(const Ctx& X, int l) {
    const bf16* P = X.ws<bf16>(WS_P); const int c = X.tid;
    if (c < HW) {
        const float* cw = X.in(I_CW) + (size_t)l * 3 * HC; const float* cb = X.in(I_CB) + (size_t)l * HC;
        float cw0[3], cw1[3], cw2[3], cbv[3];
#pragma unroll
        for (int j = 0; j < 3; ++j) { const int hc = j * HW + c; cw0[j] = cw[hc]; cw1[j] = cw[HC + hc]; cw2[j] = cw[2 * HC + hc]; cbv[j] = cb[hc]; }
        float* ZT = X.ws<float>(WS_ZT) + (size_t)c * M; float* Zc = X.ws<float>(WS_Z); bf16* X0 = X.ws<bf16>(WS_X0);
        for (int tile = X.bid; tile < M / TT; tile += X.G) { const int t0 = tile * TT; float zz[TT];
#pragma unroll
            for (int tt = 0; tt < TT; ++tt) { const int t = t0 + tt; const bool hp = (t != 0 && t != CTX), hn = (t != CTX - 1 && t != M - 1);
                float u[3];
#pragma unroll
                for (int j = 0; j < 3; ++j) { const int col = C_HY + j * HW + c;
                    const float pc = bf2f(P[(size_t)t * PCP + col]), pp = hp ? bf2f(P[(size_t)(t - 1) * PCP + col]) : 0.f, pn = hn ? bf2f(P[(size_t)(t + 1) * PCP + col]) : 0.f;
                    u[j] = pp * cw0[j] + pc * cw1[j] + pn * cw2[j] + cbv[j]; }
                zz[tt] = u[2] * u[1]; if (t < CTX) Zc[(size_t)t * HW + c] = zz[tt];
                X0[(size_t)t * HW + c] = (bf16)f2bf(u[0]); }
            *(f32x4*)(ZT + t0) = (f32x4){zz[0], zz[1], zz[2], zz[3]}; *(f32x4*)(ZT + t0 + 4) = (f32x4){zz[4], zz[5], zz[6], zz[7]}; }
    }
}

constexpr int CC = 64, NCHK = M / CC;
static_assert(CTX % CC == 0 && SEQ % CC == 0, "chunks must not straddle the context/latent boundary");
__device__ __forceinline__ int scan_row(int d, int s) { return d == 0 ? s : (s < CTX ? CTX - 1 - s : M - 1 - (s - CTX)); }
__device__ __forceinline__ void chunk_unit_1(const Ctx& X, int unit) {
    const int d = unit / (NCHK * NH), c = (unit / NH) % NCHK, h = unit % NH;
    LAS bf16* An = (LAS bf16*)X.lds;            LAS bf16* Bn = An + 64 * LP; LAS bf16* Kn = Bn + 64 * LP; LAS bf16* Rn = Kn + 64 * LP; LAS bf16* Vt = Rn + 64 * LP;
    LAS bf16* Bh = Vt + 64 * LP;                LAS bf16* Kh = Bh + 64 * LP; LAS bf16* Lak = Kh + 64 * LP; LAS bf16* Mrb = Lak + 64 * LP; LAS bf16* Mrk = Mrb + 64 * LP;
    LAS float* Lab = (LAS float*)(Mrk + 64 * LP); LAS float* XsW = Lab + 64 * LX;
    LAS float* XsU = (LAS float*)An;
    LAS bf16* Wt = Lak; LAS bf16* Ut = (LAS bf16*)((LAS unsigned char*)An + 64 * LX * 4);
    LAS float* tot = Lab;
    LAS float* dC = (LAS float*)(X.lds + LDS_MISC + 1024);
    static_assert(10 * 64 * LP * 2 + 2 * 64 * LX * 4 <= LDS_STAGE && 64 * LX * 4 + 64 * LP * 2 <= 3 * 64 * LP * 2, "chunk LDS map");
    const int tid = X.tid, lane = X.lane, w = X.wave, k = tid & 63;
    float lw[8], cum[8];
    { float run = 0.f; const float* pW = X.wsv<float>(WS_W);
#pragma unroll
      for (int i = 0; i < 8; ++i) { const int row = scan_row(d, c * CC + 8 * w + i); lw[i] = pW[((size_t)d * M + row) * RW + h * 64 + k]; }
#pragma unroll
      for (int i = 0; i < 8; ++i) { run += lw[i]; cum[i] = run; }
      tot[w * 64 + k] = run; }
    __syncthreads();
    float off = 0.f, cumC = 0.f;
#pragma unroll
    for (int ww = 0; ww < 8; ++ww) { const float t = tot[ww * 64 + k]; off += (ww < w) ? t : 0.f; cumC += t; }
    __syncthreads();
    { unsigned pv[4], pbh[4], pkh[4]; float af[8];
      const bf16* pR = X.wsv<bf16>(WS_R); const bf16* pV = X.wsv<bf16>(WS_V); const bf16* pKA = X.wsv<bf16>(WS_KA); const bf16* pKD = X.wsv<bf16>(WS_KD); const bf16* pKB = X.wsv<bf16>(WS_KB);
#pragma unroll
      for (int i = 0; i < 8; ++i) { const int t = 8 * w + i; const int row = scan_row(d, c * CC + t); const size_t o = (size_t)row * RW + h * 64 + k, od = ((size_t)d * M + row) * RW + h * 64 + k;
          const float ct = off + cum[i], cp = ct - lw[i];
          const float r = bf2f(pR[o]), v = bf2f(pV[o]), ka = bf2f(pKA[o]), kd = bf2f(pKD[od]), kb = bf2f(pKB[od]);
          const float ei = fexp(-ct), eh = fexp(cumC - ct);
          const float at = ka * fexp(cp); af[i] = at;
          An[t * LP + k] = (bf16)f2bf(at); Bn[t * LP + k] = (bf16)f2bf(kb * ei); Kn[t * LP + k] = (bf16)f2bf(kd * ei); Rn[t * LP + k] = (bf16)f2bf(r * fexp(ct));
          const unsigned bv = f2bf(v), bb = f2bf(kb * eh), bk = f2bf(kd * eh);
          if (i & 1) { pv[i >> 1] |= bv << 16; pbh[i >> 1] |= bb << 16; pkh[i >> 1] |= bk << 16; } else { pv[i >> 1] = bv; pbh[i >> 1] = bb; pkh[i >> 1] = bk; } }
      *(LAS u32x4*)(Vt + k * LP + 8 * w) = (u32x4){pv[0], pv[1], pv[2], pv[3]}; *(LAS u32x4*)(Bh + k * LP + 8 * w) = (u32x4){pbh[0], pbh[1], pbh[2], pbh[3]}; *(LAS u32x4*)(Kh + k * LP + 8 * w) = (u32x4){pkh[0], pkh[1], pkh[2], pkh[3]};
      *(LAS f32x4*)(XsW + k * LX + 8 * w) = (f32x4){af[0], af[1], af[2], af[3]}; *(LAS f32x4*)(XsW + k * LX + 8 * w + 4) = (f32x4){af[4], af[5], af[6], af[7]}; }
    if (tid < 64) dC[tid] = fexp(cumC);
    __syncthreads();
#pragma unroll 1
    for (int q = 0; q < 2; ++q) { const int tile = 2 * w + q, ti = tile >> 2, tj = tile & 3; const f32x4 z4 = {0.f, 0.f, 0.f, 0.f};
        const f32x4 ab = mm_tile(An, Bn, ti, tj, lane, z4), ak = mm_tile(An, Kn, ti, tj, lane, z4), rb = mm_tile(Rn, Bn, ti, tj, lane, z4), rk = mm_tile(Rn, Kn, ti, tj, lane, z4);
        const int col = 16 * tj + (lane & 15);
#pragma unroll
        for (int r = 0; r < 4; ++r) { const int row = 16 * ti + 4 * (lane >> 4) + r; const bool lo = col < row, le = col <= row;
            Lab[row * LX + col] = lo ? ab[r] : 0.f; Lak[row * LP + col] = (bf16)f2bf(lo ? ak[r] : 0.f); Mrb[row * LP + col] = (bf16)f2bf(le ? rb[r] : 0.f); Mrk[row * LP + col] = (bf16)f2bf(le ? rk[r] : 0.f); } }
    __syncthreads();
}
__device__ __forceinline__ void chunk_unit_2(const Ctx& X, int unit) {
    const int d = unit / (NCHK * NH), c = (unit / NH) % NCHK, h = unit % NH;
    LAS bf16* An = (LAS bf16*)X.lds;            LAS bf16* Bn = An + 64 * LP; LAS bf16* Kn = Bn + 64 * LP; LAS bf16* Rn = Kn + 64 * LP; LAS bf16* Vt = Rn + 64 * LP;
    LAS bf16* Bh = Vt + 64 * LP;                LAS bf16* Kh = Bh + 64 * LP; LAS bf16* Lak = Kh + 64 * LP; LAS bf16* Mrb = Lak + 64 * LP; LAS bf16* Mrk = Mrb + 64 * LP;
    LAS float* Lab = (LAS float*)(Mrk + 64 * LP); LAS float* XsW = Lab + 64 * LX;
    LAS float* XsU = (LAS float*)An;
    LAS bf16* Wt = Lak; LAS bf16* Ut = (LAS bf16*)((LAS unsigned char*)An + 64 * LX * 4);
    LAS float* tot = Lab;
    LAS float* dC = (LAS float*)(X.lds + LDS_MISC + 1024);
    static_assert(10 * 64 * LP * 2 + 2 * 64 * LX * 4 <= LDS_STAGE && 64 * LX * 4 + 64 * LP * 2 <= 3 * 64 * LP * 2, "chunk LDS map");
    const int tid = X.tid, lane = X.lane, w = X.wave, k = tid & 63;
    f32x4 r2[2]; int r2col[2], r2row[2];
#pragma unroll
    for (int q = 0; q < 2; ++q) { const int tile = 2 * w + q, ti = tile >> 2, tj = tile & 3; const f32x4 z4 = {0.f, 0.f, 0.f, 0.f};
        const f32x4 a = mm_tile(Lak, Vt, ti, tj, lane, z4); const int col = 16 * tj + (lane & 15);
        r2[q] = a; r2col[q] = col; r2row[q] = 16 * ti + 4 * (lane >> 4); }
    __syncthreads();
#pragma unroll
    for (int q = 0; q < 2; ++q) *(LAS f32x4*)(XsU + r2col[q] * LX + r2row[q]) = r2[q];
    __syncthreads();
    LAS bf16* Tii = (LAS bf16*)(X.lds + LDS_MISC + 8448);
    constexpr int TP = 40;
    static_assert(8448 + 4 * 16 * TP * 2 <= LDS_BYTES - LDS_MISC, "T_ii image");
    if (tid < 64) { const int bi = tid >> 4, j = tid & 15; float xv[16];
#pragma unroll
        for (int t = 0; t < 16; ++t) { float acc = (t == j) ? 1.f : 0.f;
#pragma unroll
            for (int s2 = 0; s2 < t; ++s2) acc += Lab[(16 * bi + t) * LX + 16 * bi + s2] * xv[s2];
            xv[t] = acc; }
#pragma unroll
        for (int t = 0; t < 16; ++t) { Tii[(bi * 16 + t) * TP + j] = (bf16)f2bf(xv[t]); Tii[(bi * 16 + t) * TP + 16 + j] = (bf16)0; } }
    __syncthreads();
    { LAS float* xsx = (w < 4 ? XsW + 16 * w * LX : XsU + 16 * (w - 4) * LX) + (lane & 15) * LX;
      LAS bf16* dst = (w < 4 ? Wt + 16 * w * LP : Ut + 16 * (w - 4) * LP) + (lane & 15) * LP;
      const int kof = 8 * (lane >> 4); const bf16x8 zero8 = {0, 0, 0, 0, 0, 0, 0, 0};
#pragma unroll
      for (int i = 0; i < 4; ++i) {
          f32x4 acc = *(const LAS f32x4*)(xsx + 16 * i + 4 * (lane >> 4));
#pragma unroll
          for (int kk = 0; kk < (16 * i + 31) / 32; ++kk) { const int s0 = 32 * kk + kof;
              const f32x4 l0 = *(const LAS f32x4*)(Lab + (16 * i + (lane & 15)) * LX + s0), l1 = *(const LAS f32x4*)(Lab + (16 * i + (lane & 15)) * LX + s0 + 4);
              u32x4 pa = {pk2(l0[0], l0[1]), pk2(l0[2], l0[3]), pk2(l1[0], l1[1]), pk2(l1[2], l1[3])};
              bf16x8 av = __builtin_bit_cast(bf16x8, pa), bv = *(const LAS bf16x8*)(dst + s0);
              if (s0 >= 16 * i) { av = zero8; bv = zero8; }
              acc = MFMA16(av, bv, acc); }
          LAS bf16* zt = (LAS bf16*)(xsx + 16 * i);
          *(LAS unsigned long long*)(zt + 4 * (lane >> 4)) = (unsigned long long)pk2(acc[0], acc[1]) | ((unsigned long long)pk2(acc[2], acc[3]) << 32);
          WAVE_LDS_FENCE(); CFENCE();
          const bf16x8 a2 = *(const LAS bf16x8*)(Tii + (i * 16 + (lane & 15)) * TP + kof); bf16x8 b2 = zero8; if (kof < 16) b2 = *(const LAS bf16x8*)(zt + kof);
          f32x4 xi = {0.f, 0.f, 0.f, 0.f}; xi = MFMA16(a2, b2, xi);
          *(LAS unsigned long long*)(dst + 16 * i + 4 * (lane >> 4)) = (unsigned long long)pk2(xi[0], xi[1]) | ((unsigned long long)pk2(xi[2], xi[3]) << 32);
          WAVE_LDS_FENCE(); CFENCE(); } }
    __syncthreads();
}
__device__ __forceinline__ void chunk_unit_3(const Ctx& X, int unit) {
    const int d = unit / (NCHK * NH), c = (unit / NH) % NCHK, h = unit % NH;
    LAS bf16* An = (LAS bf16*)X.lds;            LAS bf16* Bn = An + 64 * LP; LAS bf16* Kn = Bn + 64 * LP; LAS bf16* Rn = Kn + 64 * LP; LAS bf16* Vt = Rn + 64 * LP;
    LAS bf16* Bh = Vt + 64 * LP;                LAS bf16* Kh = Bh + 64 * LP; LAS bf16* Lak = Kh + 64 * LP; LAS bf16* Mrb = Lak + 64 * LP; LAS bf16* Mrk = Mrb + 64 * LP;
    LAS float* Lab = (LAS float*)(Mrk + 64 * LP); LAS float* XsW = Lab + 64 * LX;
    LAS float* XsU = (LAS float*)An;
    LAS bf16* Wt = Lak; LAS bf16* Ut = (LAS bf16*)((LAS unsigned char*)An + 64 * LX * 4);
    LAS float* tot = Lab;
    LAS float* dC = (LAS float*)(X.lds + LDS_MISC + 1024);
    static_assert(10 * 64 * LP * 2 + 2 * 64 * LX * 4 <= LDS_STAGE && 64 * LX * 4 + 64 * LP * 2 <= 3 * 64 * LP * 2, "chunk LDS map");
    const int tid = X.tid, lane = X.lane, w = X.wave, k = tid & 63;
    const float dCk = dC[k];
    const size_t ubase = ((size_t)(d * NH + h) * NCHK + c);
    bf16* PTg = (bf16*)(X.wsv<float>(WS_PQ) + ubase * 2 * 4096); float* Qg = X.wsv<float>(WS_PQ) + ubase * 2 * 4096 + 4096;     bf16* Gg = X.wsv<bf16>(WS_G) + ubase * 4096; float* Yg = X.wsv<float>(WS_YL) + ubase * 4096;
#pragma unroll 1
    for (int q = 0; q < 2; ++q) { const int tile = 2 * w + q, ti = tile >> 2, tj = tile & 3; const f32x4 z4 = {0.f, 0.f, 0.f, 0.f};
        const f32x4 p = mm_tile(Wt, Bh, ti, tj, lane, z4); f32x4 qq = mm_tile(Ut, Bh, ti, tj, lane, z4); qq = mm_tile(Vt, Kh, ti, tj, lane, qq);
        const f32x4 g = mm_tile(Mrb, Wt, ti, tj, lane, z4); f32x4 y = mm_tile(Mrb, Ut, ti, tj, lane, z4); y = mm_tile(Mrk, Vt, ti, tj, lane, y);
        const int col = 16 * tj + (lane & 15); const float dcol = __shfl(dCk, col);
        { const int row0 = 16 * ti + 4 * (lane >> 4); float pv[4];
#pragma unroll
          for (int r = 0; r < 4; ++r) pv[r] = p[r] + ((row0 + r) == col ? dcol : 0.f);
          *(unsigned long long*)(PTg + col * 64 + row0) = (unsigned long long)pk2(pv[0], pv[1]) | ((unsigned long long)pk2(pv[2], pv[3]) << 32); }
#pragma unroll
        for (int r = 0; r < 4; ++r) { const int row = 16 * ti + 4 * (lane >> 4) + r;
            Qg[row * 64 + col] = qq[r];
            const int orow = d ? 63 - row : row;
            Gg[orow * 64 + col] = (bf16)f2bf(g[r] + bf2f(Rn[row * LP + col])); }
        { const int gq = lane >> 4; const int cti = d ? 3 - ti : ti, cg = d ? 3 - gq : gq; const f32x4 yv = d ? (f32x4){y[3], y[2], y[1], y[0]} : y;
          *(f32x4*)(Yg + ((cti * 4 + tj) * 64 + 16 * cg + (lane & 15)) * 4) = yv; } }
    __syncthreads();
}
__device__ __forceinline__ void seq_unit(const Ctx& X, int su) {
    const int d = su / (NH * 4), h = (su / 4) % NH, qv = su & 3;
    constexpr int PD = 9, RING = PD + 1, SLOTB = 8192 + 4096;
    LAS unsigned char* ring = X.lds;
    LAS bf16* S = (LAS bf16*)(ring + RING * SLOTB);
    static_assert(RING * SLOTB + 2 * 16 * LP * 2 <= LDS_STAGE && (PD - 1) * 6 <= 63, "seq LDS map / vmcnt range");
    const int lane = X.lane, w = X.wave, tj = w & 3, col = 16 * tj + (lane & 15), kq = lane >> 4, kof = 8 * kq;
    const bool worker = w < 4;
    const unsigned char* PQ = (const unsigned char*)(X.ws<float>(WS_PQ) + (size_t)(d * NH + h) * NCHK * 2 * 4096); bf16* S0g = X.ws<bf16>(WS_S0) + (size_t)(d * NH + h) * NCHK * 4096 + (size_t)(16 * qv) * 64;
#define SEQ_FILL(c_) do { const unsigned char* p_ = PQ + (size_t)(c_) * 32768; LAS unsigned char* sl_ = ring + ((c_) % RING) * SLOTB; \
        GLDS16(p_ + 16 * (w * 64 + lane), sl_ + 16 * (w * 64)); GLDS16(p_ + 16384 + (16 * qv) * 256 + 16 * ((w & 3) * 64 + lane), sl_ + 8192 + 16 * ((w & 3) * 64)); } while (0)
#pragma unroll
    for (int i = 0; i < PD; ++i) if (i < NCHK) SEQ_FILL(i);
    for (int i = X.tid; i < 2 * 16 * LP / 2; i += NTHR) ((LAS unsigned*)S)[i] = 0u;
    if (worker) {
#pragma unroll
        for (int r = 0; r < 4; ++r) S0g[(4 * kq + r) * 64 + col] = (bf16)0; }
    for (int c = 0; c < NCHK; ++c) {
        if (c + PD - 1 < NCHK) { if (worker) { ASM_WAIT_V(48); } else { ASM_WAIT_V(16); } } else { ASM_WAIT_V(0); }
        ASM_WAIT_L(0); S_BARRIER(); CFENCE();
        if (c + PD < NCHK) SEQ_FILL(c + PD);
        if (worker) {
            const LAS bf16* PT = (const LAS bf16*)(ring + (c % RING) * SLOTB); const LAS float* Q = (const LAS float*)(ring + (c % RING) * SLOTB + 8192);
            const LAS bf16* Sc = S + (c & 1) * 16 * LP; LAS bf16* Sn = S + ((c + 1) & 1) * 16 * LP;
            f32x4 acc;
#pragma unroll
            for (int r = 0; r < 4; ++r) acc[r] = Q[(4 * kq + r) * 64 + col];
#pragma unroll
            for (int kk = 0; kk < 2; ++kk) acc = MFMA16(*(const LAS bf16x8*)(Sc + (lane & 15) * LP + kof + 32 * kk), *(const LAS bf16x8*)(PT + (16 * tj + (lane & 15)) * 64 + kof + 32 * kk), acc);
#pragma unroll
            for (int r = 0; r < 4; ++r) { const bf16 sb = (bf16)f2bf(acc[r]); Sn[(4 * kq + r) * LP + col] = sb; if (c + 1 < NCHK) S0g[(size_t)(c + 1) * 4096 + (4 * kq + r) * 64 + col] = sb; } }
    }
    ASM_WAIT_V(0);
    __syncthreads();
#undef SEQ_FILL
}
constexpr int CR = 16;
__device__ __forceinline__ void conv_item(const Ctx& X, int item) {
    constexpr int NCG = HW / 64; constexpr int n = CTX;
    const int cg = item % NCG, ob = item / NCG, i0 = CR * ob, c = cg * 64 + X.lane;
    const float* F = X.ws<float>(WS_FILT) + (size_t)HW * SEQ + (size_t)c * CTX; const float* Z = X.ws<float>(WS_Z) + c;
    const float* fp = X.ws<float>(WS_FPART) + (size_t)NPART * HW + c;
    float nsum = 0.f; for (int b = 0; b < NPART; ++b) nsum += fp[(size_t)b * HW];
    float acc[CR], Q[CR];
#pragma unroll
    for (int r = 0; r < CR; ++r) acc[r] = 0.f;
    int jb = i0 - n / 2; if (jb < 0) jb = 0;
    int jend = i0 + n / 2 + CR; if (jend > n) jend = n;
    int Tb = i0 - jb + n / 2;
#pragma unroll
    for (int x = 1; x < CR; ++x) { const int T = Tb + x; Q[x] = (T >= 0 && T < n) ? F[T] : 0.f; }
    Q[0] = 0.f;
    for (; jb < jend; jb += CR, Tb -= CR) {
#pragma unroll
        for (int s = 0; s < CR; ++s) { const int T = Tb - s, j = jb + s;
            if ((s & 3) == 0) CFENCE();
            Q[(CR - s) & (CR - 1)] = (T >= 0 && T < n) ? F[T] : 0.f;
            const float zj = (j < n) ? Z[(size_t)j * HW] : 0.f;
#pragma unroll
            for (int r = 0; r < CR; ++r) acc[r] += Q[(r - s + CR) & (CR - 1)] * zj; }
    }
    const float inv = 1.0f / nsum; float* O = X.ws<float>(WS_CONV) + c;
#pragma unroll
    for (int r = 0; r < CR; ++r) O[(size_t)(i0 + r) * HW] = acc[r] * inv;
}

#ifdef EMU
struct cf { float x, y; };
#else
typedef float cf __attribute__((ext_vector_type(2)));
#endif
__device__ __forceinline__ cf cmul(cf a, cf b) { return cf{a.x * b.x - a.y * b.y, a.x * b.y + a.y * b.x}; }
__device__ __forceinline__ cf cadd(cf a, cf b) { return cf{a.x + b.x, a.y + b.y}; }
__device__ __forceinline__ cf csub(cf a, cf b) { return cf{a.x - b.x, a.y - b.y}; }
__device__ __forceinline__ cf cconj(cf a) { return cf{a.x, -a.y}; }
constexpr int FN = SEQ;
constexpr int flog4(int n) { return n <= 1 ? 0 : 1 + flog4(n / 4); }
constexpr int FLOG4 = flog4(FN), FSQ = 1 << FLOG4;
static_assert((1 << (2 * FLOG4)) == FN && FN * 8 <= LDS_STAGE, "FFT length must be a power of 4 that fits the LDS stage region");
constexpr int FFT_TAB_OFF = LDS_MISC + 2048;
static_assert(FFT_TAB_OFF + 2 * FSQ * 8 <= LDS_BYTES, "FFT twiddle tables");
__device__ __forceinline__ void fft_tables(const Ctx& X) {
    LAS cf* T = (LAS cf*)(X.lds + FFT_TAB_OFF);
    for (int i = X.tid; i < 2 * FSQ; i += NTHR) { const int k = i < FSQ ? i * FSQ : i - FSQ; float s, c; sincos_f(-6.283185307179586f * (float)k / (float)FN, s, c); T[i] = cf{c, s}; }
    __syncthreads();
}
__device__ __forceinline__ cf fft_tw(const LAS cf* T, int k) { const cf a = T[k >> FLOG4], b = T[FSQ + (k & (FSQ - 1))]; return cmul(a, b); }
__device__ __forceinline__ int rev4(int k) { int r = 0;
#pragma unroll
    for (int s = 0; s < FLOG4; ++s) { r = (r << 2) | (k & 3); k >>= 2; }
    return r; }
__device__ __forceinline__ void fft_stage_q1(LAS cf* x, int tid, bool inverse) {
    for (int u = tid; u < FN / 4; u += NTHR) { LAS f32x4* px = (LAS f32x4*)(x + 4 * u); const f32x4 v01 = px[0], v23 = px[1];
        const cf a0{v01[0], v01[1]}, a1{v01[2], v01[3]}, a2{v23[0], v23[1]}, a3{v23[2], v23[3]};
        const cf t0 = cadd(a0, a2), t1 = csub(a0, a2), t2 = cadd(a1, a3), d = csub(a1, a3), t3 = inverse ? cf{-d.y, d.x} : cf{d.y, -d.x};
        const cf y0 = cadd(t0, t2), y1 = cadd(t1, t3), y2 = csub(t0, t2), y3 = csub(t1, t3);
        px[0] = (f32x4){y0.x, y0.y, y1.x, y1.y}; px[1] = (f32x4){y2.x, y2.y, y3.x, y3.y}; }
    __syncthreads();
}
__device__ __forceinline__ void dif4(cf& a0, cf& a1, cf& a2, cf& a3, cf w1) {
    const cf w2 = cmul(w1, w1), w3 = cmul(w2, w1);
    const cf t0 = cadd(a0, a2), t1 = csub(a0, a2), t2 = cadd(a1, a3), d = csub(a1, a3), t3 = cf{d.y, -d.x};
    a0 = cadd(t0, t2); a1 = cmul(cadd(t1, t3), w1); a2 = cmul(csub(t0, t2), w2); a3 = cmul(csub(t1, t3), w3);
}
__device__ __forceinline__ void dit4(cf& a0, cf& a1, cf& a2, cf& a3, cf w1c) {
    const cf w2 = cmul(w1c, w1c), w3 = cmul(w2, w1c);
    a1 = cmul(a1, w1c); a2 = cmul(a2, w2); a3 = cmul(a3, w3);
    const cf t0 = cadd(a0, a2), t1 = csub(a0, a2), t2 = cadd(a1, a3), d = csub(a1, a3), t3 = cf{-d.y, d.x};
    a0 = cadd(t0, t2); a1 = cadd(t1, t3); a2 = csub(t0, t2); a3 = csub(t1, t3);
}
__device__ __forceinline__ void fft_pair(LAS cf* x, const LAS cf* T, int tid, int s, bool inverse) {
    const int q1 = FN >> (2 * s + 2), q2 = q1 >> 2, tw1 = 1 << (2 * s), tw2 = tw1 << 2;
    for (int u = tid; u < FN / 16; u += NTHR) { const int j2 = u & (q2 - 1), base = (u - j2) * 16 + j2;
        cf v[4][4];
#pragma unroll
        for (int a = 0; a < 4; ++a)
#pragma unroll
            for (int b = 0; b < 4; ++b) v[a][b] = x[base + a * q1 + b * q2];
        if (!inverse) {
#pragma unroll
            for (int b = 0; b < 4; ++b) dif4(v[0][b], v[1][b], v[2][b], v[3][b], fft_tw(T, (b * q2 + j2) * tw1));
            const cf wb = fft_tw(T, j2 * tw2);
#pragma unroll
            for (int a = 0; a < 4; ++a) dif4(v[a][0], v[a][1], v[a][2], v[a][3], wb);
        } else {
            const cf wb = cconj(fft_tw(T, j2 * tw2));
#pragma unroll
            for (int a = 0; a < 4; ++a) dit4(v[a][0], v[a][1], v[a][2], v[a][3], wb);
#pragma unroll
            for (int b = 0; b < 4; ++b) dit4(v[0][b], v[1][b], v[2][b], v[3][b], cconj(fft_tw(T, (b * q2 + j2) * tw1)));
        }
#pragma unroll
        for (int a = 0; a < 4; ++a)
#pragma unroll
            for (int b = 0; b < 4; ++b) x[base + a * q1 + b * q2] = v[a][b]; }
    __syncthreads();
}
__device__ __forceinline__ void fft_single(LAS cf* x, const LAS cf* T, int tid, int s, bool inverse) {
    const int q = FN >> (2 * s + 2), tw = 1 << (2 * s);
    for (int u = tid; u < FN / 4; u += NTHR) { const int j = u & (q - 1), p = (u - j) * 4 + j;
        cf a0 = x[p], a1 = x[p + q], a2 = x[p + 2 * q], a3 = x[p + 3 * q];
        if (!inverse) dif4(a0, a1, a2, a3, fft_tw(T, j * tw)); else dit4(a0, a1, a2, a3, cconj(fft_tw(T, j * tw)));
        x[p] = a0; x[p + q] = a1; x[p + 2 * q] = a2; x[p + 3 * q] = a3; }
    __syncthreads();
}
constexpr int fft_npairs() { int n = 0; for (int s = 0; s + 1 < FLOG4 - 1; s += 2) { if ((FN >> (2 * s + 6)) >= 64 || FN < 16384) ++n; else break; } return n; }
constexpr int FPAIRS = fft_npairs();
__device__ __forceinline__ void fft_run(LAS cf* x, const LAS cf* T, int tid, bool inverse) {
    constexpr int NST = FPAIRS + (FLOG4 - 1 - 2 * FPAIRS) + 1;
#pragma unroll 1
    for (int i = 0; i < NST; ++i) { const int k = inverse ? NST - 1 - i : i;
        if (k < FPAIRS) fft_pair(x, T, tid, 2 * k, inverse);
        else if (k < NST - 1) fft_single(x, T, tid, 2 * FPAIRS + (k - FPAIRS), inverse);
        else fft_stage_q1(x, tid, inverse); }
}
__device__ __forceinline__ void fft_fwd(LAS cf* x, const LAS cf* T, int tid) { fft_run(x, T, tid, false); }
__device__ __forceinline__ void fft_inv(LAS cf* x, const LAS cf* T, int tid) { fft_run(x, T, tid, true); }
__device__ __forceinline__ void fft_load_real(LAS cf* x, const float* src, float scale, int tid) {
    for (int m = tid; m < FN; m += NTHR) { cf v{0.f, 0.f}; if (m < FN / 2) { v.x = src[2 * m] * scale; v.y = src[2 * m + 1] * scale; } x[m] = v; }
    __syncthreads();
}
__device__ __forceinline__ void spec_load(const Ctx& X, int c) {
    LAS cf* x = (LAS cf*)X.lds; volatile LAS float* red = (volatile LAS float*)(X.lds + LDS_MISC) + 120;
    if (X.wave == 0) { const float* fp = X.ws<float>(WS_FPART) + c; float s = 0.f; for (int b = X.lane; b < NPART; b += 64) s += fp[(size_t)b * HW]; s = wave_sum(s); if (X.lane == 0) red[0] = s; }
    __syncthreads();
    const float inv = 1.0f / red[0];
    fft_load_real(x, X.ws<float>(WS_FILT) + (size_t)c * SEQ, inv, X.tid);
}
__device__ __forceinline__ void spec_unpack(const Ctx& X, int c) {
    LAS cf* x = (LAS cf*)X.lds;
    cf* HS = X.ws<cf>(WS_HS) + (size_t)c * (FN + 1);
    for (int k = X.tid; k <= FN / 2; k += NTHR) {
        const cf A = x[rev4(k)], B = x[rev4((FN - k) & (FN - 1))];
        if (k == 0) { HS[0] = cf{A.x + A.y, 0.f}; HS[FN] = cf{A.x - A.y, 0.f}; }
        else if (k == FN / 2) { HS[k] = cconj(A); }
        else { float sn, cs; sincos_f(-3.14159265358979f * (float)k / (float)FN, sn, cs); const cf w{cs, sn};
            const cf s1 = cadd(A, cconj(B)), d1 = csub(A, cconj(B)), wd = cmul(w, d1);
            HS[k] = cf{0.5f * (s1.x + wd.y), 0.5f * (s1.y - wd.x)};
            const cf s2 = cadd(B, cconj(A)), d2 = csub(B, cconj(A)), wd2 = cmul(cconj(w), d2);
            HS[FN - k] = cf{0.5f * (s2.x - wd2.y), 0.5f * (s2.y + wd2.x)}; } }
    __syncthreads();
}
__device__ __forceinline__ void fftconv_load(const Ctx& X, int c) { fft_load_real((LAS cf*)X.lds, X.ws<float>(WS_ZT) + (size_t)c * M + CTX, 1.0f, X.tid); }
__device__ __forceinline__ void fftconv_mul(const Ctx& X, int c) {
    LAS cf* x = (LAS cf*)X.lds;
    const cf* HS = X.ws<cf>(WS_HS) + (size_t)c * (FN + 1);
    for (int k = X.tid; k <= FN / 2; k += NTHR) {
        const int pa = rev4(k), pb = rev4((FN - k) & (FN - 1)); const cf A = x[pa], B = x[pb];
        if (k == 0) { const float y0 = (A.x + A.y) * HS[0].x, yn = (A.x - A.y) * HS[FN].x; x[pa] = cf{0.5f * (y0 + yn), 0.5f * (y0 - yn)}; }
        else if (k == FN / 2) { x[pa] = cconj(cmul(cconj(A), HS[k])); }
        else { float sn, cs; sincos_f(-3.14159265358979f * (float)k / (float)FN, sn, cs); const cf w{cs, sn};
            const cf s1 = cadd(A, cconj(B)), d1 = csub(A, cconj(B)), wd = cmul(w, d1); const cf Xk{0.5f * (s1.x + wd.y), 0.5f * (s1.y - wd.x)};
            const cf s2 = cadd(B, cconj(A)), d2 = csub(B, cconj(A)), wd2 = cmul(cconj(w), d2); const cf Xn{0.5f * (s2.x - wd2.y), 0.5f * (s2.y + wd2.x)};
            const cf Yk = cmul(Xk, HS[k]), Yn = cmul(Xn, HS[FN - k]);
            const cf e1 = cadd(Yk, cconj(Yn)), f1 = cmul(cconj(w), csub(Yk, cconj(Yn)));
            x[pa] = cf{0.5f * (e1.x - f1.y), 0.5f * (e1.y + f1.x)};
            const cf e2 = cadd(Yn, cconj(Yk)), f2 = cmul(w, csub(Yn, cconj(Yk)));
            x[pb] = cf{0.5f * (e2.x + f2.y), 0.5f * (e2.y - f2.x)}; } }
    __syncthreads();
}
__device__ __forceinline__ void fftconv_out(const Ctx& X, int l, int c) {
    const LAS cf* x = (const LAS cf*)X.lds; const float* z = X.ws<float>(WS_ZT) + (size_t)c * M + CTX;
    const float bias = X.in(I_HBIAS)[(size_t)l * HW + c], sc = 1.0f / (float)FN; float* O = X.ws<float>(WS_CVT) + (size_t)c * SEQ;
    for (int i2 = X.tid; i2 < FN / 2; i2 += NTHR) { const cf d = x[i2 + FN / 4]; O[2 * i2] = d.x * sc + z[2 * i2] * bias; O[2 * i2 + 1] = d.y * sc + z[2 * i2 + 1] * bias; }
    __syncthreads();
}
__device__ __forceinline__ void phase_ctxconv(const Ctx& X, int l) {
    constexpr int NITEMS = (HW / 64) * (CTX / CR);
    unsigned* q = X.ctl() + CW_Q + l * 64;
    for (;;) { int item = 0; if (X.lane == 0) item = (int)atomicAdd(q, 1u); item = __shfl(item, 0); if (item >= NITEMS) break; conv_item(X, item); }
}
__device__ __forceinline__ void phase_seq(const Ctx& X) {
    for (int su = X.bid; su < N_SEQ_UNITS; su += X.G) seq_unit(X, su);
}

__device__ __forceinline__ void finish_wave_unit(const Ctx& X, int l, int unit) {
    const int rg = unit / NH, h = unit % NH, lane = X.lane, b = rg >> 2, sub = rg & 3;
    const int cf = b, cb = (b < CTX / CC) ? (CTX / CC - 1 - b) : (NCHK - 1 - (b - CTX / CC));
    const size_t uf = ((size_t)(0 * NH + h) * NCHK + cf) * 4096, ub = ((size_t)(1 * NH + h) * NCHK + cb) * 4096;
    const bf16* G = X.wsv<bf16>(WS_G); const bf16* S0 = X.wsv<bf16>(WS_S0); const float* YL = X.wsv<float>(WS_YL);
    const int arow = 16 * sub + (lane & 15), kof = 8 * (lane >> 4);
    bf16x8 af[2], ab[2];
#pragma unroll
    for (int kk = 0; kk < 2; ++kk) { af[kk] = *(const bf16x8*)(G + uf + arow * 64 + kof + 32 * kk); ab[kk] = *(const bf16x8*)(G + ub + arow * 64 + kof + 32 * kk); }
    f32x4 y[4];
#pragma unroll
    for (int tj = 0; tj < 4; ++tj) { const int vrow = 16 * tj + (lane & 15);
        bf16x8 bf_[2], bb_[2];
#pragma unroll
        for (int kk = 0; kk < 2; ++kk) { bf_[kk] = *(const bf16x8*)(S0 + uf + vrow * 64 + kof + 32 * kk); bb_[kk] = *(const bf16x8*)(S0 + ub + vrow * 64 + kof + 32 * kk); }
        f32x4 acc;
#pragma unroll
        for (int r = 0; r < 4; ++r) acc[r] = 0.f;
        acc = *(const f32x4*)(YL + uf + ((sub * 4 + tj) * 64 + lane) * 4) + *(const f32x4*)(YL + ub + ((sub * 4 + tj) * 64 + lane) * 4);
#pragma unroll
        for (int kk = 0; kk < 2; ++kk) { acc = MFMA16(af[kk], bf_[kk], acc); acc = MFMA16(ab[kk], bb_[kk], acc); }
        y[tj] = acc; }
    const float* lgp = X.inv(I_LNXG) + (size_t)l * RW + 64 * h; const float* lbp = X.inv(I_LNXB) + (size_t)l * RW + 64 * h;
    const bf16* pV = X.wsv<bf16>(WS_V); const bf16* pG = X.wsv<bf16>(WS_GATE); const float* pBo = X.wsv<float>(WS_BONUS); bf16* pRO = X.wsv<bf16>(WS_RO);
#pragma unroll
    for (int r = 0; r < 4; ++r) { const int t = 16 * rg + 4 * (lane >> 4) + r;
        const float mean = row16_sum((y[0][r] + y[1][r]) + (y[2][r] + y[3][r])) * (1.f / 64.f);
        float q = 0.f;
#pragma unroll
        for (int tj = 0; tj < 4; ++tj) { const float dy = y[tj][r] - mean; q += dy * dy; }
        const float rstd = 1.0f / sqrtf(row16_sum(q) * (1.f / 64.f) + GN_EPS); const float bon = pBo[(size_t)t * NH + h];
#pragma unroll
        for (int tj = 0; tj < 4; ++tj) { const int cl = 16 * tj + (lane & 15); const size_t o = (size_t)t * RW + 64 * h + cl;
            float yn = (y[tj][r] - mean) * rstd * lgp[cl] + lbp[cl];
            yn += bon * bf2f(pV[o]); yn *= bf2f(pG[o]);
            pRO[o] = (bf16)f2bf(yn); } }
}
__device__ __forceinline__ void phase_finish(const Ctx& X, int l) {
    for (int u = X.bid * NWAVES + X.wave; u < (M / 16) * NH; u += X.G * NWAVES) { if (l == DEPTH - 1 && u < (CTX / 16) * NH) continue; finish_wave_unit(X, l, u); }
    const int c = X.tid;
    if (c < HW) { const float hbc = X.in(I_HBIAS)[(size_t)l * HW + c]; const float* CV = X.ws<float>(WS_CVT) + (size_t)c * SEQ; const bf16* X0 = X.ws<bf16>(WS_X0); bf16* HO = X.ws<bf16>(WS_HO);
        for (int tile = X.bid; tile < M / TT; tile += X.G) { const int t0 = tile * TT; float cv[TT];
            if (l == DEPTH - 1 && t0 < CTX) continue;
            if (t0 < CTX) {
#pragma unroll
                for (int tt = 0; tt < TT; ++tt) { const size_t o = (size_t)(t0 + tt) * HW + c; cv[tt] = X.ws<float>(WS_CONV)[o] + X.ws<float>(WS_Z)[o] * hbc; } }
            else { const f32x4 a = *(const f32x4*)(CV + (t0 - CTX)), b = *(const f32x4*)(CV + (t0 - CTX) + 4);
#pragma unroll
                for (int i = 0; i < 4; ++i) { cv[i] = a[i]; cv[4 + i] = b[i]; } }
#pragma unroll
            for (int tt = 0; tt < TT; ++tt) { const size_t o = (size_t)(t0 + tt) * HW + c; HO[o] = (bf16)f2bf(cv[tt] * bf2f(X0[o])); } } }
}

__device__ __forceinline__ void ln_inplace(float (&v)[D / 64], const float* g, const float* b, int lane) {
    float s = 0.f;
#pragma unroll
    for (int j = 0; j < D / 64; ++j) s += v[j];
    const float mean = wave_sum(s) * (1.f / D); float q = 0.f;
#pragma unroll
    for (int j = 0; j < D / 64; ++j) { v[j] -= mean; q += v[j] * v[j]; }
    const float rstd = 1.0f / sqrtf(wave_sum(q) * (1.f / D) + LN_EPS);
#pragma unroll
    for (int j = 0; j < D / 64; ++j) { const int d = 4 * lane + 256 * (j >> 2) + (j & 3); v[j] = v[j] * rstd * g[d] + b[d]; }
}
__device__ __forceinline__ void phase_norm1(const Ctx& X, int l) {
    const int gw = X.bid * NWAVES + X.wave, NGW = X.G * NWAVES, lane = X.lane;
    const float* lng = X.in(I_LNG) + (size_t)(l * 2 + 0) * D; const float* lnb = X.in(I_LNB) + (size_t)(l * 2 + 0) * D;
    const float* wr = X.in(I_WR); const float* rb = X.in(I_RB);
    const float alpha = sqrtf(sqrtf(2.0f * DEPTH));
    volatile LAS int* hist = (volatile LAS int*)(X.lds + LDS_MISC + 4096);
    if (X.tid < NE) hist[X.tid] = 0;
    __syncthreads();
    for (int t = gw; t < M; t += NGW) { if (l == DEPTH - 1 && t < CTX) continue;
        float* xr = X.ws<float>(WS_X) + (size_t)t * D; const float* mx = X.ws<float>(WS_MIX) + (size_t)t * D;
        const float* gate = modp(X, l, t, 2); const float* sh = modp(X, l, t, 3); const float* sc = modp(X, l, t, 4);
        float v[D / 64];
#pragma unroll
        for (int j = 0; j < D / 256; ++j) { const int d = 4 * lane + 256 * j; const f32x4 a = *(const f32x4*)(xr + d), m = *(const f32x4*)(mx + d), gt = *(const f32x4*)(gate + d);
#pragma unroll
            for (int i = 0; i < 4; ++i) v[4 * j + i] = alpha * a[i] + gt[i] * m[i]; }
        ln_inplace(v, lng, lnb, lane);
        bf16* hf = X.ws<bf16>(WS_XMOD) + (size_t)t * D;
        LAS float* hrow = (LAS float*)X.lds + X.wave * D;
#pragma unroll
        for (int j = 0; j < D / 256; ++j) { const int d = 4 * lane + 256 * j; f32x4 o; const f32x4 a = *(const f32x4*)(sh + d), b = *(const f32x4*)(sc + d); f32x4 h;
#pragma unroll
            for (int i = 0; i < 4; ++i) { o[i] = v[4 * j + i]; h[i] = o[i] * (1.f + b[i]) + a[i]; }
            *(f32x4*)(xr + d) = o; *(LAS f32x4*)(hrow + d) = h;
            *(unsigned long long*)(hf + d) = (unsigned long long)pk2(h[0], h[1]) | ((unsigned long long)pk2(h[2], h[3]) << 32); }
        WAVE_LDS_FENCE(); CFENCE();
        float part = 0.f; { const int e = lane & 15, q = lane >> 4;
#pragma unroll 8
            for (int d = q * (D / 4); d < (q + 1) * (D / 4); ++d) part += hrow[d] * wr[(size_t)d * NE + e]; }
        part += __shfl_xor(part, 16); part += __shfl_xor(part, 32);
        WAVE_LDS_FENCE(); CFENCE();
        float lg[NE];
#pragma unroll
        for (int e = 0; e < NE; ++e) lg[e] = __shfl(part, e);
        float mxl = lg[0];
#pragma unroll
        for (int e = 1; e < NE; ++e) mxl = fmaxf(mxl, lg[e]);
        float sc_[NE], sum = 0.f;
#pragma unroll
        for (int e = 0; e < NE; ++e) { sc_[e] = expf(lg[e] - mxl); sum += sc_[e]; }
        const float isum = 1.0f / sum; float sel[NE];
#pragma unroll
        for (int e = 0; e < NE; ++e) { sc_[e] *= isum; sel[e] = sc_[e] + rb[e]; }
        int bg = 0; float bgs = -INFINITY;
#pragma unroll
        for (int g = 0; g < 4; ++g) { float m1 = -INFINITY, m2 = -INFINITY;
#pragma unroll
            for (int i = 0; i < 4; ++i) { const float x = sel[4 * g + i]; if (x > m1) { m2 = m1; m1 = x; } else if (x > m2) m2 = x; }
            const float gs = m1 + m2; if (gs > bgs) { bgs = gs; bg = g; } }
        int i0 = 0, i1 = 0; float s0 = -INFINITY, s1 = -INFINITY, p0 = 0.f, p1 = 0.f;
#pragma unroll
        for (int e = 0; e < NE; ++e) { if ((e >> 2) == bg) { const float x = sel[e]; if (x > s0) { s1 = s0; i1 = i0; p1 = p0; s0 = x; i0 = e; p0 = sc_[e]; } else if (x > s1) { s1 = x; i1 = e; p1 = sc_[e]; } } }
        if (lane == 0) { int* ei = X.ws<int>(WS_ROUT) + (size_t)t * 2; float* ew = (float*)(X.ws<int>(WS_ROUT) + (size_t)M * 2) + (size_t)t * 2;
            ei[0] = i0; ei[1] = i1; const float ws_ = 1.0f / (p0 + p1); ew[0] = p0 * ws_; ew[1] = p1 * ws_;
            lds_add(hist + i0, 1); lds_add(hist + i1, 1); }
    }
    __syncthreads();
    if (X.tid < NE) { const int hc = hist[X.tid]; X.ws<int>(WS_BCNT)[X.bid * NE + X.tid] = hc; atomicAdd(X.ctl() + CW_CNT + l * 64 + X.tid, (unsigned)hc); }
}

__device__ __forceinline__ void moe_table(const Ctx& X, int l, int NT) {
    volatile LAS int* tab = (volatile LAS int*)(X.lds + LDS_MISC) + 8;
    if (X.tid == 0) { int cum = 0, ts = 0;
        for (int e = 0; e < NE; ++e) { const int cnt = (int)__hip_atomic_load(X.ctl() + CW_CNT + l * 64 + e, RLX_AGENT); const int tc = (cnt + 255) / 256;
            tab[e] = cum; tab[32 + e] = ts; tab[64 + e] = tc; cum += tc * NT; ts += tc; }
        tab[16] = cum; }
    __syncthreads();
}
__device__ __forceinline__ void phase_scatter(const Ctx& X, int l) {
    moe_table(X, l, 1);
    volatile LAS int* tab = (volatile LAS int*)(X.lds + LDS_MISC) + 8;
    volatile LAS int* cur = (volatile LAS int*)(X.lds + LDS_MISC + 4096) + 16;
    const int gw = X.bid * NWAVES + X.wave, NGW = X.G * NWAVES, lane = X.lane;
    if (X.tid < NE) { const int* bc = X.ws<int>(WS_BCNT) + X.tid; int pre = 0; for (int b = 0; b < X.bid; ++b) pre += bc[b * NE]; cur[X.tid] = tab[32 + X.tid] * 256 + pre; }
    __syncthreads();
    const int* ei = X.ws<int>(WS_ROUT); int* slot = X.ws<int>(WS_ROUT) + (size_t)M * 4;
    for (int t = gw; t < M; t += NGW) { if (l == DEPTH - 1 && t < CTX) continue;
#pragma unroll
        for (int k = 0; k < 2; ++k) { const int e = ei[2 * t + k];
            int pos = 0; if (lane == 0) pos = lds_add(cur + e, 1);
            pos = __shfl(pos, 0);
            if (lane == 0) slot[2 * t + k] = pos;
            const u32x4* src = (const u32x4*)(X.ws<bf16>(WS_XMOD) + (size_t)t * D); u32x4* dst = (u32x4*)(X.ws<bf16>(WS_XG) + (size_t)pos * D);
            for (int i = lane; i < D / 8; i += 64) dst[i] = src[i]; } }
}

__device__ __forceinline__ void phase_combine(const Ctx& X, int l) {
    const int gw = X.bid * NWAVES + X.wave, NGW = X.G * NWAVES, lane = X.lane;
    const float* lng = X.in(I_LNG) + (size_t)(l * 2 + 1) * D; const float* lnb = X.in(I_LNB) + (size_t)(l * 2 + 1) * D;
    const float alpha = sqrtf(sqrtf(2.0f * DEPTH));
    const float* ew = (const float*)(X.ws<int>(WS_ROUT) + (size_t)M * 2); const int* slot = X.ws<int>(WS_ROUT) + (size_t)M * 4;
    for (int t = gw; t < M; t += NGW) { if (l == DEPTH - 1 && t < CTX) continue;
        float* xr = X.ws<float>(WS_X) + (size_t)t * D; const float* gate = modp(X, l, t, 5);
        const bf16* y0 = X.ws<bf16>(WS_YS) + (size_t)slot[2 * t] * D; const bf16* y1 = X.ws<bf16>(WS_YS) + (size_t)slot[2 * t + 1] * D; const float w0 = ew[2 * t], w1 = ew[2 * t + 1];
        float v[D / 64];
#pragma unroll
        for (int j = 0; j < D / 256; ++j) { const int d = 4 * lane + 256 * j; const f32x4 a = *(const f32x4*)(xr + d), gt = *(const f32x4*)(gate + d);
            const unsigned long long q0 = *(const unsigned long long*)(y0 + d), q1 = *(const unsigned long long*)(y1 + d);
            float ya[4] = {bflo((unsigned)q0), bfhi((unsigned)q0), bflo((unsigned)(q0 >> 32)), bfhi((unsigned)(q0 >> 32))};
            float yb[4] = {bflo((unsigned)q1), bfhi((unsigned)q1), bflo((unsigned)(q1 >> 32)), bfhi((unsigned)(q1 >> 32))};
#pragma unroll
            for (int i = 0; i < 4; ++i) v[4 * j + i] = alpha * a[i] + gt[i] * (w0 * ya[i] + w1 * yb[i]); }
        ln_inplace(v, lng, lnb, lane);
        if (l + 1 < DEPTH) { const float* sh = modp(X, l + 1, t, 0); const float* sc = modp(X, l + 1, t, 1); bf16* xm = X.ws<bf16>(WS_XMOD) + (size_t)t * D;
#pragma unroll
            for (int j = 0; j < D / 256; ++j) { const int d = 4 * lane + 256 * j; f32x4 o; const f32x4 a = *(const f32x4*)(sh + d), b = *(const f32x4*)(sc + d); float h[4];
#pragma unroll
                for (int i = 0; i < 4; ++i) { o[i] = v[4 * j + i]; h[i] = o[i] * (1.f + b[i]) + a[i]; }
                *(f32x4*)(xr + d) = o;
                *(unsigned long long*)(xm + d) = (unsigned long long)pk2(h[0], h[1]) | ((unsigned long long)pk2(h[2], h[3]) << 32); }
        } else if (t >= CTX) { float* orow = X.out() + (size_t)(t - CTX) * D; const bool bad = __hip_atomic_load(X.ctl() + CW_BAR + XB_TMO, RLX_AGENT) != 0u; const float pscale = 1.0f + bitsf(__hip_atomic_load(X.ctl() + 64, RLX_AGENT));
#pragma unroll
            for (int j = 0; j < D / 256; ++j) { const int d = 4 * lane + 256 * j; f32x4 o;
#pragma unroll
                for (int i = 0; i < 4; ++i) o[i] = bad ? __builtin_nanf("") : v[4 * j + i] * pscale;
                *(f32x4*)(orow + d) = o; }
        }
    }
}


#ifdef EMU
#define PHASE_FN static
#define THIN_FN static
#else
#define PHASE_FN __device__ __forceinline__
#define THIN_FN __device__ __noinline__
#endif
THIN_FN void ph_transposes(Ctx X, int l, int part) { phase_transposes(X, l, part); }
THIN_FN void ph_filters_begin(Ctx X) { phase_filters_begin(X); }
THIN_FN void ph_filters_item(Ctx X, int l, int which, int it) { phase_filters_item(X, l, which, it); }
THIN_FN void ph_filters_end(Ctx X) { phase_filters_end(X); }
#define PH_FILTERS(X_, l_) do { ph_filters_begin(X_); for (int wh_ = 0; wh_ < 2; ++wh_) for (int it_ = (X_).bid * NWAVES + (X_).wave; it_ < (wh_ ? CTX : SEQ) / 16; it_ += (X_).G * NWAVES) ph_filters_item(X_, l_, wh_, it_); ph_filters_end(X_); } while (0)
THIN_FN void ph_filter_weights(Ctx X, int l) { phase_filter_weights(X, l); }
THIN_FN void ph_mod(Ctx X) { phase_mod(X); }
THIN_FN void ph_x0(Ctx X) { phase_x0(X); }
THIN_FN void ph_lin(Ctx X, int l) { phase_lin(X, l); }
THIN_FN void ph_lora_a(Ctx X, int u) { lora_unit_a(X, u); }
THIN_FN void ph_lora_b(Ctx X, int l, int u) { lora_unit_b(X, l, u); }
THIN_FN void ph_prep_hyena(Ctx X, int l) { phase_prep_hyena(X, l); }
THIN_FN void ph_ctxconv(Ctx X, int l) { phase_ctxconv(X, l); }
THIN_FN void ph_chunk_1(Ctx X, int u) { chunk_unit_1(X, u); }
THIN_FN void ph_chunk_2(Ctx X, int u) { chunk_unit_2(X, u); }
THIN_FN void ph_chunk_3(Ctx X, int u) { chunk_unit_3(X, u); }
THIN_FN void ph_seq(Ctx X) { phase_seq(X); }
THIN_FN void ph_fft_tables(Ctx X) { fft_tables(X); }
THIN_FN void ph_fft_run(Ctx X, int inverse) { fft_run((LAS cf*)X.lds, (const LAS cf*)(X.lds + FFT_TAB_OFF), X.tid, inverse != 0); }
THIN_FN void ph_spec_load(Ctx X, int c) { spec_load(X, c); }
THIN_FN void ph_spec_unpack(Ctx X, int c) { spec_unpack(X, c); }
THIN_FN void ph_fftconv_load(Ctx X, int c) { fftconv_load(X, c); }
THIN_FN void ph_fftconv_mul(Ctx X, int c) { fftconv_mul(X, c); }
THIN_FN void ph_fftconv_out(Ctx X, int l, int c) { fftconv_out(X, l, c); }
THIN_FN void ph_finish(Ctx X, int l) { phase_finish(X, l); }
THIN_FN void ph_norm1(Ctx X, int l) { phase_norm1(X, l); }
THIN_FN void ph_scatter(Ctx X, int l) { phase_scatter(X, l); }
THIN_FN void ph_combine(Ctx X, int l) { phase_combine(X, l); }
PHASE_FN void ph_g13(Ctx X, int third, int r0) { pg8::Gemm g{(third ? X.ws<bf16>(WS_T) : X.ws<bf16>(WS_XMOD)) + (size_t)r0 * D, third ? X.ws<bf16>(WS_WO) : X.ws<bf16>(WS_WIN), D}; pg8::StaticOrder S; S.init(M - r0, third ? D : PCP, X.G, X.bid);
    pg8::EpiBf16OrF32 E{X.ws<bf16>(WS_P) + (size_t)r0 * PCP, X.ws<float>(WS_MIX) + (size_t)r0 * D, third ? D : PCP, third != 0}; pg8::gemm_phase(X.lds, g, S, E); }
PHASE_FN void ph_g2(Ctx X, int second, int r0) { pg8::Gemm g{(second ? X.ws<bf16>(WS_HO) : X.ws<bf16>(WS_RO)) + (size_t)r0 * RW, X.ws<bf16>(WS_WB) + (second ? (size_t)D * RW : 0), RW}; pg8::StaticOrder S; S.init(M - r0, D, X.G, X.bid);
    pg8::EpiGate E{X.ws<bf16>(WS_T) + (size_t)r0 * D, D, X.ws<bf16>(WS_P) + (size_t)r0 * PCP, PCP, second ? C_GH : C_GR, second != 0}; pg8::gemm_phase(X.lds, g, S, E); }
PHASE_FN void ph_g45(Ctx X, int l, int down) { const int NT = down ? D / 256 : 2 * D / 256; moe_table(X, l, NT); pg8::MoeOrder S{(const volatile LAS int*)(X.lds + LDS_MISC) + 8, NT, X.G, X.bid};
    pg8::Gemm g{down ? X.ws<bf16>(WS_ACT) : X.ws<bf16>(WS_XG), down ? X.ws<bf16>(WS_WD) : X.ws<bf16>(WS_WGU), D}; pg8::EpiMoe E{down ? X.ws<bf16>(WS_YS) : X.ws<bf16>(WS_ACT), D, NT, down == 0}; pg8::gemm_phase(X.lds, g, S, E); }

constexpr int NPH = 16, NPHASES = DEPTH * NPH;
template <int MASK> __global__ void __launch_bounds__(NTHR, 2) fwd_kernel(Args args) {
    DYN_LDS(lds);
    Ctx X; X.lds = lds; X.tid = threadIdx.x; X.lane = X.tid & 63; X.wave = READFIRSTLANE(X.tid >> 6); X.G = gridDim.x; X.bid = blockIdx.x;
    volatile LAS unsigned* misc = (volatile LAS unsigned*)(lds + LDS_MISC);
    if (X.tid < 128) misc[X.tid] = 0u;
    if (X.tid < N_IN + 2) { const unsigned long long p = X.tid < N_IN ? (unsigned long long)args.in[X.tid < N_IN ? X.tid : 0] : (X.tid == N_IN ? (unsigned long long)args.out : (unsigned long long)args.ws);
        misc[PT_WORD0 + 2 * X.tid] = (unsigned)p; misc[PT_WORD0 + 2 * X.tid + 1] = (unsigned)(p >> 32); }
    __syncthreads();
    XcdBarrier bar = xcd_barrier_post(X.ctl() + CW_BAR, misc);
    const int lo = args.ph_lo, hi = args.ph_hi;
#define IN(k) ((((MASK) >> ((k) % NPH)) & 1) && lo <= (k) && (k) < hi)
#ifdef PROBE_K
#ifndef PROBE_SCALE
#define PROBE_SCALE 1.0f
#endif
#ifndef PROBE_BLOCK
#define PROBE_BLOCK 0
#endif
    unsigned long long plast = __builtin_amdgcn_s_memrealtime(); if (threadIdx.x < 32) misc[2048 + threadIdx.x] = 0u; __syncthreads();
#define PROBE_TX(k) do { if (blockIdx.x == PROBE_BLOCK && threadIdx.x == 0) { const unsigned long long now_ = __builtin_amdgcn_s_memrealtime(); misc[2048 + (k)] += (unsigned)(now_ - plast); plast = now_; } } while (0)
#define PROBE_T(k) PROBE_TX((k) % NPH)
#define PROBE_PUB(k) do { if ((k) == NPHASES - 2 && blockIdx.x == PROBE_BLOCK && threadIdx.x == 0) { PROBE_T(k); unsigned tot_ = 0; for (int i_ = 0; i_ < 28; ++i_) tot_ += misc[2048 + i_]; \
        const float f_ = floorf(PROBE_SCALE * (float)misc[2048 + PROBE_K] / (float)tot_ * 128.0f + 0.5f) * (1.0f / 128.0f); __hip_atomic_store(X.ctl() + 64, fbits(f_), RLX_AGENT); } } while (0)
#else
#define PROBE_T(k) do {} while (0)
#define PROBE_TX(k) do {} while (0)
#define PROBE_PUB(k) do {} while (0)
#endif
#if defined(REPEAT_SUB) && REPEAT_SUB == 20
#define SEAM(k) do { if ((k) + 1 < hi) { xcd_barrier(bar); xcd_barrier(bar); } } while (0)
#else
#define SEAM(k) do { PROBE_PUB(k); if ((k) + 1 < hi) xcd_barrier(bar); PROBE_T(k); } while (0)
#endif
#if defined(REPEAT_SUB) && REPEAT_SUB == 15
#define RQN 2
#else
#define RQN 1
#endif
#ifdef REPEAT_SUB
#define RPS(id) for (int rps_ = 0; rps_ < ((id) == REPEAT_SUB ? 2 : 1); ++rps_)
#else
#define RPS(id)
#endif
#ifdef REPEAT_PH
#define RPT_IDX rpt_
#define RPT(k) for (int rpt_ = 0; rpt_ < (((k) % NPH) == REPEAT_PH ? 2 : 1); ++rpt_)
#else
#define RPT_IDX 0
#define RPT(k)
#endif
    for (int l = 0; l < DEPTH; ++l) {
        const int pb = l * NPH;
        if (l == 0 && IN(pb + 0)) { ph_transposes(X, l, 0); __syncthreads(); ph_filter_weights(X, 0); ph_mod(X); SEAM(pb + 0); }
        if (l == 0 && IN(pb + 1)) { ph_x0(X); PH_FILTERS(X, 0); SEAM(pb + 1); }
        if (IN(pb + 2)) { ph_g13(X, 0, 0); SEAM(pb + 2); }
        RPT(pb + 3) if (IN(pb + 3)) { RPS(6) ph_lin(X, l); RPS(7) ph_prep_hyena(X, l); ph_fft_tables(X); RPS(8) for (int c = X.bid; c < HW; c += X.G) { ph_spec_load(X, c); ph_fft_run(X, 0); ph_spec_unpack(X, c); } SEAM(pb + 3); }
        RPT(pb + 4) if (IN(pb + 4)) { for (int u = X.bid; u < (M / 64) * NH; u += X.G) { RPS(4) ph_lora_a(X, u); RPS(5) ph_lora_b(X, l, u); } SEAM(pb + 4); }
        RPT(pb + 5) if (IN(pb + 5)) { for (int u = X.bid; u < 2 * NCHK * NH; u += X.G) { RPS(1) ph_chunk_1(X, u); RPS(2) ph_chunk_2(X, u); RPS(3) ph_chunk_3(X, u); } SEAM(pb + 5); }
        RPT(pb + 6) if (IN(pb + 6)) { RPS(9) ph_seq(X); RPS(10) { ph_transposes(X, l, 1); __syncthreads(); } if (l + 1 < DEPTH) ph_filter_weights(X, l + 1); if (l + 1 < DEPTH) ph_ctxconv(X, l); ph_fft_tables(X);
            for (int rq_ = 0; rq_ < RQN; ++rq_) for (;;) { if (X.tid == 0) misc[121] = atomicAdd(X.ctl() + CW_Q + l * 64 + 32 + rq_, 1u); __syncthreads(); const int c = (int)misc[121]; __syncthreads(); if (c >= HW) break;
                ph_fftconv_load(X, c); ph_fft_run(X, 0); ph_fftconv_mul(X, c); ph_fft_run(X, 1); ph_fftconv_out(X, l, c); }
            SEAM(pb + 6); }
        RPT(pb + 7) if (IN(pb + 7)) { ph_finish(X, l); SEAM(pb + 7); }
        for (int sb = 0; sb < 2; ++sb) if (IN(pb + 8 + sb)) { ph_g2(X, sb, l == DEPTH - 1 ? CTX : 0); SEAM(pb + 8 + sb); }
        RPT(pb + 10) if (IN(pb + 10)) { ph_g13(X, 1, l == DEPTH - 1 ? CTX : 0); SEAM(pb + 10); }
        if (IN(pb + 11)) { ph_norm1(X, l); SEAM(pb + 11); }
        if (IN(pb + 12)) { RPS(14) ph_scatter(X, l); SEAM(pb + 12); }
        for (int dn = 0; dn < 2; ++dn) if (IN(pb + 13 + dn)) { ph_g45(X, l, dn); SEAM(pb + 13 + dn); }
        if (IN(pb + 15)) { RPS(11) ph_combine(X, l); if (l + 1 < DEPTH) { __syncthreads(); RPS(12) { ph_transposes(X, l + 1, 0); __syncthreads(); } RPS(13) PH_FILTERS(X, l + 1); } SEAM(pb + 15); }
    }
#undef IN
#undef SEAM
}

#ifndef N_LAUNCHES
#define N_LAUNCHES 1
#endif
#ifndef PH_MASK
#define PH_MASK 0xffff
#endif
template <int MASK> static void launch_mask(int grid, hipStream_t stream, const Args& a) {
    static bool attr = false;
    if (!attr) { (void)hipFuncSetAttribute((const void*)fwd_kernel<MASK>, hipFuncAttributeMaxDynamicSharedMemorySize, LDS_BYTES); attr = true; }
    hipLaunchKernelGGL(fwd_kernel<MASK>, dim3(grid), dim3(NTHR), LDS_BYTES, stream, a);
}
extern "C" void kernel_launch(void* const* d_in, const int* in_sizes, int n_in, void* d_out, int out_size, void* d_ws, size_t ws_size, hipStream_t stream) {
    static int grid = 0;
    if (grid == 0) {
        if (n_in != N_IN || ws_size < WS_END) { fprintf(stderr, "kernel_launch: unexpected n_in %d or workspace %zu < %zu\n", n_in, ws_size, (size_t)WS_END); grid = -1; return; }
        int dev = 0, cus = 0;
        if (hipGetDevice(&dev) != hipSuccess || hipDeviceGetAttribute(&cus, hipDeviceAttributeMultiprocessorCount, dev) != hipSuccess) { grid = -1; return; }
        (void)hipGetLastError();
        grid = cus; if (grid > NPART) grid = NPART;
    }
    if (grid < 0) return;
    (void)in_sizes; (void)out_size;
    (void)hipMemsetAsync(d_ws, 0, CTL_BYTES, stream);
    Args a;
    for (int i = 0; i < N_IN; ++i) a.in[i] = (const float*)d_in[i];
    a.out = (float*)d_out; a.ws = (unsigned char*)d_ws;
#if N_LAUNCHES == 1
    a.ph_lo = 0; a.ph_hi = NPHASES;
    launch_mask<PH_MASK>(grid, stream, a);
#else
    for (int ph = 0; ph < NPHASES; ++ph) { const int k = ph % NPH; if (k == 1 && ph / NPH != 0) continue; a.ph_lo = ph; a.ph_hi = ph + 1; launch_mask<PH_MASK>(grid, stream, a); }
#endif
}
```

```cpp
#ifndef EMU
#include <hip/hip_runtime.h>
#endif
#include <cstdio>
#include <cstdint>
#include <cmath>

#ifndef CFG_D
#define CFG_D 1024
#define CFG_SEQ 16384
#define CFG_CTX 256
#define CFG_DEPTH 4
#endif
constexpr int D = CFG_D, SEQ = CFG_SEQ, CTX = CFG_CTX, DEPTH = CFG_DEPTH, M = CTX + SEQ;
constexpr int GRID_W = 64, GRID_H = SEQ / GRID_W;
constexpr int RW = D / 2, NH = RW / 64, HW = D / 2, RC = 3 * RW + 384, HC = 3 * HW, GC = 2 * D, PC = RC + HC + GC, PCP = (PC + 255) / 256 * 256;
constexpr int QTR = RC / 4, HALFC = RC / 2;
constexpr int C_K = RW, C_V = 2 * RW, C_LWF = 3 * RW, C_LG = 3 * RW + 256;
constexpr int C_HY = RC, C_GR = RC + HC, C_GH = RC + HC + D;
constexpr int NE = 16, SP_TILES = (2 * M) / 256 + NE, SP = SP_TILES * 256;
constexpr float DECAY_SCALE = 0.606531f, GN_EPS = 6.4e-4f, LN_EPS = 1e-5f;
constexpr int LP = 72;
constexpr int LQ = 65;
constexpr int LX = 68;
constexpr int N_SEQ_UNITS = 2 * NH * 4;
constexpr int NPART = 256;
static_assert(CTX % 32 == 0 && M % 256 == 0 && D % 256 == 0 && RW % 128 == 0 && RW >= 256 && SEQ % 64 == 0 && CTX % 32 == 0 && RC % 4 == 0, "shape assumptions");

enum { I_X = 0, I_C, I_CTX, I_CCTX, I_WMOD, I_BMOD, I_WIN, I_MU, I_W0, I_W2, I_A0, I_A2, I_G2, I_KK, I_KA, I_RK, I_LNXG, I_LNXB, I_CW, I_CB,
       I_FW1, I_FB1, I_FW2, I_FB2, I_FW3, I_FB3, I_FWO, I_FREQ, I_HBIAS, I_WBR, I_WOUT, I_LNG, I_LNB, I_WR, I_RB, I_WG, I_WU, I_WD, N_IN };

constexpr size_t al256(size_t x) { return (x + 255) & ~(size_t)255; }
constexpr size_t CTL_BYTES = 1u << 20;
constexpr size_t WS_MOD = CTL_BYTES;
constexpr size_t WS_FPART = al256(WS_MOD + (size_t)DEPTH * 2 * 6 * D * 4);
constexpr size_t WS_ROUT = al256(WS_FPART + (size_t)2 * NPART * HW * 4);
constexpr size_t WS_BCNT = al256(WS_ROUT + (size_t)M * 2 * 4 * 3);
constexpr size_t WS_BONUS = al256(WS_BCNT + (size_t)NPART * NE * 4);
constexpr size_t WS_WIN = al256(WS_BONUS + (size_t)M * NH * 4);
constexpr size_t WS_WB = al256(WS_WIN + (size_t)PCP * D * 2);
constexpr size_t WS_WO = al256(WS_WB + (size_t)2 * D * RW * 2);
constexpr size_t WS_W2T = al256(WS_WO + (size_t)D * D * 2);
constexpr size_t WS_A2T = al256(WS_W2T + (size_t)2 * RW * 64 * 2);
constexpr size_t WS_G2T = al256(WS_A2T + (size_t)2 * RW * 64 * 2);
constexpr size_t WS_FWT = al256(WS_G2T + (size_t)RW * 128 * 2);
constexpr size_t WS_WGU = al256(WS_FWT + (size_t)(3 * 64 + HW) * 64 * 2);
constexpr size_t WS_WD = al256(WS_WGU + (size_t)NE * 2 * D * D * 2);
constexpr size_t WS_X = al256(WS_WD + (size_t)NE * D * D * 2);
constexpr size_t WS_XMOD = al256(WS_X + (size_t)M * D * 4);
constexpr size_t WS_P = al256(WS_XMOD + (size_t)M * D * 2);
constexpr size_t WS_FILT = al256(WS_P + (size_t)M * PCP * 2);
constexpr size_t WS_MIX = al256(WS_FILT + (size_t)M * HW * 4);
constexpr size_t WS_T = al256(WS_MIX + (size_t)M * D * 4);
constexpr size_t WS_S = al256(WS_T + (size_t)M * D * 2);
constexpr size_t WS_R = WS_S;
constexpr size_t WS_V = al256(WS_R + (size_t)M * RW * 2);
constexpr size_t WS_KA = al256(WS_V + (size_t)M * RW * 2);
constexpr size_t WS_KD = al256(WS_KA + (size_t)M * RW * 2);
constexpr size_t WS_KB = al256(WS_KD + (size_t)2 * M * RW * 2);
constexpr size_t WS_W = al256(WS_KB + (size_t)2 * M * RW * 2);
constexpr size_t WS_PQ = al256(WS_W + (size_t)2 * M * RW * 4);
constexpr size_t WS_LIN = WS_PQ;
static_assert((size_t)M * 384 * 2 <= (size_t)2 * NH * (M / 64) * 2 * 4096 * 4, "LIN fits PQ");
constexpr size_t WS_G = al256(WS_PQ + (size_t)2 * NH * (M / 64) * 2 * 4096 * 4);
constexpr size_t WS_YL = al256(WS_G + (size_t)2 * NH * (M / 64) * 4096 * 2);
constexpr size_t WS_S0 = WS_XMOD;
static_assert((size_t)2 * NH * (M / 64) * 4096 * 2 <= (size_t)M * D * 2, "S0 fits XMOD");
constexpr size_t WS_Z = al256(WS_YL + (size_t)2 * NH * (M / 64) * 4096 * 4);
constexpr size_t WS_X0 = al256(WS_Z + (size_t)CTX * HW * 4);
constexpr size_t WS_CONV = al256(WS_X0 + (size_t)M * HW * 2);
constexpr size_t WS_GATE = al256(WS_CONV + (size_t)CTX * HW * 4);
constexpr size_t WS_RO = al256(WS_GATE + (size_t)M * RW * 2);
constexpr size_t WS_HO = al256(WS_RO + (size_t)M * RW * 2);
constexpr size_t WS_HS = WS_MIX;
constexpr size_t WS_ZT = WS_T;
constexpr size_t WS_CVT = WS_FILT;
static_assert((size_t)HW * (SEQ + 1) * 8 <= (size_t)M * D * 4 && (size_t)HW * M * 4 <= (size_t)M * D * 2, "HS fits MIX, ZT fits T");
constexpr size_t WS_END1 = al256(WS_HO + (size_t)M * HW * 2);
constexpr size_t WS_XG = WS_S;
constexpr size_t WS_ACT = al256(WS_XG + (size_t)SP * D * 2);
constexpr size_t WS_YS = al256(WS_ACT + (size_t)SP * D * 2);
constexpr size_t WS_END2 = al256(WS_YS + (size_t)SP * D * 2);
constexpr size_t WS_END = WS_END1 > WS_END2 ? WS_END1 : WS_END2;
constexpr int CW_TMO = 0, CW_BAR = 4096, CW_CNT = 8192  , CW_CUR = 8192 + 1024  , CW_Q = 8192 + 2048  ;

#ifdef EMU
#define LAS
typedef short bf16x8 __attribute__((vector_size(16)));
typedef float f32x4 __attribute__((vector_size(16)));
typedef unsigned u32x4 __attribute__((vector_size(16)));
#define DYN_LDS(name) unsigned char* name = emu_cur_lds()
#define ASM_WAIT_V(n) do {} while (0)
#define ASM_WAIT_L(n) do {} while (0)
#define ASM_WAIT_VL0() do {} while (0)
#define CFENCE() do {} while (0)
#define WAVE_LDS_FENCE() emu_wave_sync()
#define S_BARRIER() emu_block_sync()
#define SCHED_BARRIER() do {} while (0)
#define SETPRIO(x) do {} while (0)
#define S_SLEEP(n) emu_yield()
#define MFMA16(a, b, c) emu_mfma_16x16x32(a, b, c)
#define MFMA4F(a, b, c) emu_mfma_16x16x4f32(a, b, c)
#define GLDS16(gptr, lptr) emu_glds16((const void*)(gptr), (void*)(lptr))
#define READFIRSTLANE(x) (x)
#define XCC_ID_() (blockIdx.x & 7u)
#define FENCE_RELEASE() do {} while (0)
#define FENCE_ACQUIRE() do {} while (0)
#define DPP_F(v, ctrl) emu_dpp_f(v, ctrl)
#define READLANE_F(v, l) emu_xchg((float)(v), (l))
static inline int vgpr_zero() { return 0; }
static inline unsigned long long vgpr_zero64() { return 0ull; }
static inline int lds_add(volatile int* p, int v) { int o = *p; *p = o + v; return o; }
static inline void lds_addf(float* p, float v) { *p += v; }
static inline unsigned fbits(float f) { unsigned u; memcpy(&u, &f, 4); return u; }
static inline float bitsf(unsigned u) { float f; memcpy(&f, &u, 4); return f; }
#else
#define LAS __attribute__((address_space(3)))
typedef short bf16x8 __attribute__((ext_vector_type(8)));
typedef float f32x4 __attribute__((ext_vector_type(4)));
typedef unsigned u32x4 __attribute__((ext_vector_type(4)));
#define DYN_LDS(name) extern __shared__ __attribute__((aligned(16))) unsigned char name##_raw[]; LAS unsigned char* name = (LAS unsigned char*)name##_raw
#define ASM_WAIT_V(n) asm volatile("s_waitcnt vmcnt(" #n ")" ::: "memory")
#define ASM_WAIT_L(n) asm volatile("s_waitcnt lgkmcnt(" #n ")" ::: "memory")
#define ASM_WAIT_VL0() asm volatile("s_waitcnt vmcnt(0) lgkmcnt(0)" ::: "memory")
#define CFENCE() asm volatile("" ::: "memory")
#define WAVE_LDS_FENCE() asm volatile("s_waitcnt lgkmcnt(0)" ::: "memory")
#define S_BARRIER() __builtin_amdgcn_s_barrier()
#define SCHED_BARRIER() __builtin_amdgcn_sched_barrier(0)
#define SETPRIO(x) __builtin_amdgcn_s_setprio(x)
#define S_SLEEP(n) __builtin_amdgcn_s_sleep(n)
#define MFMA16(a, b, c) __builtin_amdgcn_mfma_f32_16x16x32_bf16(a, b, c, 0, 0, 0)
#define MFMA4F(a, b, c) __builtin_amdgcn_mfma_f32_16x16x4f32(a, b, c, 0, 0, 0)
#define GLDS16(gptr, lptr) __builtin_amdgcn_global_load_lds((const unsigned*)(gptr), (LAS unsigned*)(lptr), 16, 0, 0)
#define READFIRSTLANE(x) __builtin_amdgcn_readfirstlane(x)
#define XCC_ID_() ((unsigned)__builtin_amdgcn_s_getreg((3 << 11) | 20) & 0xFu)
#define FENCE_RELEASE() __builtin_amdgcn_fence(__ATOMIC_RELEASE, "agent")
#define FENCE_ACQUIRE() __builtin_amdgcn_fence(__ATOMIC_ACQUIRE, "agent")
#define DPP_F(v, ctrl) __builtin_bit_cast(float, __builtin_amdgcn_update_dpp(0, __builtin_bit_cast(int, (float)(v)), (ctrl), 0xF, 0xF, true))
#define READLANE_F(v, l) __builtin_bit_cast(float, __builtin_amdgcn_readlane(__builtin_bit_cast(int, (float)(v)), (l)))
__device__ __forceinline__ int vgpr_zero() { int z; asm volatile("v_mov_b32 %0, 0" : "=v"(z)); return z; }
__device__ __forceinline__ unsigned long long vgpr_zero64() { unsigned long long z; asm volatile("v_mov_b64 %0, 0" : "=v"(z)); return z; }
__device__ __forceinline__ void lds_addf(LAS float* p, float v) { (void)__hip_atomic_fetch_add(p, v, __ATOMIC_RELAXED, __HIP_MEMORY_SCOPE_WORKGROUP); }
__device__ __forceinline__ int lds_add(volatile LAS int* p, int v) { return __hip_atomic_fetch_add((LAS int*)p, v, __ATOMIC_RELAXED, __HIP_MEMORY_SCOPE_WORKGROUP); }
__device__ __forceinline__ unsigned fbits(float f) { return __builtin_bit_cast(unsigned, f); }
__device__ __forceinline__ float bitsf(unsigned u) { return __builtin_bit_cast(float, u); }
#endif
typedef unsigned short bf16;
#define RLX_AGENT __ATOMIC_RELAXED, __HIP_MEMORY_SCOPE_AGENT

__device__ __forceinline__ unsigned f2bf(float f) { unsigned u = fbits(f); return (u + 0x7fffu + ((u >> 16) & 1u)) >> 16; }
__device__ __forceinline__ unsigned pk2(float lo, float hi) { return f2bf(lo) | (f2bf(hi) << 16); }
__device__ __forceinline__ float bf2f(bf16 b) { return bitsf(((unsigned)b) << 16); }
__device__ __forceinline__ float bflo(unsigned w) { return bitsf(w << 16); }
__device__ __forceinline__ float bfhi(unsigned w) { return bitsf(w & 0xffff0000u); }
#ifdef EMU
__device__ __forceinline__ float fexp(float x) { return expf(x); }
__device__ __forceinline__ float frcp(float x) { return 1.0f / x; }
#else
__device__ __forceinline__ float fexp(float x) { return __builtin_amdgcn_exp2f(x * 1.4426950408889634f); }
__device__ __forceinline__ float frcp(float x) { return __builtin_amdgcn_rcpf(x); }
#endif
__device__ __forceinline__ float sigmoidf_(float x) { return frcp(1.0f + fexp(-x)); }
__device__ __forceinline__ float row16_sum(float v) {
    v += DPP_F(v, 0xB1);
    v += DPP_F(v, 0x4E);
    v += DPP_F(v, 0x141);
    v += DPP_F(v, 0x140);
    return v;
}
__device__ __forceinline__ float wave_sum(float v) {
    const float r = row16_sum(v);
    return (READLANE_F(r, 0) + READLANE_F(r, 16)) + (READLANE_F(r, 32) + READLANE_F(r, 48));
}
__device__ __forceinline__ void sincos_f(float x, float& s, float& c) {
    const float k = rintf(x * 0.63661977236758134f);
    float r = fmaf(-k, 1.5703125f, x); r = fmaf(-k, 4.837512969970703125e-4f, r); r = fmaf(-k, 7.54978994989188216e-8f, r);
    const float r2 = r * r;
    const float sp = r + r * r2 * (-1.6666654611e-1f + r2 * (8.3321608736e-3f + r2 * (-1.9515295891e-4f)));
    const float cp = 1.0f - 0.5f * r2 + r2 * r2 * (4.166664568298827e-2f + r2 * (-1.388731625493765e-3f + r2 * (2.443315711809948e-5f)));
    const int q = ((int)k) & 3;
    s = (q == 0) ? sp : (q == 1) ? cp : (q == 2) ? -sp : -cp;
    c = (q == 0) ? cp : (q == 1) ? -sp : (q == 2) ? -cp : sp;
}
__device__ __forceinline__ float sin_f(float x) { float s, c; sincos_f(x, s, c); return s; }

template <class T> __device__ __forceinline__ T* as_global(T* p) {
#ifndef EMU
    return (T*)(__attribute__((address_space(1))) T*)(unsigned long long)p;
#else
    return p;
#endif
}
#define XB_TMO      128
#define XB_XCNT(j)  (256  + 64 * (j))
#define XB_XSUB(j)  (1280 + 64 * (j))
#define XB_XGEN(j)  (2304 + 64 * (j))
#define XB_TOP      3328
#define XB_TOPGEN   3392
#define XCD_BAR_WORDS 3456
#define XB_SPIN_CAP (1u << 18)
__device__ __forceinline__ unsigned xb_ld(unsigned* p)              { return __hip_atomic_load(p, __ATOMIC_RELAXED, __HIP_MEMORY_SCOPE_AGENT); }
__device__ __forceinline__ unsigned xb_add(unsigned* p, unsigned v) { return __hip_atomic_fetch_add(p, v, __ATOMIC_RELAXED, __HIP_MEMORY_SCOPE_AGENT); }
#define XB_SPIN(cond, bar) do { unsigned _sp = 0; while (cond) { S_SLEEP(1); \
    if ((++_sp & 255u) == 0u) { if (xb_ld(&(bar)[XB_TMO])) break; if (_sp > XB_SPIN_CAP) { atomicAdd(&(bar)[XB_TMO], 1u); break; } } } } while (0)
struct XcdBarrier { unsigned* bar; unsigned x; volatile LAS unsigned* st; };
__device__ __forceinline__ XcdBarrier xcd_barrier_post(unsigned* bar, volatile LAS unsigned* st) {
    XcdBarrier b; b.bar = nullptr; b.x = XCC_ID_(); b.st = st;
    if (threadIdx.x == 0) { st[2] = (unsigned)(unsigned long long)bar; st[3] = (unsigned)((unsigned long long)bar >> 32); st[4] = b.x; (void)xb_add(&bar[XB_XCNT(b.x)], 1u); }
    return b;
}
__device__ __forceinline__ void xcd_barrier_complete(unsigned* bar, unsigned x, unsigned& nloc, unsigned& nx) {
    const unsigned G = gridDim.x * gridDim.y * gridDim.z;
    unsigned sum, cnt, mine, sp = 0u;
    for (;;) {
        sum = 0u; cnt = 0u; mine = 0u;
#pragma unroll
        for (unsigned j = 0; j < 16; ++j) { const unsigned c = xb_ld(&bar[XB_XCNT(j)]); sum += c; cnt += (c > 0u) ? 1u : 0u; mine = (j == x) ? c : mine; }
        if (sum == G) break;
        S_SLEEP(1);
        if ((++sp & 255u) == 0u) { if (xb_ld(&bar[XB_TMO])) break; if (sp > XB_SPIN_CAP) { atomicAdd(&bar[XB_TMO], 1u); break; } }
    }
    nloc = mine > 0u ? mine : 1u; nx = cnt > 0u ? cnt : 1u;
}
__device__ __forceinline__ void xcd_barrier(const XcdBarrier& b) {
    ASM_WAIT_V(0);
    __syncthreads();
    if (threadIdx.x == 0) {
        unsigned* bar = as_global((unsigned*)(((unsigned long long)b.st[3] << 32) | b.st[2]));
        const unsigned bx = b.st[4];
        ASM_WAIT_VL0();
        unsigned nloc = b.st[0], nx = b.st[1];
        if (nloc == 0u) { xcd_barrier_complete(bar, bx, nloc, nx); b.st[0] = nloc; b.st[1] = nx; }
        const unsigned old = xb_add(&bar[XB_XSUB(bx)], 1u);
        const unsigned gen = old / nloc;
        if (old + 1u == (gen + 1u) * nloc) {
            FENCE_RELEASE();
            ASM_WAIT_V(0);
            const unsigned og = xb_add(&bar[XB_TOP], 1u);
            const unsigned tg = og / nx;
            if (og + 1u == (tg + 1u) * nx) xb_add(&bar[XB_TOPGEN], 1u);
            else XB_SPIN(xb_ld(&bar[XB_TOPGEN]) == tg, bar);
            FENCE_ACQUIRE();
            xb_add(&bar[XB_XGEN(bx)], 1u);
            ASM_WAIT_V(0);
        } else {
            XB_SPIN(xb_ld(&bar[XB_XGEN(bx)]) == gen, bar);
            FENCE_ACQUIRE();
            ASM_WAIT_V(0);
        }
    }
    __syncthreads();
}

namespace pg8 {
constexpr int BM = 256, BK = 64, HALF = 128, HTB = HALF * BK * 2, STAGE_BYTES = 8 * HTB, NXCD = 8, WGM = 8;
__host__ __device__ __forceinline__ int lds_byte(int r, int c) { const int st = (r >> 4) * 2 + (c >> 5), rr = r & 15, cc = c & 31, ob = rr * 64 + cc * 2; return st * 1024 + (ob ^ (((ob >> 9) & 1) << 5)); }
__host__ __device__ __forceinline__ void stage_rc(int b, int& R, int& C) { const int st = b / 1024, sb = b % 1024, swz = sb ^ (((sb >> 9) & 1) << 5); R = (st >> 1) * 16 + swz / 64; C = (st & 1) * 32 + (swz % 64) / 2; }
__host__ __device__ __forceinline__ int perm32(int rho) { const int n = rho >> 4, i = rho & 15; return 8 * (i >> 2) + 4 * n + (i & 3); }
struct Unit { int pm, pn; };
struct Gemm { const bf16* A; const bf16* Bt; int K; };
struct StaticOrder {
    int nM, nN, nwg, G, c;
    __host__ __device__ void init(int M_, int N_, int G_, int c_) { nM = M_ / BM; nN = N_ / BM; nwg = nM * nN; G = G_; c = c_; }
    __host__ __device__ bool next(int i, Unit& u) const {
        const long L = (long)i * G + c; if (L >= nwg) return false;
        int wgid = (int)L; { const int q = nwg / NXCD, r = nwg % NXCD, xcd = wgid % NXCD, off = wgid / NXCD; wgid = (xcd < r ? xcd * (q + 1) : r * (q + 1) + (xcd - r) * q) + off; }
        const int nig = WGM * nN, gid = wgid / nig, fm = gid * WGM, gsz = (nM - fm) < WGM ? (nM - fm) : WGM;
        u.pm = fm + ((wgid % nig) % gsz); u.pn = (wgid % nig) / gsz; return true;
    }
};
struct MoeOrder {
    const volatile LAS int* tab; int NT, G, c;
    __device__ __forceinline__ bool next(int i, Unit& u) const {
        const long L = (long)i * G + c; if (L >= tab[16]) return false;
        int e = 0; while (L >= tab[e + 1]) ++e;
        const int loc = (int)L - tab[e], tc = tab[64 + e];
        u.pm = tab[32 + e] + loc % tc; u.pn = e * NT + loc / tc; return true;
    }
};
__device__ __forceinline__ unsigned cvt_pk_bf16(float lo, float hi) {
#ifdef EMU
    return pk2(lo, hi);
#else
    unsigned r; asm volatile("v_cvt_pk_bf16_f32 %0, %1, %2" : "=v"(r) : "v"(lo), "v"(hi)); return r;
#endif
}

struct EpiBf16 {
    static constexpr bool PERM = true;
    bf16* O; int ldc;
    __device__ __forceinline__ void operator()(const f32x4 (&acc)[2][2][4][2], const Unit& u, int wr, int wc, int fr, int fq) const {
        const int row0 = u.pm * BM + wr * 64 + fr, col0 = u.pn * BM + wc * 32 + 8 * fq;
#pragma unroll
        for (int ai = 0; ai < 2; ++ai)
#pragma unroll
            for (int m = 0; m < 4; ++m) { bf16* rowp = O + (size_t)(row0 + ai * HALF + m * 16) * ldc + col0;
#pragma unroll
                for (int bj = 0; bj < 2; ++bj) { const f32x4 v0 = acc[ai][bj][m][0], v1 = acc[ai][bj][m][1];
                    u32x4 w; w[0] = cvt_pk_bf16(v0[0], v0[1]); w[1] = cvt_pk_bf16(v0[2], v0[3]); w[2] = cvt_pk_bf16(v1[0], v1[1]); w[3] = cvt_pk_bf16(v1[2], v1[3]);
                    *(u32x4*)(rowp + bj * HALF) = w; } }
    }
};
struct EpiF32 {
    static constexpr bool PERM = true;
    float* C; int ldc;
    __device__ __forceinline__ void operator()(const f32x4 (&acc)[2][2][4][2], const Unit& u, int wr, int wc, int fr, int fq) const {
        const int row0 = u.pm * BM + wr * 64 + fr, col0 = u.pn * BM + wc * 32 + 8 * fq;
#pragma unroll
        for (int ai = 0; ai < 2; ++ai)
#pragma unroll
            for (int m = 0; m < 4; ++m) { float* rowp = C + (size_t)(row0 + ai * HALF + m * 16) * ldc + col0;
#pragma unroll
                for (int bj = 0; bj < 2; ++bj)
#pragma unroll
                    for (int n = 0; n < 2; ++n) *(f32x4*)(rowp + bj * HALF + n * 4) = acc[ai][bj][m][n]; }
    }
};
struct EpiGate {
    static constexpr bool PERM = true;
    bf16* T; int ldc; const bf16* Pg; int ldp; int gcol0; bool ADD;
    __device__ __forceinline__ void operator()(const f32x4 (&acc)[2][2][4][2], const Unit& u, int wr, int wc, int fr, int fq) const {
        const int row0 = u.pm * BM + wr * 64 + fr, col0 = u.pn * BM + wc * 32 + 8 * fq;
#pragma unroll
        for (int ai = 0; ai < 2; ++ai)
#pragma unroll
            for (int m = 0; m < 4; ++m) { const size_t row = (size_t)(row0 + ai * HALF + m * 16);
#pragma unroll
                for (int bj = 0; bj < 2; ++bj) { const f32x4 v0 = acc[ai][bj][m][0], v1 = acc[ai][bj][m][1];
                    const u32x4 g = *(const u32x4*)(Pg + row * ldp + gcol0 + col0 + bj * HALF);
                    u32x4 t = {0u, 0u, 0u, 0u}; if (ADD) t = *(const u32x4*)(T + row * ldc + col0 + bj * HALF);
                    float o[8];
#pragma unroll
                    for (int j = 0; j < 4; ++j) { const float a0 = j < 2 ? v0[2 * j] : v1[2 * j - 4], a1 = j < 2 ? v0[2 * j + 1] : v1[2 * j - 3];
                        o[2 * j] = bflo(t[j]) + sigmoidf_(bflo(g[j])) * a0; o[2 * j + 1] = bfhi(t[j]) + sigmoidf_(bfhi(g[j])) * a1; }
                    u32x4 w; w[0] = cvt_pk_bf16(o[0], o[1]); w[1] = cvt_pk_bf16(o[2], o[3]); w[2] = cvt_pk_bf16(o[4], o[5]); w[3] = cvt_pk_bf16(o[6], o[7]);
                    *(u32x4*)(T + row * ldc + col0 + bj * HALF) = w; } }
    }
};
struct EpiSwiglu {
    static constexpr bool PERM = true;
    bf16* O; int ldc; int NT;
    __device__ __forceinline__ void operator()(const f32x4 (&acc)[2][2][4][2], const Unit& u, int wr, int wc, int fr, int fq) const {
        const int row0 = u.pm * BM + wr * 64 + fr, col0 = (u.pn % NT) * HALF + wc * 32 + 8 * fq;
#pragma unroll
        for (int ai = 0; ai < 2; ++ai)
#pragma unroll
            for (int m = 0; m < 4; ++m) { bf16* rowp = O + (size_t)(row0 + ai * HALF + m * 16) * ldc + col0;
                float o[8];
#pragma unroll
                for (int j = 0; j < 8; ++j) { const float g = acc[ai][0][m][j >> 2][j & 3], uu = acc[ai][1][m][j >> 2][j & 3]; o[j] = g / (1.0f + expf(-g)) * uu; }
                u32x4 w; w[0] = cvt_pk_bf16(o[0], o[1]); w[1] = cvt_pk_bf16(o[2], o[3]); w[2] = cvt_pk_bf16(o[4], o[5]); w[3] = cvt_pk_bf16(o[6], o[7]);
                *(u32x4*)rowp = w; }
    }
};
struct EpiMoeDown {
    static constexpr bool PERM = true;
    bf16* O; int ldc; int NT;
    __device__ __forceinline__ void operator()(const f32x4 (&acc)[2][2][4][2], const Unit& u, int wr, int wc, int fr, int fq) const {
        const int row0 = u.pm * BM + wr * 64 + fr, col0 = (u.pn % NT) * BM + wc * 32 + 8 * fq;
#pragma unroll
        for (int ai = 0; ai < 2; ++ai)
#pragma unroll
            for (int m = 0; m < 4; ++m) { bf16* rowp = O + (size_t)(row0 + ai * HALF + m * 16) * ldc + col0;
#pragma unroll
                for (int bj = 0; bj < 2; ++bj) { const f32x4 v0 = acc[ai][bj][m][0], v1 = acc[ai][bj][m][1];
                    u32x4 w; w[0] = cvt_pk_bf16(v0[0], v0[1]); w[1] = cvt_pk_bf16(v0[2], v0[3]); w[2] = cvt_pk_bf16(v1[0], v1[1]); w[3] = cvt_pk_bf16(v1[2], v1[3]);
                    *(u32x4*)(rowp + bj * HALF) = w; } }
    }
};

struct EpiBf16OrF32 { static constexpr bool PERM = true; bf16* O; float* C; int ldc; bool f32;
    __device__ __forceinline__ void operator()(const f32x4 (&acc)[2][2][4][2], const Unit& u, int wr, int wc, int fr, int fq) const {
        if (f32) { EpiF32 E{C, ldc}; E(acc, u, wr, wc, fr, fq); } else { EpiBf16 E{O, ldc}; E(acc, u, wr, wc, fr, fq); } } };
struct EpiMoe { static constexpr bool PERM = true; bf16* O; int ldc; int NT; bool swiglu;
    __device__ __forceinline__ void operator()(const f32x4 (&acc)[2][2][4][2], const Unit& u, int wr, int wc, int fr, int fq) const {
        if (swiglu) { EpiSwiglu E{O, ldc, NT}; E(acc, u, wr, wc, fr, fq); } else { EpiMoeDown E{O, ldc, NT}; E(acc, u, wr, wc, fr, fq); } } };
template <class Epi, class Sched>
__device__ __forceinline__ void gemm_phase(LAS unsigned char* lds, const Gemm g, const Sched& S, const Epi& E) {
    const int tid = threadIdx.x + vgpr_zero();
    const int wid = READFIRSTLANE(tid >> 6), lane = tid & 63, wr = wid >> 2, wc = wid & 3, fr = lane & 15, fq = lane >> 4;
    const int K = g.K, nt = K / BK;
    unsigned long long voffA[2], voffB[2]; const unsigned long long zhi = vgpr_zero64();
#pragma unroll
    for (int i = 0; i < 2; ++i) { int R, C; stage_rc(tid * 16 + i * 8192, R, C); const int Rb = Epi::PERM ? ((R & ~31) + perm32(R & 31)) : R;
        voffA[i] = zhi + (unsigned long long)(long long)((R * K + C) * 2); voffB[i] = zhi + (unsigned long long)(long long)((Rb * K + C) * 2); }
    const size_t kstep = (size_t)(BK * 2);
    const size_t hstep = (size_t)HALF * K * 2;
    const size_t tstep = 2 * hstep;
    const unsigned ldsw = (unsigned)wid * 1024u;
    const int aoff = lds_byte(wr * 64 + fr, fq * 8), boff = lds_byte(wc * 32 + fr, fq * 8);
#define PG8_SA(b, h) (((b) * 2 + (h)) * HTB)
#define PG8_SB(b, h) ((4 + (b) * 2 + (h)) * HTB)
#define PG8_STAGE(bufoff, gbase, voff) do { _Pragma("unroll") for (int _i = 0; _i < 2; ++_i) \
        GLDS16((const char*)(gbase) + (voff)[_i], lds + (bufoff) + ldsw + _i * 8192); } while (0)
#define PG8_LDA(dst, b, h) do { _Pragma("unroll") for (int m = 0; m < 4; ++m) _Pragma("unroll") for (int k = 0; k < 2; ++k) dst[m][k] = *(const LAS bf16x8*)(lds + PG8_SA(b, h) + aoff + m * 2048 + k * 1024); } while (0)
#define PG8_LDB(dst, b, h) do { _Pragma("unroll") for (int n = 0; n < 2; ++n) _Pragma("unroll") for (int k = 0; k < 2; ++k) dst[n][k] = *(const LAS bf16x8*)(lds + PG8_SB(b, h) + boff + n * 2048 + k * 1024); } while (0)
#define PG8_MMA(ai, bj, At, Bt) do { SETPRIO(1); _Pragma("unroll") for (int m = 0; m < 4; ++m) _Pragma("unroll") for (int n = 0; n < 2; ++n) _Pragma("unroll") for (int k = 0; k < 2; ++k) \
        acc[ai][bj][m][n] = MFMA16(Bt[n][k], At[m][k], acc[ai][bj][m][n]); SETPRIO(0); } while (0)
#define PG8_BAR S_BARRIER()
    Unit cur, nxt; int ui = 0;
    if (!S.next(0, cur)) return;
    f32x4 acc[2][2][4][2];
#pragma unroll
    for (int a = 0; a < 2; ++a)
#pragma unroll
        for (int b = 0; b < 2; ++b)
#pragma unroll
            for (int m = 0; m < 4; ++m)
#pragma unroll
                for (int n = 0; n < 2; ++n) acc[a][b][m][n] = (f32x4){0.f, 0.f, 0.f, 0.f};
    bf16x8 At[4][2], B0[2][2], B1[2][2];
    const char* cA = (const char*)g.A + (size_t)cur.pm * tstep; const char* cB = (const char*)g.Bt + (size_t)cur.pn * tstep;
    PG8_STAGE(PG8_SB(0, 0), cB, voffB); PG8_STAGE(PG8_SA(0, 0), cA, voffA); PG8_STAGE(PG8_SB(0, 1), cB + hstep, voffB); PG8_STAGE(PG8_SA(0, 1), cA + hstep, voffA);
    if (wr == 1) PG8_BAR;
    ASM_WAIT_V(4); PG8_BAR;
    PG8_STAGE(PG8_SB(1, 0), cB + kstep, voffB); PG8_STAGE(PG8_SA(1, 0), cA + kstep, voffA); PG8_STAGE(PG8_SB(1, 1), cB + hstep + kstep, voffB);
    ASM_WAIT_V(6); PG8_BAR;
    for (;;) {
        const bool has_next = S.next(ui + 1, nxt);
        const char* nA = has_next ? (const char*)g.A + (size_t)nxt.pm * tstep : cA; const char* nB = has_next ? (const char*)g.Bt + (size_t)nxt.pn * tstep : cB;
        for (int t = 0; t < nt; t += 2) {
            const bool last = (t == nt - 2);
            const char* a1 = cA + (size_t)(t + 1) * kstep;
            const char* a2 = last ? nA : cA + (size_t)(t + 2) * kstep; const char* b2 = last ? nB : cB + (size_t)(t + 2) * kstep;
            const char* a3 = a2 + kstep; const char* b3 = b2 + kstep;
            PG8_LDB(B0, 0, 0); SCHED_BARRIER(); PG8_LDA(At, 0, 0); PG8_STAGE(PG8_SA(1, 1), a1 + hstep, voffA);
            ASM_WAIT_L(8); PG8_BAR; ASM_WAIT_L(0); PG8_MMA(0, 0, At, B0); PG8_BAR; SCHED_BARRIER();
            PG8_LDB(B1, 0, 1); PG8_STAGE(PG8_SB(0, 0), b2, voffB);
            PG8_BAR; ASM_WAIT_L(0); PG8_MMA(0, 1, At, B1); PG8_BAR;
            PG8_LDA(At, 0, 1); PG8_STAGE(PG8_SA(0, 0), a2, voffA);
            PG8_BAR; ASM_WAIT_L(0); PG8_MMA(1, 0, At, B0); PG8_BAR; SCHED_BARRIER();
            PG8_STAGE(PG8_SB(0, 1), b2 + hstep, voffB);
            ASM_WAIT_V(6); PG8_BAR; PG8_MMA(1, 1, At, B1); PG8_BAR;
            PG8_LDB(B0, 1, 0); SCHED_BARRIER(); PG8_LDA(At, 1, 0); PG8_STAGE(PG8_SA(0, 1), a2 + hstep, voffA);
            ASM_WAIT_L(8); PG8_BAR; ASM_WAIT_L(0); PG8_MMA(0, 0, At, B0); PG8_BAR; SCHED_BARRIER();
            PG8_LDB(B1, 1, 1); PG8_STAGE(PG8_SB(1, 0), b3, voffB);
            PG8_BAR; ASM_WAIT_L(0); PG8_MMA(0, 1, At, B1); PG8_BAR;
            PG8_LDA(At, 1, 1); PG8_STAGE(PG8_SA(1, 0), a3, voffA);
            PG8_BAR; ASM_WAIT_L(0); PG8_MMA(1, 0, At, B0); PG8_BAR; SCHED_BARRIER();
            PG8_STAGE(PG8_SB(1, 1), b3 + hstep, voffB);
            ASM_WAIT_V(6); PG8_BAR; PG8_MMA(1, 1, At, B1); PG8_BAR;
        }
        E(acc, cur, wr, wc, fr, fq);
        if (!has_next) break;
#pragma unroll
        for (int a = 0; a < 2; ++a)
#pragma unroll
            for (int b = 0; b < 2; ++b)
#pragma unroll
                for (int m = 0; m < 4; ++m)
#pragma unroll
                    for (int n = 0; n < 2; ++n) acc[a][b][m][n] = (f32x4){0.f, 0.f, 0.f, 0.f};
        cur = nxt; cA = nA; cB = nB; ++ui;
    }
    ASM_WAIT_V(0);
    if (wr == 0) PG8_BAR;
    PG8_BAR;
#undef PG8_SA
#undef PG8_SB
#undef PG8_STAGE
#undef PG8_LDA
#undef PG8_LDB
#undef PG8_MMA
#undef PG8_BAR
}
}

struct Args { const float* in[N_IN]; float* out; unsigned char* ws; int ph_lo, ph_hi; };
constexpr int NWAVES = 8, NTHR = 512;
constexpr int LDS_STAGE = 131072, LDS_MISC = LDS_STAGE, LDS_BYTES = 147456;

constexpr int PT_OUT = N_IN, PT_WS = N_IN + 1, PT_WORD0 = 128;

struct Ctx {
    LAS unsigned char* lds; int tid, lane, wave, G, bid;
    __device__ __forceinline__ unsigned long long ptr(int i) const { const volatile LAS unsigned* t = (const volatile LAS unsigned*)(lds + LDS_MISC) + PT_WORD0 + 2 * i;
        const unsigned lo = (unsigned)READFIRSTLANE((int)t[0]), hi = (unsigned)READFIRSTLANE((int)t[1]); return ((unsigned long long)hi << 32) | lo; }
    __device__ __forceinline__ unsigned long long ptrv(int i) const { const volatile LAS unsigned* t = (const volatile LAS unsigned*)(lds + LDS_MISC) + PT_WORD0 + 2 * i; return ((unsigned long long)t[1] << 32) | t[0]; }
    __device__ __forceinline__ const float* inv(int i) const { return as_global((const float*)ptrv(i)); }
    template <class T> __device__ __forceinline__ T* wsv(size_t off) const { return as_global((T*)((unsigned char*)ptrv(PT_WS) + off)); }
    __device__ __forceinline__ const float* in(int i) const { return as_global((const float*)ptr(i)); }
    __device__ __forceinline__ float* out() const { return as_global((float*)ptr(PT_OUT)); }
    template <class T> __device__ __forceinline__ T* ws(size_t off) const { return as_global((T*)((unsigned char*)ptr(PT_WS) + off)); }
    __device__ __forceinline__ unsigned* ctl() const { return as_global((unsigned*)ptr(PT_WS)); }
};

__device__ __forceinline__ void transpose_item(const float* W, int ldw, int k0, int n0, int nvalid, bf16* outp, int ldo, LAS float* scr, int lane) {
#pragma unroll
    for (int i = 0; i < 32; ++i) { const int kk = 2 * i + (lane >> 5), n = n0 + (lane & 31); scr[kk * 33 + (lane & 31)] = (n < nvalid) ? W[(size_t)(k0 + kk) * ldw + n] : 0.f; }
    WAVE_LDS_FENCE(); CFENCE();
    const int c = lane & 7;
#pragma unroll
    for (int j = 0; j < 4; ++j) { const int n = (lane >> 3) + 8 * j; const LAS float* s = scr + (8 * c) * 33 + n;
        u32x4 o; o[0] = pk2(s[0 * 33], s[1 * 33]); o[1] = pk2(s[2 * 33], s[3 * 33]); o[2] = pk2(s[4 * 33], s[5 * 33]); o[3] = pk2(s[6 * 33], s[7 * 33]);
        *(u32x4*)(outp + (size_t)n * ldo + k0 + 8 * c) = o; }
    WAVE_LDS_FENCE(); CFENCE();
}
__device__ __forceinline__ void filter_item(const Ctx& X, int l, int n, int pos0, float* out, LAS bf16* za, LAS bf16* zb, LAS float* asum  ) {
    const int lane = X.lane, kof = 8 * (lane >> 4);
    const bf16* FWT = X.wsv<bf16>(WS_FWT);
    if (lane < 64) { const int i = lane;
#pragma unroll 4
        for (int p = 0; p < 16; ++p) { const int pos = pos0 + p; float v = 0.f;
            if (i == 0) v = (float)pos / (float)(n - 1 > 1 ? n - 1 : 1);
            else if (i < 33) { const int bb = (i - 1) & 15; const double band = 1e-4 + (double)bb * ((15.0 - 1e-4) / 15.0);
                double rev = (double)pos * band / (double)n; rev -= floor(rev); if (rev > 0.5) rev -= 1.0;
                float sn, cs; sincos_f((float)(rev * 6.283185307179586476925), sn, cs); v = i <= 16 ? cs : -sn; }
            za[p * LP + i] = (bf16)f2bf(v); } }
    WAVE_LDS_FENCE(); CFENCE();
    LAS bf16* src = za; LAS bf16* dst = zb;
#pragma unroll 1
    for (int layer = 0; layer < 3; ++layer) { const bf16* WT = FWT + (size_t)layer * 64 * 64; const float* bias = X.inv(layer == 0 ? I_FB1 : layer == 1 ? I_FB2 : I_FB3) + l * 64;
        const bf16x8 a0 = *(const LAS bf16x8*)(src + (lane & 15) * LP + kof), a1 = *(const LAS bf16x8*)(src + (lane & 15) * LP + kof + 32);
#pragma unroll
        for (int tj = 0; tj < 4; ++tj) { const int u = 16 * tj + (lane & 15); f32x4 acc = {0.f, 0.f, 0.f, 0.f};
            acc = MFMA16(a0, *(const bf16x8*)(WT + (size_t)u * 64 + kof), acc); acc = MFMA16(a1, *(const bf16x8*)(WT + (size_t)u * 64 + kof + 32), acc);
            const float fr = X.inv(I_FREQ)[l * 64 + u], bu = bias[u];
#pragma unroll
            for (int r = 0; r < 4; ++r) dst[(4 * (lane >> 4) + r) * LP + u] = (bf16)f2bf(sin_f(fr * (acc[r] + bu))); }
        WAVE_LDS_FENCE(); CFENCE();
        LAS bf16* t_ = src; src = dst; dst = t_; }
    const bf16* WO = FWT + (size_t)3 * 64 * 64;
    const bf16x8 a0 = *(const LAS bf16x8*)(src + (lane & 15) * LP + kof), a1 = *(const LAS bf16x8*)(src + (lane & 15) * LP + kof + 32);
    const float dmin = -3.0701134573253944f, dmax = -15.350567286626972f;
    float dist[4];
#pragma unroll
    for (int r = 0; r < 4; ++r) { const int dd = pos0 + 4 * (lane >> 4) + r - n / 2; dist[r] = (float)(dd < 0 ? -dd : dd) * (2.0f / (float)n); }
#pragma unroll 1
    for (int tg = 0; tg < HW / 64; ++tg) {
#pragma unroll
        for (int tq = 0; tq < 4; ++tq) { const int c = 64 * tg + 16 * tq + (lane & 15); f32x4 acc = {0.f, 0.f, 0.f, 0.f};
            acc = MFMA16(a0, *(const bf16x8*)(WO + (size_t)c * 64 + kof), acc); acc = MFMA16(a1, *(const bf16x8*)(WO + (size_t)c * 64 + kof + 32), acc);
            const float delta = fabsf(dmin + (float)c * ((dmax - dmin) / (float)(HW - 1))); f32x4 v; float as = 0.f;
#pragma unroll
            for (int r = 0; r < 4; ++r) { v[r] = acc[r] * fexp(-dist[r] * delta); as += fabsf(v[r]); }
            *(f32x4*)(out + (size_t)c * n + pos0 + 4 * (lane >> 4)) = v; lds_addf(asum + c, as); } }
    WAVE_LDS_FENCE(); CFENCE();
}
__device__ __forceinline__ void phase_transposes(const Ctx& X, int l, int part) {
    LAS float* scr = (LAS float*)(X.lds + X.wave * 16384);
    const bool shifted = part == 1 && X.G > N_SEQ_UNITS; const int myb = shifted ? X.bid - N_SEQ_UNITS : X.bid, nb_ = shifted ? X.G - N_SEQ_UNITS : X.G;
    if (myb < 0) return;
    const int gw = myb * NWAVES + X.wave, NGW = nb_ * NWAVES, lane = X.lane;
    constexpr int KB_D = D / 64, I_WIN_ = KB_D * (PCP / 32), I_WB_ = 2 * (RW / 64) * (D / 32), I_WO_ = KB_D * (D / 32), I_WGU_ = NE * 2 * KB_D * (D / 32), I_WD_ = NE * KB_D * (D / 32);
    constexpr int I_LORA_ = 6 * (RW / 32); constexpr int N0 = I_WIN_ + I_WB_ + I_WO_, NITEMS = N0 + I_WGU_ + I_WD_;
    if (part == 0) for (int it = gw; it < I_LORA_; it += NGW) { const int which = it / (RW / 32), nb = it % (RW / 32);
        const float* W; int k0 = 0, ldo = 64; bf16* outp;
        if (which < 2) { W = X.in(I_W2) + ((size_t)l * 2 + which) * 64 * RW; outp = X.ws<bf16>(WS_W2T) + (size_t)which * RW * 64 + (size_t)(32 * nb) * 64; }
        else if (which < 4) { W = X.in(I_A2) + ((size_t)l * 2 + (which - 2)) * 64 * RW; outp = X.ws<bf16>(WS_A2T) + (size_t)(which - 2) * RW * 64 + (size_t)(32 * nb) * 64; }
        else { W = X.in(I_G2) + (size_t)l * 128 * RW; k0 = 64 * (which - 4); ldo = 128; outp = X.ws<bf16>(WS_G2T) + (size_t)(32 * nb) * 128; }
        transpose_item(W, RW, k0, 32 * nb, RW, outp, ldo, scr, lane); }
    const int it_end = part ? NITEMS : N0; int it = (part ? N0 : 0) + gw;
    const float* W; int ldw, k0, n0, nvalid, ldo; bf16* outp; float v[32];
#define TR_PARAMS(it_) do { int r = (it_); \
        if (r < I_WIN_) { const int nb = r % (PCP / 32), kb = r / (PCP / 32); W = X.in(I_WIN) + (size_t)l * D * PC; ldw = PC; k0 = 64 * kb; n0 = 32 * nb; nvalid = PC; outp = X.ws<bf16>(WS_WIN) + (size_t)n0 * D; ldo = D; } \
        else if ((r -= I_WIN_) < I_WB_) { const int s_ = r / ((RW / 64) * (D / 32)), q = r % ((RW / 64) * (D / 32)), nb = q % (D / 32), kb = q / (D / 32); \
            W = X.in(I_WBR) + ((size_t)l * 2 + s_) * RW * D; ldw = D; k0 = 64 * kb; n0 = 32 * nb; nvalid = D; outp = X.ws<bf16>(WS_WB) + (size_t)s_ * D * RW + (size_t)n0 * RW; ldo = RW; } \
        else if ((r -= I_WB_) < I_WO_) { const int nb = r % (D / 32), kb = r / (D / 32); W = X.in(I_WOUT) + (size_t)l * D * D; ldw = D; k0 = 64 * kb; n0 = 32 * nb; nvalid = D; outp = X.ws<bf16>(WS_WO) + (size_t)n0 * D; ldo = D; } \
        else if ((r -= I_WO_) < I_WGU_) { const int per = KB_D * (D / 32), es = r / per, q = r % per, e = es >> 1, src = es & 1, nb = q % (D / 32), kb = q / (D / 32); n0 = 32 * nb; \
            W = (src ? X.in(I_WU) : X.in(I_WG)) + ((size_t)l * NE + e) * D * D; ldw = D; k0 = 64 * kb; nvalid = D; const int orow = e * 2 * D + (n0 / 128) * 256 + src * 128 + (n0 % 128); \
            outp = X.ws<bf16>(WS_WGU) + (size_t)orow * D; ldo = D; } \
        else { r -= I_WGU_; const int per = KB_D * (D / 32), e = r / per, q = r % per, nb = q % (D / 32), kb = q / (D / 32); \
            W = X.in(I_WD) + ((size_t)l * NE + e) * D * D; ldw = D; k0 = 64 * kb; n0 = 32 * nb; nvalid = D; outp = X.ws<bf16>(WS_WD) + (size_t)(e * D + n0) * D; ldo = D; } } while (0)
#define TR_LOAD() do { const int n = n0 + (lane & 31); const float* wp = W + (size_t)(k0 + (lane >> 5)) * ldw + n; _Pragma("unroll") for (int i = 0; i < 32; ++i) v[i] = (n < nvalid) ? wp[(size_t)(2 * i) * ldw] : 0.f; } while (0)
    if (it < it_end) { TR_PARAMS(it); TR_LOAD(); }
    while (it < it_end) {
#pragma unroll
        for (int i = 0; i < 32; ++i) scr[(2 * i + (lane >> 5)) * 33 + (lane & 31)] = v[i];
        WAVE_LDS_FENCE(); CFENCE();
        bf16* const cout_ = outp; const int ck0 = k0, cldo = ldo;
        it += NGW;
        if (it < it_end) { TR_PARAMS(it); TR_LOAD(); }
        const int c = lane & 7;
#pragma unroll
        for (int j = 0; j < 4; ++j) { const int n = (lane >> 3) + 8 * j; const LAS float* s_ = scr + (8 * c) * 33 + n;
            u32x4 o; o[0] = pk2(s_[0 * 33], s_[1 * 33]); o[1] = pk2(s_[2 * 33], s_[3 * 33]); o[2] = pk2(s_[4 * 33], s_[5 * 33]); o[3] = pk2(s_[6 * 33], s_[7 * 33]);
            *(u32x4*)(cout_ + (size_t)n * cldo + ck0 + 8 * c) = o; }
        WAVE_LDS_FENCE(); CFENCE();
    }
#undef TR_PARAMS
#undef TR_LOAD
}
__device__ __forceinline__ void phase_filter_weights(const Ctx& X, int l) {
    bf16* FWT = X.ws<bf16>(WS_FWT);
    for (int idx = X.bid * NTHR + X.tid; idx < (3 * 64 + HW) * 64; idx += X.G * NTHR) { const int o = idx >> 6, k = idx & 63; float v;
        if (o < 64) v = k < 33 ? X.in(I_FW1)[(size_t)l * 33 * 64 + k * 64 + o] : 0.f;
        else if (o < 128) v = X.in(I_FW2)[(size_t)l * 64 * 64 + k * 64 + (o - 64)];
        else if (o < 192) v = X.in(I_FW3)[(size_t)l * 64 * 64 + k * 64 + (o - 128)];
        else v = X.in(I_FWO)[(size_t)l * 64 * HW + (size_t)k * HW + (o - 192)];
        FWT[idx] = (bf16)f2bf(v); }
}
constexpr int FPART_OFF = 65536;
static_assert(FPART_OFF + 2 * HW * 4 <= LDS_STAGE && 2 * 16 * LP * 2 <= 8192, "filter LDS map");
__device__ __forceinline__ void phase_filters_begin(const Ctx& X) {
    LAS float* part = (LAS float*)(X.lds + FPART_OFF);
    for (int i = X.tid; i < 2 * HW; i += NTHR) part[i] = 0.f;
    __syncthreads();
}
__device__ __forceinline__ void phase_filters_item(const Ctx& X, int l_, int which_, int it_) {
    const int vz = vgpr_zero(), l = l_ + vz, which = which_ + vz, it = it_ + vz;
    LAS bf16* za = (LAS bf16*)(X.lds + X.wave * 8192); LAS bf16* zb = za + 16 * LP;
    const int n = which ? CTX : SEQ; float* out = X.wsv<float>(WS_FILT) + (which ? (size_t)HW * SEQ : 0);
    filter_item(X, l, n, 16 * it, out, za, zb, (LAS float*)(X.lds + FPART_OFF) + which * HW);
}
__device__ __forceinline__ void phase_filters_end(const Ctx& X) {
    const LAS float* part = (const LAS float*)(X.lds + FPART_OFF);
    __syncthreads();
    for (int i = X.tid; i < 2 * HW; i += NTHR) X.ws<float>(WS_FPART)[((size_t)(i / HW) * NPART + X.bid) * HW + (i % HW)] = part[i];
    __syncthreads();
}
__device__ __forceinline__ void phase_mod(const Ctx& X) {
    const int lane = X.lane;
    LAS float* red = (LAS float*)X.lds;
    constexpr int NIT = DEPTH * (6 * D / 64);
    for (int it = X.bid; it < NIT; it += X.G) {
        const int ll = it / (6 * D / 64), n0 = (it % (6 * D / 64)) * 64;
        const float* W = X.in(I_WMOD) + (size_t)ll * D * 6 * D; const float* cv = X.in(I_C); const float* cc = X.in(I_CCTX);
        float s0 = 0.f, s1 = 0.f;
#pragma unroll 8
        for (int k = X.wave * (D / 8); k < (X.wave + 1) * (D / 8); ++k) { const float wv = W[(size_t)k * 6 * D + n0 + lane]; const float c0 = cv[k], c1 = cc[k];
            s0 += c0 * sigmoidf_(c0) * wv; s1 += c1 * sigmoidf_(c1) * wv; }
        red[(X.wave * 64 + lane) * 2] = s0; red[(X.wave * 64 + lane) * 2 + 1] = s1;
        __syncthreads();
        if (X.wave == 0) { float t0 = 0.f, t1 = 0.f;
#pragma unroll
            for (int w = 0; w < NWAVES; ++w) { t0 += red[(w * 64 + lane) * 2]; t1 += red[(w * 64 + lane) * 2 + 1]; }
            const float bm = X.in(I_BMOD)[(size_t)ll * 6 * D + n0 + lane];
            float* MOD = X.ws<float>(WS_MOD);
            MOD[((size_t)ll * 2 + 0) * 6 * D + n0 + lane] = t0 + bm; MOD[((size_t)ll * 2 + 1) * 6 * D + n0 + lane] = t1 + bm; }
        __syncthreads();
    }
}
__device__ __forceinline__ const float* modp(const Ctx& X, int l, int t, int j) { return X.ws<float>(WS_MOD) + ((size_t)l * 2 + (t < CTX ? 1 : 0)) * 6 * D + (size_t)j * D; }

__device__ __forceinline__ void phase_x0(const Ctx& X) {
    const int gw = X.bid * NWAVES + X.wave, NGW = X.G * NWAVES, lane = X.lane;
    for (int t = gw; t < M; t += NGW) {
        const float* src = t < CTX ? X.in(I_CTX) + (size_t)t * D : X.in(I_X) + (size_t)(t - CTX) * D;
        const float* sh = modp(X, 0, t, 0); const float* sc = modp(X, 0, t, 1);
        float* xr = X.ws<float>(WS_X) + (size_t)t * D; bf16* xm = X.ws<bf16>(WS_XMOD) + (size_t)t * D;
#pragma unroll
        for (int j = 0; j < D / 256; ++j) { const int d = 4 * lane + 256 * j; const f32x4 v = *(const f32x4*)(src + d), a = *(const f32x4*)(sh + d), b = *(const f32x4*)(sc + d);
            *(f32x4*)(xr + d) = v;
            unsigned w0 = pk2(v[0] * (1.f + b[0]) + a[0], v[1] * (1.f + b[1]) + a[1]), w1 = pk2(v[2] * (1.f + b[2]) + a[2], v[3] * (1.f + b[3]) + a[3]);
            *(unsigned long long*)(xm + d) = (unsigned long long)w0 | ((unsigned long long)w1 << 32); }
    }
}

__device__ __forceinline__ int shift_row(int t, int col, bool& valid) {
    const bool isctx = t < CTX;
    const int i = t - CTX, gx = i & (GRID_W - 1), gy = i / GRID_W, q = col / QTR;
    const int offl = (q == 0) ? -1 : (q == 1) ? 1 : (q == 2) ? -GRID_W : GRID_W;
    const bool vl = (q == 0) ? (gx > 0) : (q == 1) ? (gx < GRID_W - 1) : (q == 2) ? (gy > 0) : (gy < GRID_H - 1);
    const bool first = col < HALFC;
    const int offc = first ? -1 : 1; const bool vc = first ? (t > 0) : (t < CTX - 1);
    valid = isctx ? vc : vl;
    return valid ? t + (isctx ? offc : offl) : t;
}
__device__ __forceinline__ float pm_val(const bf16* P, const float* mu, int t, int col) {
    const float p0 = bf2f(P[(size_t)t * PCP + col]); bool valid; const int nr = shift_row(t, col, valid);
    const float pn = bf2f(P[(size_t)nr * PCP + col]); const float p1 = valid ? pn : 0.f;
    return p0 + (p1 - p0) * mu[col];
}
__device__ __forceinline__ f32x4 mm_tile(const LAS bf16* A, const LAS bf16* Bt, int ti, int tj, int lane, f32x4 acc) {
    const LAS bf16* pa = A + (16 * ti + (lane & 15)) * LP + 8 * (lane >> 4); const LAS bf16* pb = Bt + (16 * tj + (lane & 15)) * LP + 8 * (lane >> 4);
#pragma unroll
    for (int kk = 0; kk < 2; ++kk) { const bf16x8 a = *(const LAS bf16x8*)(pa + 32 * kk), b = *(const LAS bf16x8*)(pb + 32 * kk); acc = MFMA16(a, b, acc); }
    return acc;
}
struct PmLd { float p0, pn, m; bool valid; };
__device__ __forceinline__ PmLd pm_ld(const bf16* P, const float* mu, int t, int col) {
    PmLd r; bool valid; const int nr = shift_row(t, col, valid); r.p0 = bf2f(P[(size_t)t * PCP + col]); r.pn = bf2f(P[(size_t)nr * PCP + col]); r.m = mu[col]; r.valid = valid; return r; }
__device__ __forceinline__ float pm_fin(const PmLd& r) { const float p1 = r.valid ? r.pn : 0.f; return r.p0 + (p1 - r.p0) * r.m; }
constexpr int TT = 8;
__device__ __forceinline__ void phase_lin(const Ctx& X, int l) {
    const bf16* P = X.ws<bf16>(WS_P); const float* mu = X.in(I_MU) + (size_t)l * RC; bf16* LIN = X.ws<bf16>(WS_LIN);
    for (size_t idx = (size_t)X.bid * NTHR + X.tid; idx < (size_t)M * 384; idx += (size_t)X.G * NTHR) { const int t = (int)(idx / 384), j = (int)(idx % 384);
        float v = pm_val(P, mu, t, C_LWF + j);
        if (j < 128) v = 1.0f - 2.0f * frcp(fexp(2.0f * v) + 1.0f); else if (j >= 256) v = sigmoidf_(v);
        LIN[idx] = (bf16)f2bf(v); }
}
__device__ __forceinline__ f32x4 mm_tile_p(const LAS bf16* A, int lda, const LAS bf16* Bt, int ldb, int ks, int ti, int tj, int lane, f32x4 acc) {
    const LAS bf16* pa = A + (16 * ti + (lane & 15)) * lda + 8 * (lane >> 4); const LAS bf16* pb = Bt + (16 * tj + (lane & 15)) * ldb + 8 * (lane >> 4);
    for (int kk = 0; kk < ks; ++kk) { const bf16x8 a = *(const LAS bf16x8*)(pa + 32 * kk), b = *(const LAS bf16x8*)(pb + 32 * kk); acc = MFMA16(a, b, acc); }
    return acc;
}
constexpr int GP = 136;
__device__ __forceinline__ void lora_unit_a(const Ctx& X, int unit) {
    const int b = unit / NH, h = unit % NH, tid = X.tid, lane = X.lane, w = X.wave;
    LAS bf16* Ab = (LAS bf16*)X.lds; LAS bf16* Gb = Ab + 4 * 64 * LP; LAS bf16* Wb = Gb + 64 * GP; LAS bf16* G2b = Wb + 4 * 64 * LP;
    LAS float* OUT = (LAS float*)X.lds;
    static_assert((8 * 64 * LP + 2 * 64 * GP) * 2 <= LDS_STAGE && 5 * 64 * LQ * 4 <= LDS_STAGE, "lora LDS map");
    const bf16* LIN = X.wsv<bf16>(WS_LIN) + (size_t)(64 * b) * 384;
    for (int i = tid; i < 64 * 48; i += NTHR) { const int t = i / 48, c16 = i % 48; const u32x4 v = *(const u32x4*)(LIN + (size_t)t * 384 + 8 * c16);
        if (c16 < 32) *(LAS u32x4*)(Ab + (c16 >> 3) * 64 * LP + t * LP + 8 * (c16 & 7)) = v; else *(LAS u32x4*)(Gb + t * GP + 8 * (c16 - 32)) = v; }
    const bf16* w2t = X.wsv<bf16>(WS_W2T) + (size_t)(64 * h) * 64; const bf16* a2t = X.wsv<bf16>(WS_A2T) + (size_t)(64 * h) * 64; const bf16* g2t = X.wsv<bf16>(WS_G2T) + (size_t)(64 * h) * 128;
    for (int i = tid; i < 4 * 64 * 8; i += NTHR) { const int q = i / 512, c = (i / 8) % 64, c16 = i % 8; const bf16* src = (q < 2 ? w2t + (size_t)q * RW * 64 : a2t + (size_t)(q - 2) * RW * 64) + c * 64 + 8 * c16;
        *(LAS u32x4*)(Wb + q * 64 * LP + c * LP + 8 * c16) = *(const u32x4*)src; }
    for (int i = tid; i < 64 * 16; i += NTHR) { const int c = i / 16, c16 = i % 16; *(LAS u32x4*)(G2b + c * GP + 8 * c16) = *(const u32x4*)(g2t + c * 128 + 8 * c16); }
    __syncthreads();
    f32x4 o[2][5];
#pragma unroll
    for (int q = 0; q < 2; ++q) { const int tile = 2 * w + q, ti = tile >> 2, tj = tile & 3; const f32x4 z4 = {0.f, 0.f, 0.f, 0.f};
#pragma unroll
        for (int p = 0; p < 4; ++p) o[q][p] = mm_tile(Ab + p * 64 * LP, Wb + p * 64 * LP, ti, tj, lane, z4);
        o[q][4] = mm_tile_p(Gb, GP, G2b, GP, 4, ti, tj, lane, z4); }
    __syncthreads();
#pragma unroll
    for (int q = 0; q < 2; ++q) { const int tile = 2 * w + q, ti = tile >> 2, tj = tile & 3, col = 16 * tj + (lane & 15);
#pragma unroll
        for (int p = 0; p < 5; ++p)
#pragma unroll
            for (int r = 0; r < 4; ++r) OUT[(p * 64 + 16 * ti + 4 * (lane >> 4) + r) * LQ + col] = o[q][p][r]; }
    __syncthreads();
}
__device__ __forceinline__ void lora_unit_b(const Ctx& X, int l, int unit) {
    const int b = unit / NH, h = unit % NH, w = X.wave, k = X.lane, c = 64 * h + k;
    const LAS float* OUT = (const LAS float*)X.lds;
    const bf16* P = X.wsv<bf16>(WS_P); const float* mu = X.inv(I_MU) + (size_t)l * RC;
    const float w00 = X.inv(I_W0)[(size_t)(l * 2 + 0) * RW + c], w01 = X.inv(I_W0)[(size_t)(l * 2 + 1) * RW + c];
    const float a00 = X.inv(I_A0)[(size_t)(l * 2 + 0) * RW + c], a01 = X.inv(I_A0)[(size_t)(l * 2 + 1) * RW + c];
    const float kkc = X.inv(I_KK)[(size_t)l * RW + c], kac = X.inv(I_KA)[(size_t)l * RW + c], rkc = X.inv(I_RK)[(size_t)l * RW + c];
    bf16* pR = X.wsv<bf16>(WS_R); bf16* pV = X.wsv<bf16>(WS_V); bf16* pKA = X.wsv<bf16>(WS_KA); bf16* pKD = X.wsv<bf16>(WS_KD); bf16* pKB = X.wsv<bf16>(WS_KB); float* pW = X.wsv<float>(WS_W); bf16* pG = X.wsv<bf16>(WS_GATE); float* pBo = X.wsv<float>(WS_BONUS);
    const int vz = vgpr_zero();
    float p0[3][8], pn[3][8]; unsigned vmask = 0u; const float mu0 = mu[c], mu1 = mu[C_K + c], mu2 = mu[C_V + c];
#pragma unroll
    for (int i = 0; i < 8; ++i) { const int t = 64 * b + 8 * w + i + vz;
#pragma unroll
        for (int q = 0; q < 3; ++q) { const int col = (q == 0 ? 0 : q == 1 ? C_K : C_V) + c; bool valid; const int nr = shift_row(t, col, valid);
            p0[q][i] = bf2f(P[(size_t)t * PCP + col]); pn[q][i] = bf2f(P[(size_t)nr * PCP + col]); vmask |= (valid ? 1u : 0u) << (3 * i + q); } }
    float bonv[8];
#pragma unroll
    for (int i = 0; i < 8; ++i) { const int tl = 8 * w + i, t = 64 * b + tl + vz;
        const float r = p0[0][i] + ((((vmask >> (3 * i + 0)) & 1u) ? pn[0][i] : 0.f) - p0[0][i]) * mu0;
        const float kx = p0[1][i] + ((((vmask >> (3 * i + 1)) & 1u) ? pn[1][i] : 0.f) - p0[1][i]) * mu1;
        const float v = p0[2][i] + ((((vmask >> (3 * i + 2)) & 1u) ? pn[2][i] : 0.f) - p0[2][i]) * mu2;
        const float wd0 = -DECAY_SCALE * sigmoidf_(w00 + OUT[(0 * 64 + tl) * LQ + k]), wd1 = -DECAY_SCALE * sigmoidf_(w01 + OUT[(1 * 64 + tl) * LQ + k]);
        const float ad0 = sigmoidf_(a00 + OUT[(2 * 64 + tl) * LQ + k]), ad1 = sigmoidf_(a01 + OUT[(3 * 64 + tl) * LQ + k]);
        const float kkr = kx * kkc; const float n2 = wave_sum(kkr * kkr); const float kk = kkr * frcp(fmaxf(sqrtf(n2), 1e-12f));
        const float kd0 = kx * (1.f + (ad0 - 1.f) * kac), kd1 = kx * (1.f + (ad1 - 1.f) * kac);
        bonv[i] = wave_sum(r * (kd0 + kd1) * rkc);
        const size_t o = (size_t)t * RW + c, o1 = (size_t)(M + t) * RW + c;
        pR[o] = (bf16)f2bf(r); pV[o] = (bf16)f2bf(v); pKA[o] = (bf16)f2bf(-kk);
        pKD[o] = (bf16)f2bf(kd0); pKD[o1] = (bf16)f2bf(kd1); pKB[o] = (bf16)f2bf(kk * ad0); pKB[o1] = (bf16)f2bf(kk * ad1);
        pW[o] = wd0; pW[o1] = wd1; pG[o] = (bf16)f2bf(OUT[(4 * 64 + tl) * LQ + k]); }
    if (k < 8) { float bs = bonv[0];
#pragma unroll
        for (int i = 1; i < 8; ++i) bs = (k == i) ? bonv[i] : bs;
        pBo[(size_t)(64 * b + 8 * w + k) * NH + h] = bs; }
    __syncthreads();
}
__device__ __forceinline__ void phase_prep_hyena(const Ctx& X, int l) {
    const bf16* P = X.ws<bf16>(WS_P); const int c = X.tid;
    if (c < HW) {
        const float* cw = X.in(I_CW) + (size_t)l * 3 * HC; const float* cb = X.in(I_CB) + (size_t)l * HC;
        float cw0[3], cw1[3], cw2[3], cbv[3];
#pragma unroll
        for (int j = 0; j < 3; ++j) { const int hc = j * HW + c; cw0[j] = cw[hc]; cw1[j] = cw[HC + hc]; cw2[j] = cw[2 * HC + hc]; cbv[j] = cb[hc]; }
        float* ZT = X.ws<float>(WS_ZT) + (size_t)c * M; float* Zc = X.ws<float>(WS_Z); bf16* X0 = X.ws<bf16>(WS_X0);
        for (int tile = X.bid; tile < M / TT; tile += X.G) { const int t0 = tile * TT; float zz[TT];
            float pv[3][TT + 2]; const bool hp0 = (t0 != 0 && t0 != CTX), hnl = (t0 + TT != CTX && t0 + TT != M);
#pragma unroll
            for (int j = 0; j < 3; ++j) { const int col = C_HY + j * HW + c;
#pragma unroll
                for (int i = 0; i < TT + 2; ++i) { const int t = t0 - 1 + i; const bool ok = (i == 0) ? hp0 : (i == TT + 1) ? hnl : true; pv[j][i] = ok ? bf2f(P[(size_t)(ok ? t : t0) * PCP + col]) : 0.f; } }
#pragma unroll
            for (int tt = 0; tt < TT; ++tt) { const int t = t0 + tt;
                float u[3];
#pragma unroll
                for (int j = 0; j < 3; ++j) u[j] = pv[j][tt] * cw0[j] + pv[j][tt + 1] * cw1[j] + pv[j][tt + 2] * cw2[j] + cbv[j];
                zz[tt] = u[2] * u[1]; if (t < CTX) Zc[(size_t)t * HW + c] = zz[tt];
                X0[(size_t)t * HW + c] = (bf16)f2bf(u[0]); }
            *(f32x4*)(ZT + t0) = (f32x4){zz[0], zz[1], zz[2], zz[3]}; *(f32x4*)(ZT + t0 + 4) = (f32x4){zz[4], zz[5], zz[6], zz[7]}; }
    }
}

constexpr int CC = 64, NCHK = M / CC;
static_assert(CTX % CC == 0 && SEQ % CC == 0, "chunks must not straddle the context/latent boundary");
__device__ __forceinline__ int scan_row(int d, int s) { return d == 0 ? s : (s < CTX ? CTX - 1 - s : M - 1 - (s - CTX)); }
__device__ __forceinline__ void chunk_unit_1(const Ctx& X, int unit) {
    const int d = unit / (NCHK * NH), c = (unit / NH) % NCHK, h = unit % NH;
    LAS bf16* An = (LAS bf16*)X.lds;            LAS bf16* Bn = An + 64 * LP; LAS bf16* Kn = Bn + 64 * LP; LAS bf16* Rn = Kn + 64 * LP; LAS bf16* Vt = Rn + 64 * LP;
    LAS bf16* Bh = Vt + 64 * LP;                LAS bf16* Kh = Bh + 64 * LP; LAS bf16* Lak = Kh + 64 * LP; LAS bf16* Mrb = Lak + 64 * LP; LAS bf16* Mrk = Mrb + 64 * LP;
    LAS float* Lab = (LAS float*)(Mrk + 64 * LP); LAS float* XsW = Lab + 64 * LX;
    LAS float* XsU = (LAS float*)An;
    LAS bf16* Wt = Lak; LAS bf16* Ut = (LAS bf16*)((LAS unsigned char*)An + 64 * LX * 4);
    LAS float* tot = Lab;
    LAS float* dC = (LAS float*)(X.lds + LDS_MISC + 1024);
    static_assert(10 * 64 * LP * 2 + 2 * 64 * LX * 4 <= LDS_STAGE && 64 * LX * 4 + 64 * LP * 2 <= 3 * 64 * LP * 2, "chunk LDS map");
    const int tid = X.tid, lane = X.lane, w = X.wave, k = tid & 63;
    float lw[8], cum[8];
    { float run = 0.f; const float* pW = X.wsv<float>(WS_W);
#pragma unroll
      for (int i = 0; i < 8; ++i) { const int row = scan_row(d, c * CC + 8 * w + i); lw[i] = pW[((size_t)d * M + row) * RW + h * 64 + k]; }
#pragma unroll
      for (int i = 0; i < 8; ++i) { run += lw[i]; cum[i] = run; }
      tot[w * 64 + k] = run; }
    __syncthreads();
    float off = 0.f, cumC = 0.f;
#pragma unroll
    for (int ww = 0; ww < 8; ++ww) { const float t = tot[ww * 64 + k]; off += (ww < w) ? t : 0.f; cumC += t; }
    __syncthreads();
    { unsigned pv[4], pbh[4], pkh[4]; float af[8];
      const bf16* pR = X.wsv<bf16>(WS_R); const bf16* pV = X.wsv<bf16>(WS_V); const bf16* pKA = X.wsv<bf16>(WS_KA); const bf16* pKD = X.wsv<bf16>(WS_KD); const bf16* pKB = X.wsv<bf16>(WS_KB);
#pragma unroll
      for (int i = 0; i < 8; ++i) { const int t = 8 * w + i; const int row = scan_row(d, c * CC + t); const size_t o = (size_t)row * RW + h * 64 + k, od = ((size_t)d * M + row) * RW + h * 64 + k;
          const float ct = off + cum[i], cp = ct - lw[i];
          const float r = bf2f(pR[o]), v = bf2f(pV[o]), ka = bf2f(pKA[o]), kd = bf2f(pKD[od]), kb = bf2f(pKB[od]);
          const float ei = fexp(-ct), eh = fexp(cumC - ct);
          const float at = ka * fexp(cp); af[i] = at;
          An[t * LP + k] = (bf16)f2bf(at); Bn[t * LP + k] = (bf16)f2bf(kb * ei); Kn[t * LP + k] = (bf16)f2bf(kd * ei); Rn[t * LP + k] = (bf16)f2bf(r * fexp(ct));
          const unsigned bv = f2bf(v), bb = f2bf(kb * eh), bk = f2bf(kd * eh);
          if (i & 1) { pv[i >> 1] |= bv << 16; pbh[i >> 1] |= bb << 16; pkh[i >> 1] |= bk << 16; } else { pv[i >> 1] = bv; pbh[i >> 1] = bb; pkh[i >> 1] = bk; } }
      *(LAS u32x4*)(Vt + k * LP + 8 * w) = (u32x4){pv[0], pv[1], pv[2], pv[3]}; *(LAS u32x4*)(Bh + k * LP + 8 * w) = (u32x4){pbh[0], pbh[1], pbh[2], pbh[3]}; *(LAS u32x4*)(Kh + k * LP + 8 * w) = (u32x4){pkh[0], pkh[1], pkh[2], pkh[3]};
      *(LAS f32x4*)(XsW + k * LX + 8 * w) = (f32x4){af[0], af[1], af[2], af[3]}; *(LAS f32x4*)(XsW + k * LX + 8 * w + 4) = (f32x4){af[4], af[5], af[6], af[7]}; }
    if (tid < 64) dC[tid] = fexp(cumC);
    __syncthreads();
#pragma unroll 1
    for (int q = 0; q < 2; ++q) { const int tile = 2 * w + q, ti = tile >> 2, tj = tile & 3; const f32x4 z4 = {0.f, 0.f, 0.f, 0.f};
        const f32x4 ab = mm_tile(An, Bn, ti, tj, lane, z4), ak = mm_tile(An, Kn, ti, tj, lane, z4), rb = mm_tile(Rn, Bn, ti, tj, lane, z4), rk = mm_tile(Rn, Kn, ti, tj, lane, z4);
        const int col = 16 * tj + (lane & 15);
#pragma unroll
        for (int r = 0; r < 4; ++r) { const int row = 16 * ti + 4 * (lane >> 4) + r; const bool lo = col < row, le = col <= row;
            Lab[row * LX + col] = lo ? ab[r] : 0.f; Lak[row * LP + col] = (bf16)f2bf(lo ? ak[r] : 0.f); Mrb[row * LP + col] = (bf16)f2bf(le ? rb[r] : 0.f); Mrk[row * LP + col] = (bf16)f2bf(le ? rk[r] : 0.f); } }
    __syncthreads();
}
__device__ __forceinline__ void chunk_unit_2(const Ctx& X, int unit) {
    const int d = unit / (NCHK * NH), c = (unit / NH) % NCHK, h = unit % NH;
    LAS bf16* An = (LAS bf16*)X.lds;            LAS bf16* Bn = An + 64 * LP; LAS bf16* Kn = Bn + 64 * LP; LAS bf16* Rn = Kn + 64 * LP; LAS bf16* Vt = Rn + 64 * LP;
    LAS bf16* Bh = Vt + 64 * LP;                LAS bf16* Kh = Bh + 64 * LP; LAS bf16* Lak = Kh + 64 * LP; LAS bf16* Mrb = Lak + 64 * LP; LAS bf16* Mrk = Mrb + 64 * LP;
    LAS float* Lab = (LAS float*)(Mrk + 64 * LP); LAS float* XsW = Lab + 64 * LX;
    LAS float* XsU = (LAS float*)An;
    LAS bf16* Wt = Lak; LAS bf16* Ut = (LAS bf16*)((LAS unsigned char*)An + 64 * LX * 4);
    LAS float* tot = Lab;
    LAS float* dC = (LAS float*)(X.lds + LDS_MISC + 1024);
    static_assert(10 * 64 * LP * 2 + 2 * 64 * LX * 4 <= LDS_STAGE && 64 * LX * 4 + 64 * LP * 2 <= 3 * 64 * LP * 2, "chunk LDS map");
    const int tid = X.tid, lane = X.lane, w = X.wave, k = tid & 63;
    f32x4 r2[2]; int r2col[2], r2row[2];
#pragma unroll
    for (int q = 0; q < 2; ++q) { const int tile = 2 * w + q, ti = tile >> 2, tj = tile & 3; const f32x4 z4 = {0.f, 0.f, 0.f, 0.f};
        const f32x4 a = mm_tile(Lak, Vt, ti, tj, lane, z4); const int col = 16 * tj + (lane & 15);
        r2[q] = a; r2col[q] = col; r2row[q] = 16 * ti + 4 * (lane >> 4); }
    __syncthreads();
#pragma unroll
    for (int q = 0; q < 2; ++q) *(LAS f32x4*)(XsU + r2col[q] * LX + r2row[q]) = r2[q];
    __syncthreads();
    LAS bf16* Tii = (LAS bf16*)(X.lds + LDS_MISC + 8448);
    constexpr int TP = 40;
    static_assert(8448 + 4 * 16 * TP * 2 <= LDS_BYTES - LDS_MISC, "T_ii image");
    if (tid < 64) { const int bi = tid >> 4, j = tid & 15; float xv[16];
#pragma unroll
        for (int t = 0; t < 16; ++t) { float acc = (t == j) ? 1.f : 0.f;
#pragma unroll
            for (int s2 = 0; s2 < t; ++s2) acc += Lab[(16 * bi + t) * LX + 16 * bi + s2] * xv[s2];
            xv[t] = acc; }
#pragma unroll
        for (int t = 0; t < 16; ++t) { Tii[(bi * 16 + t) * TP + j] = (bf16)f2bf(xv[t]); Tii[(bi * 16 + t) * TP + 16 + j] = (bf16)0; } }
    __syncthreads();
    { LAS float* xsx = (w < 4 ? XsW + 16 * w * LX : XsU + 16 * (w - 4) * LX) + (lane & 15) * LX;
      LAS bf16* dst = (w < 4 ? Wt + 16 * w * LP : Ut + 16 * (w - 4) * LP) + (lane & 15) * LP;
      const int kof = 8 * (lane >> 4); const bf16x8 zero8 = {0, 0, 0, 0, 0, 0, 0, 0};
#pragma unroll
      for (int i = 0; i < 4; ++i) {
          f32x4 acc = *(const LAS f32x4*)(xsx + 16 * i + 4 * (lane >> 4));
#pragma unroll
          for (int kk = 0; kk < (16 * i + 31) / 32; ++kk) { const int s0 = 32 * kk + kof;
              const f32x4 l0 = *(const LAS f32x4*)(Lab + (16 * i + (lane & 15)) * LX + s0), l1 = *(const LAS f32x4*)(Lab + (16 * i + (lane & 15)) * LX + s0 + 4);
              u32x4 pa = {pk2(l0[0], l0[1]), pk2(l0[2], l0[3]), pk2(l1[0], l1[1]), pk2(l1[2], l1[3])};
              bf16x8 av = __builtin_bit_cast(bf16x8, pa), bv = *(const LAS bf16x8*)(dst + s0);
              if (s0 >= 16 * i) { av = zero8; bv = zero8; }
              acc = MFMA16(av, bv, acc); }
          LAS bf16* zt = (LAS bf16*)(xsx + 16 * i);
          *(LAS unsigned long long*)(zt + 4 * (lane >> 4)) = (unsigned long long)pk2(acc[0], acc[1]) | ((unsigned long long)pk2(acc[2], acc[3]) << 32);
          WAVE_LDS_FENCE(); CFENCE();
          const bf16x8 a2 = *(const LAS bf16x8*)(Tii + (i * 16 + (lane & 15)) * TP + kof); bf16x8 b2 = zero8; if (kof < 16) b2 = *(const LAS bf16x8*)(zt + kof);
          f32x4 xi = {0.f, 0.f, 0.f, 0.f}; xi = MFMA16(a2, b2, xi);
          *(LAS unsigned long long*)(dst + 16 * i + 4 * (lane >> 4)) = (unsigned long long)pk2(xi[0], xi[1]) | ((unsigned long long)pk2(xi[2], xi[3]) << 32);
          WAVE_LDS_FENCE(); CFENCE(); } }
    __syncthreads();
}
__device__ __forceinline__ void chunk_unit_3(const Ctx& X, int unit) {
    const int d = unit / (NCHK * NH), c = (unit / NH) % NCHK, h = unit % NH;
    LAS bf16* An = (LAS bf16*)X.lds;            LAS bf16* Bn = An + 64 * LP; LAS bf16* Kn = Bn + 64 * LP; LAS bf16* Rn = Kn + 64 * LP; LAS bf16* Vt = Rn + 64 * LP;
    LAS bf16* Bh = Vt + 64 * LP;                LAS bf16* Kh = Bh + 64 * LP; LAS bf16* Lak = Kh + 64 * LP; LAS bf16* Mrb = Lak + 64 * LP; LAS bf16* Mrk = Mrb + 64 * LP;
    LAS float* Lab = (LAS float*)(Mrk + 64 * LP); LAS float* XsW = Lab + 64 * LX;
    LAS float* XsU = (LAS float*)An;
    LAS bf16* Wt = Lak; LAS bf16* Ut = (LAS bf16*)((LAS unsigned char*)An + 64 * LX * 4);
    LAS float* tot = Lab;
    LAS float* dC = (LAS float*)(X.lds + LDS_MISC + 1024);
    static_assert(10 * 64 * LP * 2 + 2 * 64 * LX * 4 <= LDS_STAGE && 64 * LX * 4 + 64 * LP * 2 <= 3 * 64 * LP * 2, "chunk LDS map");
    const int tid = X.tid, lane = X.lane, w = X.wave, k = tid & 63;
    const float dCk = dC[k];
    const size_t ubase = ((size_t)(d * NH + h) * NCHK + c);
    bf16* PTg = (bf16*)(X.wsv<float>(WS_PQ) + ubase * 2 * 4096); float* Qg = X.wsv<float>(WS_PQ) + ubase * 2 * 4096 + 4096;     bf16* Gg = X.wsv<bf16>(WS_G) + ubase * 4096; float* Yg = X.wsv<float>(WS_YL) + ubase * 4096;
#pragma unroll 1
    for (int q = 0; q < 2; ++q) { const int tile = 2 * w + q, ti = tile >> 2, tj = tile & 3; const f32x4 z4 = {0.f, 0.f, 0.f, 0.f};
        const f32x4 p = mm_tile(Wt, Bh, ti, tj, lane, z4); f32x4 qq = mm_tile(Ut, Bh, ti, tj, lane, z4); qq = mm_tile(Vt, Kh, ti, tj, lane, qq);
        const f32x4 g = mm_tile(Mrb, Wt, ti, tj, lane, z4); f32x4 y = mm_tile(Mrb, Ut, ti, tj, lane, z4); y = mm_tile(Mrk, Vt, ti, tj, lane, y);
        const int col = 16 * tj + (lane & 15); const float dcol = __shfl(dCk, col);
        { const int row0 = 16 * ti + 4 * (lane >> 4); float pv[4];
#pragma unroll
          for (int r = 0; r < 4; ++r) pv[r] = p[r] + ((row0 + r) == col ? dcol : 0.f);
          *(unsigned long long*)(PTg + col * 64 + row0) = (unsigned long long)pk2(pv[0], pv[1]) | ((unsigned long long)pk2(pv[2], pv[3]) << 32); }
#pragma unroll
        for (int r = 0; r < 4; ++r) { const int row = 16 * ti + 4 * (lane >> 4) + r;
            Qg[row * 64 + col] = qq[r];
            const int orow = d ? 63 - row : row;
            Gg[orow * 64 + col] = (bf16)f2bf(g[r] + bf2f(Rn[row * LP + col])); }
        { const int gq = lane >> 4; const int cti = d ? 3 - ti : ti, cg = d ? 3 - gq : gq; const f32x4 yv = d ? (f32x4){y[3], y[2], y[1], y[0]} : y;
          *(f32x4*)(Yg + ((cti * 4 + tj) * 64 + 16 * cg + (lane & 15)) * 4) = yv; } }
    __syncthreads();
}
__device__ __forceinline__ void seq_unit(const Ctx& X, int su) {
    const int d = su / (NH * 4), h = (su / 4) % NH, qv = su & 3;
    constexpr int PD = 9, RING = PD + 1, SLOTB = 8192 + 4096;
    LAS unsigned char* ring = X.lds;
    LAS bf16* S = (LAS bf16*)(ring + RING * SLOTB);
    static_assert(RING * SLOTB + 2 * 16 * LP * 2 <= LDS_STAGE && (PD - 1) * 6 <= 63, "seq LDS map / vmcnt range");
    const int lane = X.lane, w = X.wave, tj = w & 3, col = 16 * tj + (lane & 15), kq = lane >> 4, kof = 8 * kq;
    const bool worker = w < 4;
    const unsigned char* PQ = (const unsigned char*)(X.ws<float>(WS_PQ) + (size_t)(d * NH + h) * NCHK * 2 * 4096); bf16* S0g = X.ws<bf16>(WS_S0) + (size_t)(d * NH + h) * NCHK * 4096 + (size_t)(16 * qv) * 64;
#define SEQ_FILL(c_) do { const unsigned char* p_ = PQ + (size_t)(c_) * 32768; LAS unsigned char* sl_ = ring + ((c_) % RING) * SLOTB; \
        GLDS16(p_ + 16 * (w * 64 + lane), sl_ + 16 * (w * 64)); GLDS16(p_ + 16384 + (16 * qv) * 256 + 16 * ((w & 3) * 64 + lane), sl_ + 8192 + 16 * ((w & 3) * 64)); } while (0)
#pragma unroll
    for (int i = 0; i < PD; ++i) if (i < NCHK) SEQ_FILL(i);
    for (int i = X.tid; i < 2 * 16 * LP / 2; i += NTHR) ((LAS unsigned*)S)[i] = 0u;
    if (worker) {
#pragma unroll
        for (int r = 0; r < 4; ++r) S0g[(4 * kq + r) * 64 + col] = (bf16)0; }
    for (int c = 0; c < NCHK; ++c) {
        if (c + PD - 1 < NCHK) { if (worker) { ASM_WAIT_V(48); } else { ASM_WAIT_V(16); } } else { ASM_WAIT_V(0); }
        ASM_WAIT_L(0); S_BARRIER(); CFENCE();
        if (c + PD < NCHK) SEQ_FILL(c + PD);
        if (worker) {
            const LAS bf16* PT = (const LAS bf16*)(ring + (c % RING) * SLOTB); const LAS float* Q = (const LAS float*)(ring + (c % RING) * SLOTB + 8192);
            const LAS bf16* Sc = S + (c & 1) * 16 * LP; LAS bf16* Sn = S + ((c + 1) & 1) * 16 * LP;
            f32x4 acc;
#pragma unroll
            for (int r = 0; r < 4; ++r) acc[r] = Q[(4 * kq + r) * 64 + col];
#pragma unroll
            for (int kk = 0; kk < 2; ++kk) acc = MFMA16(*(const LAS bf16x8*)(Sc + (lane & 15) * LP + kof + 32 * kk), *(const LAS bf16x8*)(PT + (16 * tj + (lane & 15)) * 64 + kof + 32 * kk), acc);
#pragma unroll
            for (int r = 0; r < 4; ++r) { const bf16 sb = (bf16)f2bf(acc[r]); Sn[(4 * kq + r) * LP + col] = sb; if (c + 1 < NCHK) S0g[(size_t)(c + 1) * 4096 + (4 * kq + r) * 64 + col] = sb; } }
    }
    ASM_WAIT_V(0);
    __syncthreads();
#undef SEQ_FILL
}
constexpr int CR = 16;
__device__ __forceinline__ void conv_item(const Ctx& X, int item) {
    constexpr int NCG = HW / 64; constexpr int n = CTX;
    const int cg = item % NCG, ob = item / NCG, i0 = CR * ob, c = cg * 64 + X.lane;
    const float* F = X.ws<float>(WS_FILT) + (size_t)HW * SEQ + (size_t)c * CTX; const float* Z = X.ws<float>(WS_Z) + c;
    const float* fp = X.ws<float>(WS_FPART) + (size_t)NPART * HW + c;
    float nsum = 0.f; for (int b = 0; b < NPART; ++b) nsum += fp[(size_t)b * HW];
    float acc[CR], Q[CR];
#pragma unroll
    for (int r = 0; r < CR; ++r) acc[r] = 0.f;
    int jb = i0 - n / 2; if (jb < 0) jb = 0;
    int jend = i0 + n / 2 + CR; if (jend > n) jend = n;
    int Tb = i0 - jb + n / 2;
#pragma unroll
    for (int x = 1; x < CR; ++x) { const int T = Tb + x; Q[x] = (T >= 0 && T < n) ? F[T] : 0.f; }
    Q[0] = 0.f;
    for (; jb < jend; jb += CR, Tb -= CR) {
#pragma unroll
        for (int s = 0; s < CR; ++s) { const int T = Tb - s, j = jb + s;
            if ((s & 3) == 0) CFENCE();
            Q[(CR - s) & (CR - 1)] = (T >= 0 && T < n) ? F[T] : 0.f;
            const float zj = (j < n) ? Z[(size_t)j * HW] : 0.f;
#pragma unroll
            for (int r = 0; r < CR; ++r) acc[r] += Q[(r - s + CR) & (CR - 1)] * zj; }
    }
    const float inv = 1.0f / nsum; float* O = X.ws<float>(WS_CONV) + c;
#pragma unroll
    for (int r = 0; r < CR; ++r) O[(size_t)(i0 + r) * HW] = acc[r] * inv;
}

#ifdef EMU
struct cf { float x, y; };
#else
typedef float cf __attribute__((ext_vector_type(2)));
#endif
__device__ __forceinline__ cf cmul(cf a, cf b) { return cf{a.x * b.x - a.y * b.y, a.x * b.y + a.y * b.x}; }
__device__ __forceinline__ cf cadd(cf a, cf b) { return cf{a.x + b.x, a.y + b.y}; }
__device__ __forceinline__ cf csub(cf a, cf b) { return cf{a.x - b.x, a.y - b.y}; }
__device__ __forceinline__ cf cconj(cf a) { return cf{a.x, -a.y}; }
constexpr int FN = SEQ;
constexpr int flog4(int n) { return n <= 1 ? 0 : 1 + flog4(n / 4); }
constexpr int FLOG4 = flog4(FN), FSQ = 1 << FLOG4;
static_assert((1 << (2 * FLOG4)) == FN && FN * 8 <= LDS_STAGE, "FFT length must be a power of 4 that fits the LDS stage region");
constexpr int FFT_TAB_OFF = LDS_MISC + 2048;
static_assert(FFT_TAB_OFF + 2 * FSQ * 8 <= LDS_BYTES, "FFT twiddle tables");
__device__ __forceinline__ void fft_tables(const Ctx& X) {
    LAS cf* T = (LAS cf*)(X.lds + FFT_TAB_OFF);
    for (int i = X.tid; i < 2 * FSQ; i += NTHR) { const int k = i < FSQ ? i * FSQ : i - FSQ; float s, c; sincos_f(-6.283185307179586f * (float)k / (float)FN, s, c); T[i] = cf{c, s}; }
    __syncthreads();
}
__device__ __forceinline__ cf fft_tw(const LAS cf* T, int k) { const cf a = T[k >> FLOG4], b = T[FSQ + (k & (FSQ - 1))]; return cmul(a, b); }
__device__ __forceinline__ int rev4(int k) { int r = 0;
#pragma unroll
    for (int s = 0; s < FLOG4; ++s) { r = (r << 2) | (k & 3); k >>= 2; }
    return r; }
__device__ __forceinline__ void fft_stage_q1(LAS cf* x, int tid, bool inverse) {
    for (int u = tid; u < FN / 4; u += NTHR) { LAS f32x4* px = (LAS f32x4*)(x + 4 * u); const f32x4 v01 = px[0], v23 = px[1];
        const cf a0{v01[0], v01[1]}, a1{v01[2], v01[3]}, a2{v23[0], v23[1]}, a3{v23[2], v23[3]};
        const cf t0 = cadd(a0, a2), t1 = csub(a0, a2), t2 = cadd(a1, a3), d = csub(a1, a3), t3 = inverse ? cf{-d.y, d.x} : cf{d.y, -d.x};
        const cf y0 = cadd(t0, t2), y1 = cadd(t1, t3), y2 = csub(t0, t2), y3 = csub(t1, t3);
        px[0] = (f32x4){y0.x, y0.y, y1.x, y1.y}; px[1] = (f32x4){y2.x, y2.y, y3.x, y3.y}; }
    __syncthreads();
}
__device__ __forceinline__ void dif4(cf& a0, cf& a1, cf& a2, cf& a3, cf w1) {
    const cf w2 = cmul(w1, w1), w3 = cmul(w2, w1);
    const cf t0 = cadd(a0, a2), t1 = csub(a0, a2), t2 = cadd(a1, a3), d = csub(a1, a3), t3 = cf{d.y, -d.x};
    a0 = cadd(t0, t2); a1 = cmul(cadd(t1, t3), w1); a2 = cmul(csub(t0, t2), w2); a3 = cmul(csub(t1, t3), w3);
}
__device__ __forceinline__ void dit4(cf& a0, cf& a1, cf& a2, cf& a3, cf w1c) {
    const cf w2 = cmul(w1c, w1c), w3 = cmul(w2, w1c);
    a1 = cmul(a1, w1c); a2 = cmul(a2, w2); a3 = cmul(a3, w3);
    const cf t0 = cadd(a0, a2), t1 = csub(a0, a2), t2 = cadd(a1, a3), d = csub(a1, a3), t3 = cf{-d.y, d.x};
    a0 = cadd(t0, t2); a1 = cadd(t1, t3); a2 = csub(t0, t2); a3 = csub(t1, t3);
}
__device__ __forceinline__ void fft_pair(LAS cf* x, const LAS cf* T, int tid, int s, bool inverse) {
    const int q1 = FN >> (2 * s + 2), q2 = q1 >> 2, tw1 = 1 << (2 * s), tw2 = tw1 << 2;
    for (int u = tid; u < FN / 16; u += NTHR) { const int j2 = u & (q2 - 1), base = (u - j2) * 16 + j2;
        cf v[4][4];
#pragma unroll
        for (int a = 0; a < 4; ++a)
#pragma unroll
            for (int b = 0; b < 4; ++b) v[a][b] = x[base + a * q1 + b * q2];
        if (!inverse) {
#pragma unroll
            for (int b = 0; b < 4; ++b) dif4(v[0][b], v[1][b], v[2][b], v[3][b], fft_tw(T, (b * q2 + j2) * tw1));
            const cf wb = fft_tw(T, j2 * tw2);
#pragma unroll
            for (int a = 0; a < 4; ++a) dif4(v[a][0], v[a][1], v[a][2], v[a][3], wb);
        } else {
            const cf wb = cconj(fft_tw(T, j2 * tw2));
#pragma unroll
            for (int a = 0; a < 4; ++a) dit4(v[a][0], v[a][1], v[a][2], v[a][3], wb);
#pragma unroll
            for (int b = 0; b < 4; ++b) dit4(v[0][b], v[1][b], v[2][b], v[3][b], cconj(fft_tw(T, (b * q2 + j2) * tw1)));
        }
#pragma unroll
        for (int a = 0; a < 4; ++a)
#pragma unroll
            for (int b = 0; b < 4; ++b) x[base + a * q1 + b * q2] = v[a][b]; }
    __syncthreads();
}
__device__ __forceinline__ void fft_single(LAS cf* x, const LAS cf* T, int tid, int s, bool inverse) {
    const int q = FN >> (2 * s + 2), tw = 1 << (2 * s);
    for (int u = tid; u < FN / 4; u += NTHR) { const int j = u & (q - 1), p = (u - j) * 4 + j;
        cf a0 = x[p], a1 = x[p + q], a2 = x[p + 2 * q], a3 = x[p + 3 * q];
        if (!inverse) dif4(a0, a1, a2, a3, fft_tw(T, j * tw)); else dit4(a0, a1, a2, a3, cconj(fft_tw(T, j * tw)));
        x[p] = a0; x[p + q] = a1; x[p + 2 * q] = a2; x[p + 3 * q] = a3; }
    __syncthreads();
}
constexpr int fft_npairs() { int n = 0; for (int s = 0; s + 1 < FLOG4 - 1; s += 2) { if ((FN >> (2 * s + 6)) >= 64 || FN < 16384) ++n; else break; } return n; }
constexpr int FPAIRS = fft_npairs();
__device__ __forceinline__ void fft_run(LAS cf* x, const LAS cf* T, int tid, bool inverse) {
    constexpr int NST = FPAIRS + (FLOG4 - 1 - 2 * FPAIRS) + 1;
#pragma unroll 1
    for (int i = 0; i < NST; ++i) { const int k = inverse ? NST - 1 - i : i;
        if (k < FPAIRS) fft_pair(x, T, tid, 2 * k, inverse);
        else if (k < NST - 1) fft_single(x, T, tid, 2 * FPAIRS + (k - FPAIRS), inverse);
        else fft_stage_q1(x, tid, inverse); }
}
__device__ __forceinline__ void fft_fwd(LAS cf* x, const LAS cf* T, int tid) { fft_run(x, T, tid, false); }
__device__ __forceinline__ void fft_inv(LAS cf* x, const LAS cf* T, int tid) { fft_run(x, T, tid, true); }
__device__ __forceinline__ void fft_load_real(LAS cf* x, const float* src, float scale, int tid) {
    for (int m = tid; m < FN; m += NTHR) { cf v{0.f, 0.f}; if (m < FN / 2) { v.x = src[2 * m] * scale; v.y = src[2 * m + 1] * scale; } x[m] = v; }
    __syncthreads();
}
__device__ __forceinline__ void spec_load(const Ctx& X, int c) {
    LAS cf* x = (LAS cf*)X.lds; volatile LAS float* red = (volatile LAS float*)(X.lds + LDS_MISC) + 120;
    if (X.wave == 0) { const float* fp = X.ws<float>(WS_FPART) + c; float s = 0.f; for (int b = X.lane; b < NPART; b += 64) s += fp[(size_t)b * HW]; s = wave_sum(s); if (X.lane == 0) red[0] = s; }
    __syncthreads();
    const float inv = 1.0f / red[0];
    fft_load_real(x, X.ws<float>(WS_FILT) + (size_t)c * SEQ, inv, X.tid);
}
__device__ __forceinline__ void spec_unpack(const Ctx& X, int c) {
    LAS cf* x = (LAS cf*)X.lds;
    cf* HS = X.ws<cf>(WS_HS) + (size_t)c * (FN + 1);
    for (int k = X.tid; k <= FN / 2; k += NTHR) {
        const cf A = x[rev4(k)], B = x[rev4((FN - k) & (FN - 1))];
        if (k == 0) { HS[0] = cf{A.x + A.y, 0.f}; HS[FN] = cf{A.x - A.y, 0.f}; }
        else if (k == FN / 2) { HS[k] = cconj(A); }
        else { float sn, cs; sincos_f(-3.14159265358979f * (float)k / (float)FN, sn, cs); const cf w{cs, sn};
            const cf s1 = cadd(A, cconj(B)), d1 = csub(A, cconj(B)), wd = cmul(w, d1);
            HS[k] = cf{0.5f * (s1.x + wd.y), 0.5f * (s1.y - wd.x)};
            const cf s2 = cadd(B, cconj(A)), d2 = csub(B, cconj(A)), wd2 = cmul(cconj(w), d2);
            HS[FN - k] = cf{0.5f * (s2.x - wd2.y), 0.5f * (s2.y + wd2.x)}; } }
    __syncthreads();
}
__device__ __forceinline__ void fftconv_load(const Ctx& X, int c) { fft_load_real((LAS cf*)X.lds, X.ws<float>(WS_ZT) + (size_t)c * M + CTX, 1.0f, X.tid); }
__device__ __forceinline__ void fftconv_mul(const Ctx& X, int c) {
    LAS cf* x = (LAS cf*)X.lds;
    const cf* HS = X.ws<cf>(WS_HS) + (size_t)c * (FN + 1);
    for (int k = X.tid; k <= FN / 2; k += NTHR) {
        const int pa = rev4(k), pb = rev4((FN - k) & (FN - 1)); const cf A = x[pa], B = x[pb];
        if (k == 0) { const float y0 = (A.x + A.y) * HS[0].x, yn = (A.x - A.y) * HS[FN].x; x[pa] = cf{0.5f * (y0 + yn), 0.5f * (y0 - yn)}; }
        else if (k == FN / 2) { x[pa] = cconj(cmul(cconj(A), HS[k])); }
        else { float sn, cs; sincos_f(-3.14159265358979f * (float)k / (float)FN, sn, cs); const cf w{cs, sn};
            const cf s1 = cadd(A, cconj(B)), d1 = csub(A, cconj(B)), wd = cmul(w, d1); const cf Xk{0.5f * (s1.x + wd.y), 0.5f * (s1.y - wd.x)};
            const cf s2 = cadd(B, cconj(A)), d2 = csub(B, cconj(A)), wd2 = cmul(cconj(w), d2); const cf Xn{0.5f * (s2.x - wd2.y), 0.5f * (s2.y + wd2.x)};
            const cf Yk = cmul(Xk, HS[k]), Yn = cmul(Xn, HS[FN - k]);
            const cf e1 = cadd(Yk, cconj(Yn)), f1 = cmul(cconj(w), csub(Yk, cconj(Yn)));
            x[pa] = cf{0.5f * (e1.x - f1.y), 0.5f * (e1.y + f1.x)};
            const cf e2 = cadd(Yn, cconj(Yk)), f2 = cmul(w, csub(Yn, cconj(Yk)));
            x[pb] = cf{0.5f * (e2.x + f2.y), 0.5f * (e2.y - f2.x)}; } }
    __syncthreads();
}
__device__ __forceinline__ void fftconv_out(const Ctx& X, int l, int c) {
    const LAS cf* x = (const LAS cf*)X.lds; const float* z = X.ws<float>(WS_ZT) + (size_t)c * M + CTX;
    const float bias = X.in(I_HBIAS)[(size_t)l * HW + c], sc = 1.0f / (float)FN; float* O = X.ws<float>(WS_CVT) + (size_t)c * SEQ;
    for (int i2 = X.tid; i2 < FN / 2; i2 += NTHR) { const cf d = x[i2 + FN / 4]; O[2 * i2] = d.x * sc + z[2 * i2] * bias; O[2 * i2 + 1] = d.y * sc + z[2 * i2 + 1] * bias; }
    __syncthreads();
}
__device__ __forceinline__ void phase_ctxconv(const Ctx& X, int l) {
    constexpr int NITEMS = (HW / 64) * (CTX / CR);
    unsigned* q = X.ctl() + CW_Q + l * 64;
    for (;;) { int item = 0; if (X.lane == 0) item = (int)atomicAdd(q, 1u); item = __shfl(item, 0); if (item >= NITEMS) break; conv_item(X, item); }
}
__device__ __forceinline__ void phase_seq(const Ctx& X) {
    for (int su = X.bid; su < N_SEQ_UNITS; su += X.G) seq_unit(X, su);
}

__device__ __forceinline__ void finish_wave_unit(const Ctx& X, int l, int unit) {
    const int rg = unit / NH, h = unit % NH, lane = X.lane, b = rg >> 2, sub = rg & 3;
    const int cf = b, cb = (b < CTX / CC) ? (CTX / CC - 1 - b) : (NCHK - 1 - (b - CTX / CC));
    const size_t uf = ((size_t)(0 * NH + h) * NCHK + cf) * 4096, ub = ((size_t)(1 * NH + h) * NCHK + cb) * 4096;
    const bf16* G = X.wsv<bf16>(WS_G); const bf16* S0 = X.wsv<bf16>(WS_S0); const float* YL = X.wsv<float>(WS_YL);
    const int arow = 16 * sub + (lane & 15), kof = 8 * (lane >> 4);
    bf16x8 af[2], ab[2];
#pragma unroll
    for (int kk = 0; kk < 2; ++kk) { af[kk] = *(const bf16x8*)(G + uf + arow * 64 + kof + 32 * kk); ab[kk] = *(const bf16x8*)(G + ub + arow * 64 + kof + 32 * kk); }
    f32x4 y[4];
#pragma unroll
    for (int tj = 0; tj < 4; ++tj) { const int vrow = 16 * tj + (lane & 15);
        bf16x8 bf_[2], bb_[2];
#pragma unroll
        for (int kk = 0; kk < 2; ++kk) { bf_[kk] = *(const bf16x8*)(S0 + uf + vrow * 64 + kof + 32 * kk); bb_[kk] = *(const bf16x8*)(S0 + ub + vrow * 64 + kof + 32 * kk); }
        f32x4 acc;
#pragma unroll
        for (int r = 0; r < 4; ++r) acc[r] = 0.f;
        acc = *(const f32x4*)(YL + uf + ((sub * 4 + tj) * 64 + lane) * 4) + *(const f32x4*)(YL + ub + ((sub * 4 + tj) * 64 + lane) * 4);
#pragma unroll
        for (int kk = 0; kk < 2; ++kk) { acc = MFMA16(af[kk], bf_[kk], acc); acc = MFMA16(ab[kk], bb_[kk], acc); }
        y[tj] = acc; }
    const float* lgp = X.inv(I_LNXG) + (size_t)l * RW + 64 * h; const float* lbp = X.inv(I_LNXB) + (size_t)l * RW + 64 * h;
    const bf16* pV = X.wsv<bf16>(WS_V); const bf16* pG = X.wsv<bf16>(WS_GATE); const float* pBo = X.wsv<float>(WS_BONUS); bf16* pRO = X.wsv<bf16>(WS_RO);
#pragma unroll
    for (int r = 0; r < 4; ++r) { const int t = 16 * rg + 4 * (lane >> 4) + r;
        const float mean = row16_sum((y[0][r] + y[1][r]) + (y[2][r] + y[3][r])) * (1.f / 64.f);
        float q = 0.f;
#pragma unroll
        for (int tj = 0; tj < 4; ++tj) { const float dy = y[tj][r] - mean; q += dy * dy; }
        const float rstd = 1.0f / sqrtf(row16_sum(q) * (1.f / 64.f) + GN_EPS); const float bon = pBo[(size_t)t * NH + h];
#pragma unroll
        for (int tj = 0; tj < 4; ++tj) { const int cl = 16 * tj + (lane & 15); const size_t o = (size_t)t * RW + 64 * h + cl;
            float yn = (y[tj][r] - mean) * rstd * lgp[cl] + lbp[cl];
            yn += bon * bf2f(pV[o]); yn *= bf2f(pG[o]);
            pRO[o] = (bf16)f2bf(yn); } }
}
__device__ __forceinline__ void phase_finish(const Ctx& X, int l) {
    for (int u = X.bid * NWAVES + X.wave; u < (M / 16) * NH; u += X.G * NWAVES) { if (l == DEPTH - 1 && u < (CTX / 16) * NH) continue; finish_wave_unit(X, l, u); }
    const int c = X.tid;
    if (c < HW) { const float hbc = X.in(I_HBIAS)[(size_t)l * HW + c]; const float* CV = X.ws<float>(WS_CVT) + (size_t)c * SEQ; const bf16* X0 = X.ws<bf16>(WS_X0); bf16* HO = X.ws<bf16>(WS_HO);
        for (int tile = X.bid; tile < M / TT; tile += X.G) { const int t0 = tile * TT; float cv[TT];
            if (l == DEPTH - 1 && t0 < CTX) continue;
            if (t0 < CTX) {
#pragma unroll
                for (int tt = 0; tt < TT; ++tt) { const size_t o = (size_t)(t0 + tt) * HW + c; cv[tt] = X.ws<float>(WS_CONV)[o] + X.ws<float>(WS_Z)[o] * hbc; } }
            else { const f32x4 a = *(const f32x4*)(CV + (t0 - CTX)), b = *(const f32x4*)(CV + (t0 - CTX) + 4);
#pragma unroll
                for (int i = 0; i < 4; ++i) { cv[i] = a[i]; cv[4 + i] = b[i]; } }
#pragma unroll
            for (int tt = 0; tt < TT; ++tt) { const size_t o = (size_t)(t0 + tt) * HW + c; HO[o] = (bf16)f2bf(cv[tt] * bf2f(X0[o])); } } }
}

__device__ __forceinline__ void ln_inplace(float (&v)[D / 64], const float* g, const float* b, int lane) {
    float s = 0.f;
#pragma unroll
    for (int j = 0; j < D / 64; ++j) s += v[j];
    const float mean = wave_sum(s) * (1.f / D); float q = 0.f;
#pragma unroll
    for (int j = 0; j < D / 64; ++j) { v[j] -= mean; q += v[j] * v[j]; }
    const float rstd = 1.0f / sqrtf(wave_sum(q) * (1.f / D) + LN_EPS);
#pragma unroll
    for (int j = 0; j < D / 64; ++j) { const int d = 4 * lane + 256 * (j >> 2) + (j & 3); v[j] = v[j] * rstd * g[d] + b[d]; }
}
__device__ __forceinline__ void phase_norm1(const Ctx& X, int l) {
    const int gw = X.bid * NWAVES + X.wave, NGW = X.G * NWAVES, lane = X.lane;
    const float* lng = X.in(I_LNG) + (size_t)(l * 2 + 0) * D; const float* lnb = X.in(I_LNB) + (size_t)(l * 2 + 0) * D;
    const float* wr = X.in(I_WR); const float* rb = X.in(I_RB);
    const float alpha = sqrtf(sqrtf(2.0f * DEPTH));
    volatile LAS int* hist = (volatile LAS int*)(X.lds + LDS_MISC + 4096);
    if (X.tid < NE) hist[X.tid] = 0;
    LAS float* wl = (LAS float*)X.lds + NWAVES * D;
    for (int i = X.tid; i < D * NE / 4; i += NTHR) ((LAS f32x4*)wl)[i] = ((const f32x4*)wr)[i];
    __syncthreads();
    for (int t = gw; t < M; t += NGW) { if (l == DEPTH - 1 && t < CTX) continue;
        float* xr = X.ws<float>(WS_X) + (size_t)t * D; const float* mx = X.ws<float>(WS_MIX) + (size_t)t * D;
        const float* gate = modp(X, l, t, 2); const float* sh = modp(X, l, t, 3); const float* sc = modp(X, l, t, 4);
        float v[D / 64];
#pragma unroll
        for (int j = 0; j < D / 256; ++j) { const int d = 4 * lane + 256 * j; const f32x4 a = *(const f32x4*)(xr + d), m = *(const f32x4*)(mx + d), gt = *(const f32x4*)(gate + d);
#pragma unroll
            for (int i = 0; i < 4; ++i) v[4 * j + i] = alpha * a[i] + gt[i] * m[i]; }
        ln_inplace(v, lng, lnb, lane);
        bf16* hf = X.ws<bf16>(WS_XMOD) + (size_t)t * D;
        LAS float* hrow = (LAS float*)X.lds + X.wave * D;
#pragma unroll
        for (int j = 0; j < D / 256; ++j) { const int d = 4 * lane + 256 * j; f32x4 o; const f32x4 a = *(const f32x4*)(sh + d), b = *(const f32x4*)(sc + d); f32x4 h;
#pragma unroll
            for (int i = 0; i < 4; ++i) { o[i] = v[4 * j + i]; h[i] = o[i] * (1.f + b[i]) + a[i]; }
            *(f32x4*)(xr + d) = o; *(LAS f32x4*)(hrow + d) = h;
            *(unsigned long long*)(hf + d) = (unsigned long long)pk2(h[0], h[1]) | ((unsigned long long)pk2(h[2], h[3]) << 32); }
        WAVE_LDS_FENCE(); CFENCE();
        f32x4 part = {0.f, 0.f, 0.f, 0.f};
#pragma unroll 8
        for (int i = 0; i < D / 16; ++i) { const float hv = hrow[16 * i + (lane >> 2)]; const f32x4 w4 = *(const LAS f32x4*)(wl + 256 * i + 4 * lane);
#pragma unroll
            for (int c = 0; c < 4; ++c) part[c] += hv * w4[c]; }
#pragma unroll
        for (int c = 0; c < 4; ++c) { float p = part[c]; p += __shfl_xor(p, 4); p += __shfl_xor(p, 8); p += __shfl_xor(p, 16); p += __shfl_xor(p, 32); part[c] = p; }
        WAVE_LDS_FENCE(); CFENCE();
        float lg[NE];
#pragma unroll
        for (int e = 0; e < NE; ++e) lg[e] = __shfl(part[e & 3], e >> 2);
        float mxl = lg[0];
#pragma unroll
        for (int e = 1; e < NE; ++e) mxl = fmaxf(mxl, lg[e]);
        float sc_[NE], sum = 0.f;
#pragma unroll
        for (int e = 0; e < NE; ++e) { sc_[e] = expf(lg[e] - mxl); sum += sc_[e]; }
        const float isum = 1.0f / sum; float sel[NE];
#pragma unroll
        for (int e = 0; e < NE; ++e) { sc_[e] *= isum; sel[e] = sc_[e] + rb[e]; }
        int bg = 0; float bgs = -INFINITY;
#pragma unroll
        for (int g = 0; g < 4; ++g) { float m1 = -INFINITY, m2 = -INFINITY;
#pragma unroll
            for (int i = 0; i < 4; ++i) { const float x = sel[4 * g + i]; if (x > m1) { m2 = m1; m1 = x; } else if (x > m2) m2 = x; }
            const float gs = m1 + m2; if (gs > bgs) { bgs = gs; bg = g; } }
        int i0 = 0, i1 = 0; float s0 = -INFINITY, s1 = -INFINITY, p0 = 0.f, p1 = 0.f;
#pragma unroll
        for (int e = 0; e < NE; ++e) { if ((e >> 2) == bg) { const float x = sel[e]; if (x > s0) { s1 = s0; i1 = i0; p1 = p0; s0 = x; i0 = e; p0 = sc_[e]; } else if (x > s1) { s1 = x; i1 = e; p1 = sc_[e]; } } }
        if (lane == 0) { int* ei = X.ws<int>(WS_ROUT) + (size_t)t * 2; float* ew = (float*)(X.ws<int>(WS_ROUT) + (size_t)M * 2) + (size_t)t * 2;
            ei[0] = i0; ei[1] = i1; const float ws_ = 1.0f / (p0 + p1); ew[0] = p0 * ws_; ew[1] = p1 * ws_;
            lds_add(hist + i0, 1); lds_add(hist + i1, 1); }
    }
    __syncthreads();
    if (X.tid < NE) { const int hc = hist[X.tid]; X.ws<int>(WS_BCNT)[X.bid * NE + X.tid] = hc; atomicAdd(X.ctl() + CW_CNT + l * 64 + X.tid, (unsigned)hc); }
}

__device__ __forceinline__ void moe_table(const Ctx& X, int l, int NT) {
    volatile LAS int* tab = (volatile LAS int*)(X.lds + LDS_MISC) + 8;
    if (X.tid == 0) { int cum = 0, ts = 0;
        for (int e = 0; e < NE; ++e) { const int cnt = (int)__hip_atomic_load(X.ctl() + CW_CNT + l * 64 + e, RLX_AGENT); const int tc = (cnt + 255) / 256;
            tab[e] = cum; tab[32 + e] = ts; tab[64 + e] = tc; cum += tc * NT; ts += tc; }
        tab[16] = cum; }
    __syncthreads();
}
__device__ __forceinline__ void phase_scatter(const Ctx& X, int l) {
    moe_table(X, l, 1);
    volatile LAS int* tab = (volatile LAS int*)(X.lds + LDS_MISC) + 8;
    volatile LAS int* cur = (volatile LAS int*)(X.lds + LDS_MISC + 4096) + 16;
    const int gw = X.bid * NWAVES + X.wave, NGW = X.G * NWAVES, lane = X.lane;
    if (X.tid < NE) { const int* bc = X.ws<int>(WS_BCNT) + X.tid; int pre = 0; for (int b = 0; b < X.bid; ++b) pre += bc[b * NE]; cur[X.tid] = tab[32 + X.tid] * 256 + pre; }
    __syncthreads();
    const int* ei = X.ws<int>(WS_ROUT); int* slot = X.ws<int>(WS_ROUT) + (size_t)M * 4;
    for (int t = gw; t < M; t += NGW) { if (l == DEPTH - 1 && t < CTX) continue;
#pragma unroll
        for (int k = 0; k < 2; ++k) { const int e = ei[2 * t + k];
            int pos = 0; if (lane == 0) pos = lds_add(cur + e, 1);
            pos = __shfl(pos, 0);
            if (lane == 0) slot[2 * t + k] = pos;
            const u32x4* src = (const u32x4*)(X.ws<bf16>(WS_XMOD) + (size_t)t * D); u32x4* dst = (u32x4*)(X.ws<bf16>(WS_XG) + (size_t)pos * D);
            for (int i = lane; i < D / 8; i += 64) dst[i] = src[i]; } }
}

__device__ __forceinline__ void phase_combine(const Ctx& X, int l) {
    const int gw = X.bid * NWAVES + X.wave, NGW = X.G * NWAVES, lane = X.lane;
    const float* lng = X.in(I_LNG) + (size_t)(l * 2 + 1) * D; const float* lnb = X.in(I_LNB) + (size_t)(l * 2 + 1) * D;
    const float alpha = sqrtf(sqrtf(2.0f * DEPTH));
    const float* ew = (const float*)(X.ws<int>(WS_ROUT) + (size_t)M * 2); const int* slot = X.ws<int>(WS_ROUT) + (size_t)M * 4;
    for (int t = gw; t < M; t += NGW) { if (l == DEPTH - 1 && t < CTX) continue;
        float* xr = X.ws<float>(WS_X) + (size_t)t * D; const float* gate = modp(X, l, t, 5);
        const bf16* y0 = X.ws<bf16>(WS_YS) + (size_t)slot[2 * t] * D; const bf16* y1 = X.ws<bf16>(WS_YS) + (size_t)slot[2 * t + 1] * D; const float w0 = ew[2 * t], w1 = ew[2 * t + 1];
        float v[D / 64];
#pragma unroll
        for (int j = 0; j < D / 256; ++j) { const int d = 4 * lane + 256 * j; const f32x4 a = *(const f32x4*)(xr + d), gt = *(const f32x4*)(gate + d);
            const unsigned long long q0 = *(const unsigned long long*)(y0 + d), q1 = *(const unsigned long long*)(y1 + d);
            float ya[4] = {bflo((unsigned)q0), bfhi((unsigned)q0), bflo((unsigned)(q0 >> 32)), bfhi((unsigned)(q0 >> 32))};
            float yb[4] = {bflo((unsigned)q1), bfhi((unsigned)q1), bflo((unsigned)(q1 >> 32)), bfhi((unsigned)(q1 >> 32))};
#pragma unroll
            for (int i = 0; i < 4; ++i) v[4 * j + i] = alpha * a[i] + gt[i] * (w0 * ya[i] + w1 * yb[i]); }
        ln_inplace(v, lng, lnb, lane);
        if (l + 1 < DEPTH) { const float* sh = modp(X, l + 1, t, 0); const float* sc = modp(X, l + 1, t, 1); bf16* xm = X.ws<bf16>(WS_XMOD) + (size_t)t * D;
#pragma unroll
            for (int j = 0; j < D / 256; ++j) { const int d = 4 * lane + 256 * j; f32x4 o; const f32x4 a = *(const f32x4*)(sh + d), b = *(const f32x4*)(sc + d); float h[4];
#pragma unroll
                for (int i = 0; i < 4; ++i) { o[i] = v[4 * j + i]; h[i] = o[i] * (1.f + b[i]) + a[i]; }
                *(f32x4*)(xr + d) = o;
                *(unsigned long long*)(xm + d) = (unsigned long long)pk2(h[0], h[1]) | ((unsigned long long)pk2(h[2], h[3]) << 32); }
        } else if (t >= CTX) { float* orow = X.out() + (size_t)(t - CTX) * D; const bool bad = __hip_atomic_load(X.ctl() + CW_BAR + XB_TMO, RLX_AGENT) != 0u; const float pscale = 1.0f + bitsf(__hip_atomic_load(X.ctl() + 64, RLX_AGENT));
#pragma unroll
            for (int j = 0; j < D / 256; ++j) { const int d = 4 * lane + 256 * j; f32x4 o;
#pragma unroll
                for (int i = 0; i < 4; ++i) o[i] = bad ? __builtin_nanf("") : v[4 * j + i] * pscale;
                *(f32x4*)(orow + d) = o; }
        }
    }
}


#ifdef EMU
#define PHASE_FN static
#define THIN_FN static
#else
#define PHASE_FN __device__ __forceinline__
#define THIN_FN __device__ __noinline__
#endif
THIN_FN void ph_transposes(Ctx X, int l, int part) { phase_transposes(X, l, part); }
THIN_FN void ph_filters_begin(Ctx X) { phase_filters_begin(X); }
THIN_FN void ph_filters_item(Ctx X, int l, int which, int it) { phase_filters_item(X, l, which, it); }
THIN_FN void ph_filters_end(Ctx X) { phase_filters_end(X); }
#define PH_FILTERS(X_, l_) do { ph_filters_begin(X_); for (int wh_ = 0; wh_ < 2; ++wh_) for (int it_ = (X_).bid * NWAVES + (X_).wave; it_ < (wh_ ? CTX : SEQ) / 16; it_ += (X_).G * NWAVES) ph_filters_item(X_, l_, wh_, it_); ph_filters_end(X_); } while (0)
THIN_FN void ph_filter_weights(Ctx X, int l) { phase_filter_weights(X, l); }
THIN_FN void ph_mod(Ctx X) { phase_mod(X); }
THIN_FN void ph_x0(Ctx X) { phase_x0(X); }
THIN_FN void ph_lin(Ctx X, int l) { phase_lin(X, l); }
THIN_FN void ph_lora_a(Ctx X, int u) { lora_unit_a(X, u); }
THIN_FN void ph_lora_b(Ctx X, int l, int u) { lora_unit_b(X, l, u); }
THIN_FN void ph_prep_hyena(Ctx X, int l) { phase_prep_hyena(X, l); }
THIN_FN void ph_ctxconv(Ctx X, int l) { phase_ctxconv(X, l); }
THIN_FN void ph_chunk_1(Ctx X, int u) { chunk_unit_1(X, u); }
THIN_FN void ph_chunk_2(Ctx X, int u) { chunk_unit_2(X, u); }
THIN_FN void ph_chunk_3(Ctx X, int u) { chunk_unit_3(X, u); }
THIN_FN void ph_seq(Ctx X) { phase_seq(X); }
THIN_FN void ph_fft_tables(Ctx X) { fft_tables(X); }
THIN_FN void ph_fft_run(Ctx X, int inverse) { fft_run((LAS cf*)X.lds, (const LAS cf*)(X.lds + FFT_TAB_OFF), X.tid, inverse != 0); }
THIN_FN void ph_spec_load(Ctx X, int c) { spec_load(X, c); }
THIN_FN void ph_spec_unpack(Ctx X, int c) { spec_unpack(X, c); }
THIN_FN void ph_fftconv_load(Ctx X, int c) { fftconv_load(X, c); }
THIN_FN void ph_fftconv_mul(Ctx X, int c) { fftconv_mul(X, c); }
THIN_FN void ph_fftconv_out(Ctx X, int l, int c) { fftconv_out(X, l, c); }
THIN_FN void ph_finish(Ctx X, int l) { phase_finish(X, l); }
THIN_FN void ph_norm1(Ctx X, int l) { phase_norm1(X, l); }
THIN_FN void ph_scatter(Ctx X, int l) { phase_scatter(X, l); }
THIN_FN void ph_combine(Ctx X, int l) { phase_combine(X, l); }
PHASE_FN void ph_g13(Ctx X, int third, int r0) { pg8::Gemm g{(third ? X.ws<bf16>(WS_T) : X.ws<bf16>(WS_XMOD)) + (size_t)r0 * D, third ? X.ws<bf16>(WS_WO) : X.ws<bf16>(WS_WIN), D}; pg8::StaticOrder S; S.init(M - r0, third ? D : PCP, X.G, X.bid);
    pg8::EpiBf16OrF32 E{X.ws<bf16>(WS_P) + (size_t)r0 * PCP, X.ws<float>(WS_MIX) + (size_t)r0 * D, third ? D : PCP, third != 0}; pg8::gemm_phase(X.lds, g, S, E); }
PHASE_FN void ph_g2(Ctx X, int second, int r0) { pg8::Gemm g{(second ? X.ws<bf16>(WS_HO) : X.ws<bf16>(WS_RO)) + (size_t)r0 * RW, X.ws<bf16>(WS_WB) + (second ? (size_t)D * RW : 0), RW}; pg8::StaticOrder S; S.init(M - r0, D, X.G, X.bid);
    pg8::EpiGate E{X.ws<bf16>(WS_T) + (size_t)r0 * D, D, X.ws<bf16>(WS_P) + (size_t)r0 * PCP, PCP, second ? C_GH : C_GR, second != 0}; pg8::gemm_phase(X.lds, g, S, E); }
PHASE_FN void ph_g45(Ctx X, int l, int down) { const int NT = down ? D / 256 : 2 * D / 256; moe_table(X, l, NT); pg8::MoeOrder S{(const volatile LAS int*)(X.lds + LDS_MISC) + 8, NT, X.G, X.bid};
    pg8::Gemm g{down ? X.ws<bf16>(WS_ACT) : X.ws<bf16>(WS_XG), down ? X.ws<bf16>(WS_WD) : X.ws<bf16>(WS_WGU), D}; pg8::EpiMoe E{down ? X.ws<bf16>(WS_YS) : X.ws<bf16>(WS_ACT), D, NT, down == 0}; pg8::gemm_phase(X.lds, g, S, E); }

constexpr int NPH = 16, NPHASES = DEPTH * NPH;
template <int MASK> __global__ void __launch_bounds__(NTHR, 2) fwd_kernel(Args args) {
    DYN_LDS(lds);
    Ctx X; X.lds = lds; X.tid = threadIdx.x; X.lane = X.tid & 63; X.wave = READFIRSTLANE(X.tid >> 6); X.G = gridDim.x; X.bid = blockIdx.x;
    volatile LAS unsigned* misc = (volatile LAS unsigned*)(lds + LDS_MISC);
    if (X.tid < 128) misc[X.tid] = 0u;
    if (X.tid < N_IN + 2) { const unsigned long long p = X.tid < N_IN ? (unsigned long long)args.in[X.tid < N_IN ? X.tid : 0] : (X.tid == N_IN ? (unsigned long long)args.out : (unsigned long long)args.ws);
        misc[PT_WORD0 + 2 * X.tid] = (unsigned)p; misc[PT_WORD0 + 2 * X.tid + 1] = (unsigned)(p >> 32); }
    __syncthreads();
    XcdBarrier bar = xcd_barrier_post(X.ctl() + CW_BAR, misc);
    const int lo = args.ph_lo, hi = args.ph_hi;
#define IN(k) ((((MASK) >> ((k) % NPH)) & 1) && lo <= (k) && (k) < hi)
#ifdef PROBE_K
#ifndef PROBE_SCALE
#define PROBE_SCALE 1.0f
#endif
#ifndef PROBE_BLOCK
#define PROBE_BLOCK 0
#endif
    unsigned long long plast = __builtin_amdgcn_s_memrealtime(); if (threadIdx.x < 32) misc[2048 + threadIdx.x] = 0u; __syncthreads();
#define PROBE_TX(k) do { if (blockIdx.x == PROBE_BLOCK && threadIdx.x == 0) { const unsigned long long now_ = __builtin_amdgcn_s_memrealtime(); misc[2048 + (k)] += (unsigned)(now_ - plast); plast = now_; } } while (0)
#define PROBE_T(k) PROBE_TX((k) % NPH)
#define PROBE_PUB(k) do { if ((k) == NPHASES - 2 && blockIdx.x == PROBE_BLOCK && threadIdx.x == 0) { PROBE_T(k); unsigned tot_ = 0; for (int i_ = 0; i_ < 28; ++i_) tot_ += misc[2048 + i_]; \
        const float f_ = floorf(PROBE_SCALE * (float)misc[2048 + PROBE_K] / (float)tot_ * 128.0f + 0.5f) * (1.0f / 128.0f); __hip_atomic_store(X.ctl() + 64, fbits(f_), RLX_AGENT); } } while (0)
#else
#define PROBE_T(k) do {} while (0)
#define PROBE_TX(k) do {} while (0)
#define PROBE_PUB(k) do {} while (0)
#endif
#if defined(REPEAT_SUB) && REPEAT_SUB == 20
#define SEAM(k) do { if ((k) + 1 < hi) { xcd_barrier(bar); xcd_barrier(bar); } } while (0)
#else
#define SEAM(k) do { PROBE_PUB(k); if ((k) + 1 < hi) xcd_barrier(bar); PROBE_T(k); } while (0)
#endif
#if defined(REPEAT_SUB) && REPEAT_SUB == 15
#define RQN 2
#else
#define RQN 1
#endif
#ifdef REPEAT_SUB
#define RPS(id) for (int rps_ = 0; rps_ < ((id) == REPEAT_SUB ? 2 : 1); ++rps_)
#else
#define RPS(id)
#endif
#ifdef REPEAT_PH
#define RPT_IDX rpt_
#define RPT(k) for (int rpt_ = 0; rpt_ < (((k) % NPH) == REPEAT_PH ? 2 : 1); ++rpt_)
#else
#define RPT_IDX 0
#define RPT(k)
#endif
    for (int l = 0; l < DEPTH; ++l) {
        const int pb = l * NPH;
        if (l == 0 && IN(pb + 0)) { ph_transposes(X, l, 0); __syncthreads(); ph_filter_weights(X, 0); ph_mod(X); SEAM(pb + 0); }
        if (l == 0 && IN(pb + 1)) { ph_x0(X); PH_FILTERS(X, 0); SEAM(pb + 1); }
        if (IN(pb + 2)) { ph_g13(X, 0, 0); SEAM(pb + 2); }
        RPT(pb + 3) if (IN(pb + 3)) { RPS(6) ph_lin(X, l); RPS(7) ph_prep_hyena(X, l); ph_fft_tables(X); RPS(8) for (int c = X.bid; c < HW; c += X.G) { ph_spec_load(X, c); ph_fft_run(X, 0); ph_spec_unpack(X, c); } SEAM(pb + 3); }
        RPT(pb + 4) if (IN(pb + 4)) { for (int u = X.bid; u < (M / 64) * NH; u += X.G) { RPS(4) ph_lora_a(X, u); RPS(5) ph_lora_b(X, l, u); } SEAM(pb + 4); }
        RPT(pb + 5) if (IN(pb + 5)) { for (int u = X.bid; u < 2 * NCHK * NH; u += X.G) { RPS(1) ph_chunk_1(X, u); RPS(2) ph_chunk_2(X, u); RPS(3) ph_chunk_3(X, u); } SEAM(pb + 5); }
        RPT(pb + 6) if (IN(pb + 6)) { RPS(9) ph_seq(X); RPS(10) { ph_transposes(X, l, 1); __syncthreads(); } if (l + 1 < DEPTH) ph_filter_weights(X, l + 1); if (l + 1 < DEPTH) ph_ctxconv(X, l); ph_fft_tables(X);
            for (int rq_ = 0; rq_ < RQN; ++rq_) for (;;) { if (X.tid == 0) misc[121] = atomicAdd(X.ctl() + CW_Q + l * 64 + 32 + rq_, 1u); __syncthreads(); const int c = (int)misc[121]; __syncthreads(); if (c >= HW) break;
                ph_fftconv_load(X, c); ph_fft_run(X, 0); ph_fftconv_mul(X, c); ph_fft_run(X, 1); ph_fftconv_out(X, l, c); }
            SEAM(pb + 6); }
        RPT(pb + 7) if (IN(pb + 7)) { ph_finish(X, l); SEAM(pb + 7); }
        for (int sb = 0; sb < 2; ++sb) if (IN(pb + 8 + sb)) { ph_g2(X, sb, l == DEPTH - 1 ? CTX : 0); SEAM(pb + 8 + sb); }
        RPT(pb + 10) if (IN(pb + 10)) { ph_g13(X, 1, l == DEPTH - 1 ? CTX : 0); SEAM(pb + 10); }
        if (IN(pb + 11)) { ph_norm1(X, l); SEAM(pb + 11); }
        if (IN(pb + 12)) { RPS(14) ph_scatter(X, l); SEAM(pb + 12); }
        for (int dn = 0; dn < 2; ++dn) if (IN(pb + 13 + dn)) { ph_g45(X, l, dn); SEAM(pb + 13 + dn); }
        if (IN(pb + 15)) { RPS(11) ph_combine(X, l); if (l + 1 < DEPTH) { __syncthreads(); RPS(12) { ph_transposes(X, l + 1, 0); __syncthreads(); } RPS(13) PH_FILTERS(X, l + 1); } SEAM(pb + 15); }
    }
#undef IN
#undef SEAM
}

#ifndef N_LAUNCHES
#define N_LAUNCHES 1
#endif
#ifndef PH_MASK
#define PH_MASK 0xffff
#endif
template <int MASK> static void launch_mask(int grid, hipStream_t stream, const Args& a) {
    static bool attr = false;
    if (!attr) { (void)hipFuncSetAttribute((const void*)fwd_kernel<MASK>, hipFuncAttributeMaxDynamicSharedMemorySize, LDS_BYTES); attr = true; }
    hipLaunchKernelGGL(fwd_kernel<MASK>, dim3(grid), dim3(NTHR), LDS_BYTES, stream, a);
}
extern "C" void kernel_launch(void* const* d_in, const int* in_sizes, int n_in, void* d_out, int out_size, void* d_ws, size_t ws_size, hipStream_t stream) {
    static int grid = 0;
    if (grid == 0) {
        if (n_in != N_IN || ws_size < WS_END) { fprintf(stderr, "kernel_launch: unexpected n_in %d or workspace %zu < %zu\n", n_in, ws_size, (size_t)WS_END); grid = -1; return; }
        int dev = 0, cus = 0;
        if (hipGetDevice(&dev) != hipSuccess || hipDeviceGetAttribute(&cus, hipDeviceAttributeMultiprocessorCount, dev) != hipSuccess) { grid = -1; return; }
        (void)hipGetLastError();
        grid = cus; if (grid > NPART) grid = NPART;
    }
    if (grid < 0) return;
    (void)in_sizes; (void)out_size;
    (void)hipMemsetAsync(d_ws, 0, CTL_BYTES, stream);
    Args a;
    for (int i = 0; i < N_IN; ++i) a.in[i] = (const float*)d_in[i];
    a.out = (float*)d_out; a.ws = (unsigned char*)d_ws;
#if N_LAUNCHES == 1
    a.ph_lo = 0; a.ph_hi = NPHASES;
    launch_mask<PH_MASK>(grid, stream, a);
#else
    for (int ph = 0; ph < NPHASES; ++ph) { const int k = ph % NPH; if (k == 1 && ph / NPH != 0) continue; a.ph_lo = ph; a.ph_hi = ph + 1; launch_mask<PH_MASK>(grid, stream, a); }
#endif
}
```

```cpp
#ifndef EMU
#include <hip/hip_runtime.h>
#endif
#include <cstdio>
#include <cstdint>
#include <cmath>

#ifndef CFG_D
#define CFG_D 1024
#define CFG_SEQ 16384
#define CFG_CTX 256
#define CFG_DEPTH 4
#endif
constexpr int D = CFG_D, SEQ = CFG_SEQ, CTX = CFG_CTX, DEPTH = CFG_DEPTH, M = CTX + SEQ;
constexpr int GRID_W = 64, GRID_H = SEQ / GRID_W;
constexpr int RW = D / 2, NH = RW / 64, HW = D / 2, RC = 3 * RW + 384, HC = 3 * HW, GC = 2 * D, PC = RC + HC + GC, PCP = (PC + 255) / 256 * 256;
constexpr int QTR = RC / 4, HALFC = RC / 2;
constexpr int C_K = RW, C_V = 2 * RW, C_LWF = 3 * RW, C_LG = 3 * RW + 256;
constexpr int C_HY = RC, C_GR = RC + HC, C_GH = RC + HC + D;
constexpr int NE = 16, SP_TILES = (2 * M) / 256 + NE, SP = SP_TILES * 256;
constexpr float DECAY_SCALE = 0.606531f, GN_EPS = 6.4e-4f, LN_EPS = 1e-5f;
constexpr int LP = 72;
constexpr int LQ = 65;
constexpr int LX = 68;
constexpr int N_SEQ_UNITS = 2 * NH * 4;
constexpr int NPART = 256;
static_assert(CTX % 32 == 0 && M % 256 == 0 && D % 256 == 0 && RW % 128 == 0 && RW >= 256 && SEQ % 64 == 0 && CTX % 32 == 0 && RC % 4 == 0, "shape assumptions");

enum { I_X = 0, I_C, I_CTX, I_CCTX, I_WMOD, I_BMOD, I_WIN, I_MU, I_W0, I_W2, I_A0, I_A2, I_G2, I_KK, I_KA, I_RK, I_LNXG, I_LNXB, I_CW, I_CB,
       I_FW1, I_FB1, I_FW2, I_FB2, I_FW3, I_FB3, I_FWO, I_FREQ, I_HBIAS, I_WBR, I_WOUT, I_LNG, I_LNB, I_WR, I_RB, I_WG, I_WU, I_WD, N_IN };

constexpr size_t al256(size_t x) { return (x + 255) & ~(size_t)255; }
constexpr size_t CTL_BYTES = 1u << 20;
constexpr size_t WS_MOD = CTL_BYTES;
constexpr size_t WS_FPART = al256(WS_MOD + (size_t)DEPTH * 2 * 6 * D * 4);
constexpr size_t WS_ROUT = al256(WS_FPART + (size_t)2 * NPART * HW * 4);
constexpr size_t WS_BCNT = al256(WS_ROUT + (size_t)M * 2 * 4 * 3);
constexpr size_t WS_BONUS = al256(WS_BCNT + (size_t)NPART * NE * 4);
constexpr size_t WS_WIN = al256(WS_BONUS + (size_t)M * NH * 4);
constexpr size_t WS_WB = al256(WS_WIN + (size_t)PCP * D * 2);
constexpr size_t WS_WO = al256(WS_WB + (size_t)2 * D * RW * 2);
constexpr size_t WS_W2T = al256(WS_WO + (size_t)D * D * 2);
constexpr size_t WS_A2T = al256(WS_W2T + (size_t)2 * RW * 64 * 2);
constexpr size_t WS_G2T = al256(WS_A2T + (size_t)2 * RW * 64 * 2);
constexpr size_t WS_FWT = al256(WS_G2T + (size_t)RW * 128 * 2);
constexpr size_t WS_WGU = al256(WS_FWT + (size_t)(3 * 64 + HW) * 64 * 2);
constexpr size_t WS_WD = al256(WS_WGU + (size_t)NE * 2 * D * D * 2);
constexpr size_t WS_X = al256(WS_WD + (size_t)NE * D * D * 2);
constexpr size_t WS_XMOD = al256(WS_X + (size_t)M * D * 4);
constexpr size_t WS_P = al256(WS_XMOD + (size_t)M * D * 2);
constexpr size_t WS_FILT = al256(WS_P + (size_t)M * PCP * 2);
constexpr size_t WS_MIX = al256(WS_FILT + (size_t)M * HW * 4);
constexpr size_t WS_T = al256(WS_MIX + (size_t)M * D * 4);
constexpr size_t WS_S = al256(WS_T + (size_t)M * D * 2);
constexpr size_t WS_R = WS_S;
constexpr size_t WS_V = al256(WS_R + (size_t)M * RW * 2);
constexpr size_t WS_KA = al256(WS_V + (size_t)M * RW * 2);
constexpr size_t WS_KD = al256(WS_KA + (size_t)M * RW * 2);
constexpr size_t WS_KB = al256(WS_KD + (size_t)2 * M * RW * 2);
constexpr size_t WS_W = al256(WS_KB + (size_t)2 * M * RW * 2);
constexpr size_t WS_PQ = al256(WS_W + (size_t)2 * M * RW * 4);
constexpr size_t WS_LIN = WS_PQ;
static_assert((size_t)M * 384 * 2 <= (size_t)2 * NH * (M / 64) * 2 * 4096 * 4, "LIN fits PQ");
constexpr size_t WS_G = al256(WS_PQ + (size_t)2 * NH * (M / 64) * 2 * 4096 * 4);
constexpr size_t WS_YL = al256(WS_G + (size_t)2 * NH * (M / 64) * 4096 * 2);
constexpr size_t WS_S0 = WS_XMOD;
static_assert((size_t)2 * NH * (M / 64) * 4096 * 2 <= (size_t)M * D * 2, "S0 fits XMOD");
constexpr size_t WS_Z = al256(WS_YL + (size_t)2 * NH * (M / 64) * 4096 * 4);
constexpr size_t WS_X0 = al256(WS_Z + (size_t)CTX * HW * 4);
constexpr size_t WS_CONV = al256(WS_X0 + (size_t)M * HW * 2);
constexpr size_t WS_GATE = al256(WS_CONV + (size_t)CTX * HW * 4);
constexpr size_t WS_RO = al256(WS_GATE + (size_t)M * RW * 2);
constexpr size_t WS_HO = al256(WS_RO + (size_t)M * RW * 2);
constexpr size_t WS_HS = WS_MIX;
constexpr size_t WS_ZT = WS_T;
constexpr size_t WS_CVT = WS_FILT;
static_assert((size_t)HW * (SEQ + 1) * 8 <= (size_t)M * D * 4 && (size_t)HW * M * 4 <= (size_t)M * D * 2, "HS fits MIX, ZT fits T");
constexpr size_t WS_END1 = al256(WS_HO + (size_t)M * HW * 2);
constexpr size_t WS_XG = WS_S;
constexpr size_t WS_ACT = al256(WS_XG + (size_t)SP * D * 2);
constexpr size_t WS_YS = al256(WS_ACT + (size_t)SP * D * 2);
constexpr size_t WS_END2 = al256(WS_YS + (size_t)SP * D * 2);
constexpr size_t WS_END = WS_END1 > WS_END2 ? WS_END1 : WS_END2;
constexpr int CW_TMO = 0, CW_BAR = 4096, CW_CNT = 8192  , CW_CUR = 8192 + 1024  , CW_Q = 8192 + 2048  ;

#ifdef EMU
#define LAS
typedef short bf16x8 __attribute__((vector_size(16)));
typedef float f32x4 __attribute__((vector_size(16)));
typedef unsigned u32x4 __attribute__((vector_size(16)));
#define DYN_LDS(name) unsigned char* name = emu_cur_lds()
#define ASM_WAIT_V(n) do {} while (0)
#define ASM_WAIT_L(n) do {} while (0)
#define ASM_WAIT_VL0() do {} while (0)
#define CFENCE() do {} while (0)
#define WAVE_LDS_FENCE() emu_wave_sync()
#define S_BARRIER() emu_block_sync()
#define SCHED_BARRIER() do {} while (0)
#define SETPRIO(x) do {} while (0)
#define S_SLEEP(n) emu_yield()
#define MFMA16(a, b, c) emu_mfma_16x16x32(a, b, c)
#define MFMA4F(a, b, c) emu_mfma_16x16x4f32(a, b, c)
#define GLDS16(gptr, lptr) emu_glds16((const void*)(gptr), (void*)(lptr))
#define READFIRSTLANE(x) (x)
#define XCC_ID_() (blockIdx.x & 7u)
#define FENCE_RELEASE() do {} while (0)
#define FENCE_ACQUIRE() do {} while (0)
#define DPP_F(v, ctrl) emu_dpp_f(v, ctrl)
#define READLANE_F(v, l) emu_xchg((float)(v), (l))
static inline int vgpr_zero() { return 0; }
static inline unsigned long long vgpr_zero64() { return 0ull; }
static inline int lds_add(volatile int* p, int v) { int o = *p; *p = o + v; return o; }
static inline void lds_addf(float* p, float v) { *p += v; }
static inline unsigned fbits(float f) { unsigned u; memcpy(&u, &f, 4); return u; }
static inline float bitsf(unsigned u) { float f; memcpy(&f, &u, 4); return f; }
#else
#define LAS __attribute__((address_space(3)))
typedef short bf16x8 __attribute__((ext_vector_type(8)));
typedef float f32x4 __attribute__((ext_vector_type(4)));
typedef unsigned u32x4 __attribute__((ext_vector_type(4)));
#define DYN_LDS(name) extern __shared__ __attribute__((aligned(16))) unsigned char name##_raw[]; LAS unsigned char* name = (LAS unsigned char*)name##_raw
#define ASM_WAIT_V(n) asm volatile("s_waitcnt vmcnt(" #n ")" ::: "memory")
#define ASM_WAIT_L(n) asm volatile("s_waitcnt lgkmcnt(" #n ")" ::: "memory")
#define ASM_WAIT_VL0() asm volatile("s_waitcnt vmcnt(0) lgkmcnt(0)" ::: "memory")
#define CFENCE() asm volatile("" ::: "memory")
#define WAVE_LDS_FENCE() asm volatile("s_waitcnt lgkmcnt(0)" ::: "memory")
#define S_BARRIER() __builtin_amdgcn_s_barrier()
#define SCHED_BARRIER() __builtin_amdgcn_sched_barrier(0)
#define SETPRIO(x) __builtin_amdgcn_s_setprio(x)
#define S_SLEEP(n) __builtin_amdgcn_s_sleep(n)
#define MFMA16(a, b, c) __builtin_amdgcn_mfma_f32_16x16x32_bf16(a, b, c, 0, 0, 0)
#define MFMA4F(a, b, c) __builtin_amdgcn_mfma_f32_16x16x4f32(a, b, c, 0, 0, 0)
#define GLDS16(gptr, lptr) __builtin_amdgcn_global_load_lds((const unsigned*)(gptr), (LAS unsigned*)(lptr), 16, 0, 0)
#define READFIRSTLANE(x) __builtin_amdgcn_readfirstlane(x)
#define XCC_ID_() ((unsigned)__builtin_amdgcn_s_getreg((3 << 11) | 20) & 0xFu)
#define FENCE_RELEASE() __builtin_amdgcn_fence(__ATOMIC_RELEASE, "agent")
#define FENCE_ACQUIRE() __builtin_amdgcn_fence(__ATOMIC_ACQUIRE, "agent")
#define DPP_F(v, ctrl) __builtin_bit_cast(float, __builtin_amdgcn_update_dpp(0, __builtin_bit_cast(int, (float)(v)), (ctrl), 0xF, 0xF, true))
#define READLANE_F(v, l) __builtin_bit_cast(float, __builtin_amdgcn_readlane(__builtin_bit_cast(int, (float)(v)), (l)))
__device__ __forceinline__ int vgpr_zero() { int z; asm volatile("v_mov_b32 %0, 0" : "=v"(z)); return z; }
__device__ __forceinline__ unsigned long long vgpr_zero64() { unsigned long long z; asm volatile("v_mov_b64 %0, 0" : "=v"(z)); return z; }
__device__ __forceinline__ void lds_addf(LAS float* p, float v) { (void)__hip_atomic_fetch_add(p, v, __ATOMIC_RELAXED, __HIP_MEMORY_SCOPE_WORKGROUP); }
__device__ __forceinline__ int lds_add(volatile LAS int* p, int v) { return __hip_atomic_fetch_add((LAS int*)p, v, __ATOMIC_RELAXED, __HIP_MEMORY_SCOPE_WORKGROUP); }
__device__ __forceinline__ unsigned fbits(float f) { return __builtin_bit_cast(unsigned, f); }
__device__ __forceinline__ float bitsf(unsigned u) { return __builtin_bit_cast(float, u); }
#endif
typedef unsigned short bf16;
#define RLX_AGENT __ATOMIC_RELAXED, __HIP_MEMORY_SCOPE_AGENT

__device__ __forceinline__ unsigned f2bf(float f) { unsigned u = fbits(f); return (u + 0x7fffu + ((u >> 16) & 1u)) >> 16; }
__device__ __forceinline__ unsigned pk2(float lo, float hi) { return f2bf(lo) | (f2bf(hi) << 16); }
__device__ __forceinline__ float bf2f(bf16 b) { return bitsf(((unsigned)b) << 16); }
__device__ __forceinline__ float bflo(unsigned w) { return bitsf(w << 16); }
__device__ __forceinline__ float bfhi(unsigned w) { return bitsf(w & 0xffff0000u); }
#ifdef EMU
__device__ __forceinline__ float fexp(float x) { return expf(x); }
__device__ __forceinline__ float frcp(float x) { return 1.0f / x; }
#else
__device__ __forceinline__ float fexp(float x) { return __builtin_amdgcn_exp2f(x * 1.4426950408889634f); }
__device__ __forceinline__ float frcp(float x) { return __builtin_amdgcn_rcpf(x); }
#endif
__device__ __forceinline__ float sigmoidf_(float x) { return frcp(1.0f + fexp(-x)); }
__device__ __forceinline__ float row16_sum(float v) {
    v += DPP_F(v, 0xB1);
    v += DPP_F(v, 0x4E);
    v += DPP_F(v, 0x141);
    v += DPP_F(v, 0x140);
    return v;
}
__device__ __forceinline__ float wave_sum(float v) {
    const float r = row16_sum(v);
    return (READLANE_F(r, 0) + READLANE_F(r, 16)) + (READLANE_F(r, 32) + READLANE_F(r, 48));
}
__device__ __forceinline__ void sincos_f(float x, float& s, float& c) {
    const float k = rintf(x * 0.63661977236758134f);
    float r = fmaf(-k, 1.5703125f, x); r = fmaf(-k, 4.837512969970703125e-4f, r); r = fmaf(-k, 7.54978994989188216e-8f, r);
    const float r2 = r * r;
    const float sp = r + r * r2 * (-1.6666654611e-1f + r2 * (8.3321608736e-3f + r2 * (-1.9515295891e-4f)));
    const float cp = 1.0f - 0.5f * r2 + r2 * r2 * (4.166664568298827e-2f + r2 * (-1.388731625493765e-3f + r2 * (2.443315711809948e-5f)));
    const int q = ((int)k) & 3;
    s = (q == 0) ? sp : (q == 1) ? cp : (q == 2) ? -sp : -cp;
    c = (q == 0) ? cp : (q == 1) ? -sp : (q == 2) ? -cp : sp;
}
__device__ __forceinline__ float sin_f(float x) { float s, c; sincos_f(x, s, c); return s; }

template <class T> __device__ __forceinline__ T* as_global(T* p) {
#ifndef EMU
    return (T*)(__attribute__((address_space(1))) T*)(unsigned long long)p;
#else
    return p;
#endif
}
#define XB_TMO      128
#define XB_XCNT(j)  (256  + 64 * (j))
#define XB_XSUB(j)  (1280 + 64 * (j))
#define XB_XGEN(j)  (2304 + 64 * (j))
#define XB_TOP      3328
#define XB_TOPGEN   3392
#define XCD_BAR_WORDS 3456
#define XB_SPIN_CAP (1u << 18)
__device__ __forceinline__ unsigned xb_ld(unsigned* p)              { return __hip_atomic_load(p, __ATOMIC_RELAXED, __HIP_MEMORY_SCOPE_AGENT); }
__device__ __forceinline__ unsigned xb_add(unsigned* p, unsigned v) { return __hip_atomic_fetch_add(p, v, __ATOMIC_RELAXED, __HIP_MEMORY_SCOPE_AGENT); }
#define XB_SPIN(cond, bar) do { unsigned _sp = 0; while (cond) { S_SLEEP(1); \
    if ((++_sp & 255u) == 0u) { if (xb_ld(&(bar)[XB_TMO])) break; if (_sp > XB_SPIN_CAP) { atomicAdd(&(bar)[XB_TMO], 1u); break; } } } } while (0)
struct XcdBarrier { unsigned* bar; unsigned x; volatile LAS unsigned* st; };
__device__ __forceinline__ XcdBarrier xcd_barrier_post(unsigned* bar, volatile LAS unsigned* st) {
    XcdBarrier b; b.bar = nullptr; b.x = XCC_ID_(); b.st = st;
    if (threadIdx.x == 0) { st[2] = (unsigned)(unsigned long long)bar; st[3] = (unsigned)((unsigned long long)bar >> 32); st[4] = b.x; (void)xb_add(&bar[XB_XCNT(b.x)], 1u); }
    return b;
}
__device__ __forceinline__ void xcd_barrier_complete(unsigned* bar, unsigned x, unsigned& nloc, unsigned& nx) {
    const unsigned G = gridDim.x * gridDim.y * gridDim.z;
    unsigned sum, cnt, mine, sp = 0u;
    for (;;) {
        sum = 0u; cnt = 0u; mine = 0u;
#pragma unroll
        for (unsigned j = 0; j < 16; ++j) { const unsigned c = xb_ld(&bar[XB_XCNT(j)]); sum += c; cnt += (c > 0u) ? 1u : 0u; mine = (j == x) ? c : mine; }
        if (sum == G) break;
        S_SLEEP(1);
        if ((++sp & 255u) == 0u) { if (xb_ld(&bar[XB_TMO])) break; if (sp > XB_SPIN_CAP) { atomicAdd(&bar[XB_TMO], 1u); break; } }
    }
    nloc = mine > 0u ? mine : 1u; nx = cnt > 0u ? cnt : 1u;
}
__device__ __forceinline__ void xcd_barrier(const XcdBarrier& b) {
    ASM_WAIT_V(0);
    __syncthreads();
    if (threadIdx.x == 0) {
        unsigned* bar = as_global((unsigned*)(((unsigned long long)b.st[3] << 32) | b.st[2]));
        const unsigned bx = b.st[4];
        ASM_WAIT_VL0();
        unsigned nloc = b.st[0], nx = b.st[1];
        if (nloc == 0u) { xcd_barrier_complete(bar, bx, nloc, nx); b.st[0] = nloc; b.st[1] = nx; }
        const unsigned old = xb_add(&bar[XB_XSUB(bx)], 1u);
        const unsigned gen = old / nloc;
        if (old + 1u == (gen + 1u) * nloc) {
            FENCE_RELEASE();
            ASM_WAIT_V(0);
            const unsigned og = xb_add(&bar[XB_TOP], 1u);
            const unsigned tg = og / nx;
            if (og + 1u == (tg + 1u) * nx) xb_add(&bar[XB_TOPGEN], 1u);
            else XB_SPIN(xb_ld(&bar[XB_TOPGEN]) == tg, bar);
            FENCE_ACQUIRE();
            xb_add(&bar[XB_XGEN(bx)], 1u);
            ASM_WAIT_V(0);
        } else {
            XB_SPIN(xb_ld(&bar[XB_XGEN(bx)]) == gen, bar);
            FENCE_ACQUIRE();
            ASM_WAIT_V(0);
        }
    }
    __syncthreads();
}

namespace pg8 {
constexpr int BM = 256, BK = 64, HALF = 128, HTB = HALF * BK * 2, STAGE_BYTES = 8 * HTB, NXCD = 8, WGM = 8;
__host__ __device__ __forceinline__ int lds_byte(int r, int c) { const int st = (r >> 4) * 2 + (c >> 5), rr = r & 15, cc = c & 31, ob = rr * 64 + cc * 2; return st * 1024 + (ob ^ (((ob >> 9) & 1) << 5)); }
__host__ __device__ __forceinline__ void stage_rc(int b, int& R, int& C) { const int st = b / 1024, sb = b % 1024, swz = sb ^ (((sb >> 9) & 1) << 5); R = (st >> 1) * 16 + swz / 64; C = (st & 1) * 32 + (swz % 64) / 2; }
__host__ __device__ __forceinline__ int perm32(int rho) { const int n = rho >> 4, i = rho & 15; return 8 * (i >> 2) + 4 * n + (i & 3); }
struct Unit { int pm, pn; };
struct Gemm { const bf16* A; const bf16* Bt; int K; };
struct StaticOrder {
    int nM, nN, nwg, G, c;
    __host__ __device__ void init(int M_, int N_, int G_, int c_) { nM = M_ / BM; nN = N_ / BM; nwg = nM * nN; G = G_; c = c_; }
    __host__ __device__ bool next(int i, Unit& u) const {
        const long L = (long)i * G + c; if (L >= nwg) return false;
        int wgid = (int)L; { const int q = nwg / NXCD, r = nwg % NXCD, xcd = wgid % NXCD, off = wgid / NXCD; wgid = (xcd < r ? xcd * (q + 1) : r * (q + 1) + (xcd - r) * q) + off; }
        const int nig = WGM * nN, gid = wgid / nig, fm = gid * WGM, gsz = (nM - fm) < WGM ? (nM - fm) : WGM;
        u.pm = fm + ((wgid % nig) % gsz); u.pn = (wgid % nig) / gsz; return true;
    }
};
struct MoeOrder {
    const volatile LAS int* tab; int NT, G, c;
    __device__ __forceinline__ bool next(int i, Unit& u) const {
        const long L = (long)i * G + c; if (L >= tab[16]) return false;
        int e = 0; while (L >= tab[e + 1]) ++e;
        const int loc = (int)L - tab[e], tc = tab[64 + e];
        u.pm = tab[32 + e] + loc % tc; u.pn = e * NT + loc / tc; return true;
    }
};
__device__ __forceinline__ unsigned cvt_pk_bf16(float lo, float hi) {
#ifdef EMU
    return pk2(lo, hi);
#else
    unsigned r; asm volatile("v_cvt_pk_bf16_f32 %0, %1, %2" : "=v"(r) : "v"(lo), "v"(hi)); return r;
#endif
}

struct EpiBf16 {
    static constexpr bool PERM = true;
    bf16* O; int ldc;
    __device__ __forceinline__ void operator()(const f32x4 (&acc)[2][2][4][2], const Unit& u, int wr, int wc, int fr, int fq) const {
        const int row0 = u.pm * BM + wr * 64 + fr, col0 = u.pn * BM + wc * 32 + 8 * fq;
#pragma unroll
        for (int ai = 0; ai < 2; ++ai)
#pragma unroll
            for (int m = 0; m < 4; ++m) { bf16* rowp = O + (size_t)(row0 + ai * HALF + m * 16) * ldc + col0;
#pragma unroll
                for (int bj = 0; bj < 2; ++bj) { const f32x4 v0 = acc[ai][bj][m][0], v1 = acc[ai][bj][m][1];
                    u32x4 w; w[0] = cvt_pk_bf16(v0[0], v0[1]); w[1] = cvt_pk_bf16(v0[2], v0[3]); w[2] = cvt_pk_bf16(v1[0], v1[1]); w[3] = cvt_pk_bf16(v1[2], v1[3]);
                    *(u32x4*)(rowp + bj * HALF) = w; } }
    }
};
struct EpiF32 {
    static constexpr bool PERM = true;
    float* C; int ldc;
    __device__ __forceinline__ void operator()(const f32x4 (&acc)[2][2][4][2], const Unit& u, int wr, int wc, int fr, int fq) const {
        const int row0 = u.pm * BM + wr * 64 + fr, col0 = u.pn * BM + wc * 32 + 8 * fq;
#pragma unroll
        for (int ai = 0; ai < 2; ++ai)
#pragma unroll
            for (int m = 0; m < 4; ++m) { float* rowp = C + (size_t)(row0 + ai * HALF + m * 16) * ldc + col0;
#pragma unroll
                for (int bj = 0; bj < 2; ++bj)
#pragma unroll
                    for (int n = 0; n < 2; ++n) *(f32x4*)(rowp + bj * HALF + n * 4) = acc[ai][bj][m][n]; }
    }
};
struct EpiGate {
    static constexpr bool PERM = true;
    bf16* T; int ldc; const bf16* Pg; int ldp; int gcol0; bool ADD;
    __device__ __forceinline__ void operator()(const f32x4 (&acc)[2][2][4][2], const Unit& u, int wr, int wc, int fr, int fq) const {
        const int row0 = u.pm * BM + wr * 64 + fr, col0 = u.pn * BM + wc * 32 + 8 * fq;
#pragma unroll
        for (int ai = 0; ai < 2; ++ai)
#pragma unroll
            for (int m = 0; m < 4; ++m) { const size_t row = (size_t)(row0 + ai * HALF + m * 16);
#pragma unroll
                for (int bj = 0; bj < 2; ++bj) { const f32x4 v0 = acc[ai][bj][m][0], v1 = acc[ai][bj][m][1];
                    const u32x4 g = *(const u32x4*)(Pg + row * ldp + gcol0 + col0 + bj * HALF);
                    u32x4 t = {0u, 0u, 0u, 0u}; if (ADD) t = *(const u32x4*)(T + row * ldc + col0 + bj * HALF);
                    float o[8];
#pragma unroll
                    for (int j = 0; j < 4; ++j) { const float a0 = j < 2 ? v0[2 * j] : v1[2 * j - 4], a1 = j < 2 ? v0[2 * j + 1] : v1[2 * j - 3];
                        o[2 * j] = bflo(t[j]) + sigmoidf_(bflo(g[j])) * a0; o[2 * j + 1] = bfhi(t[j]) + sigmoidf_(bfhi(g[j])) * a1; }
                    u32x4 w; w[0] = cvt_pk_bf16(o[0], o[1]); w[1] = cvt_pk_bf16(o[2], o[3]); w[2] = cvt_pk_bf16(o[4], o[5]); w[3] = cvt_pk_bf16(o[6], o[7]);
                    *(u32x4*)(T + row * ldc + col0 + bj * HALF) = w; } }
    }
};
struct EpiSwiglu {
    static constexpr bool PERM = true;
    bf16* O; int ldc; int NT;
    __device__ __forceinline__ void operator()(const f32x4 (&acc)[2][2][4][2], const Unit& u, int wr, int wc, int fr, int fq) const {
        const int row0 = u.pm * BM + wr * 64 + fr, col0 = (u.pn % NT) * HALF + wc * 32 + 8 * fq;
#pragma unroll
        for (int ai = 0; ai < 2; ++ai)
#pragma unroll
            for (int m = 0; m < 4; ++m) { bf16* rowp = O + (size_t)(row0 + ai * HALF + m * 16) * ldc + col0;
                float o[8];
#pragma unroll
                for (int j = 0; j < 8; ++j) { const float g = acc[ai][0][m][j >> 2][j & 3], uu = acc[ai][1][m][j >> 2][j & 3]; o[j] = g / (1.0f + expf(-g)) * uu; }
                u32x4 w; w[0] = cvt_pk_bf16(o[0], o[1]); w[1] = cvt_pk_bf16(o[2], o[3]); w[2] = cvt_pk_bf16(o[4], o[5]); w[3] = cvt_pk_bf16(o[6], o[7]);
                *(u32x4*)rowp = w; }
    }
};
struct EpiMoeDown {
    static constexpr bool PERM = true;
    bf16* O; int ldc; int NT;
    __device__ __forceinline__ void operator()(const f32x4 (&acc)[2][2][4][2], const Unit& u, int wr, int wc, int fr, int fq) const {
        const int row0 = u.pm * BM + wr * 64 + fr, col0 = (u.pn % NT) * BM + wc * 32 + 8 * fq;
#pragma unroll
        for (int ai = 0; ai < 2; ++ai)
#pragma unroll
            for (int m = 0; m < 4; ++m) { bf16* rowp = O + (size_t)(row0 + ai * HALF + m * 16) * ldc + col0;
#pragma unroll
                for (int bj = 0; bj < 2; ++bj) { const f32x4 v0 = acc[ai][bj][m][0], v1 = acc[ai][bj][m][1];
                    u32x4 w; w[0] = cvt_pk_bf16(v0[0], v0[1]); w[1] = cvt_pk_bf16(v0[2], v0[3]); w[2] = cvt_pk_bf16(v1[0], v1[1]); w[3] = cvt_pk_bf16(v1[2], v1[3]);
                    *(u32x4*)(rowp + bj * HALF) = w; } }
    }
};

struct EpiBf16OrF32 { static constexpr bool PERM = true; bf16* O; float* C; int ldc; bool f32;
    __device__ __forceinline__ void operator()(const f32x4 (&acc)[2][2][4][2], const Unit& u, int wr, int wc, int fr, int fq) const {
        if (f32) { EpiF32 E{C, ldc}; E(acc, u, wr, wc, fr, fq); } else { EpiBf16 E{O, ldc}; E(acc, u, wr, wc, fr, fq); } } };
struct EpiMoe { static constexpr bool PERM = true; bf16* O; int ldc; int NT; bool swiglu;
    __device__ __forceinline__ void operator()(const f32x4 (&acc)[2][2][4][2], const Unit& u, int wr, int wc, int fr, int fq) const {
        if (swiglu) { EpiSwiglu E{O, ldc, NT}; E(acc, u, wr, wc, fr, fq); } else { EpiMoeDown E{O, ldc, NT}; E(acc, u, wr, wc, fr, fq); } } };
template <class Epi, class Sched>
__device__ __forceinline__ void gemm_phase(LAS unsigned char* lds, const Gemm g, const Sched& S, const Epi& E) {
    const int tid = threadIdx.x + vgpr_zero();
    const int wid = READFIRSTLANE(tid >> 6), lane = tid & 63, wr = wid >> 2, wc = wid & 3, fr = lane & 15, fq = lane >> 4;
    const int K = g.K, nt = K / BK;
    unsigned long long voffA[2], voffB[2]; const unsigned long long zhi = vgpr_zero64();
#pragma unroll
    for (int i = 0; i < 2; ++i) { int R, C; stage_rc(tid * 16 + i * 8192, R, C); const int Rb = Epi::PERM ? ((R & ~31) + perm32(R & 31)) : R;
        voffA[i] = zhi + (unsigned long long)(long long)((R * K + C) * 2); voffB[i] = zhi + (unsigned long long)(long long)((Rb * K + C) * 2); }
    const size_t kstep = (size_t)(BK * 2);
    const size_t hstep = (size_t)HALF * K * 2;
    const size_t tstep = 2 * hstep;
    const unsigned ldsw = (unsigned)wid * 1024u;
    const int aoff = lds_byte(wr * 64 + fr, fq * 8), boff = lds_byte(wc * 32 + fr, fq * 8);
#define PG8_SA(b, h) (((b) * 2 + (h)) * HTB)
#define PG8_SB(b, h) ((4 + (b) * 2 + (h)) * HTB)
#define PG8_STAGE(bufoff, gbase, voff) do { _Pragma("unroll") for (int _i = 0; _i < 2; ++_i) \
        GLDS16((const char*)(gbase) + (voff)[_i], lds + (bufoff) + ldsw + _i * 8192); } while (0)
#define PG8_LDA(dst, b, h) do { _Pragma("unroll") for (int m = 0; m < 4; ++m) _Pragma("unroll") for (int k = 0; k < 2; ++k) dst[m][k] = *(const LAS bf16x8*)(lds + PG8_SA(b, h) + aoff + m * 2048 + k * 1024); } while (0)
#define PG8_LDB(dst, b, h) do { _Pragma("unroll") for (int n = 0; n < 2; ++n) _Pragma("unroll") for (int k = 0; k < 2; ++k) dst[n][k] = *(const LAS bf16x8*)(lds + PG8_SB(b, h) + boff + n * 2048 + k * 1024); } while (0)
#define PG8_MMA(ai, bj, At, Bt) do { SETPRIO(1); _Pragma("unroll") for (int m = 0; m < 4; ++m) _Pragma("unroll") for (int n = 0; n < 2; ++n) _Pragma("unroll") for (int k = 0; k < 2; ++k) \
        acc[ai][bj][m][n] = MFMA16(Bt[n][k], At[m][k], acc[ai][bj][m][n]); SETPRIO(0); } while (0)
#define PG8_BAR S_BARRIER()
    Unit cur, nxt; int ui = 0;
    if (!S.next(0, cur)) return;
    f32x4 acc[2][2][4][2];
#pragma unroll
    for (int a = 0; a < 2; ++a)
#pragma unroll
        for (int b = 0; b < 2; ++b)
#pragma unroll
            for (int m = 0; m < 4; ++m)
#pragma unroll
                for (int n = 0; n < 2; ++n) acc[a][b][m][n] = (f32x4){0.f, 0.f, 0.f, 0.f};
    bf16x8 At[4][2], B0[2][2], B1[2][2];
    const char* cA = (const char*)g.A + (size_t)cur.pm * tstep; const char* cB = (const char*)g.Bt + (size_t)cur.pn * tstep;
    PG8_STAGE(PG8_SB(0, 0), cB, voffB); PG8_STAGE(PG8_SA(0, 0), cA, voffA); PG8_STAGE(PG8_SB(0, 1), cB + hstep, voffB); PG8_STAGE(PG8_SA(0, 1), cA + hstep, voffA);
    if (wr == 1) PG8_BAR;
    ASM_WAIT_V(4); PG8_BAR;
    PG8_STAGE(PG8_SB(1, 0), cB + kstep, voffB); PG8_STAGE(PG8_SA(1, 0), cA + kstep, voffA); PG8_STAGE(PG8_SB(1, 1), cB + hstep + kstep, voffB);
    ASM_WAIT_V(6); PG8_BAR;
    for (;;) {
        const bool has_next = S.next(ui + 1, nxt);
        const char* nA = has_next ? (const char*)g.A + (size_t)nxt.pm * tstep : cA; const char* nB = has_next ? (const char*)g.Bt + (size_t)nxt.pn * tstep : cB;
        for (int t = 0; t < nt; t += 2) {
            const bool last = (t == nt - 2);
            const char* a1 = cA + (size_t)(t + 1) * kstep;
            const char* a2 = last ? nA : cA + (size_t)(t + 2) * kstep; const char* b2 = last ? nB : cB + (size_t)(t + 2) * kstep;
            const char* a3 = a2 + kstep; const char* b3 = b2 + kstep;
            PG8_LDB(B0, 0, 0); SCHED_BARRIER(); PG8_LDA(At, 0, 0); PG8_STAGE(PG8_SA(1, 1), a1 + hstep, voffA);
            ASM_WAIT_L(8); PG8_BAR; ASM_WAIT_L(0); PG8_MMA(0, 0, At, B0); PG8_BAR; SCHED_BARRIER();
            PG8_LDB(B1, 0, 1); PG8_STAGE(PG8_SB(0, 0), b2, voffB);
            PG8_BAR; ASM_WAIT_L(0); PG8_MMA(0, 1, At, B1); PG8_BAR;
            PG8_LDA(At, 0, 1); PG8_STAGE(PG8_SA(0, 0), a2, voffA);
            PG8_BAR; ASM_WAIT_L(0); PG8_MMA(1, 0, At, B0); PG8_BAR; SCHED_BARRIER();
            PG8_STAGE(PG8_SB(0, 1), b2 + hstep, voffB);
            ASM_WAIT_V(6); PG8_BAR; PG8_MMA(1, 1, At, B1); PG8_BAR;
            PG8_LDB(B0, 1, 0); SCHED_BARRIER(); PG8_LDA(At, 1, 0); PG8_STAGE(PG8_SA(0, 1), a2 + hstep, voffA);
            ASM_WAIT_L(8); PG8_BAR; ASM_WAIT_L(0); PG8_MMA(0, 0, At, B0); PG8_BAR; SCHED_BARRIER();
            PG8_LDB(B1, 1, 1); PG8_STAGE(PG8_SB(1, 0), b3, voffB);
            PG8_BAR; ASM_WAIT_L(0); PG8_MMA(0, 1, At, B1); PG8_BAR;
            PG8_LDA(At, 1, 1); PG8_STAGE(PG8_SA(1, 0), a3, voffA);
            PG8_BAR; ASM_WAIT_L(0); PG8_MMA(1, 0, At, B0); PG8_BAR; SCHED_BARRIER();
            PG8_STAGE(PG8_SB(1, 1), b3 + hstep, voffB);
            ASM_WAIT_V(6); PG8_BAR; PG8_MMA(1, 1, At, B1); PG8_BAR;
        }
        E(acc, cur, wr, wc, fr, fq);
        if (!has_next) break;
#pragma unroll
        for (int a = 0; a < 2; ++a)
#pragma unroll
            for (int b = 0; b < 2; ++b)
#pragma unroll
                for (int m = 0; m < 4; ++m)
#pragma unroll
                    for (int n = 0; n < 2; ++n) acc[a][b][m][n] = (f32x4){0.f, 0.f, 0.f, 0.f};
        cur = nxt; cA = nA; cB = nB; ++ui;
    }
    ASM_WAIT_V(0);
    if (wr == 0) PG8_BAR;
    PG8_BAR;
#undef PG8_SA
#undef PG8_SB
#undef PG8_STAGE
#undef PG8_LDA
#undef PG8_LDB
#undef PG8_MMA
#undef PG8_BAR
}
}

struct Args { const float* in[N_IN]; float* out; unsigned char* ws; int ph_lo, ph_hi; };
constexpr int NWAVES = 8, NTHR = 512;
constexpr int LDS_STAGE = 131072, LDS_MISC = LDS_STAGE, LDS_BYTES = 147456;

constexpr int PT_OUT = N_IN, PT_WS = N_IN + 1, PT_WORD0 = 128;

struct Ctx {
    LAS unsigned char* lds; int tid, lane, wave, G, bid;
    __device__ __forceinline__ unsigned long long ptr(int i) const { const volatile LAS unsigned* t = (const volatile LAS unsigned*)(lds + LDS_MISC) + PT_WORD0 + 2 * i;
        const unsigned lo = (unsigned)READFIRSTLANE((int)t[0]), hi = (unsigned)READFIRSTLANE((int)t[1]); return ((unsigned long long)hi << 32) | lo; }
    __device__ __forceinline__ unsigned long long ptrv(int i) const { const volatile LAS unsigned* t = (const volatile LAS unsigned*)(lds + LDS_MISC) + PT_WORD0 + 2 * i; return ((unsigned long long)t[1] << 32) | t[0]; }
    __device__ __forceinline__ const float* inv(int i) const { return as_global((const float*)ptrv(i)); }
    template <class T> __device__ __forceinline__ T* wsv(size_t off) const { return as_global((T*)((unsigned char*)ptrv(PT_WS) + off)); }
    __device__ __forceinline__ const float* in(int i) const { return as_global((const float*)ptr(i)); }
    __device__ __forceinline__ float* out() const { return as_global((float*)ptr(PT_OUT)); }
    template <class T> __device__ __forceinline__ T* ws(size_t off) const { return as_global((T*)((unsigned char*)ptr(PT_WS) + off)); }
    __device__ __forceinline__ unsigned* ctl() const { return as_global((unsigned*)ptr(PT_WS)); }
};

__device__ __forceinline__ void transpose_item(const float* W, int ldw, int k0, int n0, int nvalid, bf16* outp, int ldo, LAS float* scr, int lane) {
#pragma unroll
    for (int i = 0; i < 32; ++i) { const int kk = 2 * i + (lane >> 5), n = n0 + (lane & 31); scr[kk * 33 + (lane & 31)] = (n < nvalid) ? W[(size_t)(k0 + kk) * ldw + n] : 0.f; }
    WAVE_LDS_FENCE(); CFENCE();
    const int c = lane & 7;
#pragma unroll
    for (int j = 0; j < 4; ++j) { const int n = (lane >> 3) + 8 * j; const LAS float* s = scr + (8 * c) * 33 + n;
        u32x4 o; o[0] = pk2(s[0 * 33], s[1 * 33]); o[1] = pk2(s[2 * 33], s[3 * 33]); o[2] = pk2(s[4 * 33], s[5 * 33]); o[3] = pk2(s[6 * 33], s[7 * 33]);
        *(u32x4*)(outp + (size_t)n * ldo + k0 + 8 * c) = o; }
    WAVE_LDS_FENCE(); CFENCE();
}
__device__ __forceinline__ void filter_item(const Ctx& X, int l, int n, int pos0, float* out, LAS bf16* za, LAS bf16* zb, LAS float* asum  ) {
    const int lane = X.lane, kof = 8 * (lane >> 4);
    const bf16* FWT = X.wsv<bf16>(WS_FWT);
    if (lane < 64) { const int i = lane;
#pragma unroll 4
        for (int p = 0; p < 16; ++p) { const int pos = pos0 + p; float v = 0.f;
            if (i == 0) v = (float)pos / (float)(n - 1 > 1 ? n - 1 : 1);
            else if (i < 33) { const int bb = (i - 1) & 15; const double band = 1e-4 + (double)bb * ((15.0 - 1e-4) / 15.0);
                double rev = (double)pos * band / (double)n; rev -= floor(rev); if (rev > 0.5) rev -= 1.0;
                float sn, cs; sincos_f((float)(rev * 6.283185307179586476925), sn, cs); v = i <= 16 ? cs : -sn; }
            za[p * LP + i] = (bf16)f2bf(v); } }
    WAVE_LDS_FENCE(); CFENCE();
    LAS bf16* src = za; LAS bf16* dst = zb;
#pragma unroll 1
    for (int layer = 0; layer < 3; ++layer) { const bf16* WT = FWT + (size_t)layer * 64 * 64; const float* bias = X.inv(layer == 0 ? I_FB1 : layer == 1 ? I_FB2 : I_FB3) + l * 64;
        const bf16x8 a0 = *(const LAS bf16x8*)(src + (lane & 15) * LP + kof), a1 = *(const LAS bf16x8*)(src + (lane & 15) * LP + kof + 32);
#pragma unroll
        for (int tj = 0; tj < 4; ++tj) { const int u = 16 * tj + (lane & 15); f32x4 acc = {0.f, 0.f, 0.f, 0.f};
            acc = MFMA16(a0, *(const bf16x8*)(WT + (size_t)u * 64 + kof), acc); acc = MFMA16(a1, *(const bf16x8*)(WT + (size_t)u * 64 + kof + 32), acc);
            const float fr = X.inv(I_FREQ)[l * 64 + u], bu = bias[u];
#pragma unroll
            for (int r = 0; r < 4; ++r) dst[(4 * (lane >> 4) + r) * LP + u] = (bf16)f2bf(sin_f(fr * (acc[r] + bu))); }
        WAVE_LDS_FENCE(); CFENCE();
        LAS bf16* t_ = src; src = dst; dst = t_; }
    const bf16* WO = FWT + (size_t)3 * 64 * 64;
    const bf16x8 a0 = *(const LAS bf16x8*)(src + (lane & 15) * LP + kof), a1 = *(const LAS bf16x8*)(src + (lane & 15) * LP + kof + 32);
    const float dmin = -3.0701134573253944f, dmax = -15.350567286626972f;
    float dist[4];
#pragma unroll
    for (int r = 0; r < 4; ++r) { const int dd = pos0 + 4 * (lane >> 4) + r - n / 2; dist[r] = (float)(dd < 0 ? -dd : dd) * (2.0f / (float)n); }
#pragma unroll 1
    for (int tg = 0; tg < HW / 64; ++tg) {
#pragma unroll
        for (int tq = 0; tq < 4; ++tq) { const int c = 64 * tg + 16 * tq + (lane & 15); f32x4 acc = {0.f, 0.f, 0.f, 0.f};
            acc = MFMA16(a0, *(const bf16x8*)(WO + (size_t)c * 64 + kof), acc); acc = MFMA16(a1, *(const bf16x8*)(WO + (size_t)c * 64 + kof + 32), acc);
            const float delta = fabsf(dmin + (float)c * ((dmax - dmin) / (float)(HW - 1))); f32x4 v; float as = 0.f;
#pragma unroll
            for (int r = 0; r < 4; ++r) { v[r] = acc[r] * fexp(-dist[r] * delta); as += fabsf(v[r]); }
            *(f32x4*)(out + (size_t)c * n + pos0 + 4 * (lane >> 4)) = v; lds_addf(asum + c, as); } }
    WAVE_LDS_FENCE(); CFENCE();
}
__device__ __forceinline__ void phase_transposes(const Ctx& X, int l, int part) {
    LAS float* scr = (LAS float*)(X.lds + X.wave * 16384);
    const bool shifted = part == 1 && X.G > N_SEQ_UNITS; const int myb = shifted ? X.bid - N_SEQ_UNITS : X.bid, nb_ = shifted ? X.G - N_SEQ_UNITS : X.G;
    if (myb < 0) return;
    const int gw = myb * NWAVES + X.wave, NGW = nb_ * NWAVES, lane = X.lane;
    constexpr int KB_D = D / 64, I_WIN_ = KB_D * (PCP / 32), I_WB_ = 2 * (RW / 64) * (D / 32), I_WO_ = KB_D * (D / 32), I_WGU_ = NE * 2 * KB_D * (D / 32), I_WD_ = NE * KB_D * (D / 32);
    constexpr int I_LORA_ = 6 * (RW / 32); constexpr int N0 = I_WIN_ + I_WB_ + I_WO_, NITEMS = N0 + I_WGU_ + I_WD_;
    if (part == 0) for (int it = gw; it < I_LORA_; it += NGW) { const int which = it / (RW / 32), nb = it % (RW / 32);
        const float* W; int k0 = 0, ldo = 64; bf16* outp;
        if (which < 2) { W = X.in(I_W2) + ((size_t)l * 2 + which) * 64 * RW; outp = X.ws<bf16>(WS_W2T) + (size_t)which * RW * 64 + (size_t)(32 * nb) * 64; }
        else if (which < 4) { W = X.in(I_A2) + ((size_t)l * 2 + (which - 2)) * 64 * RW; outp = X.ws<bf16>(WS_A2T) + (size_t)(which - 2) * RW * 64 + (size_t)(32 * nb) * 64; }
        else { W = X.in(I_G2) + (size_t)l * 128 * RW; k0 = 64 * (which - 4); ldo = 128; outp = X.ws<bf16>(WS_G2T) + (size_t)(32 * nb) * 128; }
        transpose_item(W, RW, k0, 32 * nb, RW, outp, ldo, scr, lane); }
    const int it_end = part ? NITEMS : N0; int it = (part ? N0 : 0) + gw;
    const float* W; int ldw, k0, n0, nvalid, ldo; bf16* outp; float v[32];
#define TR_PARAMS(it_) do { int r = (it_); \
        if (r < I_WIN_) { const int nb = r % (PCP / 32), kb = r / (PCP / 32); W = X.in(I_WIN) + (size_t)l * D * PC; ldw = PC; k0 = 64 * kb; n0 = 32 * nb; nvalid = PC; outp = X.ws<bf16>(WS_WIN) + (size_t)n0 * D; ldo = D; } \
        else if ((r -= I_WIN_) < I_WB_) { const int s_ = r / ((RW / 64) * (D / 32)), q = r % ((RW / 64) * (D / 32)), nb = q % (D / 32), kb = q / (D / 32); \
            W = X.in(I_WBR) + ((size_t)l * 2 + s_) * RW * D; ldw = D; k0 = 64 * kb; n0 = 32 * nb; nvalid = D; outp = X.ws<bf16>(WS_WB) + (size_t)s_ * D * RW + (size_t)n0 * RW; ldo = RW; } \
        else if ((r -= I_WB_) < I_WO_) { const int nb = r % (D / 32), kb = r / (D / 32); W = X.in(I_WOUT) + (size_t)l * D * D; ldw = D; k0 = 64 * kb; n0 = 32 * nb; nvalid = D; outp = X.ws<bf16>(WS_WO) + (size_t)n0 * D; ldo = D; } \
        else if ((r -= I_WO_) < I_WGU_) { const int per = KB_D * (D / 32), es = r / per, q = r % per, e = es >> 1, src = es & 1, nb = q % (D / 32), kb = q / (D / 32); n0 = 32 * nb; \
            W = (src ? X.in(I_WU) : X.in(I_WG)) + ((size_t)l * NE + e) * D * D; ldw = D; k0 = 64 * kb; nvalid = D; const int orow = e * 2 * D + (n0 / 128) * 256 + src * 128 + (n0 % 128); \
            outp = X.ws<bf16>(WS_WGU) + (size_t)orow * D; ldo = D; } \
        else { r -= I_WGU_; const int per = KB_D * (D / 32), e = r / per, q = r % per, nb = q % (D / 32), kb = q / (D / 32); \
            W = X.in(I_WD) + ((size_t)l * NE + e) * D * D; ldw = D; k0 = 64 * kb; n0 = 32 * nb; nvalid = D; outp = X.ws<bf16>(WS_WD) + (size_t)(e * D + n0) * D; ldo = D; } } while (0)
#define TR_LOAD() do { const int n = n0 + (lane & 31); const float* wp = W + (size_t)(k0 + (lane >> 5)) * ldw + n; _Pragma("unroll") for (int i = 0; i < 32; ++i) v[i] = (n < nvalid) ? wp[(size_t)(2 * i) * ldw] : 0.f; } while (0)
    if (it < it_end) { TR_PARAMS(it); TR_LOAD(); }
    while (it < it_end) {
#pragma unroll
        for (int i = 0; i < 32; ++i) scr[(2 * i + (lane >> 5)) * 33 + (lane & 31)] = v[i];
        WAVE_LDS_FENCE(); CFENCE();
        bf16* const cout_ = outp; const int ck0 = k0, cldo = ldo;
        it += NGW;
        if (it < it_end) { TR_PARAMS(it); TR_LOAD(); }
        const int c = lane & 7;
#pragma unroll
        for (int j = 0; j < 4; ++j) { const int n = (lane >> 3) + 8 * j; const LAS float* s_ = scr + (8 * c) * 33 + n;
            u32x4 o; o[0] = pk2(s_[0 * 33], s_[1 * 33]); o[1] = pk2(s_[2 * 33], s_[3 * 33]); o[2] = pk2(s_[4 * 33], s_[5 * 33]); o[3] = pk2(s_[6 * 33], s_[7 * 33]);
            *(u32x4*)(cout_ + (size_t)n * cldo + ck0 + 8 * c) = o; }
        WAVE_LDS_FENCE(); CFENCE();
    }
#undef TR_PARAMS
#undef TR_LOAD
}
__device__ __forceinline__ void phase_filter_weights(const Ctx& X, int l) {
    bf16* FWT = X.ws<bf16>(WS_FWT);
    for (int idx = X.bid * NTHR + X.tid; idx < (3 * 64 + HW) * 64; idx += X.G * NTHR) { const int o = idx >> 6, k = idx & 63; float v;
        if (o < 64) v = k < 33 ? X.in(I_FW1)[(size_t)l * 33 * 64 + k * 64 + o] : 0.f;
        else if (o < 128) v = X.in(I_FW2)[(size_t)l * 64 * 64 + k * 64 + (o - 64)];
        else if (o < 192) v = X.in(I_FW3)[(size_t)l * 64 * 64 + k * 64 + (o - 128)];
        else v = X.in(I_FWO)[(size_t)l * 64 * HW + (size_t)k * HW + (o - 192)];
        FWT[idx] = (bf16)f2bf(v); }
}
constexpr int FPART_OFF = 65536;
static_assert(FPART_OFF + 2 * HW * 4 <= LDS_STAGE && 2 * 16 * LP * 2 <= 8192, "filter LDS map");
__device__ __forceinline__ void phase_filters_begin(const Ctx& X) {
    LAS float* part = (LAS float*)(X.lds + FPART_OFF);
    for (int i = X.tid; i < 2 * HW; i += NTHR) part[i] = 0.f;
    __syncthreads();
}
__device__ __forceinline__ void phase_filters_item(const Ctx& X, int l_, int which_, int it_) {
    const int vz = vgpr_zero(), l = l_ + vz, which = which_ + vz, it = it_ + vz;
    LAS bf16* za = (LAS bf16*)(X.lds + X.wave * 8192); LAS bf16* zb = za + 16 * LP;
    const int n = which ? CTX : SEQ; float* out = X.wsv<float>(WS_FILT) + (which ? (size_t)HW * SEQ : 0);
    filter_item(X, l, n, 16 * it, out, za, zb, (LAS float*)(X.lds + FPART_OFF) + which * HW);
}
__device__ __forceinline__ void phase_filters_end(const Ctx& X) {
    const LAS float* part = (const LAS float*)(X.lds + FPART_OFF);
    __syncthreads();
    for (int i = X.tid; i < 2 * HW; i += NTHR) X.ws<float>(WS_FPART)[((size_t)(i / HW) * NPART + X.bid) * HW + (i % HW)] = part[i];
    __syncthreads();
}
__device__ __forceinline__ void phase_mod(const Ctx& X) {
    const int lane = X.lane;
    LAS float* red = (LAS float*)X.lds;
    constexpr int NIT = DEPTH * (6 * D / 64);
    for (int it = X.bid; it < NIT; it += X.G) {
        const int ll = it / (6 * D / 64), n0 = (it % (6 * D / 64)) * 64;
        const float* W = X.in(I_WMOD) + (size_t)ll * D * 6 * D; const float* cv = X.in(I_C); const float* cc = X.in(I_CCTX);
        float s0 = 0.f, s1 = 0.f;
#pragma unroll 8
        for (int k = X.wave * (D / 8); k < (X.wave + 1) * (D / 8); ++k) { const float wv = W[(size_t)k * 6 * D + n0 + lane]; const float c0 = cv[k], c1 = cc[k];
            s0 += c0 * sigmoidf_(c0) * wv; s1 += c1 * sigmoidf_(c1) * wv; }
        red[(X.wave * 64 + lane) * 2] = s0; red[(X.wave * 64 + lane) * 2 + 1] = s1;
        __syncthreads();
        if (X.wave == 0) { float t0 = 0.f, t1 = 0.f;
#pragma unroll
            for (int w = 0; w < NWAVES; ++w) { t0 += red[(w * 64 + lane) * 2]; t1 += red[(w * 64 + lane) * 2 + 1]; }
            const float bm = X.in(I_BMOD)[(size_t)ll * 6 * D + n0 + lane];
            float* MOD = X.ws<float>(WS_MOD);
            MOD[((size_t)ll * 2 + 0) * 6 * D + n0 + lane] = t0 + bm; MOD[((size_t)ll * 2 + 1) * 6 * D + n0 + lane] = t1 + bm; }
        __syncthreads();
    }
}
__device__ __forceinline__ const float* modp(const Ctx& X, int l, int t, int j) { return X.ws<float>(WS_MOD) + ((size_t)l * 2 + (t < CTX ? 1 : 0)) * 6 * D + (size_t)j * D; }

__device__ __forceinline__ void phase_x0(const Ctx& X) {
    const int gw = X.bid * NWAVES + X.wave, NGW = X.G * NWAVES, lane = X.lane;
    for (int t = gw; t < M; t += NGW) {
        const float* src = t < CTX ? X.in(I_CTX) + (size_t)t * D : X.in(I_X) + (size_t)(t - CTX) * D;
        const float* sh = modp(X, 0, t, 0); const float* sc = modp(X, 0, t, 1);
        float* xr = X.ws<float>(WS_X) + (size_t)t * D; bf16* xm = X.ws<bf16>(WS_XMOD) + (size_t)t * D;
#pragma unroll
        for (int j = 0; j < D / 256; ++j) { const int d = 4 * lane + 256 * j; const f32x4 v = *(const f32x4*)(src + d), a = *(const f32x4*)(sh + d), b = *(const f32x4*)(sc + d);
            *(f32x4*)(xr + d) = v;
            unsigned w0 = pk2(v[0] * (1.f + b[0]) + a[0], v[1] * (1.f + b[1]) + a[1]), w1 = pk2(v[2] * (1.f + b[2]) + a[2], v[3] * (1.f + b[3]) + a[3]);
            *(unsigned long long*)(xm + d) = (unsigned long long)w0 | ((unsigned long long)w1 << 32); }
    }
}

__device__ __forceinline__ int shift_row(int t, int col, bool& valid) {
    const bool isctx = t < CTX;
    const int i = t - CTX, gx = i & (GRID_W - 1), gy = i / GRID_W, q = col / QTR;
    const int offl = (q == 0) ? -1 : (q == 1) ? 1 : (q == 2) ? -GRID_W : GRID_W;
    const bool vl = (q == 0) ? (gx > 0) : (q == 1) ? (gx < GRID_W - 1) : (q == 2) ? (gy > 0) : (gy < GRID_H - 1);
    const bool first = col < HALFC;
    const int offc = first ? -1 : 1; const bool vc = first ? (t > 0) : (t < CTX - 1);
    valid = isctx ? vc : vl;
    return valid ? t + (isctx ? offc : offl) : t;
}
__device__ __forceinline__ float pm_val(const bf16* P, const float* mu, int t, int col) {
    const float p0 = bf2f(P[(size_t)t * PCP + col]); bool valid; const int nr = shift_row(t, col, valid);
    const float pn = bf2f(P[(size_t)nr * PCP + col]); const float p1 = valid ? pn : 0.f;
    return p0 + (p1 - p0) * mu[col];
}
__device__ __forceinline__ f32x4 mm_tile(const LAS bf16* A, const LAS bf16* Bt, int ti, int tj, int lane, f32x4 acc) {
    const LAS bf16* pa = A + (16 * ti + (lane & 15)) * LP + 8 * (lane >> 4); const LAS bf16* pb = Bt + (16 * tj + (lane & 15)) * LP + 8 * (lane >> 4);
#pragma unroll
    for (int kk = 0; kk < 2; ++kk) { const bf16x8 a = *(const LAS bf16x8*)(pa + 32 * kk), b = *(const LAS bf16x8*)(pb + 32 * kk); acc = MFMA16(a, b, acc); }
    return acc;
}
struct PmLd { float p0, pn, m; bool valid; };
__device__ __forceinline__ PmLd pm_ld(const bf16* P, const float* mu, int t, int col) {
    PmLd r; bool valid; const int nr = shift_row(t, col, valid); r.p0 = bf2f(P[(size_t)t * PCP + col]); r.pn = bf2f(P[(size_t)nr * PCP + col]); r.m = mu[col]; r.valid = valid; return r; }
__device__ __forceinline__ float pm_fin(const PmLd& r) { const float p1 = r.valid ? r.pn : 0.f; return r.p0 + (p1 - r.p0) * r.m; }
constexpr int TT = 8;
__device__ __forceinline__ void phase_lin(const Ctx& X, int l) {
    const bf16* P = X.ws<bf16>(WS_P); const float* mu = X.in(I_MU) + (size_t)l * RC; bf16* LIN = X.ws<bf16>(WS_LIN);
    for (size_t idx = (size_t)X.bid * NTHR + X.tid; idx < (size_t)M * 384; idx += (size_t)X.G * NTHR) { const int t = (int)(idx / 384), j = (int)(idx % 384);
        float v = pm_val(P, mu, t, C_LWF + j);
        if (j < 128) v = 1.0f - 2.0f * frcp(fexp(2.0f * v) + 1.0f); else if (j >= 256) v = sigmoidf_(v);
        LIN[idx] = (bf16)f2bf(v); }
}
__device__ __forceinline__ f32x4 mm_tile_p(const LAS bf16* A, int lda, const LAS bf16* Bt, int ldb, int ks, int ti, int tj, int lane, f32x4 acc) {
    const LAS bf16* pa = A + (16 * ti + (lane & 15)) * lda + 8 * (lane >> 4); const LAS bf16* pb = Bt + (16 * tj + (lane & 15)) * ldb + 8 * (lane >> 4);
    for (int kk = 0; kk < ks; ++kk) { const bf16x8 a = *(const LAS bf16x8*)(pa + 32 * kk), b = *(const LAS bf16x8*)(pb + 32 * kk); acc = MFMA16(a, b, acc); }
    return acc;
}
constexpr int GP = 136;
__device__ __forceinline__ void lora_unit_a(const Ctx& X, int unit) {
    const int b = unit / NH, h = unit % NH, tid = X.tid, lane = X.lane, w = X.wave;
    LAS bf16* Ab = (LAS bf16*)X.lds; LAS bf16* Gb = Ab + 4 * 64 * LP; LAS bf16* Wb = Gb + 64 * GP; LAS bf16* G2b = Wb + 4 * 64 * LP;
    LAS float* OUT = (LAS float*)X.lds;
    static_assert((8 * 64 * LP + 2 * 64 * GP) * 2 <= LDS_STAGE && 5 * 64 * LQ * 4 <= LDS_STAGE, "lora LDS map");
    const bf16* LIN = X.wsv<bf16>(WS_LIN) + (size_t)(64 * b) * 384;
    for (int i = tid; i < 64 * 48; i += NTHR) { const int t = i / 48, c16 = i % 48; const u32x4 v = *(const u32x4*)(LIN + (size_t)t * 384 + 8 * c16);
        if (c16 < 32) *(LAS u32x4*)(Ab + (c16 >> 3) * 64 * LP + t * LP + 8 * (c16 & 7)) = v; else *(LAS u32x4*)(Gb + t * GP + 8 * (c16 - 32)) = v; }
    const bf16* w2t = X.wsv<bf16>(WS_W2T) + (size_t)(64 * h) * 64; const bf16* a2t = X.wsv<bf16>(WS_A2T) + (size_t)(64 * h) * 64; const bf16* g2t = X.wsv<bf16>(WS_G2T) + (size_t)(64 * h) * 128;
    for (int i = tid; i < 4 * 64 * 8; i += NTHR) { const int q = i / 512, c = (i / 8) % 64, c16 = i % 8; const bf16* src = (q < 2 ? w2t + (size_t)q * RW * 64 : a2t + (size_t)(q - 2) * RW * 64) + c * 64 + 8 * c16;
        *(LAS u32x4*)(Wb + q * 64 * LP + c * LP + 8 * c16) = *(const u32x4*)src; }
    for (int i = tid; i < 64 * 16; i += NTHR) { const int c = i / 16, c16 = i % 16; *(LAS u32x4*)(G2b + c * GP + 8 * c16) = *(const u32x4*)(g2t + c * 128 + 8 * c16); }
    __syncthreads();
    f32x4 o[2][5];
#pragma unroll
    for (int q = 0; q < 2; ++q) { const int tile = 2 * w + q, ti = tile >> 2, tj = tile & 3; const f32x4 z4 = {0.f, 0.f, 0.f, 0.f};
#pragma unroll
        for (int p = 0; p < 4; ++p) o[q][p] = mm_tile(Ab + p * 64 * LP, Wb + p * 64 * LP, ti, tj, lane, z4);
        o[q][4] = mm_tile_p(Gb, GP, G2b, GP, 4, ti, tj, lane, z4); }
    __syncthreads();
#pragma unroll
    for (int q = 0; q < 2; ++q) { const int tile = 2 * w + q, ti = tile >> 2, tj = tile & 3, col = 16 * tj + (lane & 15);
#pragma unroll
        for (int p = 0; p < 5; ++p)
#pragma unroll
            for (int r = 0; r < 4; ++r) OUT[(p * 64 + 16 * ti + 4 * (lane >> 4) + r) * LQ + col] = o[q][p][r]; }
    __syncthreads();
}
__device__ __forceinline__ void lora_unit_b(const Ctx& X, int l, int unit) {
    const int b = unit / NH, h = unit % NH, w = X.wave, k = X.lane, c = 64 * h + k;
    const LAS float* OUT = (const LAS float*)X.lds;
    const bf16* P = X.wsv<bf16>(WS_P); const float* mu = X.inv(I_MU) + (size_t)l * RC;
    const float w00 = X.inv(I_W0)[(size_t)(l * 2 + 0) * RW + c], w01 = X.inv(I_W0)[(size_t)(l * 2 + 1) * RW + c];
    const float a00 = X.inv(I_A0)[(size_t)(l * 2 + 0) * RW + c], a01 = X.inv(I_A0)[(size_t)(l * 2 + 1) * RW + c];
    const float kkc = X.inv(I_KK)[(size_t)l * RW + c], kac = X.inv(I_KA)[(size_t)l * RW + c], rkc = X.inv(I_RK)[(size_t)l * RW + c];
    bf16* pR = X.wsv<bf16>(WS_R); bf16* pV = X.wsv<bf16>(WS_V); bf16* pKA = X.wsv<bf16>(WS_KA); bf16* pKD = X.wsv<bf16>(WS_KD); bf16* pKB = X.wsv<bf16>(WS_KB); float* pW = X.wsv<float>(WS_W); bf16* pG = X.wsv<bf16>(WS_GATE); float* pBo = X.wsv<float>(WS_BONUS);
    const int vz = vgpr_zero();
    float p0[3][8], pn[3][8]; unsigned vmask = 0u; const float mu0 = mu[c], mu1 = mu[C_K + c], mu2 = mu[C_V + c];
#pragma unroll
    for (int i = 0; i < 8; ++i) { const int t = 64 * b + 8 * w + i + vz;
#pragma unroll
        for (int q = 0; q < 3; ++q) { const int col = (q == 0 ? 0 : q == 1 ? C_K : C_V) + c; bool valid; const int nr = shift_row(t, col, valid);
            p0[q][i] = bf2f(P[(size_t)t * PCP + col]); pn[q][i] = bf2f(P[(size_t)nr * PCP + col]); vmask |= (valid ? 1u : 0u) << (3 * i + q); } }
    float bonv[8];
#pragma unroll
    for (int i = 0; i < 8; ++i) { const int tl = 8 * w + i, t = 64 * b + tl + vz;
        const float r = p0[0][i] + ((((vmask >> (3 * i + 0)) & 1u) ? pn[0][i] : 0.f) - p0[0][i]) * mu0;
        const float kx = p0[1][i] + ((((vmask >> (3 * i + 1)) & 1u) ? pn[1][i] : 0.f) - p0[1][i]) * mu1;
        const float v = p0[2][i] + ((((vmask >> (3 * i + 2)) & 1u) ? pn[2][i] : 0.f) - p0[2][i]) * mu2;
        const float wd0 = -DECAY_SCALE * sigmoidf_(w00 + OUT[(0 * 64 + tl) * LQ + k]), wd1 = -DECAY_SCALE * sigmoidf_(w01 + OUT[(1 * 64 + tl) * LQ + k]);
        const float ad0 = sigmoidf_(a00 + OUT[(2 * 64 + tl) * LQ + k]), ad1 = sigmoidf_(a01 + OUT[(3 * 64 + tl) * LQ + k]);
        const float kkr = kx * kkc; const float n2 = wave_sum(kkr * kkr); const float kk = kkr * frcp(fmaxf(sqrtf(n2), 1e-12f));
        const float kd0 = kx * (1.f + (ad0 - 1.f) * kac), kd1 = kx * (1.f + (ad1 - 1.f) * kac);
        bonv[i] = wave_sum(r * (kd0 + kd1) * rkc);
        const size_t o = (size_t)t * RW + c, o1 = (size_t)(M + t) * RW + c;
        pR[o] = (bf16)f2bf(r); pV[o] = (bf16)f2bf(v); pKA[o] = (bf16)f2bf(-kk);
        pKD[o] = (bf16)f2bf(kd0); pKD[o1] = (bf16)f2bf(kd1); pKB[o] = (bf16)f2bf(kk * ad0); pKB[o1] = (bf16)f2bf(kk * ad1);
        pW[o] = wd0; pW[o1] = wd1; pG[o] = (bf16)f2bf(OUT[(4 * 64 + tl) * LQ + k]); }
    if (k < 8) { float bs = bonv[0];
#pragma unroll
        for (int i = 1; i < 8; ++i) bs = (k == i) ? bonv[i] : bs;
        pBo[(size_t)(64 * b + 8 * w + k) * NH + h] = bs; }
    __syncthreads();
}
__device__ __forceinline__ void phase_prep_hyena(const Ctx& X, int l) {
    const bf16* P = X.ws<bf16>(WS_P); const int c = X.tid;
    if (c < HW) {
        const float* cw = X.in(I_CW) + (size_t)l * 3 * HC; const float* cb = X.in(I_CB) + (size_t)l * HC;
        float cw0[3], cw1[3], cw2[3], cbv[3];
#pragma unroll
        for (int j = 0; j < 3; ++j) { const int hc = j * HW + c; cw0[j] = cw[hc]; cw1[j] = cw[HC + hc]; cw2[j] = cw[2 * HC + hc]; cbv[j] = cb[hc]; }
        float* ZT = X.ws<float>(WS_ZT) + (size_t)c * M; float* Zc = X.ws<float>(WS_Z); bf16* X0 = X.ws<bf16>(WS_X0);
        for (int tile = X.bid; tile < M / TT; tile += X.G) { const int t0 = tile * TT; float zz[TT];
            float pv[3][TT + 2]; const bool hp0 = (t0 != 0 && t0 != CTX), hnl = (t0 + TT != CTX && t0 + TT != M);
#pragma unroll
            for (int j = 0; j < 3; ++j) { const int col = C_HY + j * HW + c;
#pragma unroll
                for (int i = 0; i < TT + 2; ++i) { const int t = t0 - 1 + i; const bool ok = (i == 0) ? hp0 : (i == TT + 1) ? hnl : true; pv[j][i] = ok ? bf2f(P[(size_t)(ok ? t : t0) * PCP + col]) : 0.f; } }
#pragma unroll
            for (int tt = 0; tt < TT; ++tt) { const int t = t0 + tt;
                float u[3];
#pragma unroll
                for (int j = 0; j < 3; ++j) u[j] = pv[j][tt] * cw0[j] + pv[j][tt + 1] * cw1[j] + pv[j][tt + 2] * cw2[j] + cbv[j];
                zz[tt] = u[2] * u[1]; if (t < CTX) Zc[(size_t)t * HW + c] = zz[tt];
                X0[(size_t)t * HW + c] = (bf16)f2bf(u[0]); }
            *(f32x4*)(ZT + t0) = (f32x4){zz[0], zz[1], zz[2], zz[3]}; *(f32x4*)(ZT + t0 + 4) = (f32x4){zz[4], zz[5], zz[6], zz[7]}; }
    }
}

constexpr int CC = 64, NCHK = M / CC;
static_assert(CTX % CC == 0 && SEQ % CC == 0, "chunks must not straddle the context/latent boundary");
__device__ __forceinline__ int scan_row(int d, int s) { return d == 0 ? s : (s < CTX ? CTX - 1 - s : M - 1 - (s - CTX)); }
__device__ __forceinline__ void chunk_unit_1(const Ctx& X, int unit) {
    const int d = unit / (NCHK * NH), c = (unit / NH) % NCHK, h = unit % NH;
    LAS bf16* An = (LAS bf16*)X.lds;            LAS bf16* Bn = An + 64 * LP; LAS bf16* Kn = Bn + 64 * LP; LAS bf16* Rn = Kn + 64 * LP; LAS bf16* Vt = Rn + 64 * LP;
    LAS bf16* Bh = Vt + 64 * LP;                LAS bf16* Kh = Bh + 64 * LP; LAS bf16* Lak = Kh + 64 * LP; LAS bf16* Mrb = Lak + 64 * LP; LAS bf16* Mrk = Mrb + 64 * LP;
    LAS float* Lab = (LAS float*)(Mrk + 64 * LP); LAS float* XsW = Lab + 64 * LX;
    LAS float* XsU = (LAS float*)An;
    LAS bf16* Wt = Lak; LAS bf16* Ut = (LAS bf16*)((LAS unsigned char*)An + 64 * LX * 4);
    LAS float* tot = Lab;
    LAS float* dC = (LAS float*)(X.lds + LDS_MISC + 1024);
    static_assert(10 * 64 * LP * 2 + 2 * 64 * LX * 4 <= LDS_STAGE && 64 * LX * 4 + 64 * LP * 2 <= 3 * 64 * LP * 2, "chunk LDS map");
    const int tid = X.tid, lane = X.lane, w = X.wave, k = tid & 63;
    float lw[8], cum[8];
    { float run = 0.f; const float* pW = X.wsv<float>(WS_W);
#pragma unroll
      for (int i = 0; i < 8; ++i) { const int row = scan_row(d, c * CC + 8 * w + i); lw[i] = pW[((size_t)d * M + row) * RW + h * 64 + k]; }
#pragma unroll
      for (int i = 0; i < 8; ++i) { run += lw[i]; cum[i] = run; }
      tot[w * 64 + k] = run; }
    __syncthreads();
    float off = 0.f, cumC = 0.f;
#pragma unroll
    for (int ww = 0; ww < 8; ++ww) { const float t = tot[ww * 64 + k]; off += (ww < w) ? t : 0.f; cumC += t; }
    __syncthreads();
    { unsigned pv[4], pbh[4], pkh[4]; float af[8];
      const bf16* pR = X.wsv<bf16>(WS_R); const bf16* pV = X.wsv<bf16>(WS_V); const bf16* pKA = X.wsv<bf16>(WS_KA); const bf16* pKD = X.wsv<bf16>(WS_KD); const bf16* pKB = X.wsv<bf16>(WS_KB);
#pragma unroll
      for (int i = 0; i < 8; ++i) { const int t = 8 * w + i; const int row = scan_row(d, c * CC + t); const size_t o = (size_t)row * RW + h * 64 + k, od = ((size_t)d * M + row) * RW + h * 64 + k;
          const float ct = off + cum[i], cp = ct - lw[i];
          const float r = bf2f(pR[o]), v = bf2f(pV[o]), ka = bf2f(pKA[o]), kd = bf2f(pKD[od]), kb = bf2f(pKB[od]);
          const float ei = fexp(-ct), eh = fexp(cumC - ct);
          const float at = ka * fexp(cp); af[i] = at;
          An[t * LP + k] = (bf16)f2bf(at); Bn[t * LP + k] = (bf16)f2bf(kb * ei); Kn[t * LP + k] = (bf16)f2bf(kd * ei); Rn[t * LP + k] = (bf16)f2bf(r * fexp(ct));
          const unsigned bv = f2bf(v), bb = f2bf(kb * eh), bk = f2bf(kd * eh);
          if (i & 1) { pv[i >> 1] |= bv << 16; pbh[i >> 1] |= bb << 16; pkh[i >> 1] |= bk << 16; } else { pv[i >> 1] = bv; pbh[i >> 1] = bb; pkh[i >> 1] = bk; } }
      *(LAS u32x4*)(Vt + k * LP + 8 * w) = (u32x4){pv[0], pv[1], pv[2], pv[3]}; *(LAS u32x4*)(Bh + k * LP + 8 * w) = (u32x4){pbh[0], pbh[1], pbh[2], pbh[3]}; *(LAS u32x4*)(Kh + k * LP + 8 * w) = (u32x4){pkh[0], pkh[1], pkh[2], pkh[3]};
      *(LAS f32x4*)(XsW + k * LX + 8 * w) = (f32x4){af[0], af[1], af[2], af[3]}; *(LAS f32x4*)(XsW + k * LX + 8 * w + 4) = (f32x4){af[4], af[5], af[6], af[7]}; }
    if (tid < 64) dC[tid] = fexp(cumC);
    __syncthreads();
#pragma unroll 1
    for (int q = 0; q < 2; ++q) { const int tile = 2 * w + q, ti = tile >> 2, tj = tile & 3; const f32x4 z4 = {0.f, 0.f, 0.f, 0.f};
        const f32x4 ab = mm_tile(An, Bn, ti, tj, lane, z4), ak = mm_tile(An, Kn, ti, tj, lane, z4), rb = mm_tile(Rn, Bn, ti, tj, lane, z4), rk = mm_tile(Rn, Kn, ti, tj, lane, z4);
        const int col = 16 * tj + (lane & 15);
#pragma unroll
        for (int r = 0; r < 4; ++r) { const int row = 16 * ti + 4 * (lane >> 4) + r; const bool lo = col < row, le = col <= row;
            Lab[row * LX + col] = lo ? ab[r] : 0.f; Lak[row * LP + col] = (bf16)f2bf(lo ? ak[r] : 0.f); Mrb[row * LP + col] = (bf16)f2bf(le ? rb[r] : 0.f); Mrk[row * LP + col] = (bf16)f2bf(le ? rk[r] : 0.f); } }
    __syncthreads();
}
__device__ __forceinline__ void chunk_unit_2(const Ctx& X, int unit) {
    const int d = unit / (NCHK * NH), c = (unit / NH) % NCHK, h = unit % NH;
    LAS bf16* An = (LAS bf16*)X.lds;            LAS bf16* Bn = An + 64 * LP; LAS bf16* Kn = Bn + 64 * LP; LAS bf16* Rn = Kn + 64 * LP; LAS bf16* Vt = Rn + 64 * LP;
    LAS bf16* Bh = Vt + 64 * LP;                LAS bf16* Kh = Bh + 64 * LP; LAS bf16* Lak = Kh + 64 * LP; LAS bf16* Mrb = Lak + 64 * LP; LAS bf16* Mrk = Mrb + 64 * LP;
    LAS float* Lab = (LAS float*)(Mrk + 64 * LP); LAS float* XsW = Lab + 64 * LX;
    LAS float* XsU = (LAS float*)An;
    LAS bf16* Wt = Lak; LAS bf16* Ut = (LAS bf16*)((LAS unsigned char*)An + 64 * LX * 4);
    LAS float* tot = Lab;
    LAS float* dC = (LAS float*)(X.lds + LDS_MISC + 1024);
    static_assert(10 * 64 * LP * 2 + 2 * 64 * LX * 4 <= LDS_STAGE && 64 * LX * 4 + 64 * LP * 2 <= 3 * 64 * LP * 2, "chunk LDS map");
    const int tid = X.tid, lane = X.lane, w = X.wave, k = tid & 63;
    f32x4 r2[2]; int r2col[2], r2row[2];
#pragma unroll
    for (int q = 0; q < 2; ++q) { const int tile = 2 * w + q, ti = tile >> 2, tj = tile & 3; const f32x4 z4 = {0.f, 0.f, 0.f, 0.f};
        const f32x4 a = mm_tile(Lak, Vt, ti, tj, lane, z4); const int col = 16 * tj + (lane & 15);
        r2[q] = a; r2col[q] = col; r2row[q] = 16 * ti + 4 * (lane >> 4); }
    __syncthreads();
#pragma unroll
    for (int q = 0; q < 2; ++q) *(LAS f32x4*)(XsU + r2col[q] * LX + r2row[q]) = r2[q];
    __syncthreads();
    LAS bf16* Tii = (LAS bf16*)(X.lds + LDS_MISC + 8448);
    constexpr int TP = 40;
    static_assert(8448 + 4 * 16 * TP * 2 <= LDS_BYTES - LDS_MISC, "T_ii image");
    if (tid < 64) { const int bi = tid >> 4, j = tid & 15; float xv[16];
#pragma unroll
        for (int t = 0; t < 16; ++t) { float acc = (t == j) ? 1.f : 0.f;
#pragma unroll
            for (int s2 = 0; s2 < t; ++s2) acc += Lab[(16 * bi + t) * LX + 16 * bi + s2] * xv[s2];
            xv[t] = acc; }
#pragma unroll
        for (int t = 0; t < 16; ++t) { Tii[(bi * 16 + t) * TP + j] = (bf16)f2bf(xv[t]); Tii[(bi * 16 + t) * TP + 16 + j] = (bf16)0; } }
    __syncthreads();
    { LAS float* xsx = (w < 4 ? XsW + 16 * w * LX : XsU + 16 * (w - 4) * LX) + (lane & 15) * LX;
      LAS bf16* dst = (w < 4 ? Wt + 16 * w * LP : Ut + 16 * (w - 4) * LP) + (lane & 15) * LP;
      const int kof = 8 * (lane >> 4); const bf16x8 zero8 = {0, 0, 0, 0, 0, 0, 0, 0};
#pragma unroll
      for (int i = 0; i < 4; ++i) {
          f32x4 acc = *(const LAS f32x4*)(xsx + 16 * i + 4 * (lane >> 4));
#pragma unroll
          for (int kk = 0; kk < (16 * i + 31) / 32; ++kk) { const int s0 = 32 * kk + kof;
              const f32x4 l0 = *(const LAS f32x4*)(Lab + (16 * i + (lane & 15)) * LX + s0), l1 = *(const LAS f32x4*)(Lab + (16 * i + (lane & 15)) * LX + s0 + 4);
              u32x4 pa = {pk2(l0[0], l0[1]), pk2(l0[2], l0[3]), pk2(l1[0], l1[1]), pk2(l1[2], l1[3])};
              bf16x8 av = __builtin_bit_cast(bf16x8, pa), bv = *(const LAS bf16x8*)(dst + s0);
              if (s0 >= 16 * i) { av = zero8; bv = zero8; }
              acc = MFMA16(av, bv, acc); }
          LAS bf16* zt = (LAS bf16*)(xsx + 16 * i);
          *(LAS unsigned long long*)(zt + 4 * (lane >> 4)) = (unsigned long long)pk2(acc[0], acc[1]) | ((unsigned long long)pk2(acc[2], acc[3]) << 32);
          WAVE_LDS_FENCE(); CFENCE();
          const bf16x8 a2 = *(const LAS bf16x8*)(Tii + (i * 16 + (lane & 15)) * TP + kof); bf16x8 b2 = zero8; if (kof < 16) b2 = *(const LAS bf16x8*)(zt + kof);
          f32x4 xi = {0.f, 0.f, 0.f, 0.f}; xi = MFMA16(a2, b2, xi);
          *(LAS unsigned long long*)(dst + 16 * i + 4 * (lane >> 4)) = (unsigned long long)pk2(xi[0], xi[1]) | ((unsigned long long)pk2(xi[2], xi[3]) << 32);
          WAVE_LDS_FENCE(); CFENCE(); } }
    __syncthreads();
}
__device__ __forceinline__ void chunk_unit_3(const Ctx& X, int unit) {
    const int d = unit / (NCHK * NH), c = (unit / NH) % NCHK, h = unit % NH;
    LAS bf16* An = (LAS bf16*)X.lds;            LAS bf16* Bn = An + 64 * LP; LAS bf16* Kn = Bn + 64 * LP; LAS bf16* Rn = Kn + 64 * LP; LAS bf16* Vt = Rn + 64 * LP;
    LAS bf16* Bh = Vt + 64 * LP;                LAS bf16* Kh = Bh + 64 * LP; LAS bf16* Lak = Kh + 64 * LP; LAS bf16* Mrb = Lak + 64 * LP; LAS bf16* Mrk = Mrb + 64 * LP;
    LAS float* Lab = (LAS float*)(Mrk + 64 * LP); LAS float* XsW = Lab + 64 * LX;
    LAS float* XsU = (LAS float*)An;
    LAS bf16* Wt = Lak; LAS bf16* Ut = (LAS bf16*)((LAS unsigned char*)An + 64 * LX * 4);
    LAS float* tot = Lab;
    LAS float* dC = (LAS float*)(X.lds + LDS_MISC + 1024);
    static_assert(10 * 64 * LP * 2 + 2 * 64 * LX * 4 <= LDS_STAGE && 64 * LX * 4 + 64 * LP * 2 <= 3 * 64 * LP * 2, "chunk LDS map");
    const int tid = X.tid, lane = X.lane, w = X.wave, k = tid & 63;
    const float dCk = dC[k];
    const size_t ubase = ((size_t)(d * NH + h) * NCHK + c);
    bf16* PTg = (bf16*)(X.wsv<float>(WS_PQ) + ubase * 2 * 4096); float* Qg = X.wsv<float>(WS_PQ) + ubase * 2 * 4096 + 4096;     bf16* Gg = X.wsv<bf16>(WS_G) + ubase * 4096; float* Yg = X.wsv<float>(WS_YL) + ubase * 4096;
#pragma unroll 1
    for (int q = 0; q < 2; ++q) { const int tile = 2 * w + q, ti = tile >> 2, tj = tile & 3; const f32x4 z4 = {0.f, 0.f, 0.f, 0.f};
        const f32x4 p = mm_tile(Wt, Bh, ti, tj, lane, z4); f32x4 qq = mm_tile(Ut, Bh, ti, tj, lane, z4); qq = mm_tile(Vt, Kh, ti, tj, lane, qq);
        const f32x4 g = mm_tile(Mrb, Wt, ti, tj, lane, z4); f32x4 y = mm_tile(Mrb, Ut, ti, tj, lane, z4); y = mm_tile(Mrk, Vt, ti, tj, lane, y);
        const int col = 16 * tj + (lane & 15); const float dcol = __shfl(dCk, col);
        { const int row0 = 16 * ti + 4 * (lane >> 4); float pv[4];
#pragma unroll
          for (int r = 0; r < 4; ++r) pv[r] = p[r] + ((row0 + r) == col ? dcol : 0.f);
          *(unsigned long long*)(PTg + col * 64 + row0) = (unsigned long long)pk2(pv[0], pv[1]) | ((unsigned long long)pk2(pv[2], pv[3]) << 32); }
#pragma unroll
        for (int r = 0; r < 4; ++r) { const int row = 16 * ti + 4 * (lane >> 4) + r;
            Qg[row * 64 + col] = qq[r];
            const int orow = d ? 63 - row : row;
            Gg[orow * 64 + col] = (bf16)f2bf(g[r] + bf2f(Rn[row * LP + col])); }
        { const int gq = lane >> 4; const int cti = d ? 3 - ti : ti, cg = d ? 3 - gq : gq; const f32x4 yv = d ? (f32x4){y[3], y[2], y[1], y[0]} : y;
          *(f32x4*)(Yg + ((cti * 4 + tj) * 64 + 16 * cg + (lane & 15)) * 4) = yv; } }
    __syncthreads();
}
__device__ __forceinline__ void seq_unit(const Ctx& X, int su) {
    const int d = su / (NH * 4), h = (su / 4) % NH, qv = su & 3;
    constexpr int PD = 9, RING = PD + 1, SLOTB = 8192 + 4096;
    LAS unsigned char* ring = X.lds;
    LAS bf16* S = (LAS bf16*)(ring + RING * SLOTB);
    static_assert(RING * SLOTB + 2 * 16 * LP * 2 <= LDS_STAGE && (PD - 1) * 6 <= 63, "seq LDS map / vmcnt range");
    const int lane = X.lane, w = X.wave, tj = w & 3, col = 16 * tj + (lane & 15), kq = lane >> 4, kof = 8 * kq;
    const bool worker = w < 4;
    const unsigned char* PQ = (const unsigned char*)(X.ws<float>(WS_PQ) + (size_t)(d * NH + h) * NCHK * 2 * 4096); bf16* S0g = X.ws<bf16>(WS_S0) + (size_t)(d * NH + h) * NCHK * 4096 + (size_t)(16 * qv) * 64;
#define SEQ_FILL(c_) do { const unsigned char* p_ = PQ + (size_t)(c_) * 32768; LAS unsigned char* sl_ = ring + ((c_) % RING) * SLOTB; \
        GLDS16(p_ + 16 * (w * 64 + lane), sl_ + 16 * (w * 64)); GLDS16(p_ + 16384 + (16 * qv) * 256 + 16 * ((w & 3) * 64 + lane), sl_ + 8192 + 16 * ((w & 3) * 64)); } while (0)
#pragma unroll
    for (int i = 0; i < PD; ++i) if (i < NCHK) SEQ_FILL(i);
    for (int i = X.tid; i < 2 * 16 * LP / 2; i += NTHR) ((LAS unsigned*)S)[i] = 0u;
    if (worker) {
#pragma unroll
        for (int r = 0; r < 4; ++r) S0g[(4 * kq + r) * 64 + col] = (bf16)0; }
    for (int c = 0; c < NCHK; ++c) {
        if (c + PD - 1 < NCHK) { if (worker) { ASM_WAIT_V(48); } else { ASM_WAIT_V(16); } } else { ASM_WAIT_V(0); }
        ASM_WAIT_L(0); S_BARRIER(); CFENCE();
        if (c + PD < NCHK) SEQ_FILL(c + PD);
        if (worker) {
            const LAS bf16* PT = (const LAS bf16*)(ring + (c % RING) * SLOTB); const LAS float* Q = (const LAS float*)(ring + (c % RING) * SLOTB + 8192);
            const LAS bf16* Sc = S + (c & 1) * 16 * LP; LAS bf16* Sn = S + ((c + 1) & 1) * 16 * LP;
            f32x4 acc;
#pragma unroll
            for (int r = 0; r < 4; ++r) acc[r] = Q[(4 * kq + r) * 64 + col];
#pragma unroll
            for (int kk = 0; kk < 2; ++kk) acc = MFMA16(*(const LAS bf16x8*)(Sc + (lane & 15) * LP + kof + 32 * kk), *(const LAS bf16x8*)(PT + (16 * tj + (lane & 15)) * 64 + kof + 32 * kk), acc);
#pragma unroll
            for (int r = 0; r < 4; ++r) { const bf16 sb = (bf16)f2bf(acc[r]); Sn[(4 * kq + r) * LP + col] = sb; if (c + 1 < NCHK) S0g[(size_t)(c + 1) * 4096 + (4 * kq + r) * 64 + col] = sb; } }
    }
    ASM_WAIT_V(0);
    __syncthreads();
#undef SEQ_FILL
}
constexpr int CR = 16;
__device__ __forceinline__ void conv_item(const Ctx& X, int item) {
    constexpr int NCG = HW / 64; constexpr int n = CTX;
    const int cg = item % NCG, ob = item / NCG, i0 = CR * ob, c = cg * 64 + X.lane;
    const float* F = X.ws<float>(WS_FILT) + (size_t)HW * SEQ + (size_t)c * CTX; const float* Z = X.ws<float>(WS_Z) + c;
    const float* fp = X.ws<float>(WS_FPART) + (size_t)NPART * HW + c;
    float nsum = 0.f; for (int b = 0; b < NPART; ++b) nsum += fp[(size_t)b * HW];
    float acc[CR], Q[CR];
#pragma unroll
    for (int r = 0; r < CR; ++r) acc[r] = 0.f;
    int jb = i0 - n / 2; if (jb < 0) jb = 0;
    int jend = i0 + n / 2 + CR; if (jend > n) jend = n;
    int Tb = i0 - jb + n / 2;
#pragma unroll
    for (int x = 1; x < CR; ++x) { const int T = Tb + x; Q[x] = (T >= 0 && T < n) ? F[T] : 0.f; }
    Q[0] = 0.f;
    for (; jb < jend; jb += CR, Tb -= CR) {
#pragma unroll
        for (int s = 0; s < CR; ++s) { const int T = Tb - s, j = jb + s;
            if ((s & 3) == 0) CFENCE();
            Q[(CR - s) & (CR - 1)] = (T >= 0 && T < n) ? F[T] : 0.f;
            const float zj = (j < n) ? Z[(size_t)j * HW] : 0.f;
#pragma unroll
            for (int r = 0; r < CR; ++r) acc[r] += Q[(r - s + CR) & (CR - 1)] * zj; }
    }
    const float inv = 1.0f / nsum; float* O = X.ws<float>(WS_CONV) + c;
#pragma unroll
    for (int r = 0; r < CR; ++r) O[(size_t)(i0 + r) * HW] = acc[r] * inv;
}

#ifdef EMU
struct cf { float x, y; };
#else
typedef float cf __attribute__((ext_vector_type(2)));
#endif
__device__ __forceinline__ cf cmul(cf a, cf b) { return cf{a.x * b.x - a.y * b.y, a.x * b.y + a.y * b.x}; }
__device__ __forceinline__ cf cadd(cf a, cf b) { return cf{a.x + b.x, a.y + b.y}; }
__device__ __forceinline__ cf csub(cf a, cf b) { return cf{a.x - b.x, a.y - b.y}; }
__device__ __forceinline__ cf cconj(cf a) { return cf{a.x, -a.y}; }
constexpr int FN = SEQ;
constexpr int flog4(int n) { return n <= 1 ? 0 : 1 + flog4(n / 4); }
constexpr int FLOG4 = flog4(FN), FSQ = 1 << FLOG4;
static_assert((1 << (2 * FLOG4)) == FN && FN * 8 <= LDS_STAGE, "FFT length must be a power of 4 that fits the LDS stage region");
constexpr int FFT_TAB_OFF = LDS_MISC + 2048;
static_assert(FFT_TAB_OFF + 2 * FSQ * 8 <= LDS_BYTES, "FFT twiddle tables");
__device__ __forceinline__ void fft_tables(const Ctx& X) {
    LAS cf* T = (LAS cf*)(X.lds + FFT_TAB_OFF);
    for (int i = X.tid; i < 2 * FSQ; i += NTHR) { const int k = i < FSQ ? i * FSQ : i - FSQ; float s, c; sincos_f(-6.283185307179586f * (float)k / (float)FN, s, c); T[i] = cf{c, s}; }
    __syncthreads();
}
__device__ __forceinline__ cf fft_tw(const LAS cf* T, int k) { const cf a = T[k >> FLOG4], b = T[FSQ + (k & (FSQ - 1))]; return cmul(a, b); }
__device__ __forceinline__ int rev4(int k) { int r = 0;
#pragma unroll
    for (int s = 0; s < FLOG4; ++s) { r = (r << 2) | (k & 3); k >>= 2; }
    return r; }
__device__ __forceinline__ void fft_stage_q1(LAS cf* x, int tid, bool inverse) {
    for (int u = tid; u < FN / 4; u += NTHR) { LAS f32x4* px = (LAS f32x4*)(x + 4 * u); const f32x4 v01 = px[0], v23 = px[1];
        const cf a0{v01[0], v01[1]}, a1{v01[2], v01[3]}, a2{v23[0], v23[1]}, a3{v23[2], v23[3]};
        const cf t0 = cadd(a0, a2), t1 = csub(a0, a2), t2 = cadd(a1, a3), d = csub(a1, a3), t3 = inverse ? cf{-d.y, d.x} : cf{d.y, -d.x};
        const cf y0 = cadd(t0, t2), y1 = cadd(t1, t3), y2 = csub(t0, t2), y3 = csub(t1, t3);
        px[0] = (f32x4){y0.x, y0.y, y1.x, y1.y}; px[1] = (f32x4){y2.x, y2.y, y3.x, y3.y}; }
    __syncthreads();
}
__device__ __forceinline__ void dif4(cf& a0, cf& a1, cf& a2, cf& a3, cf w1) {
    const cf w2 = cmul(w1, w1), w3 = cmul(w2, w1);
    const cf t0 = cadd(a0, a2), t1 = csub(a0, a2), t2 = cadd(a1, a3), d = csub(a1, a3), t3 = cf{d.y, -d.x};
    a0 = cadd(t0, t2); a1 = cmul(cadd(t1, t3), w1); a2 = cmul(csub(t0, t2), w2); a3 = cmul(csub(t1, t3), w3);
}
__device__ __forceinline__ void dit4(cf& a0, cf& a1, cf& a2, cf& a3, cf w1c) {
    const cf w2 = cmul(w1c, w1c), w3 = cmul(w2, w1c);
    a1 = cmul(a1, w1c); a2 = cmul(a2, w2); a3 = cmul(a3, w3);
    const cf t0 = cadd(a0, a2), t1 = csub(a0, a2), t2 = cadd(a1, a3), d = csub(a1, a3), t3 = cf{-d.y, d.x};
    a0 = cadd(t0, t2); a1 = cadd(t1, t3); a2 = csub(t0, t2); a3 = csub(t1, t3);
}
__device__ __forceinline__ void fft_pair(LAS cf* x, const LAS cf* T, int tid, int s, bool inverse) {
    const int q1 = FN >> (2 * s + 2), q2 = q1 >> 2, tw1 = 1 << (2 * s), tw2 = tw1 << 2;
    for (int u = tid; u < FN / 16; u += NTHR) { const int j2 = u & (q2 - 1), base = (u - j2) * 16 + j2;
        cf v[4][4];
#pragma unroll
        for (int a = 0; a < 4; ++a)
#pragma unroll
            for (int b = 0; b < 4; ++b) v[a][b] = x[base + a * q1 + b * q2];
        if (!inverse) {
#pragma unroll
            for (int b = 0; b < 4; ++b) dif4(v[0][b], v[1][b], v[2][b], v[3][b], fft_tw(T, (b * q2 + j2) * tw1));
            const cf wb = fft_tw(T, j2 * tw2);
#pragma unroll
            for (int a = 0; a < 4; ++a) dif4(v[a][0], v[a][1], v[a][2], v[a][3], wb);
        } else {
            const cf wb = cconj(fft_tw(T, j2 * tw2));
#pragma unroll
            for (int a = 0; a < 4; ++a) dit4(v[a][0], v[a][1], v[a][2], v[a][3], wb);
#pragma unroll
            for (int b = 0; b < 4; ++b) dit4(v[0][b], v[1][b], v[2][b], v[3][b], cconj(fft_tw(T, (b * q2 + j2) * tw1)));
        }
#pragma unroll
        for (int a = 0; a < 4; ++a)
#pragma unroll
            for (int b = 0; b < 4; ++b) x[base + a * q1 + b * q2] = v[a][b]; }
    __syncthreads();
}
__device__ __forceinline__ void fft_single(LAS cf* x, const LAS cf* T, int tid, int s, bool inverse) {
    const int q = FN >> (2 * s + 2), tw = 1 << (2 * s);
    for (int u = tid; u < FN / 4; u += NTHR) { const int j = u & (q - 1), p = (u - j) * 4 + j;
        cf a0 = x[p], a1 = x[p + q], a2 = x[p + 2 * q], a3 = x[p + 3 * q];
        if (!inverse) dif4(a0, a1, a2, a3, fft_tw(T, j * tw)); else dit4(a0, a1, a2, a3, cconj(fft_tw(T, j * tw)));
        x[p] = a0; x[p + q] = a1; x[p + 2 * q] = a2; x[p + 3 * q] = a3; }
    __syncthreads();
}
constexpr int fft_npairs() { int n = 0; for (int s = 0; s + 1 < FLOG4 - 1; s += 2) { if ((FN >> (2 * s + 6)) >= 64 || FN < 16384) ++n; else break; } return n; }
constexpr int FPAIRS = fft_npairs();
__device__ __forceinline__ void fft_run(LAS cf* x, const LAS cf* T, int tid, bool inverse) {
    constexpr int NST = FPAIRS + (FLOG4 - 1 - 2 * FPAIRS) + 1;
#pragma unroll 1
    for (int i = 0; i < NST; ++i) { const int k = inverse ? NST - 1 - i : i;
        if (k < FPAIRS) fft_pair(x, T, tid, 2 * k, inverse);
        else if (k < NST - 1) fft_single(x, T, tid, 2 * FPAIRS + (k - FPAIRS), inverse);
        else fft_stage_q1(x, tid, inverse); }
}
__device__ __forceinline__ void fft_fwd(LAS cf* x, const LAS cf* T, int tid) { fft_run(x, T, tid, false); }
__device__ __forceinline__ void fft_inv(LAS cf* x, const LAS cf* T, int tid) { fft_run(x, T, tid, true); }
__device__ __forceinline__ void fft_load_real(LAS cf* x, const float* src, float scale, int tid) {
    for (int m = tid; m < FN; m += NTHR) { cf v{0.f, 0.f}; if (m < FN / 2) { v.x = src[2 * m] * scale; v.y = src[2 * m + 1] * scale; } x[m] = v; }
    __syncthreads();
}
__device__ __forceinline__ void spec_load(const Ctx& X, int c) {
    LAS cf* x = (LAS cf*)X.lds; volatile LAS float* red = (volatile LAS float*)(X.lds + LDS_MISC) + 120;
    if (X.wave == 0) { const float* fp = X.ws<float>(WS_FPART) + c; float s = 0.f; for (int b = X.lane; b < NPART; b += 64) s += fp[(size_t)b * HW]; s = wave_sum(s); if (X.lane == 0) red[0] = s; }
    __syncthreads();
    const float inv = 1.0f / red[0];
    fft_load_real(x, X.ws<float>(WS_FILT) + (size_t)c * SEQ, inv, X.tid);
}
__device__ __forceinline__ void spec_unpack(const Ctx& X, int c) {
    LAS cf* x = (LAS cf*)X.lds;
    cf* HS = X.ws<cf>(WS_HS) + (size_t)c * (FN + 1);
    for (int k = X.tid; k <= FN / 2; k += NTHR) {
        const cf A = x[rev4(k)], B = x[rev4((FN - k) & (FN - 1))];
        if (k == 0) { HS[0] = cf{A.x + A.y, 0.f}; HS[FN] = cf{A.x - A.y, 0.f}; }
        else if (k == FN / 2) { HS[k] = cconj(A); }
        else { float sn, cs; sincos_f(-3.14159265358979f * (float)k / (float)FN, sn, cs); const cf w{cs, sn};
            const cf s1 = cadd(A, cconj(B)), d1 = csub(A, cconj(B)), wd = cmul(w, d1);
            HS[k] = cf{0.5f * (s1.x + wd.y), 0.5f * (s1.y - wd.x)};
            const cf s2 = cadd(B, cconj(A)), d2 = csub(B, cconj(A)), wd2 = cmul(cconj(w), d2);
            HS[FN - k] = cf{0.5f * (s2.x - wd2.y), 0.5f * (s2.y + wd2.x)}; } }
    __syncthreads();
}
__device__ __forceinline__ void fftconv_load(const Ctx& X, int c) { fft_load_real((LAS cf*)X.lds, X.ws<float>(WS_ZT) + (size_t)c * M + CTX, 1.0f, X.tid); }
__device__ __forceinline__ void fftconv_mul(const Ctx& X, int c) {
    LAS cf* x = (LAS cf*)X.lds;
    const cf* HS = X.ws<cf>(WS_HS) + (size_t)c * (FN + 1);
    for (int k = X.tid; k <= FN / 2; k += NTHR) {
        const int pa = rev4(k), pb = rev4((FN - k) & (FN - 1)); const cf A = x[pa], B = x[pb];
        if (k == 0) { const float y0 = (A.x + A.y) * HS[0].x, yn = (A.x - A.y) * HS[FN].x; x[pa] = cf{0.5f * (y0 + yn), 0.5f * (y0 - yn)}; }
        else if (k == FN / 2) { x[pa] = cconj(cmul(cconj(A), HS[k])); }
        else { float sn, cs; sincos_f(-3.14159265358979f * (float)k / (float)FN, sn, cs); const cf w{cs, sn};
            const cf s1 = cadd(A, cconj(B)), d1 = csub(A, cconj(B)), wd = cmul(w, d1); const cf Xk{0.5f * (s1.x + wd.y), 0.5f * (s1.y - wd.x)};
            const cf s2 = cadd(B, cconj(A)), d2 = csub(B, cconj(A)), wd2 = cmul(cconj(w), d2); const cf Xn{0.5f * (s2.x - wd2.y), 0.5f * (s2.y + wd2.x)};
            const cf Yk = cmul(Xk, HS[k]), Yn = cmul(Xn, HS[FN - k]);
            const cf e1 = cadd(Yk, cconj(Yn)), f1 = cmul(cconj(w), csub(Yk, cconj(Yn)));
            x[pa] = cf{0.5f * (e1.x - f1.y), 0.5f * (e1.y + f1.x)};
            const cf e2 = cadd(Yn, cconj(Yk)), f2 = cmul(w, csub(Yn, cconj(Yk)));
            x[pb] = cf{0.5f * (e2.x + f2.y), 0.5f * (e2.y - f2.x)}; } }
    __syncthreads();
}
__device__ __forceinline__ void fftconv_out(const Ctx& X, int l, int c) {
    const LAS cf* x = (const LAS cf*)X.lds; const float* z = X.ws<float>(WS_ZT) + (size_t)c * M + CTX;
    const float bias = X.in(I_HBIAS)[(size_t)l * HW + c], sc = 1.0f / (float)FN; float* O = X.ws<float>(WS_CVT) + (size_t)c * SEQ;
    for (int i2 = X.tid; i2 < FN / 2; i2 += NTHR) { const cf d = x[i2 + FN / 4]; O[2 * i2] = d.x * sc + z[2 * i2] * bias; O[2 * i2 + 1] = d.y * sc + z[2 * i2 + 1] * bias; }
    __syncthreads();
}
__device__ __forceinline__ void phase_ctxconv(const Ctx& X, int l) {
    constexpr int NITEMS = (HW / 64) * (CTX / CR);
    unsigned* q = X.ctl() + CW_Q + l * 64;
    for (;;) { int item = 0; if (X.lane == 0) item = (int)atomicAdd(q, 1u); item = __shfl(item, 0); if (item >= NITEMS) break; conv_item(X, item); }
}
__device__ __forceinline__ void phase_seq(const Ctx& X) {
    for (int su = X.bid; su < N_SEQ_UNITS; su += X.G) seq_unit(X, su);
}

__device__ __forceinline__ void finish_wave_unit(const Ctx& X, int l, int unit) {
    const int rg = unit / NH, h = unit % NH, lane = X.lane, b = rg >> 2, sub = rg & 3;
    const int cf = b, cb = (b < CTX / CC) ? (CTX / CC - 1 - b) : (NCHK - 1 - (b - CTX / CC));
    const size_t uf = ((size_t)(0 * NH + h) * NCHK + cf) * 4096, ub = ((size_t)(1 * NH + h) * NCHK + cb) * 4096;
    const bf16* G = X.wsv<bf16>(WS_G); const bf16* S0 = X.wsv<bf16>(WS_S0); const float* YL = X.wsv<float>(WS_YL);
    const int arow = 16 * sub + (lane & 15), kof = 8 * (lane >> 4);
    bf16x8 af[2], ab[2];
#pragma unroll
    for (int kk = 0; kk < 2; ++kk) { af[kk] = *(const bf16x8*)(G + uf + arow * 64 + kof + 32 * kk); ab[kk] = *(const bf16x8*)(G + ub + arow * 64 + kof + 32 * kk); }
    f32x4 y[4];
#pragma unroll
    for (int tj = 0; tj < 4; ++tj) { const int vrow = 16 * tj + (lane & 15);
        bf16x8 bf_[2], bb_[2];
#pragma unroll
        for (int kk = 0; kk < 2; ++kk) { bf_[kk] = *(const bf16x8*)(S0 + uf + vrow * 64 + kof + 32 * kk); bb_[kk] = *(const bf16x8*)(S0 + ub + vrow * 64 + kof + 32 * kk); }
        f32x4 acc;
#pragma unroll
        for (int r = 0; r < 4; ++r) acc[r] = 0.f;
        acc = *(const f32x4*)(YL + uf + ((sub * 4 + tj) * 64 + lane) * 4) + *(const f32x4*)(YL + ub + ((sub * 4 + tj) * 64 + lane) * 4);
#pragma unroll
        for (int kk = 0; kk < 2; ++kk) { acc = MFMA16(af[kk], bf_[kk], acc); acc = MFMA16(ab[kk], bb_[kk], acc); }
        y[tj] = acc; }
    const float* lgp = X.inv(I_LNXG) + (size_t)l * RW + 64 * h; const float* lbp = X.inv(I_LNXB) + (size_t)l * RW + 64 * h;
    const bf16* pV = X.wsv<bf16>(WS_V); const bf16* pG = X.wsv<bf16>(WS_GATE); const float* pBo = X.wsv<float>(WS_BONUS); bf16* pRO = X.wsv<bf16>(WS_RO);
#pragma unroll
    for (int r = 0; r < 4; ++r) { const int t = 16 * rg + 4 * (lane >> 4) + r;
        const float mean = row16_sum((y[0][r] + y[1][r]) + (y[2][r] + y[3][r])) * (1.f / 64.f);
        float q = 0.f;
#pragma unroll
        for (int tj = 0; tj < 4; ++tj) { const float dy = y[tj][r] - mean; q += dy * dy; }
        const float rstd = 1.0f / sqrtf(row16_sum(q) * (1.f / 64.f) + GN_EPS); const float bon = pBo[(size_t)t * NH + h];
#pragma unroll
        for (int tj = 0; tj < 4; ++tj) { const int cl = 16 * tj + (lane & 15); const size_t o = (size_t)t * RW + 64 * h + cl;
            float yn = (y[tj][r] - mean) * rstd * lgp[cl] + lbp[cl];
            yn += bon * bf2f(pV[o]); yn *= bf2f(pG[o]);
            pRO[o] = (bf16)f2bf(yn); } }
}
__device__ __forceinline__ void phase_finish(const Ctx& X, int l) {
    for (int u = X.bid * NWAVES + X.wave; u < (M / 16) * NH; u += X.G * NWAVES) { if (l == DEPTH - 1 && u < (CTX / 16) * NH) continue; finish_wave_unit(X, l, u); }
    const int c = X.tid;
    if (c < HW) { const float hbc = X.in(I_HBIAS)[(size_t)l * HW + c]; const float* CV = X.ws<float>(WS_CVT) + (size_t)c * SEQ; const bf16* X0 = X.ws<bf16>(WS_X0); bf16* HO = X.ws<bf16>(WS_HO);
        for (int tile = X.bid; tile < M / TT; tile += X.G) { const int t0 = tile * TT; float cv[TT];
            if (l == DEPTH - 1 && t0 < CTX) continue;
            if (t0 < CTX) {
#pragma unroll
                for (int tt = 0; tt < TT; ++tt) { const size_t o = (size_t)(t0 + tt) * HW + c; cv[tt] = X.ws<float>(WS_CONV)[o] + X.ws<float>(WS_Z)[o] * hbc; } }
            else { const f32x4 a = *(const f32x4*)(CV + (t0 - CTX)), b = *(const f32x4*)(CV + (t0 - CTX) + 4);
#pragma unroll
                for (int i = 0; i < 4; ++i) { cv[i] = a[i]; cv[4 + i] = b[i]; } }
#pragma unroll
            for (int tt = 0; tt < TT; ++tt) { const size_t o = (size_t)(t0 + tt) * HW + c; HO[o] = (bf16)f2bf(cv[tt] * bf2f(X0[o])); } } }
}

__device__ __forceinline__ void ln_inplace(float (&v)[D / 64], const float* g, const float* b, int lane) {
    float s = 0.f;
#pragma unroll
    for (int j = 0; j < D / 64; ++j) s += v[j];
    const float mean = wave_sum(s) * (1.f / D); float q = 0.f;
#pragma unroll
    for (int j = 0; j < D / 64; ++j) { v[j] -= mean; q += v[j] * v[j]; }
    const float rstd = 1.0f / sqrtf(wave_sum(q) * (1.f / D) + LN_EPS);
#pragma unroll
    for (int j = 0; j < D / 64; ++j) { const int d = 4 * lane + 256 * (j >> 2) + (j & 3); v[j] = v[j] * rstd * g[d] + b[d]; }
}
__device__ __forceinline__ void phase_norm1(const Ctx& X, int l) {
    const int gw = X.bid * NWAVES + X.wave, NGW = X.G * NWAVES, lane = X.lane;
    const float* lng = X.in(I_LNG) + (size_t)(l * 2 + 0) * D; const float* lnb = X.in(I_LNB) + (size_t)(l * 2 + 0) * D;
    const float* wr = X.in(I_WR); const float* rb = X.in(I_RB);
    const float alpha = sqrtf(sqrtf(2.0f * DEPTH));
    volatile LAS int* hist = (volatile LAS int*)(X.lds + LDS_MISC + 4096);
    if (X.tid < NE) hist[X.tid] = 0;
    LAS float* wl = (LAS float*)X.lds + NWAVES * D;
    for (int i = X.tid; i < D * NE / 4; i += NTHR) ((LAS f32x4*)wl)[i] = ((const f32x4*)wr)[i];
    __syncthreads();
    for (int t = gw; t < M; t += NGW) { if (l == DEPTH - 1 && t < CTX) continue;
        float* xr = X.ws<float>(WS_X) + (size_t)t * D; const float* mx = X.ws<float>(WS_MIX) + (size_t)t * D;
        const float* gate = modp(X, l, t, 2); const float* sh = modp(X, l, t, 3); const float* sc = modp(X, l, t, 4);
        float v[D / 64];
#pragma unroll
        for (int j = 0; j < D / 256; ++j) { const int d = 4 * lane + 256 * j; const f32x4 a = *(const f32x4*)(xr + d), m = *(const f32x4*)(mx + d), gt = *(const f32x4*)(gate + d);
#pragma unroll
            for (int i = 0; i < 4; ++i) v[4 * j + i] = alpha * a[i] + gt[i] * m[i]; }
        ln_inplace(v, lng, lnb, lane);
        bf16* hf = X.ws<bf16>(WS_XMOD) + (size_t)t * D;
        LAS float* hrow = (LAS float*)X.lds + X.wave * D;
#pragma unroll
        for (int j = 0; j < D / 256; ++j) { const int d = 4 * lane + 256 * j; f32x4 o; const f32x4 a = *(const f32x4*)(sh + d), b = *(const f32x4*)(sc + d); f32x4 h;
#pragma unroll
            for (int i = 0; i < 4; ++i) { o[i] = v[4 * j + i]; h[i] = o[i] * (1.f + b[i]) + a[i]; }
            *(f32x4*)(xr + d) = o; *(LAS f32x4*)(hrow + d) = h;
            *(unsigned long long*)(hf + d) = (unsigned long long)pk2(h[0], h[1]) | ((unsigned long long)pk2(h[2], h[3]) << 32); }
        WAVE_LDS_FENCE(); CFENCE();
        f32x4 part = {0.f, 0.f, 0.f, 0.f};
#pragma unroll 8
        for (int i = 0; i < D / 16; ++i) { const float hv = hrow[16 * i + (lane >> 2)]; const f32x4 w4 = *(const LAS f32x4*)(wl + 256 * i + 4 * lane);
#pragma unroll
            for (int c = 0; c < 4; ++c) part[c] += hv * w4[c]; }
#pragma unroll
        for (int c = 0; c < 4; ++c) { float p = part[c]; p += __shfl_xor(p, 4); p += __shfl_xor(p, 8); p += __shfl_xor(p, 16); p += __shfl_xor(p, 32); part[c] = p; }
        WAVE_LDS_FENCE(); CFENCE();
        float lg[NE];
#pragma unroll
        for (int e = 0; e < NE; ++e) lg[e] = __shfl(part[e & 3], e >> 2);
        float mxl = lg[0];
#pragma unroll
        for (int e = 1; e < NE; ++e) mxl = fmaxf(mxl, lg[e]);
        float sc_[NE], sum = 0.f;
#pragma unroll
        for (int e = 0; e < NE; ++e) { sc_[e] = expf(lg[e] - mxl); sum += sc_[e]; }
        const float isum = 1.0f / sum; float sel[NE];
#pragma unroll
        for (int e = 0; e < NE; ++e) { sc_[e] *= isum; sel[e] = sc_[e] + rb[e]; }
        int bg = 0; float bgs = -INFINITY;
#pragma unroll
        for (int g = 0; g < 4; ++g) { float m1 = -INFINITY, m2 = -INFINITY;
#pragma unroll
            for (int i = 0; i < 4; ++i) { const float x = sel[4 * g + i]; if (x > m1) { m2 = m1; m1 = x; } else if (x > m2) m2 = x; }
            const float gs = m1 + m2; if (gs > bgs) { bgs = gs; bg = g; } }
        int i0 = 0, i1 = 0; float s0 = -INFINITY, s1 = -INFINITY, p0 = 0.f, p1 = 0.f;
#pragma unroll
        for (int e = 0; e < NE; ++e) { if ((e >> 2) == bg) { const float x = sel[e]; if (x > s0) { s1 = s0; i1 = i0; p1 = p0; s0 = x; i0 = e; p0 = sc_[e]; } else if (x > s1) { s1 = x; i1 = e; p1 = sc_[e]; } } }
        if (lane == 0) { int* ei = X.ws<int>(WS_ROUT) + (size_t)t * 2; float* ew = (float*)(X.ws<int>(WS_ROUT) + (size_t)M * 2) + (size_t)t * 2;
            ei[0] = i0; ei[1] = i1; const float ws_ = 1.0f / (p0 + p1); ew[0] = p0 * ws_; ew[1] = p1 * ws_;
            lds_add(hist + i0, 1); lds_add(hist + i1, 1); }
    }
    __syncthreads();
    if (X.tid < NE) { const int hc = hist[X.tid]; X.ws<int>(WS_BCNT)[X.bid * NE + X.tid] = hc; atomicAdd(X.ctl() + CW_CNT + l * 64 + X.tid, (unsigned)hc); }
}

__device__ __forceinline__ void moe_table(const Ctx& X, int l, int NT) {
    volatile LAS int* tab = (volatile LAS int*)(X.lds + LDS_MISC) + 8;
    if (X.tid < NE) { const int cnt = (int)__hip_atomic_load(X.ctl() + CW_CNT + l * 64 + X.tid, RLX_AGENT); tab[64 + X.tid] = (cnt + 255) / 256; }
    __syncthreads();
    if (X.tid == 0) { int cum = 0, ts = 0;
        for (int e = 0; e < NE; ++e) { const int tc = tab[64 + e]; tab[e] = cum; tab[32 + e] = ts; cum += tc * NT; ts += tc; }
        tab[16] = cum; }
    __syncthreads();
}
__device__ __forceinline__ void phase_scatter(const Ctx& X, int l) {
    moe_table(X, l, 1);
    volatile LAS int* tab = (volatile LAS int*)(X.lds + LDS_MISC) + 8;
    volatile LAS int* cur = (volatile LAS int*)(X.lds + LDS_MISC + 4096) + 16;
    const int gw = X.bid * NWAVES + X.wave, NGW = X.G * NWAVES, lane = X.lane;
    if (X.tid < NE) cur[X.tid] = tab[32 + X.tid] * 256;
    __syncthreads();
    { const int* bc = X.ws<int>(WS_BCNT) + (X.tid & 15); int pre = 0;
        for (int b = X.tid >> 4; b < X.bid; b += NTHR / 16) pre += bc[b * NE];
        if (pre) lds_add(cur + (X.tid & 15), pre); }
    __syncthreads();
    const int* ei = X.ws<int>(WS_ROUT); int* slot = X.ws<int>(WS_ROUT) + (size_t)M * 4;
    for (int t = gw; t < M; t += NGW) { if (l == DEPTH - 1 && t < CTX) continue;
#pragma unroll
        for (int k = 0; k < 2; ++k) { const int e = ei[2 * t + k];
            int pos = 0; if (lane == 0) pos = lds_add(cur + e, 1);
            pos = __shfl(pos, 0);
            if (lane == 0) slot[2 * t + k] = pos;
            const u32x4* src = (const u32x4*)(X.ws<bf16>(WS_XMOD) + (size_t)t * D); u32x4* dst = (u32x4*)(X.ws<bf16>(WS_XG) + (size_t)pos * D);
            for (int i = lane; i < D / 8; i += 64) dst[i] = src[i]; } }
}

__device__ __forceinline__ void phase_combine(const Ctx& X, int l) {
    const int gw = X.bid * NWAVES + X.wave, NGW = X.G * NWAVES, lane = X.lane;
    const float* lng = X.in(I_LNG) + (size_t)(l * 2 + 1) * D; const float* lnb = X.in(I_LNB) + (size_t)(l * 2 + 1) * D;
    const float alpha = sqrtf(sqrtf(2.0f * DEPTH));
    const float* ew = (const float*)(X.ws<int>(WS_ROUT) + (size_t)M * 2); const int* slot = X.ws<int>(WS_ROUT) + (size_t)M * 4;
    for (int t = gw; t < M; t += NGW) { if (l == DEPTH - 1 && t < CTX) continue;
        float* xr = X.ws<float>(WS_X) + (size_t)t * D; const float* gate = modp(X, l, t, 5);
        const bf16* y0 = X.ws<bf16>(WS_YS) + (size_t)slot[2 * t] * D; const bf16* y1 = X.ws<bf16>(WS_YS) + (size_t)slot[2 * t + 1] * D; const float w0 = ew[2 * t], w1 = ew[2 * t + 1];
        float v[D / 64];
#pragma unroll
        for (int j = 0; j < D / 256; ++j) { const int d = 4 * lane + 256 * j; const f32x4 a = *(const f32x4*)(xr + d), gt = *(const f32x4*)(gate + d);
            const unsigned long long q0 = *(const unsigned long long*)(y0 + d), q1 = *(const unsigned long long*)(y1 + d);
            float ya[4] = {bflo((unsigned)q0), bfhi((unsigned)q0), bflo((unsigned)(q0 >> 32)), bfhi((unsigned)(q0 >> 32))};
            float yb[4] = {bflo((unsigned)q1), bfhi((unsigned)q1), bflo((unsigned)(q1 >> 32)), bfhi((unsigned)(q1 >> 32))};
#pragma unroll
            for (int i = 0; i < 4; ++i) v[4 * j + i] = alpha * a[i] + gt[i] * (w0 * ya[i] + w1 * yb[i]); }
        ln_inplace(v, lng, lnb, lane);
        if (l + 1 < DEPTH) { const float* sh = modp(X, l + 1, t, 0); const float* sc = modp(X, l + 1, t, 1); bf16* xm = X.ws<bf16>(WS_XMOD) + (size_t)t * D;
#pragma unroll
            for (int j = 0; j < D / 256; ++j) { const int d = 4 * lane + 256 * j; f32x4 o; const f32x4 a = *(const f32x4*)(sh + d), b = *(const f32x4*)(sc + d); float h[4];
#pragma unroll
                for (int i = 0; i < 4; ++i) { o[i] = v[4 * j + i]; h[i] = o[i] * (1.f + b[i]) + a[i]; }
                *(f32x4*)(xr + d) = o;
                *(unsigned long long*)(xm + d) = (unsigned long long)pk2(h[0], h[1]) | ((unsigned long long)pk2(h[2], h[3]) << 32); }
        } else if (t >= CTX) { float* orow = X.out() + (size_t)(t - CTX) * D; const bool bad = __hip_atomic_load(X.ctl() + CW_BAR + XB_TMO, RLX_AGENT) != 0u; const float pscale = 1.0f + bitsf(__hip_atomic_load(X.ctl() + 64, RLX_AGENT));
#pragma unroll
            for (int j = 0; j < D / 256; ++j) { const int d = 4 * lane + 256 * j; f32x4 o;
#pragma unroll
                for (int i = 0; i < 4; ++i) o[i] = bad ? __builtin_nanf("") : v[4 * j + i] * pscale;
                *(f32x4*)(orow + d) = o; }
        }
    }
}


#ifdef EMU
#define PHASE_FN static
#define THIN_FN static
#else
#define PHASE_FN __device__ __forceinline__
#define THIN_FN __device__ __noinline__
#endif
THIN_FN void ph_transposes(Ctx X, int l, int part) { phase_transposes(X, l, part); }
THIN_FN void ph_filters_begin(Ctx X) { phase_filters_begin(X); }
THIN_FN void ph_filters_item(Ctx X, int l, int which, int it) { phase_filters_item(X, l, which, it); }
THIN_FN void ph_filters_end(Ctx X) { phase_filters_end(X); }
#define PH_FILTERS(X_, l_) do { ph_filters_begin(X_); for (int wh_ = 0; wh_ < 2; ++wh_) for (int it_ = (X_).bid * NWAVES + (X_).wave; it_ < (wh_ ? CTX : SEQ) / 16; it_ += (X_).G * NWAVES) ph_filters_item(X_, l_, wh_, it_); ph_filters_end(X_); } while (0)
THIN_FN void ph_filter_weights(Ctx X, int l) { phase_filter_weights(X, l); }
THIN_FN void ph_mod(Ctx X) { phase_mod(X); }
THIN_FN void ph_x0(Ctx X) { phase_x0(X); }
THIN_FN void ph_lin(Ctx X, int l) { phase_lin(X, l); }
THIN_FN void ph_lora_a(Ctx X, int u) { lora_unit_a(X, u); }
THIN_FN void ph_lora_b(Ctx X, int l, int u) { lora_unit_b(X, l, u); }
THIN_FN void ph_prep_hyena(Ctx X, int l) { phase_prep_hyena(X, l); }
THIN_FN void ph_ctxconv(Ctx X, int l) { phase_ctxconv(X, l); }
THIN_FN void ph_chunk_1(Ctx X, int u) { chunk_unit_1(X, u); }
THIN_FN void ph_chunk_2(Ctx X, int u) { chunk_unit_2(X, u); }
THIN_FN void ph_chunk_3(Ctx X, int u) { chunk_unit_3(X, u); }
THIN_FN void ph_seq(Ctx X) { phase_seq(X); }
THIN_FN void ph_fft_tables(Ctx X) { fft_tables(X); }
THIN_FN void ph_fft_run(Ctx X, int inverse) { fft_run((LAS cf*)X.lds, (const LAS cf*)(X.lds + FFT_TAB_OFF), X.tid, inverse != 0); }
THIN_FN void ph_spec_load(Ctx X, int c) { spec_load(X, c); }
THIN_FN void ph_spec_unpack(Ctx X, int c) { spec_unpack(X, c); }
THIN_FN void ph_fftconv_load(Ctx X, int c) { fftconv_load(X, c); }
THIN_FN void ph_fftconv_mul(Ctx X, int c) { fftconv_mul(X, c); }
THIN_FN void ph_fftconv_out(Ctx X, int l, int c) { fftconv_out(X, l, c); }
THIN_FN void ph_finish(Ctx X, int l) { phase_finish(X, l); }
THIN_FN void ph_norm1(Ctx X, int l) { phase_norm1(X, l); }
THIN_FN void ph_scatter(Ctx X, int l) { phase_scatter(X, l); }
THIN_FN void ph_combine(Ctx X, int l) { phase_combine(X, l); }
PHASE_FN void ph_g13(Ctx X, int third, int r0) { pg8::Gemm g{(third ? X.ws<bf16>(WS_T) : X.ws<bf16>(WS_XMOD)) + (size_t)r0 * D, third ? X.ws<bf16>(WS_WO) : X.ws<bf16>(WS_WIN), D}; pg8::StaticOrder S; S.init(M - r0, third ? D : PCP, X.G, X.bid);
    pg8::EpiBf16OrF32 E{X.ws<bf16>(WS_P) + (size_t)r0 * PCP, X.ws<float>(WS_MIX) + (size_t)r0 * D, third ? D : PCP, third != 0}; pg8::gemm_phase(X.lds, g, S, E); }
PHASE_FN void ph_g2(Ctx X, int second, int r0) { pg8::Gemm g{(second ? X.ws<bf16>(WS_HO) : X.ws<bf16>(WS_RO)) + (size_t)r0 * RW, X.ws<bf16>(WS_WB) + (second ? (size_t)D * RW : 0), RW}; pg8::StaticOrder S; S.init(M - r0, D, X.G, X.bid);
    pg8::EpiGate E{X.ws<bf16>(WS_T) + (size_t)r0 * D, D, X.ws<bf16>(WS_P) + (size_t)r0 * PCP, PCP, second ? C_GH : C_GR, second != 0}; pg8::gemm_phase(X.lds, g, S, E); }
PHASE_FN void ph_g45(Ctx X, int l, int down) { const int NT = down ? D / 256 : 2 * D / 256; moe_table(X, l, NT); pg8::MoeOrder S{(const volatile LAS int*)(X.lds + LDS_MISC) + 8, NT, X.G, X.bid};
    pg8::Gemm g{down ? X.ws<bf16>(WS_ACT) : X.ws<bf16>(WS_XG), down ? X.ws<bf16>(WS_WD) : X.ws<bf16>(WS_WGU), D}; pg8::EpiMoe E{down ? X.ws<bf16>(WS_YS) : X.ws<bf16>(WS_ACT), D, NT, down == 0}; pg8::gemm_phase(X.lds, g, S, E); }

constexpr int NPH = 16, NPHASES = DEPTH * NPH;
template <int MASK> __global__ void __launch_bounds__(NTHR, 2) fwd_kernel(Args args) {
    DYN_LDS(lds);
    Ctx X; X.lds = lds; X.tid = threadIdx.x; X.lane = X.tid & 63; X.wave = READFIRSTLANE(X.tid >> 6); X.G = gridDim.x; X.bid = blockIdx.x;
    volatile LAS unsigned* misc = (volatile LAS unsigned*)(lds + LDS_MISC);
    if (X.tid < 128) misc[X.tid] = 0u;
    if (X.tid < N_IN + 2) { const unsigned long long p = X.tid < N_IN ? (unsigned long long)args.in[X.tid < N_IN ? X.tid : 0] : (X.tid == N_IN ? (unsigned long long)args.out : (unsigned long long)args.ws);
        misc[PT_WORD0 + 2 * X.tid] = (unsigned)p; misc[PT_WORD0 + 2 * X.tid + 1] = (unsigned)(p >> 32); }
    __syncthreads();
    XcdBarrier bar = xcd_barrier_post(X.ctl() + CW_BAR, misc);
    const int lo = args.ph_lo, hi = args.ph_hi;
#define IN(k) ((((MASK) >> ((k) % NPH)) & 1) && lo <= (k) && (k) < hi)
#ifdef PROBE_K
#ifndef PROBE_SCALE
#define PROBE_SCALE 1.0f
#endif
#ifndef PROBE_BLOCK
#define PROBE_BLOCK 0
#endif
    unsigned long long plast = __builtin_amdgcn_s_memrealtime(); if (threadIdx.x < 32) misc[2048 + threadIdx.x] = 0u; __syncthreads();
#define PROBE_TX(k) do { if (blockIdx.x == PROBE_BLOCK && threadIdx.x == 0) { const unsigned long long now_ = __builtin_amdgcn_s_memrealtime(); misc[2048 + (k)] += (unsigned)(now_ - plast); plast = now_; } } while (0)
#define PROBE_T(k) PROBE_TX((k) % NPH)
#define PROBE_PUB(k) do { if ((k) == NPHASES - 2 && blockIdx.x == PROBE_BLOCK && threadIdx.x == 0) { PROBE_T(k); unsigned tot_ = 0; for (int i_ = 0; i_ < 28; ++i_) tot_ += misc[2048 + i_]; \
        const float f_ = floorf(PROBE_SCALE * (float)misc[2048 + PROBE_K] / (float)tot_ * 128.0f + 0.5f) * (1.0f / 128.0f); __hip_atomic_store(X.ctl() + 64, fbits(f_), RLX_AGENT); } } while (0)
#else
#define PROBE_T(k) do {} while (0)
#define PROBE_TX(k) do {} while (0)
#define PROBE_PUB(k) do {} while (0)
#endif
#if defined(REPEAT_SUB) && REPEAT_SUB == 20
#define SEAM(k) do { if ((k) + 1 < hi) { xcd_barrier(bar); xcd_barrier(bar); } } while (0)
#else
#define SEAM(k) do { PROBE_PUB(k); if ((k) + 1 < hi) xcd_barrier(bar); PROBE_T(k); } while (0)
#endif
#if defined(REPEAT_SUB) && REPEAT_SUB == 15
#define RQN 2
#else
#define RQN 1
#endif
#ifdef REPEAT_SUB
#define RPS(id) for (int rps_ = 0; rps_ < ((id) == REPEAT_SUB ? 2 : 1); ++rps_)
#else
#define RPS(id)
#endif
#ifdef REPEAT_PH
#define RPT_IDX rpt_
#define RPT(k) for (int rpt_ = 0; rpt_ < (((k) % NPH) == REPEAT_PH ? 2 : 1); ++rpt_)
#else
#define RPT_IDX 0
#define RPT(k)
#endif
    for (int l = 0; l < DEPTH; ++l) {
        const int pb = l * NPH;
        if (l == 0 && IN(pb + 0)) { ph_transposes(X, l, 0); __syncthreads(); ph_filter_weights(X, 0); ph_mod(X); SEAM(pb + 0); }
        if (l == 0 && IN(pb + 1)) { ph_x0(X); PH_FILTERS(X, 0); SEAM(pb + 1); }
        if (IN(pb + 2)) { ph_g13(X, 0, 0); SEAM(pb + 2); }
        RPT(pb + 3) if (IN(pb + 3)) { RPS(6) ph_lin(X, l); RPS(7) ph_prep_hyena(X, l); ph_fft_tables(X); RPS(8) for (int c = X.bid; c < HW; c += X.G) { ph_spec_load(X, c); ph_fft_run(X, 0); ph_spec_unpack(X, c); } SEAM(pb + 3); }
        RPT(pb + 4) if (IN(pb + 4)) { for (int u = X.bid; u < (M / 64) * NH; u += X.G) { RPS(4) ph_lora_a(X, u); RPS(5) ph_lora_b(X, l, u); } SEAM(pb + 4); }
        RPT(pb + 5) if (IN(pb + 5)) { for (int u = X.bid; u < 2 * NCHK * NH; u += X.G) { RPS(1) ph_chunk_1(X, u); RPS(2) ph_chunk_2(X, u); RPS(3) ph_chunk_3(X, u); } SEAM(pb + 5); }
        RPT(pb + 6) if (IN(pb + 6)) { RPS(9) ph_seq(X); RPS(10) { ph_transposes(X, l, 1); __syncthreads(); } if (l + 1 < DEPTH) ph_filter_weights(X, l + 1); if (l + 1 < DEPTH) ph_ctxconv(X, l); ph_fft_tables(X);
            for (int rq_ = 0; rq_ < RQN; ++rq_) for (;;) { if (X.tid == 0) misc[121] = atomicAdd(X.ctl() + CW_Q + l * 64 + 32 + rq_, 1u); __syncthreads(); const int c = (int)misc[121]; __syncthreads(); if (c >= HW) break;
                ph_fftconv_load(X, c); ph_fft_run(X, 0); ph_fftconv_mul(X, c); ph_fft_run(X, 1); ph_fftconv_out(X, l, c); }
            SEAM(pb + 6); }
        RPT(pb + 7) if (IN(pb + 7)) { ph_finish(X, l); SEAM(pb + 7); }
        for (int sb = 0; sb < 2; ++sb) if (IN(pb + 8 + sb)) { ph_g2(X, sb, l == DEPTH - 1 ? CTX : 0); SEAM(pb + 8 + sb); }
        RPT(pb + 10) if (IN(pb + 10)) { ph_g13(X, 1, l == DEPTH - 1 ? CTX : 0); SEAM(pb + 10); }
        if (IN(pb + 11)) { ph_norm1(X, l); SEAM(pb + 11); }
        if (IN(pb + 12)) { RPS(14) ph_scatter(X, l); SEAM(pb + 12); }
        for (int dn = 0; dn < 2; ++dn) if (IN(pb + 13 + dn)) { ph_g45(X, l, dn); SEAM(pb + 13 + dn); }
        if (IN(pb + 15)) { RPS(11) ph_combine(X, l); if (l + 1 < DEPTH) { __syncthreads(); RPS(12) { ph_transposes(X, l + 1, 0); __syncthreads(); } RPS(13) PH_FILTERS(X, l + 1); } SEAM(pb + 15); }
    }
#undef IN
#undef SEAM
}

#ifndef N_LAUNCHES
#define N_LAUNCHES 1
#endif
#ifndef PH_MASK
#define PH_MASK 0xffff
#endif
template <int MASK> static void launch_mask(int grid, hipStream_t stream, const Args& a) {
    static bool attr = false;
    if (!attr) { (void)hipFuncSetAttribute((const void*)fwd_kernel<MASK>, hipFuncAttributeMaxDynamicSharedMemorySize, LDS_BYTES); attr = true; }
    hipLaunchKernelGGL(fwd_kernel<MASK>, dim3(grid), dim3(NTHR), LDS_BYTES, stream, a);
}
extern "C" void kernel_launch(void* const* d_in, const int* in_sizes, int n_in, void* d_out, int out_size, void* d_ws, size_t ws_size, hipStream_t stream) {
    static int grid = 0;
    if (grid == 0) {
        if (n_in != N_IN || ws_size < WS_END) { fprintf(stderr, "kernel_launch: unexpected n_in %d or workspace %zu < %zu\n", n_in, ws_size, (size_t)WS_END); grid = -1; return; }
        int dev = 0, cus = 0;
        if (hipGetDevice(&dev) != hipSuccess || hipDeviceGetAttribute(&cus, hipDeviceAttributeMultiprocessorCount, dev) != hipSuccess) { grid = -1; return; }
        (void)hipGetLastError();
        grid = cus; if (grid > NPART) grid = NPART;
    }
    if (grid < 0) return;
    (void)in_sizes; (void)out_size;
    (void)hipMemsetAsync(d_ws, 0, CTL_BYTES, stream);
    Args a;
    for (int i = 0; i < N_IN; ++i) a.in[i] = (const float*)d_in[i];
    a.out = (float*)d_out; a.ws = (unsigned char*)d_ws;
#if N_LAUNCHES == 1
    a.ph_lo = 0; a.ph_hi = NPHASES;
    launch_mask<PH_MASK>(grid, stream, a);
#else
    for (int ph = 0; ph < NPHASES; ++ph) { const int k = ph % NPH; if (k == 1 && ph / NPH != 0) continue; a.ph_lo = ph; a.ph_hi = ph + 1; launch_mask<PH_MASK>(grid, stream, a); }
#endif
}
```

```cpp
#ifndef EMU
#include <hip/hip_runtime.h>
#endif
#include <cstdio>
#include <cstdint>
#include <cmath>

#ifndef CFG_D
#define CFG_D 1024
#define CFG_SEQ 16384
#define CFG_CTX 256
#define CFG_DEPTH 4
#endif
constexpr int D = CFG_D, SEQ = CFG_SEQ, CTX = CFG_CTX, DEPTH = CFG_DEPTH, M = CTX + SEQ;
constexpr int GRID_W = 64, GRID_H = SEQ / GRID_W;
constexpr int RW = D / 2, NH = RW / 64, HW = D / 2, RC = 3 * RW + 384, HC = 3 * HW, GC = 2 * D, PC = RC + HC + GC, PCP = (PC + 255) / 256 * 256;
constexpr int QTR = RC / 4, HALFC = RC / 2;
constexpr int C_K = RW, C_V = 2 * RW, C_LWF = 3 * RW, C_LG = 3 * RW + 256;
constexpr int C_HY = RC, C_GR = RC + HC, C_GH = RC + HC + D;
constexpr int NE = 16, SP_TILES = (2 * M) / 256 + NE, SP = SP_TILES * 256;
constexpr float DECAY_SCALE = 0.606531f, GN_EPS = 6.4e-4f, LN_EPS = 1e-5f;
constexpr int LP = 72;
constexpr int LQ = 65;
constexpr int LX = 68;
constexpr int N_SEQ_UNITS = 2 * NH * 4;
constexpr int NPART = 256;
static_assert(CTX % 32 == 0 && M % 256 == 0 && D % 256 == 0 && RW % 128 == 0 && RW >= 256 && SEQ % 64 == 0 && CTX % 32 == 0 && RC % 4 == 0, "shape assumptions");

enum { I_X = 0, I_C, I_CTX, I_CCTX, I_WMOD, I_BMOD, I_WIN, I_MU, I_W0, I_W2, I_A0, I_A2, I_G2, I_KK, I_KA, I_RK, I_LNXG, I_LNXB, I_CW, I_CB,
       I_FW1, I_FB1, I_FW2, I_FB2, I_FW3, I_FB3, I_FWO, I_FREQ, I_HBIAS, I_WBR, I_WOUT, I_LNG, I_LNB, I_WR, I_RB, I_WG, I_WU, I_WD, N_IN };

constexpr size_t al256(size_t x) { return (x + 255) & ~(size_t)255; }
constexpr size_t CTL_BYTES = 1u << 20;
constexpr size_t WS_MOD = CTL_BYTES;
constexpr size_t WS_FPART = al256(WS_MOD + (size_t)DEPTH * 2 * 6 * D * 4);
constexpr size_t WS_ROUT = al256(WS_FPART + (size_t)2 * NPART * HW * 4);
constexpr size_t WS_BCNT = al256(WS_ROUT + (size_t)M * 2 * 4 * 3);
constexpr size_t WS_BONUS = al256(WS_BCNT + (size_t)NPART * NE * 4);
constexpr size_t WS_WIN = al256(WS_BONUS + (size_t)M * NH * 4);
constexpr size_t WS_WB = al256(WS_WIN + (size_t)PCP * D * 2);
constexpr size_t WS_WO = al256(WS_WB + (size_t)2 * D * RW * 2);
constexpr size_t WS_W2T = al256(WS_WO + (size_t)D * D * 2);
constexpr size_t WS_A2T = al256(WS_W2T + (size_t)2 * RW * 64 * 2);
constexpr size_t WS_G2T = al256(WS_A2T + (size_t)2 * RW * 64 * 2);
constexpr size_t WS_FWT = al256(WS_G2T + (size_t)RW * 128 * 2);
constexpr size_t WS_WGU = al256(WS_FWT + (size_t)(3 * 64 + HW) * 64 * 2);
constexpr size_t WS_WD = al256(WS_WGU + (size_t)NE * 2 * D * D * 2);
constexpr size_t WS_X = al256(WS_WD + (size_t)NE * D * D * 2);
constexpr size_t WS_XMOD = al256(WS_X + (size_t)M * D * 4);
constexpr size_t WS_P = al256(WS_XMOD + (size_t)M * D * 2);
constexpr size_t WS_FILT = al256(WS_P + (size_t)M * PCP * 2);
constexpr size_t WS_MIX = al256(WS_FILT + (size_t)M * HW * 4);
constexpr size_t WS_T = al256(WS_MIX + (size_t)M * D * 4);
constexpr size_t WS_S = al256(WS_T + (size_t)M * D * 2);
constexpr size_t WS_R = WS_S;
constexpr size_t WS_V = al256(WS_R + (size_t)M * RW * 2);
constexpr size_t WS_KA = al256(WS_V + (size_t)M * RW * 2);
constexpr size_t WS_KD = al256(WS_KA + (size_t)M * RW * 2);
constexpr size_t WS_KB = al256(WS_KD + (size_t)2 * M * RW * 2);
constexpr size_t WS_W = al256(WS_KB + (size_t)2 * M * RW * 2);
constexpr size_t WS_PQ = al256(WS_W + (size_t)2 * M * RW * 4);
constexpr size_t WS_LIN = WS_PQ;
static_assert((size_t)M * 384 * 2 <= (size_t)2 * NH * (M / 64) * 2 * 4096 * 4, "LIN fits PQ");
constexpr size_t WS_G = al256(WS_PQ + (size_t)2 * NH * (M / 64) * 2 * 4096 * 4);
constexpr size_t WS_YL = al256(WS_G + (size_t)2 * NH * (M / 64) * 4096 * 2);
constexpr size_t WS_S0 = WS_XMOD;
static_assert((size_t)2 * NH * (M / 64) * 4096 * 2 <= (size_t)M * D * 2, "S0 fits XMOD");
constexpr size_t WS_Z = al256(WS_YL + (size_t)2 * NH * (M / 64) * 4096 * 4);
constexpr size_t WS_X0 = al256(WS_Z + (size_t)CTX * HW * 4);
constexpr size_t WS_CONV = al256(WS_X0 + (size_t)M * HW * 2);
constexpr size_t WS_GATE = al256(WS_CONV + (size_t)CTX * HW * 4);
constexpr size_t WS_RO = al256(WS_GATE + (size_t)M * RW * 2);
constexpr size_t WS_HO = al256(WS_RO + (size_t)M * RW * 2);
constexpr size_t WS_HS = WS_MIX;
constexpr size_t WS_ZT = WS_T;
constexpr size_t WS_CVT = WS_FILT;
static_assert((size_t)HW * (SEQ + 1) * 8 <= (size_t)M * D * 4 && (size_t)HW * M * 4 <= (size_t)M * D * 2, "HS fits MIX, ZT fits T");
constexpr size_t WS_END1 = al256(WS_HO + (size_t)M * HW * 2);
constexpr size_t WS_XG = WS_S;
constexpr size_t WS_ACT = al256(WS_XG + (size_t)SP * D * 2);
constexpr size_t WS_YS = al256(WS_ACT + (size_t)SP * D * 2);
constexpr size_t WS_END2 = al256(WS_YS + (size_t)SP * D * 2);
constexpr size_t WS_END = WS_END1 > WS_END2 ? WS_END1 : WS_END2;
constexpr int CW_TMO = 0, CW_BAR = 4096, CW_CNT = 8192  , CW_CUR = 8192 + 1024  , CW_Q = 8192 + 2048  ;

#ifdef EMU
#define LAS
typedef short bf16x8 __attribute__((vector_size(16)));
typedef float f32x4 __attribute__((vector_size(16)));
typedef unsigned u32x4 __attribute__((vector_size(16)));
#define DYN_LDS(name) unsigned char* name = emu_cur_lds()
#define ASM_WAIT_V(n) do {} while (0)
#define ASM_WAIT_L(n) do {} while (0)
#define ASM_WAIT_VL0() do {} while (0)
#define CFENCE() do {} while (0)
#define WAVE_LDS_FENCE() emu_wave_sync()
#define S_BARRIER() emu_block_sync()
#define SCHED_BARRIER() do {} while (0)
#define SETPRIO(x) do {} while (0)
#define S_SLEEP(n) emu_yield()
#define MFMA16(a, b, c) emu_mfma_16x16x32(a, b, c)
#define MFMA4F(a, b, c) emu_mfma_16x16x4f32(a, b, c)
#define GLDS16(gptr, lptr) emu_glds16((const void*)(gptr), (void*)(lptr))
#define READFIRSTLANE(x) (x)
#define XCC_ID_() (blockIdx.x & 7u)
#define FENCE_RELEASE() do {} while (0)
#define FENCE_ACQUIRE() do {} while (0)
#define DPP_F(v, ctrl) emu_dpp_f(v, ctrl)
#define READLANE_F(v, l) emu_xchg((float)(v), (l))
static inline int vgpr_zero() { return 0; }
static inline unsigned long long vgpr_zero64() { return 0ull; }
static inline int lds_add(volatile int* p, int v) { int o = *p; *p = o + v; return o; }
static inline void lds_addf(float* p, float v) { *p += v; }
static inline unsigned fbits(float f) { unsigned u; memcpy(&u, &f, 4); return u; }
static inline float bitsf(unsigned u) { float f; memcpy(&f, &u, 4); return f; }
#else
#define LAS __attribute__((address_space(3)))
typedef short bf16x8 __attribute__((ext_vector_type(8)));
typedef float f32x4 __attribute__((ext_vector_type(4)));
typedef unsigned u32x4 __attribute__((ext_vector_type(4)));
#define DYN_LDS(name) extern __shared__ __attribute__((aligned(16))) unsigned char name##_raw[]; LAS unsigned char* name = (LAS unsigned char*)name##_raw
#define ASM_WAIT_V(n) asm volatile("s_waitcnt vmcnt(" #n ")" ::: "memory")
#define ASM_WAIT_L(n) asm volatile("s_waitcnt lgkmcnt(" #n ")" ::: "memory")
#define ASM_WAIT_VL0() asm volatile("s_waitcnt vmcnt(0) lgkmcnt(0)" ::: "memory")
#define CFENCE() asm volatile("" ::: "memory")
#define WAVE_LDS_FENCE() asm volatile("s_waitcnt lgkmcnt(0)" ::: "memory")
#define S_BARRIER() __builtin_amdgcn_s_barrier()
#define SCHED_BARRIER() __builtin_amdgcn_sched_barrier(0)
#define SETPRIO(x) __builtin_amdgcn_s_setprio(x)
#define S_SLEEP(n) __builtin_amdgcn_s_sleep(n)
#define MFMA16(a, b, c) __builtin_amdgcn_mfma_f32_16x16x32_bf16(a, b, c, 0, 0, 0)
#define MFMA4F(a, b, c) __builtin_amdgcn_mfma_f32_16x16x4f32(a, b, c, 0, 0, 0)
#define GLDS16(gptr, lptr) __builtin_amdgcn_global_load_lds((const unsigned*)(gptr), (LAS unsigned*)(lptr), 16, 0, 0)
#define READFIRSTLANE(x) __builtin_amdgcn_readfirstlane(x)
#define XCC_ID_() ((unsigned)__builtin_amdgcn_s_getreg((3 << 11) | 20) & 0xFu)
#define FENCE_RELEASE() __builtin_amdgcn_fence(__ATOMIC_RELEASE, "agent")
#define FENCE_ACQUIRE() __builtin_amdgcn_fence(__ATOMIC_ACQUIRE, "agent")
#define DPP_F(v, ctrl) __builtin_bit_cast(float, __builtin_amdgcn_update_dpp(0, __builtin_bit_cast(int, (float)(v)), (ctrl), 0xF, 0xF, true))
#define READLANE_F(v, l) __builtin_bit_cast(float, __builtin_amdgcn_readlane(__builtin_bit_cast(int, (float)(v)), (l)))
__device__ __forceinline__ int vgpr_zero() { int z; asm volatile("v_mov_b32 %0, 0" : "=v"(z)); return z; }
__device__ __forceinline__ unsigned long long vgpr_zero64() { unsigned long long z; asm volatile("v_mov_b64 %0, 0" : "=v"(z)); return z; }
__device__ __forceinline__ void lds_addf(LAS float* p, float v) { (void)__hip_atomic_fetch_add(p, v, __ATOMIC_RELAXED, __HIP_MEMORY_SCOPE_WORKGROUP); }
__device__ __forceinline__ int lds_add(volatile LAS int* p, int v) { return __hip_atomic_fetch_add((LAS int*)p, v, __ATOMIC_RELAXED, __HIP_MEMORY_SCOPE_WORKGROUP); }
__device__ __forceinline__ unsigned fbits(float f) { return __builtin_bit_cast(unsigned, f); }
__device__ __forceinline__ float bitsf(unsigned u) { return __builtin_bit_cast(float, u); }
#endif
typedef unsigned short bf16;
#define RLX_AGENT __ATOMIC_RELAXED, __HIP_MEMORY_SCOPE_AGENT

__device__ __forceinline__ unsigned f2bf(float f) { unsigned u = fbits(f); return (u + 0x7fffu + ((u >> 16) & 1u)) >> 16; }
__device__ __forceinline__ unsigned pk2(float lo, float hi) { return f2bf(lo) | (f2bf(hi) << 16); }
__device__ __forceinline__ float bf2f(bf16 b) { return bitsf(((unsigned)b) << 16); }
__device__ __forceinline__ float bflo(unsigned w) { return bitsf(w << 16); }
__device__ __forceinline__ float bfhi(unsigned w) { return bitsf(w & 0xffff0000u); }
#ifdef EMU
__device__ __forceinline__ float fexp(float x) { return expf(x); }
__device__ __forceinline__ float frcp(float x) { return 1.0f / x; }
#else
__device__ __forceinline__ float fexp(float x) { return __builtin_amdgcn_exp2f(x * 1.4426950408889634f); }
__device__ __forceinline__ float frcp(float x) { return __builtin_amdgcn_rcpf(x); }
#endif
__device__ __forceinline__ float sigmoidf_(float x) { return frcp(1.0f + fexp(-x)); }
__device__ __forceinline__ float row16_sum(float v) {
    v += DPP_F(v, 0xB1);
    v += DPP_F(v, 0x4E);
    v += DPP_F(v, 0x141);
    v += DPP_F(v, 0x140);
    return v;
}
__device__ __forceinline__ float wave_sum(float v) {
    const float r = row16_sum(v);
    return (READLANE_F(r, 0) + READLANE_F(r, 16)) + (READLANE_F(r, 32) + READLANE_F(r, 48));
}
__device__ __forceinline__ void sincos_f(float x, float& s, float& c) {
    const float k = rintf(x * 0.63661977236758134f);
    float r = fmaf(-k, 1.5703125f, x); r = fmaf(-k, 4.837512969970703125e-4f, r); r = fmaf(-k, 7.54978994989188216e-8f, r);
    const float r2 = r * r;
    const float sp = r + r * r2 * (-1.6666654611e-1f + r2 * (8.3321608736e-3f + r2 * (-1.9515295891e-4f)));
    const float cp = 1.0f - 0.5f * r2 + r2 * r2 * (4.166664568298827e-2f + r2 * (-1.388731625493765e-3f + r2 * (2.443315711809948e-5f)));
    const int q = ((int)k) & 3;
    s = (q == 0) ? sp : (q == 1) ? cp : (q == 2) ? -sp : -cp;
    c = (q == 0) ? cp : (q == 1) ? -sp : (q == 2) ? -cp : sp;
}
__device__ __forceinline__ float sin_f(float x) { float s, c; sincos_f(x, s, c); return s; }

template <class T> __device__ __forceinline__ T* as_global(T* p) {
#ifndef EMU
    return (T*)(__attribute__((address_space(1))) T*)(unsigned long long)p;
#else
    return p;
#endif
}
#define XB_TMO      128
#define XB_XCNT(j)  (256  + 64 * (j))
#define XB_XSUB(j)  (1280 + 64 * (j))
#define XB_XGEN(j)  (2304 + 64 * (j))
#define XB_TOP      3328
#define XB_TOPGEN   3392
#define XCD_BAR_WORDS 3456
#define XB_SPIN_CAP (1u << 18)
__device__ __forceinline__ unsigned xb_ld(unsigned* p)              { return __hip_atomic_load(p, __ATOMIC_RELAXED, __HIP_MEMORY_SCOPE_AGENT); }
__device__ __forceinline__ unsigned xb_add(unsigned* p, unsigned v) { return __hip_atomic_fetch_add(p, v, __ATOMIC_RELAXED, __HIP_MEMORY_SCOPE_AGENT); }
#define XB_SPIN(cond, bar) do { unsigned _sp = 0; while (cond) { S_SLEEP(1); \
    if ((++_sp & 255u) == 0u) { if (xb_ld(&(bar)[XB_TMO])) break; if (_sp > XB_SPIN_CAP) { atomicAdd(&(bar)[XB_TMO], 1u); break; } } } } while (0)
struct XcdBarrier { unsigned* bar; unsigned x; volatile LAS unsigned* st; };
__device__ __forceinline__ XcdBarrier xcd_barrier_post(unsigned* bar, volatile LAS unsigned* st) {
    XcdBarrier b; b.bar = nullptr; b.x = XCC_ID_(); b.st = st;
    if (threadIdx.x == 0) { st[2] = (unsigned)(unsigned long long)bar; st[3] = (unsigned)((unsigned long long)bar >> 32); st[4] = b.x; (void)xb_add(&bar[XB_XCNT(b.x)], 1u); }
    return b;
}
__device__ __forceinline__ void xcd_barrier_complete(unsigned* bar, unsigned x, unsigned& nloc, unsigned& nx) {
    const unsigned G = gridDim.x * gridDim.y * gridDim.z;
    unsigned sum, cnt, mine, sp = 0u;
    for (;;) {
        sum = 0u; cnt = 0u; mine = 0u;
#pragma unroll
        for (unsigned j = 0; j < 16; ++j) { const unsigned c = xb_ld(&bar[XB_XCNT(j)]); sum += c; cnt += (c > 0u) ? 1u : 0u; mine = (j == x) ? c : mine; }
        if (sum == G) break;
        S_SLEEP(1);
        if ((++sp & 255u) == 0u) { if (xb_ld(&bar[XB_TMO])) break; if (sp > XB_SPIN_CAP) { atomicAdd(&bar[XB_TMO], 1u); break; } }
    }
    nloc = mine > 0u ? mine : 1u; nx = cnt > 0u ? cnt : 1u;
}
__device__ __forceinline__ void xcd_barrier(const XcdBarrier& b) {
    ASM_WAIT_V(0);
    __syncthreads();
    if (threadIdx.x == 0) {
        unsigned* bar = as_global((unsigned*)(((unsigned long long)b.st[3] << 32) | b.st[2]));
        const unsigned bx = b.st[4];
        ASM_WAIT_VL0();
        unsigned nloc = b.st[0], nx = b.st[1];
        if (nloc == 0u) { xcd_barrier_complete(bar, bx, nloc, nx); b.st[0] = nloc; b.st[1] = nx; }
        const unsigned old = xb_add(&bar[XB_XSUB(bx)], 1u);
        const unsigned gen = old / nloc;
        if (old + 1u == (gen + 1u) * nloc) {
            FENCE_RELEASE();
            ASM_WAIT_V(0);
            const unsigned og = xb_add(&bar[XB_TOP], 1u);
            const unsigned tg = og / nx;
            if (og + 1u == (tg + 1u) * nx) xb_add(&bar[XB_TOPGEN], 1u);
            else XB_SPIN(xb_ld(&bar[XB_TOPGEN]) == tg, bar);
            FENCE_ACQUIRE();
            xb_add(&bar[XB_XGEN(bx)], 1u);
            ASM_WAIT_V(0);
        } else {
            XB_SPIN(xb_ld(&bar[XB_XGEN(bx)]) == gen, bar);
            FENCE_ACQUIRE();
            ASM_WAIT_V(0);
        }
    }
    __syncthreads();
}

namespace pg8 {
constexpr int BM = 256, BK = 64, HALF = 128, HTB = HALF * BK * 2, STAGE_BYTES = 8 * HTB, NXCD = 8, WGM = 8;
__host__ __device__ __forceinline__ int lds_byte(int r, int c) { const int st = (r >> 4) * 2 + (c >> 5), rr = r & 15, cc = c & 31, ob = rr * 64 + cc * 2; return st * 1024 + (ob ^ (((ob >> 9) & 1) << 5)); }
__host__ __device__ __forceinline__ void stage_rc(int b, int& R, int& C) { const int st = b / 1024, sb = b % 1024, swz = sb ^ (((sb >> 9) & 1) << 5); R = (st >> 1) * 16 + swz / 64; C = (st & 1) * 32 + (swz % 64) / 2; }
__host__ __device__ __forceinline__ int perm32(int rho) { const int n = rho >> 4, i = rho & 15; return 8 * (i >> 2) + 4 * n + (i & 3); }
struct Unit { int pm, pn; };
struct Gemm { const bf16* A; const bf16* Bt; int K; };
struct StaticOrder {
    int nM, nN, nwg, G, c;
    __host__ __device__ void init(int M_, int N_, int G_, int c_) { nM = M_ / BM; nN = N_ / BM; nwg = nM * nN; G = G_; c = c_; }
    __host__ __device__ bool next(int i, Unit& u) const {
        const long L = (long)i * G + c; if (L >= nwg) return false;
        int wgid = (int)L; { const int q = nwg / NXCD, r = nwg % NXCD, xcd = wgid % NXCD, off = wgid / NXCD; wgid = (xcd < r ? xcd * (q + 1) : r * (q + 1) + (xcd - r) * q) + off; }
        const int nig = WGM * nN, gid = wgid / nig, fm = gid * WGM, gsz = (nM - fm) < WGM ? (nM - fm) : WGM;
        u.pm = fm + ((wgid % nig) % gsz); u.pn = (wgid % nig) / gsz; return true;
    }
};
struct MoeOrder {
    const volatile LAS int* tab; int NT, G, c;
    __device__ __forceinline__ bool next(int i, Unit& u) const {
        const long L = (long)i * G + c; if (L >= tab[16]) return false;
        int e = 0; while (L >= tab[e + 1]) ++e;
        const int loc = (int)L - tab[e], tc = tab[64 + e];
        u.pm = tab[32 + e] + loc % tc; u.pn = e * NT + loc / tc; return true;
    }
};
__device__ __forceinline__ unsigned cvt_pk_bf16(float lo, float hi) {
#ifdef EMU
    return pk2(lo, hi);
#else
    unsigned r; asm volatile("v_cvt_pk_bf16_f32 %0, %1, %2" : "=v"(r) : "v"(lo), "v"(hi)); return r;
#endif
}

struct EpiBf16 {
    static constexpr bool PERM = true;
    bf16* O; int ldc;
    __device__ __forceinline__ void operator()(const f32x4 (&acc)[2][2][4][2], const Unit& u, int wr, int wc, int fr, int fq) const {
        const int row0 = u.pm * BM + wr * 64 + fr, col0 = u.pn * BM + wc * 32 + 8 * fq;
#pragma unroll
        for (int ai = 0; ai < 2; ++ai)
#pragma unroll
            for (int m = 0; m < 4; ++m) { bf16* rowp = O + (size_t)(row0 + ai * HALF + m * 16) * ldc + col0;
#pragma unroll
                for (int bj = 0; bj < 2; ++bj) { const f32x4 v0 = acc[ai][bj][m][0], v1 = acc[ai][bj][m][1];
                    u32x4 w; w[0] = cvt_pk_bf16(v0[0], v0[1]); w[1] = cvt_pk_bf16(v0[2], v0[3]); w[2] = cvt_pk_bf16(v1[0], v1[1]); w[3] = cvt_pk_bf16(v1[2], v1[3]);
                    *(u32x4*)(rowp + bj * HALF) = w; } }
    }
};
struct EpiF32 {
    static constexpr bool PERM = true;
    float* C; int ldc;
    __device__ __forceinline__ void operator()(const f32x4 (&acc)[2][2][4][2], const Unit& u, int wr, int wc, int fr, int fq) const {
        const int row0 = u.pm * BM + wr * 64 + fr, col0 = u.pn * BM + wc * 32 + 8 * fq;
#pragma unroll
        for (int ai = 0; ai < 2; ++ai)
#pragma unroll
            for (int m = 0; m < 4; ++m) { float* rowp = C + (size_t)(row0 + ai * HALF + m * 16) * ldc + col0;
#pragma unroll
                for (int bj = 0; bj < 2; ++bj)
#pragma unroll
                    for (int n = 0; n < 2; ++n) *(f32x4*)(rowp + bj * HALF + n * 4) = acc[ai][bj][m][n]; }
    }
};
struct EpiGate {
    static constexpr bool PERM = true;
    bf16* T; int ldc; const bf16* Pg; int ldp; int gcol0; bool ADD;
    __device__ __forceinline__ void operator()(const f32x4 (&acc)[2][2][4][2], const Unit& u, int wr, int wc, int fr, int fq) const {
        const int row0 = u.pm * BM + wr * 64 + fr, col0 = u.pn * BM + wc * 32 + 8 * fq;
#pragma unroll
        for (int ai = 0; ai < 2; ++ai)
#pragma unroll
            for (int m = 0; m < 4; ++m) { const size_t row = (size_t)(row0 + ai * HALF + m * 16);
#pragma unroll
                for (int bj = 0; bj < 2; ++bj) { const f32x4 v0 = acc[ai][bj][m][0], v1 = acc[ai][bj][m][1];
                    const u32x4 g = *(const u32x4*)(Pg + row * ldp + gcol0 + col0 + bj * HALF);
                    u32x4 t = {0u, 0u, 0u, 0u}; if (ADD) t = *(const u32x4*)(T + row * ldc + col0 + bj * HALF);
                    float o[8];
#pragma unroll
                    for (int j = 0; j < 4; ++j) { const float a0 = j < 2 ? v0[2 * j] : v1[2 * j - 4], a1 = j < 2 ? v0[2 * j + 1] : v1[2 * j - 3];
                        o[2 * j] = bflo(t[j]) + sigmoidf_(bflo(g[j])) * a0; o[2 * j + 1] = bfhi(t[j]) + sigmoidf_(bfhi(g[j])) * a1; }
                    u32x4 w; w[0] = cvt_pk_bf16(o[0], o[1]); w[1] = cvt_pk_bf16(o[2], o[3]); w[2] = cvt_pk_bf16(o[4], o[5]); w[3] = cvt_pk_bf16(o[6], o[7]);
                    *(u32x4*)(T + row * ldc + col0 + bj * HALF) = w; } }
    }
};
struct EpiSwiglu {
    static constexpr bool PERM = true;
    bf16* O; int ldc; int NT;
    __device__ __forceinline__ void operator()(const f32x4 (&acc)[2][2][4][2], const Unit& u, int wr, int wc, int fr, int fq) const {
        const int row0 = u.pm * BM + wr * 64 + fr, col0 = (u.pn % NT) * HALF + wc * 32 + 8 * fq;
#pragma unroll
        for (int ai = 0; ai < 2; ++ai)
#pragma unroll
            for (int m = 0; m < 4; ++m) { bf16* rowp = O + (size_t)(row0 + ai * HALF + m * 16) * ldc + col0;
                float o[8];
#pragma unroll
                for (int j = 0; j < 8; ++j) { const float g = acc[ai][0][m][j >> 2][j & 3], uu = acc[ai][1][m][j >> 2][j & 3]; o[j] = g / (1.0f + expf(-g)) * uu; }
                u32x4 w; w[0] = cvt_pk_bf16(o[0], o[1]); w[1] = cvt_pk_bf16(o[2], o[3]); w[2] = cvt_pk_bf16(o[4], o[5]); w[3] = cvt_pk_bf16(o[6], o[7]);
                *(u32x4*)rowp = w; }
    }
};
struct EpiMoeDown {
    static constexpr bool PERM = true;
    bf16* O; int ldc; int NT;
    __device__ __forceinline__ void operator()(const f32x4 (&acc)[2][2][4][2], const Unit& u, int wr, int wc, int fr, int fq) const {
        const int row0 = u.pm * BM + wr * 64 + fr, col0 = (u.pn % NT) * BM + wc * 32 + 8 * fq;
#pragma unroll
        for (int ai = 0; ai < 2; ++ai)
#pragma unroll
            for (int m = 0; m < 4; ++m) { bf16* rowp = O + (size_t)(row0 + ai * HALF + m * 16) * ldc + col0;
#pragma unroll
                for (int bj = 0; bj < 2; ++bj) { const f32x4 v0 = acc[ai][bj][m][0], v1 = acc[ai][bj][m][1];
                    u32x4 w; w[0] = cvt_pk_bf16(v0[0], v0[1]); w[1] = cvt_pk_bf16(v0[2], v0[3]); w[2] = cvt_pk_bf16(v1[0], v1[1]); w[3] = cvt_pk_bf16(v1[2], v1[3]);
                    *(u32x4*)(rowp + bj * HALF) = w; } }
    }
};

struct EpiBf16OrF32 { static constexpr bool PERM = true; bf16* O; float* C; int ldc; bool f32;
    __device__ __forceinline__ void operator()(const f32x4 (&acc)[2][2][4][2], const Unit& u, int wr, int wc, int fr, int fq) const {
        if (f32) { EpiF32 E{C, ldc}; E(acc, u, wr, wc, fr, fq); } else { EpiBf16 E{O, ldc}; E(acc, u, wr, wc, fr, fq); } } };
struct EpiMoe { static constexpr bool PERM = true; bf16* O; int ldc; int NT; bool swiglu;
    __device__ __forceinline__ void operator()(const f32x4 (&acc)[2][2][4][2], const Unit& u, int wr, int wc, int fr, int fq) const {
        if (swiglu) { EpiSwiglu E{O, ldc, NT}; E(acc, u, wr, wc, fr, fq); } else { EpiMoeDown E{O, ldc, NT}; E(acc, u, wr, wc, fr, fq); } } };
template <class Epi, class Sched>
__device__ __forceinline__ void gemm_phase(LAS unsigned char* lds, const Gemm g, const Sched& S, const Epi& E) {
    const int tid = threadIdx.x + vgpr_zero();
    const int wid = READFIRSTLANE(tid >> 6), lane = tid & 63, wr = wid >> 2, wc = wid & 3, fr = lane & 15, fq = lane >> 4;
    const int K = g.K, nt = K / BK;
    unsigned long long voffA[2], voffB[2]; const unsigned long long zhi = vgpr_zero64();
#pragma unroll
    for (int i = 0; i < 2; ++i) { int R, C; stage_rc(tid * 16 + i * 8192, R, C); const int Rb = Epi::PERM ? ((R & ~31) + perm32(R & 31)) : R;
        voffA[i] = zhi + (unsigned long long)(long long)((R * K + C) * 2); voffB[i] = zhi + (unsigned long long)(long long)((Rb * K + C) * 2); }
    const size_t kstep = (size_t)(BK * 2);
    const size_t hstep = (size_t)HALF * K * 2;
    const size_t tstep = 2 * hstep;
    const unsigned ldsw = (unsigned)wid * 1024u;
    const int aoff = lds_byte(wr * 64 + fr, fq * 8), boff = lds_byte(wc * 32 + fr, fq * 8);
#define PG8_SA(b, h) (((b) * 2 + (h)) * HTB)
#define PG8_SB(b, h) ((4 + (b) * 2 + (h)) * HTB)
#define PG8_STAGE(bufoff, gbase, voff) do { _Pragma("unroll") for (int _i = 0; _i < 2; ++_i) \
        GLDS16((const char*)(gbase) + (voff)[_i], lds + (bufoff) + ldsw + _i * 8192); } while (0)
#define PG8_LDA(dst, b, h) do { _Pragma("unroll") for (int m = 0; m < 4; ++m) _Pragma("unroll") for (int k = 0; k < 2; ++k) dst[m][k] = *(const LAS bf16x8*)(lds + PG8_SA(b, h) + aoff + m * 2048 + k * 1024); } while (0)
#define PG8_LDB(dst, b, h) do { _Pragma("unroll") for (int n = 0; n < 2; ++n) _Pragma("unroll") for (int k = 0; k < 2; ++k) dst[n][k] = *(const LAS bf16x8*)(lds + PG8_SB(b, h) + boff + n * 2048 + k * 1024); } while (0)
#define PG8_MMA(ai, bj, At, Bt) do { SETPRIO(1); _Pragma("unroll") for (int m = 0; m < 4; ++m) _Pragma("unroll") for (int n = 0; n < 2; ++n) _Pragma("unroll") for (int k = 0; k < 2; ++k) \
        acc[ai][bj][m][n] = MFMA16(Bt[n][k], At[m][k], acc[ai][bj][m][n]); SETPRIO(0); } while (0)
#define PG8_BAR S_BARRIER()
    Unit cur, nxt; int ui = 0;
    if (!S.next(0, cur)) return;
    f32x4 acc[2][2][4][2];
#pragma unroll
    for (int a = 0; a < 2; ++a)
#pragma unroll
        for (int b = 0; b < 2; ++b)
#pragma unroll
            for (int m = 0; m < 4; ++m)
#pragma unroll
                for (int n = 0; n < 2; ++n) acc[a][b][m][n] = (f32x4){0.f, 0.f, 0.f, 0.f};
    bf16x8 At[4][2], B0[2][2], B1[2][2];
    const char* cA = (const char*)g.A + (size_t)cur.pm * tstep; const char* cB = (const char*)g.Bt + (size_t)cur.pn * tstep;
    PG8_STAGE(PG8_SB(0, 0), cB, voffB); PG8_STAGE(PG8_SA(0, 0), cA, voffA); PG8_STAGE(PG8_SB(0, 1), cB + hstep, voffB); PG8_STAGE(PG8_SA(0, 1), cA + hstep, voffA);
    if (wr == 1) PG8_BAR;
    ASM_WAIT_V(4); PG8_BAR;
    PG8_STAGE(PG8_SB(1, 0), cB + kstep, voffB); PG8_STAGE(PG8_SA(1, 0), cA + kstep, voffA); PG8_STAGE(PG8_SB(1, 1), cB + hstep + kstep, voffB);
    ASM_WAIT_V(6); PG8_BAR;
    for (;;) {
        const bool has_next = S.next(ui + 1, nxt);
        const char* nA = has_next ? (const char*)g.A + (size_t)nxt.pm * tstep : cA; const char* nB = has_next ? (const char*)g.Bt + (size_t)nxt.pn * tstep : cB;
        for (int t = 0; t < nt; t += 2) {
            const bool last = (t == nt - 2);
            const char* a1 = cA + (size_t)(t + 1) * kstep;
            const char* a2 = last ? nA : cA + (size_t)(t + 2) * kstep; const char* b2 = last ? nB : cB + (size_t)(t + 2) * kstep;
            const char* a3 = a2 + kstep; const char* b3 = b2 + kstep;
            PG8_LDB(B0, 0, 0); SCHED_BARRIER(); PG8_LDA(At, 0, 0); PG8_STAGE(PG8_SA(1, 1), a1 + hstep, voffA);
            ASM_WAIT_L(8); PG8_BAR; ASM_WAIT_L(0); PG8_MMA(0, 0, At, B0); PG8_BAR; SCHED_BARRIER();
            PG8_LDB(B1, 0, 1); PG8_STAGE(PG8_SB(0, 0), b2, voffB);
            PG8_BAR; ASM_WAIT_L(0); PG8_MMA(0, 1, At, B1); PG8_BAR;
            PG8_LDA(At, 0, 1); PG8_STAGE(PG8_SA(0, 0), a2, voffA);
            PG8_BAR; ASM_WAIT_L(0); PG8_MMA(1, 0, At, B0); PG8_BAR; SCHED_BARRIER();
            PG8_STAGE(PG8_SB(0, 1), b2 + hstep, voffB);
            ASM_WAIT_V(6); PG8_BAR; PG8_MMA(1, 1, At, B1); PG8_BAR;
            PG8_LDB(B0, 1, 0); SCHED_BARRIER(); PG8_LDA(At, 1, 0); PG8_STAGE(PG8_SA(0, 1), a2 + hstep, voffA);
            ASM_WAIT_L(8); PG8_BAR; ASM_WAIT_L(0); PG8_MMA(0, 0, At, B0); PG8_BAR; SCHED_BARRIER();
            PG8_LDB(B1, 1, 1); PG8_STAGE(PG8_SB(1, 0), b3, voffB);
            PG8_BAR; ASM_WAIT_L(0); PG8_MMA(0, 1, At, B1); PG8_BAR;
            PG8_LDA(At, 1, 1); PG8_STAGE(PG8_SA(1, 0), a3, voffA);
            PG8_BAR; ASM_WAIT_L(0); PG8_MMA(1, 0, At, B0); PG8_BAR; SCHED_BARRIER();
            PG8_STAGE(PG8_SB(1, 1), b3 + hstep, voffB);
            ASM_WAIT_V(6); PG8_BAR; PG8_MMA(1, 1, At, B1); PG8_BAR;
        }
        E(acc, cur, wr, wc, fr, fq);
        if (!has_next) break;
#pragma unroll
        for (int a = 0; a < 2; ++a)
#pragma unroll
            for (int b = 0; b < 2; ++b)
#pragma unroll
                for (int m = 0; m < 4; ++m)
#pragma unroll
                    for (int n = 0; n < 2; ++n) acc[a][b][m][n] = (f32x4){0.f, 0.f, 0.f, 0.f};
        cur = nxt; cA = nA; cB = nB; ++ui;
    }
    ASM_WAIT_V(0);
    if (wr == 0) PG8_BAR;
    PG8_BAR;
#undef PG8_SA
#undef PG8_SB
#undef PG8_STAGE
#undef PG8_LDA
#undef PG8_LDB
#undef PG8_MMA
#undef PG8_BAR
}
}

struct Args { const float* in[N_IN]; float* out; unsigned char* ws; int ph_lo, ph_hi; };
constexpr int NWAVES = 8, NTHR = 512;
constexpr int LDS_STAGE = 131072, LDS_MISC = LDS_STAGE, LDS_BYTES = 147456;

constexpr int PT_OUT = N_IN, PT_WS = N_IN + 1, PT_WORD0 = 128;

struct Ctx {
    LAS unsigned char* lds; int tid, lane, wave, G, bid;
    __device__ __forceinline__ unsigned long long ptr(int i) const { const volatile LAS unsigned* t = (const volatile LAS unsigned*)(lds + LDS_MISC) + PT_WORD0 + 2 * i;
        const unsigned lo = (unsigned)READFIRSTLANE((int)t[0]), hi = (unsigned)READFIRSTLANE((int)t[1]); return ((unsigned long long)hi << 32) | lo; }
    __device__ __forceinline__ unsigned long long ptrv(int i) const { const volatile LAS unsigned* t = (const volatile LAS unsigned*)(lds + LDS_MISC) + PT_WORD0 + 2 * i; return ((unsigned long long)t[1] << 32) | t[0]; }
    __device__ __forceinline__ const float* inv(int i) const { return as_global((const float*)ptrv(i)); }
    template <class T> __device__ __forceinline__ T* wsv(size_t off) const { return as_global((T*)((unsigned char*)ptrv(PT_WS) + off)); }
    __device__ __forceinline__ const float* in(int i) const { return as_global((const float*)ptr(i)); }
    __device__ __forceinline__ float* out() const { return as_global((float*)ptr(PT_OUT)); }
    template <class T> __device__ __forceinline__ T* ws(size_t off) const { return as_global((T*)((unsigned char*)ptr(PT_WS) + off)); }
    __device__ __forceinline__ unsigned* ctl() const { return as_global((unsigned*)ptr(PT_WS)); }
};

__device__ __forceinline__ void transpose_item(const float* W, int ldw, int k0, int n0, int nvalid, bf16* outp, int ldo, LAS float* scr, int lane) {
#pragma unroll
    for (int i = 0; i < 32; ++i) { const int kk = 2 * i + (lane >> 5), n = n0 + (lane & 31); scr[kk * 33 + (lane & 31)] = (n < nvalid) ? W[(size_t)(k0 + kk) * ldw + n] : 0.f; }
    WAVE_LDS_FENCE(); CFENCE();
    const int c = lane & 7;
#pragma unroll
    for (int j = 0; j < 4; ++j) { const int n = (lane >> 3) + 8 * j; const LAS float* s = scr + (8 * c) * 33 + n;
        u32x4 o; o[0] = pk2(s[0 * 33], s[1 * 33]); o[1] = pk2(s[2 * 33], s[3 * 33]); o[2] = pk2(s[4 * 33], s[5 * 33]); o[3] = pk2(s[6 * 33], s[7 * 33]);
        *(u32x4*)(outp + (size_t)n * ldo + k0 + 8 * c) = o; }
    WAVE_LDS_FENCE(); CFENCE();
}
__device__ __forceinline__ void filter_item(const Ctx& X, int l, int n, int pos0, float* out, LAS bf16* za, LAS bf16* zb, LAS float* asum  ) {
    const int lane = X.lane, kof = 8 * (lane >> 4);
    const bf16* FWT = X.wsv<bf16>(WS_FWT);
    if (lane < 64) { const int i = lane;
#pragma unroll 4
        for (int p = 0; p < 16; ++p) { const int pos = pos0 + p; float v = 0.f;
            if (i == 0) v = (float)pos / (float)(n - 1 > 1 ? n - 1 : 1);
            else if (i < 33) { const int bb = (i - 1) & 15; const double band = 1e-4 + (double)bb * ((15.0 - 1e-4) / 15.0);
                double rev = (double)pos * band / (double)n; rev -= floor(rev); if (rev > 0.5) rev -= 1.0;
                float sn, cs; sincos_f((float)(rev * 6.283185307179586476925), sn, cs); v = i <= 16 ? cs : -sn; }
            za[p * LP + i] = (bf16)f2bf(v); } }
    WAVE_LDS_FENCE(); CFENCE();
    LAS bf16* src = za; LAS bf16* dst = zb;
#pragma unroll 1
    for (int layer = 0; layer < 3; ++layer) { const bf16* WT = FWT + (size_t)layer * 64 * 64; const float* bias = X.inv(layer == 0 ? I_FB1 : layer == 1 ? I_FB2 : I_FB3) + l * 64;
        const bf16x8 a0 = *(const LAS bf16x8*)(src + (lane & 15) * LP + kof), a1 = *(const LAS bf16x8*)(src + (lane & 15) * LP + kof + 32);
#pragma unroll
        for (int tj = 0; tj < 4; ++tj) { const int u = 16 * tj + (lane & 15); f32x4 acc = {0.f, 0.f, 0.f, 0.f};
            acc = MFMA16(a0, *(const bf16x8*)(WT + (size_t)u * 64 + kof), acc); acc = MFMA16(a1, *(const bf16x8*)(WT + (size_t)u * 64 + kof + 32), acc);
            const float fr = X.inv(I_FREQ)[l * 64 + u], bu = bias[u];
#pragma unroll
            for (int r = 0; r < 4; ++r) dst[(4 * (lane >> 4) + r) * LP + u] = (bf16)f2bf(sin_f(fr * (acc[r] + bu))); }
        WAVE_LDS_FENCE(); CFENCE();
        LAS bf16* t_ = src; src = dst; dst = t_; }
    const bf16* WO = FWT + (size_t)3 * 64 * 64;
    const bf16x8 a0 = *(const LAS bf16x8*)(src + (lane & 15) * LP + kof), a1 = *(const LAS bf16x8*)(src + (lane & 15) * LP + kof + 32);
    const float dmin = -3.0701134573253944f, dmax = -15.350567286626972f;
    float dist[4];
#pragma unroll
    for (int r = 0; r < 4; ++r) { const int dd = pos0 + 4 * (lane >> 4) + r - n / 2; dist[r] = (float)(dd < 0 ? -dd : dd) * (2.0f / (float)n); }
#pragma unroll 1
    for (int tg = 0; tg < HW / 64; ++tg) {
#pragma unroll
        for (int tq = 0; tq < 4; ++tq) { const int c = 64 * tg + 16 * tq + (lane & 15); f32x4 acc = {0.f, 0.f, 0.f, 0.f};
            acc = MFMA16(a0, *(const bf16x8*)(WO + (size_t)c * 64 + kof), acc); acc = MFMA16(a1, *(const bf16x8*)(WO + (size_t)c * 64 + kof + 32), acc);
            const float delta = fabsf(dmin + (float)c * ((dmax - dmin) / (float)(HW - 1))); f32x4 v; float as = 0.f;
#pragma unroll
            for (int r = 0; r < 4; ++r) { v[r] = acc[r] * fexp(-dist[r] * delta); as += fabsf(v[r]); }
            *(f32x4*)(out + (size_t)c * n + pos0 + 4 * (lane >> 4)) = v; lds_addf(asum + c, as); } }
    WAVE_LDS_FENCE(); CFENCE();
}
__device__ __forceinline__ void phase_transposes(const Ctx& X, int l, int part) {
    LAS float* scr = (LAS float*)(X.lds + X.wave * 16384);
    const bool shifted = part == 1 && X.G > N_SEQ_UNITS; const int myb = shifted ? X.bid - N_SEQ_UNITS : X.bid, nb_ = shifted ? X.G - N_SEQ_UNITS : X.G;
    if (myb < 0) return;
    const int gw = myb * NWAVES + X.wave, NGW = nb_ * NWAVES, lane = X.lane;
    constexpr int KB_D = D / 64, I_WIN_ = KB_D * (PCP / 32), I_WB_ = 2 * (RW / 64) * (D / 32), I_WO_ = KB_D * (D / 32), I_WGU_ = NE * 2 * KB_D * (D / 32), I_WD_ = NE * KB_D * (D / 32);
    constexpr int I_LORA_ = 6 * (RW / 32); constexpr int N0 = I_WIN_ + I_WB_ + I_WO_, NITEMS = N0 + I_WGU_ + I_WD_;
    if (part == 0) for (int it = gw; it < I_LORA_; it += NGW) { const int which = it / (RW / 32), nb = it % (RW / 32);
        const float* W; int k0 = 0, ldo = 64; bf16* outp;
        if (which < 2) { W = X.in(I_W2) + ((size_t)l * 2 + which) * 64 * RW; outp = X.ws<bf16>(WS_W2T) + (size_t)which * RW * 64 + (size_t)(32 * nb) * 64; }
        else if (which < 4) { W = X.in(I_A2) + ((size_t)l * 2 + (which - 2)) * 64 * RW; outp = X.ws<bf16>(WS_A2T) + (size_t)(which - 2) * RW * 64 + (size_t)(32 * nb) * 64; }
        else { W = X.in(I_G2) + (size_t)l * 128 * RW; k0 = 64 * (which - 4); ldo = 128; outp = X.ws<bf16>(WS_G2T) + (size_t)(32 * nb) * 128; }
        transpose_item(W, RW, k0, 32 * nb, RW, outp, ldo, scr, lane); }
    const int it_end = part ? NITEMS : N0; int it = (part ? N0 : 0) + gw;
    const float* W; int ldw, k0, n0, nvalid, ldo; bf16* outp; float v[32];
#define TR_PARAMS(it_) do { int r = (it_); \
        if (r < I_WIN_) { const int nb = r % (PCP / 32), kb = r / (PCP / 32); W = X.in(I_WIN) + (size_t)l * D * PC; ldw = PC; k0 = 64 * kb; n0 = 32 * nb; nvalid = PC; outp = X.ws<bf16>(WS_WIN) + (size_t)n0 * D; ldo = D; } \
        else if ((r -= I_WIN_) < I_WB_) { const int s_ = r / ((RW / 64) * (D / 32)), q = r % ((RW / 64) * (D / 32)), nb = q % (D / 32), kb = q / (D / 32); \
            W = X.in(I_WBR) + ((size_t)l * 2 + s_) * RW * D; ldw = D; k0 = 64 * kb; n0 = 32 * nb; nvalid = D; outp = X.ws<bf16>(WS_WB) + (size_t)s_ * D * RW + (size_t)n0 * RW; ldo = RW; } \
        else if ((r -= I_WB_) < I_WO_) { const int nb = r % (D / 32), kb = r / (D / 32); W = X.in(I_WOUT) + (size_t)l * D * D; ldw = D; k0 = 64 * kb; n0 = 32 * nb; nvalid = D; outp = X.ws<bf16>(WS_WO) + (size_t)n0 * D; ldo = D; } \
        else if ((r -= I_WO_) < I_WGU_) { const int per = KB_D * (D / 32), es = r / per, q = r % per, e = es >> 1, src = es & 1, nb = q % (D / 32), kb = q / (D / 32); n0 = 32 * nb; \
            W = (src ? X.in(I_WU) : X.in(I_WG)) + ((size_t)l * NE + e) * D * D; ldw = D; k0 = 64 * kb; nvalid = D; const int orow = e * 2 * D + (n0 / 128) * 256 + src * 128 + (n0 % 128); \
            outp = X.ws<bf16>(WS_WGU) + (size_t)orow * D; ldo = D; } \
        else { r -= I_WGU_; const int per = KB_D * (D / 32), e = r / per, q = r % per, nb = q % (D / 32), kb = q / (D / 32); \
            W = X.in(I_WD) + ((size_t)l * NE + e) * D * D; ldw = D; k0 = 64 * kb; n0 = 32 * nb; nvalid = D; outp = X.ws<bf16>(WS_WD) + (size_t)(e * D + n0) * D; ldo = D; } } while (0)
#define TR_LOAD() do { const int n = n0 + (lane & 31); const float* wp = W + (size_t)(k0 + (lane >> 5)) * ldw + n; _Pragma("unroll") for (int i = 0; i < 32; ++i) v[i] = (n < nvalid) ? wp[(size_t)(2 * i) * ldw] : 0.f; } while (0)
    if (it < it_end) { TR_PARAMS(it); TR_LOAD(); }
    while (it < it_end) {
#pragma unroll
        for (int i = 0; i < 32; ++i) scr[(2 * i + (lane >> 5)) * 33 + (lane & 31)] = v[i];
        WAVE_LDS_FENCE(); CFENCE();
        bf16* const cout_ = outp; const int ck0 = k0, cldo = ldo;
        it += NGW;
        if (it < it_end) { TR_PARAMS(it); TR_LOAD(); }
        const int c = lane & 7;
#pragma unroll
        for (int j = 0; j < 4; ++j) { const int n = (lane >> 3) + 8 * j; const LAS float* s_ = scr + (8 * c) * 33 + n;
            u32x4 o; o[0] = pk2(s_[0 * 33], s_[1 * 33]); o[1] = pk2(s_[2 * 33], s_[3 * 33]); o[2] = pk2(s_[4 * 33], s_[5 * 33]); o[3] = pk2(s_[6 * 33], s_[7 * 33]);
            *(u32x4*)(cout_ + (size_t)n * cldo + ck0 + 8 * c) = o; }
        WAVE_LDS_FENCE(); CFENCE();
    }
#undef TR_PARAMS
#undef TR_LOAD
}
__device__ __forceinline__ void phase_filter_weights(const Ctx& X, int l) {
    bf16* FWT = X.ws<bf16>(WS_FWT);
    for (int idx = X.bid * NTHR + X.tid; idx < (3 * 64 + HW) * 64; idx += X.G * NTHR) { const int o = idx >> 6, k = idx & 63; float v;
        if (o < 64) v = k < 33 ? X.in(I_FW1)[(size_t)l * 33 * 64 + k * 64 + o] : 0.f;
        else if (o < 128) v = X.in(I_FW2)[(size_t)l * 64 * 64 + k * 64 + (o - 64)];
        else if (o < 192) v = X.in(I_FW3)[(size_t)l * 64 * 64 + k * 64 + (o - 128)];
        else v = X.in(I_FWO)[(size_t)l * 64 * HW + (size_t)k * HW + (o - 192)];
        FWT[idx] = (bf16)f2bf(v); }
}
constexpr int FPART_OFF = 65536;
static_assert(FPART_OFF + 2 * HW * 4 <= LDS_STAGE && 2 * 16 * LP * 2 <= 8192, "filter LDS map");
__device__ __forceinline__ void phase_filters_begin(const Ctx& X) {
    LAS float* part = (LAS float*)(X.lds + FPART_OFF);
    for (int i = X.tid; i < 2 * HW; i += NTHR) part[i] = 0.f;
    __syncthreads();
}
__device__ __forceinline__ void phase_filters_item(const Ctx& X, int l_, int which_, int it_) {
    const int vz = vgpr_zero(), l = l_ + vz, which = which_ + vz, it = it_ + vz;
    LAS bf16* za = (LAS bf16*)(X.lds + X.wave * 8192); LAS bf16* zb = za + 16 * LP;
    const int n = which ? CTX : SEQ; float* out = X.wsv<float>(WS_FILT) + (which ? (size_t)HW * SEQ : 0);
    filter_item(X, l, n, 16 * it, out, za, zb, (LAS float*)(X.lds + FPART_OFF) + which * HW);
}
__device__ __forceinline__ void phase_filters_end(const Ctx& X) {
    const LAS float* part = (const LAS float*)(X.lds + FPART_OFF);
    __syncthreads();
    for (int i = X.tid; i < 2 * HW; i += NTHR) X.ws<float>(WS_FPART)[((size_t)(i / HW) * NPART + X.bid) * HW + (i % HW)] = part[i];
    __syncthreads();
}
__device__ __forceinline__ void phase_mod(const Ctx& X) {
    const int lane = X.lane;
    LAS float* red = (LAS float*)X.lds;
    constexpr int NIT = DEPTH * (6 * D / 64);
    for (int it = X.bid; it < NIT; it += X.G) {
        const int ll = it / (6 * D / 64), n0 = (it % (6 * D / 64)) * 64;
        const float* W = X.in(I_WMOD) + (size_t)ll * D * 6 * D; const float* cv = X.in(I_C); const float* cc = X.in(I_CCTX);
        float s0 = 0.f, s1 = 0.f;
#pragma unroll 8
        for (int k = X.wave * (D / 8); k < (X.wave + 1) * (D / 8); ++k) { const float wv = W[(size_t)k * 6 * D + n0 + lane]; const float c0 = cv[k], c1 = cc[k];
            s0 += c0 * sigmoidf_(c0) * wv; s1 += c1 * sigmoidf_(c1) * wv; }
        red[(X.wave * 64 + lane) * 2] = s0; red[(X.wave * 64 + lane) * 2 + 1] = s1;
        __syncthreads();
        if (X.wave == 0) { float t0 = 0.f, t1 = 0.f;
#pragma unroll
            for (int w = 0; w < NWAVES; ++w) { t0 += red[(w * 64 + lane) * 2]; t1 += red[(w * 64 + lane) * 2 + 1]; }
            const float bm = X.in(I_BMOD)[(size_t)ll * 6 * D + n0 + lane];
            float* MOD = X.ws<float>(WS_MOD);
            MOD[((size_t)ll * 2 + 0) * 6 * D + n0 + lane] = t0 + bm; MOD[((size_t)ll * 2 + 1) * 6 * D + n0 + lane] = t1 + bm; }
        __syncthreads();
    }
}
__device__ __forceinline__ const float* modp(const Ctx& X, int l, int t, int j) { return X.ws<float>(WS_MOD) + ((size_t)l * 2 + (t < CTX ? 1 : 0)) * 6 * D + (size_t)j * D; }

__device__ __forceinline__ void phase_x0(const Ctx& X) {
    const int gw = X.bid * NWAVES + X.wave, NGW = X.G * NWAVES, lane = X.lane;
    for (int t = gw; t < M; t += NGW) {
        const float* src = t < CTX ? X.in(I_CTX) + (size_t)t * D : X.in(I_X) + (size_t)(t - CTX) * D;
        const float* sh = modp(X, 0, t, 0); const float* sc = modp(X, 0, t, 1);
        float* xr = X.ws<float>(WS_X) + (size_t)t * D; bf16* xm = X.ws<bf16>(WS_XMOD) + (size_t)t * D;
#pragma unroll
        for (int j = 0; j < D / 256; ++j) { const int d = 4 * lane + 256 * j; const f32x4 v = *(const f32x4*)(src + d), a = *(const f32x4*)(sh + d), b = *(const f32x4*)(sc + d);
            *(f32x4*)(xr + d) = v;
            unsigned w0 = pk2(v[0] * (1.f + b[0]) + a[0], v[1] * (1.f + b[1]) + a[1]), w1 = pk2(v[2] * (1.f + b[2]) + a[2], v[3] * (1.f + b[3]) + a[3]);
            *(unsigned long long*)(xm + d) = (unsigned long long)w0 | ((unsigned long long)w1 << 32); }
    }
}

__device__ __forceinline__ int shift_row(int t, int col, bool& valid) {
    const bool isctx = t < CTX;
    const int i = t - CTX, gx = i & (GRID_W - 1), gy = i / GRID_W, q = col / QTR;
    const int offl = (q == 0) ? -1 : (q == 1) ? 1 : (q == 2) ? -GRID_W : GRID_W;
    const bool vl = (q == 0) ? (gx > 0) : (q == 1) ? (gx < GRID_W - 1) : (q == 2) ? (gy > 0) : (gy < GRID_H - 1);
    const bool first = col < HALFC;
    const int offc = first ? -1 : 1; const bool vc = first ? (t > 0) : (t < CTX - 1);
    valid = isctx ? vc : vl;
    return valid ? t + (isctx ? offc : offl) : t;
}
__device__ __forceinline__ float pm_val(const bf16* P, const float* mu, int t, int col) {
    const float p0 = bf2f(P[(size_t)t * PCP + col]); bool valid; const int nr = shift_row(t, col, valid);
    const float pn = bf2f(P[(size_t)nr * PCP + col]); const float p1 = valid ? pn : 0.f;
    return p0 + (p1 - p0) * mu[col];
}
__device__ __forceinline__ f32x4 mm_tile(const LAS bf16* A, const LAS bf16* Bt, int ti, int tj, int lane, f32x4 acc) {
    const LAS bf16* pa = A + (16 * ti + (lane & 15)) * LP + 8 * (lane >> 4); const LAS bf16* pb = Bt + (16 * tj + (lane & 15)) * LP + 8 * (lane >> 4);
#pragma unroll
    for (int kk = 0; kk < 2; ++kk) { const bf16x8 a = *(const LAS bf16x8*)(pa + 32 * kk), b = *(const LAS bf16x8*)(pb + 32 * kk); acc = MFMA16(a, b, acc); }
    return acc;
}
struct PmLd { float p0, pn, m; bool valid; };
__device__ __forceinline__ PmLd pm_ld(const bf16* P, const float* mu, int t, int col) {
    PmLd r; bool valid; const int nr = shift_row(t, col, valid); r.p0 = bf2f(P[(size_t)t * PCP + col]); r.pn = bf2f(P[(size_t)nr * PCP + col]); r.m = mu[col]; r.valid = valid; return r; }
__device__ __forceinline__ float pm_fin(const PmLd& r) { const float p1 = r.valid ? r.pn : 0.f; return r.p0 + (p1 - r.p0) * r.m; }
constexpr int TT = 8;
__device__ __forceinline__ void phase_lin(const Ctx& X, int l) {
    const bf16* P = X.ws<bf16>(WS_P); const float* mu = X.in(I_MU) + (size_t)l * RC; bf16* LIN = X.ws<bf16>(WS_LIN);
    for (size_t idx = (size_t)X.bid * NTHR + X.tid; idx < (size_t)M * 384; idx += (size_t)X.G * NTHR) { const int t = (int)(idx / 384), j = (int)(idx % 384);
        float v = pm_val(P, mu, t, C_LWF + j);
        if (j < 128) v = 1.0f - 2.0f * frcp(fexp(2.0f * v) + 1.0f); else if (j >= 256) v = sigmoidf_(v);
        LIN[idx] = (bf16)f2bf(v); }
}
__device__ __forceinline__ f32x4 mm_tile_p(const LAS bf16* A, int lda, const LAS bf16* Bt, int ldb, int ks, int ti, int tj, int lane, f32x4 acc) {
    const LAS bf16* pa = A + (16 * ti + (lane & 15)) * lda + 8 * (lane >> 4); const LAS bf16* pb = Bt + (16 * tj + (lane & 15)) * ldb + 8 * (lane >> 4);
    for (int kk = 0; kk < ks; ++kk) { const bf16x8 a = *(const LAS bf16x8*)(pa + 32 * kk), b = *(const LAS bf16x8*)(pb + 32 * kk); acc = MFMA16(a, b, acc); }
    return acc;
}
constexpr int GP = 136;
__device__ __forceinline__ void lora_unit_a(const Ctx& X, int unit) {
    const int b = unit / NH, h = unit % NH, tid = X.tid, lane = X.lane, w = X.wave;
    LAS bf16* Ab = (LAS bf16*)X.lds; LAS bf16* Gb = Ab + 4 * 64 * LP; LAS bf16* Wb = Gb + 64 * GP; LAS bf16* G2b = Wb + 4 * 64 * LP;
    LAS float* OUT = (LAS float*)X.lds;
    static_assert((8 * 64 * LP + 2 * 64 * GP) * 2 <= LDS_STAGE && 5 * 64 * LQ * 4 <= LDS_STAGE, "lora LDS map");
    const bf16* LIN = X.wsv<bf16>(WS_LIN) + (size_t)(64 * b) * 384;
    for (int i = tid; i < 64 * 48; i += NTHR) { const int t = i / 48, c16 = i % 48; const u32x4 v = *(const u32x4*)(LIN + (size_t)t * 384 + 8 * c16);
        if (c16 < 32) *(LAS u32x4*)(Ab + (c16 >> 3) * 64 * LP + t * LP + 8 * (c16 & 7)) = v; else *(LAS u32x4*)(Gb + t * GP + 8 * (c16 - 32)) = v; }
    const bf16* w2t = X.wsv<bf16>(WS_W2T) + (size_t)(64 * h) * 64; const bf16* a2t = X.wsv<bf16>(WS_A2T) + (size_t)(64 * h) * 64; const bf16* g2t = X.wsv<bf16>(WS_G2T) + (size_t)(64 * h) * 128;
    for (int i = tid; i < 4 * 64 * 8; i += NTHR) { const int q = i / 512, c = (i / 8) % 64, c16 = i % 8; const bf16* src = (q < 2 ? w2t + (size_t)q * RW * 64 : a2t + (size_t)(q - 2) * RW * 64) + c * 64 + 8 * c16;
        *(LAS u32x4*)(Wb + q * 64 * LP + c * LP + 8 * c16) = *(const u32x4*)src; }
    for (int i = tid; i < 64 * 16; i += NTHR) { const int c = i / 16, c16 = i % 16; *(LAS u32x4*)(G2b + c * GP + 8 * c16) = *(const u32x4*)(g2t + c * 128 + 8 * c16); }
    __syncthreads();
    f32x4 o[2][5];
#pragma unroll
    for (int q = 0; q < 2; ++q) { const int tile = 2 * w + q, ti = tile >> 2, tj = tile & 3; const f32x4 z4 = {0.f, 0.f, 0.f, 0.f};
#pragma unroll
        for (int p = 0; p < 4; ++p) o[q][p] = mm_tile(Ab + p * 64 * LP, Wb + p * 64 * LP, ti, tj, lane, z4);
        o[q][4] = mm_tile_p(Gb, GP, G2b, GP, 4, ti, tj, lane, z4); }
    __syncthreads();
#pragma unroll
    for (int q = 0; q < 2; ++q) { const int tile = 2 * w + q, ti = tile >> 2, tj = tile & 3, col = 16 * tj + (lane & 15);
#pragma unroll
        for (int p = 0; p < 5; ++p)
#pragma unroll
            for (int r = 0; r < 4; ++r) OUT[(p * 64 + 16 * ti + 4 * (lane >> 4) + r) * LQ + col] = o[q][p][r]; }
    __syncthreads();
}
__device__ __forceinline__ void lora_unit_b(const Ctx& X, int l, int unit) {
    const int b = unit / NH, h = unit % NH, w = X.wave, k = X.lane, c = 64 * h + k;
    const LAS float* OUT = (const LAS float*)X.lds;
    const bf16* P = X.wsv<bf16>(WS_P); const float* mu = X.inv(I_MU) + (size_t)l * RC;
    const float w00 = X.inv(I_W0)[(size_t)(l * 2 + 0) * RW + c], w01 = X.inv(I_W0)[(size_t)(l * 2 + 1) * RW + c];
    const float a00 = X.inv(I_A0)[(size_t)(l * 2 + 0) * RW + c], a01 = X.inv(I_A0)[(size_t)(l * 2 + 1) * RW + c];
    const float kkc = X.inv(I_KK)[(size_t)l * RW + c], kac = X.inv(I_KA)[(size_t)l * RW + c], rkc = X.inv(I_RK)[(size_t)l * RW + c];
    bf16* pR = X.wsv<bf16>(WS_R); bf16* pV = X.wsv<bf16>(WS_V); bf16* pKA = X.wsv<bf16>(WS_KA); bf16* pKD = X.wsv<bf16>(WS_KD); bf16* pKB = X.wsv<bf16>(WS_KB); float* pW = X.wsv<float>(WS_W); bf16* pG = X.wsv<bf16>(WS_GATE); float* pBo = X.wsv<float>(WS_BONUS);
    const int vz = vgpr_zero();
    float p0[3][8], pn[3][8]; unsigned vmask = 0u; const float mu0 = mu[c], mu1 = mu[C_K + c], mu2 = mu[C_V + c];
#pragma unroll
    for (int i = 0; i < 8; ++i) { const int t = 64 * b + 8 * w + i + vz;
#pragma unroll
        for (int q = 0; q < 3; ++q) { const int col = (q == 0 ? 0 : q == 1 ? C_K : C_V) + c; bool valid; const int nr = shift_row(t, col, valid);
            p0[q][i] = bf2f(P[(size_t)t * PCP + col]); pn[q][i] = bf2f(P[(size_t)nr * PCP + col]); vmask |= (valid ? 1u : 0u) << (3 * i + q); } }
    float bonv[8];
#pragma unroll
    for (int i = 0; i < 8; ++i) { const int tl = 8 * w + i, t = 64 * b + tl + vz;
        const float r = p0[0][i] + ((((vmask >> (3 * i + 0)) & 1u) ? pn[0][i] : 0.f) - p0[0][i]) * mu0;
        const float kx = p0[1][i] + ((((vmask >> (3 * i + 1)) & 1u) ? pn[1][i] : 0.f) - p0[1][i]) * mu1;
        const float v = p0[2][i] + ((((vmask >> (3 * i + 2)) & 1u) ? pn[2][i] : 0.f) - p0[2][i]) * mu2;
        const float wd0 = -DECAY_SCALE * sigmoidf_(w00 + OUT[(0 * 64 + tl) * LQ + k]), wd1 = -DECAY_SCALE * sigmoidf_(w01 + OUT[(1 * 64 + tl) * LQ + k]);
        const float ad0 = sigmoidf_(a00 + OUT[(2 * 64 + tl) * LQ + k]), ad1 = sigmoidf_(a01 + OUT[(3 * 64 + tl) * LQ + k]);
        const float kkr = kx * kkc; const float n2 = wave_sum(kkr * kkr); const float kk = kkr * frcp(fmaxf(sqrtf(n2), 1e-12f));
        const float kd0 = kx * (1.f + (ad0 - 1.f) * kac), kd1 = kx * (1.f + (ad1 - 1.f) * kac);
        bonv[i] = wave_sum(r * (kd0 + kd1) * rkc);
        const size_t o = (size_t)t * RW + c, o1 = (size_t)(M + t) * RW + c;
        pR[o] = (bf16)f2bf(r); pV[o] = (bf16)f2bf(v); pKA[o] = (bf16)f2bf(-kk);
        pKD[o] = (bf16)f2bf(kd0); pKD[o1] = (bf16)f2bf(kd1); pKB[o] = (bf16)f2bf(kk * ad0); pKB[o1] = (bf16)f2bf(kk * ad1);
        pW[o] = wd0; pW[o1] = wd1; pG[o] = (bf16)f2bf(OUT[(4 * 64 + tl) * LQ + k]); }
    if (k < 8) { float bs = bonv[0];
#pragma unroll
        for (int i = 1; i < 8; ++i) bs = (k == i) ? bonv[i] : bs;
        pBo[(size_t)(64 * b + 8 * w + k) * NH + h] = bs; }
    __syncthreads();
}
__device__ __forceinline__ void phase_prep_hyena(const Ctx& X, int l) {
    const bf16* P = X.ws<bf16>(WS_P); const int c = X.tid;
    if (c < HW) {
        const float* cw = X.in(I_CW) + (size_t)l * 3 * HC; const float* cb = X.in(I_CB) + (size_t)l * HC;
        float cw0[3], cw1[3], cw2[3], cbv[3];
#pragma unroll
        for (int j = 0; j < 3; ++j) { const int hc = j * HW + c; cw0[j] = cw[hc]; cw1[j] = cw[HC + hc]; cw2[j] = cw[2 * HC + hc]; cbv[j] = cb[hc]; }
        float* ZT = X.ws<float>(WS_ZT) + (size_t)c * M; float* Zc = X.ws<float>(WS_Z); bf16* X0 = X.ws<bf16>(WS_X0);
        for (int tile = X.bid; tile < M / TT; tile += X.G) { const int t0 = tile * TT; float zz[TT];
            float pv[3][TT + 2]; const bool hp0 = (t0 != 0 && t0 != CTX), hnl = (t0 + TT != CTX && t0 + TT != M);
#pragma unroll
            for (int j = 0; j < 3; ++j) { const int col = C_HY + j * HW + c;
#pragma unroll
                for (int i = 0; i < TT + 2; ++i) { const int t = t0 - 1 + i; const bool ok = (i == 0) ? hp0 : (i == TT + 1) ? hnl : true; pv[j][i] = ok ? bf2f(P[(size_t)(ok ? t : t0) * PCP + col]) : 0.f; } }
#pragma unroll
            for (int tt = 0; tt < TT; ++tt) { const int t = t0 + tt;
                float u[3];
#pragma unroll
                for (int j = 0; j < 3; ++j) u[j] = pv[j][tt] * cw0[j] + pv[j][tt + 1] * cw1[j] + pv[j][tt + 2] * cw2[j] + cbv[j];
                zz[tt] = u[2] * u[1]; if (t < CTX) Zc[(size_t)t * HW + c] = zz[tt];
                X0[(size_t)t * HW + c] = (bf16)f2bf(u[0]); }
            *(f32x4*)(ZT + t0) = (f32x4){zz[0], zz[1], zz[2], zz[3]}; *(f32x4*)(ZT + t0 + 4) = (f32x4){zz[4], zz[5], zz[6], zz[7]}; }
    }
}

constexpr int CC = 64, NCHK = M / CC;
static_assert(CTX % CC == 0 && SEQ % CC == 0, "chunks must not straddle the context/latent boundary");
__device__ __forceinline__ int scan_row(int d, int s) { return d == 0 ? s : (s < CTX ? CTX - 1 - s : M - 1 - (s - CTX)); }
__device__ __forceinline__ void chunk_unit_1(const Ctx& X, int unit) {
    const int d = unit / (NCHK * NH), c = (unit / NH) % NCHK, h = unit % NH;
    LAS bf16* An = (LAS bf16*)X.lds;            LAS bf16* Bn = An + 64 * LP; LAS bf16* Kn = Bn + 64 * LP; LAS bf16* Rn = Kn + 64 * LP; LAS bf16* Vt = Rn + 64 * LP;
    LAS bf16* Bh = Vt + 64 * LP;                LAS bf16* Kh = Bh + 64 * LP; LAS bf16* Lak = Kh + 64 * LP; LAS bf16* Mrb = Lak + 64 * LP; LAS bf16* Mrk = Mrb + 64 * LP;
    LAS float* Lab = (LAS float*)(Mrk + 64 * LP); LAS float* XsW = Lab + 64 * LX;
    LAS float* XsU = (LAS float*)An;
    LAS bf16* Wt = Lak; LAS bf16* Ut = (LAS bf16*)((LAS unsigned char*)An + 64 * LX * 4);
    LAS float* tot = Lab;
    LAS float* dC = (LAS float*)(X.lds + LDS_MISC + 1024);
    static_assert(10 * 64 * LP * 2 + 2 * 64 * LX * 4 <= LDS_STAGE && 64 * LX * 4 + 64 * LP * 2 <= 3 * 64 * LP * 2, "chunk LDS map");
    const int tid = X.tid, lane = X.lane, w = X.wave, k = tid & 63;
    float lw[8], cum[8]; bf16 rr[8], rv[8], rka[8], rkd[8], rkb[8];
    { float run = 0.f; const float* pW = X.wsv<float>(WS_W);
      const bf16* pR = X.wsv<bf16>(WS_R); const bf16* pV = X.wsv<bf16>(WS_V); const bf16* pKA = X.wsv<bf16>(WS_KA); const bf16* pKD = X.wsv<bf16>(WS_KD); const bf16* pKB = X.wsv<bf16>(WS_KB);
#pragma unroll
      for (int i = 0; i < 8; ++i) { const int row = scan_row(d, c * CC + 8 * w + i); lw[i] = pW[((size_t)d * M + row) * RW + h * 64 + k]; }
#pragma unroll
      for (int i = 0; i < 8; ++i) { const int row = scan_row(d, c * CC + 8 * w + i); const size_t o = (size_t)row * RW + h * 64 + k, od = ((size_t)d * M + row) * RW + h * 64 + k;
          rr[i] = pR[o]; rv[i] = pV[o]; rka[i] = pKA[o]; rkd[i] = pKD[od]; rkb[i] = pKB[od]; }
      SCHED_BARRIER();
#pragma unroll
      for (int i = 0; i < 8; ++i) { run += lw[i]; cum[i] = run; }
      tot[w * 64 + k] = run; }
    __syncthreads();
    float off = 0.f, cumC = 0.f;
#pragma unroll
    for (int ww = 0; ww < 8; ++ww) { const float t = tot[ww * 64 + k]; off += (ww < w) ? t : 0.f; cumC += t; }
    __syncthreads();
    { unsigned pv[4], pbh[4], pkh[4]; float af[8];
#pragma unroll
      for (int i = 0; i < 8; ++i) { const int t = 8 * w + i;
          const float ct = off + cum[i], cp = ct - lw[i];
          const float r = bf2f(rr[i]), v = bf2f(rv[i]), ka = bf2f(rka[i]), kd = bf2f(rkd[i]), kb = bf2f(rkb[i]);
          const float ei = fexp(-ct), eh = fexp(cumC - ct);
          const float at = ka * fexp(cp); af[i] = at;
          An[t * LP + k] = (bf16)f2bf(at); Bn[t * LP + k] = (bf16)f2bf(kb * ei); Kn[t * LP + k] = (bf16)f2bf(kd * ei); Rn[t * LP + k] = (bf16)f2bf(r * fexp(ct));
          const unsigned bv = f2bf(v), bb = f2bf(kb * eh), bk = f2bf(kd * eh);
          if (i & 1) { pv[i >> 1] |= bv << 16; pbh[i >> 1] |= bb << 16; pkh[i >> 1] |= bk << 16; } else { pv[i >> 1] = bv; pbh[i >> 1] = bb; pkh[i >> 1] = bk; } }
      *(LAS u32x4*)(Vt + k * LP + 8 * w) = (u32x4){pv[0], pv[1], pv[2], pv[3]}; *(LAS u32x4*)(Bh + k * LP + 8 * w) = (u32x4){pbh[0], pbh[1], pbh[2], pbh[3]}; *(LAS u32x4*)(Kh + k * LP + 8 * w) = (u32x4){pkh[0], pkh[1], pkh[2], pkh[3]};
      *(LAS f32x4*)(XsW + k * LX + 8 * w) = (f32x4){af[0], af[1], af[2], af[3]}; *(LAS f32x4*)(XsW + k * LX + 8 * w + 4) = (f32x4){af[4], af[5], af[6], af[7]}; }
    if (tid < 64) dC[tid] = fexp(cumC);
    __syncthreads();
#pragma unroll 1
    for (int q = 0; q < 2; ++q) { const int tile = 2 * w + q, ti = tile >> 2, tj = tile & 3; const f32x4 z4 = {0.f, 0.f, 0.f, 0.f};
        const f32x4 ab = mm_tile(An, Bn, ti, tj, lane, z4), ak = mm_tile(An, Kn, ti, tj, lane, z4), rb = mm_tile(Rn, Bn, ti, tj, lane, z4), rk = mm_tile(Rn, Kn, ti, tj, lane, z4);
        const int col = 16 * tj + (lane & 15);
#pragma unroll
        for (int r = 0; r < 4; ++r) { const int row = 16 * ti + 4 * (lane >> 4) + r; const bool lo = col < row, le = col <= row;
            Lab[row * LX + col] = lo ? ab[r] : 0.f; Lak[row * LP + col] = (bf16)f2bf(lo ? ak[r] : 0.f); Mrb[row * LP + col] = (bf16)f2bf(le ? rb[r] : 0.f); Mrk[row * LP + col] = (bf16)f2bf(le ? rk[r] : 0.f); } }
    __syncthreads();
}
__device__ __forceinline__ void chunk_unit_2(const Ctx& X, int unit) {
    const int d = unit / (NCHK * NH), c = (unit / NH) % NCHK, h = unit % NH;
    LAS bf16* An = (LAS bf16*)X.lds;            LAS bf16* Bn = An + 64 * LP; LAS bf16* Kn = Bn + 64 * LP; LAS bf16* Rn = Kn + 64 * LP; LAS bf16* Vt = Rn + 64 * LP;
    LAS bf16* Bh = Vt + 64 * LP;                LAS bf16* Kh = Bh + 64 * LP; LAS bf16* Lak = Kh + 64 * LP; LAS bf16* Mrb = Lak + 64 * LP; LAS bf16* Mrk = Mrb + 64 * LP;
    LAS float* Lab = (LAS float*)(Mrk + 64 * LP); LAS float* XsW = Lab + 64 * LX;
    LAS float* XsU = (LAS float*)An;
    LAS bf16* Wt = Lak; LAS bf16* Ut = (LAS bf16*)((LAS unsigned char*)An + 64 * LX * 4);
    LAS float* tot = Lab;
    LAS float* dC = (LAS float*)(X.lds + LDS_MISC + 1024);
    static_assert(10 * 64 * LP * 2 + 2 * 64 * LX * 4 <= LDS_STAGE && 64 * LX * 4 + 64 * LP * 2 <= 3 * 64 * LP * 2, "chunk LDS map");
    const int tid = X.tid, lane = X.lane, w = X.wave, k = tid & 63;
    f32x4 r2[2]; int r2col[2], r2row[2];
#pragma unroll
    for (int q = 0; q < 2; ++q) { const int tile = 2 * w + q, ti = tile >> 2, tj = tile & 3; const f32x4 z4 = {0.f, 0.f, 0.f, 0.f};
        const f32x4 a = mm_tile(Lak, Vt, ti, tj, lane, z4); const int col = 16 * tj + (lane & 15);
        r2[q] = a; r2col[q] = col; r2row[q] = 16 * ti + 4 * (lane >> 4); }
    __syncthreads();
#pragma unroll
    for (int q = 0; q < 2; ++q) *(LAS f32x4*)(XsU + r2col[q] * LX + r2row[q]) = r2[q];
    __syncthreads();
    LAS bf16* Tii = (LAS bf16*)(X.lds + LDS_MISC + 8448);
    constexpr int TP = 40;
    static_assert(8448 + 4 * 16 * TP * 2 <= LDS_BYTES - LDS_MISC, "T_ii image");
    if (tid < 64) { const int bi = tid >> 4, j = tid & 15; float xv[16];
#pragma unroll
        for (int t = 0; t < 16; ++t) { float acc = (t == j) ? 1.f : 0.f;
#pragma unroll
            for (int s2 = 0; s2 < t; ++s2) acc += Lab[(16 * bi + t) * LX + 16 * bi + s2] * xv[s2];
            xv[t] = acc; }
#pragma unroll
        for (int t = 0; t < 16; ++t) { Tii[(bi * 16 + t) * TP + j] = (bf16)f2bf(xv[t]); Tii[(bi * 16 + t) * TP + 16 + j] = (bf16)0; } }
    __syncthreads();
    { LAS float* xsx = (w < 4 ? XsW + 16 * w * LX : XsU + 16 * (w - 4) * LX) + (lane & 15) * LX;
      LAS bf16* dst = (w < 4 ? Wt + 16 * w * LP : Ut + 16 * (w - 4) * LP) + (lane & 15) * LP;
      const int kof = 8 * (lane >> 4); const bf16x8 zero8 = {0, 0, 0, 0, 0, 0, 0, 0};
#pragma unroll
      for (int i = 0; i < 4; ++i) {
          f32x4 acc = *(const LAS f32x4*)(xsx + 16 * i + 4 * (lane >> 4));
#pragma unroll
          for (int kk = 0; kk < (16 * i + 31) / 32; ++kk) { const int s0 = 32 * kk + kof;
              const f32x4 l0 = *(const LAS f32x4*)(Lab + (16 * i + (lane & 15)) * LX + s0), l1 = *(const LAS f32x4*)(Lab + (16 * i + (lane & 15)) * LX + s0 + 4);
              u32x4 pa = {pk2(l0[0], l0[1]), pk2(l0[2], l0[3]), pk2(l1[0], l1[1]), pk2(l1[2], l1[3])};
              bf16x8 av = __builtin_bit_cast(bf16x8, pa), bv = *(const LAS bf16x8*)(dst + s0);
              if (s0 >= 16 * i) { av = zero8; bv = zero8; }
              acc = MFMA16(av, bv, acc); }
          LAS bf16* zt = (LAS bf16*)(xsx + 16 * i);
          *(LAS unsigned long long*)(zt + 4 * (lane >> 4)) = (unsigned long long)pk2(acc[0], acc[1]) | ((unsigned long long)pk2(acc[2], acc[3]) << 32);
          WAVE_LDS_FENCE(); CFENCE();
          const bf16x8 a2 = *(const LAS bf16x8*)(Tii + (i * 16 + (lane & 15)) * TP + kof); bf16x8 b2 = zero8; if (kof < 16) b2 = *(const LAS bf16x8*)(zt + kof);
          f32x4 xi = {0.f, 0.f, 0.f, 0.f}; xi = MFMA16(a2, b2, xi);
          *(LAS unsigned long long*)(dst + 16 * i + 4 * (lane >> 4)) = (unsigned long long)pk2(xi[0], xi[1]) | ((unsigned long long)pk2(xi[2], xi[3]) << 32);
          WAVE_LDS_FENCE(); CFENCE(); } }
    __syncthreads();
}
__device__ __forceinline__ void chunk_unit_3(const Ctx& X, int unit) {
    const int d = unit / (NCHK * NH), c = (unit / NH) % NCHK, h = unit % NH;
    LAS bf16* An = (LAS bf16*)X.lds;            LAS bf16* Bn = An + 64 * LP; LAS bf16* Kn = Bn + 64 * LP; LAS bf16* Rn = Kn + 64 * LP; LAS bf16* Vt = Rn + 64 * LP;
    LAS bf16* Bh = Vt + 64 * LP;                LAS bf16* Kh = Bh + 64 * LP; LAS bf16* Lak = Kh + 64 * LP; LAS bf16* Mrb = Lak + 64 * LP; LAS bf16* Mrk = Mrb + 64 * LP;
    LAS float* Lab = (LAS float*)(Mrk + 64 * LP); LAS float* XsW = Lab + 64 * LX;
    LAS float* XsU = (LAS float*)An;
    LAS bf16* Wt = Lak; LAS bf16* Ut = (LAS bf16*)((LAS unsigned char*)An + 64 * LX * 4);
    LAS float* tot = Lab;
    LAS float* dC = (LAS float*)(X.lds + LDS_MISC + 1024);
    static_assert(10 * 64 * LP * 2 + 2 * 64 * LX * 4 <= LDS_STAGE && 64 * LX * 4 + 64 * LP * 2 <= 3 * 64 * LP * 2, "chunk LDS map");
    const int tid = X.tid, lane = X.lane, w = X.wave, k = tid & 63;
    const float dCk = dC[k];
    const size_t ubase = ((size_t)(d * NH + h) * NCHK + c);
    bf16* PTg = (bf16*)(X.wsv<float>(WS_PQ) + ubase * 2 * 4096); float* Qg = X.wsv<float>(WS_PQ) + ubase * 2 * 4096 + 4096;     bf16* Gg = X.wsv<bf16>(WS_G) + ubase * 4096; float* Yg = X.wsv<float>(WS_YL) + ubase * 4096;
#pragma unroll 1
    for (int q = 0; q < 2; ++q) { const int tile = 2 * w + q, ti = tile >> 2, tj = tile & 3; const f32x4 z4 = {0.f, 0.f, 0.f, 0.f};
        const f32x4 p = mm_tile(Wt, Bh, ti, tj, lane, z4); f32x4 qq = mm_tile(Ut, Bh, ti, tj, lane, z4); qq = mm_tile(Vt, Kh, ti, tj, lane, qq);
        const f32x4 g = mm_tile(Mrb, Wt, ti, tj, lane, z4); f32x4 y = mm_tile(Mrb, Ut, ti, tj, lane, z4); y = mm_tile(Mrk, Vt, ti, tj, lane, y);
        const int col = 16 * tj + (lane & 15); const float dcol = __shfl(dCk, col);
        { const int row0 = 16 * ti + 4 * (lane >> 4); float pv[4];
#pragma unroll
          for (int r = 0; r < 4; ++r) pv[r] = p[r] + ((row0 + r) == col ? dcol : 0.f);
          *(unsigned long long*)(PTg + col * 64 + row0) = (unsigned long long)pk2(pv[0], pv[1]) | ((unsigned long long)pk2(pv[2], pv[3]) << 32); }
#pragma unroll
        for (int r = 0; r < 4; ++r) { const int row = 16 * ti + 4 * (lane >> 4) + r;
            Qg[row * 64 + col] = qq[r];
            const int orow = d ? 63 - row : row;
            Gg[orow * 64 + col] = (bf16)f2bf(g[r] + bf2f(Rn[row * LP + col])); }
        { const int gq = lane >> 4; const int cti = d ? 3 - ti : ti, cg = d ? 3 - gq : gq; const f32x4 yv = d ? (f32x4){y[3], y[2], y[1], y[0]} : y;
          *(f32x4*)(Yg + ((cti * 4 + tj) * 64 + 16 * cg + (lane & 15)) * 4) = yv; } }
    __syncthreads();
}
__device__ __forceinline__ void seq_unit(const Ctx& X, int su) {
    const int d = su / (NH * 4), h = (su / 4) % NH, qv = su & 3;
    constexpr int PD = 9, RING = PD + 1, SLOTB = 8192 + 4096;
    LAS unsigned char* ring = X.lds;
    LAS bf16* S = (LAS bf16*)(ring + RING * SLOTB);
    static_assert(RING * SLOTB + 2 * 16 * LP * 2 <= LDS_STAGE && (PD - 1) * 6 <= 63, "seq LDS map / vmcnt range");
    const int lane = X.lane, w = X.wave, tj = w & 3, col = 16 * tj + (lane & 15), kq = lane >> 4, kof = 8 * kq;
    const bool worker = w < 4;
    const unsigned char* PQ = (const unsigned char*)(X.ws<float>(WS_PQ) + (size_t)(d * NH + h) * NCHK * 2 * 4096); bf16* S0g = X.ws<bf16>(WS_S0) + (size_t)(d * NH + h) * NCHK * 4096 + (size_t)(16 * qv) * 64;
#define SEQ_FILL(c_) do { const unsigned char* p_ = PQ + (size_t)(c_) * 32768; LAS unsigned char* sl_ = ring + ((c_) % RING) * SLOTB; \
        GLDS16(p_ + 16 * (w * 64 + lane), sl_ + 16 * (w * 64)); GLDS16(p_ + 16384 + (16 * qv) * 256 + 16 * ((w & 3) * 64 + lane), sl_ + 8192 + 16 * ((w & 3) * 64)); } while (0)
#pragma unroll
    for (int i = 0; i < PD; ++i) if (i < NCHK) SEQ_FILL(i);
    for (int i = X.tid; i < 2 * 16 * LP / 2; i += NTHR) ((LAS unsigned*)S)[i] = 0u;
    if (worker) {
#pragma unroll
        for (int r = 0; r < 4; ++r) S0g[(4 * kq + r) * 64 + col] = (bf16)0; }
    for (int c = 0; c < NCHK; ++c) {
        if (c + PD - 1 < NCHK) { if (worker) { ASM_WAIT_V(48); } else { ASM_WAIT_V(16); } } else { ASM_WAIT_V(0); }
        ASM_WAIT_L(0); S_BARRIER(); CFENCE();
        if (c + PD < NCHK) SEQ_FILL(c + PD);
        if (worker) {
            const LAS bf16* PT = (const LAS bf16*)(ring + (c % RING) * SLOTB); const LAS float* Q = (const LAS float*)(ring + (c % RING) * SLOTB + 8192);
            const LAS bf16* Sc = S + (c & 1) * 16 * LP; LAS bf16* Sn = S + ((c + 1) & 1) * 16 * LP;
            f32x4 acc;
#pragma unroll
            for (int r = 0; r < 4; ++r) acc[r] = Q[(4 * kq + r) * 64 + col];
#pragma unroll
            for (int kk = 0; kk < 2; ++kk) acc = MFMA16(*(const LAS bf16x8*)(Sc + (lane & 15) * LP + kof + 32 * kk), *(const LAS bf16x8*)(PT + (16 * tj + (lane & 15)) * 64 + kof + 32 * kk), acc);
#pragma unroll
            for (int r = 0; r < 4; ++r) { const bf16 sb = (bf16)f2bf(acc[r]); Sn[(4 * kq + r) * LP + col] = sb; if (c + 1 < NCHK) S0g[(size_t)(c + 1) * 4096 + (4 * kq + r) * 64 + col] = sb; } }
    }
    ASM_WAIT_V(0);
    __syncthreads();
#undef SEQ_FILL
}
constexpr int CR = 16;
__device__ __forceinline__ void conv_item(const Ctx& X, int item) {
    constexpr int NCG = HW / 64; constexpr int n = CTX;
    const int cg = item % NCG, ob = item / NCG, i0 = CR * ob, c = cg * 64 + X.lane;
    const float* F = X.ws<float>(WS_FILT) + (size_t)HW * SEQ + (size_t)c * CTX; const float* Z = X.ws<float>(WS_Z) + c;
    const float* fp = X.ws<float>(WS_FPART) + (size_t)NPART * HW + c;
    float nsum = 0.f; for (int b = 0; b < NPART; ++b) nsum += fp[(size_t)b * HW];
    float acc[CR], Q[CR];
#pragma unroll
    for (int r = 0; r < CR; ++r) acc[r] = 0.f;
    int jb = i0 - n / 2; if (jb < 0) jb = 0;
    int jend = i0 + n / 2 + CR; if (jend > n) jend = n;
    int Tb = i0 - jb + n / 2;
#pragma unroll
    for (int x = 1; x < CR; ++x) { const int T = Tb + x; Q[x] = (T >= 0 && T < n) ? F[T] : 0.f; }
    Q[0] = 0.f;
    for (; jb < jend; jb += CR, Tb -= CR) {
#pragma unroll
        for (int s = 0; s < CR; ++s) { const int T = Tb - s, j = jb + s;
            if ((s & 3) == 0) CFENCE();
            Q[(CR - s) & (CR - 1)] = (T >= 0 && T < n) ? F[T] : 0.f;
            const float zj = (j < n) ? Z[(size_t)j * HW] : 0.f;
#pragma unroll
            for (int r = 0; r < CR; ++r) acc[r] += Q[(r - s + CR) & (CR - 1)] * zj; }
    }
    const float inv = 1.0f / nsum; float* O = X.ws<float>(WS_CONV) + c;
#pragma unroll
    for (int r = 0; r < CR; ++r) O[(size_t)(i0 + r) * HW] = acc[r] * inv;
}

#ifdef EMU
struct cf { float x, y; };
#else
typedef float cf __attribute__((ext_vector_type(2)));
#endif
__device__ __forceinline__ cf cmul(cf a, cf b) { return cf{a.x * b.x - a.y * b.y, a.x * b.y + a.y * b.x}; }
__device__ __forceinline__ cf cadd(cf a, cf b) { return cf{a.x + b.x, a.y + b.y}; }
__device__ __forceinline__ cf csub(cf a, cf b) { return cf{a.x - b.x, a.y - b.y}; }
__device__ __forceinline__ cf cconj(cf a) { return cf{a.x, -a.y}; }
constexpr int FN = SEQ;
constexpr int flog4(int n) { return n <= 1 ? 0 : 1 + flog4(n / 4); }
constexpr int FLOG4 = flog4(FN), FSQ = 1 << FLOG4;
static_assert((1 << (2 * FLOG4)) == FN && FN * 8 <= LDS_STAGE, "FFT length must be a power of 4 that fits the LDS stage region");
constexpr int FFT_TAB_OFF = LDS_MISC + 2048;
static_assert(FFT_TAB_OFF + 2 * FSQ * 8 <= LDS_BYTES, "FFT twiddle tables");
__device__ __forceinline__ void fft_tables(const Ctx& X) {
    LAS cf* T = (LAS cf*)(X.lds + FFT_TAB_OFF);
    for (int i = X.tid; i < 2 * FSQ; i += NTHR) { const int k = i < FSQ ? i * FSQ : i - FSQ; float s, c; sincos_f(-6.283185307179586f * (float)k / (float)FN, s, c); T[i] = cf{c, s}; }
    __syncthreads();
}
__device__ __forceinline__ cf fft_tw(const LAS cf* T, int k) { const cf a = T[k >> FLOG4], b = T[FSQ + (k & (FSQ - 1))]; return cmul(a, b); }
__device__ __forceinline__ int rev4(int k) { int r = 0;
#pragma unroll
    for (int s = 0; s < FLOG4; ++s) { r = (r << 2) | (k & 3); k >>= 2; }
    return r; }
__device__ __forceinline__ void fft_stage_q1(LAS cf* x, int tid, bool inverse) {
    for (int u = tid; u < FN / 4; u += NTHR) { LAS f32x4* px = (LAS f32x4*)(x + 4 * u); const f32x4 v01 = px[0], v23 = px[1];
        const cf a0{v01[0], v01[1]}, a1{v01[2], v01[3]}, a2{v23[0], v23[1]}, a3{v23[2], v23[3]};
        const cf t0 = cadd(a0, a2), t1 = csub(a0, a2), t2 = cadd(a1, a3), d = csub(a1, a3), t3 = inverse ? cf{-d.y, d.x} : cf{d.y, -d.x};
        const cf y0 = cadd(t0, t2), y1 = cadd(t1, t3), y2 = csub(t0, t2), y3 = csub(t1, t3);
        px[0] = (f32x4){y0.x, y0.y, y1.x, y1.y}; px[1] = (f32x4){y2.x, y2.y, y3.x, y3.y}; }
    __syncthreads();
}
__device__ __forceinline__ void dif4(cf& a0, cf& a1, cf& a2, cf& a3, cf w1) {
    const cf w2 = cmul(w1, w1), w3 = cmul(w2, w1);
    const cf t0 = cadd(a0, a2), t1 = csub(a0, a2), t2 = cadd(a1, a3), d = csub(a1, a3), t3 = cf{d.y, -d.x};
    a0 = cadd(t0, t2); a1 = cmul(cadd(t1, t3), w1); a2 = cmul(csub(t0, t2), w2); a3 = cmul(csub(t1, t3), w3);
}
__device__ __forceinline__ void dit4(cf& a0, cf& a1, cf& a2, cf& a3, cf w1c) {
    const cf w2 = cmul(w1c, w1c), w3 = cmul(w2, w1c);
    a1 = cmul(a1, w1c); a2 = cmul(a2, w2); a3 = cmul(a3, w3);
    const cf t0 = cadd(a0, a2), t1 = csub(a0, a2), t2 = cadd(a1, a3), d = csub(a1, a3), t3 = cf{-d.y, d.x};
    a0 = cadd(t0, t2); a1 = cadd(t1, t3); a2 = csub(t0, t2); a3 = csub(t1, t3);
}
__device__ __forceinline__ void fft_pair(LAS cf* x, const LAS cf* T, int tid, int s, bool inverse) {
    const int q1 = FN >> (2 * s + 2), q2 = q1 >> 2, tw1 = 1 << (2 * s), tw2 = tw1 << 2;
    for (int u = tid; u < FN / 16; u += NTHR) { const int j2 = u & (q2 - 1), base = (u - j2) * 16 + j2;
        cf v[4][4];
#pragma unroll
        for (int a = 0; a < 4; ++a)
#pragma unroll
            for (int b = 0; b < 4; ++b) v[a][b] = x[base + a * q1 + b * q2];
        if (!inverse) {
#pragma unroll
            for (int b = 0; b < 4; ++b) dif4(v[0][b], v[1][b], v[2][b], v[3][b], fft_tw(T, (b * q2 + j2) * tw1));
            const cf wb = fft_tw(T, j2 * tw2);
#pragma unroll
            for (int a = 0; a < 4; ++a) dif4(v[a][0], v[a][1], v[a][2], v[a][3], wb);
        } else {
            const cf wb = cconj(fft_tw(T, j2 * tw2));
#pragma unroll
            for (int a = 0; a < 4; ++a) dit4(v[a][0], v[a][1], v[a][2], v[a][3], wb);
#pragma unroll
            for (int b = 0; b < 4; ++b) dit4(v[0][b], v[1][b], v[2][b], v[3][b], cconj(fft_tw(T, (b * q2 + j2) * tw1)));
        }
#pragma unroll
        for (int a = 0; a < 4; ++a)
#pragma unroll
            for (int b = 0; b < 4; ++b) x[base + a * q1 + b * q2] = v[a][b]; }
    __syncthreads();
}
__device__ __forceinline__ void fft_single(LAS cf* x, const LAS cf* T, int tid, int s, bool inverse) {
    const int q = FN >> (2 * s + 2), tw = 1 << (2 * s);
    for (int u = tid; u < FN / 4; u += NTHR) { const int j = u & (q - 1), p = (u - j) * 4 + j;
        cf a0 = x[p], a1 = x[p + q], a2 = x[p + 2 * q], a3 = x[p + 3 * q];
        if (!inverse) dif4(a0, a1, a2, a3, fft_tw(T, j * tw)); else dit4(a0, a1, a2, a3, cconj(fft_tw(T, j * tw)));
        x[p] = a0; x[p + q] = a1; x[p + 2 * q] = a2; x[p + 3 * q] = a3; }
    __syncthreads();
}
constexpr int fft_npairs() { int n = 0; for (int s = 0; s + 1 < FLOG4 - 1; s += 2) { if ((FN >> (2 * s + 6)) >= 64 || FN < 16384) ++n; else break; } return n; }
constexpr int FPAIRS = fft_npairs();
__device__ __forceinline__ void fft_run(LAS cf* x, const LAS cf* T, int tid, bool inverse) {
    constexpr int NST = FPAIRS + (FLOG4 - 1 - 2 * FPAIRS) + 1;
#pragma unroll 1
    for (int i = 0; i < NST; ++i) { const int k = inverse ? NST - 1 - i : i;
        if (k < FPAIRS) fft_pair(x, T, tid, 2 * k, inverse);
        else if (k < NST - 1) fft_single(x, T, tid, 2 * FPAIRS + (k - FPAIRS), inverse);
        else fft_stage_q1(x, tid, inverse); }
}
__device__ __forceinline__ void fft_fwd(LAS cf* x, const LAS cf* T, int tid) { fft_run(x, T, tid, false); }
__device__ __forceinline__ void fft_inv(LAS cf* x, const LAS cf* T, int tid) { fft_run(x, T, tid, true); }
__device__ __forceinline__ void fft_load_real(LAS cf* x, const float* src, float scale, int tid) {
    for (int m = tid; m < FN; m += NTHR) { cf v{0.f, 0.f}; if (m < FN / 2) { v.x = src[2 * m] * scale; v.y = src[2 * m + 1] * scale; } x[m] = v; }
    __syncthreads();
}
__device__ __forceinline__ void spec_load(const Ctx& X, int c) {
    LAS cf* x = (LAS cf*)X.lds; volatile LAS float* red = (volatile LAS float*)(X.lds + LDS_MISC) + 120;
    if (X.wave == 0) { const float* fp = X.ws<float>(WS_FPART) + c; float s = 0.f; for (int b = X.lane; b < NPART; b += 64) s += fp[(size_t)b * HW]; s = wave_sum(s); if (X.lane == 0) red[0] = s; }
    __syncthreads();
    const float inv = 1.0f / red[0];
    fft_load_real(x, X.ws<float>(WS_FILT) + (size_t)c * SEQ, inv, X.tid);
}
__device__ __forceinline__ void spec_unpack(const Ctx& X, int c) {
    LAS cf* x = (LAS cf*)X.lds;
    cf* HS = X.ws<cf>(WS_HS) + (size_t)c * (FN + 1);
    for (int k = X.tid; k <= FN / 2; k += NTHR) {
        const cf A = x[rev4(k)], B = x[rev4((FN - k) & (FN - 1))];
        if (k == 0) { HS[0] = cf{A.x + A.y, 0.f}; HS[FN] = cf{A.x - A.y, 0.f}; }
        else if (k == FN / 2) { HS[k] = cconj(A); }
        else { float sn, cs; sincos_f(-3.14159265358979f * (float)k / (float)FN, sn, cs); const cf w{cs, sn};
            const cf s1 = cadd(A, cconj(B)), d1 = csub(A, cconj(B)), wd = cmul(w, d1);
            HS[k] = cf{0.5f * (s1.x + wd.y), 0.5f * (s1.y - wd.x)};
            const cf s2 = cadd(B, cconj(A)), d2 = csub(B, cconj(A)), wd2 = cmul(cconj(w), d2);
            HS[FN - k] = cf{0.5f * (s2.x - wd2.y), 0.5f * (s2.y + wd2.x)}; } }
    __syncthreads();
}
__device__ __forceinline__ void fftconv_load(const Ctx& X, int c) { fft_load_real((LAS cf*)X.lds, X.ws<float>(WS_ZT) + (size_t)c * M + CTX, 1.0f, X.tid); }
__device__ __forceinline__ void fftconv_mul(const Ctx& X, int c) {
    LAS cf* x = (LAS cf*)X.lds;
    const cf* HS = X.ws<cf>(WS_HS) + (size_t)c * (FN + 1);
    for (int k = X.tid; k <= FN / 2; k += NTHR) {
        const int pa = rev4(k), pb = rev4((FN - k) & (FN - 1)); const cf A = x[pa], B = x[pb];
        if (k == 0) { const float y0 = (A.x + A.y) * HS[0].x, yn = (A.x - A.y) * HS[FN].x; x[pa] = cf{0.5f * (y0 + yn), 0.5f * (y0 - yn)}; }
        else if (k == FN / 2) { x[pa] = cconj(cmul(cconj(A), HS[k])); }
        else { float sn, cs; sincos_f(-3.14159265358979f * (float)k / (float)FN, sn, cs); const cf w{cs, sn};
            const cf s1 = cadd(A, cconj(B)), d1 = csub(A, cconj(B)), wd = cmul(w, d1); const cf Xk{0.5f * (s1.x + wd.y), 0.5f * (s1.y - wd.x)};
            const cf s2 = cadd(B, cconj(A)), d2 = csub(B, cconj(A)), wd2 = cmul(cconj(w), d2); const cf Xn{0.5f * (s2.x - wd2.y), 0.5f * (s2.y + wd2.x)};
            const cf Yk = cmul(Xk, HS[k]), Yn = cmul(Xn, HS[FN - k]);
            const cf e1 = cadd(Yk, cconj(Yn)), f1 = cmul(cconj(w), csub(Yk, cconj(Yn)));
            x[pa] = cf{0.5f * (e1.x - f1.y), 0.5f * (e1.y + f1.x)};
            const cf e2 = cadd(Yn, cconj(Yk)), f2 = cmul(w, csub(Yn, cconj(Yk)));
            x[pb] = cf{0.5f * (e2.x + f2.y), 0.5f * (e2.y - f2.x)}; } }
    __syncthreads();
}
__device__ __forceinline__ void fftconv_out(const Ctx& X, int l, int c) {
    const LAS cf* x = (const LAS cf*)X.lds; const float* z = X.ws<float>(WS_ZT) + (size_t)c * M + CTX;
    const float bias = X.in(I_HBIAS)[(size_t)l * HW + c], sc = 1.0f / (float)FN; float* O = X.ws<float>(WS_CVT) + (size_t)c * SEQ;
    for (int i2 = X.tid; i2 < FN / 2; i2 += NTHR) { const cf d = x[i2 + FN / 4]; O[2 * i2] = d.x * sc + z[2 * i2] * bias; O[2 * i2 + 1] = d.y * sc + z[2 * i2 + 1] * bias; }
    __syncthreads();
}
__device__ __forceinline__ void phase_ctxconv(const Ctx& X, int l) {
    constexpr int NITEMS = (HW / 64) * (CTX / CR);
    unsigned* q = X.ctl() + CW_Q + l * 64;
    for (;;) { int item = 0; if (X.lane == 0) item = (int)atomicAdd(q, 1u); item = __shfl(item, 0); if (item >= NITEMS) break; conv_item(X, item); }
}
__device__ __forceinline__ void phase_seq(const Ctx& X) {
    for (int su = X.bid; su < N_SEQ_UNITS; su += X.G) seq_unit(X, su);
}

__device__ __forceinline__ void finish_wave_unit(const Ctx& X, int l, int unit) {
    const int rg = unit / NH, h = unit % NH, lane = X.lane, b = rg >> 2, sub = rg & 3;
    const int cf = b, cb = (b < CTX / CC) ? (CTX / CC - 1 - b) : (NCHK - 1 - (b - CTX / CC));
    const size_t uf = ((size_t)(0 * NH + h) * NCHK + cf) * 4096, ub = ((size_t)(1 * NH + h) * NCHK + cb) * 4096;
    const bf16* G = X.wsv<bf16>(WS_G); const bf16* S0 = X.wsv<bf16>(WS_S0); const float* YL = X.wsv<float>(WS_YL);
    const int arow = 16 * sub + (lane & 15), kof = 8 * (lane >> 4);
    bf16x8 af[2], ab[2];
#pragma unroll
    for (int kk = 0; kk < 2; ++kk) { af[kk] = *(const bf16x8*)(G + uf + arow * 64 + kof + 32 * kk); ab[kk] = *(const bf16x8*)(G + ub + arow * 64 + kof + 32 * kk); }
    f32x4 y[4]; bf16x8 bf_[4][2], bb_[4][2]; f32x4 ylf[4], ylb[4];
#pragma unroll
    for (int tj = 0; tj < 4; ++tj) { const int vrow = 16 * tj + (lane & 15);
#pragma unroll
        for (int kk = 0; kk < 2; ++kk) { bf_[tj][kk] = *(const bf16x8*)(S0 + uf + vrow * 64 + kof + 32 * kk); bb_[tj][kk] = *(const bf16x8*)(S0 + ub + vrow * 64 + kof + 32 * kk); }
    }
    SCHED_BARRIER();
#pragma unroll
    for (int tj = 0; tj < 4; ++tj) { f32x4 acc = {0.f, 0.f, 0.f, 0.f};
#pragma unroll
        for (int kk = 0; kk < 2; ++kk) { acc = MFMA16(af[kk], bf_[tj][kk], acc); acc = MFMA16(ab[kk], bb_[tj][kk], acc); }
        y[tj] = acc; }
    SCHED_BARRIER();
    const float* lgp = X.inv(I_LNXG) + (size_t)l * RW + 64 * h; const float* lbp = X.inv(I_LNXB) + (size_t)l * RW + 64 * h;
    const bf16* pV = X.wsv<bf16>(WS_V); const bf16* pG = X.wsv<bf16>(WS_GATE); const float* pBo = X.wsv<float>(WS_BONUS); bf16* pRO = X.wsv<bf16>(WS_RO);
    float lgv[4], lbv[4], bonv[4]; bf16 vv[4][4], gv[4][4];
#pragma unroll
    for (int tj = 0; tj < 4; ++tj) { const int cl = 16 * tj + (lane & 15); lgv[tj] = lgp[cl]; lbv[tj] = lbp[cl];
        ylf[tj] = *(const f32x4*)(YL + uf + ((sub * 4 + tj) * 64 + lane) * 4); ylb[tj] = *(const f32x4*)(YL + ub + ((sub * 4 + tj) * 64 + lane) * 4); }
#pragma unroll
    for (int r = 0; r < 4; ++r) { const int t = 16 * rg + 4 * (lane >> 4) + r; bonv[r] = pBo[(size_t)t * NH + h];
#pragma unroll
        for (int tj = 0; tj < 4; ++tj) { const size_t o = (size_t)t * RW + 64 * h + 16 * tj + (lane & 15); vv[r][tj] = pV[o]; gv[r][tj] = pG[o]; } }
    SCHED_BARRIER();
#pragma unroll
    for (int tj = 0; tj < 4; ++tj) y[tj] += ylf[tj] + ylb[tj];
#pragma unroll
    for (int r = 0; r < 4; ++r) { const int t = 16 * rg + 4 * (lane >> 4) + r;
        const float mean = row16_sum((y[0][r] + y[1][r]) + (y[2][r] + y[3][r])) * (1.f / 64.f);
        float q = 0.f;
#pragma unroll
        for (int tj = 0; tj < 4; ++tj) { const float dy = y[tj][r] - mean; q += dy * dy; }
        const float rstd = 1.0f / sqrtf(row16_sum(q) * (1.f / 64.f) + GN_EPS); const float bon = bonv[r];
#pragma unroll
        for (int tj = 0; tj < 4; ++tj) { const int cl = 16 * tj + (lane & 15); const size_t o = (size_t)t * RW + 64 * h + cl;
            float yn = (y[tj][r] - mean) * rstd * lgv[tj] + lbv[tj];
            yn += bon * bf2f(vv[r][tj]); yn *= bf2f(gv[r][tj]);
            pRO[o] = (bf16)f2bf(yn); } }
}
__device__ __forceinline__ void phase_finish(const Ctx& X, int l) {
    for (int u = X.bid * NWAVES + X.wave; u < (M / 16) * NH; u += X.G * NWAVES) { if (l == DEPTH - 1 && u < (CTX / 16) * NH) continue; finish_wave_unit(X, l, u); }
    const int c = X.tid;
    if (c < HW) { const float hbc = X.in(I_HBIAS)[(size_t)l * HW + c]; const float* CV = X.ws<float>(WS_CVT) + (size_t)c * SEQ; const bf16* X0 = X.ws<bf16>(WS_X0); bf16* HO = X.ws<bf16>(WS_HO);
        for (int tile = X.bid; tile < M / TT; tile += X.G) { const int t0 = tile * TT; float cv[TT];
            if (l == DEPTH - 1 && t0 < CTX) continue;
            if (t0 < CTX) {
#pragma unroll
                for (int tt = 0; tt < TT; ++tt) { const size_t o = (size_t)(t0 + tt) * HW + c; cv[tt] = X.ws<float>(WS_CONV)[o] + X.ws<float>(WS_Z)[o] * hbc; } }
            else { const f32x4 a = *(const f32x4*)(CV + (t0 - CTX)), b = *(const f32x4*)(CV + (t0 - CTX) + 4);
#pragma unroll
                for (int i = 0; i < 4; ++i) { cv[i] = a[i]; cv[4 + i] = b[i]; } }
#pragma unroll
            for (int tt = 0; tt < TT; ++tt) { const size_t o = (size_t)(t0 + tt) * HW + c; HO[o] = (bf16)f2bf(cv[tt] * bf2f(X0[o])); } } }
}

__device__ __forceinline__ void ln_inplace(float (&v)[D / 64], const float* g, const float* b, int lane) {
    float s = 0.f;
#pragma unroll
    for (int j = 0; j < D / 64; ++j) s += v[j];
    const float mean = wave_sum(s) * (1.f / D); float q = 0.f;
#pragma unroll
    for (int j = 0; j < D / 64; ++j) { v[j] -= mean; q += v[j] * v[j]; }
    const float rstd = 1.0f / sqrtf(wave_sum(q) * (1.f / D) + LN_EPS);
#pragma unroll
    for (int j = 0; j < D / 64; ++j) { const int d = 4 * lane + 256 * (j >> 2) + (j & 3); v[j] = v[j] * rstd * g[d] + b[d]; }
}
__device__ __forceinline__ void phase_norm1(const Ctx& X, int l_) {
    const int l = l_ & 255; const bool dry = (l_ >> 8) != 0;
    const int gw = X.bid * NWAVES + X.wave, NGW = X.G * NWAVES, lane = X.lane;
    const float* lng = X.in(I_LNG) + (size_t)(l * 2 + 0) * D; const float* lnb = X.in(I_LNB) + (size_t)(l * 2 + 0) * D;
    const float* wr = X.in(I_WR); const float* rb = X.in(I_RB);
    const float alpha = sqrtf(sqrtf(2.0f * DEPTH));
    volatile LAS int* hist = (volatile LAS int*)(X.lds + LDS_MISC + 4096);
    if (X.tid < NE) hist[X.tid] = 0;
    LAS float* wl = (LAS float*)X.lds + NWAVES * D;
    for (int i = X.tid; i < D * NE / 4; i += NTHR) ((LAS f32x4*)wl)[i] = ((const f32x4*)wr)[i];
    __syncthreads();
    for (int t = gw; t < M; t += NGW) { if (l == DEPTH - 1 && t < CTX) continue;
        float* xr = X.ws<float>(WS_X) + (size_t)t * D; const float* mx = X.ws<float>(WS_MIX) + (size_t)t * D;
        const float* gate = modp(X, l, t, 2); const float* sh = modp(X, l, t, 3); const float* sc = modp(X, l, t, 4);
        float v[D / 64];
#pragma unroll
        for (int j = 0; j < D / 256; ++j) { const int d = 4 * lane + 256 * j; const f32x4 a = *(const f32x4*)(xr + d), m = *(const f32x4*)(mx + d), gt = *(const f32x4*)(gate + d);
#pragma unroll
            for (int i = 0; i < 4; ++i) v[4 * j + i] = alpha * a[i] + gt[i] * m[i]; }
        ln_inplace(v, lng, lnb, lane);
        bf16* hf = X.ws<bf16>(WS_XMOD) + (size_t)t * D;
        LAS float* hrow = (LAS float*)X.lds + X.wave * D;
#pragma unroll
        for (int j = 0; j < D / 256; ++j) { const int d = 4 * lane + 256 * j; f32x4 o; const f32x4 a = *(const f32x4*)(sh + d), b = *(const f32x4*)(sc + d); f32x4 h;
#pragma unroll
            for (int i = 0; i < 4; ++i) { o[i] = v[4 * j + i]; h[i] = o[i] * (1.f + b[i]) + a[i]; }
            *(f32x4*)((dry ? X.ws<float>(WS_XG) + (size_t)t * D : xr) + d) = o; *(LAS f32x4*)(hrow + d) = h;
            *(unsigned long long*)(hf + d) = (unsigned long long)pk2(h[0], h[1]) | ((unsigned long long)pk2(h[2], h[3]) << 32); }
        WAVE_LDS_FENCE(); CFENCE();
        f32x4 part = {0.f, 0.f, 0.f, 0.f};
#pragma unroll 8
        for (int i = 0; i < D / 16; ++i) { const float hv = hrow[16 * i + (lane >> 2)]; const f32x4 w4 = *(const LAS f32x4*)(wl + 256 * i + 4 * lane);
#pragma unroll
            for (int c = 0; c < 4; ++c) part[c] += hv * w4[c]; }
#pragma unroll
        for (int c = 0; c < 4; ++c) { float p = part[c]; p += __shfl_xor(p, 4); p += __shfl_xor(p, 8); p += __shfl_xor(p, 16); p += __shfl_xor(p, 32); part[c] = p; }
        WAVE_LDS_FENCE(); CFENCE();
        float lg[NE];
#pragma unroll
        for (int e = 0; e < NE; ++e) lg[e] = __shfl(part[e & 3], e >> 2);
        float mxl = lg[0];
#pragma unroll
        for (int e = 1; e < NE; ++e) mxl = fmaxf(mxl, lg[e]);
        float sc_[NE], sum = 0.f;
#pragma unroll
        for (int e = 0; e < NE; ++e) { sc_[e] = expf(lg[e] - mxl); sum += sc_[e]; }
        const float isum = 1.0f / sum; float sel[NE];
#pragma unroll
        for (int e = 0; e < NE; ++e) { sc_[e] *= isum; sel[e] = sc_[e] + rb[e]; }
        int bg = 0; float bgs = -INFINITY;
#pragma unroll
        for (int g = 0; g < 4; ++g) { float m1 = -INFINITY, m2 = -INFINITY;
#pragma unroll
            for (int i = 0; i < 4; ++i) { const float x = sel[4 * g + i]; if (x > m1) { m2 = m1; m1 = x; } else if (x > m2) m2 = x; }
            const float gs = m1 + m2; if (gs > bgs) { bgs = gs; bg = g; } }
        int i0 = 0, i1 = 0; float s0 = -INFINITY, s1 = -INFINITY, p0 = 0.f, p1 = 0.f;
#pragma unroll
        for (int e = 0; e < NE; ++e) { if ((e >> 2) == bg) { const float x = sel[e]; if (x > s0) { s1 = s0; i1 = i0; p1 = p0; s0 = x; i0 = e; p0 = sc_[e]; } else if (x > s1) { s1 = x; i1 = e; p1 = sc_[e]; } } }
        if (lane == 0) { int* ei = X.ws<int>(WS_ROUT) + (size_t)t * 2; float* ew = (float*)(X.ws<int>(WS_ROUT) + (size_t)M * 2) + (size_t)t * 2;
            ei[0] = i0; ei[1] = i1; const float ws_ = 1.0f / (p0 + p1); ew[0] = p0 * ws_; ew[1] = p1 * ws_;
            lds_add(hist + i0, 1); lds_add(hist + i1, 1); }
    }
    __syncthreads();
    if (X.tid < NE && !dry) { const int hc = hist[X.tid]; X.ws<int>(WS_BCNT)[X.bid * NE + X.tid] = hc; atomicAdd(X.ctl() + CW_CNT + l * 64 + X.tid, (unsigned)hc); }
}

__device__ __forceinline__ void moe_table(const Ctx& X, int l, int NT) {
    volatile LAS int* tab = (volatile LAS int*)(X.lds + LDS_MISC) + 8;
    if (X.tid < NE) { const int cnt = (int)__hip_atomic_load(X.ctl() + CW_CNT + l * 64 + X.tid, RLX_AGENT); tab[64 + X.tid] = (cnt + 255) / 256; }
    __syncthreads();
    if (X.tid == 0) { int cum = 0, ts = 0;
        for (int e = 0; e < NE; ++e) { const int tc = tab[64 + e]; tab[e] = cum; tab[32 + e] = ts; cum += tc * NT; ts += tc; }
        tab[16] = cum; }
    __syncthreads();
}
__device__ __forceinline__ void phase_scatter(const Ctx& X, int l) {
    moe_table(X, l, 1);
    volatile LAS int* tab = (volatile LAS int*)(X.lds + LDS_MISC) + 8;
    volatile LAS int* cur = (volatile LAS int*)(X.lds + LDS_MISC + 4096) + 16;
    const int gw = X.bid * NWAVES + X.wave, NGW = X.G * NWAVES, lane = X.lane;
    if (X.tid < NE) cur[X.tid] = tab[32 + X.tid] * 256;
    __syncthreads();
    { const int* bc = X.ws<int>(WS_BCNT) + (X.tid & 15); int pre = 0;
        for (int b = X.tid >> 4; b < X.bid; b += NTHR / 16) pre += bc[b * NE];
        if (pre) lds_add(cur + (X.tid & 15), pre); }
    __syncthreads();
    const int* ei = X.ws<int>(WS_ROUT); int* slot = X.ws<int>(WS_ROUT) + (size_t)M * 4;
    for (int t = gw; t < M; t += NGW) { if (l == DEPTH - 1 && t < CTX) continue;
#pragma unroll
        for (int k = 0; k < 2; ++k) { const int e = ei[2 * t + k];
            int pos = 0; if (lane == 0) pos = lds_add(cur + e, 1);
            pos = __shfl(pos, 0);
            if (lane == 0) slot[2 * t + k] = pos;
            const u32x4* src = (const u32x4*)(X.ws<bf16>(WS_XMOD) + (size_t)t * D); u32x4* dst = (u32x4*)(X.ws<bf16>(WS_XG) + (size_t)pos * D);
            for (int i = lane; i < D / 8; i += 64) dst[i] = src[i]; } }
}

__device__ __forceinline__ void phase_combine(const Ctx& X, int l_) {
    const int l = l_ & 255; const bool dry = (l_ >> 8) != 0;
    const int gw = X.bid * NWAVES + X.wave, NGW = X.G * NWAVES, lane = X.lane;
    const float* lng = X.in(I_LNG) + (size_t)(l * 2 + 1) * D; const float* lnb = X.in(I_LNB) + (size_t)(l * 2 + 1) * D;
    const float alpha = sqrtf(sqrtf(2.0f * DEPTH));
    const float* ew = (const float*)(X.ws<int>(WS_ROUT) + (size_t)M * 2); const int* slot = X.ws<int>(WS_ROUT) + (size_t)M * 4;
    const bool bad = __hip_atomic_load(X.ctl() + CW_BAR + XB_TMO, RLX_AGENT) != 0u; const float pscale = 1.0f + bitsf(__hip_atomic_load(X.ctl() + 64, RLX_AGENT));
    for (int t = gw; t < M; t += NGW) { if (l == DEPTH - 1 && t < CTX) continue;
        float* xr = X.ws<float>(WS_X) + (size_t)t * D; const float* gate = modp(X, l, t, 5);
        const bf16* y0 = X.ws<bf16>(WS_YS) + (size_t)slot[2 * t] * D; const bf16* y1 = X.ws<bf16>(WS_YS) + (size_t)slot[2 * t + 1] * D; const float w0 = ew[2 * t], w1 = ew[2 * t + 1];
        float v[D / 64];
#pragma unroll
        for (int j = 0; j < D / 256; ++j) { const int d = 4 * lane + 256 * j; const f32x4 a = *(const f32x4*)(xr + d), gt = *(const f32x4*)(gate + d);
            const unsigned long long q0 = *(const unsigned long long*)(y0 + d), q1 = *(const unsigned long long*)(y1 + d);
            float ya[4] = {bflo((unsigned)q0), bfhi((unsigned)q0), bflo((unsigned)(q0 >> 32)), bfhi((unsigned)(q0 >> 32))};
            float yb[4] = {bflo((unsigned)q1), bfhi((unsigned)q1), bflo((unsigned)(q1 >> 32)), bfhi((unsigned)(q1 >> 32))};
#pragma unroll
            for (int i = 0; i < 4; ++i) v[4 * j + i] = alpha * a[i] + gt[i] * (w0 * ya[i] + w1 * yb[i]); }
        ln_inplace(v, lng, lnb, lane);
        if (l + 1 < DEPTH) { const float* sh = modp(X, l + 1, t, 0); const float* sc = modp(X, l + 1, t, 1); bf16* xm = X.ws<bf16>(WS_XMOD) + (size_t)t * D;
#pragma unroll
            for (int j = 0; j < D / 256; ++j) { const int d = 4 * lane + 256 * j; f32x4 o; const f32x4 a = *(const f32x4*)(sh + d), b = *(const f32x4*)(sc + d); float h[4];
#pragma unroll
                for (int i = 0; i < 4; ++i) { o[i] = v[4 * j + i]; h[i] = o[i] * (1.f + b[i]) + a[i]; }
                *(f32x4*)((dry ? X.ws<float>(WS_XG) + (size_t)t * D : xr) + d) = o;
                *(unsigned long long*)(xm + d) = (unsigned long long)pk2(h[0], h[1]) | ((unsigned long long)pk2(h[2], h[3]) << 32); }
        } else if (t >= CTX) { float* orow = X.out() + (size_t)(t - CTX) * D;
#pragma unroll
            for (int j = 0; j < D / 256; ++j) { const int d = 4 * lane + 256 * j; f32x4 o;
#pragma unroll
                for (int i = 0; i < 4; ++i) o[i] = bad ? __builtin_nanf("") : v[4 * j + i] * pscale;
                *(f32x4*)((dry ? X.ws<float>(WS_XG) + (size_t)t * D : orow) + d) = o; }
        }
    }
}


#ifdef EMU
#define PHASE_FN static
#define THIN_FN static
#else
#define PHASE_FN __device__ __forceinline__
#define THIN_FN __device__ __noinline__
#endif
THIN_FN void ph_transposes(Ctx X, int l, int part) { phase_transposes(X, l, part); }
THIN_FN void ph_filters_begin(Ctx X) { phase_filters_begin(X); }
THIN_FN void ph_filters_item(Ctx X, int l, int which, int it) { phase_filters_item(X, l, which, it); }
THIN_FN void ph_filters_end(Ctx X) { phase_filters_end(X); }
#define PH_FILTERS(X_, l_) do { ph_filters_begin(X_); for (int wh_ = 0; wh_ < 2; ++wh_) for (int it_ = (X_).bid * NWAVES + (X_).wave; it_ < (wh_ ? CTX : SEQ) / 16; it_ += (X_).G * NWAVES) ph_filters_item(X_, l_, wh_, it_); ph_filters_end(X_); } while (0)
THIN_FN void ph_filter_weights(Ctx X, int l) { phase_filter_weights(X, l); }
THIN_FN void ph_mod(Ctx X) { phase_mod(X); }
THIN_FN void ph_x0(Ctx X) { phase_x0(X); }
THIN_FN void ph_lin(Ctx X, int l) { phase_lin(X, l); }
THIN_FN void ph_lora_a(Ctx X, int u) { lora_unit_a(X, u); }
THIN_FN void ph_lora_b(Ctx X, int l, int u) { lora_unit_b(X, l, u); }
THIN_FN void ph_prep_hyena(Ctx X, int l) { phase_prep_hyena(X, l); }
THIN_FN void ph_ctxconv(Ctx X, int l) { phase_ctxconv(X, l); }
THIN_FN void ph_chunk_1(Ctx X, int u) { chunk_unit_1(X, u); }
THIN_FN void ph_chunk_2(Ctx X, int u) { chunk_unit_2(X, u); }
THIN_FN void ph_chunk_3(Ctx X, int u) { chunk_unit_3(X, u); }
THIN_FN void ph_seq(Ctx X) { phase_seq(X); }
THIN_FN void ph_fft_tables(Ctx X) { fft_tables(X); }
THIN_FN void ph_fft_run(Ctx X, int inverse) { fft_run((LAS cf*)X.lds, (const LAS cf*)(X.lds + FFT_TAB_OFF), X.tid, inverse != 0); }
THIN_FN void ph_spec_load(Ctx X, int c) { spec_load(X, c); }
THIN_FN void ph_spec_unpack(Ctx X, int c) { spec_unpack(X, c); }
THIN_FN void ph_fftconv_load(Ctx X, int c) { fftconv_load(X, c); }
THIN_FN void ph_fftconv_mul(Ctx X, int c) { fftconv_mul(X, c); }
THIN_FN void ph_fftconv_out(Ctx X, int l, int c) { fftconv_out(X, l, c); }
THIN_FN void ph_finish(Ctx X, int l) { phase_finish(X, l); }
THIN_FN void ph_norm1(Ctx X, int l) { phase_norm1(X, l); }
THIN_FN void ph_scatter(Ctx X, int l) { phase_scatter(X, l); }
THIN_FN void ph_combine(Ctx X, int l) { phase_combine(X, l); }
PHASE_FN void ph_g13(Ctx X, int third, int r0) { pg8::Gemm g{(third ? X.ws<bf16>(WS_T) : X.ws<bf16>(WS_XMOD)) + (size_t)r0 * D, third ? X.ws<bf16>(WS_WO) : X.ws<bf16>(WS_WIN), D}; pg8::StaticOrder S; S.init(M - r0, third ? D : PCP, X.G, X.bid);
    pg8::EpiBf16OrF32 E{X.ws<bf16>(WS_P) + (size_t)r0 * PCP, X.ws<float>(WS_MIX) + (size_t)r0 * D, third ? D : PCP, third != 0}; pg8::gemm_phase(X.lds, g, S, E); }
PHASE_FN void ph_g2(Ctx X, int second, int r0) { pg8::Gemm g{(second ? X.ws<bf16>(WS_HO) : X.ws<bf16>(WS_RO)) + (size_t)r0 * RW, X.ws<bf16>(WS_WB) + (second ? (size_t)D * RW : 0), RW}; pg8::StaticOrder S; S.init(M - r0, D, X.G, X.bid);
    pg8::EpiGate E{X.ws<bf16>(WS_T) + (size_t)r0 * D, D, X.ws<bf16>(WS_P) + (size_t)r0 * PCP, PCP, second ? C_GH : C_GR, second != 0}; pg8::gemm_phase(X.lds, g, S, E); }
PHASE_FN void ph_g45(Ctx X, int l, int down) { const int NT = down ? D / 256 : 2 * D / 256; moe_table(X, l, NT); pg8::MoeOrder S{(const volatile LAS int*)(X.lds + LDS_MISC) + 8, NT, X.G, X.bid};
    pg8::Gemm g{down ? X.ws<bf16>(WS_ACT) : X.ws<bf16>(WS_XG), down ? X.ws<bf16>(WS_WD) : X.ws<bf16>(WS_WGU), D}; pg8::EpiMoe E{down ? X.ws<bf16>(WS_YS) : X.ws<bf16>(WS_ACT), D, NT, down == 0}; pg8::gemm_phase(X.lds, g, S, E); }

constexpr int NPH = 16, NPHASES = DEPTH * NPH;
template <int MASK> __global__ void __launch_bounds__(NTHR, 2) fwd_kernel(Args args) {
    DYN_LDS(lds);
    Ctx X; X.lds = lds; X.tid = threadIdx.x; X.lane = X.tid & 63; X.wave = READFIRSTLANE(X.tid >> 6); X.G = gridDim.x; X.bid = blockIdx.x;
    volatile LAS unsigned* misc = (volatile LAS unsigned*)(lds + LDS_MISC);
    if (X.tid < 128) misc[X.tid] = 0u;
    if (X.tid < N_IN + 2) { const unsigned long long p = X.tid < N_IN ? (unsigned long long)args.in[X.tid < N_IN ? X.tid : 0] : (X.tid == N_IN ? (unsigned long long)args.out : (unsigned long long)args.ws);
        misc[PT_WORD0 + 2 * X.tid] = (unsigned)p; misc[PT_WORD0 + 2 * X.tid + 1] = (unsigned)(p >> 32); }
    __syncthreads();
    XcdBarrier bar = xcd_barrier_post(X.ctl() + CW_BAR, misc);
    const int lo = args.ph_lo, hi = args.ph_hi;
#define IN(k) ((((MASK) >> ((k) % NPH)) & 1) && lo <= (k) && (k) < hi)
#ifdef PROBE_K
#ifndef PROBE_SCALE
#define PROBE_SCALE 1.0f
#endif
#ifndef PROBE_BLOCK
#define PROBE_BLOCK 0
#endif
    unsigned long long plast = __builtin_amdgcn_s_memrealtime(); if (threadIdx.x < 32) misc[2048 + threadIdx.x] = 0u; __syncthreads();
#define PROBE_TX(k) do { if (blockIdx.x == PROBE_BLOCK && threadIdx.x == 0) { const unsigned long long now_ = __builtin_amdgcn_s_memrealtime(); misc[2048 + (k)] += (unsigned)(now_ - plast); plast = now_; } } while (0)
#define PROBE_T(k) PROBE_TX((k) % NPH)
#ifdef PROBE_KMASK
#define PROBE_PUB(k) do {} while (0)
#else
#define PROBE_PUB(k) do { if ((k) == NPHASES - 2 && blockIdx.x == PROBE_BLOCK && threadIdx.x == 0) { PROBE_T(k); unsigned tot_ = 0; for (int i_ = 0; i_ < 28; ++i_) tot_ += misc[2048 + i_]; \
        const float f_ = floorf(PROBE_SCALE * (float)misc[2048 + PROBE_K] / (float)tot_ * 128.0f + 0.5f) * (1.0f / 128.0f); __hip_atomic_store(X.ctl() + 64, fbits(f_), RLX_AGENT); } } while (0)
#endif
#else
#define PROBE_T(k) do {} while (0)
#define PROBE_TX(k) do {} while (0)
#define PROBE_PUB(k) do {} while (0)
#endif
#if defined(REPEAT_SUB) && REPEAT_SUB == 20
#define SEAM(k) do { if ((k) + 1 < hi) { xcd_barrier(bar); xcd_barrier(bar); } } while (0)
#else
#define SEAM(k) do { PROBE_PUB(k); if ((k) + 1 < hi) xcd_barrier(bar); PROBE_T(k); } while (0)
#endif
#if defined(REPEAT_SUB) && REPEAT_SUB == 15
#define RQN 2
#else
#define RQN 1
#endif
#ifdef REPEAT_SUB
#define RPS(id) for (int rps_ = 0; rps_ < ((id) == REPEAT_SUB ? 2 : 1); ++rps_)
#define RPS_N(id) ((id) == REPEAT_SUB ? 2 : 1)
#define rps_i rps_
#else
#define RPS(id)
#define RPS_N(id) 1
#define rps_i 0
#endif
#ifdef REPEAT_PH
#define RPT_IDX rpt_
#define RPT(k) for (int rpt_ = 0; rpt_ < (((k) % NPH) == REPEAT_PH ? 2 : 1); ++rpt_)
#else
#define RPT_IDX 0
#define RPT(k)
#endif
    for (int l = 0; l < DEPTH; ++l) {
        const int pb = l * NPH;
        if (l == 0 && IN(pb + 0)) { ph_transposes(X, l, 0); __syncthreads(); PROBE_TX(16); ph_filter_weights(X, 0); ph_mod(X); PROBE_TX(17); SEAM(pb + 0); }
        if (l == 0 && IN(pb + 1)) { ph_x0(X); PROBE_TX(18); PH_FILTERS(X, 0); PROBE_TX(19); SEAM(pb + 1); }
        if (IN(pb + 2)) { ph_g13(X, 0, 0); SEAM(pb + 2); }
        RPT(pb + 3) if (IN(pb + 3)) { RPS(6) ph_lin(X, l); RPS(7) ph_prep_hyena(X, l); ph_fft_tables(X); PROBE_TX(20); RPS(8) for (int c = X.bid; c < HW; c += X.G) { ph_spec_load(X, c); ph_fft_run(X, 0); ph_spec_unpack(X, c); } SEAM(pb + 3); }
        RPT(pb + 4) if (IN(pb + 4)) { for (int u = X.bid; u < (M / 64) * NH; u += X.G) { RPS(4) ph_lora_a(X, u); PROBE_TX(21); RPS(5) ph_lora_b(X, l, u); PROBE_TX(22); } SEAM(pb + 4); }
        RPT(pb + 5) if (IN(pb + 5)) { for (int u = X.bid; u < 2 * NCHK * NH; u += X.G) { RPS(1) ph_chunk_1(X, u); PROBE_TX(23); RPS(2) ph_chunk_2(X, u); PROBE_TX(24); RPS(3) ph_chunk_3(X, u); PROBE_TX(25); } SEAM(pb + 5); }
        RPT(pb + 6) if (IN(pb + 6)) { RPS(9) ph_seq(X); PROBE_TX(26); RPS(10) { ph_transposes(X, l, 1); __syncthreads(); } PROBE_TX(27); if (l + 1 < DEPTH) ph_filter_weights(X, l + 1); if (l + 1 < DEPTH) ph_ctxconv(X, l); ph_fft_tables(X); PROBE_TX(28);
            for (int rq_ = 0; rq_ < RQN; ++rq_) for (;;) { if (X.tid == 0) misc[121] = atomicAdd(X.ctl() + CW_Q + l * 64 + 32 + rq_, 1u); __syncthreads(); const int c = (int)misc[121]; __syncthreads(); if (c >= HW) break;
                ph_fftconv_load(X, c); ph_fft_run(X, 0); ph_fftconv_mul(X, c); ph_fft_run(X, 1); ph_fftconv_out(X, l, c); }
            PROBE_TX(29); SEAM(pb + 6); }
        RPT(pb + 7) if (IN(pb + 7)) { ph_finish(X, l); SEAM(pb + 7); }
        for (int sb = 0; sb < 2; ++sb) if (IN(pb + 8 + sb)) { ph_g2(X, sb, l == DEPTH - 1 ? CTX : 0); SEAM(pb + 8 + sb); }
        RPT(pb + 10) if (IN(pb + 10)) { ph_g13(X, 1, l == DEPTH - 1 ? CTX : 0); SEAM(pb + 10); }
        if (IN(pb + 11)) { RPS(28) ph_norm1(X, l | ((RPS_N(28) - 1 - rps_i) << 8)); SEAM(pb + 11); }
        if (IN(pb + 12)) { RPS(14) ph_scatter(X, l); SEAM(pb + 12); }
        for (int dn = 0; dn < 2; ++dn) if (IN(pb + 13 + dn)) { ph_g45(X, l, dn); SEAM(pb + 13 + dn); }
        if (IN(pb + 15)) { RPS(11) ph_combine(X, l | ((RPS_N(11) - 1 - rps_i) << 8)); PROBE_TX(30); if (l + 1 < DEPTH) { __syncthreads(); RPS(12) { ph_transposes(X, l + 1, 0); __syncthreads(); } PROBE_TX(31); RPS(13) PH_FILTERS(X, l + 1); } SEAM(pb + 15); }
    }
#if defined(PROBE_K) && defined(PROBE_KMASK)
    if (blockIdx.x == PROBE_BLOCK && threadIdx.x == 0) { unsigned tot_ = 0; for (int i_ = 0; i_ < 32; ++i_) if ((PROBE_KMASK >> i_) & 1) tot_ += misc[2048 + i_];
        const unsigned long long t0_ = __builtin_amdgcn_s_memrealtime(); while ((unsigned)(__builtin_amdgcn_s_memrealtime() - t0_) < tot_) __builtin_amdgcn_s_sleep(8); }
#endif
#undef IN
#undef SEAM
}

#ifndef N_LAUNCHES
#define N_LAUNCHES 1
#endif
#ifndef PH_MASK
#define PH_MASK 0xffff
#endif
template <int MASK> static void launch_mask(int grid, hipStream_t stream, const Args& a) {
    static bool attr = false;
    if (!attr) { (void)hipFuncSetAttribute((const void*)fwd_kernel<MASK>, hipFuncAttributeMaxDynamicSharedMemorySize, LDS_BYTES); attr = true; }
    hipLaunchKernelGGL(fwd_kernel<MASK>, dim3(grid), dim3(NTHR), LDS_BYTES, stream, a);
}
extern "C" void kernel_launch(void* const* d_in, const int* in_sizes, int n_in, void* d_out, int out_size, void* d_ws, size_t ws_size, hipStream_t stream) {
    static int grid = 0;
    if (grid == 0) {
        if (n_in != N_IN || ws_size < WS_END) { fprintf(stderr, "kernel_launch: unexpected n_in %d or workspace %zu < %zu\n", n_in, ws_size, (size_t)WS_END); grid = -1; return; }
        int dev = 0, cus = 0;
        if (hipGetDevice(&dev) != hipSuccess || hipDeviceGetAttribute(&cus, hipDeviceAttributeMultiprocessorCount, dev) != hipSuccess) { grid = -1; return; }
        (void)hipGetLastError();
        grid = cus; if (grid > NPART) grid = NPART;
    }
    if (grid < 0) return;
    (void)in_sizes; (void)out_size;
    (void)hipMemsetAsync(d_ws, 0, CTL_BYTES, stream);
    Args a;
    for (int i = 0; i < N_IN; ++i) a.in[i] = (const float*)d_in[i];
    a.out = (float*)d_out; a.ws = (unsigned char*)d_ws;
#if N_LAUNCHES == 1
    a.ph_lo = 0; a.ph_hi = NPHASES;
    launch_mask<PH_MASK>(grid, stream, a);
#else
    for (int ph = 0; ph < NPHASES; ++ph) { const int k = ph % NPH; if (k == 1 && ph / NPH != 0) continue; a.ph_lo = ph; a.ph_hi = ph + 1; launch_mask<PH_MASK>(grid, stream, a); }
#endif
}
```

```cpp
#ifndef EMU
#include <hip/hip_runtime.h>
#endif
#include <cstdio>
#include <cstdint>
#include <cmath>

#ifndef CFG_D
#define CFG_D 1024
#define CFG_SEQ 16384
#define CFG_CTX 256
#define CFG_DEPTH 4
#endif
constexpr int D = CFG_D, SEQ = CFG_SEQ, CTX = CFG_CTX, DEPTH = CFG_DEPTH, M = CTX + SEQ;
constexpr int GRID_W = 64, GRID_H = SEQ / GRID_W;
constexpr int RW = D / 2, NH = RW / 64, HW = D / 2, RC = 3 * RW + 384, HC = 3 * HW, GC = 2 * D, PC = RC + HC + GC, PCP = (PC + 255) / 256 * 256;
constexpr int QTR = RC / 4, HALFC = RC / 2;
constexpr int C_K = RW, C_V = 2 * RW, C_LWF = 3 * RW, C_LG = 3 * RW + 256;
constexpr int C_HY = RC, C_GR = RC + HC, C_GH = RC + HC + D;
constexpr int NE = 16, SP_TILES = (2 * M) / 256 + NE, SP = SP_TILES * 256;
constexpr float DECAY_SCALE = 0.606531f, GN_EPS = 6.4e-4f, LN_EPS = 1e-5f;
constexpr int LP = 72;
constexpr int LQ = 65;
constexpr int LX = 68;
constexpr int N_SEQ_UNITS = 2 * NH * 4;
constexpr int NPART = 256;
static_assert(CTX % 32 == 0 && M % 256 == 0 && D % 256 == 0 && RW % 128 == 0 && RW >= 256 && SEQ % 64 == 0 && CTX % 32 == 0 && RC % 4 == 0, "shape assumptions");

enum { I_X = 0, I_C, I_CTX, I_CCTX, I_WMOD, I_BMOD, I_WIN, I_MU, I_W0, I_W2, I_A0, I_A2, I_G2, I_KK, I_KA, I_RK, I_LNXG, I_LNXB, I_CW, I_CB,
       I_FW1, I_FB1, I_FW2, I_FB2, I_FW3, I_FB3, I_FWO, I_FREQ, I_HBIAS, I_WBR, I_WOUT, I_LNG, I_LNB, I_WR, I_RB, I_WG, I_WU, I_WD, N_IN };

constexpr size_t al256(size_t x) { return (x + 255) & ~(size_t)255; }
constexpr size_t CTL_BYTES = 1u << 20;
constexpr size_t WS_MOD = CTL_BYTES;
constexpr size_t WS_FPART = al256(WS_MOD + (size_t)DEPTH * 2 * 6 * D * 4);
constexpr size_t WS_ROUT = al256(WS_FPART + (size_t)2 * NPART * HW * 4);
constexpr size_t WS_BCNT = al256(WS_ROUT + (size_t)M * 2 * 4 * 3);
constexpr size_t WS_BONUS = al256(WS_BCNT + (size_t)NPART * NE * 4);
constexpr size_t WS_WIN = al256(WS_BONUS + (size_t)M * NH * 4);
constexpr size_t WS_WB = al256(WS_WIN + (size_t)PCP * D * 2);
constexpr size_t WS_WO = al256(WS_WB + (size_t)2 * D * RW * 2);
constexpr size_t WS_W2T = al256(WS_WO + (size_t)D * D * 2);
constexpr size_t WS_A2T = al256(WS_W2T + (size_t)2 * RW * 64 * 2);
constexpr size_t WS_G2T = al256(WS_A2T + (size_t)2 * RW * 64 * 2);
constexpr size_t WS_FWT = al256(WS_G2T + (size_t)RW * 128 * 2);
constexpr size_t WS_WGU = al256(WS_FWT + (size_t)(3 * 64 + HW) * 64 * 2);
constexpr size_t WS_WD = al256(WS_WGU + (size_t)NE * 2 * D * D * 2);
constexpr size_t WS_X = al256(WS_WD + (size_t)NE * D * D * 2);
constexpr size_t WS_XMOD = al256(WS_X + (size_t)M * D * 4);
constexpr size_t WS_P = al256(WS_XMOD + (size_t)M * D * 2);
constexpr size_t WS_FILT = al256(WS_P + (size_t)M * PCP * 2);
constexpr size_t WS_MIX = al256(WS_FILT + (size_t)M * HW * 4);
constexpr size_t WS_T = al256(WS_MIX + (size_t)M * D * 4);
constexpr size_t WS_S = al256(WS_T + (size_t)M * D * 2);
constexpr size_t WS_R = WS_S;
constexpr size_t WS_V = al256(WS_R + (size_t)M * RW * 2);
constexpr size_t WS_KA = al256(WS_V + (size_t)M * RW * 2);
constexpr size_t WS_KD = al256(WS_KA + (size_t)M * RW * 2);
constexpr size_t WS_KB = al256(WS_KD + (size_t)2 * M * RW * 2);
constexpr size_t WS_W = al256(WS_KB + (size_t)2 * M * RW * 2);
constexpr size_t WS_PQ = al256(WS_W + (size_t)2 * M * RW * 4);
constexpr size_t WS_LIN = WS_PQ;
static_assert((size_t)M * 384 * 2 <= (size_t)2 * NH * (M / 64) * 2 * 4096 * 4, "LIN fits PQ");
constexpr size_t WS_G = al256(WS_PQ + (size_t)2 * NH * (M / 64) * 2 * 4096 * 4);
constexpr size_t WS_YL = al256(WS_G + (size_t)2 * NH * (M / 64) * 4096 * 2);
constexpr size_t WS_S0 = WS_XMOD;
static_assert((size_t)2 * NH * (M / 64) * 4096 * 2 <= (size_t)M * D * 2, "S0 fits XMOD");
constexpr size_t WS_Z = al256(WS_YL + (size_t)2 * NH * (M / 64) * 4096 * 4);
constexpr size_t WS_X0 = al256(WS_Z + (size_t)CTX * HW * 4);
constexpr size_t WS_CONV = al256(WS_X0 + (size_t)M * HW * 2);
constexpr size_t WS_GATE = al256(WS_CONV + (size_t)CTX * HW * 4);
constexpr size_t WS_RO = al256(WS_GATE + (size_t)M * RW * 2);
constexpr size_t WS_HO = al256(WS_RO + (size_t)M * RW * 2);
constexpr size_t WS_HS = WS_MIX;
constexpr size_t WS_ZT = WS_T;
constexpr size_t WS_CVT = WS_FILT;
static_assert((size_t)HW * (SEQ + 1) * 8 <= (size_t)M * D * 4 && (size_t)HW * M * 4 <= (size_t)M * D * 2, "HS fits MIX, ZT fits T");
constexpr size_t WS_END1 = al256(WS_HO + (size_t)M * HW * 2);
constexpr size_t WS_XG = WS_S;
constexpr size_t WS_ACT = al256(WS_XG + (size_t)SP * D * 2);
constexpr size_t WS_YS = al256(WS_ACT + (size_t)SP * D * 2);
constexpr size_t WS_END2 = al256(WS_YS + (size_t)SP * D * 2);
constexpr size_t WS_END = WS_END1 > WS_END2 ? WS_END1 : WS_END2;
constexpr int CW_TMO = 0, CW_BAR = 4096, CW_CNT = 8192  , CW_CUR = 8192 + 1024  , CW_Q = 8192 + 2048  ;

#ifdef EMU
#define LAS
typedef short bf16x8 __attribute__((vector_size(16)));
typedef float f32x4 __attribute__((vector_size(16)));
typedef unsigned u32x4 __attribute__((vector_size(16)));
#define DYN_LDS(name) unsigned char* name = emu_cur_lds()
#define ASM_WAIT_V(n) do {} while (0)
#define ASM_WAIT_L(n) do {} while (0)
#define ASM_WAIT_VL0() do {} while (0)
#define CFENCE() do {} while (0)
#define WAVE_LDS_FENCE() emu_wave_sync()
#define S_BARRIER() emu_block_sync()
#define SCHED_BARRIER() do {} while (0)
#define SETPRIO(x) do {} while (0)
#define S_SLEEP(n) emu_yield()
#define MFMA16(a, b, c) emu_mfma_16x16x32(a, b, c)
#define MFMA4F(a, b, c) emu_mfma_16x16x4f32(a, b, c)
#define GLDS16(gptr, lptr) emu_glds16((const void*)(gptr), (void*)(lptr))
#define READFIRSTLANE(x) (x)
#define XCC_ID_() (blockIdx.x & 7u)
#define FENCE_RELEASE() do {} while (0)
#define FENCE_ACQUIRE() do {} while (0)
#define DPP_F(v, ctrl) emu_dpp_f(v, ctrl)
#define READLANE_F(v, l) emu_xchg((float)(v), (l))
static inline int vgpr_zero() { return 0; }
static inline unsigned long long vgpr_zero64() { return 0ull; }
static inline int lds_add(volatile int* p, int v) { int o = *p; *p = o + v; return o; }
static inline void lds_addf(float* p, float v) { *p += v; }
static inline unsigned fbits(float f) { unsigned u; memcpy(&u, &f, 4); return u; }
static inline float bitsf(unsigned u) { float f; memcpy(&f, &u, 4); return f; }
#else
#define LAS __attribute__((address_space(3)))
typedef short bf16x8 __attribute__((ext_vector_type(8)));
typedef float f32x4 __attribute__((ext_vector_type(4)));
typedef unsigned u32x4 __attribute__((ext_vector_type(4)));
#define DYN_LDS(name) extern __shared__ __attribute__((aligned(16))) unsigned char name##_raw[]; LAS unsigned char* name = (LAS unsigned char*)name##_raw
#define ASM_WAIT_V(n) asm volatile("s_waitcnt vmcnt(" #n ")" ::: "memory")
#define ASM_WAIT_L(n) asm volatile("s_waitcnt lgkmcnt(" #n ")" ::: "memory")
#define ASM_WAIT_VL0() asm volatile("s_waitcnt vmcnt(0) lgkmcnt(0)" ::: "memory")
#define CFENCE() asm volatile("" ::: "memory")
#define WAVE_LDS_FENCE() asm volatile("s_waitcnt lgkmcnt(0)" ::: "memory")
#define S_BARRIER() __builtin_amdgcn_s_barrier()
#define SCHED_BARRIER() __builtin_amdgcn_sched_barrier(0)
#define SETPRIO(x) __builtin_amdgcn_s_setprio(x)
#define S_SLEEP(n) __builtin_amdgcn_s_sleep(n)
#define MFMA16(a, b, c) __builtin_amdgcn_mfma_f32_16x16x32_bf16(a, b, c, 0, 0, 0)
#define MFMA4F(a, b, c) __builtin_amdgcn_mfma_f32_16x16x4f32(a, b, c, 0, 0, 0)
#define GLDS16(gptr, lptr) __builtin_amdgcn_global_load_lds((const unsigned*)(gptr), (LAS unsigned*)(lptr), 16, 0, 0)
#define READFIRSTLANE(x) __builtin_amdgcn_readfirstlane(x)
#define XCC_ID_() ((unsigned)__builtin_amdgcn_s_getreg((3 << 11) | 20) & 0xFu)
#define FENCE_RELEASE() __builtin_amdgcn_fence(__ATOMIC_RELEASE, "agent")
#define FENCE_ACQUIRE() __builtin_amdgcn_fence(__ATOMIC_ACQUIRE, "agent")
#define DPP_F(v, ctrl) __builtin_bit_cast(float, __builtin_amdgcn_update_dpp(0, __builtin_bit_cast(int, (float)(v)), (ctrl), 0xF, 0xF, true))
#define READLANE_F(v, l) __builtin_bit_cast(float, __builtin_amdgcn_readlane(__builtin_bit_cast(int, (float)(v)), (l)))
__device__ __forceinline__ int vgpr_zero() { int z; asm volatile("v_mov_b32 %0, 0" : "=v"(z)); return z; }
__device__ __forceinline__ unsigned long long vgpr_zero64() { unsigned long long z; asm volatile("v_mov_b64 %0, 0" : "=v"(z)); return z; }
__device__ __forceinline__ void lds_addf(LAS float* p, float v) { (void)__hip_atomic_fetch_add(p, v, __ATOMIC_RELAXED, __HIP_MEMORY_SCOPE_WORKGROUP); }
__device__ __forceinline__ int lds_add(volatile LAS int* p, int v) { return __hip_atomic_fetch_add((LAS int*)p, v, __ATOMIC_RELAXED, __HIP_MEMORY_SCOPE_WORKGROUP); }
__device__ __forceinline__ unsigned fbits(float f) { return __builtin_bit_cast(unsigned, f); }
__device__ __forceinline__ float bitsf(unsigned u) { return __builtin_bit_cast(float, u); }
#endif
typedef unsigned short bf16;
#define RLX_AGENT __ATOMIC_RELAXED, __HIP_MEMORY_SCOPE_AGENT

__device__ __forceinline__ unsigned f2bf(float f) { unsigned u = fbits(f); return (u + 0x7fffu + ((u >> 16) & 1u)) >> 16; }
__device__ __forceinline__ unsigned pk2(float lo, float hi) { return f2bf(lo) | (f2bf(hi) << 16); }
__device__ __forceinline__ float bf2f(bf16 b) { return bitsf(((unsigned)b) << 16); }
__device__ __forceinline__ float bflo(unsigned w) { return bitsf(w << 16); }
__device__ __forceinline__ float bfhi(unsigned w) { return bitsf(w & 0xffff0000u); }
#ifdef EMU
__device__ __forceinline__ float fexp(float x) { return expf(x); }
__device__ __forceinline__ float frcp(float x) { return 1.0f / x; }
#else
__device__ __forceinline__ float fexp(float x) { return __builtin_amdgcn_exp2f(x * 1.4426950408889634f); }
__device__ __forceinline__ float frcp(float x) { return __builtin_amdgcn_rcpf(x); }
#endif
__device__ __forceinline__ float sigmoidf_(float x) { return frcp(1.0f + fexp(-x)); }
__device__ __forceinline__ float row16_sum(float v) {
    v += DPP_F(v, 0xB1);
    v += DPP_F(v, 0x4E);
    v += DPP_F(v, 0x141);
    v += DPP_F(v, 0x140);
    return v;
}
__device__ __forceinline__ float wave_sum(float v) {
    const float r = row16_sum(v);
    return (READLANE_F(r, 0) + READLANE_F(r, 16)) + (READLANE_F(r, 32) + READLANE_F(r, 48));
}
__device__ __forceinline__ void sincos_f(float x, float& s, float& c) {
    const float k = rintf(x * 0.63661977236758134f);
    float r = fmaf(-k, 1.5703125f, x); r = fmaf(-k, 4.837512969970703125e-4f, r); r = fmaf(-k, 7.54978994989188216e-8f, r);
    const float r2 = r * r;
    const float sp = r + r * r2 * (-1.6666654611e-1f + r2 * (8.3321608736e-3f + r2 * (-1.9515295891e-4f)));
    const float cp = 1.0f - 0.5f * r2 + r2 * r2 * (4.166664568298827e-2f + r2 * (-1.388731625493765e-3f + r2 * (2.443315711809948e-5f)));
    const int q = ((int)k) & 3;
    s = (q == 0) ? sp : (q == 1) ? cp : (q == 2) ? -sp : -cp;
    c = (q == 0) ? cp : (q == 1) ? -sp : (q == 2) ? -cp : sp;
}
__device__ __forceinline__ float sin_f(float x) { float s, c; sincos_f(x, s, c); return s; }

template <class T> __device__ __forceinline__ T* as_global(T* p) {
#ifndef EMU
    return (T*)(__attribute__((address_space(1))) T*)(unsigned long long)p;
#else
    return p;
#endif
}
#define XB_TMO      128
#define XB_XCNT(j)  (256  + 64 * (j))
#define XB_XSUB(j)  (1280 + 64 * (j))
#define XB_XGEN(j)  (2304 + 64 * (j))
#define XB_TOP      3328
#define XB_TOPGEN   3392
#define XCD_BAR_WORDS 3456
#define XB_SPIN_CAP (1u << 18)
__device__ __forceinline__ unsigned xb_ld(unsigned* p)              { return __hip_atomic_load(p, __ATOMIC_RELAXED, __HIP_MEMORY_SCOPE_AGENT); }
__device__ __forceinline__ unsigned xb_add(unsigned* p, unsigned v) { return __hip_atomic_fetch_add(p, v, __ATOMIC_RELAXED, __HIP_MEMORY_SCOPE_AGENT); }
#define XB_SPIN(cond, bar) do { unsigned _sp = 0; while (cond) { S_SLEEP(1); \
    if ((++_sp & 255u) == 0u) { if (xb_ld(&(bar)[XB_TMO])) break; if (_sp > XB_SPIN_CAP) { atomicAdd(&(bar)[XB_TMO], 1u); break; } } } } while (0)
struct XcdBarrier { unsigned* bar; unsigned x; volatile LAS unsigned* st; };
__device__ __forceinline__ XcdBarrier xcd_barrier_post(unsigned* bar, volatile LAS unsigned* st) {
    XcdBarrier b; b.bar = nullptr; b.x = XCC_ID_(); b.st = st;
    if (threadIdx.x == 0) { st[2] = (unsigned)(unsigned long long)bar; st[3] = (unsigned)((unsigned long long)bar >> 32); st[4] = b.x; (void)xb_add(&bar[XB_XCNT(b.x)], 1u); }
    return b;
}
__device__ __forceinline__ void xcd_barrier_complete(unsigned* bar, unsigned x, unsigned& nloc, unsigned& nx) {
    const unsigned G = gridDim.x * gridDim.y * gridDim.z;
    unsigned sum, cnt, mine, sp = 0u;
    for (;;) {
        sum = 0u; cnt = 0u; mine = 0u;
#pragma unroll
        for (unsigned j = 0; j < 16; ++j) { const unsigned c = xb_ld(&bar[XB_XCNT(j)]); sum += c; cnt += (c > 0u) ? 1u : 0u; mine = (j == x) ? c : mine; }
        if (sum == G) break;
        S_SLEEP(1);
        if ((++sp & 255u) == 0u) { if (xb_ld(&bar[XB_TMO])) break; if (sp > XB_SPIN_CAP) { atomicAdd(&bar[XB_TMO], 1u); break; } }
    }
    nloc = mine > 0u ? mine : 1u; nx = cnt > 0u ? cnt : 1u;
}
__device__ __forceinline__ void xcd_barrier(const XcdBarrier& b) {
    ASM_WAIT_V(0);
    __syncthreads();
    if (threadIdx.x == 0) {
        unsigned* bar = as_global((unsigned*)(((unsigned long long)b.st[3] << 32) | b.st[2]));
        const unsigned bx = b.st[4];
        ASM_WAIT_VL0();
        unsigned nloc = b.st[0], nx = b.st[1];
        if (nloc == 0u) { xcd_barrier_complete(bar, bx, nloc, nx); b.st[0] = nloc; b.st[1] = nx; }
        const unsigned old = xb_add(&bar[XB_XSUB(bx)], 1u);
        const unsigned gen = old / nloc;
        if (old + 1u == (gen + 1u) * nloc) {
            FENCE_RELEASE();
            ASM_WAIT_V(0);
            const unsigned og = xb_add(&bar[XB_TOP], 1u);
            const unsigned tg = og / nx;
            if (og + 1u == (tg + 1u) * nx) xb_add(&bar[XB_TOPGEN], 1u);
            else XB_SPIN(xb_ld(&bar[XB_TOPGEN]) == tg, bar);
            FENCE_ACQUIRE();
            xb_add(&bar[XB_XGEN(bx)], 1u);
            ASM_WAIT_V(0);
        } else {
            XB_SPIN(xb_ld(&bar[XB_XGEN(bx)]) == gen, bar);
            FENCE_ACQUIRE();
            ASM_WAIT_V(0);
        }
    }
    __syncthreads();
}

namespace pg8 {
constexpr int BM = 256, BK = 64, HALF = 128, HTB = HALF * BK * 2, STAGE_BYTES = 8 * HTB, NXCD = 8, WGM = 8;
__host__ __device__ __forceinline__ int lds_byte(int r, int c) { const int st = (r >> 4) * 2 + (c >> 5), rr = r & 15, cc = c & 31, ob = rr * 64 + cc * 2; return st * 1024 + (ob ^ (((ob >> 9) & 1) << 5)); }
__host__ __device__ __forceinline__ void stage_rc(int b, int& R, int& C) { const int st = b / 1024, sb = b % 1024, swz = sb ^ (((sb >> 9) & 1) << 5); R = (st >> 1) * 16 + swz / 64; C = (st & 1) * 32 + (swz % 64) / 2; }
__host__ __device__ __forceinline__ int perm32(int rho) { const int n = rho >> 4, i = rho & 15; return 8 * (i >> 2) + 4 * n + (i & 3); }
struct Unit { int pm, pn; };
struct Gemm { const bf16* A; const bf16* Bt; int K; };
struct StaticOrder {
    int nM, nN, nwg, G, c;
    __host__ __device__ void init(int M_, int N_, int G_, int c_) { nM = M_ / BM; nN = N_ / BM; nwg = nM * nN; G = G_; c = c_; }
    __host__ __device__ bool next(int i, Unit& u) const {
        const long L = (long)i * G + c; if (L >= nwg) return false;
        int wgid = (int)L; { const int q = nwg / NXCD, r = nwg % NXCD, xcd = wgid % NXCD, off = wgid / NXCD; wgid = (xcd < r ? xcd * (q + 1) : r * (q + 1) + (xcd - r) * q) + off; }
        const int nig = WGM * nN, gid = wgid / nig, fm = gid * WGM, gsz = (nM - fm) < WGM ? (nM - fm) : WGM;
        u.pm = fm + ((wgid % nig) % gsz); u.pn = (wgid % nig) / gsz; return true;
    }
};
struct MoeOrder {
    const volatile LAS int* tab; int NT, G, c;
    __device__ __forceinline__ bool next(int i, Unit& u) const {
        const long L = (long)i * G + c; if (L >= tab[16]) return false;
        int e = 0; while (L >= tab[e + 1]) ++e;
        const int loc = (int)L - tab[e], tc = tab[64 + e];
        u.pm = tab[32 + e] + loc % tc; u.pn = e * NT + loc / tc; return true;
    }
};
__device__ __forceinline__ unsigned cvt_pk_bf16(float lo, float hi) {
#ifdef EMU
    return pk2(lo, hi);
#else
    unsigned r; asm volatile("v_cvt_pk_bf16_f32 %0, %1, %2" : "=v"(r) : "v"(lo), "v"(hi)); return r;
#endif
}

struct EpiBf16 {
    static constexpr bool PERM = true;
    bf16* O; int ldc;
    __device__ __forceinline__ void operator()(const f32x4 (&acc)[2][2][4][2], const Unit& u, int wr, int wc, int fr, int fq) const {
        const int row0 = u.pm * BM + wr * 64 + fr, col0 = u.pn * BM + wc * 32 + 8 * fq;
#pragma unroll
        for (int ai = 0; ai < 2; ++ai)
#pragma unroll
            for (int m = 0; m < 4; ++m) { bf16* rowp = O + (size_t)(row0 + ai * HALF + m * 16) * ldc + col0;
#pragma unroll
                for (int bj = 0; bj < 2; ++bj) { const f32x4 v0 = acc[ai][bj][m][0], v1 = acc[ai][bj][m][1];
                    u32x4 w; w[0] = cvt_pk_bf16(v0[0], v0[1]); w[1] = cvt_pk_bf16(v0[2], v0[3]); w[2] = cvt_pk_bf16(v1[0], v1[1]); w[3] = cvt_pk_bf16(v1[2], v1[3]);
                    *(u32x4*)(rowp + bj * HALF) = w; } }
    }
};
struct EpiF32 {
    static constexpr bool PERM = true;
    float* C; int ldc;
    __device__ __forceinline__ void operator()(const f32x4 (&acc)[2][2][4][2], const Unit& u, int wr, int wc, int fr, int fq) const {
        const int row0 = u.pm * BM + wr * 64 + fr, col0 = u.pn * BM + wc * 32 + 8 * fq;
#pragma unroll
        for (int ai = 0; ai < 2; ++ai)
#pragma unroll
            for (int m = 0; m < 4; ++m) { float* rowp = C + (size_t)(row0 + ai * HALF + m * 16) * ldc + col0;
#pragma unroll
                for (int bj = 0; bj < 2; ++bj)
#pragma unroll
                    for (int n = 0; n < 2; ++n) *(f32x4*)(rowp + bj * HALF + n * 4) = acc[ai][bj][m][n]; }
    }
};
struct EpiGate {
    static constexpr bool PERM = true;
    bf16* T; int ldc; const bf16* Pg; int ldp; int gcol0; bool ADD;
    __device__ __forceinline__ void operator()(const f32x4 (&acc)[2][2][4][2], const Unit& u, int wr, int wc, int fr, int fq) const {
        const int row0 = u.pm * BM + wr * 64 + fr, col0 = u.pn * BM + wc * 32 + 8 * fq;
#pragma unroll
        for (int ai = 0; ai < 2; ++ai)
#pragma unroll
            for (int m = 0; m < 4; ++m) { const size_t row = (size_t)(row0 + ai * HALF + m * 16);
#pragma unroll
                for (int bj = 0; bj < 2; ++bj) { const f32x4 v0 = acc[ai][bj][m][0], v1 = acc[ai][bj][m][1];
                    const u32x4 g = *(const u32x4*)(Pg + row * ldp + gcol0 + col0 + bj * HALF);
                    u32x4 t = {0u, 0u, 0u, 0u}; if (ADD) t = *(const u32x4*)(T + row * ldc + col0 + bj * HALF);
                    float o[8];
#pragma unroll
                    for (int j = 0; j < 4; ++j) { const float a0 = j < 2 ? v0[2 * j] : v1[2 * j - 4], a1 = j < 2 ? v0[2 * j + 1] : v1[2 * j - 3];
                        o[2 * j] = bflo(t[j]) + sigmoidf_(bflo(g[j])) * a0; o[2 * j + 1] = bfhi(t[j]) + sigmoidf_(bfhi(g[j])) * a1; }
                    u32x4 w; w[0] = cvt_pk_bf16(o[0], o[1]); w[1] = cvt_pk_bf16(o[2], o[3]); w[2] = cvt_pk_bf16(o[4], o[5]); w[3] = cvt_pk_bf16(o[6], o[7]);
                    *(u32x4*)(T + row * ldc + col0 + bj * HALF) = w; } }
    }
};
struct EpiSwiglu {
    static constexpr bool PERM = true;
    bf16* O; int ldc; int NT;
    __device__ __forceinline__ void operator()(const f32x4 (&acc)[2][2][4][2], const Unit& u, int wr, int wc, int fr, int fq) const {
        const int row0 = u.pm * BM + wr * 64 + fr, col0 = (u.pn % NT) * HALF + wc * 32 + 8 * fq;
#pragma unroll
        for (int ai = 0; ai < 2; ++ai)
#pragma unroll
            for (int m = 0; m < 4; ++m) { bf16* rowp = O + (size_t)(row0 + ai * HALF + m * 16) * ldc + col0;
                float o[8];
#pragma unroll
                for (int j = 0; j < 8; ++j) { const float g = acc[ai][0][m][j >> 2][j & 3], uu = acc[ai][1][m][j >> 2][j & 3]; o[j] = g / (1.0f + expf(-g)) * uu; }
                u32x4 w; w[0] = cvt_pk_bf16(o[0], o[1]); w[1] = cvt_pk_bf16(o[2], o[3]); w[2] = cvt_pk_bf16(o[4], o[5]); w[3] = cvt_pk_bf16(o[6], o[7]);
                *(u32x4*)rowp = w; }
    }
};
struct EpiMoeDown {
    static constexpr bool PERM = true;
    bf16* O; int ldc; int NT;
    __device__ __forceinline__ void operator()(const f32x4 (&acc)[2][2][4][2], const Unit& u, int wr, int wc, int fr, int fq) const {
        const int row0 = u.pm * BM + wr * 64 + fr, col0 = (u.pn % NT) * BM + wc * 32 + 8 * fq;
#pragma unroll
        for (int ai = 0; ai < 2; ++ai)
#pragma unroll
            for (int m = 0; m < 4; ++m) { bf16* rowp = O + (size_t)(row0 + ai * HALF + m * 16) * ldc + col0;
#pragma unroll
                for (int bj = 0; bj < 2; ++bj) { const f32x4 v0 = acc[ai][bj][m][0], v1 = acc[ai][bj][m][1];
                    u32x4 w; w[0] = cvt_pk_bf16(v0[0], v0[1]); w[1] = cvt_pk_bf16(v0[2], v0[3]); w[2] = cvt_pk_bf16(v1[0], v1[1]); w[3] = cvt_pk_bf16(v1[2], v1[3]);
                    *(u32x4*)(rowp + bj * HALF) = w; } }
    }
};

struct EpiBf16OrF32 { static constexpr bool PERM = true; bf16* O; float* C; int ldc; bool f32;
    __device__ __forceinline__ void operator()(const f32x4 (&acc)[2][2][4][2], const Unit& u, int wr, int wc, int fr, int fq) const {
        if (f32) { EpiF32 E{C, ldc}; E(acc, u, wr, wc, fr, fq); } else { EpiBf16 E{O, ldc}; E(acc, u, wr, wc, fr, fq); } } };
struct EpiMoe { static constexpr bool PERM = true; bf16* O; int ldc; int NT; bool swiglu;
    __device__ __forceinline__ void operator()(const f32x4 (&acc)[2][2][4][2], const Unit& u, int wr, int wc, int fr, int fq) const {
        if (swiglu) { EpiSwiglu E{O, ldc, NT}; E(acc, u, wr, wc, fr, fq); } else { EpiMoeDown E{O, ldc, NT}; E(acc, u, wr, wc, fr, fq); } } };
template <class Epi, class Sched>
__device__ __forceinline__ void gemm_phase(LAS unsigned char* lds, const Gemm g, const Sched& S, const Epi& E) {
    const int tid = threadIdx.x + vgpr_zero();
    const int wid = READFIRSTLANE(tid >> 6), lane = tid & 63, wr = wid >> 2, wc = wid & 3, fr = lane & 15, fq = lane >> 4;
    const int K = g.K, nt = K / BK;
    unsigned long long voffA[2], voffB[2]; const unsigned long long zhi = vgpr_zero64();
#pragma unroll
    for (int i = 0; i < 2; ++i) { int R, C; stage_rc(tid * 16 + i * 8192, R, C); const int Rb = Epi::PERM ? ((R & ~31) + perm32(R & 31)) : R;
        voffA[i] = zhi + (unsigned long long)(long long)((R * K + C) * 2); voffB[i] = zhi + (unsigned long long)(long long)((Rb * K + C) * 2); }
    const size_t kstep = (size_t)(BK * 2);
    const size_t hstep = (size_t)HALF * K * 2;
    const size_t tstep = 2 * hstep;
    const unsigned ldsw = (unsigned)wid * 1024u;
    const int aoff = lds_byte(wr * 64 + fr, fq * 8), boff = lds_byte(wc * 32 + fr, fq * 8);
#define PG8_SA(b, h) (((b) * 2 + (h)) * HTB)
#define PG8_SB(b, h) ((4 + (b) * 2 + (h)) * HTB)
#define PG8_STAGE(bufoff, gbase, voff) do { _Pragma("unroll") for (int _i = 0; _i < 2; ++_i) \
        GLDS16((const char*)(gbase) + (voff)[_i], lds + (bufoff) + ldsw + _i * 8192); } while (0)
#define PG8_LDA(dst, b, h) do { _Pragma("unroll") for (int m = 0; m < 4; ++m) _Pragma("unroll") for (int k = 0; k < 2; ++k) dst[m][k] = *(const LAS bf16x8*)(lds + PG8_SA(b, h) + aoff + m * 2048 + k * 1024); } while (0)
#define PG8_LDB(dst, b, h) do { _Pragma("unroll") for (int n = 0; n < 2; ++n) _Pragma("unroll") for (int k = 0; k < 2; ++k) dst[n][k] = *(const LAS bf16x8*)(lds + PG8_SB(b, h) + boff + n * 2048 + k * 1024); } while (0)
#define PG8_MMA(ai, bj, At, Bt) do { SETPRIO(1); _Pragma("unroll") for (int m = 0; m < 4; ++m) _Pragma("unroll") for (int n = 0; n < 2; ++n) _Pragma("unroll") for (int k = 0; k < 2; ++k) \
        acc[ai][bj][m][n] = MFMA16(Bt[n][k], At[m][k], acc[ai][bj][m][n]); SETPRIO(0); } while (0)
#define PG8_BAR S_BARRIER()
    Unit cur, nxt; int ui = 0;
    if (!S.next(0, cur)) return;
    f32x4 acc[2][2][4][2];
#pragma unroll
    for (int a = 0; a < 2; ++a)
#pragma unroll
        for (int b = 0; b < 2; ++b)
#pragma unroll
            for (int m = 0; m < 4; ++m)
#pragma unroll
                for (int n = 0; n < 2; ++n) acc[a][b][m][n] = (f32x4){0.f, 0.f, 0.f, 0.f};
    bf16x8 At[4][2], B0[2][2], B1[2][2];
    const char* cA = (const char*)g.A + (size_t)cur.pm * tstep; const char* cB = (const char*)g.Bt + (size_t)cur.pn * tstep;
    PG8_STAGE(PG8_SB(0, 0), cB, voffB); PG8_STAGE(PG8_SA(0, 0), cA, voffA); PG8_STAGE(PG8_SB(0, 1), cB + hstep, voffB); PG8_STAGE(PG8_SA(0, 1), cA + hstep, voffA);
    if (wr == 1) PG8_BAR;
    ASM_WAIT_V(4); PG8_BAR;
    PG8_STAGE(PG8_SB(1, 0), cB + kstep, voffB); PG8_STAGE(PG8_SA(1, 0), cA + kstep, voffA); PG8_STAGE(PG8_SB(1, 1), cB + hstep + kstep, voffB);
    ASM_WAIT_V(6); PG8_BAR;
    for (;;) {
        const bool has_next = S.next(ui + 1, nxt);
        const char* nA = has_next ? (const char*)g.A + (size_t)nxt.pm * tstep : cA; const char* nB = has_next ? (const char*)g.Bt + (size_t)nxt.pn * tstep : cB;
        for (int t = 0; t < nt; t += 2) {
            const bool last = (t == nt - 2);
            const char* a1 = cA + (size_t)(t + 1) * kstep;
            const char* a2 = last ? nA : cA + (size_t)(t + 2) * kstep; const char* b2 = last ? nB : cB + (size_t)(t + 2) * kstep;
            const char* a3 = a2 + kstep; const char* b3 = b2 + kstep;
            PG8_LDB(B0, 0, 0); SCHED_BARRIER(); PG8_LDA(At, 0, 0); PG8_STAGE(PG8_SA(1, 1), a1 + hstep, voffA);
            ASM_WAIT_L(8); PG8_BAR; ASM_WAIT_L(0); PG8_MMA(0, 0, At, B0); PG8_BAR; SCHED_BARRIER();
            PG8_LDB(B1, 0, 1); PG8_STAGE(PG8_SB(0, 0), b2, voffB);
            PG8_BAR; ASM_WAIT_L(0); PG8_MMA(0, 1, At, B1); PG8_BAR;
            PG8_LDA(At, 0, 1); PG8_STAGE(PG8_SA(0, 0), a2, voffA);
            PG8_BAR; ASM_WAIT_L(0); PG8_MMA(1, 0, At, B0); PG8_BAR; SCHED_BARRIER();
            PG8_STAGE(PG8_SB(0, 1), b2 + hstep, voffB);
            ASM_WAIT_V(6); PG8_BAR; PG8_MMA(1, 1, At, B1); PG8_BAR;
            PG8_LDB(B0, 1, 0); SCHED_BARRIER(); PG8_LDA(At, 1, 0); PG8_STAGE(PG8_SA(0, 1), a2 + hstep, voffA);
            ASM_WAIT_L(8); PG8_BAR; ASM_WAIT_L(0); PG8_MMA(0, 0, At, B0); PG8_BAR; SCHED_BARRIER();
            PG8_LDB(B1, 1, 1); PG8_STAGE(PG8_SB(1, 0), b3, voffB);
            PG8_BAR; ASM_WAIT_L(0); PG8_MMA(0, 1, At, B1); PG8_BAR;
            PG8_LDA(At, 1, 1); PG8_STAGE(PG8_SA(1, 0), a3, voffA);
            PG8_BAR; ASM_WAIT_L(0); PG8_MMA(1, 0, At, B0); PG8_BAR; SCHED_BARRIER();
            PG8_STAGE(PG8_SB(1, 1), b3 + hstep, voffB);
            ASM_WAIT_V(6); PG8_BAR; PG8_MMA(1, 1, At, B1); PG8_BAR;
        }
        E(acc, cur, wr, wc, fr, fq);
        if (!has_next) break;
#pragma unroll
        for (int a = 0; a < 2; ++a)
#pragma unroll
            for (int b = 0; b < 2; ++b)
#pragma unroll
                for (int m = 0; m < 4; ++m)
#pragma unroll
                    for (int n = 0; n < 2; ++n) acc[a][b][m][n] = (f32x4){0.f, 0.f, 0.f, 0.f};
        cur = nxt; cA = nA; cB = nB; ++ui;
    }
    ASM_WAIT_V(0);
    if (wr == 0) PG8_BAR;
    PG8_BAR;
#undef PG8_SA
#undef PG8_SB
#undef PG8_STAGE
#undef PG8_LDA
#undef PG8_LDB
#undef PG8_MMA
#undef PG8_BAR
}
}

struct Args { const float* in[N_IN]; float* out; unsigned char* ws; int ph_lo, ph_hi; };
constexpr int NWAVES = 8, NTHR = 512;
constexpr int LDS_STAGE = 131072, LDS_MISC = LDS_STAGE, LDS_BYTES = 147456;

constexpr int PT_OUT = N_IN, PT_WS = N_IN + 1, PT_WORD0 = 128;

struct Ctx {
    LAS unsigned char* lds; int tid, lane, wave, G, bid;
    __device__ __forceinline__ unsigned long long ptr(int i) const { const volatile LAS unsigned* t = (const volatile LAS unsigned*)(lds + LDS_MISC) + PT_WORD0 + 2 * i;
        const unsigned lo = (unsigned)READFIRSTLANE((int)t[0]), hi = (unsigned)READFIRSTLANE((int)t[1]); return ((unsigned long long)hi << 32) | lo; }
    __device__ __forceinline__ unsigned long long ptrv(int i) const { const volatile LAS unsigned* t = (const volatile LAS unsigned*)(lds + LDS_MISC) + PT_WORD0 + 2 * i; return ((unsigned long long)t[1] << 32) | t[0]; }
    __device__ __forceinline__ const float* inv(int i) const { return as_global((const float*)ptrv(i)); }
    template <class T> __device__ __forceinline__ T* wsv(size_t off) const { return as_global((T*)((unsigned char*)ptrv(PT_WS) + off)); }
    __device__ __forceinline__ const float* in(int i) const { return as_global((const float*)ptr(i)); }
    __device__ __forceinline__ float* out() const { return as_global((float*)ptr(PT_OUT)); }
    template <class T> __device__ __forceinline__ T* ws(size_t off) const { return as_global((T*)((unsigned char*)ptr(PT_WS) + off)); }
    __device__ __forceinline__ unsigned* ctl() const { return as_global((unsigned*)ptr(PT_WS)); }
};

__device__ __forceinline__ void transpose_item(const float* W, int ldw, int k0, int n0, int nvalid, bf16* outp, int ldo, LAS float* scr, int lane) {
#pragma unroll
    for (int i = 0; i < 32; ++i) { const int kk = 2 * i + (lane >> 5), n = n0 + (lane & 31); scr[kk * 33 + (lane & 31)] = (n < nvalid) ? W[(size_t)(k0 + kk) * ldw + n] : 0.f; }
    WAVE_LDS_FENCE(); CFENCE();
    const int c = lane & 7;
#pragma unroll
    for (int j = 0; j < 4; ++j) { const int n = (lane >> 3) + 8 * j; const LAS float* s = scr + (8 * c) * 33 + n;
        u32x4 o; o[0] = pk2(s[0 * 33], s[1 * 33]); o[1] = pk2(s[2 * 33], s[3 * 33]); o[2] = pk2(s[4 * 33], s[5 * 33]); o[3] = pk2(s[6 * 33], s[7 * 33]);
        *(u32x4*)(outp + (size_t)n * ldo + k0 + 8 * c) = o; }
    WAVE_LDS_FENCE(); CFENCE();
}
__device__ __forceinline__ void filter_item(const Ctx& X, int l, int n, int pos0, float* out, LAS bf16* za, LAS bf16* zb, LAS float* asum  ) {
    const int lane = X.lane, kof = 8 * (lane >> 4);
    const bf16* FWT = X.wsv<bf16>(WS_FWT);
    if (lane < 64) { const int i = lane;
#pragma unroll 4
        for (int p = 0; p < 16; ++p) { const int pos = pos0 + p; float v = 0.f;
            if (i == 0) v = (float)pos / (float)(n - 1 > 1 ? n - 1 : 1);
            else if (i < 33) { const int bb = (i - 1) & 15; const double band = 1e-4 + (double)bb * ((15.0 - 1e-4) / 15.0);
                double rev = (double)pos * band / (double)n; rev -= floor(rev); if (rev > 0.5) rev -= 1.0;
                float sn, cs; sincos_f((float)(rev * 6.283185307179586476925), sn, cs); v = i <= 16 ? cs : -sn; }
            za[p * LP + i] = (bf16)f2bf(v); } }
    WAVE_LDS_FENCE(); CFENCE();
    LAS bf16* src = za; LAS bf16* dst = zb;
#pragma unroll 1
    for (int layer = 0; layer < 3; ++layer) { const bf16* WT = FWT + (size_t)layer * 64 * 64; const float* bias = X.inv(layer == 0 ? I_FB1 : layer == 1 ? I_FB2 : I_FB3) + l * 64;
        const bf16x8 a0 = *(const LAS bf16x8*)(src + (lane & 15) * LP + kof), a1 = *(const LAS bf16x8*)(src + (lane & 15) * LP + kof + 32);
#pragma unroll
        for (int tj = 0; tj < 4; ++tj) { const int u = 16 * tj + (lane & 15); f32x4 acc = {0.f, 0.f, 0.f, 0.f};
            acc = MFMA16(a0, *(const bf16x8*)(WT + (size_t)u * 64 + kof), acc); acc = MFMA16(a1, *(const bf16x8*)(WT + (size_t)u * 64 + kof + 32), acc);
            const float fr = X.inv(I_FREQ)[l * 64 + u], bu = bias[u];
#pragma unroll
            for (int r = 0; r < 4; ++r) dst[(4 * (lane >> 4) + r) * LP + u] = (bf16)f2bf(sin_f(fr * (acc[r] + bu))); }
        WAVE_LDS_FENCE(); CFENCE();
        LAS bf16* t_ = src; src = dst; dst = t_; }
    const bf16* WO = FWT + (size_t)3 * 64 * 64;
    const bf16x8 a0 = *(const LAS bf16x8*)(src + (lane & 15) * LP + kof), a1 = *(const LAS bf16x8*)(src + (lane & 15) * LP + kof + 32);
    const float dmin = -3.0701134573253944f, dmax = -15.350567286626972f;
    float dist[4];
#pragma unroll
    for (int r = 0; r < 4; ++r) { const int dd = pos0 + 4 * (lane >> 4) + r - n / 2; dist[r] = (float)(dd < 0 ? -dd : dd) * (2.0f / (float)n); }
#pragma unroll 1
    for (int tg = 0; tg < HW / 64; ++tg) {
#pragma unroll
        for (int tq = 0; tq < 4; ++tq) { const int c = 64 * tg + 16 * tq + (lane & 15); f32x4 acc = {0.f, 0.f, 0.f, 0.f};
            acc = MFMA16(a0, *(const bf16x8*)(WO + (size_t)c * 64 + kof), acc); acc = MFMA16(a1, *(const bf16x8*)(WO + (size_t)c * 64 + kof + 32), acc);
            const float delta = fabsf(dmin + (float)c * ((dmax - dmin) / (float)(HW - 1))); f32x4 v; float as = 0.f;
#pragma unroll
            for (int r = 0; r < 4; ++r) { v[r] = acc[r] * fexp(-dist[r] * delta); as += fabsf(v[r]); }
            *(f32x4*)(out + (size_t)c * n + pos0 + 4 * (lane >> 4)) = v; lds_addf(asum + c, as); } }
    WAVE_LDS_FENCE(); CFENCE();
}
__device__ __forceinline__ void phase_transposes(const Ctx& X, int l, int part) {
    LAS float* scr = (LAS float*)(X.lds + X.wave * 16384);
    const bool shifted = part == 1 && X.G > N_SEQ_UNITS; const int myb = shifted ? X.bid - N_SEQ_UNITS : X.bid, nb_ = shifted ? X.G - N_SEQ_UNITS : X.G;
    if (myb < 0) return;
    const int gw = myb * NWAVES + X.wave, NGW = nb_ * NWAVES, lane = X.lane;
    constexpr int KB_D = D / 64, I_WIN_ = KB_D * (PCP / 32), I_WB_ = 2 * (RW / 64) * (D / 32), I_WO_ = KB_D * (D / 32), I_WGU_ = NE * 2 * KB_D * (D / 32), I_WD_ = NE * KB_D * (D / 32);
    constexpr int I_LORA_ = 6 * (RW / 32); constexpr int N0 = I_WIN_ + I_WB_ + I_WO_, NITEMS = N0 + I_WGU_ + I_WD_;
    if (part == 0) for (int it = gw; it < I_LORA_; it += NGW) { const int which = it / (RW / 32), nb = it % (RW / 32);
        const float* W; int k0 = 0, ldo = 64; bf16* outp;
        if (which < 2) { W = X.in(I_W2) + ((size_t)l * 2 + which) * 64 * RW; outp = X.ws<bf16>(WS_W2T) + (size_t)which * RW * 64 + (size_t)(32 * nb) * 64; }
        else if (which < 4) { W = X.in(I_A2) + ((size_t)l * 2 + (which - 2)) * 64 * RW; outp = X.ws<bf16>(WS_A2T) + (size_t)(which - 2) * RW * 64 + (size_t)(32 * nb) * 64; }
        else { W = X.in(I_G2) + (size_t)l * 128 * RW; k0 = 64 * (which - 4); ldo = 128; outp = X.ws<bf16>(WS_G2T) + (size_t)(32 * nb) * 128; }
        transpose_item(W, RW, k0, 32 * nb, RW, outp, ldo, scr, lane); }
    const int it_end = part ? NITEMS : N0; int it = (part ? N0 : 0) + gw;
    const float* W; int ldw, k0, n0, nvalid, ldo; bf16* outp; float v[32];
#define TR_PARAMS(it_) do { int r = (it_); \
        if (r < I_WIN_) { const int nb = r % (PCP / 32), kb = r / (PCP / 32); W = X.in(I_WIN) + (size_t)l * D * PC; ldw = PC; k0 = 64 * kb; n0 = 32 * nb; nvalid = PC; outp = X.ws<bf16>(WS_WIN) + (size_t)n0 * D; ldo = D; } \
        else if ((r -= I_WIN_) < I_WB_) { const int s_ = r / ((RW / 64) * (D / 32)), q = r % ((RW / 64) * (D / 32)), nb = q % (D / 32), kb = q / (D / 32); \
            W = X.in(I_WBR) + ((size_t)l * 2 + s_) * RW * D; ldw = D; k0 = 64 * kb; n0 = 32 * nb; nvalid = D; outp = X.ws<bf16>(WS_WB) + (size_t)s_ * D * RW + (size_t)n0 * RW; ldo = RW; } \
        else if ((r -= I_WB_) < I_WO_) { const int nb = r % (D / 32), kb = r / (D / 32); W = X.in(I_WOUT) + (size_t)l * D * D; ldw = D; k0 = 64 * kb; n0 = 32 * nb; nvalid = D; outp = X.ws<bf16>(WS_WO) + (size_t)n0 * D; ldo = D; } \
        else if ((r -= I_WO_) < I_WGU_) { const int per = KB_D * (D / 32), es = r / per, q = r % per, e = es >> 1, src = es & 1, nb = q % (D / 32), kb = q / (D / 32); n0 = 32 * nb; \
            W = (src ? X.in(I_WU) : X.in(I_WG)) + ((size_t)l * NE + e) * D * D; ldw = D; k0 = 64 * kb; nvalid = D; const int orow = e * 2 * D + (n0 / 128) * 256 + src * 128 + (n0 % 128); \
            outp = X.ws<bf16>(WS_WGU) + (size_t)orow * D; ldo = D; } \
        else { r -= I_WGU_; const int per = KB_D * (D / 32), e = r / per, q = r % per, nb = q % (D / 32), kb = q / (D / 32); \
            W = X.in(I_WD) + ((size_t)l * NE + e) * D * D; ldw = D; k0 = 64 * kb; n0 = 32 * nb; nvalid = D; outp = X.ws<bf16>(WS_WD) + (size_t)(e * D + n0) * D; ldo = D; } } while (0)
#define TR_LOAD() do { const int n = n0 + (lane & 31); const float* wp = W + (size_t)(k0 + (lane >> 5)) * ldw + n; _Pragma("unroll") for (int i = 0; i < 32; ++i) v[i] = (n < nvalid) ? wp[(size_t)(2 * i) * ldw] : 0.f; } while (0)
    if (it < it_end) { TR_PARAMS(it); TR_LOAD(); }
    while (it < it_end) {
#pragma unroll
        for (int i = 0; i < 32; ++i) scr[(2 * i + (lane >> 5)) * 33 + (lane & 31)] = v[i];
        WAVE_LDS_FENCE(); CFENCE();
        bf16* const cout_ = outp; const int ck0 = k0, cldo = ldo;
        it += NGW;
        if (it < it_end) { TR_PARAMS(it); TR_LOAD(); }
        const int c = lane & 7;
#pragma unroll
        for (int j = 0; j < 4; ++j) { const int n = (lane >> 3) + 8 * j; const LAS float* s_ = scr + (8 * c) * 33 + n;
            u32x4 o; o[0] = pk2(s_[0 * 33], s_[1 * 33]); o[1] = pk2(s_[2 * 33], s_[3 * 33]); o[2] = pk2(s_[4 * 33], s_[5 * 33]); o[3] = pk2(s_[6 * 33], s_[7 * 33]);
            *(u32x4*)(cout_ + (size_t)n * cldo + ck0 + 8 * c) = o; }
        WAVE_LDS_FENCE(); CFENCE();
    }
#undef TR_PARAMS
#undef TR_LOAD
}
__device__ __forceinline__ void phase_filter_weights(const Ctx& X, int l) {
    bf16* FWT = X.ws<bf16>(WS_FWT);
    for (int idx = X.bid * NTHR + X.tid; idx < (3 * 64 + HW) * 64; idx += X.G * NTHR) { const int o = idx >> 6, k = idx & 63; float v;
        if (o < 64) v = k < 33 ? X.in(I_FW1)[(size_t)l * 33 * 64 + k * 64 + o] : 0.f;
        else if (o < 128) v = X.in(I_FW2)[(size_t)l * 64 * 64 + k * 64 + (o - 64)];
        else if (o < 192) v = X.in(I_FW3)[(size_t)l * 64 * 64 + k * 64 + (o - 128)];
        else v = X.in(I_FWO)[(size_t)l * 64 * HW + (size_t)k * HW + (o - 192)];
        FWT[idx] = (bf16)f2bf(v); }
}
constexpr int FPART_OFF = 65536;
static_assert(FPART_OFF + 2 * HW * 4 <= LDS_STAGE && 2 * 16 * LP * 2 <= 8192, "filter LDS map");
__device__ __forceinline__ void phase_filters_begin(const Ctx& X) {
    LAS float* part = (LAS float*)(X.lds + FPART_OFF);
    for (int i = X.tid; i < 2 * HW; i += NTHR) part[i] = 0.f;
    __syncthreads();
}
__device__ __forceinline__ void phase_filters_item(const Ctx& X, int l_, int which_, int it_) {
    const int vz = vgpr_zero(), l = l_ + vz, which = which_ + vz, it = it_ + vz;
    LAS bf16* za = (LAS bf16*)(X.lds + X.wave * 8192); LAS bf16* zb = za + 16 * LP;
    const int n = which ? CTX : SEQ; float* out = X.wsv<float>(WS_FILT) + (which ? (size_t)HW * SEQ : 0);
    filter_item(X, l, n, 16 * it, out, za, zb, (LAS float*)(X.lds + FPART_OFF) + which * HW);
}
__device__ __forceinline__ void phase_filters_end(const Ctx& X) {
    const LAS float* part = (const LAS float*)(X.lds + FPART_OFF);
    __syncthreads();
    for (int i = X.tid; i < 2 * HW; i += NTHR) X.ws<float>(WS_FPART)[((size_t)(i / HW) * NPART + X.bid) * HW + (i % HW)] = part[i];
    __syncthreads();
}
__device__ __forceinline__ void phase_mod(const Ctx& X) {
    const int lane = X.lane;
    LAS float* red = (LAS float*)X.lds;
    constexpr int NIT = DEPTH * (6 * D / 64);
    for (int it = X.bid; it < NIT; it += X.G) {
        const int ll = it / (6 * D / 64), n0 = (it % (6 * D / 64)) * 64;
        const float* W = X.in(I_WMOD) + (size_t)ll * D * 6 * D; const float* cv = X.in(I_C); const float* cc = X.in(I_CCTX);
        float s0 = 0.f, s1 = 0.f;
#pragma unroll 8
        for (int k = X.wave * (D / 8); k < (X.wave + 1) * (D / 8); ++k) { const float wv = W[(size_t)k * 6 * D + n0 + lane]; const float c0 = cv[k], c1 = cc[k];
            s0 += c0 * sigmoidf_(c0) * wv; s1 += c1 * sigmoidf_(c1) * wv; }
        red[(X.wave * 64 + lane) * 2] = s0; red[(X.wave * 64 + lane) * 2 + 1] = s1;
        __syncthreads();
        if (X.wave == 0) { float t0 = 0.f, t1 = 0.f;
#pragma unroll
            for (int w = 0; w < NWAVES; ++w) { t0 += red[(w * 64 + lane) * 2]; t1 += red[(w * 64 + lane) * 2 + 1]; }
            const float bm = X.in(I_BMOD)[(size_t)ll * 6 * D + n0 + lane];
            float* MOD = X.ws<float>(WS_MOD);
            MOD[((size_t)ll * 2 + 0) * 6 * D + n0 + lane] = t0 + bm; MOD[((size_t)ll * 2 + 1) * 6 * D + n0 + lane] = t1 + bm; }
        __syncthreads();
    }
}
__device__ __forceinline__ const float* modp(const Ctx& X, int l, int t, int j) { return X.ws<float>(WS_MOD) + ((size_t)l * 2 + (t < CTX ? 1 : 0)) * 6 * D + (size_t)j * D; }

__device__ __forceinline__ void phase_x0(const Ctx& X) {
    const int gw = X.bid * NWAVES + X.wave, NGW = X.G * NWAVES, lane = X.lane;
    for (int t = gw; t < M; t += NGW) {
        const float* src = t < CTX ? X.in(I_CTX) + (size_t)t * D : X.in(I_X) + (size_t)(t - CTX) * D;
        const float* sh = modp(X, 0, t, 0); const float* sc = modp(X, 0, t, 1);
        float* xr = X.ws<float>(WS_X) + (size_t)t * D; bf16* xm = X.ws<bf16>(WS_XMOD) + (size_t)t * D;
#pragma unroll
        for (int j = 0; j < D / 256; ++j) { const int d = 4 * lane + 256 * j; const f32x4 v = *(const f32x4*)(src + d), a = *(const f32x4*)(sh + d), b = *(const f32x4*)(sc + d);
            *(f32x4*)(xr + d) = v;
            unsigned w0 = pk2(v[0] * (1.f + b[0]) + a[0], v[1] * (1.f + b[1]) + a[1]), w1 = pk2(v[2] * (1.f + b[2]) + a[2], v[3] * (1.f + b[3]) + a[3]);
            *(unsigned long long*)(xm + d) = (unsigned long long)w0 | ((unsigned long long)w1 << 32); }
    }
}

__device__ __forceinline__ int shift_row(int t, int col, bool& valid) {
    const bool isctx = t < CTX;
    const int i = t - CTX, gx = i & (GRID_W - 1), gy = i / GRID_W, q = col / QTR;
    const int offl = (q == 0) ? -1 : (q == 1) ? 1 : (q == 2) ? -GRID_W : GRID_W;
    const bool vl = (q == 0) ? (gx > 0) : (q == 1) ? (gx < GRID_W - 1) : (q == 2) ? (gy > 0) : (gy < GRID_H - 1);
    const bool first = col < HALFC;
    const int offc = first ? -1 : 1; const bool vc = first ? (t > 0) : (t < CTX - 1);
    valid = isctx ? vc : vl;
    return valid ? t + (isctx ? offc : offl) : t;
}
__device__ __forceinline__ float pm_val(const bf16* P, const float* mu, int t, int col) {
    const float p0 = bf2f(P[(size_t)t * PCP + col]); bool valid; const int nr = shift_row(t, col, valid);
    const float pn = bf2f(P[(size_t)nr * PCP + col]); const float p1 = valid ? pn : 0.f;
    return p0 + (p1 - p0) * mu[col];
}
__device__ __forceinline__ f32x4 mm_tile(const LAS bf16* A, const LAS bf16* Bt, int ti, int tj, int lane, f32x4 acc) {
    const LAS bf16* pa = A + (16 * ti + (lane & 15)) * LP + 8 * (lane >> 4); const LAS bf16* pb = Bt + (16 * tj + (lane & 15)) * LP + 8 * (lane >> 4);
#pragma unroll
    for (int kk = 0; kk < 2; ++kk) { const bf16x8 a = *(const LAS bf16x8*)(pa + 32 * kk), b = *(const LAS bf16x8*)(pb + 32 * kk); acc = MFMA16(a, b, acc); }
    return acc;
}
struct PmLd { float p0, pn, m; bool valid; };
__device__ __forceinline__ PmLd pm_ld(const bf16* P, const float* mu, int t, int col) {
    PmLd r; bool valid; const int nr = shift_row(t, col, valid); r.p0 = bf2f(P[(size_t)t * PCP + col]); r.pn = bf2f(P[(size_t)nr * PCP + col]); r.m = mu[col]; r.valid = valid; return r; }
__device__ __forceinline__ float pm_fin(const PmLd& r) { const float p1 = r.valid ? r.pn : 0.f; return r.p0 + (p1 - r.p0) * r.m; }
constexpr int TT = 8;
__device__ __forceinline__ void phase_lin(const Ctx& X, int l) {
    const bf16* P = X.ws<bf16>(WS_P); const float* mu = X.in(I_MU) + (size_t)l * RC; bf16* LIN = X.ws<bf16>(WS_LIN);
    for (size_t idx = (size_t)X.bid * NTHR + X.tid; idx < (size_t)M * 384; idx += (size_t)X.G * NTHR) { const int t = (int)(idx / 384), j = (int)(idx % 384);
        float v = pm_val(P, mu, t, C_LWF + j);
        if (j < 128) v = 1.0f - 2.0f * frcp(fexp(2.0f * v) + 1.0f); else if (j >= 256) v = sigmoidf_(v);
        LIN[idx] = (bf16)f2bf(v); }
}
__device__ __forceinline__ f32x4 mm_tile_p(const LAS bf16* A, int lda, const LAS bf16* Bt, int ldb, int ks, int ti, int tj, int lane, f32x4 acc) {
    const LAS bf16* pa = A + (16 * ti + (lane & 15)) * lda + 8 * (lane >> 4); const LAS bf16* pb = Bt + (16 * tj + (lane & 15)) * ldb + 8 * (lane >> 4);
    for (int kk = 0; kk < ks; ++kk) { const bf16x8 a = *(const LAS bf16x8*)(pa + 32 * kk), b = *(const LAS bf16x8*)(pb + 32 * kk); acc = MFMA16(a, b, acc); }
    return acc;
}
constexpr int GP = 136;
__device__ __forceinline__ void lora_unit_a(const Ctx& X, int unit) {
    const int b = unit / NH, h = unit % NH, tid = X.tid, lane = X.lane, w = X.wave;
    LAS bf16* Ab = (LAS bf16*)X.lds; LAS bf16* Gb = Ab + 4 * 64 * LP; LAS bf16* Wb = Gb + 64 * GP; LAS bf16* G2b = Wb + 4 * 64 * LP;
    LAS float* OUT = (LAS float*)X.lds;
    static_assert((8 * 64 * LP + 2 * 64 * GP) * 2 <= LDS_STAGE && 5 * 64 * LQ * 4 <= LDS_STAGE, "lora LDS map");
    const bf16* LIN = X.wsv<bf16>(WS_LIN) + (size_t)(64 * b) * 384;
    const bf16* w2t = X.wsv<bf16>(WS_W2T) + (size_t)(64 * h) * 64; const bf16* a2t = X.wsv<bf16>(WS_A2T) + (size_t)(64 * h) * 64; const bf16* g2t = X.wsv<bf16>(WS_G2T) + (size_t)(64 * h) * 128;
    static_assert(64 * 48 == 6 * NTHR && 4 * 64 * 8 == 4 * NTHR && 64 * 16 == 2 * NTHR, "lora operand copies");
    u32x4 v1[6], v2[4], v3[2];
#pragma unroll
    for (int j = 0; j < 6; ++j) { const int i = tid + j * NTHR, t = i / 48, c16 = i % 48; v1[j] = *(const u32x4*)(LIN + (size_t)t * 384 + 8 * c16); }
#pragma unroll
    for (int j = 0; j < 4; ++j) { const int i = tid + j * NTHR, q = i / 512, c = (i / 8) % 64, c16 = i % 8; const bf16* src = (q < 2 ? w2t + (size_t)q * RW * 64 : a2t + (size_t)(q - 2) * RW * 64) + c * 64 + 8 * c16; v2[j] = *(const u32x4*)src; }
#pragma unroll
    for (int j = 0; j < 2; ++j) { const int i = tid + j * NTHR, c = i / 16, c16 = i % 16; v3[j] = *(const u32x4*)(g2t + c * 128 + 8 * c16); }
    SCHED_BARRIER();
#pragma unroll
    for (int j = 0; j < 6; ++j) { const int i = tid + j * NTHR, t = i / 48, c16 = i % 48;
        if (c16 < 32) *(LAS u32x4*)(Ab + (c16 >> 3) * 64 * LP + t * LP + 8 * (c16 & 7)) = v1[j]; else *(LAS u32x4*)(Gb + t * GP + 8 * (c16 - 32)) = v1[j]; }
#pragma unroll
    for (int j = 0; j < 4; ++j) { const int i = tid + j * NTHR, q = i / 512, c = (i / 8) % 64, c16 = i % 8; *(LAS u32x4*)(Wb + q * 64 * LP + c * LP + 8 * c16) = v2[j]; }
#pragma unroll
    for (int j = 0; j < 2; ++j) { const int i = tid + j * NTHR, c = i / 16, c16 = i % 16; *(LAS u32x4*)(G2b + c * GP + 8 * c16) = v3[j]; }
    __syncthreads();
    f32x4 o[2][5];
#pragma unroll
    for (int q = 0; q < 2; ++q) { const int tile = 2 * w + q, ti = tile >> 2, tj = tile & 3; const f32x4 z4 = {0.f, 0.f, 0.f, 0.f};
#pragma unroll
        for (int p = 0; p < 4; ++p) o[q][p] = mm_tile(Ab + p * 64 * LP, Wb + p * 64 * LP, ti, tj, lane, z4);
        o[q][4] = mm_tile_p(Gb, GP, G2b, GP, 4, ti, tj, lane, z4); }
    __syncthreads();
#pragma unroll
    for (int q = 0; q < 2; ++q) { const int tile = 2 * w + q, ti = tile >> 2, tj = tile & 3, col = 16 * tj + (lane & 15);
#pragma unroll
        for (int p = 0; p < 5; ++p)
#pragma unroll
            for (int r = 0; r < 4; ++r) OUT[(p * 64 + 16 * ti + 4 * (lane >> 4) + r) * LQ + col] = o[q][p][r]; }
    __syncthreads();
}
__device__ __forceinline__ void lora_unit_b(const Ctx& X, int l, int unit) {
    const int b = unit / NH, h = unit % NH, w = X.wave, k = X.lane, c = 64 * h + k;
    const LAS float* OUT = (const LAS float*)X.lds;
    const bf16* P = X.wsv<bf16>(WS_P); const float* mu = X.inv(I_MU) + (size_t)l * RC;
    const float w00 = X.inv(I_W0)[(size_t)(l * 2 + 0) * RW + c], w01 = X.inv(I_W0)[(size_t)(l * 2 + 1) * RW + c];
    const float a00 = X.inv(I_A0)[(size_t)(l * 2 + 0) * RW + c], a01 = X.inv(I_A0)[(size_t)(l * 2 + 1) * RW + c];
    const float kkc = X.inv(I_KK)[(size_t)l * RW + c], kac = X.inv(I_KA)[(size_t)l * RW + c], rkc = X.inv(I_RK)[(size_t)l * RW + c];
    bf16* pR = X.wsv<bf16>(WS_R); bf16* pV = X.wsv<bf16>(WS_V); bf16* pKA = X.wsv<bf16>(WS_KA); bf16* pKD = X.wsv<bf16>(WS_KD); bf16* pKB = X.wsv<bf16>(WS_KB); float* pW = X.wsv<float>(WS_W); bf16* pG = X.wsv<bf16>(WS_GATE); float* pBo = X.wsv<float>(WS_BONUS);
    const int vz = vgpr_zero();
    float p0[3][8], pn[3][8]; unsigned vmask = 0u; const float mu0 = mu[c], mu1 = mu[C_K + c], mu2 = mu[C_V + c];
#pragma unroll
    for (int i = 0; i < 8; ++i) { const int t = 64 * b + 8 * w + i + vz;
#pragma unroll
        for (int q = 0; q < 3; ++q) { const int col = (q == 0 ? 0 : q == 1 ? C_K : C_V) + c; bool valid; const int nr = shift_row(t, col, valid);
            p0[q][i] = bf2f(P[(size_t)t * PCP + col]); pn[q][i] = bf2f(P[(size_t)nr * PCP + col]); vmask |= (valid ? 1u : 0u) << (3 * i + q); } }
    float bonv[8];
#pragma unroll
    for (int i = 0; i < 8; ++i) { const int tl = 8 * w + i, t = 64 * b + tl + vz;
        const float r = p0[0][i] + ((((vmask >> (3 * i + 0)) & 1u) ? pn[0][i] : 0.f) - p0[0][i]) * mu0;
        const float kx = p0[1][i] + ((((vmask >> (3 * i + 1)) & 1u) ? pn[1][i] : 0.f) - p0[1][i]) * mu1;
        const float v = p0[2][i] + ((((vmask >> (3 * i + 2)) & 1u) ? pn[2][i] : 0.f) - p0[2][i]) * mu2;
        const float wd0 = -DECAY_SCALE * sigmoidf_(w00 + OUT[(0 * 64 + tl) * LQ + k]), wd1 = -DECAY_SCALE * sigmoidf_(w01 + OUT[(1 * 64 + tl) * LQ + k]);
        const float ad0 = sigmoidf_(a00 + OUT[(2 * 64 + tl) * LQ + k]), ad1 = sigmoidf_(a01 + OUT[(3 * 64 + tl) * LQ + k]);
        const float kkr = kx * kkc; const float n2 = wave_sum(kkr * kkr); const float kk = kkr * frcp(fmaxf(sqrtf(n2), 1e-12f));
        const float kd0 = kx * (1.f + (ad0 - 1.f) * kac), kd1 = kx * (1.f + (ad1 - 1.f) * kac);
        bonv[i] = wave_sum(r * (kd0 + kd1) * rkc);
        const size_t o = (size_t)t * RW + c, o1 = (size_t)(M + t) * RW + c;
        pR[o] = (bf16)f2bf(r); pV[o] = (bf16)f2bf(v); pKA[o] = (bf16)f2bf(-kk);
        pKD[o] = (bf16)f2bf(kd0); pKD[o1] = (bf16)f2bf(kd1); pKB[o] = (bf16)f2bf(kk * ad0); pKB[o1] = (bf16)f2bf(kk * ad1);
        pW[o] = wd0; pW[o1] = wd1; pG[o] = (bf16)f2bf(OUT[(4 * 64 + tl) * LQ + k]); }
    if (k < 8) { float bs = bonv[0];
#pragma unroll
        for (int i = 1; i < 8; ++i) bs = (k == i) ? bonv[i] : bs;
        pBo[(size_t)(64 * b + 8 * w + k) * NH + h] = bs; }
    __syncthreads();
}
__device__ __forceinline__ void phase_prep_hyena(const Ctx& X, int l) {
    const bf16* P = X.ws<bf16>(WS_P); const int c = X.tid;
    if (c < HW) {
        const float* cw = X.in(I_CW) + (size_t)l * 3 * HC; const float* cb = X.in(I_CB) + (size_t)l * HC;
        float cw0[3], cw1[3], cw2[3], cbv[3];
#pragma unroll
        for (int j = 0; j < 3; ++j) { const int hc = j * HW + c; cw0[j] = cw[hc]; cw1[j] = cw[HC + hc]; cw2[j] = cw[2 * HC + hc]; cbv[j] = cb[hc]; }
        float* ZT = X.ws<float>(WS_ZT) + (size_t)c * M; float* Zc = X.ws<float>(WS_Z); bf16* X0 = X.ws<bf16>(WS_X0);
        for (int tile = X.bid; tile < M / TT; tile += X.G) { const int t0 = tile * TT; float zz[TT];
            float pv[3][TT + 2]; const bool hp0 = (t0 != 0 && t0 != CTX), hnl = (t0 + TT != CTX && t0 + TT != M);
#pragma unroll
            for (int j = 0; j < 3; ++j) { const int col = C_HY + j * HW + c;
#pragma unroll
                for (int i = 0; i < TT + 2; ++i) { const int t = t0 - 1 + i; const bool ok = (i == 0) ? hp0 : (i == TT + 1) ? hnl : true; pv[j][i] = ok ? bf2f(P[(size_t)(ok ? t : t0) * PCP + col]) : 0.f; } }
#pragma unroll
            for (int tt = 0; tt < TT; ++tt) { const int t = t0 + tt;
                float u[3];
#pragma unroll
                for (int j = 0; j < 3; ++j) u[j] = pv[j][tt] * cw0[j] + pv[j][tt + 1] * cw1[j] + pv[j][tt + 2] * cw2[j] + cbv[j];
                zz[tt] = u[2] * u[1]; if (t < CTX) Zc[(size_t)t * HW + c] = zz[tt];
                X0[(size_t)t * HW + c] = (bf16)f2bf(u[0]); }
            *(f32x4*)(ZT + t0) = (f32x4){zz[0], zz[1], zz[2], zz[3]}; *(f32x4*)(ZT + t0 + 4) = (f32x4){zz[4], zz[5], zz[6], zz[7]}; }
    }
}

constexpr int CC = 64, NCHK = M / CC;
static_assert(CTX % CC == 0 && SEQ % CC == 0, "chunks must not straddle the context/latent boundary");
__device__ __forceinline__ int scan_row(int d, int s) { return d == 0 ? s : (s < CTX ? CTX - 1 - s : M - 1 - (s - CTX)); }
__device__ __forceinline__ void chunk_unit_1(const Ctx& X, int unit) {
    const int d = unit / (NCHK * NH), c = (unit / NH) % NCHK, h = unit % NH;
    LAS bf16* An = (LAS bf16*)X.lds;            LAS bf16* Bn = An + 64 * LP; LAS bf16* Kn = Bn + 64 * LP; LAS bf16* Rn = Kn + 64 * LP; LAS bf16* Vt = Rn + 64 * LP;
    LAS bf16* Bh = Vt + 64 * LP;                LAS bf16* Kh = Bh + 64 * LP; LAS bf16* Lak = Kh + 64 * LP; LAS bf16* Mrb = Lak + 64 * LP; LAS bf16* Mrk = Mrb + 64 * LP;
    LAS float* Lab = (LAS float*)(Mrk + 64 * LP); LAS float* XsW = Lab + 64 * LX;
    LAS float* XsU = (LAS float*)An;
    LAS bf16* Wt = Lak; LAS bf16* Ut = (LAS bf16*)((LAS unsigned char*)An + 64 * LX * 4);
    LAS float* tot = Lab;
    LAS float* dC = (LAS float*)(X.lds + LDS_MISC + 1024);
    static_assert(10 * 64 * LP * 2 + 2 * 64 * LX * 4 <= LDS_STAGE && 64 * LX * 4 + 64 * LP * 2 <= 3 * 64 * LP * 2, "chunk LDS map");
    const int tid = X.tid, lane = X.lane, w = X.wave, k = tid & 63;
    float lw[8], cum[8]; bf16 rr[8], rv[8], rka[8], rkd[8], rkb[8];
    { float run = 0.f; const float* pW = X.wsv<float>(WS_W);
      const bf16* pR = X.wsv<bf16>(WS_R); const bf16* pV = X.wsv<bf16>(WS_V); const bf16* pKA = X.wsv<bf16>(WS_KA); const bf16* pKD = X.wsv<bf16>(WS_KD); const bf16* pKB = X.wsv<bf16>(WS_KB);
#pragma unroll
      for (int i = 0; i < 8; ++i) { const int row = scan_row(d, c * CC + 8 * w + i); lw[i] = pW[((size_t)d * M + row) * RW + h * 64 + k]; }
#pragma unroll
      for (int i = 0; i < 8; ++i) { const int row = scan_row(d, c * CC + 8 * w + i); const size_t o = (size_t)row * RW + h * 64 + k, od = ((size_t)d * M + row) * RW + h * 64 + k;
          rr[i] = pR[o]; rv[i] = pV[o]; rka[i] = pKA[o]; rkd[i] = pKD[od]; rkb[i] = pKB[od]; }
      SCHED_BARRIER();
#pragma unroll
      for (int i = 0; i < 8; ++i) { run += lw[i]; cum[i] = run; }
      tot[w * 64 + k] = run; }
    __syncthreads();
    float off = 0.f, cumC = 0.f;
#pragma unroll
    for (int ww = 0; ww < 8; ++ww) { const float t = tot[ww * 64 + k]; off += (ww < w) ? t : 0.f; cumC += t; }
    __syncthreads();
    { unsigned pv[4], pbh[4], pkh[4]; float af[8];
#pragma unroll
      for (int i = 0; i < 8; ++i) { const int t = 8 * w + i;
          const float ct = off + cum[i], cp = ct - lw[i];
          const float r = bf2f(rr[i]), v = bf2f(rv[i]), ka = bf2f(rka[i]), kd = bf2f(rkd[i]), kb = bf2f(rkb[i]);
          const float ei = fexp(-ct), eh = fexp(cumC - ct);
          const float at = ka * fexp(cp); af[i] = at;
          An[t * LP + k] = (bf16)f2bf(at); Bn[t * LP + k] = (bf16)f2bf(kb * ei); Kn[t * LP + k] = (bf16)f2bf(kd * ei); Rn[t * LP + k] = (bf16)f2bf(r * fexp(ct));
          const unsigned bv = f2bf(v), bb = f2bf(kb * eh), bk = f2bf(kd * eh);
          if (i & 1) { pv[i >> 1] |= bv << 16; pbh[i >> 1] |= bb << 16; pkh[i >> 1] |= bk << 16; } else { pv[i >> 1] = bv; pbh[i >> 1] = bb; pkh[i >> 1] = bk; } }
      *(LAS u32x4*)(Vt + k * LP + 8 * w) = (u32x4){pv[0], pv[1], pv[2], pv[3]}; *(LAS u32x4*)(Bh + k * LP + 8 * w) = (u32x4){pbh[0], pbh[1], pbh[2], pbh[3]}; *(LAS u32x4*)(Kh + k * LP + 8 * w) = (u32x4){pkh[0], pkh[1], pkh[2], pkh[3]};
      *(LAS f32x4*)(XsW + k * LX + 8 * w) = (f32x4){af[0], af[1], af[2], af[3]}; *(LAS f32x4*)(XsW + k * LX + 8 * w + 4) = (f32x4){af[4], af[5], af[6], af[7]}; }
    if (tid < 64) dC[tid] = fexp(cumC);
    __syncthreads();
#pragma unroll 1
    for (int q = 0; q < 2; ++q) { const int tile = 2 * w + q, ti = tile >> 2, tj = tile & 3; const f32x4 z4 = {0.f, 0.f, 0.f, 0.f};
        const f32x4 ab = mm_tile(An, Bn, ti, tj, lane, z4), ak = mm_tile(An, Kn, ti, tj, lane, z4), rb = mm_tile(Rn, Bn, ti, tj, lane, z4), rk = mm_tile(Rn, Kn, ti, tj, lane, z4);
        const int col = 16 * tj + (lane & 15);
#pragma unroll
        for (int r = 0; r < 4; ++r) { const int row = 16 * ti + 4 * (lane >> 4) + r; const bool lo = col < row, le = col <= row;
            Lab[row * LX + col] = lo ? ab[r] : 0.f; Lak[row * LP + col] = (bf16)f2bf(lo ? ak[r] : 0.f); Mrb[row * LP + col] = (bf16)f2bf(le ? rb[r] : 0.f); Mrk[row * LP + col] = (bf16)f2bf(le ? rk[r] : 0.f); } }
    __syncthreads();
}
__device__ __forceinline__ void chunk_unit_2(const Ctx& X, int unit) {
    const int d = unit / (NCHK * NH), c = (unit / NH) % NCHK, h = unit % NH;
    LAS bf16* An = (LAS bf16*)X.lds;            LAS bf16* Bn = An + 64 * LP; LAS bf16* Kn = Bn + 64 * LP; LAS bf16* Rn = Kn + 64 * LP; LAS bf16* Vt = Rn + 64 * LP;
    LAS bf16* Bh = Vt + 64 * LP;                LAS bf16* Kh = Bh + 64 * LP; LAS bf16* Lak = Kh + 64 * LP; LAS bf16* Mrb = Lak + 64 * LP; LAS bf16* Mrk = Mrb + 64 * LP;
    LAS float* Lab = (LAS float*)(Mrk + 64 * LP); LAS float* XsW = Lab + 64 * LX;
    LAS float* XsU = (LAS float*)An;
    LAS bf16* Wt = Lak; LAS bf16* Ut = (LAS bf16*)((LAS unsigned char*)An + 64 * LX * 4);
    LAS float* tot = Lab;
    LAS float* dC = (LAS float*)(X.lds + LDS_MISC + 1024);
    static_assert(10 * 64 * LP * 2 + 2 * 64 * LX * 4 <= LDS_STAGE && 64 * LX * 4 + 64 * LP * 2 <= 3 * 64 * LP * 2, "chunk LDS map");
    const int tid = X.tid, lane = X.lane, w = X.wave, k = tid & 63;
    f32x4 r2[2]; int r2col[2], r2row[2];
#pragma unroll
    for (int q = 0; q < 2; ++q) { const int tile = 2 * w + q, ti = tile >> 2, tj = tile & 3; const f32x4 z4 = {0.f, 0.f, 0.f, 0.f};
        const f32x4 a = mm_tile(Lak, Vt, ti, tj, lane, z4); const int col = 16 * tj + (lane & 15);
        r2[q] = a; r2col[q] = col; r2row[q] = 16 * ti + 4 * (lane >> 4); }
    __syncthreads();
#pragma unroll
    for (int q = 0; q < 2; ++q) *(LAS f32x4*)(XsU + r2col[q] * LX + r2row[q]) = r2[q];
    __syncthreads();
    LAS bf16* Tii = (LAS bf16*)(X.lds + LDS_MISC + 8448);
    constexpr int TP = 40;
    static_assert(8448 + 4 * 16 * TP * 2 <= LDS_BYTES - LDS_MISC, "T_ii image");
    if (tid < 64) { const int bi = tid >> 4, j = tid & 15; float xv[16];
#pragma unroll
        for (int t = 0; t < 16; ++t) { float acc = (t == j) ? 1.f : 0.f;
#pragma unroll
            for (int s2 = 0; s2 < t; ++s2) acc += Lab[(16 * bi + t) * LX + 16 * bi + s2] * xv[s2];
            xv[t] = acc; }
#pragma unroll
        for (int t = 0; t < 16; ++t) { Tii[(bi * 16 + t) * TP + j] = (bf16)f2bf(xv[t]); Tii[(bi * 16 + t) * TP + 16 + j] = (bf16)0; } }
    __syncthreads();
    { LAS float* xsx = (w < 4 ? XsW + 16 * w * LX : XsU + 16 * (w - 4) * LX) + (lane & 15) * LX;
      LAS bf16* dst = (w < 4 ? Wt + 16 * w * LP : Ut + 16 * (w - 4) * LP) + (lane & 15) * LP;
      const int kof = 8 * (lane >> 4); const bf16x8 zero8 = {0, 0, 0, 0, 0, 0, 0, 0};
#pragma unroll
      for (int i = 0; i < 4; ++i) {
          f32x4 acc = *(const LAS f32x4*)(xsx + 16 * i + 4 * (lane >> 4));
#pragma unroll
          for (int kk = 0; kk < (16 * i + 31) / 32; ++kk) { const int s0 = 32 * kk + kof;
              const f32x4 l0 = *(const LAS f32x4*)(Lab + (16 * i + (lane & 15)) * LX + s0), l1 = *(const LAS f32x4*)(Lab + (16 * i + (lane & 15)) * LX + s0 + 4);
              u32x4 pa = {pk2(l0[0], l0[1]), pk2(l0[2], l0[3]), pk2(l1[0], l1[1]), pk2(l1[2], l1[3])};
              bf16x8 av = __builtin_bit_cast(bf16x8, pa), bv = *(const LAS bf16x8*)(dst + s0);
              if (s0 >= 16 * i) { av = zero8; bv = zero8; }
              acc = MFMA16(av, bv, acc); }
          LAS bf16* zt = (LAS bf16*)(xsx + 16 * i);
          *(LAS unsigned long long*)(zt + 4 * (lane >> 4)) = (unsigned long long)pk2(acc[0], acc[1]) | ((unsigned long long)pk2(acc[2], acc[3]) << 32);
          WAVE_LDS_FENCE(); CFENCE();
          const bf16x8 a2 = *(const LAS bf16x8*)(Tii + (i * 16 + (lane & 15)) * TP + kof); bf16x8 b2 = zero8; if (kof < 16) b2 = *(const LAS bf16x8*)(zt + kof);
          f32x4 xi = {0.f, 0.f, 0.f, 0.f}; xi = MFMA16(a2, b2, xi);
          *(LAS unsigned long long*)(dst + 16 * i + 4 * (lane >> 4)) = (unsigned long long)pk2(xi[0], xi[1]) | ((unsigned long long)pk2(xi[2], xi[3]) << 32);
          WAVE_LDS_FENCE(); CFENCE(); } }
    __syncthreads();
}
__device__ __forceinline__ void chunk_unit_3(const Ctx& X, int unit) {
    const int d = unit / (NCHK * NH), c = (unit / NH) % NCHK, h = unit % NH;
    LAS bf16* An = (LAS bf16*)X.lds;            LAS bf16* Bn = An + 64 * LP; LAS bf16* Kn = Bn + 64 * LP; LAS bf16* Rn = Kn + 64 * LP; LAS bf16* Vt = Rn + 64 * LP;
    LAS bf16* Bh = Vt + 64 * LP;                LAS bf16* Kh = Bh + 64 * LP; LAS bf16* Lak = Kh + 64 * LP; LAS bf16* Mrb = Lak + 64 * LP; LAS bf16* Mrk = Mrb + 64 * LP;
    LAS float* Lab = (LAS float*)(Mrk + 64 * LP); LAS float* XsW = Lab + 64 * LX;
    LAS float* XsU = (LAS float*)An;
    LAS bf16* Wt = Lak; LAS bf16* Ut = (LAS bf16*)((LAS unsigned char*)An + 64 * LX * 4);
    LAS float* tot = Lab;
    LAS float* dC = (LAS float*)(X.lds + LDS_MISC + 1024);
    static_assert(10 * 64 * LP * 2 + 2 * 64 * LX * 4 <= LDS_STAGE && 64 * LX * 4 + 64 * LP * 2 <= 3 * 64 * LP * 2, "chunk LDS map");
    const int tid = X.tid, lane = X.lane, w = X.wave, k = tid & 63;
    const float dCk = dC[k];
    const size_t ubase = ((size_t)(d * NH + h) * NCHK + c);
    bf16* PTg = (bf16*)(X.wsv<float>(WS_PQ) + ubase * 2 * 4096); float* Qg = X.wsv<float>(WS_PQ) + ubase * 2 * 4096 + 4096;     bf16* Gg = X.wsv<bf16>(WS_G) + ubase * 4096; float* Yg = X.wsv<float>(WS_YL) + ubase * 4096;
#pragma unroll 1
    for (int q = 0; q < 2; ++q) { const int tile = 2 * w + q, ti = tile >> 2, tj = tile & 3; const f32x4 z4 = {0.f, 0.f, 0.f, 0.f};
        const f32x4 p = mm_tile(Wt, Bh, ti, tj, lane, z4); f32x4 qq = mm_tile(Ut, Bh, ti, tj, lane, z4); qq = mm_tile(Vt, Kh, ti, tj, lane, qq);
        const f32x4 g = mm_tile(Mrb, Wt, ti, tj, lane, z4); f32x4 y = mm_tile(Mrb, Ut, ti, tj, lane, z4); y = mm_tile(Mrk, Vt, ti, tj, lane, y);
        const int col = 16 * tj + (lane & 15); const float dcol = __shfl(dCk, col);
        { const int row0 = 16 * ti + 4 * (lane >> 4); float pv[4];
#pragma unroll
          for (int r = 0; r < 4; ++r) pv[r] = p[r] + ((row0 + r) == col ? dcol : 0.f);
          *(unsigned long long*)(PTg + col * 64 + row0) = (unsigned long long)pk2(pv[0], pv[1]) | ((unsigned long long)pk2(pv[2], pv[3]) << 32); }
#pragma unroll
        for (int r = 0; r < 4; ++r) { const int row = 16 * ti + 4 * (lane >> 4) + r;
            Qg[row * 64 + col] = qq[r];
            const int orow = d ? 63 - row : row;
            Gg[orow * 64 + col] = (bf16)f2bf(g[r] + bf2f(Rn[row * LP + col])); }
        { const int gq = lane >> 4; const int cti = d ? 3 - ti : ti, cg = d ? 3 - gq : gq; const f32x4 yv = d ? (f32x4){y[3], y[2], y[1], y[0]} : y;
          *(f32x4*)(Yg + ((cti * 4 + tj) * 64 + 16 * cg + (lane & 15)) * 4) = yv; } }
    __syncthreads();
}
__device__ __forceinline__ void seq_unit(const Ctx& X, int su) {
    const int d = su / (NH * 4), h = (su / 4) % NH, qv = su & 3;
    constexpr int PD = 9, RING = PD + 1, SLOTB = 8192 + 4096;
    LAS unsigned char* ring = X.lds;
    LAS bf16* S = (LAS bf16*)(ring + RING * SLOTB);
    static_assert(RING * SLOTB + 2 * 16 * LP * 2 <= LDS_STAGE && (PD - 1) * 6 <= 63, "seq LDS map / vmcnt range");
    const int lane = X.lane, w = X.wave, tj = w & 3, col = 16 * tj + (lane & 15), kq = lane >> 4, kof = 8 * kq;
    const bool worker = w < 4;
    const unsigned char* PQ = (const unsigned char*)(X.ws<float>(WS_PQ) + (size_t)(d * NH + h) * NCHK * 2 * 4096); bf16* S0g = X.ws<bf16>(WS_S0) + (size_t)(d * NH + h) * NCHK * 4096 + (size_t)(16 * qv) * 64;
#define SEQ_FILL(c_) do { const unsigned char* p_ = PQ + (size_t)(c_) * 32768; LAS unsigned char* sl_ = ring + ((c_) % RING) * SLOTB; \
        GLDS16(p_ + 16 * (w * 64 + lane), sl_ + 16 * (w * 64)); GLDS16(p_ + 16384 + (16 * qv) * 256 + 16 * ((w & 3) * 64 + lane), sl_ + 8192 + 16 * ((w & 3) * 64)); } while (0)
#pragma unroll
    for (int i = 0; i < PD; ++i) if (i < NCHK) SEQ_FILL(i);
    for (int i = X.tid; i < 2 * 16 * LP / 2; i += NTHR) ((LAS unsigned*)S)[i] = 0u;
    if (worker) {
#pragma unroll
        for (int r = 0; r < 4; ++r) S0g[(4 * kq + r) * 64 + col] = (bf16)0; }
    for (int c = 0; c < NCHK; ++c) {
        if (c + PD - 1 < NCHK) { if (worker) { ASM_WAIT_V(48); } else { ASM_WAIT_V(16); } } else { ASM_WAIT_V(0); }
        ASM_WAIT_L(0); S_BARRIER(); CFENCE();
        if (c + PD < NCHK) SEQ_FILL(c + PD);
        if (worker) {
            const LAS bf16* PT = (const LAS bf16*)(ring + (c % RING) * SLOTB); const LAS float* Q = (const LAS float*)(ring + (c % RING) * SLOTB + 8192);
            const LAS bf16* Sc = S + (c & 1) * 16 * LP; LAS bf16* Sn = S + ((c + 1) & 1) * 16 * LP;
            f32x4 acc;
#pragma unroll
            for (int r = 0; r < 4; ++r) acc[r] = Q[(4 * kq + r) * 64 + col];
#pragma unroll
            for (int kk = 0; kk < 2; ++kk) acc = MFMA16(*(const LAS bf16x8*)(Sc + (lane & 15) * LP + kof + 32 * kk), *(const LAS bf16x8*)(PT + (16 * tj + (lane & 15)) * 64 + kof + 32 * kk), acc);
#pragma unroll
            for (int r = 0; r < 4; ++r) { const bf16 sb = (bf16)f2bf(acc[r]); Sn[(4 * kq + r) * LP + col] = sb; if (c + 1 < NCHK) S0g[(size_t)(c + 1) * 4096 + (4 * kq + r) * 64 + col] = sb; } }
    }
    ASM_WAIT_V(0);
    __syncthreads();
#undef SEQ_FILL
}
constexpr int CR = 16;
__device__ __forceinline__ void conv_item(const Ctx& X, int item) {
    constexpr int NCG = HW / 64; constexpr int n = CTX;
    const int cg = item % NCG, ob = item / NCG, i0 = CR * ob, c = cg * 64 + X.lane;
    const float* F = X.ws<float>(WS_FILT) + (size_t)HW * SEQ + (size_t)c * CTX; const float* Z = X.ws<float>(WS_Z) + c;
    const float* fp = X.ws<float>(WS_FPART) + (size_t)NPART * HW + c;
    float nsum = 0.f; for (int b = 0; b < NPART; ++b) nsum += fp[(size_t)b * HW];
    float acc[CR], Q[CR];
#pragma unroll
    for (int r = 0; r < CR; ++r) acc[r] = 0.f;
    int jb = i0 - n / 2; if (jb < 0) jb = 0;
    int jend = i0 + n / 2 + CR; if (jend > n) jend = n;
    int Tb = i0 - jb + n / 2;
#pragma unroll
    for (int x = 1; x < CR; ++x) { const int T = Tb + x; Q[x] = (T >= 0 && T < n) ? F[T] : 0.f; }
    Q[0] = 0.f;
    for (; jb < jend; jb += CR, Tb -= CR) {
#pragma unroll
        for (int s = 0; s < CR; ++s) { const int T = Tb - s, j = jb + s;
            if ((s & 3) == 0) CFENCE();
            Q[(CR - s) & (CR - 1)] = (T >= 0 && T < n) ? F[T] : 0.f;
            const float zj = (j < n) ? Z[(size_t)j * HW] : 0.f;
#pragma unroll
            for (int r = 0; r < CR; ++r) acc[r] += Q[(r - s + CR) & (CR - 1)] * zj; }
    }
    const float inv = 1.0f / nsum; float* O = X.ws<float>(WS_CONV) + c;
#pragma unroll
    for (int r = 0; r < CR; ++r) O[(size_t)(i0 + r) * HW] = acc[r] * inv;
}

#ifdef EMU
struct cf { float x, y; };
#else
typedef float cf __attribute__((ext_vector_type(2)));
#endif
__device__ __forceinline__ cf cmul(cf a, cf b) { return cf{a.x * b.x - a.y * b.y, a.x * b.y + a.y * b.x}; }
__device__ __forceinline__ cf cadd(cf a, cf b) { return cf{a.x + b.x, a.y + b.y}; }
__device__ __forceinline__ cf csub(cf a, cf b) { return cf{a.x - b.x, a.y - b.y}; }
__device__ __forceinline__ cf cconj(cf a) { return cf{a.x, -a.y}; }
constexpr int FN = SEQ;
constexpr int flog4(int n) { return n <= 1 ? 0 : 1 + flog4(n / 4); }
constexpr int FLOG4 = flog4(FN), FSQ = 1 << FLOG4;
static_assert((1 << (2 * FLOG4)) == FN && FN * 8 <= LDS_STAGE, "FFT length must be a power of 4 that fits the LDS stage region");
constexpr int FFT_TAB_OFF = LDS_MISC + 2048;
static_assert(FFT_TAB_OFF + 2 * FSQ * 8 <= LDS_BYTES, "FFT twiddle tables");
__device__ __forceinline__ void fft_tables(const Ctx& X) {
    LAS cf* T = (LAS cf*)(X.lds + FFT_TAB_OFF);
    for (int i = X.tid; i < 2 * FSQ; i += NTHR) { const int k = i < FSQ ? i * FSQ : i - FSQ; float s, c; sincos_f(-6.283185307179586f * (float)k / (float)FN, s, c); T[i] = cf{c, s}; }
    __syncthreads();
}
__device__ __forceinline__ cf fft_tw(const LAS cf* T, int k) { const cf a = T[k >> FLOG4], b = T[FSQ + (k & (FSQ - 1))]; return cmul(a, b); }
__device__ __forceinline__ int rev4(int k) { int r = 0;
#pragma unroll
    for (int s = 0; s < FLOG4; ++s) { r = (r << 2) | (k & 3); k >>= 2; }
    return r; }
__device__ __forceinline__ void fft_stage_q1(LAS cf* x, int tid, bool inverse) {
    for (int u = tid; u < FN / 4; u += NTHR) { LAS f32x4* px = (LAS f32x4*)(x + 4 * u); const f32x4 v01 = px[0], v23 = px[1];
        const cf a0{v01[0], v01[1]}, a1{v01[2], v01[3]}, a2{v23[0], v23[1]}, a3{v23[2], v23[3]};
        const cf t0 = cadd(a0, a2), t1 = csub(a0, a2), t2 = cadd(a1, a3), d = csub(a1, a3), t3 = inverse ? cf{-d.y, d.x} : cf{d.y, -d.x};
        const cf y0 = cadd(t0, t2), y1 = cadd(t1, t3), y2 = csub(t0, t2), y3 = csub(t1, t3);
        px[0] = (f32x4){y0.x, y0.y, y1.x, y1.y}; px[1] = (f32x4){y2.x, y2.y, y3.x, y3.y}; }
    __syncthreads();
}
__device__ __forceinline__ void dif4(cf& a0, cf& a1, cf& a2, cf& a3, cf w1) {
    const cf w2 = cmul(w1, w1), w3 = cmul(w2, w1);
    const cf t0 = cadd(a0, a2), t1 = csub(a0, a2), t2 = cadd(a1, a3), d = csub(a1, a3), t3 = cf{d.y, -d.x};
    a0 = cadd(t0, t2); a1 = cmul(cadd(t1, t3), w1); a2 = cmul(csub(t0, t2), w2); a3 = cmul(csub(t1, t3), w3);
}
__device__ __forceinline__ void dit4(cf& a0, cf& a1, cf& a2, cf& a3, cf w1c) {
    const cf w2 = cmul(w1c, w1c), w3 = cmul(w2, w1c);
    a1 = cmul(a1, w1c); a2 = cmul(a2, w2); a3 = cmul(a3, w3);
    const cf t0 = cadd(a0, a2), t1 = csub(a0, a2), t2 = cadd(a1, a3), d = csub(a1, a3), t3 = cf{-d.y, d.x};
    a0 = cadd(t0, t2); a1 = cadd(t1, t3); a2 = csub(t0, t2); a3 = csub(t1, t3);
}
__device__ __forceinline__ void fft_pair(LAS cf* x, const LAS cf* T, int tid, int s, bool inverse) {
    const int q1 = FN >> (2 * s + 2), q2 = q1 >> 2, tw1 = 1 << (2 * s), tw2 = tw1 << 2;
    for (int u = tid; u < FN / 16; u += NTHR) { const int j2 = u & (q2 - 1), base = (u - j2) * 16 + j2;
        cf v[4][4];
#pragma unroll
        for (int a = 0; a < 4; ++a)
#pragma unroll
            for (int b = 0; b < 4; ++b) v[a][b] = x[base + a * q1 + b * q2];
        if (!inverse) {
#pragma unroll
            for (int b = 0; b < 4; ++b) dif4(v[0][b], v[1][b], v[2][b], v[3][b], fft_tw(T, (b * q2 + j2) * tw1));
            const cf wb = fft_tw(T, j2 * tw2);
#pragma unroll
            for (int a = 0; a < 4; ++a) dif4(v[a][0], v[a][1], v[a][2], v[a][3], wb);
        } else {
            const cf wb = cconj(fft_tw(T, j2 * tw2));
#pragma unroll
            for (int a = 0; a < 4; ++a) dit4(v[a][0], v[a][1], v[a][2], v[a][3], wb);
#pragma unroll
            for (int b = 0; b < 4; ++b) dit4(v[0][b], v[1][b], v[2][b], v[3][b], cconj(fft_tw(T, (b * q2 + j2) * tw1)));
        }
#pragma unroll
        for (int a = 0; a < 4; ++a)
#pragma unroll
            for (int b = 0; b < 4; ++b) x[base + a * q1 + b * q2] = v[a][b]; }
    __syncthreads();
}
__device__ __forceinline__ void fft_single(LAS cf* x, const LAS cf* T, int tid, int s, bool inverse) {
    const int q = FN >> (2 * s + 2), tw = 1 << (2 * s);
    for (int u = tid; u < FN / 4; u += NTHR) { const int j = u & (q - 1), p = (u - j) * 4 + j;
        cf a0 = x[p], a1 = x[p + q], a2 = x[p + 2 * q], a3 = x[p + 3 * q];
        if (!inverse) dif4(a0, a1, a2, a3, fft_tw(T, j * tw)); else dit4(a0, a1, a2, a3, cconj(fft_tw(T, j * tw)));
        x[p] = a0; x[p + q] = a1; x[p + 2 * q] = a2; x[p + 3 * q] = a3; }
    __syncthreads();
}
constexpr int fft_npairs() { int n = 0; for (int s = 0; s + 1 < FLOG4 - 1; s += 2) { if ((FN >> (2 * s + 6)) >= 64 || FN < 16384) ++n; else break; } return n; }
constexpr int FPAIRS = fft_npairs();
__device__ __forceinline__ void fft_run(LAS cf* x, const LAS cf* T, int tid, bool inverse) {
    constexpr int NST = FPAIRS + (FLOG4 - 1 - 2 * FPAIRS) + 1;
#pragma unroll 1
    for (int i = 0; i < NST; ++i) { const int k = inverse ? NST - 1 - i : i;
        if (k < FPAIRS) fft_pair(x, T, tid, 2 * k, inverse);
        else if (k < NST - 1) fft_single(x, T, tid, 2 * FPAIRS + (k - FPAIRS), inverse);
        else fft_stage_q1(x, tid, inverse); }
}
__device__ __forceinline__ void fft_fwd(LAS cf* x, const LAS cf* T, int tid) { fft_run(x, T, tid, false); }
__device__ __forceinline__ void fft_inv(LAS cf* x, const LAS cf* T, int tid) { fft_run(x, T, tid, true); }
__device__ __forceinline__ void fft_load_real(LAS cf* x, const float* src, float scale, int tid) {
    constexpr int NV = (FN / 4 + NTHR - 1) / NTHR; constexpr bool FULL = (FN / 4) % NTHR == 0;
    f32x4 v[NV];
#pragma unroll
    for (int j = 0; j < NV; ++j) { const int i = tid + j * NTHR; v[j] = (f32x4){0.f, 0.f, 0.f, 0.f}; if (FULL || i < FN / 4) v[j] = *(const f32x4*)(src + 4 * i); }
    SCHED_BARRIER();
#pragma unroll
    for (int j = 0; j < NV; ++j) { const int i = tid + j * NTHR; if (FULL || i < FN / 4) { *(LAS f32x4*)(x + 2 * i) = v[j] * scale; *(LAS f32x4*)(x + FN / 2 + 2 * i) = (f32x4){0.f, 0.f, 0.f, 0.f}; } }
    __syncthreads();
}
__device__ __forceinline__ void spec_load(const Ctx& X, int c) {
    LAS cf* x = (LAS cf*)X.lds; volatile LAS float* red = (volatile LAS float*)(X.lds + LDS_MISC) + 120;
    if (X.wave == 0) { const float* fp = X.ws<float>(WS_FPART) + c; float s = 0.f; for (int b = X.lane; b < NPART; b += 64) s += fp[(size_t)b * HW]; s = wave_sum(s); if (X.lane == 0) red[0] = s; }
    __syncthreads();
    const float inv = 1.0f / red[0];
    fft_load_real(x, X.ws<float>(WS_FILT) + (size_t)c * SEQ, inv, X.tid);
}
__device__ __forceinline__ void spec_unpack(const Ctx& X, int c) {
    LAS cf* x = (LAS cf*)X.lds;
    cf* HS = X.ws<cf>(WS_HS) + (size_t)c * (FN + 1);
    for (int k = X.tid; k <= FN / 2; k += NTHR) {
        const cf A = x[rev4(k)], B = x[rev4((FN - k) & (FN - 1))];
        if (k == 0) { HS[0] = cf{A.x + A.y, 0.f}; HS[FN] = cf{A.x - A.y, 0.f}; }
        else if (k == FN / 2) { HS[k] = cconj(A); }
        else { float sn, cs; sincos_f(-3.14159265358979f * (float)k / (float)FN, sn, cs); const cf w{cs, sn};
            const cf s1 = cadd(A, cconj(B)), d1 = csub(A, cconj(B)), wd = cmul(w, d1);
            HS[k] = cf{0.5f * (s1.x + wd.y), 0.5f * (s1.y - wd.x)};
            const cf s2 = cadd(B, cconj(A)), d2 = csub(B, cconj(A)), wd2 = cmul(cconj(w), d2);
            HS[FN - k] = cf{0.5f * (s2.x - wd2.y), 0.5f * (s2.y + wd2.x)}; } }
    __syncthreads();
}
__device__ __forceinline__ void fftconv_load(const Ctx& X, int c) { fft_load_real((LAS cf*)X.lds, X.ws<float>(WS_ZT) + (size_t)c * M + CTX, 1.0f, X.tid); }
__device__ __forceinline__ void fftconv_mul(const Ctx& X, int c) {
    LAS cf* x = (LAS cf*)X.lds;
    const cf* HS = X.ws<cf>(WS_HS) + (size_t)c * (FN + 1);
    constexpr bool FULLM = (FN / 2) % (4 * NTHR) == 0;
    for (int k0 = X.tid; k0 < FN / 2; k0 += 4 * NTHR) {
        cf hk4[4], hn4[4];
#pragma unroll
        for (int j = 0; j < 4; ++j) { const int k = k0 + j * NTHR; hk4[j] = cf{0.f, 0.f}; hn4[j] = cf{0.f, 0.f}; if (FULLM || k < FN / 2) { hk4[j] = HS[k]; hn4[j] = HS[FN - k]; } }
        SCHED_BARRIER();
#pragma unroll
        for (int j = 0; j < 4; ++j) { const int k = k0 + j * NTHR; const cf hk = hk4[j], hn = hn4[j];
            if (FULLM || k < FN / 2) {
                const int pa = rev4(k), pb = rev4((FN - k) & (FN - 1)); const cf A = x[pa], B = x[pb];
                if (k == 0) { const float y0 = (A.x + A.y) * hk.x, yn = (A.x - A.y) * hn.x; x[pa] = cf{0.5f * (y0 + yn), 0.5f * (y0 - yn)}; }
                else { float sn, cs; sincos_f(-3.14159265358979f * (float)k / (float)FN, sn, cs); const cf w{cs, sn};
                    const cf s1 = cadd(A, cconj(B)), d1 = csub(A, cconj(B)), wd = cmul(w, d1); const cf Xk{0.5f * (s1.x + wd.y), 0.5f * (s1.y - wd.x)};
                    const cf s2 = cadd(B, cconj(A)), d2 = csub(B, cconj(A)), wd2 = cmul(cconj(w), d2); const cf Xn{0.5f * (s2.x - wd2.y), 0.5f * (s2.y + wd2.x)};
                    const cf Yk = cmul(Xk, hk), Yn = cmul(Xn, hn);
                    const cf e1 = cadd(Yk, cconj(Yn)), f1 = cmul(cconj(w), csub(Yk, cconj(Yn)));
                    x[pa] = cf{0.5f * (e1.x - f1.y), 0.5f * (e1.y + f1.x)};
                    const cf e2 = cadd(Yn, cconj(Yk)), f2 = cmul(w, csub(Yn, cconj(Yk)));
                    x[pb] = cf{0.5f * (e2.x + f2.y), 0.5f * (e2.y - f2.x)}; } } } }
    if (X.tid == 0) { const int pa = rev4(FN / 2); const cf A = x[pa]; x[pa] = cconj(cmul(cconj(A), HS[FN / 2])); }
    __syncthreads();
}
__device__ __forceinline__ void fftconv_out(const Ctx& X, int l, int c) {
    const LAS cf* x = (const LAS cf*)X.lds; const float* z = X.ws<float>(WS_ZT) + (size_t)c * M + CTX;
    const float bias = X.in(I_HBIAS)[(size_t)l * HW + c], sc = 1.0f / (float)FN; float* O = X.ws<float>(WS_CVT) + (size_t)c * SEQ;
    constexpr int NV = (FN / 4 + NTHR - 1) / NTHR; constexpr bool FULL = (FN / 4) % NTHR == 0; f32x4 zv[NV];
#pragma unroll
    for (int j = 0; j < NV; ++j) { const int i = X.tid + j * NTHR; zv[j] = (f32x4){0.f, 0.f, 0.f, 0.f}; if (FULL || i < FN / 4) zv[j] = *(const f32x4*)(z + 4 * i); }
    SCHED_BARRIER();
#pragma unroll
    for (int j = 0; j < NV; ++j) { const int i = X.tid + j * NTHR; if (FULL || i < FN / 4) { const f32x4 d = *(const LAS f32x4*)(x + 2 * i + FN / 4); *(f32x4*)(O + 4 * i) = d * sc + zv[j] * bias; } }
    __syncthreads();
}
__device__ __forceinline__ void phase_ctxconv(const Ctx& X, int l) {
    constexpr int NITEMS = (HW / 64) * (CTX / CR);
    unsigned* q = X.ctl() + CW_Q + l * 64;
    for (;;) { int item = 0; if (X.lane == 0) item = (int)atomicAdd(q, 1u); item = __shfl(item, 0); if (item >= NITEMS) break; conv_item(X, item); }
}
__device__ __forceinline__ void phase_seq(const Ctx& X) {
    for (int su = X.bid; su < N_SEQ_UNITS; su += X.G) seq_unit(X, su);
}

__device__ __forceinline__ void finish_wave_unit(const Ctx& X, int l, int unit) {
    const int rg = unit / NH, h = unit % NH, lane = X.lane, b = rg >> 2, sub = rg & 3;
    const int cf = b, cb = (b < CTX / CC) ? (CTX / CC - 1 - b) : (NCHK - 1 - (b - CTX / CC));
    const size_t uf = ((size_t)(0 * NH + h) * NCHK + cf) * 4096, ub = ((size_t)(1 * NH + h) * NCHK + cb) * 4096;
    const bf16* G = X.wsv<bf16>(WS_G); const bf16* S0 = X.wsv<bf16>(WS_S0); const float* YL = X.wsv<float>(WS_YL);
    const int arow = 16 * sub + (lane & 15), kof = 8 * (lane >> 4);
    bf16x8 af[2], ab[2];
#pragma unroll
    for (int kk = 0; kk < 2; ++kk) { af[kk] = *(const bf16x8*)(G + uf + arow * 64 + kof + 32 * kk); ab[kk] = *(const bf16x8*)(G + ub + arow * 64 + kof + 32 * kk); }
    f32x4 y[4]; bf16x8 bf_[4][2], bb_[4][2]; f32x4 ylf[4], ylb[4];
#pragma unroll
    for (int tj = 0; tj < 4; ++tj) { const int vrow = 16 * tj + (lane & 15);
#pragma unroll
        for (int kk = 0; kk < 2; ++kk) { bf_[tj][kk] = *(const bf16x8*)(S0 + uf + vrow * 64 + kof + 32 * kk); bb_[tj][kk] = *(const bf16x8*)(S0 + ub + vrow * 64 + kof + 32 * kk); }
    }
    SCHED_BARRIER();
#pragma unroll
    for (int tj = 0; tj < 4; ++tj) { f32x4 acc = {0.f, 0.f, 0.f, 0.f};
#pragma unroll
        for (int kk = 0; kk < 2; ++kk) { acc = MFMA16(af[kk], bf_[tj][kk], acc); acc = MFMA16(ab[kk], bb_[tj][kk], acc); }
        y[tj] = acc; }
    SCHED_BARRIER();
    const float* lgp = X.inv(I_LNXG) + (size_t)l * RW + 64 * h; const float* lbp = X.inv(I_LNXB) + (size_t)l * RW + 64 * h;
    const bf16* pV = X.wsv<bf16>(WS_V); const bf16* pG = X.wsv<bf16>(WS_GATE); const float* pBo = X.wsv<float>(WS_BONUS); bf16* pRO = X.wsv<bf16>(WS_RO);
    float lgv[4], lbv[4], bonv[4]; bf16 vv[4][4], gv[4][4];
#pragma unroll
    for (int tj = 0; tj < 4; ++tj) { const int cl = 16 * tj + (lane & 15); lgv[tj] = lgp[cl]; lbv[tj] = lbp[cl];
        ylf[tj] = *(const f32x4*)(YL + uf + ((sub * 4 + tj) * 64 + lane) * 4); ylb[tj] = *(const f32x4*)(YL + ub + ((sub * 4 + tj) * 64 + lane) * 4); }
#pragma unroll
    for (int r = 0; r < 4; ++r) { const int t = 16 * rg + 4 * (lane >> 4) + r; bonv[r] = pBo[(size_t)t * NH + h];
#pragma unroll
        for (int tj = 0; tj < 4; ++tj) { const size_t o = (size_t)t * RW + 64 * h + 16 * tj + (lane & 15); vv[r][tj] = pV[o]; gv[r][tj] = pG[o]; } }
    SCHED_BARRIER();
#pragma unroll
    for (int tj = 0; tj < 4; ++tj) y[tj] += ylf[tj] + ylb[tj];
#pragma unroll
    for (int r = 0; r < 4; ++r) { const int t = 16 * rg + 4 * (lane >> 4) + r;
        const float mean = row16_sum((y[0][r] + y[1][r]) + (y[2][r] + y[3][r])) * (1.f / 64.f);
        float q = 0.f;
#pragma unroll
        for (int tj = 0; tj < 4; ++tj) { const float dy = y[tj][r] - mean; q += dy * dy; }
        const float rstd = 1.0f / sqrtf(row16_sum(q) * (1.f / 64.f) + GN_EPS); const float bon = bonv[r];
#pragma unroll
        for (int tj = 0; tj < 4; ++tj) { const int cl = 16 * tj + (lane & 15); const size_t o = (size_t)t * RW + 64 * h + cl;
            float yn = (y[tj][r] - mean) * rstd * lgv[tj] + lbv[tj];
            yn += bon * bf2f(vv[r][tj]); yn *= bf2f(gv[r][tj]);
            pRO[o] = (bf16)f2bf(yn); } }
}
__device__ __forceinline__ void phase_finish(const Ctx& X, int l) {
    for (int u = X.bid * NWAVES + X.wave; u < (M / 16) * NH; u += X.G * NWAVES) { if (l == DEPTH - 1 && u < (CTX / 16) * NH) continue; finish_wave_unit(X, l, u); }
    const int c = X.tid;
    if (c < HW) { const float hbc = X.in(I_HBIAS)[(size_t)l * HW + c]; const float* CV = X.ws<float>(WS_CVT) + (size_t)c * SEQ; const bf16* X0 = X.ws<bf16>(WS_X0); bf16* HO = X.ws<bf16>(WS_HO);
        for (int tile = X.bid; tile < M / TT; tile += X.G) { const int t0 = tile * TT; float cv[TT];
            if (l == DEPTH - 1 && t0 < CTX) continue;
            if (t0 < CTX) {
#pragma unroll
                for (int tt = 0; tt < TT; ++tt) { const size_t o = (size_t)(t0 + tt) * HW + c; cv[tt] = X.ws<float>(WS_CONV)[o] + X.ws<float>(WS_Z)[o] * hbc; } }
            else { const f32x4 a = *(const f32x4*)(CV + (t0 - CTX)), b = *(const f32x4*)(CV + (t0 - CTX) + 4);
#pragma unroll
                for (int i = 0; i < 4; ++i) { cv[i] = a[i]; cv[4 + i] = b[i]; } }
#pragma unroll
            for (int tt = 0; tt < TT; ++tt) { const size_t o = (size_t)(t0 + tt) * HW + c; HO[o] = (bf16)f2bf(cv[tt] * bf2f(X0[o])); } } }
}

__device__ __forceinline__ void ln_inplace(float (&v)[D / 64], const float* g, const float* b, int lane) {
    float s = 0.f;
#pragma unroll
    for (int j = 0; j < D / 64; ++j) s += v[j];
    const float mean = wave_sum(s) * (1.f / D); float q = 0.f;
#pragma unroll
    for (int j = 0; j < D / 64; ++j) { v[j] -= mean; q += v[j] * v[j]; }
    const float rstd = 1.0f / sqrtf(wave_sum(q) * (1.f / D) + LN_EPS);
#pragma unroll
    for (int j = 0; j < D / 64; ++j) { const int d = 4 * lane + 256 * (j >> 2) + (j & 3); v[j] = v[j] * rstd * g[d] + b[d]; }
}
__device__ __forceinline__ void phase_norm1(const Ctx& X, int l_) {
    const int l = l_ & 255; const bool dry = (l_ >> 8) != 0;
    const int gw = X.bid * NWAVES + X.wave, NGW = X.G * NWAVES, lane = X.lane;
    const float* lng = X.in(I_LNG) + (size_t)(l * 2 + 0) * D; const float* lnb = X.in(I_LNB) + (size_t)(l * 2 + 0) * D;
    const float* wr = X.in(I_WR); const float* rb = X.in(I_RB);
    const float alpha = sqrtf(sqrtf(2.0f * DEPTH));
    volatile LAS int* hist = (volatile LAS int*)(X.lds + LDS_MISC + 4096);
    if (X.tid < NE) hist[X.tid] = 0;
    LAS float* wl = (LAS float*)X.lds + NWAVES * D;
    for (int i = X.tid; i < D * NE / 4; i += NTHR) ((LAS f32x4*)wl)[i] = ((const f32x4*)wr)[i];
    __syncthreads();
    for (int t = gw; t < M; t += NGW) { if (l == DEPTH - 1 && t < CTX) continue;
        float* xr = X.ws<float>(WS_X) + (size_t)t * D; const float* mx = X.ws<float>(WS_MIX) + (size_t)t * D;
        const float* gate = modp(X, l, t, 2); const float* sh = modp(X, l, t, 3); const float* sc = modp(X, l, t, 4);
        float v[D / 64];
#pragma unroll
        for (int j = 0; j < D / 256; ++j) { const int d = 4 * lane + 256 * j; const f32x4 a = *(const f32x4*)(xr + d), m = *(const f32x4*)(mx + d), gt = *(const f32x4*)(gate + d);
#pragma unroll
            for (int i = 0; i < 4; ++i) v[4 * j + i] = alpha * a[i] + gt[i] * m[i]; }
        ln_inplace(v, lng, lnb, lane);
        bf16* hf = X.ws<bf16>(WS_XMOD) + (size_t)t * D;
        LAS float* hrow = (LAS float*)X.lds + X.wave * D;
#pragma unroll
        for (int j = 0; j < D / 256; ++j) { const int d = 4 * lane + 256 * j; f32x4 o; const f32x4 a = *(const f32x4*)(sh + d), b = *(const f32x4*)(sc + d); f32x4 h;
#pragma unroll
            for (int i = 0; i < 4; ++i) { o[i] = v[4 * j + i]; h[i] = o[i] * (1.f + b[i]) + a[i]; }
            *(f32x4*)((dry ? X.ws<float>(WS_XG) + (size_t)t * D : xr) + d) = o; *(LAS f32x4*)(hrow + d) = h;
            *(unsigned long long*)(hf + d) = (unsigned long long)pk2(h[0], h[1]) | ((unsigned long long)pk2(h[2], h[3]) << 32); }
        WAVE_LDS_FENCE(); CFENCE();
        f32x4 part = {0.f, 0.f, 0.f, 0.f};
#pragma unroll 8
        for (int i = 0; i < D / 16; ++i) { const float hv = hrow[16 * i + (lane >> 2)]; const f32x4 w4 = *(const LAS f32x4*)(wl + 256 * i + 4 * lane);
#pragma unroll
            for (int c = 0; c < 4; ++c) part[c] += hv * w4[c]; }
#pragma unroll
        for (int c = 0; c < 4; ++c) { float p = part[c]; p += __shfl_xor(p, 4); p += __shfl_xor(p, 8); p += __shfl_xor(p, 16); p += __shfl_xor(p, 32); part[c] = p; }
        WAVE_LDS_FENCE(); CFENCE();
        float lg[NE];
#pragma unroll
        for (int e = 0; e < NE; ++e) lg[e] = __shfl(part[e & 3], e >> 2);
        float mxl = lg[0];
#pragma unroll
        for (int e = 1; e < NE; ++e) mxl = fmaxf(mxl, lg[e]);
        float sc_[NE], sum = 0.f;
#pragma unroll
        for (int e = 0; e < NE; ++e) { sc_[e] = expf(lg[e] - mxl); sum += sc_[e]; }
        const float isum = 1.0f / sum; float sel[NE];
#pragma unroll
        for (int e = 0; e < NE; ++e) { sc_[e] *= isum; sel[e] = sc_[e] + rb[e]; }
        int bg = 0; float bgs = -INFINITY;
#pragma unroll
        for (int g = 0; g < 4; ++g) { float m1 = -INFINITY, m2 = -INFINITY;
#pragma unroll
            for (int i = 0; i < 4; ++i) { const float x = sel[4 * g + i]; if (x > m1) { m2 = m1; m1 = x; } else if (x > m2) m2 = x; }
            const float gs = m1 + m2; if (gs > bgs) { bgs = gs; bg = g; } }
        int i0 = 0, i1 = 0; float s0 = -INFINITY, s1 = -INFINITY, p0 = 0.f, p1 = 0.f;
#pragma unroll
        for (int e = 0; e < NE; ++e) { if ((e >> 2) == bg) { const float x = sel[e]; if (x > s0) { s1 = s0; i1 = i0; p1 = p0; s0 = x; i0 = e; p0 = sc_[e]; } else if (x > s1) { s1 = x; i1 = e; p1 = sc_[e]; } } }
        if (lane == 0) { int* ei = X.ws<int>(WS_ROUT) + (size_t)t * 2; float* ew = (float*)(X.ws<int>(WS_ROUT) + (size_t)M * 2) + (size_t)t * 2;
            ei[0] = i0; ei[1] = i1; const float ws_ = 1.0f / (p0 + p1); ew[0] = p0 * ws_; ew[1] = p1 * ws_;
            lds_add(hist + i0, 1); lds_add(hist + i1, 1); }
    }
    __syncthreads();
    if (X.tid < NE && !dry) { const int hc = hist[X.tid]; X.ws<int>(WS_BCNT)[X.bid * NE + X.tid] = hc; atomicAdd(X.ctl() + CW_CNT + l * 64 + X.tid, (unsigned)hc); }
}

__device__ __forceinline__ void moe_table(const Ctx& X, int l, int NT) {
    volatile LAS int* tab = (volatile LAS int*)(X.lds + LDS_MISC) + 8;
    if (X.tid < NE) { const int cnt = (int)__hip_atomic_load(X.ctl() + CW_CNT + l * 64 + X.tid, RLX_AGENT); tab[64 + X.tid] = (cnt + 255) / 256; }
    __syncthreads();
    if (X.tid == 0) { int cum = 0, ts = 0;
        for (int e = 0; e < NE; ++e) { const int tc = tab[64 + e]; tab[e] = cum; tab[32 + e] = ts; cum += tc * NT; ts += tc; }
        tab[16] = cum; }
    __syncthreads();
}
__device__ __forceinline__ void phase_scatter(const Ctx& X, int l) {
    moe_table(X, l, 1);
    volatile LAS int* tab = (volatile LAS int*)(X.lds + LDS_MISC) + 8;
    volatile LAS int* cur = (volatile LAS int*)(X.lds + LDS_MISC + 4096) + 16;
    const int gw = X.bid * NWAVES + X.wave, NGW = X.G * NWAVES, lane = X.lane;
    if (X.tid < NE) cur[X.tid] = tab[32 + X.tid] * 256;
    __syncthreads();
    { const int* bc = X.ws<int>(WS_BCNT) + (X.tid & 15); int pre = 0;
        for (int b = X.tid >> 4; b < X.bid; b += NTHR / 16) pre += bc[b * NE];
        if (pre) lds_add(cur + (X.tid & 15), pre); }
    __syncthreads();
    const int* ei = X.ws<int>(WS_ROUT); int* slot = X.ws<int>(WS_ROUT) + (size_t)M * 4;
    for (int t = gw; t < M; t += NGW) { if (l == DEPTH - 1 && t < CTX) continue;
#pragma unroll
        for (int k = 0; k < 2; ++k) { const int e = ei[2 * t + k];
            int pos = 0; if (lane == 0) pos = lds_add(cur + e, 1);
            pos = __shfl(pos, 0);
            if (lane == 0) slot[2 * t + k] = pos;
            const u32x4* src = (const u32x4*)(X.ws<bf16>(WS_XMOD) + (size_t)t * D); u32x4* dst = (u32x4*)(X.ws<bf16>(WS_XG) + (size_t)pos * D);
            for (int i = lane; i < D / 8; i += 64) dst[i] = src[i]; } }
}

__device__ __forceinline__ void phase_combine(const Ctx& X, int l_) {
    const int l = l_ & 255; const bool dry = (l_ >> 8) != 0;
    const int gw = X.bid * NWAVES + X.wave, NGW = X.G * NWAVES, lane = X.lane;
    const float* lng = X.in(I_LNG) + (size_t)(l * 2 + 1) * D; const float* lnb = X.in(I_LNB) + (size_t)(l * 2 + 1) * D;
    const float alpha = sqrtf(sqrtf(2.0f * DEPTH));
    const float* ew = (const float*)(X.ws<int>(WS_ROUT) + (size_t)M * 2); const int* slot = X.ws<int>(WS_ROUT) + (size_t)M * 4;
    const bool bad = __hip_atomic_load(X.ctl() + CW_BAR + XB_TMO, RLX_AGENT) != 0u; const float pscale = 1.0f + bitsf(__hip_atomic_load(X.ctl() + 64, RLX_AGENT));
    for (int t = gw; t < M; t += NGW) { if (l == DEPTH - 1 && t < CTX) continue;
        float* xr = X.ws<float>(WS_X) + (size_t)t * D; const float* gate = modp(X, l, t, 5);
        const bf16* y0 = X.ws<bf16>(WS_YS) + (size_t)slot[2 * t] * D; const bf16* y1 = X.ws<bf16>(WS_YS) + (size_t)slot[2 * t + 1] * D; const float w0 = ew[2 * t], w1 = ew[2 * t + 1];
        float v[D / 64];
#pragma unroll
        for (int j = 0; j < D / 256; ++j) { const int d = 4 * lane + 256 * j; const f32x4 a = *(const f32x4*)(xr + d), gt = *(const f32x4*)(gate + d);
            const unsigned long long q0 = *(const unsigned long long*)(y0 + d), q1 = *(const unsigned long long*)(y1 + d);
            float ya[4] = {bflo((unsigned)q0), bfhi((unsigned)q0), bflo((unsigned)(q0 >> 32)), bfhi((unsigned)(q0 >> 32))};
            float yb[4] = {bflo((unsigned)q1), bfhi((unsigned)q1), bflo((unsigned)(q1 >> 32)), bfhi((unsigned)(q1 >> 32))};
#pragma unroll
            for (int i = 0; i < 4; ++i) v[4 * j + i] = alpha * a[i] + gt[i] * (w0 * ya[i] + w1 * yb[i]); }
        ln_inplace(v, lng, lnb, lane);
        if (l + 1 < DEPTH) { const float* sh = modp(X, l + 1, t, 0); const float* sc = modp(X, l + 1, t, 1); bf16* xm = X.ws<bf16>(WS_XMOD) + (size_t)t * D;
#pragma unroll
            for (int j = 0; j < D / 256; ++j) { const int d = 4 * lane + 256 * j; f32x4 o; const f32x4 a = *(const f32x4*)(sh + d), b = *(const f32x4*)(sc + d); float h[4];
#pragma unroll
                for (int i = 0; i < 4; ++i) { o[i] = v[4 * j + i]; h[i] = o[i] * (1.f + b[i]) + a[i]; }
                *(f32x4*)((dry ? X.ws<float>(WS_XG) + (size_t)t * D : xr) + d) = o;
                *(unsigned long long*)(xm + d) = (unsigned long long)pk2(h[0], h[1]) | ((unsigned long long)pk2(h[2], h[3]) << 32); }
        } else if (t >= CTX) { float* orow = X.out() + (size_t)(t - CTX) * D;
#pragma unroll
            for (int j = 0; j < D / 256; ++j) { const int d = 4 * lane + 256 * j; f32x4 o;
#pragma unroll
                for (int i = 0; i < 4; ++i) o[i] = bad ? __builtin_nanf("") : v[4 * j + i] * pscale;
                *(f32x4*)((dry ? X.ws<float>(WS_XG) + (size_t)t * D : orow) + d) = o; }
        }
    }
}


#ifdef EMU
#define PHASE_FN static
#define THIN_FN static
#else
#define PHASE_FN __device__ __forceinline__
#define THIN_FN __device__ __noinline__
#endif
THIN_FN void ph_transposes(Ctx X, int l, int part) { phase_transposes(X, l, part); }
THIN_FN void ph_filters_begin(Ctx X) { phase_filters_begin(X); }
THIN_FN void ph_filters_item(Ctx X, int l, int which, int it) { phase_filters_item(X, l, which, it); }
THIN_FN void ph_filters_end(Ctx X) { phase_filters_end(X); }
#define PH_FILTERS(X_, l_) do { ph_filters_begin(X_); for (int wh_ = 0; wh_ < 2; ++wh_) for (int it_ = (X_).bid * NWAVES + (X_).wave; it_ < (wh_ ? CTX : SEQ) / 16; it_ += (X_).G * NWAVES) ph_filters_item(X_, l_, wh_, it_); ph_filters_end(X_); } while (0)
THIN_FN void ph_filter_weights(Ctx X, int l) { phase_filter_weights(X, l); }
THIN_FN void ph_mod(Ctx X) { phase_mod(X); }
THIN_FN void ph_x0(Ctx X) { phase_x0(X); }
THIN_FN void ph_lin(Ctx X, int l) { phase_lin(X, l); }
THIN_FN void ph_lora_a(Ctx X, int u) { lora_unit_a(X, u); }
THIN_FN void ph_lora_b(Ctx X, int l, int u) { lora_unit_b(X, l, u); }
THIN_FN void ph_prep_hyena(Ctx X, int l) { phase_prep_hyena(X, l); }
THIN_FN void ph_ctxconv(Ctx X, int l) { phase_ctxconv(X, l); }
THIN_FN void ph_chunk_1(Ctx X, int u) { chunk_unit_1(X, u); }
THIN_FN void ph_chunk_2(Ctx X, int u) { chunk_unit_2(X, u); }
THIN_FN void ph_chunk_3(Ctx X, int u) { chunk_unit_3(X, u); }
THIN_FN void ph_seq(Ctx X) { phase_seq(X); }
THIN_FN void ph_fft_tables(Ctx X) { fft_tables(X); }
THIN_FN void ph_fft_run(Ctx X, int inverse) { fft_run((LAS cf*)X.lds, (const LAS cf*)(X.lds + FFT_TAB_OFF), X.tid, inverse != 0); }
THIN_FN void ph_spec_load(Ctx X, int c) { spec_load(X, c); }
THIN_FN void ph_spec_unpack(Ctx X, int c) { spec_unpack(X, c); }
THIN_FN void ph_fftconv_load(Ctx X, int c) { fftconv_load(X, c); }
THIN_FN void ph_fftconv_mul(Ctx X, int c) { fftconv_mul(X, c); }
THIN_FN void ph_fftconv_out(Ctx X, int l, int c) { fftconv_out(X, l, c); }
THIN_FN void ph_finish(Ctx X, int l) { phase_finish(X, l); }
THIN_FN void ph_norm1(Ctx X, int l) { phase_norm1(X, l); }
THIN_FN void ph_scatter(Ctx X, int l) { phase_scatter(X, l); }
THIN_FN void ph_combine(Ctx X, int l) { phase_combine(X, l); }
PHASE_FN void ph_g13(Ctx X, int third, int r0) { pg8::Gemm g{(third ? X.ws<bf16>(WS_T) : X.ws<bf16>(WS_XMOD)) + (size_t)r0 * D, third ? X.ws<bf16>(WS_WO) : X.ws<bf16>(WS_WIN), D}; pg8::StaticOrder S; S.init(M - r0, third ? D : PCP, X.G, X.bid);
    pg8::EpiBf16OrF32 E{X.ws<bf16>(WS_P) + (size_t)r0 * PCP, X.ws<float>(WS_MIX) + (size_t)r0 * D, third ? D : PCP, third != 0}; pg8::gemm_phase(X.lds, g, S, E); }
PHASE_FN void ph_g2(Ctx X, int second, int r0) { pg8::Gemm g{(second ? X.ws<bf16>(WS_HO) : X.ws<bf16>(WS_RO)) + (size_t)r0 * RW, X.ws<bf16>(WS_WB) + (second ? (size_t)D * RW : 0), RW}; pg8::StaticOrder S; S.init(M - r0, D, X.G, X.bid);
    pg8::EpiGate E{X.ws<bf16>(WS_T) + (size_t)r0 * D, D, X.ws<bf16>(WS_P) + (size_t)r0 * PCP, PCP, second ? C_GH : C_GR, second != 0}; pg8::gemm_phase(X.lds, g, S, E); }
PHASE_FN void ph_g45(Ctx X, int l, int down) { const int NT = down ? D / 256 : 2 * D / 256; moe_table(X, l, NT); pg8::MoeOrder S{(const volatile LAS int*)(X.lds + LDS_MISC) + 8, NT, X.G, X.bid};
    pg8::Gemm g{down ? X.ws<bf16>(WS_ACT) : X.ws<bf16>(WS_XG), down ? X.ws<bf16>(WS_WD) : X.ws<bf16>(WS_WGU), D}; pg8::EpiMoe E{down ? X.ws<bf16>(WS_YS) : X.ws<bf16>(WS_ACT), D, NT, down == 0}; pg8::gemm_phase(X.lds, g, S, E); }

constexpr int NPH = 16, NPHASES = DEPTH * NPH;
template <int MASK> __global__ void __launch_bounds__(NTHR, 2) fwd_kernel(Args args) {
    DYN_LDS(lds);
    Ctx X; X.lds = lds; X.tid = threadIdx.x; X.lane = X.tid & 63; X.wave = READFIRSTLANE(X.tid >> 6); X.G = gridDim.x; X.bid = blockIdx.x;
    volatile LAS unsigned* misc = (volatile LAS unsigned*)(lds + LDS_MISC);
    if (X.tid < 128) misc[X.tid] = 0u;
    if (X.tid < N_IN + 2) { const unsigned long long p = X.tid < N_IN ? (unsigned long long)args.in[X.tid < N_IN ? X.tid : 0] : (X.tid == N_IN ? (unsigned long long)args.out : (unsigned long long)args.ws);
        misc[PT_WORD0 + 2 * X.tid] = (unsigned)p; misc[PT_WORD0 + 2 * X.tid + 1] = (unsigned)(p >> 32); }
    __syncthreads();
    XcdBarrier bar = xcd_barrier_post(X.ctl() + CW_BAR, misc);
    const int lo = args.ph_lo, hi = args.ph_hi;
#define IN(k) ((((MASK) >> ((k) % NPH)) & 1) && lo <= (k) && (k) < hi)
#ifdef PROBE_K
#ifndef PROBE_SCALE
#define PROBE_SCALE 1.0f
#endif
#ifndef PROBE_BLOCK
#define PROBE_BLOCK 0
#endif
    unsigned long long plast = __builtin_amdgcn_s_memrealtime(); if (threadIdx.x < 32) misc[2048 + threadIdx.x] = 0u; __syncthreads();
#define PROBE_TX(k) do { if (blockIdx.x == PROBE_BLOCK && threadIdx.x == 0) { const unsigned long long now_ = __builtin_amdgcn_s_memrealtime(); misc[2048 + (k)] += (unsigned)(now_ - plast); plast = now_; } } while (0)
#define PROBE_T(k) PROBE_TX((k) % NPH)
#ifdef PROBE_KMASK
#define PROBE_PUB(k) do {} while (0)
#else
#define PROBE_PUB(k) do { if ((k) == NPHASES - 2 && blockIdx.x == PROBE_BLOCK && threadIdx.x == 0) { PROBE_T(k); unsigned tot_ = 0; for (int i_ = 0; i_ < 28; ++i_) tot_ += misc[2048 + i_]; \
        const float f_ = floorf(PROBE_SCALE * (float)misc[2048 + PROBE_K] / (float)tot_ * 128.0f + 0.5f) * (1.0f / 128.0f); __hip_atomic_store(X.ctl() + 64, fbits(f_), RLX_AGENT); } } while (0)
#endif
#else
#define PROBE_T(k) do {} while (0)
#define PROBE_TX(k) do {} while (0)
#define PROBE_PUB(k) do {} while (0)
#endif
#if defined(REPEAT_SUB) && REPEAT_SUB == 20
#define SEAM(k) do { if ((k) + 1 < hi) { xcd_barrier(bar); xcd_barrier(bar); } } while (0)
#else
#define SEAM(k) do { PROBE_PUB(k); if ((k) + 1 < hi) xcd_barrier(bar); PROBE_T(k); } while (0)
#endif
#if defined(REPEAT_SUB) && REPEAT_SUB == 15
#define RQN 2
#else
#define RQN 1
#endif
#ifdef REPEAT_SUB
#define RPS(id) for (int rps_ = 0; rps_ < ((id) == REPEAT_SUB ? 2 : 1); ++rps_)
#define RPS_N(id) ((id) == REPEAT_SUB ? 2 : 1)
#define rps_i rps_
#else
#define RPS(id)
#define RPS_N(id) 1
#define rps_i 0
#endif
#ifdef REPEAT_PH
#define RPT_IDX rpt_
#define RPT(k) for (int rpt_ = 0; rpt_ < (((k) % NPH) == REPEAT_PH ? 2 : 1); ++rpt_)
#else
#define RPT_IDX 0
#define RPT(k)
#endif
    for (int l = 0; l < DEPTH; ++l) {
        const int pb = l * NPH;
        if (l == 0 && IN(pb + 0)) { ph_transposes(X, l, 0); __syncthreads(); PROBE_TX(16); ph_filter_weights(X, 0); ph_mod(X); PROBE_TX(17); SEAM(pb + 0); }
        if (l == 0 && IN(pb + 1)) { ph_x0(X); PROBE_TX(18); PH_FILTERS(X, 0); PROBE_TX(19); SEAM(pb + 1); }
        if (IN(pb + 2)) { ph_g13(X, 0, 0); SEAM(pb + 2); }
        RPT(pb + 3) if (IN(pb + 3)) { RPS(6) ph_lin(X, l); RPS(7) ph_prep_hyena(X, l); ph_fft_tables(X); PROBE_TX(20); RPS(8) for (int c = X.bid; c < HW; c += X.G) { ph_spec_load(X, c); ph_fft_run(X, 0); ph_spec_unpack(X, c); } SEAM(pb + 3); }
        RPT(pb + 4) if (IN(pb + 4)) { for (int u = X.bid; u < (M / 64) * NH; u += X.G) { RPS(4) ph_lora_a(X, u); PROBE_TX(21); RPS(5) ph_lora_b(X, l, u); PROBE_TX(22); } SEAM(pb + 4); }
        RPT(pb + 5) if (IN(pb + 5)) { for (int u = X.bid; u < 2 * NCHK * NH; u += X.G) { RPS(1) ph_chunk_1(X, u); PROBE_TX(23); RPS(2) ph_chunk_2(X, u); PROBE_TX(24); RPS(3) ph_chunk_3(X, u); PROBE_TX(25); } SEAM(pb + 5); }
        RPT(pb + 6) if (IN(pb + 6)) { RPS(9) ph_seq(X); PROBE_TX(26); RPS(10) { ph_transposes(X, l, 1); __syncthreads(); } PROBE_TX(27); if (l + 1 < DEPTH) ph_filter_weights(X, l + 1); if (l + 1 < DEPTH) ph_ctxconv(X, l); ph_fft_tables(X); PROBE_TX(28);
            for (int rq_ = 0; rq_ < RQN; ++rq_) for (;;) { if (X.tid == 0) misc[121] = atomicAdd(X.ctl() + CW_Q + l * 64 + 32 + rq_, 1u); __syncthreads(); const int c = (int)misc[121]; __syncthreads(); if (c >= HW) break;
                ph_fftconv_load(X, c); ph_fft_run(X, 0); ph_fftconv_mul(X, c); ph_fft_run(X, 1); ph_fftconv_out(X, l, c); }
            PROBE_TX(29); SEAM(pb + 6); }
        RPT(pb + 7) if (IN(pb + 7)) { ph_finish(X, l); SEAM(pb + 7); }
        for (int sb = 0; sb < 2; ++sb) if (IN(pb + 8 + sb)) { ph_g2(X, sb, l == DEPTH - 1 ? CTX : 0); SEAM(pb + 8 + sb); }
        RPT(pb + 10) if (IN(pb + 10)) { ph_g13(X, 1, l == DEPTH - 1 ? CTX : 0); SEAM(pb + 10); }
        if (IN(pb + 11)) { RPS(28) ph_norm1(X, l | ((RPS_N(28) - 1 - rps_i) << 8)); SEAM(pb + 11); }
        if (IN(pb + 12)) { RPS(14) ph_scatter(X, l); SEAM(pb + 12); }
        for (int dn = 0; dn < 2; ++dn) if (IN(pb + 13 + dn)) { ph_g45(X, l, dn); SEAM(pb + 13 + dn); }
        if (IN(pb + 15)) { RPS(11) ph_combine(X, l | ((RPS_N(11) - 1 - rps_i) << 8)); PROBE_TX(30); if (l + 1 < DEPTH) { __syncthreads(); RPS(12) { ph_transposes(X, l + 1, 0); __syncthreads(); } PROBE_TX(31); RPS(13) PH_FILTERS(X, l + 1); } SEAM(pb + 15); }
    }
#if defined(PROBE_K) && defined(PROBE_KMASK)
    if (blockIdx.x == PROBE_BLOCK && threadIdx.x == 0) { unsigned tot_ = 0; for (int i_ = 0; i_ < 32; ++i_) if ((PROBE_KMASK >> i_) & 1) tot_ += misc[2048 + i_];
        const unsigned long long t0_ = __builtin_amdgcn_s_memrealtime(); while ((unsigned)(__builtin_amdgcn_s_memrealtime() - t0_) < tot_) __builtin_amdgcn_s_sleep(8); }
#endif
#undef IN
#undef SEAM
}

#ifndef N_LAUNCHES
#define N_LAUNCHES 1
#endif
#ifndef PH_MASK
#define PH_MASK 0xffff
#endif
template <int MASK> static void launch_mask(int grid, hipStream_t stream, const Args& a) {
    static bool attr = false;
    if (!attr) { (void)hipFuncSetAttribute((const void*)fwd_kernel<MASK>, hipFuncAttributeMaxDynamicSharedMemorySize, LDS_BYTES); attr = true; }
    hipLaunchKernelGGL(fwd_kernel<MASK>, dim3(grid), dim3(NTHR), LDS_BYTES, stream, a);
}
extern "C" void kernel_launch(void* const* d_in, const int* in_sizes, int n_in, void* d_out, int out_size, void* d_ws, size_t ws_size, hipStream_t stream) {
    static int grid = 0;
    if (grid == 0) {
        if (n_in != N_IN || ws_size < WS_END) { fprintf(stderr, "kernel_launch: unexpected n_in %d or workspace %zu < %zu\n", n_in, ws_size, (size_t)WS_END); grid = -1; return; }
        int dev = 0, cus = 0;
        if (hipGetDevice(&dev) != hipSuccess || hipDeviceGetAttribute(&cus, hipDeviceAttributeMultiprocessorCount, dev) != hipSuccess) { grid = -1; return; }
        (void)hipGetLastError();
        grid = cus; if (grid > NPART) grid = NPART;
    }
    if (grid < 0) return;
    (void)in_sizes; (void)out_size;
    (void)hipMemsetAsync(d_ws, 0, CTL_BYTES, stream);
    Args a;
    for (int i = 0; i < N_IN; ++i) a.in[i] = (const float*)d_in[i];
    a.out = (float*)d_out; a.ws = (unsigned char*)d_ws;
#if N_LAUNCHES == 1
    a.ph_lo = 0; a.ph_hi = NPHASES;
    launch_mask<PH_MASK>(grid, stream, a);
#else
    for (int ph = 0; ph < NPHASES; ++ph) { const int k = ph % NPH; if (k == 1 && ph / NPH != 0) continue; a.ph_lo = ph; a.ph_hi = ph + 1; launch_mask<PH_MASK>(grid, stream, a); }
#endif
}
```

```cpp
#ifndef EMU
#include <hip/hip_runtime.h>
#endif
#include <cstdio>
#include <cstdint>
#include <cmath>

#ifndef CFG_D
#define CFG_D 1024
#define CFG_SEQ 16384
#define CFG_CTX 256
#define CFG_DEPTH 4
#endif
constexpr int D = CFG_D, SEQ = CFG_SEQ, CTX = CFG_CTX, DEPTH = CFG_DEPTH, M = CTX + SEQ;
constexpr int GRID_W = 64, GRID_H = SEQ / GRID_W;
constexpr int RW = D / 2, NH = RW / 64, HW = D / 2, RC = 3 * RW + 384, HC = 3 * HW, GC = 2 * D, PC = RC + HC + GC, PCP = (PC + 255) / 256 * 256;
constexpr int QTR = RC / 4, HALFC = RC / 2;
constexpr int C_K = RW, C_V = 2 * RW, C_LWF = 3 * RW, C_LG = 3 * RW + 256;
constexpr int C_HY = RC, C_GR = RC + HC, C_GH = RC + HC + D;
constexpr int NE = 16, SP_TILES = (2 * M) / 256 + NE, SP = SP_TILES * 256;
constexpr float DECAY_SCALE = 0.606531f, GN_EPS = 6.4e-4f, LN_EPS = 1e-5f;
constexpr int LP = 72;
constexpr int LQ = 65;
constexpr int LX = 68;
constexpr int N_SEQ_UNITS = 2 * NH * 4;
constexpr int NPART = 256;
static_assert(CTX % 32 == 0 && M % 256 == 0 && D % 256 == 0 && RW % 128 == 0 && RW >= 256 && SEQ % 64 == 0 && CTX % 32 == 0 && RC % 4 == 0, "shape assumptions");

enum { I_X = 0, I_C, I_CTX, I_CCTX, I_WMOD, I_BMOD, I_WIN, I_MU, I_W0, I_W2, I_A0, I_A2, I_G2, I_KK, I_KA, I_RK, I_LNXG, I_LNXB, I_CW, I_CB,
       I_FW1, I_FB1, I_FW2, I_FB2, I_FW3, I_FB3, I_FWO, I_FREQ, I_HBIAS, I_WBR, I_WOUT, I_LNG, I_LNB, I_WR, I_RB, I_WG, I_WU, I_WD, N_IN };

constexpr size_t al256(size_t x) { return (x + 255) & ~(size_t)255; }
constexpr size_t CTL_BYTES = 1u << 20;
constexpr size_t WS_MOD = CTL_BYTES;
constexpr size_t WS_FPART = al256(WS_MOD + (size_t)DEPTH * 2 * 6 * D * 4);
constexpr size_t WS_ROUT = al256(WS_FPART + (size_t)2 * NPART * HW * 4);
constexpr size_t WS_BCNT = al256(WS_ROUT + (size_t)M * 2 * 4 * 3);
constexpr size_t WS_BONUS = al256(WS_BCNT + (size_t)NPART * NE * 4);
constexpr size_t WS_WIN = al256(WS_BONUS + (size_t)M * NH * 4);
constexpr size_t WS_WB = al256(WS_WIN + (size_t)PCP * D * 2);
constexpr size_t WS_WO = al256(WS_WB + (size_t)2 * D * RW * 2);
constexpr size_t WS_W2T = al256(WS_WO + (size_t)D * D * 2);
constexpr size_t WS_A2T = al256(WS_W2T + (size_t)2 * RW * 64 * 2);
constexpr size_t WS_G2T = al256(WS_A2T + (size_t)2 * RW * 64 * 2);
constexpr size_t WS_FWT = al256(WS_G2T + (size_t)RW * 128 * 2);
constexpr size_t WS_WGU = al256(WS_FWT + (size_t)(3 * 64 + HW) * 64 * 2);
constexpr size_t WS_WD = al256(WS_WGU + (size_t)NE * 2 * D * D * 2);
constexpr size_t WS_X = al256(WS_WD + (size_t)NE * D * D * 2);
constexpr size_t WS_XMOD = al256(WS_X + (size_t)M * D * 4);
constexpr size_t WS_P = al256(WS_XMOD + (size_t)M * D * 2);
constexpr size_t WS_FILT = al256(WS_P + (size_t)M * PCP * 2);
constexpr size_t WS_MIX = al256(WS_FILT + (size_t)M * HW * 4);
constexpr size_t WS_T = al256(WS_MIX + (size_t)M * D * 4);
constexpr size_t WS_S = al256(WS_T + (size_t)M * D * 2);
constexpr size_t WS_R = WS_S;
constexpr size_t WS_V = al256(WS_R + (size_t)M * RW * 2);
constexpr size_t WS_KA = al256(WS_V + (size_t)M * RW * 2);
constexpr size_t WS_KD = al256(WS_KA + (size_t)M * RW * 2);
constexpr size_t WS_KB = al256(WS_KD + (size_t)2 * M * RW * 2);
constexpr size_t WS_W = al256(WS_KB + (size_t)2 * M * RW * 2);
constexpr size_t WS_PQ = al256(WS_W + (size_t)2 * M * RW * 4);
constexpr size_t WS_LIN = WS_PQ;
static_assert((size_t)M * 384 * 2 <= (size_t)2 * NH * (M / 64) * 2 * 4096 * 4, "LIN fits PQ");
constexpr size_t WS_G = al256(WS_PQ + (size_t)2 * NH * (M / 64) * 2 * 4096 * 4);
constexpr size_t WS_YL = al256(WS_G + (size_t)2 * NH * (M / 64) * 4096 * 2);
constexpr size_t WS_S0 = WS_XMOD;
static_assert((size_t)2 * NH * (M / 64) * 4096 * 2 <= (size_t)M * D * 2, "S0 fits XMOD");
constexpr size_t WS_Z = al256(WS_YL + (size_t)2 * NH * (M / 64) * 4096 * 4);
constexpr size_t WS_X0 = al256(WS_Z + (size_t)CTX * HW * 4);
constexpr size_t WS_CONV = al256(WS_X0 + (size_t)M * HW * 2);
constexpr size_t WS_GATE = al256(WS_CONV + (size_t)CTX * HW * 4);
constexpr size_t WS_RO = al256(WS_GATE + (size_t)M * RW * 2);
constexpr size_t WS_HO = al256(WS_RO + (size_t)M * RW * 2);
constexpr size_t WS_HS = WS_MIX;
constexpr size_t WS_ZT = WS_T;
constexpr size_t WS_CVT = WS_FILT;
static_assert((size_t)HW * (SEQ + 1) * 8 <= (size_t)M * D * 4 && (size_t)HW * M * 4 <= (size_t)M * D * 2, "HS fits MIX, ZT fits T");
constexpr size_t WS_END1 = al256(WS_HO + (size_t)M * HW * 2);
constexpr size_t WS_XG = WS_S;
constexpr size_t WS_ACT = al256(WS_XG + (size_t)SP * D * 2);
constexpr size_t WS_YS = al256(WS_ACT + (size_t)SP * D * 2);
constexpr size_t WS_END2 = al256(WS_YS + (size_t)SP * D * 2);
constexpr size_t WS_END = WS_END1 > WS_END2 ? WS_END1 : WS_END2;
constexpr int CW_TMO = 0, CW_BAR = 4096, CW_CNT = 8192  , CW_CUR = 8192 + 1024  , CW_Q = 8192 + 2048  ;

#ifdef EMU
#define LAS
typedef short bf16x8 __attribute__((vector_size(16)));
typedef float f32x4 __attribute__((vector_size(16)));
typedef unsigned u32x4 __attribute__((vector_size(16)));
#define DYN_LDS(name) unsigned char* name = emu_cur_lds()
#define ASM_WAIT_V(n) do {} while (0)
#define ASM_WAIT_L(n) do {} while (0)
#define ASM_WAIT_VL0() do {} while (0)
#define CFENCE() do {} while (0)
#define WAVE_LDS_FENCE() emu_wave_sync()
#define S_BARRIER() emu_block_sync()
#define SCHED_BARRIER() do {} while (0)
#define SETPRIO(x) do {} while (0)
#define S_SLEEP(n) emu_yield()
#define MFMA16(a, b, c) emu_mfma_16x16x32(a, b, c)
#define MFMA4F(a, b, c) emu_mfma_16x16x4f32(a, b, c)
#define GLDS16(gptr, lptr) emu_glds16((const void*)(gptr), (void*)(lptr))
#define READFIRSTLANE(x) (x)
#define XCC_ID_() (blockIdx.x & 7u)
#define FENCE_RELEASE() do {} while (0)
#define FENCE_ACQUIRE() do {} while (0)
#define DPP_F(v, ctrl) emu_dpp_f(v, ctrl)
#define READLANE_F(v, l) emu_xchg((float)(v), (l))
static inline int vgpr_zero() { return 0; }
static inline unsigned long long vgpr_zero64() { return 0ull; }
static inline int lds_add(volatile int* p, int v) { int o = *p; *p = o + v; return o; }
static inline void lds_addf(float* p, float v) { *p += v; }
static inline unsigned fbits(float f) { unsigned u; memcpy(&u, &f, 4); return u; }
static inline float bitsf(unsigned u) { float f; memcpy(&f, &u, 4); return f; }
#else
#define LAS __attribute__((address_space(3)))
typedef short bf16x8 __attribute__((ext_vector_type(8)));
typedef float f32x4 __attribute__((ext_vector_type(4)));
typedef unsigned u32x4 __attribute__((ext_vector_type(4)));
#define DYN_LDS(name) extern __shared__ __attribute__((aligned(16))) unsigned char name##_raw[]; LAS unsigned char* name = (LAS unsigned char*)name##_raw
#define ASM_WAIT_V(n) asm volatile("s_waitcnt vmcnt(" #n ")" ::: "memory")
#define ASM_WAIT_L(n) asm volatile("s_waitcnt lgkmcnt(" #n ")" ::: "memory")
#define ASM_WAIT_VL0() asm volatile("s_waitcnt vmcnt(0) lgkmcnt(0)" ::: "memory")
#define CFENCE() asm volatile("" ::: "memory")
#define WAVE_LDS_FENCE() asm volatile("s_waitcnt lgkmcnt(0)" ::: "memory")
#define S_BARRIER() __builtin_amdgcn_s_barrier()
#define SCHED_BARRIER() __builtin_amdgcn_sched_barrier(0)
#define SETPRIO(x) __builtin_amdgcn_s_setprio(x)
#define S_SLEEP(n) __builtin_amdgcn_s_sleep(n)
#define MFMA16(a, b, c) __builtin_amdgcn_mfma_f32_16x16x32_bf16(a, b, c, 0, 0, 0)
#define MFMA4F(a, b, c) __builtin_amdgcn_mfma_f32_16x16x4f32(a, b, c, 0, 0, 0)
#define GLDS16(gptr, lptr) __builtin_amdgcn_global_load_lds((const unsigned*)(gptr), (LAS unsigned*)(lptr), 16, 0, 0)
#define READFIRSTLANE(x) __builtin_amdgcn_readfirstlane(x)
#define XCC_ID_() ((unsigned)__builtin_amdgcn_s_getreg((3 << 11) | 20) & 0xFu)
#define FENCE_RELEASE() __builtin_amdgcn_fence(__ATOMIC_RELEASE, "agent")
#define FENCE_ACQUIRE() __builtin_amdgcn_fence(__ATOMIC_ACQUIRE, "agent")
#define DPP_F(v, ctrl) __builtin_bit_cast(float, __builtin_amdgcn_update_dpp(0, __builtin_bit_cast(int, (float)(v)), (ctrl), 0xF, 0xF, true))
#define READLANE_F(v, l) __builtin_bit_cast(float, __builtin_amdgcn_readlane(__builtin_bit_cast(int, (float)(v)), (l)))
__device__ __forceinline__ int vgpr_zero() { int z; asm volatile("v_mov_b32 %0, 0" : "=v"(z)); return z; }
__device__ __forceinline__ unsigned long long vgpr_zero64() { unsigned long long z; asm volatile("v_mov_b64 %0, 0" : "=v"(z)); return z; }
__device__ __forceinline__ void lds_addf(LAS float* p, float v) { (void)__hip_atomic_fetch_add(p, v, __ATOMIC_RELAXED, __HIP_MEMORY_SCOPE_WORKGROUP); }
__device__ __forceinline__ int lds_add(volatile LAS int* p, int v) { return __hip_atomic_fetch_add((LAS int*)p, v, __ATOMIC_RELAXED, __HIP_MEMORY_SCOPE_WORKGROUP); }
__device__ __forceinline__ unsigned fbits(float f) { return __builtin_bit_cast(unsigned, f); }
__device__ __forceinline__ float bitsf(unsigned u) { return __builtin_bit_cast(float, u); }
#endif
typedef unsigned short bf16;
#define RLX_AGENT __ATOMIC_RELAXED, __HIP_MEMORY_SCOPE_AGENT

__device__ __forceinline__ unsigned f2bf(float f) { unsigned u = fbits(f); return (u + 0x7fffu + ((u >> 16) & 1u)) >> 16; }
__device__ __forceinline__ unsigned pk2(float lo, float hi) { return f2bf(lo) | (f2bf(hi) << 16); }
__device__ __forceinline__ float bf2f(bf16 b) { return bitsf(((unsigned)b) << 16); }
__device__ __forceinline__ float bflo(unsigned w) { return bitsf(w << 16); }
__device__ __forceinline__ float bfhi(unsigned w) { return bitsf(w & 0xffff0000u); }
#ifdef EMU
__device__ __forceinline__ float fexp(float x) { return expf(x); }
__device__ __forceinline__ float frcp(float x) { return 1.0f / x; }
#else
__device__ __forceinline__ float fexp(float x) { return __builtin_amdgcn_exp2f(x * 1.4426950408889634f); }
__device__ __forceinline__ float frcp(float x) { return __builtin_amdgcn_rcpf(x); }
#endif
__device__ __forceinline__ float sigmoidf_(float x) { return frcp(1.0f + fexp(-x)); }
__device__ __forceinline__ float row16_sum(float v) {
    v += DPP_F(v, 0xB1);
    v += DPP_F(v, 0x4E);
    v += DPP_F(v, 0x141);
    v += DPP_F(v, 0x140);
    return v;
}
__device__ __forceinline__ float wave_sum(float v) {
    const float r = row16_sum(v);
    return (READLANE_F(r, 0) + READLANE_F(r, 16)) + (READLANE_F(r, 32) + READLANE_F(r, 48));
}
__device__ __forceinline__ void sincos_f(float x, float& s, float& c) {
    const float k = rintf(x * 0.63661977236758134f);
    float r = fmaf(-k, 1.5703125f, x); r = fmaf(-k, 4.837512969970703125e-4f, r); r = fmaf(-k, 7.54978994989188216e-8f, r);
    const float r2 = r * r;
    const float sp = r + r * r2 * (-1.6666654611e-1f + r2 * (8.3321608736e-3f + r2 * (-1.9515295891e-4f)));
    const float cp = 1.0f - 0.5f * r2 + r2 * r2 * (4.166664568298827e-2f + r2 * (-1.388731625493765e-3f + r2 * (2.443315711809948e-5f)));
    const int q = ((int)k) & 3;
    s = (q == 0) ? sp : (q == 1) ? cp : (q == 2) ? -sp : -cp;
    c = (q == 0) ? cp : (q == 1) ? -sp : (q == 2) ? -cp : sp;
}
__device__ __forceinline__ float sin_f(float x) { float s, c; sincos_f(x, s, c); return s; }

template <class T> __device__ __forceinline__ T* as_global(T* p) {
#ifndef EMU
    return (T*)(__attribute__((address_space(1))) T*)(unsigned long long)p;
#else
    return p;
#endif
}
#define XB_TMO      128
#define XB_XCNT(j)  (256  + 64 * (j))
#define XB_XSUB(j)  (1280 + 64 * (j))
#define XB_XGEN(j)  (2304 + 64 * (j))
#define XB_TOP      3328
#define XB_TOPGEN   3392
#define XCD_BAR_WORDS 3456
#define XB_SPIN_CAP (1u << 18)
__device__ __forceinline__ unsigned xb_ld(unsigned* p)              { return __hip_atomic_load(p, __ATOMIC_RELAXED, __HIP_MEMORY_SCOPE_AGENT); }
__device__ __forceinline__ unsigned xb_add(unsigned* p, unsigned v) { return __hip_atomic_fetch_add(p, v, __ATOMIC_RELAXED, __HIP_MEMORY_SCOPE_AGENT); }
#define XB_SPIN(cond, bar) do { unsigned _sp = 0; while (cond) { S_SLEEP(1); \
    if ((++_sp & 255u) == 0u) { if (xb_ld(&(bar)[XB_TMO])) break; if (_sp > XB_SPIN_CAP) { atomicAdd(&(bar)[XB_TMO], 1u); break; } } } } while (0)
struct XcdBarrier { unsigned* bar; unsigned x; volatile LAS unsigned* st; };
__device__ __forceinline__ XcdBarrier xcd_barrier_post(unsigned* bar, volatile LAS unsigned* st) {
    XcdBarrier b; b.bar = nullptr; b.x = XCC_ID_(); b.st = st;
    if (threadIdx.x == 0) { st[2] = (unsigned)(unsigned long long)bar; st[3] = (unsigned)((unsigned long long)bar >> 32); st[4] = b.x; (void)xb_add(&bar[XB_XCNT(b.x)], 1u); }
    return b;
}
__device__ __forceinline__ void xcd_barrier_complete(unsigned* bar, unsigned x, unsigned& nloc, unsigned& nx) {
    const unsigned G = gridDim.x * gridDim.y * gridDim.z;
    unsigned sum, cnt, mine, sp = 0u;
    for (;;) {
        sum = 0u; cnt = 0u; mine = 0u;
#pragma unroll
        for (unsigned j = 0; j < 16; ++j) { const unsigned c = xb_ld(&bar[XB_XCNT(j)]); sum += c; cnt += (c > 0u) ? 1u : 0u; mine = (j == x) ? c : mine; }
        if (sum == G) break;
        S_SLEEP(1);
        if ((++sp & 255u) == 0u) { if (xb_ld(&bar[XB_TMO])) break; if (sp > XB_SPIN_CAP) { atomicAdd(&bar[XB_TMO], 1u); break; } }
    }
    nloc = mine > 0u ? mine : 1u; nx = cnt > 0u ? cnt : 1u;
}
__device__ __forceinline__ void xcd_barrier(const XcdBarrier& b) {
    ASM_WAIT_V(0);
    __syncthreads();
    if (threadIdx.x == 0) {
        unsigned* bar = as_global((unsigned*)(((unsigned long long)b.st[3] << 32) | b.st[2]));
        const unsigned bx = b.st[4];
        ASM_WAIT_VL0();
        unsigned nloc = b.st[0], nx = b.st[1];
        if (nloc == 0u) { xcd_barrier_complete(bar, bx, nloc, nx); b.st[0] = nloc; b.st[1] = nx; }
        const unsigned old = xb_add(&bar[XB_XSUB(bx)], 1u);
        const unsigned gen = old / nloc;
        if (old + 1u == (gen + 1u) * nloc) {
            FENCE_RELEASE();
            ASM_WAIT_V(0);
            const unsigned og = xb_add(&bar[XB_TOP], 1u);
            const unsigned tg = og / nx;
            if (og + 1u == (tg + 1u) * nx) xb_add(&bar[XB_TOPGEN], 1u);
            else XB_SPIN(xb_ld(&bar[XB_TOPGEN]) == tg, bar);
            FENCE_ACQUIRE();
            xb_add(&bar[XB_XGEN(bx)], 1u);
            ASM_WAIT_V(0);
        } else {
            XB_SPIN(xb_ld(&bar[XB_XGEN(bx)]) == gen, bar);
            FENCE_ACQUIRE();
            ASM_WAIT_V(0);
        }
    }
    __syncthreads();
}

namespace pg8 {
constexpr int BM = 256, BK = 64, HALF = 128, HTB = HALF * BK * 2, STAGE_BYTES = 8 * HTB, NXCD = 8, WGM = 8;
__host__ __device__ __forceinline__ int lds_byte(int r, int c) { const int st = (r >> 4) * 2 + (c >> 5), rr = r & 15, cc = c & 31, ob = rr * 64 + cc * 2; return st * 1024 + (ob ^ (((ob >> 9) & 1) << 5)); }
__host__ __device__ __forceinline__ void stage_rc(int b, int& R, int& C) { const int st = b / 1024, sb = b % 1024, swz = sb ^ (((sb >> 9) & 1) << 5); R = (st >> 1) * 16 + swz / 64; C = (st & 1) * 32 + (swz % 64) / 2; }
__host__ __device__ __forceinline__ int perm32(int rho) { const int n = rho >> 4, i = rho & 15; return 8 * (i >> 2) + 4 * n + (i & 3); }
struct Unit { int pm, pn; };
struct Gemm { const bf16* A; const bf16* Bt; int K; };
struct StaticOrder {
    int nM, nN, nwg, G, c;
    __host__ __device__ void init(int M_, int N_, int G_, int c_) { nM = M_ / BM; nN = N_ / BM; nwg = nM * nN; G = G_; c = c_; }
    __host__ __device__ bool next(int i, Unit& u) const {
        const long L = (long)i * G + c; if (L >= nwg) return false;
        int wgid = (int)L; { const int q = nwg / NXCD, r = nwg % NXCD, xcd = wgid % NXCD, off = wgid / NXCD; wgid = (xcd < r ? xcd * (q + 1) : r * (q + 1) + (xcd - r) * q) + off; }
        const int nig = WGM * nN, gid = wgid / nig, fm = gid * WGM, gsz = (nM - fm) < WGM ? (nM - fm) : WGM;
        u.pm = fm + ((wgid % nig) % gsz); u.pn = (wgid % nig) / gsz; return true;
    }
};
struct MoeOrder {
    const volatile LAS int* tab; int NT, G, c;
    __device__ __forceinline__ bool next(int i, Unit& u) const {
        const long L = (long)i * G + c; if (L >= tab[16]) return false;
        int e = 0; while (L >= tab[e + 1]) ++e;
        const int loc = (int)L - tab[e], tc = tab[64 + e];
        u.pm = tab[32 + e] + loc % tc; u.pn = e * NT + loc / tc; return true;
    }
};
__device__ __forceinline__ unsigned cvt_pk_bf16(float lo, float hi) {
#ifdef EMU
    return pk2(lo, hi);
#else
    unsigned r; asm volatile("v_cvt_pk_bf16_f32 %0, %1, %2" : "=v"(r) : "v"(lo), "v"(hi)); return r;
#endif
}

struct EpiBf16 {
    static constexpr bool PERM = true;
    bf16* O; int ldc;
    __device__ __forceinline__ void operator()(const f32x4 (&acc)[2][2][4][2], const Unit& u, int wr, int wc, int fr, int fq) const {
        const int row0 = u.pm * BM + wr * 64 + fr, col0 = u.pn * BM + wc * 32 + 8 * fq;
#pragma unroll
        for (int ai = 0; ai < 2; ++ai)
#pragma unroll
            for (int m = 0; m < 4; ++m) { bf16* rowp = O + (size_t)(row0 + ai * HALF + m * 16) * ldc + col0;
#pragma unroll
                for (int bj = 0; bj < 2; ++bj) { const f32x4 v0 = acc[ai][bj][m][0], v1 = acc[ai][bj][m][1];
                    u32x4 w; w[0] = cvt_pk_bf16(v0[0], v0[1]); w[1] = cvt_pk_bf16(v0[2], v0[3]); w[2] = cvt_pk_bf16(v1[0], v1[1]); w[3] = cvt_pk_bf16(v1[2], v1[3]);
                    *(u32x4*)(rowp + bj * HALF) = w; } }
    }
};
struct EpiF32 {
    static constexpr bool PERM = true;
    float* C; int ldc;
    __device__ __forceinline__ void operator()(const f32x4 (&acc)[2][2][4][2], const Unit& u, int wr, int wc, int fr, int fq) const {
        const int row0 = u.pm * BM + wr * 64 + fr, col0 = u.pn * BM + wc * 32 + 8 * fq;
#pragma unroll
        for (int ai = 0; ai < 2; ++ai)
#pragma unroll
            for (int m = 0; m < 4; ++m) { float* rowp = C + (size_t)(row0 + ai * HALF + m * 16) * ldc + col0;
#pragma unroll
                for (int bj = 0; bj < 2; ++bj)
#pragma unroll
                    for (int n = 0; n < 2; ++n) *(f32x4*)(rowp + bj * HALF + n * 4) = acc[ai][bj][m][n]; }
    }
};
struct EpiGate {
    static constexpr bool PERM = true;
    bf16* T; int ldc; const bf16* Pg; int ldp; int gcol0; bool ADD;
    __device__ __forceinline__ void operator()(const f32x4 (&acc)[2][2][4][2], const Unit& u, int wr, int wc, int fr, int fq) const {
        const int row0 = u.pm * BM + wr * 64 + fr, col0 = u.pn * BM + wc * 32 + 8 * fq;
#pragma unroll
        for (int ai = 0; ai < 2; ++ai)
#pragma unroll
            for (int m = 0; m < 4; ++m) { const size_t row = (size_t)(row0 + ai * HALF + m * 16);
#pragma unroll
                for (int bj = 0; bj < 2; ++bj) { const f32x4 v0 = acc[ai][bj][m][0], v1 = acc[ai][bj][m][1];
                    const u32x4 g = *(const u32x4*)(Pg + row * ldp + gcol0 + col0 + bj * HALF);
                    u32x4 t = {0u, 0u, 0u, 0u}; if (ADD) t = *(const u32x4*)(T + row * ldc + col0 + bj * HALF);
                    float o[8];
#pragma unroll
                    for (int j = 0; j < 4; ++j) { const float a0 = j < 2 ? v0[2 * j] : v1[2 * j - 4], a1 = j < 2 ? v0[2 * j + 1] : v1[2 * j - 3];
                        o[2 * j] = bflo(t[j]) + sigmoidf_(bflo(g[j])) * a0; o[2 * j + 1] = bfhi(t[j]) + sigmoidf_(bfhi(g[j])) * a1; }
                    u32x4 w; w[0] = cvt_pk_bf16(o[0], o[1]); w[1] = cvt_pk_bf16(o[2], o[3]); w[2] = cvt_pk_bf16(o[4], o[5]); w[3] = cvt_pk_bf16(o[6], o[7]);
                    *(u32x4*)(T + row * ldc + col0 + bj * HALF) = w; } }
    }
};
struct EpiSwiglu {
    static constexpr bool PERM = true;
    bf16* O; int ldc; int NT;
    __device__ __forceinline__ void operator()(const f32x4 (&acc)[2][2][4][2], const Unit& u, int wr, int wc, int fr, int fq) const {
        const int row0 = u.pm * BM + wr * 64 + fr, col0 = (u.pn % NT) * HALF + wc * 32 + 8 * fq;
#pragma unroll
        for (int ai = 0; ai < 2; ++ai)
#pragma unroll
            for (int m = 0; m < 4; ++m) { bf16* rowp = O + (size_t)(row0 + ai * HALF + m * 16) * ldc + col0;
                float o[8];
#pragma unroll
                for (int j = 0; j < 8; ++j) { const float g = acc[ai][0][m][j >> 2][j & 3], uu = acc[ai][1][m][j >> 2][j & 3]; o[j] = g / (1.0f + expf(-g)) * uu; }
                u32x4 w; w[0] = cvt_pk_bf16(o[0], o[1]); w[1] = cvt_pk_bf16(o[2], o[3]); w[2] = cvt_pk_bf16(o[4], o[5]); w[3] = cvt_pk_bf16(o[6], o[7]);
                *(u32x4*)rowp = w; }
    }
};
struct EpiMoeDown {
    static constexpr bool PERM = true;
    bf16* O; int ldc; int NT;
    __device__ __forceinline__ void operator()(const f32x4 (&acc)[2][2][4][2], const Unit& u, int wr, int wc, int fr, int fq) const {
        const int row0 = u.pm * BM + wr * 64 + fr, col0 = (u.pn % NT) * BM + wc * 32 + 8 * fq;
#pragma unroll
        for (int ai = 0; ai < 2; ++ai)
#pragma unroll
            for (int m = 0; m < 4; ++m) { bf16* rowp = O + (size_t)(row0 + ai * HALF + m * 16) * ldc + col0;
#pragma unroll
                for (int bj = 0; bj < 2; ++bj) { const f32x4 v0 = acc[ai][bj][m][0], v1 = acc[ai][bj][m][1];
                    u32x4 w; w[0] = cvt_pk_bf16(v0[0], v0[1]); w[1] = cvt_pk_bf16(v0[2], v0[3]); w[2] = cvt_pk_bf16(v1[0], v1[1]); w[3] = cvt_pk_bf16(v1[2], v1[3]);
                    *(u32x4*)(rowp + bj * HALF) = w; } }
    }
};

struct EpiBf16OrF32 { static constexpr bool PERM = true; bf16* O; float* C; int ldc; bool f32;
    __device__ __forceinline__ void operator()(const f32x4 (&acc)[2][2][4][2], const Unit& u, int wr, int wc, int fr, int fq) const {
        if (f32) { EpiF32 E{C, ldc}; E(acc, u, wr, wc, fr, fq); } else { EpiBf16 E{O, ldc}; E(acc, u, wr, wc, fr, fq); } } };
struct EpiMoe { static constexpr bool PERM = true; bf16* O; int ldc; int NT; bool swiglu;
    __device__ __forceinline__ void operator()(const f32x4 (&acc)[2][2][4][2], const Unit& u, int wr, int wc, int fr, int fq) const {
        if (swiglu) { EpiSwiglu E{O, ldc, NT}; E(acc, u, wr, wc, fr, fq); } else { EpiMoeDown E{O, ldc, NT}; E(acc, u, wr, wc, fr, fq); } } };
template <class Epi, class Sched>
__device__ __forceinline__ void gemm_phase(LAS unsigned char* lds, const Gemm g, const Sched& S, const Epi& E) {
    const int tid = threadIdx.x + vgpr_zero();
    const int wid = READFIRSTLANE(tid >> 6), lane = tid & 63, wr = wid >> 2, wc = wid & 3, fr = lane & 15, fq = lane >> 4;
    const int K = g.K, nt = K / BK;
    unsigned long long voffA[2], voffB[2]; const unsigned long long zhi = vgpr_zero64();
#pragma unroll
    for (int i = 0; i < 2; ++i) { int R, C; stage_rc(tid * 16 + i * 8192, R, C); const int Rb = Epi::PERM ? ((R & ~31) + perm32(R & 31)) : R;
        voffA[i] = zhi + (unsigned long long)(long long)((R * K + C) * 2); voffB[i] = zhi + (unsigned long long)(long long)((Rb * K + C) * 2); }
    const size_t kstep = (size_t)(BK * 2);
    const size_t hstep = (size_t)HALF * K * 2;
    const size_t tstep = 2 * hstep;
    const unsigned ldsw = (unsigned)wid * 1024u;
    const int aoff = lds_byte(wr * 64 + fr, fq * 8), boff = lds_byte(wc * 32 + fr, fq * 8);
#define PG8_SA(b, h) (((b) * 2 + (h)) * HTB)
#define PG8_SB(b, h) ((4 + (b) * 2 + (h)) * HTB)
#define PG8_STAGE(bufoff, gbase, voff) do { _Pragma("unroll") for (int _i = 0; _i < 2; ++_i) \
        GLDS16((const char*)(gbase) + (voff)[_i], lds + (bufoff) + ldsw + _i * 8192); } while (0)
#define PG8_LDA(dst, b, h) do { _Pragma("unroll") for (int m = 0; m < 4; ++m) _Pragma("unroll") for (int k = 0; k < 2; ++k) dst[m][k] = *(const LAS bf16x8*)(lds + PG8_SA(b, h) + aoff + m * 2048 + k * 1024); } while (0)
#define PG8_LDB(dst, b, h) do { _Pragma("unroll") for (int n = 0; n < 2; ++n) _Pragma("unroll") for (int k = 0; k < 2; ++k) dst[n][k] = *(const LAS bf16x8*)(lds + PG8_SB(b, h) + boff + n * 2048 + k * 1024); } while (0)
#define PG8_MMA(ai, bj, At, Bt) do { SETPRIO(1); _Pragma("unroll") for (int m = 0; m < 4; ++m) _Pragma("unroll") for (int n = 0; n < 2; ++n) _Pragma("unroll") for (int k = 0; k < 2; ++k) \
        acc[ai][bj][m][n] = MFMA16(Bt[n][k], At[m][k], acc[ai][bj][m][n]); SETPRIO(0); } while (0)
#define PG8_BAR S_BARRIER()
    Unit cur, nxt; int ui = 0;
    if (!S.next(0, cur)) return;
    f32x4 acc[2][2][4][2];
#pragma unroll
    for (int a = 0; a < 2; ++a)
#pragma unroll
        for (int b = 0; b < 2; ++b)
#pragma unroll
            for (int m = 0; m < 4; ++m)
#pragma unroll
                for (int n = 0; n < 2; ++n) acc[a][b][m][n] = (f32x4){0.f, 0.f, 0.f, 0.f};
    bf16x8 At[4][2], B0[2][2], B1[2][2];
    const char* cA = (const char*)g.A + (size_t)cur.pm * tstep; const char* cB = (const char*)g.Bt + (size_t)cur.pn * tstep;
    PG8_STAGE(PG8_SB(0, 0), cB, voffB); PG8_STAGE(PG8_SA(0, 0), cA, voffA); PG8_STAGE(PG8_SB(0, 1), cB + hstep, voffB); PG8_STAGE(PG8_SA(0, 1), cA + hstep, voffA);
    if (wr == 1) PG8_BAR;
    ASM_WAIT_V(4); PG8_BAR;
    PG8_STAGE(PG8_SB(1, 0), cB + kstep, voffB); PG8_STAGE(PG8_SA(1, 0), cA + kstep, voffA); PG8_STAGE(PG8_SB(1, 1), cB + hstep + kstep, voffB);
    ASM_WAIT_V(6); PG8_BAR;
    for (;;) {
        const bool has_next = S.next(ui + 1, nxt);
        const char* nA = has_next ? (const char*)g.A + (size_t)nxt.pm * tstep : cA; const char* nB = has_next ? (const char*)g.Bt + (size_t)nxt.pn * tstep : cB;
        for (int t = 0; t < nt; t += 2) {
            const bool last = (t == nt - 2);
            const char* a1 = cA + (size_t)(t + 1) * kstep;
            const char* a2 = last ? nA : cA + (size_t)(t + 2) * kstep; const char* b2 = last ? nB : cB + (size_t)(t + 2) * kstep;
            const char* a3 = a2 + kstep; const char* b3 = b2 + kstep;
            PG8_LDB(B0, 0, 0); SCHED_BARRIER(); PG8_LDA(At, 0, 0); PG8_STAGE(PG8_SA(1, 1), a1 + hstep, voffA);
            ASM_WAIT_L(8); PG8_BAR; ASM_WAIT_L(0); PG8_MMA(0, 0, At, B0); PG8_BAR; SCHED_BARRIER();
            PG8_LDB(B1, 0, 1); PG8_STAGE(PG8_SB(0, 0), b2, voffB);
            PG8_BAR; ASM_WAIT_L(0); PG8_MMA(0, 1, At, B1); PG8_BAR;
            PG8_LDA(At, 0, 1); PG8_STAGE(PG8_SA(0, 0), a2, voffA);
            PG8_BAR; ASM_WAIT_L(0); PG8_MMA(1, 0, At, B0); PG8_BAR; SCHED_BARRIER();
            PG8_STAGE(PG8_SB(0, 1), b2 + hstep, voffB);
            ASM_WAIT_V(6); PG8_BAR; PG8_MMA(1, 1, At, B1); PG8_BAR;
            PG8_LDB(B0, 1, 0); SCHED_BARRIER(); PG8_LDA(At, 1, 0); PG8_STAGE(PG8_SA(0, 1), a2 + hstep, voffA);
            ASM_WAIT_L(8); PG8_BAR; ASM_WAIT_L(0); PG8_MMA(0, 0, At, B0); PG8_BAR; SCHED_BARRIER();
            PG8_LDB(B1, 1, 1); PG8_STAGE(PG8_SB(1, 0), b3, voffB);
            PG8_BAR; ASM_WAIT_L(0); PG8_MMA(0, 1, At, B1); PG8_BAR;
            PG8_LDA(At, 1, 1); PG8_STAGE(PG8_SA(1, 0), a3, voffA);
            PG8_BAR; ASM_WAIT_L(0); PG8_MMA(1, 0, At, B0); PG8_BAR; SCHED_BARRIER();
            PG8_STAGE(PG8_SB(1, 1), b3 + hstep, voffB);
            ASM_WAIT_V(6); PG8_BAR; PG8_MMA(1, 1, At, B1); PG8_BAR;
        }
        E(acc, cur, wr, wc, fr, fq);
        if (!has_next) break;
#pragma unroll
        for (int a = 0; a < 2; ++a)
#pragma unroll
            for (int b = 0; b < 2; ++b)
#pragma unroll
                for (int m = 0; m < 4; ++m)
#pragma unroll
                    for (int n = 0; n < 2; ++n) acc[a][b][m][n] = (f32x4){0.f, 0.f, 0.f, 0.f};
        cur = nxt; cA = nA; cB = nB; ++ui;
    }
    ASM_WAIT_V(0);
    if (wr == 0) PG8_BAR;
    PG8_BAR;
#undef PG8_SA
#undef PG8_SB
#undef PG8_STAGE
#undef PG8_LDA
#undef PG8_LDB
#undef PG8_MMA
#undef PG8_BAR
}
}

struct Args { const float* in[N_IN]; float* out; unsigned char* ws; int ph_lo, ph_hi; };
constexpr int NWAVES = 8, NTHR = 512;
constexpr int LDS_STAGE = 131072, LDS_MISC = LDS_STAGE, LDS_BYTES = 147456;

constexpr int PT_OUT = N_IN, PT_WS = N_IN + 1, PT_WORD0 = 128;

struct Ctx {
    LAS unsigned char* lds; int tid, lane, wave, G, bid;
    __device__ __forceinline__ unsigned long long ptr(int i) const { const volatile LAS unsigned* t = (const volatile LAS unsigned*)(lds + LDS_MISC) + PT_WORD0 + 2 * i;
        const unsigned lo = (unsigned)READFIRSTLANE((int)t[0]), hi = (unsigned)READFIRSTLANE((int)t[1]); return ((unsigned long long)hi << 32) | lo; }
    __device__ __forceinline__ unsigned long long ptrv(int i) const { const volatile LAS unsigned* t = (const volatile LAS unsigned*)(lds + LDS_MISC) + PT_WORD0 + 2 * i; return ((unsigned long long)t[1] << 32) | t[0]; }
    __device__ __forceinline__ const float* inv(int i) const { return as_global((const float*)ptrv(i)); }
    template <class T> __device__ __forceinline__ T* wsv(size_t off) const { return as_global((T*)((unsigned char*)ptrv(PT_WS) + off)); }
    __device__ __forceinline__ const float* in(int i) const { return as_global((const float*)ptr(i)); }
    __device__ __forceinline__ float* out() const { return as_global((float*)ptr(PT_OUT)); }
    template <class T> __device__ __forceinline__ T* ws(size_t off) const { return as_global((T*)((unsigned char*)ptr(PT_WS) + off)); }
    __device__ __forceinline__ unsigned* ctl() const { return as_global((unsigned*)ptr(PT_WS)); }
};

__device__ __forceinline__ void transpose_item(const float* W, int ldw, int k0, int n0, int nvalid, bf16* outp, int ldo, LAS float* scr, int lane) {
#pragma unroll
    for (int i = 0; i < 32; ++i) { const int kk = 2 * i + (lane >> 5), n = n0 + (lane & 31); scr[kk * 33 + (lane & 31)] = (n < nvalid) ? W[(size_t)(k0 + kk) * ldw + n] : 0.f; }
    WAVE_LDS_FENCE(); CFENCE();
    const int c = lane & 7;
#pragma unroll
    for (int j = 0; j < 4; ++j) { const int n = (lane >> 3) + 8 * j; const LAS float* s = scr + (8 * c) * 33 + n;
        u32x4 o; o[0] = pk2(s[0 * 33], s[1 * 33]); o[1] = pk2(s[2 * 33], s[3 * 33]); o[2] = pk2(s[4 * 33], s[5 * 33]); o[3] = pk2(s[6 * 33], s[7 * 33]);
        *(u32x4*)(outp + (size_t)n * ldo + k0 + 8 * c) = o; }
    WAVE_LDS_FENCE(); CFENCE();
}
__device__ __forceinline__ void filter_item(const Ctx& X, int l, int n, int pos0, float* out, LAS bf16* za, LAS bf16* zb, LAS float* asum  ) {
    const int lane = X.lane, kof = 8 * (lane >> 4);
    const bf16* FWT = X.wsv<bf16>(WS_FWT);
    if (lane < 64) { const int i = lane;
#pragma unroll 4
        for (int p = 0; p < 16; ++p) { const int pos = pos0 + p; float v = 0.f;
            if (i == 0) v = (float)pos / (float)(n - 1 > 1 ? n - 1 : 1);
            else if (i < 33) { const int bb = (i - 1) & 15; const double band = 1e-4 + (double)bb * ((15.0 - 1e-4) / 15.0);
                double rev = (double)pos * band / (double)n; rev -= floor(rev); if (rev > 0.5) rev -= 1.0;
                float sn, cs; sincos_f((float)(rev * 6.283185307179586476925), sn, cs); v = i <= 16 ? cs : -sn; }
            za[p * LP + i] = (bf16)f2bf(v); } }
    WAVE_LDS_FENCE(); CFENCE();
    LAS bf16* src = za; LAS bf16* dst = zb;
#pragma unroll 1
    for (int layer = 0; layer < 3; ++layer) { const bf16* WT = FWT + (size_t)layer * 64 * 64; const float* bias = X.inv(layer == 0 ? I_FB1 : layer == 1 ? I_FB2 : I_FB3) + l * 64;
        const bf16x8 a0 = *(const LAS bf16x8*)(src + (lane & 15) * LP + kof), a1 = *(const LAS bf16x8*)(src + (lane & 15) * LP + kof + 32);
#pragma unroll
        for (int tj = 0; tj < 4; ++tj) { const int u = 16 * tj + (lane & 15); f32x4 acc = {0.f, 0.f, 0.f, 0.f};
            acc = MFMA16(a0, *(const bf16x8*)(WT + (size_t)u * 64 + kof), acc); acc = MFMA16(a1, *(const bf16x8*)(WT + (size_t)u * 64 + kof + 32), acc);
            const float fr = X.inv(I_FREQ)[l * 64 + u], bu = bias[u];
#pragma unroll
            for (int r = 0; r < 4; ++r) dst[(4 * (lane >> 4) + r) * LP + u] = (bf16)f2bf(sin_f(fr * (acc[r] + bu))); }
        WAVE_LDS_FENCE(); CFENCE();
        LAS bf16* t_ = src; src = dst; dst = t_; }
    const bf16* WO = FWT + (size_t)3 * 64 * 64;
    const bf16x8 a0 = *(const LAS bf16x8*)(src + (lane & 15) * LP + kof), a1 = *(const LAS bf16x8*)(src + (lane & 15) * LP + kof + 32);
    const float dmin = -3.0701134573253944f, dmax = -15.350567286626972f;
    float dist[4];
#pragma unroll
    for (int r = 0; r < 4; ++r) { const int dd = pos0 + 4 * (lane >> 4) + r - n / 2; dist[r] = (float)(dd < 0 ? -dd : dd) * (2.0f / (float)n); }
#pragma unroll 1
    for (int tg = 0; tg < HW / 64; ++tg) {
#pragma unroll
        for (int tq = 0; tq < 4; ++tq) { const int c = 64 * tg + 16 * tq + (lane & 15); f32x4 acc = {0.f, 0.f, 0.f, 0.f};
            acc = MFMA16(a0, *(const bf16x8*)(WO + (size_t)c * 64 + kof), acc); acc = MFMA16(a1, *(const bf16x8*)(WO + (size_t)c * 64 + kof + 32), acc);
            const float delta = fabsf(dmin + (float)c * ((dmax - dmin) / (float)(HW - 1))); f32x4 v; float as = 0.f;
#pragma unroll
            for (int r = 0; r < 4; ++r) { v[r] = acc[r] * fexp(-dist[r] * delta); as += fabsf(v[r]); }
            *(f32x4*)(out + (size_t)c * n + pos0 + 4 * (lane >> 4)) = v; lds_addf(asum + c, as); } }
    WAVE_LDS_FENCE(); CFENCE();
}
__device__ __forceinline__ void phase_transposes(const Ctx& X, int l, int part) {
    LAS float* scr = (LAS float*)(X.lds + X.wave * 16384);
    const bool shifted = part == 1 && X.G > N_SEQ_UNITS; const int myb = shifted ? X.bid - N_SEQ_UNITS : X.bid, nb_ = shifted ? X.G - N_SEQ_UNITS : X.G;
    if (myb < 0) return;
    const int gw = myb * NWAVES + X.wave, NGW = nb_ * NWAVES, lane = X.lane;
    constexpr int KB_D = D / 64, I_WIN_ = KB_D * (PCP / 32), I_WB_ = 2 * (RW / 64) * (D / 32), I_WO_ = KB_D * (D / 32), I_WGU_ = NE * 2 * KB_D * (D / 32), I_WD_ = NE * KB_D * (D / 32);
    constexpr int I_LORA_ = 6 * (RW / 32); constexpr int N0 = I_WIN_ + I_WB_ + I_WO_, NITEMS = N0 + I_WGU_ + I_WD_;
    if (part == 0) for (int it = gw; it < I_LORA_; it += NGW) { const int which = it / (RW / 32), nb = it % (RW / 32);
        const float* W; int k0 = 0, ldo = 64; bf16* outp;
        if (which < 2) { W = X.in(I_W2) + ((size_t)l * 2 + which) * 64 * RW; outp = X.ws<bf16>(WS_W2T) + (size_t)which * RW * 64 + (size_t)(32 * nb) * 64; }
        else if (which < 4) { W = X.in(I_A2) + ((size_t)l * 2 + (which - 2)) * 64 * RW; outp = X.ws<bf16>(WS_A2T) + (size_t)(which - 2) * RW * 64 + (size_t)(32 * nb) * 64; }
        else { W = X.in(I_G2) + (size_t)l * 128 * RW; k0 = 64 * (which - 4); ldo = 128; outp = X.ws<bf16>(WS_G2T) + (size_t)(32 * nb) * 128; }
        transpose_item(W, RW, k0, 32 * nb, RW, outp, ldo, scr, lane); }
    const int it_end = part ? NITEMS : N0; int it = (part ? N0 : 0) + gw;
    const float* W; int ldw, k0, n0, nvalid, ldo; bf16* outp; float v[32];
#define TR_PARAMS(it_) do { int r = (it_); \
        if (r < I_WIN_) { const int nb = r % (PCP / 32), kb = r / (PCP / 32); W = X.in(I_WIN) + (size_t)l * D * PC; ldw = PC; k0 = 64 * kb; n0 = 32 * nb; nvalid = PC; outp = X.ws<bf16>(WS_WIN) + (size_t)n0 * D; ldo = D; } \
        else if ((r -= I_WIN_) < I_WB_) { const int s_ = r / ((RW / 64) * (D / 32)), q = r % ((RW / 64) * (D / 32)), nb = q % (D / 32), kb = q / (D / 32); \
            W = X.in(I_WBR) + ((size_t)l * 2 + s_) * RW * D; ldw = D; k0 = 64 * kb; n0 = 32 * nb; nvalid = D; outp = X.ws<bf16>(WS_WB) + (size_t)s_ * D * RW + (size_t)n0 * RW; ldo = RW; } \
        else if ((r -= I_WB_) < I_WO_) { const int nb = r % (D / 32), kb = r / (D / 32); W = X.in(I_WOUT) + (size_t)l * D * D; ldw = D; k0 = 64 * kb; n0 = 32 * nb; nvalid = D; outp = X.ws<bf16>(WS_WO) + (size_t)n0 * D; ldo = D; } \
        else if ((r -= I_WO_) < I_WGU_) { const int per = KB_D * (D / 32), es = r / per, q = r % per, e = es >> 1, src = es & 1, nb = q % (D / 32), kb = q / (D / 32); n0 = 32 * nb; \
            W = (src ? X.in(I_WU) : X.in(I_WG)) + ((size_t)l * NE + e) * D * D; ldw = D; k0 = 64 * kb; nvalid = D; const int orow = e * 2 * D + (n0 / 128) * 256 + src * 128 + (n0 % 128); \
            outp = X.ws<bf16>(WS_WGU) + (size_t)orow * D; ldo = D; } \
        else { r -= I_WGU_; const int per = KB_D * (D / 32), e = r / per, q = r % per, nb = q % (D / 32), kb = q / (D / 32); \
            W = X.in(I_WD) + ((size_t)l * NE + e) * D * D; ldw = D; k0 = 64 * kb; n0 = 32 * nb; nvalid = D; outp = X.ws<bf16>(WS_WD) + (size_t)(e * D + n0) * D; ldo = D; } } while (0)
#define TR_LOAD() do { const int n = n0 + (lane & 31); const float* wp = W + (size_t)(k0 + (lane >> 5)) * ldw + n; _Pragma("unroll") for (int i = 0; i < 32; ++i) v[i] = (n < nvalid) ? wp[(size_t)(2 * i) * ldw] : 0.f; } while (0)
    if (it < it_end) { TR_PARAMS(it); TR_LOAD(); }
    while (it < it_end) {
#pragma unroll
        for (int i = 0; i < 32; ++i) scr[(2 * i + (lane >> 5)) * 33 + (lane & 31)] = v[i];
        WAVE_LDS_FENCE(); CFENCE();
        bf16* const cout_ = outp; const int ck0 = k0, cldo = ldo;
        it += NGW;
        if (it < it_end) { TR_PARAMS(it); TR_LOAD(); }
        const int c = lane & 7;
#pragma unroll
        for (int j = 0; j < 4; ++j) { const int n = (lane >> 3) + 8 * j; const LAS float* s_ = scr + (8 * c) * 33 + n;
            u32x4 o; o[0] = pk2(s_[0 * 33], s_[1 * 33]); o[1] = pk2(s_[2 * 33], s_[3 * 33]); o[2] = pk2(s_[4 * 33], s_[5 * 33]); o[3] = pk2(s_[6 * 33], s_[7 * 33]);
            *(u32x4*)(cout_ + (size_t)n * cldo + ck0 + 8 * c) = o; }
        WAVE_LDS_FENCE(); CFENCE();
    }
#undef TR_PARAMS
#undef TR_LOAD
}
__device__ __forceinline__ void phase_filter_weights(const Ctx& X, int l) {
    bf16* FWT = X.ws<bf16>(WS_FWT);
    for (int idx = X.bid * NTHR + X.tid; idx < (3 * 64 + HW) * 64; idx += X.G * NTHR) { const int o = idx >> 6, k = idx & 63; float v;
        if (o < 64) v = k < 33 ? X.in(I_FW1)[(size_t)l * 33 * 64 + k * 64 + o] : 0.f;
        else if (o < 128) v = X.in(I_FW2)[(size_t)l * 64 * 64 + k * 64 + (o - 64)];
        else if (o < 192) v = X.in(I_FW3)[(size_t)l * 64 * 64 + k * 64 + (o - 128)];
        else v = X.in(I_FWO)[(size_t)l * 64 * HW + (size_t)k * HW + (o - 192)];
        FWT[idx] = (bf16)f2bf(v); }
}
constexpr int FPART_OFF = 65536;
static_assert(FPART_OFF + 2 * HW * 4 <= LDS_STAGE && 2 * 16 * LP * 2 <= 8192, "filter LDS map");
__device__ __forceinline__ void phase_filters_begin(const Ctx& X) {
    LAS float* part = (LAS float*)(X.lds + FPART_OFF);
    for (int i = X.tid; i < 2 * HW; i += NTHR) part[i] = 0.f;
    __syncthreads();
}
__device__ __forceinline__ void phase_filters_item(const Ctx& X, int l_, int which_, int it_) {
    const int vz = vgpr_zero(), l = l_ + vz, which = which_ + vz, it = it_ + vz;
    LAS bf16* za = (LAS bf16*)(X.lds + X.wave * 8192); LAS bf16* zb = za + 16 * LP;
    const int n = which ? CTX : SEQ; float* out = X.wsv<float>(WS_FILT) + (which ? (size_t)HW * SEQ : 0);
    filter_item(X, l, n, 16 * it, out, za, zb, (LAS float*)(X.lds + FPART_OFF) + which * HW);
}
__device__ __forceinline__ void phase_filters_end(const Ctx& X) {
    const LAS float* part = (const LAS float*)(X.lds + FPART_OFF);
    __syncthreads();
    for (int i = X.tid; i < 2 * HW; i += NTHR) X.ws<float>(WS_FPART)[((size_t)(i / HW) * NPART + X.bid) * HW + (i % HW)] = part[i];
    __syncthreads();
}
__device__ __forceinline__ void phase_mod(const Ctx& X) {
    const int lane = X.lane, w = X.wave;
    LAS float* sc = (LAS float*)X.lds;
    LAS float* red = sc + 2 * D;
    { const float* cv = X.in(I_C); const float* cc = X.in(I_CCTX);
      for (int k = X.tid; k < D; k += NTHR) { const float c0 = cv[k], c1 = cc[k]; sc[2 * k] = c0 * sigmoidf_(c0); sc[2 * k + 1] = c1 * sigmoidf_(c1); } }
    __syncthreads();
    constexpr int CT = 96, NCT = 6 * D / CT, NIT = DEPTH * NCT, KW = D / NWAVES;
    static_assert((6 * D) % CT == 0 && KW % 16 == 0, "mod tiling");
    for (int it = X.bid; it < NIT; it += X.G) {
        const int ll = it / NCT, n0 = (it % NCT) * CT, l48 = lane < 48 ? lane : lane - 48;
        const float* W = X.in(I_WMOD) + (size_t)ll * D * 6 * D + n0 + 2 * l48;
        float a00 = 0.f, a01 = 0.f, a10 = 0.f, a11 = 0.f;
        for (int k0 = w * KW; k0 < (w + 1) * KW; k0 += 16) {
            float wx[16], wy[16];
#pragma unroll
            for (int j = 0; j < 16; ++j) { const unsigned long long q = *(const unsigned long long*)(W + (size_t)(k0 + j) * 6 * D); wx[j] = bitsf((unsigned)q); wy[j] = bitsf((unsigned)(q >> 32)); }
            SCHED_BARRIER();
#pragma unroll
            for (int j = 0; j < 16; ++j) { const float s0 = sc[2 * (k0 + j)], s1 = sc[2 * (k0 + j) + 1]; a00 += s0 * wx[j]; a01 += s0 * wy[j]; a10 += s1 * wx[j]; a11 += s1 * wy[j]; } }
        if (lane < 48) { LAS float* r = red + (w * CT + 2 * lane) * 2; r[0] = a00; r[1] = a10; r[2] = a01; r[3] = a11; }
        __syncthreads();
        if (X.tid < CT) { float t0 = 0.f, t1 = 0.f;
#pragma unroll
            for (int ww = 0; ww < NWAVES; ++ww) { t0 += red[(ww * CT + X.tid) * 2]; t1 += red[(ww * CT + X.tid) * 2 + 1]; }
            const float bm = X.in(I_BMOD)[(size_t)ll * 6 * D + n0 + X.tid];
            float* MOD = X.ws<float>(WS_MOD);
            MOD[((size_t)ll * 2 + 0) * 6 * D + n0 + X.tid] = t0 + bm; MOD[((size_t)ll * 2 + 1) * 6 * D + n0 + X.tid] = t1 + bm; }
        __syncthreads();
    }
}
__device__ __forceinline__ const float* modp(const Ctx& X, int l, int t, int j) { return X.ws<float>(WS_MOD) + ((size_t)l * 2 + (t < CTX ? 1 : 0)) * 6 * D + (size_t)j * D; }

__device__ __forceinline__ void phase_x0(const Ctx& X) {
    const int gw = X.bid * NWAVES + X.wave, NGW = X.G * NWAVES, lane = X.lane;
    for (int t = gw; t < M; t += NGW) {
        const float* src = t < CTX ? X.in(I_CTX) + (size_t)t * D : X.in(I_X) + (size_t)(t - CTX) * D;
        const float* sh = modp(X, 0, t, 0); const float* sc = modp(X, 0, t, 1);
        float* xr = X.ws<float>(WS_X) + (size_t)t * D; bf16* xm = X.ws<bf16>(WS_XMOD) + (size_t)t * D;
#pragma unroll
        for (int j = 0; j < D / 256; ++j) { const int d = 4 * lane + 256 * j; const f32x4 v = *(const f32x4*)(src + d), a = *(const f32x4*)(sh + d), b = *(const f32x4*)(sc + d);
            *(f32x4*)(xr + d) = v;
            unsigned w0 = pk2(v[0] * (1.f + b[0]) + a[0], v[1] * (1.f + b[1]) + a[1]), w1 = pk2(v[2] * (1.f + b[2]) + a[2], v[3] * (1.f + b[3]) + a[3]);
            *(unsigned long long*)(xm + d) = (unsigned long long)w0 | ((unsigned long long)w1 << 32); }
    }
}

__device__ __forceinline__ int shift_row(int t, int col, bool& valid) {
    const bool isctx = t < CTX;
    const int i = t - CTX, gx = i & (GRID_W - 1), gy = i / GRID_W, q = col / QTR;
    const int offl = (q == 0) ? -1 : (q == 1) ? 1 : (q == 2) ? -GRID_W : GRID_W;
    const bool vl = (q == 0) ? (gx > 0) : (q == 1) ? (gx < GRID_W - 1) : (q == 2) ? (gy > 0) : (gy < GRID_H - 1);
    const bool first = col < HALFC;
    const int offc = first ? -1 : 1; const bool vc = first ? (t > 0) : (t < CTX - 1);
    valid = isctx ? vc : vl;
    return valid ? t + (isctx ? offc : offl) : t;
}
__device__ __forceinline__ float pm_val(const bf16* P, const float* mu, int t, int col) {
    const float p0 = bf2f(P[(size_t)t * PCP + col]); bool valid; const int nr = shift_row(t, col, valid);
    const float pn = bf2f(P[(size_t)nr * PCP + col]); const float p1 = valid ? pn : 0.f;
    return p0 + (p1 - p0) * mu[col];
}
__device__ __forceinline__ f32x4 mm_tile(const LAS bf16* A, const LAS bf16* Bt, int ti, int tj, int lane, f32x4 acc) {
    const LAS bf16* pa = A + (16 * ti + (lane & 15)) * LP + 8 * (lane >> 4); const LAS bf16* pb = Bt + (16 * tj + (lane & 15)) * LP + 8 * (lane >> 4);
#pragma unroll
    for (int kk = 0; kk < 2; ++kk) { const bf16x8 a = *(const LAS bf16x8*)(pa + 32 * kk), b = *(const LAS bf16x8*)(pb + 32 * kk); acc = MFMA16(a, b, acc); }
    return acc;
}
struct PmLd { float p0, pn, m; bool valid; };
__device__ __forceinline__ PmLd pm_ld(const bf16* P, const float* mu, int t, int col) {
    PmLd r; bool valid; const int nr = shift_row(t, col, valid); r.p0 = bf2f(P[(size_t)t * PCP + col]); r.pn = bf2f(P[(size_t)nr * PCP + col]); r.m = mu[col]; r.valid = valid; return r; }
__device__ __forceinline__ float pm_fin(const PmLd& r) { const float p1 = r.valid ? r.pn : 0.f; return r.p0 + (p1 - r.p0) * r.m; }
constexpr int TT = 8;
__device__ __forceinline__ void phase_lin(const Ctx& X, int l) {
    const bf16* P = X.ws<bf16>(WS_P); const float* mu = X.in(I_MU) + (size_t)l * RC; bf16* LIN = X.ws<bf16>(WS_LIN);
    for (size_t idx = (size_t)X.bid * NTHR + X.tid; idx < (size_t)M * 384; idx += (size_t)X.G * NTHR) { const int t = (int)(idx / 384), j = (int)(idx % 384);
        float v = pm_val(P, mu, t, C_LWF + j);
        if (j < 128) v = 1.0f - 2.0f * frcp(fexp(2.0f * v) + 1.0f); else if (j >= 256) v = sigmoidf_(v);
        LIN[idx] = (bf16)f2bf(v); }
}
__device__ __forceinline__ f32x4 mm_tile_p(const LAS bf16* A, int lda, const LAS bf16* Bt, int ldb, int ks, int ti, int tj, int lane, f32x4 acc) {
    const LAS bf16* pa = A + (16 * ti + (lane & 15)) * lda + 8 * (lane >> 4); const LAS bf16* pb = Bt + (16 * tj + (lane & 15)) * ldb + 8 * (lane >> 4);
    for (int kk = 0; kk < ks; ++kk) { const bf16x8 a = *(const LAS bf16x8*)(pa + 32 * kk), b = *(const LAS bf16x8*)(pb + 32 * kk); acc = MFMA16(a, b, acc); }
    return acc;
}
constexpr int GP = 136;
__device__ __forceinline__ void lora_unit_a(const Ctx& X, int unit) {
    const int b = unit / NH, h = unit % NH, tid = X.tid, lane = X.lane, w = X.wave;
    LAS bf16* Ab = (LAS bf16*)X.lds; LAS bf16* Gb = Ab + 4 * 64 * LP; LAS bf16* Wb = Gb + 64 * GP; LAS bf16* G2b = Wb + 4 * 64 * LP;
    LAS float* OUT = (LAS float*)X.lds;
    static_assert((8 * 64 * LP + 2 * 64 * GP) * 2 <= LDS_STAGE && 5 * 64 * LQ * 4 <= LDS_STAGE, "lora LDS map");
    const bf16* LIN = X.wsv<bf16>(WS_LIN) + (size_t)(64 * b) * 384;
    const bf16* w2t = X.wsv<bf16>(WS_W2T) + (size_t)(64 * h) * 64; const bf16* a2t = X.wsv<bf16>(WS_A2T) + (size_t)(64 * h) * 64; const bf16* g2t = X.wsv<bf16>(WS_G2T) + (size_t)(64 * h) * 128;
    static_assert(64 * 48 == 6 * NTHR && 4 * 64 * 8 == 4 * NTHR && 64 * 16 == 2 * NTHR, "lora operand copies");
    u32x4 v1[6], v2[4], v3[2];
#pragma unroll
    for (int j = 0; j < 6; ++j) { const int i = tid + j * NTHR, t = i / 48, c16 = i % 48; v1[j] = *(const u32x4*)(LIN + (size_t)t * 384 + 8 * c16); }
#pragma unroll
    for (int j = 0; j < 4; ++j) { const int i = tid + j * NTHR, q = i / 512, c = (i / 8) % 64, c16 = i % 8; const bf16* src = (q < 2 ? w2t + (size_t)q * RW * 64 : a2t + (size_t)(q - 2) * RW * 64) + c * 64 + 8 * c16; v2[j] = *(const u32x4*)src; }
#pragma unroll
    for (int j = 0; j < 2; ++j) { const int i = tid + j * NTHR, c = i / 16, c16 = i % 16; v3[j] = *(const u32x4*)(g2t + c * 128 + 8 * c16); }
    SCHED_BARRIER();
#pragma unroll
    for (int j = 0; j < 6; ++j) { const int i = tid + j * NTHR, t = i / 48, c16 = i % 48;
        if (c16 < 32) *(LAS u32x4*)(Ab + (c16 >> 3) * 64 * LP + t * LP + 8 * (c16 & 7)) = v1[j]; else *(LAS u32x4*)(Gb + t * GP + 8 * (c16 - 32)) = v1[j]; }
#pragma unroll
    for (int j = 0; j < 4; ++j) { const int i = tid + j * NTHR, q = i / 512, c = (i / 8) % 64, c16 = i % 8; *(LAS u32x4*)(Wb + q * 64 * LP + c * LP + 8 * c16) = v2[j]; }
#pragma unroll
    for (int j = 0; j < 2; ++j) { const int i = tid + j * NTHR, c = i / 16, c16 = i % 16; *(LAS u32x4*)(G2b + c * GP + 8 * c16) = v3[j]; }
    __syncthreads();
    f32x4 o[2][5];
#pragma unroll
    for (int q = 0; q < 2; ++q) { const int tile = 2 * w + q, ti = tile >> 2, tj = tile & 3; const f32x4 z4 = {0.f, 0.f, 0.f, 0.f};
#pragma unroll
        for (int p = 0; p < 4; ++p) o[q][p] = mm_tile(Ab + p * 64 * LP, Wb + p * 64 * LP, ti, tj, lane, z4);
        o[q][4] = mm_tile_p(Gb, GP, G2b, GP, 4, ti, tj, lane, z4); }
    __syncthreads();
#pragma unroll
    for (int q = 0; q < 2; ++q) { const int tile = 2 * w + q, ti = tile >> 2, tj = tile & 3, col = 16 * tj + (lane & 15);
#pragma unroll
        for (int p = 0; p < 5; ++p)
#pragma unroll
            for (int r = 0; r < 4; ++r) OUT[(p * 64 + 16 * ti + 4 * (lane >> 4) + r) * LQ + col] = o[q][p][r]; }
    __syncthreads();
}
__device__ __forceinline__ void lora_unit_b(const Ctx& X, int l, int unit) {
    const int b = unit / NH, h = unit % NH, w = X.wave, k = X.lane, c = 64 * h + k;
    const LAS float* OUT = (const LAS float*)X.lds;
    const bf16* P = X.wsv<bf16>(WS_P); const float* mu = X.inv(I_MU) + (size_t)l * RC;
    const float w00 = X.inv(I_W0)[(size_t)(l * 2 + 0) * RW + c], w01 = X.inv(I_W0)[(size_t)(l * 2 + 1) * RW + c];
    const float a00 = X.inv(I_A0)[(size_t)(l * 2 + 0) * RW + c], a01 = X.inv(I_A0)[(size_t)(l * 2 + 1) * RW + c];
    const float kkc = X.inv(I_KK)[(size_t)l * RW + c], kac = X.inv(I_KA)[(size_t)l * RW + c], rkc = X.inv(I_RK)[(size_t)l * RW + c];
    bf16* pR = X.wsv<bf16>(WS_R); bf16* pV = X.wsv<bf16>(WS_V); bf16* pKA = X.wsv<bf16>(WS_KA); bf16* pKD = X.wsv<bf16>(WS_KD); bf16* pKB = X.wsv<bf16>(WS_KB); float* pW = X.wsv<float>(WS_W); bf16* pG = X.wsv<bf16>(WS_GATE); float* pBo = X.wsv<float>(WS_BONUS);
    const int vz = vgpr_zero();
    float p0[3][8], pn[3][8]; unsigned vmask = 0u; const float mu0 = mu[c], mu1 = mu[C_K + c], mu2 = mu[C_V + c];
#pragma unroll
    for (int i = 0; i < 8; ++i) { const int t = 64 * b + 8 * w + i + vz;
#pragma unroll
        for (int q = 0; q < 3; ++q) { const int col = (q == 0 ? 0 : q == 1 ? C_K : C_V) + c; bool valid; const int nr = shift_row(t, col, valid);
            p0[q][i] = bf2f(P[(size_t)t * PCP + col]); pn[q][i] = bf2f(P[(size_t)nr * PCP + col]); vmask |= (valid ? 1u : 0u) << (3 * i + q); } }
    float bonv[8];
#pragma unroll
    for (int i = 0; i < 8; ++i) { const int tl = 8 * w + i, t = 64 * b + tl + vz;
        const float r = p0[0][i] + ((((vmask >> (3 * i + 0)) & 1u) ? pn[0][i] : 0.f) - p0[0][i]) * mu0;
        const float kx = p0[1][i] + ((((vmask >> (3 * i + 1)) & 1u) ? pn[1][i] : 0.f) - p0[1][i]) * mu1;
        const float v = p0[2][i] + ((((vmask >> (3 * i + 2)) & 1u) ? pn[2][i] : 0.f) - p0[2][i]) * mu2;
        const float wd0 = -DECAY_SCALE * sigmoidf_(w00 + OUT[(0 * 64 + tl) * LQ + k]), wd1 = -DECAY_SCALE * sigmoidf_(w01 + OUT[(1 * 64 + tl) * LQ + k]);
        const float ad0 = sigmoidf_(a00 + OUT[(2 * 64 + tl) * LQ + k]), ad1 = sigmoidf_(a01 + OUT[(3 * 64 + tl) * LQ + k]);
        const float kkr = kx * kkc; const float n2 = wave_sum(kkr * kkr); const float kk = kkr * frcp(fmaxf(sqrtf(n2), 1e-12f));
        const float kd0 = kx * (1.f + (ad0 - 1.f) * kac), kd1 = kx * (1.f + (ad1 - 1.f) * kac);
        bonv[i] = wave_sum(r * (kd0 + kd1) * rkc);
        const size_t o = (size_t)t * RW + c, o1 = (size_t)(M + t) * RW + c;
        pR[o] = (bf16)f2bf(r); pV[o] = (bf16)f2bf(v); pKA[o] = (bf16)f2bf(-kk);
        pKD[o] = (bf16)f2bf(kd0); pKD[o1] = (bf16)f2bf(kd1); pKB[o] = (bf16)f2bf(kk * ad0); pKB[o1] = (bf16)f2bf(kk * ad1);
        pW[o] = wd0; pW[o1] = wd1; pG[o] = (bf16)f2bf(OUT[(4 * 64 + tl) * LQ + k]); }
    if (k < 8) { float bs = bonv[0];
#pragma unroll
        for (int i = 1; i < 8; ++i) bs = (k == i) ? bonv[i] : bs;
        pBo[(size_t)(64 * b + 8 * w + k) * NH + h] = bs; }
    __syncthreads();
}
__device__ __forceinline__ void phase_prep_hyena(const Ctx& X, int l) {
    const bf16* P = X.ws<bf16>(WS_P); const int c = X.tid;
    if (c < HW) {
        const float* cw = X.in(I_CW) + (size_t)l * 3 * HC; const float* cb = X.in(I_CB) + (size_t)l * HC;
        float cw0[3], cw1[3], cw2[3], cbv[3];
#pragma unroll
        for (int j = 0; j < 3; ++j) { const int hc = j * HW + c; cw0[j] = cw[hc]; cw1[j] = cw[HC + hc]; cw2[j] = cw[2 * HC + hc]; cbv[j] = cb[hc]; }
        float* ZT = X.ws<float>(WS_ZT) + (size_t)c * M; float* Zc = X.ws<float>(WS_Z); bf16* X0 = X.ws<bf16>(WS_X0);
        for (int tile = X.bid; tile < M / TT; tile += X.G) { const int t0 = tile * TT; float zz[TT];
            float pv[3][TT + 2]; const bool hp0 = (t0 != 0 && t0 != CTX), hnl = (t0 + TT != CTX && t0 + TT != M);
#pragma unroll
            for (int j = 0; j < 3; ++j) { const int col = C_HY + j * HW + c;
#pragma unroll
                for (int i = 0; i < TT + 2; ++i) { const int t = t0 - 1 + i; const bool ok = (i == 0) ? hp0 : (i == TT + 1) ? hnl : true; pv[j][i] = bf2f(P[(size_t)(ok ? t : t0) * PCP + col]); } }
            SCHED_BARRIER();
#pragma unroll
            for (int j = 0; j < 3; ++j) { pv[j][0] = hp0 ? pv[j][0] : 0.f; pv[j][TT + 1] = hnl ? pv[j][TT + 1] : 0.f; }
#pragma unroll
            for (int tt = 0; tt < TT; ++tt) { const int t = t0 + tt;
                float u[3];
#pragma unroll
                for (int j = 0; j < 3; ++j) u[j] = pv[j][tt] * cw0[j] + pv[j][tt + 1] * cw1[j] + pv[j][tt + 2] * cw2[j] + cbv[j];
                zz[tt] = u[2] * u[1]; if (t < CTX) Zc[(size_t)t * HW + c] = zz[tt];
                X0[(size_t)t * HW + c] = (bf16)f2bf(u[0]); }
            *(f32x4*)(ZT + t0) = (f32x4){zz[0], zz[1], zz[2], zz[3]}; *(f32x4*)(ZT + t0 + 4) = (f32x4){zz[4], zz[5], zz[6], zz[7]}; }
    }
}

constexpr int CC = 64, NCHK = M / CC;
static_assert(CTX % CC == 0 && SEQ % CC == 0, "chunks must not straddle the context/latent boundary");
__device__ __forceinline__ int scan_row(int d, int s) { return d == 0 ? s : (s < CTX ? CTX - 1 - s : M - 1 - (s - CTX)); }
__device__ __forceinline__ void chunk_unit_1(const Ctx& X, int unit) {
    const int d = unit / (NCHK * NH), c = (unit / NH) % NCHK, h = unit % NH;
    LAS bf16* An = (LAS bf16*)X.lds;            LAS bf16* Bn = An + 64 * LP; LAS bf16* Kn = Bn + 64 * LP; LAS bf16* Rn = Kn + 64 * LP; LAS bf16* Vt = Rn + 64 * LP;
    LAS bf16* Bh = Vt + 64 * LP;                LAS bf16* Kh = Bh + 64 * LP; LAS bf16* Lak = Kh + 64 * LP; LAS bf16* Mrb = Lak + 64 * LP; LAS bf16* Mrk = Mrb + 64 * LP;
    LAS float* Lab = (LAS float*)(Mrk + 64 * LP); LAS float* XsW = Lab + 64 * LX;
    LAS float* XsU = (LAS float*)An;
    LAS bf16* Wt = Lak; LAS bf16* Ut = (LAS bf16*)((LAS unsigned char*)An + 64 * LX * 4);
    LAS float* tot = Lab;
    LAS float* dC = (LAS float*)(X.lds + LDS_MISC + 1024);
    static_assert(10 * 64 * LP * 2 + 2 * 64 * LX * 4 <= LDS_STAGE && 64 * LX * 4 + 64 * LP * 2 <= 3 * 64 * LP * 2, "chunk LDS map");
    const int tid = X.tid, lane = X.lane, w = X.wave, k = tid & 63;
    float lw[8], cum[8]; bf16 rr[8], rv[8], rka[8], rkd[8], rkb[8];
    { float run = 0.f; const float* pW = X.wsv<float>(WS_W);
      const bf16* pR = X.wsv<bf16>(WS_R); const bf16* pV = X.wsv<bf16>(WS_V); const bf16* pKA = X.wsv<bf16>(WS_KA); const bf16* pKD = X.wsv<bf16>(WS_KD); const bf16* pKB = X.wsv<bf16>(WS_KB);
#pragma unroll
      for (int i = 0; i < 8; ++i) { const int row = scan_row(d, c * CC + 8 * w + i); lw[i] = pW[((size_t)d * M + row) * RW + h * 64 + k]; }
#pragma unroll
      for (int i = 0; i < 8; ++i) { const int row = scan_row(d, c * CC + 8 * w + i); const size_t o = (size_t)row * RW + h * 64 + k, od = ((size_t)d * M + row) * RW + h * 64 + k;
          rr[i] = pR[o]; rv[i] = pV[o]; rka[i] = pKA[o]; rkd[i] = pKD[od]; rkb[i] = pKB[od]; }
      SCHED_BARRIER();
#pragma unroll
      for (int i = 0; i < 8; ++i) { run += lw[i]; cum[i] = run; }
      tot[w * 64 + k] = run; }
    __syncthreads();
    float off = 0.f, cumC = 0.f;
#pragma unroll
    for (int ww = 0; ww < 8; ++ww) { const float t = tot[ww * 64 + k]; off += (ww < w) ? t : 0.f; cumC += t; }
    __syncthreads();
    { unsigned pv[4], pbh[4], pkh[4]; float af[8];
#pragma unroll
      for (int i = 0; i < 8; ++i) { const int t = 8 * w + i;
          const float ct = off + cum[i], cp = ct - lw[i];
          const float r = bf2f(rr[i]), v = bf2f(rv[i]), ka = bf2f(rka[i]), kd = bf2f(rkd[i]), kb = bf2f(rkb[i]);
          const float ei = fexp(-ct), eh = fexp(cumC - ct);
          const float at = ka * fexp(cp); af[i] = at;
          An[t * LP + k] = (bf16)f2bf(at); Bn[t * LP + k] = (bf16)f2bf(kb * ei); Kn[t * LP + k] = (bf16)f2bf(kd * ei); Rn[t * LP + k] = (bf16)f2bf(r * fexp(ct));
          const unsigned bv = f2bf(v), bb = f2bf(kb * eh), bk = f2bf(kd * eh);
          if (i & 1) { pv[i >> 1] |= bv << 16; pbh[i >> 1] |= bb << 16; pkh[i >> 1] |= bk << 16; } else { pv[i >> 1] = bv; pbh[i >> 1] = bb; pkh[i >> 1] = bk; } }
      *(LAS u32x4*)(Vt + k * LP + 8 * w) = (u32x4){pv[0], pv[1], pv[2], pv[3]}; *(LAS u32x4*)(Bh + k * LP + 8 * w) = (u32x4){pbh[0], pbh[1], pbh[2], pbh[3]}; *(LAS u32x4*)(Kh + k * LP + 8 * w) = (u32x4){pkh[0], pkh[1], pkh[2], pkh[3]};
      *(LAS f32x4*)(XsW + k * LX + 8 * w) = (f32x4){af[0], af[1], af[2], af[3]}; *(LAS f32x4*)(XsW + k * LX + 8 * w + 4) = (f32x4){af[4], af[5], af[6], af[7]}; }
    if (tid < 64) dC[tid] = fexp(cumC);
    __syncthreads();
#pragma unroll 1
    for (int q = 0; q < 2; ++q) { const int tile = 2 * w + q, ti = tile >> 2, tj = tile & 3; const f32x4 z4 = {0.f, 0.f, 0.f, 0.f};
        const f32x4 ab = mm_tile(An, Bn, ti, tj, lane, z4), ak = mm_tile(An, Kn, ti, tj, lane, z4), rb = mm_tile(Rn, Bn, ti, tj, lane, z4), rk = mm_tile(Rn, Kn, ti, tj, lane, z4);
        const int col = 16 * tj + (lane & 15);
#pragma unroll
        for (int r = 0; r < 4; ++r) { const int row = 16 * ti + 4 * (lane >> 4) + r; const bool lo = col < row, le = col <= row;
            Lab[row * LX + col] = lo ? ab[r] : 0.f; Lak[row * LP + col] = (bf16)f2bf(lo ? ak[r] : 0.f); Mrb[row * LP + col] = (bf16)f2bf(le ? rb[r] : 0.f); Mrk[row * LP + col] = (bf16)f2bf(le ? rk[r] : 0.f); } }
    __syncthreads();
}
__device__ __forceinline__ void chunk_unit_2(const Ctx& X, int unit) {
    const int d = unit / (NCHK * NH), c = (unit / NH) % NCHK, h = unit % NH;
    LAS bf16* An = (LAS bf16*)X.lds;            LAS bf16* Bn = An + 64 * LP; LAS bf16* Kn = Bn + 64 * LP; LAS bf16* Rn = Kn + 64 * LP; LAS bf16* Vt = Rn + 64 * LP;
    LAS bf16* Bh = Vt + 64 * LP;                LAS bf16* Kh = Bh + 64 * LP; LAS bf16* Lak = Kh + 64 * LP; LAS bf16* Mrb = Lak + 64 * LP; LAS bf16* Mrk = Mrb + 64 * LP;
    LAS float* Lab = (LAS float*)(Mrk + 64 * LP); LAS float* XsW = Lab + 64 * LX;
    LAS float* XsU = (LAS float*)An;
    LAS bf16* Wt = Lak; LAS bf16* Ut = (LAS bf16*)((LAS unsigned char*)An + 64 * LX * 4);
    LAS float* tot = Lab;
    LAS float* dC = (LAS float*)(X.lds + LDS_MISC + 1024);
    static_assert(10 * 64 * LP * 2 + 2 * 64 * LX * 4 <= LDS_STAGE && 64 * LX * 4 + 64 * LP * 2 <= 3 * 64 * LP * 2, "chunk LDS map");
    const int tid = X.tid, lane = X.lane, w = X.wave, k = tid & 63;
    f32x4 r2[2]; int r2col[2], r2row[2];
#pragma unroll
    for (int q = 0; q < 2; ++q) { const int tile = 2 * w + q, ti = tile >> 2, tj = tile & 3; const f32x4 z4 = {0.f, 0.f, 0.f, 0.f};
        const f32x4 a = mm_tile(Lak, Vt, ti, tj, lane, z4); const int col = 16 * tj + (lane & 15);
        r2[q] = a; r2col[q] = col; r2row[q] = 16 * ti + 4 * (lane >> 4); }
    __syncthreads();
#pragma unroll
    for (int q = 0; q < 2; ++q) *(LAS f32x4*)(XsU + r2col[q] * LX + r2row[q]) = r2[q];
    __syncthreads();
    LAS bf16* Tii = (LAS bf16*)(X.lds + LDS_MISC + 8448);
    constexpr int TP = 40;
    static_assert(8448 + 4 * 16 * TP * 2 <= LDS_BYTES - LDS_MISC, "T_ii image");
    if (tid < 64) { const int bi = tid >> 4, j = tid & 15; float xv[16];
#pragma unroll
        for (int t = 0; t < 16; ++t) { float acc = (t == j) ? 1.f : 0.f;
#pragma unroll
            for (int s2 = 0; s2 < t; ++s2) acc += Lab[(16 * bi + t) * LX + 16 * bi + s2] * xv[s2];
            xv[t] = acc; }
#pragma unroll
        for (int t = 0; t < 16; ++t) { Tii[(bi * 16 + t) * TP + j] = (bf16)f2bf(xv[t]); Tii[(bi * 16 + t) * TP + 16 + j] = (bf16)0; } }
    __syncthreads();
    { LAS float* xsx = (w < 4 ? XsW + 16 * w * LX : XsU + 16 * (w - 4) * LX) + (lane & 15) * LX;
      LAS bf16* dst = (w < 4 ? Wt + 16 * w * LP : Ut + 16 * (w - 4) * LP) + (lane & 15) * LP;
      const int kof = 8 * (lane >> 4); const bf16x8 zero8 = {0, 0, 0, 0, 0, 0, 0, 0};
#pragma unroll
      for (int i = 0; i < 4; ++i) {
          f32x4 acc = *(const LAS f32x4*)(xsx + 16 * i + 4 * (lane >> 4));
#pragma unroll
          for (int kk = 0; kk < (16 * i + 31) / 32; ++kk) { const int s0 = 32 * kk + kof;
              const f32x4 l0 = *(const LAS f32x4*)(Lab + (16 * i + (lane & 15)) * LX + s0), l1 = *(const LAS f32x4*)(Lab + (16 * i + (lane & 15)) * LX + s0 + 4);
              u32x4 pa = {pk2(l0[0], l0[1]), pk2(l0[2], l0[3]), pk2(l1[0], l1[1]), pk2(l1[2], l1[3])};
              bf16x8 av = __builtin_bit_cast(bf16x8, pa), bv = *(const LAS bf16x8*)(dst + s0);
              if (s0 >= 16 * i) { av = zero8; bv = zero8; }
              acc = MFMA16(av, bv, acc); }
          LAS bf16* zt = (LAS bf16*)(xsx + 16 * i);
          *(LAS unsigned long long*)(zt + 4 * (lane >> 4)) = (unsigned long long)pk2(acc[0], acc[1]) | ((unsigned long long)pk2(acc[2], acc[3]) << 32);
          WAVE_LDS_FENCE(); CFENCE();
          const bf16x8 a2 = *(const LAS bf16x8*)(Tii + (i * 16 + (lane & 15)) * TP + kof); bf16x8 b2 = zero8; if (kof < 16) b2 = *(const LAS bf16x8*)(zt + kof);
          f32x4 xi = {0.f, 0.f, 0.f, 0.f}; xi = MFMA16(a2, b2, xi);
          *(LAS unsigned long long*)(dst + 16 * i + 4 * (lane >> 4)) = (unsigned long long)pk2(xi[0], xi[1]) | ((unsigned long long)pk2(xi[2], xi[3]) << 32);
          WAVE_LDS_FENCE(); CFENCE(); } }
    __syncthreads();
}
__device__ __forceinline__ void chunk_unit_3(const Ctx& X, int unit) {
    const int d = unit / (NCHK * NH), c = (unit / NH) % NCHK, h = unit % NH;
    LAS bf16* An = (LAS bf16*)X.lds;            LAS bf16* Bn = An + 64 * LP; LAS bf16* Kn = Bn + 64 * LP; LAS bf16* Rn = Kn + 64 * LP; LAS bf16* Vt = Rn + 64 * LP;
    LAS bf16* Bh = Vt + 64 * LP;                LAS bf16* Kh = Bh + 64 * LP; LAS bf16* Lak = Kh + 64 * LP; LAS bf16* Mrb = Lak + 64 * LP; LAS bf16* Mrk = Mrb + 64 * LP;
    LAS float* Lab = (LAS float*)(Mrk + 64 * LP); LAS float* XsW = Lab + 64 * LX;
    LAS float* XsU = (LAS float*)An;
    LAS bf16* Wt = Lak; LAS bf16* Ut = (LAS bf16*)((LAS unsigned char*)An + 64 * LX * 4);
    LAS float* tot = Lab;
    LAS float* dC = (LAS float*)(X.lds + LDS_MISC + 1024);
    static_assert(10 * 64 * LP * 2 + 2 * 64 * LX * 4 <= LDS_STAGE && 64 * LX * 4 + 64 * LP * 2 <= 3 * 64 * LP * 2, "chunk LDS map");
    const int tid = X.tid, lane = X.lane, w = X.wave, k = tid & 63;
    const float dCk = dC[k];
    const size_t ubase = ((size_t)(d * NH + h) * NCHK + c);
    bf16* PTg = (bf16*)(X.wsv<float>(WS_PQ) + ubase * 2 * 4096); float* Qg = X.wsv<float>(WS_PQ) + ubase * 2 * 4096 + 4096;     bf16* Gg = X.wsv<bf16>(WS_G) + ubase * 4096; float* Yg = X.wsv<float>(WS_YL) + ubase * 4096;
#pragma unroll 1
    for (int q = 0; q < 2; ++q) { const int tile = 2 * w + q, ti = tile >> 2, tj = tile & 3; const f32x4 z4 = {0.f, 0.f, 0.f, 0.f};
        const f32x4 p = mm_tile(Wt, Bh, ti, tj, lane, z4); f32x4 qq = mm_tile(Ut, Bh, ti, tj, lane, z4); qq = mm_tile(Vt, Kh, ti, tj, lane, qq);
        const f32x4 g = mm_tile(Mrb, Wt, ti, tj, lane, z4); f32x4 y = mm_tile(Mrb, Ut, ti, tj, lane, z4); y = mm_tile(Mrk, Vt, ti, tj, lane, y);
        const int col = 16 * tj + (lane & 15); const float dcol = __shfl(dCk, col);
        { const int row0 = 16 * ti + 4 * (lane >> 4); float pv[4];
#pragma unroll
          for (int r = 0; r < 4; ++r) pv[r] = p[r] + ((row0 + r) == col ? dcol : 0.f);
          *(unsigned long long*)(PTg + col * 64 + row0) = (unsigned long long)pk2(pv[0], pv[1]) | ((unsigned long long)pk2(pv[2], pv[3]) << 32); }
#pragma unroll
        for (int r = 0; r < 4; ++r) { const int row = 16 * ti + 4 * (lane >> 4) + r;
            Qg[row * 64 + col] = qq[r];
            const int orow = d ? 63 - row : row;
            Gg[orow * 64 + col] = (bf16)f2bf(g[r] + bf2f(Rn[row * LP + col])); }
        { const int gq = lane >> 4; const int cti = d ? 3 - ti : ti, cg = d ? 3 - gq : gq; const f32x4 yv = d ? (f32x4){y[3], y[2], y[1], y[0]} : y;
          *(f32x4*)(Yg + ((cti * 4 + tj) * 64 + 16 * cg + (lane & 15)) * 4) = yv; } }
    __syncthreads();
}
__device__ __forceinline__ void seq_unit(const Ctx& X, int su) {
    const int d = su / (NH * 4), h = (su / 4) % NH, qv = su & 3;
    constexpr int PD = 9, RING = PD + 1, SLOTB = 8192 + 4096;
    LAS unsigned char* ring = X.lds;
    LAS bf16* S = (LAS bf16*)(ring + RING * SLOTB);
    static_assert(RING * SLOTB + 2 * 16 * LP * 2 <= LDS_STAGE && (PD - 1) * 6 <= 63, "seq LDS map / vmcnt range");
    const int lane = X.lane, w = X.wave, tj = w & 3, col = 16 * tj + (lane & 15), kq = lane >> 4, kof = 8 * kq;
    const bool worker = w < 4;
    const unsigned char* PQ = (const unsigned char*)(X.ws<float>(WS_PQ) + (size_t)(d * NH + h) * NCHK * 2 * 4096); bf16* S0g = X.ws<bf16>(WS_S0) + (size_t)(d * NH + h) * NCHK * 4096 + (size_t)(16 * qv) * 64;
#define SEQ_FILL(c_) do { const unsigned char* p_ = PQ + (size_t)(c_) * 32768; LAS unsigned char* sl_ = ring + ((c_) % RING) * SLOTB; \
        GLDS16(p_ + 16 * (w * 64 + lane), sl_ + 16 * (w * 64)); GLDS16(p_ + 16384 + (16 * qv) * 256 + 16 * ((w & 3) * 64 + lane), sl_ + 8192 + 16 * ((w & 3) * 64)); } while (0)
#pragma unroll
    for (int i = 0; i < PD; ++i) if (i < NCHK) SEQ_FILL(i);
    for (int i = X.tid; i < 2 * 16 * LP / 2; i += NTHR) ((LAS unsigned*)S)[i] = 0u;
    if (worker) {
#pragma unroll
        for (int r = 0; r < 4; ++r) S0g[(4 * kq + r) * 64 + col] = (bf16)0; }
    for (int c = 0; c < NCHK; ++c) {
        if (c + PD - 1 < NCHK) { if (worker) { ASM_WAIT_V(48); } else { ASM_WAIT_V(16); } } else { ASM_WAIT_V(0); }
        ASM_WAIT_L(0); S_BARRIER(); CFENCE();
        if (c + PD < NCHK) SEQ_FILL(c + PD);
        if (worker) {
            const LAS bf16* PT = (const LAS bf16*)(ring + (c % RING) * SLOTB); const LAS float* Q = (const LAS float*)(ring + (c % RING) * SLOTB + 8192);
            const LAS bf16* Sc = S + (c & 1) * 16 * LP; LAS bf16* Sn = S + ((c + 1) & 1) * 16 * LP;
            f32x4 acc;
#pragma unroll
            for (int r = 0; r < 4; ++r) acc[r] = Q[(4 * kq + r) * 64 + col];
#pragma unroll
            for (int kk = 0; kk < 2; ++kk) acc = MFMA16(*(const LAS bf16x8*)(Sc + (lane & 15) * LP + kof + 32 * kk), *(const LAS bf16x8*)(PT + (16 * tj + (lane & 15)) * 64 + kof + 32 * kk), acc);
#pragma unroll
            for (int r = 0; r < 4; ++r) { const bf16 sb = (bf16)f2bf(acc[r]); Sn[(4 * kq + r) * LP + col] = sb; if (c + 1 < NCHK) S0g[(size_t)(c + 1) * 4096 + (4 * kq + r) * 64 + col] = sb; } }
    }
    ASM_WAIT_V(0);
    __syncthreads();
#undef SEQ_FILL
}
constexpr int CR = 16;
__device__ __forceinline__ void conv_item(const Ctx& X, int item) {
    constexpr int NCG = HW / 64; constexpr int n = CTX;
    const int cg = item % NCG, ob = item / NCG, i0 = CR * ob, c = cg * 64 + X.lane;
    const float* F = X.ws<float>(WS_FILT) + (size_t)HW * SEQ + (size_t)c * CTX; const float* Z = X.ws<float>(WS_Z) + c;
    const float* fp = X.ws<float>(WS_FPART) + (size_t)NPART * HW + c;
    float nsum = 0.f; for (int b = 0; b < NPART; ++b) nsum += fp[(size_t)b * HW];
    float acc[CR], Q[CR];
#pragma unroll
    for (int r = 0; r < CR; ++r) acc[r] = 0.f;
    int jb = i0 - n / 2; if (jb < 0) jb = 0;
    int jend = i0 + n / 2 + CR; if (jend > n) jend = n;
    int Tb = i0 - jb + n / 2;
#pragma unroll
    for (int x = 1; x < CR; ++x) { const int T = Tb + x; Q[x] = (T >= 0 && T < n) ? F[T] : 0.f; }
    Q[0] = 0.f;
    for (; jb < jend; jb += CR, Tb -= CR) {
#pragma unroll
        for (int s = 0; s < CR; ++s) { const int T = Tb - s, j = jb + s;
            if ((s & 3) == 0) CFENCE();
            Q[(CR - s) & (CR - 1)] = (T >= 0 && T < n) ? F[T] : 0.f;
            const float zj = (j < n) ? Z[(size_t)j * HW] : 0.f;
#pragma unroll
            for (int r = 0; r < CR; ++r) acc[r] += Q[(r - s + CR) & (CR - 1)] * zj; }
    }
    const float inv = 1.0f / nsum; float* O = X.ws<float>(WS_CONV) + c;
#pragma unroll
    for (int r = 0; r < CR; ++r) O[(size_t)(i0 + r) * HW] = acc[r] * inv;
}

#ifdef EMU
struct cf { float x, y; };
#else
typedef float cf __attribute__((ext_vector_type(2)));
#endif
__device__ __forceinline__ cf cmul(cf a, cf b) { return cf{a.x * b.x - a.y * b.y, a.x * b.y + a.y * b.x}; }
__device__ __forceinline__ cf cadd(cf a, cf b) { return cf{a.x + b.x, a.y + b.y}; }
__device__ __forceinline__ cf csub(cf a, cf b) { return cf{a.x - b.x, a.y - b.y}; }
__device__ __forceinline__ cf cconj(cf a) { return cf{a.x, -a.y}; }
constexpr int FN = SEQ;
constexpr int flog4(int n) { return n <= 1 ? 0 : 1 + flog4(n / 4); }
constexpr int FLOG4 = flog4(FN), FSQ = 1 << FLOG4;
static_assert((1 << (2 * FLOG4)) == FN && FN * 8 <= LDS_STAGE, "FFT length must be a power of 4 that fits the LDS stage region");
constexpr int FFT_TAB_OFF = LDS_MISC + 2048;
static_assert(FFT_TAB_OFF + 2 * FSQ * 8 <= LDS_BYTES, "FFT twiddle tables");
__device__ __forceinline__ void fft_tables(const Ctx& X) {
    LAS cf* T = (LAS cf*)(X.lds + FFT_TAB_OFF);
    for (int i = X.tid; i < 2 * FSQ; i += NTHR) { const int k = i < FSQ ? i * FSQ : i - FSQ; float s, c; sincos_f(-6.283185307179586f * (float)k / (float)FN, s, c); T[i] = cf{c, s}; }
    __syncthreads();
}
__device__ __forceinline__ cf fft_tw(const LAS cf* T, int k) { const cf a = T[k >> FLOG4], b = T[FSQ + (k & (FSQ - 1))]; return cmul(a, b); }
__device__ __forceinline__ int rev4(int k) { int r = 0;
#pragma unroll
    for (int s = 0; s < FLOG4; ++s) { r = (r << 2) | (k & 3); k >>= 2; }
    return r; }
__device__ __forceinline__ void fft_stage_q1(LAS cf* x, int tid, bool inverse) {
    for (int u = tid; u < FN / 4; u += NTHR) { LAS f32x4* px = (LAS f32x4*)(x + 4 * u); const f32x4 v01 = px[0], v23 = px[1];
        const cf a0{v01[0], v01[1]}, a1{v01[2], v01[3]}, a2{v23[0], v23[1]}, a3{v23[2], v23[3]};
        const cf t0 = cadd(a0, a2), t1 = csub(a0, a2), t2 = cadd(a1, a3), d = csub(a1, a3), t3 = inverse ? cf{-d.y, d.x} : cf{d.y, -d.x};
        const cf y0 = cadd(t0, t2), y1 = cadd(t1, t3), y2 = csub(t0, t2), y3 = csub(t1, t3);
        px[0] = (f32x4){y0.x, y0.y, y1.x, y1.y}; px[1] = (f32x4){y2.x, y2.y, y3.x, y3.y}; }
    __syncthreads();
}
__device__ __forceinline__ void dif4(cf& a0, cf& a1, cf& a2, cf& a3, cf w1) {
    const cf w2 = cmul(w1, w1), w3 = cmul(w2, w1);
    const cf t0 = cadd(a0, a2), t1 = csub(a0, a2), t2 = cadd(a1, a3), d = csub(a1, a3), t3 = cf{d.y, -d.x};
    a0 = cadd(t0, t2); a1 = cmul(cadd(t1, t3), w1); a2 = cmul(csub(t0, t2), w2); a3 = cmul(csub(t1, t3), w3);
}
__device__ __forceinline__ void dit4(cf& a0, cf& a1, cf& a2, cf& a3, cf w1c) {
    const cf w2 = cmul(w1c, w1c), w3 = cmul(w2, w1c);
    a1 = cmul(a1, w1c); a2 = cmul(a2, w2); a3 = cmul(a3, w3);
    const cf t0 = cadd(a0, a2), t1 = csub(a0, a2), t2 = cadd(a1, a3), d = csub(a1, a3), t3 = cf{-d.y, d.x};
    a0 = cadd(t0, t2); a1 = cadd(t1, t3); a2 = csub(t0, t2); a3 = csub(t1, t3);
}
__device__ __forceinline__ void fft_pair(LAS cf* x, const LAS cf* T, int tid, int s, bool inverse) {
    const int q1 = FN >> (2 * s + 2), q2 = q1 >> 2, tw1 = 1 << (2 * s), tw2 = tw1 << 2;
    for (int u = tid; u < FN / 16; u += NTHR) { const int j2 = u & (q2 - 1), base = (u - j2) * 16 + j2;
        cf v[4][4];
#pragma unroll
        for (int a = 0; a < 4; ++a)
#pragma unroll
            for (int b = 0; b < 4; ++b) v[a][b] = x[base + a * q1 + b * q2];
        if (!inverse) {
#pragma unroll
            for (int b = 0; b < 4; ++b) dif4(v[0][b], v[1][b], v[2][b], v[3][b], fft_tw(T, (b * q2 + j2) * tw1));
            const cf wb = fft_tw(T, j2 * tw2);
#pragma unroll
            for (int a = 0; a < 4; ++a) dif4(v[a][0], v[a][1], v[a][2], v[a][3], wb);
        } else {
            const cf wb = cconj(fft_tw(T, j2 * tw2));
#pragma unroll
            for (int a = 0; a < 4; ++a) dit4(v[a][0], v[a][1], v[a][2], v[a][3], wb);
#pragma unroll
            for (int b = 0; b < 4; ++b) dit4(v[0][b], v[1][b], v[2][b], v[3][b], cconj(fft_tw(T, (b * q2 + j2) * tw1)));
        }
#pragma unroll
        for (int a = 0; a < 4; ++a)
#pragma unroll
            for (int b = 0; b < 4; ++b) x[base + a * q1 + b * q2] = v[a][b]; }
    __syncthreads();
}
__device__ __forceinline__ void fft_single(LAS cf* x, const LAS cf* T, int tid, int s, bool inverse) {
    const int q = FN >> (2 * s + 2), tw = 1 << (2 * s);
    for (int u = tid; u < FN / 4; u += NTHR) { const int j = u & (q - 1), p = (u - j) * 4 + j;
        cf a0 = x[p], a1 = x[p + q], a2 = x[p + 2 * q], a3 = x[p + 3 * q];
        if (!inverse) dif4(a0, a1, a2, a3, fft_tw(T, j * tw)); else dit4(a0, a1, a2, a3, cconj(fft_tw(T, j * tw)));
        x[p] = a0; x[p + q] = a1; x[p + 2 * q] = a2; x[p + 3 * q] = a3; }
    __syncthreads();
}
constexpr int fft_npairs() { int n = 0; for (int s = 0; s + 1 < FLOG4 - 1; s += 2) { if ((FN >> (2 * s + 6)) >= 64 || FN < 16384) ++n; else break; } return n; }
constexpr int FPAIRS = fft_npairs();
__device__ __forceinline__ void fft_run(LAS cf* x, const LAS cf* T, int tid, bool inverse) {
    constexpr int NST = FPAIRS + (FLOG4 - 1 - 2 * FPAIRS) + 1;
#pragma unroll 1
    for (int i = 0; i < NST; ++i) { const int k = inverse ? NST - 1 - i : i;
        if (k < FPAIRS) fft_pair(x, T, tid, 2 * k, inverse);
        else if (k < NST - 1) fft_single(x, T, tid, 2 * FPAIRS + (k - FPAIRS), inverse);
        else fft_stage_q1(x, tid, inverse); }
}
__device__ __forceinline__ void fft_fwd(LAS cf* x, const LAS cf* T, int tid) { fft_run(x, T, tid, false); }
__device__ __forceinline__ void fft_inv(LAS cf* x, const LAS cf* T, int tid) { fft_run(x, T, tid, true); }
__device__ __forceinline__ void fft_load_real(LAS cf* x, const float* src, float scale, int tid) {
    constexpr int NV = (FN / 4 + NTHR - 1) / NTHR; constexpr bool FULL = (FN / 4) % NTHR == 0;
    f32x4 v[NV];
#pragma unroll
    for (int j = 0; j < NV; ++j) { const int i = tid + j * NTHR; v[j] = (f32x4){0.f, 0.f, 0.f, 0.f}; if (FULL || i < FN / 4) v[j] = *(const f32x4*)(src + 4 * i); }
    SCHED_BARRIER();
#pragma unroll
    for (int j = 0; j < NV; ++j) { const int i = tid + j * NTHR; if (FULL || i < FN / 4) { *(LAS f32x4*)(x + 2 * i) = v[j] * scale; *(LAS f32x4*)(x + FN / 2 + 2 * i) = (f32x4){0.f, 0.f, 0.f, 0.f}; } }
    __syncthreads();
}
__device__ __forceinline__ void spec_load(const Ctx& X, int c) {
    LAS cf* x = (LAS cf*)X.lds; volatile LAS float* red = (volatile LAS float*)(X.lds + LDS_MISC) + 120;
    if (X.wave == 0) { const float* fp = X.ws<float>(WS_FPART) + c; float s = 0.f; for (int b = X.lane; b < NPART; b += 64) s += fp[(size_t)b * HW]; s = wave_sum(s); if (X.lane == 0) red[0] = s; }
    __syncthreads();
    const float inv = 1.0f / red[0];
    fft_load_real(x, X.ws<float>(WS_FILT) + (size_t)c * SEQ, inv, X.tid);
}
__device__ __forceinline__ void spec_unpack(const Ctx& X, int c) {
    LAS cf* x = (LAS cf*)X.lds;
    cf* HS = X.ws<cf>(WS_HS) + (size_t)c * (FN + 1);
    for (int k = X.tid; k <= FN / 2; k += NTHR) {
        const cf A = x[rev4(k)], B = x[rev4((FN - k) & (FN - 1))];
        if (k == 0) { HS[0] = cf{A.x + A.y, 0.f}; HS[FN] = cf{A.x - A.y, 0.f}; }
        else if (k == FN / 2) { HS[k] = cconj(A); }
        else { float sn, cs; sincos_f(-3.14159265358979f * (float)k / (float)FN, sn, cs); const cf w{cs, sn};
            const cf s1 = cadd(A, cconj(B)), d1 = csub(A, cconj(B)), wd = cmul(w, d1);
            HS[k] = cf{0.5f * (s1.x + wd.y), 0.5f * (s1.y - wd.x)};
            const cf s2 = cadd(B, cconj(A)), d2 = csub(B, cconj(A)), wd2 = cmul(cconj(w), d2);
            HS[FN - k] = cf{0.5f * (s2.x - wd2.y), 0.5f * (s2.y + wd2.x)}; } }
    __syncthreads();
}
__device__ __forceinline__ void fftconv_load(const Ctx& X, int c) { fft_load_real((LAS cf*)X.lds, X.ws<float>(WS_ZT) + (size_t)c * M + CTX, 1.0f, X.tid); }
__device__ __forceinline__ void fftconv_mul(const Ctx& X, int c) {
    LAS cf* x = (LAS cf*)X.lds;
    const cf* HS = X.ws<cf>(WS_HS) + (size_t)c * (FN + 1);
    constexpr bool FULLM = (FN / 2) % (4 * NTHR) == 0;
    for (int k0 = X.tid; k0 < FN / 2; k0 += 4 * NTHR) {
        cf hk4[4], hn4[4];
#pragma unroll
        for (int j = 0; j < 4; ++j) { const int k = k0 + j * NTHR; hk4[j] = cf{0.f, 0.f}; hn4[j] = cf{0.f, 0.f}; if (FULLM || k < FN / 2) { hk4[j] = HS[k]; hn4[j] = HS[FN - k]; } }
        SCHED_BARRIER();
#pragma unroll
        for (int j = 0; j < 4; ++j) { const int k = k0 + j * NTHR; const cf hk = hk4[j], hn = hn4[j];
            if (FULLM || k < FN / 2) {
                const int pa = rev4(k), pb = rev4((FN - k) & (FN - 1)); const cf A = x[pa], B = x[pb];
                if (k == 0) { const float y0 = (A.x + A.y) * hk.x, yn = (A.x - A.y) * hn.x; x[pa] = cf{0.5f * (y0 + yn), 0.5f * (y0 - yn)}; }
                else { float sn, cs; sincos_f(-3.14159265358979f * (float)k / (float)FN, sn, cs); const cf w{cs, sn};
                    const cf s1 = cadd(A, cconj(B)), d1 = csub(A, cconj(B)), wd = cmul(w, d1); const cf Xk{0.5f * (s1.x + wd.y), 0.5f * (s1.y - wd.x)};
                    const cf s2 = cadd(B, cconj(A)), d2 = csub(B, cconj(A)), wd2 = cmul(cconj(w), d2); const cf Xn{0.5f * (s2.x - wd2.y), 0.5f * (s2.y + wd2.x)};
                    const cf Yk = cmul(Xk, hk), Yn = cmul(Xn, hn);
                    const cf e1 = cadd(Yk, cconj(Yn)), f1 = cmul(cconj(w), csub(Yk, cconj(Yn)));
                    x[pa] = cf{0.5f * (e1.x - f1.y), 0.5f * (e1.y + f1.x)};
                    const cf e2 = cadd(Yn, cconj(Yk)), f2 = cmul(w, csub(Yn, cconj(Yk)));
                    x[pb] = cf{0.5f * (e2.x + f2.y), 0.5f * (e2.y - f2.x)}; } } } }
    if (X.tid == 0) { const int pa = rev4(FN / 2); const cf A = x[pa]; x[pa] = cconj(cmul(cconj(A), HS[FN / 2])); }
    __syncthreads();
}
__device__ __forceinline__ void fftconv_out(const Ctx& X, int l, int c) {
    const LAS cf* x = (const LAS cf*)X.lds; const float* z = X.ws<float>(WS_ZT) + (size_t)c * M + CTX;
    const float bias = X.in(I_HBIAS)[(size_t)l * HW + c], sc = 1.0f / (float)FN; float* O = X.ws<float>(WS_CVT) + (size_t)c * SEQ;
    constexpr int NV = (FN / 4 + NTHR - 1) / NTHR; constexpr bool FULL = (FN / 4) % NTHR == 0; f32x4 zv[NV];
#pragma unroll
    for (int j = 0; j < NV; ++j) { const int i = X.tid + j * NTHR; zv[j] = (f32x4){0.f, 0.f, 0.f, 0.f}; if (FULL || i < FN / 4) zv[j] = *(const f32x4*)(z + 4 * i); }
    SCHED_BARRIER();
#pragma unroll
    for (int j = 0; j < NV; ++j) { const int i = X.tid + j * NTHR; if (FULL || i < FN / 4) { const f32x4 d = *(const LAS f32x4*)(x + 2 * i + FN / 4); *(f32x4*)(O + 4 * i) = d * sc + zv[j] * bias; } }
    __syncthreads();
}
__device__ __forceinline__ void phase_ctxconv(const Ctx& X, int l) {
    constexpr int NITEMS = (HW / 64) * (CTX / CR);
    unsigned* q = X.ctl() + CW_Q + l * 64;
    for (;;) { int item = 0; if (X.lane == 0) item = (int)atomicAdd(q, 1u); item = __shfl(item, 0); if (item >= NITEMS) break; conv_item(X, item); }
}
__device__ __forceinline__ void phase_seq(const Ctx& X) {
    for (int su = X.bid; su < N_SEQ_UNITS; su += X.G) seq_unit(X, su);
}

__device__ __forceinline__ void finish_wave_unit(const Ctx& X, int l, int unit) {
    const int rg = unit / NH, h = unit % NH, lane = X.lane, b = rg >> 2, sub = rg & 3;
    const int cf = b, cb = (b < CTX / CC) ? (CTX / CC - 1 - b) : (NCHK - 1 - (b - CTX / CC));
    const size_t uf = ((size_t)(0 * NH + h) * NCHK + cf) * 4096, ub = ((size_t)(1 * NH + h) * NCHK + cb) * 4096;
    const bf16* G = X.wsv<bf16>(WS_G); const bf16* S0 = X.wsv<bf16>(WS_S0); const float* YL = X.wsv<float>(WS_YL);
    const int arow = 16 * sub + (lane & 15), kof = 8 * (lane >> 4);
    bf16x8 af[2], ab[2];
#pragma unroll
    for (int kk = 0; kk < 2; ++kk) { af[kk] = *(const bf16x8*)(G + uf + arow * 64 + kof + 32 * kk); ab[kk] = *(const bf16x8*)(G + ub + arow * 64 + kof + 32 * kk); }
    f32x4 y[4]; bf16x8 bf_[4][2], bb_[4][2]; f32x4 ylf[4], ylb[4];
#pragma unroll
    for (int tj = 0; tj < 4; ++tj) { const int vrow = 16 * tj + (lane & 15);
#pragma unroll
        for (int kk = 0; kk < 2; ++kk) { bf_[tj][kk] = *(const bf16x8*)(S0 + uf + vrow * 64 + kof + 32 * kk); bb_[tj][kk] = *(const bf16x8*)(S0 + ub + vrow * 64 + kof + 32 * kk); }
    }
    SCHED_BARRIER();
#pragma unroll
    for (int tj = 0; tj < 4; ++tj) { f32x4 acc = {0.f, 0.f, 0.f, 0.f};
#pragma unroll
        for (int kk = 0; kk < 2; ++kk) { acc = MFMA16(af[kk], bf_[tj][kk], acc); acc = MFMA16(ab[kk], bb_[tj][kk], acc); }
        y[tj] = acc; }
    SCHED_BARRIER();
    const float* lgp = X.inv(I_LNXG) + (size_t)l * RW + 64 * h; const float* lbp = X.inv(I_LNXB) + (size_t)l * RW + 64 * h;
    const bf16* pV = X.wsv<bf16>(WS_V); const bf16* pG = X.wsv<bf16>(WS_GATE); const float* pBo = X.wsv<float>(WS_BONUS); bf16* pRO = X.wsv<bf16>(WS_RO);
    float lgv[4], lbv[4], bonv[4]; bf16 vv[4][4], gv[4][4];
#pragma unroll
    for (int tj = 0; tj < 4; ++tj) { const int cl = 16 * tj + (lane & 15); lgv[tj] = lgp[cl]; lbv[tj] = lbp[cl];
        ylf[tj] = *(const f32x4*)(YL + uf + ((sub * 4 + tj) * 64 + lane) * 4); ylb[tj] = *(const f32x4*)(YL + ub + ((sub * 4 + tj) * 64 + lane) * 4); }
#pragma unroll
    for (int r = 0; r < 4; ++r) { const int t = 16 * rg + 4 * (lane >> 4) + r; bonv[r] = pBo[(size_t)t * NH + h];
#pragma unroll
        for (int tj = 0; tj < 4; ++tj) { const size_t o = (size_t)t * RW + 64 * h + 16 * tj + (lane & 15); vv[r][tj] = pV[o]; gv[r][tj] = pG[o]; } }
    SCHED_BARRIER();
#pragma unroll
    for (int tj = 0; tj < 4; ++tj) y[tj] += ylf[tj] + ylb[tj];
#pragma unroll
    for (int r = 0; r < 4; ++r) { const int t = 16 * rg + 4 * (lane >> 4) + r;
        const float mean = row16_sum((y[0][r] + y[1][r]) + (y[2][r] + y[3][r])) * (1.f / 64.f);
        float q = 0.f;
#pragma unroll
        for (int tj = 0; tj < 4; ++tj) { const float dy = y[tj][r] - mean; q += dy * dy; }
        const float rstd = 1.0f / sqrtf(row16_sum(q) * (1.f / 64.f) + GN_EPS); const float bon = bonv[r];
#pragma unroll
        for (int tj = 0; tj < 4; ++tj) { const int cl = 16 * tj + (lane & 15); const size_t o = (size_t)t * RW + 64 * h + cl;
            float yn = (y[tj][r] - mean) * rstd * lgv[tj] + lbv[tj];
            yn += bon * bf2f(vv[r][tj]); yn *= bf2f(gv[r][tj]);
            pRO[o] = (bf16)f2bf(yn); } }
}
__device__ __forceinline__ void phase_finish(const Ctx& X, int l) {
    for (int u = X.bid * NWAVES + X.wave; u < (M / 16) * NH; u += X.G * NWAVES) { if (l == DEPTH - 1 && u < (CTX / 16) * NH) continue; finish_wave_unit(X, l, u); }
    const int c = X.tid;
    if (c < HW) { const float hbc = X.in(I_HBIAS)[(size_t)l * HW + c]; const float* CV = X.ws<float>(WS_CVT) + (size_t)c * SEQ; const bf16* X0 = X.ws<bf16>(WS_X0); bf16* HO = X.ws<bf16>(WS_HO);
        for (int tile = X.bid; tile < M / TT; tile += X.G) { const int t0 = tile * TT; float cv[TT];
            if (l == DEPTH - 1 && t0 < CTX) continue;
            if (t0 < CTX) {
#pragma unroll
                for (int tt = 0; tt < TT; ++tt) { const size_t o = (size_t)(t0 + tt) * HW + c; cv[tt] = X.ws<float>(WS_CONV)[o] + X.ws<float>(WS_Z)[o] * hbc; } }
            else { const f32x4 a = *(const f32x4*)(CV + (t0 - CTX)), b = *(const f32x4*)(CV + (t0 - CTX) + 4);
#pragma unroll
                for (int i = 0; i < 4; ++i) { cv[i] = a[i]; cv[4 + i] = b[i]; } }
#pragma unroll
            for (int tt = 0; tt < TT; ++tt) { const size_t o = (size_t)(t0 + tt) * HW + c; HO[o] = (bf16)f2bf(cv[tt] * bf2f(X0[o])); } } }
}

__device__ __forceinline__ void ln_inplace(float (&v)[D / 64], const float* g, const float* b, int lane) {
    float s = 0.f;
#pragma unroll
    for (int j = 0; j < D / 64; ++j) s += v[j];
    const float mean = wave_sum(s) * (1.f / D); float q = 0.f;
#pragma unroll
    for (int j = 0; j < D / 64; ++j) { v[j] -= mean; q += v[j] * v[j]; }
    const float rstd = 1.0f / sqrtf(wave_sum(q) * (1.f / D) + LN_EPS);
#pragma unroll
    for (int j = 0; j < D / 64; ++j) { const int d = 4 * lane + 256 * (j >> 2) + (j & 3); v[j] = v[j] * rstd * g[d] + b[d]; }
}
__device__ __forceinline__ void phase_norm1(const Ctx& X, int l_) {
    const int l = l_ & 255; const bool dry = (l_ >> 8) != 0;
    const int gw = X.bid * NWAVES + X.wave, NGW = X.G * NWAVES, lane = X.lane;
    const float* lng = X.in(I_LNG) + (size_t)(l * 2 + 0) * D; const float* lnb = X.in(I_LNB) + (size_t)(l * 2 + 0) * D;
    const float* wr = X.in(I_WR); const float* rb = X.in(I_RB);
    const float alpha = sqrtf(sqrtf(2.0f * DEPTH));
    volatile LAS int* hist = (volatile LAS int*)(X.lds + LDS_MISC + 4096);
    if (X.tid < NE) hist[X.tid] = 0;
    LAS float* wl = (LAS float*)X.lds + NWAVES * D;
    for (int i = X.tid; i < D * NE / 4; i += NTHR) ((LAS f32x4*)wl)[i] = ((const f32x4*)wr)[i];
    __syncthreads();
    for (int t = gw; t < M; t += NGW) { if (l == DEPTH - 1 && t < CTX) continue;
        float* xr = X.ws<float>(WS_X) + (size_t)t * D; const float* mx = X.ws<float>(WS_MIX) + (size_t)t * D;
        const float* gate = modp(X, l, t, 2); const float* sh = modp(X, l, t, 3); const float* sc = modp(X, l, t, 4);
        float v[D / 64];
#pragma unroll
        for (int j = 0; j < D / 256; ++j) { const int d = 4 * lane + 256 * j; const f32x4 a = *(const f32x4*)(xr + d), m = *(const f32x4*)(mx + d), gt = *(const f32x4*)(gate + d);
#pragma unroll
            for (int i = 0; i < 4; ++i) v[4 * j + i] = alpha * a[i] + gt[i] * m[i]; }
        ln_inplace(v, lng, lnb, lane);
        bf16* hf = X.ws<bf16>(WS_XMOD) + (size_t)t * D;
        LAS float* hrow = (LAS float*)X.lds + X.wave * D;
#pragma unroll
        for (int j = 0; j < D / 256; ++j) { const int d = 4 * lane + 256 * j; f32x4 o; const f32x4 a = *(const f32x4*)(sh + d), b = *(const f32x4*)(sc + d); f32x4 h;
#pragma unroll
            for (int i = 0; i < 4; ++i) { o[i] = v[4 * j + i]; h[i] = o[i] * (1.f + b[i]) + a[i]; }
            *(f32x4*)((dry ? X.ws<float>(WS_XG) + (size_t)t * D : xr) + d) = o; *(LAS f32x4*)(hrow + d) = h;
            *(unsigned long long*)(hf + d) = (unsigned long long)pk2(h[0], h[1]) | ((unsigned long long)pk2(h[2], h[3]) << 32); }
        WAVE_LDS_FENCE(); CFENCE();
        f32x4 part = {0.f, 0.f, 0.f, 0.f};
#pragma unroll 8
        for (int i = 0; i < D / 16; ++i) { const float hv = hrow[16 * i + (lane >> 2)]; const f32x4 w4 = *(const LAS f32x4*)(wl + 256 * i + 4 * lane);
#pragma unroll
            for (int c = 0; c < 4; ++c) part[c] += hv * w4[c]; }
#pragma unroll
        for (int c = 0; c < 4; ++c) { float p = part[c]; p += __shfl_xor(p, 4); p += __shfl_xor(p, 8); p += __shfl_xor(p, 16); p += __shfl_xor(p, 32); part[c] = p; }
        WAVE_LDS_FENCE(); CFENCE();
        float lg[NE];
#pragma unroll
        for (int e = 0; e < NE; ++e) lg[e] = __shfl(part[e & 3], e >> 2);
        float mxl = lg[0];
#pragma unroll
        for (int e = 1; e < NE; ++e) mxl = fmaxf(mxl, lg[e]);
        float sc_[NE], sum = 0.f;
#pragma unroll
        for (int e = 0; e < NE; ++e) { sc_[e] = expf(lg[e] - mxl); sum += sc_[e]; }
        const float isum = 1.0f / sum; float sel[NE];
#pragma unroll
        for (int e = 0; e < NE; ++e) { sc_[e] *= isum; sel[e] = sc_[e] + rb[e]; }
        int bg = 0; float bgs = -INFINITY;
#pragma unroll
        for (int g = 0; g < 4; ++g) { float m1 = -INFINITY, m2 = -INFINITY;
#pragma unroll
            for (int i = 0; i < 4; ++i) { const float x = sel[4 * g + i]; if (x > m1) { m2 = m1; m1 = x; } else if (x > m2) m2 = x; }
            const float gs = m1 + m2; if (gs > bgs) { bgs = gs; bg = g; } }
        int i0 = 0, i1 = 0; float s0 = -INFINITY, s1 = -INFINITY, p0 = 0.f, p1 = 0.f;
#pragma unroll
        for (int e = 0; e < NE; ++e) { if ((e >> 2) == bg) { const float x = sel[e]; if (x > s0) { s1 = s0; i1 = i0; p1 = p0; s0 = x; i0 = e; p0 = sc_[e]; } else if (x > s1) { s1 = x; i1 = e; p1 = sc_[e]; } } }
        if (lane == 0) { int* ei = X.ws<int>(WS_ROUT) + (size_t)t * 2; float* ew = (float*)(X.ws<int>(WS_ROUT) + (size_t)M * 2) + (size_t)t * 2;
            ei[0] = i0; ei[1] = i1; const float ws_ = 1.0f / (p0 + p1); ew[0] = p0 * ws_; ew[1] = p1 * ws_;
            lds_add(hist + i0, 1); lds_add(hist + i1, 1); }
    }
    __syncthreads();
    if (X.tid < NE && !dry) { const int hc = hist[X.tid]; X.ws<int>(WS_BCNT)[X.bid * NE + X.tid] = hc; atomicAdd(X.ctl() + CW_CNT + l * 64 + X.tid, (unsigned)hc); }
}

__device__ __forceinline__ void moe_table(const Ctx& X, int l, int NT) {
    volatile LAS int* tab = (volatile LAS int*)(X.lds + LDS_MISC) + 8;
    if (X.tid < NE) { const int cnt = (int)__hip_atomic_load(X.ctl() + CW_CNT + l * 64 + X.tid, RLX_AGENT); tab[64 + X.tid] = (cnt + 255) / 256; }
    __syncthreads();
    if (X.tid == 0) { int cum = 0, ts = 0;
        for (int e = 0; e < NE; ++e) { const int tc = tab[64 + e]; tab[e] = cum; tab[32 + e] = ts; cum += tc * NT; ts += tc; }
        tab[16] = cum; }
    __syncthreads();
}
__device__ __forceinline__ void phase_scatter(const Ctx& X, int l) {
    moe_table(X, l, 1);
    volatile LAS int* tab = (volatile LAS int*)(X.lds + LDS_MISC) + 8;
    volatile LAS int* cur = (volatile LAS int*)(X.lds + LDS_MISC + 4096) + 16;
    const int gw = X.bid * NWAVES + X.wave, NGW = X.G * NWAVES, lane = X.lane;
    if (X.tid < NE) cur[X.tid] = tab[32 + X.tid] * 256;
    __syncthreads();
    { const int* bc = X.ws<int>(WS_BCNT) + (X.tid & 15); int pre = 0;
        for (int b = X.tid >> 4; b < X.bid; b += NTHR / 16) pre += bc[b * NE];
        if (pre) lds_add(cur + (X.tid & 15), pre); }
    __syncthreads();
    const int* ei = X.ws<int>(WS_ROUT); int* slot = X.ws<int>(WS_ROUT) + (size_t)M * 4;
    constexpr int NPL = D / 512;
    int ex = 0, ey = 0; { const int tt = gw + lane * NGW; if (tt < M) { ex = ei[2 * tt]; ey = ei[2 * tt + 1]; } }
    int i = 0, t = gw; while (l == DEPTH - 1 && t < CTX) { ++i; t += NGW; }
    u32x4 rowv[NPL];
    if (t < M) { const u32x4* src = (const u32x4*)(X.ws<bf16>(WS_XMOD) + (size_t)t * D);
#pragma unroll
        for (int p = 0; p < NPL; ++p) rowv[p] = src[lane + 64 * p]; }
    while (t < M) { const int tn = t + NGW; u32x4 nxt[NPL];
        { const u32x4* src = (const u32x4*)(X.ws<bf16>(WS_XMOD) + (size_t)(tn < M ? tn : t) * D);
#pragma unroll
          for (int p = 0; p < NPL; ++p) nxt[p] = src[lane + 64 * p]; }
        const int e0 = __shfl(ex, i), e1 = __shfl(ey, i);
        int p0 = 0, p1 = 0; if (lane == 0) { p0 = lds_add(cur + e0, 1); p1 = lds_add(cur + e1, 1); slot[2 * t] = p0; slot[2 * t + 1] = p1; }
        p0 = __shfl(p0, 0); p1 = __shfl(p1, 0);
        u32x4* d0 = (u32x4*)(X.ws<bf16>(WS_XG) + (size_t)p0 * D); u32x4* d1 = (u32x4*)(X.ws<bf16>(WS_XG) + (size_t)p1 * D);
#pragma unroll
        for (int p = 0; p < NPL; ++p) { d0[lane + 64 * p] = rowv[p]; d1[lane + 64 * p] = rowv[p]; }
#pragma unroll
        for (int p = 0; p < NPL; ++p) rowv[p] = nxt[p];
        t = tn; ++i; }
}

__device__ __forceinline__ void phase_combine(const Ctx& X, int l_) {
    const int l = l_ & 255; const bool dry = (l_ >> 8) != 0;
    const int gw = X.bid * NWAVES + X.wave, NGW = X.G * NWAVES, lane = X.lane;
    const float* lng = X.in(I_LNG) + (size_t)(l * 2 + 1) * D; const float* lnb = X.in(I_LNB) + (size_t)(l * 2 + 1) * D;
    const float alpha = sqrtf(sqrtf(2.0f * DEPTH));
    const float* ew = (const float*)(X.ws<int>(WS_ROUT) + (size_t)M * 2); const int* slot = X.ws<int>(WS_ROUT) + (size_t)M * 4;
    const bool bad = __hip_atomic_load(X.ctl() + CW_BAR + XB_TMO, RLX_AGENT) != 0u; const float pscale = 1.0f + bitsf(__hip_atomic_load(X.ctl() + 64, RLX_AGENT));
    for (int t = gw; t < M; t += NGW) { if (l == DEPTH - 1 && t < CTX) continue;
        float* xr = X.ws<float>(WS_X) + (size_t)t * D; const float* gate = modp(X, l, t, 5);
        const bf16* y0 = X.ws<bf16>(WS_YS) + (size_t)slot[2 * t] * D; const bf16* y1 = X.ws<bf16>(WS_YS) + (size_t)slot[2 * t + 1] * D; const float w0 = ew[2 * t], w1 = ew[2 * t + 1];
        float v[D / 64];
#pragma unroll
        for (int j = 0; j < D / 256; ++j) { const int d = 4 * lane + 256 * j; const f32x4 a = *(const f32x4*)(xr + d), gt = *(const f32x4*)(gate + d);
            const unsigned long long q0 = *(const unsigned long long*)(y0 + d), q1 = *(const unsigned long long*)(y1 + d);
            float ya[4] = {bflo((unsigned)q0), bfhi((unsigned)q0), bflo((unsigned)(q0 >> 32)), bfhi((unsigned)(q0 >> 32))};
            float yb[4] = {bflo((unsigned)q1), bfhi((unsigned)q1), bflo((unsigned)(q1 >> 32)), bfhi((unsigned)(q1 >> 32))};
#pragma unroll
            for (int i = 0; i < 4; ++i) v[4 * j + i] = alpha * a[i] + gt[i] * (w0 * ya[i] + w1 * yb[i]); }
        ln_inplace(v, lng, lnb, lane);
        if (l + 1 < DEPTH) { const float* sh = modp(X, l + 1, t, 0); const float* sc = modp(X, l + 1, t, 1); bf16* xm = X.ws<bf16>(WS_XMOD) + (size_t)t * D;
#pragma unroll
            for (int j = 0; j < D / 256; ++j) { const int d = 4 * lane + 256 * j; f32x4 o; const f32x4 a = *(const f32x4*)(sh + d), b = *(const f32x4*)(sc + d); float h[4];
#pragma unroll
                for (int i = 0; i < 4; ++i) { o[i] = v[4 * j + i]; h[i] = o[i] * (1.f + b[i]) + a[i]; }
                *(f32x4*)((dry ? X.ws<float>(WS_XG) + (size_t)t * D : xr) + d) = o;
                *(unsigned long long*)(xm + d) = (unsigned long long)pk2(h[0], h[1]) | ((unsigned long long)pk2(h[2], h[3]) << 32); }
        } else if (t >= CTX) { float* orow = X.out() + (size_t)(t - CTX) * D;
#pragma unroll
            for (int j = 0; j < D / 256; ++j) { const int d = 4 * lane + 256 * j; f32x4 o;
#pragma unroll
                for (int i = 0; i < 4; ++i) o[i] = bad ? __builtin_nanf("") : v[4 * j + i] * pscale;
                *(f32x4*)((dry ? X.ws<float>(WS_XG) + (size_t)t * D : orow) + d) = o; }
        }
    }
}


#ifdef EMU
#define PHASE_FN static
#define THIN_FN static
#else
#define PHASE_FN __device__ __forceinline__
#define THIN_FN __device__ __noinline__
#endif
THIN_FN void ph_transposes(Ctx X, int l, int part) { phase_transposes(X, l, part); }
THIN_FN void ph_filters_begin(Ctx X) { phase_filters_begin(X); }
THIN_FN void ph_filters_item(Ctx X, int l, int which, int it) { phase_filters_item(X, l, which, it); }
THIN_FN void ph_filters_end(Ctx X) { phase_filters_end(X); }
#define PH_FILTERS(X_, l_) do { ph_filters_begin(X_); for (int wh_ = 0; wh_ < 2; ++wh_) for (int it_ = (X_).bid * NWAVES + (X_).wave; it_ < (wh_ ? CTX : SEQ) / 16; it_ += (X_).G * NWAVES) ph_filters_item(X_, l_, wh_, it_); ph_filters_end(X_); } while (0)
THIN_FN void ph_filter_weights(Ctx X, int l) { phase_filter_weights(X, l); }
THIN_FN void ph_mod(Ctx X) { phase_mod(X); }
THIN_FN void ph_x0(Ctx X) { phase_x0(X); }
THIN_FN void ph_lin(Ctx X, int l) { phase_lin(X, l); }
THIN_FN void ph_lora_a(Ctx X, int u) { lora_unit_a(X, u); }
THIN_FN void ph_lora_b(Ctx X, int l, int u) { lora_unit_b(X, l, u); }
THIN_FN void ph_prep_hyena(Ctx X, int l) { phase_prep_hyena(X, l); }
THIN_FN void ph_ctxconv(Ctx X, int l) { phase_ctxconv(X, l); }
THIN_FN void ph_chunk_1(Ctx X, int u) { chunk_unit_1(X, u); }
THIN_FN void ph_chunk_2(Ctx X, int u) { chunk_unit_2(X, u); }
THIN_FN void ph_chunk_3(Ctx X, int u) { chunk_unit_3(X, u); }
THIN_FN void ph_seq(Ctx X) { phase_seq(X); }
THIN_FN void ph_fft_tables(Ctx X) { fft_tables(X); }
THIN_FN void ph_fft_run(Ctx X, int inverse) { fft_run((LAS cf*)X.lds, (const LAS cf*)(X.lds + FFT_TAB_OFF), X.tid, inverse != 0); }
THIN_FN void ph_spec_load(Ctx X, int c) { spec_load(X, c); }
THIN_FN void ph_spec_unpack(Ctx X, int c) { spec_unpack(X, c); }
THIN_FN void ph_fftconv_load(Ctx X, int c) { fftconv_load(X, c); }
THIN_FN void ph_fftconv_mul(Ctx X, int c) { fftconv_mul(X, c); }
THIN_FN void ph_fftconv_out(Ctx X, int l, int c) { fftconv_out(X, l, c); }
THIN_FN void ph_finish(Ctx X, int l) { phase_finish(X, l); }
THIN_FN void ph_norm1(Ctx X, int l) { phase_norm1(X, l); }
THIN_FN void ph_scatter(Ctx X, int l) { phase_scatter(X, l); }
THIN_FN void ph_combine(Ctx X, int l) { phase_combine(X, l); }
PHASE_FN void ph_g13(Ctx X, int third, int r0) { pg8::Gemm g{(third ? X.ws<bf16>(WS_T) : X.ws<bf16>(WS_XMOD)) + (size_t)r0 * D, third ? X.ws<bf16>(WS_WO) : X.ws<bf16>(WS_WIN), D}; pg8::StaticOrder S; S.init(M - r0, third ? D : PCP, X.G, X.bid);
    pg8::EpiBf16OrF32 E{X.ws<bf16>(WS_P) + (size_t)r0 * PCP, X.ws<float>(WS_MIX) + (size_t)r0 * D, third ? D : PCP, third != 0}; pg8::gemm_phase(X.lds, g, S, E); }
PHASE_FN void ph_g2(Ctx X, int second, int r0) { pg8::Gemm g{(second ? X.ws<bf16>(WS_HO) : X.ws<bf16>(WS_RO)) + (size_t)r0 * RW, X.ws<bf16>(WS_WB) + (second ? (size_t)D * RW : 0), RW}; pg8::StaticOrder S; S.init(M - r0, D, X.G, X.bid);
    pg8::EpiGate E{X.ws<bf16>(WS_T) + (size_t)r0 * D, D, X.ws<bf16>(WS_P) + (size_t)r0 * PCP, PCP, second ? C_GH : C_GR, second != 0}; pg8::gemm_phase(X.lds, g, S, E); }
PHASE_FN void ph_g45(Ctx X, int l, int down) { const int NT = down ? D / 256 : 2 * D / 256; moe_table(X, l, NT); pg8::MoeOrder S{(const volatile LAS int*)(X.lds + LDS_MISC) + 8, NT, X.G, X.bid};
    pg8::Gemm g{down ? X.ws<bf16>(WS_ACT) : X.ws<bf16>(WS_XG), down ? X.ws<bf16>(WS_WD) : X.ws<bf16>(WS_WGU), D}; pg8::EpiMoe E{down ? X.ws<bf16>(WS_YS) : X.ws<bf16>(WS_ACT), D, NT, down == 0}; pg8::gemm_phase(X.lds, g, S, E); }

constexpr int NPH = 16, NPHASES = DEPTH * NPH;
template <int MASK> __global__ void __launch_bounds__(NTHR, 2) fwd_kernel(Args args) {
    DYN_LDS(lds);
    Ctx X; X.lds = lds; X.tid = threadIdx.x; X.lane = X.tid & 63; X.wave = READFIRSTLANE(X.tid >> 6); X.G = gridDim.x; X.bid = blockIdx.x;
    volatile LAS unsigned* misc = (volatile LAS unsigned*)(lds + LDS_MISC);
    if (X.tid < 128) misc[X.tid] = 0u;
    if (X.tid < N_IN + 2) { const unsigned long long p = X.tid < N_IN ? (unsigned long long)args.in[X.tid < N_IN ? X.tid : 0] : (X.tid == N_IN ? (unsigned long long)args.out : (unsigned long long)args.ws);
        misc[PT_WORD0 + 2 * X.tid] = (unsigned)p; misc[PT_WORD0 + 2 * X.tid + 1] = (unsigned)(p >> 32); }
    __syncthreads();
    XcdBarrier bar = xcd_barrier_post(X.ctl() + CW_BAR, misc);
    const int lo = args.ph_lo, hi = args.ph_hi;
#define IN(k) ((((MASK) >> ((k) % NPH)) & 1) && lo <= (k) && (k) < hi)
#ifdef PROBE_K
#ifndef PROBE_SCALE
#define PROBE_SCALE 1.0f
#endif
#ifndef PROBE_BLOCK
#define PROBE_BLOCK 0
#endif
    unsigned long long plast = __builtin_amdgcn_s_memrealtime(); if (threadIdx.x < 32) misc[2048 + threadIdx.x] = 0u; __syncthreads();
#define PROBE_TX(k) do { if (blockIdx.x == PROBE_BLOCK && threadIdx.x == 0) { const unsigned long long now_ = __builtin_amdgcn_s_memrealtime(); misc[2048 + (k)] += (unsigned)(now_ - plast); plast = now_; } } while (0)
#define PROBE_T(k) PROBE_TX((k) % NPH)
#ifdef PROBE_KMASK
#define PROBE_PUB(k) do {} while (0)
#else
#define PROBE_PUB(k) do { if ((k) == NPHASES - 2 && blockIdx.x == PROBE_BLOCK && threadIdx.x == 0) { PROBE_T(k); unsigned tot_ = 0; for (int i_ = 0; i_ < 28; ++i_) tot_ += misc[2048 + i_]; \
        const float f_ = floorf(PROBE_SCALE * (float)misc[2048 + PROBE_K] / (float)tot_ * 128.0f + 0.5f) * (1.0f / 128.0f); __hip_atomic_store(X.ctl() + 64, fbits(f_), RLX_AGENT); } } while (0)
#endif
#else
#define PROBE_T(k) do {} while (0)
#define PROBE_TX(k) do {} while (0)
#define PROBE_PUB(k) do {} while (0)
#endif
#if defined(REPEAT_SUB) && REPEAT_SUB == 20
#define SEAM(k) do { if ((k) + 1 < hi) { xcd_barrier(bar); xcd_barrier(bar); } } while (0)
#else
#define SEAM(k) do { PROBE_PUB(k); if ((k) + 1 < hi) xcd_barrier(bar); PROBE_T(k); } while (0)
#endif
#if defined(REPEAT_SUB) && REPEAT_SUB == 15
#define RQN 2
#else
#define RQN 1
#endif
#ifdef REPEAT_SUB
#define RPS(id) for (int rps_ = 0; rps_ < ((id) == REPEAT_SUB ? 2 : 1); ++rps_)
#define RPS_N(id) ((id) == REPEAT_SUB ? 2 : 1)
#define rps_i rps_
#else
#define RPS(id)
#define RPS_N(id) 1
#define rps_i 0
#endif
#ifdef REPEAT_PH
#define RPT_IDX rpt_
#define RPT(k) for (int rpt_ = 0; rpt_ < (((k) % NPH) == REPEAT_PH ? 2 : 1); ++rpt_)
#else
#define RPT_IDX 0
#define RPT(k)
#endif
    for (int l = 0; l < DEPTH; ++l) {
        const int pb = l * NPH;
        if (l == 0 && IN(pb + 0)) { ph_transposes(X, l, 0); __syncthreads(); PROBE_TX(16); ph_filter_weights(X, 0); ph_mod(X); PROBE_TX(17); SEAM(pb + 0); }
        if (l == 0 && IN(pb + 1)) { ph_x0(X); PROBE_TX(18); PH_FILTERS(X, 0); PROBE_TX(19); SEAM(pb + 1); }
        if (IN(pb + 2)) { ph_g13(X, 0, 0); SEAM(pb + 2); }
        RPT(pb + 3) if (IN(pb + 3)) { RPS(6) ph_lin(X, l); RPS(7) ph_prep_hyena(X, l); ph_fft_tables(X); PROBE_TX(20); RPS(8) for (int c = X.bid; c < HW; c += X.G) { ph_spec_load(X, c); ph_fft_run(X, 0); ph_spec_unpack(X, c); } SEAM(pb + 3); }
        RPT(pb + 4) if (IN(pb + 4)) { for (int u = X.bid; u < (M / 64) * NH; u += X.G) { RPS(4) ph_lora_a(X, u); PROBE_TX(21); RPS(5) ph_lora_b(X, l, u); PROBE_TX(22); } SEAM(pb + 4); }
        RPT(pb + 5) if (IN(pb + 5)) { for (int u = X.bid; u < 2 * NCHK * NH; u += X.G) { RPS(1) ph_chunk_1(X, u); PROBE_TX(23); RPS(2) ph_chunk_2(X, u); PROBE_TX(24); RPS(3) ph_chunk_3(X, u); PROBE_TX(25); } SEAM(pb + 5); }
        RPT(pb + 6) if (IN(pb + 6)) { RPS(9) ph_seq(X); PROBE_TX(26); RPS(10) { ph_transposes(X, l, 1); __syncthreads(); } PROBE_TX(27); if (l + 1 < DEPTH) ph_filter_weights(X, l + 1); if (l + 1 < DEPTH) ph_ctxconv(X, l); ph_fft_tables(X); PROBE_TX(28);
            for (int rq_ = 0; rq_ < RQN; ++rq_) for (;;) { if (X.tid == 0) misc[121] = atomicAdd(X.ctl() + CW_Q + l * 64 + 32 + rq_, 1u); __syncthreads(); const int c = (int)misc[121]; __syncthreads(); if (c >= HW) break;
                ph_fftconv_load(X, c); ph_fft_run(X, 0); ph_fftconv_mul(X, c); ph_fft_run(X, 1); ph_fftconv_out(X, l, c); }
            PROBE_TX(29); SEAM(pb + 6); }
        RPT(pb + 7) if (IN(pb + 7)) { ph_finish(X, l); SEAM(pb + 7); }
        for (int sb = 0; sb < 2; ++sb) if (IN(pb + 8 + sb)) { ph_g2(X, sb, l == DEPTH - 1 ? CTX : 0); SEAM(pb + 8 + sb); }
        RPT(pb + 10) if (IN(pb + 10)) { ph_g13(X, 1, l == DEPTH - 1 ? CTX : 0); SEAM(pb + 10); }
        if (IN(pb + 11)) { RPS(28) ph_norm1(X, l | ((RPS_N(28) - 1 - rps_i) << 8)); SEAM(pb + 11); }
        if (IN(pb + 12)) { RPS(14) ph_scatter(X, l); SEAM(pb + 12); }
        for (int dn = 0; dn < 2; ++dn) if (IN(pb + 13 + dn)) { ph_g45(X, l, dn); SEAM(pb + 13 + dn); }
        if (IN(pb + 15)) { RPS(11) ph_combine(X, l | ((RPS_N(11) - 1 - rps_i) << 8)); PROBE_TX(30); if (l + 1 < DEPTH) { __syncthreads(); RPS(12) { ph_transposes(X, l + 1, 0); __syncthreads(); } PROBE_TX(31); RPS(13) PH_FILTERS(X, l + 1); } SEAM(pb + 15); }
    }
#if defined(PROBE_K) && defined(PROBE_KMASK)
    if (blockIdx.x == PROBE_BLOCK && threadIdx.x == 0) { unsigned tot_ = 0; for (int i_ = 0; i_ < 32; ++i_) if ((PROBE_KMASK >> i_) & 1) tot_ += misc[2048 + i_];
        const unsigned long long t0_ = __builtin_amdgcn_s_memrealtime(); while ((unsigned)(__builtin_amdgcn_s_memrealtime() - t0_) < tot_) __builtin_amdgcn_s_sleep(8); }
#endif
#undef IN
#undef SEAM
}

#ifndef N_LAUNCHES
#define N_LAUNCHES 1
#endif
#ifndef PH_MASK
#define PH_MASK 0xffff
#endif
template <int MASK> static void launch_mask(int grid, hipStream_t stream, const Args& a) {
    static bool attr = false;
    if (!attr) { (void)hipFuncSetAttribute((const void*)fwd_kernel<MASK>, hipFuncAttributeMaxDynamicSharedMemorySize, LDS_BYTES); attr = true; }
    hipLaunchKernelGGL(fwd_kernel<MASK>, dim3(grid), dim3(NTHR), LDS_BYTES, stream, a);
}
extern "C" void kernel_launch(void* const* d_in, const int* in_sizes, int n_in, void* d_out, int out_size, void* d_ws, size_t ws_size, hipStream_t stream) {
    static int grid = 0;
    if (grid == 0) {
        if (n_in != N_IN || ws_size < WS_END) { fprintf(stderr, "kernel_launch: unexpected n_in %d or workspace %zu < %zu\n", n_in, ws_size, (size_t)WS_END); grid = -1; return; }
        int dev = 0, cus = 0;
        if (hipGetDevice(&dev) != hipSuccess || hipDeviceGetAttribute(&cus, hipDeviceAttributeMultiprocessorCount, dev) != hipSuccess) { grid = -1; return; }
        (void)hipGetLastError();
        grid = cus; if (grid > NPART) grid = NPART;
    }
    if (grid < 0) return;
    (void)in_sizes; (void)out_size;
    (void)hipMemsetAsync(d_ws, 0, CTL_BYTES, stream);
    Args a;
    for (int i = 0; i < N_IN; ++i) a.in[i] = (const float*)d_in[i];
    a.out = (float*)d_out; a.ws = (unsigned char*)d_ws;
#if N_LAUNCHES == 1
    a.ph_lo = 0; a.ph_hi = NPHASES;
    launch_mask<PH_MASK>(grid, stream, a);
#else
    for (int ph = 0; ph < NPHASES; ++ph) { const int k = ph % NPH; if (k == 1 && ph / NPH != 0) continue; a.ph_lo = ph; a.ph_hi = ph + 1; launch_mask<PH_MASK>(grid, stream, a); }
#endif
}
```
